# Optimizing an MI355X kernel written in HIP

```python
import jax
import jax.numpy as jnp
from jax import lax
import numpy as np

D_MODEL = 1024
BATCH = 16
SEQ = 256
DEPTH = 2
DEC_BATCH = 2
DEC_SEQ = 4096
PAST_LEN = 512

GRID_W = 64
Q_BLOCK = 128
ROPE_THETA = 10000.0
EPS = 1e-6

GQA_HEADS = 8
GQA_KV_HEADS = 2
GQA_REP = GQA_HEADS // GQA_KV_HEADS
GQA_HEAD_DIM = 64
GQA_WIDTH = GQA_HEADS * GQA_HEAD_DIM
GQA_KV_WIDTH = GQA_KV_HEADS * GQA_HEAD_DIM
GLA_HEADS = 4
GLA_DK = 64
GLA_DV = 128
GLA_WIDTH = GLA_HEADS * GLA_DV
GLA_K_WIDTH = GLA_HEADS * GLA_DK
GLA_RANK = 16
GLA_NORMALIZER = 16.0
GLA_CHUNK = 64
MLA_HEADS = 4
MLA_Q_LORA = 256
MLA_KV_LORA = 256
MLA_NOPE_DIM = 64
MLA_ROPE_DIM = 32
MLA_V_DIM = 128
MLA_WIDTH = MLA_HEADS * MLA_V_DIM

IN_SPLITS = (GQA_WIDTH, GQA_KV_WIDTH, GQA_KV_WIDTH, GQA_WIDTH,
             GLA_K_WIDTH, GLA_K_WIDTH, GLA_WIDTH, GLA_WIDTH, GLA_RANK, GLA_RANK,
             MLA_Q_LORA, MLA_KV_LORA, MLA_ROPE_DIM, MLA_WIDTH,
             D_MODEL, D_MODEL, D_MODEL)
N_IN = sum(IN_SPLITS)

kernel_name = 'hybrid_diffusion_gqa_gla_mla_step'


def rms_norm(x, g):
    xf = x.astype(jnp.float32)
    y = xf * lax.rsqrt(jnp.mean(xf * xf, axis=-1, keepdims=True) + EPS)
    return (y * g.astype(jnp.float32)).astype(x.dtype)


def rope_1d(x, pos):
    half = x.shape[-1] // 2
    freqs = ROPE_THETA ** (-jnp.arange(half, dtype=jnp.float32) / half)
    ang = pos[:, None] * freqs
    ang = ang.reshape((1, ang.shape[0]) + (1,) * (x.ndim - 3) + (half,))
    cos, sin = jnp.cos(ang), jnp.sin(ang)
    xf = x.astype(jnp.float32)
    x1, x2 = xf[..., :half], xf[..., half:]
    return jnp.concatenate([x1 * cos - x2 * sin, x1 * sin + x2 * cos], axis=-1).astype(x.dtype)


def axial_rope(x, row, col):
    h = x.shape[-1] // 2
    return jnp.concatenate([rope_1d(x[..., :h], row), rope_1d(x[..., h:], col)], axis=-1)


def block_attention(q, k, v):
    b, nq, g, r, dq = q.shape
    dv = v.shape[-1]
    scale = dq ** -0.5
    qb = q.reshape(b, nq // Q_BLOCK, Q_BLOCK, g, r, dq).swapaxes(0, 1)

    def one_block(qi):
        s = jnp.einsum('bqgrd,bkgd->bgrqk', qi, k).astype(jnp.float32) * scale
        p = jax.nn.softmax(s, axis=-1).astype(v.dtype)
        return jnp.einsum('bgrqk,bkgv->bqgrv', p, v)

    o = lax.map(one_block, qb)
    return o.swapaxes(0, 1).reshape(b, nq, g * r, dv)


def gla_chunked(q, k, v, log_a, s0):
    b, n, h, dk = q.shape
    dv = v.shape[-1]
    nc = n // GLA_CHUNK

    def chunks(t):
        return t.astype(jnp.float32).reshape((b, nc, GLA_CHUNK) + t.shape[2:]).swapaxes(0, 1)

    mask = jnp.tril(jnp.ones((GLA_CHUNK, GLA_CHUNK), dtype=bool))[None, :, :, None, None]

    def step(s, inp):
        qc, kc, vc, gc = inp
        cum = jnp.cumsum(gc, axis=1)
        last = cum[:, -1]
        o_inter = jnp.einsum('bchk,bhkv->bchv', qc * jnp.exp(cum), s)
        decay = jnp.exp(jnp.where(mask, cum[:, :, None] - cum[:, None, :], -jnp.inf))
        att = jnp.einsum('bihk,bjhk,bijhk->bhij', qc, kc, decay)
        o_intra = jnp.einsum('bhij,bjhv->bihv', att, vc)
        s_new = jnp.exp(last)[..., None] * s + jnp.einsum(
            'bjhk,bjhv->bhkv', kc * jnp.exp(last[:, None] - cum), vc)
        return s_new, o_inter + o_intra

    s_fin, o = lax.scan(step, s0.astype(jnp.float32), (chunks(q), chunks(k), chunks(v), chunks(log_a)))
    return o.swapaxes(0, 1).reshape(b, n, h, dv), s_fin


def gla_bidirectional(q, k, v, la_f, la_b, s0_f, s0_b):
    flip = lambda t: jnp.flip(t, axis=1)
    o_f, s_f = gla_chunked(q, k, v, la_f, s0_f)
    o_b, s_b = gla_chunked(flip(q), flip(k), flip(v), flip(la_b), s0_b)
    return o_f + flip(o_b), s_f, s_b


def modulation(cond, w, b):
    m = (jax.nn.silu(cond) @ w + b)[..., None, :]
    return jnp.split(m, 3, axis=-1)


def mixer(h, p, pos, cache):
    bsz, n, _ = h.shape
    z = h @ p['w_in']
    offs = [int(i) for i in np.cumsum(IN_SPLITS)[:-1]]
    (qa, ka, va, ga, qg, kg, vg, gg, rf, rb,
     qlat, kvlat, kr, gc, m1, m2, m3) = jnp.split(z, offs, axis=-1)
    is_ctx = cache is None

    qa = rms_norm(qa.reshape(bsz, n, GQA_KV_HEADS, GQA_REP, GQA_HEAD_DIM), p['g_q_norm'])
    ka = rms_norm(ka.reshape(bsz, n, GQA_KV_HEADS, GQA_HEAD_DIM), p['g_k_norm'])
    va = va.reshape(bsz, n, GQA_KV_HEADS, GQA_HEAD_DIM)
    if is_ctx:
        k_all, v_all = ka, va
    else:
        row, col = pos
        qa = axial_rope(qa, row, col)
        k_all = jnp.concatenate([cache['gqa_k'].astype(h.dtype), axial_rope(ka, row, col)], axis=1)
        v_all = jnp.concatenate([cache['gqa_v'].astype(h.dtype), va], axis=1)
    y_a = block_attention(qa, k_all, v_all).reshape(bsz, n, GQA_WIDTH)
    y_a = (y_a * jax.nn.silu(ga)) @ p['w_o_gqa']

    qg = qg.reshape(bsz, n, GLA_HEADS, GLA_DK) * (GLA_DK ** -0.5)
    kg = kg.reshape(bsz, n, GLA_HEADS, GLA_DK)
    vg = vg.reshape(bsz, n, GLA_HEADS, GLA_DV)
    la_f = jax.nn.log_sigmoid((rf @ p['w_gla_decay_fwd'] + p['b_gla_decay_fwd']).astype(jnp.float32))
    la_b = jax.nn.log_sigmoid((rb @ p['w_gla_decay_bwd'] + p['b_gla_decay_bwd']).astype(jnp.float32))
    la_f = la_f.reshape(bsz, n, GLA_HEADS, GLA_DK) / GLA_NORMALIZER
    la_b = la_b.reshape(bsz, n, GLA_HEADS, GLA_DK) / GLA_NORMALIZER
    if is_ctx:
        s0_f = jnp.zeros((bsz, GLA_HEADS, GLA_DK, GLA_DV), jnp.float32)
        s0_b = s0_f
    else:
        s0_f, s0_b = cache['gla_fwd'], cache['gla_bwd']
    o_g, s_f, s_b = gla_bidirectional(qg, kg, vg, la_f, la_b, s0_f, s0_b)
    o_g = rms_norm(o_g.astype(h.dtype), p['g_gla_out']).reshape(bsz, n, GLA_WIDTH)
    y_b = (o_g * jax.nn.silu(gg)) @ p['w_o_gla']

    cq = (rms_norm(qlat, p['g_mla_q']) @ p['w_mla_uq']).reshape(bsz, n, MLA_HEADS, MLA_NOPE_DIM + MLA_ROPE_DIM)
    q_nope, q_rope = cq[..., :MLA_NOPE_DIM], cq[..., MLA_NOPE_DIM:]
    ckv = rms_norm(kvlat, p['g_mla_kv'])
    if is_ctx:
        ckv_all, kr_all = ckv, kr
    else:
        q_rope = axial_rope(q_rope, row, col)
        kr_lat = axial_rope(kr[:, :, None, :], row, col)[:, :, 0]
        ckv_all = jnp.concatenate([cache['mla_ckv'].astype(h.dtype), ckv], axis=1)
        kr_all = jnp.concatenate([cache['mla_krope'].astype(h.dtype), kr_lat], axis=1)
    nk = ckv_all.shape[1]
    kv = (ckv_all @ p['w_mla_ukv']).reshape(bsz, nk, MLA_HEADS, MLA_NOPE_DIM + MLA_V_DIM)
    k_nope, v_c = kv[..., :MLA_NOPE_DIM], kv[..., MLA_NOPE_DIM:]
    k_c = jnp.concatenate(
        [k_nope, jnp.broadcast_to(kr_all[:, :, None, :], (bsz, nk, MLA_HEADS, MLA_ROPE_DIM))], axis=-1)
    q_c = jnp.concatenate([q_nope, q_rope], axis=-1)[:, :, :, None, :]
    y_c = block_attention(q_c, k_c, v_c).reshape(bsz, n, MLA_WIDTH)
    y_c = (y_c * jax.nn.silu(gc)) @ p['w_o_mla']

    merged = jax.nn.sigmoid(m1) * y_a + jax.nn.sigmoid(m2) * y_b + jax.nn.sigmoid(m3) * y_c
    out = merged @ p['w_out']
    ctx_tensors = (ka, va, ckv, kr, s_f, s_b) if is_ctx else None
    return out, ctx_tensors


def setup_inputs(seed: int = 0) -> dict:
    key = jax.random.key(seed)
    keys = iter(jax.random.split(key, 40))
    L, D = DEPTH, D_MODEL

    def nrm(shape, scale):
        return jax.random.normal(next(keys), shape, jnp.float32) * scale

    return {
        'x_prompt': nrm((BATCH, SEQ, D), 1.0),
        'x_sample': nrm((DEC_BATCH, DEC_SEQ, D), 1.0),
        'cache_gqa_k': nrm((DEC_BATCH, DEPTH, PAST_LEN, GQA_KV_HEADS, GQA_HEAD_DIM), 1.0),
        'cache_gqa_v': nrm((DEC_BATCH, DEPTH, PAST_LEN, GQA_KV_HEADS, GQA_HEAD_DIM), 1.0),
        'cache_mla_ckv': nrm((DEC_BATCH, DEPTH, PAST_LEN, MLA_KV_LORA), 1.0),
        'cache_mla_krope': nrm((DEC_BATCH, DEPTH, PAST_LEN, MLA_ROPE_DIM), 1.0),
        'state_gla_fwd': nrm((DEC_BATCH, DEPTH, GLA_HEADS, GLA_DK, GLA_DV), 0.5),
        'state_gla_bwd': nrm((DEC_BATCH, DEPTH, GLA_HEADS, GLA_DK, GLA_DV), 0.5),
        'c': nrm((DEC_BATCH, D), 1.0),
        'c_ctx': nrm((D,), 1.0),
        'w_mod': nrm((L, D, 3 * D), 0.5 * D ** -0.5),
        'b_mod': nrm((L, 3 * D), 0.02),
        'g_pre': 1.0 + nrm((L, D), 0.02),
        'g_post': 1.0 + nrm((L, D), 0.02),
        'w_in': nrm((L, D, N_IN), D ** -0.5),
        'g_q_norm': 1.0 + nrm((L, GQA_HEAD_DIM), 0.02),
        'g_k_norm': 1.0 + nrm((L, GQA_HEAD_DIM), 0.02),
        'w_gla_decay_fwd': nrm((L, GLA_RANK, GLA_K_WIDTH), GLA_RANK ** -0.5),
        'b_gla_decay_fwd': nrm((L, GLA_K_WIDTH), 0.1),
        'w_gla_decay_bwd': nrm((L, GLA_RANK, GLA_K_WIDTH), GLA_RANK ** -0.5),
        'b_gla_decay_bwd': nrm((L, GLA_K_WIDTH), 0.1),
        'g_gla_out': 1.0 + nrm((L, GLA_DV), 0.02),
        'g_mla_q': 1.0 + nrm((L, MLA_Q_LORA), 0.02),
        'g_mla_kv': 1.0 + nrm((L, MLA_KV_LORA), 0.02),
        'w_mla_uq': nrm((L, MLA_Q_LORA, MLA_HEADS * (MLA_NOPE_DIM + MLA_ROPE_DIM)), MLA_Q_LORA ** -0.5),
        'w_mla_ukv': nrm((L, MLA_KV_LORA, MLA_HEADS * (MLA_NOPE_DIM + MLA_V_DIM)), MLA_KV_LORA ** -0.5),
        'w_o_gqa': nrm((L, GQA_WIDTH, D), GQA_WIDTH ** -0.5),
        'w_o_gla': nrm((L, GLA_WIDTH, D), GLA_WIDTH ** -0.5),
        'w_o_mla': nrm((L, MLA_WIDTH, D), MLA_WIDTH ** -0.5),
        'w_out': nrm((L, D, D), D ** -0.5),
    }


def reference(x_prompt, x_sample, cache_gqa_k, cache_gqa_v, cache_mla_ckv, cache_mla_krope,
              state_gla_fwd, state_gla_bwd, c, c_ctx, w_mod, b_mod, g_pre, g_post, w_in,
              g_q_norm, g_k_norm, w_gla_decay_fwd, b_gla_decay_fwd, w_gla_decay_bwd,
              b_gla_decay_bwd, g_gla_out, g_mla_q, g_mla_kv, w_mla_uq, w_mla_ukv,
              w_o_gqa, w_o_gla, w_o_mla, w_out):
    rows = x_sample.shape[1] // GRID_W
    row = jnp.repeat(jnp.arange(rows), GRID_W).astype(jnp.float32)
    col = jnp.tile(jnp.arange(GRID_W), rows).astype(jnp.float32)

    def layer_params(l):
        return {
            'w_in': w_in[l], 'g_q_norm': g_q_norm[l], 'g_k_norm': g_k_norm[l],
            'w_gla_decay_fwd': w_gla_decay_fwd[l], 'b_gla_decay_fwd': b_gla_decay_fwd[l],
            'w_gla_decay_bwd': w_gla_decay_bwd[l], 'b_gla_decay_bwd': b_gla_decay_bwd[l],
            'g_gla_out': g_gla_out[l], 'g_mla_q': g_mla_q[l], 'g_mla_kv': g_mla_kv[l],
            'w_mla_uq': w_mla_uq[l], 'w_mla_ukv': w_mla_ukv[l],
            'w_o_gqa': w_o_gqa[l], 'w_o_gla': w_o_gla[l], 'w_o_mla': w_o_mla[l], 'w_out': w_out[l],
        }

    def sub_layer(x, cond, l, pos, cache):
        shift, scale, gate = modulation(cond, w_mod[l], b_mod[l])
        h = rms_norm(x, g_pre[l]) * (1 + scale) + shift
        out, ctx = mixer(h, layer_params(l), pos, cache)
        return x + gate * rms_norm(out, g_post[l]), ctx

    xp = x_prompt
    ks, vs, ckvs, krs, sfs, sbs = [], [], [], [], [], []
    for l in range(DEPTH):
        xp, ctx = sub_layer(xp, c_ctx, l, None, None)
        ks.append(ctx[0]); vs.append(ctx[1]); ckvs.append(ctx[2])
        krs.append(ctx[3]); sfs.append(ctx[4]); sbs.append(ctx[5])
    y_prompt = xp

    xs = x_sample
    for l in range(DEPTH):
        cache = {
            'gqa_k': cache_gqa_k[:, l], 'gqa_v': cache_gqa_v[:, l],
            'mla_ckv': cache_mla_ckv[:, l], 'mla_krope': cache_mla_krope[:, l],
            'gla_fwd': state_gla_fwd[:, l], 'gla_bwd': state_gla_bwd[:, l],
        }
        xs, _ = sub_layer(xs, c, l, (row, col), cache)
    y_sample = xs

    return (y_prompt, y_sample, jnp.stack(ks, axis=1), jnp.stack(vs, axis=1),
            jnp.stack(ckvs, axis=1), jnp.stack(krs, axis=1),
            jnp.stack(sfs, axis=1), jnp.stack(sbs, axis=1))
```

```cpp
#include <hip/hip_runtime.h>
#include <hip/hip_cooperative_groups.h>
#include <cstdio>
namespace cg = cooperative_groups;

typedef unsigned short bfr;
typedef __attribute__((ext_vector_type(8))) short bf16x8;
typedef __attribute__((ext_vector_type(4))) float f32x4;
typedef __attribute__((ext_vector_type(4))) unsigned u32x4;
typedef __attribute__((ext_vector_type(2))) unsigned u32x2;

#define NROWS 12288
#define NCTX 4096
#define ZLD 6976
#define LDT 72
#define SMEM_SHORTS (4 * 128 * LDT)

#define C_QA 0
#define C_KA 512
#define C_VA 640
#define C_GA 768
#define C_QG 1280
#define C_KG 1536
#define C_VG 1792
#define C_GG 2304
#define C_RF 2816
#define C_RB 2832
#define C_QL 2848
#define C_KV 3104
#define C_KR 3360
#define C_GC 3392
#define C_M1 3904
#define C_M2 4928
#define C_M3 5952

#define WS_CTR 0ul
#define WS_MODP 4096ul
#define WS_MOD (WS_MODP + 589824ul)
#define WS_ROPE (WS_MOD + 73728ul)
#define WS_WIN (WS_ROPE + 16384ul)
#define WS_WUQ (WS_WIN + 14417920ul)
#define WS_WUKV (WS_WUQ + 196608ul)
#define WS_WOA (WS_WUKV + 393216ul)
#define WS_WOB (WS_WOA + 1048576ul)
#define WS_WOC (WS_WOB + 1048576ul)
#define WS_WOUT (WS_WOC + 1048576ul)
#define WS_KCA (WS_WOUT + 2097152ul)
#define WS_CKVC (WS_KCA + 262144ul)
#define WS_KRC (WS_CKVC + 524288ul)
#define WS_VTA (WS_KRC + 65536ul)
#define WS_CQ (WS_VTA + 3407872ul)
#define WS_KNOPE (WS_CQ + 9437184ul)
#define WS_VTC (WS_KNOPE + 6815744ul)
#define WS_R1 (WS_VTC + 13631488ul)
#define WS_Z (WS_R1 + 25165824ul)
#define WS_END (WS_Z + 171442176ul)

#define O_Y 0
#define O_GK 12582912
#define O_GV 13631488
#define O_CKV 14680064
#define O_KR 16777216
#define O_SF 17039360
#define O_SB 18087936

struct Params {
  const float* in[30];
  float* out;
  unsigned char* ws;
};

__device__ __forceinline__ int tidx() {
  int t = threadIdx.x;
  asm volatile("" : "+v"(t));
  return t;
}
__device__ __forceinline__ Params launder(const Params& p) {
  Params q = p;
#pragma unroll
  for (int i = 0; i < 30; i++) asm volatile("" : "+s"(q.in[i]));
  asm volatile("" : "+s"(q.out));
  asm volatile("" : "+s"(q.ws));
  return q;
}
__device__ __forceinline__ float bf2f(bfr b) { return __uint_as_float(((unsigned)b) << 16); }
__device__ __forceinline__ bfr f2bf(float f) {
  unsigned u = __float_as_uint(f);
  u += 0x7fffu + ((u >> 16) & 1u);
  return (bfr)(u >> 16);
}
__device__ __forceinline__ unsigned pack2(float a, float b) { return (unsigned)f2bf(a) | ((unsigned)f2bf(b) << 16); }
__device__ __forceinline__ float lo16(unsigned u) { return __uint_as_float(u << 16); }
__device__ __forceinline__ float hi16(unsigned u) { return __uint_as_float(u & 0xffff0000u); }
__device__ __forceinline__ float siluf(float x) { return x / (1.f + __expf(-x)); }
__device__ __forceinline__ float sigmf(float x) { return 1.f / (1.f + __expf(-x)); }
__device__ __forceinline__ f32x4 mfma16(bf16x8 a, bf16x8 b, f32x4 c) {
  return __builtin_amdgcn_mfma_f32_16x16x32_bf16(a, b, c, 0, 0, 0);
}
__device__ __forceinline__ const float* xrow(const Params& p, int row) {
  return row < NCTX ? p.in[0] + (long)row * 1024 : p.in[1] + (long)(row - NCTX) * 1024;
}
__device__ __forceinline__ int row_cond(int row) { return row < NCTX ? 0 : 1 + ((row - NCTX) >> 12); }
__device__ __forceinline__ float wave_sum(float v) {
  v += __shfl_xor(v, 1); v += __shfl_xor(v, 2); v += __shfl_xor(v, 4);
  v += __shfl_xor(v, 8); v += __shfl_xor(v, 16); v += __shfl_xor(v, 32);
  return v;
}

#define TIDX tidx()
__device__ __forceinline__ void gemm128(const bfr* __restrict__ P, long ldp, int pmax,
                                        const bfr* __restrict__ Q, long ldq, int qmax, int K,
                                        f32x4 (&acc)[4][4], bfr* sm) {
  const int tid = TIDX, lane = tid & 63, wid = tid >> 6;
  const int wr = wid >> 1, wc = wid & 1;
  const int lr = tid >> 3, lc = (tid & 7) * 8;
  u32x4 rp[4], rq[4];
  const bfr* pp[4];
  const bfr* qp[4];
#pragma unroll
  for (int i = 0; i < 4; i++) {
    int r = lr + 32 * i;
    pp[i] = P + (long)min(r, pmax - 1) * ldp + lc;
    qp[i] = Q + (long)min(r, qmax - 1) * ldq + lc;
    rp[i] = *(const u32x4*)(pp[i]);
    rq[i] = *(const u32x4*)(qp[i]);
  }
  const int nk = K >> 6;
  for (int kt = 0; kt < nk; kt++) {
    bfr* Ps = sm + (kt & 1) * (2 * 128 * LDT);
    bfr* Qs = Ps + 128 * LDT;
#pragma unroll
    for (int i = 0; i < 4; i++) {
      *(u32x4*)(Ps + (lr + 32 * i) * LDT + lc) = rp[i];
      *(u32x4*)(Qs + (lr + 32 * i) * LDT + lc) = rq[i];
    }
    __syncthreads();
    if (kt + 1 < nk) {
#pragma unroll
      for (int i = 0; i < 4; i++) {
        rp[i] = *(const u32x4*)(pp[i] + (kt + 1) * 64);
        rq[i] = *(const u32x4*)(qp[i] + (kt + 1) * 64);
      }
    }
#pragma unroll
    for (int kk = 0; kk < 2; kk++) {
      bf16x8 pf[4], qf[4];
#pragma unroll
      for (int m = 0; m < 4; m++) {
        pf[m] = *(const bf16x8*)(Ps + (wr * 64 + m * 16 + (lane & 15)) * LDT + kk * 32 + (lane >> 4) * 8);
        qf[m] = *(const bf16x8*)(Qs + (wc * 64 + m * 16 + (lane & 15)) * LDT + kk * 32 + (lane >> 4) * 8);
      }
#pragma unroll
      for (int m = 0; m < 4; m++)
#pragma unroll
        for (int n = 0; n < 4; n++) acc[m][n] = mfma16(pf[m], qf[n], acc[m][n]);
    }
  }
  __syncthreads();
}

__device__ __forceinline__ void phase_s0(const Params& p, bfr* sm) {
  const int tid = TIDX;
  if (blockIdx.x == 0 && tid < 64) ((unsigned*)(p.ws + WS_CTR))[tid] = 0u;
  float* rope = (float*)(p.ws + WS_ROPE);
  for (int idx = blockIdx.x * 256 + tid; idx < 1536; idx += gridDim.x * 256) {
    if (idx < 1024) {
      int pos = idx >> 4, i = idx & 15;
      float fr = powf(10000.f, -(float)i / 16.f);
      float a = (float)pos * fr;
      rope[idx] = cosf(a);
      rope[1024 + idx] = sinf(a);
    } else {
      int j = idx - 1024;
      int pos = j >> 3, i = j & 7;
      float fr = powf(10000.f, -(float)i / 8.f);
      float a = (float)pos * fr;
      rope[2048 + j] = cosf(a);
      rope[2560 + j] = sinf(a);
    }
  }
  float* smf = (float*)sm;
  float* modp = (float*)(p.ws + WS_MODP);
  for (int it = blockIdx.x; it < 768; it += gridDim.x) {
    int l = it / 384, rem = it % 384, cgp = rem >> 3, ks = rem & 7;
    int col = cgp * 64 + (tid & 63), kq = tid >> 6;
    const float* w = p.in[10] + (long)l * 1024 * 3072 + col;
    float a0 = 0.f, a1 = 0.f, a2 = 0.f;
    int k0 = ks * 128 + kq * 32;
#pragma unroll 8
    for (int k = k0; k < k0 + 32; k++) {
      float wv = w[(long)k * 3072];
      a0 += siluf(p.in[9][k]) * wv;
      a1 += siluf(p.in[8][k]) * wv;
      a2 += siluf(p.in[8][1024 + k]) * wv;
    }
    smf[(kq * 3 + 0) * 64 + (tid & 63)] = a0;
    smf[(kq * 3 + 1) * 64 + (tid & 63)] = a1;
    smf[(kq * 3 + 2) * 64 + (tid & 63)] = a2;
    __syncthreads();
    if (tid < 192) {
      int c = tid >> 6, cc = tid & 63;
      float s = smf[(0 * 3 + c) * 64 + cc] + smf[(1 * 3 + c) * 64 + cc] + smf[(2 * 3 + c) * 64 + cc] + smf[(3 * 3 + c) * 64 + cc];
      modp[((ks * 2 + l) * 3 + c) * 3072 + cgp * 64 + cc] = s;
    }
    __syncthreads();
  }
}

__device__ __forceinline__ void phase_s1(const Params& p) {
  float* modp = (float*)(p.ws + WS_MODP);
  float* mod = (float*)(p.ws + WS_MOD);
  for (int idx = blockIdx.x * 256 + TIDX; idx < 2 * 3 * 3072; idx += gridDim.x * 256) {
    int l = idx / 9216, n = idx % 3072;
    float s = p.in[11][l * 3072 + n];
#pragma unroll
    for (int ks = 0; ks < 8; ks++) s += modp[ks * 18432 + idx];
    mod[idx] = s;
  }
}

__device__ __forceinline__ void wconv_tile(const float* __restrict__ src, int K, int N, bfr* __restrict__ dst,
                                           int tk, int tn, float* smf) {
  const int tid = TIDX;
  const int n = tid & 63, kb = tid >> 6;
#pragma unroll
  for (int i = 0; i < 16; i++) {
    int k = kb + 4 * i;
    smf[k * 65 + n] = src[(long)(tk * 64 + k) * N + tn * 64 + n];
  }
  __syncthreads();
#pragma unroll
  for (int i = 0; i < 16; i++) {
    int idx = tid + 256 * i;
    int nn = idx >> 6, k = idx & 63;
    dst[(long)(tn * 64 + nn) * K + tk * 64 + k] = f2bf(smf[k * 65 + nn]);
  }
  __syncthreads();
}

#define WCONV_ITEMS 2456
__device__ __forceinline__ void wconv_phase(const Params& p, int l, bfr* sm) {
  float* smf = (float*)sm;
  for (int item0 = blockIdx.x; item0 < WCONV_ITEMS; item0 += gridDim.x) {
    int item = item0;
    const float* src;
    bfr* dst;
    int K, N, tk, tn;
    if (item < 1744) {
      src = p.in[14] + (long)l * 1024 * 6976; K = 1024; N = 6976; dst = (bfr*)(p.ws + WS_WIN); tk = item & 15; tn = item >> 4;
    } else if (item < 1768) {
      item -= 1744;
      src = p.in[24] + (long)l * 256 * 384; K = 256; N = 384; dst = (bfr*)(p.ws + WS_WUQ); tk = item & 3; tn = item >> 2;
    } else if (item < 1816) {
      item -= 1768;
      src = p.in[25] + (long)l * 256 * 768; K = 256; N = 768; dst = (bfr*)(p.ws + WS_WUKV); tk = item & 3; tn = item >> 2;
    } else if (item < 2200) {
      item -= 1816;
      int w = item >> 7, it = item & 127;
      src = (w == 0 ? p.in[26] : (w == 1 ? p.in[27] : p.in[28])) + (long)l * 512 * 1024;
      K = 512; N = 1024; dst = (bfr*)(p.ws + WS_WOA + (unsigned long)w * 1048576ul); tk = it & 7; tn = it >> 3;
    } else {
      item -= 2200;
      src = p.in[29] + (long)l * 1024 * 1024; K = 1024; N = 1024; dst = (bfr*)(p.ws + WS_WOUT); tk = item & 15; tn = item >> 4;
    }
    wconv_tile(src, K, N, dst, tk, tn, smf);
  }
}

__device__ __forceinline__ void phase_prenorm0(const Params& p) {
  const int lane = TIDX & 63;
  const float* mod = (const float*)(p.ws + WS_MOD);
  bfr* H = (bfr*)(p.ws + WS_R1);
  for (int row = blockIdx.x * 4 + (TIDX >> 6); row < NROWS; row += gridDim.x * 4) {
    const float* x = xrow(p, row);
    const float* md = mod + (0 * 3 + row_cond(row)) * 3072;
    float4 v[4];
    float ss = 0.f;
#pragma unroll
    for (int i = 0; i < 4; i++) {
      v[i] = *(const float4*)(x + i * 256 + lane * 4);
      ss += v[i].x * v[i].x + v[i].y * v[i].y + v[i].z * v[i].z + v[i].w * v[i].w;
    }
    ss = wave_sum(ss);
    float rs = rsqrtf(ss * (1.f / 1024.f) + 1e-6f);
#pragma unroll
    for (int i = 0; i < 4; i++) {
      int n = i * 256 + lane * 4;
      float4 g = *(const float4*)(p.in[12] + n);
      float4 sh = *(const float4*)(md + n);
      float4 sc = *(const float4*)(md + 1024 + n);
      float h0 = v[i].x * rs * g.x * (1.f + sc.x) + sh.x;
      float h1 = v[i].y * rs * g.y * (1.f + sc.y) + sh.y;
      float h2 = v[i].z * rs * g.z * (1.f + sc.z) + sh.z;
      float h3 = v[i].w * rs * g.w * (1.f + sc.w) + sh.w;
      u32x2 o;
      o.x = pack2(h0, h1);
      o.y = pack2(h2, h3);
      *(u32x2*)(H + (long)row * 1024 + n) = o;
    }
  }
}

__device__ __forceinline__ void phase_inproj(const Params& p, bfr* sm) {
  const bfr* H = (const bfr*)(p.ws + WS_R1);
  const bfr* W = (const bfr*)(p.ws + WS_WIN);
  bfr* Z = (bfr*)(p.ws + WS_Z);
  const int lane = TIDX & 63, wid = TIDX >> 6, wr = wid >> 1, wc = wid & 1;
  for (int t = blockIdx.x; t < 96 * 55; t += gridDim.x) {
    int tn = t % 55, tm = t / 55;
    f32x4 acc[4][4];
#pragma unroll
    for (int a = 0; a < 4; a++)
#pragma unroll
      for (int b = 0; b < 4; b++) acc[a][b] = (f32x4){0.f, 0.f, 0.f, 0.f};
    gemm128(W + (long)tn * 128 * 1024, 1024, ZLD - tn * 128, H + (long)tm * 128 * 1024, 1024, 128, 1024, acc, sm);
#pragma unroll
    for (int pi = 0; pi < 4; pi++) {
      int n0 = tn * 128 + wr * 64 + pi * 16 + (lane >> 4) * 4;
      if (n0 < ZLD) {
#pragma unroll
        for (int qi = 0; qi < 4; qi++) {
          int tok = tm * 128 + wc * 64 + qi * 16 + (lane & 15);
          u32x2 o;
          o.x = pack2(acc[pi][qi][0], acc[pi][qi][1]);
          o.y = pack2(acc[pi][qi][2], acc[pi][qi][3]);
          *(u32x2*)(Z + (long)tok * ZLD + n0) = o;
        }
      }
    }
  }
}

__device__ __forceinline__ void unpack8(u32x4 v, float* x) {
  x[0] = lo16(v.x); x[1] = hi16(v.x); x[2] = lo16(v.y); x[3] = hi16(v.y);
  x[4] = lo16(v.z); x[5] = hi16(v.z); x[6] = lo16(v.w); x[7] = hi16(v.w);
}
__device__ __forceinline__ u32x4 pack8(const float* y) {
  u32x4 o;
  o.x = pack2(y[0], y[1]); o.y = pack2(y[2], y[3]); o.z = pack2(y[4], y[5]); o.w = pack2(y[6], y[7]);
  return o;
}

__device__ __forceinline__ void phase_rowpost(const Params& p, int l) {
  const int lane = TIDX & 63;
  bfr* Z = (bfr*)(p.ws + WS_Z);
  const float* rope = (const float*)(p.ws + WS_ROPE);
  bfr* VTA = (bfr*)(p.ws + WS_VTA);
  bfr* KCA = (bfr*)(p.ws + WS_KCA);
  bfr* CKVC = (bfr*)(p.ws + WS_CKVC);
  bfr* KRC = (bfr*)(p.ws + WS_KRC);
  float* out = p.out;
  for (int row = blockIdx.x * 4 + (TIDX >> 6); row < NROWS + 1024; row += gridDim.x * 4) {
    if (row < NROWS) {
      const bool lat = row >= NCTX;
      const int bc = row >> 8, tc = row & 255;
      const int bl = (row - NCTX) >> 12, tl = (row - NCTX) & 4095;
      const int prow = tl >> 6, pcol = tl & 63;
      bfr* z = Z + (long)row * ZLD;
      {
        float x[8];
        unpack8(*(const u32x4*)(z + C_QA + lane * 8), x);
        float ss = 0.f;
#pragma unroll
        for (int e = 0; e < 8; e++) ss += x[e] * x[e];
        ss += __shfl_xor(ss, 1); ss += __shfl_xor(ss, 2); ss += __shfl_xor(ss, 4);
        float rs = rsqrtf(ss * (1.f / 64.f) + 1e-6f);
        int sub = lane & 7;
        const float* g = p.in[15] + l * 64 + sub * 8;
#pragma unroll
        for (int e = 0; e < 8; e++) x[e] = x[e] * rs * g[e];
        if (lat) {
          int pos = (sub >> 2) ? pcol : prow;
          bool hi = (sub & 2) != 0;
          int i0 = (sub & 1) * 8;
#pragma unroll
          for (int e = 0; e < 8; e++) {
            float yp = __shfl_xor(x[e], 2);
            float c = rope[pos * 16 + i0 + e], s = rope[1024 + pos * 16 + i0 + e];
            x[e] = hi ? (yp * s + x[e] * c) : (x[e] * c - yp * s);
          }
        }
        const float qs = 0.125f * 1.4426950408889634f;
#pragma unroll
        for (int e = 0; e < 8; e++) x[e] *= qs;
        *(u32x4*)(z + C_QA + lane * 8) = pack8(x);
      }
      {
        int L = lane & 15;
        float x[8];
        unpack8(*(const u32x4*)(z + C_KA + L * 8), x);
        float ss = 0.f;
#pragma unroll
        for (int e = 0; e < 8; e++) ss += x[e] * x[e];
        ss += __shfl_xor(ss, 1); ss += __shfl_xor(ss, 2); ss += __shfl_xor(ss, 4);
        float rs = rsqrtf(ss * (1.f / 64.f) + 1e-6f);
        int sub = L & 7;
        const float* g = p.in[16] + l * 64 + sub * 8;
#pragma unroll
        for (int e = 0; e < 8; e++) x[e] = x[e] * rs * g[e];
        if (lat) {
          int pos = (sub >> 2) ? pcol : prow;
          bool hi = (sub & 2) != 0;
          int i0 = (sub & 1) * 8;
#pragma unroll
          for (int e = 0; e < 8; e++) {
            float yp = __shfl_xor(x[e], 2);
            float c = rope[pos * 16 + i0 + e], s = rope[1024 + pos * 16 + i0 + e];
            x[e] = hi ? (yp * s + x[e] * c) : (x[e] * c - yp * s);
          }
        } else if (lane < 16) {
          float* o = out + O_GK + ((long)(bc * 2 + l) * 256 + tc) * 128 + L * 8;
          *(float4*)(o) = make_float4(x[0], x[1], x[2], x[3]);
          *(float4*)(o + 4) = make_float4(x[4], x[5], x[6], x[7]);
        }
        if (lane < 16) *(u32x4*)(z + C_KA + L * 8) = pack8(x);
      }
      if (lane < 16) {
        int L = lane;
        u32x4 raw = *(const u32x4*)(z + C_VA + L * 8);
        float x[8];
        unpack8(raw, x);
        if (!lat) {
          float* o = out + O_GV + ((long)(bc * 2 + l) * 256 + tc) * 128 + L * 8;
          *(float4*)(o) = make_float4(x[0], x[1], x[2], x[3]);
          *(float4*)(o + 4) = make_float4(x[4], x[5], x[6], x[7]);
        }
        int g = L >> 3, d0 = (L & 7) * 8;
        long base; int nk, key;
        if (!lat) { base = (long)bc * 32768; nk = 256; key = tc; }
        else { base = 16l * 32768 + (long)bl * (2 * 64 * 4608); nk = 4608; key = 512 + tl; }
        const bfr* rb = (const bfr*)&raw;
#pragma unroll
        for (int e = 0; e < 8; e++) VTA[base + (long)(g * 64 + d0 + e) * nk + key] = rb[e];
      }
      {
        u32x2 rq = *(const u32x2*)(z + C_QL + lane * 4);
        u32x2 rk = *(const u32x2*)(z + C_KV + lane * 4);
        float q[4] = {lo16(rq.x), hi16(rq.x), lo16(rq.y), hi16(rq.y)};
        float k[4] = {lo16(rk.x), hi16(rk.x), lo16(rk.y), hi16(rk.y)};
        float sq = q[0] * q[0] + q[1] * q[1] + q[2] * q[2] + q[3] * q[3];
        float sk = k[0] * k[0] + k[1] * k[1] + k[2] * k[2] + k[3] * k[3];
        sq = wave_sum(sq);
        sk = wave_sum(sk);
        float rq_ = rsqrtf(sq * (1.f / 256.f) + 1e-6f), rk_ = rsqrtf(sk * (1.f / 256.f) + 1e-6f);
        float4 gq = *(const float4*)(p.in[22] + l * 256 + lane * 4);
        float4 gk = *(const float4*)(p.in[23] + l * 256 + lane * 4);
        q[0] *= rq_ * gq.x; q[1] *= rq_ * gq.y; q[2] *= rq_ * gq.z; q[3] *= rq_ * gq.w;
        k[0] *= rk_ * gk.x; k[1] *= rk_ * gk.y; k[2] *= rk_ * gk.z; k[3] *= rk_ * gk.w;
        u32x2 o;
        o.x = pack2(q[0], q[1]); o.y = pack2(q[2], q[3]);
        *(u32x2*)(z + C_QL + lane * 4) = o;
        o.x = pack2(k[0], k[1]); o.y = pack2(k[2], k[3]);
        *(u32x2*)(z + C_KV + lane * 4) = o;
        if (!lat) *(float4*)(out + O_CKV + ((long)(bc * 2 + l) * 256 + tc) * 256 + lane * 4) = make_float4(k[0], k[1], k[2], k[3]);
      }
      {
        int L = lane & 3;
        float x[8];
        unpack8(*(const u32x4*)(z + C_KR + L * 8), x);
        if (lat) {
          int pos = (L >> 1) ? pcol : prow;
          bool hi = (L & 1) != 0;
#pragma unroll
          for (int e = 0; e < 8; e++) {
            float yp = __shfl_xor(x[e], 1);
            float c = rope[2048 + pos * 8 + e], s = rope[2560 + pos * 8 + e];
            x[e] = hi ? (yp * s + x[e] * c) : (x[e] * c - yp * s);
          }
          if (lane < 4) *(u32x4*)(z + C_KR + L * 8) = pack8(x);
        } else if (lane < 4) {
          float* o = out + O_KR + ((long)(bc * 2 + l) * 256 + tc) * 32 + L * 8;
          *(float4*)(o) = make_float4(x[0], x[1], x[2], x[3]);
          *(float4*)(o + 4) = make_float4(x[4], x[5], x[6], x[7]);
        }
      }
    } else {
      int cr = row - NROWS;
      int b = cr >> 9, t = cr & 511;
      long src = (long)(b * 2 + l) * 512 + t;
      {
        float2 kv = *(const float2*)(p.in[2] + src * 128 + lane * 2);
        *(unsigned*)(KCA + (long)(b * 512 + t) * 128 + lane * 2) = pack2(kv.x, kv.y);
        float2 vv = *(const float2*)(p.in[3] + src * 128 + lane * 2);
        int c0 = lane * 2;
        long base = 16l * 32768 + (long)b * (2 * 64 * 4608);
        VTA[base + (long)c0 * 4608 + t] = f2bf(vv.x);
        VTA[base + (long)(c0 + 1) * 4608 + t] = f2bf(vv.y);
        float4 cv = *(const float4*)(p.in[4] + src * 256 + lane * 4);
        u32x2 o;
        o.x = pack2(cv.x, cv.y); o.y = pack2(cv.z, cv.w);
        *(u32x2*)(CKVC + (long)(b * 512 + t) * 256 + lane * 4) = o;
        if (lane < 32) KRC[(long)(b * 512 + t) * 32 + lane] = f2bf(p.in[5][src * 32 + lane]);
      }
    }
  }
}

__device__ __forceinline__ void phase_mla_up(const Params& p, bfr* sm) {
  bfr* Z = (bfr*)(p.ws + WS_Z);
  const float* rope = (const float*)(p.ws + WS_ROPE);
  const int lane = TIDX & 63, wid = TIDX >> 6, wr = wid >> 1, wc = wid & 1;
  const int g = lane >> 4;
  for (int t = blockIdx.x; t < 288 + 624; t += gridDim.x) {
    f32x4 acc[4][4];
#pragma unroll
    for (int a = 0; a < 4; a++)
#pragma unroll
      for (int b = 0; b < 4; b++) acc[a][b] = (f32x4){0.f, 0.f, 0.f, 0.f};
    if (t < 288) {
      int tn = t % 3, tm = t / 3;
      gemm128((const bfr*)(p.ws + WS_WUQ) + (long)tn * 128 * 256, 256, 128, Z + (long)tm * 128 * ZLD + C_QL, ZLD, 128, 256,
              acc, sm);
      bfr* CQ = (bfr*)(p.ws + WS_CQ);
      const float qs = 0.10206207261596577f * 1.4426950408889634f;
#pragma unroll
      for (int pi = 0; pi < 4; pi++) {
        int nb = tn * 128 + wr * 64 + pi * 16;
        int wb = nb % 96;
        bool ropet = wb >= 64;
        int part = (wb - 64) >> 4;
#pragma unroll
        for (int qi = 0; qi < 4; qi++) {
          int tok = tm * 128 + wc * 64 + qi * 16 + (lane & 15);
          float y[4] = {acc[pi][qi][0], acc[pi][qi][1], acc[pi][qi][2], acc[pi][qi][3]};
          if (ropet) {
            bool lat = tok >= NCTX;
            int tl = (tok - NCTX) & 4095;
            int pos = part ? (tl & 63) : (tl >> 6);
            bool hi = (g & 2) != 0;
            int i0 = (g & 1) * 4;
#pragma unroll
            for (int r = 0; r < 4; r++) {
              float yp = __shfl_xor(y[r], 32);
              float c = rope[2048 + pos * 8 + i0 + r], s = rope[2560 + pos * 8 + i0 + r];
              float yr = hi ? (yp * s + y[r] * c) : (y[r] * c - yp * s);
              y[r] = lat ? yr : y[r];
            }
          }
          u32x2 o;
          o.x = pack2(y[0] * qs, y[1] * qs);
          o.y = pack2(y[2] * qs, y[3] * qs);
          *(u32x2*)(CQ + (long)tok * 384 + nb + g * 4) = o;
        }
      }
    } else {
      int t2 = t - 288;
      int tn = t2 % 6, tm = t2 / 6;
      const bfr* Q;
      long ldq;
      long kbase, vbase;
      int nk, key0;
      if (tm < 32) {
        Q = Z + (long)tm * 128 * ZLD + C_KV;
        ldq = ZLD;
        int s = tm >> 1;
        key0 = (tm & 1) * 128;
        nk = 256;
        kbase = (long)s * (4 * 256 * 64);
        vbase = (long)s * 131072;
      } else {
        int r = (tm - 32) * 128;
        int b = r / 4608, within = r % 4608;
        key0 = within;
        nk = 4608;
        kbase = 16l * (4 * 256 * 64) + (long)b * (4 * 4608 * 64);
        vbase = 16l * 131072 + (long)b * (4 * 128 * 4608);
        if (within < 512) {
          Q = (const bfr*)(p.ws + WS_CKVC) + (long)(b * 512 + within) * 256;
          ldq = 256;
        } else {
          Q = Z + (long)(NCTX + b * 4096 + within - 512) * ZLD + C_KV;
          ldq = ZLD;
        }
      }
      gemm128((const bfr*)(p.ws + WS_WUKV) + (long)tn * 128 * 256, 256, 128, Q, ldq, 128, 256, acc, sm);
      bfr* KN = (bfr*)(p.ws + WS_KNOPE);
      bfr* VTC = (bfr*)(p.ws + WS_VTC);
#pragma unroll
      for (int pi = 0; pi < 4; pi++) {
        int n0 = tn * 128 + wr * 64 + pi * 16 + g * 4;
        int head = n0 / 192, w = n0 % 192;
#pragma unroll
        for (int qi = 0; qi < 4; qi++) {
          int key = key0 + wc * 64 + qi * 16 + (lane & 15);
          if (w < 64) {
            u32x2 o;
            o.x = pack2(acc[pi][qi][0], acc[pi][qi][1]);
            o.y = pack2(acc[pi][qi][2], acc[pi][qi][3]);
            *(u32x2*)(KN + kbase + ((long)head * nk + key) * 64 + w) = o;
          } else {
#pragma unroll
            for (int r = 0; r < 4; r++)
              VTC[vbase + ((long)head * 128 + (w - 64) + r) * nk + key] = f2bf(acc[pi][qi][r]);
          }
        }
      }
    }
  }
}

template <int DQ, int DV, bool MLA>
__device__ __forceinline__ void attn_item(const Params& p, int seq, int head, int qblk, bfr* sm) {
  constexpr int KLD = DQ + 8;
  constexpr int KSZ = 64 * KLD;
  constexpr int VSZ = DV * LDT;
  constexpr int BUF = KSZ + VSZ;
  constexpr int NKK = DQ / 32;
  constexpr int NDV = DV / 16;
  constexpr int NVL = DV / 32;
  const int tid = TIDX, lane = tid & 63, wid = tid >> 6, g = lane >> 4, l15 = lane & 15;
  bfr* Z = (bfr*)(p.ws + WS_Z);
  const bool lat = seq >= 16;
  const int b = seq - 16;
  const int nk = lat ? 4608 : 256;
  const int rowbase = lat ? NCTX + b * 4096 : seq * 256;
  const int nkt = nk >> 6;

  bf16x8 qf[2][NKK];
#pragma unroll
  for (int qb = 0; qb < 2; qb++) {
    int qrow = rowbase + qblk * 128 + wid * 32 + qb * 16 + l15;
    const bfr* qp = MLA ? ((const bfr*)(p.ws + WS_CQ) + (long)qrow * 384 + head * 96) : (Z + (long)qrow * ZLD + C_QA + head * 64);
#pragma unroll
    for (int kk = 0; kk < NKK; kk++) qf[qb][kk] = *(const bf16x8*)(qp + kk * 32 + g * 8);
  }

  u32x4 rk[2], rkr, rv[NVL];
  auto prefetch = [&](int kt) {
    int k0 = kt * 64;
    bool cache = lat && (k0 < 512);
    int tokrow0 = lat ? (NCTX + b * 4096 + k0 - 512) : (seq * 256 + k0);
    if (!MLA) {
      int kvh = head >> 2;
#pragma unroll
      for (int i = 0; i < 2; i++) {
        int c = tid + 256 * i;
        int kr_ = c >> 3, ch = c & 7;
        const bfr* src = cache ? ((const bfr*)(p.ws + WS_KCA) + (long)(b * 512 + k0 + kr_) * 128 + kvh * 64 + ch * 8)
                               : (Z + (long)(tokrow0 + kr_) * ZLD + C_KA + kvh * 64 + ch * 8);
        rk[i] = *(const u32x4*)src;
      }
      long vb = lat ? (16l * 32768 + (long)b * (2 * 64 * 4608)) : ((long)seq * 32768);
#pragma unroll
      for (int i = 0; i < NVL; i++) {
        int c = tid + 256 * i;
        int dv = c >> 3, ch = c & 7;
        rv[i] = *(const u32x4*)((const bfr*)(p.ws + WS_VTA) + vb + (long)(kvh * 64 + dv) * nk + k0 + ch * 8);
      }
    } else {
      long kb = lat ? (16l * (4 * 256 * 64) + (long)b * (4 * 4608 * 64)) : ((long)seq * (4 * 256 * 64));
#pragma unroll
      for (int i = 0; i < 2; i++) {
        int c = tid + 256 * i;
        int kr_ = c >> 3, ch = c & 7;
        rk[i] = *(const u32x4*)((const bfr*)(p.ws + WS_KNOPE) + kb + ((long)head * nk + k0 + kr_) * 64 + ch * 8);
      }
      {
        int kr_ = tid >> 2, ch = tid & 3;
        const bfr* src = cache ? ((const bfr*)(p.ws + WS_KRC) + (long)(b * 512 + k0 + kr_) * 32 + ch * 8)
                               : (Z + (long)(tokrow0 + kr_) * ZLD + C_KR + ch * 8);
        rkr = *(const u32x4*)src;
      }
      long vb = lat ? (16l * 131072 + (long)b * (4 * 128 * 4608)) : ((long)seq * 131072);
#pragma unroll
      for (int i = 0; i < NVL; i++) {
        int c = tid + 256 * i;
        int dv = c >> 3, ch = c & 7;
        rv[i] = *(const u32x4*)((const bfr*)(p.ws + WS_VTC) + vb + (long)(head * 128 + dv) * nk + k0 + ch * 8);
      }
    }
  };

  f32x4 o[2][NDV];
#pragma unroll
  for (int qb = 0; qb < 2; qb++)
#pragma unroll
    for (int d = 0; d < NDV; d++) o[qb][d] = (f32x4){0.f, 0.f, 0.f, 0.f};
  float mrun[2] = {-1e30f, -1e30f}, lsum[2] = {0.f, 0.f};

  prefetch(0);
  for (int kt = 0; kt < nkt; kt++) {
    bfr* Ks = sm + (kt & 1) * BUF;
    bfr* Vs = Ks + KSZ;
#pragma unroll
    for (int i = 0; i < 2; i++) {
      int c = tid + 256 * i;
      *(u32x4*)(Ks + (c >> 3) * KLD + (c & 7) * 8) = rk[i];
    }
    if (MLA) *(u32x4*)(Ks + (tid >> 2) * KLD + 64 + (tid & 3) * 8) = rkr;
#pragma unroll
    for (int i = 0; i < NVL; i++) {
      int c = tid + 256 * i;
      *(u32x4*)(Vs + (c >> 3) * LDT + (c & 7) * 8) = rv[i];
    }
    __syncthreads();
    if (kt + 1 < nkt) prefetch(kt + 1);

    f32x4 s[2][4];
#pragma unroll
    for (int t = 0; t < 4; t++) {
      s[0][t] = (f32x4){0.f, 0.f, 0.f, 0.f};
      s[1][t] = (f32x4){0.f, 0.f, 0.f, 0.f};
      int krow = 32 * (t >> 1) + 8 * (l15 >> 2) + 4 * (t & 1) + (l15 & 3);
#pragma unroll
      for (int kk = 0; kk < NKK; kk++) {
        bf16x8 kf = *(const bf16x8*)(Ks + krow * KLD + kk * 32 + g * 8);
        s[0][t] = mfma16(kf, qf[0][kk], s[0][t]);
        s[1][t] = mfma16(kf, qf[1][kk], s[1][t]);
      }
    }
    bf16x8 pf[2][2];
#pragma unroll
    for (int qb = 0; qb < 2; qb++) {
      float mt = s[qb][0][0];
#pragma unroll
      for (int t = 0; t < 4; t++)
#pragma unroll
        for (int r = 0; r < 4; r++) mt = fmaxf(mt, s[qb][t][r]);
      mt = fmaxf(mt, __shfl_xor(mt, 16));
      mt = fmaxf(mt, __shfl_xor(mt, 32));
      float mnew = fmaxf(mrun[qb], mt);
      float alpha = __builtin_amdgcn_exp2f(mrun[qb] - mnew);
      mrun[qb] = mnew;
      float ps = 0.f;
#pragma unroll
      for (int t = 0; t < 4; t++)
#pragma unroll
        for (int r = 0; r < 4; r++) {
          float pv = __builtin_amdgcn_exp2f(s[qb][t][r] - mnew);
          ps += pv;
          s[qb][t][r] = pv;
        }
      lsum[qb] = lsum[qb] * alpha + ps;
#pragma unroll
      for (int d = 0; d < NDV; d++) {
        o[qb][d][0] *= alpha; o[qb][d][1] *= alpha; o[qb][d][2] *= alpha; o[qb][d][3] *= alpha;
      }
#pragma unroll
      for (int sx = 0; sx < 2; sx++) {
        u32x4 u;
        u.x = pack2(s[qb][2 * sx][0], s[qb][2 * sx][1]);
        u.y = pack2(s[qb][2 * sx][2], s[qb][2 * sx][3]);
        u.z = pack2(s[qb][2 * sx + 1][0], s[qb][2 * sx + 1][1]);
        u.w = pack2(s[qb][2 * sx + 1][2], s[qb][2 * sx + 1][3]);
        pf[qb][sx] = *(bf16x8*)&u;
      }
    }
#pragma unroll
    for (int d = 0; d < NDV; d++) {
#pragma unroll
      for (int sx = 0; sx < 2; sx++) {
        bf16x8 vf = *(const bf16x8*)(Vs + (d * 16 + l15) * LDT + sx * 32 + g * 8);
        o[0][d] = mfma16(vf, pf[0][sx], o[0][d]);
        o[1][d] = mfma16(vf, pf[1][sx], o[1][d]);
      }
    }
  }
  __syncthreads();
#pragma unroll
  for (int qb = 0; qb < 2; qb++) {
    float lt = lsum[qb];
    lt += __shfl_xor(lt, 16);
    lt += __shfl_xor(lt, 32);
    float inv = 1.f / lt;
    int qrow = rowbase + qblk * 128 + wid * 32 + qb * 16 + l15;
    bfr* gp = Z + (long)qrow * ZLD + (MLA ? C_GC : C_GA) + head * DV + g * 4;
#pragma unroll
    for (int d = 0; d < NDV; d++) {
      u32x2 gr = *(const u32x2*)(gp + d * 16);
      float y0 = o[qb][d][0] * inv * siluf(lo16(gr.x));
      float y1 = o[qb][d][1] * inv * siluf(hi16(gr.x));
      float y2 = o[qb][d][2] * inv * siluf(lo16(gr.y));
      float y3 = o[qb][d][3] * inv * siluf(hi16(gr.y));
      u32x2 ov;
      ov.x = pack2(y0, y1);
      ov.y = pack2(y2, y3);
      *(u32x2*)(gp + d * 16) = ov;
    }
  }
}

__device__ __forceinline__ void gla_item(const Params& p, int l, int seq, int h, int dir, int vsl, bfr* sm) {
  const int tid = TIDX, lane = tid & 63, wid = tid >> 6, g = lane >> 4, l15 = lane & 15;
  bfr* Z = (bfr*)(p.ws + WS_Z);
  bfr* OG = (bfr*)(p.ws + WS_R1) + (long)dir * NROWS * 512;
  const bool lat = seq >= 16;
  const int b = seq - 16;
  const int N = lat ? 4096 : 256;
  const int rowbase = lat ? NCTX + b * 4096 : seq * 256;
  const int nc = N >> 6;
  const int vs0 = vsl * 32;
  bfr* Qr = sm;
  bfr* Kr = Qr + 64 * LDT;
  bfr* Qe = Kr + 64 * LDT;
  bfr* Ke = Qe + 64 * LDT;
  bfr* KlT = Ke + 64 * LDT;
  bfr* Vt = KlT + 64 * LDT;
  bfr* St = Vt + 32 * LDT;
  float* RF = (float*)(St + 32 * LDT);
  float* tot = RF + 64 * 16;
  float* lastv = tot + 256;
  bfr* Att = Qr;

  const int ch = tid & 63, part = tid >> 6;
  float wd[16];
  {
    const float* W = (dir ? p.in[19] : p.in[17]) + (long)l * 16 * 256 + h * 64 + ch;
#pragma unroll
    for (int r = 0; r < 16; r++) wd[r] = W[r * 256];
  }
  const float bias = (dir ? p.in[20] : p.in[18])[l * 256 + h * 64 + ch];

  f32x4 st[2];
  if (lat) {
    const float* S0 = (dir ? p.in[7] : p.in[6]) + ((long)((b * 2 + l) * 4 + h)) * 8192 + (long)(16 * wid + l15) * 128 + vs0;
    float4 a = *(const float4*)(S0 + 4 * g);
    float4 c = *(const float4*)(S0 + 16 + 4 * g);
    st[0] = (f32x4){a.x, a.y, a.z, a.w};
    st[1] = (f32x4){c.x, c.y, c.z, c.w};
  } else {
    st[0] = (f32x4){0.f, 0.f, 0.f, 0.f};
    st[1] = (f32x4){0.f, 0.f, 0.f, 0.f};
  }
#pragma unroll
  for (int mv = 0; mv < 2; mv++)
#pragma unroll
    for (int r = 0; r < 4; r++) St[(16 * mv + 4 * g + r) * LDT + 16 * wid + l15] = f2bf(st[mv][r]);

  u32x4 rq[2], rk[2], rv, rr;
  auto prefetch = [&](int c) {
#pragma unroll
    for (int ii = 0; ii < 2; ii++) {
      int cc = tid + 256 * ii;
      int i = cc >> 3, c8 = cc & 7;
      int tok = dir ? (N - 1 - (c * 64 + i)) : (c * 64 + i);
      const bfr* zr = Z + (long)(rowbase + tok) * ZLD;
      rq[ii] = *(const u32x4*)(zr + C_QG + h * 64 + c8 * 8);
      rk[ii] = *(const u32x4*)(zr + C_KG + h * 64 + c8 * 8);
    }
    {
      int i = tid >> 2, c4 = tid & 3;
      int tok = dir ? (N - 1 - (c * 64 + i)) : (c * 64 + i);
      rv = *(const u32x4*)(Z + (long)(rowbase + tok) * ZLD + C_VG + h * 128 + vs0 + c4 * 8);
    }
    if (tid < 128) {
      int i = tid >> 1, hf = tid & 1;
      int tok = dir ? (N - 1 - (c * 64 + i)) : (c * 64 + i);
      rr = *(const u32x4*)(Z + (long)(rowbase + tok) * ZLD + (dir ? C_RB : C_RF) + hf * 8);
    }
  };

  prefetch(0);
  for (int c = 0; c < nc; c++) {
#pragma unroll
    for (int ii = 0; ii < 2; ii++) {
      int cc = tid + 256 * ii;
      *(u32x4*)(Qr + (cc >> 3) * LDT + (cc & 7) * 8) = rq[ii];
      *(u32x4*)(Kr + (cc >> 3) * LDT + (cc & 7) * 8) = rk[ii];
    }
    {
      int i = tid >> 2, c4 = tid & 3;
      const bfr* rb = (const bfr*)&rv;
#pragma unroll
      for (int e = 0; e < 8; e++) Vt[(c4 * 8 + e) * LDT + i] = rb[e];
    }
    if (tid < 128) {
      int i = tid >> 1, hf = tid & 1;
      float x[8];
      unpack8(rr, x);
#pragma unroll
      for (int e = 0; e < 8; e++) RF[i * 16 + hf * 8 + e] = x[e];
    }
    __syncthreads();
    if (c + 1 < nc) prefetch(c + 1);
    float cum[16];
    {
      float run = 0.f;
#pragma unroll
      for (int ii = 0; ii < 16; ii++) {
        int i = part * 16 + ii;
        float x = bias;
#pragma unroll
        for (int r = 0; r < 16; r++) x += RF[i * 16 + r] * wd[r];
        float la = (fminf(x, 0.f) - log1pf(__expf(-fabsf(x)))) * (1.f / 16.f);
        run += la;
        cum[ii] = run;
      }
      tot[part * 64 + ch] = run;
    }
    __syncthreads();
    {
      float off = 0.f, last = 0.f;
#pragma unroll
      for (int pp = 0; pp < 4; pp++) {
        float tv = tot[pp * 64 + ch];
        if (pp < part) off += tv;
        last += tv;
      }
      if (part == 0) lastv[ch] = last;
#pragma unroll
      for (int ii = 0; ii < 16; ii++) {
        int i = part * 16 + ii;
        float cc = cum[ii] + off;
        float qv = bf2f(Qr[i * LDT + ch]), kv = bf2f(Kr[i * LDT + ch]);
        Qe[i * LDT + ch] = f2bf(qv * __expf(cc) * 0.125f);
        Ke[i * LDT + ch] = f2bf(kv * __expf(-cc));
        KlT[ch * LDT + i] = f2bf(kv * __expf(last - cc));
      }
    }
    __syncthreads();
    f32x4 stn[2];
    {
      f32x4 att[4];
      bf16x8 qa[2];
#pragma unroll
      for (int kk = 0; kk < 2; kk++) qa[kk] = *(const bf16x8*)(Qe + (16 * wid + l15) * LDT + kk * 32 + g * 8);
#pragma unroll
      for (int nj = 0; nj < 4; nj++) {
        att[nj] = (f32x4){0.f, 0.f, 0.f, 0.f};
#pragma unroll
        for (int kk = 0; kk < 2; kk++) {
          bf16x8 kb = *(const bf16x8*)(Ke + (16 * nj + l15) * LDT + kk * 32 + g * 8);
          att[nj] = mfma16(qa[kk], kb, att[nj]);
        }
      }
      float el = __expf(lastv[16 * wid + l15]);
#pragma unroll
      for (int mv = 0; mv < 2; mv++) {
        stn[mv] = st[mv] * el;
#pragma unroll
        for (int kk = 0; kk < 2; kk++) {
          bf16x8 va = *(const bf16x8*)(Vt + (16 * mv + l15) * LDT + kk * 32 + g * 8);
          bf16x8 kb = *(const bf16x8*)(KlT + (16 * wid + l15) * LDT + kk * 32 + g * 8);
          stn[mv] = mfma16(va, kb, stn[mv]);
        }
      }
#pragma unroll
      for (int nj = 0; nj < 4; nj++)
#pragma unroll
        for (int r = 0; r < 4; r++) {
          int i = 16 * wid + 4 * g + r, j = 16 * nj + l15;
          Att[i * LDT + j] = f2bf(i >= j ? att[nj][r] : 0.f);
        }
    }
    __syncthreads();
    {
      bf16x8 aa[2], qa[2];
#pragma unroll
      for (int kk = 0; kk < 2; kk++) {
        aa[kk] = *(const bf16x8*)(Att + (16 * wid + l15) * LDT + kk * 32 + g * 8);
        qa[kk] = *(const bf16x8*)(Qe + (16 * wid + l15) * LDT + kk * 32 + g * 8);
      }
#pragma unroll
      for (int nv = 0; nv < 2; nv++) {
        f32x4 oc = (f32x4){0.f, 0.f, 0.f, 0.f};
#pragma unroll
        for (int kk = 0; kk < 2; kk++) {
          bf16x8 vb = *(const bf16x8*)(Vt + (16 * nv + l15) * LDT + kk * 32 + g * 8);
          oc = mfma16(aa[kk], vb, oc);
          bf16x8 sb = *(const bf16x8*)(St + (16 * nv + l15) * LDT + kk * 32 + g * 8);
          oc = mfma16(qa[kk], sb, oc);
        }
#pragma unroll
        for (int r = 0; r < 4; r++) {
          int i = 16 * wid + 4 * g + r;
          int tok = dir ? (N - 1 - (c * 64 + i)) : (c * 64 + i);
          OG[(long)(rowbase + tok) * 512 + h * 128 + vs0 + 16 * nv + l15] = f2bf(oc[r]);
        }
      }
    }
    __syncthreads();
#pragma unroll
    for (int mv = 0; mv < 2; mv++) {
      st[mv] = stn[mv];
#pragma unroll
      for (int r = 0; r < 4; r++) St[(16 * mv + 4 * g + r) * LDT + 16 * wid + l15] = f2bf(st[mv][r]);
    }
  }
  __syncthreads();
  if (!lat) {
    float* so = p.out + (dir ? O_SB : O_SF) + ((long)((seq * 2 + l) * 4 + h)) * 8192 + (long)(16 * wid + l15) * 128 + vs0;
    *(float4*)(so + 4 * g) = make_float4(st[0][0], st[0][1], st[0][2], st[0][3]);
    *(float4*)(so + 16 + 4 * g) = make_float4(st[1][0], st[1][1], st[1][2], st[1][3]);
  }
}

__device__ __forceinline__ void phase_mixers(const Params& p, int l, bfr* sm, int* s_item) {
  unsigned* ctr = (unsigned*)(p.ws + WS_CTR) + l;
  for (;;) {
    if (TIDX == 0) *s_item = (int)atomicAdd(ctr, 1u);
    __syncthreads();
    int idx = *s_item;
    __syncthreads();
    if (idx >= 1728) break;
    int kind, a0, a1, a2, a3 = 0;
    if (idx < 64) {
      kind = 0; a0 = 16 + (idx >> 5); a1 = (idx >> 3) & 3; a2 = (idx >> 2) & 1; a3 = idx & 3;
    } else if (idx < 320) {
      int i = idx - 64;
      kind = 1; a0 = 16 + (i >> 7); a1 = (i >> 5) & 3; a2 = i & 31;
    } else if (idx < 832) {
      int i = idx - 320;
      kind = 2; a0 = 16 + (i >> 8); a1 = (i >> 5) & 7; a2 = i & 31;
    } else if (idx < 1344) {
      int i = idx - 832;
      kind = 0; a0 = i >> 5; a1 = (i >> 3) & 3; a2 = (i >> 2) & 1; a3 = i & 3;
    } else if (idx < 1472) {
      int i = idx - 1344;
      kind = 1; a0 = i >> 3; a1 = (i >> 1) & 3; a2 = i & 1;
    } else {
      int i = idx - 1472;
      kind = 2; a0 = i >> 4; a1 = (i >> 1) & 7; a2 = i & 1;
    }
    if (kind == 0) gla_item(p, l, a0, a1, a2, a3, sm);
    else if (kind == 1) attn_item<96, 128, true>(p, a0, a1, a2, sm);
    else attn_item<64, 64, false>(p, a0, a1, a2, sm);
  }
}

__device__ __forceinline__ void phase_gla_out(const Params& p, int l) {
  const int lane = TIDX & 63;
  bfr* Z = (bfr*)(p.ws + WS_Z);
  const bfr* OF = (const bfr*)(p.ws + WS_R1);
  const bfr* OB = OF + (long)NROWS * 512;
  for (int row = blockIdx.x * 4 + (TIDX >> 6); row < NROWS; row += gridDim.x * 4) {
    float a[8], c[8], gt[8];
    unpack8(*(const u32x4*)(OF + (long)row * 512 + lane * 8), a);
    unpack8(*(const u32x4*)(OB + (long)row * 512 + lane * 8), c);
    bfr* gp = Z + (long)row * ZLD + C_GG + lane * 8;
    unpack8(*(const u32x4*)gp, gt);
    float ss = 0.f;
#pragma unroll
    for (int e = 0; e < 8; e++) {
      a[e] = bf2f(f2bf(a[e] + c[e]));
      ss += a[e] * a[e];
    }
    ss += __shfl_xor(ss, 1); ss += __shfl_xor(ss, 2); ss += __shfl_xor(ss, 4); ss += __shfl_xor(ss, 8);
    float rs = rsqrtf(ss * (1.f / 128.f) + 1e-6f);
    const float* gg = p.in[21] + l * 128 + (lane & 15) * 8;
#pragma unroll
    for (int e = 0; e < 8; e++) a[e] = a[e] * rs * gg[e] * siluf(gt[e]);
    *(u32x4*)gp = pack8(a);
  }
}

__device__ __forceinline__ void phase_merge(const Params& p, bfr* sm) {
  bfr* Z = (bfr*)(p.ws + WS_Z);
  bfr* MG = (bfr*)(p.ws + WS_R1);
  const int lane = TIDX & 63, wid = TIDX >> 6, wr = wid >> 1, wc = wid & 1, g = lane >> 4;
  for (int t = blockIdx.x; t < 96 * 8; t += gridDim.x) {
    int tn = t & 7, tm = t >> 3;
    f32x4 totl[4][4];
#pragma unroll
    for (int a = 0; a < 4; a++)
#pragma unroll
      for (int b = 0; b < 4; b++) totl[a][b] = (f32x4){0.f, 0.f, 0.f, 0.f};
#pragma unroll 1
    for (int seg = 0; seg < 3; seg++) {
      f32x4 acc[4][4];
#pragma unroll
      for (int a = 0; a < 4; a++)
#pragma unroll
        for (int b = 0; b < 4; b++) acc[a][b] = (f32x4){0.f, 0.f, 0.f, 0.f};
      int ycol = seg == 0 ? C_GA : (seg == 1 ? C_GG : C_GC);
      int mcol = C_M1 + seg * 1024;
      const bfr* W = (const bfr*)(p.ws + WS_WOA + (unsigned long)seg * 1048576ul) + (long)tn * 128 * 512;
      gemm128(W, 512, 128, Z + (long)tm * 128 * ZLD + ycol, ZLD, 128, 512, acc, sm);
#pragma unroll
      for (int pi = 0; pi < 4; pi++) {
        int n0 = tn * 128 + wr * 64 + pi * 16 + g * 4;
#pragma unroll
        for (int qi = 0; qi < 4; qi++) {
          int tok = tm * 128 + wc * 64 + qi * 16 + (lane & 15);
          u32x2 mr = *(const u32x2*)(Z + (long)tok * ZLD + mcol + n0);
          totl[pi][qi][0] += sigmf(lo16(mr.x)) * acc[pi][qi][0];
          totl[pi][qi][1] += sigmf(hi16(mr.x)) * acc[pi][qi][1];
          totl[pi][qi][2] += sigmf(lo16(mr.y)) * acc[pi][qi][2];
          totl[pi][qi][3] += sigmf(hi16(mr.y)) * acc[pi][qi][3];
        }
      }
    }
#pragma unroll
    for (int pi = 0; pi < 4; pi++) {
      int n0 = tn * 128 + wr * 64 + pi * 16 + g * 4;
#pragma unroll
      for (int qi = 0; qi < 4; qi++) {
        int tok = tm * 128 + wc * 64 + qi * 16 + (lane & 15);
        u32x2 o;
        o.x = pack2(totl[pi][qi][0], totl[pi][qi][1]);
        o.y = pack2(totl[pi][qi][2], totl[pi][qi][3]);
        *(u32x2*)(MG + (long)tok * 1024 + n0) = o;
      }
    }
  }
}

__device__ __forceinline__ void phase_outproj(const Params& p, bfr* sm) {
  const bfr* MG = (const bfr*)(p.ws + WS_R1);
  float* OUT = (float*)(p.ws + WS_Z);
  const int lane = TIDX & 63, wid = TIDX >> 6, wr = wid >> 1, wc = wid & 1, g = lane >> 4;
  for (int t = blockIdx.x; t < 96 * 8; t += gridDim.x) {
    int tn = t & 7, tm = t >> 3;
    f32x4 acc[4][4];
#pragma unroll
    for (int a = 0; a < 4; a++)
#pragma unroll
      for (int b = 0; b < 4; b++) acc[a][b] = (f32x4){0.f, 0.f, 0.f, 0.f};
    gemm128((const bfr*)(p.ws + WS_WOUT) + (long)tn * 128 * 1024, 1024, 128, MG + (long)tm * 128 * 1024, 1024, 128, 1024, acc,
            sm);
#pragma unroll
    for (int pi = 0; pi < 4; pi++) {
      int n0 = tn * 128 + wr * 64 + pi * 16 + g * 4;
#pragma unroll
      for (int qi = 0; qi < 4; qi++) {
        int tok = tm * 128 + wc * 64 + qi * 16 + (lane & 15);
        *(float4*)(OUT + (long)tok * 1024 + n0) = make_float4(acc[pi][qi][0], acc[pi][qi][1], acc[pi][qi][2], acc[pi][qi][3]);
      }
    }
  }
}

__device__ __forceinline__ void phase_post(const Params& p, int l) {
  const int lane = TIDX & 63;
  const float* mod = (const float*)(p.ws + WS_MOD);
  const float* OUT = (const float*)(p.ws + WS_Z);
  bfr* H = (bfr*)(p.ws + WS_R1);
  for (int row = blockIdx.x * 4 + (TIDX >> 6); row < NROWS; row += gridDim.x * 4) {
    const float* x = (l == 0) ? xrow(p, row) : (p.out + (long)row * 1024);
    const float* md = mod + (l * 3 + row_cond(row)) * 3072;
    float4 v[4];
    float ss = 0.f;
#pragma unroll
    for (int i = 0; i < 4; i++) {
      v[i] = *(const float4*)(OUT + (long)row * 1024 + i * 256 + lane * 4);
      ss += v[i].x * v[i].x + v[i].y * v[i].y + v[i].z * v[i].z + v[i].w * v[i].w;
    }
    ss = wave_sum(ss);
    float rs = rsqrtf(ss * (1.f / 1024.f) + 1e-6f);
    float ss2 = 0.f;
#pragma unroll
    for (int i = 0; i < 4; i++) {
      int n = i * 256 + lane * 4;
      float4 g = *(const float4*)(p.in[13] + l * 1024 + n);
      float4 gt = *(const float4*)(md + 2048 + n);
      float4 xv = *(const float4*)(x + n);
      v[i].x = xv.x + gt.x * (v[i].x * rs * g.x);
      v[i].y = xv.y + gt.y * (v[i].y * rs * g.y);
      v[i].z = xv.z + gt.z * (v[i].z * rs * g.z);
      v[i].w = xv.w + gt.w * (v[i].w * rs * g.w);
      *(float4*)(p.out + (long)row * 1024 + n) = v[i];
      ss2 += v[i].x * v[i].x + v[i].y * v[i].y + v[i].z * v[i].z + v[i].w * v[i].w;
    }
    if (l == 0) {
      ss2 = wave_sum(ss2);
      float rs2 = rsqrtf(ss2 * (1.f / 1024.f) + 1e-6f);
      const float* md1 = mod + (1 * 3 + row_cond(row)) * 3072;
#pragma unroll
      for (int i = 0; i < 4; i++) {
        int n = i * 256 + lane * 4;
        float4 g = *(const float4*)(p.in[12] + 1024 + n);
        float4 sh = *(const float4*)(md1 + n);
        float4 sc = *(const float4*)(md1 + 1024 + n);
        float h0 = v[i].x * rs2 * g.x * (1.f + sc.x) + sh.x;
        float h1 = v[i].y * rs2 * g.y * (1.f + sc.y) + sh.y;
        float h2 = v[i].z * rs2 * g.z * (1.f + sc.z) + sh.z;
        float h3 = v[i].w * rs2 * g.w * (1.f + sc.w) + sh.w;
        u32x2 o;
        o.x = pack2(h0, h1);
        o.y = pack2(h2, h3);
        *(u32x2*)(H + (long)row * 1024 + n) = o;
      }
    }
  }
}

__global__ void __launch_bounds__(256, 2) fwd_megakernel(Params p) {
  __shared__ __attribute__((aligned(16))) bfr sm[SMEM_SHORTS];
  __shared__ int s_item;
  cg::grid_group grid = cg::this_grid();

#ifndef PH
#define PH 0xffff
#endif
#if PH & 1
  phase_s0(launder(p), sm);
#endif
  grid.sync();
#if PH & 2
  phase_s1(launder(p));
  wconv_phase(p, 0, sm);
#endif
  grid.sync();
#if PH & 4
  phase_prenorm0(launder(p));
#endif
  grid.sync();
  for (int l = 0; l < 2; l++) {
#if PH & 8
    phase_inproj(launder(p), sm);
#endif
    grid.sync();
#if PH & 16
    phase_rowpost(launder(p), l);
#endif
    grid.sync();
#if PH & 32
    phase_mla_up(launder(p), sm);
#endif
    grid.sync();
#if PH & 64
    phase_mixers(launder(p), l, sm, &s_item);
#endif
    grid.sync();
#if PH & 128
    phase_gla_out(launder(p), l);
#endif
    grid.sync();
#if PH & 256
    phase_merge(launder(p), sm);
#endif
    grid.sync();
#if PH & 512
    phase_outproj(launder(p), sm);
#endif
    grid.sync();
#if PH & 1024
    phase_post(launder(p), l);
    if (l == 0) wconv_phase(p, 1, sm);
#endif
    grid.sync();
  }
}

extern "C" void kernel_launch(void* const* d_in, const int* in_sizes, int n_in, void* d_out, int out_size, void* d_ws,
                              size_t ws_size, hipStream_t stream) {
  static int grid_blocks = 0;
  if (!grid_blocks) {
    int dev = 0, cus = 0, per_cu = 0;
    hipGetDevice(&dev);
    hipDeviceGetAttribute(&cus, hipDeviceAttributeMultiprocessorCount, dev);
    hipOccupancyMaxActiveBlocksPerMultiprocessor(&per_cu, fwd_megakernel, 256, 0);
    if (per_cu > 2) per_cu = 2;
    if (per_cu < 1) per_cu = 1;
    grid_blocks = cus * per_cu;
  }
  Params p{};
  for (int i = 0; i < 30; i++) p.in[i] = (const float*)d_in[i];
  p.out = (float*)d_out;
  p.ws = (unsigned char*)d_ws;
  void* args[] = {&p};
  hipError_t e = hipLaunchCooperativeKernel((void*)fwd_megakernel, dim3(grid_blocks), dim3(256), args, 0, stream);
  if (e != hipSuccess) fprintf(stderr, "cooperative launch failed: %s (grid %d)\n", hipGetErrorString(e), grid_blocks);
}
```

```cpp
#include <hip/hip_runtime.h>
#include <hip/hip_cooperative_groups.h>
#include <cstdio>
namespace cg = cooperative_groups;

typedef unsigned short bfr;
typedef __attribute__((ext_vector_type(8))) short bf16x8;
typedef __attribute__((ext_vector_type(4))) float f32x4;
typedef __attribute__((ext_vector_type(4))) unsigned u32x4;
typedef __attribute__((ext_vector_type(2))) unsigned u32x2;

#define NROWS 12288
#define NCTX 4096
#define ZLD 6976
#define LDT 72
#define SMEM_SHORTS (4 * 128 * LDT)

#define C_QA 0
#define C_KA 512
#define C_VA 640
#define C_GA 768
#define C_QG 1280
#define C_KG 1536
#define C_VG 1792
#define C_GG 2304
#define C_RF 2816
#define C_RB 2832
#define C_QL 2848
#define C_KV 3104
#define C_KR 3360
#define C_GC 3392
#define C_M1 3904
#define C_M2 4928
#define C_M3 5952

#define WS_BAR 0ul
#define WS_CTR 16384ul
#define WS_MODP 20480ul
#define WS_MOD (WS_MODP + 589824ul)
#define WS_ROPE (WS_MOD + 73728ul)
#define WS_WIN (WS_ROPE + 16384ul)
#define WS_WUQ (WS_WIN + 14417920ul)
#define WS_WUKV (WS_WUQ + 196608ul)
#define WS_WOA (WS_WUKV + 393216ul)
#define WS_WOB (WS_WOA + 1048576ul)
#define WS_WOC (WS_WOB + 1048576ul)
#define WS_WOUT (WS_WOC + 1048576ul)
#define WS_KCA (WS_WOUT + 2097152ul)
#define WS_CKVC (WS_KCA + 262144ul)
#define WS_KRC (WS_CKVC + 524288ul)
#define WS_VTA (WS_KRC + 65536ul)
#define WS_CQ (WS_VTA + 3407872ul)
#define WS_KNOPE (WS_CQ + 9437184ul)
#define WS_VTC (WS_KNOPE + 6815744ul)
#define WS_R1 (WS_VTC + 13631488ul)
#define WS_Z (WS_R1 + 25165824ul)
#define WS_END (WS_Z + 171442176ul)

#define O_Y 0
#define O_GK 12582912
#define O_GV 13631488
#define O_CKV 14680064
#define O_KR 16777216
#define O_SF 17039360
#define O_SB 18087936

struct Params {
  const float* in[30];
  float* out;
  unsigned char* ws;
};

__device__ __forceinline__ int tidx() {
  int t = threadIdx.x;
  asm volatile("" : "+v"(t));
  return t;
}
__device__ __forceinline__ Params launder(const Params& p) {
  Params q;
  long zo = 0;
  asm volatile("" : "+s"(zo));
#pragma unroll
  for (int i = 0; i < 30; i++) q.in[i] = p.in[i] + zo;
  q.out = p.out + zo;
  q.ws = p.ws + zo;
  return q;
}
__device__ __forceinline__ float bf2f(bfr b) { return __uint_as_float(((unsigned)b) << 16); }
__device__ __forceinline__ bfr f2bf(float f) {
  unsigned u = __float_as_uint(f);
  u += 0x7fffu + ((u >> 16) & 1u);
  return (bfr)(u >> 16);
}
__device__ __forceinline__ unsigned pack2(float a, float b) { return (unsigned)f2bf(a) | ((unsigned)f2bf(b) << 16); }
__device__ __forceinline__ float lo16(unsigned u) { return __uint_as_float(u << 16); }
__device__ __forceinline__ float hi16(unsigned u) { return __uint_as_float(u & 0xffff0000u); }
__device__ __forceinline__ float siluf(float x) { return x / (1.f + __expf(-x)); }
__device__ __forceinline__ float sigmf(float x) { return 1.f / (1.f + __expf(-x)); }
__device__ __forceinline__ f32x4 mfma16(bf16x8 a, bf16x8 b, f32x4 c) {
  return __builtin_amdgcn_mfma_f32_16x16x32_bf16(a, b, c, 0, 0, 0);
}
__device__ __forceinline__ const float* xrow(const Params& p, int row) {
  return row < NCTX ? p.in[0] + (long)row * 1024 : p.in[1] + (long)(row - NCTX) * 1024;
}
__device__ __forceinline__ int row_cond(int row) { return row < NCTX ? 0 : 1 + ((row - NCTX) >> 12); }
__device__ __forceinline__ float wave_sum(float v) {
  v += __shfl_xor(v, 1); v += __shfl_xor(v, 2); v += __shfl_xor(v, 4);
  v += __shfl_xor(v, 8); v += __shfl_xor(v, 16); v += __shfl_xor(v, 32);
  return v;
}

#define XB_TMO      128
#define XB_XCNT(j)  (256  + 64 * (j))
#define XB_XSUB(j)  (1280 + 64 * (j))
#define XB_XGEN(j)  (2304 + 64 * (j))
#define XB_TOP      3328
#define XB_TOPGEN   3392
#define XCD_BAR_WORDS 3456
#define XB_SPIN_CAP (1u << 18)
#define LAS __attribute__((address_space(3)))

__device__ __forceinline__ unsigned xb_ld(unsigned* p)              { return __hip_atomic_load(p, __ATOMIC_RELAXED, __HIP_MEMORY_SCOPE_AGENT); }
__device__ __forceinline__ unsigned xb_add(unsigned* p, unsigned v) { return __hip_atomic_fetch_add(p, v, __ATOMIC_RELAXED, __HIP_MEMORY_SCOPE_AGENT); }
__device__ __forceinline__ unsigned xb_xcc_id() { return (unsigned)__builtin_amdgcn_s_getreg((3 << 11) | 20) & 0xFu; }
#define XB_SPIN(cond, bar) do { unsigned _sp = 0; while (cond) { __builtin_amdgcn_s_sleep(1); \
    if ((++_sp & 255u) == 0u) { if (xb_ld(&(bar)[XB_TMO])) break; if (_sp > XB_SPIN_CAP) { atomicAdd(&(bar)[XB_TMO], 1u); break; } } } } while (0)

struct XcdBarrier {
    unsigned* bar; unsigned x;
    volatile LAS unsigned* st;
};

__device__ __forceinline__ XcdBarrier xcd_barrier_post(unsigned* bar, volatile LAS unsigned* st) {
    XcdBarrier b; b.bar = bar; b.x = xb_xcc_id(); b.st = st;
    if (threadIdx.x == 0) (void)xb_add(&bar[XB_XCNT(b.x)], 1u);
    return b;
}
__device__ __forceinline__ void xcd_barrier_complete(unsigned* bar, unsigned x, unsigned& nloc, unsigned& nx) {
    const unsigned G = gridDim.x * gridDim.y * gridDim.z;
    unsigned sum, cnt, mine, sp = 0u;
    for (;;) {
        sum = 0u; cnt = 0u; mine = 0u;
#pragma unroll
        for (unsigned j = 0; j < 16; ++j) { const unsigned c = xb_ld(&bar[XB_XCNT(j)]); sum += c; cnt += (c > 0u) ? 1u : 0u; mine = (j == x) ? c : mine; }
        if (sum == G) break;
        __builtin_amdgcn_s_sleep(1);
        if ((++sp & 255u) == 0u) { if (xb_ld(&bar[XB_TMO])) break; if (sp > XB_SPIN_CAP) { atomicAdd(&bar[XB_TMO], 1u); break; } }
    }
    nloc = mine > 0u ? mine : 1u; nx = cnt > 0u ? cnt : 1u;
}

__device__ __forceinline__ void xcd_barrier(const XcdBarrier& b) {
    asm volatile("s_waitcnt vmcnt(0)" ::: "memory");
    __syncthreads();
    if (threadIdx.x == 0) {
        unsigned* bar = b.bar;
        __builtin_amdgcn_s_waitcnt(0);
        unsigned nloc = b.st[0], nx = b.st[1];
        if (nloc == 0u) { xcd_barrier_complete(bar, b.x, nloc, nx); b.st[0] = nloc; b.st[1] = nx; }
        const unsigned old = xb_add(&bar[XB_XSUB(b.x)], 1u);
        const unsigned gen = old / nloc;
        if (old + 1u == (gen + 1u) * nloc) {
            __builtin_amdgcn_fence(__ATOMIC_RELEASE, "agent");
            asm volatile("s_waitcnt vmcnt(0)" ::: "memory");
            const unsigned og = xb_add(&bar[XB_TOP], 1u);
            const unsigned tg = og / nx;
            if (og + 1u == (tg + 1u) * nx) xb_add(&bar[XB_TOPGEN], 1u);
            else XB_SPIN(xb_ld(&bar[XB_TOPGEN]) == tg, bar);
            __builtin_amdgcn_fence(__ATOMIC_ACQUIRE, "agent");
            xb_add(&bar[XB_XGEN(b.x)], 1u);
            asm volatile("s_waitcnt vmcnt(0)" ::: "memory");
        } else {
            XB_SPIN(xb_ld(&bar[XB_XGEN(b.x)]) == gen, bar);
            __builtin_amdgcn_fence(__ATOMIC_ACQUIRE, "agent");
            asm volatile("s_waitcnt vmcnt(0)" ::: "memory");
        }
    }
    __syncthreads();
}


#define TIDX tidx()
__device__ __forceinline__ void gemm128(const bfr* __restrict__ P, long ldp, int pmax,
                                        const bfr* __restrict__ Q, long ldq, int qmax, int K,
                                        f32x4 (&acc)[4][4], bfr* sm) {
  const int tid = TIDX, lane = tid & 63, wid = tid >> 6;
  const int wr = wid >> 1, wc = wid & 1;
  const int lr = tid >> 3, lc = (tid & 7) * 8;
  u32x4 rp[4], rq[4];
  const bfr* pp[4];
  const bfr* qp[4];
#pragma unroll
  for (int i = 0; i < 4; i++) {
    int r = lr + 32 * i;
    pp[i] = P + (long)min(r, pmax - 1) * ldp + lc;
    qp[i] = Q + (long)min(r, qmax - 1) * ldq + lc;
    rp[i] = *(const u32x4*)(pp[i]);
    rq[i] = *(const u32x4*)(qp[i]);
  }
  const int nk = K >> 6;
  for (int kt = 0; kt < nk; kt++) {
    bfr* Ps = sm + (kt & 1) * (2 * 128 * LDT);
    bfr* Qs = Ps + 128 * LDT;
#pragma unroll
    for (int i = 0; i < 4; i++) {
      *(u32x4*)(Ps + (lr + 32 * i) * LDT + lc) = rp[i];
      *(u32x4*)(Qs + (lr + 32 * i) * LDT + lc) = rq[i];
    }
    __syncthreads();
    if (kt + 1 < nk) {
#pragma unroll
      for (int i = 0; i < 4; i++) {
        rp[i] = *(const u32x4*)(pp[i] + (kt + 1) * 64);
        rq[i] = *(const u32x4*)(qp[i] + (kt + 1) * 64);
      }
    }
#pragma unroll
    for (int kk = 0; kk < 2; kk++) {
      bf16x8 pf[4], qf[4];
#pragma unroll
      for (int m = 0; m < 4; m++) {
        pf[m] = *(const bf16x8*)(Ps + (wr * 64 + m * 16 + (lane & 15)) * LDT + kk * 32 + (lane >> 4) * 8);
        qf[m] = *(const bf16x8*)(Qs + (wc * 64 + m * 16 + (lane & 15)) * LDT + kk * 32 + (lane >> 4) * 8);
      }
#pragma unroll
      for (int m = 0; m < 4; m++)
#pragma unroll
        for (int n = 0; n < 4; n++) acc[m][n] = mfma16(pf[m], qf[n], acc[m][n]);
    }
  }
  __syncthreads();
}

__device__ __forceinline__ void phase_s0(const Params& p, bfr* sm) {
  const int tid = TIDX;
  float* rope = (float*)(p.ws + WS_ROPE);
  for (int idx = blockIdx.x * 256 + tid; idx < 1536; idx += gridDim.x * 256) {
    if (idx < 1024) {
      int pos = idx >> 4, i = idx & 15;
      float fr = powf(10000.f, -(float)i / 16.f);
      float a = (float)pos * fr;
      rope[idx] = cosf(a);
      rope[1024 + idx] = sinf(a);
    } else {
      int j = idx - 1024;
      int pos = j >> 3, i = j & 7;
      float fr = powf(10000.f, -(float)i / 8.f);
      float a = (float)pos * fr;
      rope[2048 + j] = cosf(a);
      rope[2560 + j] = sinf(a);
    }
  }
  float* smf = (float*)sm;
  float* modp = (float*)(p.ws + WS_MODP);
  for (int it = blockIdx.x; it < 768; it += gridDim.x) {
    int l = it / 384, rem = it % 384, cgp = rem >> 3, ks = rem & 7;
    int col = cgp * 64 + (tid & 63), kq = tid >> 6;
    const float* w = p.in[10] + (long)l * 1024 * 3072 + col;
    float a0 = 0.f, a1 = 0.f, a2 = 0.f;
    int k0 = ks * 128 + kq * 32;
#pragma unroll 8
    for (int k = k0; k < k0 + 32; k++) {
      float wv = w[(long)k * 3072];
      a0 += siluf(p.in[9][k]) * wv;
      a1 += siluf(p.in[8][k]) * wv;
      a2 += siluf(p.in[8][1024 + k]) * wv;
    }
    smf[(kq * 3 + 0) * 64 + (tid & 63)] = a0;
    smf[(kq * 3 + 1) * 64 + (tid & 63)] = a1;
    smf[(kq * 3 + 2) * 64 + (tid & 63)] = a2;
    __syncthreads();
    if (tid < 192) {
      int c = tid >> 6, cc = tid & 63;
      float s = smf[(0 * 3 + c) * 64 + cc] + smf[(1 * 3 + c) * 64 + cc] + smf[(2 * 3 + c) * 64 + cc] + smf[(3 * 3 + c) * 64 + cc];
      modp[((ks * 2 + l) * 3 + c) * 3072 + cgp * 64 + cc] = s;
    }
    __syncthreads();
  }
}

__device__ __forceinline__ void phase_s1(const Params& p) {
  float* modp = (float*)(p.ws + WS_MODP);
  float* mod = (float*)(p.ws + WS_MOD);
  for (int idx = blockIdx.x * 256 + TIDX; idx < 2 * 3 * 3072; idx += gridDim.x * 256) {
    int l = idx / 9216, n = idx % 3072;
    float s = p.in[11][l * 3072 + n];
#pragma unroll
    for (int ks = 0; ks < 8; ks++) s += modp[ks * 18432 + idx];
    mod[idx] = s;
  }
}

__device__ __forceinline__ void wconv_tile(const float* __restrict__ src, int K, int N, bfr* __restrict__ dst,
                                           int tk, int tn, float* smf) {
  const int tid = TIDX;
  const int n = tid & 63, kb = tid >> 6;
#pragma unroll
  for (int i = 0; i < 16; i++) {
    int k = kb + 4 * i;
    smf[k * 65 + n] = src[(long)(tk * 64 + k) * N + tn * 64 + n];
  }
  __syncthreads();
#pragma unroll
  for (int i = 0; i < 16; i++) {
    int idx = tid + 256 * i;
    int nn = idx >> 6, k = idx & 63;
    dst[(long)(tn * 64 + nn) * K + tk * 64 + k] = f2bf(smf[k * 65 + nn]);
  }
  __syncthreads();
}

#define WCONV_ITEMS 2456
__device__ __forceinline__ void wconv_phase(const Params& p, int l, bfr* sm) {
  float* smf = (float*)sm;
  for (int item0 = blockIdx.x; item0 < WCONV_ITEMS; item0 += gridDim.x) {
    int item = item0;
    const float* src;
    bfr* dst;
    int K, N, tk, tn;
    if (item < 1744) {
      src = p.in[14] + (long)l * 1024 * 6976; K = 1024; N = 6976; dst = (bfr*)(p.ws + WS_WIN); tk = item & 15; tn = item >> 4;
    } else if (item < 1768) {
      item -= 1744;
      src = p.in[24] + (long)l * 256 * 384; K = 256; N = 384; dst = (bfr*)(p.ws + WS_WUQ); tk = item & 3; tn = item >> 2;
    } else if (item < 1816) {
      item -= 1768;
      src = p.in[25] + (long)l * 256 * 768; K = 256; N = 768; dst = (bfr*)(p.ws + WS_WUKV); tk = item & 3; tn = item >> 2;
    } else if (item < 2200) {
      item -= 1816;
      int w = item >> 7, it = item & 127;
      src = (w == 0 ? p.in[26] : (w == 1 ? p.in[27] : p.in[28])) + (long)l * 512 * 1024;
      K = 512; N = 1024; dst = (bfr*)(p.ws + WS_WOA + (unsigned long)w * 1048576ul); tk = it & 7; tn = it >> 3;
    } else {
      item -= 2200;
      src = p.in[29] + (long)l * 1024 * 1024; K = 1024; N = 1024; dst = (bfr*)(p.ws + WS_WOUT); tk = item & 15; tn = item >> 4;
    }
    wconv_tile(src, K, N, dst, tk, tn, smf);
  }
}

__device__ __forceinline__ void phase_prenorm0(const Params& p) {
  const int lane = TIDX & 63;
  const float* mod = (const float*)(p.ws + WS_MOD);
  bfr* H = (bfr*)(p.ws + WS_R1);
  for (int row = blockIdx.x * 4 + (TIDX >> 6); row < NROWS; row += gridDim.x * 4) {
    const float* x = xrow(p, row);
    const float* md = mod + (0 * 3 + row_cond(row)) * 3072;
    float4 v[4];
    float ss = 0.f;
#pragma unroll
    for (int i = 0; i < 4; i++) {
      v[i] = *(const float4*)(x + i * 256 + lane * 4);
      ss += v[i].x * v[i].x + v[i].y * v[i].y + v[i].z * v[i].z + v[i].w * v[i].w;
    }
    ss = wave_sum(ss);
    float rs = rsqrtf(ss * (1.f / 1024.f) + 1e-6f);
#pragma unroll
    for (int i = 0; i < 4; i++) {
      int n = i * 256 + lane * 4;
      float4 g = *(const float4*)(p.in[12] + n);
      float4 sh = *(const float4*)(md + n);
      float4 sc = *(const float4*)(md + 1024 + n);
      float h0 = v[i].x * rs * g.x * (1.f + sc.x) + sh.x;
      float h1 = v[i].y * rs * g.y * (1.f + sc.y) + sh.y;
      float h2 = v[i].z * rs * g.z * (1.f + sc.z) + sh.z;
      float h3 = v[i].w * rs * g.w * (1.f + sc.w) + sh.w;
      u32x2 o;
      o.x = pack2(h0, h1);
      o.y = pack2(h2, h3);
      *(u32x2*)(H + (long)row * 1024 + n) = o;
    }
  }
}

__device__ __forceinline__ void phase_inproj(const Params& p, bfr* sm) {
  const bfr* H = (const bfr*)(p.ws + WS_R1);
  const bfr* W = (const bfr*)(p.ws + WS_WIN);
  bfr* Z = (bfr*)(p.ws + WS_Z);
  const int lane = TIDX & 63, wid = TIDX >> 6, wr = wid >> 1, wc = wid & 1;
  for (int t = blockIdx.x; t < 96 * 55; t += gridDim.x) {
    int tn = t % 55, tm = t / 55;
    f32x4 acc[4][4];
#pragma unroll
    for (int a = 0; a < 4; a++)
#pragma unroll
      for (int b = 0; b < 4; b++) acc[a][b] = (f32x4){0.f, 0.f, 0.f, 0.f};
    gemm128(W + (long)tn * 128 * 1024, 1024, ZLD - tn * 128, H + (long)tm * 128 * 1024, 1024, 128, 1024, acc, sm);
#pragma unroll
    for (int pi = 0; pi < 4; pi++) {
      int n0 = tn * 128 + wr * 64 + pi * 16 + (lane >> 4) * 4;
      if (n0 < ZLD) {
#pragma unroll
        for (int qi = 0; qi < 4; qi++) {
          int tok = tm * 128 + wc * 64 + qi * 16 + (lane & 15);
          u32x2 o;
          o.x = pack2(acc[pi][qi][0], acc[pi][qi][1]);
          o.y = pack2(acc[pi][qi][2], acc[pi][qi][3]);
          *(u32x2*)(Z + (long)tok * ZLD + n0) = o;
        }
      }
    }
  }
}

__device__ __forceinline__ void unpack8(u32x4 v, float* x) {
  x[0] = lo16(v.x); x[1] = hi16(v.x); x[2] = lo16(v.y); x[3] = hi16(v.y);
  x[4] = lo16(v.z); x[5] = hi16(v.z); x[6] = lo16(v.w); x[7] = hi16(v.w);
}
__device__ __forceinline__ u32x4 pack8(const float* y) {
  u32x4 o;
  o.x = pack2(y[0], y[1]); o.y = pack2(y[2], y[3]); o.z = pack2(y[4], y[5]); o.w = pack2(y[6], y[7]);
  return o;
}

__device__ __forceinline__ void phase_rowpost(const Params& p, int l) {
  const int lane = TIDX & 63;
  bfr* Z = (bfr*)(p.ws + WS_Z);
  const float* rope = (const float*)(p.ws + WS_ROPE);
  bfr* VTA = (bfr*)(p.ws + WS_VTA);
  bfr* KCA = (bfr*)(p.ws + WS_KCA);
  bfr* CKVC = (bfr*)(p.ws + WS_CKVC);
  bfr* KRC = (bfr*)(p.ws + WS_KRC);
  float* out = p.out;
  for (int row = blockIdx.x * 4 + (TIDX >> 6); row < NROWS + 1024; row += gridDim.x * 4) {
    if (row < NROWS) {
      const bool lat = row >= NCTX;
      const int bc = row >> 8, tc = row & 255;
      const int bl = (row - NCTX) >> 12, tl = (row - NCTX) & 4095;
      const int prow = tl >> 6, pcol = tl & 63;
      bfr* z = Z + (long)row * ZLD;
      {
        float x[8];
        unpack8(*(const u32x4*)(z + C_QA + lane * 8), x);
        float ss = 0.f;
#pragma unroll
        for (int e = 0; e < 8; e++) ss += x[e] * x[e];
        ss += __shfl_xor(ss, 1); ss += __shfl_xor(ss, 2); ss += __shfl_xor(ss, 4);
        float rs = rsqrtf(ss * (1.f / 64.f) + 1e-6f);
        int sub = lane & 7;
        const float* g = p.in[15] + l * 64 + sub * 8;
#pragma unroll
        for (int e = 0; e < 8; e++) x[e] = x[e] * rs * g[e];
        if (lat) {
          int pos = (sub >> 2) ? pcol : prow;
          bool hi = (sub & 2) != 0;
          int i0 = (sub & 1) * 8;
#pragma unroll
          for (int e = 0; e < 8; e++) {
            float yp = __shfl_xor(x[e], 2);
            float c = rope[pos * 16 + i0 + e], s = rope[1024 + pos * 16 + i0 + e];
            x[e] = hi ? (yp * s + x[e] * c) : (x[e] * c - yp * s);
          }
        }
        const float qs = 0.125f * 1.4426950408889634f;
#pragma unroll
        for (int e = 0; e < 8; e++) x[e] *= qs;
        *(u32x4*)(z + C_QA + lane * 8) = pack8(x);
      }
      {
        int L = lane & 15;
        float x[8];
        unpack8(*(const u32x4*)(z + C_KA + L * 8), x);
        float ss = 0.f;
#pragma unroll
        for (int e = 0; e < 8; e++) ss += x[e] * x[e];
        ss += __shfl_xor(ss, 1); ss += __shfl_xor(ss, 2); ss += __shfl_xor(ss, 4);
        float rs = rsqrtf(ss * (1.f / 64.f) + 1e-6f);
        int sub = L & 7;
        const float* g = p.in[16] + l * 64 + sub * 8;
#pragma unroll
        for (int e = 0; e < 8; e++) x[e] = x[e] * rs * g[e];
        if (lat) {
          int pos = (sub >> 2) ? pcol : prow;
          bool hi = (sub & 2) != 0;
          int i0 = (sub & 1) * 8;
#pragma unroll
          for (int e = 0; e < 8; e++) {
            float yp = __shfl_xor(x[e], 2);
            float c = rope[pos * 16 + i0 + e], s = rope[1024 + pos * 16 + i0 + e];
            x[e] = hi ? (yp * s + x[e] * c) : (x[e] * c - yp * s);
          }
        } else if (lane < 16) {
          float* o = out + O_GK + ((long)(bc * 2 + l) * 256 + tc) * 128 + L * 8;
          *(float4*)(o) = make_float4(x[0], x[1], x[2], x[3]);
          *(float4*)(o + 4) = make_float4(x[4], x[5], x[6], x[7]);
        }
        if (lane < 16) *(u32x4*)(z + C_KA + L * 8) = pack8(x);
      }
      if (lane < 16) {
        int L = lane;
        u32x4 raw = *(const u32x4*)(z + C_VA + L * 8);
        float x[8];
        unpack8(raw, x);
        if (!lat) {
          float* o = out + O_GV + ((long)(bc * 2 + l) * 256 + tc) * 128 + L * 8;
          *(float4*)(o) = make_float4(x[0], x[1], x[2], x[3]);
          *(float4*)(o + 4) = make_float4(x[4], x[5], x[6], x[7]);
        }
        int g = L >> 3, d0 = (L & 7) * 8;
        long base; int nk, key;
        if (!lat) { base = (long)bc * 32768; nk = 256; key = tc; }
        else { base = 16l * 32768 + (long)bl * (2 * 64 * 4608); nk = 4608; key = 512 + tl; }
        const bfr* rb = (const bfr*)&raw;
#pragma unroll
        for (int e = 0; e < 8; e++) VTA[base + (long)(g * 64 + d0 + e) * nk + key] = rb[e];
      }
      {
        u32x2 rq = *(const u32x2*)(z + C_QL + lane * 4);
        u32x2 rk = *(const u32x2*)(z + C_KV + lane * 4);
        float q[4] = {lo16(rq.x), hi16(rq.x), lo16(rq.y), hi16(rq.y)};
        float k[4] = {lo16(rk.x), hi16(rk.x), lo16(rk.y), hi16(rk.y)};
        float sq = q[0] * q[0] + q[1] * q[1] + q[2] * q[2] + q[3] * q[3];
        float sk = k[0] * k[0] + k[1] * k[1] + k[2] * k[2] + k[3] * k[3];
        sq = wave_sum(sq);
        sk = wave_sum(sk);
        float rq_ = rsqrtf(sq * (1.f / 256.f) + 1e-6f), rk_ = rsqrtf(sk * (1.f / 256.f) + 1e-6f);
        float4 gq = *(const float4*)(p.in[22] + l * 256 + lane * 4);
        float4 gk = *(const float4*)(p.in[23] + l * 256 + lane * 4);
        q[0] *= rq_ * gq.x; q[1] *= rq_ * gq.y; q[2] *= rq_ * gq.z; q[3] *= rq_ * gq.w;
        k[0] *= rk_ * gk.x; k[1] *= rk_ * gk.y; k[2] *= rk_ * gk.z; k[3] *= rk_ * gk.w;
        u32x2 o;
        o.x = pack2(q[0], q[1]); o.y = pack2(q[2], q[3]);
        *(u32x2*)(z + C_QL + lane * 4) = o;
        o.x = pack2(k[0], k[1]); o.y = pack2(k[2], k[3]);
        *(u32x2*)(z + C_KV + lane * 4) = o;
        if (!lat) *(float4*)(out + O_CKV + ((long)(bc * 2 + l) * 256 + tc) * 256 + lane * 4) = make_float4(k[0], k[1], k[2], k[3]);
      }
      {
        int L = lane & 3;
        float x[8];
        unpack8(*(const u32x4*)(z + C_KR + L * 8), x);
        if (lat) {
          int pos = (L >> 1) ? pcol : prow;
          bool hi = (L & 1) != 0;
#pragma unroll
          for (int e = 0; e < 8; e++) {
            float yp = __shfl_xor(x[e], 1);
            float c = rope[2048 + pos * 8 + e], s = rope[2560 + pos * 8 + e];
            x[e] = hi ? (yp * s + x[e] * c) : (x[e] * c - yp * s);
          }
          if (lane < 4) *(u32x4*)(z + C_KR + L * 8) = pack8(x);
        } else if (lane < 4) {
          float* o = out + O_KR + ((long)(bc * 2 + l) * 256 + tc) * 32 + L * 8;
          *(float4*)(o) = make_float4(x[0], x[1], x[2], x[3]);
          *(float4*)(o + 4) = make_float4(x[4], x[5], x[6], x[7]);
        }
      }
    } else {
      int cr = row - NROWS;
      int b = cr >> 9, t = cr & 511;
      long src = (long)(b * 2 + l) * 512 + t;
      {
        float2 kv = *(const float2*)(p.in[2] + src * 128 + lane * 2);
        *(unsigned*)(KCA + (long)(b * 512 + t) * 128 + lane * 2) = pack2(kv.x, kv.y);
        float2 vv = *(const float2*)(p.in[3] + src * 128 + lane * 2);
        int c0 = lane * 2;
        long base = 16l * 32768 + (long)b * (2 * 64 * 4608);
        VTA[base + (long)c0 * 4608 + t] = f2bf(vv.x);
        VTA[base + (long)(c0 + 1) * 4608 + t] = f2bf(vv.y);
        float4 cv = *(const float4*)(p.in[4] + src * 256 + lane * 4);
        u32x2 o;
        o.x = pack2(cv.x, cv.y); o.y = pack2(cv.z, cv.w);
        *(u32x2*)(CKVC + (long)(b * 512 + t) * 256 + lane * 4) = o;
        if (lane < 32) KRC[(long)(b * 512 + t) * 32 + lane] = f2bf(p.in[5][src * 32 + lane]);
      }
    }
  }
}

__device__ __forceinline__ void phase_mla_up(const Params& p, bfr* sm) {
  bfr* Z = (bfr*)(p.ws + WS_Z);
  const float* rope = (const float*)(p.ws + WS_ROPE);
  const int lane = TIDX & 63, wid = TIDX >> 6, wr = wid >> 1, wc = wid & 1;
  const int g = lane >> 4;
  for (int t = blockIdx.x; t < 288 + 624; t += gridDim.x) {
    f32x4 acc[4][4];
#pragma unroll
    for (int a = 0; a < 4; a++)
#pragma unroll
      for (int b = 0; b < 4; b++) acc[a][b] = (f32x4){0.f, 0.f, 0.f, 0.f};
    if (t < 288) {
      int tn = t % 3, tm = t / 3;
      gemm128((const bfr*)(p.ws + WS_WUQ) + (long)tn * 128 * 256, 256, 128, Z + (long)tm * 128 * ZLD + C_QL, ZLD, 128, 256,
              acc, sm);
      bfr* CQ = (bfr*)(p.ws + WS_CQ);
      const float qs = 0.10206207261596577f * 1.4426950408889634f;
#pragma unroll
      for (int pi = 0; pi < 4; pi++) {
        int nb = tn * 128 + wr * 64 + pi * 16;
        int wb = nb % 96;
        bool ropet = wb >= 64;
        int part = (wb - 64) >> 4;
#pragma unroll
        for (int qi = 0; qi < 4; qi++) {
          int tok = tm * 128 + wc * 64 + qi * 16 + (lane & 15);
          float y[4] = {acc[pi][qi][0], acc[pi][qi][1], acc[pi][qi][2], acc[pi][qi][3]};
          if (ropet) {
            bool lat = tok >= NCTX;
            int tl = (tok - NCTX) & 4095;
            int pos = part ? (tl & 63) : (tl >> 6);
            bool hi = (g & 2) != 0;
            int i0 = (g & 1) * 4;
#pragma unroll
            for (int r = 0; r < 4; r++) {
              float yp = __shfl_xor(y[r], 32);
              float c = rope[2048 + pos * 8 + i0 + r], s = rope[2560 + pos * 8 + i0 + r];
              float yr = hi ? (yp * s + y[r] * c) : (y[r] * c - yp * s);
              y[r] = lat ? yr : y[r];
            }
          }
          u32x2 o;
          o.x = pack2(y[0] * qs, y[1] * qs);
          o.y = pack2(y[2] * qs, y[3] * qs);
          *(u32x2*)(CQ + (long)tok * 384 + nb + g * 4) = o;
        }
      }
    } else {
      int t2 = t - 288;
      int tn = t2 % 6, tm = t2 / 6;
      const bfr* Q;
      long ldq;
      long kbase, vbase;
      int nk, key0;
      if (tm < 32) {
        Q = Z + (long)tm * 128 * ZLD + C_KV;
        ldq = ZLD;
        int s = tm >> 1;
        key0 = (tm & 1) * 128;
        nk = 256;
        kbase = (long)s * (4 * 256 * 64);
        vbase = (long)s * 131072;
      } else {
        int r = (tm - 32) * 128;
        int b = r / 4608, within = r % 4608;
        key0 = within;
        nk = 4608;
        kbase = 16l * (4 * 256 * 64) + (long)b * (4 * 4608 * 64);
        vbase = 16l * 131072 + (long)b * (4 * 128 * 4608);
        if (within < 512) {
          Q = (const bfr*)(p.ws + WS_CKVC) + (long)(b * 512 + within) * 256;
          ldq = 256;
        } else {
          Q = Z + (long)(NCTX + b * 4096 + within - 512) * ZLD + C_KV;
          ldq = ZLD;
        }
      }
      gemm128((const bfr*)(p.ws + WS_WUKV) + (long)tn * 128 * 256, 256, 128, Q, ldq, 128, 256, acc, sm);
      bfr* KN = (bfr*)(p.ws + WS_KNOPE);
      bfr* VTC = (bfr*)(p.ws + WS_VTC);
#pragma unroll
      for (int pi = 0; pi < 4; pi++) {
        int n0 = tn * 128 + wr * 64 + pi * 16 + g * 4;
        int head = n0 / 192, w = n0 % 192;
#pragma unroll
        for (int qi = 0; qi < 4; qi++) {
          int key = key0 + wc * 64 + qi * 16 + (lane & 15);
          if (w < 64) {
            u32x2 o;
            o.x = pack2(acc[pi][qi][0], acc[pi][qi][1]);
            o.y = pack2(acc[pi][qi][2], acc[pi][qi][3]);
            *(u32x2*)(KN + kbase + ((long)head * nk + key) * 64 + w) = o;
          } else {
#pragma unroll
            for (int r = 0; r < 4; r++)
              VTC[vbase + ((long)head * 128 + (w - 64) + r) * nk + key] = f2bf(acc[pi][qi][r]);
          }
        }
      }
    }
  }
}

template <int DQ, int DV, bool MLA>
__device__ __forceinline__ void attn_item(const Params& p, int seq, int head, int qblk, bfr* sm, int dry) {
  constexpr int KLD = DQ + 8;
  constexpr int KSZ = 64 * KLD;
  constexpr int VSZ = DV * LDT;
  constexpr int BUF = KSZ + VSZ;
  constexpr int NKK = DQ / 32;
  constexpr int NDV = DV / 16;
  constexpr int NVL = DV / 32;
  const int tid = TIDX, lane = tid & 63, wid = tid >> 6, g = lane >> 4, l15 = lane & 15;
  bfr* Z = (bfr*)(p.ws + WS_Z);
  const bool lat = seq >= 16;
  const int b = seq - 16;
  const int nk = lat ? 4608 : 256;
  const int rowbase = lat ? NCTX + b * 4096 : seq * 256;
  const int nkt = nk >> 6;

  bf16x8 qf[2][NKK];
#pragma unroll
  for (int qb = 0; qb < 2; qb++) {
    int qrow = rowbase + qblk * 128 + wid * 32 + qb * 16 + l15;
    const bfr* qp = MLA ? ((const bfr*)(p.ws + WS_CQ) + (long)qrow * 384 + head * 96) : (Z + (long)qrow * ZLD + C_QA + head * 64);
#pragma unroll
    for (int kk = 0; kk < NKK; kk++) qf[qb][kk] = *(const bf16x8*)(qp + kk * 32 + g * 8);
  }

  u32x4 rk[2], rkr, rv[NVL];
  auto prefetch = [&](int kt) {
    int k0 = kt * 64;
    bool cache = lat && (k0 < 512);
    int tokrow0 = lat ? (NCTX + b * 4096 + k0 - 512) : (seq * 256 + k0);
    if (!MLA) {
      int kvh = head >> 2;
#pragma unroll
      for (int i = 0; i < 2; i++) {
        int c = tid + 256 * i;
        int kr_ = c >> 3, ch = c & 7;
        const bfr* src = cache ? ((const bfr*)(p.ws + WS_KCA) + (long)(b * 512 + k0 + kr_) * 128 + kvh * 64 + ch * 8)
                               : (Z + (long)(tokrow0 + kr_) * ZLD + C_KA + kvh * 64 + ch * 8);
        rk[i] = *(const u32x4*)src;
      }
      long vb = lat ? (16l * 32768 + (long)b * (2 * 64 * 4608)) : ((long)seq * 32768);
#pragma unroll
      for (int i = 0; i < NVL; i++) {
        int c = tid + 256 * i;
        int dv = c >> 3, ch = c & 7;
        rv[i] = *(const u32x4*)((const bfr*)(p.ws + WS_VTA) + vb + (long)(kvh * 64 + dv) * nk + k0 + ch * 8);
      }
    } else {
      long kb = lat ? (16l * (4 * 256 * 64) + (long)b * (4 * 4608 * 64)) : ((long)seq * (4 * 256 * 64));
#pragma unroll
      for (int i = 0; i < 2; i++) {
        int c = tid + 256 * i;
        int kr_ = c >> 3, ch = c & 7;
        rk[i] = *(const u32x4*)((const bfr*)(p.ws + WS_KNOPE) + kb + ((long)head * nk + k0 + kr_) * 64 + ch * 8);
      }
      {
        int kr_ = tid >> 2, ch = tid & 3;
        const bfr* src = cache ? ((const bfr*)(p.ws + WS_KRC) + (long)(b * 512 + k0 + kr_) * 32 + ch * 8)
                               : (Z + (long)(tokrow0 + kr_) * ZLD + C_KR + ch * 8);
        rkr = *(const u32x4*)src;
      }
      long vb = lat ? (16l * 131072 + (long)b * (4 * 128 * 4608)) : ((long)seq * 131072);
#pragma unroll
      for (int i = 0; i < NVL; i++) {
        int c = tid + 256 * i;
        int dv = c >> 3, ch = c & 7;
        rv[i] = *(const u32x4*)((const bfr*)(p.ws + WS_VTC) + vb + (long)(head * 128 + dv) * nk + k0 + ch * 8);
      }
    }
  };

  f32x4 o[2][NDV];
#pragma unroll
  for (int qb = 0; qb < 2; qb++)
#pragma unroll
    for (int d = 0; d < NDV; d++) o[qb][d] = (f32x4){0.f, 0.f, 0.f, 0.f};
  float mrun[2] = {-1e30f, -1e30f}, lsum[2] = {0.f, 0.f};

  prefetch(0);
  for (int kt = 0; kt < nkt; kt++) {
    bfr* Ks = sm + (kt & 1) * BUF;
    bfr* Vs = Ks + KSZ;
#pragma unroll
    for (int i = 0; i < 2; i++) {
      int c = tid + 256 * i;
      *(u32x4*)(Ks + (c >> 3) * KLD + (c & 7) * 8) = rk[i];
    }
    if (MLA) *(u32x4*)(Ks + (tid >> 2) * KLD + 64 + (tid & 3) * 8) = rkr;
#pragma unroll
    for (int i = 0; i < NVL; i++) {
      int c = tid + 256 * i;
      *(u32x4*)(Vs + (c >> 3) * LDT + (c & 7) * 8) = rv[i];
    }
    __syncthreads();
    if (kt + 1 < nkt) prefetch(kt + 1);

    f32x4 s[2][4];
#pragma unroll
    for (int t = 0; t < 4; t++) {
      s[0][t] = (f32x4){0.f, 0.f, 0.f, 0.f};
      s[1][t] = (f32x4){0.f, 0.f, 0.f, 0.f};
      int krow = 32 * (t >> 1) + 8 * (l15 >> 2) + 4 * (t & 1) + (l15 & 3);
#pragma unroll
      for (int kk = 0; kk < NKK; kk++) {
        bf16x8 kf = *(const bf16x8*)(Ks + krow * KLD + kk * 32 + g * 8);
        s[0][t] = mfma16(kf, qf[0][kk], s[0][t]);
        s[1][t] = mfma16(kf, qf[1][kk], s[1][t]);
      }
    }
    bf16x8 pf[2][2];
#pragma unroll
    for (int qb = 0; qb < 2; qb++) {
      float mt = s[qb][0][0];
#pragma unroll
      for (int t = 0; t < 4; t++)
#pragma unroll
        for (int r = 0; r < 4; r++) mt = fmaxf(mt, s[qb][t][r]);
      mt = fmaxf(mt, __shfl_xor(mt, 16));
      mt = fmaxf(mt, __shfl_xor(mt, 32));
      float mnew = fmaxf(mrun[qb], mt);
      float alpha = __builtin_amdgcn_exp2f(mrun[qb] - mnew);
      mrun[qb] = mnew;
      float ps = 0.f;
#pragma unroll
      for (int t = 0; t < 4; t++)
#pragma unroll
        for (int r = 0; r < 4; r++) {
          float pv = __builtin_amdgcn_exp2f(s[qb][t][r] - mnew);
          ps += pv;
          s[qb][t][r] = pv;
        }
      lsum[qb] = lsum[qb] * alpha + ps;
#pragma unroll
      for (int d = 0; d < NDV; d++) {
        o[qb][d][0] *= alpha; o[qb][d][1] *= alpha; o[qb][d][2] *= alpha; o[qb][d][3] *= alpha;
      }
#pragma unroll
      for (int sx = 0; sx < 2; sx++) {
        u32x4 u;
        u.x = pack2(s[qb][2 * sx][0], s[qb][2 * sx][1]);
        u.y = pack2(s[qb][2 * sx][2], s[qb][2 * sx][3]);
        u.z = pack2(s[qb][2 * sx + 1][0], s[qb][2 * sx + 1][1]);
        u.w = pack2(s[qb][2 * sx + 1][2], s[qb][2 * sx + 1][3]);
        pf[qb][sx] = *(bf16x8*)&u;
      }
    }
#pragma unroll
    for (int d = 0; d < NDV; d++) {
#pragma unroll
      for (int sx = 0; sx < 2; sx++) {
        bf16x8 vf = *(const bf16x8*)(Vs + (d * 16 + l15) * LDT + sx * 32 + g * 8);
        o[0][d] = mfma16(vf, pf[0][sx], o[0][d]);
        o[1][d] = mfma16(vf, pf[1][sx], o[1][d]);
      }
    }
  }
  __syncthreads();
#pragma unroll
  for (int qb = 0; qb < 2; qb++) {
    float lt = lsum[qb];
    lt += __shfl_xor(lt, 16);
    lt += __shfl_xor(lt, 32);
    float inv = 1.f / lt;
    int qrow = rowbase + qblk * 128 + wid * 32 + qb * 16 + l15;
    bfr* gp = Z + (long)qrow * ZLD + (MLA ? C_GC : C_GA) + head * DV + g * 4;
#pragma unroll
    for (int d = 0; d < NDV; d++) {
      u32x2 gr = *(const u32x2*)(gp + d * 16);
      float y0 = o[qb][d][0] * inv * siluf(lo16(gr.x));
      float y1 = o[qb][d][1] * inv * siluf(hi16(gr.x));
      float y2 = o[qb][d][2] * inv * siluf(lo16(gr.y));
      float y3 = o[qb][d][3] * inv * siluf(hi16(gr.y));
      u32x2 ov;
      ov.x = pack2(y0, y1);
      ov.y = pack2(y2, y3);
      if (!dry) *(u32x2*)(gp + d * 16) = ov;
    }
  }
}

__device__ __forceinline__ void gla_item(const Params& p, int l, int seq, int h, int dir, int vsl, bfr* sm) {
  const int tid = TIDX, lane = tid & 63, wid = tid >> 6, g = lane >> 4, l15 = lane & 15;
  bfr* Z = (bfr*)(p.ws + WS_Z);
  bfr* OG = (bfr*)(p.ws + WS_R1) + (long)dir * NROWS * 512;
  const bool lat = seq >= 16;
  const int b = seq - 16;
  const int N = lat ? 4096 : 256;
  const int rowbase = lat ? NCTX + b * 4096 : seq * 256;
  const int nc = N >> 6;
  const int vs0 = vsl * 32;
  bfr* Qr = sm;
  bfr* Kr = Qr + 64 * LDT;
  bfr* Qe = Kr + 64 * LDT;
  bfr* Ke = Qe + 64 * LDT;
  bfr* KlT = Ke + 64 * LDT;
  bfr* Vt = KlT + 64 * LDT;
  bfr* St = Vt + 32 * LDT;
  float* RF = (float*)(St + 32 * LDT);
  float* tot = RF + 64 * 16;
  float* lastv = tot + 256;
  bfr* Att = Qr;

  const int ch = tid & 63, part = tid >> 6;
  float wd[16];
  {
    const float* W = (dir ? p.in[19] : p.in[17]) + (long)l * 16 * 256 + h * 64 + ch;
#pragma unroll
    for (int r = 0; r < 16; r++) wd[r] = W[r * 256];
  }
  const float bias = (dir ? p.in[20] : p.in[18])[l * 256 + h * 64 + ch];

  f32x4 st[2];
  if (lat) {
    const float* S0 = (dir ? p.in[7] : p.in[6]) + ((long)((b * 2 + l) * 4 + h)) * 8192 + (long)(16 * wid + l15) * 128 + vs0;
    float4 a = *(const float4*)(S0 + 4 * g);
    float4 c = *(const float4*)(S0 + 16 + 4 * g);
    st[0] = (f32x4){a.x, a.y, a.z, a.w};
    st[1] = (f32x4){c.x, c.y, c.z, c.w};
  } else {
    st[0] = (f32x4){0.f, 0.f, 0.f, 0.f};
    st[1] = (f32x4){0.f, 0.f, 0.f, 0.f};
  }
#pragma unroll
  for (int mv = 0; mv < 2; mv++)
#pragma unroll
    for (int r = 0; r < 4; r++) St[(16 * mv + 4 * g + r) * LDT + 16 * wid + l15] = f2bf(st[mv][r]);

  u32x4 rq[2], rk[2], rv, rr;
  auto prefetch = [&](int c) {
#pragma unroll
    for (int ii = 0; ii < 2; ii++) {
      int cc = tid + 256 * ii;
      int i = cc >> 3, c8 = cc & 7;
      int tok = dir ? (N - 1 - (c * 64 + i)) : (c * 64 + i);
      const bfr* zr = Z + (long)(rowbase + tok) * ZLD;
      rq[ii] = *(const u32x4*)(zr + C_QG + h * 64 + c8 * 8);
      rk[ii] = *(const u32x4*)(zr + C_KG + h * 64 + c8 * 8);
    }
    {
      int i = tid >> 2, c4 = tid & 3;
      int tok = dir ? (N - 1 - (c * 64 + i)) : (c * 64 + i);
      rv = *(const u32x4*)(Z + (long)(rowbase + tok) * ZLD + C_VG + h * 128 + vs0 + c4 * 8);
    }
    if (tid < 128) {
      int i = tid >> 1, hf = tid & 1;
      int tok = dir ? (N - 1 - (c * 64 + i)) : (c * 64 + i);
      rr = *(const u32x4*)(Z + (long)(rowbase + tok) * ZLD + (dir ? C_RB : C_RF) + hf * 8);
    }
  };

  prefetch(0);
  for (int c = 0; c < nc; c++) {
#pragma unroll
    for (int ii = 0; ii < 2; ii++) {
      int cc = tid + 256 * ii;
      *(u32x4*)(Qr + (cc >> 3) * LDT + (cc & 7) * 8) = rq[ii];
      *(u32x4*)(Kr + (cc >> 3) * LDT + (cc & 7) * 8) = rk[ii];
    }
    {
      int i = tid >> 2, c4 = tid & 3;
      const bfr* rb = (const bfr*)&rv;
#pragma unroll
      for (int e = 0; e < 8; e++) Vt[(c4 * 8 + e) * LDT + i] = rb[e];
    }
    if (tid < 128) {
      int i = tid >> 1, hf = tid & 1;
      float x[8];
      unpack8(rr, x);
#pragma unroll
      for (int e = 0; e < 8; e++) RF[i * 16 + hf * 8 + e] = x[e];
    }
    __syncthreads();
    if (c + 1 < nc) prefetch(c + 1);
    float cum[16];
    {
      float run = 0.f;
#pragma unroll
      for (int ii = 0; ii < 16; ii++) {
        int i = part * 16 + ii;
        float x = bias;
#pragma unroll
        for (int r = 0; r < 16; r++) x += RF[i * 16 + r] * wd[r];
        float la = (fminf(x, 0.f) - log1pf(__expf(-fabsf(x)))) * (1.f / 16.f);
        run += la;
        cum[ii] = run;
      }
      tot[part * 64 + ch] = run;
    }
    __syncthreads();
    {
      float off = 0.f, last = 0.f;
#pragma unroll
      for (int pp = 0; pp < 4; pp++) {
        float tv = tot[pp * 64 + ch];
        if (pp < part) off += tv;
        last += tv;
      }
      if (part == 0) lastv[ch] = last;
#pragma unroll
      for (int ii = 0; ii < 16; ii++) {
        int i = part * 16 + ii;
        float cc = cum[ii] + off;
        float qv = bf2f(Qr[i * LDT + ch]), kv = bf2f(Kr[i * LDT + ch]);
        Qe[i * LDT + ch] = f2bf(qv * __expf(cc) * 0.125f);
        Ke[i * LDT + ch] = f2bf(kv * __expf(-cc));
        KlT[ch * LDT + i] = f2bf(kv * __expf(last - cc));
      }
    }
    __syncthreads();
    f32x4 stn[2];
    {
      f32x4 att[4];
      bf16x8 qa[2];
#pragma unroll
      for (int kk = 0; kk < 2; kk++) qa[kk] = *(const bf16x8*)(Qe + (16 * wid + l15) * LDT + kk * 32 + g * 8);
#pragma unroll
      for (int nj = 0; nj < 4; nj++) {
        att[nj] = (f32x4){0.f, 0.f, 0.f, 0.f};
#pragma unroll
        for (int kk = 0; kk < 2; kk++) {
          bf16x8 kb = *(const bf16x8*)(Ke + (16 * nj + l15) * LDT + kk * 32 + g * 8);
          att[nj] = mfma16(qa[kk], kb, att[nj]);
        }
      }
      float el = __expf(lastv[16 * wid + l15]);
#pragma unroll
      for (int mv = 0; mv < 2; mv++) {
        stn[mv] = st[mv] * el;
#pragma unroll
        for (int kk = 0; kk < 2; kk++) {
          bf16x8 va = *(const bf16x8*)(Vt + (16 * mv + l15) * LDT + kk * 32 + g * 8);
          bf16x8 kb = *(const bf16x8*)(KlT + (16 * wid + l15) * LDT + kk * 32 + g * 8);
          stn[mv] = mfma16(va, kb, stn[mv]);
        }
      }
#pragma unroll
      for (int nj = 0; nj < 4; nj++)
#pragma unroll
        for (int r = 0; r < 4; r++) {
          int i = 16 * wid + 4 * g + r, j = 16 * nj + l15;
          Att[i * LDT + j] = f2bf(i >= j ? att[nj][r] : 0.f);
        }
    }
    __syncthreads();
    {
      bf16x8 aa[2], qa[2];
#pragma unroll
      for (int kk = 0; kk < 2; kk++) {
        aa[kk] = *(const bf16x8*)(Att + (16 * wid + l15) * LDT + kk * 32 + g * 8);
        qa[kk] = *(const bf16x8*)(Qe + (16 * wid + l15) * LDT + kk * 32 + g * 8);
      }
#pragma unroll
      for (int nv = 0; nv < 2; nv++) {
        f32x4 oc = (f32x4){0.f, 0.f, 0.f, 0.f};
#pragma unroll
        for (int kk = 0; kk < 2; kk++) {
          bf16x8 vb = *(const bf16x8*)(Vt + (16 * nv + l15) * LDT + kk * 32 + g * 8);
          oc = mfma16(aa[kk], vb, oc);
          bf16x8 sb = *(const bf16x8*)(St + (16 * nv + l15) * LDT + kk * 32 + g * 8);
          oc = mfma16(qa[kk], sb, oc);
        }
#pragma unroll
        for (int r = 0; r < 4; r++) {
          int i = 16 * wid + 4 * g + r;
          int tok = dir ? (N - 1 - (c * 64 + i)) : (c * 64 + i);
          OG[(long)(rowbase + tok) * 512 + h * 128 + vs0 + 16 * nv + l15] = f2bf(oc[r]);
        }
      }
    }
    __syncthreads();
#pragma unroll
    for (int mv = 0; mv < 2; mv++) {
      st[mv] = stn[mv];
#pragma unroll
      for (int r = 0; r < 4; r++) St[(16 * mv + 4 * g + r) * LDT + 16 * wid + l15] = f2bf(st[mv][r]);
    }
  }
  __syncthreads();
  if (!lat) {
    float* so = p.out + (dir ? O_SB : O_SF) + ((long)((seq * 2 + l) * 4 + h)) * 8192 + (long)(16 * wid + l15) * 128 + vs0;
    *(float4*)(so + 4 * g) = make_float4(st[0][0], st[0][1], st[0][2], st[0][3]);
    *(float4*)(so + 16 + 4 * g) = make_float4(st[1][0], st[1][1], st[1][2], st[1][3]);
  }
}

__device__ __forceinline__ void phase_mixers(const Params& p, int l, bfr* sm, int* s_item, int dry) {
  unsigned* ctr = (unsigned*)(p.ws + WS_CTR) + l + 2 * dry;
  for (;;) {
    if (TIDX == 0) *s_item = (int)atomicAdd(ctr, 1u);
    __syncthreads();
    int idx = *s_item;
    __syncthreads();
    if (idx >= 1728) break;
    int kind, a0, a1, a2, a3 = 0;
    if (idx < 64) {
      kind = 0; a0 = 16 + (idx >> 5); a1 = (idx >> 3) & 3; a2 = (idx >> 2) & 1; a3 = idx & 3;
    } else if (idx < 320) {
      int i = idx - 64;
      kind = 1; a0 = 16 + (i >> 7); a1 = (i >> 5) & 3; a2 = i & 31;
    } else if (idx < 832) {
      int i = idx - 320;
      kind = 2; a0 = 16 + (i >> 8); a1 = (i >> 5) & 7; a2 = i & 31;
    } else if (idx < 1344) {
      int i = idx - 832;
      kind = 0; a0 = i >> 5; a1 = (i >> 3) & 3; a2 = (i >> 2) & 1; a3 = i & 3;
    } else if (idx < 1472) {
      int i = idx - 1344;
      kind = 1; a0 = i >> 3; a1 = (i >> 1) & 3; a2 = i & 1;
    } else {
      int i = idx - 1472;
      kind = 2; a0 = i >> 4; a1 = (i >> 1) & 7; a2 = i & 1;
    }
    if (kind == 0) gla_item(p, l, a0, a1, a2, a3, sm);
    else if (kind == 1) attn_item<96, 128, true>(p, a0, a1, a2, sm, dry);
    else attn_item<64, 64, false>(p, a0, a1, a2, sm, dry);
  }
}

__device__ __forceinline__ void phase_gla_out(const Params& p, int l) {
  const int lane = TIDX & 63;
  bfr* Z = (bfr*)(p.ws + WS_Z);
  const bfr* OF = (const bfr*)(p.ws + WS_R1);
  const bfr* OB = OF + (long)NROWS * 512;
  for (int row = blockIdx.x * 4 + (TIDX >> 6); row < NROWS; row += gridDim.x * 4) {
    float a[8], c[8], gt[8];
    unpack8(*(const u32x4*)(OF + (long)row * 512 + lane * 8), a);
    unpack8(*(const u32x4*)(OB + (long)row * 512 + lane * 8), c);
    bfr* gp = Z + (long)row * ZLD + C_GG + lane * 8;
    unpack8(*(const u32x4*)gp, gt);
    float ss = 0.f;
#pragma unroll
    for (int e = 0; e < 8; e++) {
      a[e] = bf2f(f2bf(a[e] + c[e]));
      ss += a[e] * a[e];
    }
    ss += __shfl_xor(ss, 1); ss += __shfl_xor(ss, 2); ss += __shfl_xor(ss, 4); ss += __shfl_xor(ss, 8);
    float rs = rsqrtf(ss * (1.f / 128.f) + 1e-6f);
    const float* gg = p.in[21] + l * 128 + (lane & 15) * 8;
#pragma unroll
    for (int e = 0; e < 8; e++) a[e] = a[e] * rs * gg[e] * siluf(gt[e]);
    *(u32x4*)gp = pack8(a);
  }
}

__device__ __forceinline__ void phase_merge(const Params& p, bfr* sm) {
  bfr* Z = (bfr*)(p.ws + WS_Z);
  bfr* MG = (bfr*)(p.ws + WS_R1);
  const int lane = TIDX & 63, wid = TIDX >> 6, wr = wid >> 1, wc = wid & 1, g = lane >> 4;
  for (int t = blockIdx.x; t < 96 * 8; t += gridDim.x) {
    int tn = t & 7, tm = t >> 3;
    f32x4 totl[4][4];
#pragma unroll
    for (int a = 0; a < 4; a++)
#pragma unroll
      for (int b = 0; b < 4; b++) totl[a][b] = (f32x4){0.f, 0.f, 0.f, 0.f};
#pragma unroll 1
    for (int seg = 0; seg < 3; seg++) {
      f32x4 acc[4][4];
#pragma unroll
      for (int a = 0; a < 4; a++)
#pragma unroll
        for (int b = 0; b < 4; b++) acc[a][b] = (f32x4){0.f, 0.f, 0.f, 0.f};
      int ycol = seg == 0 ? C_GA : (seg == 1 ? C_GG : C_GC);
      int mcol = C_M1 + seg * 1024;
      const bfr* W = (const bfr*)(p.ws + WS_WOA + (unsigned long)seg * 1048576ul) + (long)tn * 128 * 512;
      gemm128(W, 512, 128, Z + (long)tm * 128 * ZLD + ycol, ZLD, 128, 512, acc, sm);
#pragma unroll
      for (int pi = 0; pi < 4; pi++) {
        int n0 = tn * 128 + wr * 64 + pi * 16 + g * 4;
#pragma unroll
        for (int qi = 0; qi < 4; qi++) {
          int tok = tm * 128 + wc * 64 + qi * 16 + (lane & 15);
          u32x2 mr = *(const u32x2*)(Z + (long)tok * ZLD + mcol + n0);
          totl[pi][qi][0] += sigmf(lo16(mr.x)) * acc[pi][qi][0];
          totl[pi][qi][1] += sigmf(hi16(mr.x)) * acc[pi][qi][1];
          totl[pi][qi][2] += sigmf(lo16(mr.y)) * acc[pi][qi][2];
          totl[pi][qi][3] += sigmf(hi16(mr.y)) * acc[pi][qi][3];
        }
      }
    }
#pragma unroll
    for (int pi = 0; pi < 4; pi++) {
      int n0 = tn * 128 + wr * 64 + pi * 16 + g * 4;
#pragma unroll
      for (int qi = 0; qi < 4; qi++) {
        int tok = tm * 128 + wc * 64 + qi * 16 + (lane & 15);
        u32x2 o;
        o.x = pack2(totl[pi][qi][0], totl[pi][qi][1]);
        o.y = pack2(totl[pi][qi][2], totl[pi][qi][3]);
        *(u32x2*)(MG + (long)tok * 1024 + n0) = o;
      }
    }
  }
}

__device__ __forceinline__ void phase_outproj(const Params& p, bfr* sm) {
  const bfr* MG = (const bfr*)(p.ws + WS_R1);
  float* OUT = (float*)(p.ws + WS_Z);
  const int lane = TIDX & 63, wid = TIDX >> 6, wr = wid >> 1, wc = wid & 1, g = lane >> 4;
  for (int t = blockIdx.x; t < 96 * 8; t += gridDim.x) {
    int tn = t & 7, tm = t >> 3;
    f32x4 acc[4][4];
#pragma unroll
    for (int a = 0; a < 4; a++)
#pragma unroll
      for (int b = 0; b < 4; b++) acc[a][b] = (f32x4){0.f, 0.f, 0.f, 0.f};
    gemm128((const bfr*)(p.ws + WS_WOUT) + (long)tn * 128 * 1024, 1024, 128, MG + (long)tm * 128 * 1024, 1024, 128, 1024, acc,
            sm);
#pragma unroll
    for (int pi = 0; pi < 4; pi++) {
      int n0 = tn * 128 + wr * 64 + pi * 16 + g * 4;
#pragma unroll
      for (int qi = 0; qi < 4; qi++) {
        int tok = tm * 128 + wc * 64 + qi * 16 + (lane & 15);
        *(float4*)(OUT + (long)tok * 1024 + n0) = make_float4(acc[pi][qi][0], acc[pi][qi][1], acc[pi][qi][2], acc[pi][qi][3]);
      }
    }
  }
}

__device__ __forceinline__ void phase_post(const Params& p, int l) {
  const int lane = TIDX & 63;
  const float* mod = (const float*)(p.ws + WS_MOD);
  const float* OUT = (const float*)(p.ws + WS_Z);
  bfr* H = (bfr*)(p.ws + WS_R1);
  for (int row = blockIdx.x * 4 + (TIDX >> 6); row < NROWS; row += gridDim.x * 4) {
    const float* x = (l == 0) ? xrow(p, row) : (p.out + (long)row * 1024);
    const float* md = mod + (l * 3 + row_cond(row)) * 3072;
    float4 v[4];
    float ss = 0.f;
#pragma unroll
    for (int i = 0; i < 4; i++) {
      v[i] = *(const float4*)(OUT + (long)row * 1024 + i * 256 + lane * 4);
      ss += v[i].x * v[i].x + v[i].y * v[i].y + v[i].z * v[i].z + v[i].w * v[i].w;
    }
    ss = wave_sum(ss);
    float rs = rsqrtf(ss * (1.f / 1024.f) + 1e-6f);
    float ss2 = 0.f;
#pragma unroll
    for (int i = 0; i < 4; i++) {
      int n = i * 256 + lane * 4;
      float4 g = *(const float4*)(p.in[13] + l * 1024 + n);
      float4 gt = *(const float4*)(md + 2048 + n);
      float4 xv = *(const float4*)(x + n);
      v[i].x = xv.x + gt.x * (v[i].x * rs * g.x);
      v[i].y = xv.y + gt.y * (v[i].y * rs * g.y);
      v[i].z = xv.z + gt.z * (v[i].z * rs * g.z);
      v[i].w = xv.w + gt.w * (v[i].w * rs * g.w);
      *(float4*)(p.out + (long)row * 1024 + n) = v[i];
      ss2 += v[i].x * v[i].x + v[i].y * v[i].y + v[i].z * v[i].z + v[i].w * v[i].w;
    }
    if (l == 0) {
      ss2 = wave_sum(ss2);
      float rs2 = rsqrtf(ss2 * (1.f / 1024.f) + 1e-6f);
      const float* md1 = mod + (1 * 3 + row_cond(row)) * 3072;
#pragma unroll
      for (int i = 0; i < 4; i++) {
        int n = i * 256 + lane * 4;
        float4 g = *(const float4*)(p.in[12] + 1024 + n);
        float4 sh = *(const float4*)(md1 + n);
        float4 sc = *(const float4*)(md1 + 1024 + n);
        float h0 = v[i].x * rs2 * g.x * (1.f + sc.x) + sh.x;
        float h1 = v[i].y * rs2 * g.y * (1.f + sc.y) + sh.y;
        float h2 = v[i].z * rs2 * g.z * (1.f + sc.z) + sh.z;
        float h3 = v[i].w * rs2 * g.w * (1.f + sc.w) + sh.w;
        u32x2 o;
        o.x = pack2(h0, h1);
        o.y = pack2(h2, h3);
        *(u32x2*)(H + (long)row * 1024 + n) = o;
      }
    }
  }
}

__global__ void __launch_bounds__(256, 2) fwd_megakernel(Params p) {
  __shared__ __attribute__((aligned(16))) bfr sm[SMEM_SHORTS];
  __shared__ int s_item;
  cg::grid_group grid = cg::this_grid();
  __shared__ uint4 xb_words;
  if (threadIdx.x == 0) xb_words = make_uint4(0u, 0u, 0u, 0u);
  __syncthreads();
  XcdBarrier xb = xcd_barrier_post((unsigned*)(p.ws + WS_BAR), (volatile LAS unsigned*)&xb_words);
  if (p.ws == nullptr) grid.sync();
#ifdef PROBE_SYNC
#define GSYNC do { xcd_barrier(xb); xcd_barrier(xb); } while (0)
#else
#define GSYNC xcd_barrier(xb)
#endif
#ifdef PROBE_PRE
  phase_s0(launder(p), sm);
  GSYNC;
  phase_s1(launder(p));
  wconv_phase(p, 0, sm);
  GSYNC;
  phase_prenorm0(launder(p));
  GSYNC;
#endif

#ifndef PH
#define PH 0xffff
#endif
#if PH & 1
  phase_s0(launder(p), sm);
#endif
  GSYNC;
#if PH & 2
  phase_s1(launder(p));
  wconv_phase(p, 0, sm);
#endif
  GSYNC;
#if PH & 4
  phase_prenorm0(launder(p));
#endif
  GSYNC;
  for (int l = 0; l < 2; l++) {
#if PH & 8
#ifdef PROBE_INPROJ
    phase_inproj(launder(p), sm);
    GSYNC;
#endif
    phase_inproj(launder(p), sm);
#endif
    GSYNC;
#if PH & 16
    phase_rowpost(launder(p), l);
#endif
    GSYNC;
#if PH & 32
#ifdef PROBE_MLAUP
    phase_mla_up(launder(p), sm);
    GSYNC;
#endif
    phase_mla_up(launder(p), sm);
#endif
    GSYNC;
#if PH & 64
#ifdef PROBE_MIX
    { int dry = 1; asm volatile("" : "+s"(dry)); phase_mixers(launder(p), l, sm, &s_item, dry); }
    GSYNC;
#endif
    { int dry = 0; asm volatile("" : "+s"(dry)); phase_mixers(launder(p), l, sm, &s_item, dry); }
#endif
    GSYNC;
#if PH & 128
    phase_gla_out(launder(p), l);
#endif
    GSYNC;
#if PH & 256
#ifdef PROBE_MERGE
    phase_merge(launder(p), sm);
    GSYNC;
#endif
    phase_merge(launder(p), sm);
#endif
    GSYNC;
#if PH & 512
#ifdef PROBE_MERGE
    phase_outproj(launder(p), sm);
    GSYNC;
#endif
    phase_outproj(launder(p), sm);
#endif
    GSYNC;
#if PH & 1024
    phase_post(launder(p), l);
    if (l == 0) wconv_phase(p, 1, sm);
#endif
    GSYNC;
  }
}

extern "C" void kernel_launch(void* const* d_in, const int* in_sizes, int n_in, void* d_out, int out_size, void* d_ws,
                              size_t ws_size, hipStream_t stream) {
  static int grid_blocks = 0;
  if (!grid_blocks) {
    int dev = 0, cus = 0, per_cu = 0;
    hipGetDevice(&dev);
    hipDeviceGetAttribute(&cus, hipDeviceAttributeMultiprocessorCount, dev);
    hipOccupancyMaxActiveBlocksPerMultiprocessor(&per_cu, fwd_megakernel, 256, 0);
    if (per_cu > 2) per_cu = 2;
    if (per_cu < 1) per_cu = 1;
    grid_blocks = cus * per_cu;
  }
  Params p{};
  for (int i = 0; i < 30; i++) p.in[i] = (const float*)d_in[i];
  p.out = (float*)d_out;
  p.ws = (unsigned char*)d_ws;
  hipMemsetAsync(d_ws, 0, 20480, stream);
  void* args[] = {&p};
  hipError_t e = hipLaunchCooperativeKernel((void*)fwd_megakernel, dim3(grid_blocks), dim3(256), args, 0, stream);
  if (e != hipSuccess) fprintf(stderr, "cooperative launch failed: %s (grid %d)\n", hipGetErrorString(e), grid_blocks);
}
```

```cpp
#include <hip/hip_runtime.h>
#include <hip/hip_cooperative_groups.h>
#include <cstdio>
namespace cg = cooperative_groups;

typedef unsigned short bfr;
typedef __attribute__((ext_vector_type(8))) short bf16x8;
typedef __attribute__((ext_vector_type(4))) float f32x4;
typedef __attribute__((ext_vector_type(4))) unsigned u32x4;
typedef __attribute__((ext_vector_type(2))) unsigned u32x2;

#define NROWS 12288
#define NCTX 4096
#define ZLD 6976
#define LDT 72
#define SMEM_SHORTS (4 * 128 * LDT)

#define C_QA 0
#define C_KA 512
#define C_VA 640
#define C_GA 768
#define C_QG 1280
#define C_KG 1536
#define C_VG 1792
#define C_GG 2304
#define C_RF 2816
#define C_RB 2832
#define C_QL 2848
#define C_KV 3104
#define C_KR 3360
#define C_GC 3392
#define C_M1 3904
#define C_M2 4928
#define C_M3 5952

#define WS_BAR 0ul
#define WS_CTR 16384ul
#define WS_MODP 20480ul
#define WS_MOD (WS_MODP + 589824ul)
#define WS_ROPE (WS_MOD + 73728ul)
#define WS_WIN (WS_ROPE + 16384ul)
#define WS_WUQ (WS_WIN + 14417920ul)
#define WS_WUKV (WS_WUQ + 196608ul)
#define WS_WOA (WS_WUKV + 393216ul)
#define WS_WOB (WS_WOA + 1048576ul)
#define WS_WOC (WS_WOB + 1048576ul)
#define WS_WOUT (WS_WOC + 1048576ul)
#define WS_KCA (WS_WOUT + 2097152ul)
#define WS_CKVC (WS_KCA + 262144ul)
#define WS_KRC (WS_CKVC + 524288ul)
#define WS_VTA (WS_KRC + 65536ul)
#define WS_CQ (WS_VTA + 3407872ul)
#define WS_KNOPE (WS_CQ + 9437184ul)
#define WS_VTC (WS_KNOPE + 6815744ul)
#define WS_R1 (WS_VTC + 13631488ul)
#define WS_Z (WS_R1 + 25165824ul)
#define WS_END (WS_Z + 171442176ul)

#define O_Y 0
#define O_GK 12582912
#define O_GV 13631488
#define O_CKV 14680064
#define O_KR 16777216
#define O_SF 17039360
#define O_SB 18087936

struct Params {
  const float* in[30];
  float* out;
  unsigned char* ws;
};

__device__ __forceinline__ int tidx() {
  int t = threadIdx.x;
  asm volatile("" : "+v"(t));
  return t;
}
__device__ __forceinline__ Params launder(const Params& p) {
  Params q;
  long zo = 0;
  asm volatile("" : "+s"(zo));
#pragma unroll
  for (int i = 0; i < 30; i++) q.in[i] = p.in[i] + zo;
  q.out = p.out + zo;
  q.ws = p.ws + zo;
  return q;
}
__device__ __forceinline__ float bf2f(bfr b) { return __uint_as_float(((unsigned)b) << 16); }
__device__ __forceinline__ bfr f2bf(float f) {
  unsigned u = __float_as_uint(f);
  u += 0x7fffu + ((u >> 16) & 1u);
  return (bfr)(u >> 16);
}
__device__ __forceinline__ unsigned pack2(float a, float b) { return (unsigned)f2bf(a) | ((unsigned)f2bf(b) << 16); }
__device__ __forceinline__ float lo16(unsigned u) { return __uint_as_float(u << 16); }
__device__ __forceinline__ float hi16(unsigned u) { return __uint_as_float(u & 0xffff0000u); }
__device__ __forceinline__ float siluf(float x) { return x / (1.f + __expf(-x)); }
__device__ __forceinline__ float sigmf(float x) { return 1.f / (1.f + __expf(-x)); }
__device__ __forceinline__ f32x4 mfma16(bf16x8 a, bf16x8 b, f32x4 c) {
  return __builtin_amdgcn_mfma_f32_16x16x32_bf16(a, b, c, 0, 0, 0);
}
__device__ __forceinline__ const float* xrow(const Params& p, int row) {
  return row < NCTX ? p.in[0] + (long)row * 1024 : p.in[1] + (long)(row - NCTX) * 1024;
}
__device__ __forceinline__ int row_cond(int row) { return row < NCTX ? 0 : 1 + ((row - NCTX) >> 12); }
__device__ __forceinline__ float wave_sum(float v) {
  v += __shfl_xor(v, 1); v += __shfl_xor(v, 2); v += __shfl_xor(v, 4);
  v += __shfl_xor(v, 8); v += __shfl_xor(v, 16); v += __shfl_xor(v, 32);
  return v;
}

#define XB_TMO      128
#define XB_XCNT(j)  (256  + 64 * (j))
#define XB_XSUB(j)  (1280 + 64 * (j))
#define XB_XGEN(j)  (2304 + 64 * (j))
#define XB_TOP      3328
#define XB_TOPGEN   3392
#define XCD_BAR_WORDS 3456
#define XB_SPIN_CAP (1u << 18)
#define LAS __attribute__((address_space(3)))

__device__ __forceinline__ unsigned xb_ld(unsigned* p)              { return __hip_atomic_load(p, __ATOMIC_RELAXED, __HIP_MEMORY_SCOPE_AGENT); }
__device__ __forceinline__ unsigned xb_add(unsigned* p, unsigned v) { return __hip_atomic_fetch_add(p, v, __ATOMIC_RELAXED, __HIP_MEMORY_SCOPE_AGENT); }
__device__ __forceinline__ unsigned xb_xcc_id() { return (unsigned)__builtin_amdgcn_s_getreg((3 << 11) | 20) & 0xFu; }
#define XB_SPIN(cond, bar) do { unsigned _sp = 0; while (cond) { __builtin_amdgcn_s_sleep(1); \
    if ((++_sp & 255u) == 0u) { if (xb_ld(&(bar)[XB_TMO])) break; if (_sp > XB_SPIN_CAP) { atomicAdd(&(bar)[XB_TMO], 1u); break; } } } } while (0)

struct XcdBarrier {
    unsigned* bar; unsigned x;
    volatile LAS unsigned* st;
};

__device__ __forceinline__ XcdBarrier xcd_barrier_post(unsigned* bar, volatile LAS unsigned* st) {
    XcdBarrier b; b.bar = bar; b.x = xb_xcc_id(); b.st = st;
    if (threadIdx.x == 0) (void)xb_add(&bar[XB_XCNT(b.x)], 1u);
    return b;
}
__device__ __forceinline__ void xcd_barrier_complete(unsigned* bar, unsigned x, unsigned& nloc, unsigned& nx) {
    const unsigned G = gridDim.x * gridDim.y * gridDim.z;
    unsigned sum, cnt, mine, sp = 0u;
    for (;;) {
        sum = 0u; cnt = 0u; mine = 0u;
#pragma unroll
        for (unsigned j = 0; j < 16; ++j) { const unsigned c = xb_ld(&bar[XB_XCNT(j)]); sum += c; cnt += (c > 0u) ? 1u : 0u; mine = (j == x) ? c : mine; }
        if (sum == G) break;
        __builtin_amdgcn_s_sleep(1);
        if ((++sp & 255u) == 0u) { if (xb_ld(&bar[XB_TMO])) break; if (sp > XB_SPIN_CAP) { atomicAdd(&bar[XB_TMO], 1u); break; } }
    }
    nloc = mine > 0u ? mine : 1u; nx = cnt > 0u ? cnt : 1u;
}

__device__ __forceinline__ void xcd_barrier(const XcdBarrier& b) {
    asm volatile("s_waitcnt vmcnt(0)" ::: "memory");
    __syncthreads();
    if (threadIdx.x == 0) {
        unsigned* bar = b.bar;
        __builtin_amdgcn_s_waitcnt(0);
        unsigned nloc = b.st[0], nx = b.st[1];
        if (nloc == 0u) { xcd_barrier_complete(bar, b.x, nloc, nx); b.st[0] = nloc; b.st[1] = nx; }
        const unsigned old = xb_add(&bar[XB_XSUB(b.x)], 1u);
        const unsigned gen = old / nloc;
        if (old + 1u == (gen + 1u) * nloc) {
            __builtin_amdgcn_fence(__ATOMIC_RELEASE, "agent");
            asm volatile("s_waitcnt vmcnt(0)" ::: "memory");
            const unsigned og = xb_add(&bar[XB_TOP], 1u);
            const unsigned tg = og / nx;
            if (og + 1u == (tg + 1u) * nx) xb_add(&bar[XB_TOPGEN], 1u);
            else XB_SPIN(xb_ld(&bar[XB_TOPGEN]) == tg, bar);
            __builtin_amdgcn_fence(__ATOMIC_ACQUIRE, "agent");
            xb_add(&bar[XB_XGEN(b.x)], 1u);
            asm volatile("s_waitcnt vmcnt(0)" ::: "memory");
        } else {
            XB_SPIN(xb_ld(&bar[XB_XGEN(b.x)]) == gen, bar);
            __builtin_amdgcn_fence(__ATOMIC_ACQUIRE, "agent");
            asm volatile("s_waitcnt vmcnt(0)" ::: "memory");
        }
    }
    __syncthreads();
}


#define TIDX tidx()
__device__ __forceinline__ void gemm128(const bfr* __restrict__ P, long ldp, int pmax,
                                        const bfr* __restrict__ Q, long ldq, int qmax, int K,
                                        f32x4 (&acc)[4][4], bfr* sm) {
  const int tid = TIDX, lane = tid & 63, wid = tid >> 6;
  const int wr = wid >> 1, wc = wid & 1;
  const int lr = tid >> 3, lc = (tid & 7) * 8;
  u32x4 rp[4], rq[4];
  const bfr* pp[4];
  const bfr* qp[4];
#pragma unroll
  for (int i = 0; i < 4; i++) {
    int r = lr + 32 * i;
    pp[i] = P + (long)min(r, pmax - 1) * ldp + lc;
    qp[i] = Q + (long)min(r, qmax - 1) * ldq + lc;
    rp[i] = *(const u32x4*)(pp[i]);
    rq[i] = *(const u32x4*)(qp[i]);
  }
  const int nk = K >> 6;
  for (int kt = 0; kt < nk; kt++) {
    bfr* Ps = sm + (kt & 1) * (2 * 128 * LDT);
    bfr* Qs = Ps + 128 * LDT;
#pragma unroll
    for (int i = 0; i < 4; i++) {
      *(u32x4*)(Ps + (lr + 32 * i) * LDT + lc) = rp[i];
      *(u32x4*)(Qs + (lr + 32 * i) * LDT + lc) = rq[i];
    }
    __syncthreads();
    if (kt + 1 < nk) {
#pragma unroll
      for (int i = 0; i < 4; i++) {
        rp[i] = *(const u32x4*)(pp[i] + (kt + 1) * 64);
        rq[i] = *(const u32x4*)(qp[i] + (kt + 1) * 64);
      }
    }
#pragma unroll
    for (int kk = 0; kk < 2; kk++) {
      bf16x8 pf[4], qf[4];
#pragma unroll
      for (int m = 0; m < 4; m++) {
        pf[m] = *(const bf16x8*)(Ps + (wr * 64 + m * 16 + (lane & 15)) * LDT + kk * 32 + (lane >> 4) * 8);
        qf[m] = *(const bf16x8*)(Qs + (wc * 64 + m * 16 + (lane & 15)) * LDT + kk * 32 + (lane >> 4) * 8);
      }
#pragma unroll
      for (int m = 0; m < 4; m++)
#pragma unroll
        for (int n = 0; n < 4; n++) acc[m][n] = mfma16(pf[m], qf[n], acc[m][n]);
    }
  }
  __syncthreads();
}

__device__ __forceinline__ void phase_s0(const Params& p, bfr* sm) {
  const int tid = TIDX;
  float* rope = (float*)(p.ws + WS_ROPE);
  for (int idx = blockIdx.x * 256 + tid; idx < 1536; idx += gridDim.x * 256) {
    if (idx < 1024) {
      int pos = idx >> 4, i = idx & 15;
      float fr = powf(10000.f, -(float)i / 16.f);
      float a = (float)pos * fr;
      rope[idx] = cosf(a);
      rope[1024 + idx] = sinf(a);
    } else {
      int j = idx - 1024;
      int pos = j >> 3, i = j & 7;
      float fr = powf(10000.f, -(float)i / 8.f);
      float a = (float)pos * fr;
      rope[2048 + j] = cosf(a);
      rope[2560 + j] = sinf(a);
    }
  }
  float* smf = (float*)sm;
  float* modp = (float*)(p.ws + WS_MODP);
  for (int it = blockIdx.x; it < 768; it += gridDim.x) {
    int l = it / 384, rem = it % 384, cgp = rem >> 3, ks = rem & 7;
    int col = cgp * 64 + (tid & 63), kq = tid >> 6;
    const float* w = p.in[10] + (long)l * 1024 * 3072 + col;
    float a0 = 0.f, a1 = 0.f, a2 = 0.f;
    int k0 = ks * 128 + kq * 32;
#pragma unroll 8
    for (int k = k0; k < k0 + 32; k++) {
      float wv = w[(long)k * 3072];
      a0 += siluf(p.in[9][k]) * wv;
      a1 += siluf(p.in[8][k]) * wv;
      a2 += siluf(p.in[8][1024 + k]) * wv;
    }
    smf[(kq * 3 + 0) * 64 + (tid & 63)] = a0;
    smf[(kq * 3 + 1) * 64 + (tid & 63)] = a1;
    smf[(kq * 3 + 2) * 64 + (tid & 63)] = a2;
    __syncthreads();
    if (tid < 192) {
      int c = tid >> 6, cc = tid & 63;
      float s = smf[(0 * 3 + c) * 64 + cc] + smf[(1 * 3 + c) * 64 + cc] + smf[(2 * 3 + c) * 64 + cc] + smf[(3 * 3 + c) * 64 + cc];
      modp[((ks * 2 + l) * 3 + c) * 3072 + cgp * 64 + cc] = s;
    }
    __syncthreads();
  }
}

__device__ __forceinline__ void phase_s1(const Params& p) {
  float* modp = (float*)(p.ws + WS_MODP);
  float* mod = (float*)(p.ws + WS_MOD);
  for (int idx = blockIdx.x * 256 + TIDX; idx < 2 * 3 * 3072; idx += gridDim.x * 256) {
    int l = idx / 9216, n = idx % 3072;
    float s = p.in[11][l * 3072 + n];
#pragma unroll
    for (int ks = 0; ks < 8; ks++) s += modp[ks * 18432 + idx];
    mod[idx] = s;
  }
}

__device__ __forceinline__ void wconv_tile(const float* __restrict__ src, int K, int N, bfr* __restrict__ dst,
                                           int tk, int tn, float* smf) {
  const int tid = TIDX;
  const int n = tid & 63, kb = tid >> 6;
#pragma unroll
  for (int i = 0; i < 16; i++) {
    int k = kb + 4 * i;
    smf[k * 65 + n] = src[(long)(tk * 64 + k) * N + tn * 64 + n];
  }
  __syncthreads();
#pragma unroll
  for (int i = 0; i < 16; i++) {
    int idx = tid + 256 * i;
    int nn = idx >> 6, k = idx & 63;
    dst[(long)(tn * 64 + nn) * K + tk * 64 + k] = f2bf(smf[k * 65 + nn]);
  }
  __syncthreads();
}

#define WCONV_ITEMS 2456
__device__ __forceinline__ void wconv_phase(const Params& p, int l, bfr* sm) {
  float* smf = (float*)sm;
  for (int item0 = blockIdx.x; item0 < WCONV_ITEMS; item0 += gridDim.x) {
    int item = item0;
    const float* src;
    bfr* dst;
    int K, N, tk, tn;
    if (item < 1744) {
      src = p.in[14] + (long)l * 1024 * 6976; K = 1024; N = 6976; dst = (bfr*)(p.ws + WS_WIN); tk = item & 15; tn = item >> 4;
    } else if (item < 1768) {
      item -= 1744;
      src = p.in[24] + (long)l * 256 * 384; K = 256; N = 384; dst = (bfr*)(p.ws + WS_WUQ); tk = item & 3; tn = item >> 2;
    } else if (item < 1816) {
      item -= 1768;
      src = p.in[25] + (long)l * 256 * 768; K = 256; N = 768; dst = (bfr*)(p.ws + WS_WUKV); tk = item & 3; tn = item >> 2;
    } else if (item < 2200) {
      item -= 1816;
      int w = item >> 7, it = item & 127;
      src = (w == 0 ? p.in[26] : (w == 1 ? p.in[27] : p.in[28])) + (long)l * 512 * 1024;
      K = 512; N = 1024; dst = (bfr*)(p.ws + WS_WOA + (unsigned long)w * 1048576ul); tk = it & 7; tn = it >> 3;
    } else {
      item -= 2200;
      src = p.in[29] + (long)l * 1024 * 1024; K = 1024; N = 1024; dst = (bfr*)(p.ws + WS_WOUT); tk = item & 15; tn = item >> 4;
    }
    wconv_tile(src, K, N, dst, tk, tn, smf);
  }
}

__device__ __forceinline__ void phase_prenorm0(const Params& p) {
  const int lane = TIDX & 63;
  const float* mod = (const float*)(p.ws + WS_MOD);
  bfr* H = (bfr*)(p.ws + WS_R1);
  for (int row = blockIdx.x * 4 + (TIDX >> 6); row < NROWS; row += gridDim.x * 4) {
    const float* x = xrow(p, row);
    const float* md = mod + (0 * 3 + row_cond(row)) * 3072;
    float4 v[4];
    float ss = 0.f;
#pragma unroll
    for (int i = 0; i < 4; i++) {
      v[i] = *(const float4*)(x + i * 256 + lane * 4);
      ss += v[i].x * v[i].x + v[i].y * v[i].y + v[i].z * v[i].z + v[i].w * v[i].w;
    }
    ss = wave_sum(ss);
    float rs = rsqrtf(ss * (1.f / 1024.f) + 1e-6f);
#pragma unroll
    for (int i = 0; i < 4; i++) {
      int n = i * 256 + lane * 4;
      float4 g = *(const float4*)(p.in[12] + n);
      float4 sh = *(const float4*)(md + n);
      float4 sc = *(const float4*)(md + 1024 + n);
      float h0 = v[i].x * rs * g.x * (1.f + sc.x) + sh.x;
      float h1 = v[i].y * rs * g.y * (1.f + sc.y) + sh.y;
      float h2 = v[i].z * rs * g.z * (1.f + sc.z) + sh.z;
      float h3 = v[i].w * rs * g.w * (1.f + sc.w) + sh.w;
      u32x2 o;
      o.x = pack2(h0, h1);
      o.y = pack2(h2, h3);
      *(u32x2*)(H + (long)row * 1024 + n) = o;
    }
  }
}

__device__ __forceinline__ void phase_inproj(const Params& p, bfr* sm) {
  const bfr* H = (const bfr*)(p.ws + WS_R1);
  const bfr* W = (const bfr*)(p.ws + WS_WIN);
  bfr* Z = (bfr*)(p.ws + WS_Z);
  const int lane = TIDX & 63, wid = TIDX >> 6, wr = wid >> 1, wc = wid & 1;
  for (int t = blockIdx.x; t < 96 * 55; t += gridDim.x) {
    int tn = t % 55, tm = t / 55;
    f32x4 acc[4][4];
#pragma unroll
    for (int a = 0; a < 4; a++)
#pragma unroll
      for (int b = 0; b < 4; b++) acc[a][b] = (f32x4){0.f, 0.f, 0.f, 0.f};
    gemm128(W + (long)tn * 128 * 1024, 1024, ZLD - tn * 128, H + (long)tm * 128 * 1024, 1024, 128, 1024, acc, sm);
#pragma unroll
    for (int pi = 0; pi < 4; pi++) {
      int n0 = tn * 128 + wr * 64 + pi * 16 + (lane >> 4) * 4;
      if (n0 < ZLD) {
#pragma unroll
        for (int qi = 0; qi < 4; qi++) {
          int tok = tm * 128 + wc * 64 + qi * 16 + (lane & 15);
          u32x2 o;
          o.x = pack2(acc[pi][qi][0], acc[pi][qi][1]);
          o.y = pack2(acc[pi][qi][2], acc[pi][qi][3]);
          *(u32x2*)(Z + (long)tok * ZLD + n0) = o;
        }
      }
    }
  }
}

__device__ __forceinline__ void unpack8(u32x4 v, float* x) {
  x[0] = lo16(v.x); x[1] = hi16(v.x); x[2] = lo16(v.y); x[3] = hi16(v.y);
  x[4] = lo16(v.z); x[5] = hi16(v.z); x[6] = lo16(v.w); x[7] = hi16(v.w);
}
__device__ __forceinline__ u32x4 pack8(const float* y) {
  u32x4 o;
  o.x = pack2(y[0], y[1]); o.y = pack2(y[2], y[3]); o.z = pack2(y[4], y[5]); o.w = pack2(y[6], y[7]);
  return o;
}

__device__ __forceinline__ void phase_rowpost(const Params& p, int l) {
  const int lane = TIDX & 63;
  bfr* Z = (bfr*)(p.ws + WS_Z);
  const float* rope = (const float*)(p.ws + WS_ROPE);
  bfr* VTA = (bfr*)(p.ws + WS_VTA);
  bfr* KCA = (bfr*)(p.ws + WS_KCA);
  bfr* CKVC = (bfr*)(p.ws + WS_CKVC);
  bfr* KRC = (bfr*)(p.ws + WS_KRC);
  float* out = p.out;
  for (int row = blockIdx.x * 4 + (TIDX >> 6); row < NROWS + 1024; row += gridDim.x * 4) {
    if (row < NROWS) {
      const bool lat = row >= NCTX;
      const int bc = row >> 8, tc = row & 255;
      const int bl = (row - NCTX) >> 12, tl = (row - NCTX) & 4095;
      const int prow = tl >> 6, pcol = tl & 63;
      bfr* z = Z + (long)row * ZLD;
      {
        float x[8];
        unpack8(*(const u32x4*)(z + C_QA + lane * 8), x);
        float ss = 0.f;
#pragma unroll
        for (int e = 0; e < 8; e++) ss += x[e] * x[e];
        ss += __shfl_xor(ss, 1); ss += __shfl_xor(ss, 2); ss += __shfl_xor(ss, 4);
        float rs = rsqrtf(ss * (1.f / 64.f) + 1e-6f);
        int sub = lane & 7;
        const float* g = p.in[15] + l * 64 + sub * 8;
#pragma unroll
        for (int e = 0; e < 8; e++) x[e] = x[e] * rs * g[e];
        if (lat) {
          int pos = (sub >> 2) ? pcol : prow;
          bool hi = (sub & 2) != 0;
          int i0 = (sub & 1) * 8;
#pragma unroll
          for (int e = 0; e < 8; e++) {
            float yp = __shfl_xor(x[e], 2);
            float c = rope[pos * 16 + i0 + e], s = rope[1024 + pos * 16 + i0 + e];
            x[e] = hi ? (yp * s + x[e] * c) : (x[e] * c - yp * s);
          }
        }
        const float qs = 0.125f * 1.4426950408889634f;
#pragma unroll
        for (int e = 0; e < 8; e++) x[e] *= qs;
        *(u32x4*)(z + C_QA + lane * 8) = pack8(x);
      }
      {
        int L = lane & 15;
        float x[8];
        unpack8(*(const u32x4*)(z + C_KA + L * 8), x);
        float ss = 0.f;
#pragma unroll
        for (int e = 0; e < 8; e++) ss += x[e] * x[e];
        ss += __shfl_xor(ss, 1); ss += __shfl_xor(ss, 2); ss += __shfl_xor(ss, 4);
        float rs = rsqrtf(ss * (1.f / 64.f) + 1e-6f);
        int sub = L & 7;
        const float* g = p.in[16] + l * 64 + sub * 8;
#pragma unroll
        for (int e = 0; e < 8; e++) x[e] = x[e] * rs * g[e];
        if (lat) {
          int pos = (sub >> 2) ? pcol : prow;
          bool hi = (sub & 2) != 0;
          int i0 = (sub & 1) * 8;
#pragma unroll
          for (int e = 0; e < 8; e++) {
            float yp = __shfl_xor(x[e], 2);
            float c = rope[pos * 16 + i0 + e], s = rope[1024 + pos * 16 + i0 + e];
            x[e] = hi ? (yp * s + x[e] * c) : (x[e] * c - yp * s);
          }
        } else if (lane < 16) {
          float* o = out + O_GK + ((long)(bc * 2 + l) * 256 + tc) * 128 + L * 8;
          *(float4*)(o) = make_float4(x[0], x[1], x[2], x[3]);
          *(float4*)(o + 4) = make_float4(x[4], x[5], x[6], x[7]);
        }
        if (lane < 16) *(u32x4*)(z + C_KA + L * 8) = pack8(x);
      }
      if (lane < 16) {
        int L = lane;
        u32x4 raw = *(const u32x4*)(z + C_VA + L * 8);
        float x[8];
        unpack8(raw, x);
        if (!lat) {
          float* o = out + O_GV + ((long)(bc * 2 + l) * 256 + tc) * 128 + L * 8;
          *(float4*)(o) = make_float4(x[0], x[1], x[2], x[3]);
          *(float4*)(o + 4) = make_float4(x[4], x[5], x[6], x[7]);
        }
        int g = L >> 3, d0 = (L & 7) * 8;
        long base; int nk, key;
        if (!lat) { base = (long)bc * 32768; nk = 256; key = tc; }
        else { base = 16l * 32768 + (long)bl * (2 * 64 * 4608); nk = 4608; key = 512 + tl; }
        const bfr* rb = (const bfr*)&raw;
#pragma unroll
        for (int e = 0; e < 8; e++) VTA[base + (long)(g * 64 + d0 + e) * nk + key] = rb[e];
      }
      {
        u32x2 rq = *(const u32x2*)(z + C_QL + lane * 4);
        u32x2 rk = *(const u32x2*)(z + C_KV + lane * 4);
        float q[4] = {lo16(rq.x), hi16(rq.x), lo16(rq.y), hi16(rq.y)};
        float k[4] = {lo16(rk.x), hi16(rk.x), lo16(rk.y), hi16(rk.y)};
        float sq = q[0] * q[0] + q[1] * q[1] + q[2] * q[2] + q[3] * q[3];
        float sk = k[0] * k[0] + k[1] * k[1] + k[2] * k[2] + k[3] * k[3];
        sq = wave_sum(sq);
        sk = wave_sum(sk);
        float rq_ = rsqrtf(sq * (1.f / 256.f) + 1e-6f), rk_ = rsqrtf(sk * (1.f / 256.f) + 1e-6f);
        float4 gq = *(const float4*)(p.in[22] + l * 256 + lane * 4);
        float4 gk = *(const float4*)(p.in[23] + l * 256 + lane * 4);
        q[0] *= rq_ * gq.x; q[1] *= rq_ * gq.y; q[2] *= rq_ * gq.z; q[3] *= rq_ * gq.w;
        k[0] *= rk_ * gk.x; k[1] *= rk_ * gk.y; k[2] *= rk_ * gk.z; k[3] *= rk_ * gk.w;
        u32x2 o;
        o.x = pack2(q[0], q[1]); o.y = pack2(q[2], q[3]);
        *(u32x2*)(z + C_QL + lane * 4) = o;
        o.x = pack2(k[0], k[1]); o.y = pack2(k[2], k[3]);
        *(u32x2*)(z + C_KV + lane * 4) = o;
        if (!lat) *(float4*)(out + O_CKV + ((long)(bc * 2 + l) * 256 + tc) * 256 + lane * 4) = make_float4(k[0], k[1], k[2], k[3]);
      }
      {
        int L = lane & 3;
        float x[8];
        unpack8(*(const u32x4*)(z + C_KR + L * 8), x);
        if (lat) {
          int pos = (L >> 1) ? pcol : prow;
          bool hi = (L & 1) != 0;
#pragma unroll
          for (int e = 0; e < 8; e++) {
            float yp = __shfl_xor(x[e], 1);
            float c = rope[2048 + pos * 8 + e], s = rope[2560 + pos * 8 + e];
            x[e] = hi ? (yp * s + x[e] * c) : (x[e] * c - yp * s);
          }
          if (lane < 4) *(u32x4*)(z + C_KR + L * 8) = pack8(x);
        } else if (lane < 4) {
          float* o = out + O_KR + ((long)(bc * 2 + l) * 256 + tc) * 32 + L * 8;
          *(float4*)(o) = make_float4(x[0], x[1], x[2], x[3]);
          *(float4*)(o + 4) = make_float4(x[4], x[5], x[6], x[7]);
        }
      }
    } else {
      int cr = row - NROWS;
      int b = cr >> 9, t = cr & 511;
      long src = (long)(b * 2 + l) * 512 + t;
      {
        float2 kv = *(const float2*)(p.in[2] + src * 128 + lane * 2);
        *(unsigned*)(KCA + (long)(b * 512 + t) * 128 + lane * 2) = pack2(kv.x, kv.y);
        float2 vv = *(const float2*)(p.in[3] + src * 128 + lane * 2);
        int c0 = lane * 2;
        long base = 16l * 32768 + (long)b * (2 * 64 * 4608);
        VTA[base + (long)c0 * 4608 + t] = f2bf(vv.x);
        VTA[base + (long)(c0 + 1) * 4608 + t] = f2bf(vv.y);
        float4 cv = *(const float4*)(p.in[4] + src * 256 + lane * 4);
        u32x2 o;
        o.x = pack2(cv.x, cv.y); o.y = pack2(cv.z, cv.w);
        *(u32x2*)(CKVC + (long)(b * 512 + t) * 256 + lane * 4) = o;
        if (lane < 32) KRC[(long)(b * 512 + t) * 32 + lane] = f2bf(p.in[5][src * 32 + lane]);
      }
    }
  }
}

#define WS_PREP1 251703296ul
#define WS_EL (WS_WIN + 12582912ul)
__device__ __forceinline__ bfr* prep_base(const Params& p, int b, int h, int dir, int c) {
  return (bfr*)(p.ws + (b ? WS_PREP1 : WS_WIN)) + (long)((h * 2 + dir) * 64 + c) * 12288;
}

__device__ __forceinline__ void gla_chunk_prep(int tid, const float (&wd)[16], float bias, const bfr* Qr, const bfr* Kr,
                                               bfr* Qe, bfr* Ke, bfr* KlT, const float* RF, float* tot, float* lastv) {
  const int ch = tid & 63, part = tid >> 6;
  float cum[16];
  {
    float run = 0.f;
#pragma unroll
    for (int ii = 0; ii < 16; ii++) {
      int i = part * 16 + ii;
      float x = bias;
#pragma unroll
      for (int r = 0; r < 16; r++) x += RF[i * 16 + r] * wd[r];
      float la = (fminf(x, 0.f) - __logf(1.f + __expf(-fabsf(x)))) * (1.f / 16.f);
      run += la;
      cum[ii] = run;
    }
    tot[part * 64 + ch] = run;
  }
  __syncthreads();
  {
    float off = 0.f, last = 0.f;
#pragma unroll
    for (int pp = 0; pp < 4; pp++) {
      float tv = tot[pp * 64 + ch];
      if (pp < part) off += tv;
      last += tv;
    }
    if (part == 0) lastv[ch] = last;
#pragma unroll
    for (int ii = 0; ii < 16; ii++) {
      int i = part * 16 + ii;
      float cc = cum[ii] + off;
      float qv = bf2f(Qr[i * LDT + ch]), kv = bf2f(Kr[i * LDT + ch]);
      Qe[i * LDT + ch] = f2bf(qv * __expf(cc) * 0.125f);
      Ke[i * LDT + ch] = f2bf(kv * __expf(-cc));
      KlT[ch * LDT + i] = f2bf(kv * __expf(last - cc));
    }
  }
  __syncthreads();
}

__device__ __forceinline__ void gla_att(int wid, int g, int l15, const bfr* Qe, const bfr* Ke, bfr* Att) {
  f32x4 att[4];
  bf16x8 qa[2];
#pragma unroll
  for (int kk = 0; kk < 2; kk++) qa[kk] = *(const bf16x8*)(Qe + (16 * wid + l15) * LDT + kk * 32 + g * 8);
#pragma unroll
  for (int nj = 0; nj < 4; nj++) {
    att[nj] = (f32x4){0.f, 0.f, 0.f, 0.f};
#pragma unroll
    for (int kk = 0; kk < 2; kk++) {
      bf16x8 kb = *(const bf16x8*)(Ke + (16 * nj + l15) * LDT + kk * 32 + g * 8);
      att[nj] = mfma16(qa[kk], kb, att[nj]);
    }
  }
#pragma unroll
  for (int nj = 0; nj < 4; nj++)
#pragma unroll
    for (int r = 0; r < 4; r++) {
      int i = 16 * wid + 4 * g + r, j = 16 * nj + l15;
      Att[i * LDT + j] = f2bf(i >= j ? att[nj][r] : 0.f);
    }
}

__device__ __forceinline__ void gla_prep_item(const Params& p, int l, int b, int h, int dir, int c, bfr* sm) {
  const int tid = TIDX, lane = tid & 63, wid = tid >> 6, g = lane >> 4, l15 = lane & 15;
  const bfr* Z = (const bfr*)(p.ws + WS_Z);
  const int N = 4096;
  const int rowbase = NCTX + b * 4096;
  bfr* Qr = sm;
  bfr* Kr = Qr + 64 * LDT;
  bfr* Qe = Kr + 64 * LDT;
  bfr* Ke = Qe + 64 * LDT;
  bfr* KlT = Ke + 64 * LDT;
  float* RF = (float*)(KlT + 64 * LDT);
  float* tot = RF + 64 * 16;
  float* lastv = tot + 256;
  bfr* Att = Qr;
  const int ch = tid & 63;
  float wd[16];
  {
    const float* W = (dir ? p.in[19] : p.in[17]) + (long)l * 16 * 256 + h * 64 + ch;
#pragma unroll
    for (int r = 0; r < 16; r++) wd[r] = W[r * 256];
  }
  const float bias = (dir ? p.in[20] : p.in[18])[l * 256 + h * 64 + ch];
#pragma unroll
  for (int ii = 0; ii < 2; ii++) {
    int cc = tid + 256 * ii;
    int i = cc >> 3, c8 = cc & 7;
    int tok = dir ? (N - 1 - (c * 64 + i)) : (c * 64 + i);
    const bfr* zr = Z + (long)(rowbase + tok) * ZLD;
    *(u32x4*)(Qr + i * LDT + c8 * 8) = *(const u32x4*)(zr + C_QG + h * 64 + c8 * 8);
    *(u32x4*)(Kr + i * LDT + c8 * 8) = *(const u32x4*)(zr + C_KG + h * 64 + c8 * 8);
  }
  if (tid < 128) {
    int i = tid >> 1, hf = tid & 1;
    int tok = dir ? (N - 1 - (c * 64 + i)) : (c * 64 + i);
    u32x4 rr = *(const u32x4*)(Z + (long)(rowbase + tok) * ZLD + (dir ? C_RB : C_RF) + hf * 8);
    float x[8];
    unpack8(rr, x);
#pragma unroll
    for (int e = 0; e < 8; e++) RF[i * 16 + hf * 8 + e] = x[e];
  }
  __syncthreads();
  gla_chunk_prep(tid, wd, bias, Qr, Kr, Qe, Ke, KlT, RF, tot, lastv);
  gla_att(wid, g, l15, Qe, Ke, Att);
  __syncthreads();
  bfr* dst = prep_base(p, b, h, dir, c);
#pragma unroll
  for (int ii = 0; ii < 2; ii++) {
    int cc = tid + 256 * ii;
    int i = cc >> 3, c8 = cc & 7;
    *(u32x4*)(dst + i * 64 + c8 * 8) = *(const u32x4*)(Qe + i * LDT + c8 * 8);
    *(u32x4*)(dst + 4096 + i * 64 + c8 * 8) = *(const u32x4*)(KlT + i * LDT + c8 * 8);
    *(u32x4*)(dst + 8192 + i * 64 + c8 * 8) = *(const u32x4*)(Att + i * LDT + c8 * 8);
  }
  if (tid < 64) ((float*)(p.ws + WS_EL))[((long)(((b * 4 + h) * 2 + dir) * 64 + c)) * 64 + tid] = __expf(lastv[tid]);
  __syncthreads();
}

__device__ __forceinline__ void gla_chain_item(const Params& p, int l, int b, int h, int dir, int vh, bfr* sm) {
  const int tid = TIDX, lane = tid & 63, wid = tid >> 6, g = lane >> 4, l15 = lane & 15;
  const bfr* Z = (const bfr*)(p.ws + WS_Z);
  bfr* OG = (bfr*)(p.ws + WS_R1) + (long)dir * NROWS * 512;
  const float* EL = (const float*)(p.ws + WS_EL) + (long)(((b * 4 + h) * 2 + dir) * 64) * 64;
  const int N = 4096, nc = 64;
  const int rowbase = NCTX + b * 4096;
  const int vs0 = vh * 64;
  bfr* Vt = sm;
  bfr* St = Vt + 64 * LDT;
  f32x4 st[4];
  {
    const float* S0 = (dir ? p.in[7] : p.in[6]) + ((long)((b * 2 + l) * 4 + h)) * 8192 + (long)(16 * wid + l15) * 128 + vs0;
#pragma unroll
    for (int vt = 0; vt < 4; vt++) {
      float4 a = *(const float4*)(S0 + 16 * vt + 4 * g);
      st[vt] = (f32x4){a.x, a.y, a.z, a.w};
#pragma unroll
      for (int r = 0; r < 4; r++) St[(16 * vt + 4 * g + r) * LDT + 16 * wid + l15] = f2bf(st[vt][r]);
    }
  }
  u32x4 n_qe[2], n_kl[2], n_at[2], n_v[2];
  float n_el;
  auto prefetch = [&](int c) {
    const bfr* base = prep_base(p, b, h, dir, c) + (16 * wid + l15) * 64 + 8 * g;
#pragma unroll
    for (int kk = 0; kk < 2; kk++) {
      n_qe[kk] = *(const u32x4*)(base + kk * 32);
      n_kl[kk] = *(const u32x4*)(base + 4096 + kk * 32);
      n_at[kk] = *(const u32x4*)(base + 8192 + kk * 32);
    }
    n_el = EL[c * 64 + 16 * wid + l15];
#pragma unroll
    for (int ii = 0; ii < 2; ii++) {
      int cc = tid + 256 * ii;
      int i = cc >> 3, c8 = cc & 7;
      int tok = dir ? (N - 1 - (c * 64 + i)) : (c * 64 + i);
      n_v[ii] = *(const u32x4*)(Z + (long)(rowbase + tok) * ZLD + C_VG + h * 128 + vs0 + c8 * 8);
    }
  };
  prefetch(0);
  for (int c = 0; c < nc; c++) {
    u32x4 c_qe[2] = {n_qe[0], n_qe[1]}, c_kl[2] = {n_kl[0], n_kl[1]}, c_at[2] = {n_at[0], n_at[1]};
    const float el = n_el;
#pragma unroll
    for (int ii = 0; ii < 2; ii++) {
      int cc = tid + 256 * ii;
      int i = cc >> 3, c8 = cc & 7;
      const bfr* rb = (const bfr*)&n_v[ii];
#pragma unroll
      for (int e = 0; e < 8; e++) Vt[(c8 * 8 + e) * LDT + i] = rb[e];
    }
    __syncthreads();
    if (c + 1 < nc) prefetch(c + 1);
    f32x4 stn[4];
    const int i = 16 * wid + l15;
    const int tok = dir ? (N - 1 - (c * 64 + i)) : (c * 64 + i);
    bfr* og = OG + (long)(rowbase + tok) * 512 + h * 128 + vs0 + 4 * g;
#pragma unroll
    for (int vt = 0; vt < 4; vt++) {
      f32x4 oc = (f32x4){0.f, 0.f, 0.f, 0.f};
      stn[vt] = st[vt] * el;
#pragma unroll
      for (int kk = 0; kk < 2; kk++) {
        bf16x8 vf = *(const bf16x8*)(Vt + (16 * vt + l15) * LDT + kk * 32 + g * 8);
        bf16x8 sf = *(const bf16x8*)(St + (16 * vt + l15) * LDT + kk * 32 + g * 8);
        oc = mfma16(vf, *(bf16x8*)&c_at[kk], oc);
        oc = mfma16(sf, *(bf16x8*)&c_qe[kk], oc);
        stn[vt] = mfma16(vf, *(bf16x8*)&c_kl[kk], stn[vt]);
      }
      u32x2 ov;
      ov.x = pack2(oc[0], oc[1]);
      ov.y = pack2(oc[2], oc[3]);
      *(u32x2*)(og + 16 * vt) = ov;
    }
    __syncthreads();
#pragma unroll
    for (int vt = 0; vt < 4; vt++) {
      st[vt] = stn[vt];
#pragma unroll
      for (int r = 0; r < 4; r++) St[(16 * vt + 4 * g + r) * LDT + 16 * wid + l15] = f2bf(st[vt][r]);
    }
  }
  __syncthreads();
}

template <int VS>
__device__ __forceinline__ void gla_item(const Params& p, int l, int seq, int h, int dir, int vsl, bfr* sm) {
  constexpr int NVT = VS / 16;
  constexpr int NVL = VS / 32;
  const int tid = TIDX, lane = tid & 63, wid = tid >> 6, g = lane >> 4, l15 = lane & 15;
  bfr* Z = (bfr*)(p.ws + WS_Z);
  bfr* OG = (bfr*)(p.ws + WS_R1) + (long)dir * NROWS * 512;
  const bool lat = seq >= 16;
  const int b = seq - 16;
  const int N = lat ? 4096 : 256;
  const int rowbase = lat ? NCTX + b * 4096 : seq * 256;
  const int nc = N >> 6;
  const int vs0 = vsl * VS;
  bfr* Qr = sm;
  bfr* Kr = Qr + 64 * LDT;
  bfr* Qe = Kr + 64 * LDT;
  bfr* Ke = Qe + 64 * LDT;
  bfr* KlT = Ke + 64 * LDT;
  float* RF = (float*)(KlT + 64 * LDT);
  float* tot = RF + 64 * 16;
  float* lastv = tot + 256;
  bfr* Vt = (bfr*)(lastv + 64);
  bfr* St = Vt + VS * LDT;
  bfr* Att = Qr;
  const int ch = tid & 63;
  float wd[16];
  {
    const float* W = (dir ? p.in[19] : p.in[17]) + (long)l * 16 * 256 + h * 64 + ch;
#pragma unroll
    for (int r = 0; r < 16; r++) wd[r] = W[r * 256];
  }
  const float bias = (dir ? p.in[20] : p.in[18])[l * 256 + h * 64 + ch];

  f32x4 st[NVT];
  {
    const float* S0 = (dir ? p.in[7] : p.in[6]) + ((long)((b * 2 + l) * 4 + h)) * 8192 + (long)(16 * wid + l15) * 128 + vs0;
#pragma unroll
    for (int mv = 0; mv < NVT; mv++) {
      if (lat) {
        float4 a = *(const float4*)(S0 + 16 * mv + 4 * g);
        st[mv] = (f32x4){a.x, a.y, a.z, a.w};
      } else {
        st[mv] = (f32x4){0.f, 0.f, 0.f, 0.f};
      }
#pragma unroll
      for (int r = 0; r < 4; r++) St[(16 * mv + 4 * g + r) * LDT + 16 * wid + l15] = f2bf(st[mv][r]);
    }
  }
  u32x4 rq[2], rk[2], rv[NVL], rr;
  auto prefetch = [&](int c) {
#pragma unroll
    for (int ii = 0; ii < 2; ii++) {
      int cc = tid + 256 * ii;
      int i = cc >> 3, c8 = cc & 7;
      int tok = dir ? (N - 1 - (c * 64 + i)) : (c * 64 + i);
      const bfr* zr = Z + (long)(rowbase + tok) * ZLD;
      rq[ii] = *(const u32x4*)(zr + C_QG + h * 64 + c8 * 8);
      rk[ii] = *(const u32x4*)(zr + C_KG + h * 64 + c8 * 8);
    }
#pragma unroll
    for (int ii = 0; ii < NVL; ii++) {
      int cc = tid + 256 * ii;
      int i = cc / (VS / 8), c4 = cc % (VS / 8);
      int tok = dir ? (N - 1 - (c * 64 + i)) : (c * 64 + i);
      rv[ii] = *(const u32x4*)(Z + (long)(rowbase + tok) * ZLD + C_VG + h * 128 + vs0 + c4 * 8);
    }
    if (tid < 128) {
      int i = tid >> 1, hf = tid & 1;
      int tok = dir ? (N - 1 - (c * 64 + i)) : (c * 64 + i);
      rr = *(const u32x4*)(Z + (long)(rowbase + tok) * ZLD + (dir ? C_RB : C_RF) + hf * 8);
    }
  };
  prefetch(0);
  for (int c = 0; c < nc; c++) {
#pragma unroll
    for (int ii = 0; ii < 2; ii++) {
      int cc = tid + 256 * ii;
      *(u32x4*)(Qr + (cc >> 3) * LDT + (cc & 7) * 8) = rq[ii];
      *(u32x4*)(Kr + (cc >> 3) * LDT + (cc & 7) * 8) = rk[ii];
    }
#pragma unroll
    for (int ii = 0; ii < NVL; ii++) {
      int cc = tid + 256 * ii;
      int i = cc / (VS / 8), c4 = cc % (VS / 8);
      const bfr* rb = (const bfr*)&rv[ii];
#pragma unroll
      for (int e = 0; e < 8; e++) Vt[(c4 * 8 + e) * LDT + i] = rb[e];
    }
    if (tid < 128) {
      int i = tid >> 1, hf = tid & 1;
      float x[8];
      unpack8(rr, x);
#pragma unroll
      for (int e = 0; e < 8; e++) RF[i * 16 + hf * 8 + e] = x[e];
    }
    __syncthreads();
    if (c + 1 < nc) prefetch(c + 1);
    gla_chunk_prep(tid, wd, bias, Qr, Kr, Qe, Ke, KlT, RF, tot, lastv);
    f32x4 stn[NVT];
    {
      float el = __expf(lastv[16 * wid + l15]);
#pragma unroll
      for (int mv = 0; mv < NVT; mv++) {
        stn[mv] = st[mv] * el;
#pragma unroll
        for (int kk = 0; kk < 2; kk++) {
          bf16x8 va = *(const bf16x8*)(Vt + (16 * mv + l15) * LDT + kk * 32 + g * 8);
          bf16x8 kb = *(const bf16x8*)(KlT + (16 * wid + l15) * LDT + kk * 32 + g * 8);
          stn[mv] = mfma16(va, kb, stn[mv]);
        }
      }
      gla_att(wid, g, l15, Qe, Ke, Att);
    }
    __syncthreads();
    {
      bf16x8 aa[2], qa[2];
#pragma unroll
      for (int kk = 0; kk < 2; kk++) {
        aa[kk] = *(const bf16x8*)(Att + (16 * wid + l15) * LDT + kk * 32 + g * 8);
        qa[kk] = *(const bf16x8*)(Qe + (16 * wid + l15) * LDT + kk * 32 + g * 8);
      }
#pragma unroll
      for (int nv = 0; nv < NVT; nv++) {
        f32x4 oc = (f32x4){0.f, 0.f, 0.f, 0.f};
#pragma unroll
        for (int kk = 0; kk < 2; kk++) {
          bf16x8 vb = *(const bf16x8*)(Vt + (16 * nv + l15) * LDT + kk * 32 + g * 8);
          oc = mfma16(aa[kk], vb, oc);
          bf16x8 sb = *(const bf16x8*)(St + (16 * nv + l15) * LDT + kk * 32 + g * 8);
          oc = mfma16(qa[kk], sb, oc);
        }
#pragma unroll
        for (int r = 0; r < 4; r++) {
          int i = 16 * wid + 4 * g + r;
          int tok = dir ? (N - 1 - (c * 64 + i)) : (c * 64 + i);
          OG[(long)(rowbase + tok) * 512 + h * 128 + vs0 + 16 * nv + l15] = f2bf(oc[r]);
        }
      }
    }
    __syncthreads();
#pragma unroll
    for (int mv = 0; mv < NVT; mv++) {
      st[mv] = stn[mv];
#pragma unroll
      for (int r = 0; r < 4; r++) St[(16 * mv + 4 * g + r) * LDT + 16 * wid + l15] = f2bf(st[mv][r]);
    }
  }
  __syncthreads();
  if (!lat) {
    float* so = p.out + (dir ? O_SB : O_SF) + ((long)((seq * 2 + l) * 4 + h)) * 8192 + (long)(16 * wid + l15) * 128 + vs0;
#pragma unroll
    for (int mv = 0; mv < NVT; mv++)
      *(float4*)(so + 16 * mv + 4 * g) = make_float4(st[mv][0], st[mv][1], st[mv][2], st[mv][3]);
  }
}

__device__ __forceinline__ void phase_mla_up(const Params& p, int l, bfr* sm) {
  bfr* Z = (bfr*)(p.ws + WS_Z);
  const float* rope = (const float*)(p.ws + WS_ROPE);
  const int lane = TIDX & 63, wid = TIDX >> 6, wr = wid >> 1, wc = wid & 1;
  const int g = lane >> 4;
  for (int t = blockIdx.x; t < 288 + 624 + 1024; t += gridDim.x) {
    if (t >= 912) {
      int i = t - 912;
      gla_prep_item(p, l, i >> 9, (i >> 7) & 3, (i >> 6) & 1, i & 63, sm);
      continue;
    }
    f32x4 acc[4][4];
#pragma unroll
    for (int a = 0; a < 4; a++)
#pragma unroll
      for (int b = 0; b < 4; b++) acc[a][b] = (f32x4){0.f, 0.f, 0.f, 0.f};
    if (t < 288) {
      int tn = t % 3, tm = t / 3;
      gemm128((const bfr*)(p.ws + WS_WUQ) + (long)tn * 128 * 256, 256, 128, Z + (long)tm * 128 * ZLD + C_QL, ZLD, 128, 256,
              acc, sm);
      bfr* CQ = (bfr*)(p.ws + WS_CQ);
      const float qs = 0.10206207261596577f * 1.4426950408889634f;
#pragma unroll
      for (int pi = 0; pi < 4; pi++) {
        int nb = tn * 128 + wr * 64 + pi * 16;
        int wb = nb % 96;
        bool ropet = wb >= 64;
        int part = (wb - 64) >> 4;
#pragma unroll
        for (int qi = 0; qi < 4; qi++) {
          int tok = tm * 128 + wc * 64 + qi * 16 + (lane & 15);
          float y[4] = {acc[pi][qi][0], acc[pi][qi][1], acc[pi][qi][2], acc[pi][qi][3]};
          if (ropet) {
            bool lat = tok >= NCTX;
            int tl = (tok - NCTX) & 4095;
            int pos = part ? (tl & 63) : (tl >> 6);
            bool hi = (g & 2) != 0;
            int i0 = (g & 1) * 4;
#pragma unroll
            for (int r = 0; r < 4; r++) {
              float yp = __shfl_xor(y[r], 32);
              float c = rope[2048 + pos * 8 + i0 + r], s = rope[2560 + pos * 8 + i0 + r];
              float yr = hi ? (yp * s + y[r] * c) : (y[r] * c - yp * s);
              y[r] = lat ? yr : y[r];
            }
          }
          u32x2 o;
          o.x = pack2(y[0] * qs, y[1] * qs);
          o.y = pack2(y[2] * qs, y[3] * qs);
          *(u32x2*)(CQ + (long)tok * 384 + nb + g * 4) = o;
        }
      }
    } else {
      int t2 = t - 288;
      int tn = t2 % 6, tm = t2 / 6;
      const bfr* Q;
      long ldq;
      long kbase, vbase;
      int nk, key0;
      if (tm < 32) {
        Q = Z + (long)tm * 128 * ZLD + C_KV;
        ldq = ZLD;
        int s = tm >> 1;
        key0 = (tm & 1) * 128;
        nk = 256;
        kbase = (long)s * (4 * 256 * 64);
        vbase = (long)s * 131072;
      } else {
        int r = (tm - 32) * 128;
        int b = r / 4608, within = r % 4608;
        key0 = within;
        nk = 4608;
        kbase = 16l * (4 * 256 * 64) + (long)b * (4 * 4608 * 64);
        vbase = 16l * 131072 + (long)b * (4 * 128 * 4608);
        if (within < 512) {
          Q = (const bfr*)(p.ws + WS_CKVC) + (long)(b * 512 + within) * 256;
          ldq = 256;
        } else {
          Q = Z + (long)(NCTX + b * 4096 + within - 512) * ZLD + C_KV;
          ldq = ZLD;
        }
      }
      gemm128((const bfr*)(p.ws + WS_WUKV) + (long)tn * 128 * 256, 256, 128, Q, ldq, 128, 256, acc, sm);
      bfr* KN = (bfr*)(p.ws + WS_KNOPE);
      bfr* VTC = (bfr*)(p.ws + WS_VTC);
#pragma unroll
      for (int pi = 0; pi < 4; pi++) {
        int n0 = tn * 128 + wr * 64 + pi * 16 + g * 4;
        int head = n0 / 192, w = n0 % 192;
#pragma unroll
        for (int qi = 0; qi < 4; qi++) {
          int key = key0 + wc * 64 + qi * 16 + (lane & 15);
          if (w < 64) {
            u32x2 o;
            o.x = pack2(acc[pi][qi][0], acc[pi][qi][1]);
            o.y = pack2(acc[pi][qi][2], acc[pi][qi][3]);
            *(u32x2*)(KN + kbase + ((long)head * nk + key) * 64 + w) = o;
          } else {
#pragma unroll
            for (int r = 0; r < 4; r++)
              VTC[vbase + ((long)head * 128 + (w - 64) + r) * nk + key] = f2bf(acc[pi][qi][r]);
          }
        }
      }
    }
  }
}

template <int DQ, int DV, bool MLA>
__device__ __forceinline__ void attn_item(const Params& p, int seq, int head, int qblk, bfr* sm, int dry) {
  constexpr int KLD = DQ + 8;
  constexpr int KSZ = 64 * KLD;
  constexpr int VSZ = DV * LDT;
  constexpr int BUF = KSZ + VSZ;
  constexpr int NKK = DQ / 32;
  constexpr int NDV = DV / 16;
  constexpr int NVL = DV / 32;
  const int tid = TIDX, lane = tid & 63, wid = tid >> 6, g = lane >> 4, l15 = lane & 15;
  bfr* Z = (bfr*)(p.ws + WS_Z);
  const bool lat = seq >= 16;
  const int b = seq - 16;
  const int nk = lat ? 4608 : 256;
  const int rowbase = lat ? NCTX + b * 4096 : seq * 256;
  const int nkt = nk >> 6;

  bf16x8 qf[2][NKK];
#pragma unroll
  for (int qb = 0; qb < 2; qb++) {
    int qrow = rowbase + qblk * 128 + wid * 32 + qb * 16 + l15;
    const bfr* qp = MLA ? ((const bfr*)(p.ws + WS_CQ) + (long)qrow * 384 + head * 96) : (Z + (long)qrow * ZLD + C_QA + head * 64);
#pragma unroll
    for (int kk = 0; kk < NKK; kk++) qf[qb][kk] = *(const bf16x8*)(qp + kk * 32 + g * 8);
  }

  u32x4 rk[2], rkr, rv[NVL];
  auto prefetch = [&](int kt) {
    int k0 = kt * 64;
    bool cache = lat && (k0 < 512);
    int tokrow0 = lat ? (NCTX + b * 4096 + k0 - 512) : (seq * 256 + k0);
    if (!MLA) {
      int kvh = head >> 2;
#pragma unroll
      for (int i = 0; i < 2; i++) {
        int c = tid + 256 * i;
        int kr_ = c >> 3, ch = c & 7;
        const bfr* src = cache ? ((const bfr*)(p.ws + WS_KCA) + (long)(b * 512 + k0 + kr_) * 128 + kvh * 64 + ch * 8)
                               : (Z + (long)(tokrow0 + kr_) * ZLD + C_KA + kvh * 64 + ch * 8);
        rk[i] = *(const u32x4*)src;
      }
      long vb = lat ? (16l * 32768 + (long)b * (2 * 64 * 4608)) : ((long)seq * 32768);
#pragma unroll
      for (int i = 0; i < NVL; i++) {
        int c = tid + 256 * i;
        int dv = c >> 3, ch = c & 7;
        rv[i] = *(const u32x4*)((const bfr*)(p.ws + WS_VTA) + vb + (long)(kvh * 64 + dv) * nk + k0 + ch * 8);
      }
    } else {
      long kb = lat ? (16l * (4 * 256 * 64) + (long)b * (4 * 4608 * 64)) : ((long)seq * (4 * 256 * 64));
#pragma unroll
      for (int i = 0; i < 2; i++) {
        int c = tid + 256 * i;
        int kr_ = c >> 3, ch = c & 7;
        rk[i] = *(const u32x4*)((const bfr*)(p.ws + WS_KNOPE) + kb + ((long)head * nk + k0 + kr_) * 64 + ch * 8);
      }
      {
        int kr_ = tid >> 2, ch = tid & 3;
        const bfr* src = cache ? ((const bfr*)(p.ws + WS_KRC) + (long)(b * 512 + k0 + kr_) * 32 + ch * 8)
                               : (Z + (long)(tokrow0 + kr_) * ZLD + C_KR + ch * 8);
        rkr = *(const u32x4*)src;
      }
      long vb = lat ? (16l * 131072 + (long)b * (4 * 128 * 4608)) : ((long)seq * 131072);
#pragma unroll
      for (int i = 0; i < NVL; i++) {
        int c = tid + 256 * i;
        int dv = c >> 3, ch = c & 7;
        rv[i] = *(const u32x4*)((const bfr*)(p.ws + WS_VTC) + vb + (long)(head * 128 + dv) * nk + k0 + ch * 8);
      }
    }
  };

  f32x4 o[2][NDV];
#pragma unroll
  for (int qb = 0; qb < 2; qb++)
#pragma unroll
    for (int d = 0; d < NDV; d++) o[qb][d] = (f32x4){0.f, 0.f, 0.f, 0.f};
  float mrun[2] = {-1e30f, -1e30f}, lsum[2] = {0.f, 0.f};

  prefetch(0);
  for (int kt = 0; kt < nkt; kt++) {
    bfr* Ks = sm + (kt & 1) * BUF;
    bfr* Vs = Ks + KSZ;
#pragma unroll
    for (int i = 0; i < 2; i++) {
      int c = tid + 256 * i;
      *(u32x4*)(Ks + (c >> 3) * KLD + (c & 7) * 8) = rk[i];
    }
    if (MLA) *(u32x4*)(Ks + (tid >> 2) * KLD + 64 + (tid & 3) * 8) = rkr;
#pragma unroll
    for (int i = 0; i < NVL; i++) {
      int c = tid + 256 * i;
      *(u32x4*)(Vs + (c >> 3) * LDT + (c & 7) * 8) = rv[i];
    }
    __syncthreads();
    if (kt + 1 < nkt) prefetch(kt + 1);

    f32x4 s[2][4];
#pragma unroll
    for (int t = 0; t < 4; t++) {
      s[0][t] = (f32x4){0.f, 0.f, 0.f, 0.f};
      s[1][t] = (f32x4){0.f, 0.f, 0.f, 0.f};
      int krow = 32 * (t >> 1) + 8 * (l15 >> 2) + 4 * (t & 1) + (l15 & 3);
#pragma unroll
      for (int kk = 0; kk < NKK; kk++) {
        bf16x8 kf = *(const bf16x8*)(Ks + krow * KLD + kk * 32 + g * 8);
        s[0][t] = mfma16(kf, qf[0][kk], s[0][t]);
        s[1][t] = mfma16(kf, qf[1][kk], s[1][t]);
      }
    }
    bf16x8 pf[2][2];
#pragma unroll
    for (int qb = 0; qb < 2; qb++) {
      float mt = s[qb][0][0];
#pragma unroll
      for (int t = 0; t < 4; t++)
#pragma unroll
        for (int r = 0; r < 4; r++) mt = fmaxf(mt, s[qb][t][r]);
      mt = fmaxf(mt, __shfl_xor(mt, 16));
      mt = fmaxf(mt, __shfl_xor(mt, 32));
      float mnew = fmaxf(mrun[qb], mt);
      float alpha = __builtin_amdgcn_exp2f(mrun[qb] - mnew);
      mrun[qb] = mnew;
      float ps = 0.f;
#pragma unroll
      for (int t = 0; t < 4; t++)
#pragma unroll
        for (int r = 0; r < 4; r++) {
          float pv = __builtin_amdgcn_exp2f(s[qb][t][r] - mnew);
          ps += pv;
          s[qb][t][r] = pv;
        }
      lsum[qb] = lsum[qb] * alpha + ps;
#pragma unroll
      for (int d = 0; d < NDV; d++) {
        o[qb][d][0] *= alpha; o[qb][d][1] *= alpha; o[qb][d][2] *= alpha; o[qb][d][3] *= alpha;
      }
#pragma unroll
      for (int sx = 0; sx < 2; sx++) {
        u32x4 u;
        u.x = pack2(s[qb][2 * sx][0], s[qb][2 * sx][1]);
        u.y = pack2(s[qb][2 * sx][2], s[qb][2 * sx][3]);
        u.z = pack2(s[qb][2 * sx + 1][0], s[qb][2 * sx + 1][1]);
        u.w = pack2(s[qb][2 * sx + 1][2], s[qb][2 * sx + 1][3]);
        pf[qb][sx] = *(bf16x8*)&u;
      }
    }
#pragma unroll
    for (int d = 0; d < NDV; d++) {
#pragma unroll
      for (int sx = 0; sx < 2; sx++) {
        bf16x8 vf = *(const bf16x8*)(Vs + (d * 16 + l15) * LDT + sx * 32 + g * 8);
        o[0][d] = mfma16(vf, pf[0][sx], o[0][d]);
        o[1][d] = mfma16(vf, pf[1][sx], o[1][d]);
      }
    }
  }
  __syncthreads();
#pragma unroll
  for (int qb = 0; qb < 2; qb++) {
    float lt = lsum[qb];
    lt += __shfl_xor(lt, 16);
    lt += __shfl_xor(lt, 32);
    float inv = 1.f / lt;
    int qrow = rowbase + qblk * 128 + wid * 32 + qb * 16 + l15;
    bfr* gp = Z + (long)qrow * ZLD + (MLA ? C_GC : C_GA) + head * DV + g * 4;
#pragma unroll
    for (int d = 0; d < NDV; d++) {
      u32x2 gr = *(const u32x2*)(gp + d * 16);
      float y0 = o[qb][d][0] * inv * siluf(lo16(gr.x));
      float y1 = o[qb][d][1] * inv * siluf(hi16(gr.x));
      float y2 = o[qb][d][2] * inv * siluf(lo16(gr.y));
      float y3 = o[qb][d][3] * inv * siluf(hi16(gr.y));
      u32x2 ov;
      ov.x = pack2(y0, y1);
      ov.y = pack2(y2, y3);
      if (!dry) *(u32x2*)(gp + d * 16) = ov;
    }
  }
}

__device__ __forceinline__ void phase_mixers(const Params& p, int l, bfr* sm, int* s_item, int dry) {
  unsigned* ctr = (unsigned*)(p.ws + WS_CTR) + l + 2 * dry;
  for (;;) {
    if (TIDX == 0) *s_item = (int)atomicAdd(ctr, 1u);
    __syncthreads();
    int idx = *s_item;
    __syncthreads();
    if (idx >= 1440) break;
    int kind, a0, a1, a2, a3 = 0;
    if (idx < 32) {
      kind = 3; a0 = idx >> 4; a1 = (idx >> 2) & 3; a2 = (idx >> 1) & 1; a3 = idx & 1;
    } else if (idx < 288) {
      int i = idx - 32;
      kind = 1; a0 = 16 + (i >> 7); a1 = (i >> 5) & 3; a2 = i & 31;
    } else if (idx < 800) {
      int i = idx - 288;
      kind = 2; a0 = 16 + (i >> 8); a1 = (i >> 5) & 7; a2 = i & 31;
    } else if (idx < 1056) {
      int i = idx - 800;
      kind = 0; a0 = i >> 4; a1 = (i >> 2) & 3; a2 = (i >> 1) & 1; a3 = i & 1;
    } else if (idx < 1184) {
      int i = idx - 1056;
      kind = 1; a0 = i >> 3; a1 = (i >> 1) & 3; a2 = i & 1;
    } else {
      int i = idx - 1184;
      kind = 2; a0 = i >> 4; a1 = (i >> 1) & 7; a2 = i & 1;
    }
#ifdef PROBE_MIXKIND
    if (dry && ((PROBE_MIXKIND == 1) != (kind == 0 || kind == 3))) continue;
#endif
    if (kind == 0) gla_item<64>(p, l, a0, a1, a2, a3, sm);
    else if (kind == 3) gla_chain_item(p, l, a0, a1, a2, a3, sm);
    else if (kind == 1) attn_item<96, 128, true>(p, a0, a1, a2, sm, dry);
    else attn_item<64, 64, false>(p, a0, a1, a2, sm, dry);
  }
}

__device__ __forceinline__ void phase_gla_out(const Params& p, int l) {
  const int lane = TIDX & 63;
  bfr* Z = (bfr*)(p.ws + WS_Z);
  const bfr* OF = (const bfr*)(p.ws + WS_R1);
  const bfr* OB = OF + (long)NROWS * 512;
  for (int row = blockIdx.x * 4 + (TIDX >> 6); row < NROWS; row += gridDim.x * 4) {
    float a[8], c[8], gt[8];
    unpack8(*(const u32x4*)(OF + (long)row * 512 + lane * 8), a);
    unpack8(*(const u32x4*)(OB + (long)row * 512 + lane * 8), c);
    bfr* gp = Z + (long)row * ZLD + C_GG + lane * 8;
    unpack8(*(const u32x4*)gp, gt);
    float ss = 0.f;
#pragma unroll
    for (int e = 0; e < 8; e++) {
      a[e] = bf2f(f2bf(a[e] + c[e]));
      ss += a[e] * a[e];
    }
    ss += __shfl_xor(ss, 1); ss += __shfl_xor(ss, 2); ss += __shfl_xor(ss, 4); ss += __shfl_xor(ss, 8);
    float rs = rsqrtf(ss * (1.f / 128.f) + 1e-6f);
    const float* gg = p.in[21] + l * 128 + (lane & 15) * 8;
#pragma unroll
    for (int e = 0; e < 8; e++) a[e] = a[e] * rs * gg[e] * siluf(gt[e]);
    *(u32x4*)gp = pack8(a);
  }
}

__device__ __forceinline__ void phase_merge(const Params& p, bfr* sm) {
  bfr* Z = (bfr*)(p.ws + WS_Z);
  bfr* MG = (bfr*)(p.ws + WS_R1);
  const int lane = TIDX & 63, wid = TIDX >> 6, wr = wid >> 1, wc = wid & 1, g = lane >> 4;
  for (int t = blockIdx.x; t < 96 * 8; t += gridDim.x) {
    int tn = t & 7, tm = t >> 3;
    f32x4 totl[4][4];
#pragma unroll
    for (int a = 0; a < 4; a++)
#pragma unroll
      for (int b = 0; b < 4; b++) totl[a][b] = (f32x4){0.f, 0.f, 0.f, 0.f};
#pragma unroll 1
    for (int seg = 0; seg < 3; seg++) {
      f32x4 acc[4][4];
#pragma unroll
      for (int a = 0; a < 4; a++)
#pragma unroll
        for (int b = 0; b < 4; b++) acc[a][b] = (f32x4){0.f, 0.f, 0.f, 0.f};
      int ycol = seg == 0 ? C_GA : (seg == 1 ? C_GG : C_GC);
      int mcol = C_M1 + seg * 1024;
      const bfr* W = (const bfr*)(p.ws + WS_WOA + (unsigned long)seg * 1048576ul) + (long)tn * 128 * 512;
      gemm128(W, 512, 128, Z + (long)tm * 128 * ZLD + ycol, ZLD, 128, 512, acc, sm);
#pragma unroll
      for (int pi = 0; pi < 4; pi++) {
        int n0 = tn * 128 + wr * 64 + pi * 16 + g * 4;
#pragma unroll
        for (int qi = 0; qi < 4; qi++) {
          int tok = tm * 128 + wc * 64 + qi * 16 + (lane & 15);
          u32x2 mr = *(const u32x2*)(Z + (long)tok * ZLD + mcol + n0);
          totl[pi][qi][0] += sigmf(lo16(mr.x)) * acc[pi][qi][0];
          totl[pi][qi][1] += sigmf(hi16(mr.x)) * acc[pi][qi][1];
          totl[pi][qi][2] += sigmf(lo16(mr.y)) * acc[pi][qi][2];
          totl[pi][qi][3] += sigmf(hi16(mr.y)) * acc[pi][qi][3];
        }
      }
    }
#pragma unroll
    for (int pi = 0; pi < 4; pi++) {
      int n0 = tn * 128 + wr * 64 + pi * 16 + g * 4;
#pragma unroll
      for (int qi = 0; qi < 4; qi++) {
        int tok = tm * 128 + wc * 64 + qi * 16 + (lane & 15);
        u32x2 o;
        o.x = pack2(totl[pi][qi][0], totl[pi][qi][1]);
        o.y = pack2(totl[pi][qi][2], totl[pi][qi][3]);
        *(u32x2*)(MG + (long)tok * 1024 + n0) = o;
      }
    }
  }
}

__device__ __forceinline__ void phase_outproj(const Params& p, bfr* sm) {
  const bfr* MG = (const bfr*)(p.ws + WS_R1);
  float* OUT = (float*)(p.ws + WS_Z);
  const int lane = TIDX & 63, wid = TIDX >> 6, wr = wid >> 1, wc = wid & 1, g = lane >> 4;
  for (int t = blockIdx.x; t < 96 * 8; t += gridDim.x) {
    int tn = t & 7, tm = t >> 3;
    f32x4 acc[4][4];
#pragma unroll
    for (int a = 0; a < 4; a++)
#pragma unroll
      for (int b = 0; b < 4; b++) acc[a][b] = (f32x4){0.f, 0.f, 0.f, 0.f};
    gemm128((const bfr*)(p.ws + WS_WOUT) + (long)tn * 128 * 1024, 1024, 128, MG + (long)tm * 128 * 1024, 1024, 128, 1024, acc,
            sm);
#pragma unroll
    for (int pi = 0; pi < 4; pi++) {
      int n0 = tn * 128 + wr * 64 + pi * 16 + g * 4;
#pragma unroll
      for (int qi = 0; qi < 4; qi++) {
        int tok = tm * 128 + wc * 64 + qi * 16 + (lane & 15);
        *(float4*)(OUT + (long)tok * 1024 + n0) = make_float4(acc[pi][qi][0], acc[pi][qi][1], acc[pi][qi][2], acc[pi][qi][3]);
      }
    }
  }
}

__device__ __forceinline__ void phase_post(const Params& p, int l) {
  const int lane = TIDX & 63;
  const float* mod = (const float*)(p.ws + WS_MOD);
  const float* OUT = (const float*)(p.ws + WS_Z);
  bfr* H = (bfr*)(p.ws + WS_R1);
  for (int row = blockIdx.x * 4 + (TIDX >> 6); row < NROWS; row += gridDim.x * 4) {
    const float* x = (l == 0) ? xrow(p, row) : (p.out + (long)row * 1024);
    const float* md = mod + (l * 3 + row_cond(row)) * 3072;
    float4 v[4];
    float ss = 0.f;
#pragma unroll
    for (int i = 0; i < 4; i++) {
      v[i] = *(const float4*)(OUT + (long)row * 1024 + i * 256 + lane * 4);
      ss += v[i].x * v[i].x + v[i].y * v[i].y + v[i].z * v[i].z + v[i].w * v[i].w;
    }
    ss = wave_sum(ss);
    float rs = rsqrtf(ss * (1.f / 1024.f) + 1e-6f);
    float ss2 = 0.f;
#pragma unroll
    for (int i = 0; i < 4; i++) {
      int n = i * 256 + lane * 4;
      float4 g = *(const float4*)(p.in[13] + l * 1024 + n);
      float4 gt = *(const float4*)(md + 2048 + n);
      float4 xv = *(const float4*)(x + n);
      v[i].x = xv.x + gt.x * (v[i].x * rs * g.x);
      v[i].y = xv.y + gt.y * (v[i].y * rs * g.y);
      v[i].z = xv.z + gt.z * (v[i].z * rs * g.z);
      v[i].w = xv.w + gt.w * (v[i].w * rs * g.w);
      *(float4*)(p.out + (long)row * 1024 + n) = v[i];
      ss2 += v[i].x * v[i].x + v[i].y * v[i].y + v[i].z * v[i].z + v[i].w * v[i].w;
    }
    if (l == 0) {
      ss2 = wave_sum(ss2);
      float rs2 = rsqrtf(ss2 * (1.f / 1024.f) + 1e-6f);
      const float* md1 = mod + (1 * 3 + row_cond(row)) * 3072;
#pragma unroll
      for (int i = 0; i < 4; i++) {
        int n = i * 256 + lane * 4;
        float4 g = *(const float4*)(p.in[12] + 1024 + n);
        float4 sh = *(const float4*)(md1 + n);
        float4 sc = *(const float4*)(md1 + 1024 + n);
        float h0 = v[i].x * rs2 * g.x * (1.f + sc.x) + sh.x;
        float h1 = v[i].y * rs2 * g.y * (1.f + sc.y) + sh.y;
        float h2 = v[i].z * rs2 * g.z * (1.f + sc.z) + sh.z;
        float h3 = v[i].w * rs2 * g.w * (1.f + sc.w) + sh.w;
        u32x2 o;
        o.x = pack2(h0, h1);
        o.y = pack2(h2, h3);
        *(u32x2*)(H + (long)row * 1024 + n) = o;
      }
    }
  }
}

__global__ void __launch_bounds__(256, 2) fwd_megakernel(Params p) {
  __shared__ __attribute__((aligned(16))) bfr sm[SMEM_SHORTS];
  __shared__ int s_item;
  cg::grid_group grid = cg::this_grid();
  __shared__ uint4 xb_words;
  if (threadIdx.x == 0) xb_words = make_uint4(0u, 0u, 0u, 0u);
  __syncthreads();
  XcdBarrier xb = xcd_barrier_post((unsigned*)(p.ws + WS_BAR), (volatile LAS unsigned*)&xb_words);
  if (p.ws == nullptr) grid.sync();
#ifdef PROBE_SYNC
#define GSYNC do { xcd_barrier(xb); xcd_barrier(xb); } while (0)
#else
#define GSYNC xcd_barrier(xb)
#endif
#ifdef PROBE_PRE
  phase_s0(launder(p), sm);
  GSYNC;
  phase_s1(launder(p));
  wconv_phase(p, 0, sm);
  GSYNC;
  phase_prenorm0(launder(p));
  GSYNC;
#endif

#ifndef PH
#define PH 0xffff
#endif
#if PH & 1
  phase_s0(launder(p), sm);
#endif
  GSYNC;
#if PH & 2
  phase_s1(launder(p));
  wconv_phase(p, 0, sm);
#endif
  GSYNC;
#if PH & 4
  phase_prenorm0(launder(p));
#endif
  GSYNC;
  for (int l = 0; l < 2; l++) {
#if PH & 8
#ifdef PROBE_INPROJ
    phase_inproj(launder(p), sm);
    GSYNC;
#endif
    phase_inproj(launder(p), sm);
#endif
    GSYNC;
#if PH & 16
    phase_rowpost(launder(p), l);
#endif
    GSYNC;
#if PH & 32
#ifdef PROBE_MLAUP
    phase_mla_up(launder(p), l, sm);
    GSYNC;
#endif
    phase_mla_up(launder(p), l, sm);
#endif
    GSYNC;
#if PH & 64
#ifdef PROBE_MIX
    { int dry = 1; asm volatile("" : "+s"(dry)); phase_mixers(launder(p), l, sm, &s_item, dry); }
    GSYNC;
#endif
    { int dry = 0; asm volatile("" : "+s"(dry)); phase_mixers(launder(p), l, sm, &s_item, dry); }
#endif
    GSYNC;
#if PH & 128
    phase_gla_out(launder(p), l);
#endif
    GSYNC;
#if PH & 256
#ifdef PROBE_MERGE
    phase_merge(launder(p), sm);
    GSYNC;
#endif
    phase_merge(launder(p), sm);
#endif
    GSYNC;
#if PH & 512
#ifdef PROBE_MERGE
    phase_outproj(launder(p), sm);
    GSYNC;
#endif
    phase_outproj(launder(p), sm);
#endif
    GSYNC;
#if PH & 1024
    phase_post(launder(p), l);
    if (l == 0) wconv_phase(p, 1, sm);
#endif
    GSYNC;
  }
}

extern "C" void kernel_launch(void* const* d_in, const int* in_sizes, int n_in, void* d_out, int out_size, void* d_ws,
                              size_t ws_size, hipStream_t stream) {
  static int grid_blocks = 0;
  if (!grid_blocks) {
    int dev = 0, cus = 0, per_cu = 0;
    hipGetDevice(&dev);
    hipDeviceGetAttribute(&cus, hipDeviceAttributeMultiprocessorCount, dev);
    hipOccupancyMaxActiveBlocksPerMultiprocessor(&per_cu, fwd_megakernel, 256, 0);
    if (per_cu > 2) per_cu = 2;
    if (per_cu < 1) per_cu = 1;
    grid_blocks = cus * per_cu;
  }
  Params p{};
  for (int i = 0; i < 30; i++) p.in[i] = (const float*)d_in[i];
  p.out = (float*)d_out;
  p.ws = (unsigned char*)d_ws;
  hipMemsetAsync(d_ws, 0, 20480, stream);
  void* args[] = {&p};
  hipError_t e = hipLaunchCooperativeKernel((void*)fwd_megakernel, dim3(grid_blocks), dim3(256), args, 0, stream);
  if (e != hipSuccess) fprintf(stderr, "cooperative launch failed: %s (grid %d)\n", hipGetErrorString(e), grid_blocks);
}
```

```cpp
#include <hip/hip_runtime.h>
#include <hip/hip_cooperative_groups.h>
#include <cstdio>
namespace cg = cooperative_groups;

typedef unsigned short bfr;
typedef __attribute__((ext_vector_type(8))) short bf16x8;
typedef __attribute__((ext_vector_type(4))) float f32x4;
typedef __attribute__((ext_vector_type(4))) unsigned u32x4;
typedef __attribute__((ext_vector_type(2))) unsigned u32x2;

#define NROWS 12288
#define NCTX 4096
#define ZLD 6976
#define LDT 72
#define SMEM_SHORTS (4 * 128 * LDT)

#define C_QA 0
#define C_KA 512
#define C_VA 640
#define C_GA 768
#define C_QG 1280
#define C_KG 1536
#define C_VG 1792
#define C_GG 2304
#define C_RF 2816
#define C_RB 2832
#define C_QL 2848
#define C_KV 3104
#define C_KR 3360
#define C_GC 3392
#define C_M1 3904
#define C_M2 4928
#define C_M3 5952

#define WS_BAR 0ul
#define WS_CTR 16384ul
#define WS_MODP 20480ul
#define WS_MOD (WS_MODP + 589824ul)
#define WS_ROPE (WS_MOD + 73728ul)
#define WS_WIN (WS_ROPE + 16384ul)
#define WS_WUQ (WS_WIN + 14417920ul)
#define WS_WUKV (WS_WUQ + 196608ul)
#define WS_WOA (WS_WUKV + 393216ul)
#define WS_WOB (WS_WOA + 1048576ul)
#define WS_WOC (WS_WOB + 1048576ul)
#define WS_WOUT (WS_WOC + 1048576ul)
#define WS_KCA (WS_WOUT + 2097152ul)
#define WS_CKVC (WS_KCA + 262144ul)
#define WS_KRC (WS_CKVC + 524288ul)
#define WS_VTA (WS_KRC + 65536ul)
#define WS_CQ (WS_VTA + 3407872ul)
#define WS_KNOPE (WS_CQ + 9437184ul)
#define WS_VTC (WS_KNOPE + 6815744ul)
#define WS_R1 (WS_VTC + 13631488ul)
#define WS_Z (WS_R1 + 25165824ul)
#define WS_END (WS_Z + 171442176ul)

#define O_Y 0
#define O_GK 12582912
#define O_GV 13631488
#define O_CKV 14680064
#define O_KR 16777216
#define O_SF 17039360
#define O_SB 18087936

struct Params {
  const float* in[30];
  float* out;
  unsigned char* ws;
};

__device__ __forceinline__ int tidx() {
  int t = threadIdx.x;
  asm volatile("" : "+v"(t));
  return t;
}
__device__ __forceinline__ Params launder(const Params& p) {
  Params q;
  long zo = 0;
  asm volatile("" : "+s"(zo));
#pragma unroll
  for (int i = 0; i < 30; i++) q.in[i] = p.in[i] + zo;
  q.out = p.out + zo;
  q.ws = p.ws + zo;
  return q;
}
__device__ __forceinline__ float bf2f(bfr b) { return __uint_as_float(((unsigned)b) << 16); }
typedef float f32x2_t __attribute__((ext_vector_type(2)));
typedef __bf16 bf16x2_t __attribute__((ext_vector_type(2)));
__device__ __forceinline__ bfr f2bf(float f) {
  __bf16 r = (__bf16)f;
  return *(bfr*)&r;
}
__device__ __forceinline__ unsigned pack2(float a, float b) {
  f32x2_t v = {a, b};
  bf16x2_t r = __builtin_convertvector(v, bf16x2_t);
  return *(unsigned*)&r;
}
__device__ __forceinline__ float lo16(unsigned u) { return __uint_as_float(u << 16); }
__device__ __forceinline__ float hi16(unsigned u) { return __uint_as_float(u & 0xffff0000u); }
__device__ __forceinline__ float siluf(float x) { return x / (1.f + __expf(-x)); }
__device__ __forceinline__ float sigmf(float x) { return 1.f / (1.f + __expf(-x)); }
__device__ __forceinline__ f32x4 mfma16(bf16x8 a, bf16x8 b, f32x4 c) {
  return __builtin_amdgcn_mfma_f32_16x16x32_bf16(a, b, c, 0, 0, 0);
}
__device__ __forceinline__ const float* xrow(const Params& p, int row) {
  return row < NCTX ? p.in[0] + (long)row * 1024 : p.in[1] + (long)(row - NCTX) * 1024;
}
__device__ __forceinline__ int row_cond(int row) { return row < NCTX ? 0 : 1 + ((row - NCTX) >> 12); }
__device__ __forceinline__ float wave_sum(float v) {
  v += __shfl_xor(v, 1); v += __shfl_xor(v, 2); v += __shfl_xor(v, 4);
  v += __shfl_xor(v, 8); v += __shfl_xor(v, 16); v += __shfl_xor(v, 32);
  return v;
}

#define XB_TMO      128
#define XB_XCNT(j)  (256  + 64 * (j))
#define XB_XSUB(j)  (1280 + 64 * (j))
#define XB_XGEN(j)  (2304 + 64 * (j))
#define XB_TOP      3328
#define XB_TOPGEN   3392
#define XCD_BAR_WORDS 3456
#define XB_SPIN_CAP (1u << 18)
#define LAS __attribute__((address_space(3)))

__device__ __forceinline__ unsigned xb_ld(unsigned* p)              { return __hip_atomic_load(p, __ATOMIC_RELAXED, __HIP_MEMORY_SCOPE_AGENT); }
__device__ __forceinline__ unsigned xb_add(unsigned* p, unsigned v) { return __hip_atomic_fetch_add(p, v, __ATOMIC_RELAXED, __HIP_MEMORY_SCOPE_AGENT); }
__device__ __forceinline__ unsigned xb_xcc_id() { return (unsigned)__builtin_amdgcn_s_getreg((3 << 11) | 20) & 0xFu; }
#define XB_SPIN(cond, bar) do { unsigned _sp = 0; while (cond) { __builtin_amdgcn_s_sleep(1); \
    if ((++_sp & 255u) == 0u) { if (xb_ld(&(bar)[XB_TMO])) break; if (_sp > XB_SPIN_CAP) { atomicAdd(&(bar)[XB_TMO], 1u); break; } } } } while (0)

struct XcdBarrier {
    unsigned* bar; unsigned x;
    volatile LAS unsigned* st;
};

__device__ __forceinline__ XcdBarrier xcd_barrier_post(unsigned* bar, volatile LAS unsigned* st) {
    XcdBarrier b; b.bar = bar; b.x = xb_xcc_id(); b.st = st;
    if (threadIdx.x == 0) (void)xb_add(&bar[XB_XCNT(b.x)], 1u);
    return b;
}
__device__ __forceinline__ void xcd_barrier_complete(unsigned* bar, unsigned x, unsigned& nloc, unsigned& nx) {
    const unsigned G = gridDim.x * gridDim.y * gridDim.z;
    unsigned sum, cnt, mine, sp = 0u;
    for (;;) {
        sum = 0u; cnt = 0u; mine = 0u;
#pragma unroll
        for (unsigned j = 0; j < 16; ++j) { const unsigned c = xb_ld(&bar[XB_XCNT(j)]); sum += c; cnt += (c > 0u) ? 1u : 0u; mine = (j == x) ? c : mine; }
        if (sum == G) break;
        __builtin_amdgcn_s_sleep(1);
        if ((++sp & 255u) == 0u) { if (xb_ld(&bar[XB_TMO])) break; if (sp > XB_SPIN_CAP) { atomicAdd(&bar[XB_TMO], 1u); break; } }
    }
    nloc = mine > 0u ? mine : 1u; nx = cnt > 0u ? cnt : 1u;
}

__device__ __forceinline__ void xcd_barrier(const XcdBarrier& b) {
    asm volatile("s_waitcnt vmcnt(0)" ::: "memory");
    __syncthreads();
    if (threadIdx.x == 0) {
        unsigned* bar = b.bar;
        __builtin_amdgcn_s_waitcnt(0);
        unsigned nloc = b.st[0], nx = b.st[1];
        if (nloc == 0u) { xcd_barrier_complete(bar, b.x, nloc, nx); b.st[0] = nloc; b.st[1] = nx; }
        const unsigned old = xb_add(&bar[XB_XSUB(b.x)], 1u);
        const unsigned gen = old / nloc;
        if (old + 1u == (gen + 1u) * nloc) {
            __builtin_amdgcn_fence(__ATOMIC_RELEASE, "agent");
            asm volatile("s_waitcnt vmcnt(0)" ::: "memory");
            const unsigned og = xb_add(&bar[XB_TOP], 1u);
            const unsigned tg = og / nx;
            if (og + 1u == (tg + 1u) * nx) xb_add(&bar[XB_TOPGEN], 1u);
            else XB_SPIN(xb_ld(&bar[XB_TOPGEN]) == tg, bar);
            __builtin_amdgcn_fence(__ATOMIC_ACQUIRE, "agent");
            xb_add(&bar[XB_XGEN(b.x)], 1u);
            asm volatile("s_waitcnt vmcnt(0)" ::: "memory");
        } else {
            XB_SPIN(xb_ld(&bar[XB_XGEN(b.x)]) == gen, bar);
            __builtin_amdgcn_fence(__ATOMIC_ACQUIRE, "agent");
            asm volatile("s_waitcnt vmcnt(0)" ::: "memory");
        }
    }
    __syncthreads();
}


#define TIDX tidx()
__device__ __forceinline__ void gemm128(const bfr* __restrict__ P, long ldp, int pmax,
                                        const bfr* __restrict__ Q, long ldq, int qmax, int K,
                                        f32x4 (&acc)[4][4], bfr* sm) {
  const int tid = TIDX, lane = tid & 63, wid = tid >> 6;
  const int wr = wid >> 1, wc = wid & 1;
  const int lr = tid >> 3, lc = (tid & 7) * 8;
  u32x4 rp[4], rq[4];
  const bfr* pp[4];
  const bfr* qp[4];
#pragma unroll
  for (int i = 0; i < 4; i++) {
    int r = lr + 32 * i;
    pp[i] = P + (long)min(r, pmax - 1) * ldp + lc;
    qp[i] = Q + (long)min(r, qmax - 1) * ldq + lc;
    rp[i] = *(const u32x4*)(pp[i]);
    rq[i] = *(const u32x4*)(qp[i]);
  }
  const int nk = K >> 6;
  for (int kt = 0; kt < nk; kt++) {
    bfr* Ps = sm + (kt & 1) * (2 * 128 * LDT);
    bfr* Qs = Ps + 128 * LDT;
#pragma unroll
    for (int i = 0; i < 4; i++) {
      *(u32x4*)(Ps + (lr + 32 * i) * LDT + lc) = rp[i];
      *(u32x4*)(Qs + (lr + 32 * i) * LDT + lc) = rq[i];
    }
    __syncthreads();
    if (kt + 1 < nk) {
#pragma unroll
      for (int i = 0; i < 4; i++) {
        rp[i] = *(const u32x4*)(pp[i] + (kt + 1) * 64);
        rq[i] = *(const u32x4*)(qp[i] + (kt + 1) * 64);
      }
    }
#pragma unroll
    for (int kk = 0; kk < 2; kk++) {
      bf16x8 pf[4], qf[4];
#pragma unroll
      for (int m = 0; m < 4; m++) {
        pf[m] = *(const bf16x8*)(Ps + (wr * 64 + m * 16 + (lane & 15)) * LDT + kk * 32 + (lane >> 4) * 8);
        qf[m] = *(const bf16x8*)(Qs + (wc * 64 + m * 16 + (lane & 15)) * LDT + kk * 32 + (lane >> 4) * 8);
      }
#pragma unroll
      for (int m = 0; m < 4; m++)
#pragma unroll
        for (int n = 0; n < 4; n++) acc[m][n] = mfma16(pf[m], qf[n], acc[m][n]);
    }
  }
  __syncthreads();
}

__device__ __forceinline__ void phase_s0(const Params& p, bfr* sm) {
  const int tid = TIDX;
  float* rope = (float*)(p.ws + WS_ROPE);
  for (int idx = blockIdx.x * 256 + tid; idx < 1536; idx += gridDim.x * 256) {
    if (idx < 1024) {
      int pos = idx >> 4, i = idx & 15;
      float fr = powf(10000.f, -(float)i / 16.f);
      float a = (float)pos * fr;
      rope[idx] = cosf(a);
      rope[1024 + idx] = sinf(a);
    } else {
      int j = idx - 1024;
      int pos = j >> 3, i = j & 7;
      float fr = powf(10000.f, -(float)i / 8.f);
      float a = (float)pos * fr;
      rope[2048 + j] = cosf(a);
      rope[2560 + j] = sinf(a);
    }
  }
  float* smf = (float*)sm;
  float* modp = (float*)(p.ws + WS_MODP);
  for (int it = blockIdx.x; it < 768; it += gridDim.x) {
    int l = it / 384, rem = it % 384, cgp = rem >> 3, ks = rem & 7;
    int col = cgp * 64 + (tid & 63), kq = tid >> 6;
    const float* w = p.in[10] + (long)l * 1024 * 3072 + col;
    float a0 = 0.f, a1 = 0.f, a2 = 0.f;
    int k0 = ks * 128 + kq * 32;
#pragma unroll 8
    for (int k = k0; k < k0 + 32; k++) {
      float wv = w[(long)k * 3072];
      a0 += siluf(p.in[9][k]) * wv;
      a1 += siluf(p.in[8][k]) * wv;
      a2 += siluf(p.in[8][1024 + k]) * wv;
    }
    smf[(kq * 3 + 0) * 64 + (tid & 63)] = a0;
    smf[(kq * 3 + 1) * 64 + (tid & 63)] = a1;
    smf[(kq * 3 + 2) * 64 + (tid & 63)] = a2;
    __syncthreads();
    if (tid < 192) {
      int c = tid >> 6, cc = tid & 63;
      float s = smf[(0 * 3 + c) * 64 + cc] + smf[(1 * 3 + c) * 64 + cc] + smf[(2 * 3 + c) * 64 + cc] + smf[(3 * 3 + c) * 64 + cc];
      modp[((ks * 2 + l) * 3 + c) * 3072 + cgp * 64 + cc] = s;
    }
    __syncthreads();
  }
}

__device__ __forceinline__ void phase_s1(const Params& p) {
  float* modp = (float*)(p.ws + WS_MODP);
  float* mod = (float*)(p.ws + WS_MOD);
  for (int idx = blockIdx.x * 256 + TIDX; idx < 2 * 3 * 3072; idx += gridDim.x * 256) {
    int l = idx / 9216, n = idx % 3072;
    float s = p.in[11][l * 3072 + n];
#pragma unroll
    for (int ks = 0; ks < 8; ks++) s += modp[ks * 18432 + idx];
    mod[idx] = s;
  }
}

__device__ __forceinline__ void wconv_tile(const float* __restrict__ src, int K, int N, bfr* __restrict__ dst,
                                           int tk, int tn, float* smf) {
  const int tid = TIDX;
  const int n = tid & 63, kb = tid >> 6;
#pragma unroll
  for (int i = 0; i < 16; i++) {
    int k = kb + 4 * i;
    smf[k * 65 + n] = src[(long)(tk * 64 + k) * N + tn * 64 + n];
  }
  __syncthreads();
#pragma unroll
  for (int i = 0; i < 16; i++) {
    int idx = tid + 256 * i;
    int nn = idx >> 6, k = idx & 63;
    dst[(long)(tn * 64 + nn) * K + tk * 64 + k] = f2bf(smf[k * 65 + nn]);
  }
  __syncthreads();
}

#define WCONV_ITEMS 2456
__device__ __forceinline__ void wconv_phase(const Params& p, int l, bfr* sm) {
  float* smf = (float*)sm;
  for (int item0 = blockIdx.x; item0 < WCONV_ITEMS; item0 += gridDim.x) {
    int item = item0;
    const float* src;
    bfr* dst;
    int K, N, tk, tn;
    if (item < 1744) {
      src = p.in[14] + (long)l * 1024 * 6976; K = 1024; N = 6976; dst = (bfr*)(p.ws + WS_WIN); tk = item & 15; tn = item >> 4;
    } else if (item < 1768) {
      item -= 1744;
      src = p.in[24] + (long)l * 256 * 384; K = 256; N = 384; dst = (bfr*)(p.ws + WS_WUQ); tk = item & 3; tn = item >> 2;
    } else if (item < 1816) {
      item -= 1768;
      src = p.in[25] + (long)l * 256 * 768; K = 256; N = 768; dst = (bfr*)(p.ws + WS_WUKV); tk = item & 3; tn = item >> 2;
    } else if (item < 2200) {
      item -= 1816;
      int w = item >> 7, it = item & 127;
      src = (w == 0 ? p.in[26] : (w == 1 ? p.in[27] : p.in[28])) + (long)l * 512 * 1024;
      K = 512; N = 1024; dst = (bfr*)(p.ws + WS_WOA + (unsigned long)w * 1048576ul); tk = it & 7; tn = it >> 3;
    } else {
      item -= 2200;
      src = p.in[29] + (long)l * 1024 * 1024; K = 1024; N = 1024; dst = (bfr*)(p.ws + WS_WOUT); tk = item & 15; tn = item >> 4;
    }
    wconv_tile(src, K, N, dst, tk, tn, smf);
  }
}

__device__ __forceinline__ void phase_prenorm0(const Params& p) {
  const int lane = TIDX & 63;
  const float* mod = (const float*)(p.ws + WS_MOD);
  bfr* H = (bfr*)(p.ws + WS_R1);
  for (int row = blockIdx.x * 4 + (TIDX >> 6); row < NROWS; row += gridDim.x * 4) {
    const float* x = xrow(p, row);
    const float* md = mod + (0 * 3 + row_cond(row)) * 3072;
    float4 v[4];
    float ss = 0.f;
#pragma unroll
    for (int i = 0; i < 4; i++) {
      v[i] = *(const float4*)(x + i * 256 + lane * 4);
      ss += v[i].x * v[i].x + v[i].y * v[i].y + v[i].z * v[i].z + v[i].w * v[i].w;
    }
    ss = wave_sum(ss);
    float rs = rsqrtf(ss * (1.f / 1024.f) + 1e-6f);
#pragma unroll
    for (int i = 0; i < 4; i++) {
      int n = i * 256 + lane * 4;
      float4 g = *(const float4*)(p.in[12] + n);
      float4 sh = *(const float4*)(md + n);
      float4 sc = *(const float4*)(md + 1024 + n);
      float h0 = v[i].x * rs * g.x * (1.f + sc.x) + sh.x;
      float h1 = v[i].y * rs * g.y * (1.f + sc.y) + sh.y;
      float h2 = v[i].z * rs * g.z * (1.f + sc.z) + sh.z;
      float h3 = v[i].w * rs * g.w * (1.f + sc.w) + sh.w;
      u32x2 o;
      o.x = pack2(h0, h1);
      o.y = pack2(h2, h3);
      *(u32x2*)(H + (long)row * 1024 + n) = o;
    }
  }
}

__device__ __forceinline__ void phase_inproj(const Params& p, bfr* sm) {
  const bfr* H = (const bfr*)(p.ws + WS_R1);
  const bfr* W = (const bfr*)(p.ws + WS_WIN);
  bfr* Z = (bfr*)(p.ws + WS_Z);
  const int lane = TIDX & 63, wid = TIDX >> 6, wr = wid >> 1, wc = wid & 1;
  for (int t = blockIdx.x; t < 96 * 55; t += gridDim.x) {
    int tn = t % 55, tm = t / 55;
    f32x4 acc[4][4];
#pragma unroll
    for (int a = 0; a < 4; a++)
#pragma unroll
      for (int b = 0; b < 4; b++) acc[a][b] = (f32x4){0.f, 0.f, 0.f, 0.f};
    gemm128(W + (long)tn * 128 * 1024, 1024, ZLD - tn * 128, H + (long)tm * 128 * 1024, 1024, 128, 1024, acc, sm);
#pragma unroll
    for (int pi = 0; pi < 4; pi++) {
      int n0 = tn * 128 + wr * 64 + pi * 16 + (lane >> 4) * 4;
      if (n0 < ZLD) {
#pragma unroll
        for (int qi = 0; qi < 4; qi++) {
          int tok = tm * 128 + wc * 64 + qi * 16 + (lane & 15);
          u32x2 o;
          o.x = pack2(acc[pi][qi][0], acc[pi][qi][1]);
          o.y = pack2(acc[pi][qi][2], acc[pi][qi][3]);
          *(u32x2*)(Z + (long)tok * ZLD + n0) = o;
        }
      }
    }
  }
}

__device__ __forceinline__ void unpack8(u32x4 v, float* x) {
  x[0] = lo16(v.x); x[1] = hi16(v.x); x[2] = lo16(v.y); x[3] = hi16(v.y);
  x[4] = lo16(v.z); x[5] = hi16(v.z); x[6] = lo16(v.w); x[7] = hi16(v.w);
}
__device__ __forceinline__ u32x4 pack8(const float* y) {
  u32x4 o;
  o.x = pack2(y[0], y[1]); o.y = pack2(y[2], y[3]); o.z = pack2(y[4], y[5]); o.w = pack2(y[6], y[7]);
  return o;
}

__device__ __forceinline__ void phase_rowpost(const Params& p, int l) {
  const int lane = TIDX & 63;
  bfr* Z = (bfr*)(p.ws + WS_Z);
  const float* rope = (const float*)(p.ws + WS_ROPE);
  bfr* VTA = (bfr*)(p.ws + WS_VTA);
  bfr* KCA = (bfr*)(p.ws + WS_KCA);
  bfr* CKVC = (bfr*)(p.ws + WS_CKVC);
  bfr* KRC = (bfr*)(p.ws + WS_KRC);
  float* out = p.out;
  for (int row = blockIdx.x * 4 + (TIDX >> 6); row < NROWS + 1024; row += gridDim.x * 4) {
    if (row < NROWS) {
      const bool lat = row >= NCTX;
      const int bc = row >> 8, tc = row & 255;
      const int bl = (row - NCTX) >> 12, tl = (row - NCTX) & 4095;
      const int prow = tl >> 6, pcol = tl & 63;
      bfr* z = Z + (long)row * ZLD;
      {
        float x[8];
        unpack8(*(const u32x4*)(z + C_QA + lane * 8), x);
        float ss = 0.f;
#pragma unroll
        for (int e = 0; e < 8; e++) ss += x[e] * x[e];
        ss += __shfl_xor(ss, 1); ss += __shfl_xor(ss, 2); ss += __shfl_xor(ss, 4);
        float rs = rsqrtf(ss * (1.f / 64.f) + 1e-6f);
        int sub = lane & 7;
        const float* g = p.in[15] + l * 64 + sub * 8;
#pragma unroll
        for (int e = 0; e < 8; e++) x[e] = x[e] * rs * g[e];
        if (lat) {
          int pos = (sub >> 2) ? pcol : prow;
          bool hi = (sub & 2) != 0;
          int i0 = (sub & 1) * 8;
#pragma unroll
          for (int e = 0; e < 8; e++) {
            float yp = __shfl_xor(x[e], 2);
            float c = rope[pos * 16 + i0 + e], s = rope[1024 + pos * 16 + i0 + e];
            x[e] = hi ? (yp * s + x[e] * c) : (x[e] * c - yp * s);
          }
        }
        const float qs = 0.125f * 1.4426950408889634f;
#pragma unroll
        for (int e = 0; e < 8; e++) x[e] *= qs;
        *(u32x4*)(z + C_QA + lane * 8) = pack8(x);
      }
      {
        int L = lane & 15;
        float x[8];
        unpack8(*(const u32x4*)(z + C_KA + L * 8), x);
        float ss = 0.f;
#pragma unroll
        for (int e = 0; e < 8; e++) ss += x[e] * x[e];
        ss += __shfl_xor(ss, 1); ss += __shfl_xor(ss, 2); ss += __shfl_xor(ss, 4);
        float rs = rsqrtf(ss * (1.f / 64.f) + 1e-6f);
        int sub = L & 7;
        const float* g = p.in[16] + l * 64 + sub * 8;
#pragma unroll
        for (int e = 0; e < 8; e++) x[e] = x[e] * rs * g[e];
        if (lat) {
          int pos = (sub >> 2) ? pcol : prow;
          bool hi = (sub & 2) != 0;
          int i0 = (sub & 1) * 8;
#pragma unroll
          for (int e = 0; e < 8; e++) {
            float yp = __shfl_xor(x[e], 2);
            float c = rope[pos * 16 + i0 + e], s = rope[1024 + pos * 16 + i0 + e];
            x[e] = hi ? (yp * s + x[e] * c) : (x[e] * c - yp * s);
          }
        } else if (lane < 16) {
          float* o = out + O_GK + ((long)(bc * 2 + l) * 256 + tc) * 128 + L * 8;
          *(float4*)(o) = make_float4(x[0], x[1], x[2], x[3]);
          *(float4*)(o + 4) = make_float4(x[4], x[5], x[6], x[7]);
        }
        if (lane < 16) *(u32x4*)(z + C_KA + L * 8) = pack8(x);
      }
      if (lane < 16) {
        int L = lane;
        u32x4 raw = *(const u32x4*)(z + C_VA + L * 8);
        float x[8];
        unpack8(raw, x);
        if (!lat) {
          float* o = out + O_GV + ((long)(bc * 2 + l) * 256 + tc) * 128 + L * 8;
          *(float4*)(o) = make_float4(x[0], x[1], x[2], x[3]);
          *(float4*)(o + 4) = make_float4(x[4], x[5], x[6], x[7]);
        }
        int g = L >> 3, d0 = (L & 7) * 8;
        long base; int nk, key;
        if (!lat) { base = (long)bc * 32768; nk = 256; key = tc; }
        else { base = 16l * 32768 + (long)bl * (2 * 64 * 4608); nk = 4608; key = 512 + tl; }
        const bfr* rb = (const bfr*)&raw;
#pragma unroll
        for (int e = 0; e < 8; e++) VTA[base + (long)(g * 64 + d0 + e) * nk + key] = rb[e];
      }
      {
        u32x2 rq = *(const u32x2*)(z + C_QL + lane * 4);
        u32x2 rk = *(const u32x2*)(z + C_KV + lane * 4);
        float q[4] = {lo16(rq.x), hi16(rq.x), lo16(rq.y), hi16(rq.y)};
        float k[4] = {lo16(rk.x), hi16(rk.x), lo16(rk.y), hi16(rk.y)};
        float sq = q[0] * q[0] + q[1] * q[1] + q[2] * q[2] + q[3] * q[3];
        float sk = k[0] * k[0] + k[1] * k[1] + k[2] * k[2] + k[3] * k[3];
        sq = wave_sum(sq);
        sk = wave_sum(sk);
        float rq_ = rsqrtf(sq * (1.f / 256.f) + 1e-6f), rk_ = rsqrtf(sk * (1.f / 256.f) + 1e-6f);
        float4 gq = *(const float4*)(p.in[22] + l * 256 + lane * 4);
        float4 gk = *(const float4*)(p.in[23] + l * 256 + lane * 4);
        q[0] *= rq_ * gq.x; q[1] *= rq_ * gq.y; q[2] *= rq_ * gq.z; q[3] *= rq_ * gq.w;
        k[0] *= rk_ * gk.x; k[1] *= rk_ * gk.y; k[2] *= rk_ * gk.z; k[3] *= rk_ * gk.w;
        u32x2 o;
        o.x = pack2(q[0], q[1]); o.y = pack2(q[2], q[3]);
        *(u32x2*)(z + C_QL + lane * 4) = o;
        o.x = pack2(k[0], k[1]); o.y = pack2(k[2], k[3]);
        *(u32x2*)(z + C_KV + lane * 4) = o;
        if (!lat) *(float4*)(out + O_CKV + ((long)(bc * 2 + l) * 256 + tc) * 256 + lane * 4) = make_float4(k[0], k[1], k[2], k[3]);
      }
      {
        int L = lane & 3;
        float x[8];
        unpack8(*(const u32x4*)(z + C_KR + L * 8), x);
        if (lat) {
          int pos = (L >> 1) ? pcol : prow;
          bool hi = (L & 1) != 0;
#pragma unroll
          for (int e = 0; e < 8; e++) {
            float yp = __shfl_xor(x[e], 1);
            float c = rope[2048 + pos * 8 + e], s = rope[2560 + pos * 8 + e];
            x[e] = hi ? (yp * s + x[e] * c) : (x[e] * c - yp * s);
          }
          if (lane < 4) *(u32x4*)(z + C_KR + L * 8) = pack8(x);
        } else if (lane < 4) {
          float* o = out + O_KR + ((long)(bc * 2 + l) * 256 + tc) * 32 + L * 8;
          *(float4*)(o) = make_float4(x[0], x[1], x[2], x[3]);
          *(float4*)(o + 4) = make_float4(x[4], x[5], x[6], x[7]);
        }
      }
    } else {
      int cr = row - NROWS;
      int b = cr >> 9, t = cr & 511;
      long src = (long)(b * 2 + l) * 512 + t;
      {
        float2 kv = *(const float2*)(p.in[2] + src * 128 + lane * 2);
        *(unsigned*)(KCA + (long)(b * 512 + t) * 128 + lane * 2) = pack2(kv.x, kv.y);
        float2 vv = *(const float2*)(p.in[3] + src * 128 + lane * 2);
        int c0 = lane * 2;
        long base = 16l * 32768 + (long)b * (2 * 64 * 4608);
        VTA[base + (long)c0 * 4608 + t] = f2bf(vv.x);
        VTA[base + (long)(c0 + 1) * 4608 + t] = f2bf(vv.y);
        float4 cv = *(const float4*)(p.in[4] + src * 256 + lane * 4);
        u32x2 o;
        o.x = pack2(cv.x, cv.y); o.y = pack2(cv.z, cv.w);
        *(u32x2*)(CKVC + (long)(b * 512 + t) * 256 + lane * 4) = o;
        if (lane < 32) KRC[(long)(b * 512 + t) * 32 + lane] = f2bf(p.in[5][src * 32 + lane]);
      }
    }
  }
}

#define WS_PREP1 251703296ul
#define WS_EL (WS_WIN + 12582912ul)
__device__ __forceinline__ bfr* prep_base(const Params& p, int b, int h, int dir, int c) {
  return (bfr*)(p.ws + (b ? WS_PREP1 : WS_WIN)) + (long)((h * 2 + dir) * 64 + c) * 12288;
}

__device__ __forceinline__ void gla_chunk_prep(int tid, const float (&wd)[16], float bias, const bfr* Qr, const bfr* Kr,
                                               bfr* Qe, bfr* Ke, bfr* KlT, const float* RF, float* tot, float* lastv) {
  const int ch = tid & 63, part = tid >> 6;
  float cum[16];
  {
    float run = 0.f;
#pragma unroll
    for (int ii = 0; ii < 16; ii++) {
      int i = part * 16 + ii;
      float x = bias;
#pragma unroll
      for (int r = 0; r < 16; r++) x += RF[i * 16 + r] * wd[r];
      float la = (fminf(x, 0.f) - __logf(1.f + __expf(-fabsf(x)))) * (1.f / 16.f);
      run += la;
      cum[ii] = run;
    }
    tot[part * 64 + ch] = run;
  }
  __syncthreads();
  {
    float off = 0.f, last = 0.f;
#pragma unroll
    for (int pp = 0; pp < 4; pp++) {
      float tv = tot[pp * 64 + ch];
      if (pp < part) off += tv;
      last += tv;
    }
    if (part == 0) lastv[ch] = last;
#pragma unroll
    for (int ii = 0; ii < 16; ii++) {
      int i = part * 16 + ii;
      float cc = cum[ii] + off;
      float qv = bf2f(Qr[i * LDT + ch]), kv = bf2f(Kr[i * LDT + ch]);
      Qe[i * LDT + ch] = f2bf(qv * __expf(cc) * 0.125f);
      Ke[i * LDT + ch] = f2bf(kv * __expf(-cc));
      KlT[ch * LDT + i] = f2bf(kv * __expf(last - cc));
    }
  }
  __syncthreads();
}

__device__ __forceinline__ void gla_att(int wid, int g, int l15, const bfr* Qe, const bfr* Ke, bfr* Att) {
  f32x4 att[4];
  bf16x8 qa[2];
#pragma unroll
  for (int kk = 0; kk < 2; kk++) qa[kk] = *(const bf16x8*)(Qe + (16 * wid + l15) * LDT + kk * 32 + g * 8);
#pragma unroll
  for (int nj = 0; nj < 4; nj++) {
    att[nj] = (f32x4){0.f, 0.f, 0.f, 0.f};
#pragma unroll
    for (int kk = 0; kk < 2; kk++) {
      bf16x8 kb = *(const bf16x8*)(Ke + (16 * nj + l15) * LDT + kk * 32 + g * 8);
      att[nj] = mfma16(qa[kk], kb, att[nj]);
    }
  }
#pragma unroll
  for (int nj = 0; nj < 4; nj++)
#pragma unroll
    for (int r = 0; r < 4; r++) {
      int i = 16 * wid + 4 * g + r, j = 16 * nj + l15;
      Att[i * LDT + j] = f2bf(i >= j ? att[nj][r] : 0.f);
    }
}

__device__ __forceinline__ void gla_prep_item(const Params& p, int l, int b, int h, int dir, int c, bfr* sm) {
  const int tid = TIDX, lane = tid & 63, wid = tid >> 6, g = lane >> 4, l15 = lane & 15;
  const bfr* Z = (const bfr*)(p.ws + WS_Z);
  const int N = 4096;
  const int rowbase = NCTX + b * 4096;
  bfr* Qr = sm;
  bfr* Kr = Qr + 64 * LDT;
  bfr* Qe = Kr + 64 * LDT;
  bfr* Ke = Qe + 64 * LDT;
  bfr* KlT = Ke + 64 * LDT;
  float* RF = (float*)(KlT + 64 * LDT);
  float* tot = RF + 64 * 16;
  float* lastv = tot + 256;
  bfr* Att = Qr;
  const int ch = tid & 63;
  float wd[16];
  {
    const float* W = (dir ? p.in[19] : p.in[17]) + (long)l * 16 * 256 + h * 64 + ch;
#pragma unroll
    for (int r = 0; r < 16; r++) wd[r] = W[r * 256];
  }
  const float bias = (dir ? p.in[20] : p.in[18])[l * 256 + h * 64 + ch];
#pragma unroll
  for (int ii = 0; ii < 2; ii++) {
    int cc = tid + 256 * ii;
    int i = cc >> 3, c8 = cc & 7;
    int tok = dir ? (N - 1 - (c * 64 + i)) : (c * 64 + i);
    const bfr* zr = Z + (long)(rowbase + tok) * ZLD;
    *(u32x4*)(Qr + i * LDT + c8 * 8) = *(const u32x4*)(zr + C_QG + h * 64 + c8 * 8);
    *(u32x4*)(Kr + i * LDT + c8 * 8) = *(const u32x4*)(zr + C_KG + h * 64 + c8 * 8);
  }
  if (tid < 128) {
    int i = tid >> 1, hf = tid & 1;
    int tok = dir ? (N - 1 - (c * 64 + i)) : (c * 64 + i);
    u32x4 rr = *(const u32x4*)(Z + (long)(rowbase + tok) * ZLD + (dir ? C_RB : C_RF) + hf * 8);
    float x[8];
    unpack8(rr, x);
#pragma unroll
    for (int e = 0; e < 8; e++) RF[i * 16 + hf * 8 + e] = x[e];
  }
  __syncthreads();
  gla_chunk_prep(tid, wd, bias, Qr, Kr, Qe, Ke, KlT, RF, tot, lastv);
  gla_att(wid, g, l15, Qe, Ke, Att);
  __syncthreads();
  bfr* dst = prep_base(p, b, h, dir, c);
#pragma unroll
  for (int ii = 0; ii < 2; ii++) {
    int cc = tid + 256 * ii;
    int i = cc >> 3, c8 = cc & 7;
    *(u32x4*)(dst + i * 64 + c8 * 8) = *(const u32x4*)(Qe + i * LDT + c8 * 8);
    *(u32x4*)(dst + 4096 + i * 64 + c8 * 8) = *(const u32x4*)(KlT + i * LDT + c8 * 8);
    *(u32x4*)(dst + 8192 + i * 64 + c8 * 8) = *(const u32x4*)(Att + i * LDT + c8 * 8);
  }
  if (tid < 64) ((float*)(p.ws + WS_EL))[((long)(((b * 4 + h) * 2 + dir) * 64 + c)) * 64 + tid] = __expf(lastv[tid]);
  __syncthreads();
}

__device__ __forceinline__ void gla_chain_item(const Params& p, int l, int b, int h, int dir, int vh, bfr* sm) {
  const int tid = TIDX, lane = tid & 63, wid = tid >> 6, g = lane >> 4, l15 = lane & 15;
  const bfr* Z = (const bfr*)(p.ws + WS_Z);
  bfr* OG = (bfr*)(p.ws + WS_R1) + (long)dir * NROWS * 512;
  const float* EL = (const float*)(p.ws + WS_EL) + (long)(((b * 4 + h) * 2 + dir) * 64) * 64;
  const int N = 4096, nc = 64;
  const int rowbase = NCTX + b * 4096;
  const int vs0 = vh * 64;
  bfr* Vt = sm;
  bfr* St = Vt + 64 * LDT;
  f32x4 st[4];
  {
    const float* S0 = (dir ? p.in[7] : p.in[6]) + ((long)((b * 2 + l) * 4 + h)) * 8192 + (long)(16 * wid + l15) * 128 + vs0;
#pragma unroll
    for (int vt = 0; vt < 4; vt++) {
      float4 a = *(const float4*)(S0 + 16 * vt + 4 * g);
      st[vt] = (f32x4){a.x, a.y, a.z, a.w};
#pragma unroll
      for (int r = 0; r < 4; r++) St[(16 * vt + 4 * g + r) * LDT + 16 * wid + l15] = f2bf(st[vt][r]);
    }
  }
  u32x4 n_qe[2], n_kl[2], n_at[2], n_v[2];
  float n_el;
  auto prefetch = [&](int c) {
    const bfr* base = prep_base(p, b, h, dir, c) + (16 * wid + l15) * 64 + 8 * g;
#pragma unroll
    for (int kk = 0; kk < 2; kk++) {
      n_qe[kk] = *(const u32x4*)(base + kk * 32);
      n_kl[kk] = *(const u32x4*)(base + 4096 + kk * 32);
      n_at[kk] = *(const u32x4*)(base + 8192 + kk * 32);
    }
    n_el = EL[c * 64 + 16 * wid + l15];
#pragma unroll
    for (int ii = 0; ii < 2; ii++) {
      int cc = tid + 256 * ii;
      int i = cc >> 3, c8 = cc & 7;
      int tok = dir ? (N - 1 - (c * 64 + i)) : (c * 64 + i);
      n_v[ii] = *(const u32x4*)(Z + (long)(rowbase + tok) * ZLD + C_VG + h * 128 + vs0 + c8 * 8);
    }
  };
  prefetch(0);
  for (int c = 0; c < nc; c++) {
    u32x4 c_qe[2] = {n_qe[0], n_qe[1]}, c_kl[2] = {n_kl[0], n_kl[1]}, c_at[2] = {n_at[0], n_at[1]};
    const float el = n_el;
#pragma unroll
    for (int ii = 0; ii < 2; ii++) {
      int cc = tid + 256 * ii;
      int i = cc >> 3, c8 = cc & 7;
      const bfr* rb = (const bfr*)&n_v[ii];
#pragma unroll
      for (int e = 0; e < 8; e++) Vt[(c8 * 8 + e) * LDT + i] = rb[e];
    }
    __syncthreads();
    if (c + 1 < nc) prefetch(c + 1);
    f32x4 stn[4];
    const int i = 16 * wid + l15;
    const int tok = dir ? (N - 1 - (c * 64 + i)) : (c * 64 + i);
    bfr* og = OG + (long)(rowbase + tok) * 512 + h * 128 + vs0 + 4 * g;
#pragma unroll
    for (int vt = 0; vt < 4; vt++) {
      f32x4 oc = (f32x4){0.f, 0.f, 0.f, 0.f};
      stn[vt] = st[vt] * el;
#pragma unroll
      for (int kk = 0; kk < 2; kk++) {
        bf16x8 vf = *(const bf16x8*)(Vt + (16 * vt + l15) * LDT + kk * 32 + g * 8);
        bf16x8 sf = *(const bf16x8*)(St + (16 * vt + l15) * LDT + kk * 32 + g * 8);
        oc = mfma16(vf, *(bf16x8*)&c_at[kk], oc);
        oc = mfma16(sf, *(bf16x8*)&c_qe[kk], oc);
        stn[vt] = mfma16(vf, *(bf16x8*)&c_kl[kk], stn[vt]);
      }
      u32x2 ov;
      ov.x = pack2(oc[0], oc[1]);
      ov.y = pack2(oc[2], oc[3]);
      *(u32x2*)(og + 16 * vt) = ov;
    }
    __syncthreads();
#pragma unroll
    for (int vt = 0; vt < 4; vt++) {
      st[vt] = stn[vt];
#pragma unroll
      for (int r = 0; r < 4; r++) St[(16 * vt + 4 * g + r) * LDT + 16 * wid + l15] = f2bf(st[vt][r]);
    }
  }
  __syncthreads();
}

template <int VS>
__device__ __forceinline__ void gla_item(const Params& p, int l, int seq, int h, int dir, int vsl, bfr* sm) {
  constexpr int NVT = VS / 16;
  constexpr int NVL = VS / 32;
  const int tid = TIDX, lane = tid & 63, wid = tid >> 6, g = lane >> 4, l15 = lane & 15;
  bfr* Z = (bfr*)(p.ws + WS_Z);
  bfr* OG = (bfr*)(p.ws + WS_R1) + (long)dir * NROWS * 512;
  const bool lat = seq >= 16;
  const int b = seq - 16;
  const int N = lat ? 4096 : 256;
  const int rowbase = lat ? NCTX + b * 4096 : seq * 256;
  const int nc = N >> 6;
  const int vs0 = vsl * VS;
  bfr* Qr = sm;
  bfr* Kr = Qr + 64 * LDT;
  bfr* Qe = Kr + 64 * LDT;
  bfr* Ke = Qe + 64 * LDT;
  bfr* KlT = Ke + 64 * LDT;
  float* RF = (float*)(KlT + 64 * LDT);
  float* tot = RF + 64 * 16;
  float* lastv = tot + 256;
  bfr* Vt = (bfr*)(lastv + 64);
  bfr* St = Vt + VS * LDT;
  bfr* Att = Qr;
  const int ch = tid & 63;
  float wd[16];
  {
    const float* W = (dir ? p.in[19] : p.in[17]) + (long)l * 16 * 256 + h * 64 + ch;
#pragma unroll
    for (int r = 0; r < 16; r++) wd[r] = W[r * 256];
  }
  const float bias = (dir ? p.in[20] : p.in[18])[l * 256 + h * 64 + ch];

  f32x4 st[NVT];
  {
    const float* S0 = (dir ? p.in[7] : p.in[6]) + ((long)((b * 2 + l) * 4 + h)) * 8192 + (long)(16 * wid + l15) * 128 + vs0;
#pragma unroll
    for (int mv = 0; mv < NVT; mv++) {
      if (lat) {
        float4 a = *(const float4*)(S0 + 16 * mv + 4 * g);
        st[mv] = (f32x4){a.x, a.y, a.z, a.w};
      } else {
        st[mv] = (f32x4){0.f, 0.f, 0.f, 0.f};
      }
#pragma unroll
      for (int r = 0; r < 4; r++) St[(16 * mv + 4 * g + r) * LDT + 16 * wid + l15] = f2bf(st[mv][r]);
    }
  }
  u32x4 rq[2], rk[2], rv[NVL], rr;
  auto prefetch = [&](int c) {
#pragma unroll
    for (int ii = 0; ii < 2; ii++) {
      int cc = tid + 256 * ii;
      int i = cc >> 3, c8 = cc & 7;
      int tok = dir ? (N - 1 - (c * 64 + i)) : (c * 64 + i);
      const bfr* zr = Z + (long)(rowbase + tok) * ZLD;
      rq[ii] = *(const u32x4*)(zr + C_QG + h * 64 + c8 * 8);
      rk[ii] = *(const u32x4*)(zr + C_KG + h * 64 + c8 * 8);
    }
#pragma unroll
    for (int ii = 0; ii < NVL; ii++) {
      int cc = tid + 256 * ii;
      int i = cc / (VS / 8), c4 = cc % (VS / 8);
      int tok = dir ? (N - 1 - (c * 64 + i)) : (c * 64 + i);
      rv[ii] = *(const u32x4*)(Z + (long)(rowbase + tok) * ZLD + C_VG + h * 128 + vs0 + c4 * 8);
    }
    if (tid < 128) {
      int i = tid >> 1, hf = tid & 1;
      int tok = dir ? (N - 1 - (c * 64 + i)) : (c * 64 + i);
      rr = *(const u32x4*)(Z + (long)(rowbase + tok) * ZLD + (dir ? C_RB : C_RF) + hf * 8);
    }
  };
  prefetch(0);
  for (int c = 0; c < nc; c++) {
#pragma unroll
    for (int ii = 0; ii < 2; ii++) {
      int cc = tid + 256 * ii;
      *(u32x4*)(Qr + (cc >> 3) * LDT + (cc & 7) * 8) = rq[ii];
      *(u32x4*)(Kr + (cc >> 3) * LDT + (cc & 7) * 8) = rk[ii];
    }
#pragma unroll
    for (int ii = 0; ii < NVL; ii++) {
      int cc = tid + 256 * ii;
      int i = cc / (VS / 8), c4 = cc % (VS / 8);
      const bfr* rb = (const bfr*)&rv[ii];
#pragma unroll
      for (int e = 0; e < 8; e++) Vt[(c4 * 8 + e) * LDT + i] = rb[e];
    }
    if (tid < 128) {
      int i = tid >> 1, hf = tid & 1;
      float x[8];
      unpack8(rr, x);
#pragma unroll
      for (int e = 0; e < 8; e++) RF[i * 16 + hf * 8 + e] = x[e];
    }
    __syncthreads();
    if (c + 1 < nc) prefetch(c + 1);
    gla_chunk_prep(tid, wd, bias, Qr, Kr, Qe, Ke, KlT, RF, tot, lastv);
    f32x4 stn[NVT];
    {
      float el = __expf(lastv[16 * wid + l15]);
#pragma unroll
      for (int mv = 0; mv < NVT; mv++) {
        stn[mv] = st[mv] * el;
#pragma unroll
        for (int kk = 0; kk < 2; kk++) {
          bf16x8 va = *(const bf16x8*)(Vt + (16 * mv + l15) * LDT + kk * 32 + g * 8);
          bf16x8 kb = *(const bf16x8*)(KlT + (16 * wid + l15) * LDT + kk * 32 + g * 8);
          stn[mv] = mfma16(va, kb, stn[mv]);
        }
      }
      gla_att(wid, g, l15, Qe, Ke, Att);
    }
    __syncthreads();
    {
      bf16x8 aa[2], qa[2];
#pragma unroll
      for (int kk = 0; kk < 2; kk++) {
        aa[kk] = *(const bf16x8*)(Att + (16 * wid + l15) * LDT + kk * 32 + g * 8);
        qa[kk] = *(const bf16x8*)(Qe + (16 * wid + l15) * LDT + kk * 32 + g * 8);
      }
#pragma unroll
      for (int nv = 0; nv < NVT; nv++) {
        f32x4 oc = (f32x4){0.f, 0.f, 0.f, 0.f};
#pragma unroll
        for (int kk = 0; kk < 2; kk++) {
          bf16x8 vb = *(const bf16x8*)(Vt + (16 * nv + l15) * LDT + kk * 32 + g * 8);
          oc = mfma16(aa[kk], vb, oc);
          bf16x8 sb = *(const bf16x8*)(St + (16 * nv + l15) * LDT + kk * 32 + g * 8);
          oc = mfma16(qa[kk], sb, oc);
        }
#pragma unroll
        for (int r = 0; r < 4; r++) {
          int i = 16 * wid + 4 * g + r;
          int tok = dir ? (N - 1 - (c * 64 + i)) : (c * 64 + i);
          OG[(long)(rowbase + tok) * 512 + h * 128 + vs0 + 16 * nv + l15] = f2bf(oc[r]);
        }
      }
    }
    __syncthreads();
#pragma unroll
    for (int mv = 0; mv < NVT; mv++) {
      st[mv] = stn[mv];
#pragma unroll
      for (int r = 0; r < 4; r++) St[(16 * mv + 4 * g + r) * LDT + 16 * wid + l15] = f2bf(st[mv][r]);
    }
  }
  __syncthreads();
  if (!lat) {
    float* so = p.out + (dir ? O_SB : O_SF) + ((long)((seq * 2 + l) * 4 + h)) * 8192 + (long)(16 * wid + l15) * 128 + vs0;
#pragma unroll
    for (int mv = 0; mv < NVT; mv++)
      *(float4*)(so + 16 * mv + 4 * g) = make_float4(st[mv][0], st[mv][1], st[mv][2], st[mv][3]);
  }
}

__device__ __forceinline__ void phase_mla_up(const Params& p, int l, bfr* sm) {
  bfr* Z = (bfr*)(p.ws + WS_Z);
  const float* rope = (const float*)(p.ws + WS_ROPE);
  const int lane = TIDX & 63, wid = TIDX >> 6, wr = wid >> 1, wc = wid & 1;
  const int g = lane >> 4;
  for (int t = blockIdx.x; t < 288 + 624 + 1024; t += gridDim.x) {
    if (t >= 912) {
      int i = t - 912;
      gla_prep_item(p, l, i >> 9, (i >> 7) & 3, (i >> 6) & 1, i & 63, sm);
      continue;
    }
    f32x4 acc[4][4];
#pragma unroll
    for (int a = 0; a < 4; a++)
#pragma unroll
      for (int b = 0; b < 4; b++) acc[a][b] = (f32x4){0.f, 0.f, 0.f, 0.f};
    if (t < 288) {
      int tn = t % 3, tm = t / 3;
      gemm128((const bfr*)(p.ws + WS_WUQ) + (long)tn * 128 * 256, 256, 128, Z + (long)tm * 128 * ZLD + C_QL, ZLD, 128, 256,
              acc, sm);
      bfr* CQ = (bfr*)(p.ws + WS_CQ);
      const float qs = 0.10206207261596577f * 1.4426950408889634f;
#pragma unroll
      for (int pi = 0; pi < 4; pi++) {
        int nb = tn * 128 + wr * 64 + pi * 16;
        int wb = nb % 96;
        bool ropet = wb >= 64;
        int part = (wb - 64) >> 4;
#pragma unroll
        for (int qi = 0; qi < 4; qi++) {
          int tok = tm * 128 + wc * 64 + qi * 16 + (lane & 15);
          float y[4] = {acc[pi][qi][0], acc[pi][qi][1], acc[pi][qi][2], acc[pi][qi][3]};
          if (ropet) {
            bool lat = tok >= NCTX;
            int tl = (tok - NCTX) & 4095;
            int pos = part ? (tl & 63) : (tl >> 6);
            bool hi = (g & 2) != 0;
            int i0 = (g & 1) * 4;
#pragma unroll
            for (int r = 0; r < 4; r++) {
              float yp = __shfl_xor(y[r], 32);
              float c = rope[2048 + pos * 8 + i0 + r], s = rope[2560 + pos * 8 + i0 + r];
              float yr = hi ? (yp * s + y[r] * c) : (y[r] * c - yp * s);
              y[r] = lat ? yr : y[r];
            }
          }
          u32x2 o;
          o.x = pack2(y[0] * qs, y[1] * qs);
          o.y = pack2(y[2] * qs, y[3] * qs);
          *(u32x2*)(CQ + (long)tok * 384 + nb + g * 4) = o;
        }
      }
    } else {
      int t2 = t - 288;
      int tn = t2 % 6, tm = t2 / 6;
      const bfr* Q;
      long ldq;
      long kbase, vbase;
      int nk, key0;
      if (tm < 32) {
        Q = Z + (long)tm * 128 * ZLD + C_KV;
        ldq = ZLD;
        int s = tm >> 1;
        key0 = (tm & 1) * 128;
        nk = 256;
        kbase = (long)s * (4 * 256 * 64);
        vbase = (long)s * 131072;
      } else {
        int r = (tm - 32) * 128;
        int b = r / 4608, within = r % 4608;
        key0 = within;
        nk = 4608;
        kbase = 16l * (4 * 256 * 64) + (long)b * (4 * 4608 * 64);
        vbase = 16l * 131072 + (long)b * (4 * 128 * 4608);
        if (within < 512) {
          Q = (const bfr*)(p.ws + WS_CKVC) + (long)(b * 512 + within) * 256;
          ldq = 256;
        } else {
          Q = Z + (long)(NCTX + b * 4096 + within - 512) * ZLD + C_KV;
          ldq = ZLD;
        }
      }
      gemm128((const bfr*)(p.ws + WS_WUKV) + (long)tn * 128 * 256, 256, 128, Q, ldq, 128, 256, acc, sm);
      bfr* KN = (bfr*)(p.ws + WS_KNOPE);
      bfr* VTC = (bfr*)(p.ws + WS_VTC);
#pragma unroll
      for (int pi = 0; pi < 4; pi++) {
        int n0 = tn * 128 + wr * 64 + pi * 16 + g * 4;
        int head = n0 / 192, w = n0 % 192;
#pragma unroll
        for (int qi = 0; qi < 4; qi++) {
          int key = key0 + wc * 64 + qi * 16 + (lane & 15);
          if (w < 64) {
            u32x2 o;
            o.x = pack2(acc[pi][qi][0], acc[pi][qi][1]);
            o.y = pack2(acc[pi][qi][2], acc[pi][qi][3]);
            *(u32x2*)(KN + kbase + ((long)head * nk + key) * 64 + w) = o;
          } else {
#pragma unroll
            for (int r = 0; r < 4; r++)
              VTC[vbase + ((long)head * 128 + (w - 64) + r) * nk + key] = f2bf(acc[pi][qi][r]);
          }
        }
      }
    }
  }
}

template <int DQ, int DV, bool MLA>
__device__ __forceinline__ void attn_item(const Params& p, int seq, int head, int qblk, bfr* sm, int dry) {
  constexpr int KLD = DQ + 8;
  constexpr int KSZ = 64 * KLD;
  constexpr int VSZ = DV * LDT;
  constexpr int BUF = KSZ + VSZ;
  constexpr int NKK = DQ / 32;
  constexpr int NDV = DV / 16;
  constexpr int NVL = DV / 32;
  const int tid = TIDX, lane = tid & 63, wid = tid >> 6, g = lane >> 4, l15 = lane & 15;
  bfr* Z = (bfr*)(p.ws + WS_Z);
  const bool lat = seq >= 16;
  const int b = seq - 16;
  const int nk = lat ? 4608 : 256;
  const int rowbase = lat ? NCTX + b * 4096 : seq * 256;
  const int nkt = nk >> 6;

  bf16x8 qf[2][NKK];
#pragma unroll
  for (int qb = 0; qb < 2; qb++) {
    int qrow = rowbase + qblk * 128 + wid * 32 + qb * 16 + l15;
    const bfr* qp = MLA ? ((const bfr*)(p.ws + WS_CQ) + (long)qrow * 384 + head * 96) : (Z + (long)qrow * ZLD + C_QA + head * 64);
#pragma unroll
    for (int kk = 0; kk < NKK; kk++) qf[qb][kk] = *(const bf16x8*)(qp + kk * 32 + g * 8);
  }

  u32x4 rk[2], rkr, rv[NVL];
  auto prefetch = [&](int kt) {
    int k0 = kt * 64;
    bool cache = lat && (k0 < 512);
    int tokrow0 = lat ? (NCTX + b * 4096 + k0 - 512) : (seq * 256 + k0);
    if (!MLA) {
      int kvh = head >> 2;
#pragma unroll
      for (int i = 0; i < 2; i++) {
        int c = tid + 256 * i;
        int kr_ = c >> 3, ch = c & 7;
        const bfr* src = cache ? ((const bfr*)(p.ws + WS_KCA) + (long)(b * 512 + k0 + kr_) * 128 + kvh * 64 + ch * 8)
                               : (Z + (long)(tokrow0 + kr_) * ZLD + C_KA + kvh * 64 + ch * 8);
        rk[i] = *(const u32x4*)src;
      }
      long vb = lat ? (16l * 32768 + (long)b * (2 * 64 * 4608)) : ((long)seq * 32768);
#pragma unroll
      for (int i = 0; i < NVL; i++) {
        int c = tid + 256 * i;
        int dv = c >> 3, ch = c & 7;
        rv[i] = *(const u32x4*)((const bfr*)(p.ws + WS_VTA) + vb + (long)(kvh * 64 + dv) * nk + k0 + ch * 8);
      }
    } else {
      long kb = lat ? (16l * (4 * 256 * 64) + (long)b * (4 * 4608 * 64)) : ((long)seq * (4 * 256 * 64));
#pragma unroll
      for (int i = 0; i < 2; i++) {
        int c = tid + 256 * i;
        int kr_ = c >> 3, ch = c & 7;
        rk[i] = *(const u32x4*)((const bfr*)(p.ws + WS_KNOPE) + kb + ((long)head * nk + k0 + kr_) * 64 + ch * 8);
      }
      {
        int kr_ = tid >> 2, ch = tid & 3;
        const bfr* src = cache ? ((const bfr*)(p.ws + WS_KRC) + (long)(b * 512 + k0 + kr_) * 32 + ch * 8)
                               : (Z + (long)(tokrow0 + kr_) * ZLD + C_KR + ch * 8);
        rkr = *(const u32x4*)src;
      }
      long vb = lat ? (16l * 131072 + (long)b * (4 * 128 * 4608)) : ((long)seq * 131072);
#pragma unroll
      for (int i = 0; i < NVL; i++) {
        int c = tid + 256 * i;
        int dv = c >> 3, ch = c & 7;
        rv[i] = *(const u32x4*)((const bfr*)(p.ws + WS_VTC) + vb + (long)(head * 128 + dv) * nk + k0 + ch * 8);
      }
    }
  };

  f32x4 o[2][NDV];
#pragma unroll
  for (int qb = 0; qb < 2; qb++)
#pragma unroll
    for (int d = 0; d < NDV; d++) o[qb][d] = (f32x4){0.f, 0.f, 0.f, 0.f};
  float mrun[2] = {-1e30f, -1e30f}, lsum[2] = {0.f, 0.f};

  prefetch(0);
  for (int kt = 0; kt < nkt; kt++) {
    bfr* Ks = sm + (kt & 1) * BUF;
    bfr* Vs = Ks + KSZ;
#pragma unroll
    for (int i = 0; i < 2; i++) {
      int c = tid + 256 * i;
      *(u32x4*)(Ks + (c >> 3) * KLD + (c & 7) * 8) = rk[i];
    }
    if (MLA) *(u32x4*)(Ks + (tid >> 2) * KLD + 64 + (tid & 3) * 8) = rkr;
#pragma unroll
    for (int i = 0; i < NVL; i++) {
      int c = tid + 256 * i;
      *(u32x4*)(Vs + (c >> 3) * LDT + (c & 7) * 8) = rv[i];
    }
    __syncthreads();
    if (kt + 1 < nkt) prefetch(kt + 1);

    f32x4 s[2][4];
#pragma unroll
    for (int t = 0; t < 4; t++) {
      s[0][t] = (f32x4){0.f, 0.f, 0.f, 0.f};
      s[1][t] = (f32x4){0.f, 0.f, 0.f, 0.f};
      int krow = 32 * (t >> 1) + 8 * (l15 >> 2) + 4 * (t & 1) + (l15 & 3);
#pragma unroll
      for (int kk = 0; kk < NKK; kk++) {
        bf16x8 kf = *(const bf16x8*)(Ks + krow * KLD + kk * 32 + g * 8);
        s[0][t] = mfma16(kf, qf[0][kk], s[0][t]);
        s[1][t] = mfma16(kf, qf[1][kk], s[1][t]);
      }
    }
    bf16x8 pf[2][2];
#pragma unroll
    for (int qb = 0; qb < 2; qb++) {
      float mt = s[qb][0][0];
#pragma unroll
      for (int t = 0; t < 4; t++)
#pragma unroll
        for (int r = 0; r < 4; r++) mt = fmaxf(mt, s[qb][t][r]);
      mt = fmaxf(mt, __shfl_xor(mt, 16));
      mt = fmaxf(mt, __shfl_xor(mt, 32));
      float mnew = fmaxf(mrun[qb], mt);
      float alpha = __builtin_amdgcn_exp2f(mrun[qb] - mnew);
      mrun[qb] = mnew;
      float ps = 0.f;
#pragma unroll
      for (int t = 0; t < 4; t++)
#pragma unroll
        for (int r = 0; r < 4; r++) {
          float pv = __builtin_amdgcn_exp2f(s[qb][t][r] - mnew);
          ps += pv;
          s[qb][t][r] = pv;
        }
      lsum[qb] = lsum[qb] * alpha + ps;
#pragma unroll
      for (int d = 0; d < NDV; d++) {
        o[qb][d][0] *= alpha; o[qb][d][1] *= alpha; o[qb][d][2] *= alpha; o[qb][d][3] *= alpha;
      }
#pragma unroll
      for (int sx = 0; sx < 2; sx++) {
        u32x4 u;
        u.x = pack2(s[qb][2 * sx][0], s[qb][2 * sx][1]);
        u.y = pack2(s[qb][2 * sx][2], s[qb][2 * sx][3]);
        u.z = pack2(s[qb][2 * sx + 1][0], s[qb][2 * sx + 1][1]);
        u.w = pack2(s[qb][2 * sx + 1][2], s[qb][2 * sx + 1][3]);
        pf[qb][sx] = *(bf16x8*)&u;
      }
    }
#pragma unroll
    for (int d = 0; d < NDV; d++) {
#pragma unroll
      for (int sx = 0; sx < 2; sx++) {
        bf16x8 vf = *(const bf16x8*)(Vs + (d * 16 + l15) * LDT + sx * 32 + g * 8);
        o[0][d] = mfma16(vf, pf[0][sx], o[0][d]);
        o[1][d] = mfma16(vf, pf[1][sx], o[1][d]);
      }
    }
  }
  __syncthreads();
#pragma unroll
  for (int qb = 0; qb < 2; qb++) {
    float lt = lsum[qb];
    lt += __shfl_xor(lt, 16);
    lt += __shfl_xor(lt, 32);
    float inv = 1.f / lt;
    int qrow = rowbase + qblk * 128 + wid * 32 + qb * 16 + l15;
    bfr* gp = Z + (long)qrow * ZLD + (MLA ? C_GC : C_GA) + head * DV + g * 4;
#pragma unroll
    for (int d = 0; d < NDV; d++) {
      u32x2 gr = *(const u32x2*)(gp + d * 16);
      float y0 = o[qb][d][0] * inv * siluf(lo16(gr.x));
      float y1 = o[qb][d][1] * inv * siluf(hi16(gr.x));
      float y2 = o[qb][d][2] * inv * siluf(lo16(gr.y));
      float y3 = o[qb][d][3] * inv * siluf(hi16(gr.y));
      u32x2 ov;
      ov.x = pack2(y0, y1);
      ov.y = pack2(y2, y3);
      if (!dry) *(u32x2*)(gp + d * 16) = ov;
    }
  }
}

__device__ __forceinline__ void phase_mixers(const Params& p, int l, bfr* sm, int* s_item, int dry) {
  unsigned* ctr = (unsigned*)(p.ws + WS_CTR) + l + 2 * dry;
  for (;;) {
    if (TIDX == 0) *s_item = (int)atomicAdd(ctr, 1u);
    __syncthreads();
    int idx = *s_item;
    __syncthreads();
    if (idx >= 1440) break;
    int kind, a0, a1, a2, a3 = 0;
    if (idx < 32) {
      kind = 3; a0 = idx >> 4; a1 = (idx >> 2) & 3; a2 = (idx >> 1) & 1; a3 = idx & 1;
    } else if (idx < 288) {
      int i = idx - 32;
      kind = 1; a0 = 16 + (i >> 7); a1 = (i >> 5) & 3; a2 = i & 31;
    } else if (idx < 800) {
      int i = idx - 288;
      kind = 2; a0 = 16 + (i >> 8); a1 = (i >> 5) & 7; a2 = i & 31;
    } else if (idx < 1056) {
      int i = idx - 800;
      kind = 0; a0 = i >> 4; a1 = (i >> 2) & 3; a2 = (i >> 1) & 1; a3 = i & 1;
    } else if (idx < 1184) {
      int i = idx - 1056;
      kind = 1; a0 = i >> 3; a1 = (i >> 1) & 3; a2 = i & 1;
    } else {
      int i = idx - 1184;
      kind = 2; a0 = i >> 4; a1 = (i >> 1) & 7; a2 = i & 1;
    }
#ifdef PROBE_MIXKIND
    if (dry && ((PROBE_MIXKIND == 1) != (kind == 0 || kind == 3))) continue;
#endif
    if (kind == 0) gla_item<64>(p, l, a0, a1, a2, a3, sm);
    else if (kind == 3) gla_chain_item(p, l, a0, a1, a2, a3, sm);
    else if (kind == 1) attn_item<96, 128, true>(p, a0, a1, a2, sm, dry);
    else attn_item<64, 64, false>(p, a0, a1, a2, sm, dry);
  }
}

__device__ __forceinline__ void phase_gla_out(const Params& p, int l) {
  const int lane = TIDX & 63;
  bfr* Z = (bfr*)(p.ws + WS_Z);
  const bfr* OF = (const bfr*)(p.ws + WS_R1);
  const bfr* OB = OF + (long)NROWS * 512;
  for (int row = blockIdx.x * 4 + (TIDX >> 6); row < NROWS; row += gridDim.x * 4) {
    float a[8], c[8], gt[8];
    unpack8(*(const u32x4*)(OF + (long)row * 512 + lane * 8), a);
    unpack8(*(const u32x4*)(OB + (long)row * 512 + lane * 8), c);
    bfr* gp = Z + (long)row * ZLD + C_GG + lane * 8;
    unpack8(*(const u32x4*)gp, gt);
    float ss = 0.f;
#pragma unroll
    for (int e = 0; e < 8; e++) {
      a[e] = bf2f(f2bf(a[e] + c[e]));
      ss += a[e] * a[e];
    }
    ss += __shfl_xor(ss, 1); ss += __shfl_xor(ss, 2); ss += __shfl_xor(ss, 4); ss += __shfl_xor(ss, 8);
    float rs = rsqrtf(ss * (1.f / 128.f) + 1e-6f);
    const float* gg = p.in[21] + l * 128 + (lane & 15) * 8;
#pragma unroll
    for (int e = 0; e < 8; e++) a[e] = a[e] * rs * gg[e] * siluf(gt[e]);
    *(u32x4*)gp = pack8(a);
  }
}

__device__ __forceinline__ void phase_merge(const Params& p, bfr* sm) {
  bfr* Z = (bfr*)(p.ws + WS_Z);
  bfr* MG = (bfr*)(p.ws + WS_R1);
  const int lane = TIDX & 63, wid = TIDX >> 6, wr = wid >> 1, wc = wid & 1, g = lane >> 4;
  for (int t = blockIdx.x; t < 96 * 8; t += gridDim.x) {
    int tn = t & 7, tm = t >> 3;
    f32x4 totl[4][4];
#pragma unroll
    for (int a = 0; a < 4; a++)
#pragma unroll
      for (int b = 0; b < 4; b++) totl[a][b] = (f32x4){0.f, 0.f, 0.f, 0.f};
#pragma unroll 1
    for (int seg = 0; seg < 3; seg++) {
      f32x4 acc[4][4];
#pragma unroll
      for (int a = 0; a < 4; a++)
#pragma unroll
        for (int b = 0; b < 4; b++) acc[a][b] = (f32x4){0.f, 0.f, 0.f, 0.f};
      int ycol = seg == 0 ? C_GA : (seg == 1 ? C_GG : C_GC);
      int mcol = C_M1 + seg * 1024;
      const bfr* W = (const bfr*)(p.ws + WS_WOA + (unsigned long)seg * 1048576ul) + (long)tn * 128 * 512;
      gemm128(W, 512, 128, Z + (long)tm * 128 * ZLD + ycol, ZLD, 128, 512, acc, sm);
#pragma unroll
      for (int pi = 0; pi < 4; pi++) {
        int n0 = tn * 128 + wr * 64 + pi * 16 + g * 4;
#pragma unroll
        for (int qi = 0; qi < 4; qi++) {
          int tok = tm * 128 + wc * 64 + qi * 16 + (lane & 15);
          u32x2 mr = *(const u32x2*)(Z + (long)tok * ZLD + mcol + n0);
          totl[pi][qi][0] += sigmf(lo16(mr.x)) * acc[pi][qi][0];
          totl[pi][qi][1] += sigmf(hi16(mr.x)) * acc[pi][qi][1];
          totl[pi][qi][2] += sigmf(lo16(mr.y)) * acc[pi][qi][2];
          totl[pi][qi][3] += sigmf(hi16(mr.y)) * acc[pi][qi][3];
        }
      }
    }
#pragma unroll
    for (int pi = 0; pi < 4; pi++) {
      int n0 = tn * 128 + wr * 64 + pi * 16 + g * 4;
#pragma unroll
      for (int qi = 0; qi < 4; qi++) {
        int tok = tm * 128 + wc * 64 + qi * 16 + (lane & 15);
        u32x2 o;
        o.x = pack2(totl[pi][qi][0], totl[pi][qi][1]);
        o.y = pack2(totl[pi][qi][2], totl[pi][qi][3]);
        *(u32x2*)(MG + (long)tok * 1024 + n0) = o;
      }
    }
  }
}

__device__ __forceinline__ void phase_outproj(const Params& p, bfr* sm) {
  const bfr* MG = (const bfr*)(p.ws + WS_R1);
  float* OUT = (float*)(p.ws + WS_Z);
  const int lane = TIDX & 63, wid = TIDX >> 6, wr = wid >> 1, wc = wid & 1, g = lane >> 4;
  for (int t = blockIdx.x; t < 96 * 8; t += gridDim.x) {
    int tn = t & 7, tm = t >> 3;
    f32x4 acc[4][4];
#pragma unroll
    for (int a = 0; a < 4; a++)
#pragma unroll
      for (int b = 0; b < 4; b++) acc[a][b] = (f32x4){0.f, 0.f, 0.f, 0.f};
    gemm128((const bfr*)(p.ws + WS_WOUT) + (long)tn * 128 * 1024, 1024, 128, MG + (long)tm * 128 * 1024, 1024, 128, 1024, acc,
            sm);
#pragma unroll
    for (int pi = 0; pi < 4; pi++) {
      int n0 = tn * 128 + wr * 64 + pi * 16 + g * 4;
#pragma unroll
      for (int qi = 0; qi < 4; qi++) {
        int tok = tm * 128 + wc * 64 + qi * 16 + (lane & 15);
        *(float4*)(OUT + (long)tok * 1024 + n0) = make_float4(acc[pi][qi][0], acc[pi][qi][1], acc[pi][qi][2], acc[pi][qi][3]);
      }
    }
  }
}

__device__ __forceinline__ void phase_post(const Params& p, int l) {
  const int lane = TIDX & 63;
  const float* mod = (const float*)(p.ws + WS_MOD);
  const float* OUT = (const float*)(p.ws + WS_Z);
  bfr* H = (bfr*)(p.ws + WS_R1);
  for (int row = blockIdx.x * 4 + (TIDX >> 6); row < NROWS; row += gridDim.x * 4) {
    const float* x = (l == 0) ? xrow(p, row) : (p.out + (long)row * 1024);
    const float* md = mod + (l * 3 + row_cond(row)) * 3072;
    float4 v[4];
    float ss = 0.f;
#pragma unroll
    for (int i = 0; i < 4; i++) {
      v[i] = *(const float4*)(OUT + (long)row * 1024 + i * 256 + lane * 4);
      ss += v[i].x * v[i].x + v[i].y * v[i].y + v[i].z * v[i].z + v[i].w * v[i].w;
    }
    ss = wave_sum(ss);
    float rs = rsqrtf(ss * (1.f / 1024.f) + 1e-6f);
    float ss2 = 0.f;
#pragma unroll
    for (int i = 0; i < 4; i++) {
      int n = i * 256 + lane * 4;
      float4 g = *(const float4*)(p.in[13] + l * 1024 + n);
      float4 gt = *(const float4*)(md + 2048 + n);
      float4 xv = *(const float4*)(x + n);
      v[i].x = xv.x + gt.x * (v[i].x * rs * g.x);
      v[i].y = xv.y + gt.y * (v[i].y * rs * g.y);
      v[i].z = xv.z + gt.z * (v[i].z * rs * g.z);
      v[i].w = xv.w + gt.w * (v[i].w * rs * g.w);
      *(float4*)(p.out + (long)row * 1024 + n) = v[i];
      ss2 += v[i].x * v[i].x + v[i].y * v[i].y + v[i].z * v[i].z + v[i].w * v[i].w;
    }
    if (l == 0) {
      ss2 = wave_sum(ss2);
      float rs2 = rsqrtf(ss2 * (1.f / 1024.f) + 1e-6f);
      const float* md1 = mod + (1 * 3 + row_cond(row)) * 3072;
#pragma unroll
      for (int i = 0; i < 4; i++) {
        int n = i * 256 + lane * 4;
        float4 g = *(const float4*)(p.in[12] + 1024 + n);
        float4 sh = *(const float4*)(md1 + n);
        float4 sc = *(const float4*)(md1 + 1024 + n);
        float h0 = v[i].x * rs2 * g.x * (1.f + sc.x) + sh.x;
        float h1 = v[i].y * rs2 * g.y * (1.f + sc.y) + sh.y;
        float h2 = v[i].z * rs2 * g.z * (1.f + sc.z) + sh.z;
        float h3 = v[i].w * rs2 * g.w * (1.f + sc.w) + sh.w;
        u32x2 o;
        o.x = pack2(h0, h1);
        o.y = pack2(h2, h3);
        *(u32x2*)(H + (long)row * 1024 + n) = o;
      }
    }
  }
}

__global__ void __launch_bounds__(256, 2) fwd_megakernel(Params p) {
  __shared__ __attribute__((aligned(16))) bfr sm[SMEM_SHORTS];
  __shared__ int s_item;
  cg::grid_group grid = cg::this_grid();
  __shared__ uint4 xb_words;
  if (threadIdx.x == 0) xb_words = make_uint4(0u, 0u, 0u, 0u);
  __syncthreads();
  XcdBarrier xb = xcd_barrier_post((unsigned*)(p.ws + WS_BAR), (volatile LAS unsigned*)&xb_words);
  if (p.ws == nullptr) grid.sync();
#ifdef PROBE_SYNC
#define GSYNC do { xcd_barrier(xb); xcd_barrier(xb); } while (0)
#else
#define GSYNC xcd_barrier(xb)
#endif
#ifdef PROBE_PRE
  phase_s0(launder(p), sm);
  GSYNC;
  phase_s1(launder(p));
  wconv_phase(p, 0, sm);
  GSYNC;
  phase_prenorm0(launder(p));
  GSYNC;
#endif

#ifndef PH
#define PH 0xffff
#endif
#if PH & 1
  phase_s0(launder(p), sm);
#endif
  GSYNC;
#if PH & 2
  phase_s1(launder(p));
  wconv_phase(p, 0, sm);
#endif
  GSYNC;
#if PH & 4
  phase_prenorm0(launder(p));
#endif
  GSYNC;
  for (int l = 0; l < 2; l++) {
#if PH & 8
#ifdef PROBE_INPROJ
    phase_inproj(launder(p), sm);
    GSYNC;
#endif
    phase_inproj(launder(p), sm);
#endif
    GSYNC;
#if PH & 16
    phase_rowpost(launder(p), l);
#endif
    GSYNC;
#if PH & 32
#ifdef PROBE_MLAUP
    phase_mla_up(launder(p), l, sm);
    GSYNC;
#endif
    phase_mla_up(launder(p), l, sm);
#endif
    GSYNC;
#if PH & 64
#ifdef PROBE_MIX
    { int dry = 1; asm volatile("" : "+s"(dry)); phase_mixers(launder(p), l, sm, &s_item, dry); }
    GSYNC;
#endif
    { int dry = 0; asm volatile("" : "+s"(dry)); phase_mixers(launder(p), l, sm, &s_item, dry); }
#endif
    GSYNC;
#if PH & 128
    phase_gla_out(launder(p), l);
#endif
    GSYNC;
#if PH & 256
#ifdef PROBE_MERGE
    phase_merge(launder(p), sm);
    GSYNC;
#endif
    phase_merge(launder(p), sm);
#endif
    GSYNC;
#if PH & 512
#ifdef PROBE_MERGE
    phase_outproj(launder(p), sm);
    GSYNC;
#endif
    phase_outproj(launder(p), sm);
#endif
    GSYNC;
#if PH & 1024
    phase_post(launder(p), l);
    if (l == 0) wconv_phase(p, 1, sm);
#endif
    GSYNC;
  }
}

extern "C" void kernel_launch(void* const* d_in, const int* in_sizes, int n_in, void* d_out, int out_size, void* d_ws,
                              size_t ws_size, hipStream_t stream) {
  static int grid_blocks = 0;
  if (!grid_blocks) {
    int dev = 0, cus = 0, per_cu = 0;
    hipGetDevice(&dev);
    hipDeviceGetAttribute(&cus, hipDeviceAttributeMultiprocessorCount, dev);
    hipOccupancyMaxActiveBlocksPerMultiprocessor(&per_cu, fwd_megakernel, 256, 0);
    if (per_cu > 2) per_cu = 2;
    if (per_cu < 1) per_cu = 1;
    grid_blocks = cus * per_cu;
  }
  Params p{};
  for (int i = 0; i < 30; i++) p.in[i] = (const float*)d_in[i];
  p.out = (float*)d_out;
  p.ws = (unsigned char*)d_ws;
  hipMemsetAsync(d_ws, 0, 20480, stream);
  void* args[] = {&p};
  hipError_t e = hipLaunchCooperativeKernel((void*)fwd_megakernel, dim3(grid_blocks), dim3(256), args, 0, stream);
  if (e != hipSuccess) fprintf(stderr, "cooperative launch failed: %s (grid %d)\n", hipGetErrorString(e), grid_blocks);
}
```

```cpp
#include <hip/hip_runtime.h>
#include <hip/hip_cooperative_groups.h>
#include <cstdio>
namespace cg = cooperative_groups;

typedef unsigned short bfr;
typedef __attribute__((ext_vector_type(8))) short bf16x8;
typedef __attribute__((ext_vector_type(4))) float f32x4;
typedef __attribute__((ext_vector_type(4))) unsigned u32x4;
typedef __attribute__((ext_vector_type(2))) unsigned u32x2;

#define NROWS 12288
#define NCTX 4096
#define ZLD 6976
#define LDT 72
#define SMEM_SHORTS (4 * 128 * LDT)

#define C_QA 0
#define C_KA 512
#define C_VA 640
#define C_GA 768
#define C_QG 1280
#define C_KG 1536
#define C_VG 1792
#define C_GG 2304
#define C_RF 2816
#define C_RB 2832
#define C_QL 2848
#define C_KV 3104
#define C_KR 3360
#define C_GC 3392
#define C_M1 3904
#define C_M2 4928
#define C_M3 5952

#define WS_BAR 0ul
#define WS_CTR 16384ul
#define WS_MODP 20480ul
#define WS_MOD (WS_MODP + 589824ul)
#define WS_ROPE (WS_MOD + 73728ul)
#define WS_WIN (WS_ROPE + 16384ul)
#define WS_WUQ (WS_WIN + 14417920ul)
#define WS_WUKV (WS_WUQ + 196608ul)
#define WS_WOA (WS_WUKV + 393216ul)
#define WS_WOB (WS_WOA + 1048576ul)
#define WS_WOC (WS_WOB + 1048576ul)
#define WS_WOUT (WS_WOC + 1048576ul)
#define WS_KCA (WS_WOUT + 2097152ul)
#define WS_CKVC (WS_KCA + 262144ul)
#define WS_KRC (WS_CKVC + 524288ul)
#define WS_VTA (WS_KRC + 65536ul)
#define WS_CQ (WS_VTA + 3407872ul)
#define WS_KNOPE (WS_CQ + 9437184ul)
#define WS_VTC (WS_KNOPE + 6815744ul)
#define WS_R1 (WS_VTC + 13631488ul)
#define WS_Z (WS_R1 + 25165824ul)
#define WS_END (WS_Z + 171442176ul)

#define O_Y 0
#define O_GK 12582912
#define O_GV 13631488
#define O_CKV 14680064
#define O_KR 16777216
#define O_SF 17039360
#define O_SB 18087936

struct Params {
  const float* in[30];
  float* out;
  unsigned char* ws;
};

__device__ __forceinline__ int tidx() {
  int t = threadIdx.x;
  asm volatile("" : "+v"(t));
  return t;
}
__device__ __forceinline__ Params launder(const Params& p) {
  Params q;
  long zo = 0;
  asm volatile("" : "+s"(zo));
#pragma unroll
  for (int i = 0; i < 30; i++) q.in[i] = p.in[i] + zo;
  q.out = p.out + zo;
  q.ws = p.ws + zo;
  return q;
}
__device__ __forceinline__ float bf2f(bfr b) { return __uint_as_float(((unsigned)b) << 16); }
typedef float f32x2_t __attribute__((ext_vector_type(2)));
typedef __bf16 bf16x2_t __attribute__((ext_vector_type(2)));
__device__ __forceinline__ bfr f2bf(float f) {
  __bf16 r = (__bf16)f;
  return *(bfr*)&r;
}
__device__ __forceinline__ unsigned pack2(float a, float b) {
  f32x2_t v = {a, b};
  bf16x2_t r = __builtin_convertvector(v, bf16x2_t);
  return *(unsigned*)&r;
}
__device__ __forceinline__ float lo16(unsigned u) { return __uint_as_float(u << 16); }
__device__ __forceinline__ float hi16(unsigned u) { return __uint_as_float(u & 0xffff0000u); }
__device__ __forceinline__ float siluf(float x) { return x / (1.f + __expf(-x)); }
__device__ __forceinline__ float sigmf(float x) { return 1.f / (1.f + __expf(-x)); }
__device__ __forceinline__ f32x4 mfma16(bf16x8 a, bf16x8 b, f32x4 c) {
  return __builtin_amdgcn_mfma_f32_16x16x32_bf16(a, b, c, 0, 0, 0);
}
__device__ __forceinline__ const float* xrow(const Params& p, int row) {
  return row < NCTX ? p.in[0] + (long)row * 1024 : p.in[1] + (long)(row - NCTX) * 1024;
}
__device__ __forceinline__ int row_cond(int row) { return row < NCTX ? 0 : 1 + ((row - NCTX) >> 12); }
__device__ __forceinline__ float wave_sum(float v) {
  v += __shfl_xor(v, 1); v += __shfl_xor(v, 2); v += __shfl_xor(v, 4);
  v += __shfl_xor(v, 8); v += __shfl_xor(v, 16); v += __shfl_xor(v, 32);
  return v;
}

#define XB_TMO      128
#define XB_XCNT(j)  (256  + 64 * (j))
#define XB_XSUB(j)  (1280 + 64 * (j))
#define XB_XGEN(j)  (2304 + 64 * (j))
#define XB_TOP      3328
#define XB_TOPGEN   3392
#define XCD_BAR_WORDS 3456
#define XB_SPIN_CAP (1u << 18)
#define LAS __attribute__((address_space(3)))

__device__ __forceinline__ unsigned xb_ld(unsigned* p)              { return __hip_atomic_load(p, __ATOMIC_RELAXED, __HIP_MEMORY_SCOPE_AGENT); }
__device__ __forceinline__ unsigned xb_add(unsigned* p, unsigned v) { return __hip_atomic_fetch_add(p, v, __ATOMIC_RELAXED, __HIP_MEMORY_SCOPE_AGENT); }
__device__ __forceinline__ unsigned xb_xcc_id() { return (unsigned)__builtin_amdgcn_s_getreg((3 << 11) | 20) & 0xFu; }
#define XB_SPIN(cond, bar) do { unsigned _sp = 0; while (cond) { __builtin_amdgcn_s_sleep(1); \
    if ((++_sp & 255u) == 0u) { if (xb_ld(&(bar)[XB_TMO])) break; if (_sp > XB_SPIN_CAP) { atomicAdd(&(bar)[XB_TMO], 1u); break; } } } } while (0)

struct XcdBarrier {
    unsigned* bar; unsigned x;
    volatile LAS unsigned* st;
};

__device__ __forceinline__ XcdBarrier xcd_barrier_post(unsigned* bar, volatile LAS unsigned* st) {
    XcdBarrier b; b.bar = bar; b.x = xb_xcc_id(); b.st = st;
    if (threadIdx.x == 0) (void)xb_add(&bar[XB_XCNT(b.x)], 1u);
    return b;
}
__device__ __forceinline__ void xcd_barrier_complete(unsigned* bar, unsigned x, unsigned& nloc, unsigned& nx) {
    const unsigned G = gridDim.x * gridDim.y * gridDim.z;
    unsigned sum, cnt, mine, sp = 0u;
    for (;;) {
        sum = 0u; cnt = 0u; mine = 0u;
#pragma unroll
        for (unsigned j = 0; j < 16; ++j) { const unsigned c = xb_ld(&bar[XB_XCNT(j)]); sum += c; cnt += (c > 0u) ? 1u : 0u; mine = (j == x) ? c : mine; }
        if (sum == G) break;
        __builtin_amdgcn_s_sleep(1);
        if ((++sp & 255u) == 0u) { if (xb_ld(&bar[XB_TMO])) break; if (sp > XB_SPIN_CAP) { atomicAdd(&bar[XB_TMO], 1u); break; } }
    }
    nloc = mine > 0u ? mine : 1u; nx = cnt > 0u ? cnt : 1u;
}

__device__ __forceinline__ void xcd_barrier(const XcdBarrier& b) {
    asm volatile("s_waitcnt vmcnt(0)" ::: "memory");
    __syncthreads();
    if (threadIdx.x == 0) {
        unsigned* bar = b.bar;
        __builtin_amdgcn_s_waitcnt(0);
        unsigned nloc = b.st[0], nx = b.st[1];
        if (nloc == 0u) { xcd_barrier_complete(bar, b.x, nloc, nx); b.st[0] = nloc; b.st[1] = nx; }
        const unsigned old = xb_add(&bar[XB_XSUB(b.x)], 1u);
        const unsigned gen = old / nloc;
        if (old + 1u == (gen + 1u) * nloc) {
            __builtin_amdgcn_fence(__ATOMIC_RELEASE, "agent");
            asm volatile("s_waitcnt vmcnt(0)" ::: "memory");
            const unsigned og = xb_add(&bar[XB_TOP], 1u);
            const unsigned tg = og / nx;
            if (og + 1u == (tg + 1u) * nx) xb_add(&bar[XB_TOPGEN], 1u);
            else XB_SPIN(xb_ld(&bar[XB_TOPGEN]) == tg, bar);
            __builtin_amdgcn_fence(__ATOMIC_ACQUIRE, "agent");
            xb_add(&bar[XB_XGEN(b.x)], 1u);
            asm volatile("s_waitcnt vmcnt(0)" ::: "memory");
        } else {
            XB_SPIN(xb_ld(&bar[XB_XGEN(b.x)]) == gen, bar);
            __builtin_amdgcn_fence(__ATOMIC_ACQUIRE, "agent");
            asm volatile("s_waitcnt vmcnt(0)" ::: "memory");
        }
    }
    __syncthreads();
}


#define TIDX tidx()
#define LDS3 __attribute__((address_space(3)))
__device__ __forceinline__ void glds16(const bfr* g, bfr* l) {
  __builtin_amdgcn_global_load_lds((const unsigned*)g, (LDS3 unsigned*)l, 16, 0, 0);
}
__device__ __forceinline__ void gemm128(const bfr* __restrict__ P, long ldp, int pmax,
                                        const bfr* __restrict__ Q, long ldq, int qmax, int K,
                                        f32x4 (&acc)[4][4], bfr* sm) {
  const int tid = TIDX, lane = tid & 63, wid = tid >> 6;
  const int wr = wid >> 1, wc = wid & 1;
  const int l15 = lane & 15, g = lane >> 4;
  const bfr* pp[2];
  const bfr* qp[2];
  {
    const int r0 = tid >> 2;
    const int c = (tid & 3) ^ ((tid >> 4) & 3);
#pragma unroll
    for (int i = 0; i < 2; i++) {
      int r = r0 + 64 * i;
      pp[i] = P + (long)min(r, pmax - 1) * ldp + c * 8;
      qp[i] = Q + (long)min(r, qmax - 1) * ldq + c * 8;
    }
  }
  const int nk = K >> 5;
#define GEMM_ISSUE(T)                                                    \
  do {                                                                   \
    bfr* nb_ = sm + ((T) & 3) * 8192;                                    \
    glds16(pp[0] + (T) * 32, nb_ + tid * 8);                             \
    glds16(pp[1] + (T) * 32, nb_ + 2048 + tid * 8);                      \
    glds16(qp[0] + (T) * 32, nb_ + 4096 + tid * 8);                      \
    glds16(qp[1] + (T) * 32, nb_ + 6144 + tid * 8);                      \
  } while (0)
  GEMM_ISSUE(0);
  GEMM_ISSUE(1);
  GEMM_ISSUE(2);
  const int pos = (g ^ ((l15 >> 2) & 3)) * 8;
  for (int kt = 0; kt < nk; kt++) {
    if (kt + 2 < nk) asm volatile("s_waitcnt vmcnt(8)" ::: "memory");
    else if (kt + 1 < nk) asm volatile("s_waitcnt vmcnt(4)" ::: "memory");
    else asm volatile("s_waitcnt vmcnt(0)" ::: "memory");
    __builtin_amdgcn_s_barrier();
    if (kt + 3 < nk) GEMM_ISSUE(kt + 3);
    const bfr* Ps = sm + (kt & 3) * 8192;
    const bfr* Qs = Ps + 4096;
    bf16x8 pf[4], qf[4];
#pragma unroll
    for (int m = 0; m < 4; m++) {
      pf[m] = *(const bf16x8*)(Ps + (wr * 64 + m * 16 + l15) * 32 + pos);
      qf[m] = *(const bf16x8*)(Qs + (wc * 64 + m * 16 + l15) * 32 + pos);
    }
#pragma unroll
    for (int m = 0; m < 4; m++)
#pragma unroll
      for (int n = 0; n < 4; n++) acc[m][n] = mfma16(pf[m], qf[n], acc[m][n]);
  }
#undef GEMM_ISSUE
  __syncthreads();
}

__device__ __forceinline__ void phase_s0(const Params& p, bfr* sm) {
  const int tid = TIDX;
  float* rope = (float*)(p.ws + WS_ROPE);
  for (int idx = blockIdx.x * 256 + tid; idx < 1536; idx += gridDim.x * 256) {
    if (idx < 1024) {
      int pos = idx >> 4, i = idx & 15;
      float fr = powf(10000.f, -(float)i / 16.f);
      float a = (float)pos * fr;
      rope[idx] = cosf(a);
      rope[1024 + idx] = sinf(a);
    } else {
      int j = idx - 1024;
      int pos = j >> 3, i = j & 7;
      float fr = powf(10000.f, -(float)i / 8.f);
      float a = (float)pos * fr;
      rope[2048 + j] = cosf(a);
      rope[2560 + j] = sinf(a);
    }
  }
  float* smf = (float*)sm;
  float* modp = (float*)(p.ws + WS_MODP);
  for (int it = blockIdx.x; it < 768; it += gridDim.x) {
    int l = it / 384, rem = it % 384, cgp = rem >> 3, ks = rem & 7;
    int col = cgp * 64 + (tid & 63), kq = tid >> 6;
    const float* w = p.in[10] + (long)l * 1024 * 3072 + col;
    float a0 = 0.f, a1 = 0.f, a2 = 0.f;
    int k0 = ks * 128 + kq * 32;
#pragma unroll 8
    for (int k = k0; k < k0 + 32; k++) {
      float wv = w[(long)k * 3072];
      a0 += siluf(p.in[9][k]) * wv;
      a1 += siluf(p.in[8][k]) * wv;
      a2 += siluf(p.in[8][1024 + k]) * wv;
    }
    smf[(kq * 3 + 0) * 64 + (tid & 63)] = a0;
    smf[(kq * 3 + 1) * 64 + (tid & 63)] = a1;
    smf[(kq * 3 + 2) * 64 + (tid & 63)] = a2;
    __syncthreads();
    if (tid < 192) {
      int c = tid >> 6, cc = tid & 63;
      float s = smf[(0 * 3 + c) * 64 + cc] + smf[(1 * 3 + c) * 64 + cc] + smf[(2 * 3 + c) * 64 + cc] + smf[(3 * 3 + c) * 64 + cc];
      modp[((ks * 2 + l) * 3 + c) * 3072 + cgp * 64 + cc] = s;
    }
    __syncthreads();
  }
}

__device__ __forceinline__ void phase_s1(const Params& p) {
  float* modp = (float*)(p.ws + WS_MODP);
  float* mod = (float*)(p.ws + WS_MOD);
  for (int idx = blockIdx.x * 256 + TIDX; idx < 2 * 3 * 3072; idx += gridDim.x * 256) {
    int l = idx / 9216, n = idx % 3072;
    float s = p.in[11][l * 3072 + n];
#pragma unroll
    for (int ks = 0; ks < 8; ks++) s += modp[ks * 18432 + idx];
    mod[idx] = s;
  }
}

__device__ __forceinline__ void wconv_tile(const float* __restrict__ src, int K, int N, bfr* __restrict__ dst,
                                           int tk, int tn, float* smf) {
  const int tid = TIDX;
  const int n = tid & 63, kb = tid >> 6;
#pragma unroll
  for (int i = 0; i < 16; i++) {
    int k = kb + 4 * i;
    smf[k * 65 + n] = src[(long)(tk * 64 + k) * N + tn * 64 + n];
  }
  __syncthreads();
#pragma unroll
  for (int i = 0; i < 16; i++) {
    int idx = tid + 256 * i;
    int nn = idx >> 6, k = idx & 63;
    dst[(long)(tn * 64 + nn) * K + tk * 64 + k] = f2bf(smf[k * 65 + nn]);
  }
  __syncthreads();
}

#define WCONV_ITEMS 2456
__device__ __forceinline__ void wconv_phase(const Params& p, int l, bfr* sm) {
  float* smf = (float*)sm;
  for (int item0 = blockIdx.x; item0 < WCONV_ITEMS; item0 += gridDim.x) {
    int item = item0;
    const float* src;
    bfr* dst;
    int K, N, tk, tn;
    if (item < 1744) {
      src = p.in[14] + (long)l * 1024 * 6976; K = 1024; N = 6976; dst = (bfr*)(p.ws + WS_WIN); tk = item & 15; tn = item >> 4;
    } else if (item < 1768) {
      item -= 1744;
      src = p.in[24] + (long)l * 256 * 384; K = 256; N = 384; dst = (bfr*)(p.ws + WS_WUQ); tk = item & 3; tn = item >> 2;
    } else if (item < 1816) {
      item -= 1768;
      src = p.in[25] + (long)l * 256 * 768; K = 256; N = 768; dst = (bfr*)(p.ws + WS_WUKV); tk = item & 3; tn = item >> 2;
    } else if (item < 2200) {
      item -= 1816;
      int w = item >> 7, it = item & 127;
      src = (w == 0 ? p.in[26] : (w == 1 ? p.in[27] : p.in[28])) + (long)l * 512 * 1024;
      K = 512; N = 1024; dst = (bfr*)(p.ws + WS_WOA + (unsigned long)w * 1048576ul); tk = it & 7; tn = it >> 3;
    } else {
      item -= 2200;
      src = p.in[29] + (long)l * 1024 * 1024; K = 1024; N = 1024; dst = (bfr*)(p.ws + WS_WOUT); tk = item & 15; tn = item >> 4;
    }
    wconv_tile(src, K, N, dst, tk, tn, smf);
  }
}

__device__ __forceinline__ void phase_prenorm0(const Params& p) {
  const int lane = TIDX & 63;
  const float* mod = (const float*)(p.ws + WS_MOD);
  bfr* H = (bfr*)(p.ws + WS_R1);
  for (int row = blockIdx.x * 4 + (TIDX >> 6); row < NROWS; row += gridDim.x * 4) {
    const float* x = xrow(p, row);
    const float* md = mod + (0 * 3 + row_cond(row)) * 3072;
    float4 v[4];
    float ss = 0.f;
#pragma unroll
    for (int i = 0; i < 4; i++) {
      v[i] = *(const float4*)(x + i * 256 + lane * 4);
      ss += v[i].x * v[i].x + v[i].y * v[i].y + v[i].z * v[i].z + v[i].w * v[i].w;
    }
    ss = wave_sum(ss);
    float rs = rsqrtf(ss * (1.f / 1024.f) + 1e-6f);
#pragma unroll
    for (int i = 0; i < 4; i++) {
      int n = i * 256 + lane * 4;
      float4 g = *(const float4*)(p.in[12] + n);
      float4 sh = *(const float4*)(md + n);
      float4 sc = *(const float4*)(md + 1024 + n);
      float h0 = v[i].x * rs * g.x * (1.f + sc.x) + sh.x;
      float h1 = v[i].y * rs * g.y * (1.f + sc.y) + sh.y;
      float h2 = v[i].z * rs * g.z * (1.f + sc.z) + sh.z;
      float h3 = v[i].w * rs * g.w * (1.f + sc.w) + sh.w;
      u32x2 o;
      o.x = pack2(h0, h1);
      o.y = pack2(h2, h3);
      *(u32x2*)(H + (long)row * 1024 + n) = o;
    }
  }
}

__device__ __forceinline__ unsigned xcc_id() { return (unsigned)__builtin_amdgcn_s_getreg((3 << 11) | 20) & 7u; }
template <class CountF>
__device__ __forceinline__ int xq_take(unsigned* ctr, int& q, int& tried, unsigned first, CountF cnt) {
  unsigned j = first;
  for (;;) {
    if (j < (unsigned)cnt(q)) return (q << 20) | (int)j;
    q = (q + 1) & 7;
    if (++tried >= 8) return -1;
    j = atomicAdd(ctr + q * 16, 1u);
  }
}

__device__ __forceinline__ void phase_inproj(const Params& p, int l, bfr* sm, int* s_item) {
  const bfr* H = (const bfr*)(p.ws + WS_R1);
  const bfr* W = (const bfr*)(p.ws + WS_WIN);
  bfr* Z = (bfr*)(p.ws + WS_Z);
  const int tid = TIDX;
  const int lane = tid & 63, wid = tid >> 6, wr = wid >> 1, wc = wid & 1;
  unsigned* ctr = (unsigned*)(p.ws + WS_CTR) + l * 128;
  auto cnt = [](int q) { return 96 * ((55 * (q + 1)) / 8 - (55 * q) / 8); };
  int q = (int)xcc_id(), tried = 0;
  unsigned nxt = 0;
  if (tid == 0) nxt = atomicAdd(ctr + q * 16, 1u);
  for (;;) {
    if (tid == 0) *s_item = xq_take(ctr, q, tried, nxt, cnt);
    __syncthreads();
    const int it = *s_item;
    __syncthreads();
    if (it < 0) break;
    const int qq = it >> 20, j = it & 0xfffff;
    if (tid == 0) nxt = atomicAdd(ctr + q * 16, 1u);
    const int tn0 = (55 * qq) / 8, w = (55 * (qq + 1)) / 8 - tn0;
    const int tm = j / w, tn = tn0 + j % w;
    f32x4 acc[4][4];
#pragma unroll
    for (int a = 0; a < 4; a++)
#pragma unroll
      for (int b = 0; b < 4; b++) acc[a][b] = (f32x4){0.f, 0.f, 0.f, 0.f};
    gemm128(W + (long)tn * 128 * 1024, 1024, ZLD - tn * 128, H + (long)tm * 128 * 1024, 1024, 128, 1024, acc, sm);
#pragma unroll
    for (int pi = 0; pi < 4; pi++) {
      int n0 = tn * 128 + wr * 64 + pi * 16 + (lane >> 4) * 4;
      if (n0 < ZLD) {
#pragma unroll
        for (int qi = 0; qi < 4; qi++) {
          int tok = tm * 128 + wc * 64 + qi * 16 + (lane & 15);
          u32x2 o;
          o.x = pack2(acc[pi][qi][0], acc[pi][qi][1]);
          o.y = pack2(acc[pi][qi][2], acc[pi][qi][3]);
          *(u32x2*)(Z + (long)tok * ZLD + n0) = o;
        }
      }
    }
  }
}

__device__ __forceinline__ void unpack8(u32x4 v, float* x) {
  x[0] = lo16(v.x); x[1] = hi16(v.x); x[2] = lo16(v.y); x[3] = hi16(v.y);
  x[4] = lo16(v.z); x[5] = hi16(v.z); x[6] = lo16(v.w); x[7] = hi16(v.w);
}
__device__ __forceinline__ u32x4 pack8(const float* y) {
  u32x4 o;
  o.x = pack2(y[0], y[1]); o.y = pack2(y[2], y[3]); o.z = pack2(y[4], y[5]); o.w = pack2(y[6], y[7]);
  return o;
}

__device__ __forceinline__ void phase_rowpost(const Params& p, int l) {
  const int lane = TIDX & 63;
  bfr* Z = (bfr*)(p.ws + WS_Z);
  const float* rope = (const float*)(p.ws + WS_ROPE);
  bfr* VTA = (bfr*)(p.ws + WS_VTA);
  bfr* KCA = (bfr*)(p.ws + WS_KCA);
  bfr* CKVC = (bfr*)(p.ws + WS_CKVC);
  bfr* KRC = (bfr*)(p.ws + WS_KRC);
  float* out = p.out;
  for (int row = blockIdx.x * 4 + (TIDX >> 6); row < NROWS + 1024; row += gridDim.x * 4) {
    if (row < NROWS) {
      const bool lat = row >= NCTX;
      const int bc = row >> 8, tc = row & 255;
      const int bl = (row - NCTX) >> 12, tl = (row - NCTX) & 4095;
      const int prow = tl >> 6, pcol = tl & 63;
      bfr* z = Z + (long)row * ZLD;
      {
        float x[8];
        unpack8(*(const u32x4*)(z + C_QA + lane * 8), x);
        float ss = 0.f;
#pragma unroll
        for (int e = 0; e < 8; e++) ss += x[e] * x[e];
        ss += __shfl_xor(ss, 1); ss += __shfl_xor(ss, 2); ss += __shfl_xor(ss, 4);
        float rs = rsqrtf(ss * (1.f / 64.f) + 1e-6f);
        int sub = lane & 7;
        const float* g = p.in[15] + l * 64 + sub * 8;
#pragma unroll
        for (int e = 0; e < 8; e++) x[e] = x[e] * rs * g[e];
        if (lat) {
          int pos = (sub >> 2) ? pcol : prow;
          bool hi = (sub & 2) != 0;
          int i0 = (sub & 1) * 8;
#pragma unroll
          for (int e = 0; e < 8; e++) {
            float yp = __shfl_xor(x[e], 2);
            float c = rope[pos * 16 + i0 + e], s = rope[1024 + pos * 16 + i0 + e];
            x[e] = hi ? (yp * s + x[e] * c) : (x[e] * c - yp * s);
          }
        }
        const float qs = 0.125f * 1.4426950408889634f;
#pragma unroll
        for (int e = 0; e < 8; e++) x[e] *= qs;
        *(u32x4*)(z + C_QA + lane * 8) = pack8(x);
      }
      {
        int L = lane & 15;
        float x[8];
        unpack8(*(const u32x4*)(z + C_KA + L * 8), x);
        float ss = 0.f;
#pragma unroll
        for (int e = 0; e < 8; e++) ss += x[e] * x[e];
        ss += __shfl_xor(ss, 1); ss += __shfl_xor(ss, 2); ss += __shfl_xor(ss, 4);
        float rs = rsqrtf(ss * (1.f / 64.f) + 1e-6f);
        int sub = L & 7;
        const float* g = p.in[16] + l * 64 + sub * 8;
#pragma unroll
        for (int e = 0; e < 8; e++) x[e] = x[e] * rs * g[e];
        if (lat) {
          int pos = (sub >> 2) ? pcol : prow;
          bool hi = (sub & 2) != 0;
          int i0 = (sub & 1) * 8;
#pragma unroll
          for (int e = 0; e < 8; e++) {
            float yp = __shfl_xor(x[e], 2);
            float c = rope[pos * 16 + i0 + e], s = rope[1024 + pos * 16 + i0 + e];
            x[e] = hi ? (yp * s + x[e] * c) : (x[e] * c - yp * s);
          }
        } else if (lane < 16) {
          float* o = out + O_GK + ((long)(bc * 2 + l) * 256 + tc) * 128 + L * 8;
          *(float4*)(o) = make_float4(x[0], x[1], x[2], x[3]);
          *(float4*)(o + 4) = make_float4(x[4], x[5], x[6], x[7]);
        }
        if (lane < 16) *(u32x4*)(z + C_KA + L * 8) = pack8(x);
      }
      if (lane < 16) {
        int L = lane;
        u32x4 raw = *(const u32x4*)(z + C_VA + L * 8);
        float x[8];
        unpack8(raw, x);
        if (!lat) {
          float* o = out + O_GV + ((long)(bc * 2 + l) * 256 + tc) * 128 + L * 8;
          *(float4*)(o) = make_float4(x[0], x[1], x[2], x[3]);
          *(float4*)(o + 4) = make_float4(x[4], x[5], x[6], x[7]);
        }
        int g = L >> 3, d0 = (L & 7) * 8;
        long base; int nk, key;
        if (!lat) { base = (long)bc * 32768; nk = 256; key = tc; }
        else { base = 16l * 32768 + (long)bl * (2 * 64 * 4608); nk = 4608; key = 512 + tl; }
        const bfr* rb = (const bfr*)&raw;
#pragma unroll
        for (int e = 0; e < 8; e++) VTA[base + (long)(g * 64 + d0 + e) * nk + key] = rb[e];
      }
      {
        u32x2 rq = *(const u32x2*)(z + C_QL + lane * 4);
        u32x2 rk = *(const u32x2*)(z + C_KV + lane * 4);
        float q[4] = {lo16(rq.x), hi16(rq.x), lo16(rq.y), hi16(rq.y)};
        float k[4] = {lo16(rk.x), hi16(rk.x), lo16(rk.y), hi16(rk.y)};
        float sq = q[0] * q[0] + q[1] * q[1] + q[2] * q[2] + q[3] * q[3];
        float sk = k[0] * k[0] + k[1] * k[1] + k[2] * k[2] + k[3] * k[3];
        sq = wave_sum(sq);
        sk = wave_sum(sk);
        float rq_ = rsqrtf(sq * (1.f / 256.f) + 1e-6f), rk_ = rsqrtf(sk * (1.f / 256.f) + 1e-6f);
        float4 gq = *(const float4*)(p.in[22] + l * 256 + lane * 4);
        float4 gk = *(const float4*)(p.in[23] + l * 256 + lane * 4);
        q[0] *= rq_ * gq.x; q[1] *= rq_ * gq.y; q[2] *= rq_ * gq.z; q[3] *= rq_ * gq.w;
        k[0] *= rk_ * gk.x; k[1] *= rk_ * gk.y; k[2] *= rk_ * gk.z; k[3] *= rk_ * gk.w;
        u32x2 o;
        o.x = pack2(q[0], q[1]); o.y = pack2(q[2], q[3]);
        *(u32x2*)(z + C_QL + lane * 4) = o;
        o.x = pack2(k[0], k[1]); o.y = pack2(k[2], k[3]);
        *(u32x2*)(z + C_KV + lane * 4) = o;
        if (!lat) *(float4*)(out + O_CKV + ((long)(bc * 2 + l) * 256 + tc) * 256 + lane * 4) = make_float4(k[0], k[1], k[2], k[3]);
      }
      {
        int L = lane & 3;
        float x[8];
        unpack8(*(const u32x4*)(z + C_KR + L * 8), x);
        if (lat) {
          int pos = (L >> 1) ? pcol : prow;
          bool hi = (L & 1) != 0;
#pragma unroll
          for (int e = 0; e < 8; e++) {
            float yp = __shfl_xor(x[e], 1);
            float c = rope[2048 + pos * 8 + e], s = rope[2560 + pos * 8 + e];
            x[e] = hi ? (yp * s + x[e] * c) : (x[e] * c - yp * s);
          }
          if (lane < 4) *(u32x4*)(z + C_KR + L * 8) = pack8(x);
        } else if (lane < 4) {
          float* o = out + O_KR + ((long)(bc * 2 + l) * 256 + tc) * 32 + L * 8;
          *(float4*)(o) = make_float4(x[0], x[1], x[2], x[3]);
          *(float4*)(o + 4) = make_float4(x[4], x[5], x[6], x[7]);
        }
      }
    } else {
      int cr = row - NROWS;
      int b = cr >> 9, t = cr & 511;
      long src = (long)(b * 2 + l) * 512 + t;
      {
        float2 kv = *(const float2*)(p.in[2] + src * 128 + lane * 2);
        *(unsigned*)(KCA + (long)(b * 512 + t) * 128 + lane * 2) = pack2(kv.x, kv.y);
        float2 vv = *(const float2*)(p.in[3] + src * 128 + lane * 2);
        int c0 = lane * 2;
        long base = 16l * 32768 + (long)b * (2 * 64 * 4608);
        VTA[base + (long)c0 * 4608 + t] = f2bf(vv.x);
        VTA[base + (long)(c0 + 1) * 4608 + t] = f2bf(vv.y);
        float4 cv = *(const float4*)(p.in[4] + src * 256 + lane * 4);
        u32x2 o;
        o.x = pack2(cv.x, cv.y); o.y = pack2(cv.z, cv.w);
        *(u32x2*)(CKVC + (long)(b * 512 + t) * 256 + lane * 4) = o;
        if (lane < 32) KRC[(long)(b * 512 + t) * 32 + lane] = f2bf(p.in[5][src * 32 + lane]);
      }
    }
  }
}

#define WS_PREP1 251703296ul
#define WS_EL (WS_WIN + 12582912ul)
__device__ __forceinline__ bfr* prep_base(const Params& p, int b, int h, int dir, int c) {
  return (bfr*)(p.ws + (b ? WS_PREP1 : WS_WIN)) + (long)((h * 2 + dir) * 64 + c) * 12288;
}

__device__ __forceinline__ void gla_chunk_prep(int tid, const float (&wd)[16], float bias, const bfr* Qr, const bfr* Kr,
                                               bfr* Qe, bfr* Ke, bfr* KlT, const float* RF, float* tot, float* lastv) {
  const int ch = tid & 63, part = tid >> 6;
  float cum[16];
  {
    float run = 0.f;
#pragma unroll
    for (int ii = 0; ii < 16; ii++) {
      int i = part * 16 + ii;
      float x = bias;
#pragma unroll
      for (int r = 0; r < 16; r++) x += RF[i * 16 + r] * wd[r];
      float la = (fminf(x, 0.f) - __logf(1.f + __expf(-fabsf(x)))) * (1.f / 16.f);
      run += la;
      cum[ii] = run;
    }
    tot[part * 64 + ch] = run;
  }
  __syncthreads();
  {
    float off = 0.f, last = 0.f;
#pragma unroll
    for (int pp = 0; pp < 4; pp++) {
      float tv = tot[pp * 64 + ch];
      if (pp < part) off += tv;
      last += tv;
    }
    if (part == 0) lastv[ch] = last;
#pragma unroll
    for (int ii = 0; ii < 16; ii++) {
      int i = part * 16 + ii;
      float cc = cum[ii] + off;
      float qv = bf2f(Qr[i * LDT + ch]), kv = bf2f(Kr[i * LDT + ch]);
      Qe[i * LDT + ch] = f2bf(qv * __expf(cc) * 0.125f);
      Ke[i * LDT + ch] = f2bf(kv * __expf(-cc));
      KlT[ch * LDT + i] = f2bf(kv * __expf(last - cc));
    }
  }
  __syncthreads();
}

__device__ __forceinline__ void gla_att(int wid, int g, int l15, const bfr* Qe, const bfr* Ke, bfr* Att) {
  f32x4 att[4];
  bf16x8 qa[2];
#pragma unroll
  for (int kk = 0; kk < 2; kk++) qa[kk] = *(const bf16x8*)(Qe + (16 * wid + l15) * LDT + kk * 32 + g * 8);
#pragma unroll
  for (int nj = 0; nj < 4; nj++) {
    att[nj] = (f32x4){0.f, 0.f, 0.f, 0.f};
#pragma unroll
    for (int kk = 0; kk < 2; kk++) {
      bf16x8 kb = *(const bf16x8*)(Ke + (16 * nj + l15) * LDT + kk * 32 + g * 8);
      att[nj] = mfma16(qa[kk], kb, att[nj]);
    }
  }
#pragma unroll
  for (int nj = 0; nj < 4; nj++)
#pragma unroll
    for (int r = 0; r < 4; r++) {
      int i = 16 * wid + 4 * g + r, j = 16 * nj + l15;
      Att[i * LDT + j] = f2bf(i >= j ? att[nj][r] : 0.f);
    }
}

__device__ __forceinline__ void gla_prep_item(const Params& p, int l, int b, int h, int dir, int c, bfr* sm) {
  const int tid = TIDX, lane = tid & 63, wid = tid >> 6, g = lane >> 4, l15 = lane & 15;
  const bfr* Z = (const bfr*)(p.ws + WS_Z);
  const int N = 4096;
  const int rowbase = NCTX + b * 4096;
  bfr* Qr = sm;
  bfr* Kr = Qr + 64 * LDT;
  bfr* Qe = Kr + 64 * LDT;
  bfr* Ke = Qe + 64 * LDT;
  bfr* KlT = Ke + 64 * LDT;
  float* RF = (float*)(KlT + 64 * LDT);
  float* tot = RF + 64 * 16;
  float* lastv = tot + 256;
  bfr* Att = Qr;
  const int ch = tid & 63;
  float wd[16];
  {
    const float* W = (dir ? p.in[19] : p.in[17]) + (long)l * 16 * 256 + h * 64 + ch;
#pragma unroll
    for (int r = 0; r < 16; r++) wd[r] = W[r * 256];
  }
  const float bias = (dir ? p.in[20] : p.in[18])[l * 256 + h * 64 + ch];
#pragma unroll
  for (int ii = 0; ii < 2; ii++) {
    int cc = tid + 256 * ii;
    int i = cc >> 3, c8 = cc & 7;
    int tok = dir ? (N - 1 - (c * 64 + i)) : (c * 64 + i);
    const bfr* zr = Z + (long)(rowbase + tok) * ZLD;
    *(u32x4*)(Qr + i * LDT + c8 * 8) = *(const u32x4*)(zr + C_QG + h * 64 + c8 * 8);
    *(u32x4*)(Kr + i * LDT + c8 * 8) = *(const u32x4*)(zr + C_KG + h * 64 + c8 * 8);
  }
  if (tid < 128) {
    int i = tid >> 1, hf = tid & 1;
    int tok = dir ? (N - 1 - (c * 64 + i)) : (c * 64 + i);
    u32x4 rr = *(const u32x4*)(Z + (long)(rowbase + tok) * ZLD + (dir ? C_RB : C_RF) + hf * 8);
    float x[8];
    unpack8(rr, x);
#pragma unroll
    for (int e = 0; e < 8; e++) RF[i * 16 + hf * 8 + e] = x[e];
  }
  __syncthreads();
  gla_chunk_prep(tid, wd, bias, Qr, Kr, Qe, Ke, KlT, RF, tot, lastv);
  gla_att(wid, g, l15, Qe, Ke, Att);
  __syncthreads();
  bfr* dst = prep_base(p, b, h, dir, c);
#pragma unroll
  for (int ii = 0; ii < 2; ii++) {
    int cc = tid + 256 * ii;
    int i = cc >> 3, c8 = cc & 7;
    *(u32x4*)(dst + i * 64 + c8 * 8) = *(const u32x4*)(Qe + i * LDT + c8 * 8);
    *(u32x4*)(dst + 4096 + i * 64 + c8 * 8) = *(const u32x4*)(KlT + i * LDT + c8 * 8);
    *(u32x4*)(dst + 8192 + i * 64 + c8 * 8) = *(const u32x4*)(Att + i * LDT + c8 * 8);
  }
  if (tid < 64) ((float*)(p.ws + WS_EL))[((long)(((b * 4 + h) * 2 + dir) * 64 + c)) * 64 + tid] = __expf(lastv[tid]);
  __syncthreads();
}

__device__ __forceinline__ void gla_chain_item(const Params& p, int l, int b, int h, int dir, int vh, bfr* sm) {
  const int tid = TIDX, lane = tid & 63, wid = tid >> 6, g = lane >> 4, l15 = lane & 15;
  const bfr* Z = (const bfr*)(p.ws + WS_Z);
  bfr* OG = (bfr*)(p.ws + WS_R1) + (long)dir * NROWS * 512;
  const float* EL = (const float*)(p.ws + WS_EL) + (long)(((b * 4 + h) * 2 + dir) * 64) * 64;
  const int N = 4096, nc = 64;
  const int rowbase = NCTX + b * 4096;
  const int vs0 = vh * 64;
  bfr* Vt = sm;
  bfr* St = Vt + 64 * LDT;
  f32x4 st[4];
  {
    const float* S0 = (dir ? p.in[7] : p.in[6]) + ((long)((b * 2 + l) * 4 + h)) * 8192 + (long)(16 * wid + l15) * 128 + vs0;
#pragma unroll
    for (int vt = 0; vt < 4; vt++) {
      float4 a = *(const float4*)(S0 + 16 * vt + 4 * g);
      st[vt] = (f32x4){a.x, a.y, a.z, a.w};
#pragma unroll
      for (int r = 0; r < 4; r++) St[(16 * vt + 4 * g + r) * LDT + 16 * wid + l15] = f2bf(st[vt][r]);
    }
  }
  u32x4 n_qe[2], n_kl[2], n_at[2], n_v[2];
  float n_el;
  auto prefetch = [&](int c) {
    const bfr* base = prep_base(p, b, h, dir, c) + (16 * wid + l15) * 64 + 8 * g;
#pragma unroll
    for (int kk = 0; kk < 2; kk++) {
      n_qe[kk] = *(const u32x4*)(base + kk * 32);
      n_kl[kk] = *(const u32x4*)(base + 4096 + kk * 32);
      n_at[kk] = *(const u32x4*)(base + 8192 + kk * 32);
    }
    n_el = EL[c * 64 + 16 * wid + l15];
#pragma unroll
    for (int ii = 0; ii < 2; ii++) {
      int cc = tid + 256 * ii;
      int i = cc >> 3, c8 = cc & 7;
      int tok = dir ? (N - 1 - (c * 64 + i)) : (c * 64 + i);
      n_v[ii] = *(const u32x4*)(Z + (long)(rowbase + tok) * ZLD + C_VG + h * 128 + vs0 + c8 * 8);
    }
  };
  prefetch(0);
  for (int c = 0; c < nc; c++) {
    u32x4 c_qe[2] = {n_qe[0], n_qe[1]}, c_kl[2] = {n_kl[0], n_kl[1]}, c_at[2] = {n_at[0], n_at[1]};
    const float el = n_el;
#pragma unroll
    for (int ii = 0; ii < 2; ii++) {
      int cc = tid + 256 * ii;
      int i = cc >> 3, c8 = cc & 7;
      const bfr* rb = (const bfr*)&n_v[ii];
#pragma unroll
      for (int e = 0; e < 8; e++) Vt[(c8 * 8 + e) * LDT + i] = rb[e];
    }
    __syncthreads();
    if (c + 1 < nc) prefetch(c + 1);
    f32x4 stn[4];
    const int i = 16 * wid + l15;
    const int tok = dir ? (N - 1 - (c * 64 + i)) : (c * 64 + i);
    bfr* og = OG + (long)(rowbase + tok) * 512 + h * 128 + vs0 + 4 * g;
#pragma unroll
    for (int vt = 0; vt < 4; vt++) {
      f32x4 oc = (f32x4){0.f, 0.f, 0.f, 0.f};
      stn[vt] = st[vt] * el;
#pragma unroll
      for (int kk = 0; kk < 2; kk++) {
        bf16x8 vf = *(const bf16x8*)(Vt + (16 * vt + l15) * LDT + kk * 32 + g * 8);
        bf16x8 sf = *(const bf16x8*)(St + (16 * vt + l15) * LDT + kk * 32 + g * 8);
        oc = mfma16(vf, *(bf16x8*)&c_at[kk], oc);
        oc = mfma16(sf, *(bf16x8*)&c_qe[kk], oc);
        stn[vt] = mfma16(vf, *(bf16x8*)&c_kl[kk], stn[vt]);
      }
      u32x2 ov;
      ov.x = pack2(oc[0], oc[1]);
      ov.y = pack2(oc[2], oc[3]);
      *(u32x2*)(og + 16 * vt) = ov;
    }
    __syncthreads();
#pragma unroll
    for (int vt = 0; vt < 4; vt++) {
      st[vt] = stn[vt];
#pragma unroll
      for (int r = 0; r < 4; r++) St[(16 * vt + 4 * g + r) * LDT + 16 * wid + l15] = f2bf(st[vt][r]);
    }
  }
  __syncthreads();
}

template <int VS>
__device__ __forceinline__ void gla_item(const Params& p, int l, int seq, int h, int dir, int vsl, bfr* sm) {
  constexpr int NVT = VS / 16;
  constexpr int NVL = VS / 32;
  const int tid = TIDX, lane = tid & 63, wid = tid >> 6, g = lane >> 4, l15 = lane & 15;
  bfr* Z = (bfr*)(p.ws + WS_Z);
  bfr* OG = (bfr*)(p.ws + WS_R1) + (long)dir * NROWS * 512;
  const bool lat = seq >= 16;
  const int b = seq - 16;
  const int N = lat ? 4096 : 256;
  const int rowbase = lat ? NCTX + b * 4096 : seq * 256;
  const int nc = N >> 6;
  const int vs0 = vsl * VS;
  bfr* Qr = sm;
  bfr* Kr = Qr + 64 * LDT;
  bfr* Qe = Kr + 64 * LDT;
  bfr* Ke = Qe + 64 * LDT;
  bfr* KlT = Ke + 64 * LDT;
  float* RF = (float*)(KlT + 64 * LDT);
  float* tot = RF + 64 * 16;
  float* lastv = tot + 256;
  bfr* Vt = (bfr*)(lastv + 64);
  bfr* St = Vt + VS * LDT;
  bfr* Att = Qr;
  const int ch = tid & 63;
  float wd[16];
  {
    const float* W = (dir ? p.in[19] : p.in[17]) + (long)l * 16 * 256 + h * 64 + ch;
#pragma unroll
    for (int r = 0; r < 16; r++) wd[r] = W[r * 256];
  }
  const float bias = (dir ? p.in[20] : p.in[18])[l * 256 + h * 64 + ch];

  f32x4 st[NVT];
  {
    const float* S0 = (dir ? p.in[7] : p.in[6]) + ((long)((b * 2 + l) * 4 + h)) * 8192 + (long)(16 * wid + l15) * 128 + vs0;
#pragma unroll
    for (int mv = 0; mv < NVT; mv++) {
      if (lat) {
        float4 a = *(const float4*)(S0 + 16 * mv + 4 * g);
        st[mv] = (f32x4){a.x, a.y, a.z, a.w};
      } else {
        st[mv] = (f32x4){0.f, 0.f, 0.f, 0.f};
      }
#pragma unroll
      for (int r = 0; r < 4; r++) St[(16 * mv + 4 * g + r) * LDT + 16 * wid + l15] = f2bf(st[mv][r]);
    }
  }
  u32x4 rq[2], rk[2], rv[NVL], rr;
  auto prefetch = [&](int c) {
#pragma unroll
    for (int ii = 0; ii < 2; ii++) {
      int cc = tid + 256 * ii;
      int i = cc >> 3, c8 = cc & 7;
      int tok = dir ? (N - 1 - (c * 64 + i)) : (c * 64 + i);
      const bfr* zr = Z + (long)(rowbase + tok) * ZLD;
      rq[ii] = *(const u32x4*)(zr + C_QG + h * 64 + c8 * 8);
      rk[ii] = *(const u32x4*)(zr + C_KG + h * 64 + c8 * 8);
    }
#pragma unroll
    for (int ii = 0; ii < NVL; ii++) {
      int cc = tid + 256 * ii;
      int i = cc / (VS / 8), c4 = cc % (VS / 8);
      int tok = dir ? (N - 1 - (c * 64 + i)) : (c * 64 + i);
      rv[ii] = *(const u32x4*)(Z + (long)(rowbase + tok) * ZLD + C_VG + h * 128 + vs0 + c4 * 8);
    }
    if (tid < 128) {
      int i = tid >> 1, hf = tid & 1;
      int tok = dir ? (N - 1 - (c * 64 + i)) : (c * 64 + i);
      rr = *(const u32x4*)(Z + (long)(rowbase + tok) * ZLD + (dir ? C_RB : C_RF) + hf * 8);
    }
  };
  prefetch(0);
  for (int c = 0; c < nc; c++) {
#pragma unroll
    for (int ii = 0; ii < 2; ii++) {
      int cc = tid + 256 * ii;
      *(u32x4*)(Qr + (cc >> 3) * LDT + (cc & 7) * 8) = rq[ii];
      *(u32x4*)(Kr + (cc >> 3) * LDT + (cc & 7) * 8) = rk[ii];
    }
#pragma unroll
    for (int ii = 0; ii < NVL; ii++) {
      int cc = tid + 256 * ii;
      int i = cc / (VS / 8), c4 = cc % (VS / 8);
      const bfr* rb = (const bfr*)&rv[ii];
#pragma unroll
      for (int e = 0; e < 8; e++) Vt[(c4 * 8 + e) * LDT + i] = rb[e];
    }
    if (tid < 128) {
      int i = tid >> 1, hf = tid & 1;
      float x[8];
      unpack8(rr, x);
#pragma unroll
      for (int e = 0; e < 8; e++) RF[i * 16 + hf * 8 + e] = x[e];
    }
    __syncthreads();
    if (c + 1 < nc) prefetch(c + 1);
    gla_chunk_prep(tid, wd, bias, Qr, Kr, Qe, Ke, KlT, RF, tot, lastv);
    f32x4 stn[NVT];
    {
      float el = __expf(lastv[16 * wid + l15]);
#pragma unroll
      for (int mv = 0; mv < NVT; mv++) {
        stn[mv] = st[mv] * el;
#pragma unroll
        for (int kk = 0; kk < 2; kk++) {
          bf16x8 va = *(const bf16x8*)(Vt + (16 * mv + l15) * LDT + kk * 32 + g * 8);
          bf16x8 kb = *(const bf16x8*)(KlT + (16 * wid + l15) * LDT + kk * 32 + g * 8);
          stn[mv] = mfma16(va, kb, stn[mv]);
        }
      }
      gla_att(wid, g, l15, Qe, Ke, Att);
    }
    __syncthreads();
    {
      bf16x8 aa[2], qa[2];
#pragma unroll
      for (int kk = 0; kk < 2; kk++) {
        aa[kk] = *(const bf16x8*)(Att + (16 * wid + l15) * LDT + kk * 32 + g * 8);
        qa[kk] = *(const bf16x8*)(Qe + (16 * wid + l15) * LDT + kk * 32 + g * 8);
      }
#pragma unroll
      for (int nv = 0; nv < NVT; nv++) {
        f32x4 oc = (f32x4){0.f, 0.f, 0.f, 0.f};
#pragma unroll
        for (int kk = 0; kk < 2; kk++) {
          bf16x8 vb = *(const bf16x8*)(Vt + (16 * nv + l15) * LDT + kk * 32 + g * 8);
          oc = mfma16(aa[kk], vb, oc);
          bf16x8 sb = *(const bf16x8*)(St + (16 * nv + l15) * LDT + kk * 32 + g * 8);
          oc = mfma16(qa[kk], sb, oc);
        }
#pragma unroll
        for (int r = 0; r < 4; r++) {
          int i = 16 * wid + 4 * g + r;
          int tok = dir ? (N - 1 - (c * 64 + i)) : (c * 64 + i);
          OG[(long)(rowbase + tok) * 512 + h * 128 + vs0 + 16 * nv + l15] = f2bf(oc[r]);
        }
      }
    }
    __syncthreads();
#pragma unroll
    for (int mv = 0; mv < NVT; mv++) {
      st[mv] = stn[mv];
#pragma unroll
      for (int r = 0; r < 4; r++) St[(16 * mv + 4 * g + r) * LDT + 16 * wid + l15] = f2bf(st[mv][r]);
    }
  }
  __syncthreads();
  if (!lat) {
    float* so = p.out + (dir ? O_SB : O_SF) + ((long)((seq * 2 + l) * 4 + h)) * 8192 + (long)(16 * wid + l15) * 128 + vs0;
#pragma unroll
    for (int mv = 0; mv < NVT; mv++)
      *(float4*)(so + 16 * mv + 4 * g) = make_float4(st[mv][0], st[mv][1], st[mv][2], st[mv][3]);
  }
}

__device__ __forceinline__ void phase_mla_up(const Params& p, int l, bfr* sm) {
  bfr* Z = (bfr*)(p.ws + WS_Z);
  const float* rope = (const float*)(p.ws + WS_ROPE);
  const int lane = TIDX & 63, wid = TIDX >> 6, wr = wid >> 1, wc = wid & 1;
  const int g = lane >> 4;
  for (int t = blockIdx.x; t < 288 + 624 + 1024; t += gridDim.x) {
    if (t >= 912) {
      int i = t - 912;
      gla_prep_item(p, l, i >> 9, (i >> 7) & 3, (i >> 6) & 1, i & 63, sm);
      continue;
    }
    f32x4 acc[4][4];
#pragma unroll
    for (int a = 0; a < 4; a++)
#pragma unroll
      for (int b = 0; b < 4; b++) acc[a][b] = (f32x4){0.f, 0.f, 0.f, 0.f};
    if (t < 288) {
      int tn = t % 3, tm = t / 3;
      gemm128((const bfr*)(p.ws + WS_WUQ) + (long)tn * 128 * 256, 256, 128, Z + (long)tm * 128 * ZLD + C_QL, ZLD, 128, 256,
              acc, sm);
      bfr* CQ = (bfr*)(p.ws + WS_CQ);
      const float qs = 0.10206207261596577f * 1.4426950408889634f;
#pragma unroll
      for (int pi = 0; pi < 4; pi++) {
        int nb = tn * 128 + wr * 64 + pi * 16;
        int wb = nb % 96;
        bool ropet = wb >= 64;
        int part = (wb - 64) >> 4;
#pragma unroll
        for (int qi = 0; qi < 4; qi++) {
          int tok = tm * 128 + wc * 64 + qi * 16 + (lane & 15);
          float y[4] = {acc[pi][qi][0], acc[pi][qi][1], acc[pi][qi][2], acc[pi][qi][3]};
          if (ropet) {
            bool lat = tok >= NCTX;
            int tl = (tok - NCTX) & 4095;
            int pos = part ? (tl & 63) : (tl >> 6);
            bool hi = (g & 2) != 0;
            int i0 = (g & 1) * 4;
#pragma unroll
            for (int r = 0; r < 4; r++) {
              float yp = __shfl_xor(y[r], 32);
              float c = rope[2048 + pos * 8 + i0 + r], s = rope[2560 + pos * 8 + i0 + r];
              float yr = hi ? (yp * s + y[r] * c) : (y[r] * c - yp * s);
              y[r] = lat ? yr : y[r];
            }
          }
          u32x2 o;
          o.x = pack2(y[0] * qs, y[1] * qs);
          o.y = pack2(y[2] * qs, y[3] * qs);
          *(u32x2*)(CQ + (long)tok * 384 + nb + g * 4) = o;
        }
      }
    } else {
      int t2 = t - 288;
      int tn = t2 % 6, tm = t2 / 6;
      const bfr* Q;
      long ldq;
      long kbase, vbase;
      int nk, key0;
      if (tm < 32) {
        Q = Z + (long)tm * 128 * ZLD + C_KV;
        ldq = ZLD;
        int s = tm >> 1;
        key0 = (tm & 1) * 128;
        nk = 256;
        kbase = (long)s * (4 * 256 * 64);
        vbase = (long)s * 131072;
      } else {
        int r = (tm - 32) * 128;
        int b = r / 4608, within = r % 4608;
        key0 = within;
        nk = 4608;
        kbase = 16l * (4 * 256 * 64) + (long)b * (4 * 4608 * 64);
        vbase = 16l * 131072 + (long)b * (4 * 128 * 4608);
        if (within < 512) {
          Q = (const bfr*)(p.ws + WS_CKVC) + (long)(b * 512 + within) * 256;
          ldq = 256;
        } else {
          Q = Z + (long)(NCTX + b * 4096 + within - 512) * ZLD + C_KV;
          ldq = ZLD;
        }
      }
      gemm128((const bfr*)(p.ws + WS_WUKV) + (long)tn * 128 * 256, 256, 128, Q, ldq, 128, 256, acc, sm);
      bfr* KN = (bfr*)(p.ws + WS_KNOPE);
      bfr* VTC = (bfr*)(p.ws + WS_VTC);
#pragma unroll
      for (int pi = 0; pi < 4; pi++) {
        int n0 = tn * 128 + wr * 64 + pi * 16 + g * 4;
        int head = n0 / 192, w = n0 % 192;
#pragma unroll
        for (int qi = 0; qi < 4; qi++) {
          int key = key0 + wc * 64 + qi * 16 + (lane & 15);
          if (w < 64) {
            u32x2 o;
            o.x = pack2(acc[pi][qi][0], acc[pi][qi][1]);
            o.y = pack2(acc[pi][qi][2], acc[pi][qi][3]);
            *(u32x2*)(KN + kbase + ((long)head * nk + key) * 64 + w) = o;
          } else {
#pragma unroll
            for (int r = 0; r < 4; r++)
              VTC[vbase + ((long)head * 128 + (w - 64) + r) * nk + key] = f2bf(acc[pi][qi][r]);
          }
        }
      }
    }
  }
}

template <int DQ, int DV, bool MLA>
__device__ __forceinline__ void attn_item(const Params& p, int seq, int head, int qblk, bfr* sm, int dry) {
  constexpr int KLD = DQ + 8;
  constexpr int KSZ = 64 * KLD;
  constexpr int VSZ = DV * LDT;
  constexpr int BUF = KSZ + VSZ;
  constexpr int NKK = DQ / 32;
  constexpr int NDV = DV / 16;
  constexpr int NVL = DV / 32;
  const int tid = TIDX, lane = tid & 63, wid = tid >> 6, g = lane >> 4, l15 = lane & 15;
  bfr* Z = (bfr*)(p.ws + WS_Z);
  const bool lat = seq >= 16;
  const int b = seq - 16;
  const int nk = lat ? 4608 : 256;
  const int rowbase = lat ? NCTX + b * 4096 : seq * 256;
  const int nkt = nk >> 6;

  bf16x8 qf[2][NKK];
#pragma unroll
  for (int qb = 0; qb < 2; qb++) {
    int qrow = rowbase + qblk * 128 + wid * 32 + qb * 16 + l15;
    const bfr* qp = MLA ? ((const bfr*)(p.ws + WS_CQ) + (long)qrow * 384 + head * 96) : (Z + (long)qrow * ZLD + C_QA + head * 64);
#pragma unroll
    for (int kk = 0; kk < NKK; kk++) qf[qb][kk] = *(const bf16x8*)(qp + kk * 32 + g * 8);
  }

  u32x4 rk[2], rkr, rv[NVL];
  auto prefetch = [&](int kt) {
    int k0 = kt * 64;
    bool cache = lat && (k0 < 512);
    int tokrow0 = lat ? (NCTX + b * 4096 + k0 - 512) : (seq * 256 + k0);
    if (!MLA) {
      int kvh = head >> 2;
#pragma unroll
      for (int i = 0; i < 2; i++) {
        int c = tid + 256 * i;
        int kr_ = c >> 3, ch = c & 7;
        const bfr* src = cache ? ((const bfr*)(p.ws + WS_KCA) + (long)(b * 512 + k0 + kr_) * 128 + kvh * 64 + ch * 8)
                               : (Z + (long)(tokrow0 + kr_) * ZLD + C_KA + kvh * 64 + ch * 8);
        rk[i] = *(const u32x4*)src;
      }
      long vb = lat ? (16l * 32768 + (long)b * (2 * 64 * 4608)) : ((long)seq * 32768);
#pragma unroll
      for (int i = 0; i < NVL; i++) {
        int c = tid + 256 * i;
        int dv = c >> 3, ch = c & 7;
        rv[i] = *(const u32x4*)((const bfr*)(p.ws + WS_VTA) + vb + (long)(kvh * 64 + dv) * nk + k0 + ch * 8);
      }
    } else {
      long kb = lat ? (16l * (4 * 256 * 64) + (long)b * (4 * 4608 * 64)) : ((long)seq * (4 * 256 * 64));
#pragma unroll
      for (int i = 0; i < 2; i++) {
        int c = tid + 256 * i;
        int kr_ = c >> 3, ch = c & 7;
        rk[i] = *(const u32x4*)((const bfr*)(p.ws + WS_KNOPE) + kb + ((long)head * nk + k0 + kr_) * 64 + ch * 8);
      }
      {
        int kr_ = tid >> 2, ch = tid & 3;
        const bfr* src = cache ? ((const bfr*)(p.ws + WS_KRC) + (long)(b * 512 + k0 + kr_) * 32 + ch * 8)
                               : (Z + (long)(tokrow0 + kr_) * ZLD + C_KR + ch * 8);
        rkr = *(const u32x4*)src;
      }
      long vb = lat ? (16l * 131072 + (long)b * (4 * 128 * 4608)) : ((long)seq * 131072);
#pragma unroll
      for (int i = 0; i < NVL; i++) {
        int c = tid + 256 * i;
        int dv = c >> 3, ch = c & 7;
        rv[i] = *(const u32x4*)((const bfr*)(p.ws + WS_VTC) + vb + (long)(head * 128 + dv) * nk + k0 + ch * 8);
      }
    }
  };

  f32x4 o[2][NDV];
#pragma unroll
  for (int qb = 0; qb < 2; qb++)
#pragma unroll
    for (int d = 0; d < NDV; d++) o[qb][d] = (f32x4){0.f, 0.f, 0.f, 0.f};
  float mrun[2] = {-1e30f, -1e30f}, lsum[2] = {0.f, 0.f};

  prefetch(0);
  for (int kt = 0; kt < nkt; kt++) {
    bfr* Ks = sm + (kt & 1) * BUF;
    bfr* Vs = Ks + KSZ;
#pragma unroll
    for (int i = 0; i < 2; i++) {
      int c = tid + 256 * i;
      *(u32x4*)(Ks + (c >> 3) * KLD + (c & 7) * 8) = rk[i];
    }
    if (MLA) *(u32x4*)(Ks + (tid >> 2) * KLD + 64 + (tid & 3) * 8) = rkr;
#pragma unroll
    for (int i = 0; i < NVL; i++) {
      int c = tid + 256 * i;
      *(u32x4*)(Vs + (c >> 3) * LDT + (c & 7) * 8) = rv[i];
    }
    __syncthreads();
    if (kt + 1 < nkt) prefetch(kt + 1);

    f32x4 s[2][4];
#pragma unroll
    for (int t = 0; t < 4; t++) {
      s[0][t] = (f32x4){0.f, 0.f, 0.f, 0.f};
      s[1][t] = (f32x4){0.f, 0.f, 0.f, 0.f};
      int krow = 32 * (t >> 1) + 8 * (l15 >> 2) + 4 * (t & 1) + (l15 & 3);
#pragma unroll
      for (int kk = 0; kk < NKK; kk++) {
        bf16x8 kf = *(const bf16x8*)(Ks + krow * KLD + kk * 32 + g * 8);
        s[0][t] = mfma16(kf, qf[0][kk], s[0][t]);
        s[1][t] = mfma16(kf, qf[1][kk], s[1][t]);
      }
    }
    bf16x8 pf[2][2];
#pragma unroll
    for (int qb = 0; qb < 2; qb++) {
      float mt = s[qb][0][0];
#pragma unroll
      for (int t = 0; t < 4; t++)
#pragma unroll
        for (int r = 0; r < 4; r++) mt = fmaxf(mt, s[qb][t][r]);
      mt = fmaxf(mt, __shfl_xor(mt, 16));
      mt = fmaxf(mt, __shfl_xor(mt, 32));
      float mnew = fmaxf(mrun[qb], mt);
      float alpha = __builtin_amdgcn_exp2f(mrun[qb] - mnew);
      mrun[qb] = mnew;
      float ps = 0.f;
#pragma unroll
      for (int t = 0; t < 4; t++)
#pragma unroll
        for (int r = 0; r < 4; r++) {
          float pv = __builtin_amdgcn_exp2f(s[qb][t][r] - mnew);
          ps += pv;
          s[qb][t][r] = pv;
        }
      lsum[qb] = lsum[qb] * alpha + ps;
#pragma unroll
      for (int d = 0; d < NDV; d++) {
        o[qb][d][0] *= alpha; o[qb][d][1] *= alpha; o[qb][d][2] *= alpha; o[qb][d][3] *= alpha;
      }
#pragma unroll
      for (int sx = 0; sx < 2; sx++) {
        u32x4 u;
        u.x = pack2(s[qb][2 * sx][0], s[qb][2 * sx][1]);
        u.y = pack2(s[qb][2 * sx][2], s[qb][2 * sx][3]);
        u.z = pack2(s[qb][2 * sx + 1][0], s[qb][2 * sx + 1][1]);
        u.w = pack2(s[qb][2 * sx + 1][2], s[qb][2 * sx + 1][3]);
        pf[qb][sx] = *(bf16x8*)&u;
      }
    }
#pragma unroll
    for (int d = 0; d < NDV; d++) {
#pragma unroll
      for (int sx = 0; sx < 2; sx++) {
        bf16x8 vf = *(const bf16x8*)(Vs + (d * 16 + l15) * LDT + sx * 32 + g * 8);
        o[0][d] = mfma16(vf, pf[0][sx], o[0][d]);
        o[1][d] = mfma16(vf, pf[1][sx], o[1][d]);
      }
    }
  }
  __syncthreads();
#pragma unroll
  for (int qb = 0; qb < 2; qb++) {
    float lt = lsum[qb];
    lt += __shfl_xor(lt, 16);
    lt += __shfl_xor(lt, 32);
    float inv = 1.f / lt;
    int qrow = rowbase + qblk * 128 + wid * 32 + qb * 16 + l15;
    bfr* gp = Z + (long)qrow * ZLD + (MLA ? C_GC : C_GA) + head * DV + g * 4;
#pragma unroll
    for (int d = 0; d < NDV; d++) {
      u32x2 gr = *(const u32x2*)(gp + d * 16);
      float y0 = o[qb][d][0] * inv * siluf(lo16(gr.x));
      float y1 = o[qb][d][1] * inv * siluf(hi16(gr.x));
      float y2 = o[qb][d][2] * inv * siluf(lo16(gr.y));
      float y3 = o[qb][d][3] * inv * siluf(hi16(gr.y));
      u32x2 ov;
      ov.x = pack2(y0, y1);
      ov.y = pack2(y2, y3);
      if (!dry) *(u32x2*)(gp + d * 16) = ov;
    }
  }
}

__device__ __forceinline__ void phase_mixers(const Params& p, int l, bfr* sm, int* s_item, int dry) {
  unsigned* ctr = (unsigned*)(p.ws + WS_CTR) + (2 + l + 2 * dry) * 128;
  auto cnt = [](int) { return 180; };
  int q = (int)xcc_id(), tried = 0;
  for (;;) {
    if (TIDX == 0) {
      unsigned first = atomicAdd(ctr + q * 16, 1u);
      *s_item = xq_take(ctr, q, tried, first, cnt);
    }
    __syncthreads();
    const int it = *s_item;
    __syncthreads();
    if (it < 0) break;
    const int x = it >> 20, j = it & 0xfffff;
    int kind, a0, a1, a2, a3 = 0;
    if (j < 4) {
      int idx = x * 4 + j;
      kind = 3; a0 = idx >> 4; a1 = (idx >> 2) & 3; a2 = (idx >> 1) & 1; a3 = idx & 1;
    } else if (j < 36) {
      kind = 1; a0 = 16 + (x >> 2); a1 = x & 3; a2 = j - 4;
    } else if (j < 100) {
      int i = j - 36;
      kind = 2; a0 = 16 + (x >> 2); a1 = ((x >> 1) & 1) * 4 + (x & 1) * 2 + (i >> 5); a2 = i & 31;
    } else if (j < 132) {
      int i = j - 100;
      kind = 0; a0 = 2 * x + (i >> 4); a1 = (i >> 2) & 3; a2 = (i >> 1) & 1; a3 = i & 1;
    } else if (j < 148) {
      int i = j - 132;
      kind = 1; a0 = 2 * x + (i >> 3); a1 = (i >> 1) & 3; a2 = i & 1;
    } else {
      int i = j - 148;
      kind = 2; a0 = 2 * x + (i >> 4); a1 = (i >> 1) & 7; a2 = i & 1;
    }
#ifdef PROBE_MIXKIND
    if (dry && ((PROBE_MIXKIND == 1) != (kind == 0 || kind == 3))) continue;
#endif
    if (kind == 0) gla_item<64>(p, l, a0, a1, a2, a3, sm);
    else if (kind == 3) gla_chain_item(p, l, a0, a1, a2, a3, sm);
    else if (kind == 1) attn_item<96, 128, true>(p, a0, a1, a2, sm, dry);
    else attn_item<64, 64, false>(p, a0, a1, a2, sm, dry);
  }
}

__device__ __forceinline__ void phase_gla_out(const Params& p, int l) {
  const int lane = TIDX & 63;
  bfr* Z = (bfr*)(p.ws + WS_Z);
  const bfr* OF = (const bfr*)(p.ws + WS_R1);
  const bfr* OB = OF + (long)NROWS * 512;
  for (int row = blockIdx.x * 4 + (TIDX >> 6); row < NROWS; row += gridDim.x * 4) {
    float a[8], c[8], gt[8];
    unpack8(*(const u32x4*)(OF + (long)row * 512 + lane * 8), a);
    unpack8(*(const u32x4*)(OB + (long)row * 512 + lane * 8), c);
    bfr* gp = Z + (long)row * ZLD + C_GG + lane * 8;
    unpack8(*(const u32x4*)gp, gt);
    float ss = 0.f;
#pragma unroll
    for (int e = 0; e < 8; e++) {
      a[e] = bf2f(f2bf(a[e] + c[e]));
      ss += a[e] * a[e];
    }
    ss += __shfl_xor(ss, 1); ss += __shfl_xor(ss, 2); ss += __shfl_xor(ss, 4); ss += __shfl_xor(ss, 8);
    float rs = rsqrtf(ss * (1.f / 128.f) + 1e-6f);
    const float* gg = p.in[21] + l * 128 + (lane & 15) * 8;
#pragma unroll
    for (int e = 0; e < 8; e++) a[e] = a[e] * rs * gg[e] * siluf(gt[e]);
    *(u32x4*)gp = pack8(a);
  }
}

__device__ __forceinline__ void phase_merge(const Params& p, bfr* sm) {
  bfr* Z = (bfr*)(p.ws + WS_Z);
  bfr* MG = (bfr*)(p.ws + WS_R1);
  const int lane = TIDX & 63, wid = TIDX >> 6, wr = wid >> 1, wc = wid & 1, g = lane >> 4;
  for (int t = blockIdx.x; t < 96 * 8; t += gridDim.x) {
    int tn = t & 7, tm = t >> 3;
    f32x4 totl[4][4];
#pragma unroll
    for (int a = 0; a < 4; a++)
#pragma unroll
      for (int b = 0; b < 4; b++) totl[a][b] = (f32x4){0.f, 0.f, 0.f, 0.f};
#pragma unroll 1
    for (int seg = 0; seg < 3; seg++) {
      f32x4 acc[4][4];
#pragma unroll
      for (int a = 0; a < 4; a++)
#pragma unroll
        for (int b = 0; b < 4; b++) acc[a][b] = (f32x4){0.f, 0.f, 0.f, 0.f};
      int ycol = seg == 0 ? C_GA : (seg == 1 ? C_GG : C_GC);
      int mcol = C_M1 + seg * 1024;
      const bfr* W = (const bfr*)(p.ws + WS_WOA + (unsigned long)seg * 1048576ul) + (long)tn * 128 * 512;
      gemm128(W, 512, 128, Z + (long)tm * 128 * ZLD + ycol, ZLD, 128, 512, acc, sm);
#pragma unroll
      for (int pi = 0; pi < 4; pi++) {
        int n0 = tn * 128 + wr * 64 + pi * 16 + g * 4;
#pragma unroll
        for (int qi = 0; qi < 4; qi++) {
          int tok = tm * 128 + wc * 64 + qi * 16 + (lane & 15);
          u32x2 mr = *(const u32x2*)(Z + (long)tok * ZLD + mcol + n0);
          totl[pi][qi][0] += sigmf(lo16(mr.x)) * acc[pi][qi][0];
          totl[pi][qi][1] += sigmf(hi16(mr.x)) * acc[pi][qi][1];
          totl[pi][qi][2] += sigmf(lo16(mr.y)) * acc[pi][qi][2];
          totl[pi][qi][3] += sigmf(hi16(mr.y)) * acc[pi][qi][3];
        }
      }
    }
#pragma unroll
    for (int pi = 0; pi < 4; pi++) {
      int n0 = tn * 128 + wr * 64 + pi * 16 + g * 4;
#pragma unroll
      for (int qi = 0; qi < 4; qi++) {
        int tok = tm * 128 + wc * 64 + qi * 16 + (lane & 15);
        u32x2 o;
        o.x = pack2(totl[pi][qi][0], totl[pi][qi][1]);
        o.y = pack2(totl[pi][qi][2], totl[pi][qi][3]);
        *(u32x2*)(MG + (long)tok * 1024 + n0) = o;
      }
    }
  }
}

__device__ __forceinline__ void phase_outproj(const Params& p, bfr* sm) {
  const bfr* MG = (const bfr*)(p.ws + WS_R1);
  float* OUT = (float*)(p.ws + WS_Z);
  const int lane = TIDX & 63, wid = TIDX >> 6, wr = wid >> 1, wc = wid & 1, g = lane >> 4;
  for (int t = blockIdx.x; t < 96 * 8; t += gridDim.x) {
    int tn = t & 7, tm = t >> 3;
    f32x4 acc[4][4];
#pragma unroll
    for (int a = 0; a < 4; a++)
#pragma unroll
      for (int b = 0; b < 4; b++) acc[a][b] = (f32x4){0.f, 0.f, 0.f, 0.f};
    gemm128((const bfr*)(p.ws + WS_WOUT) + (long)tn * 128 * 1024, 1024, 128, MG + (long)tm * 128 * 1024, 1024, 128, 1024, acc,
            sm);
#pragma unroll
    for (int pi = 0; pi < 4; pi++) {
      int n0 = tn * 128 + wr * 64 + pi * 16 + g * 4;
#pragma unroll
      for (int qi = 0; qi < 4; qi++) {
        int tok = tm * 128 + wc * 64 + qi * 16 + (lane & 15);
        *(float4*)(OUT + (long)tok * 1024 + n0) = make_float4(acc[pi][qi][0], acc[pi][qi][1], acc[pi][qi][2], acc[pi][qi][3]);
      }
    }
  }
}

__device__ __forceinline__ void phase_post(const Params& p, int l) {
  const int lane = TIDX & 63;
  const float* mod = (const float*)(p.ws + WS_MOD);
  const float* OUT = (const float*)(p.ws + WS_Z);
  bfr* H = (bfr*)(p.ws + WS_R1);
  for (int row = blockIdx.x * 4 + (TIDX >> 6); row < NROWS; row += gridDim.x * 4) {
    const float* x = (l == 0) ? xrow(p, row) : (p.out + (long)row * 1024);
    const float* md = mod + (l * 3 + row_cond(row)) * 3072;
    float4 v[4];
    float ss = 0.f;
#pragma unroll
    for (int i = 0; i < 4; i++) {
      v[i] = *(const float4*)(OUT + (long)row * 1024 + i * 256 + lane * 4);
      ss += v[i].x * v[i].x + v[i].y * v[i].y + v[i].z * v[i].z + v[i].w * v[i].w;
    }
    ss = wave_sum(ss);
    float rs = rsqrtf(ss * (1.f / 1024.f) + 1e-6f);
    float ss2 = 0.f;
#pragma unroll
    for (int i = 0; i < 4; i++) {
      int n = i * 256 + lane * 4;
      float4 g = *(const float4*)(p.in[13] + l * 1024 + n);
      float4 gt = *(const float4*)(md + 2048 + n);
      float4 xv = *(const float4*)(x + n);
      v[i].x = xv.x + gt.x * (v[i].x * rs * g.x);
      v[i].y = xv.y + gt.y * (v[i].y * rs * g.y);
      v[i].z = xv.z + gt.z * (v[i].z * rs * g.z);
      v[i].w = xv.w + gt.w * (v[i].w * rs * g.w);
      *(float4*)(p.out + (long)row * 1024 + n) = v[i];
      ss2 += v[i].x * v[i].x + v[i].y * v[i].y + v[i].z * v[i].z + v[i].w * v[i].w;
    }
    if (l == 0) {
      ss2 = wave_sum(ss2);
      float rs2 = rsqrtf(ss2 * (1.f / 1024.f) + 1e-6f);
      const float* md1 = mod + (1 * 3 + row_cond(row)) * 3072;
#pragma unroll
      for (int i = 0; i < 4; i++) {
        int n = i * 256 + lane * 4;
        float4 g = *(const float4*)(p.in[12] + 1024 + n);
        float4 sh = *(const float4*)(md1 + n);
        float4 sc = *(const float4*)(md1 + 1024 + n);
        float h0 = v[i].x * rs2 * g.x * (1.f + sc.x) + sh.x;
        float h1 = v[i].y * rs2 * g.y * (1.f + sc.y) + sh.y;
        float h2 = v[i].z * rs2 * g.z * (1.f + sc.z) + sh.z;
        float h3 = v[i].w * rs2 * g.w * (1.f + sc.w) + sh.w;
        u32x2 o;
        o.x = pack2(h0, h1);
        o.y = pack2(h2, h3);
        *(u32x2*)(H + (long)row * 1024 + n) = o;
      }
    }
  }
}

__global__ void __launch_bounds__(256, 2) fwd_megakernel(Params p) {
  __shared__ __attribute__((aligned(16))) bfr sm[SMEM_SHORTS + 16];
  int* s_item_p = (int*)(sm + SMEM_SHORTS + 8);
  cg::grid_group grid = cg::this_grid();
  if (threadIdx.x == 0) { ((unsigned*)(sm + SMEM_SHORTS))[0] = 0u; ((unsigned*)(sm + SMEM_SHORTS))[1] = 0u; }
  __syncthreads();
  XcdBarrier xb = xcd_barrier_post((unsigned*)(p.ws + WS_BAR), (volatile LAS unsigned*)(sm + SMEM_SHORTS));
  if (p.ws == nullptr) grid.sync();
#ifdef PROBE_SYNC
#define GSYNC do { xcd_barrier(xb); xcd_barrier(xb); } while (0)
#else
#define GSYNC xcd_barrier(xb)
#endif
#ifdef PROBE_PRE
  phase_s0(launder(p), sm);
  GSYNC;
  phase_s1(launder(p));
  wconv_phase(p, 0, sm);
  GSYNC;
  phase_prenorm0(launder(p));
  GSYNC;
#endif

#ifndef PH
#define PH 0xffff
#endif
#if PH & 1
  phase_s0(launder(p), sm);
#endif
  GSYNC;
#if PH & 2
  phase_s1(launder(p));
  wconv_phase(p, 0, sm);
#endif
  GSYNC;
#if PH & 4
  phase_prenorm0(launder(p));
#endif
  GSYNC;
  for (int l = 0; l < 2; l++) {
#if PH & 8
#ifdef PROBE_INPROJ
    phase_inproj(launder(p), l, sm, s_item_p);
    GSYNC;
#endif
    phase_inproj(launder(p), l, sm, s_item_p);
#endif
    GSYNC;
#if PH & 16
    phase_rowpost(launder(p), l);
#endif
    GSYNC;
#if PH & 32
#ifdef PROBE_MLAUP
    phase_mla_up(launder(p), l, sm);
    GSYNC;
#endif
    phase_mla_up(launder(p), l, sm);
#endif
    GSYNC;
#if PH & 64
#ifdef PROBE_MIX
    { int dry = 1; asm volatile("" : "+s"(dry)); phase_mixers(launder(p), l, sm, s_item_p, dry); }
    GSYNC;
#endif
    { int dry = 0; asm volatile("" : "+s"(dry)); phase_mixers(launder(p), l, sm, s_item_p, dry); }
#endif
    GSYNC;
#if PH & 128
    phase_gla_out(launder(p), l);
#endif
    GSYNC;
#if PH & 256
#ifdef PROBE_MERGE
    phase_merge(launder(p), sm);
    GSYNC;
#endif
    phase_merge(launder(p), sm);
#endif
    GSYNC;
#if PH & 512
#ifdef PROBE_MERGE
    phase_outproj(launder(p), sm);
    GSYNC;
#endif
    phase_outproj(launder(p), sm);
#endif
    GSYNC;
#if PH & 1024
    phase_post(launder(p), l);
    if (l == 0) wconv_phase(p, 1, sm);
#endif
    GSYNC;
  }
}

extern "C" void kernel_launch(void* const* d_in, const int* in_sizes, int n_in, void* d_out, int out_size, void* d_ws,
                              size_t ws_size, hipStream_t stream) {
  static int grid_blocks = 0;
  if (!grid_blocks) {
    int dev = 0, cus = 0, per_cu = 0;
    hipGetDevice(&dev);
    hipDeviceGetAttribute(&cus, hipDeviceAttributeMultiprocessorCount, dev);
    hipOccupancyMaxActiveBlocksPerMultiprocessor(&per_cu, fwd_megakernel, 256, 0);
    if (per_cu > 2) per_cu = 2;
    if (per_cu < 1) per_cu = 1;
    grid_blocks = cus * per_cu;
  }
  Params p{};
  for (int i = 0; i < 30; i++) p.in[i] = (const float*)d_in[i];
  p.out = (float*)d_out;
  p.ws = (unsigned char*)d_ws;
  hipMemsetAsync(d_ws, 0, 20480, stream);
  void* args[] = {&p};
  hipError_t e = hipLaunchCooperativeKernel((void*)fwd_megakernel, dim3(grid_blocks), dim3(256), args, 0, stream);
  if (e != hipSuccess) fprintf(stderr, "cooperative launch failed: %s (grid %d)\n", hipGetErrorString(e), grid_blocks);
}
```

```cpp
#include <hip/hip_runtime.h>
#include <hip/hip_cooperative_groups.h>
#include <cstdio>
namespace cg = cooperative_groups;

typedef unsigned short bfr;
typedef __attribute__((ext_vector_type(8))) short bf16x8;
typedef __attribute__((ext_vector_type(4))) float f32x4;
typedef __attribute__((ext_vector_type(4))) unsigned u32x4;
typedef __attribute__((ext_vector_type(2))) unsigned u32x2;

#define NROWS 12288
#define NCTX 4096
#define ZLD 6976
#define LDT 72
#define SMEM_SHORTS (4 * 128 * LDT)

#define C_QA 0
#define C_KA 512
#define C_VA 640
#define C_GA 768
#define C_QG 1280
#define C_KG 1536
#define C_VG 1792
#define C_GG 2304
#define C_RF 2816
#define C_RB 2832
#define C_QL 2848
#define C_KV 3104
#define C_KR 3360
#define C_GC 3392
#define C_M1 3904
#define C_M2 4928
#define C_M3 5952

#define WS_BAR 0ul
#define WS_CTR 16384ul
#define WS_MODP 20480ul
#define WS_MOD (WS_MODP + 589824ul)
#define WS_ROPE (WS_MOD + 73728ul)
#define WS_WIN (WS_ROPE + 16384ul)
#define WS_WUQ (WS_WIN + 14417920ul)
#define WS_WUKV (WS_WUQ + 196608ul)
#define WS_WOA (WS_WUKV + 393216ul)
#define WS_WOB (WS_WOA + 1048576ul)
#define WS_WOC (WS_WOB + 1048576ul)
#define WS_WOUT (WS_WOC + 1048576ul)
#define WS_KCA (WS_WOUT + 2097152ul)
#define WS_CKVC (WS_KCA + 262144ul)
#define WS_KRC (WS_CKVC + 524288ul)
#define WS_VTA (WS_KRC + 65536ul)
#define WS_CQ (WS_VTA + 3407872ul)
#define WS_KNOPE (WS_CQ + 9437184ul)
#define WS_VTC (WS_KNOPE + 6815744ul)
#define WS_R1 (WS_VTC + 13631488ul)
#define WS_Z (WS_R1 + 25165824ul)
#define WS_END (WS_Z + 171442176ul)

#define O_Y 0
#define O_GK 12582912
#define O_GV 13631488
#define O_CKV 14680064
#define O_KR 16777216
#define O_SF 17039360
#define O_SB 18087936

struct Params {
  const float* in[30];
  float* out;
  unsigned char* ws;
};

__device__ __forceinline__ int tidx() {
  int t = threadIdx.x;
  asm volatile("" : "+v"(t));
  return t;
}
__device__ __forceinline__ Params launder(const Params& p) {
  Params q;
  long zo = 0;
  asm volatile("" : "+s"(zo));
#pragma unroll
  for (int i = 0; i < 30; i++) q.in[i] = p.in[i] + zo;
  q.out = p.out + zo;
  q.ws = p.ws + zo;
  return q;
}
__device__ __forceinline__ float bf2f(bfr b) { return __uint_as_float(((unsigned)b) << 16); }
typedef float f32x2_t __attribute__((ext_vector_type(2)));
typedef __bf16 bf16x2_t __attribute__((ext_vector_type(2)));
__device__ __forceinline__ bfr f2bf(float f) {
  __bf16 r = (__bf16)f;
  return *(bfr*)&r;
}
__device__ __forceinline__ unsigned pack2(float a, float b) {
  f32x2_t v = {a, b};
  bf16x2_t r = __builtin_convertvector(v, bf16x2_t);
  return *(unsigned*)&r;
}
__device__ __forceinline__ float lo16(unsigned u) { return __uint_as_float(u << 16); }
__device__ __forceinline__ float hi16(unsigned u) { return __uint_as_float(u & 0xffff0000u); }
__device__ __forceinline__ float siluf(float x) { return x / (1.f + __expf(-x)); }
__device__ __forceinline__ float sigmf(float x) { return 1.f / (1.f + __expf(-x)); }
__device__ __forceinline__ f32x4 mfma16(bf16x8 a, bf16x8 b, f32x4 c) {
  return __builtin_amdgcn_mfma_f32_16x16x32_bf16(a, b, c, 0, 0, 0);
}
__device__ __forceinline__ const float* xrow(const Params& p, int row) {
  return row < NCTX ? p.in[0] + (long)row * 1024 : p.in[1] + (long)(row - NCTX) * 1024;
}
__device__ __forceinline__ int row_cond(int row) { return row < NCTX ? 0 : 1 + ((row - NCTX) >> 12); }
__device__ __forceinline__ float wave_sum(float v) {
  v += __shfl_xor(v, 1); v += __shfl_xor(v, 2); v += __shfl_xor(v, 4);
  v += __shfl_xor(v, 8); v += __shfl_xor(v, 16); v += __shfl_xor(v, 32);
  return v;
}

#define XB_TMO      128
#define XB_XCNT(j)  (256  + 64 * (j))
#define XB_XSUB(j)  (1280 + 64 * (j))
#define XB_XGEN(j)  (2304 + 64 * (j))
#define XB_TOP      3328
#define XB_TOPGEN   3392
#define XCD_BAR_WORDS 3456
#define XB_SPIN_CAP (1u << 18)
#define LAS __attribute__((address_space(3)))

__device__ __forceinline__ unsigned xb_ld(unsigned* p)              { return __hip_atomic_load(p, __ATOMIC_RELAXED, __HIP_MEMORY_SCOPE_AGENT); }
__device__ __forceinline__ unsigned xb_add(unsigned* p, unsigned v) { return __hip_atomic_fetch_add(p, v, __ATOMIC_RELAXED, __HIP_MEMORY_SCOPE_AGENT); }
__device__ __forceinline__ unsigned xb_xcc_id() { return (unsigned)__builtin_amdgcn_s_getreg((3 << 11) | 20) & 0xFu; }
#define XB_SPIN(cond, bar) do { unsigned _sp = 0; while (cond) { __builtin_amdgcn_s_sleep(1); \
    if ((++_sp & 255u) == 0u) { if (xb_ld(&(bar)[XB_TMO])) break; if (_sp > XB_SPIN_CAP) { atomicAdd(&(bar)[XB_TMO], 1u); break; } } } } while (0)

struct XcdBarrier {
    unsigned* bar; unsigned x;
    volatile LAS unsigned* st;
};

__device__ __forceinline__ XcdBarrier xcd_barrier_post(unsigned* bar, volatile LAS unsigned* st) {
    XcdBarrier b; b.bar = bar; b.x = xb_xcc_id(); b.st = st;
    if (threadIdx.x == 0) (void)xb_add(&bar[XB_XCNT(b.x)], 1u);
    return b;
}
__device__ __forceinline__ void xcd_barrier_complete(unsigned* bar, unsigned x, unsigned& nloc, unsigned& nx) {
    const unsigned G = gridDim.x * gridDim.y * gridDim.z;
    unsigned sum, cnt, mine, sp = 0u;
    for (;;) {
        sum = 0u; cnt = 0u; mine = 0u;
#pragma unroll
        for (unsigned j = 0; j < 16; ++j) { const unsigned c = xb_ld(&bar[XB_XCNT(j)]); sum += c; cnt += (c > 0u) ? 1u : 0u; mine = (j == x) ? c : mine; }
        if (sum == G) break;
        __builtin_amdgcn_s_sleep(1);
        if ((++sp & 255u) == 0u) { if (xb_ld(&bar[XB_TMO])) break; if (sp > XB_SPIN_CAP) { atomicAdd(&bar[XB_TMO], 1u); break; } }
    }
    nloc = mine > 0u ? mine : 1u; nx = cnt > 0u ? cnt : 1u;
}

__device__ __forceinline__ void xcd_barrier(const XcdBarrier& b) {
    asm volatile("s_waitcnt vmcnt(0)" ::: "memory");
    __syncthreads();
    if (threadIdx.x == 0) {
        unsigned* bar = b.bar;
        __builtin_amdgcn_s_waitcnt(0);
        unsigned nloc = b.st[0], nx = b.st[1];
        if (nloc == 0u) { xcd_barrier_complete(bar, b.x, nloc, nx); b.st[0] = nloc; b.st[1] = nx; }
        const unsigned old = xb_add(&bar[XB_XSUB(b.x)], 1u);
        const unsigned gen = old / nloc;
        if (old + 1u == (gen + 1u) * nloc) {
            __builtin_amdgcn_fence(__ATOMIC_RELEASE, "agent");
            asm volatile("s_waitcnt vmcnt(0)" ::: "memory");
            const unsigned og = xb_add(&bar[XB_TOP], 1u);
            const unsigned tg = og / nx;
            if (og + 1u == (tg + 1u) * nx) xb_add(&bar[XB_TOPGEN], 1u);
            else XB_SPIN(xb_ld(&bar[XB_TOPGEN]) == tg, bar);
            __builtin_amdgcn_fence(__ATOMIC_ACQUIRE, "agent");
            xb_add(&bar[XB_XGEN(b.x)], 1u);
            asm volatile("s_waitcnt vmcnt(0)" ::: "memory");
        } else {
            XB_SPIN(xb_ld(&bar[XB_XGEN(b.x)]) == gen, bar);
            __builtin_amdgcn_fence(__ATOMIC_ACQUIRE, "agent");
            asm volatile("s_waitcnt vmcnt(0)" ::: "memory");
        }
    }
    __syncthreads();
}


#define TIDX tidx()
#define LDS3 __attribute__((address_space(3)))
__device__ __forceinline__ void glds16(const bfr* g, bfr* l) {
  __builtin_amdgcn_global_load_lds((const unsigned*)g, (LDS3 unsigned*)l, 16, 0, 0);
}
__device__ __forceinline__ void gemm128(const bfr* __restrict__ P, long ldp, int pmax,
                                        const bfr* __restrict__ Q, long ldq, int qmax, int K,
                                        f32x4 (&acc)[4][4], bfr* sm) {
  const int tid = TIDX, lane = tid & 63, wid = tid >> 6;
  const int wr = wid >> 1, wc = wid & 1;
  const int l15 = lane & 15, g = lane >> 4;
  const bfr* pp[2];
  const bfr* qp[2];
  {
    const int r0 = tid >> 2;
    const int c = (tid & 3) ^ ((tid >> 4) & 3);
#pragma unroll
    for (int i = 0; i < 2; i++) {
      int r = r0 + 64 * i;
      pp[i] = P + (long)min(r, pmax - 1) * ldp + c * 8;
      qp[i] = Q + (long)min(r, qmax - 1) * ldq + c * 8;
    }
  }
  const int nk = K >> 5;
#define GEMM_ISSUE(T)                                                    \
  do {                                                                   \
    bfr* nb_ = sm + ((T) & 3) * 8192;                                    \
    glds16(pp[0] + (T) * 32, nb_ + tid * 8);                             \
    glds16(pp[1] + (T) * 32, nb_ + 2048 + tid * 8);                      \
    glds16(qp[0] + (T) * 32, nb_ + 4096 + tid * 8);                      \
    glds16(qp[1] + (T) * 32, nb_ + 6144 + tid * 8);                      \
  } while (0)
  GEMM_ISSUE(0);
  GEMM_ISSUE(1);
  GEMM_ISSUE(2);
  const int pos = (g ^ ((l15 >> 2) & 3)) * 8;
  for (int kt = 0; kt < nk; kt++) {
    if (kt + 2 < nk) asm volatile("s_waitcnt vmcnt(8)" ::: "memory");
    else if (kt + 1 < nk) asm volatile("s_waitcnt vmcnt(4)" ::: "memory");
    else asm volatile("s_waitcnt vmcnt(0)" ::: "memory");
    __builtin_amdgcn_s_barrier();
    if (kt + 3 < nk) GEMM_ISSUE(kt + 3);
    const bfr* Ps = sm + (kt & 3) * 8192;
    const bfr* Qs = Ps + 4096;
    bf16x8 pf[4], qf[4];
#pragma unroll
    for (int m = 0; m < 4; m++) {
      pf[m] = *(const bf16x8*)(Ps + (wr * 64 + m * 16 + l15) * 32 + pos);
      qf[m] = *(const bf16x8*)(Qs + (wc * 64 + m * 16 + l15) * 32 + pos);
    }
#pragma unroll
    for (int m = 0; m < 4; m++)
#pragma unroll
      for (int n = 0; n < 4; n++) acc[m][n] = mfma16(pf[m], qf[n], acc[m][n]);
  }
#undef GEMM_ISSUE
  __syncthreads();
}

__device__ __forceinline__ void phase_s0(const Params& p, bfr* sm) {
  const int tid = TIDX;
  float* rope = (float*)(p.ws + WS_ROPE);
  for (int idx = blockIdx.x * 256 + tid; idx < 1536; idx += gridDim.x * 256) {
    if (idx < 1024) {
      int pos = idx >> 4, i = idx & 15;
      float fr = powf(10000.f, -(float)i / 16.f);
      float a = (float)pos * fr;
      rope[idx] = cosf(a);
      rope[1024 + idx] = sinf(a);
    } else {
      int j = idx - 1024;
      int pos = j >> 3, i = j & 7;
      float fr = powf(10000.f, -(float)i / 8.f);
      float a = (float)pos * fr;
      rope[2048 + j] = cosf(a);
      rope[2560 + j] = sinf(a);
    }
  }
  float* smf = (float*)sm;
  float* modp = (float*)(p.ws + WS_MODP);
  for (int it = blockIdx.x; it < 768; it += gridDim.x) {
    int l = it / 384, rem = it % 384, cgp = rem >> 3, ks = rem & 7;
    int col = cgp * 64 + (tid & 63), kq = tid >> 6;
    const float* w = p.in[10] + (long)l * 1024 * 3072 + col;
    float a0 = 0.f, a1 = 0.f, a2 = 0.f;
    int k0 = ks * 128 + kq * 32;
#pragma unroll 8
    for (int k = k0; k < k0 + 32; k++) {
      float wv = w[(long)k * 3072];
      a0 += siluf(p.in[9][k]) * wv;
      a1 += siluf(p.in[8][k]) * wv;
      a2 += siluf(p.in[8][1024 + k]) * wv;
    }
    smf[(kq * 3 + 0) * 64 + (tid & 63)] = a0;
    smf[(kq * 3 + 1) * 64 + (tid & 63)] = a1;
    smf[(kq * 3 + 2) * 64 + (tid & 63)] = a2;
    __syncthreads();
    if (tid < 192) {
      int c = tid >> 6, cc = tid & 63;
      float s = smf[(0 * 3 + c) * 64 + cc] + smf[(1 * 3 + c) * 64 + cc] + smf[(2 * 3 + c) * 64 + cc] + smf[(3 * 3 + c) * 64 + cc];
      modp[((ks * 2 + l) * 3 + c) * 3072 + cgp * 64 + cc] = s;
    }
    __syncthreads();
  }
}

__device__ __forceinline__ void phase_s1(const Params& p) {
  float* modp = (float*)(p.ws + WS_MODP);
  float* mod = (float*)(p.ws + WS_MOD);
  for (int idx = blockIdx.x * 256 + TIDX; idx < 2 * 3 * 3072; idx += gridDim.x * 256) {
    int l = idx / 9216, n = idx % 3072;
    float s = p.in[11][l * 3072 + n];
#pragma unroll
    for (int ks = 0; ks < 8; ks++) s += modp[ks * 18432 + idx];
    mod[idx] = s;
  }
}

__device__ __forceinline__ void wconv_tile(const float* __restrict__ src, int K, int N, bfr* __restrict__ dst,
                                           int tk, int tn, float* smf) {
  const int tid = TIDX;
  const int n = tid & 63, kb = tid >> 6;
#pragma unroll
  for (int i = 0; i < 16; i++) {
    int k = kb + 4 * i;
    smf[k * 65 + n] = src[(long)(tk * 64 + k) * N + tn * 64 + n];
  }
  __syncthreads();
#pragma unroll
  for (int i = 0; i < 16; i++) {
    int idx = tid + 256 * i;
    int nn = idx >> 6, k = idx & 63;
    dst[(long)(tn * 64 + nn) * K + tk * 64 + k] = f2bf(smf[k * 65 + nn]);
  }
  __syncthreads();
}

#define WCONV_ITEMS 2456
__device__ __forceinline__ void wconv_phase(const Params& p, int l, bfr* sm) {
  float* smf = (float*)sm;
  for (int item0 = blockIdx.x; item0 < WCONV_ITEMS; item0 += gridDim.x) {
    int item = item0;
    const float* src;
    bfr* dst;
    int K, N, tk, tn;
    if (item < 1744) {
      src = p.in[14] + (long)l * 1024 * 6976; K = 1024; N = 6976; dst = (bfr*)(p.ws + WS_WIN); tk = item & 15; tn = item >> 4;
    } else if (item < 1768) {
      item -= 1744;
      src = p.in[24] + (long)l * 256 * 384; K = 256; N = 384; dst = (bfr*)(p.ws + WS_WUQ); tk = item & 3; tn = item >> 2;
    } else if (item < 1816) {
      item -= 1768;
      src = p.in[25] + (long)l * 256 * 768; K = 256; N = 768; dst = (bfr*)(p.ws + WS_WUKV); tk = item & 3; tn = item >> 2;
    } else if (item < 2200) {
      item -= 1816;
      int w = item >> 7, it = item & 127;
      src = (w == 0 ? p.in[26] : (w == 1 ? p.in[27] : p.in[28])) + (long)l * 512 * 1024;
      K = 512; N = 1024; dst = (bfr*)(p.ws + WS_WOA + (unsigned long)w * 1048576ul); tk = it & 7; tn = it >> 3;
    } else {
      item -= 2200;
      src = p.in[29] + (long)l * 1024 * 1024; K = 1024; N = 1024; dst = (bfr*)(p.ws + WS_WOUT); tk = item & 15; tn = item >> 4;
    }
    wconv_tile(src, K, N, dst, tk, tn, smf);
  }
}

__device__ __forceinline__ void phase_prenorm0(const Params& p) {
  const int lane = TIDX & 63;
  const float* mod = (const float*)(p.ws + WS_MOD);
  bfr* H = (bfr*)(p.ws + WS_R1);
  for (int row = blockIdx.x * 4 + (TIDX >> 6); row < NROWS; row += gridDim.x * 4) {
    const float* x = xrow(p, row);
    const float* md = mod + (0 * 3 + row_cond(row)) * 3072;
    float4 v[4];
    float ss = 0.f;
#pragma unroll
    for (int i = 0; i < 4; i++) {
      v[i] = *(const float4*)(x + i * 256 + lane * 4);
      ss += v[i].x * v[i].x + v[i].y * v[i].y + v[i].z * v[i].z + v[i].w * v[i].w;
    }
    ss = wave_sum(ss);
    float rs = rsqrtf(ss * (1.f / 1024.f) + 1e-6f);
#pragma unroll
    for (int i = 0; i < 4; i++) {
      int n = i * 256 + lane * 4;
      float4 g = *(const float4*)(p.in[12] + n);
      float4 sh = *(const float4*)(md + n);
      float4 sc = *(const float4*)(md + 1024 + n);
      float h0 = v[i].x * rs * g.x * (1.f + sc.x) + sh.x;
      float h1 = v[i].y * rs * g.y * (1.f + sc.y) + sh.y;
      float h2 = v[i].z * rs * g.z * (1.f + sc.z) + sh.z;
      float h3 = v[i].w * rs * g.w * (1.f + sc.w) + sh.w;
      u32x2 o;
      o.x = pack2(h0, h1);
      o.y = pack2(h2, h3);
      *(u32x2*)(H + (long)row * 1024 + n) = o;
    }
  }
}

__device__ __forceinline__ unsigned xcc_id() { return (unsigned)__builtin_amdgcn_s_getreg((3 << 11) | 20) & 7u; }
template <class CountF>
__device__ __forceinline__ int xq_take(unsigned* ctr, int& q, int& tried, unsigned first, CountF cnt) {
  unsigned j = first;
  for (;;) {
    if (j < (unsigned)cnt(q)) return (q << 20) | (int)j;
    q = (q + 1) & 7;
    if (++tried >= 8) return -1;
    j = atomicAdd(ctr + q * 16, 1u);
  }
}

__device__ __forceinline__ void phase_inproj(const Params& p, int l, bfr* sm, int* s_item, int slot) {
  const bfr* H = (const bfr*)(p.ws + WS_R1);
  const bfr* W = (const bfr*)(p.ws + WS_WIN);
  bfr* Z = (bfr*)(p.ws + WS_Z);
  const int tid = TIDX;
  const int lane = tid & 63, wid = tid >> 6, wr = wid >> 1, wc = wid & 1;
  unsigned* ctr = (unsigned*)(p.ws + WS_CTR) + slot * 128;
  auto cnt = [](int q) { return 96 * ((55 * (q + 1)) / 8 - (55 * q) / 8); };
  int q = (int)xcc_id(), tried = 0;
  unsigned nxt = 0;
  if (tid == 0) nxt = atomicAdd(ctr + q * 16, 1u);
  for (;;) {
    if (tid == 0) *s_item = xq_take(ctr, q, tried, nxt, cnt);
    __syncthreads();
    const int it = *s_item;
    __syncthreads();
    if (it < 0) break;
    const int qq = it >> 20, j = it & 0xfffff;
    if (tid == 0) nxt = atomicAdd(ctr + q * 16, 1u);
    const int tn0 = (55 * qq) / 8, w = (55 * (qq + 1)) / 8 - tn0;
    const int tm = j / w, tn = tn0 + j % w;
    f32x4 acc[4][4];
#pragma unroll
    for (int a = 0; a < 4; a++)
#pragma unroll
      for (int b = 0; b < 4; b++) acc[a][b] = (f32x4){0.f, 0.f, 0.f, 0.f};
#ifdef PROBE_DEGEN
    if (slot >= 6) gemm128(W, 1024, 128, H, 1024, 128, 1024, acc, sm); else
#endif
    gemm128(W + (long)tn * 128 * 1024, 1024, ZLD - tn * 128, H + (long)tm * 128 * 1024, 1024, 128, 1024, acc, sm);
    {
      const int g = lane >> 4, l15 = lane & 15;
#pragma unroll
      for (int pi = 0; pi < 4; pi++)
#pragma unroll
        for (int qi = 0; qi < 4; qi++) {
          u32x2 o;
          o.x = pack2(acc[pi][qi][0], acc[pi][qi][1]);
          o.y = pack2(acc[pi][qi][2], acc[pi][qi][3]);
          *(u32x2*)(sm + (wc * 64 + qi * 16 + l15) * 136 + wr * 64 + pi * 16 + g * 4) = o;
        }
      __syncthreads();
      const int ncol = (ZLD - tn * 128) >> 3;
#pragma unroll
      for (int i = 0; i < 8; i++) {
        int c = tid + 256 * i;
        int row = c >> 4, c16 = c & 15;
        if (c16 < ncol)
          *(u32x4*)(Z + (long)(tm * 128 + row) * ZLD + tn * 128 + c16 * 8) = *(const u32x4*)(sm + row * 136 + c16 * 8);
      }
      __syncthreads();
    }
  }
}

__device__ __forceinline__ void unpack8(u32x4 v, float* x) {
  x[0] = lo16(v.x); x[1] = hi16(v.x); x[2] = lo16(v.y); x[3] = hi16(v.y);
  x[4] = lo16(v.z); x[5] = hi16(v.z); x[6] = lo16(v.w); x[7] = hi16(v.w);
}
__device__ __forceinline__ u32x4 pack8(const float* y) {
  u32x4 o;
  o.x = pack2(y[0], y[1]); o.y = pack2(y[2], y[3]); o.z = pack2(y[4], y[5]); o.w = pack2(y[6], y[7]);
  return o;
}

__device__ __forceinline__ void phase_rowpost(const Params& p, int l) {
  const int lane = TIDX & 63;
  bfr* Z = (bfr*)(p.ws + WS_Z);
  const float* rope = (const float*)(p.ws + WS_ROPE);
  bfr* VTA = (bfr*)(p.ws + WS_VTA);
  bfr* KCA = (bfr*)(p.ws + WS_KCA);
  bfr* CKVC = (bfr*)(p.ws + WS_CKVC);
  bfr* KRC = (bfr*)(p.ws + WS_KRC);
  float* out = p.out;
  for (int row = blockIdx.x * 4 + (TIDX >> 6); row < NROWS + 1024; row += gridDim.x * 4) {
    if (row < NROWS) {
      const bool lat = row >= NCTX;
      const int bc = row >> 8, tc = row & 255;
      const int bl = (row - NCTX) >> 12, tl = (row - NCTX) & 4095;
      const int prow = tl >> 6, pcol = tl & 63;
      bfr* z = Z + (long)row * ZLD;
      {
        float x[8];
        unpack8(*(const u32x4*)(z + C_QA + lane * 8), x);
        float ss = 0.f;
#pragma unroll
        for (int e = 0; e < 8; e++) ss += x[e] * x[e];
        ss += __shfl_xor(ss, 1); ss += __shfl_xor(ss, 2); ss += __shfl_xor(ss, 4);
        float rs = rsqrtf(ss * (1.f / 64.f) + 1e-6f);
        int sub = lane & 7;
        const float* g = p.in[15] + l * 64 + sub * 8;
#pragma unroll
        for (int e = 0; e < 8; e++) x[e] = x[e] * rs * g[e];
        if (lat) {
          int pos = (sub >> 2) ? pcol : prow;
          bool hi = (sub & 2) != 0;
          int i0 = (sub & 1) * 8;
#pragma unroll
          for (int e = 0; e < 8; e++) {
            float yp = __shfl_xor(x[e], 2);
            float c = rope[pos * 16 + i0 + e], s = rope[1024 + pos * 16 + i0 + e];
            x[e] = hi ? (yp * s + x[e] * c) : (x[e] * c - yp * s);
          }
        }
        const float qs = 0.125f * 1.4426950408889634f;
#pragma unroll
        for (int e = 0; e < 8; e++) x[e] *= qs;
        *(u32x4*)(z + C_QA + lane * 8) = pack8(x);
      }
      {
        int L = lane & 15;
        float x[8];
        unpack8(*(const u32x4*)(z + C_KA + L * 8), x);
        float ss = 0.f;
#pragma unroll
        for (int e = 0; e < 8; e++) ss += x[e] * x[e];
        ss += __shfl_xor(ss, 1); ss += __shfl_xor(ss, 2); ss += __shfl_xor(ss, 4);
        float rs = rsqrtf(ss * (1.f / 64.f) + 1e-6f);
        int sub = L & 7;
        const float* g = p.in[16] + l * 64 + sub * 8;
#pragma unroll
        for (int e = 0; e < 8; e++) x[e] = x[e] * rs * g[e];
        if (lat) {
          int pos = (sub >> 2) ? pcol : prow;
          bool hi = (sub & 2) != 0;
          int i0 = (sub & 1) * 8;
#pragma unroll
          for (int e = 0; e < 8; e++) {
            float yp = __shfl_xor(x[e], 2);
            float c = rope[pos * 16 + i0 + e], s = rope[1024 + pos * 16 + i0 + e];
            x[e] = hi ? (yp * s + x[e] * c) : (x[e] * c - yp * s);
          }
        } else if (lane < 16) {
          float* o = out + O_GK + ((long)(bc * 2 + l) * 256 + tc) * 128 + L * 8;
          *(float4*)(o) = make_float4(x[0], x[1], x[2], x[3]);
          *(float4*)(o + 4) = make_float4(x[4], x[5], x[6], x[7]);
        }
        if (lane < 16) *(u32x4*)(z + C_KA + L * 8) = pack8(x);
      }
      if (lane < 16) {
        int L = lane;
        u32x4 raw = *(const u32x4*)(z + C_VA + L * 8);
        float x[8];
        unpack8(raw, x);
        if (!lat) {
          float* o = out + O_GV + ((long)(bc * 2 + l) * 256 + tc) * 128 + L * 8;
          *(float4*)(o) = make_float4(x[0], x[1], x[2], x[3]);
          *(float4*)(o + 4) = make_float4(x[4], x[5], x[6], x[7]);
        }
        int g = L >> 3, d0 = (L & 7) * 8;
        long base; int nk, key;
        if (!lat) { base = (long)bc * 32768; nk = 256; key = tc; }
        else { base = 16l * 32768 + (long)bl * (2 * 64 * 4608); nk = 4608; key = 512 + tl; }
        const bfr* rb = (const bfr*)&raw;
#pragma unroll
        for (int e = 0; e < 8; e++) VTA[base + (long)(g * 64 + d0 + e) * nk + key] = rb[e];
      }
      {
        u32x2 rq = *(const u32x2*)(z + C_QL + lane * 4);
        u32x2 rk = *(const u32x2*)(z + C_KV + lane * 4);
        float q[4] = {lo16(rq.x), hi16(rq.x), lo16(rq.y), hi16(rq.y)};
        float k[4] = {lo16(rk.x), hi16(rk.x), lo16(rk.y), hi16(rk.y)};
        float sq = q[0] * q[0] + q[1] * q[1] + q[2] * q[2] + q[3] * q[3];
        float sk = k[0] * k[0] + k[1] * k[1] + k[2] * k[2] + k[3] * k[3];
        sq = wave_sum(sq);
        sk = wave_sum(sk);
        float rq_ = rsqrtf(sq * (1.f / 256.f) + 1e-6f), rk_ = rsqrtf(sk * (1.f / 256.f) + 1e-6f);
        float4 gq = *(const float4*)(p.in[22] + l * 256 + lane * 4);
        float4 gk = *(const float4*)(p.in[23] + l * 256 + lane * 4);
        q[0] *= rq_ * gq.x; q[1] *= rq_ * gq.y; q[2] *= rq_ * gq.z; q[3] *= rq_ * gq.w;
        k[0] *= rk_ * gk.x; k[1] *= rk_ * gk.y; k[2] *= rk_ * gk.z; k[3] *= rk_ * gk.w;
        u32x2 o;
        o.x = pack2(q[0], q[1]); o.y = pack2(q[2], q[3]);
        *(u32x2*)(z + C_QL + lane * 4) = o;
        o.x = pack2(k[0], k[1]); o.y = pack2(k[2], k[3]);
        *(u32x2*)(z + C_KV + lane * 4) = o;
        if (!lat) *(float4*)(out + O_CKV + ((long)(bc * 2 + l) * 256 + tc) * 256 + lane * 4) = make_float4(k[0], k[1], k[2], k[3]);
      }
      {
        int L = lane & 3;
        float x[8];
        unpack8(*(const u32x4*)(z + C_KR + L * 8), x);
        if (lat) {
          int pos = (L >> 1) ? pcol : prow;
          bool hi = (L & 1) != 0;
#pragma unroll
          for (int e = 0; e < 8; e++) {
            float yp = __shfl_xor(x[e], 1);
            float c = rope[2048 + pos * 8 + e], s = rope[2560 + pos * 8 + e];
            x[e] = hi ? (yp * s + x[e] * c) : (x[e] * c - yp * s);
          }
          if (lane < 4) *(u32x4*)(z + C_KR + L * 8) = pack8(x);
        } else if (lane < 4) {
          float* o = out + O_KR + ((long)(bc * 2 + l) * 256 + tc) * 32 + L * 8;
          *(float4*)(o) = make_float4(x[0], x[1], x[2], x[3]);
          *(float4*)(o + 4) = make_float4(x[4], x[5], x[6], x[7]);
        }
      }
    } else {
      int cr = row - NROWS;
      int b = cr >> 9, t = cr & 511;
      long src = (long)(b * 2 + l) * 512 + t;
      {
        float2 kv = *(const float2*)(p.in[2] + src * 128 + lane * 2);
        *(unsigned*)(KCA + (long)(b * 512 + t) * 128 + lane * 2) = pack2(kv.x, kv.y);
        float2 vv = *(const float2*)(p.in[3] + src * 128 + lane * 2);
        int c0 = lane * 2;
        long base = 16l * 32768 + (long)b * (2 * 64 * 4608);
        VTA[base + (long)c0 * 4608 + t] = f2bf(vv.x);
        VTA[base + (long)(c0 + 1) * 4608 + t] = f2bf(vv.y);
        float4 cv = *(const float4*)(p.in[4] + src * 256 + lane * 4);
        u32x2 o;
        o.x = pack2(cv.x, cv.y); o.y = pack2(cv.z, cv.w);
        *(u32x2*)(CKVC + (long)(b * 512 + t) * 256 + lane * 4) = o;
        if (lane < 32) KRC[(long)(b * 512 + t) * 32 + lane] = f2bf(p.in[5][src * 32 + lane]);
      }
    }
  }
}

#define WS_PREP1 251703296ul
#define WS_EL (WS_WIN + 12582912ul)
__device__ __forceinline__ bfr* prep_base(const Params& p, int b, int h, int dir, int c) {
  return (bfr*)(p.ws + (b ? WS_PREP1 : WS_WIN)) + (long)((h * 2 + dir) * 64 + c) * 12288;
}

__device__ __forceinline__ void gla_chunk_prep(int tid, const float (&wd)[16], float bias, const bfr* Qr, const bfr* Kr,
                                               bfr* Qe, bfr* Ke, bfr* KlT, const float* RF, float* tot, float* lastv) {
  const int ch = tid & 63, part = tid >> 6;
  float cum[16];
  {
    float run = 0.f;
#pragma unroll
    for (int ii = 0; ii < 16; ii++) {
      int i = part * 16 + ii;
      float x = bias;
#pragma unroll
      for (int r = 0; r < 16; r++) x += RF[i * 16 + r] * wd[r];
      float la = (fminf(x, 0.f) - __logf(1.f + __expf(-fabsf(x)))) * (1.f / 16.f);
      run += la;
      cum[ii] = run;
    }
    tot[part * 64 + ch] = run;
  }
  __syncthreads();
  {
    float off = 0.f, last = 0.f;
#pragma unroll
    for (int pp = 0; pp < 4; pp++) {
      float tv = tot[pp * 64 + ch];
      if (pp < part) off += tv;
      last += tv;
    }
    if (part == 0) lastv[ch] = last;
#pragma unroll
    for (int ii = 0; ii < 16; ii++) {
      int i = part * 16 + ii;
      float cc = cum[ii] + off;
      float qv = bf2f(Qr[i * LDT + ch]), kv = bf2f(Kr[i * LDT + ch]);
      Qe[i * LDT + ch] = f2bf(qv * __expf(cc) * 0.125f);
      Ke[i * LDT + ch] = f2bf(kv * __expf(-cc));
      KlT[ch * LDT + i] = f2bf(kv * __expf(last - cc));
    }
  }
  __syncthreads();
}

__device__ __forceinline__ void gla_att(int wid, int g, int l15, const bfr* Qe, const bfr* Ke, bfr* Att) {
  f32x4 att[4];
  bf16x8 qa[2];
#pragma unroll
  for (int kk = 0; kk < 2; kk++) qa[kk] = *(const bf16x8*)(Qe + (16 * wid + l15) * LDT + kk * 32 + g * 8);
#pragma unroll
  for (int nj = 0; nj < 4; nj++) {
    att[nj] = (f32x4){0.f, 0.f, 0.f, 0.f};
#pragma unroll
    for (int kk = 0; kk < 2; kk++) {
      bf16x8 kb = *(const bf16x8*)(Ke + (16 * nj + l15) * LDT + kk * 32 + g * 8);
      att[nj] = mfma16(qa[kk], kb, att[nj]);
    }
  }
#pragma unroll
  for (int nj = 0; nj < 4; nj++)
#pragma unroll
    for (int r = 0; r < 4; r++) {
      int i = 16 * wid + 4 * g + r, j = 16 * nj + l15;
      Att[i * LDT + j] = f2bf(i >= j ? att[nj][r] : 0.f);
    }
}

__device__ __forceinline__ void gla_prep_item(const Params& p, int l, int b, int h, int dir, int c, bfr* sm) {
  const int tid = TIDX, lane = tid & 63, wid = tid >> 6, g = lane >> 4, l15 = lane & 15;
  const bfr* Z = (const bfr*)(p.ws + WS_Z);
  const int N = 4096;
  const int rowbase = NCTX + b * 4096;
  bfr* Qr = sm;
  bfr* Kr = Qr + 64 * LDT;
  bfr* Qe = Kr + 64 * LDT;
  bfr* Ke = Qe + 64 * LDT;
  bfr* KlT = Ke + 64 * LDT;
  float* RF = (float*)(KlT + 64 * LDT);
  float* tot = RF + 64 * 16;
  float* lastv = tot + 256;
  bfr* Att = Qr;
  const int ch = tid & 63;
  float wd[16];
  {
    const float* W = (dir ? p.in[19] : p.in[17]) + (long)l * 16 * 256 + h * 64 + ch;
#pragma unroll
    for (int r = 0; r < 16; r++) wd[r] = W[r * 256];
  }
  const float bias = (dir ? p.in[20] : p.in[18])[l * 256 + h * 64 + ch];
#pragma unroll
  for (int ii = 0; ii < 2; ii++) {
    int cc = tid + 256 * ii;
    int i = cc >> 3, c8 = cc & 7;
    int tok = dir ? (N - 1 - (c * 64 + i)) : (c * 64 + i);
    const bfr* zr = Z + (long)(rowbase + tok) * ZLD;
    *(u32x4*)(Qr + i * LDT + c8 * 8) = *(const u32x4*)(zr + C_QG + h * 64 + c8 * 8);
    *(u32x4*)(Kr + i * LDT + c8 * 8) = *(const u32x4*)(zr + C_KG + h * 64 + c8 * 8);
  }
  if (tid < 128) {
    int i = tid >> 1, hf = tid & 1;
    int tok = dir ? (N - 1 - (c * 64 + i)) : (c * 64 + i);
    u32x4 rr = *(const u32x4*)(Z + (long)(rowbase + tok) * ZLD + (dir ? C_RB : C_RF) + hf * 8);
    float x[8];
    unpack8(rr, x);
#pragma unroll
    for (int e = 0; e < 8; e++) RF[i * 16 + hf * 8 + e] = x[e];
  }
  __syncthreads();
  gla_chunk_prep(tid, wd, bias, Qr, Kr, Qe, Ke, KlT, RF, tot, lastv);
  gla_att(wid, g, l15, Qe, Ke, Att);
  __syncthreads();
  bfr* dst = prep_base(p, b, h, dir, c);
#pragma unroll
  for (int ii = 0; ii < 2; ii++) {
    int cc = tid + 256 * ii;
    int i = cc >> 3, c8 = cc & 7;
    *(u32x4*)(dst + i * 64 + c8 * 8) = *(const u32x4*)(Qe + i * LDT + c8 * 8);
    *(u32x4*)(dst + 4096 + i * 64 + c8 * 8) = *(const u32x4*)(KlT + i * LDT + c8 * 8);
    *(u32x4*)(dst + 8192 + i * 64 + c8 * 8) = *(const u32x4*)(Att + i * LDT + c8 * 8);
  }
  if (tid < 64) ((float*)(p.ws + WS_EL))[((long)(((b * 4 + h) * 2 + dir) * 64 + c)) * 64 + tid] = __expf(lastv[tid]);
  __syncthreads();
}

__device__ __forceinline__ void gla_chain_item(const Params& p, int l, int b, int h, int dir, int vh, bfr* sm) {
  const int tid = TIDX, lane = tid & 63, wid = tid >> 6, g = lane >> 4, l15 = lane & 15;
  const bfr* Z = (const bfr*)(p.ws + WS_Z);
  bfr* OG = (bfr*)(p.ws + WS_R1) + (long)dir * NROWS * 512;
  const float* EL = (const float*)(p.ws + WS_EL) + (long)(((b * 4 + h) * 2 + dir) * 64) * 64;
  const int N = 4096, nc = 64;
  const int rowbase = NCTX + b * 4096;
  const int vs0 = vh * 64;
  bfr* Vt = sm;
  bfr* St = Vt + 64 * LDT;
  f32x4 st[4];
  {
    const float* S0 = (dir ? p.in[7] : p.in[6]) + ((long)((b * 2 + l) * 4 + h)) * 8192 + (long)(16 * wid + l15) * 128 + vs0;
#pragma unroll
    for (int vt = 0; vt < 4; vt++) {
      float4 a = *(const float4*)(S0 + 16 * vt + 4 * g);
      st[vt] = (f32x4){a.x, a.y, a.z, a.w};
#pragma unroll
      for (int r = 0; r < 4; r++) St[(16 * vt + 4 * g + r) * LDT + 16 * wid + l15] = f2bf(st[vt][r]);
    }
  }
  u32x4 n_qe[2], n_kl[2], n_at[2], n_v[2];
  float n_el;
  auto prefetch = [&](int c) {
    const bfr* base = prep_base(p, b, h, dir, c) + (16 * wid + l15) * 64 + 8 * g;
#pragma unroll
    for (int kk = 0; kk < 2; kk++) {
      n_qe[kk] = *(const u32x4*)(base + kk * 32);
      n_kl[kk] = *(const u32x4*)(base + 4096 + kk * 32);
      n_at[kk] = *(const u32x4*)(base + 8192 + kk * 32);
    }
    n_el = EL[c * 64 + 16 * wid + l15];
#pragma unroll
    for (int ii = 0; ii < 2; ii++) {
      int cc = tid + 256 * ii;
      int i = cc >> 3, c8 = cc & 7;
      int tok = dir ? (N - 1 - (c * 64 + i)) : (c * 64 + i);
      n_v[ii] = *(const u32x4*)(Z + (long)(rowbase + tok) * ZLD + C_VG + h * 128 + vs0 + c8 * 8);
    }
  };
  prefetch(0);
  for (int c = 0; c < nc; c++) {
    u32x4 c_qe[2] = {n_qe[0], n_qe[1]}, c_kl[2] = {n_kl[0], n_kl[1]}, c_at[2] = {n_at[0], n_at[1]};
    const float el = n_el;
#pragma unroll
    for (int ii = 0; ii < 2; ii++) {
      int cc = tid + 256 * ii;
      int i = cc >> 3, c8 = cc & 7;
      const bfr* rb = (const bfr*)&n_v[ii];
#pragma unroll
      for (int e = 0; e < 8; e++) Vt[(c8 * 8 + e) * LDT + i] = rb[e];
    }
    __syncthreads();
    if (c + 1 < nc) prefetch(c + 1);
    f32x4 stn[4];
    const int i = 16 * wid + l15;
    const int tok = dir ? (N - 1 - (c * 64 + i)) : (c * 64 + i);
    bfr* og = OG + (long)(rowbase + tok) * 512 + h * 128 + vs0 + 4 * g;
#pragma unroll
    for (int vt = 0; vt < 4; vt++) {
      f32x4 oc = (f32x4){0.f, 0.f, 0.f, 0.f};
      stn[vt] = st[vt] * el;
#pragma unroll
      for (int kk = 0; kk < 2; kk++) {
        bf16x8 vf = *(const bf16x8*)(Vt + (16 * vt + l15) * LDT + kk * 32 + g * 8);
        bf16x8 sf = *(const bf16x8*)(St + (16 * vt + l15) * LDT + kk * 32 + g * 8);
        oc = mfma16(vf, *(bf16x8*)&c_at[kk], oc);
        oc = mfma16(sf, *(bf16x8*)&c_qe[kk], oc);
        stn[vt] = mfma16(vf, *(bf16x8*)&c_kl[kk], stn[vt]);
      }
      u32x2 ov;
      ov.x = pack2(oc[0], oc[1]);
      ov.y = pack2(oc[2], oc[3]);
      *(u32x2*)(og + 16 * vt) = ov;
    }
    __syncthreads();
#pragma unroll
    for (int vt = 0; vt < 4; vt++) {
      st[vt] = stn[vt];
#pragma unroll
      for (int r = 0; r < 4; r++) St[(16 * vt + 4 * g + r) * LDT + 16 * wid + l15] = f2bf(st[vt][r]);
    }
  }
  __syncthreads();
}

template <int VS>
__device__ __forceinline__ void gla_item(const Params& p, int l, int seq, int h, int dir, int vsl, bfr* sm) {
  constexpr int NVT = VS / 16;
  constexpr int NVL = VS / 32;
  const int tid = TIDX, lane = tid & 63, wid = tid >> 6, g = lane >> 4, l15 = lane & 15;
  bfr* Z = (bfr*)(p.ws + WS_Z);
  bfr* OG = (bfr*)(p.ws + WS_R1) + (long)dir * NROWS * 512;
  const bool lat = seq >= 16;
  const int b = seq - 16;
  const int N = lat ? 4096 : 256;
  const int rowbase = lat ? NCTX + b * 4096 : seq * 256;
  const int nc = N >> 6;
  const int vs0 = vsl * VS;
  bfr* Qr = sm;
  bfr* Kr = Qr + 64 * LDT;
  bfr* Qe = Kr + 64 * LDT;
  bfr* Ke = Qe + 64 * LDT;
  bfr* KlT = Ke + 64 * LDT;
  float* RF = (float*)(KlT + 64 * LDT);
  float* tot = RF + 64 * 16;
  float* lastv = tot + 256;
  bfr* Vt = (bfr*)(lastv + 64);
  bfr* St = Vt + VS * LDT;
  bfr* Att = Qr;
  const int ch = tid & 63;
  float wd[16];
  {
    const float* W = (dir ? p.in[19] : p.in[17]) + (long)l * 16 * 256 + h * 64 + ch;
#pragma unroll
    for (int r = 0; r < 16; r++) wd[r] = W[r * 256];
  }
  const float bias = (dir ? p.in[20] : p.in[18])[l * 256 + h * 64 + ch];

  f32x4 st[NVT];
  {
    const float* S0 = (dir ? p.in[7] : p.in[6]) + ((long)((b * 2 + l) * 4 + h)) * 8192 + (long)(16 * wid + l15) * 128 + vs0;
#pragma unroll
    for (int mv = 0; mv < NVT; mv++) {
      if (lat) {
        float4 a = *(const float4*)(S0 + 16 * mv + 4 * g);
        st[mv] = (f32x4){a.x, a.y, a.z, a.w};
      } else {
        st[mv] = (f32x4){0.f, 0.f, 0.f, 0.f};
      }
#pragma unroll
      for (int r = 0; r < 4; r++) St[(16 * mv + 4 * g + r) * LDT + 16 * wid + l15] = f2bf(st[mv][r]);
    }
  }
  u32x4 rq[2], rk[2], rv[NVL], rr;
  auto prefetch = [&](int c) {
#pragma unroll
    for (int ii = 0; ii < 2; ii++) {
      int cc = tid + 256 * ii;
      int i = cc >> 3, c8 = cc & 7;
      int tok = dir ? (N - 1 - (c * 64 + i)) : (c * 64 + i);
      const bfr* zr = Z + (long)(rowbase + tok) * ZLD;
      rq[ii] = *(const u32x4*)(zr + C_QG + h * 64 + c8 * 8);
      rk[ii] = *(const u32x4*)(zr + C_KG + h * 64 + c8 * 8);
    }
#pragma unroll
    for (int ii = 0; ii < NVL; ii++) {
      int cc = tid + 256 * ii;
      int i = cc / (VS / 8), c4 = cc % (VS / 8);
      int tok = dir ? (N - 1 - (c * 64 + i)) : (c * 64 + i);
      rv[ii] = *(const u32x4*)(Z + (long)(rowbase + tok) * ZLD + C_VG + h * 128 + vs0 + c4 * 8);
    }
    if (tid < 128) {
      int i = tid >> 1, hf = tid & 1;
      int tok = dir ? (N - 1 - (c * 64 + i)) : (c * 64 + i);
      rr = *(const u32x4*)(Z + (long)(rowbase + tok) * ZLD + (dir ? C_RB : C_RF) + hf * 8);
    }
  };
  prefetch(0);
  for (int c = 0; c < nc; c++) {
#pragma unroll
    for (int ii = 0; ii < 2; ii++) {
      int cc = tid + 256 * ii;
      *(u32x4*)(Qr + (cc >> 3) * LDT + (cc & 7) * 8) = rq[ii];
      *(u32x4*)(Kr + (cc >> 3) * LDT + (cc & 7) * 8) = rk[ii];
    }
#pragma unroll
    for (int ii = 0; ii < NVL; ii++) {
      int cc = tid + 256 * ii;
      int i = cc / (VS / 8), c4 = cc % (VS / 8);
      const bfr* rb = (const bfr*)&rv[ii];
#pragma unroll
      for (int e = 0; e < 8; e++) Vt[(c4 * 8 + e) * LDT + i] = rb[e];
    }
    if (tid < 128) {
      int i = tid >> 1, hf = tid & 1;
      float x[8];
      unpack8(rr, x);
#pragma unroll
      for (int e = 0; e < 8; e++) RF[i * 16 + hf * 8 + e] = x[e];
    }
    __syncthreads();
    if (c + 1 < nc) prefetch(c + 1);
    gla_chunk_prep(tid, wd, bias, Qr, Kr, Qe, Ke, KlT, RF, tot, lastv);
    f32x4 stn[NVT];
    {
      float el = __expf(lastv[16 * wid + l15]);
#pragma unroll
      for (int mv = 0; mv < NVT; mv++) {
        stn[mv] = st[mv] * el;
#pragma unroll
        for (int kk = 0; kk < 2; kk++) {
          bf16x8 va = *(const bf16x8*)(Vt + (16 * mv + l15) * LDT + kk * 32 + g * 8);
          bf16x8 kb = *(const bf16x8*)(KlT + (16 * wid + l15) * LDT + kk * 32 + g * 8);
          stn[mv] = mfma16(va, kb, stn[mv]);
        }
      }
      gla_att(wid, g, l15, Qe, Ke, Att);
    }
    __syncthreads();
    {
      bf16x8 aa[2], qa[2];
#pragma unroll
      for (int kk = 0; kk < 2; kk++) {
        aa[kk] = *(const bf16x8*)(Att + (16 * wid + l15) * LDT + kk * 32 + g * 8);
        qa[kk] = *(const bf16x8*)(Qe + (16 * wid + l15) * LDT + kk * 32 + g * 8);
      }
#pragma unroll
      for (int nv = 0; nv < NVT; nv++) {
        f32x4 oc = (f32x4){0.f, 0.f, 0.f, 0.f};
#pragma unroll
        for (int kk = 0; kk < 2; kk++) {
          bf16x8 vb = *(const bf16x8*)(Vt + (16 * nv + l15) * LDT + kk * 32 + g * 8);
          oc = mfma16(aa[kk], vb, oc);
          bf16x8 sb = *(const bf16x8*)(St + (16 * nv + l15) * LDT + kk * 32 + g * 8);
          oc = mfma16(qa[kk], sb, oc);
        }
#pragma unroll
        for (int r = 0; r < 4; r++) {
          int i = 16 * wid + 4 * g + r;
          int tok = dir ? (N - 1 - (c * 64 + i)) : (c * 64 + i);
          OG[(long)(rowbase + tok) * 512 + h * 128 + vs0 + 16 * nv + l15] = f2bf(oc[r]);
        }
      }
    }
    __syncthreads();
#pragma unroll
    for (int mv = 0; mv < NVT; mv++) {
      st[mv] = stn[mv];
#pragma unroll
      for (int r = 0; r < 4; r++) St[(16 * mv + 4 * g + r) * LDT + 16 * wid + l15] = f2bf(st[mv][r]);
    }
  }
  __syncthreads();
  if (!lat) {
    float* so = p.out + (dir ? O_SB : O_SF) + ((long)((seq * 2 + l) * 4 + h)) * 8192 + (long)(16 * wid + l15) * 128 + vs0;
#pragma unroll
    for (int mv = 0; mv < NVT; mv++)
      *(float4*)(so + 16 * mv + 4 * g) = make_float4(st[mv][0], st[mv][1], st[mv][2], st[mv][3]);
  }
}

__device__ __forceinline__ void phase_mla_up(const Params& p, int l, bfr* sm) {
  bfr* Z = (bfr*)(p.ws + WS_Z);
  const float* rope = (const float*)(p.ws + WS_ROPE);
  const int lane = TIDX & 63, wid = TIDX >> 6, wr = wid >> 1, wc = wid & 1;
  const int g = lane >> 4;
  for (int t = blockIdx.x; t < 288 + 624 + 1024; t += gridDim.x) {
    if (t >= 912) {
      int i = t - 912;
      gla_prep_item(p, l, i >> 9, (i >> 7) & 3, (i >> 6) & 1, i & 63, sm);
      continue;
    }
    f32x4 acc[4][4];
#pragma unroll
    for (int a = 0; a < 4; a++)
#pragma unroll
      for (int b = 0; b < 4; b++) acc[a][b] = (f32x4){0.f, 0.f, 0.f, 0.f};
    if (t < 288) {
      int tn = t % 3, tm = t / 3;
      gemm128((const bfr*)(p.ws + WS_WUQ) + (long)tn * 128 * 256, 256, 128, Z + (long)tm * 128 * ZLD + C_QL, ZLD, 128, 256,
              acc, sm);
      bfr* CQ = (bfr*)(p.ws + WS_CQ);
      const float qs = 0.10206207261596577f * 1.4426950408889634f;
#pragma unroll
      for (int pi = 0; pi < 4; pi++) {
        int nb = tn * 128 + wr * 64 + pi * 16;
        int wb = nb % 96;
        bool ropet = wb >= 64;
        int part = (wb - 64) >> 4;
#pragma unroll
        for (int qi = 0; qi < 4; qi++) {
          int tok = tm * 128 + wc * 64 + qi * 16 + (lane & 15);
          float y[4] = {acc[pi][qi][0], acc[pi][qi][1], acc[pi][qi][2], acc[pi][qi][3]};
          if (ropet) {
            bool lat = tok >= NCTX;
            int tl = (tok - NCTX) & 4095;
            int pos = part ? (tl & 63) : (tl >> 6);
            bool hi = (g & 2) != 0;
            int i0 = (g & 1) * 4;
#pragma unroll
            for (int r = 0; r < 4; r++) {
              float yp = __shfl_xor(y[r], 32);
              float c = rope[2048 + pos * 8 + i0 + r], s = rope[2560 + pos * 8 + i0 + r];
              float yr = hi ? (yp * s + y[r] * c) : (y[r] * c - yp * s);
              y[r] = lat ? yr : y[r];
            }
          }
          u32x2 o;
          o.x = pack2(y[0] * qs, y[1] * qs);
          o.y = pack2(y[2] * qs, y[3] * qs);
          *(u32x2*)(CQ + (long)tok * 384 + nb + g * 4) = o;
        }
      }
    } else {
      int t2 = t - 288;
      int tn = t2 % 6, tm = t2 / 6;
      const bfr* Q;
      long ldq;
      long kbase, vbase;
      int nk, key0;
      if (tm < 32) {
        Q = Z + (long)tm * 128 * ZLD + C_KV;
        ldq = ZLD;
        int s = tm >> 1;
        key0 = (tm & 1) * 128;
        nk = 256;
        kbase = (long)s * (4 * 256 * 64);
        vbase = (long)s * 131072;
      } else {
        int r = (tm - 32) * 128;
        int b = r / 4608, within = r % 4608;
        key0 = within;
        nk = 4608;
        kbase = 16l * (4 * 256 * 64) + (long)b * (4 * 4608 * 64);
        vbase = 16l * 131072 + (long)b * (4 * 128 * 4608);
        if (within < 512) {
          Q = (const bfr*)(p.ws + WS_CKVC) + (long)(b * 512 + within) * 256;
          ldq = 256;
        } else {
          Q = Z + (long)(NCTX + b * 4096 + within - 512) * ZLD + C_KV;
          ldq = ZLD;
        }
      }
      gemm128((const bfr*)(p.ws + WS_WUKV) + (long)tn * 128 * 256, 256, 128, Q, ldq, 128, 256, acc, sm);
      bfr* KN = (bfr*)(p.ws + WS_KNOPE);
      bfr* VTC = (bfr*)(p.ws + WS_VTC);
#pragma unroll
      for (int pi = 0; pi < 4; pi++) {
        int n0 = tn * 128 + wr * 64 + pi * 16 + g * 4;
        int head = n0 / 192, w = n0 % 192;
#pragma unroll
        for (int qi = 0; qi < 4; qi++) {
          int key = key0 + wc * 64 + qi * 16 + (lane & 15);
          if (w < 64) {
            u32x2 o;
            o.x = pack2(acc[pi][qi][0], acc[pi][qi][1]);
            o.y = pack2(acc[pi][qi][2], acc[pi][qi][3]);
            *(u32x2*)(KN + kbase + ((long)head * nk + key) * 64 + w) = o;
          } else {
#pragma unroll
            for (int r = 0; r < 4; r++)
              VTC[vbase + ((long)head * 128 + (w - 64) + r) * nk + key] = f2bf(acc[pi][qi][r]);
          }
        }
      }
    }
  }
}

template <int DQ, int DV, bool MLA>
__device__ __forceinline__ void attn_item(const Params& p, int seq, int head, int qblk, bfr* sm, int dry) {
  constexpr int KLD = DQ + 8;
  constexpr int KSZ = 64 * KLD;
  constexpr int VSZ = DV * LDT;
  constexpr int BUF = KSZ + VSZ;
  constexpr int NKK = DQ / 32;
  constexpr int NDV = DV / 16;
  constexpr int NVL = DV / 32;
  const int tid = TIDX, lane = tid & 63, wid = tid >> 6, g = lane >> 4, l15 = lane & 15;
  bfr* Z = (bfr*)(p.ws + WS_Z);
  const bool lat = seq >= 16;
  const int b = seq - 16;
  const int nk = lat ? 4608 : 256;
  const int rowbase = lat ? NCTX + b * 4096 : seq * 256;
  const int nkt = nk >> 6;

  bf16x8 qf[2][NKK];
#pragma unroll
  for (int qb = 0; qb < 2; qb++) {
    int qrow = rowbase + qblk * 128 + wid * 32 + qb * 16 + l15;
    const bfr* qp = MLA ? ((const bfr*)(p.ws + WS_CQ) + (long)qrow * 384 + head * 96) : (Z + (long)qrow * ZLD + C_QA + head * 64);
#pragma unroll
    for (int kk = 0; kk < NKK; kk++) qf[qb][kk] = *(const bf16x8*)(qp + kk * 32 + g * 8);
  }

  u32x4 rk[2], rkr, rv[NVL];
  auto prefetch = [&](int kt) {
    int k0 = kt * 64;
    bool cache = lat && (k0 < 512);
    int tokrow0 = lat ? (NCTX + b * 4096 + k0 - 512) : (seq * 256 + k0);
    if (!MLA) {
      int kvh = head >> 2;
#pragma unroll
      for (int i = 0; i < 2; i++) {
        int c = tid + 256 * i;
        int kr_ = c >> 3, ch = c & 7;
        const bfr* src = cache ? ((const bfr*)(p.ws + WS_KCA) + (long)(b * 512 + k0 + kr_) * 128 + kvh * 64 + ch * 8)
                               : (Z + (long)(tokrow0 + kr_) * ZLD + C_KA + kvh * 64 + ch * 8);
        rk[i] = *(const u32x4*)src;
      }
      long vb = lat ? (16l * 32768 + (long)b * (2 * 64 * 4608)) : ((long)seq * 32768);
#pragma unroll
      for (int i = 0; i < NVL; i++) {
        int c = tid + 256 * i;
        int dv = c >> 3, ch = c & 7;
        rv[i] = *(const u32x4*)((const bfr*)(p.ws + WS_VTA) + vb + (long)(kvh * 64 + dv) * nk + k0 + ch * 8);
      }
    } else {
      long kb = lat ? (16l * (4 * 256 * 64) + (long)b * (4 * 4608 * 64)) : ((long)seq * (4 * 256 * 64));
#pragma unroll
      for (int i = 0; i < 2; i++) {
        int c = tid + 256 * i;
        int kr_ = c >> 3, ch = c & 7;
        rk[i] = *(const u32x4*)((const bfr*)(p.ws + WS_KNOPE) + kb + ((long)head * nk + k0 + kr_) * 64 + ch * 8);
      }
      {
        int kr_ = tid >> 2, ch = tid & 3;
        const bfr* src = cache ? ((const bfr*)(p.ws + WS_KRC) + (long)(b * 512 + k0 + kr_) * 32 + ch * 8)
                               : (Z + (long)(tokrow0 + kr_) * ZLD + C_KR + ch * 8);
        rkr = *(const u32x4*)src;
      }
      long vb = lat ? (16l * 131072 + (long)b * (4 * 128 * 4608)) : ((long)seq * 131072);
#pragma unroll
      for (int i = 0; i < NVL; i++) {
        int c = tid + 256 * i;
        int dv = c >> 3, ch = c & 7;
        rv[i] = *(const u32x4*)((const bfr*)(p.ws + WS_VTC) + vb + (long)(head * 128 + dv) * nk + k0 + ch * 8);
      }
    }
  };

  f32x4 o[2][NDV];
#pragma unroll
  for (int qb = 0; qb < 2; qb++)
#pragma unroll
    for (int d = 0; d < NDV; d++) o[qb][d] = (f32x4){0.f, 0.f, 0.f, 0.f};
  float mrun[2] = {-1e30f, -1e30f}, lsum[2] = {0.f, 0.f};

  prefetch(0);
  for (int kt = 0; kt < nkt; kt++) {
    bfr* Ks = sm + (kt & 1) * BUF;
    bfr* Vs = Ks + KSZ;
#pragma unroll
    for (int i = 0; i < 2; i++) {
      int c = tid + 256 * i;
      *(u32x4*)(Ks + (c >> 3) * KLD + (c & 7) * 8) = rk[i];
    }
    if (MLA) *(u32x4*)(Ks + (tid >> 2) * KLD + 64 + (tid & 3) * 8) = rkr;
#pragma unroll
    for (int i = 0; i < NVL; i++) {
      int c = tid + 256 * i;
      *(u32x4*)(Vs + (c >> 3) * LDT + (c & 7) * 8) = rv[i];
    }
    __syncthreads();
    if (kt + 1 < nkt) prefetch(kt + 1);

    f32x4 s[2][4];
#pragma unroll
    for (int t = 0; t < 4; t++) {
      s[0][t] = (f32x4){0.f, 0.f, 0.f, 0.f};
      s[1][t] = (f32x4){0.f, 0.f, 0.f, 0.f};
      int krow = 32 * (t >> 1) + 8 * (l15 >> 2) + 4 * (t & 1) + (l15 & 3);
#pragma unroll
      for (int kk = 0; kk < NKK; kk++) {
        bf16x8 kf = *(const bf16x8*)(Ks + krow * KLD + kk * 32 + g * 8);
        s[0][t] = mfma16(kf, qf[0][kk], s[0][t]);
        s[1][t] = mfma16(kf, qf[1][kk], s[1][t]);
      }
    }
    bf16x8 pf[2][2];
#pragma unroll
    for (int qb = 0; qb < 2; qb++) {
      float mt = s[qb][0][0];
#pragma unroll
      for (int t = 0; t < 4; t++)
#pragma unroll
        for (int r = 0; r < 4; r++) mt = fmaxf(mt, s[qb][t][r]);
      mt = fmaxf(mt, __shfl_xor(mt, 16));
      mt = fmaxf(mt, __shfl_xor(mt, 32));
      float mnew = fmaxf(mrun[qb], mt);
      float alpha = __builtin_amdgcn_exp2f(mrun[qb] - mnew);
      mrun[qb] = mnew;
      float ps = 0.f;
#pragma unroll
      for (int t = 0; t < 4; t++)
#pragma unroll
        for (int r = 0; r < 4; r++) {
          float pv = __builtin_amdgcn_exp2f(s[qb][t][r] - mnew);
          ps += pv;
          s[qb][t][r] = pv;
        }
      lsum[qb] = lsum[qb] * alpha + ps;
#pragma unroll
      for (int d = 0; d < NDV; d++) {
        o[qb][d][0] *= alpha; o[qb][d][1] *= alpha; o[qb][d][2] *= alpha; o[qb][d][3] *= alpha;
      }
#pragma unroll
      for (int sx = 0; sx < 2; sx++) {
        u32x4 u;
        u.x = pack2(s[qb][2 * sx][0], s[qb][2 * sx][1]);
        u.y = pack2(s[qb][2 * sx][2], s[qb][2 * sx][3]);
        u.z = pack2(s[qb][2 * sx + 1][0], s[qb][2 * sx + 1][1]);
        u.w = pack2(s[qb][2 * sx + 1][2], s[qb][2 * sx + 1][3]);
        pf[qb][sx] = *(bf16x8*)&u;
      }
    }
#pragma unroll
    for (int d = 0; d < NDV; d++) {
#pragma unroll
      for (int sx = 0; sx < 2; sx++) {
        bf16x8 vf = *(const bf16x8*)(Vs + (d * 16 + l15) * LDT + sx * 32 + g * 8);
        o[0][d] = mfma16(vf, pf[0][sx], o[0][d]);
        o[1][d] = mfma16(vf, pf[1][sx], o[1][d]);
      }
    }
  }
  __syncthreads();
#pragma unroll
  for (int qb = 0; qb < 2; qb++) {
    float lt = lsum[qb];
    lt += __shfl_xor(lt, 16);
    lt += __shfl_xor(lt, 32);
    float inv = 1.f / lt;
    int qrow = rowbase + qblk * 128 + wid * 32 + qb * 16 + l15;
    bfr* gp = Z + (long)qrow * ZLD + (MLA ? C_GC : C_GA) + head * DV + g * 4;
#pragma unroll
    for (int d = 0; d < NDV; d++) {
      u32x2 gr = *(const u32x2*)(gp + d * 16);
      float y0 = o[qb][d][0] * inv * siluf(lo16(gr.x));
      float y1 = o[qb][d][1] * inv * siluf(hi16(gr.x));
      float y2 = o[qb][d][2] * inv * siluf(lo16(gr.y));
      float y3 = o[qb][d][3] * inv * siluf(hi16(gr.y));
      u32x2 ov;
      ov.x = pack2(y0, y1);
      ov.y = pack2(y2, y3);
      if (!dry) *(u32x2*)(gp + d * 16) = ov;
    }
  }
}

__device__ __forceinline__ void phase_mixers(const Params& p, int l, bfr* sm, int* s_item, int dry) {
  unsigned* ctr = (unsigned*)(p.ws + WS_CTR) + (2 + l + 2 * dry) * 128;
  auto cnt = [](int) { return 180; };
  int q = (int)xcc_id(), tried = 0;
  for (;;) {
    if (TIDX == 0) {
      unsigned first = atomicAdd(ctr + q * 16, 1u);
      *s_item = xq_take(ctr, q, tried, first, cnt);
    }
    __syncthreads();
    const int it = *s_item;
    __syncthreads();
    if (it < 0) break;
    const int x = it >> 20, j = it & 0xfffff;
    int kind, a0, a1, a2, a3 = 0;
    if (j < 4) {
      int idx = x * 4 + j;
      kind = 3; a0 = idx >> 4; a1 = (idx >> 2) & 3; a2 = (idx >> 1) & 1; a3 = idx & 1;
    } else if (j < 36) {
      kind = 1; a0 = 16 + (x >> 2); a1 = x & 3; a2 = j - 4;
    } else if (j < 100) {
      int i = j - 36;
      kind = 2; a0 = 16 + (x >> 2); a1 = ((x >> 1) & 1) * 4 + (x & 1) * 2 + (i >> 5); a2 = i & 31;
    } else if (j < 132) {
      int i = j - 100;
      kind = 0; a0 = 2 * x + (i >> 4); a1 = (i >> 2) & 3; a2 = (i >> 1) & 1; a3 = i & 1;
    } else if (j < 148) {
      int i = j - 132;
      kind = 1; a0 = 2 * x + (i >> 3); a1 = (i >> 1) & 3; a2 = i & 1;
    } else {
      int i = j - 148;
      kind = 2; a0 = 2 * x + (i >> 4); a1 = (i >> 1) & 7; a2 = i & 1;
    }
#ifdef PROBE_MIXKIND
    if (dry && ((PROBE_MIXKIND == 1) != (kind == 0 || kind == 3))) continue;
#endif
    if (kind == 0) gla_item<64>(p, l, a0, a1, a2, a3, sm);
    else if (kind == 3) gla_chain_item(p, l, a0, a1, a2, a3, sm);
    else if (kind == 1) attn_item<96, 128, true>(p, a0, a1, a2, sm, dry);
    else attn_item<64, 64, false>(p, a0, a1, a2, sm, dry);
  }
}

__device__ __forceinline__ void phase_gla_out(const Params& p, int l) {
  const int lane = TIDX & 63;
  bfr* Z = (bfr*)(p.ws + WS_Z);
  const bfr* OF = (const bfr*)(p.ws + WS_R1);
  const bfr* OB = OF + (long)NROWS * 512;
  for (int row = blockIdx.x * 4 + (TIDX >> 6); row < NROWS; row += gridDim.x * 4) {
    float a[8], c[8], gt[8];
    unpack8(*(const u32x4*)(OF + (long)row * 512 + lane * 8), a);
    unpack8(*(const u32x4*)(OB + (long)row * 512 + lane * 8), c);
    bfr* gp = Z + (long)row * ZLD + C_GG + lane * 8;
    unpack8(*(const u32x4*)gp, gt);
    float ss = 0.f;
#pragma unroll
    for (int e = 0; e < 8; e++) {
      a[e] = bf2f(f2bf(a[e] + c[e]));
      ss += a[e] * a[e];
    }
    ss += __shfl_xor(ss, 1); ss += __shfl_xor(ss, 2); ss += __shfl_xor(ss, 4); ss += __shfl_xor(ss, 8);
    float rs = rsqrtf(ss * (1.f / 128.f) + 1e-6f);
    const float* gg = p.in[21] + l * 128 + (lane & 15) * 8;
#pragma unroll
    for (int e = 0; e < 8; e++) a[e] = a[e] * rs * gg[e] * siluf(gt[e]);
    *(u32x4*)gp = pack8(a);
  }
}

__device__ __forceinline__ void phase_merge(const Params& p, bfr* sm) {
  bfr* Z = (bfr*)(p.ws + WS_Z);
  bfr* MG = (bfr*)(p.ws + WS_R1);
  const int lane = TIDX & 63, wid = TIDX >> 6, wr = wid >> 1, wc = wid & 1, g = lane >> 4;
  for (int t = blockIdx.x; t < 96 * 8; t += gridDim.x) {
    int tn = t & 7, tm = t >> 3;
    f32x4 totl[4][4];
#pragma unroll
    for (int a = 0; a < 4; a++)
#pragma unroll
      for (int b = 0; b < 4; b++) totl[a][b] = (f32x4){0.f, 0.f, 0.f, 0.f};
#pragma unroll 1
    for (int seg = 0; seg < 3; seg++) {
      f32x4 acc[4][4];
#pragma unroll
      for (int a = 0; a < 4; a++)
#pragma unroll
        for (int b = 0; b < 4; b++) acc[a][b] = (f32x4){0.f, 0.f, 0.f, 0.f};
      int ycol = seg == 0 ? C_GA : (seg == 1 ? C_GG : C_GC);
      int mcol = C_M1 + seg * 1024;
      const bfr* W = (const bfr*)(p.ws + WS_WOA + (unsigned long)seg * 1048576ul) + (long)tn * 128 * 512;
      gemm128(W, 512, 128, Z + (long)tm * 128 * ZLD + ycol, ZLD, 128, 512, acc, sm);
#pragma unroll
      for (int pi = 0; pi < 4; pi++) {
        int n0 = tn * 128 + wr * 64 + pi * 16 + g * 4;
#pragma unroll
        for (int qi = 0; qi < 4; qi++) {
          int tok = tm * 128 + wc * 64 + qi * 16 + (lane & 15);
          u32x2 mr = *(const u32x2*)(Z + (long)tok * ZLD + mcol + n0);
          totl[pi][qi][0] += sigmf(lo16(mr.x)) * acc[pi][qi][0];
          totl[pi][qi][1] += sigmf(hi16(mr.x)) * acc[pi][qi][1];
          totl[pi][qi][2] += sigmf(lo16(mr.y)) * acc[pi][qi][2];
          totl[pi][qi][3] += sigmf(hi16(mr.y)) * acc[pi][qi][3];
        }
      }
    }
#pragma unroll
    for (int pi = 0; pi < 4; pi++) {
      int n0 = tn * 128 + wr * 64 + pi * 16 + g * 4;
#pragma unroll
      for (int qi = 0; qi < 4; qi++) {
        int tok = tm * 128 + wc * 64 + qi * 16 + (lane & 15);
        u32x2 o;
        o.x = pack2(totl[pi][qi][0], totl[pi][qi][1]);
        o.y = pack2(totl[pi][qi][2], totl[pi][qi][3]);
        *(u32x2*)(MG + (long)tok * 1024 + n0) = o;
      }
    }
  }
}

__device__ __forceinline__ void phase_outproj(const Params& p, bfr* sm) {
  const bfr* MG = (const bfr*)(p.ws + WS_R1);
  float* OUT = (float*)(p.ws + WS_Z);
  const int lane = TIDX & 63, wid = TIDX >> 6, wr = wid >> 1, wc = wid & 1, g = lane >> 4;
  for (int t = blockIdx.x; t < 96 * 8; t += gridDim.x) {
    int tn = t & 7, tm = t >> 3;
    f32x4 acc[4][4];
#pragma unroll
    for (int a = 0; a < 4; a++)
#pragma unroll
      for (int b = 0; b < 4; b++) acc[a][b] = (f32x4){0.f, 0.f, 0.f, 0.f};
    gemm128((const bfr*)(p.ws + WS_WOUT) + (long)tn * 128 * 1024, 1024, 128, MG + (long)tm * 128 * 1024, 1024, 128, 1024, acc,
            sm);
#pragma unroll
    for (int pi = 0; pi < 4; pi++) {
      int n0 = tn * 128 + wr * 64 + pi * 16 + g * 4;
#pragma unroll
      for (int qi = 0; qi < 4; qi++) {
        int tok = tm * 128 + wc * 64 + qi * 16 + (lane & 15);
        *(float4*)(OUT + (long)tok * 1024 + n0) = make_float4(acc[pi][qi][0], acc[pi][qi][1], acc[pi][qi][2], acc[pi][qi][3]);
      }
    }
  }
}

__device__ __forceinline__ void phase_post(const Params& p, int l) {
  const int lane = TIDX & 63;
  const float* mod = (const float*)(p.ws + WS_MOD);
  const float* OUT = (const float*)(p.ws + WS_Z);
  bfr* H = (bfr*)(p.ws + WS_R1);
  for (int row = blockIdx.x * 4 + (TIDX >> 6); row < NROWS; row += gridDim.x * 4) {
    const float* x = (l == 0) ? xrow(p, row) : (p.out + (long)row * 1024);
    const float* md = mod + (l * 3 + row_cond(row)) * 3072;
    float4 v[4];
    float ss = 0.f;
#pragma unroll
    for (int i = 0; i < 4; i++) {
      v[i] = *(const float4*)(OUT + (long)row * 1024 + i * 256 + lane * 4);
      ss += v[i].x * v[i].x + v[i].y * v[i].y + v[i].z * v[i].z + v[i].w * v[i].w;
    }
    ss = wave_sum(ss);
    float rs = rsqrtf(ss * (1.f / 1024.f) + 1e-6f);
    float ss2 = 0.f;
#pragma unroll
    for (int i = 0; i < 4; i++) {
      int n = i * 256 + lane * 4;
      float4 g = *(const float4*)(p.in[13] + l * 1024 + n);
      float4 gt = *(const float4*)(md + 2048 + n);
      float4 xv = *(const float4*)(x + n);
      v[i].x = xv.x + gt.x * (v[i].x * rs * g.x);
      v[i].y = xv.y + gt.y * (v[i].y * rs * g.y);
      v[i].z = xv.z + gt.z * (v[i].z * rs * g.z);
      v[i].w = xv.w + gt.w * (v[i].w * rs * g.w);
      *(float4*)(p.out + (long)row * 1024 + n) = v[i];
      ss2 += v[i].x * v[i].x + v[i].y * v[i].y + v[i].z * v[i].z + v[i].w * v[i].w;
    }
    if (l == 0) {
      ss2 = wave_sum(ss2);
      float rs2 = rsqrtf(ss2 * (1.f / 1024.f) + 1e-6f);
      const float* md1 = mod + (1 * 3 + row_cond(row)) * 3072;
#pragma unroll
      for (int i = 0; i < 4; i++) {
        int n = i * 256 + lane * 4;
        float4 g = *(const float4*)(p.in[12] + 1024 + n);
        float4 sh = *(const float4*)(md1 + n);
        float4 sc = *(const float4*)(md1 + 1024 + n);
        float h0 = v[i].x * rs2 * g.x * (1.f + sc.x) + sh.x;
        float h1 = v[i].y * rs2 * g.y * (1.f + sc.y) + sh.y;
        float h2 = v[i].z * rs2 * g.z * (1.f + sc.z) + sh.z;
        float h3 = v[i].w * rs2 * g.w * (1.f + sc.w) + sh.w;
        u32x2 o;
        o.x = pack2(h0, h1);
        o.y = pack2(h2, h3);
        *(u32x2*)(H + (long)row * 1024 + n) = o;
      }
    }
  }
}

__global__ void __launch_bounds__(256, 2) fwd_megakernel(Params p) {
  __shared__ __attribute__((aligned(16))) bfr sm[SMEM_SHORTS + 16];
  int* s_item_p = (int*)(sm + SMEM_SHORTS + 8);
  cg::grid_group grid = cg::this_grid();
  if (threadIdx.x == 0) { ((unsigned*)(sm + SMEM_SHORTS))[0] = 0u; ((unsigned*)(sm + SMEM_SHORTS))[1] = 0u; }
  __syncthreads();
  XcdBarrier xb = xcd_barrier_post((unsigned*)(p.ws + WS_BAR), (volatile LAS unsigned*)(sm + SMEM_SHORTS));
  if (p.ws == nullptr) grid.sync();
#ifdef PROBE_SYNC
#define GSYNC do { xcd_barrier(xb); xcd_barrier(xb); } while (0)
#else
#define GSYNC xcd_barrier(xb)
#endif
#ifdef PROBE_PRE
  phase_s0(launder(p), sm);
  GSYNC;
  phase_s1(launder(p));
  wconv_phase(p, 0, sm);
  GSYNC;
  phase_prenorm0(launder(p));
  GSYNC;
#endif

#ifndef PH
#define PH 0xffff
#endif
#if PH & 1
  phase_s0(launder(p), sm);
#endif
  GSYNC;
#if PH & 2
  phase_s1(launder(p));
  wconv_phase(p, 0, sm);
#endif
  GSYNC;
#if PH & 4
  phase_prenorm0(launder(p));
#endif
  GSYNC;
  for (int l = 0; l < 2; l++) {
#if PH & 8
#ifdef PROBE_INPROJ
    phase_inproj(launder(p), l, sm, s_item_p, 6 + l);
    GSYNC;
#endif
    phase_inproj(launder(p), l, sm, s_item_p, l);
#endif
    GSYNC;
#if PH & 16
    phase_rowpost(launder(p), l);
#endif
    GSYNC;
#if PH & 32
#ifdef PROBE_MLAUP
    phase_mla_up(launder(p), l, sm);
    GSYNC;
#endif
    phase_mla_up(launder(p), l, sm);
#endif
    GSYNC;
#if PH & 64
#ifdef PROBE_MIX
    { int dry = 1; asm volatile("" : "+s"(dry)); phase_mixers(launder(p), l, sm, s_item_p, dry); }
    GSYNC;
#endif
    { int dry = 0; asm volatile("" : "+s"(dry)); phase_mixers(launder(p), l, sm, s_item_p, dry); }
#endif
    GSYNC;
#if PH & 128
    phase_gla_out(launder(p), l);
#endif
    GSYNC;
#if PH & 256
#ifdef PROBE_MERGE
    phase_merge(launder(p), sm);
    GSYNC;
#endif
    phase_merge(launder(p), sm);
#endif
    GSYNC;
#if PH & 512
#ifdef PROBE_MERGE
    phase_outproj(launder(p), sm);
    GSYNC;
#endif
    phase_outproj(launder(p), sm);
#endif
    GSYNC;
#if PH & 1024
    phase_post(launder(p), l);
    if (l == 0) wconv_phase(p, 1, sm);
#endif
    GSYNC;
  }
}

extern "C" void kernel_launch(void* const* d_in, const int* in_sizes, int n_in, void* d_out, int out_size, void* d_ws,
                              size_t ws_size, hipStream_t stream) {
  static int grid_blocks = 0;
  if (!grid_blocks) {
    int dev = 0, cus = 0, per_cu = 0;
    hipGetDevice(&dev);
    hipDeviceGetAttribute(&cus, hipDeviceAttributeMultiprocessorCount, dev);
    hipOccupancyMaxActiveBlocksPerMultiprocessor(&per_cu, fwd_megakernel, 256, 0);
    if (per_cu > 2) per_cu = 2;
    if (per_cu < 1) per_cu = 1;
    grid_blocks = cus * per_cu;
  }
  Params p{};
  for (int i = 0; i < 30; i++) p.in[i] = (const float*)d_in[i];
  p.out = (float*)d_out;
  p.ws = (unsigned char*)d_ws;
  hipMemsetAsync(d_ws, 0, 20480, stream);
  void* args[] = {&p};
  hipError_t e = hipLaunchCooperativeKernel((void*)fwd_megakernel, dim3(grid_blocks), dim3(256), args, 0, stream);
  if (e != hipSuccess) fprintf(stderr, "cooperative launch failed: %s (grid %d)\n", hipGetErrorString(e), grid_blocks);
}
```

```cpp
#include <hip/hip_runtime.h>
#include <hip/hip_cooperative_groups.h>
#include <cstdio>
namespace cg = cooperative_groups;

typedef unsigned short bfr;
typedef __attribute__((ext_vector_type(8))) short bf16x8;
typedef __attribute__((ext_vector_type(4))) float f32x4;
typedef __attribute__((ext_vector_type(4))) unsigned u32x4;
typedef __attribute__((ext_vector_type(2))) unsigned u32x2;

#define NROWS 12288
#define NCTX 4096
#define ZLD 6976
#define LDT 72
#define SMEM_SHORTS (4 * 128 * LDT)

#define C_QA 0
#define C_KA 512
#define C_VA 640
#define C_GA 768
#define C_QG 1280
#define C_KG 1536
#define C_VG 1792
#define C_GG 2304
#define C_RF 2816
#define C_RB 2832
#define C_QL 2848
#define C_KV 3104
#define C_KR 3360
#define C_GC 3392
#define C_M1 3904
#define C_M2 4928
#define C_M3 5952

#define WS_BAR 0ul
#define WS_CTR 16384ul
#define WS_MODP 20480ul
#define WS_MOD (WS_MODP + 589824ul)
#define WS_ROPE (WS_MOD + 73728ul)
#define WS_WIN (WS_ROPE + 16384ul)
#define WS_WUQ (WS_WIN + 14417920ul)
#define WS_WUKV (WS_WUQ + 196608ul)
#define WS_WOA (WS_WUKV + 393216ul)
#define WS_WOB (WS_WOA + 1048576ul)
#define WS_WOC (WS_WOB + 1048576ul)
#define WS_WOUT (WS_WOC + 1048576ul)
#define WS_KCA (WS_WOUT + 2097152ul)
#define WS_CKVC (WS_KCA + 262144ul)
#define WS_KRC (WS_CKVC + 524288ul)
#define WS_VTA (WS_KRC + 65536ul)
#define WS_CQ (WS_VTA + 3407872ul)
#define WS_KNOPE (WS_CQ + 9437184ul)
#define WS_VTC (WS_KNOPE + 6815744ul)
#define WS_R1 (WS_VTC + 13631488ul)
#define WS_Z (WS_R1 + 25165824ul)
#define WS_END (WS_Z + 171442176ul)

#define O_Y 0
#define O_GK 12582912
#define O_GV 13631488
#define O_CKV 14680064
#define O_KR 16777216
#define O_SF 17039360
#define O_SB 18087936

struct Params {
  const float* in[30];
  float* out;
  unsigned char* ws;
};

__device__ __forceinline__ int tidx() {
  int t = threadIdx.x;
  asm volatile("" : "+v"(t));
  return t;
}
__device__ __forceinline__ Params launder(const Params& p) {
  Params q;
  long zo = 0;
  asm volatile("" : "+s"(zo));
#pragma unroll
  for (int i = 0; i < 30; i++) q.in[i] = p.in[i] + zo;
  q.out = p.out + zo;
  q.ws = p.ws + zo;
  return q;
}
__device__ __forceinline__ float bf2f(bfr b) { return __uint_as_float(((unsigned)b) << 16); }
typedef float f32x2_t __attribute__((ext_vector_type(2)));
typedef __bf16 bf16x2_t __attribute__((ext_vector_type(2)));
__device__ __forceinline__ bfr f2bf(float f) {
  __bf16 r = (__bf16)f;
  return *(bfr*)&r;
}
__device__ __forceinline__ unsigned pack2(float a, float b) {
  f32x2_t v = {a, b};
  bf16x2_t r = __builtin_convertvector(v, bf16x2_t);
  return *(unsigned*)&r;
}
__device__ __forceinline__ float lo16(unsigned u) { return __uint_as_float(u << 16); }
__device__ __forceinline__ float hi16(unsigned u) { return __uint_as_float(u & 0xffff0000u); }
__device__ __forceinline__ float siluf(float x) { return x / (1.f + __expf(-x)); }
__device__ __forceinline__ float sigmf(float x) { return 1.f / (1.f + __expf(-x)); }
__device__ __forceinline__ f32x4 mfma16(bf16x8 a, bf16x8 b, f32x4 c) {
  return __builtin_amdgcn_mfma_f32_16x16x32_bf16(a, b, c, 0, 0, 0);
}
__device__ __forceinline__ const float* xrow(const Params& p, int row) {
  return row < NCTX ? p.in[0] + (long)row * 1024 : p.in[1] + (long)(row - NCTX) * 1024;
}
__device__ __forceinline__ int row_cond(int row) { return row < NCTX ? 0 : 1 + ((row - NCTX) >> 12); }
__device__ __forceinline__ float wave_sum(float v) {
  v += __shfl_xor(v, 1); v += __shfl_xor(v, 2); v += __shfl_xor(v, 4);
  v += __shfl_xor(v, 8); v += __shfl_xor(v, 16); v += __shfl_xor(v, 32);
  return v;
}

#define XB_TMO      128
#define XB_XCNT(j)  (256  + 64 * (j))
#define XB_XSUB(j)  (1280 + 64 * (j))
#define XB_XGEN(j)  (2304 + 64 * (j))
#define XB_TOP      3328
#define XB_TOPGEN   3392
#define XCD_BAR_WORDS 3456
#define XB_SPIN_CAP (1u << 18)
#define LAS __attribute__((address_space(3)))

__device__ __forceinline__ unsigned xb_ld(unsigned* p)              { return __hip_atomic_load(p, __ATOMIC_RELAXED, __HIP_MEMORY_SCOPE_AGENT); }
__device__ __forceinline__ unsigned xb_add(unsigned* p, unsigned v) { return __hip_atomic_fetch_add(p, v, __ATOMIC_RELAXED, __HIP_MEMORY_SCOPE_AGENT); }
__device__ __forceinline__ unsigned xb_xcc_id() { return (unsigned)__builtin_amdgcn_s_getreg((3 << 11) | 20) & 0xFu; }
#define XB_SPIN(cond, bar) do { unsigned _sp = 0; while (cond) { __builtin_amdgcn_s_sleep(1); \
    if ((++_sp & 255u) == 0u) { if (xb_ld(&(bar)[XB_TMO])) break; if (_sp > XB_SPIN_CAP) { atomicAdd(&(bar)[XB_TMO], 1u); break; } } } } while (0)

struct XcdBarrier {
    unsigned* bar; unsigned x;
    volatile LAS unsigned* st;
};

__device__ __forceinline__ XcdBarrier xcd_barrier_post(unsigned* bar, volatile LAS unsigned* st) {
    XcdBarrier b; b.bar = bar; b.x = xb_xcc_id(); b.st = st;
    if (threadIdx.x == 0) (void)xb_add(&bar[XB_XCNT(b.x)], 1u);
    return b;
}
__device__ __forceinline__ void xcd_barrier_complete(unsigned* bar, unsigned x, unsigned& nloc, unsigned& nx) {
    const unsigned G = gridDim.x * gridDim.y * gridDim.z;
    unsigned sum, cnt, mine, sp = 0u;
    for (;;) {
        sum = 0u; cnt = 0u; mine = 0u;
#pragma unroll
        for (unsigned j = 0; j < 16; ++j) { const unsigned c = xb_ld(&bar[XB_XCNT(j)]); sum += c; cnt += (c > 0u) ? 1u : 0u; mine = (j == x) ? c : mine; }
        if (sum == G) break;
        __builtin_amdgcn_s_sleep(1);
        if ((++sp & 255u) == 0u) { if (xb_ld(&bar[XB_TMO])) break; if (sp > XB_SPIN_CAP) { atomicAdd(&bar[XB_TMO], 1u); break; } }
    }
    nloc = mine > 0u ? mine : 1u; nx = cnt > 0u ? cnt : 1u;
}

__device__ __forceinline__ void xcd_barrier(const XcdBarrier& b) {
    asm volatile("s_waitcnt vmcnt(0)" ::: "memory");
    __syncthreads();
    if (threadIdx.x == 0) {
        unsigned* bar = b.bar;
        __builtin_amdgcn_s_waitcnt(0);
        unsigned nloc = b.st[0], nx = b.st[1];
        if (nloc == 0u) { xcd_barrier_complete(bar, b.x, nloc, nx); b.st[0] = nloc; b.st[1] = nx; }
        const unsigned old = xb_add(&bar[XB_XSUB(b.x)], 1u);
        const unsigned gen = old / nloc;
        if (old + 1u == (gen + 1u) * nloc) {
            __builtin_amdgcn_fence(__ATOMIC_RELEASE, "agent");
            asm volatile("s_waitcnt vmcnt(0)" ::: "memory");
            const unsigned og = xb_add(&bar[XB_TOP], 1u);
            const unsigned tg = og / nx;
            if (og + 1u == (tg + 1u) * nx) xb_add(&bar[XB_TOPGEN], 1u);
            else XB_SPIN(xb_ld(&bar[XB_TOPGEN]) == tg, bar);
            __builtin_amdgcn_fence(__ATOMIC_ACQUIRE, "agent");
            xb_add(&bar[XB_XGEN(b.x)], 1u);
            asm volatile("s_waitcnt vmcnt(0)" ::: "memory");
        } else {
            XB_SPIN(xb_ld(&bar[XB_XGEN(b.x)]) == gen, bar);
            __builtin_amdgcn_fence(__ATOMIC_ACQUIRE, "agent");
            asm volatile("s_waitcnt vmcnt(0)" ::: "memory");
        }
    }
    __syncthreads();
}


#define TIDX tidx()
#define LDS3 __attribute__((address_space(3)))
__device__ __forceinline__ void glds16(const bfr* g, bfr* l) {
  __builtin_amdgcn_global_load_lds((const unsigned*)g, (LDS3 unsigned*)l, 16, 0, 0);
}
__device__ __forceinline__ void gemm128(const bfr* __restrict__ P, long ldp, int pmax,
                                        const bfr* __restrict__ Q, long ldq, int qmax, int K,
                                        f32x4 (&acc)[4][4], bfr* sm) {
  const int tid = TIDX, lane = tid & 63, wid = tid >> 6;
  const int wr = wid >> 1, wc = wid & 1;
  const int l15 = lane & 15, g = lane >> 4;
  const bfr* pp[2];
  const bfr* qp[2];
  {
    const int r0 = tid >> 2;
    const int c = (tid & 3) ^ ((tid >> 4) & 3);
#pragma unroll
    for (int i = 0; i < 2; i++) {
      int r = r0 + 64 * i;
      pp[i] = P + (long)min(r, pmax - 1) * ldp + c * 8;
      qp[i] = Q + (long)min(r, qmax - 1) * ldq + c * 8;
    }
  }
  const int nk = K >> 5;
#define GEMM_ISSUE(T)                                                    \
  do {                                                                   \
    bfr* nb_ = sm + ((T) & 3) * 8192;                                    \
    glds16(pp[0] + (T) * 32, nb_ + tid * 8);                             \
    glds16(pp[1] + (T) * 32, nb_ + 2048 + tid * 8);                      \
    glds16(qp[0] + (T) * 32, nb_ + 4096 + tid * 8);                      \
    glds16(qp[1] + (T) * 32, nb_ + 6144 + tid * 8);                      \
  } while (0)
  GEMM_ISSUE(0);
  GEMM_ISSUE(1);
  GEMM_ISSUE(2);
  const int pos = (g ^ ((l15 >> 2) & 3)) * 8;
  for (int kt = 0; kt < nk; kt++) {
    if (kt + 2 < nk) asm volatile("s_waitcnt vmcnt(8)" ::: "memory");
    else if (kt + 1 < nk) asm volatile("s_waitcnt vmcnt(4)" ::: "memory");
    else asm volatile("s_waitcnt vmcnt(0)" ::: "memory");
    __builtin_amdgcn_s_barrier();
    if (kt + 3 < nk) GEMM_ISSUE(kt + 3);
    const bfr* Ps = sm + (kt & 3) * 8192;
    const bfr* Qs = Ps + 4096;
    bf16x8 pf[4], qf[4];
#pragma unroll
    for (int m = 0; m < 4; m++) {
      pf[m] = *(const bf16x8*)(Ps + (wr * 64 + m * 16 + l15) * 32 + pos);
      qf[m] = *(const bf16x8*)(Qs + (wc * 64 + m * 16 + l15) * 32 + pos);
    }
#pragma unroll
    for (int m = 0; m < 4; m++)
#pragma unroll
      for (int n = 0; n < 4; n++) acc[m][n] = mfma16(pf[m], qf[n], acc[m][n]);
  }
#undef GEMM_ISSUE
  __syncthreads();
}

__device__ __forceinline__ void gemm256x128(const bfr* __restrict__ P, long ldp, int pmax,
                                            const bfr* __restrict__ Q, long ldq, int K,
                                            f32x4 (&acc)[8][4], bfr* sm, int mode = 0) {
  const int tid = TIDX, lane = tid & 63, wid = tid >> 6;
  const int wr = wid >> 1, wc = wid & 1;
  const int l15 = lane & 15, g = lane >> 4;
  const bfr* pp[4];
  const bfr* qp[2];
  {
    const int r0 = tid >> 2;
    const int c = (tid & 3) ^ (((tid >> 5) & 1) * 3);
#pragma unroll
    for (int i = 0; i < 4; i++) pp[i] = P + (long)min(r0 + 64 * i, pmax - 1) * ldp + c * 8;
#pragma unroll
    for (int i = 0; i < 2; i++) qp[i] = Q + (long)(r0 + 64 * i) * ldq + c * 8;
  }
  const int nk = K >> 5;
#define GEMMW_ISSUE(T)                                                   \
  do {                                                                   \
    bfr* nb_ = sm + ((T) % 3) * 12288;                                   \
    glds16(pp[0] + (T) * 32, nb_ + tid * 8);                             \
    glds16(pp[1] + (T) * 32, nb_ + 2048 + tid * 8);                      \
    glds16(pp[2] + (T) * 32, nb_ + 4096 + tid * 8);                      \
    glds16(pp[3] + (T) * 32, nb_ + 6144 + tid * 8);                      \
    glds16(qp[0] + (T) * 32, nb_ + 8192 + tid * 8);                      \
    glds16(qp[1] + (T) * 32, nb_ + 10240 + tid * 8);                     \
  } while (0)
  GEMMW_ISSUE(0);
  GEMMW_ISSUE(1);
  const int pos = (g ^ (((l15 >> 3) & 1) * 3)) * 8;
  int st = 0;
  for (int kt = 0; kt < nk; kt++) {
    if (kt + 1 < nk) asm volatile("s_waitcnt vmcnt(6)" ::: "memory");
    else asm volatile("s_waitcnt vmcnt(0)" ::: "memory");
    __builtin_amdgcn_s_barrier();
    if (kt + 2 < nk && mode != 1) GEMMW_ISSUE(kt + 2);
    const bfr* Ps = sm + st * 12288;
    const bfr* Qs = Ps + 8192;
    st = (st == 2) ? 0 : st + 1;
    if (mode == 2) continue;
    bf16x8 qf[4];
#pragma unroll
    for (int n = 0; n < 4; n++) qf[n] = *(const bf16x8*)(Qs + (wc * 64 + n * 16 + l15) * 32 + pos);
#pragma unroll
    for (int m = 0; m < 8; m++) {
      bf16x8 pf = *(const bf16x8*)(Ps + (wr * 128 + m * 16 + l15) * 32 + pos);
#pragma unroll
      for (int n = 0; n < 4; n++) acc[m][n] = mfma16(pf, qf[n], acc[m][n]);
    }
  }
#undef GEMMW_ISSUE
  __syncthreads();
}

__device__ __forceinline__ void phase_s0(const Params& p, bfr* sm) {
  const int tid = TIDX;
  float* rope = (float*)(p.ws + WS_ROPE);
  for (int idx = blockIdx.x * 256 + tid; idx < 1536; idx += gridDim.x * 256) {
    if (idx < 1024) {
      int pos = idx >> 4, i = idx & 15;
      float fr = powf(10000.f, -(float)i / 16.f);
      float a = (float)pos * fr;
      rope[idx] = cosf(a);
      rope[1024 + idx] = sinf(a);
    } else {
      int j = idx - 1024;
      int pos = j >> 3, i = j & 7;
      float fr = powf(10000.f, -(float)i / 8.f);
      float a = (float)pos * fr;
      rope[2048 + j] = cosf(a);
      rope[2560 + j] = sinf(a);
    }
  }
  float* smf = (float*)sm;
  float* modp = (float*)(p.ws + WS_MODP);
  for (int it = blockIdx.x; it < 768; it += gridDim.x) {
    int l = it / 384, rem = it % 384, cgp = rem >> 3, ks = rem & 7;
    int col = cgp * 64 + (tid & 63), kq = tid >> 6;
    const float* w = p.in[10] + (long)l * 1024 * 3072 + col;
    float a0 = 0.f, a1 = 0.f, a2 = 0.f;
    int k0 = ks * 128 + kq * 32;
#pragma unroll 8
    for (int k = k0; k < k0 + 32; k++) {
      float wv = w[(long)k * 3072];
      a0 += siluf(p.in[9][k]) * wv;
      a1 += siluf(p.in[8][k]) * wv;
      a2 += siluf(p.in[8][1024 + k]) * wv;
    }
    smf[(kq * 3 + 0) * 64 + (tid & 63)] = a0;
    smf[(kq * 3 + 1) * 64 + (tid & 63)] = a1;
    smf[(kq * 3 + 2) * 64 + (tid & 63)] = a2;
    __syncthreads();
    if (tid < 192) {
      int c = tid >> 6, cc = tid & 63;
      float s = smf[(0 * 3 + c) * 64 + cc] + smf[(1 * 3 + c) * 64 + cc] + smf[(2 * 3 + c) * 64 + cc] + smf[(3 * 3 + c) * 64 + cc];
      modp[((ks * 2 + l) * 3 + c) * 3072 + cgp * 64 + cc] = s;
    }
    __syncthreads();
  }
}

__device__ __forceinline__ void phase_s1(const Params& p) {
  float* modp = (float*)(p.ws + WS_MODP);
  float* mod = (float*)(p.ws + WS_MOD);
  for (int idx = blockIdx.x * 256 + TIDX; idx < 2 * 3 * 3072; idx += gridDim.x * 256) {
    int l = idx / 9216, n = idx % 3072;
    float s = p.in[11][l * 3072 + n];
#pragma unroll
    for (int ks = 0; ks < 8; ks++) s += modp[ks * 18432 + idx];
    mod[idx] = s;
  }
}

__device__ __forceinline__ void wconv_tile(const float* __restrict__ src, int K, int N, bfr* __restrict__ dst,
                                           int tk, int tn, float* smf) {
  const int tid = TIDX;
  const int n = tid & 63, kb = tid >> 6;
#pragma unroll
  for (int i = 0; i < 16; i++) {
    int k = kb + 4 * i;
    smf[k * 65 + n] = src[(long)(tk * 64 + k) * N + tn * 64 + n];
  }
  __syncthreads();
#pragma unroll
  for (int i = 0; i < 16; i++) {
    int idx = tid + 256 * i;
    int nn = idx >> 6, k = idx & 63;
    dst[(long)(tn * 64 + nn) * K + tk * 64 + k] = f2bf(smf[k * 65 + nn]);
  }
  __syncthreads();
}

#define WCONV_ITEMS 2456
__device__ __forceinline__ void wconv_phase(const Params& p, int l, bfr* sm) {
  float* smf = (float*)sm;
  for (int item0 = blockIdx.x; item0 < WCONV_ITEMS; item0 += gridDim.x) {
    int item = item0;
    const float* src;
    bfr* dst;
    int K, N, tk, tn;
    if (item < 1744) {
      src = p.in[14] + (long)l * 1024 * 6976; K = 1024; N = 6976; dst = (bfr*)(p.ws + WS_WIN); tk = item & 15; tn = item >> 4;
    } else if (item < 1768) {
      item -= 1744;
      src = p.in[24] + (long)l * 256 * 384; K = 256; N = 384; dst = (bfr*)(p.ws + WS_WUQ); tk = item & 3; tn = item >> 2;
    } else if (item < 1816) {
      item -= 1768;
      src = p.in[25] + (long)l * 256 * 768; K = 256; N = 768; dst = (bfr*)(p.ws + WS_WUKV); tk = item & 3; tn = item >> 2;
    } else if (item < 2200) {
      item -= 1816;
      int w = item >> 7, it = item & 127;
      src = (w == 0 ? p.in[26] : (w == 1 ? p.in[27] : p.in[28])) + (long)l * 512 * 1024;
      K = 512; N = 1024; dst = (bfr*)(p.ws + WS_WOA + (unsigned long)w * 1048576ul); tk = it & 7; tn = it >> 3;
    } else {
      item -= 2200;
      src = p.in[29] + (long)l * 1024 * 1024; K = 1024; N = 1024; dst = (bfr*)(p.ws + WS_WOUT); tk = item & 15; tn = item >> 4;
    }
    wconv_tile(src, K, N, dst, tk, tn, smf);
  }
}

__device__ __forceinline__ void phase_prenorm0(const Params& p) {
  const int lane = TIDX & 63;
  const float* mod = (const float*)(p.ws + WS_MOD);
  bfr* H = (bfr*)(p.ws + WS_R1);
  for (int row = blockIdx.x * 4 + (TIDX >> 6); row < NROWS; row += gridDim.x * 4) {
    const float* x = xrow(p, row);
    const float* md = mod + (0 * 3 + row_cond(row)) * 3072;
    float4 v[4];
    float ss = 0.f;
#pragma unroll
    for (int i = 0; i < 4; i++) {
      v[i] = *(const float4*)(x + i * 256 + lane * 4);
      ss += v[i].x * v[i].x + v[i].y * v[i].y + v[i].z * v[i].z + v[i].w * v[i].w;
    }
    ss = wave_sum(ss);
    float rs = rsqrtf(ss * (1.f / 1024.f) + 1e-6f);
#pragma unroll
    for (int i = 0; i < 4; i++) {
      int n = i * 256 + lane * 4;
      float4 g = *(const float4*)(p.in[12] + n);
      float4 sh = *(const float4*)(md + n);
      float4 sc = *(const float4*)(md + 1024 + n);
      float h0 = v[i].x * rs * g.x * (1.f + sc.x) + sh.x;
      float h1 = v[i].y * rs * g.y * (1.f + sc.y) + sh.y;
      float h2 = v[i].z * rs * g.z * (1.f + sc.z) + sh.z;
      float h3 = v[i].w * rs * g.w * (1.f + sc.w) + sh.w;
      u32x2 o;
      o.x = pack2(h0, h1);
      o.y = pack2(h2, h3);
      *(u32x2*)(H + (long)row * 1024 + n) = o;
    }
  }
}

__device__ __forceinline__ unsigned xcc_id() { return (unsigned)__builtin_amdgcn_s_getreg((3 << 11) | 20) & 7u; }
template <class CountF>
__device__ __forceinline__ int xq_take(unsigned* ctr, int& q, int& tried, unsigned first, CountF cnt) {
  unsigned j = first;
  for (;;) {
    if (j < (unsigned)cnt(q)) return (q << 20) | (int)j;
    q = (q + 1) & 7;
    if (++tried >= 8) return -1;
    j = atomicAdd(ctr + q * 16, 1u);
  }
}

__device__ __forceinline__ void phase_inproj(const Params& p, int l, bfr* sm, int* s_item, int slot) {
  const bfr* H = (const bfr*)(p.ws + WS_R1);
  const bfr* W = (const bfr*)(p.ws + WS_WIN);
  bfr* Z = (bfr*)(p.ws + WS_Z);
  const int tid = TIDX;
  const int lane = tid & 63, wid = tid >> 6, wr = wid >> 1, wc = wid & 1;
  unsigned* ctr = (unsigned*)(p.ws + WS_CTR) + slot * 128;
  auto cnt = [](int q) { return 96 * ((28 * (q + 1)) / 8 - (28 * q) / 8); };
  int q = (int)xcc_id(), tried = 0;
  unsigned nxt = 0;
  if (tid == 0) nxt = atomicAdd(ctr + q * 16, 1u);
  for (;;) {
    if (tid == 0) *s_item = xq_take(ctr, q, tried, nxt, cnt);
    __syncthreads();
    const int it = *s_item;
    __syncthreads();
    if (it < 0) break;
    const int qq = it >> 20, j = it & 0xfffff;
    if (tid == 0) nxt = atomicAdd(ctr + q * 16, 1u);
    const int tn0 = (28 * qq) / 8, w = (28 * (qq + 1)) / 8 - tn0;
    const int tm = j / w, tn = tn0 + j % w;
    f32x4 acc[8][4];
#pragma unroll
    for (int a = 0; a < 8; a++)
#pragma unroll
      for (int b = 0; b < 4; b++) acc[a][b] = (f32x4){0.f, 0.f, 0.f, 0.f};
#ifdef PROBE_GMODE
    { int mode = (slot >= 6) ? PROBE_GMODE : 0; asm volatile("" : "+s"(mode));
      gemm256x128(W + (long)tn * 256 * 1024, 1024, ZLD - tn * 256, H + (long)tm * 128 * 1024, 1024, 1024, acc, sm, mode); }
#else
    gemm256x128(W + (long)tn * 256 * 1024, 1024, ZLD - tn * 256, H + (long)tm * 128 * 1024, 1024, 1024, acc, sm);
#endif
    {
      const int g = lane >> 4, l15 = lane & 15;
#pragma unroll
      for (int pi = 0; pi < 8; pi++)
#pragma unroll
        for (int qi = 0; qi < 4; qi++) {
          u32x2 o;
          o.x = pack2(acc[pi][qi][0], acc[pi][qi][1]);
          o.y = pack2(acc[pi][qi][2], acc[pi][qi][3]);
          *(u32x2*)(sm + (wc * 64 + qi * 16 + l15) * 264 + wr * 128 + pi * 16 + g * 4) = o;
        }
      __syncthreads();
      const int ncol = min(32, (ZLD - tn * 256) >> 3);
#pragma unroll
      for (int i = 0; i < 16; i++) {
        int c = tid + 256 * i;
        int row = c >> 5, c16 = c & 31;
        if (c16 < ncol)
          *(u32x4*)(Z + (long)(tm * 128 + row) * ZLD + tn * 256 + c16 * 8) = *(const u32x4*)(sm + row * 264 + c16 * 8);
      }
      __syncthreads();
    }
  }
}

__device__ __forceinline__ void unpack8(u32x4 v, float* x) {
  x[0] = lo16(v.x); x[1] = hi16(v.x); x[2] = lo16(v.y); x[3] = hi16(v.y);
  x[4] = lo16(v.z); x[5] = hi16(v.z); x[6] = lo16(v.w); x[7] = hi16(v.w);
}
__device__ __forceinline__ u32x4 pack8(const float* y) {
  u32x4 o;
  o.x = pack2(y[0], y[1]); o.y = pack2(y[2], y[3]); o.z = pack2(y[4], y[5]); o.w = pack2(y[6], y[7]);
  return o;
}

__device__ __forceinline__ void phase_rowpost(const Params& p, int l) {
  const int lane = TIDX & 63;
  bfr* Z = (bfr*)(p.ws + WS_Z);
  const float* rope = (const float*)(p.ws + WS_ROPE);
  bfr* VTA = (bfr*)(p.ws + WS_VTA);
  bfr* KCA = (bfr*)(p.ws + WS_KCA);
  bfr* CKVC = (bfr*)(p.ws + WS_CKVC);
  bfr* KRC = (bfr*)(p.ws + WS_KRC);
  float* out = p.out;
  for (int row = blockIdx.x * 4 + (TIDX >> 6); row < NROWS + 1024; row += gridDim.x * 4) {
    if (row < NROWS) {
      const bool lat = row >= NCTX;
      const int bc = row >> 8, tc = row & 255;
      const int bl = (row - NCTX) >> 12, tl = (row - NCTX) & 4095;
      const int prow = tl >> 6, pcol = tl & 63;
      bfr* z = Z + (long)row * ZLD;
      {
        float x[8];
        unpack8(*(const u32x4*)(z + C_QA + lane * 8), x);
        float ss = 0.f;
#pragma unroll
        for (int e = 0; e < 8; e++) ss += x[e] * x[e];
        ss += __shfl_xor(ss, 1); ss += __shfl_xor(ss, 2); ss += __shfl_xor(ss, 4);
        float rs = rsqrtf(ss * (1.f / 64.f) + 1e-6f);
        int sub = lane & 7;
        const float* g = p.in[15] + l * 64 + sub * 8;
#pragma unroll
        for (int e = 0; e < 8; e++) x[e] = x[e] * rs * g[e];
        if (lat) {
          int pos = (sub >> 2) ? pcol : prow;
          bool hi = (sub & 2) != 0;
          int i0 = (sub & 1) * 8;
#pragma unroll
          for (int e = 0; e < 8; e++) {
            float yp = __shfl_xor(x[e], 2);
            float c = rope[pos * 16 + i0 + e], s = rope[1024 + pos * 16 + i0 + e];
            x[e] = hi ? (yp * s + x[e] * c) : (x[e] * c - yp * s);
          }
        }
        const float qs = 0.125f * 1.4426950408889634f;
#pragma unroll
        for (int e = 0; e < 8; e++) x[e] *= qs;
        *(u32x4*)(z + C_QA + lane * 8) = pack8(x);
      }
      {
        int L = lane & 15;
        float x[8];
        unpack8(*(const u32x4*)(z + C_KA + L * 8), x);
        float ss = 0.f;
#pragma unroll
        for (int e = 0; e < 8; e++) ss += x[e] * x[e];
        ss += __shfl_xor(ss, 1); ss += __shfl_xor(ss, 2); ss += __shfl_xor(ss, 4);
        float rs = rsqrtf(ss * (1.f / 64.f) + 1e-6f);
        int sub = L & 7;
        const float* g = p.in[16] + l * 64 + sub * 8;
#pragma unroll
        for (int e = 0; e < 8; e++) x[e] = x[e] * rs * g[e];
        if (lat) {
          int pos = (sub >> 2) ? pcol : prow;
          bool hi = (sub & 2) != 0;
          int i0 = (sub & 1) * 8;
#pragma unroll
          for (int e = 0; e < 8; e++) {
            float yp = __shfl_xor(x[e], 2);
            float c = rope[pos * 16 + i0 + e], s = rope[1024 + pos * 16 + i0 + e];
            x[e] = hi ? (yp * s + x[e] * c) : (x[e] * c - yp * s);
          }
        } else if (lane < 16) {
          float* o = out + O_GK + ((long)(bc * 2 + l) * 256 + tc) * 128 + L * 8;
          *(float4*)(o) = make_float4(x[0], x[1], x[2], x[3]);
          *(float4*)(o + 4) = make_float4(x[4], x[5], x[6], x[7]);
        }
        if (lane < 16) *(u32x4*)(z + C_KA + L * 8) = pack8(x);
      }
      if (lane < 16) {
        int L = lane;
        u32x4 raw = *(const u32x4*)(z + C_VA + L * 8);
        float x[8];
        unpack8(raw, x);
        if (!lat) {
          float* o = out + O_GV + ((long)(bc * 2 + l) * 256 + tc) * 128 + L * 8;
          *(float4*)(o) = make_float4(x[0], x[1], x[2], x[3]);
          *(float4*)(o + 4) = make_float4(x[4], x[5], x[6], x[7]);
        }
        int g = L >> 3, d0 = (L & 7) * 8;
        long base; int nk, key;
        if (!lat) { base = (long)bc * 32768; nk = 256; key = tc; }
        else { base = 16l * 32768 + (long)bl * (2 * 64 * 4608); nk = 4608; key = 512 + tl; }
        const bfr* rb = (const bfr*)&raw;
#pragma unroll
        for (int e = 0; e < 8; e++) VTA[base + (long)(g * 64 + d0 + e) * nk + key] = rb[e];
      }
      {
        u32x2 rq = *(const u32x2*)(z + C_QL + lane * 4);
        u32x2 rk = *(const u32x2*)(z + C_KV + lane * 4);
        float q[4] = {lo16(rq.x), hi16(rq.x), lo16(rq.y), hi16(rq.y)};
        float k[4] = {lo16(rk.x), hi16(rk.x), lo16(rk.y), hi16(rk.y)};
        float sq = q[0] * q[0] + q[1] * q[1] + q[2] * q[2] + q[3] * q[3];
        float sk = k[0] * k[0] + k[1] * k[1] + k[2] * k[2] + k[3] * k[3];
        sq = wave_sum(sq);
        sk = wave_sum(sk);
        float rq_ = rsqrtf(sq * (1.f / 256.f) + 1e-6f), rk_ = rsqrtf(sk * (1.f / 256.f) + 1e-6f);
        float4 gq = *(const float4*)(p.in[22] + l * 256 + lane * 4);
        float4 gk = *(const float4*)(p.in[23] + l * 256 + lane * 4);
        q[0] *= rq_ * gq.x; q[1] *= rq_ * gq.y; q[2] *= rq_ * gq.z; q[3] *= rq_ * gq.w;
        k[0] *= rk_ * gk.x; k[1] *= rk_ * gk.y; k[2] *= rk_ * gk.z; k[3] *= rk_ * gk.w;
        u32x2 o;
        o.x = pack2(q[0], q[1]); o.y = pack2(q[2], q[3]);
        *(u32x2*)(z + C_QL + lane * 4) = o;
        o.x = pack2(k[0], k[1]); o.y = pack2(k[2], k[3]);
        *(u32x2*)(z + C_KV + lane * 4) = o;
        if (!lat) *(float4*)(out + O_CKV + ((long)(bc * 2 + l) * 256 + tc) * 256 + lane * 4) = make_float4(k[0], k[1], k[2], k[3]);
      }
      {
        int L = lane & 3;
        float x[8];
        unpack8(*(const u32x4*)(z + C_KR + L * 8), x);
        if (lat) {
          int pos = (L >> 1) ? pcol : prow;
          bool hi = (L & 1) != 0;
#pragma unroll
          for (int e = 0; e < 8; e++) {
            float yp = __shfl_xor(x[e], 1);
            float c = rope[2048 + pos * 8 + e], s = rope[2560 + pos * 8 + e];
            x[e] = hi ? (yp * s + x[e] * c) : (x[e] * c - yp * s);
          }
          if (lane < 4) *(u32x4*)(z + C_KR + L * 8) = pack8(x);
        } else if (lane < 4) {
          float* o = out + O_KR + ((long)(bc * 2 + l) * 256 + tc) * 32 + L * 8;
          *(float4*)(o) = make_float4(x[0], x[1], x[2], x[3]);
          *(float4*)(o + 4) = make_float4(x[4], x[5], x[6], x[7]);
        }
      }
    } else {
      int cr = row - NROWS;
      int b = cr >> 9, t = cr & 511;
      long src = (long)(b * 2 + l) * 512 + t;
      {
        float2 kv = *(const float2*)(p.in[2] + src * 128 + lane * 2);
        *(unsigned*)(KCA + (long)(b * 512 + t) * 128 + lane * 2) = pack2(kv.x, kv.y);
        float2 vv = *(const float2*)(p.in[3] + src * 128 + lane * 2);
        int c0 = lane * 2;
        long base = 16l * 32768 + (long)b * (2 * 64 * 4608);
        VTA[base + (long)c0 * 4608 + t] = f2bf(vv.x);
        VTA[base + (long)(c0 + 1) * 4608 + t] = f2bf(vv.y);
        float4 cv = *(const float4*)(p.in[4] + src * 256 + lane * 4);
        u32x2 o;
        o.x = pack2(cv.x, cv.y); o.y = pack2(cv.z, cv.w);
        *(u32x2*)(CKVC + (long)(b * 512 + t) * 256 + lane * 4) = o;
        if (lane < 32) KRC[(long)(b * 512 + t) * 32 + lane] = f2bf(p.in[5][src * 32 + lane]);
      }
    }
  }
}

#define WS_PREP1 251703296ul
#define WS_EL (WS_WIN + 12582912ul)
__device__ __forceinline__ bfr* prep_base(const Params& p, int b, int h, int dir, int c) {
  return (bfr*)(p.ws + (b ? WS_PREP1 : WS_WIN)) + (long)((h * 2 + dir) * 64 + c) * 12288;
}

__device__ __forceinline__ void gla_chunk_prep(int tid, const float (&wd)[16], float bias, const bfr* Qr, const bfr* Kr,
                                               bfr* Qe, bfr* Ke, bfr* KlT, const float* RF, float* tot, float* lastv) {
  const int ch = tid & 63, part = tid >> 6;
  float cum[16];
  {
    float run = 0.f;
#pragma unroll
    for (int ii = 0; ii < 16; ii++) {
      int i = part * 16 + ii;
      float x = bias;
#pragma unroll
      for (int r = 0; r < 16; r++) x += RF[i * 16 + r] * wd[r];
      float la = (fminf(x, 0.f) - __logf(1.f + __expf(-fabsf(x)))) * (1.f / 16.f);
      run += la;
      cum[ii] = run;
    }
    tot[part * 64 + ch] = run;
  }
  __syncthreads();
  {
    float off = 0.f, last = 0.f;
#pragma unroll
    for (int pp = 0; pp < 4; pp++) {
      float tv = tot[pp * 64 + ch];
      if (pp < part) off += tv;
      last += tv;
    }
    if (part == 0) lastv[ch] = last;
#pragma unroll
    for (int ii = 0; ii < 16; ii++) {
      int i = part * 16 + ii;
      float cc = cum[ii] + off;
      float qv = bf2f(Qr[i * LDT + ch]), kv = bf2f(Kr[i * LDT + ch]);
      Qe[i * LDT + ch] = f2bf(qv * __expf(cc) * 0.125f);
      Ke[i * LDT + ch] = f2bf(kv * __expf(-cc));
      KlT[ch * LDT + i] = f2bf(kv * __expf(last - cc));
    }
  }
  __syncthreads();
}

__device__ __forceinline__ void gla_att(int wid, int g, int l15, const bfr* Qe, const bfr* Ke, bfr* Att) {
  f32x4 att[4];
  bf16x8 qa[2];
#pragma unroll
  for (int kk = 0; kk < 2; kk++) qa[kk] = *(const bf16x8*)(Qe + (16 * wid + l15) * LDT + kk * 32 + g * 8);
#pragma unroll
  for (int nj = 0; nj < 4; nj++) {
    att[nj] = (f32x4){0.f, 0.f, 0.f, 0.f};
#pragma unroll
    for (int kk = 0; kk < 2; kk++) {
      bf16x8 kb = *(const bf16x8*)(Ke + (16 * nj + l15) * LDT + kk * 32 + g * 8);
      att[nj] = mfma16(qa[kk], kb, att[nj]);
    }
  }
#pragma unroll
  for (int nj = 0; nj < 4; nj++)
#pragma unroll
    for (int r = 0; r < 4; r++) {
      int i = 16 * wid + 4 * g + r, j = 16 * nj + l15;
      Att[i * LDT + j] = f2bf(i >= j ? att[nj][r] : 0.f);
    }
}

__device__ __forceinline__ void gla_prep_item(const Params& p, int l, int b, int h, int dir, int c, bfr* sm) {
  const int tid = TIDX, lane = tid & 63, wid = tid >> 6, g = lane >> 4, l15 = lane & 15;
  const bfr* Z = (const bfr*)(p.ws + WS_Z);
  const int N = 4096;
  const int rowbase = NCTX + b * 4096;
  bfr* Qr = sm;
  bfr* Kr = Qr + 64 * LDT;
  bfr* Qe = Kr + 64 * LDT;
  bfr* Ke = Qe + 64 * LDT;
  bfr* KlT = Ke + 64 * LDT;
  float* RF = (float*)(KlT + 64 * LDT);
  float* tot = RF + 64 * 16;
  float* lastv = tot + 256;
  bfr* Att = Qr;
  const int ch = tid & 63;
  float wd[16];
  {
    const float* W = (dir ? p.in[19] : p.in[17]) + (long)l * 16 * 256 + h * 64 + ch;
#pragma unroll
    for (int r = 0; r < 16; r++) wd[r] = W[r * 256];
  }
  const float bias = (dir ? p.in[20] : p.in[18])[l * 256 + h * 64 + ch];
#pragma unroll
  for (int ii = 0; ii < 2; ii++) {
    int cc = tid + 256 * ii;
    int i = cc >> 3, c8 = cc & 7;
    int tok = dir ? (N - 1 - (c * 64 + i)) : (c * 64 + i);
    const bfr* zr = Z + (long)(rowbase + tok) * ZLD;
    *(u32x4*)(Qr + i * LDT + c8 * 8) = *(const u32x4*)(zr + C_QG + h * 64 + c8 * 8);
    *(u32x4*)(Kr + i * LDT + c8 * 8) = *(const u32x4*)(zr + C_KG + h * 64 + c8 * 8);
  }
  if (tid < 128) {
    int i = tid >> 1, hf = tid & 1;
    int tok = dir ? (N - 1 - (c * 64 + i)) : (c * 64 + i);
    u32x4 rr = *(const u32x4*)(Z + (long)(rowbase + tok) * ZLD + (dir ? C_RB : C_RF) + hf * 8);
    float x[8];
    unpack8(rr, x);
#pragma unroll
    for (int e = 0; e < 8; e++) RF[i * 16 + hf * 8 + e] = x[e];
  }
  __syncthreads();
  gla_chunk_prep(tid, wd, bias, Qr, Kr, Qe, Ke, KlT, RF, tot, lastv);
  gla_att(wid, g, l15, Qe, Ke, Att);
  __syncthreads();
  bfr* dst = prep_base(p, b, h, dir, c);
#pragma unroll
  for (int ii = 0; ii < 2; ii++) {
    int cc = tid + 256 * ii;
    int i = cc >> 3, c8 = cc & 7;
    *(u32x4*)(dst + i * 64 + c8 * 8) = *(const u32x4*)(Qe + i * LDT + c8 * 8);
    *(u32x4*)(dst + 4096 + i * 64 + c8 * 8) = *(const u32x4*)(KlT + i * LDT + c8 * 8);
    *(u32x4*)(dst + 8192 + i * 64 + c8 * 8) = *(const u32x4*)(Att + i * LDT + c8 * 8);
  }
  if (tid < 64) ((float*)(p.ws + WS_EL))[((long)(((b * 4 + h) * 2 + dir) * 64 + c)) * 64 + tid] = __expf(lastv[tid]);
  __syncthreads();
}

__device__ __forceinline__ void gla_chain_item(const Params& p, int l, int b, int h, int dir, int vh, bfr* sm) {
  const int tid = TIDX, lane = tid & 63, wid = tid >> 6, g = lane >> 4, l15 = lane & 15;
  const bfr* Z = (const bfr*)(p.ws + WS_Z);
  bfr* OG = (bfr*)(p.ws + WS_R1) + (long)dir * NROWS * 512;
  const float* EL = (const float*)(p.ws + WS_EL) + (long)(((b * 4 + h) * 2 + dir) * 64) * 64;
  const int N = 4096, nc = 64;
  const int rowbase = NCTX + b * 4096;
  const int vs0 = vh * 64;
  bfr* Vt = sm;
  bfr* St = Vt + 64 * LDT;
  f32x4 st[4];
  {
    const float* S0 = (dir ? p.in[7] : p.in[6]) + ((long)((b * 2 + l) * 4 + h)) * 8192 + (long)(16 * wid + l15) * 128 + vs0;
#pragma unroll
    for (int vt = 0; vt < 4; vt++) {
      float4 a = *(const float4*)(S0 + 16 * vt + 4 * g);
      st[vt] = (f32x4){a.x, a.y, a.z, a.w};
#pragma unroll
      for (int r = 0; r < 4; r++) St[(16 * vt + 4 * g + r) * LDT + 16 * wid + l15] = f2bf(st[vt][r]);
    }
  }
  u32x4 n_qe[2], n_kl[2], n_at[2], n_v[2];
  float n_el;
  auto prefetch = [&](int c) {
    const bfr* base = prep_base(p, b, h, dir, c) + (16 * wid + l15) * 64 + 8 * g;
#pragma unroll
    for (int kk = 0; kk < 2; kk++) {
      n_qe[kk] = *(const u32x4*)(base + kk * 32);
      n_kl[kk] = *(const u32x4*)(base + 4096 + kk * 32);
      n_at[kk] = *(const u32x4*)(base + 8192 + kk * 32);
    }
    n_el = EL[c * 64 + 16 * wid + l15];
#pragma unroll
    for (int ii = 0; ii < 2; ii++) {
      int cc = tid + 256 * ii;
      int i = cc >> 3, c8 = cc & 7;
      int tok = dir ? (N - 1 - (c * 64 + i)) : (c * 64 + i);
      n_v[ii] = *(const u32x4*)(Z + (long)(rowbase + tok) * ZLD + C_VG + h * 128 + vs0 + c8 * 8);
    }
  };
  prefetch(0);
  for (int c = 0; c < nc; c++) {
    u32x4 c_qe[2] = {n_qe[0], n_qe[1]}, c_kl[2] = {n_kl[0], n_kl[1]}, c_at[2] = {n_at[0], n_at[1]};
    const float el = n_el;
#pragma unroll
    for (int ii = 0; ii < 2; ii++) {
      int cc = tid + 256 * ii;
      int i = cc >> 3, c8 = cc & 7;
      const bfr* rb = (const bfr*)&n_v[ii];
#pragma unroll
      for (int e = 0; e < 8; e++) Vt[(c8 * 8 + e) * LDT + i] = rb[e];
    }
    __syncthreads();
    if (c + 1 < nc) prefetch(c + 1);
    f32x4 stn[4];
    const int i = 16 * wid + l15;
    const int tok = dir ? (N - 1 - (c * 64 + i)) : (c * 64 + i);
    bfr* og = OG + (long)(rowbase + tok) * 512 + h * 128 + vs0 + 4 * g;
#pragma unroll
    for (int vt = 0; vt < 4; vt++) {
      f32x4 oc = (f32x4){0.f, 0.f, 0.f, 0.f};
      stn[vt] = st[vt] * el;
#pragma unroll
      for (int kk = 0; kk < 2; kk++) {
        bf16x8 vf = *(const bf16x8*)(Vt + (16 * vt + l15) * LDT + kk * 32 + g * 8);
        bf16x8 sf = *(const bf16x8*)(St + (16 * vt + l15) * LDT + kk * 32 + g * 8);
        oc = mfma16(vf, *(bf16x8*)&c_at[kk], oc);
        oc = mfma16(sf, *(bf16x8*)&c_qe[kk], oc);
        stn[vt] = mfma16(vf, *(bf16x8*)&c_kl[kk], stn[vt]);
      }
      u32x2 ov;
      ov.x = pack2(oc[0], oc[1]);
      ov.y = pack2(oc[2], oc[3]);
      *(u32x2*)(og + 16 * vt) = ov;
    }
    __syncthreads();
#pragma unroll
    for (int vt = 0; vt < 4; vt++) {
      st[vt] = stn[vt];
#pragma unroll
      for (int r = 0; r < 4; r++) St[(16 * vt + 4 * g + r) * LDT + 16 * wid + l15] = f2bf(st[vt][r]);
    }
  }
  __syncthreads();
}

template <int VS>
__device__ __forceinline__ void gla_item(const Params& p, int l, int seq, int h, int dir, int vsl, bfr* sm) {
  constexpr int NVT = VS / 16;
  constexpr int NVL = VS / 32;
  const int tid = TIDX, lane = tid & 63, wid = tid >> 6, g = lane >> 4, l15 = lane & 15;
  bfr* Z = (bfr*)(p.ws + WS_Z);
  bfr* OG = (bfr*)(p.ws + WS_R1) + (long)dir * NROWS * 512;
  const bool lat = seq >= 16;
  const int b = seq - 16;
  const int N = lat ? 4096 : 256;
  const int rowbase = lat ? NCTX + b * 4096 : seq * 256;
  const int nc = N >> 6;
  const int vs0 = vsl * VS;
  bfr* Qr = sm;
  bfr* Kr = Qr + 64 * LDT;
  bfr* Qe = Kr + 64 * LDT;
  bfr* Ke = Qe + 64 * LDT;
  bfr* KlT = Ke + 64 * LDT;
  float* RF = (float*)(KlT + 64 * LDT);
  float* tot = RF + 64 * 16;
  float* lastv = tot + 256;
  bfr* Vt = (bfr*)(lastv + 64);
  bfr* St = Vt + VS * LDT;
  bfr* Att = Qr;
  const int ch = tid & 63;
  float wd[16];
  {
    const float* W = (dir ? p.in[19] : p.in[17]) + (long)l * 16 * 256 + h * 64 + ch;
#pragma unroll
    for (int r = 0; r < 16; r++) wd[r] = W[r * 256];
  }
  const float bias = (dir ? p.in[20] : p.in[18])[l * 256 + h * 64 + ch];

  f32x4 st[NVT];
  {
    const float* S0 = (dir ? p.in[7] : p.in[6]) + ((long)((b * 2 + l) * 4 + h)) * 8192 + (long)(16 * wid + l15) * 128 + vs0;
#pragma unroll
    for (int mv = 0; mv < NVT; mv++) {
      if (lat) {
        float4 a = *(const float4*)(S0 + 16 * mv + 4 * g);
        st[mv] = (f32x4){a.x, a.y, a.z, a.w};
      } else {
        st[mv] = (f32x4){0.f, 0.f, 0.f, 0.f};
      }
#pragma unroll
      for (int r = 0; r < 4; r++) St[(16 * mv + 4 * g + r) * LDT + 16 * wid + l15] = f2bf(st[mv][r]);
    }
  }
  u32x4 rq[2], rk[2], rv[NVL], rr;
  auto prefetch = [&](int c) {
#pragma unroll
    for (int ii = 0; ii < 2; ii++) {
      int cc = tid + 256 * ii;
      int i = cc >> 3, c8 = cc & 7;
      int tok = dir ? (N - 1 - (c * 64 + i)) : (c * 64 + i);
      const bfr* zr = Z + (long)(rowbase + tok) * ZLD;
      rq[ii] = *(const u32x4*)(zr + C_QG + h * 64 + c8 * 8);
      rk[ii] = *(const u32x4*)(zr + C_KG + h * 64 + c8 * 8);
    }
#pragma unroll
    for (int ii = 0; ii < NVL; ii++) {
      int cc = tid + 256 * ii;
      int i = cc / (VS / 8), c4 = cc % (VS / 8);
      int tok = dir ? (N - 1 - (c * 64 + i)) : (c * 64 + i);
      rv[ii] = *(const u32x4*)(Z + (long)(rowbase + tok) * ZLD + C_VG + h * 128 + vs0 + c4 * 8);
    }
    if (tid < 128) {
      int i = tid >> 1, hf = tid & 1;
      int tok = dir ? (N - 1 - (c * 64 + i)) : (c * 64 + i);
      rr = *(const u32x4*)(Z + (long)(rowbase + tok) * ZLD + (dir ? C_RB : C_RF) + hf * 8);
    }
  };
  prefetch(0);
  for (int c = 0; c < nc; c++) {
#pragma unroll
    for (int ii = 0; ii < 2; ii++) {
      int cc = tid + 256 * ii;
      *(u32x4*)(Qr + (cc >> 3) * LDT + (cc & 7) * 8) = rq[ii];
      *(u32x4*)(Kr + (cc >> 3) * LDT + (cc & 7) * 8) = rk[ii];
    }
#pragma unroll
    for (int ii = 0; ii < NVL; ii++) {
      int cc = tid + 256 * ii;
      int i = cc / (VS / 8), c4 = cc % (VS / 8);
      const bfr* rb = (const bfr*)&rv[ii];
#pragma unroll
      for (int e = 0; e < 8; e++) Vt[(c4 * 8 + e) * LDT + i] = rb[e];
    }
    if (tid < 128) {
      int i = tid >> 1, hf = tid & 1;
      float x[8];
      unpack8(rr, x);
#pragma unroll
      for (int e = 0; e < 8; e++) RF[i * 16 + hf * 8 + e] = x[e];
    }
    __syncthreads();
    if (c + 1 < nc) prefetch(c + 1);
    gla_chunk_prep(tid, wd, bias, Qr, Kr, Qe, Ke, KlT, RF, tot, lastv);
    f32x4 stn[NVT];
    {
      float el = __expf(lastv[16 * wid + l15]);
#pragma unroll
      for (int mv = 0; mv < NVT; mv++) {
        stn[mv] = st[mv] * el;
#pragma unroll
        for (int kk = 0; kk < 2; kk++) {
          bf16x8 va = *(const bf16x8*)(Vt + (16 * mv + l15) * LDT + kk * 32 + g * 8);
          bf16x8 kb = *(const bf16x8*)(KlT + (16 * wid + l15) * LDT + kk * 32 + g * 8);
          stn[mv] = mfma16(va, kb, stn[mv]);
        }
      }
      gla_att(wid, g, l15, Qe, Ke, Att);
    }
    __syncthreads();
    {
      bf16x8 aa[2], qa[2];
#pragma unroll
      for (int kk = 0; kk < 2; kk++) {
        aa[kk] = *(const bf16x8*)(Att + (16 * wid + l15) * LDT + kk * 32 + g * 8);
        qa[kk] = *(const bf16x8*)(Qe + (16 * wid + l15) * LDT + kk * 32 + g * 8);
      }
#pragma unroll
      for (int nv = 0; nv < NVT; nv++) {
        f32x4 oc = (f32x4){0.f, 0.f, 0.f, 0.f};
#pragma unroll
        for (int kk = 0; kk < 2; kk++) {
          bf16x8 vb = *(const bf16x8*)(Vt + (16 * nv + l15) * LDT + kk * 32 + g * 8);
          oc = mfma16(aa[kk], vb, oc);
          bf16x8 sb = *(const bf16x8*)(St + (16 * nv + l15) * LDT + kk * 32 + g * 8);
          oc = mfma16(qa[kk], sb, oc);
        }
#pragma unroll
        for (int r = 0; r < 4; r++) {
          int i = 16 * wid + 4 * g + r;
          int tok = dir ? (N - 1 - (c * 64 + i)) : (c * 64 + i);
          OG[(long)(rowbase + tok) * 512 + h * 128 + vs0 + 16 * nv + l15] = f2bf(oc[r]);
        }
      }
    }
    __syncthreads();
#pragma unroll
    for (int mv = 0; mv < NVT; mv++) {
      st[mv] = stn[mv];
#pragma unroll
      for (int r = 0; r < 4; r++) St[(16 * mv + 4 * g + r) * LDT + 16 * wid + l15] = f2bf(st[mv][r]);
    }
  }
  __syncthreads();
  if (!lat) {
    float* so = p.out + (dir ? O_SB : O_SF) + ((long)((seq * 2 + l) * 4 + h)) * 8192 + (long)(16 * wid + l15) * 128 + vs0;
#pragma unroll
    for (int mv = 0; mv < NVT; mv++)
      *(float4*)(so + 16 * mv + 4 * g) = make_float4(st[mv][0], st[mv][1], st[mv][2], st[mv][3]);
  }
}

__device__ __forceinline__ void phase_mla_up(const Params& p, int l, bfr* sm) {
  bfr* Z = (bfr*)(p.ws + WS_Z);
  const float* rope = (const float*)(p.ws + WS_ROPE);
  const int lane = TIDX & 63, wid = TIDX >> 6, wr = wid >> 1, wc = wid & 1;
  const int g = lane >> 4;
  for (int t = blockIdx.x; t < 288 + 624 + 1024; t += gridDim.x) {
    if (t >= 912) {
      int i = t - 912;
      gla_prep_item(p, l, i >> 9, (i >> 7) & 3, (i >> 6) & 1, i & 63, sm);
      continue;
    }
    f32x4 acc[4][4];
#pragma unroll
    for (int a = 0; a < 4; a++)
#pragma unroll
      for (int b = 0; b < 4; b++) acc[a][b] = (f32x4){0.f, 0.f, 0.f, 0.f};
    if (t < 288) {
      int tn = t % 3, tm = t / 3;
      gemm128((const bfr*)(p.ws + WS_WUQ) + (long)tn * 128 * 256, 256, 128, Z + (long)tm * 128 * ZLD + C_QL, ZLD, 128, 256,
              acc, sm);
      bfr* CQ = (bfr*)(p.ws + WS_CQ);
      const float qs = 0.10206207261596577f * 1.4426950408889634f;
#pragma unroll
      for (int pi = 0; pi < 4; pi++) {
        int nb = tn * 128 + wr * 64 + pi * 16;
        int wb = nb % 96;
        bool ropet = wb >= 64;
        int part = (wb - 64) >> 4;
#pragma unroll
        for (int qi = 0; qi < 4; qi++) {
          int tok = tm * 128 + wc * 64 + qi * 16 + (lane & 15);
          float y[4] = {acc[pi][qi][0], acc[pi][qi][1], acc[pi][qi][2], acc[pi][qi][3]};
          if (ropet) {
            bool lat = tok >= NCTX;
            int tl = (tok - NCTX) & 4095;
            int pos = part ? (tl & 63) : (tl >> 6);
            bool hi = (g & 2) != 0;
            int i0 = (g & 1) * 4;
#pragma unroll
            for (int r = 0; r < 4; r++) {
              float yp = __shfl_xor(y[r], 32);
              float c = rope[2048 + pos * 8 + i0 + r], s = rope[2560 + pos * 8 + i0 + r];
              float yr = hi ? (yp * s + y[r] * c) : (y[r] * c - yp * s);
              y[r] = lat ? yr : y[r];
            }
          }
          u32x2 o;
          o.x = pack2(y[0] * qs, y[1] * qs);
          o.y = pack2(y[2] * qs, y[3] * qs);
          *(u32x2*)(CQ + (long)tok * 384 + nb + g * 4) = o;
        }
      }
    } else {
      int t2 = t - 288;
      int tn = t2 % 6, tm = t2 / 6;
      const bfr* Q;
      long ldq;
      long kbase, vbase;
      int nk, key0;
      if (tm < 32) {
        Q = Z + (long)tm * 128 * ZLD + C_KV;
        ldq = ZLD;
        int s = tm >> 1;
        key0 = (tm & 1) * 128;
        nk = 256;
        kbase = (long)s * (4 * 256 * 64);
        vbase = (long)s * 131072;
      } else {
        int r = (tm - 32) * 128;
        int b = r / 4608, within = r % 4608;
        key0 = within;
        nk = 4608;
        kbase = 16l * (4 * 256 * 64) + (long)b * (4 * 4608 * 64);
        vbase = 16l * 131072 + (long)b * (4 * 128 * 4608);
        if (within < 512) {
          Q = (const bfr*)(p.ws + WS_CKVC) + (long)(b * 512 + within) * 256;
          ldq = 256;
        } else {
          Q = Z + (long)(NCTX + b * 4096 + within - 512) * ZLD + C_KV;
          ldq = ZLD;
        }
      }
      gemm128((const bfr*)(p.ws + WS_WUKV) + (long)tn * 128 * 256, 256, 128, Q, ldq, 128, 256, acc, sm);
      bfr* KN = (bfr*)(p.ws + WS_KNOPE);
      bfr* VTC = (bfr*)(p.ws + WS_VTC);
#pragma unroll
      for (int pi = 0; pi < 4; pi++) {
        int n0 = tn * 128 + wr * 64 + pi * 16 + g * 4;
        int head = n0 / 192, w = n0 % 192;
#pragma unroll
        for (int qi = 0; qi < 4; qi++) {
          int key = key0 + wc * 64 + qi * 16 + (lane & 15);
          if (w < 64) {
            u32x2 o;
            o.x = pack2(acc[pi][qi][0], acc[pi][qi][1]);
            o.y = pack2(acc[pi][qi][2], acc[pi][qi][3]);
            *(u32x2*)(KN + kbase + ((long)head * nk + key) * 64 + w) = o;
          } else {
#pragma unroll
            for (int r = 0; r < 4; r++)
              VTC[vbase + ((long)head * 128 + (w - 64) + r) * nk + key] = f2bf(acc[pi][qi][r]);
          }
        }
      }
    }
  }
}

template <int DQ, int DV, bool MLA>
__device__ __forceinline__ void attn_item(const Params& p, int seq, int head, int qblk, bfr* sm, int dry) {
  constexpr int KLD = DQ + 8;
  constexpr int KSZ = 64 * KLD;
  constexpr int VSZ = DV * LDT;
  constexpr int BUF = KSZ + VSZ;
  constexpr int NKK = DQ / 32;
  constexpr int NDV = DV / 16;
  constexpr int NVL = DV / 32;
  const int tid = TIDX, lane = tid & 63, wid = tid >> 6, g = lane >> 4, l15 = lane & 15;
  bfr* Z = (bfr*)(p.ws + WS_Z);
  const bool lat = seq >= 16;
  const int b = seq - 16;
  const int nk = lat ? 4608 : 256;
  const int rowbase = lat ? NCTX + b * 4096 : seq * 256;
  const int nkt = nk >> 6;

  bf16x8 qf[2][NKK];
#pragma unroll
  for (int qb = 0; qb < 2; qb++) {
    int qrow = rowbase + qblk * 128 + wid * 32 + qb * 16 + l15;
    const bfr* qp = MLA ? ((const bfr*)(p.ws + WS_CQ) + (long)qrow * 384 + head * 96) : (Z + (long)qrow * ZLD + C_QA + head * 64);
#pragma unroll
    for (int kk = 0; kk < NKK; kk++) qf[qb][kk] = *(const bf16x8*)(qp + kk * 32 + g * 8);
  }

  u32x4 rk[2], rkr, rv[NVL];
  auto prefetch = [&](int kt) {
    int k0 = kt * 64;
    bool cache = lat && (k0 < 512);
    int tokrow0 = lat ? (NCTX + b * 4096 + k0 - 512) : (seq * 256 + k0);
    if (!MLA) {
      int kvh = head >> 2;
#pragma unroll
      for (int i = 0; i < 2; i++) {
        int c = tid + 256 * i;
        int kr_ = c >> 3, ch = c & 7;
        const bfr* src = cache ? ((const bfr*)(p.ws + WS_KCA) + (long)(b * 512 + k0 + kr_) * 128 + kvh * 64 + ch * 8)
                               : (Z + (long)(tokrow0 + kr_) * ZLD + C_KA + kvh * 64 + ch * 8);
        rk[i] = *(const u32x4*)src;
      }
      long vb = lat ? (16l * 32768 + (long)b * (2 * 64 * 4608)) : ((long)seq * 32768);
#pragma unroll
      for (int i = 0; i < NVL; i++) {
        int c = tid + 256 * i;
        int dv = c >> 3, ch = c & 7;
        rv[i] = *(const u32x4*)((const bfr*)(p.ws + WS_VTA) + vb + (long)(kvh * 64 + dv) * nk + k0 + ch * 8);
      }
    } else {
      long kb = lat ? (16l * (4 * 256 * 64) + (long)b * (4 * 4608 * 64)) : ((long)seq * (4 * 256 * 64));
#pragma unroll
      for (int i = 0; i < 2; i++) {
        int c = tid + 256 * i;
        int kr_ = c >> 3, ch = c & 7;
        rk[i] = *(const u32x4*)((const bfr*)(p.ws + WS_KNOPE) + kb + ((long)head * nk + k0 + kr_) * 64 + ch * 8);
      }
      {
        int kr_ = tid >> 2, ch = tid & 3;
        const bfr* src = cache ? ((const bfr*)(p.ws + WS_KRC) + (long)(b * 512 + k0 + kr_) * 32 + ch * 8)
                               : (Z + (long)(tokrow0 + kr_) * ZLD + C_KR + ch * 8);
        rkr = *(const u32x4*)src;
      }
      long vb = lat ? (16l * 131072 + (long)b * (4 * 128 * 4608)) : ((long)seq * 131072);
#pragma unroll
      for (int i = 0; i < NVL; i++) {
        int c = tid + 256 * i;
        int dv = c >> 3, ch = c & 7;
        rv[i] = *(const u32x4*)((const bfr*)(p.ws + WS_VTC) + vb + (long)(head * 128 + dv) * nk + k0 + ch * 8);
      }
    }
  };

  f32x4 o[2][NDV];
#pragma unroll
  for (int qb = 0; qb < 2; qb++)
#pragma unroll
    for (int d = 0; d < NDV; d++) o[qb][d] = (f32x4){0.f, 0.f, 0.f, 0.f};
  float mrun[2] = {0.f, 0.f};
  f32x4 lacc[2] = {(f32x4){0.f, 0.f, 0.f, 0.f}, (f32x4){0.f, 0.f, 0.f, 0.f}};
  const bf16x8 ones = (bf16x8){(short)0x3F80, (short)0x3F80, (short)0x3F80, (short)0x3F80, (short)0x3F80, (short)0x3F80, (short)0x3F80, (short)0x3F80};

  prefetch(0);
  for (int kt = 0; kt < nkt; kt++) {
    bfr* Ks = sm + (kt & 1) * BUF;
    bfr* Vs = Ks + KSZ;
#pragma unroll
    for (int i = 0; i < 2; i++) {
      int c = tid + 256 * i;
      *(u32x4*)(Ks + (c >> 3) * KLD + (c & 7) * 8) = rk[i];
    }
    if (MLA) *(u32x4*)(Ks + (tid >> 2) * KLD + 64 + (tid & 3) * 8) = rkr;
#pragma unroll
    for (int i = 0; i < NVL; i++) {
      int c = tid + 256 * i;
      *(u32x4*)(Vs + (c >> 3) * LDT + (c & 7) * 8) = rv[i];
    }
    __syncthreads();
    if (kt + 1 < nkt) prefetch(kt + 1);

    f32x4 s[2][4];
#pragma unroll
    for (int t = 0; t < 4; t++) {
      s[0][t] = (f32x4){-mrun[0], -mrun[0], -mrun[0], -mrun[0]};
      s[1][t] = (f32x4){-mrun[1], -mrun[1], -mrun[1], -mrun[1]};
      int krow = 32 * (t >> 1) + 8 * (l15 >> 2) + 4 * (t & 1) + (l15 & 3);
#pragma unroll
      for (int kk = 0; kk < NKK; kk++) {
        bf16x8 kf = *(const bf16x8*)(Ks + krow * KLD + kk * 32 + g * 8);
        s[0][t] = mfma16(kf, qf[0][kk], s[0][t]);
        s[1][t] = mfma16(kf, qf[1][kk], s[1][t]);
      }
    }
    bf16x8 pf[2][2];
#pragma unroll
    for (int qb = 0; qb < 2; qb++) {
      float mt = s[qb][0][0];
#pragma unroll
      for (int t = 0; t < 4; t++)
#pragma unroll
        for (int r = 0; r < 4; r++) mt = fmaxf(mt, s[qb][t][r]);
      mt = fmaxf(mt, __shfl_xor(mt, 16));
      mt = fmaxf(mt, __shfl_xor(mt, 32));
      const bool need = mt > 8.f;
      if (__builtin_amdgcn_ballot_w64(need) != 0ull) {
        const float dm = need ? mt : 0.f;
        const float alpha = __builtin_amdgcn_exp2f(-dm);
        mrun[qb] += dm;
        lacc[qb] *= alpha;
#pragma unroll
        for (int d = 0; d < NDV; d++) o[qb][d] *= alpha;
#pragma unroll
        for (int t = 0; t < 4; t++) s[qb][t] -= dm;
      }
#pragma unroll
      for (int t = 0; t < 4; t++)
#pragma unroll
        for (int r = 0; r < 4; r++) s[qb][t][r] = __builtin_amdgcn_exp2f(s[qb][t][r]);
#pragma unroll
      for (int sx = 0; sx < 2; sx++) {
        u32x4 u;
        u.x = pack2(s[qb][2 * sx][0], s[qb][2 * sx][1]);
        u.y = pack2(s[qb][2 * sx][2], s[qb][2 * sx][3]);
        u.z = pack2(s[qb][2 * sx + 1][0], s[qb][2 * sx + 1][1]);
        u.w = pack2(s[qb][2 * sx + 1][2], s[qb][2 * sx + 1][3]);
        pf[qb][sx] = *(bf16x8*)&u;
      }
    }
#pragma unroll
    for (int d = 0; d < NDV; d++) {
#pragma unroll
      for (int sx = 0; sx < 2; sx++) {
        bf16x8 vf = *(const bf16x8*)(Vs + (d * 16 + l15) * LDT + sx * 32 + g * 8);
        o[0][d] = mfma16(vf, pf[0][sx], o[0][d]);
        o[1][d] = mfma16(vf, pf[1][sx], o[1][d]);
      }
    }
#pragma unroll
    for (int sx = 0; sx < 2; sx++) {
      lacc[0] = mfma16(ones, pf[0][sx], lacc[0]);
      lacc[1] = mfma16(ones, pf[1][sx], lacc[1]);
    }
  }
  __syncthreads();
#pragma unroll
  for (int qb = 0; qb < 2; qb++) {
    float inv = 1.f / lacc[qb][0];
    int qrow = rowbase + qblk * 128 + wid * 32 + qb * 16 + l15;
    bfr* gp = Z + (long)qrow * ZLD + (MLA ? C_GC : C_GA) + head * DV + g * 4;
#pragma unroll
    for (int d = 0; d < NDV; d++) {
      u32x2 gr = *(const u32x2*)(gp + d * 16);
      float y0 = o[qb][d][0] * inv * siluf(lo16(gr.x));
      float y1 = o[qb][d][1] * inv * siluf(hi16(gr.x));
      float y2 = o[qb][d][2] * inv * siluf(lo16(gr.y));
      float y3 = o[qb][d][3] * inv * siluf(hi16(gr.y));
      u32x2 ov;
      ov.x = pack2(y0, y1);
      ov.y = pack2(y2, y3);
      if (!dry) *(u32x2*)(gp + d * 16) = ov;
    }
  }
}

__device__ __forceinline__ void phase_mixers(const Params& p, int l, bfr* sm, int* s_item, int dry) {
  unsigned* ctr = (unsigned*)(p.ws + WS_CTR) + (2 + l + 2 * dry) * 128;
  auto cnt = [](int) { return 180; };
  int q = (int)xcc_id(), tried = 0;
  for (;;) {
    if (TIDX == 0) {
      unsigned first = atomicAdd(ctr + q * 16, 1u);
      *s_item = xq_take(ctr, q, tried, first, cnt);
    }
    __syncthreads();
    const int it = *s_item;
    __syncthreads();
    if (it < 0) break;
    const int x = it >> 20, j = it & 0xfffff;
    int kind, a0, a1, a2, a3 = 0;
    if (j < 4) {
      int idx = x * 4 + j;
      kind = 3; a0 = idx >> 4; a1 = (idx >> 2) & 3; a2 = (idx >> 1) & 1; a3 = idx & 1;
    } else if (j < 36) {
      kind = 1; a0 = 16 + (x >> 2); a1 = x & 3; a2 = j - 4;
    } else if (j < 100) {
      int i = j - 36;
      kind = 2; a0 = 16 + (x >> 2); a1 = ((x >> 1) & 1) * 4 + (x & 1) * 2 + (i >> 5); a2 = i & 31;
    } else if (j < 132) {
      int i = j - 100;
      kind = 0; a0 = 2 * x + (i >> 4); a1 = (i >> 2) & 3; a2 = (i >> 1) & 1; a3 = i & 1;
    } else if (j < 148) {
      int i = j - 132;
      kind = 1; a0 = 2 * x + (i >> 3); a1 = (i >> 1) & 3; a2 = i & 1;
    } else {
      int i = j - 148;
      kind = 2; a0 = 2 * x + (i >> 4); a1 = (i >> 1) & 7; a2 = i & 1;
    }
#ifdef PROBE_MIXKIND
    if (dry && ((PROBE_MIXKIND == 1) != (kind == 0 || kind == 3))) continue;
#endif
    if (kind == 0) gla_item<64>(p, l, a0, a1, a2, a3, sm);
    else if (kind == 3) gla_chain_item(p, l, a0, a1, a2, a3, sm);
    else if (kind == 1) attn_item<96, 128, true>(p, a0, a1, a2, sm, dry);
    else attn_item<64, 64, false>(p, a0, a1, a2, sm, dry);
  }
}

__device__ __forceinline__ void phase_gla_out(const Params& p, int l) {
  const int lane = TIDX & 63;
  bfr* Z = (bfr*)(p.ws + WS_Z);
  const bfr* OF = (const bfr*)(p.ws + WS_R1);
  const bfr* OB = OF + (long)NROWS * 512;
  for (int row = blockIdx.x * 4 + (TIDX >> 6); row < NROWS; row += gridDim.x * 4) {
    float a[8], c[8], gt[8];
    unpack8(*(const u32x4*)(OF + (long)row * 512 + lane * 8), a);
    unpack8(*(const u32x4*)(OB + (long)row * 512 + lane * 8), c);
    bfr* gp = Z + (long)row * ZLD + C_GG + lane * 8;
    unpack8(*(const u32x4*)gp, gt);
    float ss = 0.f;
#pragma unroll
    for (int e = 0; e < 8; e++) {
      a[e] = bf2f(f2bf(a[e] + c[e]));
      ss += a[e] * a[e];
    }
    ss += __shfl_xor(ss, 1); ss += __shfl_xor(ss, 2); ss += __shfl_xor(ss, 4); ss += __shfl_xor(ss, 8);
    float rs = rsqrtf(ss * (1.f / 128.f) + 1e-6f);
    const float* gg = p.in[21] + l * 128 + (lane & 15) * 8;
#pragma unroll
    for (int e = 0; e < 8; e++) a[e] = a[e] * rs * gg[e] * siluf(gt[e]);
    *(u32x4*)gp = pack8(a);
  }
}

__device__ __forceinline__ void phase_merge(const Params& p, bfr* sm) {
  bfr* Z = (bfr*)(p.ws + WS_Z);
  bfr* MG = (bfr*)(p.ws + WS_R1);
  const int lane = TIDX & 63, wid = TIDX >> 6, wr = wid >> 1, wc = wid & 1, g = lane >> 4;
  for (int t = blockIdx.x; t < 96 * 8; t += gridDim.x) {
    int tn = t & 7, tm = t >> 3;
    f32x4 totl[4][4];
#pragma unroll
    for (int a = 0; a < 4; a++)
#pragma unroll
      for (int b = 0; b < 4; b++) totl[a][b] = (f32x4){0.f, 0.f, 0.f, 0.f};
#pragma unroll 1
    for (int seg = 0; seg < 3; seg++) {
      f32x4 acc[4][4];
#pragma unroll
      for (int a = 0; a < 4; a++)
#pragma unroll
        for (int b = 0; b < 4; b++) acc[a][b] = (f32x4){0.f, 0.f, 0.f, 0.f};
      int ycol = seg == 0 ? C_GA : (seg == 1 ? C_GG : C_GC);
      int mcol = C_M1 + seg * 1024;
      const bfr* W = (const bfr*)(p.ws + WS_WOA + (unsigned long)seg * 1048576ul) + (long)tn * 128 * 512;
      gemm128(W, 512, 128, Z + (long)tm * 128 * ZLD + ycol, ZLD, 128, 512, acc, sm);
#pragma unroll
      for (int pi = 0; pi < 4; pi++) {
        int n0 = tn * 128 + wr * 64 + pi * 16 + g * 4;
#pragma unroll
        for (int qi = 0; qi < 4; qi++) {
          int tok = tm * 128 + wc * 64 + qi * 16 + (lane & 15);
          u32x2 mr = *(const u32x2*)(Z + (long)tok * ZLD + mcol + n0);
          totl[pi][qi][0] += sigmf(lo16(mr.x)) * acc[pi][qi][0];
          totl[pi][qi][1] += sigmf(hi16(mr.x)) * acc[pi][qi][1];
          totl[pi][qi][2] += sigmf(lo16(mr.y)) * acc[pi][qi][2];
          totl[pi][qi][3] += sigmf(hi16(mr.y)) * acc[pi][qi][3];
        }
      }
    }
#pragma unroll
    for (int pi = 0; pi < 4; pi++) {
      int n0 = tn * 128 + wr * 64 + pi * 16 + g * 4;
#pragma unroll
      for (int qi = 0; qi < 4; qi++) {
        int tok = tm * 128 + wc * 64 + qi * 16 + (lane & 15);
        u32x2 o;
        o.x = pack2(totl[pi][qi][0], totl[pi][qi][1]);
        o.y = pack2(totl[pi][qi][2], totl[pi][qi][3]);
        *(u32x2*)(MG + (long)tok * 1024 + n0) = o;
      }
    }
  }
}

__device__ __forceinline__ void phase_outproj(const Params& p, bfr* sm) {
  const bfr* MG = (const bfr*)(p.ws + WS_R1);
  float* OUT = (float*)(p.ws + WS_Z);
  const int lane = TIDX & 63, wid = TIDX >> 6, wr = wid >> 1, wc = wid & 1, g = lane >> 4;
  for (int t = blockIdx.x; t < 96 * 8; t += gridDim.x) {
    int tn = t & 7, tm = t >> 3;
    f32x4 acc[4][4];
#pragma unroll
    for (int a = 0; a < 4; a++)
#pragma unroll
      for (int b = 0; b < 4; b++) acc[a][b] = (f32x4){0.f, 0.f, 0.f, 0.f};
    gemm128((const bfr*)(p.ws + WS_WOUT) + (long)tn * 128 * 1024, 1024, 128, MG + (long)tm * 128 * 1024, 1024, 128, 1024, acc,
            sm);
#pragma unroll
    for (int pi = 0; pi < 4; pi++) {
      int n0 = tn * 128 + wr * 64 + pi * 16 + g * 4;
#pragma unroll
      for (int qi = 0; qi < 4; qi++) {
        int tok = tm * 128 + wc * 64 + qi * 16 + (lane & 15);
        *(float4*)(OUT + (long)tok * 1024 + n0) = make_float4(acc[pi][qi][0], acc[pi][qi][1], acc[pi][qi][2], acc[pi][qi][3]);
      }
    }
  }
}

__device__ __forceinline__ void phase_post(const Params& p, int l) {
  const int lane = TIDX & 63;
  const float* mod = (const float*)(p.ws + WS_MOD);
  const float* OUT = (const float*)(p.ws + WS_Z);
  bfr* H = (bfr*)(p.ws + WS_R1);
  for (int row = blockIdx.x * 4 + (TIDX >> 6); row < NROWS; row += gridDim.x * 4) {
    const float* x = (l == 0) ? xrow(p, row) : (p.out + (long)row * 1024);
    const float* md = mod + (l * 3 + row_cond(row)) * 3072;
    float4 v[4];
    float ss = 0.f;
#pragma unroll
    for (int i = 0; i < 4; i++) {
      v[i] = *(const float4*)(OUT + (long)row * 1024 + i * 256 + lane * 4);
      ss += v[i].x * v[i].x + v[i].y * v[i].y + v[i].z * v[i].z + v[i].w * v[i].w;
    }
    ss = wave_sum(ss);
    float rs = rsqrtf(ss * (1.f / 1024.f) + 1e-6f);
    float ss2 = 0.f;
#pragma unroll
    for (int i = 0; i < 4; i++) {
      int n = i * 256 + lane * 4;
      float4 g = *(const float4*)(p.in[13] + l * 1024 + n);
      float4 gt = *(const float4*)(md + 2048 + n);
      float4 xv = *(const float4*)(x + n);
      v[i].x = xv.x + gt.x * (v[i].x * rs * g.x);
      v[i].y = xv.y + gt.y * (v[i].y * rs * g.y);
      v[i].z = xv.z + gt.z * (v[i].z * rs * g.z);
      v[i].w = xv.w + gt.w * (v[i].w * rs * g.w);
      *(float4*)(p.out + (long)row * 1024 + n) = v[i];
      ss2 += v[i].x * v[i].x + v[i].y * v[i].y + v[i].z * v[i].z + v[i].w * v[i].w;
    }
    if (l == 0) {
      ss2 = wave_sum(ss2);
      float rs2 = rsqrtf(ss2 * (1.f / 1024.f) + 1e-6f);
      const float* md1 = mod + (1 * 3 + row_cond(row)) * 3072;
#pragma unroll
      for (int i = 0; i < 4; i++) {
        int n = i * 256 + lane * 4;
        float4 g = *(const float4*)(p.in[12] + 1024 + n);
        float4 sh = *(const float4*)(md1 + n);
        float4 sc = *(const float4*)(md1 + 1024 + n);
        float h0 = v[i].x * rs2 * g.x * (1.f + sc.x) + sh.x;
        float h1 = v[i].y * rs2 * g.y * (1.f + sc.y) + sh.y;
        float h2 = v[i].z * rs2 * g.z * (1.f + sc.z) + sh.z;
        float h3 = v[i].w * rs2 * g.w * (1.f + sc.w) + sh.w;
        u32x2 o;
        o.x = pack2(h0, h1);
        o.y = pack2(h2, h3);
        *(u32x2*)(H + (long)row * 1024 + n) = o;
      }
    }
  }
}

__global__ void __launch_bounds__(256, 2) fwd_megakernel(Params p) {
  __shared__ __attribute__((aligned(16))) bfr sm[SMEM_SHORTS + 16];
  int* s_item_p = (int*)(sm + SMEM_SHORTS + 8);
  cg::grid_group grid = cg::this_grid();
  if (threadIdx.x == 0) { ((unsigned*)(sm + SMEM_SHORTS))[0] = 0u; ((unsigned*)(sm + SMEM_SHORTS))[1] = 0u; }
  __syncthreads();
  XcdBarrier xb = xcd_barrier_post((unsigned*)(p.ws + WS_BAR), (volatile LAS unsigned*)(sm + SMEM_SHORTS));
  if (p.ws == nullptr) grid.sync();
#ifdef PROBE_SYNC
#define GSYNC do { xcd_barrier(xb); xcd_barrier(xb); } while (0)
#else
#define GSYNC xcd_barrier(xb)
#endif
#ifdef PROBE_PRE
  phase_s0(launder(p), sm);
  GSYNC;
  phase_s1(launder(p));
  wconv_phase(p, 0, sm);
  GSYNC;
  phase_prenorm0(launder(p));
  GSYNC;
#endif

#ifndef PH
#define PH 0xffff
#endif
#if PH & 1
  phase_s0(launder(p), sm);
#endif
  GSYNC;
#if PH & 2
  phase_s1(launder(p));
  wconv_phase(p, 0, sm);
#endif
  GSYNC;
#if PH & 4
  phase_prenorm0(launder(p));
#endif
  GSYNC;
  for (int l = 0; l < 2; l++) {
#if PH & 8
#ifdef PROBE_INPROJ
    phase_inproj(launder(p), l, sm, s_item_p, 6 + l);
    GSYNC;
#endif
    phase_inproj(launder(p), l, sm, s_item_p, l);
#endif
    GSYNC;
#if PH & 16
    phase_rowpost(launder(p), l);
#endif
    GSYNC;
#if PH & 32
#ifdef PROBE_MLAUP
    phase_mla_up(launder(p), l, sm);
    GSYNC;
#endif
    phase_mla_up(launder(p), l, sm);
#endif
    GSYNC;
#if PH & 64
#ifdef PROBE_MIX
    { int dry = 1; asm volatile("" : "+s"(dry)); phase_mixers(launder(p), l, sm, s_item_p, dry); }
    GSYNC;
#endif
    { int dry = 0; asm volatile("" : "+s"(dry)); phase_mixers(launder(p), l, sm, s_item_p, dry); }
#endif
    GSYNC;
#if PH & 128
    phase_gla_out(launder(p), l);
#endif
    GSYNC;
#if PH & 256
#ifdef PROBE_MERGE
    phase_merge(launder(p), sm);
    GSYNC;
#endif
    phase_merge(launder(p), sm);
#endif
    GSYNC;
#if PH & 512
#ifdef PROBE_MERGE
    phase_outproj(launder(p), sm);
    GSYNC;
#endif
    phase_outproj(launder(p), sm);
#endif
    GSYNC;
#if PH & 1024
    phase_post(launder(p), l);
    if (l == 0) wconv_phase(p, 1, sm);
#endif
    GSYNC;
  }
}

extern "C" void kernel_launch(void* const* d_in, const int* in_sizes, int n_in, void* d_out, int out_size, void* d_ws,
                              size_t ws_size, hipStream_t stream) {
  static int grid_blocks = 0;
  if (!grid_blocks) {
    int dev = 0, cus = 0, per_cu = 0;
    hipGetDevice(&dev);
    hipDeviceGetAttribute(&cus, hipDeviceAttributeMultiprocessorCount, dev);
    hipOccupancyMaxActiveBlocksPerMultiprocessor(&per_cu, fwd_megakernel, 256, 0);
    if (per_cu > 2) per_cu = 2;
    if (per_cu < 1) per_cu = 1;
    grid_blocks = cus * per_cu;
  }
  Params p{};
  for (int i = 0; i < 30; i++) p.in[i] = (const float*)d_in[i];
  p.out = (float*)d_out;
  p.ws = (unsigned char*)d_ws;
  hipMemsetAsync(d_ws, 0, 20480, stream);
  void* args[] = {&p};
  hipError_t e = hipLaunchCooperativeKernel((void*)fwd_megakernel, dim3(grid_blocks), dim3(256), args, 0, stream);
  if (e != hipSuccess) fprintf(stderr, "cooperative launch failed: %s (grid %d)\n", hipGetErrorString(e), grid_blocks);
}
```

```cpp
#include <hip/hip_runtime.h>
#include <hip/hip_cooperative_groups.h>
#include <cstdio>
namespace cg = cooperative_groups;

typedef unsigned short bfr;
typedef __attribute__((ext_vector_type(8))) short bf16x8;
typedef __attribute__((ext_vector_type(4))) float f32x4;
typedef __attribute__((ext_vector_type(4))) unsigned u32x4;
typedef __attribute__((ext_vector_type(2))) unsigned u32x2;

#define NROWS 12288
#define NCTX 4096
#define ZLD 6976
#define LDT 72
#define SMEM_SHORTS (4 * 128 * LDT)

#define C_QA 0
#define C_KA 512
#define C_VA 640
#define C_GA 768
#define C_QG 1280
#define C_KG 1536
#define C_VG 1792
#define C_GG 2304
#define C_RF 2816
#define C_RB 2832
#define C_QL 2848
#define C_KV 3104
#define C_KR 3360
#define C_GC 3392
#define C_M1 3904
#define C_M2 4928
#define C_M3 5952

#define WS_BAR 0ul
#define WS_CTR 16384ul
#define WS_MODP 20480ul
#define WS_MOD (WS_MODP + 589824ul)
#define WS_ROPE (WS_MOD + 73728ul)
#define WS_WIN (WS_ROPE + 16384ul)
#define WS_WUQ (WS_WIN + 14417920ul)
#define WS_WUKV (WS_WUQ + 196608ul)
#define WS_WOA (WS_WUKV + 393216ul)
#define WS_WOB (WS_WOA + 1048576ul)
#define WS_WOC (WS_WOB + 1048576ul)
#define WS_WOUT (WS_WOC + 1048576ul)
#define WS_KCA (WS_WOUT + 2097152ul)
#define WS_CKVC (WS_KCA + 262144ul)
#define WS_KRC (WS_CKVC + 524288ul)
#define WS_VTA (WS_KRC + 65536ul)
#define WS_CQ (WS_VTA + 3407872ul)
#define WS_KNOPE (WS_CQ + 9437184ul)
#define WS_VTC (WS_KNOPE + 6815744ul)
#define WS_R1 (WS_VTC + 13631488ul)
#define WS_Z (WS_R1 + 25165824ul)
#define WS_END (WS_Z + 171442176ul)

#define O_Y 0
#define O_GK 12582912
#define O_GV 13631488
#define O_CKV 14680064
#define O_KR 16777216
#define O_SF 17039360
#define O_SB 18087936

struct Params {
  const float* in[30];
  float* out;
  unsigned char* ws;
};

__device__ __forceinline__ int tidx() {
  int t = threadIdx.x;
  asm volatile("" : "+v"(t));
  return t;
}
__device__ __forceinline__ Params launder(const Params& p) {
  Params q;
  long zo = 0;
  asm volatile("" : "+s"(zo));
#pragma unroll
  for (int i = 0; i < 30; i++) q.in[i] = p.in[i] + zo;
  q.out = p.out + zo;
  q.ws = p.ws + zo;
  return q;
}
__device__ __forceinline__ float bf2f(bfr b) { return __uint_as_float(((unsigned)b) << 16); }
typedef float f32x2_t __attribute__((ext_vector_type(2)));
typedef __bf16 bf16x2_t __attribute__((ext_vector_type(2)));
__device__ __forceinline__ bfr f2bf(float f) {
  __bf16 r = (__bf16)f;
  return *(bfr*)&r;
}
__device__ __forceinline__ unsigned pack2(float a, float b) {
  f32x2_t v = {a, b};
  bf16x2_t r = __builtin_convertvector(v, bf16x2_t);
  return *(unsigned*)&r;
}
__device__ __forceinline__ float lo16(unsigned u) { return __uint_as_float(u << 16); }
__device__ __forceinline__ float hi16(unsigned u) { return __uint_as_float(u & 0xffff0000u); }
__device__ __forceinline__ float siluf(float x) { return x / (1.f + __expf(-x)); }
__device__ __forceinline__ float sigmf(float x) { return 1.f / (1.f + __expf(-x)); }
__device__ __forceinline__ f32x4 mfma16(bf16x8 a, bf16x8 b, f32x4 c) {
  return __builtin_amdgcn_mfma_f32_16x16x32_bf16(a, b, c, 0, 0, 0);
}
__device__ __forceinline__ const float* xrow(const Params& p, int row) {
  return row < NCTX ? p.in[0] + (long)row * 1024 : p.in[1] + (long)(row - NCTX) * 1024;
}
__device__ __forceinline__ int row_cond(int row) { return row < NCTX ? 0 : 1 + ((row - NCTX) >> 12); }
__device__ __forceinline__ float wave_sum(float v) {
  v += __shfl_xor(v, 1); v += __shfl_xor(v, 2); v += __shfl_xor(v, 4);
  v += __shfl_xor(v, 8); v += __shfl_xor(v, 16); v += __shfl_xor(v, 32);
  return v;
}

#define XB_TMO      128
#define XB_XCNT(j)  (256  + 64 * (j))
#define XB_XSUB(j)  (1280 + 64 * (j))
#define XB_XGEN(j)  (2304 + 64 * (j))
#define XB_TOP      3328
#define XB_TOPGEN   3392
#define XCD_BAR_WORDS 3456
#define XB_SPIN_CAP (1u << 18)
#define LAS __attribute__((address_space(3)))

__device__ __forceinline__ unsigned xb_ld(unsigned* p)              { return __hip_atomic_load(p, __ATOMIC_RELAXED, __HIP_MEMORY_SCOPE_AGENT); }
__device__ __forceinline__ unsigned xb_add(unsigned* p, unsigned v) { return __hip_atomic_fetch_add(p, v, __ATOMIC_RELAXED, __HIP_MEMORY_SCOPE_AGENT); }
__device__ __forceinline__ unsigned xb_xcc_id() { return (unsigned)__builtin_amdgcn_s_getreg((3 << 11) | 20) & 0xFu; }
#define XB_SPIN(cond, bar) do { unsigned _sp = 0; while (cond) { __builtin_amdgcn_s_sleep(1); \
    if ((++_sp & 255u) == 0u) { if (xb_ld(&(bar)[XB_TMO])) break; if (_sp > XB_SPIN_CAP) { atomicAdd(&(bar)[XB_TMO], 1u); break; } } } } while (0)

struct XcdBarrier {
    unsigned* bar; unsigned x;
    volatile LAS unsigned* st;
};

__device__ __forceinline__ XcdBarrier xcd_barrier_post(unsigned* bar, volatile LAS unsigned* st) {
    XcdBarrier b; b.bar = bar; b.x = xb_xcc_id(); b.st = st;
    if (threadIdx.x == 0) (void)xb_add(&bar[XB_XCNT(b.x)], 1u);
    return b;
}
__device__ __forceinline__ void xcd_barrier_complete(unsigned* bar, unsigned x, unsigned& nloc, unsigned& nx) {
    const unsigned G = gridDim.x * gridDim.y * gridDim.z;
    unsigned sum, cnt, mine, sp = 0u;
    for (;;) {
        sum = 0u; cnt = 0u; mine = 0u;
#pragma unroll
        for (unsigned j = 0; j < 16; ++j) { const unsigned c = xb_ld(&bar[XB_XCNT(j)]); sum += c; cnt += (c > 0u) ? 1u : 0u; mine = (j == x) ? c : mine; }
        if (sum == G) break;
        __builtin_amdgcn_s_sleep(1);
        if ((++sp & 255u) == 0u) { if (xb_ld(&bar[XB_TMO])) break; if (sp > XB_SPIN_CAP) { atomicAdd(&bar[XB_TMO], 1u); break; } }
    }
    nloc = mine > 0u ? mine : 1u; nx = cnt > 0u ? cnt : 1u;
}

__device__ __forceinline__ void xcd_barrier(const XcdBarrier& b) {
    asm volatile("s_waitcnt vmcnt(0)" ::: "memory");
    __syncthreads();
    if (threadIdx.x == 0) {
        unsigned* bar = b.bar;
        __builtin_amdgcn_s_waitcnt(0);
        unsigned nloc = b.st[0], nx = b.st[1];
        if (nloc == 0u) { xcd_barrier_complete(bar, b.x, nloc, nx); b.st[0] = nloc; b.st[1] = nx; }
        const unsigned old = xb_add(&bar[XB_XSUB(b.x)], 1u);
        const unsigned gen = old / nloc;
        if (old + 1u == (gen + 1u) * nloc) {
            __builtin_amdgcn_fence(__ATOMIC_RELEASE, "agent");
            asm volatile("s_waitcnt vmcnt(0)" ::: "memory");
            const unsigned og = xb_add(&bar[XB_TOP], 1u);
            const unsigned tg = og / nx;
            if (og + 1u == (tg + 1u) * nx) xb_add(&bar[XB_TOPGEN], 1u);
            else XB_SPIN(xb_ld(&bar[XB_TOPGEN]) == tg, bar);
            __builtin_amdgcn_fence(__ATOMIC_ACQUIRE, "agent");
            xb_add(&bar[XB_XGEN(b.x)], 1u);
            asm volatile("s_waitcnt vmcnt(0)" ::: "memory");
        } else {
            XB_SPIN(xb_ld(&bar[XB_XGEN(b.x)]) == gen, bar);
            __builtin_amdgcn_fence(__ATOMIC_ACQUIRE, "agent");
            asm volatile("s_waitcnt vmcnt(0)" ::: "memory");
        }
    }
    __syncthreads();
}


#define TIDX tidx()
#define LDS3 __attribute__((address_space(3)))
__device__ __forceinline__ void glds16(const bfr* g, bfr* l) {
  __builtin_amdgcn_global_load_lds((const unsigned*)g, (LDS3 unsigned*)l, 16, 0, 0);
}
__device__ __forceinline__ void gemm128(const bfr* __restrict__ P, long ldp, int pmax,
                                        const bfr* __restrict__ Q, long ldq, int qmax, int K,
                                        f32x4 (&acc)[4][4], bfr* sm) {
  const int tid = TIDX, lane = tid & 63, wid = tid >> 6;
  const int wr = wid >> 1, wc = wid & 1;
  const int l15 = lane & 15, g = lane >> 4;
  const bfr* pp[2];
  const bfr* qp[2];
  {
    const int r0 = tid >> 2;
    const int c = (tid & 3) ^ ((tid >> 4) & 3);
#pragma unroll
    for (int i = 0; i < 2; i++) {
      int r = r0 + 64 * i;
      pp[i] = P + (long)min(r, pmax - 1) * ldp + c * 8;
      qp[i] = Q + (long)min(r, qmax - 1) * ldq + c * 8;
    }
  }
  const int nk = K >> 5;
#define GEMM_ISSUE(T)                                                    \
  do {                                                                   \
    bfr* nb_ = sm + ((T) & 3) * 8192;                                    \
    glds16(pp[0] + (T) * 32, nb_ + tid * 8);                             \
    glds16(pp[1] + (T) * 32, nb_ + 2048 + tid * 8);                      \
    glds16(qp[0] + (T) * 32, nb_ + 4096 + tid * 8);                      \
    glds16(qp[1] + (T) * 32, nb_ + 6144 + tid * 8);                      \
  } while (0)
  GEMM_ISSUE(0);
  GEMM_ISSUE(1);
  GEMM_ISSUE(2);
  const int pos = (g ^ ((l15 >> 2) & 3)) * 8;
  for (int kt = 0; kt < nk; kt++) {
    if (kt + 2 < nk) asm volatile("s_waitcnt vmcnt(8)" ::: "memory");
    else if (kt + 1 < nk) asm volatile("s_waitcnt vmcnt(4)" ::: "memory");
    else asm volatile("s_waitcnt vmcnt(0)" ::: "memory");
    __builtin_amdgcn_s_barrier();
    if (kt + 3 < nk) GEMM_ISSUE(kt + 3);
    const bfr* Ps = sm + (kt & 3) * 8192;
    const bfr* Qs = Ps + 4096;
    bf16x8 pf[4], qf[4];
#pragma unroll
    for (int m = 0; m < 4; m++) {
      pf[m] = *(const bf16x8*)(Ps + (wr * 64 + m * 16 + l15) * 32 + pos);
      qf[m] = *(const bf16x8*)(Qs + (wc * 64 + m * 16 + l15) * 32 + pos);
    }
#pragma unroll
    for (int m = 0; m < 4; m++)
#pragma unroll
      for (int n = 0; n < 4; n++) acc[m][n] = mfma16(pf[m], qf[n], acc[m][n]);
  }
#undef GEMM_ISSUE
  __syncthreads();
}

template <int NQ>
__device__ __forceinline__ void gemm128q(const bfr* __restrict__ P, long ldp, const bfr* __restrict__ Q, long ldq, int K,
                                         f32x4 (&acc)[4][NQ], bfr* sm) {
  constexpr int QI = NQ / 2;
  constexpr int STG = 4096 + QI * 2048;
  const int tid = TIDX, lane = tid & 63, wid = tid >> 6;
  const int wr = wid >> 1, wc = wid & 1;
  const int l15 = lane & 15, g = lane >> 4;
  const bfr* pp[2];
  const bfr* qp[QI];
  {
    const int r0 = tid >> 2;
    const int c = (tid & 3) ^ (((tid >> 5) & 1) * 3);
#pragma unroll
    for (int i = 0; i < 2; i++) pp[i] = P + (long)(r0 + 64 * i) * ldp + c * 8;
#pragma unroll
    for (int i = 0; i < QI; i++) qp[i] = Q + (long)(r0 + 64 * i) * ldq + c * 8;
  }
  const int nk = K >> 5;
  auto issue = [&](int T) {
    bfr* nb_ = sm + (T & 3) * STG;
    glds16(pp[0] + T * 32, nb_ + tid * 8);
    glds16(pp[1] + T * 32, nb_ + 2048 + tid * 8);
#pragma unroll
    for (int i = 0; i < QI; i++) glds16(qp[i] + T * 32, nb_ + 4096 + i * 2048 + tid * 8);
  };
  issue(0);
  issue(1);
  issue(2);
  const int pos = (g ^ (((l15 >> 3) & 1) * 3)) * 8;
  for (int kt = 0; kt < nk; kt++) {
    if (kt + 2 < nk) {
      if (QI == 2) asm volatile("s_waitcnt vmcnt(8)" ::: "memory"); else asm volatile("s_waitcnt vmcnt(6)" ::: "memory");
    } else if (kt + 1 < nk) {
      if (QI == 2) asm volatile("s_waitcnt vmcnt(4)" ::: "memory"); else asm volatile("s_waitcnt vmcnt(3)" ::: "memory");
    } else {
      asm volatile("s_waitcnt vmcnt(0)" ::: "memory");
    }
    __builtin_amdgcn_s_barrier();
    if (kt + 3 < nk) issue(kt + 3);
    const bfr* Ps = sm + (kt & 3) * STG;
    const bfr* Qs = Ps + 4096;
    bf16x8 pf[4], qf[NQ];
#pragma unroll
    for (int m = 0; m < 4; m++) pf[m] = *(const bf16x8*)(Ps + (wr * 64 + m * 16 + l15) * 32 + pos);
#pragma unroll
    for (int n = 0; n < NQ; n++) qf[n] = *(const bf16x8*)(Qs + (wc * 16 * NQ + n * 16 + l15) * 32 + pos);
#pragma unroll
    for (int m = 0; m < 4; m++)
#pragma unroll
      for (int n = 0; n < NQ; n++) acc[m][n] = mfma16(pf[m], qf[n], acc[m][n]);
  }
  __syncthreads();
}

__device__ __forceinline__ void gemm256x128(const bfr* __restrict__ P, long ldp, int pmax,
                                            const bfr* __restrict__ Q, long ldq, int K,
                                            f32x4 (&acc)[8][4], bfr* sm, int mode = 0) {
  const int tid = TIDX, lane = tid & 63, wid = tid >> 6;
  const int wr = wid >> 1, wc = wid & 1;
  const int l15 = lane & 15, g = lane >> 4;
  const bfr* pp[4];
  const bfr* qp[2];
  {
    const int r0 = tid >> 2;
    const int c = (tid & 3) ^ (((tid >> 5) & 1) * 3);
#pragma unroll
    for (int i = 0; i < 4; i++) pp[i] = P + (long)min(r0 + 64 * i, pmax - 1) * ldp + c * 8;
#pragma unroll
    for (int i = 0; i < 2; i++) qp[i] = Q + (long)(r0 + 64 * i) * ldq + c * 8;
  }
  const int nk = K >> 5;
#define GEMMW_ISSUE(T)                                                   \
  do {                                                                   \
    bfr* nb_ = sm + ((T) % 3) * 12288;                                   \
    glds16(pp[0] + (T) * 32, nb_ + tid * 8);                             \
    glds16(pp[1] + (T) * 32, nb_ + 2048 + tid * 8);                      \
    glds16(pp[2] + (T) * 32, nb_ + 4096 + tid * 8);                      \
    glds16(pp[3] + (T) * 32, nb_ + 6144 + tid * 8);                      \
    glds16(qp[0] + (T) * 32, nb_ + 8192 + tid * 8);                      \
    glds16(qp[1] + (T) * 32, nb_ + 10240 + tid * 8);                     \
  } while (0)
  GEMMW_ISSUE(0);
  GEMMW_ISSUE(1);
  const int pos = (g ^ (((l15 >> 3) & 1) * 3)) * 8;
  int st = 0;
  for (int kt = 0; kt < nk; kt++) {
    if (kt + 1 < nk) asm volatile("s_waitcnt vmcnt(6)" ::: "memory");
    else asm volatile("s_waitcnt vmcnt(0)" ::: "memory");
    __builtin_amdgcn_s_barrier();
    if (kt + 2 < nk && mode != 1) GEMMW_ISSUE(kt + 2);
    const bfr* Ps = sm + st * 12288;
    const bfr* Qs = Ps + 8192;
    st = (st == 2) ? 0 : st + 1;
    bf16x8 qf[4], pf[8];
#pragma unroll
    for (int n = 0; n < 4; n++) qf[n] = *(const bf16x8*)(Qs + (wc * 64 + n * 16 + l15) * 32 + pos);
#pragma unroll
    for (int m = 0; m < 8; m++) pf[m] = *(const bf16x8*)(Ps + (wr * 128 + m * 16 + l15) * 32 + pos);
#pragma unroll
    for (int m = 0; m < 8; m++)
#pragma unroll
      for (int n = 0; n < 4; n++) acc[m][n] = mfma16(pf[m], qf[n], acc[m][n]);
    __builtin_amdgcn_sched_group_barrier(0x100, 6, 0);
#pragma unroll
    for (int i = 0; i < 6; i++) {
      __builtin_amdgcn_sched_group_barrier(0x008, 4, 0);
      __builtin_amdgcn_sched_group_barrier(0x100, 1, 0);
    }
    __builtin_amdgcn_sched_group_barrier(0x008, 8, 0);
  }
#undef GEMMW_ISSUE
  __syncthreads();
}

__device__ __forceinline__ void phase_s0(const Params& p, bfr* sm) {
  const int tid = TIDX;
  float* rope = (float*)(p.ws + WS_ROPE);
  for (int idx = blockIdx.x * 256 + tid; idx < 1536; idx += gridDim.x * 256) {
    if (idx < 1024) {
      int pos = idx >> 4, i = idx & 15;
      float fr = powf(10000.f, -(float)i / 16.f);
      float a = (float)pos * fr;
      rope[idx] = cosf(a);
      rope[1024 + idx] = sinf(a);
    } else {
      int j = idx - 1024;
      int pos = j >> 3, i = j & 7;
      float fr = powf(10000.f, -(float)i / 8.f);
      float a = (float)pos * fr;
      rope[2048 + j] = cosf(a);
      rope[2560 + j] = sinf(a);
    }
  }
  float* smf = (float*)sm;
  float* modp = (float*)(p.ws + WS_MODP);
  for (int it = blockIdx.x; it < 768; it += gridDim.x) {
    int l = it / 384, rem = it % 384, cgp = rem >> 3, ks = rem & 7;
    int col = cgp * 64 + (tid & 63), kq = tid >> 6;
    const float* w = p.in[10] + (long)l * 1024 * 3072 + col;
    float a0 = 0.f, a1 = 0.f, a2 = 0.f;
    int k0 = ks * 128 + kq * 32;
#pragma unroll 8
    for (int k = k0; k < k0 + 32; k++) {
      float wv = w[(long)k * 3072];
      a0 += siluf(p.in[9][k]) * wv;
      a1 += siluf(p.in[8][k]) * wv;
      a2 += siluf(p.in[8][1024 + k]) * wv;
    }
    smf[(kq * 3 + 0) * 64 + (tid & 63)] = a0;
    smf[(kq * 3 + 1) * 64 + (tid & 63)] = a1;
    smf[(kq * 3 + 2) * 64 + (tid & 63)] = a2;
    __syncthreads();
    if (tid < 192) {
      int c = tid >> 6, cc = tid & 63;
      float s = smf[(0 * 3 + c) * 64 + cc] + smf[(1 * 3 + c) * 64 + cc] + smf[(2 * 3 + c) * 64 + cc] + smf[(3 * 3 + c) * 64 + cc];
      modp[((ks * 2 + l) * 3 + c) * 3072 + cgp * 64 + cc] = s;
    }
    __syncthreads();
  }
}

__device__ __forceinline__ void phase_s1(const Params& p) {
  float* modp = (float*)(p.ws + WS_MODP);
  float* mod = (float*)(p.ws + WS_MOD);
  for (int idx = blockIdx.x * 256 + TIDX; idx < 2 * 3 * 3072; idx += gridDim.x * 256) {
    int l = idx / 9216, n = idx % 3072;
    float s = p.in[11][l * 3072 + n];
#pragma unroll
    for (int ks = 0; ks < 8; ks++) s += modp[ks * 18432 + idx];
    mod[idx] = s;
  }
}

__device__ __forceinline__ void wconv_tile(const float* __restrict__ src, int K, int N, bfr* __restrict__ dst,
                                           int tk, int tn, float* smf) {
  const int tid = TIDX;
  const int n = tid & 63, kb = tid >> 6;
#pragma unroll
  for (int i = 0; i < 16; i++) {
    int k = kb + 4 * i;
    smf[k * 65 + n] = src[(long)(tk * 64 + k) * N + tn * 64 + n];
  }
  __syncthreads();
#pragma unroll
  for (int i = 0; i < 16; i++) {
    int idx = tid + 256 * i;
    int nn = idx >> 6, k = idx & 63;
    dst[(long)(tn * 64 + nn) * K + tk * 64 + k] = f2bf(smf[k * 65 + nn]);
  }
  __syncthreads();
}

#define WCONV_ITEMS 2456
__device__ __forceinline__ void wconv_phase(const Params& p, int l, bfr* sm) {
  float* smf = (float*)sm;
  for (int item0 = blockIdx.x; item0 < WCONV_ITEMS; item0 += gridDim.x) {
    int item = item0;
    const float* src;
    bfr* dst;
    int K, N, tk, tn;
    if (item < 1744) {
      src = p.in[14] + (long)l * 1024 * 6976; K = 1024; N = 6976; dst = (bfr*)(p.ws + WS_WIN); tk = item & 15; tn = item >> 4;
    } else if (item < 1768) {
      item -= 1744;
      src = p.in[24] + (long)l * 256 * 384; K = 256; N = 384; dst = (bfr*)(p.ws + WS_WUQ); tk = item & 3; tn = item >> 2;
    } else if (item < 1816) {
      item -= 1768;
      src = p.in[25] + (long)l * 256 * 768; K = 256; N = 768; dst = (bfr*)(p.ws + WS_WUKV); tk = item & 3; tn = item >> 2;
    } else if (item < 2200) {
      item -= 1816;
      int w = item >> 7, it = item & 127;
      src = (w == 0 ? p.in[26] : (w == 1 ? p.in[27] : p.in[28])) + (long)l * 512 * 1024;
      K = 512; N = 1024; dst = (bfr*)(p.ws + WS_WOA + (unsigned long)w * 1048576ul); tk = it & 7; tn = it >> 3;
    } else {
      item -= 2200;
      src = p.in[29] + (long)l * 1024 * 1024; K = 1024; N = 1024; dst = (bfr*)(p.ws + WS_WOUT); tk = item & 15; tn = item >> 4;
    }
    wconv_tile(src, K, N, dst, tk, tn, smf);
  }
}

__device__ __forceinline__ void phase_prenorm0(const Params& p) {
  const int lane = TIDX & 63;
  const float* mod = (const float*)(p.ws + WS_MOD);
  bfr* H = (bfr*)(p.ws + WS_R1);
  for (int row = blockIdx.x * 4 + (TIDX >> 6); row < NROWS; row += gridDim.x * 4) {
    const float* x = xrow(p, row);
    const float* md = mod + (0 * 3 + row_cond(row)) * 3072;
    float4 v[4];
    float ss = 0.f;
#pragma unroll
    for (int i = 0; i < 4; i++) {
      v[i] = *(const float4*)(x + i * 256 + lane * 4);
      ss += v[i].x * v[i].x + v[i].y * v[i].y + v[i].z * v[i].z + v[i].w * v[i].w;
    }
    ss = wave_sum(ss);
    float rs = rsqrtf(ss * (1.f / 1024.f) + 1e-6f);
#pragma unroll
    for (int i = 0; i < 4; i++) {
      int n = i * 256 + lane * 4;
      float4 g = *(const float4*)(p.in[12] + n);
      float4 sh = *(const float4*)(md + n);
      float4 sc = *(const float4*)(md + 1024 + n);
      float h0 = v[i].x * rs * g.x * (1.f + sc.x) + sh.x;
      float h1 = v[i].y * rs * g.y * (1.f + sc.y) + sh.y;
      float h2 = v[i].z * rs * g.z * (1.f + sc.z) + sh.z;
      float h3 = v[i].w * rs * g.w * (1.f + sc.w) + sh.w;
      u32x2 o;
      o.x = pack2(h0, h1);
      o.y = pack2(h2, h3);
      *(u32x2*)(H + (long)row * 1024 + n) = o;
    }
  }
}

__device__ __forceinline__ unsigned xcc_id() { return (unsigned)__builtin_amdgcn_s_getreg((3 << 11) | 20) & 7u; }
template <class CountF>
__device__ __forceinline__ int xq_take(unsigned* ctr, int& q, int& tried, unsigned first, CountF cnt) {
  unsigned j = first;
  for (;;) {
    if (j < (unsigned)cnt(q)) return (q << 20) | (int)j;
    q = (q + 1) & 7;
    if (++tried >= 8) return -1;
    j = atomicAdd(ctr + q * 16, 1u);
  }
}

__device__ __forceinline__ void phase_inproj(const Params& p, int l, bfr* sm, int* s_item, int slot) {
  const bfr* H = (const bfr*)(p.ws + WS_R1);
  const bfr* W = (const bfr*)(p.ws + WS_WIN);
  bfr* Z = (bfr*)(p.ws + WS_Z);
  const int tid = TIDX;
  const int lane = tid & 63, wid = tid >> 6, wr = wid >> 1, wc = wid & 1;
  unsigned* ctr = (unsigned*)(p.ws + WS_CTR) + slot * 128;
  auto cnt = [](int q) { return 96 * ((28 * (q + 1)) / 8 - (28 * q) / 8); };
  int q = (int)xcc_id(), tried = 0;
  unsigned nxt = 0;
  if (tid == 0) nxt = atomicAdd(ctr + q * 16, 1u);
  for (;;) {
    if (tid == 0) *s_item = xq_take(ctr, q, tried, nxt, cnt);
    __syncthreads();
    const int it = *s_item;
    __syncthreads();
    if (it < 0) break;
    const int qq = it >> 20, j = it & 0xfffff;
    if (tid == 0) nxt = atomicAdd(ctr + q * 16, 1u);
    const int tn0 = (28 * qq) / 8, w = (28 * (qq + 1)) / 8 - tn0;
    const int tm = j / w, tn = tn0 + j % w;
    f32x4 acc[8][4];
#pragma unroll
    for (int a = 0; a < 8; a++)
#pragma unroll
      for (int b = 0; b < 4; b++) acc[a][b] = (f32x4){0.f, 0.f, 0.f, 0.f};
#ifdef PROBE_GMODE
    { int mode = (slot >= 6) ? PROBE_GMODE : 0; asm volatile("" : "+s"(mode));
#ifdef PROBE_DEGEN
      if (slot >= 6) gemm256x128(W, 1024, 256, H, 1024, 1024, acc, sm, mode); else
#endif
      gemm256x128(W + (long)tn * 256 * 1024, 1024, ZLD - tn * 256, H + (long)tm * 128 * 1024, 1024, 1024, acc, sm, mode); }
#else
    gemm256x128(W + (long)tn * 256 * 1024, 1024, ZLD - tn * 256, H + (long)tm * 128 * 1024, 1024, 1024, acc, sm);
#endif
    {
      const int g = lane >> 4, l15 = lane & 15;
#pragma unroll
      for (int pi = 0; pi < 8; pi++)
#pragma unroll
        for (int qi = 0; qi < 4; qi++) {
          u32x2 o;
          o.x = pack2(acc[pi][qi][0], acc[pi][qi][1]);
          o.y = pack2(acc[pi][qi][2], acc[pi][qi][3]);
          *(u32x2*)(sm + (wc * 64 + qi * 16 + l15) * 264 + wr * 128 + pi * 16 + g * 4) = o;
        }
      __syncthreads();
      const int ncol = min(32, (ZLD - tn * 256) >> 3);
#pragma unroll
      for (int i = 0; i < 16; i++) {
        int c = tid + 256 * i;
        int row = c >> 5, c16 = c & 31;
        if (c16 < ncol)
          *(u32x4*)(Z + (long)(tm * 128 + row) * ZLD + tn * 256 + c16 * 8) = *(const u32x4*)(sm + row * 264 + c16 * 8);
      }
      __syncthreads();
    }
  }
}

__device__ __forceinline__ void unpack8(u32x4 v, float* x) {
  x[0] = lo16(v.x); x[1] = hi16(v.x); x[2] = lo16(v.y); x[3] = hi16(v.y);
  x[4] = lo16(v.z); x[5] = hi16(v.z); x[6] = lo16(v.w); x[7] = hi16(v.w);
}
__device__ __forceinline__ u32x4 pack8(const float* y) {
  u32x4 o;
  o.x = pack2(y[0], y[1]); o.y = pack2(y[2], y[3]); o.z = pack2(y[4], y[5]); o.w = pack2(y[6], y[7]);
  return o;
}

__device__ __forceinline__ void phase_rowpost(const Params& p, int l) {
  const int lane = TIDX & 63;
  bfr* Z = (bfr*)(p.ws + WS_Z);
  const float* rope = (const float*)(p.ws + WS_ROPE);
  bfr* VTA = (bfr*)(p.ws + WS_VTA);
  bfr* KCA = (bfr*)(p.ws + WS_KCA);
  bfr* CKVC = (bfr*)(p.ws + WS_CKVC);
  bfr* KRC = (bfr*)(p.ws + WS_KRC);
  float* out = p.out;
  for (int row = blockIdx.x * 4 + (TIDX >> 6); row < NROWS + 1024; row += gridDim.x * 4) {
    if (row < NROWS) {
      const bool lat = row >= NCTX;
      const int bc = row >> 8, tc = row & 255;
      const int bl = (row - NCTX) >> 12, tl = (row - NCTX) & 4095;
      const int prow = tl >> 6, pcol = tl & 63;
      bfr* z = Z + (long)row * ZLD;
      {
        float x[8];
        unpack8(*(const u32x4*)(z + C_QA + lane * 8), x);
        float ss = 0.f;
#pragma unroll
        for (int e = 0; e < 8; e++) ss += x[e] * x[e];
        ss += __shfl_xor(ss, 1); ss += __shfl_xor(ss, 2); ss += __shfl_xor(ss, 4);
        float rs = rsqrtf(ss * (1.f / 64.f) + 1e-6f);
        int sub = lane & 7;
        const float* g = p.in[15] + l * 64 + sub * 8;
#pragma unroll
        for (int e = 0; e < 8; e++) x[e] = x[e] * rs * g[e];
        if (lat) {
          int pos = (sub >> 2) ? pcol : prow;
          bool hi = (sub & 2) != 0;
          int i0 = (sub & 1) * 8;
#pragma unroll
          for (int e = 0; e < 8; e++) {
            float yp = __shfl_xor(x[e], 2);
            float c = rope[pos * 16 + i0 + e], s = rope[1024 + pos * 16 + i0 + e];
            x[e] = hi ? (yp * s + x[e] * c) : (x[e] * c - yp * s);
          }
        }
        const float qs = 0.125f * 1.4426950408889634f;
#pragma unroll
        for (int e = 0; e < 8; e++) x[e] *= qs;
        *(u32x4*)(z + C_QA + lane * 8) = pack8(x);
      }
      {
        int L = lane & 15;
        float x[8];
        unpack8(*(const u32x4*)(z + C_KA + L * 8), x);
        float ss = 0.f;
#pragma unroll
        for (int e = 0; e < 8; e++) ss += x[e] * x[e];
        ss += __shfl_xor(ss, 1); ss += __shfl_xor(ss, 2); ss += __shfl_xor(ss, 4);
        float rs = rsqrtf(ss * (1.f / 64.f) + 1e-6f);
        int sub = L & 7;
        const float* g = p.in[16] + l * 64 + sub * 8;
#pragma unroll
        for (int e = 0; e < 8; e++) x[e] = x[e] * rs * g[e];
        if (lat) {
          int pos = (sub >> 2) ? pcol : prow;
          bool hi = (sub & 2) != 0;
          int i0 = (sub & 1) * 8;
#pragma unroll
          for (int e = 0; e < 8; e++) {
            float yp = __shfl_xor(x[e], 2);
            float c = rope[pos * 16 + i0 + e], s = rope[1024 + pos * 16 + i0 + e];
            x[e] = hi ? (yp * s + x[e] * c) : (x[e] * c - yp * s);
          }
        } else if (lane < 16) {
          float* o = out + O_GK + ((long)(bc * 2 + l) * 256 + tc) * 128 + L * 8;
          *(float4*)(o) = make_float4(x[0], x[1], x[2], x[3]);
          *(float4*)(o + 4) = make_float4(x[4], x[5], x[6], x[7]);
        }
        if (lane < 16) *(u32x4*)(z + C_KA + L * 8) = pack8(x);
      }
      if (lane < 16) {
        int L = lane;
        u32x4 raw = *(const u32x4*)(z + C_VA + L * 8);
        float x[8];
        unpack8(raw, x);
        if (!lat) {
          float* o = out + O_GV + ((long)(bc * 2 + l) * 256 + tc) * 128 + L * 8;
          *(float4*)(o) = make_float4(x[0], x[1], x[2], x[3]);
          *(float4*)(o + 4) = make_float4(x[4], x[5], x[6], x[7]);
        }
        int g = L >> 3, d0 = (L & 7) * 8;
        long base; int nk, key;
        if (!lat) { base = (long)bc * 32768; nk = 256; key = tc; }
        else { base = 16l * 32768 + (long)bl * (2 * 64 * 4608); nk = 4608; key = 512 + tl; }
        const bfr* rb = (const bfr*)&raw;
#pragma unroll
        for (int e = 0; e < 8; e++) VTA[base + (long)(g * 64 + d0 + e) * nk + key] = rb[e];
      }
      {
        u32x2 rq = *(const u32x2*)(z + C_QL + lane * 4);
        u32x2 rk = *(const u32x2*)(z + C_KV + lane * 4);
        float q[4] = {lo16(rq.x), hi16(rq.x), lo16(rq.y), hi16(rq.y)};
        float k[4] = {lo16(rk.x), hi16(rk.x), lo16(rk.y), hi16(rk.y)};
        float sq = q[0] * q[0] + q[1] * q[1] + q[2] * q[2] + q[3] * q[3];
        float sk = k[0] * k[0] + k[1] * k[1] + k[2] * k[2] + k[3] * k[3];
        sq = wave_sum(sq);
        sk = wave_sum(sk);
        float rq_ = rsqrtf(sq * (1.f / 256.f) + 1e-6f), rk_ = rsqrtf(sk * (1.f / 256.f) + 1e-6f);
        float4 gq = *(const float4*)(p.in[22] + l * 256 + lane * 4);
        float4 gk = *(const float4*)(p.in[23] + l * 256 + lane * 4);
        q[0] *= rq_ * gq.x; q[1] *= rq_ * gq.y; q[2] *= rq_ * gq.z; q[3] *= rq_ * gq.w;
        k[0] *= rk_ * gk.x; k[1] *= rk_ * gk.y; k[2] *= rk_ * gk.z; k[3] *= rk_ * gk.w;
        u32x2 o;
        o.x = pack2(q[0], q[1]); o.y = pack2(q[2], q[3]);
        *(u32x2*)(z + C_QL + lane * 4) = o;
        o.x = pack2(k[0], k[1]); o.y = pack2(k[2], k[3]);
        *(u32x2*)(z + C_KV + lane * 4) = o;
        if (!lat) *(float4*)(out + O_CKV + ((long)(bc * 2 + l) * 256 + tc) * 256 + lane * 4) = make_float4(k[0], k[1], k[2], k[3]);
      }
      {
        int L = lane & 3;
        float x[8];
        unpack8(*(const u32x4*)(z + C_KR + L * 8), x);
        if (lat) {
          int pos = (L >> 1) ? pcol : prow;
          bool hi = (L & 1) != 0;
#pragma unroll
          for (int e = 0; e < 8; e++) {
            float yp = __shfl_xor(x[e], 1);
            float c = rope[2048 + pos * 8 + e], s = rope[2560 + pos * 8 + e];
            x[e] = hi ? (yp * s + x[e] * c) : (x[e] * c - yp * s);
          }
          if (lane < 4) *(u32x4*)(z + C_KR + L * 8) = pack8(x);
        } else if (lane < 4) {
          float* o = out + O_KR + ((long)(bc * 2 + l) * 256 + tc) * 32 + L * 8;
          *(float4*)(o) = make_float4(x[0], x[1], x[2], x[3]);
          *(float4*)(o + 4) = make_float4(x[4], x[5], x[6], x[7]);
        }
      }
    } else {
      int cr = row - NROWS;
      int b = cr >> 9, t = cr & 511;
      long src = (long)(b * 2 + l) * 512 + t;
      {
        float2 kv = *(const float2*)(p.in[2] + src * 128 + lane * 2);
        *(unsigned*)(KCA + (long)(b * 512 + t) * 128 + lane * 2) = pack2(kv.x, kv.y);
        float2 vv = *(const float2*)(p.in[3] + src * 128 + lane * 2);
        int c0 = lane * 2;
        long base = 16l * 32768 + (long)b * (2 * 64 * 4608);
        VTA[base + (long)c0 * 4608 + t] = f2bf(vv.x);
        VTA[base + (long)(c0 + 1) * 4608 + t] = f2bf(vv.y);
        float4 cv = *(const float4*)(p.in[4] + src * 256 + lane * 4);
        u32x2 o;
        o.x = pack2(cv.x, cv.y); o.y = pack2(cv.z, cv.w);
        *(u32x2*)(CKVC + (long)(b * 512 + t) * 256 + lane * 4) = o;
        if (lane < 32) KRC[(long)(b * 512 + t) * 32 + lane] = f2bf(p.in[5][src * 32 + lane]);
      }
    }
  }
}

#define WS_PREP1 251703296ul
#define WS_EL (WS_WIN + 12582912ul)
__device__ __forceinline__ bfr* prep_base(const Params& p, int b, int h, int dir, int c) {
  return (bfr*)(p.ws + (b ? WS_PREP1 : WS_WIN)) + (long)((h * 2 + dir) * 64 + c) * 12288;
}

__device__ __forceinline__ void gla_chunk_prep(int tid, const float (&wd)[16], float bias, const bfr* Qr, const bfr* Kr,
                                               bfr* Qe, bfr* Ke, bfr* KlT, const float* RF, float* tot, float* lastv) {
  const int ch = tid & 63, part = tid >> 6;
  float cum[16];
  {
    float run = 0.f;
#pragma unroll
    for (int ii = 0; ii < 16; ii++) {
      int i = part * 16 + ii;
      float x = bias;
#pragma unroll
      for (int r = 0; r < 16; r++) x += RF[i * 16 + r] * wd[r];
      float la = (fminf(x, 0.f) - __logf(1.f + __expf(-fabsf(x)))) * (1.f / 16.f);
      run += la;
      cum[ii] = run;
    }
    tot[part * 64 + ch] = run;
  }
  __syncthreads();
  {
    float off = 0.f, last = 0.f;
#pragma unroll
    for (int pp = 0; pp < 4; pp++) {
      float tv = tot[pp * 64 + ch];
      if (pp < part) off += tv;
      last += tv;
    }
    if (part == 0) lastv[ch] = last;
#pragma unroll
    for (int ii = 0; ii < 16; ii++) {
      int i = part * 16 + ii;
      float cc = cum[ii] + off;
      float qv = bf2f(Qr[i * LDT + ch]), kv = bf2f(Kr[i * LDT + ch]);
      Qe[i * LDT + ch] = f2bf(qv * __expf(cc) * 0.125f);
      Ke[i * LDT + ch] = f2bf(kv * __expf(-cc));
      KlT[ch * LDT + i] = f2bf(kv * __expf(last - cc));
    }
  }
  __syncthreads();
}

__device__ __forceinline__ void gla_att(int wid, int g, int l15, const bfr* Qe, const bfr* Ke, bfr* Att) {
  f32x4 att[4];
  bf16x8 qa[2];
#pragma unroll
  for (int kk = 0; kk < 2; kk++) qa[kk] = *(const bf16x8*)(Qe + (16 * wid + l15) * LDT + kk * 32 + g * 8);
#pragma unroll
  for (int nj = 0; nj < 4; nj++) {
    att[nj] = (f32x4){0.f, 0.f, 0.f, 0.f};
#pragma unroll
    for (int kk = 0; kk < 2; kk++) {
      bf16x8 kb = *(const bf16x8*)(Ke + (16 * nj + l15) * LDT + kk * 32 + g * 8);
      att[nj] = mfma16(qa[kk], kb, att[nj]);
    }
  }
#pragma unroll
  for (int nj = 0; nj < 4; nj++)
#pragma unroll
    for (int r = 0; r < 4; r++) {
      int i = 16 * wid + 4 * g + r, j = 16 * nj + l15;
      Att[i * LDT + j] = f2bf(i >= j ? att[nj][r] : 0.f);
    }
}

__device__ __forceinline__ void gla_prep_item(const Params& p, int l, int b, int h, int dir, int c, bfr* sm) {
  const int tid = TIDX, lane = tid & 63, wid = tid >> 6, g = lane >> 4, l15 = lane & 15;
  const bfr* Z = (const bfr*)(p.ws + WS_Z);
  const int N = 4096;
  const int rowbase = NCTX + b * 4096;
  bfr* Qr = sm;
  bfr* Kr = Qr + 64 * LDT;
  bfr* Qe = Kr + 64 * LDT;
  bfr* Ke = Qe + 64 * LDT;
  bfr* KlT = Ke + 64 * LDT;
  float* RF = (float*)(KlT + 64 * LDT);
  float* tot = RF + 64 * 16;
  float* lastv = tot + 256;
  bfr* Att = Qr;
  const int ch = tid & 63;
  float wd[16];
  {
    const float* W = (dir ? p.in[19] : p.in[17]) + (long)l * 16 * 256 + h * 64 + ch;
#pragma unroll
    for (int r = 0; r < 16; r++) wd[r] = W[r * 256];
  }
  const float bias = (dir ? p.in[20] : p.in[18])[l * 256 + h * 64 + ch];
#pragma unroll
  for (int ii = 0; ii < 2; ii++) {
    int cc = tid + 256 * ii;
    int i = cc >> 3, c8 = cc & 7;
    int tok = dir ? (N - 1 - (c * 64 + i)) : (c * 64 + i);
    const bfr* zr = Z + (long)(rowbase + tok) * ZLD;
    *(u32x4*)(Qr + i * LDT + c8 * 8) = *(const u32x4*)(zr + C_QG + h * 64 + c8 * 8);
    *(u32x4*)(Kr + i * LDT + c8 * 8) = *(const u32x4*)(zr + C_KG + h * 64 + c8 * 8);
  }
  if (tid < 128) {
    int i = tid >> 1, hf = tid & 1;
    int tok = dir ? (N - 1 - (c * 64 + i)) : (c * 64 + i);
    u32x4 rr = *(const u32x4*)(Z + (long)(rowbase + tok) * ZLD + (dir ? C_RB : C_RF) + hf * 8);
    float x[8];
    unpack8(rr, x);
#pragma unroll
    for (int e = 0; e < 8; e++) RF[i * 16 + hf * 8 + e] = x[e];
  }
  __syncthreads();
  gla_chunk_prep(tid, wd, bias, Qr, Kr, Qe, Ke, KlT, RF, tot, lastv);
  gla_att(wid, g, l15, Qe, Ke, Att);
  __syncthreads();
  bfr* dst = prep_base(p, b, h, dir, c);
#pragma unroll
  for (int ii = 0; ii < 2; ii++) {
    int cc = tid + 256 * ii;
    int i = cc >> 3, c8 = cc & 7;
    *(u32x4*)(dst + i * 64 + c8 * 8) = *(const u32x4*)(Qe + i * LDT + c8 * 8);
    *(u32x4*)(dst + 4096 + i * 64 + c8 * 8) = *(const u32x4*)(KlT + i * LDT + c8 * 8);
    *(u32x4*)(dst + 8192 + i * 64 + c8 * 8) = *(const u32x4*)(Att + i * LDT + c8 * 8);
  }
  if (tid < 64) ((float*)(p.ws + WS_EL))[((long)(((b * 4 + h) * 2 + dir) * 64 + c)) * 64 + tid] = __expf(lastv[tid]);
  __syncthreads();
}

__device__ __forceinline__ void gla_chain_item(const Params& p, int l, int b, int h, int dir, int vh, bfr* sm) {
  const int tid = TIDX, lane = tid & 63, wid = tid >> 6, g = lane >> 4, l15 = lane & 15;
  const bfr* Z = (const bfr*)(p.ws + WS_Z);
  bfr* OG = (bfr*)(p.ws + WS_R1) + (long)dir * NROWS * 512;
  const float* EL = (const float*)(p.ws + WS_EL) + (long)(((b * 4 + h) * 2 + dir) * 64) * 64;
  const int N = 4096, nc = 64;
  const int rowbase = NCTX + b * 4096;
  const int vs0 = vh * 64;
  bfr* Vt = sm;
  bfr* St = Vt + 64 * LDT;
  f32x4 st[4];
  {
    const float* S0 = (dir ? p.in[7] : p.in[6]) + ((long)((b * 2 + l) * 4 + h)) * 8192 + (long)(16 * wid + l15) * 128 + vs0;
#pragma unroll
    for (int vt = 0; vt < 4; vt++) {
      float4 a = *(const float4*)(S0 + 16 * vt + 4 * g);
      st[vt] = (f32x4){a.x, a.y, a.z, a.w};
#pragma unroll
      for (int r = 0; r < 4; r++) St[(16 * vt + 4 * g + r) * LDT + 16 * wid + l15] = f2bf(st[vt][r]);
    }
  }
  u32x4 n_qe[2], n_kl[2], n_at[2], n_v[2];
  float n_el;
  auto prefetch = [&](int c) {
    const bfr* base = prep_base(p, b, h, dir, c) + (16 * wid + l15) * 64 + 8 * g;
#pragma unroll
    for (int kk = 0; kk < 2; kk++) {
      n_qe[kk] = *(const u32x4*)(base + kk * 32);
      n_kl[kk] = *(const u32x4*)(base + 4096 + kk * 32);
      n_at[kk] = *(const u32x4*)(base + 8192 + kk * 32);
    }
    n_el = EL[c * 64 + 16 * wid + l15];
#pragma unroll
    for (int ii = 0; ii < 2; ii++) {
      int cc = tid + 256 * ii;
      int i = cc >> 3, c8 = cc & 7;
      int tok = dir ? (N - 1 - (c * 64 + i)) : (c * 64 + i);
      n_v[ii] = *(const u32x4*)(Z + (long)(rowbase + tok) * ZLD + C_VG + h * 128 + vs0 + c8 * 8);
    }
  };
  prefetch(0);
  for (int c = 0; c < nc; c++) {
    u32x4 c_qe[2] = {n_qe[0], n_qe[1]}, c_kl[2] = {n_kl[0], n_kl[1]}, c_at[2] = {n_at[0], n_at[1]};
    const float el = n_el;
#pragma unroll
    for (int ii = 0; ii < 2; ii++) {
      int cc = tid + 256 * ii;
      int i = cc >> 3, c8 = cc & 7;
      const bfr* rb = (const bfr*)&n_v[ii];
#pragma unroll
      for (int e = 0; e < 8; e++) Vt[(c8 * 8 + e) * LDT + i] = rb[e];
    }
    __syncthreads();
    if (c + 1 < nc) prefetch(c + 1);
    f32x4 stn[4];
    const int i = 16 * wid + l15;
    const int tok = dir ? (N - 1 - (c * 64 + i)) : (c * 64 + i);
    bfr* og = OG + (long)(rowbase + tok) * 512 + h * 128 + vs0 + 4 * g;
#pragma unroll
    for (int vt = 0; vt < 4; vt++) {
      f32x4 oc = (f32x4){0.f, 0.f, 0.f, 0.f};
      stn[vt] = st[vt] * el;
#pragma unroll
      for (int kk = 0; kk < 2; kk++) {
        bf16x8 vf = *(const bf16x8*)(Vt + (16 * vt + l15) * LDT + kk * 32 + g * 8);
        bf16x8 sf = *(const bf16x8*)(St + (16 * vt + l15) * LDT + kk * 32 + g * 8);
        oc = mfma16(vf, *(bf16x8*)&c_at[kk], oc);
        oc = mfma16(sf, *(bf16x8*)&c_qe[kk], oc);
        stn[vt] = mfma16(vf, *(bf16x8*)&c_kl[kk], stn[vt]);
      }
      u32x2 ov;
      ov.x = pack2(oc[0], oc[1]);
      ov.y = pack2(oc[2], oc[3]);
      *(u32x2*)(og + 16 * vt) = ov;
    }
    __syncthreads();
#pragma unroll
    for (int vt = 0; vt < 4; vt++) {
      st[vt] = stn[vt];
#pragma unroll
      for (int r = 0; r < 4; r++) St[(16 * vt + 4 * g + r) * LDT + 16 * wid + l15] = f2bf(st[vt][r]);
    }
  }
  __syncthreads();
}

template <int VS>
__device__ __forceinline__ void gla_item(const Params& p, int l, int seq, int h, int dir, int vsl, bfr* sm) {
  constexpr int NVT = VS / 16;
  constexpr int NVL = VS / 32;
  const int tid = TIDX, lane = tid & 63, wid = tid >> 6, g = lane >> 4, l15 = lane & 15;
  bfr* Z = (bfr*)(p.ws + WS_Z);
  bfr* OG = (bfr*)(p.ws + WS_R1) + (long)dir * NROWS * 512;
  const bool lat = seq >= 16;
  const int b = seq - 16;
  const int N = lat ? 4096 : 256;
  const int rowbase = lat ? NCTX + b * 4096 : seq * 256;
  const int nc = N >> 6;
  const int vs0 = vsl * VS;
  bfr* Qr = sm;
  bfr* Kr = Qr + 64 * LDT;
  bfr* Qe = Kr + 64 * LDT;
  bfr* Ke = Qe + 64 * LDT;
  bfr* KlT = Ke + 64 * LDT;
  float* RF = (float*)(KlT + 64 * LDT);
  float* tot = RF + 64 * 16;
  float* lastv = tot + 256;
  bfr* Vt = (bfr*)(lastv + 64);
  bfr* St = Vt + VS * LDT;
  bfr* Att = Qr;
  const int ch = tid & 63;
  float wd[16];
  {
    const float* W = (dir ? p.in[19] : p.in[17]) + (long)l * 16 * 256 + h * 64 + ch;
#pragma unroll
    for (int r = 0; r < 16; r++) wd[r] = W[r * 256];
  }
  const float bias = (dir ? p.in[20] : p.in[18])[l * 256 + h * 64 + ch];

  f32x4 st[NVT];
  {
    const float* S0 = (dir ? p.in[7] : p.in[6]) + ((long)((b * 2 + l) * 4 + h)) * 8192 + (long)(16 * wid + l15) * 128 + vs0;
#pragma unroll
    for (int mv = 0; mv < NVT; mv++) {
      if (lat) {
        float4 a = *(const float4*)(S0 + 16 * mv + 4 * g);
        st[mv] = (f32x4){a.x, a.y, a.z, a.w};
      } else {
        st[mv] = (f32x4){0.f, 0.f, 0.f, 0.f};
      }
#pragma unroll
      for (int r = 0; r < 4; r++) St[(16 * mv + 4 * g + r) * LDT + 16 * wid + l15] = f2bf(st[mv][r]);
    }
  }
  u32x4 rq[2], rk[2], rv[NVL], rr;
  auto prefetch = [&](int c) {
#pragma unroll
    for (int ii = 0; ii < 2; ii++) {
      int cc = tid + 256 * ii;
      int i = cc >> 3, c8 = cc & 7;
      int tok = dir ? (N - 1 - (c * 64 + i)) : (c * 64 + i);
      const bfr* zr = Z + (long)(rowbase + tok) * ZLD;
      rq[ii] = *(const u32x4*)(zr + C_QG + h * 64 + c8 * 8);
      rk[ii] = *(const u32x4*)(zr + C_KG + h * 64 + c8 * 8);
    }
#pragma unroll
    for (int ii = 0; ii < NVL; ii++) {
      int cc = tid + 256 * ii;
      int i = cc / (VS / 8), c4 = cc % (VS / 8);
      int tok = dir ? (N - 1 - (c * 64 + i)) : (c * 64 + i);
      rv[ii] = *(const u32x4*)(Z + (long)(rowbase + tok) * ZLD + C_VG + h * 128 + vs0 + c4 * 8);
    }
    if (tid < 128) {
      int i = tid >> 1, hf = tid & 1;
      int tok = dir ? (N - 1 - (c * 64 + i)) : (c * 64 + i);
      rr = *(const u32x4*)(Z + (long)(rowbase + tok) * ZLD + (dir ? C_RB : C_RF) + hf * 8);
    }
  };
  prefetch(0);
  for (int c = 0; c < nc; c++) {
#pragma unroll
    for (int ii = 0; ii < 2; ii++) {
      int cc = tid + 256 * ii;
      *(u32x4*)(Qr + (cc >> 3) * LDT + (cc & 7) * 8) = rq[ii];
      *(u32x4*)(Kr + (cc >> 3) * LDT + (cc & 7) * 8) = rk[ii];
    }
#pragma unroll
    for (int ii = 0; ii < NVL; ii++) {
      int cc = tid + 256 * ii;
      int i = cc / (VS / 8), c4 = cc % (VS / 8);
      const bfr* rb = (const bfr*)&rv[ii];
#pragma unroll
      for (int e = 0; e < 8; e++) Vt[(c4 * 8 + e) * LDT + i] = rb[e];
    }
    if (tid < 128) {
      int i = tid >> 1, hf = tid & 1;
      float x[8];
      unpack8(rr, x);
#pragma unroll
      for (int e = 0; e < 8; e++) RF[i * 16 + hf * 8 + e] = x[e];
    }
    __syncthreads();
    if (c + 1 < nc) prefetch(c + 1);
    gla_chunk_prep(tid, wd, bias, Qr, Kr, Qe, Ke, KlT, RF, tot, lastv);
    f32x4 stn[NVT];
    {
      float el = __expf(lastv[16 * wid + l15]);
#pragma unroll
      for (int mv = 0; mv < NVT; mv++) {
        stn[mv] = st[mv] * el;
#pragma unroll
        for (int kk = 0; kk < 2; kk++) {
          bf16x8 va = *(const bf16x8*)(Vt + (16 * mv + l15) * LDT + kk * 32 + g * 8);
          bf16x8 kb = *(const bf16x8*)(KlT + (16 * wid + l15) * LDT + kk * 32 + g * 8);
          stn[mv] = mfma16(va, kb, stn[mv]);
        }
      }
      gla_att(wid, g, l15, Qe, Ke, Att);
    }
    __syncthreads();
    {
      bf16x8 aa[2], qa[2];
#pragma unroll
      for (int kk = 0; kk < 2; kk++) {
        aa[kk] = *(const bf16x8*)(Att + (16 * wid + l15) * LDT + kk * 32 + g * 8);
        qa[kk] = *(const bf16x8*)(Qe + (16 * wid + l15) * LDT + kk * 32 + g * 8);
      }
#pragma unroll
      for (int nv = 0; nv < NVT; nv++) {
        f32x4 oc = (f32x4){0.f, 0.f, 0.f, 0.f};
#pragma unroll
        for (int kk = 0; kk < 2; kk++) {
          bf16x8 vb = *(const bf16x8*)(Vt + (16 * nv + l15) * LDT + kk * 32 + g * 8);
          oc = mfma16(aa[kk], vb, oc);
          bf16x8 sb = *(const bf16x8*)(St + (16 * nv + l15) * LDT + kk * 32 + g * 8);
          oc = mfma16(qa[kk], sb, oc);
        }
#pragma unroll
        for (int r = 0; r < 4; r++) {
          int i = 16 * wid + 4 * g + r;
          int tok = dir ? (N - 1 - (c * 64 + i)) : (c * 64 + i);
          OG[(long)(rowbase + tok) * 512 + h * 128 + vs0 + 16 * nv + l15] = f2bf(oc[r]);
        }
      }
    }
    __syncthreads();
#pragma unroll
    for (int mv = 0; mv < NVT; mv++) {
      st[mv] = stn[mv];
#pragma unroll
      for (int r = 0; r < 4; r++) St[(16 * mv + 4 * g + r) * LDT + 16 * wid + l15] = f2bf(st[mv][r]);
    }
  }
  __syncthreads();
  if (!lat) {
    float* so = p.out + (dir ? O_SB : O_SF) + ((long)((seq * 2 + l) * 4 + h)) * 8192 + (long)(16 * wid + l15) * 128 + vs0;
#pragma unroll
    for (int mv = 0; mv < NVT; mv++)
      *(float4*)(so + 16 * mv + 4 * g) = make_float4(st[mv][0], st[mv][1], st[mv][2], st[mv][3]);
  }
}

__device__ __forceinline__ void phase_mla_up(const Params& p, int l, bfr* sm) {
  bfr* Z = (bfr*)(p.ws + WS_Z);
  const float* rope = (const float*)(p.ws + WS_ROPE);
  const int lane = TIDX & 63, wid = TIDX >> 6, wr = wid >> 1, wc = wid & 1;
  const int g = lane >> 4;
  for (int t = blockIdx.x; t < 288 + 624 + 1024; t += gridDim.x) {
    if (t >= 912) {
      int i = t - 912;
      gla_prep_item(p, l, i >> 9, (i >> 7) & 3, (i >> 6) & 1, i & 63, sm);
      continue;
    }
    f32x4 acc[4][4];
#pragma unroll
    for (int a = 0; a < 4; a++)
#pragma unroll
      for (int b = 0; b < 4; b++) acc[a][b] = (f32x4){0.f, 0.f, 0.f, 0.f};
    if (t < 288) {
      int tn = t % 3, tm = t / 3;
      gemm128((const bfr*)(p.ws + WS_WUQ) + (long)tn * 128 * 256, 256, 128, Z + (long)tm * 128 * ZLD + C_QL, ZLD, 128, 256,
              acc, sm);
      bfr* CQ = (bfr*)(p.ws + WS_CQ);
      const float qs = 0.10206207261596577f * 1.4426950408889634f;
#pragma unroll
      for (int pi = 0; pi < 4; pi++) {
        int nb = tn * 128 + wr * 64 + pi * 16;
        int wb = nb % 96;
        bool ropet = wb >= 64;
        int part = (wb - 64) >> 4;
#pragma unroll
        for (int qi = 0; qi < 4; qi++) {
          int tok = tm * 128 + wc * 64 + qi * 16 + (lane & 15);
          float y[4] = {acc[pi][qi][0], acc[pi][qi][1], acc[pi][qi][2], acc[pi][qi][3]};
          if (ropet) {
            bool lat = tok >= NCTX;
            int tl = (tok - NCTX) & 4095;
            int pos = part ? (tl & 63) : (tl >> 6);
            bool hi = (g & 2) != 0;
            int i0 = (g & 1) * 4;
#pragma unroll
            for (int r = 0; r < 4; r++) {
              float yp = __shfl_xor(y[r], 32);
              float c = rope[2048 + pos * 8 + i0 + r], s = rope[2560 + pos * 8 + i0 + r];
              float yr = hi ? (yp * s + y[r] * c) : (y[r] * c - yp * s);
              y[r] = lat ? yr : y[r];
            }
          }
          u32x2 o;
          o.x = pack2(y[0] * qs, y[1] * qs);
          o.y = pack2(y[2] * qs, y[3] * qs);
          *(u32x2*)(CQ + (long)tok * 384 + nb + g * 4) = o;
        }
      }
    } else {
      int t2 = t - 288;
      int tn = t2 % 6, tm = t2 / 6;
      const bfr* Q;
      long ldq;
      long kbase, vbase;
      int nk, key0;
      if (tm < 32) {
        Q = Z + (long)tm * 128 * ZLD + C_KV;
        ldq = ZLD;
        int s = tm >> 1;
        key0 = (tm & 1) * 128;
        nk = 256;
        kbase = (long)s * (4 * 256 * 64);
        vbase = (long)s * 131072;
      } else {
        int r = (tm - 32) * 128;
        int b = r / 4608, within = r % 4608;
        key0 = within;
        nk = 4608;
        kbase = 16l * (4 * 256 * 64) + (long)b * (4 * 4608 * 64);
        vbase = 16l * 131072 + (long)b * (4 * 128 * 4608);
        if (within < 512) {
          Q = (const bfr*)(p.ws + WS_CKVC) + (long)(b * 512 + within) * 256;
          ldq = 256;
        } else {
          Q = Z + (long)(NCTX + b * 4096 + within - 512) * ZLD + C_KV;
          ldq = ZLD;
        }
      }
      gemm128((const bfr*)(p.ws + WS_WUKV) + (long)tn * 128 * 256, 256, 128, Q, ldq, 128, 256, acc, sm);
      bfr* KN = (bfr*)(p.ws + WS_KNOPE);
      bfr* VTC = (bfr*)(p.ws + WS_VTC);
#pragma unroll
      for (int pi = 0; pi < 4; pi++) {
        int n0 = tn * 128 + wr * 64 + pi * 16 + g * 4;
        int head = n0 / 192, w = n0 % 192;
#pragma unroll
        for (int qi = 0; qi < 4; qi++) {
          int key = key0 + wc * 64 + qi * 16 + (lane & 15);
          if (w < 64) {
            u32x2 o;
            o.x = pack2(acc[pi][qi][0], acc[pi][qi][1]);
            o.y = pack2(acc[pi][qi][2], acc[pi][qi][3]);
            *(u32x2*)(KN + kbase + ((long)head * nk + key) * 64 + w) = o;
          } else {
#pragma unroll
            for (int r = 0; r < 4; r++)
              VTC[vbase + ((long)head * 128 + (w - 64) + r) * nk + key] = f2bf(acc[pi][qi][r]);
          }
        }
      }
    }
  }
}

template <int DQ, int DV, bool MLA>
__device__ __forceinline__ void attn_item(const Params& p, int seq, int head, int qblk, bfr* sm, int dry, int amode = 0) {
  constexpr int KLD = DQ + 8;
  constexpr int KSZ = 64 * KLD;
  constexpr int VSZ = DV * LDT;
  constexpr int BUF = KSZ + VSZ;
  constexpr int NKK = DQ / 32;
  constexpr int NDV = DV / 16;
  constexpr int NVL = DV / 32;
  const int tid = TIDX, lane = tid & 63, wid = tid >> 6, g = lane >> 4, l15 = lane & 15;
  bfr* Z = (bfr*)(p.ws + WS_Z);
  const bool lat = seq >= 16;
  const int b = seq - 16;
  const int nk = lat ? 4608 : 256;
  const int rowbase = lat ? NCTX + b * 4096 : seq * 256;
  const int nkt = nk >> 6;

  bf16x8 qf[2][NKK];
#pragma unroll
  for (int qb = 0; qb < 2; qb++) {
    int qrow = rowbase + qblk * 128 + wid * 32 + qb * 16 + l15;
    const bfr* qp = MLA ? ((const bfr*)(p.ws + WS_CQ) + (long)qrow * 384 + head * 96) : (Z + (long)qrow * ZLD + C_QA + head * 64);
#pragma unroll
    for (int kk = 0; kk < NKK; kk++) qf[qb][kk] = *(const bf16x8*)(qp + kk * 32 + g * 8);
  }

  u32x4 rk[2], rkr, rv[NVL];
  auto prefetch = [&](int kt) {
    int k0 = kt * 64;
    bool cache = lat && (k0 < 512);
    int tokrow0 = lat ? (NCTX + b * 4096 + k0 - 512) : (seq * 256 + k0);
    if (!MLA) {
      int kvh = head >> 2;
#pragma unroll
      for (int i = 0; i < 2; i++) {
        int c = tid + 256 * i;
        int kr_ = c >> 3, ch = c & 7;
        const bfr* src = cache ? ((const bfr*)(p.ws + WS_KCA) + (long)(b * 512 + k0 + kr_) * 128 + kvh * 64 + ch * 8)
                               : (Z + (long)(tokrow0 + kr_) * ZLD + C_KA + kvh * 64 + ch * 8);
        rk[i] = *(const u32x4*)src;
      }
      long vb = lat ? (16l * 32768 + (long)b * (2 * 64 * 4608)) : ((long)seq * 32768);
#pragma unroll
      for (int i = 0; i < NVL; i++) {
        int c = tid + 256 * i;
        int dv = c >> 3, ch = c & 7;
        rv[i] = *(const u32x4*)((const bfr*)(p.ws + WS_VTA) + vb + (long)(kvh * 64 + dv) * nk + k0 + ch * 8);
      }
    } else {
      long kb = lat ? (16l * (4 * 256 * 64) + (long)b * (4 * 4608 * 64)) : ((long)seq * (4 * 256 * 64));
#pragma unroll
      for (int i = 0; i < 2; i++) {
        int c = tid + 256 * i;
        int kr_ = c >> 3, ch = c & 7;
        rk[i] = *(const u32x4*)((const bfr*)(p.ws + WS_KNOPE) + kb + ((long)head * nk + k0 + kr_) * 64 + ch * 8);
      }
      {
        int kr_ = tid >> 2, ch = tid & 3;
        const bfr* src = cache ? ((const bfr*)(p.ws + WS_KRC) + (long)(b * 512 + k0 + kr_) * 32 + ch * 8)
                               : (Z + (long)(tokrow0 + kr_) * ZLD + C_KR + ch * 8);
        rkr = *(const u32x4*)src;
      }
      long vb = lat ? (16l * 131072 + (long)b * (4 * 128 * 4608)) : ((long)seq * 131072);
#pragma unroll
      for (int i = 0; i < NVL; i++) {
        int c = tid + 256 * i;
        int dv = c >> 3, ch = c & 7;
        rv[i] = *(const u32x4*)((const bfr*)(p.ws + WS_VTC) + vb + (long)(head * 128 + dv) * nk + k0 + ch * 8);
      }
    }
  };

  f32x4 o[2][NDV];
#pragma unroll
  for (int qb = 0; qb < 2; qb++)
#pragma unroll
    for (int d = 0; d < NDV; d++) o[qb][d] = (f32x4){0.f, 0.f, 0.f, 0.f};
  float mrun[2] = {0.f, 0.f};
  f32x4 lacc[2] = {(f32x4){0.f, 0.f, 0.f, 0.f}, (f32x4){0.f, 0.f, 0.f, 0.f}};
  const bf16x8 ones = (bf16x8){(short)0x3F80, (short)0x3F80, (short)0x3F80, (short)0x3F80, (short)0x3F80, (short)0x3F80, (short)0x3F80, (short)0x3F80};

  prefetch(0);
  for (int kt = 0; kt < nkt; kt++) {
    bfr* Ks = sm + (kt & 1) * BUF;
    bfr* Vs = Ks + KSZ;
    if (amode != 1) {
#pragma unroll
    for (int i = 0; i < 2; i++) {
      int c = tid + 256 * i;
      *(u32x4*)(Ks + (c >> 3) * KLD + (c & 7) * 8) = rk[i];
    }
    if (MLA) *(u32x4*)(Ks + (tid >> 2) * KLD + 64 + (tid & 3) * 8) = rkr;
#pragma unroll
    for (int i = 0; i < NVL; i++) {
      int c = tid + 256 * i;
      *(u32x4*)(Vs + (c >> 3) * LDT + (c & 7) * 8) = rv[i];
    }
    }
    __syncthreads();
    if (kt + 1 < nkt && amode != 1) prefetch(kt + 1);
    if (amode == 2) continue;

    f32x4 s[2][4];
#pragma unroll
    for (int t = 0; t < 4; t++) {
      s[0][t] = (f32x4){-mrun[0], -mrun[0], -mrun[0], -mrun[0]};
      s[1][t] = (f32x4){-mrun[1], -mrun[1], -mrun[1], -mrun[1]};
      int krow = 32 * (t >> 1) + 8 * (l15 >> 2) + 4 * (t & 1) + (l15 & 3);
#pragma unroll
      for (int kk = 0; kk < NKK; kk++) {
        bf16x8 kf = *(const bf16x8*)(Ks + krow * KLD + kk * 32 + g * 8);
        s[0][t] = mfma16(kf, qf[0][kk], s[0][t]);
        s[1][t] = mfma16(kf, qf[1][kk], s[1][t]);
      }
    }
    bf16x8 pf[2][2];
#pragma unroll
    for (int qb = 0; qb < 2; qb++) {
      float mt = s[qb][0][0];
#pragma unroll
      for (int t = 0; t < 4; t++)
#pragma unroll
        for (int r = 0; r < 4; r++) mt = fmaxf(mt, s[qb][t][r]);
      if (__builtin_amdgcn_ballot_w64(mt > 8.f) != 0ull) {
        mt = fmaxf(mt, __shfl_xor(mt, 16));
        mt = fmaxf(mt, __shfl_xor(mt, 32));
        const bool need = mt > 8.f;
        const float dm = need ? mt : 0.f;
        const float alpha = __builtin_amdgcn_exp2f(-dm);
        mrun[qb] += dm;
        lacc[qb] *= alpha;
#pragma unroll
        for (int d = 0; d < NDV; d++) o[qb][d] *= alpha;
#pragma unroll
        for (int t = 0; t < 4; t++) s[qb][t] -= dm;
      }
#pragma unroll
      for (int t = 0; t < 4; t++)
#pragma unroll
        for (int r = 0; r < 4; r++) s[qb][t][r] = __builtin_amdgcn_exp2f(s[qb][t][r]);
#pragma unroll
      for (int sx = 0; sx < 2; sx++) {
        u32x4 u;
        u.x = pack2(s[qb][2 * sx][0], s[qb][2 * sx][1]);
        u.y = pack2(s[qb][2 * sx][2], s[qb][2 * sx][3]);
        u.z = pack2(s[qb][2 * sx + 1][0], s[qb][2 * sx + 1][1]);
        u.w = pack2(s[qb][2 * sx + 1][2], s[qb][2 * sx + 1][3]);
        pf[qb][sx] = *(bf16x8*)&u;
      }
    }
#pragma unroll
    for (int d = 0; d < NDV; d++) {
#pragma unroll
      for (int sx = 0; sx < 2; sx++) {
        bf16x8 vf = *(const bf16x8*)(Vs + (d * 16 + l15) * LDT + sx * 32 + g * 8);
        o[0][d] = mfma16(vf, pf[0][sx], o[0][d]);
        o[1][d] = mfma16(vf, pf[1][sx], o[1][d]);
      }
    }
#pragma unroll
    for (int sx = 0; sx < 2; sx++) {
      lacc[0] = mfma16(ones, pf[0][sx], lacc[0]);
      lacc[1] = mfma16(ones, pf[1][sx], lacc[1]);
    }
  }
  __syncthreads();
#pragma unroll
  for (int qb = 0; qb < 2; qb++) {
    float inv = 1.f / lacc[qb][0];
    int qrow = rowbase + qblk * 128 + wid * 32 + qb * 16 + l15;
    bfr* gp = Z + (long)qrow * ZLD + (MLA ? C_GC : C_GA) + head * DV + g * 4;
#pragma unroll
    for (int d = 0; d < NDV; d++) {
      u32x2 gr = *(const u32x2*)(gp + d * 16);
      float y0 = o[qb][d][0] * inv * siluf(lo16(gr.x));
      float y1 = o[qb][d][1] * inv * siluf(hi16(gr.x));
      float y2 = o[qb][d][2] * inv * siluf(lo16(gr.y));
      float y3 = o[qb][d][3] * inv * siluf(hi16(gr.y));
      u32x2 ov;
      ov.x = pack2(y0, y1);
      ov.y = pack2(y2, y3);
      if (!dry) *(u32x2*)(gp + d * 16) = ov;
    }
  }
}

__device__ __forceinline__ void phase_mixers(const Params& p, int l, bfr* sm, int* s_item, int dry) {
  unsigned* ctr = (unsigned*)(p.ws + WS_CTR) + (2 + l + 2 * dry) * 128;
  auto cnt = [](int) { return 180; };
  int q = (int)xcc_id(), tried = 0;
  for (;;) {
    if (TIDX == 0) {
      unsigned first = atomicAdd(ctr + q * 16, 1u);
      *s_item = xq_take(ctr, q, tried, first, cnt);
    }
    __syncthreads();
    const int it = *s_item;
    __syncthreads();
    if (it < 0) break;
    const int x = it >> 20, j = it & 0xfffff;
    int kind, a0, a1, a2, a3 = 0;
    if (j < 4) {
      int idx = x * 4 + j;
      kind = 3; a0 = idx >> 4; a1 = (idx >> 2) & 3; a2 = (idx >> 1) & 1; a3 = idx & 1;
    } else if (j < 36) {
      kind = 1; a0 = 16 + (x >> 2); a1 = x & 3; a2 = j - 4;
    } else if (j < 100) {
      int i = j - 36;
      kind = 2; a0 = 16 + (x >> 2); a1 = ((x >> 1) & 1) * 4 + (x & 1) * 2 + (i >> 5); a2 = i & 31;
    } else if (j < 132) {
      int i = j - 100;
      kind = 0; a0 = 2 * x + (i >> 4); a1 = (i >> 2) & 3; a2 = (i >> 1) & 1; a3 = i & 1;
    } else if (j < 148) {
      int i = j - 132;
      kind = 1; a0 = 2 * x + (i >> 3); a1 = (i >> 1) & 3; a2 = i & 1;
    } else {
      int i = j - 148;
      kind = 2; a0 = 2 * x + (i >> 4); a1 = (i >> 1) & 7; a2 = i & 1;
    }
#ifdef PROBE_MIXKIND
    if (dry && ((PROBE_MIXKIND == 1) != (kind == 0 || kind == 3))) continue;
#endif
    if (kind == 0) gla_item<64>(p, l, a0, a1, a2, a3, sm);
    else if (kind == 3) gla_chain_item(p, l, a0, a1, a2, a3, sm);
#ifdef PROBE_AMODE
    else if (kind == 1) { int am = dry ? PROBE_AMODE : 0; attn_item<96, 128, true>(p, a0, a1, a2, sm, dry, am); }
    else { int am = dry ? PROBE_AMODE : 0; attn_item<64, 64, false>(p, a0, a1, a2, sm, dry, am); }
#else
    else if (kind == 1) attn_item<96, 128, true>(p, a0, a1, a2, sm, dry);
    else attn_item<64, 64, false>(p, a0, a1, a2, sm, dry);
#endif
  }
}

__device__ __forceinline__ void phase_gla_out(const Params& p, int l) {
  const int lane = TIDX & 63;
  bfr* Z = (bfr*)(p.ws + WS_Z);
  const bfr* OF = (const bfr*)(p.ws + WS_R1);
  const bfr* OB = OF + (long)NROWS * 512;
  for (int row = blockIdx.x * 4 + (TIDX >> 6); row < NROWS; row += gridDim.x * 4) {
    float a[8], c[8], gt[8];
    unpack8(*(const u32x4*)(OF + (long)row * 512 + lane * 8), a);
    unpack8(*(const u32x4*)(OB + (long)row * 512 + lane * 8), c);
    bfr* gp = Z + (long)row * ZLD + C_GG + lane * 8;
    unpack8(*(const u32x4*)gp, gt);
    float ss = 0.f;
#pragma unroll
    for (int e = 0; e < 8; e++) {
      a[e] = bf2f(f2bf(a[e] + c[e]));
      ss += a[e] * a[e];
    }
    ss += __shfl_xor(ss, 1); ss += __shfl_xor(ss, 2); ss += __shfl_xor(ss, 4); ss += __shfl_xor(ss, 8);
    float rs = rsqrtf(ss * (1.f / 128.f) + 1e-6f);
    const float* gg = p.in[21] + l * 128 + (lane & 15) * 8;
#pragma unroll
    for (int e = 0; e < 8; e++) a[e] = a[e] * rs * gg[e] * siluf(gt[e]);
    *(u32x4*)gp = pack8(a);
  }
}

template <int NQ>
__device__ __forceinline__ void merge_tile(const Params& p, bfr* sm, int tn, int tok0) {
  bfr* Z = (bfr*)(p.ws + WS_Z);
  bfr* MG = (bfr*)(p.ws + WS_R1);
  const int lane = TIDX & 63, wid = TIDX >> 6, wr = wid >> 1, wc = wid & 1, g = lane >> 4;
  f32x4 totl[4][NQ];
#pragma unroll
  for (int a = 0; a < 4; a++)
#pragma unroll
    for (int b = 0; b < NQ; b++) totl[a][b] = (f32x4){0.f, 0.f, 0.f, 0.f};
#pragma unroll 1
  for (int seg = 0; seg < 3; seg++) {
    f32x4 acc[4][NQ];
#pragma unroll
    for (int a = 0; a < 4; a++)
#pragma unroll
      for (int b = 0; b < NQ; b++) acc[a][b] = (f32x4){0.f, 0.f, 0.f, 0.f};
    int ycol = seg == 0 ? C_GA : (seg == 1 ? C_GG : C_GC);
    int mcol = C_M1 + seg * 1024;
    const bfr* W = (const bfr*)(p.ws + WS_WOA + (unsigned long)seg * 1048576ul) + (long)tn * 128 * 512;
    gemm128q<NQ>(W, 512, Z + (long)tok0 * ZLD + ycol, ZLD, 512, acc, sm);
#pragma unroll
    for (int pi = 0; pi < 4; pi++) {
      int n0 = tn * 128 + wr * 64 + pi * 16 + g * 4;
#pragma unroll
      for (int qi = 0; qi < NQ; qi++) {
        int tok = tok0 + wc * 16 * NQ + qi * 16 + (lane & 15);
        u32x2 mr = *(const u32x2*)(Z + (long)tok * ZLD + mcol + n0);
        totl[pi][qi][0] += sigmf(lo16(mr.x)) * acc[pi][qi][0];
        totl[pi][qi][1] += sigmf(hi16(mr.x)) * acc[pi][qi][1];
        totl[pi][qi][2] += sigmf(lo16(mr.y)) * acc[pi][qi][2];
        totl[pi][qi][3] += sigmf(hi16(mr.y)) * acc[pi][qi][3];
      }
    }
  }
#pragma unroll
  for (int pi = 0; pi < 4; pi++) {
    int n0 = tn * 128 + wr * 64 + pi * 16 + g * 4;
#pragma unroll
    for (int qi = 0; qi < NQ; qi++) {
      int tok = tok0 + wc * 16 * NQ + qi * 16 + (lane & 15);
      u32x2 o;
      o.x = pack2(totl[pi][qi][0], totl[pi][qi][1]);
      o.y = pack2(totl[pi][qi][2], totl[pi][qi][3]);
      *(u32x2*)(MG + (long)tok * 1024 + n0) = o;
    }
  }
}

__device__ __forceinline__ void phase_merge(const Params& p, bfr* sm) {
  for (int t = blockIdx.x; t < 1024; t += gridDim.x) {
    if (t < 512) {
      merge_tile<4>(p, sm, t & 7, (t >> 3) * 128);
    } else {
      int u = t - 512;
      int full = 512 + (u >> 1);
      merge_tile<2>(p, sm, full & 7, (full >> 3) * 128 + (u & 1) * 64);
    }
  }
}

template <int NQ>
__device__ __forceinline__ void outproj_tile(const Params& p, bfr* sm, int tn, int tok0) {
  const bfr* MG = (const bfr*)(p.ws + WS_R1);
  float* OUT = (float*)(p.ws + WS_Z);
  const int lane = TIDX & 63, wid = TIDX >> 6, wr = wid >> 1, wc = wid & 1, g = lane >> 4;
  f32x4 acc[4][NQ];
#pragma unroll
  for (int a = 0; a < 4; a++)
#pragma unroll
    for (int b = 0; b < NQ; b++) acc[a][b] = (f32x4){0.f, 0.f, 0.f, 0.f};
  gemm128q<NQ>((const bfr*)(p.ws + WS_WOUT) + (long)tn * 128 * 1024, 1024, MG + (long)tok0 * 1024, 1024, 1024, acc, sm);
#pragma unroll
  for (int pi = 0; pi < 4; pi++) {
    int n0 = tn * 128 + wr * 64 + pi * 16 + g * 4;
#pragma unroll
    for (int qi = 0; qi < NQ; qi++) {
      int tok = tok0 + wc * 16 * NQ + qi * 16 + (lane & 15);
      *(float4*)(OUT + (long)tok * 1024 + n0) = make_float4(acc[pi][qi][0], acc[pi][qi][1], acc[pi][qi][2], acc[pi][qi][3]);
    }
  }
}
__device__ __forceinline__ void phase_outproj(const Params& p, bfr* sm) {
  for (int t = blockIdx.x; t < 1024; t += gridDim.x) {
    if (t < 512) {
      outproj_tile<4>(p, sm, t & 7, (t >> 3) * 128);
    } else {
      int u = t - 512;
      int full = 512 + (u >> 1);
      outproj_tile<2>(p, sm, full & 7, (full >> 3) * 128 + (u & 1) * 64);
    }
  }
}

__device__ __forceinline__ void phase_post(const Params& p, int l) {
  const int lane = TIDX & 63;
  const float* mod = (const float*)(p.ws + WS_MOD);
  const float* OUT = (const float*)(p.ws + WS_Z);
  bfr* H = (bfr*)(p.ws + WS_R1);
  for (int row = blockIdx.x * 4 + (TIDX >> 6); row < NROWS; row += gridDim.x * 4) {
    const float* x = (l == 0) ? xrow(p, row) : (p.out + (long)row * 1024);
    const float* md = mod + (l * 3 + row_cond(row)) * 3072;
    float4 v[4];
    float ss = 0.f;
#pragma unroll
    for (int i = 0; i < 4; i++) {
      v[i] = *(const float4*)(OUT + (long)row * 1024 + i * 256 + lane * 4);
      ss += v[i].x * v[i].x + v[i].y * v[i].y + v[i].z * v[i].z + v[i].w * v[i].w;
    }
    ss = wave_sum(ss);
    float rs = rsqrtf(ss * (1.f / 1024.f) + 1e-6f);
    float ss2 = 0.f;
#pragma unroll
    for (int i = 0; i < 4; i++) {
      int n = i * 256 + lane * 4;
      float4 g = *(const float4*)(p.in[13] + l * 1024 + n);
      float4 gt = *(const float4*)(md + 2048 + n);
      float4 xv = *(const float4*)(x + n);
      v[i].x = xv.x + gt.x * (v[i].x * rs * g.x);
      v[i].y = xv.y + gt.y * (v[i].y * rs * g.y);
      v[i].z = xv.z + gt.z * (v[i].z * rs * g.z);
      v[i].w = xv.w + gt.w * (v[i].w * rs * g.w);
      *(float4*)(p.out + (long)row * 1024 + n) = v[i];
      ss2 += v[i].x * v[i].x + v[i].y * v[i].y + v[i].z * v[i].z + v[i].w * v[i].w;
    }
    if (l == 0) {
      ss2 = wave_sum(ss2);
      float rs2 = rsqrtf(ss2 * (1.f / 1024.f) + 1e-6f);
      const float* md1 = mod + (1 * 3 + row_cond(row)) * 3072;
#pragma unroll
      for (int i = 0; i < 4; i++) {
        int n = i * 256 + lane * 4;
        float4 g = *(const float4*)(p.in[12] + 1024 + n);
        float4 sh = *(const float4*)(md1 + n);
        float4 sc = *(const float4*)(md1 + 1024 + n);
        float h0 = v[i].x * rs2 * g.x * (1.f + sc.x) + sh.x;
        float h1 = v[i].y * rs2 * g.y * (1.f + sc.y) + sh.y;
        float h2 = v[i].z * rs2 * g.z * (1.f + sc.z) + sh.z;
        float h3 = v[i].w * rs2 * g.w * (1.f + sc.w) + sh.w;
        u32x2 o;
        o.x = pack2(h0, h1);
        o.y = pack2(h2, h3);
        *(u32x2*)(H + (long)row * 1024 + n) = o;
      }
    }
  }
}

__global__ void __launch_bounds__(256, 2) fwd_megakernel(Params p) {
  __shared__ __attribute__((aligned(16))) bfr sm[SMEM_SHORTS + 16];
  int* s_item_p = (int*)(sm + SMEM_SHORTS + 8);
  cg::grid_group grid = cg::this_grid();
  if (threadIdx.x == 0) { ((unsigned*)(sm + SMEM_SHORTS))[0] = 0u; ((unsigned*)(sm + SMEM_SHORTS))[1] = 0u; }
  __syncthreads();
  XcdBarrier xb = xcd_barrier_post((unsigned*)(p.ws + WS_BAR), (volatile LAS unsigned*)(sm + SMEM_SHORTS));
  if (p.ws == nullptr) grid.sync();
  (void)xb;
#define GSYNC1 do { XcdBarrier b_; b_.bar = (unsigned*)(p.ws + WS_BAR); b_.x = xb_xcc_id(); \
                    b_.st = (volatile LAS unsigned*)(sm + SMEM_SHORTS); xcd_barrier(b_); } while (0)
#ifdef PROBE_SYNC
#define GSYNC do { GSYNC1; GSYNC1; } while (0)
#else
#define GSYNC GSYNC1
#endif
#ifdef PROBE_PRE
  phase_s0(launder(p), sm);
  GSYNC;
  phase_s1(launder(p));
  wconv_phase(p, 0, sm);
  GSYNC;
  phase_prenorm0(launder(p));
  GSYNC;
#endif

#ifndef PH
#define PH 0xffff
#endif
#if PH & 1
  phase_s0(launder(p), sm);
#endif
  GSYNC;
#if PH & 2
  phase_s1(launder(p));
  wconv_phase(p, 0, sm);
#endif
  GSYNC;
#if PH & 4
  phase_prenorm0(launder(p));
#endif
  GSYNC;
  for (int l = 0; l < 2; l++) {
#if PH & 8
#ifdef PROBE_INPROJ
    phase_inproj(launder(p), l, sm, s_item_p, 6 + l);
    GSYNC;
#endif
    phase_inproj(launder(p), l, sm, s_item_p, l);
#endif
    GSYNC;
#if PH & 16
    phase_rowpost(launder(p), l);
#endif
    GSYNC;
#if PH & 32
#ifdef PROBE_MLAUP
    phase_mla_up(launder(p), l, sm);
    GSYNC;
#endif
    phase_mla_up(launder(p), l, sm);
#endif
    GSYNC;
#if PH & 64
#ifdef PROBE_MIX
    { int dry = 1; asm volatile("" : "+s"(dry)); phase_mixers(launder(p), l, sm, s_item_p, dry); }
    GSYNC;
#endif
    { int dry = 0; asm volatile("" : "+s"(dry)); phase_mixers(launder(p), l, sm, s_item_p, dry); }
#endif
    GSYNC;
#if PH & 128
    phase_gla_out(launder(p), l);
#endif
    GSYNC;
#if PH & 256
#ifdef PROBE_MERGE
    phase_merge(launder(p), sm);
    GSYNC;
#endif
    phase_merge(launder(p), sm);
#endif
    GSYNC;
#if PH & 512
#ifdef PROBE_MERGE
    phase_outproj(launder(p), sm);
    GSYNC;
#endif
    phase_outproj(launder(p), sm);
#endif
    GSYNC;
#if PH & 1024
    phase_post(launder(p), l);
    if (l == 0) wconv_phase(p, 1, sm);
#endif
    GSYNC;
  }
}

extern "C" void kernel_launch(void* const* d_in, const int* in_sizes, int n_in, void* d_out, int out_size, void* d_ws,
                              size_t ws_size, hipStream_t stream) {
  static int grid_blocks = 0;
  if (!grid_blocks) {
    int dev = 0, cus = 0, per_cu = 0;
    hipGetDevice(&dev);
    hipDeviceGetAttribute(&cus, hipDeviceAttributeMultiprocessorCount, dev);
    hipOccupancyMaxActiveBlocksPerMultiprocessor(&per_cu, fwd_megakernel, 256, 0);
    if (per_cu > 2) per_cu = 2;
    if (per_cu < 1) per_cu = 1;
    grid_blocks = cus * per_cu;
  }
  Params p{};
  for (int i = 0; i < 30; i++) p.in[i] = (const float*)d_in[i];
  p.out = (float*)d_out;
  p.ws = (unsigned char*)d_ws;
  hipMemsetAsync(d_ws, 0, 20480, stream);
  void* args[] = {&p};
  hipError_t e = hipLaunchCooperativeKernel((void*)fwd_megakernel, dim3(grid_blocks), dim3(256), args, 0, stream);
  if (e != hipSuccess) fprintf(stderr, "cooperative launch failed: %s (grid %d)\n", hipGetErrorString(e), grid_blocks);
}
```

```cpp
#include <hip/hip_runtime.h>
#include <hip/hip_cooperative_groups.h>
#include <cstdio>
namespace cg = cooperative_groups;

typedef unsigned short bfr;
typedef __attribute__((ext_vector_type(8))) short bf16x8;
typedef __attribute__((ext_vector_type(4))) float f32x4;
typedef __attribute__((ext_vector_type(4))) unsigned u32x4;
typedef __attribute__((ext_vector_type(2))) unsigned u32x2;

#define NROWS 12288
#define NCTX 4096
#define ZLD 6976
#define LDT 72
#define SMEM_SHORTS (4 * 128 * LDT)

#define C_QA 0
#define C_KA 512
#define C_VA 640
#define C_GA 768
#define C_QG 1280
#define C_KG 1536
#define C_VG 1792
#define C_GG 2304
#define C_RF 2816
#define C_RB 2832
#define C_QL 2848
#define C_KV 3104
#define C_KR 3360
#define C_GC 3392
#define C_M1 3904
#define C_M2 4928
#define C_M3 5952

#define WS_BAR 0ul
#define WS_CTR 16384ul
#define WS_MODP 20480ul
#define WS_MOD (WS_MODP + 589824ul)
#define WS_ROPE (WS_MOD + 73728ul)
#define WS_WIN (WS_ROPE + 16384ul)
#define WS_WUQ (WS_WIN + 14417920ul)
#define WS_WUKV (WS_WUQ + 196608ul)
#define WS_WOA (WS_WUKV + 393216ul)
#define WS_WOB (WS_WOA + 1048576ul)
#define WS_WOC (WS_WOB + 1048576ul)
#define WS_WOUT (WS_WOC + 1048576ul)
#define WS_KCA (WS_WOUT + 2097152ul)
#define WS_CKVC (WS_KCA + 262144ul)
#define WS_KRC (WS_CKVC + 524288ul)
#define WS_VTA (WS_KRC + 65536ul)
#define WS_CQ (WS_VTA + 3407872ul)
#define WS_KNOPE (WS_CQ + 9437184ul)
#define WS_VTC (WS_KNOPE + 6815744ul)
#define WS_R1 (WS_VTC + 13631488ul)
#define WS_Z (WS_R1 + 25165824ul)
#define WS_END (WS_Z + 171442176ul)

#define O_Y 0
#define O_GK 12582912
#define O_GV 13631488
#define O_CKV 14680064
#define O_KR 16777216
#define O_SF 17039360
#define O_SB 18087936

struct Params {
  const float* in[30];
  float* out;
  unsigned char* ws;
};

__device__ __forceinline__ int tidx() {
  int t = threadIdx.x;
  asm volatile("" : "+v"(t));
  return t;
}
__device__ __forceinline__ Params launder(const Params& p) {
  Params q;
  long zo = 0;
  asm volatile("" : "+s"(zo));
#pragma unroll
  for (int i = 0; i < 30; i++) q.in[i] = p.in[i] + zo;
  q.out = p.out + zo;
  q.ws = p.ws + zo;
  return q;
}
__device__ __forceinline__ float bf2f(bfr b) { return __uint_as_float(((unsigned)b) << 16); }
typedef float f32x2_t __attribute__((ext_vector_type(2)));
typedef __bf16 bf16x2_t __attribute__((ext_vector_type(2)));
__device__ __forceinline__ bfr f2bf(float f) {
  __bf16 r = (__bf16)f;
  return *(bfr*)&r;
}
__device__ __forceinline__ unsigned pack2(float a, float b) {
  f32x2_t v = {a, b};
  bf16x2_t r = __builtin_convertvector(v, bf16x2_t);
  return *(unsigned*)&r;
}
__device__ __forceinline__ float lo16(unsigned u) { return __uint_as_float(u << 16); }
__device__ __forceinline__ float hi16(unsigned u) { return __uint_as_float(u & 0xffff0000u); }
__device__ __forceinline__ float siluf(float x) { return x / (1.f + __expf(-x)); }
__device__ __forceinline__ float sigmf(float x) { return 1.f / (1.f + __expf(-x)); }
__device__ __forceinline__ f32x4 mfma16(bf16x8 a, bf16x8 b, f32x4 c) {
  return __builtin_amdgcn_mfma_f32_16x16x32_bf16(a, b, c, 0, 0, 0);
}
__device__ __forceinline__ const float* xrow(const Params& p, int row) {
  return row < NCTX ? p.in[0] + (long)row * 1024 : p.in[1] + (long)(row - NCTX) * 1024;
}
__device__ __forceinline__ int row_cond(int row) { return row < NCTX ? 0 : 1 + ((row - NCTX) >> 12); }
__device__ __forceinline__ float wave_sum(float v) {
  v += __shfl_xor(v, 1); v += __shfl_xor(v, 2); v += __shfl_xor(v, 4);
  v += __shfl_xor(v, 8); v += __shfl_xor(v, 16); v += __shfl_xor(v, 32);
  return v;
}

#define XB_TMO      128
#define XB_XCNT(j)  (256  + 64 * (j))
#define XB_XSUB(j)  (1280 + 64 * (j))
#define XB_XGEN(j)  (2304 + 64 * (j))
#define XB_TOP      3328
#define XB_TOPGEN   3392
#define XCD_BAR_WORDS 3456
#define XB_SPIN_CAP (1u << 18)
#define LAS __attribute__((address_space(3)))

__device__ __forceinline__ unsigned xb_ld(unsigned* p)              { return __hip_atomic_load(p, __ATOMIC_RELAXED, __HIP_MEMORY_SCOPE_AGENT); }
__device__ __forceinline__ unsigned xb_add(unsigned* p, unsigned v) { return __hip_atomic_fetch_add(p, v, __ATOMIC_RELAXED, __HIP_MEMORY_SCOPE_AGENT); }
__device__ __forceinline__ unsigned xb_xcc_id() { return (unsigned)__builtin_amdgcn_s_getreg((3 << 11) | 20) & 0xFu; }
#define XB_SPIN(cond, bar) do { unsigned _sp = 0; while (cond) { __builtin_amdgcn_s_sleep(1); \
    if ((++_sp & 255u) == 0u) { if (xb_ld(&(bar)[XB_TMO])) break; if (_sp > XB_SPIN_CAP) { atomicAdd(&(bar)[XB_TMO], 1u); break; } } } } while (0)

struct XcdBarrier {
    unsigned* bar; unsigned x;
    volatile LAS unsigned* st;
};

__device__ __forceinline__ XcdBarrier xcd_barrier_post(unsigned* bar, volatile LAS unsigned* st) {
    XcdBarrier b; b.bar = bar; b.x = xb_xcc_id(); b.st = st;
    if (threadIdx.x == 0) (void)xb_add(&bar[XB_XCNT(b.x)], 1u);
    return b;
}
__device__ __forceinline__ void xcd_barrier_complete(unsigned* bar, unsigned x, unsigned& nloc, unsigned& nx) {
    const unsigned G = gridDim.x * gridDim.y * gridDim.z;
    unsigned sum, cnt, mine, sp = 0u;
    for (;;) {
        sum = 0u; cnt = 0u; mine = 0u;
#pragma unroll
        for (unsigned j = 0; j < 16; ++j) { const unsigned c = xb_ld(&bar[XB_XCNT(j)]); sum += c; cnt += (c > 0u) ? 1u : 0u; mine = (j == x) ? c : mine; }
        if (sum == G) break;
        __builtin_amdgcn_s_sleep(1);
        if ((++sp & 255u) == 0u) { if (xb_ld(&bar[XB_TMO])) break; if (sp > XB_SPIN_CAP) { atomicAdd(&bar[XB_TMO], 1u); break; } }
    }
    nloc = mine > 0u ? mine : 1u; nx = cnt > 0u ? cnt : 1u;
}

__device__ __forceinline__ void xcd_barrier(const XcdBarrier& b) {
    asm volatile("s_waitcnt vmcnt(0)" ::: "memory");
    __syncthreads();
    if (threadIdx.x == 0) {
        unsigned* bar = b.bar;
        __builtin_amdgcn_s_waitcnt(0);
        unsigned nloc = b.st[0], nx = b.st[1];
        if (nloc == 0u) { xcd_barrier_complete(bar, b.x, nloc, nx); b.st[0] = nloc; b.st[1] = nx; }
        const unsigned old = xb_add(&bar[XB_XSUB(b.x)], 1u);
        const unsigned gen = old / nloc;
        if (old + 1u == (gen + 1u) * nloc) {
            __builtin_amdgcn_fence(__ATOMIC_RELEASE, "agent");
            asm volatile("s_waitcnt vmcnt(0)" ::: "memory");
            const unsigned og = xb_add(&bar[XB_TOP], 1u);
            const unsigned tg = og / nx;
            if (og + 1u == (tg + 1u) * nx) xb_add(&bar[XB_TOPGEN], 1u);
            else XB_SPIN(xb_ld(&bar[XB_TOPGEN]) == tg, bar);
            __builtin_amdgcn_fence(__ATOMIC_ACQUIRE, "agent");
            xb_add(&bar[XB_XGEN(b.x)], 1u);
            asm volatile("s_waitcnt vmcnt(0)" ::: "memory");
        } else {
            XB_SPIN(xb_ld(&bar[XB_XGEN(b.x)]) == gen, bar);
            __builtin_amdgcn_fence(__ATOMIC_ACQUIRE, "agent");
            asm volatile("s_waitcnt vmcnt(0)" ::: "memory");
        }
    }
    __syncthreads();
}


#define TIDX tidx()
#define LDS3 __attribute__((address_space(3)))
__device__ __forceinline__ void glds16(const bfr* g, bfr* l) {
  __builtin_amdgcn_global_load_lds((const unsigned*)g, (LDS3 unsigned*)l, 16, 0, 0);
}
__device__ __forceinline__ void gemm128(const bfr* __restrict__ P, long ldp, int pmax,
                                        const bfr* __restrict__ Q, long ldq, int qmax, int K,
                                        f32x4 (&acc)[4][4], bfr* sm) {
  const int tid = TIDX, lane = tid & 63, wid = tid >> 6;
  const int wr = wid >> 1, wc = wid & 1;
  const int l15 = lane & 15, g = lane >> 4;
  const bfr* pp[2];
  const bfr* qp[2];
  {
    const int r0 = tid >> 2;
    const int c = (tid & 3) ^ ((tid >> 4) & 3);
#pragma unroll
    for (int i = 0; i < 2; i++) {
      int r = r0 + 64 * i;
      pp[i] = P + (long)min(r, pmax - 1) * ldp + c * 8;
      qp[i] = Q + (long)min(r, qmax - 1) * ldq + c * 8;
    }
  }
  const int nk = K >> 5;
#define GEMM_ISSUE(T)                                                    \
  do {                                                                   \
    bfr* nb_ = sm + ((T) & 3) * 8192;                                    \
    glds16(pp[0] + (T) * 32, nb_ + tid * 8);                             \
    glds16(pp[1] + (T) * 32, nb_ + 2048 + tid * 8);                      \
    glds16(qp[0] + (T) * 32, nb_ + 4096 + tid * 8);                      \
    glds16(qp[1] + (T) * 32, nb_ + 6144 + tid * 8);                      \
  } while (0)
  GEMM_ISSUE(0);
  GEMM_ISSUE(1);
  GEMM_ISSUE(2);
  const int pos = (g ^ ((l15 >> 2) & 3)) * 8;
  for (int kt = 0; kt < nk; kt++) {
    if (kt + 2 < nk) asm volatile("s_waitcnt vmcnt(8)" ::: "memory");
    else if (kt + 1 < nk) asm volatile("s_waitcnt vmcnt(4)" ::: "memory");
    else asm volatile("s_waitcnt vmcnt(0)" ::: "memory");
    __builtin_amdgcn_s_barrier();
    if (kt + 3 < nk) GEMM_ISSUE(kt + 3);
    const bfr* Ps = sm + (kt & 3) * 8192;
    const bfr* Qs = Ps + 4096;
    bf16x8 pf[4], qf[4];
#pragma unroll
    for (int m = 0; m < 4; m++) {
      pf[m] = *(const bf16x8*)(Ps + (wr * 64 + m * 16 + l15) * 32 + pos);
      qf[m] = *(const bf16x8*)(Qs + (wc * 64 + m * 16 + l15) * 32 + pos);
    }
#pragma unroll
    for (int m = 0; m < 4; m++)
#pragma unroll
      for (int n = 0; n < 4; n++) acc[m][n] = mfma16(pf[m], qf[n], acc[m][n]);
  }
#undef GEMM_ISSUE
  __syncthreads();
}

template <int NQ>
__device__ __forceinline__ void gemm128q(const bfr* __restrict__ P, long ldp, const bfr* __restrict__ Q, long ldq, int K,
                                         f32x4 (&acc)[4][NQ], bfr* sm) {
  constexpr int QI = NQ / 2;
  constexpr int STG = 4096 + QI * 2048;
  const int tid = TIDX, lane = tid & 63, wid = tid >> 6;
  const int wr = wid >> 1, wc = wid & 1;
  const int l15 = lane & 15, g = lane >> 4;
  const bfr* pp[2];
  const bfr* qp[QI];
  {
    const int r0 = tid >> 2;
    const int c = (tid & 3) ^ (((tid >> 5) & 1) * 3);
#pragma unroll
    for (int i = 0; i < 2; i++) pp[i] = P + (long)(r0 + 64 * i) * ldp + c * 8;
#pragma unroll
    for (int i = 0; i < QI; i++) qp[i] = Q + (long)(r0 + 64 * i) * ldq + c * 8;
  }
  const int nk = K >> 5;
  auto issue = [&](int T) {
    bfr* nb_ = sm + (T & 3) * STG;
    glds16(pp[0] + T * 32, nb_ + tid * 8);
    glds16(pp[1] + T * 32, nb_ + 2048 + tid * 8);
#pragma unroll
    for (int i = 0; i < QI; i++) glds16(qp[i] + T * 32, nb_ + 4096 + i * 2048 + tid * 8);
  };
  issue(0);
  issue(1);
  issue(2);
  const int pos = (g ^ (((l15 >> 3) & 1) * 3)) * 8;
  for (int kt = 0; kt < nk; kt++) {
    if (kt + 2 < nk) {
      if (QI == 2) asm volatile("s_waitcnt vmcnt(8)" ::: "memory"); else asm volatile("s_waitcnt vmcnt(6)" ::: "memory");
    } else if (kt + 1 < nk) {
      if (QI == 2) asm volatile("s_waitcnt vmcnt(4)" ::: "memory"); else asm volatile("s_waitcnt vmcnt(3)" ::: "memory");
    } else {
      asm volatile("s_waitcnt vmcnt(0)" ::: "memory");
    }
    __builtin_amdgcn_s_barrier();
    if (kt + 3 < nk) issue(kt + 3);
    const bfr* Ps = sm + (kt & 3) * STG;
    const bfr* Qs = Ps + 4096;
    bf16x8 pf[4], qf[NQ];
#pragma unroll
    for (int m = 0; m < 4; m++) pf[m] = *(const bf16x8*)(Ps + (wr * 64 + m * 16 + l15) * 32 + pos);
#pragma unroll
    for (int n = 0; n < NQ; n++) qf[n] = *(const bf16x8*)(Qs + (wc * 16 * NQ + n * 16 + l15) * 32 + pos);
#pragma unroll
    for (int m = 0; m < 4; m++)
#pragma unroll
      for (int n = 0; n < NQ; n++) acc[m][n] = mfma16(pf[m], qf[n], acc[m][n]);
  }
  __syncthreads();
}

__device__ __forceinline__ void gemm256x128(const bfr* __restrict__ P, long ldp, int pmax,
                                            const bfr* __restrict__ Q, long ldq, int K,
                                            f32x4 (&acc)[8][4], bfr* sm, int mode = 0) {
  const int tid = TIDX, lane = tid & 63, wid = tid >> 6;
  const int wr = wid >> 1, wc = wid & 1;
  const int l15 = lane & 15, g = lane >> 4;
  const bfr* pp[4];
  const bfr* qp[2];
  {
    const int r0 = tid >> 2;
    const int c = (tid & 3) ^ (((tid >> 5) & 1) * 3);
#pragma unroll
    for (int i = 0; i < 4; i++) pp[i] = P + (long)min(r0 + 64 * i, pmax - 1) * ldp + c * 8;
#pragma unroll
    for (int i = 0; i < 2; i++) qp[i] = Q + (long)(r0 + 64 * i) * ldq + c * 8;
  }
  const int nk = K >> 5;
#define GEMMW_ISSUE(T)                                                   \
  do {                                                                   \
    bfr* nb_ = sm + ((T) % 3) * 12288;                                   \
    glds16(pp[0] + (T) * 32, nb_ + tid * 8);                             \
    glds16(pp[1] + (T) * 32, nb_ + 2048 + tid * 8);                      \
    glds16(pp[2] + (T) * 32, nb_ + 4096 + tid * 8);                      \
    glds16(pp[3] + (T) * 32, nb_ + 6144 + tid * 8);                      \
    glds16(qp[0] + (T) * 32, nb_ + 8192 + tid * 8);                      \
    glds16(qp[1] + (T) * 32, nb_ + 10240 + tid * 8);                     \
  } while (0)
  GEMMW_ISSUE(0);
  GEMMW_ISSUE(1);
  const int pos = (g ^ (((l15 >> 3) & 1) * 3)) * 8;
  int st = 0;
  for (int kt = 0; kt < nk; kt++) {
    if (kt + 1 < nk) asm volatile("s_waitcnt vmcnt(6)" ::: "memory");
    else asm volatile("s_waitcnt vmcnt(0)" ::: "memory");
    __builtin_amdgcn_s_barrier();
    if (kt + 2 < nk && mode != 1) GEMMW_ISSUE(kt + 2);
    const bfr* Ps = sm + st * 12288;
    const bfr* Qs = Ps + 8192;
    st = (st == 2) ? 0 : st + 1;
    bf16x8 qf[4], pf[8];
#pragma unroll
    for (int n = 0; n < 4; n++) qf[n] = *(const bf16x8*)(Qs + (wc * 64 + n * 16 + l15) * 32 + pos);
#pragma unroll
    for (int m = 0; m < 8; m++) pf[m] = *(const bf16x8*)(Ps + (wr * 128 + m * 16 + l15) * 32 + pos);
#pragma unroll
    for (int m = 0; m < 8; m++)
#pragma unroll
      for (int n = 0; n < 4; n++) acc[m][n] = mfma16(pf[m], qf[n], acc[m][n]);
    __builtin_amdgcn_sched_group_barrier(0x100, 6, 0);
#pragma unroll
    for (int i = 0; i < 6; i++) {
      __builtin_amdgcn_sched_group_barrier(0x008, 4, 0);
      __builtin_amdgcn_sched_group_barrier(0x100, 1, 0);
    }
    __builtin_amdgcn_sched_group_barrier(0x008, 8, 0);
  }
#undef GEMMW_ISSUE
  __syncthreads();
}

__device__ __forceinline__ void phase_s0(const Params& p, bfr* sm) {
  const int tid = TIDX;
  float* rope = (float*)(p.ws + WS_ROPE);
  for (int idx = blockIdx.x * 256 + tid; idx < 1536; idx += gridDim.x * 256) {
    if (idx < 1024) {
      int pos = idx >> 4, i = idx & 15;
      float fr = powf(10000.f, -(float)i / 16.f);
      float a = (float)pos * fr;
      rope[idx] = cosf(a);
      rope[1024 + idx] = sinf(a);
    } else {
      int j = idx - 1024;
      int pos = j >> 3, i = j & 7;
      float fr = powf(10000.f, -(float)i / 8.f);
      float a = (float)pos * fr;
      rope[2048 + j] = cosf(a);
      rope[2560 + j] = sinf(a);
    }
  }
  float* smf = (float*)sm;
  float* modp = (float*)(p.ws + WS_MODP);
  for (int it = blockIdx.x; it < 768; it += gridDim.x) {
    int l = it / 384, rem = it % 384, cgp = rem >> 3, ks = rem & 7;
    int col = cgp * 64 + (tid & 63), kq = tid >> 6;
    const float* w = p.in[10] + (long)l * 1024 * 3072 + col;
    float a0 = 0.f, a1 = 0.f, a2 = 0.f;
    int k0 = ks * 128 + kq * 32;
#pragma unroll 8
    for (int k = k0; k < k0 + 32; k++) {
      float wv = w[(long)k * 3072];
      a0 += siluf(p.in[9][k]) * wv;
      a1 += siluf(p.in[8][k]) * wv;
      a2 += siluf(p.in[8][1024 + k]) * wv;
    }
    smf[(kq * 3 + 0) * 64 + (tid & 63)] = a0;
    smf[(kq * 3 + 1) * 64 + (tid & 63)] = a1;
    smf[(kq * 3 + 2) * 64 + (tid & 63)] = a2;
    __syncthreads();
    if (tid < 192) {
      int c = tid >> 6, cc = tid & 63;
      float s = smf[(0 * 3 + c) * 64 + cc] + smf[(1 * 3 + c) * 64 + cc] + smf[(2 * 3 + c) * 64 + cc] + smf[(3 * 3 + c) * 64 + cc];
      modp[((ks * 2 + l) * 3 + c) * 3072 + cgp * 64 + cc] = s;
    }
    __syncthreads();
  }
}

__device__ __forceinline__ void phase_s1(const Params& p) {
  float* modp = (float*)(p.ws + WS_MODP);
  float* mod = (float*)(p.ws + WS_MOD);
  for (int idx = blockIdx.x * 256 + TIDX; idx < 2 * 3 * 3072; idx += gridDim.x * 256) {
    int l = idx / 9216, n = idx % 3072;
    float s = p.in[11][l * 3072 + n];
#pragma unroll
    for (int ks = 0; ks < 8; ks++) s += modp[ks * 18432 + idx];
    mod[idx] = s;
  }
}

__device__ __forceinline__ void wconv_tile(const float* __restrict__ src, int K, int N, bfr* __restrict__ dst,
                                           int tk, int tn, float* smf) {
  bfr* sT = (bfr*)smf;
  const int tid = TIDX;
  const int n4 = (tid & 15) * 4, kb = tid >> 4;
#pragma unroll
  for (int i = 0; i < 4; i++) {
    int k = kb + 16 * i;
    float4 v = *(const float4*)(src + (long)(tk * 64 + k) * N + tn * 64 + n4);
    sT[(n4 + 0) * 72 + k] = f2bf(v.x);
    sT[(n4 + 1) * 72 + k] = f2bf(v.y);
    sT[(n4 + 2) * 72 + k] = f2bf(v.z);
    sT[(n4 + 3) * 72 + k] = f2bf(v.w);
  }
  __syncthreads();
#pragma unroll
  for (int i = 0; i < 2; i++) {
    int c = tid + 256 * i;
    int n = c >> 3, kc = c & 7;
    *(u32x4*)(dst + (long)(tn * 64 + n) * K + tk * 64 + kc * 8) = *(const u32x4*)(sT + n * 72 + kc * 8);
  }
  __syncthreads();
}

#define WCONV_ITEMS 2456
__device__ __forceinline__ void wconv_phase(const Params& p, int l, bfr* sm) {
  float* smf = (float*)sm;
  for (int item0 = blockIdx.x; item0 < WCONV_ITEMS; item0 += gridDim.x) {
    int item = item0;
    const float* src;
    bfr* dst;
    int K, N, tk, tn;
    if (item < 1744) {
      src = p.in[14] + (long)l * 1024 * 6976; K = 1024; N = 6976; dst = (bfr*)(p.ws + WS_WIN); tk = item & 15; tn = item >> 4;
    } else if (item < 1768) {
      item -= 1744;
      src = p.in[24] + (long)l * 256 * 384; K = 256; N = 384; dst = (bfr*)(p.ws + WS_WUQ); tk = item & 3; tn = item >> 2;
    } else if (item < 1816) {
      item -= 1768;
      src = p.in[25] + (long)l * 256 * 768; K = 256; N = 768; dst = (bfr*)(p.ws + WS_WUKV); tk = item & 3; tn = item >> 2;
    } else if (item < 2200) {
      item -= 1816;
      int w = item >> 7, it = item & 127;
      src = (w == 0 ? p.in[26] : (w == 1 ? p.in[27] : p.in[28])) + (long)l * 512 * 1024;
      K = 512; N = 1024; dst = (bfr*)(p.ws + WS_WOA + (unsigned long)w * 1048576ul); tk = it & 7; tn = it >> 3;
    } else {
      item -= 2200;
      src = p.in[29] + (long)l * 1024 * 1024; K = 1024; N = 1024; dst = (bfr*)(p.ws + WS_WOUT); tk = item & 15; tn = item >> 4;
    }
    wconv_tile(src, K, N, dst, tk, tn, smf);
  }
}

__device__ __forceinline__ void phase_prenorm0(const Params& p) {
  const int lane = TIDX & 63;
  const float* mod = (const float*)(p.ws + WS_MOD);
  bfr* H = (bfr*)(p.ws + WS_R1);
  for (int row = blockIdx.x * 4 + (TIDX >> 6); row < NROWS; row += gridDim.x * 4) {
    const float* x = xrow(p, row);
    const float* md = mod + (0 * 3 + row_cond(row)) * 3072;
    float4 v[4];
    float ss = 0.f;
#pragma unroll
    for (int i = 0; i < 4; i++) {
      v[i] = *(const float4*)(x + i * 256 + lane * 4);
      ss += v[i].x * v[i].x + v[i].y * v[i].y + v[i].z * v[i].z + v[i].w * v[i].w;
    }
    ss = wave_sum(ss);
    float rs = rsqrtf(ss * (1.f / 1024.f) + 1e-6f);
#pragma unroll
    for (int i = 0; i < 4; i++) {
      int n = i * 256 + lane * 4;
      float4 g = *(const float4*)(p.in[12] + n);
      float4 sh = *(const float4*)(md + n);
      float4 sc = *(const float4*)(md + 1024 + n);
      float h0 = v[i].x * rs * g.x * (1.f + sc.x) + sh.x;
      float h1 = v[i].y * rs * g.y * (1.f + sc.y) + sh.y;
      float h2 = v[i].z * rs * g.z * (1.f + sc.z) + sh.z;
      float h3 = v[i].w * rs * g.w * (1.f + sc.w) + sh.w;
      u32x2 o;
      o.x = pack2(h0, h1);
      o.y = pack2(h2, h3);
      *(u32x2*)(H + (long)row * 1024 + n) = o;
    }
  }
}

__device__ __forceinline__ unsigned xcc_id() { return (unsigned)__builtin_amdgcn_s_getreg((3 << 11) | 20) & 7u; }
template <class CountF>
__device__ __forceinline__ int xq_take(unsigned* ctr, int& q, int& tried, unsigned first, CountF cnt) {
  unsigned j = first;
  for (;;) {
    if (j < (unsigned)cnt(q)) return (q << 20) | (int)j;
    q = (q + 1) & 7;
    if (++tried >= 8) return -1;
    j = atomicAdd(ctr + q * 16, 1u);
  }
}

__device__ __forceinline__ void phase_inproj(const Params& p, int l, bfr* sm, int* s_item, int slot) {
  const bfr* H = (const bfr*)(p.ws + WS_R1);
  const bfr* W = (const bfr*)(p.ws + WS_WIN);
  bfr* Z = (bfr*)(p.ws + WS_Z);
  const int tid = TIDX;
  const int lane = tid & 63, wid = tid >> 6, wr = wid >> 1, wc = wid & 1;
  unsigned* ctr = (unsigned*)(p.ws + WS_CTR) + slot * 128;
  auto cnt = [](int q) { return 96 * ((28 * (q + 1)) / 8 - (28 * q) / 8); };
  int q = (int)xcc_id(), tried = 0;
  unsigned nxt = 0;
  if (tid == 0) nxt = atomicAdd(ctr + q * 16, 1u);
  for (;;) {
    if (tid == 0) *s_item = xq_take(ctr, q, tried, nxt, cnt);
    __syncthreads();
    const int it = *s_item;
    __syncthreads();
    if (it < 0) break;
    const int qq = it >> 20, j = it & 0xfffff;
    if (tid == 0) nxt = atomicAdd(ctr + q * 16, 1u);
    const int tn0 = (28 * qq) / 8, w = (28 * (qq + 1)) / 8 - tn0;
    const int tm = j / w, tn = tn0 + j % w;
    f32x4 acc[8][4];
#pragma unroll
    for (int a = 0; a < 8; a++)
#pragma unroll
      for (int b = 0; b < 4; b++) acc[a][b] = (f32x4){0.f, 0.f, 0.f, 0.f};
#ifdef PROBE_GMODE
    { int mode = (slot >= 6) ? PROBE_GMODE : 0; asm volatile("" : "+s"(mode));
#ifdef PROBE_DEGEN
      if (slot >= 6) gemm256x128(W, 1024, 256, H, 1024, 1024, acc, sm, mode); else
#endif
      gemm256x128(W + (long)tn * 256 * 1024, 1024, ZLD - tn * 256, H + (long)tm * 128 * 1024, 1024, 1024, acc, sm, mode); }
#else
    gemm256x128(W + (long)tn * 256 * 1024, 1024, ZLD - tn * 256, H + (long)tm * 128 * 1024, 1024, 1024, acc, sm);
#endif
    {
      const int g = lane >> 4, l15 = lane & 15;
#pragma unroll
      for (int pi = 0; pi < 8; pi++)
#pragma unroll
        for (int qi = 0; qi < 4; qi++) {
          u32x2 o;
          o.x = pack2(acc[pi][qi][0], acc[pi][qi][1]);
          o.y = pack2(acc[pi][qi][2], acc[pi][qi][3]);
          *(u32x2*)(sm + (wc * 64 + qi * 16 + l15) * 264 + wr * 128 + pi * 16 + g * 4) = o;
        }
      __syncthreads();
      const int ncol = min(32, (ZLD - tn * 256) >> 3);
#pragma unroll
      for (int i = 0; i < 16; i++) {
        int c = tid + 256 * i;
        int row = c >> 5, c16 = c & 31;
        if (c16 < ncol)
          *(u32x4*)(Z + (long)(tm * 128 + row) * ZLD + tn * 256 + c16 * 8) = *(const u32x4*)(sm + row * 264 + c16 * 8);
      }
      __syncthreads();
    }
  }
}

__device__ __forceinline__ void unpack8(u32x4 v, float* x) {
  x[0] = lo16(v.x); x[1] = hi16(v.x); x[2] = lo16(v.y); x[3] = hi16(v.y);
  x[4] = lo16(v.z); x[5] = hi16(v.z); x[6] = lo16(v.w); x[7] = hi16(v.w);
}
__device__ __forceinline__ u32x4 pack8(const float* y) {
  u32x4 o;
  o.x = pack2(y[0], y[1]); o.y = pack2(y[2], y[3]); o.z = pack2(y[4], y[5]); o.w = pack2(y[6], y[7]);
  return o;
}

__device__ __forceinline__ void phase_rowpost(const Params& p, int l) {
  const int lane = TIDX & 63;
  bfr* Z = (bfr*)(p.ws + WS_Z);
  const float* rope = (const float*)(p.ws + WS_ROPE);
  bfr* VTA = (bfr*)(p.ws + WS_VTA);
  bfr* KCA = (bfr*)(p.ws + WS_KCA);
  bfr* CKVC = (bfr*)(p.ws + WS_CKVC);
  bfr* KRC = (bfr*)(p.ws + WS_KRC);
  float* out = p.out;
  for (int row = blockIdx.x * 4 + (TIDX >> 6); row < NROWS + 1024; row += gridDim.x * 4) {
    if (row < NROWS) {
      const bool lat = row >= NCTX;
      const int bc = row >> 8, tc = row & 255;
      const int bl = (row - NCTX) >> 12, tl = (row - NCTX) & 4095;
      const int prow = tl >> 6, pcol = tl & 63;
      bfr* z = Z + (long)row * ZLD;
      {
        float x[8];
        unpack8(*(const u32x4*)(z + C_QA + lane * 8), x);
        float ss = 0.f;
#pragma unroll
        for (int e = 0; e < 8; e++) ss += x[e] * x[e];
        ss += __shfl_xor(ss, 1); ss += __shfl_xor(ss, 2); ss += __shfl_xor(ss, 4);
        float rs = rsqrtf(ss * (1.f / 64.f) + 1e-6f);
        int sub = lane & 7;
        const float* g = p.in[15] + l * 64 + sub * 8;
#pragma unroll
        for (int e = 0; e < 8; e++) x[e] = x[e] * rs * g[e];
        if (lat) {
          int pos = (sub >> 2) ? pcol : prow;
          bool hi = (sub & 2) != 0;
          int i0 = (sub & 1) * 8;
#pragma unroll
          for (int e = 0; e < 8; e++) {
            float yp = __shfl_xor(x[e], 2);
            float c = rope[pos * 16 + i0 + e], s = rope[1024 + pos * 16 + i0 + e];
            x[e] = hi ? (yp * s + x[e] * c) : (x[e] * c - yp * s);
          }
        }
        const float qs = 0.125f * 1.4426950408889634f;
#pragma unroll
        for (int e = 0; e < 8; e++) x[e] *= qs;
        *(u32x4*)(z + C_QA + lane * 8) = pack8(x);
      }
      {
        int L = lane & 15;
        float x[8];
        unpack8(*(const u32x4*)(z + C_KA + L * 8), x);
        float ss = 0.f;
#pragma unroll
        for (int e = 0; e < 8; e++) ss += x[e] * x[e];
        ss += __shfl_xor(ss, 1); ss += __shfl_xor(ss, 2); ss += __shfl_xor(ss, 4);
        float rs = rsqrtf(ss * (1.f / 64.f) + 1e-6f);
        int sub = L & 7;
        const float* g = p.in[16] + l * 64 + sub * 8;
#pragma unroll
        for (int e = 0; e < 8; e++) x[e] = x[e] * rs * g[e];
        if (lat) {
          int pos = (sub >> 2) ? pcol : prow;
          bool hi = (sub & 2) != 0;
          int i0 = (sub & 1) * 8;
#pragma unroll
          for (int e = 0; e < 8; e++) {
            float yp = __shfl_xor(x[e], 2);
            float c = rope[pos * 16 + i0 + e], s = rope[1024 + pos * 16 + i0 + e];
            x[e] = hi ? (yp * s + x[e] * c) : (x[e] * c - yp * s);
          }
        } else if (lane < 16) {
          float* o = out + O_GK + ((long)(bc * 2 + l) * 256 + tc) * 128 + L * 8;
          *(float4*)(o) = make_float4(x[0], x[1], x[2], x[3]);
          *(float4*)(o + 4) = make_float4(x[4], x[5], x[6], x[7]);
        }
        if (lane < 16) *(u32x4*)(z + C_KA + L * 8) = pack8(x);
      }
      if (lane < 16) {
        int L = lane;
        u32x4 raw = *(const u32x4*)(z + C_VA + L * 8);
        float x[8];
        unpack8(raw, x);
        if (!lat) {
          float* o = out + O_GV + ((long)(bc * 2 + l) * 256 + tc) * 128 + L * 8;
          *(float4*)(o) = make_float4(x[0], x[1], x[2], x[3]);
          *(float4*)(o + 4) = make_float4(x[4], x[5], x[6], x[7]);
        }
        int g = L >> 3, d0 = (L & 7) * 8;
        long base; int nk, key;
        if (!lat) { base = (long)bc * 32768; nk = 256; key = tc; }
        else { base = 16l * 32768 + (long)bl * (2 * 64 * 4608); nk = 4608; key = 512 + tl; }
        const bfr* rb = (const bfr*)&raw;
#pragma unroll
        for (int e = 0; e < 8; e++) VTA[base + (long)(g * 64 + d0 + e) * nk + key] = rb[e];
      }
      {
        u32x2 rq = *(const u32x2*)(z + C_QL + lane * 4);
        u32x2 rk = *(const u32x2*)(z + C_KV + lane * 4);
        float q[4] = {lo16(rq.x), hi16(rq.x), lo16(rq.y), hi16(rq.y)};
        float k[4] = {lo16(rk.x), hi16(rk.x), lo16(rk.y), hi16(rk.y)};
        float sq = q[0] * q[0] + q[1] * q[1] + q[2] * q[2] + q[3] * q[3];
        float sk = k[0] * k[0] + k[1] * k[1] + k[2] * k[2] + k[3] * k[3];
        sq = wave_sum(sq);
        sk = wave_sum(sk);
        float rq_ = rsqrtf(sq * (1.f / 256.f) + 1e-6f), rk_ = rsqrtf(sk * (1.f / 256.f) + 1e-6f);
        float4 gq = *(const float4*)(p.in[22] + l * 256 + lane * 4);
        float4 gk = *(const float4*)(p.in[23] + l * 256 + lane * 4);
        q[0] *= rq_ * gq.x; q[1] *= rq_ * gq.y; q[2] *= rq_ * gq.z; q[3] *= rq_ * gq.w;
        k[0] *= rk_ * gk.x; k[1] *= rk_ * gk.y; k[2] *= rk_ * gk.z; k[3] *= rk_ * gk.w;
        u32x2 o;
        o.x = pack2(q[0], q[1]); o.y = pack2(q[2], q[3]);
        *(u32x2*)(z + C_QL + lane * 4) = o;
        o.x = pack2(k[0], k[1]); o.y = pack2(k[2], k[3]);
        *(u32x2*)(z + C_KV + lane * 4) = o;
        if (!lat) *(float4*)(out + O_CKV + ((long)(bc * 2 + l) * 256 + tc) * 256 + lane * 4) = make_float4(k[0], k[1], k[2], k[3]);
      }
      {
        int L = lane & 3;
        float x[8];
        unpack8(*(const u32x4*)(z + C_KR + L * 8), x);
        if (lat) {
          int pos = (L >> 1) ? pcol : prow;
          bool hi = (L & 1) != 0;
#pragma unroll
          for (int e = 0; e < 8; e++) {
            float yp = __shfl_xor(x[e], 1);
            float c = rope[2048 + pos * 8 + e], s = rope[2560 + pos * 8 + e];
            x[e] = hi ? (yp * s + x[e] * c) : (x[e] * c - yp * s);
          }
          if (lane < 4) *(u32x4*)(z + C_KR + L * 8) = pack8(x);
        } else if (lane < 4) {
          float* o = out + O_KR + ((long)(bc * 2 + l) * 256 + tc) * 32 + L * 8;
          *(float4*)(o) = make_float4(x[0], x[1], x[2], x[3]);
          *(float4*)(o + 4) = make_float4(x[4], x[5], x[6], x[7]);
        }
      }
    } else {
      int cr = row - NROWS;
      int b = cr >> 9, t = cr & 511;
      long src = (long)(b * 2 + l) * 512 + t;
      {
        float2 kv = *(const float2*)(p.in[2] + src * 128 + lane * 2);
        *(unsigned*)(KCA + (long)(b * 512 + t) * 128 + lane * 2) = pack2(kv.x, kv.y);
        float2 vv = *(const float2*)(p.in[3] + src * 128 + lane * 2);
        int c0 = lane * 2;
        long base = 16l * 32768 + (long)b * (2 * 64 * 4608);
        VTA[base + (long)c0 * 4608 + t] = f2bf(vv.x);
        VTA[base + (long)(c0 + 1) * 4608 + t] = f2bf(vv.y);
        float4 cv = *(const float4*)(p.in[4] + src * 256 + lane * 4);
        u32x2 o;
        o.x = pack2(cv.x, cv.y); o.y = pack2(cv.z, cv.w);
        *(u32x2*)(CKVC + (long)(b * 512 + t) * 256 + lane * 4) = o;
        if (lane < 32) KRC[(long)(b * 512 + t) * 32 + lane] = f2bf(p.in[5][src * 32 + lane]);
      }
    }
  }
}

#define WS_PREP1 251703296ul
#define WS_EL (WS_WIN + 12582912ul)
__device__ __forceinline__ bfr* prep_base(const Params& p, int b, int h, int dir, int c) {
  return (bfr*)(p.ws + (b ? WS_PREP1 : WS_WIN)) + (long)((h * 2 + dir) * 64 + c) * 12288;
}

__device__ __forceinline__ void gla_chunk_prep(int tid, const float (&wd)[16], float bias, const bfr* Qr, const bfr* Kr,
                                               bfr* Qe, bfr* Ke, bfr* KlT, const float* RF, float* tot, float* lastv) {
  const int ch = tid & 63, part = tid >> 6;
  float cum[16];
  {
    float run = 0.f;
#pragma unroll
    for (int ii = 0; ii < 16; ii++) {
      int i = part * 16 + ii;
      float x = bias;
#pragma unroll
      for (int r = 0; r < 16; r++) x += RF[i * 16 + r] * wd[r];
      float la = (fminf(x, 0.f) - __logf(1.f + __expf(-fabsf(x)))) * (1.f / 16.f);
      run += la;
      cum[ii] = run;
    }
    tot[part * 64 + ch] = run;
  }
  __syncthreads();
  {
    float off = 0.f, last = 0.f;
#pragma unroll
    for (int pp = 0; pp < 4; pp++) {
      float tv = tot[pp * 64 + ch];
      if (pp < part) off += tv;
      last += tv;
    }
    if (part == 0) lastv[ch] = last;
#pragma unroll
    for (int ii = 0; ii < 16; ii++) {
      int i = part * 16 + ii;
      float cc = cum[ii] + off;
      float qv = bf2f(Qr[i * LDT + ch]), kv = bf2f(Kr[i * LDT + ch]);
      Qe[i * LDT + ch] = f2bf(qv * __expf(cc) * 0.125f);
      Ke[i * LDT + ch] = f2bf(kv * __expf(-cc));
      KlT[ch * LDT + i] = f2bf(kv * __expf(last - cc));
    }
  }
  __syncthreads();
}

__device__ __forceinline__ void gla_att(int wid, int g, int l15, const bfr* Qe, const bfr* Ke, bfr* Att) {
  f32x4 att[4];
  bf16x8 qa[2];
#pragma unroll
  for (int kk = 0; kk < 2; kk++) qa[kk] = *(const bf16x8*)(Qe + (16 * wid + l15) * LDT + kk * 32 + g * 8);
#pragma unroll
  for (int nj = 0; nj < 4; nj++) {
    att[nj] = (f32x4){0.f, 0.f, 0.f, 0.f};
#pragma unroll
    for (int kk = 0; kk < 2; kk++) {
      bf16x8 kb = *(const bf16x8*)(Ke + (16 * nj + l15) * LDT + kk * 32 + g * 8);
      att[nj] = mfma16(qa[kk], kb, att[nj]);
    }
  }
#pragma unroll
  for (int nj = 0; nj < 4; nj++)
#pragma unroll
    for (int r = 0; r < 4; r++) {
      int i = 16 * wid + 4 * g + r, j = 16 * nj + l15;
      Att[i * LDT + j] = f2bf(i >= j ? att[nj][r] : 0.f);
    }
}

__device__ __forceinline__ void gla_prep_item(const Params& p, int l, int b, int h, int dir, int c, bfr* sm) {
  const int tid = TIDX, lane = tid & 63, wid = tid >> 6, g = lane >> 4, l15 = lane & 15;
  const bfr* Z = (const bfr*)(p.ws + WS_Z);
  const int N = 4096;
  const int rowbase = NCTX + b * 4096;
  bfr* Qr = sm;
  bfr* Kr = Qr + 64 * LDT;
  bfr* Qe = Kr + 64 * LDT;
  bfr* Ke = Qe + 64 * LDT;
  bfr* KlT = Ke + 64 * LDT;
  float* RF = (float*)(KlT + 64 * LDT);
  float* tot = RF + 64 * 16;
  float* lastv = tot + 256;
  bfr* Att = Qr;
  const int ch = tid & 63;
  float wd[16];
  {
    const float* W = (dir ? p.in[19] : p.in[17]) + (long)l * 16 * 256 + h * 64 + ch;
#pragma unroll
    for (int r = 0; r < 16; r++) wd[r] = W[r * 256];
  }
  const float bias = (dir ? p.in[20] : p.in[18])[l * 256 + h * 64 + ch];
#pragma unroll
  for (int ii = 0; ii < 2; ii++) {
    int cc = tid + 256 * ii;
    int i = cc >> 3, c8 = cc & 7;
    int tok = dir ? (N - 1 - (c * 64 + i)) : (c * 64 + i);
    const bfr* zr = Z + (long)(rowbase + tok) * ZLD;
    *(u32x4*)(Qr + i * LDT + c8 * 8) = *(const u32x4*)(zr + C_QG + h * 64 + c8 * 8);
    *(u32x4*)(Kr + i * LDT + c8 * 8) = *(const u32x4*)(zr + C_KG + h * 64 + c8 * 8);
  }
  if (tid < 128) {
    int i = tid >> 1, hf = tid & 1;
    int tok = dir ? (N - 1 - (c * 64 + i)) : (c * 64 + i);
    u32x4 rr = *(const u32x4*)(Z + (long)(rowbase + tok) * ZLD + (dir ? C_RB : C_RF) + hf * 8);
    float x[8];
    unpack8(rr, x);
#pragma unroll
    for (int e = 0; e < 8; e++) RF[i * 16 + hf * 8 + e] = x[e];
  }
  __syncthreads();
  gla_chunk_prep(tid, wd, bias, Qr, Kr, Qe, Ke, KlT, RF, tot, lastv);
  gla_att(wid, g, l15, Qe, Ke, Att);
  __syncthreads();
  bfr* dst = prep_base(p, b, h, dir, c);
#pragma unroll
  for (int ii = 0; ii < 2; ii++) {
    int cc = tid + 256 * ii;
    int i = cc >> 3, c8 = cc & 7;
    *(u32x4*)(dst + i * 64 + c8 * 8) = *(const u32x4*)(Qe + i * LDT + c8 * 8);
    *(u32x4*)(dst + 4096 + i * 64 + c8 * 8) = *(const u32x4*)(KlT + i * LDT + c8 * 8);
    *(u32x4*)(dst + 8192 + i * 64 + c8 * 8) = *(const u32x4*)(Att + i * LDT + c8 * 8);
  }
  if (tid < 64) ((float*)(p.ws + WS_EL))[((long)(((b * 4 + h) * 2 + dir) * 64 + c)) * 64 + tid] = __expf(lastv[tid]);
  __syncthreads();
}

__device__ __forceinline__ void gla_chain_item(const Params& p, int l, int b, int h, int dir, int vh, bfr* sm) {
  const int tid = TIDX, lane = tid & 63, wid = tid >> 6, g = lane >> 4, l15 = lane & 15;
  const bfr* Z = (const bfr*)(p.ws + WS_Z);
  bfr* OG = (bfr*)(p.ws + WS_R1) + (long)dir * NROWS * 512;
  const float* EL = (const float*)(p.ws + WS_EL) + (long)(((b * 4 + h) * 2 + dir) * 64) * 64;
  const int N = 4096, nc = 64;
  const int rowbase = NCTX + b * 4096;
  const int vs0 = vh * 64;
  bfr* Vt = sm;
  bfr* St = Vt + 64 * LDT;
  f32x4 st[4];
  {
    const float* S0 = (dir ? p.in[7] : p.in[6]) + ((long)((b * 2 + l) * 4 + h)) * 8192 + (long)(16 * wid + l15) * 128 + vs0;
#pragma unroll
    for (int vt = 0; vt < 4; vt++) {
      float4 a = *(const float4*)(S0 + 16 * vt + 4 * g);
      st[vt] = (f32x4){a.x, a.y, a.z, a.w};
#pragma unroll
      for (int r = 0; r < 4; r++) St[(16 * vt + 4 * g + r) * LDT + 16 * wid + l15] = f2bf(st[vt][r]);
    }
  }
  u32x4 n_qe[2], n_kl[2], n_at[2], n_v[2];
  float n_el;
  auto prefetch = [&](int c) {
    const bfr* base = prep_base(p, b, h, dir, c) + (16 * wid + l15) * 64 + 8 * g;
#pragma unroll
    for (int kk = 0; kk < 2; kk++) {
      n_qe[kk] = *(const u32x4*)(base + kk * 32);
      n_kl[kk] = *(const u32x4*)(base + 4096 + kk * 32);
      n_at[kk] = *(const u32x4*)(base + 8192 + kk * 32);
    }
    n_el = EL[c * 64 + 16 * wid + l15];
#pragma unroll
    for (int ii = 0; ii < 2; ii++) {
      int cc = tid + 256 * ii;
      int i = cc >> 3, c8 = cc & 7;
      int tok = dir ? (N - 1 - (c * 64 + i)) : (c * 64 + i);
      n_v[ii] = *(const u32x4*)(Z + (long)(rowbase + tok) * ZLD + C_VG + h * 128 + vs0 + c8 * 8);
    }
  };
  prefetch(0);
  for (int c = 0; c < nc; c++) {
    u32x4 c_qe[2] = {n_qe[0], n_qe[1]}, c_kl[2] = {n_kl[0], n_kl[1]}, c_at[2] = {n_at[0], n_at[1]};
    const float el = n_el;
#pragma unroll
    for (int ii = 0; ii < 2; ii++) {
      int cc = tid + 256 * ii;
      int i = cc >> 3, c8 = cc & 7;
      const bfr* rb = (const bfr*)&n_v[ii];
#pragma unroll
      for (int e = 0; e < 8; e++) Vt[(c8 * 8 + e) * LDT + i] = rb[e];
    }
    __syncthreads();
    if (c + 1 < nc) prefetch(c + 1);
    f32x4 stn[4];
    const int i = 16 * wid + l15;
    const int tok = dir ? (N - 1 - (c * 64 + i)) : (c * 64 + i);
    bfr* og = OG + (long)(rowbase + tok) * 512 + h * 128 + vs0 + 4 * g;
#pragma unroll
    for (int vt = 0; vt < 4; vt++) {
      f32x4 oc = (f32x4){0.f, 0.f, 0.f, 0.f};
      stn[vt] = st[vt] * el;
#pragma unroll
      for (int kk = 0; kk < 2; kk++) {
        bf16x8 vf = *(const bf16x8*)(Vt + (16 * vt + l15) * LDT + kk * 32 + g * 8);
        bf16x8 sf = *(const bf16x8*)(St + (16 * vt + l15) * LDT + kk * 32 + g * 8);
        oc = mfma16(vf, *(bf16x8*)&c_at[kk], oc);
        oc = mfma16(sf, *(bf16x8*)&c_qe[kk], oc);
        stn[vt] = mfma16(vf, *(bf16x8*)&c_kl[kk], stn[vt]);
      }
      u32x2 ov;
      ov.x = pack2(oc[0], oc[1]);
      ov.y = pack2(oc[2], oc[3]);
      *(u32x2*)(og + 16 * vt) = ov;
    }
    __syncthreads();
#pragma unroll
    for (int vt = 0; vt < 4; vt++) {
      st[vt] = stn[vt];
#pragma unroll
      for (int r = 0; r < 4; r++) St[(16 * vt + 4 * g + r) * LDT + 16 * wid + l15] = f2bf(st[vt][r]);
    }
  }
  __syncthreads();
}

template <int VS>
__device__ __forceinline__ void gla_item(const Params& p, int l, int seq, int h, int dir, int vsl, bfr* sm) {
  constexpr int NVT = VS / 16;
  constexpr int NVL = VS / 32;
  const int tid = TIDX, lane = tid & 63, wid = tid >> 6, g = lane >> 4, l15 = lane & 15;
  bfr* Z = (bfr*)(p.ws + WS_Z);
  bfr* OG = (bfr*)(p.ws + WS_R1) + (long)dir * NROWS * 512;
  const bool lat = seq >= 16;
  const int b = seq - 16;
  const int N = lat ? 4096 : 256;
  const int rowbase = lat ? NCTX + b * 4096 : seq * 256;
  const int nc = N >> 6;
  const int vs0 = vsl * VS;
  bfr* Qr = sm;
  bfr* Kr = Qr + 64 * LDT;
  bfr* Qe = Kr + 64 * LDT;
  bfr* Ke = Qe + 64 * LDT;
  bfr* KlT = Ke + 64 * LDT;
  float* RF = (float*)(KlT + 64 * LDT);
  float* tot = RF + 64 * 16;
  float* lastv = tot + 256;
  bfr* Vt = (bfr*)(lastv + 64);
  bfr* St = Vt + VS * LDT;
  bfr* Att = Qr;
  const int ch = tid & 63;
  float wd[16];
  {
    const float* W = (dir ? p.in[19] : p.in[17]) + (long)l * 16 * 256 + h * 64 + ch;
#pragma unroll
    for (int r = 0; r < 16; r++) wd[r] = W[r * 256];
  }
  const float bias = (dir ? p.in[20] : p.in[18])[l * 256 + h * 64 + ch];

  f32x4 st[NVT];
  {
    const float* S0 = (dir ? p.in[7] : p.in[6]) + ((long)((b * 2 + l) * 4 + h)) * 8192 + (long)(16 * wid + l15) * 128 + vs0;
#pragma unroll
    for (int mv = 0; mv < NVT; mv++) {
      if (lat) {
        float4 a = *(const float4*)(S0 + 16 * mv + 4 * g);
        st[mv] = (f32x4){a.x, a.y, a.z, a.w};
      } else {
        st[mv] = (f32x4){0.f, 0.f, 0.f, 0.f};
      }
#pragma unroll
      for (int r = 0; r < 4; r++) St[(16 * mv + 4 * g + r) * LDT + 16 * wid + l15] = f2bf(st[mv][r]);
    }
  }
  u32x4 rq[2], rk[2], rv[NVL], rr;
  auto prefetch = [&](int c) {
#pragma unroll
    for (int ii = 0; ii < 2; ii++) {
      int cc = tid + 256 * ii;
      int i = cc >> 3, c8 = cc & 7;
      int tok = dir ? (N - 1 - (c * 64 + i)) : (c * 64 + i);
      const bfr* zr = Z + (long)(rowbase + tok) * ZLD;
      rq[ii] = *(const u32x4*)(zr + C_QG + h * 64 + c8 * 8);
      rk[ii] = *(const u32x4*)(zr + C_KG + h * 64 + c8 * 8);
    }
#pragma unroll
    for (int ii = 0; ii < NVL; ii++) {
      int cc = tid + 256 * ii;
      int i = cc / (VS / 8), c4 = cc % (VS / 8);
      int tok = dir ? (N - 1 - (c * 64 + i)) : (c * 64 + i);
      rv[ii] = *(const u32x4*)(Z + (long)(rowbase + tok) * ZLD + C_VG + h * 128 + vs0 + c4 * 8);
    }
    if (tid < 128) {
      int i = tid >> 1, hf = tid & 1;
      int tok = dir ? (N - 1 - (c * 64 + i)) : (c * 64 + i);
      rr = *(const u32x4*)(Z + (long)(rowbase + tok) * ZLD + (dir ? C_RB : C_RF) + hf * 8);
    }
  };
  prefetch(0);
  for (int c = 0; c < nc; c++) {
#pragma unroll
    for (int ii = 0; ii < 2; ii++) {
      int cc = tid + 256 * ii;
      *(u32x4*)(Qr + (cc >> 3) * LDT + (cc & 7) * 8) = rq[ii];
      *(u32x4*)(Kr + (cc >> 3) * LDT + (cc & 7) * 8) = rk[ii];
    }
#pragma unroll
    for (int ii = 0; ii < NVL; ii++) {
      int cc = tid + 256 * ii;
      int i = cc / (VS / 8), c4 = cc % (VS / 8);
      const bfr* rb = (const bfr*)&rv[ii];
#pragma unroll
      for (int e = 0; e < 8; e++) Vt[(c4 * 8 + e) * LDT + i] = rb[e];
    }
    if (tid < 128) {
      int i = tid >> 1, hf = tid & 1;
      float x[8];
      unpack8(rr, x);
#pragma unroll
      for (int e = 0; e < 8; e++) RF[i * 16 + hf * 8 + e] = x[e];
    }
    __syncthreads();
    if (c + 1 < nc) prefetch(c + 1);
    gla_chunk_prep(tid, wd, bias, Qr, Kr, Qe, Ke, KlT, RF, tot, lastv);
    f32x4 stn[NVT];
    {
      float el = __expf(lastv[16 * wid + l15]);
#pragma unroll
      for (int mv = 0; mv < NVT; mv++) {
        stn[mv] = st[mv] * el;
#pragma unroll
        for (int kk = 0; kk < 2; kk++) {
          bf16x8 va = *(const bf16x8*)(Vt + (16 * mv + l15) * LDT + kk * 32 + g * 8);
          bf16x8 kb = *(const bf16x8*)(KlT + (16 * wid + l15) * LDT + kk * 32 + g * 8);
          stn[mv] = mfma16(va, kb, stn[mv]);
        }
      }
      gla_att(wid, g, l15, Qe, Ke, Att);
    }
    __syncthreads();
    {
      bf16x8 aa[2], qa[2];
#pragma unroll
      for (int kk = 0; kk < 2; kk++) {
        aa[kk] = *(const bf16x8*)(Att + (16 * wid + l15) * LDT + kk * 32 + g * 8);
        qa[kk] = *(const bf16x8*)(Qe + (16 * wid + l15) * LDT + kk * 32 + g * 8);
      }
#pragma unroll
      for (int nv = 0; nv < NVT; nv++) {
        f32x4 oc = (f32x4){0.f, 0.f, 0.f, 0.f};
#pragma unroll
        for (int kk = 0; kk < 2; kk++) {
          bf16x8 vb = *(const bf16x8*)(Vt + (16 * nv + l15) * LDT + kk * 32 + g * 8);
          oc = mfma16(aa[kk], vb, oc);
          bf16x8 sb = *(const bf16x8*)(St + (16 * nv + l15) * LDT + kk * 32 + g * 8);
          oc = mfma16(qa[kk], sb, oc);
        }
#pragma unroll
        for (int r = 0; r < 4; r++) {
          int i = 16 * wid + 4 * g + r;
          int tok = dir ? (N - 1 - (c * 64 + i)) : (c * 64 + i);
          OG[(long)(rowbase + tok) * 512 + h * 128 + vs0 + 16 * nv + l15] = f2bf(oc[r]);
        }
      }
    }
    __syncthreads();
#pragma unroll
    for (int mv = 0; mv < NVT; mv++) {
      st[mv] = stn[mv];
#pragma unroll
      for (int r = 0; r < 4; r++) St[(16 * mv + 4 * g + r) * LDT + 16 * wid + l15] = f2bf(st[mv][r]);
    }
  }
  __syncthreads();
  if (!lat) {
    float* so = p.out + (dir ? O_SB : O_SF) + ((long)((seq * 2 + l) * 4 + h)) * 8192 + (long)(16 * wid + l15) * 128 + vs0;
#pragma unroll
    for (int mv = 0; mv < NVT; mv++)
      *(float4*)(so + 16 * mv + 4 * g) = make_float4(st[mv][0], st[mv][1], st[mv][2], st[mv][3]);
  }
}

__device__ __forceinline__ void phase_mla_up(const Params& p, int l, bfr* sm) {
  bfr* Z = (bfr*)(p.ws + WS_Z);
  const float* rope = (const float*)(p.ws + WS_ROPE);
  const int lane = TIDX & 63, wid = TIDX >> 6, wr = wid >> 1, wc = wid & 1;
  const int g = lane >> 4;
  for (int t = blockIdx.x; t < 288 + 624 + 1024; t += gridDim.x) {
    if (t >= 912) {
      int i = t - 912;
      gla_prep_item(p, l, i >> 9, (i >> 7) & 3, (i >> 6) & 1, i & 63, sm);
      continue;
    }
    f32x4 acc[4][4];
#pragma unroll
    for (int a = 0; a < 4; a++)
#pragma unroll
      for (int b = 0; b < 4; b++) acc[a][b] = (f32x4){0.f, 0.f, 0.f, 0.f};
    if (t < 288) {
      int tn = t % 3, tm = t / 3;
      gemm128((const bfr*)(p.ws + WS_WUQ) + (long)tn * 128 * 256, 256, 128, Z + (long)tm * 128 * ZLD + C_QL, ZLD, 128, 256,
              acc, sm);
      bfr* CQ = (bfr*)(p.ws + WS_CQ);
      const float qs = 0.10206207261596577f * 1.4426950408889634f;
#pragma unroll
      for (int pi = 0; pi < 4; pi++) {
        int nb = tn * 128 + wr * 64 + pi * 16;
        int wb = nb % 96;
        bool ropet = wb >= 64;
        int part = (wb - 64) >> 4;
#pragma unroll
        for (int qi = 0; qi < 4; qi++) {
          int tok = tm * 128 + wc * 64 + qi * 16 + (lane & 15);
          float y[4] = {acc[pi][qi][0], acc[pi][qi][1], acc[pi][qi][2], acc[pi][qi][3]};
          if (ropet) {
            bool lat = tok >= NCTX;
            int tl = (tok - NCTX) & 4095;
            int pos = part ? (tl & 63) : (tl >> 6);
            bool hi = (g & 2) != 0;
            int i0 = (g & 1) * 4;
#pragma unroll
            for (int r = 0; r < 4; r++) {
              float yp = __shfl_xor(y[r], 32);
              float c = rope[2048 + pos * 8 + i0 + r], s = rope[2560 + pos * 8 + i0 + r];
              float yr = hi ? (yp * s + y[r] * c) : (y[r] * c - yp * s);
              y[r] = lat ? yr : y[r];
            }
          }
          u32x2 o;
          o.x = pack2(y[0] * qs, y[1] * qs);
          o.y = pack2(y[2] * qs, y[3] * qs);
          *(u32x2*)(CQ + (long)tok * 384 + nb + g * 4) = o;
        }
      }
    } else {
      int t2 = t - 288;
      int tn = t2 % 6, tm = t2 / 6;
      const bfr* Q;
      long ldq;
      long kbase, vbase;
      int nk, key0;
      if (tm < 32) {
        Q = Z + (long)tm * 128 * ZLD + C_KV;
        ldq = ZLD;
        int s = tm >> 1;
        key0 = (tm & 1) * 128;
        nk = 256;
        kbase = (long)s * (4 * 256 * 64);
        vbase = (long)s * 131072;
      } else {
        int r = (tm - 32) * 128;
        int b = r / 4608, within = r % 4608;
        key0 = within;
        nk = 4608;
        kbase = 16l * (4 * 256 * 64) + (long)b * (4 * 4608 * 64);
        vbase = 16l * 131072 + (long)b * (4 * 128 * 4608);
        if (within < 512) {
          Q = (const bfr*)(p.ws + WS_CKVC) + (long)(b * 512 + within) * 256;
          ldq = 256;
        } else {
          Q = Z + (long)(NCTX + b * 4096 + within - 512) * ZLD + C_KV;
          ldq = ZLD;
        }
      }
      gemm128((const bfr*)(p.ws + WS_WUKV) + (long)tn * 128 * 256, 256, 128, Q, ldq, 128, 256, acc, sm);
      bfr* KN = (bfr*)(p.ws + WS_KNOPE);
      bfr* VTC = (bfr*)(p.ws + WS_VTC);
#pragma unroll
      for (int pi = 0; pi < 4; pi++) {
        int n0 = tn * 128 + wr * 64 + pi * 16 + g * 4;
        int head = n0 / 192, w = n0 % 192;
#pragma unroll
        for (int qi = 0; qi < 4; qi++) {
          int key = key0 + wc * 64 + qi * 16 + (lane & 15);
          if (w < 64) {
            u32x2 o;
            o.x = pack2(acc[pi][qi][0], acc[pi][qi][1]);
            o.y = pack2(acc[pi][qi][2], acc[pi][qi][3]);
            *(u32x2*)(KN + kbase + ((long)head * nk + key) * 64 + w) = o;
          } else {
#pragma unroll
            for (int r = 0; r < 4; r++)
              VTC[vbase + ((long)head * 128 + (w - 64) + r) * nk + key] = f2bf(acc[pi][qi][r]);
          }
        }
      }
    }
  }
}

template <int DQ, int DV, bool MLA, int NQB>
__device__ __forceinline__ void attn_item(const Params& p, int seq, int head, int qoff, bfr* sm, int dry, int amode = 0) {
  constexpr int KLD = DQ + 8;
  constexpr int KSZ = 64 * KLD;
  constexpr int VSZ = DV * LDT;
  constexpr int BUF = KSZ + VSZ;
  constexpr int NKK = DQ / 32;
  constexpr int NDV = DV / 16;
  constexpr int NVL = DV / 32;
  const int tid = TIDX, lane = tid & 63, wid = tid >> 6, g = lane >> 4, l15 = lane & 15;
  bfr* Z = (bfr*)(p.ws + WS_Z);
  const bool lat = seq >= 16;
  const int b = seq - 16;
  const int nk = lat ? 4608 : 256;
  const int rowbase = lat ? NCTX + b * 4096 : seq * 256;
  const int nkt = nk >> 6;

  bf16x8 qf[NQB][NKK];
#pragma unroll
  for (int qb = 0; qb < NQB; qb++) {
    int qrow = rowbase + qoff + wid * (16 * NQB) + qb * 16 + l15;
    const bfr* qp = MLA ? ((const bfr*)(p.ws + WS_CQ) + (long)qrow * 384 + head * 96) : (Z + (long)qrow * ZLD + C_QA + head * 64);
#pragma unroll
    for (int kk = 0; kk < NKK; kk++) qf[qb][kk] = *(const bf16x8*)(qp + kk * 32 + g * 8);
  }

  u32x4 rk[2], rkr, rv[NVL];
  auto prefetch = [&](int kt) {
    int k0 = kt * 64;
    bool cache = lat && (k0 < 512);
    int tokrow0 = lat ? (NCTX + b * 4096 + k0 - 512) : (seq * 256 + k0);
    if (!MLA) {
      int kvh = head >> 2;
#pragma unroll
      for (int i = 0; i < 2; i++) {
        int c = tid + 256 * i;
        int kr_ = c >> 3, ch = c & 7;
        const bfr* src = cache ? ((const bfr*)(p.ws + WS_KCA) + (long)(b * 512 + k0 + kr_) * 128 + kvh * 64 + ch * 8)
                               : (Z + (long)(tokrow0 + kr_) * ZLD + C_KA + kvh * 64 + ch * 8);
        rk[i] = *(const u32x4*)src;
      }
      long vb = lat ? (16l * 32768 + (long)b * (2 * 64 * 4608)) : ((long)seq * 32768);
#pragma unroll
      for (int i = 0; i < NVL; i++) {
        int c = tid + 256 * i;
        int dv = c >> 3, ch = c & 7;
        rv[i] = *(const u32x4*)((const bfr*)(p.ws + WS_VTA) + vb + (long)(kvh * 64 + dv) * nk + k0 + ch * 8);
      }
    } else {
      long kb = lat ? (16l * (4 * 256 * 64) + (long)b * (4 * 4608 * 64)) : ((long)seq * (4 * 256 * 64));
#pragma unroll
      for (int i = 0; i < 2; i++) {
        int c = tid + 256 * i;
        int kr_ = c >> 3, ch = c & 7;
        rk[i] = *(const u32x4*)((const bfr*)(p.ws + WS_KNOPE) + kb + ((long)head * nk + k0 + kr_) * 64 + ch * 8);
      }
      {
        int kr_ = tid >> 2, ch = tid & 3;
        const bfr* src = cache ? ((const bfr*)(p.ws + WS_KRC) + (long)(b * 512 + k0 + kr_) * 32 + ch * 8)
                               : (Z + (long)(tokrow0 + kr_) * ZLD + C_KR + ch * 8);
        rkr = *(const u32x4*)src;
      }
      long vb = lat ? (16l * 131072 + (long)b * (4 * 128 * 4608)) : ((long)seq * 131072);
#pragma unroll
      for (int i = 0; i < NVL; i++) {
        int c = tid + 256 * i;
        int dv = c >> 3, ch = c & 7;
        rv[i] = *(const u32x4*)((const bfr*)(p.ws + WS_VTC) + vb + (long)(head * 128 + dv) * nk + k0 + ch * 8);
      }
    }
  };

  f32x4 o[NQB][NDV];
#pragma unroll
  for (int qb = 0; qb < NQB; qb++)
#pragma unroll
    for (int d = 0; d < NDV; d++) o[qb][d] = (f32x4){0.f, 0.f, 0.f, 0.f};
  float mrun[NQB];
  f32x4 lacc[NQB];
#pragma unroll
  for (int qb = 0; qb < NQB; qb++) { mrun[qb] = 0.f; lacc[qb] = (f32x4){0.f, 0.f, 0.f, 0.f}; }
  const bf16x8 ones = (bf16x8){(short)0x3F80, (short)0x3F80, (short)0x3F80, (short)0x3F80, (short)0x3F80, (short)0x3F80, (short)0x3F80, (short)0x3F80};

  prefetch(0);
  for (int kt = 0; kt < nkt; kt++) {
    bfr* Ks = sm + (kt & 1) * BUF;
    bfr* Vs = Ks + KSZ;
    if (amode != 1) {
#pragma unroll
    for (int i = 0; i < 2; i++) {
      int c = tid + 256 * i;
      *(u32x4*)(Ks + (c >> 3) * KLD + (c & 7) * 8) = rk[i];
    }
    if (MLA) *(u32x4*)(Ks + (tid >> 2) * KLD + 64 + (tid & 3) * 8) = rkr;
#pragma unroll
    for (int i = 0; i < NVL; i++) {
      int c = tid + 256 * i;
      *(u32x4*)(Vs + (c >> 3) * LDT + (c & 7) * 8) = rv[i];
    }
    }
    __syncthreads();
    if (kt + 1 < nkt && amode != 1) prefetch(kt + 1);
    if (amode == 2) continue;

    f32x4 s[NQB][4];
    bf16x8 kfr[4][NKK];
#pragma unroll
    for (int t = 0; t < 2; t++) {
      int krow = 32 * (t >> 1) + 8 * (l15 >> 2) + 4 * (t & 1) + (l15 & 3);
#pragma unroll
      for (int kk = 0; kk < NKK; kk++) kfr[t][kk] = *(const bf16x8*)(Ks + krow * KLD + kk * 32 + g * 8);
    }
#pragma unroll
    for (int t = 0; t < 4; t++) {
#pragma unroll
      for (int qb = 0; qb < NQB; qb++) s[qb][t] = (f32x4){-mrun[qb], -mrun[qb], -mrun[qb], -mrun[qb]};
      if (t + 2 < 4) {
        int krow = 32 * ((t + 2) >> 1) + 8 * (l15 >> 2) + 4 * ((t + 2) & 1) + (l15 & 3);
#pragma unroll
        for (int kk = 0; kk < NKK; kk++) kfr[t + 2][kk] = *(const bf16x8*)(Ks + krow * KLD + kk * 32 + g * 8);
      }
#pragma unroll
      for (int kk = 0; kk < NKK; kk++) {
#pragma unroll
        for (int qb = 0; qb < NQB; qb++) s[qb][t] = mfma16(kfr[t][kk], qf[qb][kk], s[qb][t]);
      }
    }
    bf16x8 vfr[4][2];
#pragma unroll
    for (int d = 0; d < 4; d++)
#pragma unroll
      for (int sx = 0; sx < 2; sx++) vfr[d][sx] = *(const bf16x8*)(Vs + (d * 16 + l15) * LDT + sx * 32 + g * 8);
    bf16x8 pf[NQB][2];
#pragma unroll
    for (int qb = 0; qb < NQB; qb++) {
      float mt = s[qb][0][0];
#pragma unroll
      for (int t = 0; t < 4; t++)
#pragma unroll
        for (int r = 0; r < 4; r++) mt = fmaxf(mt, s[qb][t][r]);
      const bool first = (kt == 0);
      if (first || __builtin_amdgcn_ballot_w64(mt > 8.f) != 0ull) {
        mt = fmaxf(mt, __shfl_xor(mt, 16));
        mt = fmaxf(mt, __shfl_xor(mt, 32));
        const bool need = first || mt > 8.f;
        const float dm = need ? mt : 0.f;
        const float alpha = first ? 1.f : __builtin_amdgcn_exp2f(-dm);
        mrun[qb] += dm;
        lacc[qb] *= alpha;
#pragma unroll
        for (int d = 0; d < NDV; d++) o[qb][d] *= alpha;
#pragma unroll
        for (int t = 0; t < 4; t++) s[qb][t] -= dm;
      }
#pragma unroll
      for (int t = 0; t < 4; t++)
#pragma unroll
        for (int r = 0; r < 4; r++) s[qb][t][r] = __builtin_amdgcn_exp2f(s[qb][t][r]);
#pragma unroll
      for (int sx = 0; sx < 2; sx++) {
        u32x4 u;
        u.x = pack2(s[qb][2 * sx][0], s[qb][2 * sx][1]);
        u.y = pack2(s[qb][2 * sx][2], s[qb][2 * sx][3]);
        u.z = pack2(s[qb][2 * sx + 1][0], s[qb][2 * sx + 1][1]);
        u.w = pack2(s[qb][2 * sx + 1][2], s[qb][2 * sx + 1][3]);
        pf[qb][sx] = *(bf16x8*)&u;
      }
    }
#pragma unroll
    for (int d = 0; d < NDV; d++) {
#pragma unroll
      for (int sx = 0; sx < 2; sx++) {
#pragma unroll
        for (int qb = 0; qb < NQB; qb++) o[qb][d] = mfma16(vfr[d & 3][sx], pf[qb][sx], o[qb][d]);
      }
      if (d + 4 < NDV) {
#pragma unroll
        for (int sx = 0; sx < 2; sx++)
          vfr[d & 3][sx] = *(const bf16x8*)(Vs + ((d + 4) * 16 + l15) * LDT + sx * 32 + g * 8);
      }
    }
#pragma unroll
    for (int sx = 0; sx < 2; sx++) {
#pragma unroll
      for (int qb = 0; qb < NQB; qb++) lacc[qb] = mfma16(ones, pf[qb][sx], lacc[qb]);
    }
  }
  __syncthreads();
#pragma unroll
  for (int qb = 0; qb < NQB; qb++) {
    float inv = 1.f / lacc[qb][0];
    int qrow = rowbase + qoff + wid * (16 * NQB) + qb * 16 + l15;
    bfr* gp = Z + (long)qrow * ZLD + (MLA ? C_GC : C_GA) + head * DV + g * 4;
#pragma unroll
    for (int d = 0; d < NDV; d++) {
      u32x2 gr = *(const u32x2*)(gp + d * 16);
      float y0 = o[qb][d][0] * inv * siluf(lo16(gr.x));
      float y1 = o[qb][d][1] * inv * siluf(hi16(gr.x));
      float y2 = o[qb][d][2] * inv * siluf(lo16(gr.y));
      float y3 = o[qb][d][3] * inv * siluf(hi16(gr.y));
      u32x2 ov;
      ov.x = pack2(y0, y1);
      ov.y = pack2(y2, y3);
      if (!dry) *(u32x2*)(gp + d * 16) = ov;
    }
  }
}

__device__ __forceinline__ void phase_mixers(const Params& p, int l, bfr* sm, int* s_item, int dry) {
  unsigned* ctr = (unsigned*)(p.ws + WS_CTR) + (2 + l + 2 * dry) * 128;
  auto cnt = [](int) { return 184; };
  int q = (int)xcc_id(), tried = 0;
  for (;;) {
    if (TIDX == 0) {
      unsigned first = atomicAdd(ctr + q * 16, 1u);
      *s_item = xq_take(ctr, q, tried, first, cnt);
    }
    __syncthreads();
    const int it = *s_item;
    __syncthreads();
    if (it < 0) break;
    const int x = it >> 20, j = it & 0xfffff;
    int kind, a0, a1, a2, a3 = 0;
    if (j < 4) {
      int idx = x * 4 + j;
      kind = 3; a0 = idx >> 4; a1 = (idx >> 2) & 3; a2 = (idx >> 1) & 1; a3 = idx & 1;
    } else if (j < 36) {
      kind = 1; a0 = 16 + (x >> 2); a1 = x & 3; a2 = (j - 4) * 128;
    } else if (j < 96) {
      int i = j - 36;
      kind = 2; a0 = 16 + (x >> 2); a1 = ((x >> 1) & 1) * 4 + (x & 1) * 2 + (i >> 5); a2 = (i & 31) * 128;
    } else if (j < 104) {
      int k = j - 96;
      int i = 60 + (k >> 1);
      kind = 4; a0 = 16 + (x >> 2); a1 = ((x >> 1) & 1) * 4 + (x & 1) * 2 + (i >> 5); a2 = (i & 31) * 128 + (k & 1) * 64;
    } else if (j < 136) {
      int i = j - 104;
      kind = 0; a0 = 2 * x + (i >> 4); a1 = (i >> 2) & 3; a2 = (i >> 1) & 1; a3 = i & 1;
    } else if (j < 152) {
      int i = j - 136;
      kind = 1; a0 = 2 * x + (i >> 3); a1 = (i >> 1) & 3; a2 = (i & 1) * 128;
    } else {
      int i = j - 152;
      kind = 2; a0 = 2 * x + (i >> 4); a1 = (i >> 1) & 7; a2 = (i & 1) * 128;
    }
#ifdef PROBE_MIXKIND
    if (dry && ((PROBE_MIXKIND == 1) != (kind == 0 || kind == 3))) continue;
#endif
    if (kind == 0) gla_item<64>(p, l, a0, a1, a2, a3, sm);
    else if (kind == 3) gla_chain_item(p, l, a0, a1, a2, a3, sm);
    else if (kind == 1) attn_item<96, 128, true, 2>(p, a0, a1, a2, sm, dry);
    else if (kind == 2) attn_item<64, 64, false, 2>(p, a0, a1, a2, sm, dry);
    else attn_item<64, 64, false, 1>(p, a0, a1, a2, sm, dry);
  }
}

__device__ __forceinline__ void phase_gla_out(const Params& p, int l) {
  const int lane = TIDX & 63;
  bfr* Z = (bfr*)(p.ws + WS_Z);
  const bfr* OF = (const bfr*)(p.ws + WS_R1);
  const bfr* OB = OF + (long)NROWS * 512;
  for (int row = blockIdx.x * 4 + (TIDX >> 6); row < NROWS; row += gridDim.x * 4) {
    float a[8], c[8], gt[8];
    unpack8(*(const u32x4*)(OF + (long)row * 512 + lane * 8), a);
    unpack8(*(const u32x4*)(OB + (long)row * 512 + lane * 8), c);
    bfr* gp = Z + (long)row * ZLD + C_GG + lane * 8;
    unpack8(*(const u32x4*)gp, gt);
    float ss = 0.f;
#pragma unroll
    for (int e = 0; e < 8; e++) {
      a[e] = bf2f(f2bf(a[e] + c[e]));
      ss += a[e] * a[e];
    }
    ss += __shfl_xor(ss, 1); ss += __shfl_xor(ss, 2); ss += __shfl_xor(ss, 4); ss += __shfl_xor(ss, 8);
    float rs = rsqrtf(ss * (1.f / 128.f) + 1e-6f);
    const float* gg = p.in[21] + l * 128 + (lane & 15) * 8;
#pragma unroll
    for (int e = 0; e < 8; e++) a[e] = a[e] * rs * gg[e] * siluf(gt[e]);
    *(u32x4*)gp = pack8(a);
  }
}

template <int NQ>
__device__ __forceinline__ void merge_tile(const Params& p, bfr* sm, int tn, int tok0) {
  bfr* Z = (bfr*)(p.ws + WS_Z);
  bfr* MG = (bfr*)(p.ws + WS_R1);
  const int lane = TIDX & 63, wid = TIDX >> 6, wr = wid >> 1, wc = wid & 1, g = lane >> 4;
  f32x4 totl[4][NQ];
#pragma unroll
  for (int a = 0; a < 4; a++)
#pragma unroll
    for (int b = 0; b < NQ; b++) totl[a][b] = (f32x4){0.f, 0.f, 0.f, 0.f};
#pragma unroll 1
  for (int seg = 0; seg < 3; seg++) {
    f32x4 acc[4][NQ];
#pragma unroll
    for (int a = 0; a < 4; a++)
#pragma unroll
      for (int b = 0; b < NQ; b++) acc[a][b] = (f32x4){0.f, 0.f, 0.f, 0.f};
    int ycol = seg == 0 ? C_GA : (seg == 1 ? C_GG : C_GC);
    int mcol = C_M1 + seg * 1024;
    const bfr* W = (const bfr*)(p.ws + WS_WOA + (unsigned long)seg * 1048576ul) + (long)tn * 128 * 512;
    gemm128q<NQ>(W, 512, Z + (long)tok0 * ZLD + ycol, ZLD, 512, acc, sm);
#pragma unroll
    for (int pi = 0; pi < 4; pi++) {
      int n0 = tn * 128 + wr * 64 + pi * 16 + g * 4;
#pragma unroll
      for (int qi = 0; qi < NQ; qi++) {
        int tok = tok0 + wc * 16 * NQ + qi * 16 + (lane & 15);
        u32x2 mr = *(const u32x2*)(Z + (long)tok * ZLD + mcol + n0);
        totl[pi][qi][0] += sigmf(lo16(mr.x)) * acc[pi][qi][0];
        totl[pi][qi][1] += sigmf(hi16(mr.x)) * acc[pi][qi][1];
        totl[pi][qi][2] += sigmf(lo16(mr.y)) * acc[pi][qi][2];
        totl[pi][qi][3] += sigmf(hi16(mr.y)) * acc[pi][qi][3];
      }
    }
  }
#pragma unroll
  for (int pi = 0; pi < 4; pi++) {
    int n0 = tn * 128 + wr * 64 + pi * 16 + g * 4;
#pragma unroll
    for (int qi = 0; qi < NQ; qi++) {
      int tok = tok0 + wc * 16 * NQ + qi * 16 + (lane & 15);
      u32x2 o;
      o.x = pack2(totl[pi][qi][0], totl[pi][qi][1]);
      o.y = pack2(totl[pi][qi][2], totl[pi][qi][3]);
      *(u32x2*)(MG + (long)tok * 1024 + n0) = o;
    }
  }
}

__device__ __forceinline__ void phase_merge(const Params& p, bfr* sm) {
  for (int t = blockIdx.x; t < 1024; t += gridDim.x) {
    if (t < 512) {
      merge_tile<4>(p, sm, t & 7, (t >> 3) * 128);
    } else {
      int u = t - 512;
      int full = 512 + (u >> 1);
      merge_tile<2>(p, sm, full & 7, (full >> 3) * 128 + (u & 1) * 64);
    }
  }
}

template <int NQ>
__device__ __forceinline__ void outproj_tile(const Params& p, bfr* sm, int tn, int tok0) {
  const bfr* MG = (const bfr*)(p.ws + WS_R1);
  float* OUT = (float*)(p.ws + WS_Z);
  const int lane = TIDX & 63, wid = TIDX >> 6, wr = wid >> 1, wc = wid & 1, g = lane >> 4;
  f32x4 acc[4][NQ];
#pragma unroll
  for (int a = 0; a < 4; a++)
#pragma unroll
    for (int b = 0; b < NQ; b++) acc[a][b] = (f32x4){0.f, 0.f, 0.f, 0.f};
  gemm128q<NQ>((const bfr*)(p.ws + WS_WOUT) + (long)tn * 128 * 1024, 1024, MG + (long)tok0 * 1024, 1024, 1024, acc, sm);
#pragma unroll
  for (int pi = 0; pi < 4; pi++) {
    int n0 = tn * 128 + wr * 64 + pi * 16 + g * 4;
#pragma unroll
    for (int qi = 0; qi < NQ; qi++) {
      int tok = tok0 + wc * 16 * NQ + qi * 16 + (lane & 15);
      *(float4*)(OUT + (long)tok * 1024 + n0) = make_float4(acc[pi][qi][0], acc[pi][qi][1], acc[pi][qi][2], acc[pi][qi][3]);
    }
  }
}
__device__ __forceinline__ void phase_outproj(const Params& p, bfr* sm) {
  for (int t = blockIdx.x; t < 1024; t += gridDim.x) {
    if (t < 512) {
      outproj_tile<4>(p, sm, t & 7, (t >> 3) * 128);
    } else {
      int u = t - 512;
      int full = 512 + (u >> 1);
      outproj_tile<2>(p, sm, full & 7, (full >> 3) * 128 + (u & 1) * 64);
    }
  }
}

__device__ __forceinline__ void phase_post(const Params& p, int l) {
  const int lane = TIDX & 63;
  const float* mod = (const float*)(p.ws + WS_MOD);
  const float* OUT = (const float*)(p.ws + WS_Z);
  bfr* H = (bfr*)(p.ws + WS_R1);
  for (int row = blockIdx.x * 4 + (TIDX >> 6); row < NROWS; row += gridDim.x * 4) {
    const float* x = (l == 0) ? xrow(p, row) : (p.out + (long)row * 1024);
    const float* md = mod + (l * 3 + row_cond(row)) * 3072;
    float4 v[4];
    float ss = 0.f;
#pragma unroll
    for (int i = 0; i < 4; i++) {
      v[i] = *(const float4*)(OUT + (long)row * 1024 + i * 256 + lane * 4);
      ss += v[i].x * v[i].x + v[i].y * v[i].y + v[i].z * v[i].z + v[i].w * v[i].w;
    }
    ss = wave_sum(ss);
    float rs = rsqrtf(ss * (1.f / 1024.f) + 1e-6f);
    float ss2 = 0.f;
#pragma unroll
    for (int i = 0; i < 4; i++) {
      int n = i * 256 + lane * 4;
      float4 g = *(const float4*)(p.in[13] + l * 1024 + n);
      float4 gt = *(const float4*)(md + 2048 + n);
      float4 xv = *(const float4*)(x + n);
      v[i].x = xv.x + gt.x * (v[i].x * rs * g.x);
      v[i].y = xv.y + gt.y * (v[i].y * rs * g.y);
      v[i].z = xv.z + gt.z * (v[i].z * rs * g.z);
      v[i].w = xv.w + gt.w * (v[i].w * rs * g.w);
      *(float4*)(p.out + (long)row * 1024 + n) = v[i];
      ss2 += v[i].x * v[i].x + v[i].y * v[i].y + v[i].z * v[i].z + v[i].w * v[i].w;
    }
    if (l == 0) {
      ss2 = wave_sum(ss2);
      float rs2 = rsqrtf(ss2 * (1.f / 1024.f) + 1e-6f);
      const float* md1 = mod + (1 * 3 + row_cond(row)) * 3072;
#pragma unroll
      for (int i = 0; i < 4; i++) {
        int n = i * 256 + lane * 4;
        float4 g = *(const float4*)(p.in[12] + 1024 + n);
        float4 sh = *(const float4*)(md1 + n);
        float4 sc = *(const float4*)(md1 + 1024 + n);
        float h0 = v[i].x * rs2 * g.x * (1.f + sc.x) + sh.x;
        float h1 = v[i].y * rs2 * g.y * (1.f + sc.y) + sh.y;
        float h2 = v[i].z * rs2 * g.z * (1.f + sc.z) + sh.z;
        float h3 = v[i].w * rs2 * g.w * (1.f + sc.w) + sh.w;
        u32x2 o;
        o.x = pack2(h0, h1);
        o.y = pack2(h2, h3);
        *(u32x2*)(H + (long)row * 1024 + n) = o;
      }
    }
  }
}

__global__ void __launch_bounds__(256, 2) fwd_megakernel(Params p) {
  __shared__ __attribute__((aligned(16))) bfr sm[SMEM_SHORTS + 16];
  int* s_item_p = (int*)(sm + SMEM_SHORTS + 8);
  cg::grid_group grid = cg::this_grid();
  if (threadIdx.x == 0) { ((unsigned*)(sm + SMEM_SHORTS))[0] = 0u; ((unsigned*)(sm + SMEM_SHORTS))[1] = 0u; }
  __syncthreads();
  XcdBarrier xb = xcd_barrier_post((unsigned*)(p.ws + WS_BAR), (volatile LAS unsigned*)(sm + SMEM_SHORTS));
  if (p.ws == nullptr) grid.sync();
  (void)xb;
#define GSYNC1 do { XcdBarrier b_; b_.bar = (unsigned*)(p.ws + WS_BAR); b_.x = xb_xcc_id(); \
                    b_.st = (volatile LAS unsigned*)(sm + SMEM_SHORTS); xcd_barrier(b_); } while (0)
#ifdef PROBE_SYNC
#define GSYNC do { GSYNC1; GSYNC1; } while (0)
#else
#define GSYNC GSYNC1
#endif
#ifdef PROBE_PRE
  phase_s0(launder(p), sm);
  GSYNC;
  phase_s1(launder(p));
  wconv_phase(p, 0, sm);
  GSYNC;
  phase_prenorm0(launder(p));
  GSYNC;
#endif

#ifndef PH
#define PH 0xffff
#endif
#if PH & 1
  phase_s0(launder(p), sm);
#endif
  GSYNC;
#if PH & 2
  phase_s1(launder(p));
  wconv_phase(p, 0, sm);
#endif
  GSYNC;
#if PH & 4
  phase_prenorm0(launder(p));
#endif
  GSYNC;
  for (int l = 0; l < 2; l++) {
#if PH & 8
#ifdef PROBE_INPROJ
    phase_inproj(launder(p), l, sm, s_item_p, 6 + l);
    GSYNC;
#endif
    phase_inproj(launder(p), l, sm, s_item_p, l);
#endif
    GSYNC;
#if PH & 16
    phase_rowpost(launder(p), l);
#endif
    GSYNC;
#if PH & 32
#ifdef PROBE_MLAUP
    phase_mla_up(launder(p), l, sm);
    GSYNC;
#endif
    phase_mla_up(launder(p), l, sm);
#endif
    GSYNC;
#if PH & 64
#ifdef PROBE_MIX
    { int dry = 1; asm volatile("" : "+s"(dry)); phase_mixers(launder(p), l, sm, s_item_p, dry); }
    GSYNC;
#endif
    { int dry = 0; asm volatile("" : "+s"(dry)); phase_mixers(launder(p), l, sm, s_item_p, dry); }
#endif
    GSYNC;
#if PH & 128
    phase_gla_out(launder(p), l);
#endif
    GSYNC;
#if PH & 256
#ifdef PROBE_MERGE
    phase_merge(launder(p), sm);
    GSYNC;
#endif
    phase_merge(launder(p), sm);
#endif
    GSYNC;
#if PH & 512
#ifdef PROBE_MERGE
    phase_outproj(launder(p), sm);
    GSYNC;
#endif
    phase_outproj(launder(p), sm);
#endif
    GSYNC;
#if PH & 1024
    phase_post(launder(p), l);
    if (l == 0) wconv_phase(p, 1, sm);
#endif
    GSYNC;
  }
}

extern "C" void kernel_launch(void* const* d_in, const int* in_sizes, int n_in, void* d_out, int out_size, void* d_ws,
                              size_t ws_size, hipStream_t stream) {
  static int grid_blocks = 0;
  if (!grid_blocks) {
    int dev = 0, cus = 0, per_cu = 0;
    hipGetDevice(&dev);
    hipDeviceGetAttribute(&cus, hipDeviceAttributeMultiprocessorCount, dev);
    hipOccupancyMaxActiveBlocksPerMultiprocessor(&per_cu, fwd_megakernel, 256, 0);
    if (per_cu > 2) per_cu = 2;
    if (per_cu < 1) per_cu = 1;
    grid_blocks = cus * per_cu;
  }
  Params p{};
  for (int i = 0; i < 30; i++) p.in[i] = (const float*)d_in[i];
  p.out = (float*)d_out;
  p.ws = (unsigned char*)d_ws;
  hipMemsetAsync(d_ws, 0, 20480, stream);
  void* args[] = {&p};
  hipError_t e = hipLaunchCooperativeKernel((void*)fwd_megakernel, dim3(grid_blocks), dim3(256), args, 0, stream);
  if (e != hipSuccess) fprintf(stderr, "cooperative launch failed: %s (grid %d)\n", hipGetErrorString(e), grid_blocks);
}
```

```cpp
#include <hip/hip_runtime.h>
#include <hip/hip_cooperative_groups.h>
#include <cstdio>
namespace cg = cooperative_groups;

typedef unsigned short bfr;
typedef __attribute__((ext_vector_type(8))) short bf16x8;
typedef __attribute__((ext_vector_type(4))) float f32x4;
typedef __attribute__((ext_vector_type(4))) unsigned u32x4;
typedef __attribute__((ext_vector_type(2))) unsigned u32x2;

#define NROWS 12288
#define NCTX 4096
#define ZLD 6976
#define LDT 72
#define SMEM_SHORTS (4 * 128 * LDT)

#define C_QA 0
#define C_KA 512
#define C_VA 640
#define C_GA 768
#define C_QG 1280
#define C_KG 1536
#define C_VG 1792
#define C_GG 2304
#define C_RF 2816
#define C_RB 2832
#define C_QL 2848
#define C_KV 3104
#define C_KR 3360
#define C_GC 3392
#define C_M1 3904
#define C_M2 4928
#define C_M3 5952

#define WS_BAR 0ul
#define WS_CTR 16384ul
#define WS_MODP 20480ul
#define WS_MOD (WS_MODP + 589824ul)
#define WS_ROPE (WS_MOD + 73728ul)
#define WS_WIN (WS_ROPE + 16384ul)
#define WS_WUQ (WS_WIN + 14417920ul)
#define WS_WUKV (WS_WUQ + 196608ul)
#define WS_WOA (WS_WUKV + 393216ul)
#define WS_WOB (WS_WOA + 1048576ul)
#define WS_WOC (WS_WOB + 1048576ul)
#define WS_WOUT (WS_WOC + 1048576ul)
#define WS_KCA (WS_WOUT + 2097152ul)
#define WS_CKVC (WS_KCA + 262144ul)
#define WS_KRC (WS_CKVC + 524288ul)
#define WS_VTA (WS_KRC + 65536ul)
#define WS_CQ (WS_VTA + 3407872ul)
#define WS_KNOPE (WS_CQ + 9437184ul)
#define WS_VTC (WS_KNOPE + 6815744ul)
#define WS_R1 (WS_VTC + 13631488ul)
#define WS_Z (WS_R1 + 25165824ul)
#define WS_END (WS_Z + 171442176ul)

#define O_Y 0
#define O_GK 12582912
#define O_GV 13631488
#define O_CKV 14680064
#define O_KR 16777216
#define O_SF 17039360
#define O_SB 18087936

struct Params {
  const float* in[30];
  float* out;
  unsigned char* ws;
};

__device__ __forceinline__ int tidx() {
  int t = threadIdx.x;
  asm volatile("" : "+v"(t));
  return t;
}
__device__ __forceinline__ Params launder(const Params& p) {
  Params q;
  long zo = 0;
  asm volatile("" : "+s"(zo));
#pragma unroll
  for (int i = 0; i < 30; i++) q.in[i] = p.in[i] + zo;
  q.out = p.out + zo;
  q.ws = p.ws + zo;
  return q;
}
__device__ __forceinline__ float bf2f(bfr b) { return __uint_as_float(((unsigned)b) << 16); }
typedef float f32x2_t __attribute__((ext_vector_type(2)));
typedef __bf16 bf16x2_t __attribute__((ext_vector_type(2)));
__device__ __forceinline__ bfr f2bf(float f) {
  __bf16 r = (__bf16)f;
  return *(bfr*)&r;
}
__device__ __forceinline__ unsigned pack2(float a, float b) {
  f32x2_t v = {a, b};
  bf16x2_t r = __builtin_convertvector(v, bf16x2_t);
  return *(unsigned*)&r;
}
__device__ __forceinline__ float lo16(unsigned u) { return __uint_as_float(u << 16); }
__device__ __forceinline__ float hi16(unsigned u) { return __uint_as_float(u & 0xffff0000u); }
__device__ __forceinline__ float siluf(float x) { return x / (1.f + __expf(-x)); }
__device__ __forceinline__ float sigmf(float x) { return 1.f / (1.f + __expf(-x)); }
__device__ __forceinline__ f32x4 mfma16(bf16x8 a, bf16x8 b, f32x4 c) {
  return __builtin_amdgcn_mfma_f32_16x16x32_bf16(a, b, c, 0, 0, 0);
}
__device__ __forceinline__ const float* xrow(const Params& p, int row) {
  return row < NCTX ? p.in[0] + (long)row * 1024 : p.in[1] + (long)(row - NCTX) * 1024;
}
__device__ __forceinline__ int row_cond(int row) { return row < NCTX ? 0 : 1 + ((row - NCTX) >> 12); }
__device__ __forceinline__ float wave_sum(float v) {
  v += __shfl_xor(v, 1); v += __shfl_xor(v, 2); v += __shfl_xor(v, 4);
  v += __shfl_xor(v, 8); v += __shfl_xor(v, 16); v += __shfl_xor(v, 32);
  return v;
}

#define XB_TMO      128
#define XB_XCNT(j)  (256  + 64 * (j))
#define XB_XSUB(j)  (1280 + 64 * (j))
#define XB_XGEN(j)  (2304 + 64 * (j))
#define XB_TOP      3328
#define XB_TOPGEN   3392
#define XCD_BAR_WORDS 3456
#define XB_SPIN_CAP (1u << 18)
#define LAS __attribute__((address_space(3)))

__device__ __forceinline__ unsigned xb_ld(unsigned* p)              { return __hip_atomic_load(p, __ATOMIC_RELAXED, __HIP_MEMORY_SCOPE_AGENT); }
__device__ __forceinline__ unsigned xb_add(unsigned* p, unsigned v) { return __hip_atomic_fetch_add(p, v, __ATOMIC_RELAXED, __HIP_MEMORY_SCOPE_AGENT); }
__device__ __forceinline__ unsigned xb_xcc_id() { return (unsigned)__builtin_amdgcn_s_getreg((3 << 11) | 20) & 0xFu; }
#define XB_SPIN(cond, bar) do { unsigned _sp = 0; while (cond) { __builtin_amdgcn_s_sleep(1); \
    if ((++_sp & 255u) == 0u) { if (xb_ld(&(bar)[XB_TMO])) break; if (_sp > XB_SPIN_CAP) { atomicAdd(&(bar)[XB_TMO], 1u); break; } } } } while (0)

struct XcdBarrier {
    unsigned* bar; unsigned x;
    volatile LAS unsigned* st;
};

__device__ __forceinline__ XcdBarrier xcd_barrier_post(unsigned* bar, volatile LAS unsigned* st) {
    XcdBarrier b; b.bar = bar; b.x = xb_xcc_id(); b.st = st;
    if (threadIdx.x == 0) (void)xb_add(&bar[XB_XCNT(b.x)], 1u);
    return b;
}
__device__ __forceinline__ void xcd_barrier_complete(unsigned* bar, unsigned x, unsigned& nloc, unsigned& nx) {
    const unsigned G = gridDim.x * gridDim.y * gridDim.z;
    unsigned sum, cnt, mine, sp = 0u;
    for (;;) {
        sum = 0u; cnt = 0u; mine = 0u;
#pragma unroll
        for (unsigned j = 0; j < 16; ++j) { const unsigned c = xb_ld(&bar[XB_XCNT(j)]); sum += c; cnt += (c > 0u) ? 1u : 0u; mine = (j == x) ? c : mine; }
        if (sum == G) break;
        __builtin_amdgcn_s_sleep(1);
        if ((++sp & 255u) == 0u) { if (xb_ld(&bar[XB_TMO])) break; if (sp > XB_SPIN_CAP) { atomicAdd(&bar[XB_TMO], 1u); break; } }
    }
    nloc = mine > 0u ? mine : 1u; nx = cnt > 0u ? cnt : 1u;
}

__device__ __forceinline__ void xcd_barrier(const XcdBarrier& b) {
    asm volatile("s_waitcnt vmcnt(0)" ::: "memory");
    __syncthreads();
    if (threadIdx.x == 0) {
        unsigned* bar = b.bar;
        __builtin_amdgcn_s_waitcnt(0);
        unsigned nloc = b.st[0], nx = b.st[1];
        if (nloc == 0u) { xcd_barrier_complete(bar, b.x, nloc, nx); b.st[0] = nloc; b.st[1] = nx; }
        const unsigned old = xb_add(&bar[XB_XSUB(b.x)], 1u);
        const unsigned gen = old / nloc;
        if (old + 1u == (gen + 1u) * nloc) {
            __builtin_amdgcn_fence(__ATOMIC_RELEASE, "agent");
            asm volatile("s_waitcnt vmcnt(0)" ::: "memory");
            const unsigned og = xb_add(&bar[XB_TOP], 1u);
            const unsigned tg = og / nx;
            if (og + 1u == (tg + 1u) * nx) xb_add(&bar[XB_TOPGEN], 1u);
            else XB_SPIN(xb_ld(&bar[XB_TOPGEN]) == tg, bar);
            __builtin_amdgcn_fence(__ATOMIC_ACQUIRE, "agent");
            xb_add(&bar[XB_XGEN(b.x)], 1u);
            asm volatile("s_waitcnt vmcnt(0)" ::: "memory");
        } else {
            XB_SPIN(xb_ld(&bar[XB_XGEN(b.x)]) == gen, bar);
            __builtin_amdgcn_fence(__ATOMIC_ACQUIRE, "agent");
            asm volatile("s_waitcnt vmcnt(0)" ::: "memory");
        }
    }
    __syncthreads();
}


#define TIDX tidx()
#define LDS3 __attribute__((address_space(3)))
__device__ __forceinline__ void glds16(const bfr* g, bfr* l) {
  __builtin_amdgcn_global_load_lds((const unsigned*)g, (LDS3 unsigned*)l, 16, 0, 0);
}
__device__ __forceinline__ void gemm128(const bfr* __restrict__ P, long ldp, int pmax,
                                        const bfr* __restrict__ Q, long ldq, int qmax, int K,
                                        f32x4 (&acc)[4][4], bfr* sm) {
  const int tid = TIDX, lane = tid & 63, wid = tid >> 6;
  const int wr = wid >> 1, wc = wid & 1;
  const int l15 = lane & 15, g = lane >> 4;
  const bfr* pp[2];
  const bfr* qp[2];
  {
    const int r0 = tid >> 2;
    const int c = (tid & 3) ^ ((tid >> 4) & 3);
#pragma unroll
    for (int i = 0; i < 2; i++) {
      int r = r0 + 64 * i;
      pp[i] = P + (long)min(r, pmax - 1) * ldp + c * 8;
      qp[i] = Q + (long)min(r, qmax - 1) * ldq + c * 8;
    }
  }
  const int nk = K >> 5;
#define GEMM_ISSUE(T)                                                    \
  do {                                                                   \
    bfr* nb_ = sm + ((T) & 3) * 8192;                                    \
    glds16(pp[0] + (T) * 32, nb_ + tid * 8);                             \
    glds16(pp[1] + (T) * 32, nb_ + 2048 + tid * 8);                      \
    glds16(qp[0] + (T) * 32, nb_ + 4096 + tid * 8);                      \
    glds16(qp[1] + (T) * 32, nb_ + 6144 + tid * 8);                      \
  } while (0)
  GEMM_ISSUE(0);
  GEMM_ISSUE(1);
  GEMM_ISSUE(2);
  const int pos = (g ^ ((l15 >> 2) & 3)) * 8;
  for (int kt = 0; kt < nk; kt++) {
    if (kt + 2 < nk) asm volatile("s_waitcnt vmcnt(8)" ::: "memory");
    else if (kt + 1 < nk) asm volatile("s_waitcnt vmcnt(4)" ::: "memory");
    else asm volatile("s_waitcnt vmcnt(0)" ::: "memory");
    __builtin_amdgcn_s_barrier();
    if (kt + 3 < nk) GEMM_ISSUE(kt + 3);
    const bfr* Ps = sm + (kt & 3) * 8192;
    const bfr* Qs = Ps + 4096;
    bf16x8 pf[4], qf[4];
#pragma unroll
    for (int m = 0; m < 4; m++) {
      pf[m] = *(const bf16x8*)(Ps + (wr * 64 + m * 16 + l15) * 32 + pos);
      qf[m] = *(const bf16x8*)(Qs + (wc * 64 + m * 16 + l15) * 32 + pos);
    }
#pragma unroll
    for (int m = 0; m < 4; m++)
#pragma unroll
      for (int n = 0; n < 4; n++) acc[m][n] = mfma16(pf[m], qf[n], acc[m][n]);
  }
#undef GEMM_ISSUE
  __syncthreads();
}

template <int NQ>
__device__ __forceinline__ void gemm128q(const bfr* __restrict__ P, long ldp, const bfr* __restrict__ Q, long ldq, int K,
                                         f32x4 (&acc)[4][NQ], bfr* sm) {
  constexpr int QI = NQ / 2;
  constexpr int STG = 4096 + QI * 2048;
  const int tid = TIDX, lane = tid & 63, wid = tid >> 6;
  const int wr = wid >> 1, wc = wid & 1;
  const int l15 = lane & 15, g = lane >> 4;
  const bfr* pp[2];
  const bfr* qp[QI];
  {
    const int r0 = tid >> 2;
    const int c = (tid & 3) ^ (((tid >> 5) & 1) * 3);
#pragma unroll
    for (int i = 0; i < 2; i++) pp[i] = P + (long)(r0 + 64 * i) * ldp + c * 8;
#pragma unroll
    for (int i = 0; i < QI; i++) qp[i] = Q + (long)(r0 + 64 * i) * ldq + c * 8;
  }
  const int nk = K >> 5;
  auto issue = [&](int T) {
    bfr* nb_ = sm + (T & 3) * STG;
    glds16(pp[0] + T * 32, nb_ + tid * 8);
    glds16(pp[1] + T * 32, nb_ + 2048 + tid * 8);
#pragma unroll
    for (int i = 0; i < QI; i++) glds16(qp[i] + T * 32, nb_ + 4096 + i * 2048 + tid * 8);
  };
  issue(0);
  issue(1);
  issue(2);
  const int pos = (g ^ (((l15 >> 3) & 1) * 3)) * 8;
  for (int kt = 0; kt < nk; kt++) {
    if (kt + 2 < nk) {
      if (QI == 2) asm volatile("s_waitcnt vmcnt(8)" ::: "memory"); else asm volatile("s_waitcnt vmcnt(6)" ::: "memory");
    } else if (kt + 1 < nk) {
      if (QI == 2) asm volatile("s_waitcnt vmcnt(4)" ::: "memory"); else asm volatile("s_waitcnt vmcnt(3)" ::: "memory");
    } else {
      asm volatile("s_waitcnt vmcnt(0)" ::: "memory");
    }
    __builtin_amdgcn_s_barrier();
    if (kt + 3 < nk) issue(kt + 3);
    const bfr* Ps = sm + (kt & 3) * STG;
    const bfr* Qs = Ps + 4096;
    bf16x8 pf[4], qf[NQ];
#pragma unroll
    for (int m = 0; m < 4; m++) pf[m] = *(const bf16x8*)(Ps + (wr * 64 + m * 16 + l15) * 32 + pos);
#pragma unroll
    for (int n = 0; n < NQ; n++) qf[n] = *(const bf16x8*)(Qs + (wc * 16 * NQ + n * 16 + l15) * 32 + pos);
#pragma unroll
    for (int m = 0; m < 4; m++)
#pragma unroll
      for (int n = 0; n < NQ; n++) acc[m][n] = mfma16(pf[m], qf[n], acc[m][n]);
  }
  __syncthreads();
}

template <int NQ>
__device__ __forceinline__ void gemm256x128(const bfr* __restrict__ P, long ldp, int pmax,
                                            const bfr* __restrict__ Q, long ldq, int K,
                                            f32x4 (&acc)[8][NQ], bfr* sm) {
  constexpr int QI = NQ / 2;
  constexpr int STG = 8192 + QI * 2048;
  const int tid = TIDX, lane = tid & 63, wid = tid >> 6;
  const int wr = wid >> 1, wc = wid & 1;
  const int l15 = lane & 15, g = lane >> 4;
  const bfr* pp[4];
  const bfr* qp[QI];
  {
    const int r0 = tid >> 2;
    const int c = (tid & 3) ^ (((tid >> 5) & 1) * 3);
#pragma unroll
    for (int i = 0; i < 4; i++) pp[i] = P + (long)min(r0 + 64 * i, pmax - 1) * ldp + c * 8;
#pragma unroll
    for (int i = 0; i < QI; i++) qp[i] = Q + (long)(r0 + 64 * i) * ldq + c * 8;
  }
  const int nk = K >> 5;
  auto issue = [&](int T, int stg) {
    bfr* nb_ = sm + stg * STG;
    glds16(pp[0] + T * 32, nb_ + tid * 8);
    glds16(pp[1] + T * 32, nb_ + 2048 + tid * 8);
    glds16(pp[2] + T * 32, nb_ + 4096 + tid * 8);
    glds16(pp[3] + T * 32, nb_ + 6144 + tid * 8);
#pragma unroll
    for (int i = 0; i < QI; i++) glds16(qp[i] + T * 32, nb_ + 8192 + i * 2048 + tid * 8);
  };
  issue(0, 0);
  issue(1, 1);
  const int pos = (g ^ (((l15 >> 3) & 1) * 3)) * 8;
  int st = 0;
  for (int kt = 0; kt < nk; kt++) {
    if (kt + 1 < nk) {
      if (QI == 2) asm volatile("s_waitcnt vmcnt(6)" ::: "memory"); else asm volatile("s_waitcnt vmcnt(5)" ::: "memory");
    } else {
      asm volatile("s_waitcnt vmcnt(0)" ::: "memory");
    }
    __builtin_amdgcn_s_barrier();
    if (kt + 2 < nk) issue(kt + 2, st == 0 ? 2 : st - 1);
    const bfr* Ps = sm + st * STG;
    const bfr* Qs = Ps + 8192;
    st = (st == 2) ? 0 : st + 1;
    bf16x8 qf[NQ], pf[8];
#pragma unroll
    for (int n = 0; n < NQ; n++) qf[n] = *(const bf16x8*)(Qs + (wc * 16 * NQ + n * 16 + l15) * 32 + pos);
#pragma unroll
    for (int m = 0; m < 8; m++) pf[m] = *(const bf16x8*)(Ps + (wr * 128 + m * 16 + l15) * 32 + pos);
#pragma unroll
    for (int m = 0; m < 8; m++)
#pragma unroll
      for (int n = 0; n < NQ; n++) acc[m][n] = mfma16(pf[m], qf[n], acc[m][n]);
    __builtin_amdgcn_sched_group_barrier(0x100, NQ + 2, 0);
#pragma unroll
    for (int i = 0; i < 6; i++) {
      __builtin_amdgcn_sched_group_barrier(0x008, NQ, 0);
      __builtin_amdgcn_sched_group_barrier(0x100, 1, 0);
    }
    __builtin_amdgcn_sched_group_barrier(0x008, 2 * NQ, 0);
  }
  __syncthreads();
}

template <int NQ>
__device__ __forceinline__ void gemm128k64(const bfr* __restrict__ P, long ldp, int pmax,
                                           const bfr* __restrict__ Q, long ldq, int K,
                                           f32x4 (&acc)[4][NQ], bfr* sm) {
  constexpr int STG = 8192 + 2048 * NQ;
  const int tid = TIDX, lane = tid & 63, wid = tid >> 6;
  const int wr = wid >> 1, wc = wid & 1;
  const int l15 = lane & 15, g = lane >> 4;
  const bfr* pp[4];
  const bfr* qp[NQ];
  {
    const int r0 = tid >> 3;
    const int c = (tid & 7) ^ ((tid >> 4) & 7);
#pragma unroll
    for (int i = 0; i < 4; i++) pp[i] = P + (long)min(r0 + 32 * i, pmax - 1) * ldp + c * 8;
#pragma unroll
    for (int i = 0; i < NQ; i++) qp[i] = Q + (long)(r0 + 32 * i) * ldq + c * 8;
  }
  const int nk = K >> 6;
#pragma unroll
  for (int i = 0; i < 4; i++) glds16(pp[i], sm + i * 2048 + tid * 8);
#pragma unroll
  for (int i = 0; i < NQ; i++) glds16(qp[i], sm + 8192 + i * 2048 + tid * 8);
  const int swz = l15 >> 1;
  for (int kt = 0; kt < nk; kt++) {
    asm volatile("s_waitcnt vmcnt(0)" ::: "memory");
    __builtin_amdgcn_s_barrier();
    if (kt + 1 < nk) {
      bfr* nb = sm + ((kt + 1) & 1) * STG;
#pragma unroll
      for (int i = 0; i < 4; i++) glds16(pp[i] + (kt + 1) * 64, nb + i * 2048 + tid * 8);
#pragma unroll
      for (int i = 0; i < NQ; i++) glds16(qp[i] + (kt + 1) * 64, nb + 8192 + i * 2048 + tid * 8);
    }
    const bfr* Ps = sm + (kt & 1) * STG;
    const bfr* Qs = Ps + 8192;
#pragma unroll
    for (int kk = 0; kk < 2; kk++) {
      bf16x8 pf[4], qf[NQ];
      const int pos = ((kk * 4 + g) ^ swz) * 8;
#pragma unroll
      for (int m = 0; m < 4; m++) pf[m] = *(const bf16x8*)(Ps + (wr * 64 + m * 16 + l15) * 64 + pos);
#pragma unroll
      for (int n = 0; n < NQ; n++) qf[n] = *(const bf16x8*)(Qs + (wc * 16 * NQ + n * 16 + l15) * 64 + pos);
#pragma unroll
      for (int m = 0; m < 4; m++)
#pragma unroll
        for (int n = 0; n < NQ; n++) acc[m][n] = mfma16(pf[m], qf[n], acc[m][n]);
    }
  }
  __syncthreads();
}

__device__ __forceinline__ void phase_s0(const Params& p, bfr* sm) {
  const int tid = TIDX;
  float* rope = (float*)(p.ws + WS_ROPE);
  for (int idx = blockIdx.x * 256 + tid; idx < 1536; idx += gridDim.x * 256) {
    if (idx < 1024) {
      int pos = idx >> 4, i = idx & 15;
      float fr = powf(10000.f, -(float)i / 16.f);
      float a = (float)pos * fr;
      rope[idx] = cosf(a);
      rope[1024 + idx] = sinf(a);
    } else {
      int j = idx - 1024;
      int pos = j >> 3, i = j & 7;
      float fr = powf(10000.f, -(float)i / 8.f);
      float a = (float)pos * fr;
      rope[2048 + j] = cosf(a);
      rope[2560 + j] = sinf(a);
    }
  }
  float* smf = (float*)sm;
  float* modp = (float*)(p.ws + WS_MODP);
  for (int it = blockIdx.x; it < 768; it += gridDim.x) {
    int l = it / 384, rem = it % 384, cgp = rem >> 3, ks = rem & 7;
    int col = cgp * 64 + (tid & 63), kq = tid >> 6;
    const float* w = p.in[10] + (long)l * 1024 * 3072 + col;
    float a0 = 0.f, a1 = 0.f, a2 = 0.f;
    int k0 = ks * 128 + kq * 32;
#pragma unroll 8
    for (int k = k0; k < k0 + 32; k++) {
      float wv = w[(long)k * 3072];
      a0 += siluf(p.in[9][k]) * wv;
      a1 += siluf(p.in[8][k]) * wv;
      a2 += siluf(p.in[8][1024 + k]) * wv;
    }
    smf[(kq * 3 + 0) * 64 + (tid & 63)] = a0;
    smf[(kq * 3 + 1) * 64 + (tid & 63)] = a1;
    smf[(kq * 3 + 2) * 64 + (tid & 63)] = a2;
    __syncthreads();
    if (tid < 192) {
      int c = tid >> 6, cc = tid & 63;
      float s = smf[(0 * 3 + c) * 64 + cc] + smf[(1 * 3 + c) * 64 + cc] + smf[(2 * 3 + c) * 64 + cc] + smf[(3 * 3 + c) * 64 + cc];
      modp[((ks * 2 + l) * 3 + c) * 3072 + cgp * 64 + cc] = s;
    }
    __syncthreads();
  }
}

__device__ __forceinline__ void phase_s1(const Params& p) {
  float* modp = (float*)(p.ws + WS_MODP);
  float* mod = (float*)(p.ws + WS_MOD);
  for (int idx = blockIdx.x * 256 + TIDX; idx < 2 * 3 * 3072; idx += gridDim.x * 256) {
    int l = idx / 9216, n = idx % 3072;
    float s = p.in[11][l * 3072 + n];
#pragma unroll
    for (int ks = 0; ks < 8; ks++) s += modp[ks * 18432 + idx];
    mod[idx] = s;
  }
}

__device__ __forceinline__ void wconv_tile(const float* __restrict__ src, int K, int N, bfr* __restrict__ dst,
                                           int tk, int tn, float* smf) {
  bfr* sT = (bfr*)smf;
  const int tid = TIDX;
  const int n4 = (tid & 15) * 4, kb = tid >> 4;
#pragma unroll
  for (int i = 0; i < 4; i++) {
    int k = kb + 16 * i;
    float4 v = *(const float4*)(src + (long)(tk * 64 + k) * N + tn * 64 + n4);
    sT[(n4 + 0) * 72 + k] = f2bf(v.x);
    sT[(n4 + 1) * 72 + k] = f2bf(v.y);
    sT[(n4 + 2) * 72 + k] = f2bf(v.z);
    sT[(n4 + 3) * 72 + k] = f2bf(v.w);
  }
  __syncthreads();
#pragma unroll
  for (int i = 0; i < 2; i++) {
    int c = tid + 256 * i;
    int n = c >> 3, kc = c & 7;
    *(u32x4*)(dst + (long)(tn * 64 + n) * K + tk * 64 + kc * 8) = *(const u32x4*)(sT + n * 72 + kc * 8);
  }
  __syncthreads();
}

#define WCONV_ITEMS 2456
__device__ __forceinline__ void wconv_phase(const Params& p, int l, bfr* sm) {
  float* smf = (float*)sm;
  for (int item0 = blockIdx.x; item0 < WCONV_ITEMS; item0 += gridDim.x) {
    int item = item0;
    const float* src;
    bfr* dst;
    int K, N, tk, tn;
    if (item < 1744) {
      src = p.in[14] + (long)l * 1024 * 6976; K = 1024; N = 6976; dst = (bfr*)(p.ws + WS_WIN); tk = item & 15; tn = item >> 4;
    } else if (item < 1768) {
      item -= 1744;
      src = p.in[24] + (long)l * 256 * 384; K = 256; N = 384; dst = (bfr*)(p.ws + WS_WUQ); tk = item & 3; tn = item >> 2;
    } else if (item < 1816) {
      item -= 1768;
      src = p.in[25] + (long)l * 256 * 768; K = 256; N = 768; dst = (bfr*)(p.ws + WS_WUKV); tk = item & 3; tn = item >> 2;
    } else if (item < 2200) {
      item -= 1816;
      int w = item >> 7, it = item & 127;
      src = (w == 0 ? p.in[26] : (w == 1 ? p.in[27] : p.in[28])) + (long)l * 512 * 1024;
      K = 512; N = 1024; dst = (bfr*)(p.ws + WS_WOA + (unsigned long)w * 1048576ul); tk = it & 7; tn = it >> 3;
    } else {
      item -= 2200;
      src = p.in[29] + (long)l * 1024 * 1024; K = 1024; N = 1024; dst = (bfr*)(p.ws + WS_WOUT); tk = item & 15; tn = item >> 4;
    }
    wconv_tile(src, K, N, dst, tk, tn, smf);
  }
}

__device__ __forceinline__ void phase_prenorm0(const Params& p) {
  const int lane = TIDX & 63;
  const float* mod = (const float*)(p.ws + WS_MOD);
  bfr* H = (bfr*)(p.ws + WS_R1);
  for (int row = blockIdx.x * 4 + (TIDX >> 6); row < NROWS; row += gridDim.x * 4) {
    const float* x = xrow(p, row);
    const float* md = mod + (0 * 3 + row_cond(row)) * 3072;
    float4 v[4];
    float ss = 0.f;
#pragma unroll
    for (int i = 0; i < 4; i++) {
      v[i] = *(const float4*)(x + i * 256 + lane * 4);
      ss += v[i].x * v[i].x + v[i].y * v[i].y + v[i].z * v[i].z + v[i].w * v[i].w;
    }
    ss = wave_sum(ss);
    float rs = rsqrtf(ss * (1.f / 1024.f) + 1e-6f);
#pragma unroll
    for (int i = 0; i < 4; i++) {
      int n = i * 256 + lane * 4;
      float4 g = *(const float4*)(p.in[12] + n);
      float4 sh = *(const float4*)(md + n);
      float4 sc = *(const float4*)(md + 1024 + n);
      float h0 = v[i].x * rs * g.x * (1.f + sc.x) + sh.x;
      float h1 = v[i].y * rs * g.y * (1.f + sc.y) + sh.y;
      float h2 = v[i].z * rs * g.z * (1.f + sc.z) + sh.z;
      float h3 = v[i].w * rs * g.w * (1.f + sc.w) + sh.w;
      u32x2 o;
      o.x = pack2(h0, h1);
      o.y = pack2(h2, h3);
      *(u32x2*)(H + (long)row * 1024 + n) = o;
    }
  }
}

__device__ __forceinline__ unsigned xcc_id() { return (unsigned)__builtin_amdgcn_s_getreg((3 << 11) | 20) & 7u; }
template <class CountF>
__device__ __forceinline__ int xq_take(unsigned* ctr, int& q, int& tried, unsigned first, CountF cnt) {
  unsigned j = first;
  for (;;) {
    if (j < (unsigned)cnt(q)) return (q << 20) | (int)j;
    q = (q + 1) & 7;
    if (++tried >= 8) return -1;
    j = atomicAdd(ctr + q * 16, 1u);
  }
}

__device__ __forceinline__ void phase_inproj(const Params& p, int l, bfr* sm, int* s_item, int slot) {
  const bfr* H = (const bfr*)(p.ws + WS_R1);
  const bfr* W = (const bfr*)(p.ws + WS_WIN);
  bfr* Z = (bfr*)(p.ws + WS_Z);
  const int tid = TIDX;
  const int lane = tid & 63, wid = tid >> 6, wr = wid >> 1, wc = wid & 1;
  unsigned* ctr = (unsigned*)(p.ws + WS_CTR) + slot * 128;
  auto cnt = [](int q) { return 96 * ((55 * (q + 1)) / 8 - (55 * q) / 8); };
  int q = (int)xcc_id(), tried = 0;
  unsigned nxt = 0;
  if (tid == 0) nxt = atomicAdd(ctr + q * 16, 1u);
  for (;;) {
    if (tid == 0) *s_item = xq_take(ctr, q, tried, nxt, cnt);
    __syncthreads();
    const int it = *s_item;
    __syncthreads();
    if (it < 0) break;
    const int qq = it >> 20, j = it & 0xfffff;
    if (tid == 0) nxt = atomicAdd(ctr + q * 16, 1u);
    const int tn0 = (55 * qq) / 8, w = (55 * (qq + 1)) / 8 - tn0;
    const int tm = j / w, tn = tn0 + j % w;
    f32x4 acc[4][4];
#pragma unroll
    for (int a = 0; a < 4; a++)
#pragma unroll
      for (int b = 0; b < 4; b++) acc[a][b] = (f32x4){0.f, 0.f, 0.f, 0.f};
    gemm128k64<4>(W + (long)tn * 128 * 1024, 1024, ZLD - tn * 128, H + (long)tm * 128 * 1024, 1024, 1024, acc, sm);
    {
      const int g = lane >> 4, l15 = lane & 15;
#pragma unroll
      for (int pi = 0; pi < 4; pi++)
#pragma unroll
        for (int qi = 0; qi < 4; qi++) {
          u32x2 o;
          o.x = pack2(acc[pi][qi][0], acc[pi][qi][1]);
          o.y = pack2(acc[pi][qi][2], acc[pi][qi][3]);
          *(u32x2*)(sm + (wc * 64 + qi * 16 + l15) * 136 + wr * 64 + pi * 16 + g * 4) = o;
        }
      __syncthreads();
      const int ncol = (ZLD - tn * 128) >> 3;
#pragma unroll
      for (int i = 0; i < 8; i++) {
        int c = tid + 256 * i;
        int row = c >> 4, c16 = c & 15;
        if (c16 < ncol)
          *(u32x4*)(Z + (long)(tm * 128 + row) * ZLD + tn * 128 + c16 * 8) = *(const u32x4*)(sm + row * 136 + c16 * 8);
      }
      __syncthreads();
    }
  }
}

__device__ __forceinline__ void unpack8(u32x4 v, float* x) {
  x[0] = lo16(v.x); x[1] = hi16(v.x); x[2] = lo16(v.y); x[3] = hi16(v.y);
  x[4] = lo16(v.z); x[5] = hi16(v.z); x[6] = lo16(v.w); x[7] = hi16(v.w);
}
__device__ __forceinline__ u32x4 pack8(const float* y) {
  u32x4 o;
  o.x = pack2(y[0], y[1]); o.y = pack2(y[2], y[3]); o.z = pack2(y[4], y[5]); o.w = pack2(y[6], y[7]);
  return o;
}

__device__ __forceinline__ void phase_rowpost(const Params& p, int l) {
  const int lane = TIDX & 63;
  bfr* Z = (bfr*)(p.ws + WS_Z);
  const float* rope = (const float*)(p.ws + WS_ROPE);
  bfr* VTA = (bfr*)(p.ws + WS_VTA);
  bfr* KCA = (bfr*)(p.ws + WS_KCA);
  bfr* CKVC = (bfr*)(p.ws + WS_CKVC);
  bfr* KRC = (bfr*)(p.ws + WS_KRC);
  float* out = p.out;
  for (int row = blockIdx.x * 4 + (TIDX >> 6); row < NROWS + 1024; row += gridDim.x * 4) {
    if (row < NROWS) {
      const bool lat = row >= NCTX;
      const int bc = row >> 8, tc = row & 255;
      const int bl = (row - NCTX) >> 12, tl = (row - NCTX) & 4095;
      const int prow = tl >> 6, pcol = tl & 63;
      bfr* z = Z + (long)row * ZLD;
      {
        float x[8];
        unpack8(*(const u32x4*)(z + C_QA + lane * 8), x);
        float ss = 0.f;
#pragma unroll
        for (int e = 0; e < 8; e++) ss += x[e] * x[e];
        ss += __shfl_xor(ss, 1); ss += __shfl_xor(ss, 2); ss += __shfl_xor(ss, 4);
        float rs = rsqrtf(ss * (1.f / 64.f) + 1e-6f);
        int sub = lane & 7;
        const float* g = p.in[15] + l * 64 + sub * 8;
#pragma unroll
        for (int e = 0; e < 8; e++) x[e] = x[e] * rs * g[e];
        if (lat) {
          int pos = (sub >> 2) ? pcol : prow;
          bool hi = (sub & 2) != 0;
          int i0 = (sub & 1) * 8;
#pragma unroll
          for (int e = 0; e < 8; e++) {
            float yp = __shfl_xor(x[e], 2);
            float c = rope[pos * 16 + i0 + e], s = rope[1024 + pos * 16 + i0 + e];
            x[e] = hi ? (yp * s + x[e] * c) : (x[e] * c - yp * s);
          }
        }
        const float qs = 0.125f * 1.4426950408889634f;
#pragma unroll
        for (int e = 0; e < 8; e++) x[e] *= qs;
        *(u32x4*)(z + C_QA + lane * 8) = pack8(x);
      }
      {
        int L = lane & 15;
        float x[8];
        unpack8(*(const u32x4*)(z + C_KA + L * 8), x);
        float ss = 0.f;
#pragma unroll
        for (int e = 0; e < 8; e++) ss += x[e] * x[e];
        ss += __shfl_xor(ss, 1); ss += __shfl_xor(ss, 2); ss += __shfl_xor(ss, 4);
        float rs = rsqrtf(ss * (1.f / 64.f) + 1e-6f);
        int sub = L & 7;
        const float* g = p.in[16] + l * 64 + sub * 8;
#pragma unroll
        for (int e = 0; e < 8; e++) x[e] = x[e] * rs * g[e];
        if (lat) {
          int pos = (sub >> 2) ? pcol : prow;
          bool hi = (sub & 2) != 0;
          int i0 = (sub & 1) * 8;
#pragma unroll
          for (int e = 0; e < 8; e++) {
            float yp = __shfl_xor(x[e], 2);
            float c = rope[pos * 16 + i0 + e], s = rope[1024 + pos * 16 + i0 + e];
            x[e] = hi ? (yp * s + x[e] * c) : (x[e] * c - yp * s);
          }
        } else if (lane < 16) {
          float* o = out + O_GK + ((long)(bc * 2 + l) * 256 + tc) * 128 + L * 8;
          *(float4*)(o) = make_float4(x[0], x[1], x[2], x[3]);
          *(float4*)(o + 4) = make_float4(x[4], x[5], x[6], x[7]);
        }
        if (lane < 16) *(u32x4*)(z + C_KA + L * 8) = pack8(x);
      }
      if (lane < 16) {
        int L = lane;
        u32x4 raw = *(const u32x4*)(z + C_VA + L * 8);
        float x[8];
        unpack8(raw, x);
        if (!lat) {
          float* o = out + O_GV + ((long)(bc * 2 + l) * 256 + tc) * 128 + L * 8;
          *(float4*)(o) = make_float4(x[0], x[1], x[2], x[3]);
          *(float4*)(o + 4) = make_float4(x[4], x[5], x[6], x[7]);
        }
        int g = L >> 3, d0 = (L & 7) * 8;
        long base; int nk, key;
        if (!lat) { base = (long)bc * 32768; nk = 256; key = tc; }
        else { base = 16l * 32768 + (long)bl * (2 * 64 * 4608); nk = 4608; key = 512 + tl; }
        const bfr* rb = (const bfr*)&raw;
#pragma unroll
        for (int e = 0; e < 8; e++) VTA[base + (long)(g * 64 + d0 + e) * nk + key] = rb[e];
      }
      {
        u32x2 rq = *(const u32x2*)(z + C_QL + lane * 4);
        u32x2 rk = *(const u32x2*)(z + C_KV + lane * 4);
        float q[4] = {lo16(rq.x), hi16(rq.x), lo16(rq.y), hi16(rq.y)};
        float k[4] = {lo16(rk.x), hi16(rk.x), lo16(rk.y), hi16(rk.y)};
        float sq = q[0] * q[0] + q[1] * q[1] + q[2] * q[2] + q[3] * q[3];
        float sk = k[0] * k[0] + k[1] * k[1] + k[2] * k[2] + k[3] * k[3];
        sq = wave_sum(sq);
        sk = wave_sum(sk);
        float rq_ = rsqrtf(sq * (1.f / 256.f) + 1e-6f), rk_ = rsqrtf(sk * (1.f / 256.f) + 1e-6f);
        float4 gq = *(const float4*)(p.in[22] + l * 256 + lane * 4);
        float4 gk = *(const float4*)(p.in[23] + l * 256 + lane * 4);
        q[0] *= rq_ * gq.x; q[1] *= rq_ * gq.y; q[2] *= rq_ * gq.z; q[3] *= rq_ * gq.w;
        k[0] *= rk_ * gk.x; k[1] *= rk_ * gk.y; k[2] *= rk_ * gk.z; k[3] *= rk_ * gk.w;
        u32x2 o;
        o.x = pack2(q[0], q[1]); o.y = pack2(q[2], q[3]);
        *(u32x2*)(z + C_QL + lane * 4) = o;
        o.x = pack2(k[0], k[1]); o.y = pack2(k[2], k[3]);
        *(u32x2*)(z + C_KV + lane * 4) = o;
        if (!lat) *(float4*)(out + O_CKV + ((long)(bc * 2 + l) * 256 + tc) * 256 + lane * 4) = make_float4(k[0], k[1], k[2], k[3]);
      }
      {
        int L = lane & 3;
        float x[8];
        unpack8(*(const u32x4*)(z + C_KR + L * 8), x);
        if (lat) {
          int pos = (L >> 1) ? pcol : prow;
          bool hi = (L & 1) != 0;
#pragma unroll
          for (int e = 0; e < 8; e++) {
            float yp = __shfl_xor(x[e], 1);
            float c = rope[2048 + pos * 8 + e], s = rope[2560 + pos * 8 + e];
            x[e] = hi ? (yp * s + x[e] * c) : (x[e] * c - yp * s);
          }
          if (lane < 4) *(u32x4*)(z + C_KR + L * 8) = pack8(x);
        } else if (lane < 4) {
          float* o = out + O_KR + ((long)(bc * 2 + l) * 256 + tc) * 32 + L * 8;
          *(float4*)(o) = make_float4(x[0], x[1], x[2], x[3]);
          *(float4*)(o + 4) = make_float4(x[4], x[5], x[6], x[7]);
        }
      }
    } else {
      int cr = row - NROWS;
      int b = cr >> 9, t = cr & 511;
      long src = (long)(b * 2 + l) * 512 + t;
      {
        float2 kv = *(const float2*)(p.in[2] + src * 128 + lane * 2);
        *(unsigned*)(KCA + (long)(b * 512 + t) * 128 + lane * 2) = pack2(kv.x, kv.y);
        float2 vv = *(const float2*)(p.in[3] + src * 128 + lane * 2);
        int c0 = lane * 2;
        long base = 16l * 32768 + (long)b * (2 * 64 * 4608);
        VTA[base + (long)c0 * 4608 + t] = f2bf(vv.x);
        VTA[base + (long)(c0 + 1) * 4608 + t] = f2bf(vv.y);
        float4 cv = *(const float4*)(p.in[4] + src * 256 + lane * 4);
        u32x2 o;
        o.x = pack2(cv.x, cv.y); o.y = pack2(cv.z, cv.w);
        *(u32x2*)(CKVC + (long)(b * 512 + t) * 256 + lane * 4) = o;
        if (lane < 32) KRC[(long)(b * 512 + t) * 32 + lane] = f2bf(p.in[5][src * 32 + lane]);
      }
    }
  }
}

#define WS_PREP1 251703296ul
#define WS_EL (WS_WIN + 12582912ul)
__device__ __forceinline__ bfr* prep_base(const Params& p, int b, int h, int dir, int c) {
  return (bfr*)(p.ws + (b ? WS_PREP1 : WS_WIN)) + (long)((h * 2 + dir) * 64 + c) * 12288;
}

__device__ __forceinline__ void gla_chunk_prep(int tid, const float (&wd)[16], float bias, const bfr* Qr, const bfr* Kr,
                                               bfr* Qe, bfr* Ke, bfr* KlT, const float* RF, float* tot, float* lastv) {
  const int ch = tid & 63, part = tid >> 6;
  float cum[16];
  {
    float run = 0.f;
#pragma unroll
    for (int ii = 0; ii < 16; ii++) {
      int i = part * 16 + ii;
      float x = bias;
#pragma unroll
      for (int r = 0; r < 16; r++) x += RF[i * 16 + r] * wd[r];
      float la = (fminf(x, 0.f) - __logf(1.f + __expf(-fabsf(x)))) * (1.f / 16.f);
      run += la;
      cum[ii] = run;
    }
    tot[part * 64 + ch] = run;
  }
  __syncthreads();
  {
    float off = 0.f, last = 0.f;
#pragma unroll
    for (int pp = 0; pp < 4; pp++) {
      float tv = tot[pp * 64 + ch];
      if (pp < part) off += tv;
      last += tv;
    }
    if (part == 0) lastv[ch] = last;
#pragma unroll
    for (int ii = 0; ii < 16; ii++) {
      int i = part * 16 + ii;
      float cc = cum[ii] + off;
      float qv = bf2f(Qr[i * LDT + ch]), kv = bf2f(Kr[i * LDT + ch]);
      Qe[i * LDT + ch] = f2bf(qv * __expf(cc) * 0.125f);
      Ke[i * LDT + ch] = f2bf(kv * __expf(-cc));
      KlT[ch * LDT + i] = f2bf(kv * __expf(last - cc));
    }
  }
  __syncthreads();
}

__device__ __forceinline__ void gla_att(int wid, int g, int l15, const bfr* Qe, const bfr* Ke, bfr* Att) {
  f32x4 att[4];
  bf16x8 qa[2];
#pragma unroll
  for (int kk = 0; kk < 2; kk++) qa[kk] = *(const bf16x8*)(Qe + (16 * wid + l15) * LDT + kk * 32 + g * 8);
#pragma unroll
  for (int nj = 0; nj < 4; nj++) {
    att[nj] = (f32x4){0.f, 0.f, 0.f, 0.f};
#pragma unroll
    for (int kk = 0; kk < 2; kk++) {
      bf16x8 kb = *(const bf16x8*)(Ke + (16 * nj + l15) * LDT + kk * 32 + g * 8);
      att[nj] = mfma16(qa[kk], kb, att[nj]);
    }
  }
#pragma unroll
  for (int nj = 0; nj < 4; nj++)
#pragma unroll
    for (int r = 0; r < 4; r++) {
      int i = 16 * wid + 4 * g + r, j = 16 * nj + l15;
      Att[i * LDT + j] = f2bf(i >= j ? att[nj][r] : 0.f);
    }
}

__device__ __forceinline__ void gla_prep_item(const Params& p, int l, int b, int h, int dir, int c, bfr* sm) {
  const int tid = TIDX, lane = tid & 63, wid = tid >> 6, g = lane >> 4, l15 = lane & 15;
  const bfr* Z = (const bfr*)(p.ws + WS_Z);
  const int N = 4096;
  const int rowbase = NCTX + b * 4096;
  bfr* Qr = sm;
  bfr* Kr = Qr + 64 * LDT;
  bfr* Qe = Kr + 64 * LDT;
  bfr* Ke = Qe + 64 * LDT;
  bfr* KlT = Ke + 64 * LDT;
  float* RF = (float*)(KlT + 64 * LDT);
  float* tot = RF + 64 * 16;
  float* lastv = tot + 256;
  bfr* Att = Qr;
  const int ch = tid & 63;
  float wd[16];
  {
    const float* W = (dir ? p.in[19] : p.in[17]) + (long)l * 16 * 256 + h * 64 + ch;
#pragma unroll
    for (int r = 0; r < 16; r++) wd[r] = W[r * 256];
  }
  const float bias = (dir ? p.in[20] : p.in[18])[l * 256 + h * 64 + ch];
#pragma unroll
  for (int ii = 0; ii < 2; ii++) {
    int cc = tid + 256 * ii;
    int i = cc >> 3, c8 = cc & 7;
    int tok = dir ? (N - 1 - (c * 64 + i)) : (c * 64 + i);
    const bfr* zr = Z + (long)(rowbase + tok) * ZLD;
    *(u32x4*)(Qr + i * LDT + c8 * 8) = *(const u32x4*)(zr + C_QG + h * 64 + c8 * 8);
    *(u32x4*)(Kr + i * LDT + c8 * 8) = *(const u32x4*)(zr + C_KG + h * 64 + c8 * 8);
  }
  if (tid < 128) {
    int i = tid >> 1, hf = tid & 1;
    int tok = dir ? (N - 1 - (c * 64 + i)) : (c * 64 + i);
    u32x4 rr = *(const u32x4*)(Z + (long)(rowbase + tok) * ZLD + (dir ? C_RB : C_RF) + hf * 8);
    float x[8];
    unpack8(rr, x);
#pragma unroll
    for (int e = 0; e < 8; e++) RF[i * 16 + hf * 8 + e] = x[e];
  }
  __syncthreads();
  gla_chunk_prep(tid, wd, bias, Qr, Kr, Qe, Ke, KlT, RF, tot, lastv);
  gla_att(wid, g, l15, Qe, Ke, Att);
  __syncthreads();
  bfr* dst = prep_base(p, b, h, dir, c);
#pragma unroll
  for (int ii = 0; ii < 2; ii++) {
    int cc = tid + 256 * ii;
    int i = cc >> 3, c8 = cc & 7;
    *(u32x4*)(dst + i * 64 + c8 * 8) = *(const u32x4*)(Qe + i * LDT + c8 * 8);
    *(u32x4*)(dst + 4096 + i * 64 + c8 * 8) = *(const u32x4*)(KlT + i * LDT + c8 * 8);
    *(u32x4*)(dst + 8192 + i * 64 + c8 * 8) = *(const u32x4*)(Att + i * LDT + c8 * 8);
  }
  if (tid < 64) ((float*)(p.ws + WS_EL))[((long)(((b * 4 + h) * 2 + dir) * 64 + c)) * 64 + tid] = __expf(lastv[tid]);
  __syncthreads();
}

__device__ __forceinline__ void gla_chain_item(const Params& p, int l, int b, int h, int dir, int vh, bfr* sm) {
  const int tid = TIDX, lane = tid & 63, wid = tid >> 6, g = lane >> 4, l15 = lane & 15;
  const bfr* Z = (const bfr*)(p.ws + WS_Z);
  bfr* OG = (bfr*)(p.ws + WS_R1) + (long)dir * NROWS * 512;
  const float* EL = (const float*)(p.ws + WS_EL) + (long)(((b * 4 + h) * 2 + dir) * 64) * 64;
  const int N = 4096, nc = 64;
  const int rowbase = NCTX + b * 4096;
  const int vs0 = vh * 64;
  bfr* Vt = sm;
  bfr* St = Vt + 64 * LDT;
  f32x4 st[4];
  {
    const float* S0 = (dir ? p.in[7] : p.in[6]) + ((long)((b * 2 + l) * 4 + h)) * 8192 + (long)(16 * wid + l15) * 128 + vs0;
#pragma unroll
    for (int vt = 0; vt < 4; vt++) {
      float4 a = *(const float4*)(S0 + 16 * vt + 4 * g);
      st[vt] = (f32x4){a.x, a.y, a.z, a.w};
#pragma unroll
      for (int r = 0; r < 4; r++) St[(16 * vt + 4 * g + r) * LDT + 16 * wid + l15] = f2bf(st[vt][r]);
    }
  }
  u32x4 n_qe[2], n_kl[2], n_at[2], n_v[2];
  float n_el;
  auto prefetch = [&](int c) {
    const bfr* base = prep_base(p, b, h, dir, c) + (16 * wid + l15) * 64 + 8 * g;
#pragma unroll
    for (int kk = 0; kk < 2; kk++) {
      n_qe[kk] = *(const u32x4*)(base + kk * 32);
      n_kl[kk] = *(const u32x4*)(base + 4096 + kk * 32);
      n_at[kk] = *(const u32x4*)(base + 8192 + kk * 32);
    }
    n_el = EL[c * 64 + 16 * wid + l15];
#pragma unroll
    for (int ii = 0; ii < 2; ii++) {
      int cc = tid + 256 * ii;
      int i = cc >> 3, c8 = cc & 7;
      int tok = dir ? (N - 1 - (c * 64 + i)) : (c * 64 + i);
      n_v[ii] = *(const u32x4*)(Z + (long)(rowbase + tok) * ZLD + C_VG + h * 128 + vs0 + c8 * 8);
    }
  };
  prefetch(0);
  for (int c = 0; c < nc; c++) {
    u32x4 c_qe[2] = {n_qe[0], n_qe[1]}, c_kl[2] = {n_kl[0], n_kl[1]}, c_at[2] = {n_at[0], n_at[1]};
    const float el = n_el;
#pragma unroll
    for (int ii = 0; ii < 2; ii++) {
      int cc = tid + 256 * ii;
      int i = cc >> 3, c8 = cc & 7;
      const bfr* rb = (const bfr*)&n_v[ii];
#pragma unroll
      for (int e = 0; e < 8; e++) Vt[(c8 * 8 + e) * LDT + i] = rb[e];
    }
    __syncthreads();
    if (c + 1 < nc) prefetch(c + 1);
    f32x4 stn[4];
    const int i = 16 * wid + l15;
    const int tok = dir ? (N - 1 - (c * 64 + i)) : (c * 64 + i);
    bfr* og = OG + (long)(rowbase + tok) * 512 + h * 128 + vs0 + 4 * g;
#pragma unroll
    for (int vt = 0; vt < 4; vt++) {
      f32x4 oc = (f32x4){0.f, 0.f, 0.f, 0.f};
      stn[vt] = st[vt] * el;
#pragma unroll
      for (int kk = 0; kk < 2; kk++) {
        bf16x8 vf = *(const bf16x8*)(Vt + (16 * vt + l15) * LDT + kk * 32 + g * 8);
        bf16x8 sf = *(const bf16x8*)(St + (16 * vt + l15) * LDT + kk * 32 + g * 8);
        oc = mfma16(vf, *(bf16x8*)&c_at[kk], oc);
        oc = mfma16(sf, *(bf16x8*)&c_qe[kk], oc);
        stn[vt] = mfma16(vf, *(bf16x8*)&c_kl[kk], stn[vt]);
      }
      u32x2 ov;
      ov.x = pack2(oc[0], oc[1]);
      ov.y = pack2(oc[2], oc[3]);
      *(u32x2*)(og + 16 * vt) = ov;
    }
    __syncthreads();
#pragma unroll
    for (int vt = 0; vt < 4; vt++) {
      st[vt] = stn[vt];
#pragma unroll
      for (int r = 0; r < 4; r++) St[(16 * vt + 4 * g + r) * LDT + 16 * wid + l15] = f2bf(st[vt][r]);
    }
  }
  __syncthreads();
}

template <int VS>
__device__ __forceinline__ void gla_item(const Params& p, int l, int seq, int h, int dir, int vsl, bfr* sm) {
  constexpr int NVT = VS / 16;
  constexpr int NVL = VS / 32;
  const int tid = TIDX, lane = tid & 63, wid = tid >> 6, g = lane >> 4, l15 = lane & 15;
  bfr* Z = (bfr*)(p.ws + WS_Z);
  bfr* OG = (bfr*)(p.ws + WS_R1) + (long)dir * NROWS * 512;
  const bool lat = seq >= 16;
  const int b = seq - 16;
  const int N = lat ? 4096 : 256;
  const int rowbase = lat ? NCTX + b * 4096 : seq * 256;
  const int nc = N >> 6;
  const int vs0 = vsl * VS;
  bfr* Qr = sm;
  bfr* Kr = Qr + 64 * LDT;
  bfr* Qe = Kr + 64 * LDT;
  bfr* Ke = Qe + 64 * LDT;
  bfr* KlT = Ke + 64 * LDT;
  float* RF = (float*)(KlT + 64 * LDT);
  float* tot = RF + 64 * 16;
  float* lastv = tot + 256;
  bfr* Vt = (bfr*)(lastv + 64);
  bfr* St = Vt + VS * LDT;
  bfr* Att = Qr;
  const int ch = tid & 63;
  float wd[16];
  {
    const float* W = (dir ? p.in[19] : p.in[17]) + (long)l * 16 * 256 + h * 64 + ch;
#pragma unroll
    for (int r = 0; r < 16; r++) wd[r] = W[r * 256];
  }
  const float bias = (dir ? p.in[20] : p.in[18])[l * 256 + h * 64 + ch];

  f32x4 st[NVT];
  {
    const float* S0 = (dir ? p.in[7] : p.in[6]) + ((long)((b * 2 + l) * 4 + h)) * 8192 + (long)(16 * wid + l15) * 128 + vs0;
#pragma unroll
    for (int mv = 0; mv < NVT; mv++) {
      if (lat) {
        float4 a = *(const float4*)(S0 + 16 * mv + 4 * g);
        st[mv] = (f32x4){a.x, a.y, a.z, a.w};
      } else {
        st[mv] = (f32x4){0.f, 0.f, 0.f, 0.f};
      }
#pragma unroll
      for (int r = 0; r < 4; r++) St[(16 * mv + 4 * g + r) * LDT + 16 * wid + l15] = f2bf(st[mv][r]);
    }
  }
  u32x4 rq[2], rk[2], rv[NVL], rr;
  auto prefetch = [&](int c) {
#pragma unroll
    for (int ii = 0; ii < 2; ii++) {
      int cc = tid + 256 * ii;
      int i = cc >> 3, c8 = cc & 7;
      int tok = dir ? (N - 1 - (c * 64 + i)) : (c * 64 + i);
      const bfr* zr = Z + (long)(rowbase + tok) * ZLD;
      rq[ii] = *(const u32x4*)(zr + C_QG + h * 64 + c8 * 8);
      rk[ii] = *(const u32x4*)(zr + C_KG + h * 64 + c8 * 8);
    }
#pragma unroll
    for (int ii = 0; ii < NVL; ii++) {
      int cc = tid + 256 * ii;
      int i = cc / (VS / 8), c4 = cc % (VS / 8);
      int tok = dir ? (N - 1 - (c * 64 + i)) : (c * 64 + i);
      rv[ii] = *(const u32x4*)(Z + (long)(rowbase + tok) * ZLD + C_VG + h * 128 + vs0 + c4 * 8);
    }
    if (tid < 128) {
      int i = tid >> 1, hf = tid & 1;
      int tok = dir ? (N - 1 - (c * 64 + i)) : (c * 64 + i);
      rr = *(const u32x4*)(Z + (long)(rowbase + tok) * ZLD + (dir ? C_RB : C_RF) + hf * 8);
    }
  };
  prefetch(0);
  for (int c = 0; c < nc; c++) {
#pragma unroll
    for (int ii = 0; ii < 2; ii++) {
      int cc = tid + 256 * ii;
      *(u32x4*)(Qr + (cc >> 3) * LDT + (cc & 7) * 8) = rq[ii];
      *(u32x4*)(Kr + (cc >> 3) * LDT + (cc & 7) * 8) = rk[ii];
    }
#pragma unroll
    for (int ii = 0; ii < NVL; ii++) {
      int cc = tid + 256 * ii;
      int i = cc / (VS / 8), c4 = cc % (VS / 8);
      const bfr* rb = (const bfr*)&rv[ii];
#pragma unroll
      for (int e = 0; e < 8; e++) Vt[(c4 * 8 + e) * LDT + i] = rb[e];
    }
    if (tid < 128) {
      int i = tid >> 1, hf = tid & 1;
      float x[8];
      unpack8(rr, x);
#pragma unroll
      for (int e = 0; e < 8; e++) RF[i * 16 + hf * 8 + e] = x[e];
    }
    __syncthreads();
    if (c + 1 < nc) prefetch(c + 1);
    gla_chunk_prep(tid, wd, bias, Qr, Kr, Qe, Ke, KlT, RF, tot, lastv);
    f32x4 stn[NVT];
    {
      float el = __expf(lastv[16 * wid + l15]);
#pragma unroll
      for (int mv = 0; mv < NVT; mv++) {
        stn[mv] = st[mv] * el;
#pragma unroll
        for (int kk = 0; kk < 2; kk++) {
          bf16x8 va = *(const bf16x8*)(Vt + (16 * mv + l15) * LDT + kk * 32 + g * 8);
          bf16x8 kb = *(const bf16x8*)(KlT + (16 * wid + l15) * LDT + kk * 32 + g * 8);
          stn[mv] = mfma16(va, kb, stn[mv]);
        }
      }
      gla_att(wid, g, l15, Qe, Ke, Att);
    }
    __syncthreads();
    {
      bf16x8 aa[2], qa[2];
#pragma unroll
      for (int kk = 0; kk < 2; kk++) {
        aa[kk] = *(const bf16x8*)(Att + (16 * wid + l15) * LDT + kk * 32 + g * 8);
        qa[kk] = *(const bf16x8*)(Qe + (16 * wid + l15) * LDT + kk * 32 + g * 8);
      }
#pragma unroll
      for (int nv = 0; nv < NVT; nv++) {
        f32x4 oc = (f32x4){0.f, 0.f, 0.f, 0.f};
#pragma unroll
        for (int kk = 0; kk < 2; kk++) {
          bf16x8 vb = *(const bf16x8*)(Vt + (16 * nv + l15) * LDT + kk * 32 + g * 8);
          oc = mfma16(aa[kk], vb, oc);
          bf16x8 sb = *(const bf16x8*)(St + (16 * nv + l15) * LDT + kk * 32 + g * 8);
          oc = mfma16(qa[kk], sb, oc);
        }
#pragma unroll
        for (int r = 0; r < 4; r++) {
          int i = 16 * wid + 4 * g + r;
          int tok = dir ? (N - 1 - (c * 64 + i)) : (c * 64 + i);
          OG[(long)(rowbase + tok) * 512 + h * 128 + vs0 + 16 * nv + l15] = f2bf(oc[r]);
        }
      }
    }
    __syncthreads();
#pragma unroll
    for (int mv = 0; mv < NVT; mv++) {
      st[mv] = stn[mv];
#pragma unroll
      for (int r = 0; r < 4; r++) St[(16 * mv + 4 * g + r) * LDT + 16 * wid + l15] = f2bf(st[mv][r]);
    }
  }
  __syncthreads();
  if (!lat) {
    float* so = p.out + (dir ? O_SB : O_SF) + ((long)((seq * 2 + l) * 4 + h)) * 8192 + (long)(16 * wid + l15) * 128 + vs0;
#pragma unroll
    for (int mv = 0; mv < NVT; mv++)
      *(float4*)(so + 16 * mv + 4 * g) = make_float4(st[mv][0], st[mv][1], st[mv][2], st[mv][3]);
  }
}

__device__ __forceinline__ void phase_mla_up(const Params& p, int l, bfr* sm) {
  bfr* Z = (bfr*)(p.ws + WS_Z);
  const float* rope = (const float*)(p.ws + WS_ROPE);
  const int lane = TIDX & 63, wid = TIDX >> 6, wr = wid >> 1, wc = wid & 1;
  const int g = lane >> 4;
  for (int t = blockIdx.x; t < 288 + 624 + 1024; t += gridDim.x) {
    if (t >= 912) {
      int i = t - 912;
      gla_prep_item(p, l, i >> 9, (i >> 7) & 3, (i >> 6) & 1, i & 63, sm);
      continue;
    }
    f32x4 acc[4][4];
#pragma unroll
    for (int a = 0; a < 4; a++)
#pragma unroll
      for (int b = 0; b < 4; b++) acc[a][b] = (f32x4){0.f, 0.f, 0.f, 0.f};
    if (t < 288) {
      int tn = t % 3, tm = t / 3;
      gemm128k64<4>((const bfr*)(p.ws + WS_WUQ) + (long)tn * 128 * 256, 256, 128, Z + (long)tm * 128 * ZLD + C_QL, ZLD, 256,
                    acc, sm);
      bfr* CQ = (bfr*)(p.ws + WS_CQ);
      const float qs = 0.10206207261596577f * 1.4426950408889634f;
#pragma unroll
      for (int pi = 0; pi < 4; pi++) {
        int nb = tn * 128 + wr * 64 + pi * 16;
        int wb = nb % 96;
        bool ropet = wb >= 64;
        int part = (wb - 64) >> 4;
#pragma unroll
        for (int qi = 0; qi < 4; qi++) {
          int tok = tm * 128 + wc * 64 + qi * 16 + (lane & 15);
          float y[4] = {acc[pi][qi][0], acc[pi][qi][1], acc[pi][qi][2], acc[pi][qi][3]};
          if (ropet) {
            bool lat = tok >= NCTX;
            int tl = (tok - NCTX) & 4095;
            int pos = part ? (tl & 63) : (tl >> 6);
            bool hi = (g & 2) != 0;
            int i0 = (g & 1) * 4;
#pragma unroll
            for (int r = 0; r < 4; r++) {
              float yp = __shfl_xor(y[r], 32);
              float c = rope[2048 + pos * 8 + i0 + r], s = rope[2560 + pos * 8 + i0 + r];
              float yr = hi ? (yp * s + y[r] * c) : (y[r] * c - yp * s);
              y[r] = lat ? yr : y[r];
            }
          }
          u32x2 o;
          o.x = pack2(y[0] * qs, y[1] * qs);
          o.y = pack2(y[2] * qs, y[3] * qs);
          *(u32x2*)(CQ + (long)tok * 384 + nb + g * 4) = o;
        }
      }
    } else {
      int t2 = t - 288;
      int tn = t2 % 6, tm = t2 / 6;
      const bfr* Q;
      long ldq;
      long kbase, vbase;
      int nk, key0;
      if (tm < 32) {
        Q = Z + (long)tm * 128 * ZLD + C_KV;
        ldq = ZLD;
        int s = tm >> 1;
        key0 = (tm & 1) * 128;
        nk = 256;
        kbase = (long)s * (4 * 256 * 64);
        vbase = (long)s * 131072;
      } else {
        int r = (tm - 32) * 128;
        int b = r / 4608, within = r % 4608;
        key0 = within;
        nk = 4608;
        kbase = 16l * (4 * 256 * 64) + (long)b * (4 * 4608 * 64);
        vbase = 16l * 131072 + (long)b * (4 * 128 * 4608);
        if (within < 512) {
          Q = (const bfr*)(p.ws + WS_CKVC) + (long)(b * 512 + within) * 256;
          ldq = 256;
        } else {
          Q = Z + (long)(NCTX + b * 4096 + within - 512) * ZLD + C_KV;
          ldq = ZLD;
        }
      }
      gemm128k64<4>((const bfr*)(p.ws + WS_WUKV) + (long)tn * 128 * 256, 256, 128, Q, ldq, 256, acc, sm);
      bfr* KN = (bfr*)(p.ws + WS_KNOPE);
      bfr* VTC = (bfr*)(p.ws + WS_VTC);
#pragma unroll
      for (int pi = 0; pi < 4; pi++) {
        int n0 = tn * 128 + wr * 64 + pi * 16 + g * 4;
        int head = n0 / 192, w = n0 % 192;
#pragma unroll
        for (int qi = 0; qi < 4; qi++) {
          int key = key0 + wc * 64 + qi * 16 + (lane & 15);
          if (w < 64) {
            u32x2 o;
            o.x = pack2(acc[pi][qi][0], acc[pi][qi][1]);
            o.y = pack2(acc[pi][qi][2], acc[pi][qi][3]);
            *(u32x2*)(KN + kbase + ((long)head * nk + key) * 64 + w) = o;
          } else {
#pragma unroll
            for (int r = 0; r < 4; r++)
              VTC[vbase + ((long)head * 128 + (w - 64) + r) * nk + key] = f2bf(acc[pi][qi][r]);
          }
        }
      }
    }
  }
}

template <int DQ, int DV, bool MLA, int NQB>
__device__ __forceinline__ void attn_item(const Params& p, int seq, int head, int qoff, bfr* sm, int dry, int amode = 0) {
  constexpr int KLD = DQ + 8;
  constexpr int KSZ = 64 * KLD;
  constexpr int VSZ = DV * LDT;
  constexpr int BUF = KSZ + VSZ;
  constexpr int NKK = DQ / 32;
  constexpr int NDV = DV / 16;
  constexpr int NVL = DV / 32;
  const int tid = TIDX, lane = tid & 63, wid = tid >> 6, g = lane >> 4, l15 = lane & 15;
  bfr* Z = (bfr*)(p.ws + WS_Z);
  const bool lat = seq >= 16;
  const int b = seq - 16;
  const int nk = lat ? 4608 : 256;
  const int rowbase = lat ? NCTX + b * 4096 : seq * 256;
  const int nkt = nk >> 6;

  bf16x8 qf[NQB][NKK];
#pragma unroll
  for (int qb = 0; qb < NQB; qb++) {
    int qrow = rowbase + qoff + wid * (16 * NQB) + qb * 16 + l15;
    const bfr* qp = MLA ? ((const bfr*)(p.ws + WS_CQ) + (long)qrow * 384 + head * 96) : (Z + (long)qrow * ZLD + C_QA + head * 64);
#pragma unroll
    for (int kk = 0; kk < NKK; kk++) qf[qb][kk] = *(const bf16x8*)(qp + kk * 32 + g * 8);
  }

  u32x4 rk[2], rkr, rv[NVL];
  auto prefetch = [&](int kt) {
    int k0 = kt * 64;
    bool cache = lat && (k0 < 512);
    int tokrow0 = lat ? (NCTX + b * 4096 + k0 - 512) : (seq * 256 + k0);
    if (!MLA) {
      int kvh = head >> 2;
#pragma unroll
      for (int i = 0; i < 2; i++) {
        int c = tid + 256 * i;
        int kr_ = c >> 3, ch = c & 7;
        const bfr* src = cache ? ((const bfr*)(p.ws + WS_KCA) + (long)(b * 512 + k0 + kr_) * 128 + kvh * 64 + ch * 8)
                               : (Z + (long)(tokrow0 + kr_) * ZLD + C_KA + kvh * 64 + ch * 8);
        rk[i] = *(const u32x4*)src;
      }
      long vb = lat ? (16l * 32768 + (long)b * (2 * 64 * 4608)) : ((long)seq * 32768);
#pragma unroll
      for (int i = 0; i < NVL; i++) {
        int c = tid + 256 * i;
        int dv = c >> 3, ch = c & 7;
        rv[i] = *(const u32x4*)((const bfr*)(p.ws + WS_VTA) + vb + (long)(kvh * 64 + dv) * nk + k0 + ch * 8);
      }
    } else {
      long kb = lat ? (16l * (4 * 256 * 64) + (long)b * (4 * 4608 * 64)) : ((long)seq * (4 * 256 * 64));
#pragma unroll
      for (int i = 0; i < 2; i++) {
        int c = tid + 256 * i;
        int kr_ = c >> 3, ch = c & 7;
        rk[i] = *(const u32x4*)((const bfr*)(p.ws + WS_KNOPE) + kb + ((long)head * nk + k0 + kr_) * 64 + ch * 8);
      }
      {
        int kr_ = tid >> 2, ch = tid & 3;
        const bfr* src = cache ? ((const bfr*)(p.ws + WS_KRC) + (long)(b * 512 + k0 + kr_) * 32 + ch * 8)
                               : (Z + (long)(tokrow0 + kr_) * ZLD + C_KR + ch * 8);
        rkr = *(const u32x4*)src;
      }
      long vb = lat ? (16l * 131072 + (long)b * (4 * 128 * 4608)) : ((long)seq * 131072);
#pragma unroll
      for (int i = 0; i < NVL; i++) {
        int c = tid + 256 * i;
        int dv = c >> 3, ch = c & 7;
        rv[i] = *(const u32x4*)((const bfr*)(p.ws + WS_VTC) + vb + (long)(head * 128 + dv) * nk + k0 + ch * 8);
      }
    }
  };

  f32x4 o[NQB][NDV];
#pragma unroll
  for (int qb = 0; qb < NQB; qb++)
#pragma unroll
    for (int d = 0; d < NDV; d++) o[qb][d] = (f32x4){0.f, 0.f, 0.f, 0.f};
  float mrun[NQB];
  f32x4 lacc[NQB];
#pragma unroll
  for (int qb = 0; qb < NQB; qb++) { mrun[qb] = 0.f; lacc[qb] = (f32x4){0.f, 0.f, 0.f, 0.f}; }
  const bf16x8 ones = (bf16x8){(short)0x3F80, (short)0x3F80, (short)0x3F80, (short)0x3F80, (short)0x3F80, (short)0x3F80, (short)0x3F80, (short)0x3F80};

  prefetch(0);
  for (int kt = 0; kt < nkt; kt++) {
    bfr* Ks = sm + (kt & 1) * BUF;
    bfr* Vs = Ks + KSZ;
    if (amode != 1) {
#pragma unroll
    for (int i = 0; i < 2; i++) {
      int c = tid + 256 * i;
      *(u32x4*)(Ks + (c >> 3) * KLD + (c & 7) * 8) = rk[i];
    }
    if (MLA) *(u32x4*)(Ks + (tid >> 2) * KLD + 64 + (tid & 3) * 8) = rkr;
#pragma unroll
    for (int i = 0; i < NVL; i++) {
      int c = tid + 256 * i;
      *(u32x4*)(Vs + (c >> 3) * LDT + (c & 7) * 8) = rv[i];
    }
    }
    __syncthreads();
    if (kt + 1 < nkt && amode != 1) prefetch(kt + 1);
    if (amode == 2) continue;

    f32x4 s[NQB][4];
    bf16x8 kfr[4][NKK];
#pragma unroll
    for (int t = 0; t < 2; t++) {
      int krow = 32 * (t >> 1) + 8 * (l15 >> 2) + 4 * (t & 1) + (l15 & 3);
#pragma unroll
      for (int kk = 0; kk < NKK; kk++) kfr[t][kk] = *(const bf16x8*)(Ks + krow * KLD + kk * 32 + g * 8);
    }
#pragma unroll
    for (int t = 0; t < 4; t++) {
#pragma unroll
      for (int qb = 0; qb < NQB; qb++) s[qb][t] = (f32x4){-mrun[qb], -mrun[qb], -mrun[qb], -mrun[qb]};
      if (t + 2 < 4) {
        int krow = 32 * ((t + 2) >> 1) + 8 * (l15 >> 2) + 4 * ((t + 2) & 1) + (l15 & 3);
#pragma unroll
        for (int kk = 0; kk < NKK; kk++) kfr[t + 2][kk] = *(const bf16x8*)(Ks + krow * KLD + kk * 32 + g * 8);
      }
#pragma unroll
      for (int kk = 0; kk < NKK; kk++) {
#pragma unroll
        for (int qb = 0; qb < NQB; qb++) s[qb][t] = mfma16(kfr[t][kk], qf[qb][kk], s[qb][t]);
      }
    }
    bf16x8 vfr[4][2];
#pragma unroll
    for (int d = 0; d < 4; d++)
#pragma unroll
      for (int sx = 0; sx < 2; sx++) vfr[d][sx] = *(const bf16x8*)(Vs + (d * 16 + l15) * LDT + sx * 32 + g * 8);
    bf16x8 pf[NQB][2];
#pragma unroll
    for (int qb = 0; qb < NQB; qb++) {
      float mt = s[qb][0][0];
#pragma unroll
      for (int t = 0; t < 4; t++)
#pragma unroll
        for (int r = 0; r < 4; r++) mt = fmaxf(mt, s[qb][t][r]);
      const bool first = (kt == 0);
      if (first || __builtin_amdgcn_ballot_w64(mt > 8.f) != 0ull) {
        mt = fmaxf(mt, __shfl_xor(mt, 16));
        mt = fmaxf(mt, __shfl_xor(mt, 32));
        const bool need = first || mt > 8.f;
        const float dm = need ? mt : 0.f;
        const float alpha = first ? 1.f : __builtin_amdgcn_exp2f(-dm);
        mrun[qb] += dm;
        lacc[qb] *= alpha;
#pragma unroll
        for (int d = 0; d < NDV; d++) o[qb][d] *= alpha;
#pragma unroll
        for (int t = 0; t < 4; t++) s[qb][t] -= dm;
      }
#pragma unroll
      for (int t = 0; t < 4; t++)
#pragma unroll
        for (int r = 0; r < 4; r++) s[qb][t][r] = __builtin_amdgcn_exp2f(s[qb][t][r]);
#pragma unroll
      for (int sx = 0; sx < 2; sx++) {
        u32x4 u;
        u.x = pack2(s[qb][2 * sx][0], s[qb][2 * sx][1]);
        u.y = pack2(s[qb][2 * sx][2], s[qb][2 * sx][3]);
        u.z = pack2(s[qb][2 * sx + 1][0], s[qb][2 * sx + 1][1]);
        u.w = pack2(s[qb][2 * sx + 1][2], s[qb][2 * sx + 1][3]);
        pf[qb][sx] = *(bf16x8*)&u;
      }
    }
#pragma unroll
    for (int d = 0; d < NDV; d++) {
#pragma unroll
      for (int sx = 0; sx < 2; sx++) {
#pragma unroll
        for (int qb = 0; qb < NQB; qb++) o[qb][d] = mfma16(vfr[d & 3][sx], pf[qb][sx], o[qb][d]);
      }
      if (d + 4 < NDV) {
#pragma unroll
        for (int sx = 0; sx < 2; sx++)
          vfr[d & 3][sx] = *(const bf16x8*)(Vs + ((d + 4) * 16 + l15) * LDT + sx * 32 + g * 8);
      }
    }
#pragma unroll
    for (int sx = 0; sx < 2; sx++) {
#pragma unroll
      for (int qb = 0; qb < NQB; qb++) lacc[qb] = mfma16(ones, pf[qb][sx], lacc[qb]);
    }
  }
  __syncthreads();
#pragma unroll
  for (int qb = 0; qb < NQB; qb++) {
    float inv = 1.f / lacc[qb][0];
    int qrow = rowbase + qoff + wid * (16 * NQB) + qb * 16 + l15;
    bfr* gp = Z + (long)qrow * ZLD + (MLA ? C_GC : C_GA) + head * DV + g * 4;
#pragma unroll
    for (int d = 0; d < NDV; d++) {
      u32x2 gr = *(const u32x2*)(gp + d * 16);
      float y0 = o[qb][d][0] * inv * siluf(lo16(gr.x));
      float y1 = o[qb][d][1] * inv * siluf(hi16(gr.x));
      float y2 = o[qb][d][2] * inv * siluf(lo16(gr.y));
      float y3 = o[qb][d][3] * inv * siluf(hi16(gr.y));
      u32x2 ov;
      ov.x = pack2(y0, y1);
      ov.y = pack2(y2, y3);
      if (!dry) *(u32x2*)(gp + d * 16) = ov;
    }
  }
}

__device__ __forceinline__ void phase_mixers(const Params& p, int l, bfr* sm, int* s_item, int dry) {
  unsigned* ctr = (unsigned*)(p.ws + WS_CTR) + (2 + l + 2 * dry) * 128;
  auto cnt = [](int) { return 184; };
  int q = (int)xcc_id(), tried = 0;
  for (;;) {
    if (TIDX == 0) {
      unsigned first = atomicAdd(ctr + q * 16, 1u);
      *s_item = xq_take(ctr, q, tried, first, cnt);
    }
    __syncthreads();
    const int it = *s_item;
    __syncthreads();
    if (it < 0) break;
    const int x = it >> 20, j = it & 0xfffff;
    int kind, a0, a1, a2, a3 = 0;
    if (j < 4) {
      int idx = x * 4 + j;
      kind = 3; a0 = idx >> 4; a1 = (idx >> 2) & 3; a2 = (idx >> 1) & 1; a3 = idx & 1;
    } else if (j < 36) {
      kind = 1; a0 = 16 + (x >> 2); a1 = x & 3; a2 = (j - 4) * 128;
    } else if (j < 96) {
      int i = j - 36;
      kind = 2; a0 = 16 + (x >> 2); a1 = ((x >> 1) & 1) * 4 + (x & 1) * 2 + (i >> 5); a2 = (i & 31) * 128;
    } else if (j < 104) {
      int k = j - 96;
      int i = 60 + (k >> 1);
      kind = 4; a0 = 16 + (x >> 2); a1 = ((x >> 1) & 1) * 4 + (x & 1) * 2 + (i >> 5); a2 = (i & 31) * 128 + (k & 1) * 64;
    } else if (j < 136) {
      int i = j - 104;
      kind = 0; a0 = 2 * x + (i >> 4); a1 = (i >> 2) & 3; a2 = (i >> 1) & 1; a3 = i & 1;
    } else if (j < 152) {
      int i = j - 136;
      kind = 1; a0 = 2 * x + (i >> 3); a1 = (i >> 1) & 3; a2 = (i & 1) * 128;
    } else {
      int i = j - 152;
      kind = 2; a0 = 2 * x + (i >> 4); a1 = (i >> 1) & 7; a2 = (i & 1) * 128;
    }
#ifdef PROBE_MIXKIND
    if (dry && ((PROBE_MIXKIND == 1) != (kind == 0 || kind == 3))) continue;
#endif
    if (kind == 0) gla_item<64>(p, l, a0, a1, a2, a3, sm);
    else if (kind == 3) gla_chain_item(p, l, a0, a1, a2, a3, sm);
    else if (kind == 1) attn_item<96, 128, true, 2>(p, a0, a1, a2, sm, dry);
    else if (kind == 2) attn_item<64, 64, false, 2>(p, a0, a1, a2, sm, dry);
    else attn_item<64, 64, false, 1>(p, a0, a1, a2, sm, dry);
  }
}

__device__ __forceinline__ void phase_gla_out(const Params& p, int l) {
  const int lane = TIDX & 63;
  bfr* Z = (bfr*)(p.ws + WS_Z);
  const bfr* OF = (const bfr*)(p.ws + WS_R1);
  const bfr* OB = OF + (long)NROWS * 512;
  for (int row = blockIdx.x * 4 + (TIDX >> 6); row < NROWS; row += gridDim.x * 4) {
    float a[8], c[8], gt[8];
    unpack8(*(const u32x4*)(OF + (long)row * 512 + lane * 8), a);
    unpack8(*(const u32x4*)(OB + (long)row * 512 + lane * 8), c);
    bfr* gp = Z + (long)row * ZLD + C_GG + lane * 8;
    unpack8(*(const u32x4*)gp, gt);
    float ss = 0.f;
#pragma unroll
    for (int e = 0; e < 8; e++) {
      a[e] = bf2f(f2bf(a[e] + c[e]));
      ss += a[e] * a[e];
    }
    ss += __shfl_xor(ss, 1); ss += __shfl_xor(ss, 2); ss += __shfl_xor(ss, 4); ss += __shfl_xor(ss, 8);
    float rs = rsqrtf(ss * (1.f / 128.f) + 1e-6f);
    const float* gg = p.in[21] + l * 128 + (lane & 15) * 8;
#pragma unroll
    for (int e = 0; e < 8; e++) a[e] = a[e] * rs * gg[e] * siluf(gt[e]);
    *(u32x4*)gp = pack8(a);
  }
}

template <int NQ>
__device__ __forceinline__ void merge_tile(const Params& p, bfr* sm, int tn, int tok0) {
  bfr* Z = (bfr*)(p.ws + WS_Z);
  bfr* MG = (bfr*)(p.ws + WS_R1);
  const int lane = TIDX & 63, wid = TIDX >> 6, wr = wid >> 1, wc = wid & 1, g = lane >> 4;
  f32x4 totl[4][NQ];
#pragma unroll
  for (int a = 0; a < 4; a++)
#pragma unroll
    for (int b = 0; b < NQ; b++) totl[a][b] = (f32x4){0.f, 0.f, 0.f, 0.f};
#pragma unroll 1
  for (int seg = 0; seg < 3; seg++) {
    f32x4 acc[4][NQ];
#pragma unroll
    for (int a = 0; a < 4; a++)
#pragma unroll
      for (int b = 0; b < NQ; b++) acc[a][b] = (f32x4){0.f, 0.f, 0.f, 0.f};
    int ycol = seg == 0 ? C_GA : (seg == 1 ? C_GG : C_GC);
    int mcol = C_M1 + seg * 1024;
    const bfr* W = (const bfr*)(p.ws + WS_WOA + (unsigned long)seg * 1048576ul) + (long)tn * 128 * 512;
    gemm128k64<NQ>(W, 512, 128, Z + (long)tok0 * ZLD + ycol, ZLD, 512, acc, sm);
#pragma unroll
    for (int pi = 0; pi < 4; pi++) {
      int n0 = tn * 128 + wr * 64 + pi * 16 + g * 4;
#pragma unroll
      for (int qi = 0; qi < NQ; qi++) {
        int tok = tok0 + wc * 16 * NQ + qi * 16 + (lane & 15);
        u32x2 mr = *(const u32x2*)(Z + (long)tok * ZLD + mcol + n0);
        totl[pi][qi][0] += sigmf(lo16(mr.x)) * acc[pi][qi][0];
        totl[pi][qi][1] += sigmf(hi16(mr.x)) * acc[pi][qi][1];
        totl[pi][qi][2] += sigmf(lo16(mr.y)) * acc[pi][qi][2];
        totl[pi][qi][3] += sigmf(hi16(mr.y)) * acc[pi][qi][3];
      }
    }
  }
#pragma unroll
  for (int pi = 0; pi < 4; pi++) {
    int n0 = tn * 128 + wr * 64 + pi * 16 + g * 4;
#pragma unroll
    for (int qi = 0; qi < NQ; qi++) {
      int tok = tok0 + wc * 16 * NQ + qi * 16 + (lane & 15);
      u32x2 o;
      o.x = pack2(totl[pi][qi][0], totl[pi][qi][1]);
      o.y = pack2(totl[pi][qi][2], totl[pi][qi][3]);
      *(u32x2*)(MG + (long)tok * 1024 + n0) = o;
    }
  }
}

__device__ __forceinline__ void phase_merge(const Params& p, bfr* sm) {
  for (int t = blockIdx.x; t < 1024; t += gridDim.x) {
    if (t < 512) {
      merge_tile<4>(p, sm, t & 7, (t >> 3) * 128);
    } else {
      int u = t - 512;
      int full = 512 + (u >> 1);
      merge_tile<2>(p, sm, full & 7, (full >> 3) * 128 + (u & 1) * 64);
    }
  }
}

template <int NQ>
__device__ __forceinline__ void outproj_tile(const Params& p, bfr* sm, int tn, int tok0) {
  const bfr* MG = (const bfr*)(p.ws + WS_R1);
  float* OUT = (float*)(p.ws + WS_Z);
  const int lane = TIDX & 63, wid = TIDX >> 6, wr = wid >> 1, wc = wid & 1, g = lane >> 4;
  f32x4 acc[4][NQ];
#pragma unroll
  for (int a = 0; a < 4; a++)
#pragma unroll
    for (int b = 0; b < NQ; b++) acc[a][b] = (f32x4){0.f, 0.f, 0.f, 0.f};
  gemm128k64<NQ>((const bfr*)(p.ws + WS_WOUT) + (long)tn * 128 * 1024, 1024, 128, MG + (long)tok0 * 1024, 1024, 1024, acc, sm);
#pragma unroll
  for (int pi = 0; pi < 4; pi++) {
    int n0 = tn * 128 + wr * 64 + pi * 16 + g * 4;
#pragma unroll
    for (int qi = 0; qi < NQ; qi++) {
      int tok = tok0 + wc * 16 * NQ + qi * 16 + (lane & 15);
      *(float4*)(OUT + (long)tok * 1024 + n0) = make_float4(acc[pi][qi][0], acc[pi][qi][1], acc[pi][qi][2], acc[pi][qi][3]);
    }
  }
}
__device__ __forceinline__ void phase_outproj(const Params& p, bfr* sm) {
  for (int t = blockIdx.x; t < 1024; t += gridDim.x) {
    if (t < 512) {
      outproj_tile<4>(p, sm, t & 7, (t >> 3) * 128);
    } else {
      int u = t - 512;
      int full = 512 + (u >> 1);
      outproj_tile<2>(p, sm, full & 7, (full >> 3) * 128 + (u & 1) * 64);
    }
  }
}

__device__ __forceinline__ void phase_post(const Params& p, int l) {
  const int lane = TIDX & 63;
  const float* mod = (const float*)(p.ws + WS_MOD);
  const float* OUT = (const float*)(p.ws + WS_Z);
  bfr* H = (bfr*)(p.ws + WS_R1);
  for (int row = blockIdx.x * 4 + (TIDX >> 6); row < NROWS; row += gridDim.x * 4) {
    const float* x = (l == 0) ? xrow(p, row) : (p.out + (long)row * 1024);
    const float* md = mod + (l * 3 + row_cond(row)) * 3072;
    float4 v[4];
    float ss = 0.f;
#pragma unroll
    for (int i = 0; i < 4; i++) {
      v[i] = *(const float4*)(OUT + (long)row * 1024 + i * 256 + lane * 4);
      ss += v[i].x * v[i].x + v[i].y * v[i].y + v[i].z * v[i].z + v[i].w * v[i].w;
    }
    ss = wave_sum(ss);
    float rs = rsqrtf(ss * (1.f / 1024.f) + 1e-6f);
    float ss2 = 0.f;
#pragma unroll
    for (int i = 0; i < 4; i++) {
      int n = i * 256 + lane * 4;
      float4 g = *(const float4*)(p.in[13] + l * 1024 + n);
      float4 gt = *(const float4*)(md + 2048 + n);
      float4 xv = *(const float4*)(x + n);
      v[i].x = xv.x + gt.x * (v[i].x * rs * g.x);
      v[i].y = xv.y + gt.y * (v[i].y * rs * g.y);
      v[i].z = xv.z + gt.z * (v[i].z * rs * g.z);
      v[i].w = xv.w + gt.w * (v[i].w * rs * g.w);
      *(float4*)(p.out + (long)row * 1024 + n) = v[i];
      ss2 += v[i].x * v[i].x + v[i].y * v[i].y + v[i].z * v[i].z + v[i].w * v[i].w;
    }
    if (l == 0) {
      ss2 = wave_sum(ss2);
      float rs2 = rsqrtf(ss2 * (1.f / 1024.f) + 1e-6f);
      const float* md1 = mod + (1 * 3 + row_cond(row)) * 3072;
#pragma unroll
      for (int i = 0; i < 4; i++) {
        int n = i * 256 + lane * 4;
        float4 g = *(const float4*)(p.in[12] + 1024 + n);
        float4 sh = *(const float4*)(md1 + n);
        float4 sc = *(const float4*)(md1 + 1024 + n);
        float h0 = v[i].x * rs2 * g.x * (1.f + sc.x) + sh.x;
        float h1 = v[i].y * rs2 * g.y * (1.f + sc.y) + sh.y;
        float h2 = v[i].z * rs2 * g.z * (1.f + sc.z) + sh.z;
        float h3 = v[i].w * rs2 * g.w * (1.f + sc.w) + sh.w;
        u32x2 o;
        o.x = pack2(h0, h1);
        o.y = pack2(h2, h3);
        *(u32x2*)(H + (long)row * 1024 + n) = o;
      }
    }
  }
}

__global__ void __launch_bounds__(256, 2) fwd_megakernel(Params p) {
  __shared__ __attribute__((aligned(16))) bfr sm[SMEM_SHORTS + 16];
  int* s_item_p = (int*)(sm + SMEM_SHORTS + 8);
  cg::grid_group grid = cg::this_grid();
  if (threadIdx.x == 0) { ((unsigned*)(sm + SMEM_SHORTS))[0] = 0u; ((unsigned*)(sm + SMEM_SHORTS))[1] = 0u; }
  __syncthreads();
  XcdBarrier xb = xcd_barrier_post((unsigned*)(p.ws + WS_BAR), (volatile LAS unsigned*)(sm + SMEM_SHORTS));
  if (p.ws == nullptr) grid.sync();
  (void)xb;
#define GSYNC1 do { XcdBarrier b_; b_.bar = (unsigned*)(p.ws + WS_BAR); b_.x = xb_xcc_id(); \
                    b_.st = (volatile LAS unsigned*)(sm + SMEM_SHORTS); xcd_barrier(b_); } while (0)
#ifdef PROBE_SYNC
#define GSYNC do { GSYNC1; GSYNC1; } while (0)
#else
#define GSYNC GSYNC1
#endif
#ifdef PROBE_PRE
  phase_s0(launder(p), sm);
  GSYNC;
  phase_s1(launder(p));
  wconv_phase(p, 0, sm);
  GSYNC;
  phase_prenorm0(launder(p));
  GSYNC;
#endif

#ifndef PH
#define PH 0xffff
#endif
#if PH & 1
  phase_s0(launder(p), sm);
#endif
  GSYNC;
#if PH & 2
  phase_s1(launder(p));
  wconv_phase(p, 0, sm);
#endif
  GSYNC;
#if PH & 4
  phase_prenorm0(launder(p));
#endif
  GSYNC;
  for (int l = 0; l < 2; l++) {
#if PH & 8
#ifdef PROBE_INPROJ
    phase_inproj(launder(p), l, sm, s_item_p, 6 + l);
    GSYNC;
#endif
    phase_inproj(launder(p), l, sm, s_item_p, l);
#endif
    GSYNC;
#if PH & 16
    phase_rowpost(launder(p), l);
#endif
    GSYNC;
#if PH & 32
#ifdef PROBE_MLAUP
    phase_mla_up(launder(p), l, sm);
    GSYNC;
#endif
    phase_mla_up(launder(p), l, sm);
#endif
    GSYNC;
#if PH & 64
#ifdef PROBE_MIX
    { int dry = 1; asm volatile("" : "+s"(dry)); phase_mixers(launder(p), l, sm, s_item_p, dry); }
    GSYNC;
#endif
    { int dry = 0; asm volatile("" : "+s"(dry)); phase_mixers(launder(p), l, sm, s_item_p, dry); }
#endif
    GSYNC;
#if PH & 128
    phase_gla_out(launder(p), l);
#endif
    GSYNC;
#if PH & 256
#ifdef PROBE_MERGE
    phase_merge(launder(p), sm);
    GSYNC;
#endif
    phase_merge(launder(p), sm);
#endif
    GSYNC;
#if PH & 512
#ifdef PROBE_MERGE
    phase_outproj(launder(p), sm);
    GSYNC;
#endif
    phase_outproj(launder(p), sm);
#endif
    GSYNC;
#if PH & 1024
    phase_post(launder(p), l);
    if (l == 0) wconv_phase(p, 1, sm);
#endif
    GSYNC;
  }
}

extern "C" void kernel_launch(void* const* d_in, const int* in_sizes, int n_in, void* d_out, int out_size, void* d_ws,
                              size_t ws_size, hipStream_t stream) {
  static int grid_blocks = 0;
  if (!grid_blocks) {
    int dev = 0, cus = 0, per_cu = 0;
    hipGetDevice(&dev);
    hipDeviceGetAttribute(&cus, hipDeviceAttributeMultiprocessorCount, dev);
    hipOccupancyMaxActiveBlocksPerMultiprocessor(&per_cu, fwd_megakernel, 256, 0);
    if (per_cu > 2) per_cu = 2;
    if (per_cu < 1) per_cu = 1;
    grid_blocks = cus * per_cu;
  }
  Params p{};
  for (int i = 0; i < 30; i++) p.in[i] = (const float*)d_in[i];
  p.out = (float*)d_out;
  p.ws = (unsigned char*)d_ws;
  hipMemsetAsync(d_ws, 0, 20480, stream);
  void* args[] = {&p};
  hipError_t e = hipLaunchCooperativeKernel((void*)fwd_megakernel, dim3(grid_blocks), dim3(256), args, 0, stream);
  if (e != hipSuccess) fprintf(stderr, "cooperative launch failed: %s (grid %d)\n", hipGetErrorString(e), grid_blocks);
}
```

```cpp
#include <hip/hip_runtime.h>
#include <hip/hip_cooperative_groups.h>
#include <cstdio>
namespace cg = cooperative_groups;

typedef unsigned short bfr;
typedef __attribute__((ext_vector_type(8))) short bf16x8;
typedef __attribute__((ext_vector_type(4))) float f32x4;
typedef __attribute__((ext_vector_type(4))) unsigned u32x4;
typedef __attribute__((ext_vector_type(2))) unsigned u32x2;

#define NROWS 12288
#define NCTX 4096
#define ZLD 6976
#define LDT 72
#define SMEM_SHORTS (4 * 128 * LDT)

#define C_QA 0
#define C_KA 512
#define C_VA 640
#define C_GA 768
#define C_QG 1280
#define C_KG 1536
#define C_VG 1792
#define C_GG 2304
#define C_RF 2816
#define C_RB 2832
#define C_QL 2848
#define C_KV 3104
#define C_KR 3360
#define C_GC 3392
#define C_M1 3904
#define C_M2 4928
#define C_M3 5952

#define WS_BAR 0ul
#define WS_CTR 16384ul
#define WS_MODP 20480ul
#define WS_MOD (WS_MODP + 589824ul)
#define WS_ROPE (WS_MOD + 73728ul)
#define WS_WIN (WS_ROPE + 16384ul)
#define WS_WUQ (WS_WIN + 14417920ul)
#define WS_WUKV (WS_WUQ + 196608ul)
#define WS_WOA (WS_WUKV + 393216ul)
#define WS_WOB (WS_WOA + 1048576ul)
#define WS_WOC (WS_WOB + 1048576ul)
#define WS_WOUT (WS_WOC + 1048576ul)
#define WS_KCA (WS_WOUT + 2097152ul)
#define WS_CKVC (WS_KCA + 262144ul)
#define WS_KRC (WS_CKVC + 524288ul)
#define WS_VTA (WS_KRC + 65536ul)
#define WS_CQ (WS_VTA + 3407872ul)
#define WS_KNOPE (WS_CQ + 9437184ul)
#define WS_VTC (WS_KNOPE + 6815744ul)
#define WS_R1 (WS_VTC + 13631488ul)
#define WS_Z (WS_R1 + 25165824ul)
#define WS_END (WS_Z + 171442176ul)

#define O_Y 0
#define O_GK 12582912
#define O_GV 13631488
#define O_CKV 14680064
#define O_KR 16777216
#define O_SF 17039360
#define O_SB 18087936

struct Params {
  const float* in[30];
  float* out;
  unsigned char* ws;
};

__device__ __forceinline__ int tidx() {
  int t = threadIdx.x;
  asm volatile("" : "+v"(t));
  return t;
}
__device__ __forceinline__ Params launder(const Params& p) {
  Params q;
  long zo = 0;
  asm volatile("" : "+s"(zo));
#pragma unroll
  for (int i = 0; i < 30; i++) q.in[i] = p.in[i] + zo;
  q.out = p.out + zo;
  q.ws = p.ws + zo;
  return q;
}
__device__ __forceinline__ float bf2f(bfr b) { return __uint_as_float(((unsigned)b) << 16); }
typedef float f32x2_t __attribute__((ext_vector_type(2)));
typedef __bf16 bf16x2_t __attribute__((ext_vector_type(2)));
__device__ __forceinline__ bfr f2bf(float f) {
  __bf16 r = (__bf16)f;
  return *(bfr*)&r;
}
__device__ __forceinline__ unsigned pack2(float a, float b) {
  f32x2_t v = {a, b};
  bf16x2_t r = __builtin_convertvector(v, bf16x2_t);
  return *(unsigned*)&r;
}
__device__ __forceinline__ float lo16(unsigned u) { return __uint_as_float(u << 16); }
__device__ __forceinline__ float hi16(unsigned u) { return __uint_as_float(u & 0xffff0000u); }
__device__ __forceinline__ float siluf(float x) { return x / (1.f + __expf(-x)); }
__device__ __forceinline__ float sigmf(float x) { return 1.f / (1.f + __expf(-x)); }
__device__ __forceinline__ f32x4 mfma16(bf16x8 a, bf16x8 b, f32x4 c) {
  return __builtin_amdgcn_mfma_f32_16x16x32_bf16(a, b, c, 0, 0, 0);
}
__device__ __forceinline__ const float* xrow(const Params& p, int row) {
  return row < NCTX ? p.in[0] + (long)row * 1024 : p.in[1] + (long)(row - NCTX) * 1024;
}
__device__ __forceinline__ int row_cond(int row) { return row < NCTX ? 0 : 1 + ((row - NCTX) >> 12); }
__device__ __forceinline__ float wave_sum(float v) {
  v += __shfl_xor(v, 1); v += __shfl_xor(v, 2); v += __shfl_xor(v, 4);
  v += __shfl_xor(v, 8); v += __shfl_xor(v, 16); v += __shfl_xor(v, 32);
  return v;
}

#define XB_TMO      128
#define XB_XCNT(j)  (256  + 64 * (j))
#define XB_XSUB(j)  (1280 + 64 * (j))
#define XB_XGEN(j)  (2304 + 64 * (j))
#define XB_TOP      3328
#define XB_TOPGEN   3392
#define XCD_BAR_WORDS 3456
#define XB_SPIN_CAP (1u << 18)
#define LAS __attribute__((address_space(3)))

__device__ __forceinline__ unsigned xb_ld(unsigned* p)              { return __hip_atomic_load(p, __ATOMIC_RELAXED, __HIP_MEMORY_SCOPE_AGENT); }
__device__ __forceinline__ unsigned xb_add(unsigned* p, unsigned v) { return __hip_atomic_fetch_add(p, v, __ATOMIC_RELAXED, __HIP_MEMORY_SCOPE_AGENT); }
__device__ __forceinline__ unsigned xb_xcc_id() { return (unsigned)__builtin_amdgcn_s_getreg((3 << 11) | 20) & 0xFu; }
#define XB_SPIN(cond, bar) do { unsigned _sp = 0; while (cond) { __builtin_amdgcn_s_sleep(1); \
    if ((++_sp & 255u) == 0u) { if (xb_ld(&(bar)[XB_TMO])) break; if (_sp > XB_SPIN_CAP) { atomicAdd(&(bar)[XB_TMO], 1u); break; } } } } while (0)

struct XcdBarrier {
    unsigned* bar; unsigned x;
    volatile LAS unsigned* st;
};

__device__ __forceinline__ XcdBarrier xcd_barrier_post(unsigned* bar, volatile LAS unsigned* st) {
    XcdBarrier b; b.bar = bar; b.x = xb_xcc_id(); b.st = st;
    if (threadIdx.x == 0) (void)xb_add(&bar[XB_XCNT(b.x)], 1u);
    return b;
}
__device__ __forceinline__ void xcd_barrier_complete(unsigned* bar, unsigned x, unsigned& nloc, unsigned& nx) {
    const unsigned G = gridDim.x * gridDim.y * gridDim.z;
    unsigned sum, cnt, mine, sp = 0u;
    for (;;) {
        sum = 0u; cnt = 0u; mine = 0u;
#pragma unroll
        for (unsigned j = 0; j < 16; ++j) { const unsigned c = xb_ld(&bar[XB_XCNT(j)]); sum += c; cnt += (c > 0u) ? 1u : 0u; mine = (j == x) ? c : mine; }
        if (sum == G) break;
        __builtin_amdgcn_s_sleep(1);
        if ((++sp & 255u) == 0u) { if (xb_ld(&bar[XB_TMO])) break; if (sp > XB_SPIN_CAP) { atomicAdd(&bar[XB_TMO], 1u); break; } }
    }
    nloc = mine > 0u ? mine : 1u; nx = cnt > 0u ? cnt : 1u;
}

__device__ __forceinline__ void xcd_barrier(const XcdBarrier& b) {
    asm volatile("s_waitcnt vmcnt(0)" ::: "memory");
    __syncthreads();
    if (threadIdx.x == 0) {
        unsigned* bar = b.bar;
        __builtin_amdgcn_s_waitcnt(0);
        unsigned nloc = b.st[0], nx = b.st[1];
        if (nloc == 0u) { xcd_barrier_complete(bar, b.x, nloc, nx); b.st[0] = nloc; b.st[1] = nx; }
        const unsigned old = xb_add(&bar[XB_XSUB(b.x)], 1u);
        const unsigned gen = old / nloc;
        if (old + 1u == (gen + 1u) * nloc) {
            __builtin_amdgcn_fence(__ATOMIC_RELEASE, "agent");
            asm volatile("s_waitcnt vmcnt(0)" ::: "memory");
            const unsigned og = xb_add(&bar[XB_TOP], 1u);
            const unsigned tg = og / nx;
            if (og + 1u == (tg + 1u) * nx) xb_add(&bar[XB_TOPGEN], 1u);
            else XB_SPIN(xb_ld(&bar[XB_TOPGEN]) == tg, bar);
            __builtin_amdgcn_fence(__ATOMIC_ACQUIRE, "agent");
            xb_add(&bar[XB_XGEN(b.x)], 1u);
            asm volatile("s_waitcnt vmcnt(0)" ::: "memory");
        } else {
            XB_SPIN(xb_ld(&bar[XB_XGEN(b.x)]) == gen, bar);
            __builtin_amdgcn_fence(__ATOMIC_ACQUIRE, "agent");
            asm volatile("s_waitcnt vmcnt(0)" ::: "memory");
        }
    }
    __syncthreads();
}


#define TIDX tidx()
#define LDS3 __attribute__((address_space(3)))
__device__ __forceinline__ void glds16(const bfr* g, bfr* l) {
  __builtin_amdgcn_global_load_lds((const unsigned*)g, (LDS3 unsigned*)l, 16, 0, 0);
}
__device__ __forceinline__ void gemm128(const bfr* __restrict__ P, long ldp, int pmax,
                                        const bfr* __restrict__ Q, long ldq, int qmax, int K,
                                        f32x4 (&acc)[4][4], bfr* sm) {
  const int tid = TIDX, lane = tid & 63, wid = tid >> 6;
  const int wr = wid >> 1, wc = wid & 1;
  const int l15 = lane & 15, g = lane >> 4;
  const bfr* pp[2];
  const bfr* qp[2];
  {
    const int r0 = tid >> 2;
    const int c = (tid & 3) ^ ((tid >> 4) & 3);
#pragma unroll
    for (int i = 0; i < 2; i++) {
      int r = r0 + 64 * i;
      pp[i] = P + (long)min(r, pmax - 1) * ldp + c * 8;
      qp[i] = Q + (long)min(r, qmax - 1) * ldq + c * 8;
    }
  }
  const int nk = K >> 5;
#define GEMM_ISSUE(T)                                                    \
  do {                                                                   \
    bfr* nb_ = sm + ((T) & 3) * 8192;                                    \
    glds16(pp[0] + (T) * 32, nb_ + tid * 8);                             \
    glds16(pp[1] + (T) * 32, nb_ + 2048 + tid * 8);                      \
    glds16(qp[0] + (T) * 32, nb_ + 4096 + tid * 8);                      \
    glds16(qp[1] + (T) * 32, nb_ + 6144 + tid * 8);                      \
  } while (0)
  GEMM_ISSUE(0);
  GEMM_ISSUE(1);
  GEMM_ISSUE(2);
  const int pos = (g ^ ((l15 >> 2) & 3)) * 8;
  for (int kt = 0; kt < nk; kt++) {
    if (kt + 2 < nk) asm volatile("s_waitcnt vmcnt(8)" ::: "memory");
    else if (kt + 1 < nk) asm volatile("s_waitcnt vmcnt(4)" ::: "memory");
    else asm volatile("s_waitcnt vmcnt(0)" ::: "memory");
    __builtin_amdgcn_s_barrier();
    if (kt + 3 < nk) GEMM_ISSUE(kt + 3);
    const bfr* Ps = sm + (kt & 3) * 8192;
    const bfr* Qs = Ps + 4096;
    bf16x8 pf[4], qf[4];
#pragma unroll
    for (int m = 0; m < 4; m++) {
      pf[m] = *(const bf16x8*)(Ps + (wr * 64 + m * 16 + l15) * 32 + pos);
      qf[m] = *(const bf16x8*)(Qs + (wc * 64 + m * 16 + l15) * 32 + pos);
    }
#pragma unroll
    for (int m = 0; m < 4; m++)
#pragma unroll
      for (int n = 0; n < 4; n++) acc[m][n] = mfma16(pf[m], qf[n], acc[m][n]);
  }
#undef GEMM_ISSUE
  __syncthreads();
}

template <int NQ>
__device__ __forceinline__ void gemm128q(const bfr* __restrict__ P, long ldp, const bfr* __restrict__ Q, long ldq, int K,
                                         f32x4 (&acc)[4][NQ], bfr* sm) {
  constexpr int QI = NQ / 2;
  constexpr int STG = 4096 + QI * 2048;
  const int tid = TIDX, lane = tid & 63, wid = tid >> 6;
  const int wr = wid >> 1, wc = wid & 1;
  const int l15 = lane & 15, g = lane >> 4;
  const bfr* pp[2];
  const bfr* qp[QI];
  {
    const int r0 = tid >> 2;
    const int c = (tid & 3) ^ (((tid >> 5) & 1) * 3);
#pragma unroll
    for (int i = 0; i < 2; i++) pp[i] = P + (long)(r0 + 64 * i) * ldp + c * 8;
#pragma unroll
    for (int i = 0; i < QI; i++) qp[i] = Q + (long)(r0 + 64 * i) * ldq + c * 8;
  }
  const int nk = K >> 5;
  auto issue = [&](int T) {
    bfr* nb_ = sm + (T & 3) * STG;
    glds16(pp[0] + T * 32, nb_ + tid * 8);
    glds16(pp[1] + T * 32, nb_ + 2048 + tid * 8);
#pragma unroll
    for (int i = 0; i < QI; i++) glds16(qp[i] + T * 32, nb_ + 4096 + i * 2048 + tid * 8);
  };
  issue(0);
  issue(1);
  issue(2);
  const int pos = (g ^ (((l15 >> 3) & 1) * 3)) * 8;
  for (int kt = 0; kt < nk; kt++) {
    if (kt + 2 < nk) {
      if (QI == 2) asm volatile("s_waitcnt vmcnt(8)" ::: "memory"); else asm volatile("s_waitcnt vmcnt(6)" ::: "memory");
    } else if (kt + 1 < nk) {
      if (QI == 2) asm volatile("s_waitcnt vmcnt(4)" ::: "memory"); else asm volatile("s_waitcnt vmcnt(3)" ::: "memory");
    } else {
      asm volatile("s_waitcnt vmcnt(0)" ::: "memory");
    }
    __builtin_amdgcn_s_barrier();
    if (kt + 3 < nk) issue(kt + 3);
    const bfr* Ps = sm + (kt & 3) * STG;
    const bfr* Qs = Ps + 4096;
    bf16x8 pf[4], qf[NQ];
#pragma unroll
    for (int m = 0; m < 4; m++) pf[m] = *(const bf16x8*)(Ps + (wr * 64 + m * 16 + l15) * 32 + pos);
#pragma unroll
    for (int n = 0; n < NQ; n++) qf[n] = *(const bf16x8*)(Qs + (wc * 16 * NQ + n * 16 + l15) * 32 + pos);
#pragma unroll
    for (int m = 0; m < 4; m++)
#pragma unroll
      for (int n = 0; n < NQ; n++) acc[m][n] = mfma16(pf[m], qf[n], acc[m][n]);
  }
  __syncthreads();
}

template <int NQ>
__device__ __forceinline__ void gemm256x128(const bfr* __restrict__ P, long ldp, int pmax,
                                            const bfr* __restrict__ Q, long ldq, int K,
                                            f32x4 (&acc)[8][NQ], bfr* sm) {
  constexpr int QI = NQ / 2;
  constexpr int STG = 8192 + QI * 2048;
  const int tid = TIDX, lane = tid & 63, wid = tid >> 6;
  const int wr = wid >> 1, wc = wid & 1;
  const int l15 = lane & 15, g = lane >> 4;
  const bfr* pp[4];
  const bfr* qp[QI];
  {
    const int r0 = tid >> 2;
    const int c = (tid & 3) ^ (((tid >> 5) & 1) * 3);
#pragma unroll
    for (int i = 0; i < 4; i++) pp[i] = P + (long)min(r0 + 64 * i, pmax - 1) * ldp + c * 8;
#pragma unroll
    for (int i = 0; i < QI; i++) qp[i] = Q + (long)(r0 + 64 * i) * ldq + c * 8;
  }
  const int nk = K >> 5;
  auto issue = [&](int T, int stg) {
    bfr* nb_ = sm + stg * STG;
    glds16(pp[0] + T * 32, nb_ + tid * 8);
    glds16(pp[1] + T * 32, nb_ + 2048 + tid * 8);
    glds16(pp[2] + T * 32, nb_ + 4096 + tid * 8);
    glds16(pp[3] + T * 32, nb_ + 6144 + tid * 8);
#pragma unroll
    for (int i = 0; i < QI; i++) glds16(qp[i] + T * 32, nb_ + 8192 + i * 2048 + tid * 8);
  };
  issue(0, 0);
  issue(1, 1);
  const int pos = (g ^ (((l15 >> 3) & 1) * 3)) * 8;
  int st = 0;
  for (int kt = 0; kt < nk; kt++) {
    if (kt + 1 < nk) {
      if (QI == 2) asm volatile("s_waitcnt vmcnt(6)" ::: "memory"); else asm volatile("s_waitcnt vmcnt(5)" ::: "memory");
    } else {
      asm volatile("s_waitcnt vmcnt(0)" ::: "memory");
    }
    __builtin_amdgcn_s_barrier();
    if (kt + 2 < nk) issue(kt + 2, st == 0 ? 2 : st - 1);
    const bfr* Ps = sm + st * STG;
    const bfr* Qs = Ps + 8192;
    st = (st == 2) ? 0 : st + 1;
    bf16x8 qf[NQ], pf[8];
#pragma unroll
    for (int n = 0; n < NQ; n++) qf[n] = *(const bf16x8*)(Qs + (wc * 16 * NQ + n * 16 + l15) * 32 + pos);
#pragma unroll
    for (int m = 0; m < 8; m++) pf[m] = *(const bf16x8*)(Ps + (wr * 128 + m * 16 + l15) * 32 + pos);
#pragma unroll
    for (int m = 0; m < 8; m++)
#pragma unroll
      for (int n = 0; n < NQ; n++) acc[m][n] = mfma16(pf[m], qf[n], acc[m][n]);
    __builtin_amdgcn_sched_group_barrier(0x100, NQ + 2, 0);
#pragma unroll
    for (int i = 0; i < 6; i++) {
      __builtin_amdgcn_sched_group_barrier(0x008, NQ, 0);
      __builtin_amdgcn_sched_group_barrier(0x100, 1, 0);
    }
    __builtin_amdgcn_sched_group_barrier(0x008, 2 * NQ, 0);
  }
  __syncthreads();
}

template <int NQ, bool PIPE>
__device__ __forceinline__ void gemm128k64(const bfr* __restrict__ P, long ldp, int pmax,
                                           const bfr* __restrict__ Q, long ldq, int K,
                                           f32x4 (&acc)[4][NQ], bfr* sm) {
  constexpr int STG = 8192 + 2048 * NQ;
  const int tid = TIDX, lane = tid & 63, wid = tid >> 6;
  const int wr = wid >> 1, wc = wid & 1;
  const int l15 = lane & 15, g = lane >> 4;
  const bfr* pp[4];
  const bfr* qp[NQ];
  {
    const int r0 = tid >> 3;
    const int c = (tid & 7) ^ ((tid >> 4) & 7);
#pragma unroll
    for (int i = 0; i < 4; i++) pp[i] = P + (long)min(r0 + 32 * i, pmax - 1) * ldp + c * 8;
#pragma unroll
    for (int i = 0; i < NQ; i++) qp[i] = Q + (long)(r0 + 32 * i) * ldq + c * 8;
  }
  const int nk = K >> 6;
#pragma unroll
  for (int i = 0; i < 4; i++) glds16(pp[i], sm + i * 2048 + tid * 8);
#pragma unroll
  for (int i = 0; i < NQ; i++) glds16(qp[i], sm + 8192 + i * 2048 + tid * 8);
  const int swz = l15 >> 1;
  for (int kt = 0; kt < nk; kt++) {
    asm volatile("s_waitcnt vmcnt(0)" ::: "memory");
    __builtin_amdgcn_s_barrier();
    if (kt + 1 < nk) {
      bfr* nb = sm + ((kt + 1) & 1) * STG;
#pragma unroll
      for (int i = 0; i < 4; i++) glds16(pp[i] + (kt + 1) * 64, nb + i * 2048 + tid * 8);
#pragma unroll
      for (int i = 0; i < NQ; i++) glds16(qp[i] + (kt + 1) * 64, nb + 8192 + i * 2048 + tid * 8);
    }
    const bfr* Ps = sm + (kt & 1) * STG;
    const bfr* Qs = Ps + 8192;
    if (PIPE) {
      bf16x8 pf[2][4], qf[2][NQ];
#pragma unroll
      for (int kk = 0; kk < 2; kk++) {
        const int pos = ((kk * 4 + g) ^ swz) * 8;
#pragma unroll
        for (int m = 0; m < 4; m++) pf[kk][m] = *(const bf16x8*)(Ps + (wr * 64 + m * 16 + l15) * 64 + pos);
#pragma unroll
        for (int n = 0; n < NQ; n++) qf[kk][n] = *(const bf16x8*)(Qs + (wc * 16 * NQ + n * 16 + l15) * 64 + pos);
      }
#pragma unroll
      for (int kk = 0; kk < 2; kk++)
#pragma unroll
        for (int m = 0; m < 4; m++)
#pragma unroll
          for (int n = 0; n < NQ; n++) acc[m][n] = mfma16(pf[kk][m], qf[kk][n], acc[m][n]);
      __builtin_amdgcn_sched_group_barrier(0x100, 4 + NQ, 0);
#pragma unroll
      for (int i = 0; i < 4 + NQ; i++) {
        __builtin_amdgcn_sched_group_barrier(0x008, NQ == 4 ? 2 : 1, 0);
        __builtin_amdgcn_sched_group_barrier(0x100, 1, 0);
      }
      __builtin_amdgcn_sched_group_barrier(0x008, NQ == 4 ? 16 : 10, 0);
    } else {
#pragma unroll
      for (int kk = 0; kk < 2; kk++) {
        bf16x8 pf[4], qf[NQ];
        const int pos = ((kk * 4 + g) ^ swz) * 8;
#pragma unroll
        for (int m = 0; m < 4; m++) pf[m] = *(const bf16x8*)(Ps + (wr * 64 + m * 16 + l15) * 64 + pos);
#pragma unroll
        for (int n = 0; n < NQ; n++) qf[n] = *(const bf16x8*)(Qs + (wc * 16 * NQ + n * 16 + l15) * 64 + pos);
#pragma unroll
        for (int m = 0; m < 4; m++)
#pragma unroll
          for (int n = 0; n < NQ; n++) acc[m][n] = mfma16(pf[m], qf[n], acc[m][n]);
      }
    }
  }
  __syncthreads();
}

__device__ __forceinline__ void phase_s0(const Params& p, bfr* sm) {
  const int tid = TIDX;
  float* rope = (float*)(p.ws + WS_ROPE);
  for (int idx = blockIdx.x * 256 + tid; idx < 1536; idx += gridDim.x * 256) {
    if (idx < 1024) {
      int pos = idx >> 4, i = idx & 15;
      float fr = powf(10000.f, -(float)i / 16.f);
      float a = (float)pos * fr;
      rope[idx] = cosf(a);
      rope[1024 + idx] = sinf(a);
    } else {
      int j = idx - 1024;
      int pos = j >> 3, i = j & 7;
      float fr = powf(10000.f, -(float)i / 8.f);
      float a = (float)pos * fr;
      rope[2048 + j] = cosf(a);
      rope[2560 + j] = sinf(a);
    }
  }
  float* smf = (float*)sm;
  float* modp = (float*)(p.ws + WS_MODP);
  for (int it = blockIdx.x; it < 768; it += gridDim.x) {
    int l = it / 384, rem = it % 384, cgp = rem >> 3, ks = rem & 7;
    int col = cgp * 64 + (tid & 63), kq = tid >> 6;
    const float* w = p.in[10] + (long)l * 1024 * 3072 + col;
    float a0 = 0.f, a1 = 0.f, a2 = 0.f;
    int k0 = ks * 128 + kq * 32;
#pragma unroll 8
    for (int k = k0; k < k0 + 32; k++) {
      float wv = w[(long)k * 3072];
      a0 += siluf(p.in[9][k]) * wv;
      a1 += siluf(p.in[8][k]) * wv;
      a2 += siluf(p.in[8][1024 + k]) * wv;
    }
    smf[(kq * 3 + 0) * 64 + (tid & 63)] = a0;
    smf[(kq * 3 + 1) * 64 + (tid & 63)] = a1;
    smf[(kq * 3 + 2) * 64 + (tid & 63)] = a2;
    __syncthreads();
    if (tid < 192) {
      int c = tid >> 6, cc = tid & 63;
      float s = smf[(0 * 3 + c) * 64 + cc] + smf[(1 * 3 + c) * 64 + cc] + smf[(2 * 3 + c) * 64 + cc] + smf[(3 * 3 + c) * 64 + cc];
      modp[((ks * 2 + l) * 3 + c) * 3072 + cgp * 64 + cc] = s;
    }
    __syncthreads();
  }
}

__device__ __forceinline__ void phase_s1(const Params& p) {
  float* modp = (float*)(p.ws + WS_MODP);
  float* mod = (float*)(p.ws + WS_MOD);
  for (int idx = blockIdx.x * 256 + TIDX; idx < 2 * 3 * 3072; idx += gridDim.x * 256) {
    int l = idx / 9216, n = idx % 3072;
    float s = p.in[11][l * 3072 + n];
#pragma unroll
    for (int ks = 0; ks < 8; ks++) s += modp[ks * 18432 + idx];
    mod[idx] = s;
  }
}

__device__ __forceinline__ void wconv_tile(const float* __restrict__ src, int K, int N, bfr* __restrict__ dst,
                                           int tk, int tn, float* smf) {
  bfr* sT = (bfr*)smf;
  const int tid = TIDX;
  const int n4 = (tid & 15) * 4, kb = tid >> 4;
#pragma unroll
  for (int i = 0; i < 4; i++) {
    int k = kb + 16 * i;
    float4 v = *(const float4*)(src + (long)(tk * 64 + k) * N + tn * 64 + n4);
    sT[(n4 + 0) * 72 + k] = f2bf(v.x);
    sT[(n4 + 1) * 72 + k] = f2bf(v.y);
    sT[(n4 + 2) * 72 + k] = f2bf(v.z);
    sT[(n4 + 3) * 72 + k] = f2bf(v.w);
  }
  __syncthreads();
#pragma unroll
  for (int i = 0; i < 2; i++) {
    int c = tid + 256 * i;
    int n = c >> 3, kc = c & 7;
    *(u32x4*)(dst + (long)(tn * 64 + n) * K + tk * 64 + kc * 8) = *(const u32x4*)(sT + n * 72 + kc * 8);
  }
  __syncthreads();
}

#define WCONV_ITEMS 2456
__device__ __forceinline__ void wconv_phase(const Params& p, int l, bfr* sm) {
  float* smf = (float*)sm;
  for (int item0 = blockIdx.x; item0 < WCONV_ITEMS; item0 += gridDim.x) {
    int item = item0;
    const float* src;
    bfr* dst;
    int K, N, tk, tn;
    if (item < 1744) {
      src = p.in[14] + (long)l * 1024 * 6976; K = 1024; N = 6976; dst = (bfr*)(p.ws + WS_WIN); tk = item & 15; tn = item >> 4;
    } else if (item < 1768) {
      item -= 1744;
      src = p.in[24] + (long)l * 256 * 384; K = 256; N = 384; dst = (bfr*)(p.ws + WS_WUQ); tk = item & 3; tn = item >> 2;
    } else if (item < 1816) {
      item -= 1768;
      src = p.in[25] + (long)l * 256 * 768; K = 256; N = 768; dst = (bfr*)(p.ws + WS_WUKV); tk = item & 3; tn = item >> 2;
    } else if (item < 2200) {
      item -= 1816;
      int w = item >> 7, it = item & 127;
      src = (w == 0 ? p.in[26] : (w == 1 ? p.in[27] : p.in[28])) + (long)l * 512 * 1024;
      K = 512; N = 1024; dst = (bfr*)(p.ws + WS_WOA + (unsigned long)w * 1048576ul); tk = it & 7; tn = it >> 3;
    } else {
      item -= 2200;
      src = p.in[29] + (long)l * 1024 * 1024; K = 1024; N = 1024; dst = (bfr*)(p.ws + WS_WOUT); tk = item & 15; tn = item >> 4;
    }
    wconv_tile(src, K, N, dst, tk, tn, smf);
  }
}

__device__ __forceinline__ void phase_prenorm0(const Params& p) {
  const int lane = TIDX & 63;
  const float* mod = (const float*)(p.ws + WS_MOD);
  bfr* H = (bfr*)(p.ws + WS_R1);
  for (int row = blockIdx.x * 4 + (TIDX >> 6); row < NROWS; row += gridDim.x * 4) {
    const float* x = xrow(p, row);
    const float* md = mod + (0 * 3 + row_cond(row)) * 3072;
    float4 v[4];
    float ss = 0.f;
#pragma unroll
    for (int i = 0; i < 4; i++) {
      v[i] = *(const float4*)(x + i * 256 + lane * 4);
      ss += v[i].x * v[i].x + v[i].y * v[i].y + v[i].z * v[i].z + v[i].w * v[i].w;
    }
    ss = wave_sum(ss);
    float rs = rsqrtf(ss * (1.f / 1024.f) + 1e-6f);
#pragma unroll
    for (int i = 0; i < 4; i++) {
      int n = i * 256 + lane * 4;
      float4 g = *(const float4*)(p.in[12] + n);
      float4 sh = *(const float4*)(md + n);
      float4 sc = *(const float4*)(md + 1024 + n);
      float h0 = v[i].x * rs * g.x * (1.f + sc.x) + sh.x;
      float h1 = v[i].y * rs * g.y * (1.f + sc.y) + sh.y;
      float h2 = v[i].z * rs * g.z * (1.f + sc.z) + sh.z;
      float h3 = v[i].w * rs * g.w * (1.f + sc.w) + sh.w;
      u32x2 o;
      o.x = pack2(h0, h1);
      o.y = pack2(h2, h3);
      *(u32x2*)(H + (long)row * 1024 + n) = o;
    }
  }
}

__device__ __forceinline__ unsigned xcc_id() { return (unsigned)__builtin_amdgcn_s_getreg((3 << 11) | 20) & 7u; }
template <class CountF>
__device__ __forceinline__ int xq_take(unsigned* ctr, int& q, int& tried, unsigned first, CountF cnt) {
  unsigned j = first;
  for (;;) {
    if (j < (unsigned)cnt(q)) return (q << 20) | (int)j;
    q = (q + 1) & 7;
    if (++tried >= 8) return -1;
    j = atomicAdd(ctr + q * 16, 1u);
  }
}

__device__ __forceinline__ void phase_inproj(const Params& p, int l, bfr* sm, int* s_item, int slot) {
  const bfr* H = (const bfr*)(p.ws + WS_R1);
  const bfr* W = (const bfr*)(p.ws + WS_WIN);
  bfr* Z = (bfr*)(p.ws + WS_Z);
  const int tid = TIDX;
  const int lane = tid & 63, wid = tid >> 6, wr = wid >> 1, wc = wid & 1;
  unsigned* ctr = (unsigned*)(p.ws + WS_CTR) + slot * 128;
  auto cnt = [](int q) { return 96 * ((55 * (q + 1)) / 8 - (55 * q) / 8); };
  int q = (int)xcc_id(), tried = 0;
  unsigned nxt = 0;
  if (tid == 0) nxt = atomicAdd(ctr + q * 16, 1u);
  for (;;) {
    if (tid == 0) *s_item = xq_take(ctr, q, tried, nxt, cnt);
    __syncthreads();
    const int it = *s_item;
    __syncthreads();
    if (it < 0) break;
    const int qq = it >> 20, j = it & 0xfffff;
    if (tid == 0) nxt = atomicAdd(ctr + q * 16, 1u);
    const int tn0 = (55 * qq) / 8, w = (55 * (qq + 1)) / 8 - tn0;
    const int tm = j / w, tn = tn0 + j % w;
    f32x4 acc[4][4];
#pragma unroll
    for (int a = 0; a < 4; a++)
#pragma unroll
      for (int b = 0; b < 4; b++) acc[a][b] = (f32x4){0.f, 0.f, 0.f, 0.f};
    gemm128k64<4, true>(W + (long)tn * 128 * 1024, 1024, ZLD - tn * 128, H + (long)tm * 128 * 1024, 1024, 1024, acc, sm);
    {
      const int g = lane >> 4, l15 = lane & 15;
#pragma unroll
      for (int pi = 0; pi < 4; pi++)
#pragma unroll
        for (int qi = 0; qi < 4; qi++) {
          u32x2 o;
          o.x = pack2(acc[pi][qi][0], acc[pi][qi][1]);
          o.y = pack2(acc[pi][qi][2], acc[pi][qi][3]);
          *(u32x2*)(sm + (wc * 64 + qi * 16 + l15) * 136 + wr * 64 + pi * 16 + g * 4) = o;
        }
      __syncthreads();
      const int ncol = (ZLD - tn * 128) >> 3;
#pragma unroll
      for (int i = 0; i < 8; i++) {
        int c = tid + 256 * i;
        int row = c >> 4, c16 = c & 15;
        if (c16 < ncol)
          *(u32x4*)(Z + (long)(tm * 128 + row) * ZLD + tn * 128 + c16 * 8) = *(const u32x4*)(sm + row * 136 + c16 * 8);
      }
      __syncthreads();
    }
  }
}

__device__ __forceinline__ void unpack8(u32x4 v, float* x) {
  x[0] = lo16(v.x); x[1] = hi16(v.x); x[2] = lo16(v.y); x[3] = hi16(v.y);
  x[4] = lo16(v.z); x[5] = hi16(v.z); x[6] = lo16(v.w); x[7] = hi16(v.w);
}
__device__ __forceinline__ u32x4 pack8(const float* y) {
  u32x4 o;
  o.x = pack2(y[0], y[1]); o.y = pack2(y[2], y[3]); o.z = pack2(y[4], y[5]); o.w = pack2(y[6], y[7]);
  return o;
}

__device__ __forceinline__ void phase_rowpost(const Params& p, int l) {
  const int lane = TIDX & 63;
  bfr* Z = (bfr*)(p.ws + WS_Z);
  const float* rope = (const float*)(p.ws + WS_ROPE);
  bfr* VTA = (bfr*)(p.ws + WS_VTA);
  bfr* KCA = (bfr*)(p.ws + WS_KCA);
  bfr* CKVC = (bfr*)(p.ws + WS_CKVC);
  bfr* KRC = (bfr*)(p.ws + WS_KRC);
  float* out = p.out;
  for (int row = blockIdx.x * 4 + (TIDX >> 6); row < NROWS + 1024; row += gridDim.x * 4) {
    if (row < NROWS) {
      const bool lat = row >= NCTX;
      const int bc = row >> 8, tc = row & 255;
      const int bl = (row - NCTX) >> 12, tl = (row - NCTX) & 4095;
      const int prow = tl >> 6, pcol = tl & 63;
      bfr* z = Z + (long)row * ZLD;
      {
        float x[8];
        unpack8(*(const u32x4*)(z + C_QA + lane * 8), x);
        float ss = 0.f;
#pragma unroll
        for (int e = 0; e < 8; e++) ss += x[e] * x[e];
        ss += __shfl_xor(ss, 1); ss += __shfl_xor(ss, 2); ss += __shfl_xor(ss, 4);
        float rs = rsqrtf(ss * (1.f / 64.f) + 1e-6f);
        int sub = lane & 7;
        const float* g = p.in[15] + l * 64 + sub * 8;
#pragma unroll
        for (int e = 0; e < 8; e++) x[e] = x[e] * rs * g[e];
        if (lat) {
          int pos = (sub >> 2) ? pcol : prow;
          bool hi = (sub & 2) != 0;
          int i0 = (sub & 1) * 8;
#pragma unroll
          for (int e = 0; e < 8; e++) {
            float yp = __shfl_xor(x[e], 2);
            float c = rope[pos * 16 + i0 + e], s = rope[1024 + pos * 16 + i0 + e];
            x[e] = hi ? (yp * s + x[e] * c) : (x[e] * c - yp * s);
          }
        }
        const float qs = 0.125f * 1.4426950408889634f;
#pragma unroll
        for (int e = 0; e < 8; e++) x[e] *= qs;
        *(u32x4*)(z + C_QA + lane * 8) = pack8(x);
      }
      {
        int L = lane & 15;
        float x[8];
        unpack8(*(const u32x4*)(z + C_KA + L * 8), x);
        float ss = 0.f;
#pragma unroll
        for (int e = 0; e < 8; e++) ss += x[e] * x[e];
        ss += __shfl_xor(ss, 1); ss += __shfl_xor(ss, 2); ss += __shfl_xor(ss, 4);
        float rs = rsqrtf(ss * (1.f / 64.f) + 1e-6f);
        int sub = L & 7;
        const float* g = p.in[16] + l * 64 + sub * 8;
#pragma unroll
        for (int e = 0; e < 8; e++) x[e] = x[e] * rs * g[e];
        if (lat) {
          int pos = (sub >> 2) ? pcol : prow;
          bool hi = (sub & 2) != 0;
          int i0 = (sub & 1) * 8;
#pragma unroll
          for (int e = 0; e < 8; e++) {
            float yp = __shfl_xor(x[e], 2);
            float c = rope[pos * 16 + i0 + e], s = rope[1024 + pos * 16 + i0 + e];
            x[e] = hi ? (yp * s + x[e] * c) : (x[e] * c - yp * s);
          }
        } else if (lane < 16) {
          float* o = out + O_GK + ((long)(bc * 2 + l) * 256 + tc) * 128 + L * 8;
          *(float4*)(o) = make_float4(x[0], x[1], x[2], x[3]);
          *(float4*)(o + 4) = make_float4(x[4], x[5], x[6], x[7]);
        }
        if (lane < 16) *(u32x4*)(z + C_KA + L * 8) = pack8(x);
      }
      if (lane < 16) {
        int L = lane;
        u32x4 raw = *(const u32x4*)(z + C_VA + L * 8);
        float x[8];
        unpack8(raw, x);
        if (!lat) {
          float* o = out + O_GV + ((long)(bc * 2 + l) * 256 + tc) * 128 + L * 8;
          *(float4*)(o) = make_float4(x[0], x[1], x[2], x[3]);
          *(float4*)(o + 4) = make_float4(x[4], x[5], x[6], x[7]);
        }
        int g = L >> 3, d0 = (L & 7) * 8;
        long base; int nk, key;
        if (!lat) { base = (long)bc * 32768; nk = 256; key = tc; }
        else { base = 16l * 32768 + (long)bl * (2 * 64 * 4608); nk = 4608; key = 512 + tl; }
        const bfr* rb = (const bfr*)&raw;
#pragma unroll
        for (int e = 0; e < 8; e++) VTA[base + (long)(g * 64 + d0 + e) * nk + key] = rb[e];
      }
      {
        u32x2 rq = *(const u32x2*)(z + C_QL + lane * 4);
        u32x2 rk = *(const u32x2*)(z + C_KV + lane * 4);
        float q[4] = {lo16(rq.x), hi16(rq.x), lo16(rq.y), hi16(rq.y)};
        float k[4] = {lo16(rk.x), hi16(rk.x), lo16(rk.y), hi16(rk.y)};
        float sq = q[0] * q[0] + q[1] * q[1] + q[2] * q[2] + q[3] * q[3];
        float sk = k[0] * k[0] + k[1] * k[1] + k[2] * k[2] + k[3] * k[3];
        sq = wave_sum(sq);
        sk = wave_sum(sk);
        float rq_ = rsqrtf(sq * (1.f / 256.f) + 1e-6f), rk_ = rsqrtf(sk * (1.f / 256.f) + 1e-6f);
        float4 gq = *(const float4*)(p.in[22] + l * 256 + lane * 4);
        float4 gk = *(const float4*)(p.in[23] + l * 256 + lane * 4);
        q[0] *= rq_ * gq.x; q[1] *= rq_ * gq.y; q[2] *= rq_ * gq.z; q[3] *= rq_ * gq.w;
        k[0] *= rk_ * gk.x; k[1] *= rk_ * gk.y; k[2] *= rk_ * gk.z; k[3] *= rk_ * gk.w;
        u32x2 o;
        o.x = pack2(q[0], q[1]); o.y = pack2(q[2], q[3]);
        *(u32x2*)(z + C_QL + lane * 4) = o;
        o.x = pack2(k[0], k[1]); o.y = pack2(k[2], k[3]);
        *(u32x2*)(z + C_KV + lane * 4) = o;
        if (!lat) *(float4*)(out + O_CKV + ((long)(bc * 2 + l) * 256 + tc) * 256 + lane * 4) = make_float4(k[0], k[1], k[2], k[3]);
      }
      {
        int L = lane & 3;
        float x[8];
        unpack8(*(const u32x4*)(z + C_KR + L * 8), x);
        if (lat) {
          int pos = (L >> 1) ? pcol : prow;
          bool hi = (L & 1) != 0;
#pragma unroll
          for (int e = 0; e < 8; e++) {
            float yp = __shfl_xor(x[e], 1);
            float c = rope[2048 + pos * 8 + e], s = rope[2560 + pos * 8 + e];
            x[e] = hi ? (yp * s + x[e] * c) : (x[e] * c - yp * s);
          }
          if (lane < 4) *(u32x4*)(z + C_KR + L * 8) = pack8(x);
        } else if (lane < 4) {
          float* o = out + O_KR + ((long)(bc * 2 + l) * 256 + tc) * 32 + L * 8;
          *(float4*)(o) = make_float4(x[0], x[1], x[2], x[3]);
          *(float4*)(o + 4) = make_float4(x[4], x[5], x[6], x[7]);
        }
      }
    } else {
      int cr = row - NROWS;
      int b = cr >> 9, t = cr & 511;
      long src = (long)(b * 2 + l) * 512 + t;
      {
        float2 kv = *(const float2*)(p.in[2] + src * 128 + lane * 2);
        *(unsigned*)(KCA + (long)(b * 512 + t) * 128 + lane * 2) = pack2(kv.x, kv.y);
        float2 vv = *(const float2*)(p.in[3] + src * 128 + lane * 2);
        int c0 = lane * 2;
        long base = 16l * 32768 + (long)b * (2 * 64 * 4608);
        VTA[base + (long)c0 * 4608 + t] = f2bf(vv.x);
        VTA[base + (long)(c0 + 1) * 4608 + t] = f2bf(vv.y);
        float4 cv = *(const float4*)(p.in[4] + src * 256 + lane * 4);
        u32x2 o;
        o.x = pack2(cv.x, cv.y); o.y = pack2(cv.z, cv.w);
        *(u32x2*)(CKVC + (long)(b * 512 + t) * 256 + lane * 4) = o;
        if (lane < 32) KRC[(long)(b * 512 + t) * 32 + lane] = f2bf(p.in[5][src * 32 + lane]);
      }
    }
  }
}

#define WS_PREP1 251703296ul
#define WS_EL (WS_WIN + 12582912ul)
__device__ __forceinline__ bfr* prep_base(const Params& p, int b, int h, int dir, int c) {
  return (bfr*)(p.ws + (b ? WS_PREP1 : WS_WIN)) + (long)((h * 2 + dir) * 64 + c) * 12288;
}

__device__ __forceinline__ void gla_chunk_prep(int tid, const float (&wd)[16], float bias, const bfr* Qr, const bfr* Kr,
                                               bfr* Qe, bfr* Ke, bfr* KlT, const float* RF, float* tot, float* lastv) {
  const int ch = tid & 63, part = tid >> 6;
  float cum[16];
  {
    float run = 0.f;
#pragma unroll
    for (int ii = 0; ii < 16; ii++) {
      int i = part * 16 + ii;
      float x = bias;
#pragma unroll
      for (int r = 0; r < 16; r++) x += RF[i * 16 + r] * wd[r];
      float la = (fminf(x, 0.f) - __logf(1.f + __expf(-fabsf(x)))) * (1.f / 16.f);
      run += la;
      cum[ii] = run;
    }
    tot[part * 64 + ch] = run;
  }
  __syncthreads();
  {
    float off = 0.f, last = 0.f;
#pragma unroll
    for (int pp = 0; pp < 4; pp++) {
      float tv = tot[pp * 64 + ch];
      if (pp < part) off += tv;
      last += tv;
    }
    if (part == 0) lastv[ch] = last;
#pragma unroll
    for (int ii = 0; ii < 16; ii++) {
      int i = part * 16 + ii;
      float cc = cum[ii] + off;
      float qv = bf2f(Qr[i * LDT + ch]), kv = bf2f(Kr[i * LDT + ch]);
      Qe[i * LDT + ch] = f2bf(qv * __expf(cc) * 0.125f);
      Ke[i * LDT + ch] = f2bf(kv * __expf(-cc));
      KlT[ch * LDT + i] = f2bf(kv * __expf(last - cc));
    }
  }
  __syncthreads();
}

__device__ __forceinline__ void gla_att(int wid, int g, int l15, const bfr* Qe, const bfr* Ke, bfr* Att) {
  f32x4 att[4];
  bf16x8 qa[2];
#pragma unroll
  for (int kk = 0; kk < 2; kk++) qa[kk] = *(const bf16x8*)(Qe + (16 * wid + l15) * LDT + kk * 32 + g * 8);
#pragma unroll
  for (int nj = 0; nj < 4; nj++) {
    att[nj] = (f32x4){0.f, 0.f, 0.f, 0.f};
#pragma unroll
    for (int kk = 0; kk < 2; kk++) {
      bf16x8 kb = *(const bf16x8*)(Ke + (16 * nj + l15) * LDT + kk * 32 + g * 8);
      att[nj] = mfma16(qa[kk], kb, att[nj]);
    }
  }
#pragma unroll
  for (int nj = 0; nj < 4; nj++)
#pragma unroll
    for (int r = 0; r < 4; r++) {
      int i = 16 * wid + 4 * g + r, j = 16 * nj + l15;
      Att[i * LDT + j] = f2bf(i >= j ? att[nj][r] : 0.f);
    }
}

__device__ __forceinline__ void gla_prep_item(const Params& p, int l, int b, int h, int dir, int c, bfr* sm) {
  const int tid = TIDX, lane = tid & 63, wid = tid >> 6, g = lane >> 4, l15 = lane & 15;
  const bfr* Z = (const bfr*)(p.ws + WS_Z);
  const int N = 4096;
  const int rowbase = NCTX + b * 4096;
  bfr* Qr = sm;
  bfr* Kr = Qr + 64 * LDT;
  bfr* Qe = Kr + 64 * LDT;
  bfr* Ke = Qe + 64 * LDT;
  bfr* KlT = Ke + 64 * LDT;
  float* RF = (float*)(KlT + 64 * LDT);
  float* tot = RF + 64 * 16;
  float* lastv = tot + 256;
  bfr* Att = Qr;
  const int ch = tid & 63;
  float wd[16];
  {
    const float* W = (dir ? p.in[19] : p.in[17]) + (long)l * 16 * 256 + h * 64 + ch;
#pragma unroll
    for (int r = 0; r < 16; r++) wd[r] = W[r * 256];
  }
  const float bias = (dir ? p.in[20] : p.in[18])[l * 256 + h * 64 + ch];
#pragma unroll
  for (int ii = 0; ii < 2; ii++) {
    int cc = tid + 256 * ii;
    int i = cc >> 3, c8 = cc & 7;
    int tok = dir ? (N - 1 - (c * 64 + i)) : (c * 64 + i);
    const bfr* zr = Z + (long)(rowbase + tok) * ZLD;
    *(u32x4*)(Qr + i * LDT + c8 * 8) = *(const u32x4*)(zr + C_QG + h * 64 + c8 * 8);
    *(u32x4*)(Kr + i * LDT + c8 * 8) = *(const u32x4*)(zr + C_KG + h * 64 + c8 * 8);
  }
  if (tid < 128) {
    int i = tid >> 1, hf = tid & 1;
    int tok = dir ? (N - 1 - (c * 64 + i)) : (c * 64 + i);
    u32x4 rr = *(const u32x4*)(Z + (long)(rowbase + tok) * ZLD + (dir ? C_RB : C_RF) + hf * 8);
    float x[8];
    unpack8(rr, x);
#pragma unroll
    for (int e = 0; e < 8; e++) RF[i * 16 + hf * 8 + e] = x[e];
  }
  __syncthreads();
  gla_chunk_prep(tid, wd, bias, Qr, Kr, Qe, Ke, KlT, RF, tot, lastv);
  gla_att(wid, g, l15, Qe, Ke, Att);
  __syncthreads();
  bfr* dst = prep_base(p, b, h, dir, c);
#pragma unroll
  for (int ii = 0; ii < 2; ii++) {
    int cc = tid + 256 * ii;
    int i = cc >> 3, c8 = cc & 7;
    *(u32x4*)(dst + i * 64 + c8 * 8) = *(const u32x4*)(Qe + i * LDT + c8 * 8);
    *(u32x4*)(dst + 4096 + i * 64 + c8 * 8) = *(const u32x4*)(KlT + i * LDT + c8 * 8);
    *(u32x4*)(dst + 8192 + i * 64 + c8 * 8) = *(const u32x4*)(Att + i * LDT + c8 * 8);
  }
  if (tid < 64) ((float*)(p.ws + WS_EL))[((long)(((b * 4 + h) * 2 + dir) * 64 + c)) * 64 + tid] = __expf(lastv[tid]);
  __syncthreads();
}

__device__ __forceinline__ void gla_chain_item(const Params& p, int l, int b, int h, int dir, int vh, bfr* sm) {
  const int tid = TIDX, lane = tid & 63, wid = tid >> 6, g = lane >> 4, l15 = lane & 15;
  const bfr* Z = (const bfr*)(p.ws + WS_Z);
  bfr* OG = (bfr*)(p.ws + WS_R1) + (long)dir * NROWS * 512;
  const float* EL = (const float*)(p.ws + WS_EL) + (long)(((b * 4 + h) * 2 + dir) * 64) * 64;
  const int N = 4096, nc = 64;
  const int rowbase = NCTX + b * 4096;
  const int vs0 = vh * 64;
  bfr* Vt = sm;
  bfr* St = Vt + 64 * LDT;
  f32x4 st[4];
  {
    const float* S0 = (dir ? p.in[7] : p.in[6]) + ((long)((b * 2 + l) * 4 + h)) * 8192 + (long)(16 * wid + l15) * 128 + vs0;
#pragma unroll
    for (int vt = 0; vt < 4; vt++) {
      float4 a = *(const float4*)(S0 + 16 * vt + 4 * g);
      st[vt] = (f32x4){a.x, a.y, a.z, a.w};
#pragma unroll
      for (int r = 0; r < 4; r++) St[(16 * vt + 4 * g + r) * LDT + 16 * wid + l15] = f2bf(st[vt][r]);
    }
  }
  u32x4 n_qe[2], n_kl[2], n_at[2], n_v[2];
  float n_el;
  auto prefetch = [&](int c) {
    const bfr* base = prep_base(p, b, h, dir, c) + (16 * wid + l15) * 64 + 8 * g;
#pragma unroll
    for (int kk = 0; kk < 2; kk++) {
      n_qe[kk] = *(const u32x4*)(base + kk * 32);
      n_kl[kk] = *(const u32x4*)(base + 4096 + kk * 32);
      n_at[kk] = *(const u32x4*)(base + 8192 + kk * 32);
    }
    n_el = EL[c * 64 + 16 * wid + l15];
#pragma unroll
    for (int ii = 0; ii < 2; ii++) {
      int cc = tid + 256 * ii;
      int i = cc >> 3, c8 = cc & 7;
      int tok = dir ? (N - 1 - (c * 64 + i)) : (c * 64 + i);
      n_v[ii] = *(const u32x4*)(Z + (long)(rowbase + tok) * ZLD + C_VG + h * 128 + vs0 + c8 * 8);
    }
  };
  prefetch(0);
  for (int c = 0; c < nc; c++) {
    u32x4 c_qe[2] = {n_qe[0], n_qe[1]}, c_kl[2] = {n_kl[0], n_kl[1]}, c_at[2] = {n_at[0], n_at[1]};
    const float el = n_el;
#pragma unroll
    for (int ii = 0; ii < 2; ii++) {
      int cc = tid + 256 * ii;
      int i = cc >> 3, c8 = cc & 7;
      const bfr* rb = (const bfr*)&n_v[ii];
#pragma unroll
      for (int e = 0; e < 8; e++) Vt[(c8 * 8 + e) * LDT + i] = rb[e];
    }
    __syncthreads();
    if (c + 1 < nc) prefetch(c + 1);
    f32x4 stn[4];
    const int i = 16 * wid + l15;
    const int tok = dir ? (N - 1 - (c * 64 + i)) : (c * 64 + i);
    bfr* og = OG + (long)(rowbase + tok) * 512 + h * 128 + vs0 + 4 * g;
#pragma unroll
    for (int vt = 0; vt < 4; vt++) {
      f32x4 oc = (f32x4){0.f, 0.f, 0.f, 0.f};
      stn[vt] = st[vt] * el;
#pragma unroll
      for (int kk = 0; kk < 2; kk++) {
        bf16x8 vf = *(const bf16x8*)(Vt + (16 * vt + l15) * LDT + kk * 32 + g * 8);
        bf16x8 sf = *(const bf16x8*)(St + (16 * vt + l15) * LDT + kk * 32 + g * 8);
        oc = mfma16(vf, *(bf16x8*)&c_at[kk], oc);
        oc = mfma16(sf, *(bf16x8*)&c_qe[kk], oc);
        stn[vt] = mfma16(vf, *(bf16x8*)&c_kl[kk], stn[vt]);
      }
      u32x2 ov;
      ov.x = pack2(oc[0], oc[1]);
      ov.y = pack2(oc[2], oc[3]);
      *(u32x2*)(og + 16 * vt) = ov;
    }
    __syncthreads();
#pragma unroll
    for (int vt = 0; vt < 4; vt++) {
      st[vt] = stn[vt];
#pragma unroll
      for (int r = 0; r < 4; r++) St[(16 * vt + 4 * g + r) * LDT + 16 * wid + l15] = f2bf(st[vt][r]);
    }
  }
  __syncthreads();
}

template <int VS>
__device__ __forceinline__ void gla_item(const Params& p, int l, int seq, int h, int dir, int vsl, bfr* sm) {
  constexpr int NVT = VS / 16;
  constexpr int NVL = VS / 32;
  const int tid = TIDX, lane = tid & 63, wid = tid >> 6, g = lane >> 4, l15 = lane & 15;
  bfr* Z = (bfr*)(p.ws + WS_Z);
  bfr* OG = (bfr*)(p.ws + WS_R1) + (long)dir * NROWS * 512;
  const bool lat = seq >= 16;
  const int b = seq - 16;
  const int N = lat ? 4096 : 256;
  const int rowbase = lat ? NCTX + b * 4096 : seq * 256;
  const int nc = N >> 6;
  const int vs0 = vsl * VS;
  bfr* Qr = sm;
  bfr* Kr = Qr + 64 * LDT;
  bfr* Qe = Kr + 64 * LDT;
  bfr* Ke = Qe + 64 * LDT;
  bfr* KlT = Ke + 64 * LDT;
  float* RF = (float*)(KlT + 64 * LDT);
  float* tot = RF + 64 * 16;
  float* lastv = tot + 256;
  bfr* Vt = (bfr*)(lastv + 64);
  bfr* St = Vt + VS * LDT;
  bfr* Att = Qr;
  const int ch = tid & 63;
  float wd[16];
  {
    const float* W = (dir ? p.in[19] : p.in[17]) + (long)l * 16 * 256 + h * 64 + ch;
#pragma unroll
    for (int r = 0; r < 16; r++) wd[r] = W[r * 256];
  }
  const float bias = (dir ? p.in[20] : p.in[18])[l * 256 + h * 64 + ch];

  f32x4 st[NVT];
  {
    const float* S0 = (dir ? p.in[7] : p.in[6]) + ((long)((b * 2 + l) * 4 + h)) * 8192 + (long)(16 * wid + l15) * 128 + vs0;
#pragma unroll
    for (int mv = 0; mv < NVT; mv++) {
      if (lat) {
        float4 a = *(const float4*)(S0 + 16 * mv + 4 * g);
        st[mv] = (f32x4){a.x, a.y, a.z, a.w};
      } else {
        st[mv] = (f32x4){0.f, 0.f, 0.f, 0.f};
      }
#pragma unroll
      for (int r = 0; r < 4; r++) St[(16 * mv + 4 * g + r) * LDT + 16 * wid + l15] = f2bf(st[mv][r]);
    }
  }
  u32x4 rq[2], rk[2], rv[NVL], rr;
  auto prefetch = [&](int c) {
#pragma unroll
    for (int ii = 0; ii < 2; ii++) {
      int cc = tid + 256 * ii;
      int i = cc >> 3, c8 = cc & 7;
      int tok = dir ? (N - 1 - (c * 64 + i)) : (c * 64 + i);
      const bfr* zr = Z + (long)(rowbase + tok) * ZLD;
      rq[ii] = *(const u32x4*)(zr + C_QG + h * 64 + c8 * 8);
      rk[ii] = *(const u32x4*)(zr + C_KG + h * 64 + c8 * 8);
    }
#pragma unroll
    for (int ii = 0; ii < NVL; ii++) {
      int cc = tid + 256 * ii;
      int i = cc / (VS / 8), c4 = cc % (VS / 8);
      int tok = dir ? (N - 1 - (c * 64 + i)) : (c * 64 + i);
      rv[ii] = *(const u32x4*)(Z + (long)(rowbase + tok) * ZLD + C_VG + h * 128 + vs0 + c4 * 8);
    }
    if (tid < 128) {
      int i = tid >> 1, hf = tid & 1;
      int tok = dir ? (N - 1 - (c * 64 + i)) : (c * 64 + i);
      rr = *(const u32x4*)(Z + (long)(rowbase + tok) * ZLD + (dir ? C_RB : C_RF) + hf * 8);
    }
  };
  prefetch(0);
  for (int c = 0; c < nc; c++) {
#pragma unroll
    for (int ii = 0; ii < 2; ii++) {
      int cc = tid + 256 * ii;
      *(u32x4*)(Qr + (cc >> 3) * LDT + (cc & 7) * 8) = rq[ii];
      *(u32x4*)(Kr + (cc >> 3) * LDT + (cc & 7) * 8) = rk[ii];
    }
#pragma unroll
    for (int ii = 0; ii < NVL; ii++) {
      int cc = tid + 256 * ii;
      int i = cc / (VS / 8), c4 = cc % (VS / 8);
      const bfr* rb = (const bfr*)&rv[ii];
#pragma unroll
      for (int e = 0; e < 8; e++) Vt[(c4 * 8 + e) * LDT + i] = rb[e];
    }
    if (tid < 128) {
      int i = tid >> 1, hf = tid & 1;
      float x[8];
      unpack8(rr, x);
#pragma unroll
      for (int e = 0; e < 8; e++) RF[i * 16 + hf * 8 + e] = x[e];
    }
    __syncthreads();
    if (c + 1 < nc) prefetch(c + 1);
    gla_chunk_prep(tid, wd, bias, Qr, Kr, Qe, Ke, KlT, RF, tot, lastv);
    f32x4 stn[NVT];
    {
      float el = __expf(lastv[16 * wid + l15]);
#pragma unroll
      for (int mv = 0; mv < NVT; mv++) {
        stn[mv] = st[mv] * el;
#pragma unroll
        for (int kk = 0; kk < 2; kk++) {
          bf16x8 va = *(const bf16x8*)(Vt + (16 * mv + l15) * LDT + kk * 32 + g * 8);
          bf16x8 kb = *(const bf16x8*)(KlT + (16 * wid + l15) * LDT + kk * 32 + g * 8);
          stn[mv] = mfma16(va, kb, stn[mv]);
        }
      }
      gla_att(wid, g, l15, Qe, Ke, Att);
    }
    __syncthreads();
    {
      bf16x8 aa[2], qa[2];
#pragma unroll
      for (int kk = 0; kk < 2; kk++) {
        aa[kk] = *(const bf16x8*)(Att + (16 * wid + l15) * LDT + kk * 32 + g * 8);
        qa[kk] = *(const bf16x8*)(Qe + (16 * wid + l15) * LDT + kk * 32 + g * 8);
      }
#pragma unroll
      for (int nv = 0; nv < NVT; nv++) {
        f32x4 oc = (f32x4){0.f, 0.f, 0.f, 0.f};
#pragma unroll
        for (int kk = 0; kk < 2; kk++) {
          bf16x8 vb = *(const bf16x8*)(Vt + (16 * nv + l15) * LDT + kk * 32 + g * 8);
          oc = mfma16(aa[kk], vb, oc);
          bf16x8 sb = *(const bf16x8*)(St + (16 * nv + l15) * LDT + kk * 32 + g * 8);
          oc = mfma16(qa[kk], sb, oc);
        }
#pragma unroll
        for (int r = 0; r < 4; r++) {
          int i = 16 * wid + 4 * g + r;
          int tok = dir ? (N - 1 - (c * 64 + i)) : (c * 64 + i);
          OG[(long)(rowbase + tok) * 512 + h * 128 + vs0 + 16 * nv + l15] = f2bf(oc[r]);
        }
      }
    }
    __syncthreads();
#pragma unroll
    for (int mv = 0; mv < NVT; mv++) {
      st[mv] = stn[mv];
#pragma unroll
      for (int r = 0; r < 4; r++) St[(16 * mv + 4 * g + r) * LDT + 16 * wid + l15] = f2bf(st[mv][r]);
    }
  }
  __syncthreads();
  if (!lat) {
    float* so = p.out + (dir ? O_SB : O_SF) + ((long)((seq * 2 + l) * 4 + h)) * 8192 + (long)(16 * wid + l15) * 128 + vs0;
#pragma unroll
    for (int mv = 0; mv < NVT; mv++)
      *(float4*)(so + 16 * mv + 4 * g) = make_float4(st[mv][0], st[mv][1], st[mv][2], st[mv][3]);
  }
}

__device__ __forceinline__ void phase_mla_up(const Params& p, int l, bfr* sm) {
  bfr* Z = (bfr*)(p.ws + WS_Z);
  const float* rope = (const float*)(p.ws + WS_ROPE);
  const int lane = TIDX & 63, wid = TIDX >> 6, wr = wid >> 1, wc = wid & 1;
  const int g = lane >> 4;
  for (int t = blockIdx.x; t < 288 + 624 + 1024; t += gridDim.x) {
    if (t >= 912) {
      int i = t - 912;
      gla_prep_item(p, l, i >> 9, (i >> 7) & 3, (i >> 6) & 1, i & 63, sm);
      continue;
    }
    f32x4 acc[4][4];
#pragma unroll
    for (int a = 0; a < 4; a++)
#pragma unroll
      for (int b = 0; b < 4; b++) acc[a][b] = (f32x4){0.f, 0.f, 0.f, 0.f};
    if (t < 288) {
      int tn = t % 3, tm = t / 3;
      gemm128k64<4, true>((const bfr*)(p.ws + WS_WUQ) + (long)tn * 128 * 256, 256, 128, Z + (long)tm * 128 * ZLD + C_QL, ZLD, 256,
                    acc, sm);
      bfr* CQ = (bfr*)(p.ws + WS_CQ);
      const float qs = 0.10206207261596577f * 1.4426950408889634f;
#pragma unroll
      for (int pi = 0; pi < 4; pi++) {
        int nb = tn * 128 + wr * 64 + pi * 16;
        int wb = nb % 96;
        bool ropet = wb >= 64;
        int part = (wb - 64) >> 4;
#pragma unroll
        for (int qi = 0; qi < 4; qi++) {
          int tok = tm * 128 + wc * 64 + qi * 16 + (lane & 15);
          float y[4] = {acc[pi][qi][0], acc[pi][qi][1], acc[pi][qi][2], acc[pi][qi][3]};
          if (ropet) {
            bool lat = tok >= NCTX;
            int tl = (tok - NCTX) & 4095;
            int pos = part ? (tl & 63) : (tl >> 6);
            bool hi = (g & 2) != 0;
            int i0 = (g & 1) * 4;
#pragma unroll
            for (int r = 0; r < 4; r++) {
              float yp = __shfl_xor(y[r], 32);
              float c = rope[2048 + pos * 8 + i0 + r], s = rope[2560 + pos * 8 + i0 + r];
              float yr = hi ? (yp * s + y[r] * c) : (y[r] * c - yp * s);
              y[r] = lat ? yr : y[r];
            }
          }
          u32x2 o;
          o.x = pack2(y[0] * qs, y[1] * qs);
          o.y = pack2(y[2] * qs, y[3] * qs);
          *(u32x2*)(CQ + (long)tok * 384 + nb + g * 4) = o;
        }
      }
    } else {
      int t2 = t - 288;
      int tn = t2 % 6, tm = t2 / 6;
      const bfr* Q;
      long ldq;
      long kbase, vbase;
      int nk, key0;
      if (tm < 32) {
        Q = Z + (long)tm * 128 * ZLD + C_KV;
        ldq = ZLD;
        int s = tm >> 1;
        key0 = (tm & 1) * 128;
        nk = 256;
        kbase = (long)s * (4 * 256 * 64);
        vbase = (long)s * 131072;
      } else {
        int r = (tm - 32) * 128;
        int b = r / 4608, within = r % 4608;
        key0 = within;
        nk = 4608;
        kbase = 16l * (4 * 256 * 64) + (long)b * (4 * 4608 * 64);
        vbase = 16l * 131072 + (long)b * (4 * 128 * 4608);
        if (within < 512) {
          Q = (const bfr*)(p.ws + WS_CKVC) + (long)(b * 512 + within) * 256;
          ldq = 256;
        } else {
          Q = Z + (long)(NCTX + b * 4096 + within - 512) * ZLD + C_KV;
          ldq = ZLD;
        }
      }
      gemm128k64<4, true>((const bfr*)(p.ws + WS_WUKV) + (long)tn * 128 * 256, 256, 128, Q, ldq, 256, acc, sm);
      bfr* KN = (bfr*)(p.ws + WS_KNOPE);
      bfr* VTC = (bfr*)(p.ws + WS_VTC);
#pragma unroll
      for (int pi = 0; pi < 4; pi++) {
        int n0 = tn * 128 + wr * 64 + pi * 16 + g * 4;
        int head = n0 / 192, w = n0 % 192;
#pragma unroll
        for (int qi = 0; qi < 4; qi++) {
          int key = key0 + wc * 64 + qi * 16 + (lane & 15);
          if (w < 64) {
            u32x2 o;
            o.x = pack2(acc[pi][qi][0], acc[pi][qi][1]);
            o.y = pack2(acc[pi][qi][2], acc[pi][qi][3]);
            *(u32x2*)(KN + kbase + ((long)head * nk + key) * 64 + w) = o;
          } else {
#pragma unroll
            for (int r = 0; r < 4; r++)
              VTC[vbase + ((long)head * 128 + (w - 64) + r) * nk + key] = f2bf(acc[pi][qi][r]);
          }
        }
      }
    }
  }
}

template <int DQ, int DV, bool MLA, int NQB>
__device__ __forceinline__ void attn_item(const Params& p, int seq, int head, int qoff, bfr* sm, int dry, int amode = 0) {
  constexpr int KLD = DQ + 8;
  constexpr int KSZ = 64 * KLD;
  constexpr int VSZ = DV * LDT;
  constexpr int BUF = KSZ + VSZ;
  constexpr int NKK = DQ / 32;
  constexpr int NDV = DV / 16;
  constexpr int NVL = DV / 32;
  const int tid = TIDX, lane = tid & 63, wid = tid >> 6, g = lane >> 4, l15 = lane & 15;
  bfr* Z = (bfr*)(p.ws + WS_Z);
  const bool lat = seq >= 16;
  const int b = seq - 16;
  const int nk = lat ? 4608 : 256;
  const int rowbase = lat ? NCTX + b * 4096 : seq * 256;
  const int nkt = nk >> 6;

  bf16x8 qf[NQB][NKK];
#pragma unroll
  for (int qb = 0; qb < NQB; qb++) {
    int qrow = rowbase + qoff + wid * (16 * NQB) + qb * 16 + l15;
    const bfr* qp = MLA ? ((const bfr*)(p.ws + WS_CQ) + (long)qrow * 384 + head * 96) : (Z + (long)qrow * ZLD + C_QA + head * 64);
#pragma unroll
    for (int kk = 0; kk < NKK; kk++) qf[qb][kk] = *(const bf16x8*)(qp + kk * 32 + g * 8);
  }

  u32x4 rk[2], rkr, rv[NVL];
  auto prefetch = [&](int kt) {
    int k0 = kt * 64;
    bool cache = lat && (k0 < 512);
    int tokrow0 = lat ? (NCTX + b * 4096 + k0 - 512) : (seq * 256 + k0);
    if (!MLA) {
      int kvh = head >> 2;
#pragma unroll
      for (int i = 0; i < 2; i++) {
        int c = tid + 256 * i;
        int kr_ = c >> 3, ch = c & 7;
        const bfr* src = cache ? ((const bfr*)(p.ws + WS_KCA) + (long)(b * 512 + k0 + kr_) * 128 + kvh * 64 + ch * 8)
                               : (Z + (long)(tokrow0 + kr_) * ZLD + C_KA + kvh * 64 + ch * 8);
        rk[i] = *(const u32x4*)src;
      }
      long vb = lat ? (16l * 32768 + (long)b * (2 * 64 * 4608)) : ((long)seq * 32768);
#pragma unroll
      for (int i = 0; i < NVL; i++) {
        int c = tid + 256 * i;
        int dv = c >> 3, ch = c & 7;
        rv[i] = *(const u32x4*)((const bfr*)(p.ws + WS_VTA) + vb + (long)(kvh * 64 + dv) * nk + k0 + ch * 8);
      }
    } else {
      long kb = lat ? (16l * (4 * 256 * 64) + (long)b * (4 * 4608 * 64)) : ((long)seq * (4 * 256 * 64));
#pragma unroll
      for (int i = 0; i < 2; i++) {
        int c = tid + 256 * i;
        int kr_ = c >> 3, ch = c & 7;
        rk[i] = *(const u32x4*)((const bfr*)(p.ws + WS_KNOPE) + kb + ((long)head * nk + k0 + kr_) * 64 + ch * 8);
      }
      {
        int kr_ = tid >> 2, ch = tid & 3;
        const bfr* src = cache ? ((const bfr*)(p.ws + WS_KRC) + (long)(b * 512 + k0 + kr_) * 32 + ch * 8)
                               : (Z + (long)(tokrow0 + kr_) * ZLD + C_KR + ch * 8);
        rkr = *(const u32x4*)src;
      }
      long vb = lat ? (16l * 131072 + (long)b * (4 * 128 * 4608)) : ((long)seq * 131072);
#pragma unroll
      for (int i = 0; i < NVL; i++) {
        int c = tid + 256 * i;
        int dv = c >> 3, ch = c & 7;
        rv[i] = *(const u32x4*)((const bfr*)(p.ws + WS_VTC) + vb + (long)(head * 128 + dv) * nk + k0 + ch * 8);
      }
    }
  };

  f32x4 o[NQB][NDV];
#pragma unroll
  for (int qb = 0; qb < NQB; qb++)
#pragma unroll
    for (int d = 0; d < NDV; d++) o[qb][d] = (f32x4){0.f, 0.f, 0.f, 0.f};
  float mrun[NQB];
  f32x4 lacc[NQB];
#pragma unroll
  for (int qb = 0; qb < NQB; qb++) { mrun[qb] = 0.f; lacc[qb] = (f32x4){0.f, 0.f, 0.f, 0.f}; }
  const bf16x8 ones = (bf16x8){(short)0x3F80, (short)0x3F80, (short)0x3F80, (short)0x3F80, (short)0x3F80, (short)0x3F80, (short)0x3F80, (short)0x3F80};

  prefetch(0);
  for (int kt = 0; kt < nkt; kt++) {
    bfr* Ks = sm + (kt & 1) * BUF;
    bfr* Vs = Ks + KSZ;
    if (amode != 1) {
#pragma unroll
    for (int i = 0; i < 2; i++) {
      int c = tid + 256 * i;
      *(u32x4*)(Ks + (c >> 3) * KLD + (c & 7) * 8) = rk[i];
    }
    if (MLA) *(u32x4*)(Ks + (tid >> 2) * KLD + 64 + (tid & 3) * 8) = rkr;
#pragma unroll
    for (int i = 0; i < NVL; i++) {
      int c = tid + 256 * i;
      *(u32x4*)(Vs + (c >> 3) * LDT + (c & 7) * 8) = rv[i];
    }
    }
    __syncthreads();
    if (kt + 1 < nkt && amode != 1) prefetch(kt + 1);
    if (amode == 2) continue;

    f32x4 s[NQB][4];
    bf16x8 kfr[4][NKK];
#pragma unroll
    for (int t = 0; t < 2; t++) {
      int krow = 32 * (t >> 1) + 8 * (l15 >> 2) + 4 * (t & 1) + (l15 & 3);
#pragma unroll
      for (int kk = 0; kk < NKK; kk++) kfr[t][kk] = *(const bf16x8*)(Ks + krow * KLD + kk * 32 + g * 8);
    }
#pragma unroll
    for (int t = 0; t < 4; t++) {
#pragma unroll
      for (int qb = 0; qb < NQB; qb++) s[qb][t] = (f32x4){-mrun[qb], -mrun[qb], -mrun[qb], -mrun[qb]};
      if (t + 2 < 4) {
        int krow = 32 * ((t + 2) >> 1) + 8 * (l15 >> 2) + 4 * ((t + 2) & 1) + (l15 & 3);
#pragma unroll
        for (int kk = 0; kk < NKK; kk++) kfr[t + 2][kk] = *(const bf16x8*)(Ks + krow * KLD + kk * 32 + g * 8);
      }
#pragma unroll
      for (int kk = 0; kk < NKK; kk++) {
#pragma unroll
        for (int qb = 0; qb < NQB; qb++) s[qb][t] = mfma16(kfr[t][kk], qf[qb][kk], s[qb][t]);
      }
    }
    bf16x8 vfr[4][2];
#pragma unroll
    for (int d = 0; d < 4; d++)
#pragma unroll
      for (int sx = 0; sx < 2; sx++) vfr[d][sx] = *(const bf16x8*)(Vs + (d * 16 + l15) * LDT + sx * 32 + g * 8);
    bf16x8 pf[NQB][2];
#pragma unroll
    for (int qb = 0; qb < NQB; qb++) {
      float mt = s[qb][0][0];
#pragma unroll
      for (int t = 0; t < 4; t++)
#pragma unroll
        for (int r = 0; r < 4; r++) mt = fmaxf(mt, s[qb][t][r]);
      const bool first = (kt == 0);
      if (first || __builtin_amdgcn_ballot_w64(mt > 8.f) != 0ull) {
        mt = fmaxf(mt, __shfl_xor(mt, 16));
        mt = fmaxf(mt, __shfl_xor(mt, 32));
        const bool need = first || mt > 8.f;
        const float dm = need ? mt : 0.f;
        const float alpha = first ? 1.f : __builtin_amdgcn_exp2f(-dm);
        mrun[qb] += dm;
        lacc[qb] *= alpha;
#pragma unroll
        for (int d = 0; d < NDV; d++) o[qb][d] *= alpha;
#pragma unroll
        for (int t = 0; t < 4; t++) s[qb][t] -= dm;
      }
#pragma unroll
      for (int t = 0; t < 4; t++)
#pragma unroll
        for (int r = 0; r < 4; r++) s[qb][t][r] = __builtin_amdgcn_exp2f(s[qb][t][r]);
#pragma unroll
      for (int sx = 0; sx < 2; sx++) {
        u32x4 u;
        u.x = pack2(s[qb][2 * sx][0], s[qb][2 * sx][1]);
        u.y = pack2(s[qb][2 * sx][2], s[qb][2 * sx][3]);
        u.z = pack2(s[qb][2 * sx + 1][0], s[qb][2 * sx + 1][1]);
        u.w = pack2(s[qb][2 * sx + 1][2], s[qb][2 * sx + 1][3]);
        pf[qb][sx] = *(bf16x8*)&u;
      }
    }
#pragma unroll
    for (int d = 0; d < NDV; d++) {
#pragma unroll
      for (int sx = 0; sx < 2; sx++) {
#pragma unroll
        for (int qb = 0; qb < NQB; qb++) o[qb][d] = mfma16(vfr[d & 3][sx], pf[qb][sx], o[qb][d]);
      }
      if (d + 4 < NDV) {
#pragma unroll
        for (int sx = 0; sx < 2; sx++)
          vfr[d & 3][sx] = *(const bf16x8*)(Vs + ((d + 4) * 16 + l15) * LDT + sx * 32 + g * 8);
      }
    }
#pragma unroll
    for (int sx = 0; sx < 2; sx++) {
#pragma unroll
      for (int qb = 0; qb < NQB; qb++) lacc[qb] = mfma16(ones, pf[qb][sx], lacc[qb]);
    }
  }
  __syncthreads();
#pragma unroll
  for (int qb = 0; qb < NQB; qb++) {
    float inv = 1.f / lacc[qb][0];
    int qrow = rowbase + qoff + wid * (16 * NQB) + qb * 16 + l15;
    bfr* gp = Z + (long)qrow * ZLD + (MLA ? C_GC : C_GA) + head * DV + g * 4;
#pragma unroll
    for (int d = 0; d < NDV; d++) {
      u32x2 gr = *(const u32x2*)(gp + d * 16);
      float y0 = o[qb][d][0] * inv * siluf(lo16(gr.x));
      float y1 = o[qb][d][1] * inv * siluf(hi16(gr.x));
      float y2 = o[qb][d][2] * inv * siluf(lo16(gr.y));
      float y3 = o[qb][d][3] * inv * siluf(hi16(gr.y));
      u32x2 ov;
      ov.x = pack2(y0, y1);
      ov.y = pack2(y2, y3);
      if (!dry) *(u32x2*)(gp + d * 16) = ov;
    }
  }
}

__device__ __forceinline__ void phase_mixers(const Params& p, int l, bfr* sm, int* s_item, int dry) {
  unsigned* ctr = (unsigned*)(p.ws + WS_CTR) + (2 + l + 2 * dry) * 128;
  auto cnt = [](int) { return 184; };
  int q = (int)xcc_id(), tried = 0;
  for (;;) {
    if (TIDX == 0) {
      unsigned first = atomicAdd(ctr + q * 16, 1u);
      *s_item = xq_take(ctr, q, tried, first, cnt);
    }
    __syncthreads();
    const int it = *s_item;
    __syncthreads();
    if (it < 0) break;
    const int x = it >> 20, j = it & 0xfffff;
    int kind, a0, a1, a2, a3 = 0;
    if (j < 4) {
      int idx = x * 4 + j;
      kind = 3; a0 = idx >> 4; a1 = (idx >> 2) & 3; a2 = (idx >> 1) & 1; a3 = idx & 1;
    } else if (j < 36) {
      kind = 1; a0 = 16 + (x >> 2); a1 = x & 3; a2 = (j - 4) * 128;
    } else if (j < 96) {
      int i = j - 36;
      kind = 2; a0 = 16 + (x >> 2); a1 = ((x >> 1) & 1) * 4 + (x & 1) * 2 + (i >> 5); a2 = (i & 31) * 128;
    } else if (j < 104) {
      int k = j - 96;
      int i = 60 + (k >> 1);
      kind = 4; a0 = 16 + (x >> 2); a1 = ((x >> 1) & 1) * 4 + (x & 1) * 2 + (i >> 5); a2 = (i & 31) * 128 + (k & 1) * 64;
    } else if (j < 136) {
      int i = j - 104;
      kind = 0; a0 = 2 * x + (i >> 4); a1 = (i >> 2) & 3; a2 = (i >> 1) & 1; a3 = i & 1;
    } else if (j < 152) {
      int i = j - 136;
      kind = 1; a0 = 2 * x + (i >> 3); a1 = (i >> 1) & 3; a2 = (i & 1) * 128;
    } else {
      int i = j - 152;
      kind = 2; a0 = 2 * x + (i >> 4); a1 = (i >> 1) & 7; a2 = (i & 1) * 128;
    }
#ifdef PROBE_MIXKIND
    if (dry && ((PROBE_MIXKIND == 1) != (kind == 0 || kind == 3))) continue;
#endif
    if (kind == 0) gla_item<64>(p, l, a0, a1, a2, a3, sm);
    else if (kind == 3) gla_chain_item(p, l, a0, a1, a2, a3, sm);
    else if (kind == 1) attn_item<96, 128, true, 2>(p, a0, a1, a2, sm, dry);
    else if (kind == 2) attn_item<64, 64, false, 2>(p, a0, a1, a2, sm, dry);
    else attn_item<64, 64, false, 1>(p, a0, a1, a2, sm, dry);
  }
}

__device__ __forceinline__ void phase_gla_out(const Params& p, int l) {
  const int lane = TIDX & 63;
  bfr* Z = (bfr*)(p.ws + WS_Z);
  const bfr* OF = (const bfr*)(p.ws + WS_R1);
  const bfr* OB = OF + (long)NROWS * 512;
  for (int row = blockIdx.x * 4 + (TIDX >> 6); row < NROWS; row += gridDim.x * 4) {
    float a[8], c[8], gt[8];
    unpack8(*(const u32x4*)(OF + (long)row * 512 + lane * 8), a);
    unpack8(*(const u32x4*)(OB + (long)row * 512 + lane * 8), c);
    bfr* gp = Z + (long)row * ZLD + C_GG + lane * 8;
    unpack8(*(const u32x4*)gp, gt);
    float ss = 0.f;
#pragma unroll
    for (int e = 0; e < 8; e++) {
      a[e] = bf2f(f2bf(a[e] + c[e]));
      ss += a[e] * a[e];
    }
    ss += __shfl_xor(ss, 1); ss += __shfl_xor(ss, 2); ss += __shfl_xor(ss, 4); ss += __shfl_xor(ss, 8);
    float rs = rsqrtf(ss * (1.f / 128.f) + 1e-6f);
    const float* gg = p.in[21] + l * 128 + (lane & 15) * 8;
#pragma unroll
    for (int e = 0; e < 8; e++) a[e] = a[e] * rs * gg[e] * siluf(gt[e]);
    *(u32x4*)gp = pack8(a);
  }
}

template <int NQ>
__device__ __forceinline__ void merge_tile(const Params& p, bfr* sm, int tn, int tok0) {
  bfr* Z = (bfr*)(p.ws + WS_Z);
  bfr* MG = (bfr*)(p.ws + WS_R1);
  const int lane = TIDX & 63, wid = TIDX >> 6, wr = wid >> 1, wc = wid & 1, g = lane >> 4;
  f32x4 totl[4][NQ];
#pragma unroll
  for (int a = 0; a < 4; a++)
#pragma unroll
    for (int b = 0; b < NQ; b++) totl[a][b] = (f32x4){0.f, 0.f, 0.f, 0.f};
#pragma unroll 1
  for (int seg = 0; seg < 3; seg++) {
    f32x4 acc[4][NQ];
#pragma unroll
    for (int a = 0; a < 4; a++)
#pragma unroll
      for (int b = 0; b < NQ; b++) acc[a][b] = (f32x4){0.f, 0.f, 0.f, 0.f};
    int ycol = seg == 0 ? C_GA : (seg == 1 ? C_GG : C_GC);
    int mcol = C_M1 + seg * 1024;
    const bfr* W = (const bfr*)(p.ws + WS_WOA + (unsigned long)seg * 1048576ul) + (long)tn * 128 * 512;
    gemm128k64<NQ, false>(W, 512, 128, Z + (long)tok0 * ZLD + ycol, ZLD, 512, acc, sm);
#pragma unroll
    for (int pi = 0; pi < 4; pi++) {
      int n0 = tn * 128 + wr * 64 + pi * 16 + g * 4;
#pragma unroll
      for (int qi = 0; qi < NQ; qi++) {
        int tok = tok0 + wc * 16 * NQ + qi * 16 + (lane & 15);
        u32x2 mr = *(const u32x2*)(Z + (long)tok * ZLD + mcol + n0);
        totl[pi][qi][0] += sigmf(lo16(mr.x)) * acc[pi][qi][0];
        totl[pi][qi][1] += sigmf(hi16(mr.x)) * acc[pi][qi][1];
        totl[pi][qi][2] += sigmf(lo16(mr.y)) * acc[pi][qi][2];
        totl[pi][qi][3] += sigmf(hi16(mr.y)) * acc[pi][qi][3];
      }
    }
  }
#pragma unroll
  for (int pi = 0; pi < 4; pi++) {
    int n0 = tn * 128 + wr * 64 + pi * 16 + g * 4;
#pragma unroll
    for (int qi = 0; qi < NQ; qi++) {
      int tok = tok0 + wc * 16 * NQ + qi * 16 + (lane & 15);
      u32x2 o;
      o.x = pack2(totl[pi][qi][0], totl[pi][qi][1]);
      o.y = pack2(totl[pi][qi][2], totl[pi][qi][3]);
      *(u32x2*)(MG + (long)tok * 1024 + n0) = o;
    }
  }
}

__device__ __forceinline__ void phase_merge(const Params& p, bfr* sm) {
  for (int t = blockIdx.x; t < 1024; t += gridDim.x) {
    if (t < 512) {
      merge_tile<4>(p, sm, t & 7, (t >> 3) * 128);
    } else {
      int u = t - 512;
      int full = 512 + (u >> 1);
      merge_tile<2>(p, sm, full & 7, (full >> 3) * 128 + (u & 1) * 64);
    }
  }
}

template <int NQ>
__device__ __forceinline__ void outproj_tile(const Params& p, bfr* sm, int tn, int tok0) {
  const bfr* MG = (const bfr*)(p.ws + WS_R1);
  float* OUT = (float*)(p.ws + WS_Z);
  const int lane = TIDX & 63, wid = TIDX >> 6, wr = wid >> 1, wc = wid & 1, g = lane >> 4;
  f32x4 acc[4][NQ];
#pragma unroll
  for (int a = 0; a < 4; a++)
#pragma unroll
    for (int b = 0; b < NQ; b++) acc[a][b] = (f32x4){0.f, 0.f, 0.f, 0.f};
  gemm128k64<NQ, true>((const bfr*)(p.ws + WS_WOUT) + (long)tn * 128 * 1024, 1024, 128, MG + (long)tok0 * 1024, 1024, 1024, acc, sm);
#pragma unroll
  for (int pi = 0; pi < 4; pi++) {
    int n0 = tn * 128 + wr * 64 + pi * 16 + g * 4;
#pragma unroll
    for (int qi = 0; qi < NQ; qi++) {
      int tok = tok0 + wc * 16 * NQ + qi * 16 + (lane & 15);
      *(float4*)(OUT + (long)tok * 1024 + n0) = make_float4(acc[pi][qi][0], acc[pi][qi][1], acc[pi][qi][2], acc[pi][qi][3]);
    }
  }
}
__device__ __forceinline__ void phase_outproj(const Params& p, bfr* sm) {
  for (int t = blockIdx.x; t < 1024; t += gridDim.x) {
    if (t < 512) {
      outproj_tile<4>(p, sm, t & 7, (t >> 3) * 128);
    } else {
      int u = t - 512;
      int full = 512 + (u >> 1);
      outproj_tile<2>(p, sm, full & 7, (full >> 3) * 128 + (u & 1) * 64);
    }
  }
}

__device__ __forceinline__ void phase_post(const Params& p, int l) {
  const int lane = TIDX & 63;
  const float* mod = (const float*)(p.ws + WS_MOD);
  const float* OUT = (const float*)(p.ws + WS_Z);
  bfr* H = (bfr*)(p.ws + WS_R1);
  for (int row = blockIdx.x * 4 + (TIDX >> 6); row < NROWS; row += gridDim.x * 4) {
    const float* x = (l == 0) ? xrow(p, row) : (p.out + (long)row * 1024);
    const float* md = mod + (l * 3 + row_cond(row)) * 3072;
    float4 v[4];
    float ss = 0.f;
#pragma unroll
    for (int i = 0; i < 4; i++) {
      v[i] = *(const float4*)(OUT + (long)row * 1024 + i * 256 + lane * 4);
      ss += v[i].x * v[i].x + v[i].y * v[i].y + v[i].z * v[i].z + v[i].w * v[i].w;
    }
    ss = wave_sum(ss);
    float rs = rsqrtf(ss * (1.f / 1024.f) + 1e-6f);
    float ss2 = 0.f;
#pragma unroll
    for (int i = 0; i < 4; i++) {
      int n = i * 256 + lane * 4;
      float4 g = *(const float4*)(p.in[13] + l * 1024 + n);
      float4 gt = *(const float4*)(md + 2048 + n);
      float4 xv = *(const float4*)(x + n);
      v[i].x = xv.x + gt.x * (v[i].x * rs * g.x);
      v[i].y = xv.y + gt.y * (v[i].y * rs * g.y);
      v[i].z = xv.z + gt.z * (v[i].z * rs * g.z);
      v[i].w = xv.w + gt.w * (v[i].w * rs * g.w);
      *(float4*)(p.out + (long)row * 1024 + n) = v[i];
      ss2 += v[i].x * v[i].x + v[i].y * v[i].y + v[i].z * v[i].z + v[i].w * v[i].w;
    }
    if (l == 0) {
      ss2 = wave_sum(ss2);
      float rs2 = rsqrtf(ss2 * (1.f / 1024.f) + 1e-6f);
      const float* md1 = mod + (1 * 3 + row_cond(row)) * 3072;
#pragma unroll
      for (int i = 0; i < 4; i++) {
        int n = i * 256 + lane * 4;
        float4 g = *(const float4*)(p.in[12] + 1024 + n);
        float4 sh = *(const float4*)(md1 + n);
        float4 sc = *(const float4*)(md1 + 1024 + n);
        float h0 = v[i].x * rs2 * g.x * (1.f + sc.x) + sh.x;
        float h1 = v[i].y * rs2 * g.y * (1.f + sc.y) + sh.y;
        float h2 = v[i].z * rs2 * g.z * (1.f + sc.z) + sh.z;
        float h3 = v[i].w * rs2 * g.w * (1.f + sc.w) + sh.w;
        u32x2 o;
        o.x = pack2(h0, h1);
        o.y = pack2(h2, h3);
        *(u32x2*)(H + (long)row * 1024 + n) = o;
      }
    }
  }
}

__global__ void __launch_bounds__(256, 2) fwd_megakernel(Params p) {
  __shared__ __attribute__((aligned(16))) bfr sm[SMEM_SHORTS + 16];
  int* s_item_p = (int*)(sm + SMEM_SHORTS + 8);
  cg::grid_group grid = cg::this_grid();
  if (threadIdx.x == 0) { ((unsigned*)(sm + SMEM_SHORTS))[0] = 0u; ((unsigned*)(sm + SMEM_SHORTS))[1] = 0u; }
  __syncthreads();
  XcdBarrier xb = xcd_barrier_post((unsigned*)(p.ws + WS_BAR), (volatile LAS unsigned*)(sm + SMEM_SHORTS));
  if (p.ws == nullptr) grid.sync();
  (void)xb;
#define GSYNC1 do { XcdBarrier b_; b_.bar = (unsigned*)(p.ws + WS_BAR); b_.x = xb_xcc_id(); \
                    b_.st = (volatile LAS unsigned*)(sm + SMEM_SHORTS); xcd_barrier(b_); } while (0)
#ifdef PROBE_SYNC
#define GSYNC do { GSYNC1; GSYNC1; } while (0)
#else
#define GSYNC GSYNC1
#endif
#ifdef PROBE_PRE
  phase_s0(launder(p), sm);
  GSYNC;
  phase_s1(launder(p));
  wconv_phase(p, 0, sm);
  GSYNC;
  phase_prenorm0(launder(p));
  GSYNC;
#endif

#ifndef PH
#define PH 0xffff
#endif
#if PH & 1
  phase_s0(launder(p), sm);
#endif
  GSYNC;
#if PH & 2
  phase_s1(launder(p));
  wconv_phase(p, 0, sm);
#endif
  GSYNC;
#if PH & 4
  phase_prenorm0(launder(p));
#endif
  GSYNC;
  for (int l = 0; l < 2; l++) {
#if PH & 8
#ifdef PROBE_INPROJ
    phase_inproj(launder(p), l, sm, s_item_p, 6 + l);
    GSYNC;
#endif
    phase_inproj(launder(p), l, sm, s_item_p, l);
#endif
    GSYNC;
#if PH & 16
    phase_rowpost(launder(p), l);
#endif
    GSYNC;
#if PH & 32
#ifdef PROBE_MLAUP
    phase_mla_up(launder(p), l, sm);
    GSYNC;
#endif
    phase_mla_up(launder(p), l, sm);
#endif
    GSYNC;
#if PH & 64
#ifdef PROBE_MIX
    { int dry = 1; asm volatile("" : "+s"(dry)); phase_mixers(launder(p), l, sm, s_item_p, dry); }
    GSYNC;
#endif
    { int dry = 0; asm volatile("" : "+s"(dry)); phase_mixers(launder(p), l, sm, s_item_p, dry); }
#endif
    GSYNC;
#if PH & 128
    phase_gla_out(launder(p), l);
#endif
    GSYNC;
#if PH & 256
#ifdef PROBE_MERGE
    phase_merge(launder(p), sm);
    GSYNC;
#endif
    phase_merge(launder(p), sm);
#endif
    GSYNC;
#if PH & 512
#ifdef PROBE_MERGE
    phase_outproj(launder(p), sm);
    GSYNC;
#endif
    phase_outproj(launder(p), sm);
#endif
    GSYNC;
#if PH & 1024
    phase_post(launder(p), l);
    if (l == 0) wconv_phase(p, 1, sm);
#endif
    GSYNC;
  }
}

extern "C" void kernel_launch(void* const* d_in, const int* in_sizes, int n_in, void* d_out, int out_size, void* d_ws,
                              size_t ws_size, hipStream_t stream) {
  static int grid_blocks = 0;
  if (!grid_blocks) {
    int dev = 0, cus = 0, per_cu = 0;
    hipGetDevice(&dev);
    hipDeviceGetAttribute(&cus, hipDeviceAttributeMultiprocessorCount, dev);
    hipOccupancyMaxActiveBlocksPerMultiprocessor(&per_cu, fwd_megakernel, 256, 0);
    if (per_cu > 2) per_cu = 2;
    if (per_cu < 1) per_cu = 1;
    grid_blocks = cus * per_cu;
  }
  Params p{};
  for (int i = 0; i < 30; i++) p.in[i] = (const float*)d_in[i];
  p.out = (float*)d_out;
  p.ws = (unsigned char*)d_ws;
  hipMemsetAsync(d_ws, 0, 20480, stream);
  void* args[] = {&p};
  hipError_t e = hipLaunchCooperativeKernel((void*)fwd_megakernel, dim3(grid_blocks), dim3(256), args, 0, stream);
  if (e != hipSuccess) fprintf(stderr, "cooperative launch failed: %s (grid %d)\n", hipGetErrorString(e), grid_blocks);
}
```

```cpp
#include <hip/hip_runtime.h>
#include <hip/hip_cooperative_groups.h>
#include <cstdio>
namespace cg = cooperative_groups;

typedef unsigned short bfr;
typedef __attribute__((ext_vector_type(8))) short bf16x8;
typedef __attribute__((ext_vector_type(4))) float f32x4;
typedef __attribute__((ext_vector_type(4))) unsigned u32x4;
typedef __attribute__((ext_vector_type(2))) unsigned u32x2;

#define NROWS 12288
#define NCTX 4096
#define ZLD 6976
#define LDT 72
#define SMEM_SHORTS (4 * 128 * LDT)

#define C_QA 0
#define C_KA 512
#define C_VA 640
#define C_GA 768
#define C_QG 1280
#define C_KG 1536
#define C_VG 1792
#define C_GG 2304
#define C_RF 2816
#define C_RB 2832
#define C_QL 2848
#define C_KV 3104
#define C_KR 3360
#define C_GC 3392
#define C_M1 3904
#define C_M2 4928
#define C_M3 5952

#define WS_BAR 0ul
#define WS_CTR 16384ul
#define WS_MODP 20480ul
#define WS_MOD (WS_MODP + 589824ul)
#define WS_ROPE (WS_MOD + 73728ul)
#define WS_WIN (WS_ROPE + 16384ul)
#define WS_WUQ (WS_WIN + 14417920ul)
#define WS_WUKV (WS_WUQ + 196608ul)
#define WS_WOA (WS_WUKV + 393216ul)
#define WS_WOB (WS_WOA + 1048576ul)
#define WS_WOC (WS_WOB + 1048576ul)
#define WS_WOUT (WS_WOC + 1048576ul)
#define WS_KCA (WS_WOUT + 2097152ul)
#define WS_CKVC (WS_KCA + 262144ul)
#define WS_KRC (WS_CKVC + 524288ul)
#define WS_VTA (WS_KRC + 65536ul)
#define WS_CQ (WS_VTA + 3407872ul)
#define WS_KNOPE (WS_CQ + 9437184ul)
#define WS_VTC (WS_KNOPE + 6815744ul)
#define WS_R1 (WS_VTC + 13631488ul)
#define WS_Z (WS_R1 + 25165824ul)
#define WS_END (WS_Z + 171442176ul)

#define O_Y 0
#define O_GK 12582912
#define O_GV 13631488
#define O_CKV 14680064
#define O_KR 16777216
#define O_SF 17039360
#define O_SB 18087936

struct Params {
  const float* in[30];
  float* out;
  unsigned char* ws;
};

__device__ __forceinline__ int tidx() {
  int t = threadIdx.x;
  asm volatile("" : "+v"(t));
  return t;
}
__device__ __forceinline__ Params launder(const Params& p) {
  Params q;
  long zo = 0;
  asm volatile("" : "+s"(zo));
#pragma unroll
  for (int i = 0; i < 30; i++) q.in[i] = p.in[i] + zo;
  q.out = p.out + zo;
  q.ws = p.ws + zo;
  return q;
}
__device__ __forceinline__ float bf2f(bfr b) { return __uint_as_float(((unsigned)b) << 16); }
typedef float f32x2_t __attribute__((ext_vector_type(2)));
typedef __bf16 bf16x2_t __attribute__((ext_vector_type(2)));
__device__ __forceinline__ bfr f2bf(float f) {
  __bf16 r = (__bf16)f;
  return *(bfr*)&r;
}
__device__ __forceinline__ unsigned pack2(float a, float b) {
  f32x2_t v = {a, b};
  bf16x2_t r = __builtin_convertvector(v, bf16x2_t);
  return *(unsigned*)&r;
}
__device__ __forceinline__ float lo16(unsigned u) { return __uint_as_float(u << 16); }
__device__ __forceinline__ float hi16(unsigned u) { return __uint_as_float(u & 0xffff0000u); }
__device__ __forceinline__ float siluf(float x) { return x / (1.f + __expf(-x)); }
__device__ __forceinline__ float sigmf(float x) { return 1.f / (1.f + __expf(-x)); }
__device__ __forceinline__ f32x4 mfma16(bf16x8 a, bf16x8 b, f32x4 c) {
  return __builtin_amdgcn_mfma_f32_16x16x32_bf16(a, b, c, 0, 0, 0);
}
__device__ __forceinline__ const float* xrow(const Params& p, int row) {
  return row < NCTX ? p.in[0] + (long)row * 1024 : p.in[1] + (long)(row - NCTX) * 1024;
}
__device__ __forceinline__ int row_cond(int row) { return row < NCTX ? 0 : 1 + ((row - NCTX) >> 12); }
__device__ __forceinline__ float wave_sum(float v) {
  v += __shfl_xor(v, 1); v += __shfl_xor(v, 2); v += __shfl_xor(v, 4);
  v += __shfl_xor(v, 8); v += __shfl_xor(v, 16); v += __shfl_xor(v, 32);
  return v;
}

#define XB_TMO      128
#define XB_XCNT(j)  (256  + 64 * (j))
#define XB_XSUB(j)  (1280 + 64 * (j))
#define XB_XGEN(j)  (2304 + 64 * (j))
#define XB_TOP      3328
#define XB_TOPGEN   3392
#define XCD_BAR_WORDS 3456
#define XB_SPIN_CAP (1u << 18)
#define LAS __attribute__((address_space(3)))

__device__ __forceinline__ unsigned xb_ld(unsigned* p)              { return __hip_atomic_load(p, __ATOMIC_RELAXED, __HIP_MEMORY_SCOPE_AGENT); }
__device__ __forceinline__ unsigned xb_add(unsigned* p, unsigned v) { return __hip_atomic_fetch_add(p, v, __ATOMIC_RELAXED, __HIP_MEMORY_SCOPE_AGENT); }
__device__ __forceinline__ unsigned xb_xcc_id() { return (unsigned)__builtin_amdgcn_s_getreg((3 << 11) | 20) & 0xFu; }
#define XB_SPIN(cond, bar) do { unsigned _sp = 0; while (cond) { __builtin_amdgcn_s_sleep(1); \
    if ((++_sp & 255u) == 0u) { if (xb_ld(&(bar)[XB_TMO])) break; if (_sp > XB_SPIN_CAP) { atomicAdd(&(bar)[XB_TMO], 1u); break; } } } } while (0)

struct XcdBarrier {
    unsigned* bar; unsigned x;
    volatile LAS unsigned* st;
};

__device__ __forceinline__ XcdBarrier xcd_barrier_post(unsigned* bar, volatile LAS unsigned* st) {
    XcdBarrier b; b.bar = bar; b.x = xb_xcc_id(); b.st = st;
    if (threadIdx.x == 0) (void)xb_add(&bar[XB_XCNT(b.x)], 1u);
    return b;
}
__device__ __forceinline__ void xcd_barrier_complete(unsigned* bar, unsigned x, unsigned& nloc, unsigned& nx) {
    const unsigned G = gridDim.x * gridDim.y * gridDim.z;
    unsigned sum, cnt, mine, sp = 0u;
    for (;;) {
        sum = 0u; cnt = 0u; mine = 0u;
#pragma unroll
        for (unsigned j = 0; j < 16; ++j) { const unsigned c = xb_ld(&bar[XB_XCNT(j)]); sum += c; cnt += (c > 0u) ? 1u : 0u; mine = (j == x) ? c : mine; }
        if (sum == G) break;
        __builtin_amdgcn_s_sleep(1);
        if ((++sp & 255u) == 0u) { if (xb_ld(&bar[XB_TMO])) break; if (sp > XB_SPIN_CAP) { atomicAdd(&bar[XB_TMO], 1u); break; } }
    }
    nloc = mine > 0u ? mine : 1u; nx = cnt > 0u ? cnt : 1u;
}

__device__ __forceinline__ void xcd_barrier(const XcdBarrier& b) {
    asm volatile("s_waitcnt vmcnt(0)" ::: "memory");
    __syncthreads();
    if (threadIdx.x == 0) {
        unsigned* bar = b.bar;
        __builtin_amdgcn_s_waitcnt(0);
        unsigned nloc = b.st[0], nx = b.st[1];
        if (nloc == 0u) { xcd_barrier_complete(bar, b.x, nloc, nx); b.st[0] = nloc; b.st[1] = nx; }
        const unsigned old = xb_add(&bar[XB_XSUB(b.x)], 1u);
        const unsigned gen = old / nloc;
        if (old + 1u == (gen + 1u) * nloc) {
            __builtin_amdgcn_fence(__ATOMIC_RELEASE, "agent");
            asm volatile("s_waitcnt vmcnt(0)" ::: "memory");
            const unsigned og = xb_add(&bar[XB_TOP], 1u);
            const unsigned tg = og / nx;
            if (og + 1u == (tg + 1u) * nx) xb_add(&bar[XB_TOPGEN], 1u);
            else XB_SPIN(xb_ld(&bar[XB_TOPGEN]) == tg, bar);
            __builtin_amdgcn_fence(__ATOMIC_ACQUIRE, "agent");
            xb_add(&bar[XB_XGEN(b.x)], 1u);
            asm volatile("s_waitcnt vmcnt(0)" ::: "memory");
        } else {
            XB_SPIN(xb_ld(&bar[XB_XGEN(b.x)]) == gen, bar);
            __builtin_amdgcn_fence(__ATOMIC_ACQUIRE, "agent");
            asm volatile("s_waitcnt vmcnt(0)" ::: "memory");
        }
    }
    __syncthreads();
}


#define TIDX tidx()
#define LDS3 __attribute__((address_space(3)))
__device__ __forceinline__ void glds16(const bfr* g, bfr* l) {
  __builtin_amdgcn_global_load_lds((const unsigned*)g, (LDS3 unsigned*)l, 16, 0, 0);
}
__device__ __forceinline__ void gemm128(const bfr* __restrict__ P, long ldp, int pmax,
                                        const bfr* __restrict__ Q, long ldq, int qmax, int K,
                                        f32x4 (&acc)[4][4], bfr* sm) {
  const int tid = TIDX, lane = tid & 63, wid = tid >> 6;
  const int wr = wid >> 1, wc = wid & 1;
  const int l15 = lane & 15, g = lane >> 4;
  const bfr* pp[2];
  const bfr* qp[2];
  {
    const int r0 = tid >> 2;
    const int c = (tid & 3) ^ ((tid >> 4) & 3);
#pragma unroll
    for (int i = 0; i < 2; i++) {
      int r = r0 + 64 * i;
      pp[i] = P + (long)min(r, pmax - 1) * ldp + c * 8;
      qp[i] = Q + (long)min(r, qmax - 1) * ldq + c * 8;
    }
  }
  const int nk = K >> 5;
#define GEMM_ISSUE(T)                                                    \
  do {                                                                   \
    bfr* nb_ = sm + ((T) & 3) * 8192;                                    \
    glds16(pp[0] + (T) * 32, nb_ + tid * 8);                             \
    glds16(pp[1] + (T) * 32, nb_ + 2048 + tid * 8);                      \
    glds16(qp[0] + (T) * 32, nb_ + 4096 + tid * 8);                      \
    glds16(qp[1] + (T) * 32, nb_ + 6144 + tid * 8);                      \
  } while (0)
  GEMM_ISSUE(0);
  GEMM_ISSUE(1);
  GEMM_ISSUE(2);
  const int pos = (g ^ ((l15 >> 2) & 3)) * 8;
  for (int kt = 0; kt < nk; kt++) {
    if (kt + 2 < nk) asm volatile("s_waitcnt vmcnt(8)" ::: "memory");
    else if (kt + 1 < nk) asm volatile("s_waitcnt vmcnt(4)" ::: "memory");
    else asm volatile("s_waitcnt vmcnt(0)" ::: "memory");
    __builtin_amdgcn_s_barrier();
    if (kt + 3 < nk) GEMM_ISSUE(kt + 3);
    const bfr* Ps = sm + (kt & 3) * 8192;
    const bfr* Qs = Ps + 4096;
    bf16x8 pf[4], qf[4];
#pragma unroll
    for (int m = 0; m < 4; m++) {
      pf[m] = *(const bf16x8*)(Ps + (wr * 64 + m * 16 + l15) * 32 + pos);
      qf[m] = *(const bf16x8*)(Qs + (wc * 64 + m * 16 + l15) * 32 + pos);
    }
#pragma unroll
    for (int m = 0; m < 4; m++)
#pragma unroll
      for (int n = 0; n < 4; n++) acc[m][n] = mfma16(pf[m], qf[n], acc[m][n]);
  }
#undef GEMM_ISSUE
  __syncthreads();
}

template <int NQ>
__device__ __forceinline__ void gemm128q(const bfr* __restrict__ P, long ldp, const bfr* __restrict__ Q, long ldq, int K,
                                         f32x4 (&acc)[4][NQ], bfr* sm) {
  constexpr int QI = NQ / 2;
  constexpr int STG = 4096 + QI * 2048;
  const int tid = TIDX, lane = tid & 63, wid = tid >> 6;
  const int wr = wid >> 1, wc = wid & 1;
  const int l15 = lane & 15, g = lane >> 4;
  const bfr* pp[2];
  const bfr* qp[QI];
  {
    const int r0 = tid >> 2;
    const int c = (tid & 3) ^ (((tid >> 5) & 1) * 3);
#pragma unroll
    for (int i = 0; i < 2; i++) pp[i] = P + (long)(r0 + 64 * i) * ldp + c * 8;
#pragma unroll
    for (int i = 0; i < QI; i++) qp[i] = Q + (long)(r0 + 64 * i) * ldq + c * 8;
  }
  const int nk = K >> 5;
  auto issue = [&](int T) {
    bfr* nb_ = sm + (T & 3) * STG;
    glds16(pp[0] + T * 32, nb_ + tid * 8);
    glds16(pp[1] + T * 32, nb_ + 2048 + tid * 8);
#pragma unroll
    for (int i = 0; i < QI; i++) glds16(qp[i] + T * 32, nb_ + 4096 + i * 2048 + tid * 8);
  };
  issue(0);
  issue(1);
  issue(2);
  const int pos = (g ^ (((l15 >> 3) & 1) * 3)) * 8;
  for (int kt = 0; kt < nk; kt++) {
    if (kt + 2 < nk) {
      if (QI == 2) asm volatile("s_waitcnt vmcnt(8)" ::: "memory"); else asm volatile("s_waitcnt vmcnt(6)" ::: "memory");
    } else if (kt + 1 < nk) {
      if (QI == 2) asm volatile("s_waitcnt vmcnt(4)" ::: "memory"); else asm volatile("s_waitcnt vmcnt(3)" ::: "memory");
    } else {
      asm volatile("s_waitcnt vmcnt(0)" ::: "memory");
    }
    __builtin_amdgcn_s_barrier();
    if (kt + 3 < nk) issue(kt + 3);
    const bfr* Ps = sm + (kt & 3) * STG;
    const bfr* Qs = Ps + 4096;
    bf16x8 pf[4], qf[NQ];
#pragma unroll
    for (int m = 0; m < 4; m++) pf[m] = *(const bf16x8*)(Ps + (wr * 64 + m * 16 + l15) * 32 + pos);
#pragma unroll
    for (int n = 0; n < NQ; n++) qf[n] = *(const bf16x8*)(Qs + (wc * 16 * NQ + n * 16 + l15) * 32 + pos);
#pragma unroll
    for (int m = 0; m < 4; m++)
#pragma unroll
      for (int n = 0; n < NQ; n++) acc[m][n] = mfma16(pf[m], qf[n], acc[m][n]);
  }
  __syncthreads();
}

template <int NQ>
__device__ __forceinline__ void gemm256x128(const bfr* __restrict__ P, long ldp, int pmax,
                                            const bfr* __restrict__ Q, long ldq, int K,
                                            f32x4 (&acc)[8][NQ], bfr* sm) {
  constexpr int QI = NQ / 2;
  constexpr int STG = 8192 + QI * 2048;
  const int tid = TIDX, lane = tid & 63, wid = tid >> 6;
  const int wr = wid >> 1, wc = wid & 1;
  const int l15 = lane & 15, g = lane >> 4;
  const bfr* pp[4];
  const bfr* qp[QI];
  {
    const int r0 = tid >> 2;
    const int c = (tid & 3) ^ (((tid >> 5) & 1) * 3);
#pragma unroll
    for (int i = 0; i < 4; i++) pp[i] = P + (long)min(r0 + 64 * i, pmax - 1) * ldp + c * 8;
#pragma unroll
    for (int i = 0; i < QI; i++) qp[i] = Q + (long)(r0 + 64 * i) * ldq + c * 8;
  }
  const int nk = K >> 5;
  auto issue = [&](int T, int stg) {
    bfr* nb_ = sm + stg * STG;
    glds16(pp[0] + T * 32, nb_ + tid * 8);
    glds16(pp[1] + T * 32, nb_ + 2048 + tid * 8);
    glds16(pp[2] + T * 32, nb_ + 4096 + tid * 8);
    glds16(pp[3] + T * 32, nb_ + 6144 + tid * 8);
#pragma unroll
    for (int i = 0; i < QI; i++) glds16(qp[i] + T * 32, nb_ + 8192 + i * 2048 + tid * 8);
  };
  issue(0, 0);
  issue(1, 1);
  const int pos = (g ^ (((l15 >> 3) & 1) * 3)) * 8;
  int st = 0;
  for (int kt = 0; kt < nk; kt++) {
    if (kt + 1 < nk) {
      if (QI == 2) asm volatile("s_waitcnt vmcnt(6)" ::: "memory"); else asm volatile("s_waitcnt vmcnt(5)" ::: "memory");
    } else {
      asm volatile("s_waitcnt vmcnt(0)" ::: "memory");
    }
    __builtin_amdgcn_s_barrier();
    if (kt + 2 < nk) issue(kt + 2, st == 0 ? 2 : st - 1);
    const bfr* Ps = sm + st * STG;
    const bfr* Qs = Ps + 8192;
    st = (st == 2) ? 0 : st + 1;
    bf16x8 qf[NQ], pf[8];
#pragma unroll
    for (int n = 0; n < NQ; n++) qf[n] = *(const bf16x8*)(Qs + (wc * 16 * NQ + n * 16 + l15) * 32 + pos);
#pragma unroll
    for (int m = 0; m < 8; m++) pf[m] = *(const bf16x8*)(Ps + (wr * 128 + m * 16 + l15) * 32 + pos);
#pragma unroll
    for (int m = 0; m < 8; m++)
#pragma unroll
      for (int n = 0; n < NQ; n++) acc[m][n] = mfma16(pf[m], qf[n], acc[m][n]);
    __builtin_amdgcn_sched_group_barrier(0x100, NQ + 2, 0);
#pragma unroll
    for (int i = 0; i < 6; i++) {
      __builtin_amdgcn_sched_group_barrier(0x008, NQ, 0);
      __builtin_amdgcn_sched_group_barrier(0x100, 1, 0);
    }
    __builtin_amdgcn_sched_group_barrier(0x008, 2 * NQ, 0);
  }
  __syncthreads();
}

template <int NQ, bool PIPE, bool TAIL = false>
__device__ __forceinline__ void gemm128k64(const bfr* __restrict__ P, long ldp, int pmax,
                                           const bfr* __restrict__ Q, long ldq, int K,
                                           f32x4 (&acc)[4][NQ], bfr* sm, const bfr* tail_src = nullptr, long tail_ld = 0) {
  constexpr int STG = 8192 + 2048 * NQ;
  const int tid = TIDX, lane = tid & 63, wid = tid >> 6;
  const int wr = wid >> 1, wc = wid & 1;
  const int l15 = lane & 15, g = lane >> 4;
  const bfr* pp[4];
  const bfr* qp[NQ];
  {
    const int r0 = tid >> 3;
    const int c = (tid & 7) ^ ((tid >> 4) & 7);
#pragma unroll
    for (int i = 0; i < 4; i++) pp[i] = P + (long)min(r0 + 32 * i, pmax - 1) * ldp + c * 8;
#pragma unroll
    for (int i = 0; i < NQ; i++) qp[i] = Q + (long)(r0 + 32 * i) * ldq + c * 8;
  }
  const int nk = K >> 6;
#pragma unroll
  for (int i = 0; i < 4; i++) glds16(pp[i], sm + i * 2048 + tid * 8);
#pragma unroll
  for (int i = 0; i < NQ; i++) glds16(qp[i], sm + 8192 + i * 2048 + tid * 8);
  const int swz = l15 >> 1;
  for (int kt = 0; kt < nk; kt++) {
    asm volatile("s_waitcnt vmcnt(0)" ::: "memory");
    __builtin_amdgcn_s_barrier();
    if (kt + 1 < nk) {
      bfr* nb = sm + ((kt + 1) & 1) * STG;
#pragma unroll
      for (int i = 0; i < 4; i++) glds16(pp[i] + (kt + 1) * 64, nb + i * 2048 + tid * 8);
#pragma unroll
      for (int i = 0; i < NQ; i++) glds16(qp[i] + (kt + 1) * 64, nb + 8192 + i * 2048 + tid * 8);
    } else if (TAIL) {
      bfr* nb = sm + ((kt + 1) & 1) * STG;
      const bfr* ts = tail_src + (long)(tid >> 4) * tail_ld + (((tid & 15) ^ ((tid >> 4) & 15)) * 8);
#pragma unroll
      for (int i = 0; i < 2 * NQ; i++) glds16(ts + (long)(16 * i) * tail_ld, nb + i * 2048 + tid * 8);
    }
    const bfr* Ps = sm + (kt & 1) * STG;
    const bfr* Qs = Ps + 8192;
    if (PIPE) {
      bf16x8 pf[2][4], qf[2][NQ];
#pragma unroll
      for (int kk = 0; kk < 2; kk++) {
        const int pos = ((kk * 4 + g) ^ swz) * 8;
#pragma unroll
        for (int m = 0; m < 4; m++) pf[kk][m] = *(const bf16x8*)(Ps + (wr * 64 + m * 16 + l15) * 64 + pos);
#pragma unroll
        for (int n = 0; n < NQ; n++) qf[kk][n] = *(const bf16x8*)(Qs + (wc * 16 * NQ + n * 16 + l15) * 64 + pos);
      }
#pragma unroll
      for (int kk = 0; kk < 2; kk++)
#pragma unroll
        for (int m = 0; m < 4; m++)
#pragma unroll
          for (int n = 0; n < NQ; n++) acc[m][n] = mfma16(pf[kk][m], qf[kk][n], acc[m][n]);
      __builtin_amdgcn_sched_group_barrier(0x100, 4 + NQ, 0);
#pragma unroll
      for (int i = 0; i < 4 + NQ; i++) {
        __builtin_amdgcn_sched_group_barrier(0x008, NQ == 4 ? 2 : 1, 0);
        __builtin_amdgcn_sched_group_barrier(0x100, 1, 0);
      }
      __builtin_amdgcn_sched_group_barrier(0x008, NQ == 4 ? 16 : 10, 0);
    } else {
#pragma unroll
      for (int kk = 0; kk < 2; kk++) {
        bf16x8 pf[4], qf[NQ];
        const int pos = ((kk * 4 + g) ^ swz) * 8;
#pragma unroll
        for (int m = 0; m < 4; m++) pf[m] = *(const bf16x8*)(Ps + (wr * 64 + m * 16 + l15) * 64 + pos);
#pragma unroll
        for (int n = 0; n < NQ; n++) qf[n] = *(const bf16x8*)(Qs + (wc * 16 * NQ + n * 16 + l15) * 64 + pos);
#pragma unroll
        for (int m = 0; m < 4; m++)
#pragma unroll
          for (int n = 0; n < NQ; n++) acc[m][n] = mfma16(pf[m], qf[n], acc[m][n]);
      }
    }
  }
  if (TAIL) asm volatile("s_waitcnt vmcnt(0)" ::: "memory");
  __syncthreads();
}

__device__ __forceinline__ void gemm160x128(const bfr* __restrict__ P, long ldp, int pmax,
                                            const bfr* __restrict__ Q, long ldq, int K,
                                            f32x4 (&acc)[5][4], bfr* sm) {
  constexpr int STG = 160 * 64 + 128 * 64;
  const int tid = TIDX, lane = tid & 63, wid = tid >> 6;
  const int wr = wid >> 1, wc = wid & 1;
  const int l15 = lane & 15, g = lane >> 4;
  const bfr* pp[5];
  const bfr* qp[4];
  {
    const int r0 = tid >> 3;
    const int c = (tid & 7) ^ ((tid >> 4) & 7);
#pragma unroll
    for (int i = 0; i < 5; i++) pp[i] = P + (long)min(r0 + 32 * i, pmax - 1) * ldp + c * 8;
#pragma unroll
    for (int i = 0; i < 4; i++) qp[i] = Q + (long)(r0 + 32 * i) * ldq + c * 8;
  }
  const int nk = K >> 6;
#pragma unroll
  for (int i = 0; i < 5; i++) glds16(pp[i], sm + i * 2048 + tid * 8);
#pragma unroll
  for (int i = 0; i < 4; i++) glds16(qp[i], sm + 10240 + i * 2048 + tid * 8);
  const int swz = l15 >> 1;
  for (int kt = 0; kt < nk; kt++) {
    asm volatile("s_waitcnt vmcnt(0)" ::: "memory");
    __builtin_amdgcn_s_barrier();
    if (kt + 1 < nk) {
      bfr* nb = sm + ((kt + 1) & 1) * STG;
#pragma unroll
      for (int i = 0; i < 5; i++) glds16(pp[i] + (kt + 1) * 64, nb + i * 2048 + tid * 8);
#pragma unroll
      for (int i = 0; i < 4; i++) glds16(qp[i] + (kt + 1) * 64, nb + 10240 + i * 2048 + tid * 8);
    }
    const bfr* Ps = sm + (kt & 1) * STG;
    const bfr* Qs = Ps + 10240;
    bf16x8 pf[2][5], qf[2][4];
#pragma unroll
    for (int kk = 0; kk < 2; kk++) {
      const int pos = ((kk * 4 + g) ^ swz) * 8;
#pragma unroll
      for (int m = 0; m < 5; m++) pf[kk][m] = *(const bf16x8*)(Ps + (wr * 80 + m * 16 + l15) * 64 + pos);
#pragma unroll
      for (int n = 0; n < 4; n++) qf[kk][n] = *(const bf16x8*)(Qs + (wc * 64 + n * 16 + l15) * 64 + pos);
    }
#pragma unroll
    for (int kk = 0; kk < 2; kk++)
#pragma unroll
      for (int m = 0; m < 5; m++)
#pragma unroll
        for (int n = 0; n < 4; n++) acc[m][n] = mfma16(pf[kk][m], qf[kk][n], acc[m][n]);
    __builtin_amdgcn_sched_group_barrier(0x100, 9, 0);
#pragma unroll
    for (int i = 0; i < 9; i++) {
      __builtin_amdgcn_sched_group_barrier(0x008, 2, 0);
      __builtin_amdgcn_sched_group_barrier(0x100, 1, 0);
    }
    __builtin_amdgcn_sched_group_barrier(0x008, 22, 0);
  }
  __syncthreads();
}

__device__ __forceinline__ void phase_s0(const Params& p, bfr* sm) {
  const int tid = TIDX;
  float* rope = (float*)(p.ws + WS_ROPE);
  for (int idx = blockIdx.x * 256 + tid; idx < 1536; idx += gridDim.x * 256) {
    if (idx < 1024) {
      int pos = idx >> 4, i = idx & 15;
      float fr = powf(10000.f, -(float)i / 16.f);
      float a = (float)pos * fr;
      rope[idx] = cosf(a);
      rope[1024 + idx] = sinf(a);
    } else {
      int j = idx - 1024;
      int pos = j >> 3, i = j & 7;
      float fr = powf(10000.f, -(float)i / 8.f);
      float a = (float)pos * fr;
      rope[2048 + j] = cosf(a);
      rope[2560 + j] = sinf(a);
    }
  }
  float* smf = (float*)sm;
  float* modp = (float*)(p.ws + WS_MODP);
  for (int it = blockIdx.x; it < 768; it += gridDim.x) {
    int l = it / 384, rem = it % 384, cgp = rem >> 3, ks = rem & 7;
    int col = cgp * 64 + (tid & 63), kq = tid >> 6;
    const float* w = p.in[10] + (long)l * 1024 * 3072 + col;
    float a0 = 0.f, a1 = 0.f, a2 = 0.f;
    int k0 = ks * 128 + kq * 32;
#pragma unroll 8
    for (int k = k0; k < k0 + 32; k++) {
      float wv = w[(long)k * 3072];
      a0 += siluf(p.in[9][k]) * wv;
      a1 += siluf(p.in[8][k]) * wv;
      a2 += siluf(p.in[8][1024 + k]) * wv;
    }
    smf[(kq * 3 + 0) * 64 + (tid & 63)] = a0;
    smf[(kq * 3 + 1) * 64 + (tid & 63)] = a1;
    smf[(kq * 3 + 2) * 64 + (tid & 63)] = a2;
    __syncthreads();
    if (tid < 192) {
      int c = tid >> 6, cc = tid & 63;
      float s = smf[(0 * 3 + c) * 64 + cc] + smf[(1 * 3 + c) * 64 + cc] + smf[(2 * 3 + c) * 64 + cc] + smf[(3 * 3 + c) * 64 + cc];
      modp[((ks * 2 + l) * 3 + c) * 3072 + cgp * 64 + cc] = s;
    }
    __syncthreads();
  }
}

__device__ __forceinline__ void phase_s1(const Params& p) {
  float* modp = (float*)(p.ws + WS_MODP);
  float* mod = (float*)(p.ws + WS_MOD);
  for (int idx = blockIdx.x * 256 + TIDX; idx < 2 * 3 * 3072; idx += gridDim.x * 256) {
    int l = idx / 9216, n = idx % 3072;
    float s = p.in[11][l * 3072 + n];
#pragma unroll
    for (int ks = 0; ks < 8; ks++) s += modp[ks * 18432 + idx];
    mod[idx] = s;
  }
}

__device__ __forceinline__ void wconv_tile(const float* __restrict__ src, int K, int N, bfr* __restrict__ dst,
                                           int tk, int tn, float* smf) {
  bfr* sT = (bfr*)smf;
  const int tid = TIDX;
  const int n4 = (tid & 15) * 4, kb = tid >> 4;
#pragma unroll
  for (int i = 0; i < 4; i++) {
    int k = kb + 16 * i;
    float4 v = *(const float4*)(src + (long)(tk * 64 + k) * N + tn * 64 + n4);
    sT[(n4 + 0) * 72 + k] = f2bf(v.x);
    sT[(n4 + 1) * 72 + k] = f2bf(v.y);
    sT[(n4 + 2) * 72 + k] = f2bf(v.z);
    sT[(n4 + 3) * 72 + k] = f2bf(v.w);
  }
  __syncthreads();
#pragma unroll
  for (int i = 0; i < 2; i++) {
    int c = tid + 256 * i;
    int n = c >> 3, kc = c & 7;
    *(u32x4*)(dst + (long)(tn * 64 + n) * K + tk * 64 + kc * 8) = *(const u32x4*)(sT + n * 72 + kc * 8);
  }
  __syncthreads();
}

#define WCONV_ITEMS 2456
__device__ __forceinline__ void wconv_phase(const Params& p, int l, bfr* sm) {
  float* smf = (float*)sm;
  for (int item0 = blockIdx.x; item0 < WCONV_ITEMS; item0 += gridDim.x) {
    int item = item0;
    const float* src;
    bfr* dst;
    int K, N, tk, tn;
    if (item < 1744) {
      src = p.in[14] + (long)l * 1024 * 6976; K = 1024; N = 6976; dst = (bfr*)(p.ws + WS_WIN); tk = item & 15; tn = item >> 4;
    } else if (item < 1768) {
      item -= 1744;
      src = p.in[24] + (long)l * 256 * 384; K = 256; N = 384; dst = (bfr*)(p.ws + WS_WUQ); tk = item & 3; tn = item >> 2;
    } else if (item < 1816) {
      item -= 1768;
      src = p.in[25] + (long)l * 256 * 768; K = 256; N = 768; dst = (bfr*)(p.ws + WS_WUKV); tk = item & 3; tn = item >> 2;
    } else if (item < 2200) {
      item -= 1816;
      int w = item >> 7, it = item & 127;
      src = (w == 0 ? p.in[26] : (w == 1 ? p.in[27] : p.in[28])) + (long)l * 512 * 1024;
      K = 512; N = 1024; dst = (bfr*)(p.ws + WS_WOA + (unsigned long)w * 1048576ul); tk = it & 7; tn = it >> 3;
    } else {
      item -= 2200;
      src = p.in[29] + (long)l * 1024 * 1024; K = 1024; N = 1024; dst = (bfr*)(p.ws + WS_WOUT); tk = item & 15; tn = item >> 4;
    }
    wconv_tile(src, K, N, dst, tk, tn, smf);
  }
}

__device__ __forceinline__ void phase_prenorm0(const Params& p) {
  const int lane = TIDX & 63;
  const float* mod = (const float*)(p.ws + WS_MOD);
  bfr* H = (bfr*)(p.ws + WS_R1);
  for (int row = blockIdx.x * 4 + (TIDX >> 6); row < NROWS; row += gridDim.x * 4) {
    const float* x = xrow(p, row);
    const float* md = mod + (0 * 3 + row_cond(row)) * 3072;
    float4 v[4];
    float ss = 0.f;
#pragma unroll
    for (int i = 0; i < 4; i++) {
      v[i] = *(const float4*)(x + i * 256 + lane * 4);
      ss += v[i].x * v[i].x + v[i].y * v[i].y + v[i].z * v[i].z + v[i].w * v[i].w;
    }
    ss = wave_sum(ss);
    float rs = rsqrtf(ss * (1.f / 1024.f) + 1e-6f);
#pragma unroll
    for (int i = 0; i < 4; i++) {
      int n = i * 256 + lane * 4;
      float4 g = *(const float4*)(p.in[12] + n);
      float4 sh = *(const float4*)(md + n);
      float4 sc = *(const float4*)(md + 1024 + n);
      float h0 = v[i].x * rs * g.x * (1.f + sc.x) + sh.x;
      float h1 = v[i].y * rs * g.y * (1.f + sc.y) + sh.y;
      float h2 = v[i].z * rs * g.z * (1.f + sc.z) + sh.z;
      float h3 = v[i].w * rs * g.w * (1.f + sc.w) + sh.w;
      u32x2 o;
      o.x = pack2(h0, h1);
      o.y = pack2(h2, h3);
      *(u32x2*)(H + (long)row * 1024 + n) = o;
    }
  }
}

__device__ __forceinline__ unsigned xcc_id() { return (unsigned)__builtin_amdgcn_s_getreg((3 << 11) | 20) & 7u; }
template <class CountF>
__device__ __forceinline__ int xq_take(unsigned* ctr, int& q, int& tried, unsigned first, CountF cnt) {
  unsigned j = first;
  for (;;) {
    if (j < (unsigned)cnt(q)) return (q << 20) | (int)j;
    q = (q + 1) & 7;
    if (++tried >= 8) return -1;
    j = atomicAdd(ctr + q * 16, 1u);
  }
}

__device__ __forceinline__ void phase_inproj(const Params& p, int l, bfr* sm, int* s_item, int slot) {
  const bfr* H = (const bfr*)(p.ws + WS_R1);
  const bfr* W = (const bfr*)(p.ws + WS_WIN);
  bfr* Z = (bfr*)(p.ws + WS_Z);
  const int tid = TIDX;
  const int lane = tid & 63, wid = tid >> 6, wr = wid >> 1, wc = wid & 1;
  unsigned* ctr = (unsigned*)(p.ws + WS_CTR) + slot * 128;
  auto cnt = [](int q) { return 96 * ((44 * (q + 1)) / 8 - (44 * q) / 8); };
  int q = (int)xcc_id(), tried = 0;
  unsigned nxt = 0;
  if (tid == 0) nxt = atomicAdd(ctr + q * 16, 1u);
  for (;;) {
    if (tid == 0) *s_item = xq_take(ctr, q, tried, nxt, cnt);
    __syncthreads();
    const int it = *s_item;
    __syncthreads();
    if (it < 0) break;
    const int qq = it >> 20, j = it & 0xfffff;
    if (tid == 0) nxt = atomicAdd(ctr + q * 16, 1u);
    const int tn0 = (44 * qq) / 8, w = (44 * (qq + 1)) / 8 - tn0;
    const int tm = j / w, tn = tn0 + j % w;
    f32x4 acc[5][4];
#pragma unroll
    for (int a = 0; a < 5; a++)
#pragma unroll
      for (int b = 0; b < 4; b++) acc[a][b] = (f32x4){0.f, 0.f, 0.f, 0.f};
    gemm160x128(W + (long)tn * 160 * 1024, 1024, ZLD - tn * 160, H + (long)tm * 128 * 1024, 1024, 1024, acc, sm);
    {
      const int g = lane >> 4, l15 = lane & 15;
#pragma unroll
      for (int pi = 0; pi < 5; pi++)
#pragma unroll
        for (int qi = 0; qi < 4; qi++) {
          u32x2 o;
          o.x = pack2(acc[pi][qi][0], acc[pi][qi][1]);
          o.y = pack2(acc[pi][qi][2], acc[pi][qi][3]);
          *(u32x2*)(sm + (wc * 64 + qi * 16 + l15) * 168 + wr * 80 + pi * 16 + g * 4) = o;
        }
      __syncthreads();
      const int ncol = min(20, (ZLD - tn * 160) >> 3);
#pragma unroll
      for (int i = 0; i < 10; i++) {
        int c = tid + 256 * i;
        int row = c / 20, c16 = c % 20;
        if (c16 < ncol)
          *(u32x4*)(Z + (long)(tm * 128 + row) * ZLD + tn * 160 + c16 * 8) = *(const u32x4*)(sm + row * 168 + c16 * 8);
      }
      __syncthreads();
    }
  }
}

__device__ __forceinline__ void unpack8(u32x4 v, float* x) {
  x[0] = lo16(v.x); x[1] = hi16(v.x); x[2] = lo16(v.y); x[3] = hi16(v.y);
  x[4] = lo16(v.z); x[5] = hi16(v.z); x[6] = lo16(v.w); x[7] = hi16(v.w);
}
__device__ __forceinline__ u32x4 pack8(const float* y) {
  u32x4 o;
  o.x = pack2(y[0], y[1]); o.y = pack2(y[2], y[3]); o.z = pack2(y[4], y[5]); o.w = pack2(y[6], y[7]);
  return o;
}

__device__ __forceinline__ void phase_rowpost(const Params& p, int l) {
  const int lane = TIDX & 63;
  bfr* Z = (bfr*)(p.ws + WS_Z);
  const float* rope = (const float*)(p.ws + WS_ROPE);
  bfr* VTA = (bfr*)(p.ws + WS_VTA);
  bfr* KCA = (bfr*)(p.ws + WS_KCA);
  bfr* CKVC = (bfr*)(p.ws + WS_CKVC);
  bfr* KRC = (bfr*)(p.ws + WS_KRC);
  float* out = p.out;
  for (int row = blockIdx.x * 4 + (TIDX >> 6); row < NROWS + 1024; row += gridDim.x * 4) {
    if (row < NROWS) {
      const bool lat = row >= NCTX;
      const int bc = row >> 8, tc = row & 255;
      const int bl = (row - NCTX) >> 12, tl = (row - NCTX) & 4095;
      const int prow = tl >> 6, pcol = tl & 63;
      bfr* z = Z + (long)row * ZLD;
      {
        float x[8];
        unpack8(*(const u32x4*)(z + C_QA + lane * 8), x);
        float ss = 0.f;
#pragma unroll
        for (int e = 0; e < 8; e++) ss += x[e] * x[e];
        ss += __shfl_xor(ss, 1); ss += __shfl_xor(ss, 2); ss += __shfl_xor(ss, 4);
        float rs = rsqrtf(ss * (1.f / 64.f) + 1e-6f);
        int sub = lane & 7;
        const float* g = p.in[15] + l * 64 + sub * 8;
#pragma unroll
        for (int e = 0; e < 8; e++) x[e] = x[e] * rs * g[e];
        if (lat) {
          int pos = (sub >> 2) ? pcol : prow;
          bool hi = (sub & 2) != 0;
          int i0 = (sub & 1) * 8;
#pragma unroll
          for (int e = 0; e < 8; e++) {
            float yp = __shfl_xor(x[e], 2);
            float c = rope[pos * 16 + i0 + e], s = rope[1024 + pos * 16 + i0 + e];
            x[e] = hi ? (yp * s + x[e] * c) : (x[e] * c - yp * s);
          }
        }
        const float qs = 0.125f * 1.4426950408889634f;
#pragma unroll
        for (int e = 0; e < 8; e++) x[e] *= qs;
        *(u32x4*)(z + C_QA + lane * 8) = pack8(x);
      }
      {
        int L = lane & 15;
        float x[8];
        unpack8(*(const u32x4*)(z + C_KA + L * 8), x);
        float ss = 0.f;
#pragma unroll
        for (int e = 0; e < 8; e++) ss += x[e] * x[e];
        ss += __shfl_xor(ss, 1); ss += __shfl_xor(ss, 2); ss += __shfl_xor(ss, 4);
        float rs = rsqrtf(ss * (1.f / 64.f) + 1e-6f);
        int sub = L & 7;
        const float* g = p.in[16] + l * 64 + sub * 8;
#pragma unroll
        for (int e = 0; e < 8; e++) x[e] = x[e] * rs * g[e];
        if (lat) {
          int pos = (sub >> 2) ? pcol : prow;
          bool hi = (sub & 2) != 0;
          int i0 = (sub & 1) * 8;
#pragma unroll
          for (int e = 0; e < 8; e++) {
            float yp = __shfl_xor(x[e], 2);
            float c = rope[pos * 16 + i0 + e], s = rope[1024 + pos * 16 + i0 + e];
            x[e] = hi ? (yp * s + x[e] * c) : (x[e] * c - yp * s);
          }
        } else if (lane < 16) {
          float* o = out + O_GK + ((long)(bc * 2 + l) * 256 + tc) * 128 + L * 8;
          *(float4*)(o) = make_float4(x[0], x[1], x[2], x[3]);
          *(float4*)(o + 4) = make_float4(x[4], x[5], x[6], x[7]);
        }
        if (lane < 16) *(u32x4*)(z + C_KA + L * 8) = pack8(x);
      }
      if (lane < 16) {
        int L = lane;
        u32x4 raw = *(const u32x4*)(z + C_VA + L * 8);
        float x[8];
        unpack8(raw, x);
        if (!lat) {
          float* o = out + O_GV + ((long)(bc * 2 + l) * 256 + tc) * 128 + L * 8;
          *(float4*)(o) = make_float4(x[0], x[1], x[2], x[3]);
          *(float4*)(o + 4) = make_float4(x[4], x[5], x[6], x[7]);
        }
        int g = L >> 3, d0 = (L & 7) * 8;
        long base; int nk, key;
        if (!lat) { base = (long)bc * 32768; nk = 256; key = tc; }
        else { base = 16l * 32768 + (long)bl * (2 * 64 * 4608); nk = 4608; key = 512 + tl; }
        const bfr* rb = (const bfr*)&raw;
#pragma unroll
        for (int e = 0; e < 8; e++) VTA[base + (long)(g * 64 + d0 + e) * nk + key] = rb[e];
      }
      {
        u32x2 rq = *(const u32x2*)(z + C_QL + lane * 4);
        u32x2 rk = *(const u32x2*)(z + C_KV + lane * 4);
        float q[4] = {lo16(rq.x), hi16(rq.x), lo16(rq.y), hi16(rq.y)};
        float k[4] = {lo16(rk.x), hi16(rk.x), lo16(rk.y), hi16(rk.y)};
        float sq = q[0] * q[0] + q[1] * q[1] + q[2] * q[2] + q[3] * q[3];
        float sk = k[0] * k[0] + k[1] * k[1] + k[2] * k[2] + k[3] * k[3];
        sq = wave_sum(sq);
        sk = wave_sum(sk);
        float rq_ = rsqrtf(sq * (1.f / 256.f) + 1e-6f), rk_ = rsqrtf(sk * (1.f / 256.f) + 1e-6f);
        float4 gq = *(const float4*)(p.in[22] + l * 256 + lane * 4);
        float4 gk = *(const float4*)(p.in[23] + l * 256 + lane * 4);
        q[0] *= rq_ * gq.x; q[1] *= rq_ * gq.y; q[2] *= rq_ * gq.z; q[3] *= rq_ * gq.w;
        k[0] *= rk_ * gk.x; k[1] *= rk_ * gk.y; k[2] *= rk_ * gk.z; k[3] *= rk_ * gk.w;
        u32x2 o;
        o.x = pack2(q[0], q[1]); o.y = pack2(q[2], q[3]);
        *(u32x2*)(z + C_QL + lane * 4) = o;
        o.x = pack2(k[0], k[1]); o.y = pack2(k[2], k[3]);
        *(u32x2*)(z + C_KV + lane * 4) = o;
        if (!lat) *(float4*)(out + O_CKV + ((long)(bc * 2 + l) * 256 + tc) * 256 + lane * 4) = make_float4(k[0], k[1], k[2], k[3]);
      }
      {
        int L = lane & 3;
        float x[8];
        unpack8(*(const u32x4*)(z + C_KR + L * 8), x);
        if (lat) {
          int pos = (L >> 1) ? pcol : prow;
          bool hi = (L & 1) != 0;
#pragma unroll
          for (int e = 0; e < 8; e++) {
            float yp = __shfl_xor(x[e], 1);
            float c = rope[2048 + pos * 8 + e], s = rope[2560 + pos * 8 + e];
            x[e] = hi ? (yp * s + x[e] * c) : (x[e] * c - yp * s);
          }
          if (lane < 4) *(u32x4*)(z + C_KR + L * 8) = pack8(x);
        } else if (lane < 4) {
          float* o = out + O_KR + ((long)(bc * 2 + l) * 256 + tc) * 32 + L * 8;
          *(float4*)(o) = make_float4(x[0], x[1], x[2], x[3]);
          *(float4*)(o + 4) = make_float4(x[4], x[5], x[6], x[7]);
        }
      }
    } else {
      int cr = row - NROWS;
      int b = cr >> 9, t = cr & 511;
      long src = (long)(b * 2 + l) * 512 + t;
      {
        float2 kv = *(const float2*)(p.in[2] + src * 128 + lane * 2);
        *(unsigned*)(KCA + (long)(b * 512 + t) * 128 + lane * 2) = pack2(kv.x, kv.y);
        float2 vv = *(const float2*)(p.in[3] + src * 128 + lane * 2);
        int c0 = lane * 2;
        long base = 16l * 32768 + (long)b * (2 * 64 * 4608);
        VTA[base + (long)c0 * 4608 + t] = f2bf(vv.x);
        VTA[base + (long)(c0 + 1) * 4608 + t] = f2bf(vv.y);
        float4 cv = *(const float4*)(p.in[4] + src * 256 + lane * 4);
        u32x2 o;
        o.x = pack2(cv.x, cv.y); o.y = pack2(cv.z, cv.w);
        *(u32x2*)(CKVC + (long)(b * 512 + t) * 256 + lane * 4) = o;
        if (lane < 32) KRC[(long)(b * 512 + t) * 32 + lane] = f2bf(p.in[5][src * 32 + lane]);
      }
    }
  }
}

#define WS_PREP1 251703296ul
#define WS_EL (WS_WIN + 12582912ul)
__device__ __forceinline__ bfr* prep_base(const Params& p, int b, int h, int dir, int c) {
  return (bfr*)(p.ws + (b ? WS_PREP1 : WS_WIN)) + (long)((h * 2 + dir) * 64 + c) * 12288;
}

__device__ __forceinline__ void gla_chunk_prep(int tid, const float (&wd)[16], float bias, const bfr* Qr, const bfr* Kr,
                                               bfr* Qe, bfr* Ke, bfr* KlT, const float* RF, float* tot, float* lastv) {
  const int ch = tid & 63, part = tid >> 6;
  float cum[16];
  {
    float run = 0.f;
#pragma unroll
    for (int ii = 0; ii < 16; ii++) {
      int i = part * 16 + ii;
      float x = bias;
#pragma unroll
      for (int r = 0; r < 16; r++) x += RF[i * 16 + r] * wd[r];
      float la = (fminf(x, 0.f) - __logf(1.f + __expf(-fabsf(x)))) * (1.f / 16.f);
      run += la;
      cum[ii] = run;
    }
    tot[part * 64 + ch] = run;
  }
  __syncthreads();
  {
    float off = 0.f, last = 0.f;
#pragma unroll
    for (int pp = 0; pp < 4; pp++) {
      float tv = tot[pp * 64 + ch];
      if (pp < part) off += tv;
      last += tv;
    }
    if (part == 0) lastv[ch] = last;
#pragma unroll
    for (int ii = 0; ii < 16; ii++) {
      int i = part * 16 + ii;
      float cc = cum[ii] + off;
      float qv = bf2f(Qr[i * LDT + ch]), kv = bf2f(Kr[i * LDT + ch]);
      Qe[i * LDT + ch] = f2bf(qv * __expf(cc) * 0.125f);
      Ke[i * LDT + ch] = f2bf(kv * __expf(-cc));
      KlT[ch * LDT + i] = f2bf(kv * __expf(last - cc));
    }
  }
  __syncthreads();
}

__device__ __forceinline__ void gla_att(int wid, int g, int l15, const bfr* Qe, const bfr* Ke, bfr* Att) {
  f32x4 att[4];
  bf16x8 qa[2];
#pragma unroll
  for (int kk = 0; kk < 2; kk++) qa[kk] = *(const bf16x8*)(Qe + (16 * wid + l15) * LDT + kk * 32 + g * 8);
#pragma unroll
  for (int nj = 0; nj < 4; nj++) {
    att[nj] = (f32x4){0.f, 0.f, 0.f, 0.f};
#pragma unroll
    for (int kk = 0; kk < 2; kk++) {
      bf16x8 kb = *(const bf16x8*)(Ke + (16 * nj + l15) * LDT + kk * 32 + g * 8);
      att[nj] = mfma16(qa[kk], kb, att[nj]);
    }
  }
#pragma unroll
  for (int nj = 0; nj < 4; nj++)
#pragma unroll
    for (int r = 0; r < 4; r++) {
      int i = 16 * wid + 4 * g + r, j = 16 * nj + l15;
      Att[i * LDT + j] = f2bf(i >= j ? att[nj][r] : 0.f);
    }
}

__device__ __forceinline__ void gla_prep_item(const Params& p, int l, int b, int h, int dir, int c, bfr* sm) {
  const int tid = TIDX, lane = tid & 63, wid = tid >> 6, g = lane >> 4, l15 = lane & 15;
  const bfr* Z = (const bfr*)(p.ws + WS_Z);
  const int N = 4096;
  const int rowbase = NCTX + b * 4096;
  bfr* Qr = sm;
  bfr* Kr = Qr + 64 * LDT;
  bfr* Qe = Kr + 64 * LDT;
  bfr* Ke = Qe + 64 * LDT;
  bfr* KlT = Ke + 64 * LDT;
  float* RF = (float*)(KlT + 64 * LDT);
  float* tot = RF + 64 * 16;
  float* lastv = tot + 256;
  bfr* Att = Qr;
  const int ch = tid & 63;
  float wd[16];
  {
    const float* W = (dir ? p.in[19] : p.in[17]) + (long)l * 16 * 256 + h * 64 + ch;
#pragma unroll
    for (int r = 0; r < 16; r++) wd[r] = W[r * 256];
  }
  const float bias = (dir ? p.in[20] : p.in[18])[l * 256 + h * 64 + ch];
#pragma unroll
  for (int ii = 0; ii < 2; ii++) {
    int cc = tid + 256 * ii;
    int i = cc >> 3, c8 = cc & 7;
    int tok = dir ? (N - 1 - (c * 64 + i)) : (c * 64 + i);
    const bfr* zr = Z + (long)(rowbase + tok) * ZLD;
    *(u32x4*)(Qr + i * LDT + c8 * 8) = *(const u32x4*)(zr + C_QG + h * 64 + c8 * 8);
    *(u32x4*)(Kr + i * LDT + c8 * 8) = *(const u32x4*)(zr + C_KG + h * 64 + c8 * 8);
  }
  if (tid < 128) {
    int i = tid >> 1, hf = tid & 1;
    int tok = dir ? (N - 1 - (c * 64 + i)) : (c * 64 + i);
    u32x4 rr = *(const u32x4*)(Z + (long)(rowbase + tok) * ZLD + (dir ? C_RB : C_RF) + hf * 8);
    float x[8];
    unpack8(rr, x);
#pragma unroll
    for (int e = 0; e < 8; e++) RF[i * 16 + hf * 8 + e] = x[e];
  }
  __syncthreads();
  gla_chunk_prep(tid, wd, bias, Qr, Kr, Qe, Ke, KlT, RF, tot, lastv);
  gla_att(wid, g, l15, Qe, Ke, Att);
  __syncthreads();
  bfr* dst = prep_base(p, b, h, dir, c);
#pragma unroll
  for (int ii = 0; ii < 2; ii++) {
    int cc = tid + 256 * ii;
    int i = cc >> 3, c8 = cc & 7;
    *(u32x4*)(dst + i * 64 + c8 * 8) = *(const u32x4*)(Qe + i * LDT + c8 * 8);
    *(u32x4*)(dst + 4096 + i * 64 + c8 * 8) = *(const u32x4*)(KlT + i * LDT + c8 * 8);
    *(u32x4*)(dst + 8192 + i * 64 + c8 * 8) = *(const u32x4*)(Att + i * LDT + c8 * 8);
  }
  if (tid < 64) ((float*)(p.ws + WS_EL))[((long)(((b * 4 + h) * 2 + dir) * 64 + c)) * 64 + tid] = __expf(lastv[tid]);
  __syncthreads();
}

__device__ __forceinline__ void gla_chain_item(const Params& p, int l, int b, int h, int dir, int vh, bfr* sm) {
  const int tid = TIDX, lane = tid & 63, wid = tid >> 6, g = lane >> 4, l15 = lane & 15;
  const bfr* Z = (const bfr*)(p.ws + WS_Z);
  bfr* OG = (bfr*)(p.ws + WS_R1) + (long)dir * NROWS * 512;
  const float* EL = (const float*)(p.ws + WS_EL) + (long)(((b * 4 + h) * 2 + dir) * 64) * 64;
  const int N = 4096, nc = 64;
  const int rowbase = NCTX + b * 4096;
  const int vs0 = vh * 64;
  bfr* Vt = sm;
  bfr* St = Vt + 64 * LDT;
  f32x4 st[4];
  {
    const float* S0 = (dir ? p.in[7] : p.in[6]) + ((long)((b * 2 + l) * 4 + h)) * 8192 + (long)(16 * wid + l15) * 128 + vs0;
#pragma unroll
    for (int vt = 0; vt < 4; vt++) {
      float4 a = *(const float4*)(S0 + 16 * vt + 4 * g);
      st[vt] = (f32x4){a.x, a.y, a.z, a.w};
#pragma unroll
      for (int r = 0; r < 4; r++) St[(16 * vt + 4 * g + r) * LDT + 16 * wid + l15] = f2bf(st[vt][r]);
    }
  }
  u32x4 n_qe[2], n_kl[2], n_at[2], n_v[2];
  float n_el;
  auto prefetch = [&](int c) {
    const bfr* base = prep_base(p, b, h, dir, c) + (16 * wid + l15) * 64 + 8 * g;
#pragma unroll
    for (int kk = 0; kk < 2; kk++) {
      n_qe[kk] = *(const u32x4*)(base + kk * 32);
      n_kl[kk] = *(const u32x4*)(base + 4096 + kk * 32);
      n_at[kk] = *(const u32x4*)(base + 8192 + kk * 32);
    }
    n_el = EL[c * 64 + 16 * wid + l15];
#pragma unroll
    for (int ii = 0; ii < 2; ii++) {
      int cc = tid + 256 * ii;
      int i = cc >> 3, c8 = cc & 7;
      int tok = dir ? (N - 1 - (c * 64 + i)) : (c * 64 + i);
      n_v[ii] = *(const u32x4*)(Z + (long)(rowbase + tok) * ZLD + C_VG + h * 128 + vs0 + c8 * 8);
    }
  };
  prefetch(0);
  for (int c = 0; c < nc; c++) {
    u32x4 c_qe[2] = {n_qe[0], n_qe[1]}, c_kl[2] = {n_kl[0], n_kl[1]}, c_at[2] = {n_at[0], n_at[1]};
    const float el = n_el;
#pragma unroll
    for (int ii = 0; ii < 2; ii++) {
      int cc = tid + 256 * ii;
      int i = cc >> 3, c8 = cc & 7;
      const bfr* rb = (const bfr*)&n_v[ii];
#pragma unroll
      for (int e = 0; e < 8; e++) Vt[(c8 * 8 + e) * LDT + i] = rb[e];
    }
    __syncthreads();
    if (c + 1 < nc) prefetch(c + 1);
    f32x4 stn[4];
    const int i = 16 * wid + l15;
    const int tok = dir ? (N - 1 - (c * 64 + i)) : (c * 64 + i);
    bfr* og = OG + (long)(rowbase + tok) * 512 + h * 128 + vs0 + 4 * g;
#pragma unroll
    for (int vt = 0; vt < 4; vt++) {
      f32x4 oc = (f32x4){0.f, 0.f, 0.f, 0.f};
      stn[vt] = st[vt] * el;
#pragma unroll
      for (int kk = 0; kk < 2; kk++) {
        bf16x8 vf = *(const bf16x8*)(Vt + (16 * vt + l15) * LDT + kk * 32 + g * 8);
        bf16x8 sf = *(const bf16x8*)(St + (16 * vt + l15) * LDT + kk * 32 + g * 8);
        oc = mfma16(vf, *(bf16x8*)&c_at[kk], oc);
        oc = mfma16(sf, *(bf16x8*)&c_qe[kk], oc);
        stn[vt] = mfma16(vf, *(bf16x8*)&c_kl[kk], stn[vt]);
      }
      u32x2 ov;
      ov.x = pack2(oc[0], oc[1]);
      ov.y = pack2(oc[2], oc[3]);
      *(u32x2*)(og + 16 * vt) = ov;
    }
    __syncthreads();
#pragma unroll
    for (int vt = 0; vt < 4; vt++) {
      st[vt] = stn[vt];
#pragma unroll
      for (int r = 0; r < 4; r++) St[(16 * vt + 4 * g + r) * LDT + 16 * wid + l15] = f2bf(st[vt][r]);
    }
  }
  __syncthreads();
}

template <int VS>
__device__ __forceinline__ void gla_item(const Params& p, int l, int seq, int h, int dir, int vsl, bfr* sm) {
  constexpr int NVT = VS / 16;
  constexpr int NVL = VS / 32;
  const int tid = TIDX, lane = tid & 63, wid = tid >> 6, g = lane >> 4, l15 = lane & 15;
  bfr* Z = (bfr*)(p.ws + WS_Z);
  bfr* OG = (bfr*)(p.ws + WS_R1) + (long)dir * NROWS * 512;
  const bool lat = seq >= 16;
  const int b = seq - 16;
  const int N = lat ? 4096 : 256;
  const int rowbase = lat ? NCTX + b * 4096 : seq * 256;
  const int nc = N >> 6;
  const int vs0 = vsl * VS;
  bfr* Qr = sm;
  bfr* Kr = Qr + 64 * LDT;
  bfr* Qe = Kr + 64 * LDT;
  bfr* Ke = Qe + 64 * LDT;
  bfr* KlT = Ke + 64 * LDT;
  float* RF = (float*)(KlT + 64 * LDT);
  float* tot = RF + 64 * 16;
  float* lastv = tot + 256;
  bfr* Vt = (bfr*)(lastv + 64);
  bfr* St = Vt + VS * LDT;
  bfr* Att = Qr;
  const int ch = tid & 63;
  float wd[16];
  {
    const float* W = (dir ? p.in[19] : p.in[17]) + (long)l * 16 * 256 + h * 64 + ch;
#pragma unroll
    for (int r = 0; r < 16; r++) wd[r] = W[r * 256];
  }
  const float bias = (dir ? p.in[20] : p.in[18])[l * 256 + h * 64 + ch];

  f32x4 st[NVT];
  {
    const float* S0 = (dir ? p.in[7] : p.in[6]) + ((long)((b * 2 + l) * 4 + h)) * 8192 + (long)(16 * wid + l15) * 128 + vs0;
#pragma unroll
    for (int mv = 0; mv < NVT; mv++) {
      if (lat) {
        float4 a = *(const float4*)(S0 + 16 * mv + 4 * g);
        st[mv] = (f32x4){a.x, a.y, a.z, a.w};
      } else {
        st[mv] = (f32x4){0.f, 0.f, 0.f, 0.f};
      }
#pragma unroll
      for (int r = 0; r < 4; r++) St[(16 * mv + 4 * g + r) * LDT + 16 * wid + l15] = f2bf(st[mv][r]);
    }
  }
  u32x4 rq[2], rk[2], rv[NVL], rr;
  auto prefetch = [&](int c) {
#pragma unroll
    for (int ii = 0; ii < 2; ii++) {
      int cc = tid + 256 * ii;
      int i = cc >> 3, c8 = cc & 7;
      int tok = dir ? (N - 1 - (c * 64 + i)) : (c * 64 + i);
      const bfr* zr = Z + (long)(rowbase + tok) * ZLD;
      rq[ii] = *(const u32x4*)(zr + C_QG + h * 64 + c8 * 8);
      rk[ii] = *(const u32x4*)(zr + C_KG + h * 64 + c8 * 8);
    }
#pragma unroll
    for (int ii = 0; ii < NVL; ii++) {
      int cc = tid + 256 * ii;
      int i = cc / (VS / 8), c4 = cc % (VS / 8);
      int tok = dir ? (N - 1 - (c * 64 + i)) : (c * 64 + i);
      rv[ii] = *(const u32x4*)(Z + (long)(rowbase + tok) * ZLD + C_VG + h * 128 + vs0 + c4 * 8);
    }
    if (tid < 128) {
      int i = tid >> 1, hf = tid & 1;
      int tok = dir ? (N - 1 - (c * 64 + i)) : (c * 64 + i);
      rr = *(const u32x4*)(Z + (long)(rowbase + tok) * ZLD + (dir ? C_RB : C_RF) + hf * 8);
    }
  };
  prefetch(0);
  for (int c = 0; c < nc; c++) {
#pragma unroll
    for (int ii = 0; ii < 2; ii++) {
      int cc = tid + 256 * ii;
      *(u32x4*)(Qr + (cc >> 3) * LDT + (cc & 7) * 8) = rq[ii];
      *(u32x4*)(Kr + (cc >> 3) * LDT + (cc & 7) * 8) = rk[ii];
    }
#pragma unroll
    for (int ii = 0; ii < NVL; ii++) {
      int cc = tid + 256 * ii;
      int i = cc / (VS / 8), c4 = cc % (VS / 8);
      const bfr* rb = (const bfr*)&rv[ii];
#pragma unroll
      for (int e = 0; e < 8; e++) Vt[(c4 * 8 + e) * LDT + i] = rb[e];
    }
    if (tid < 128) {
      int i = tid >> 1, hf = tid & 1;
      float x[8];
      unpack8(rr, x);
#pragma unroll
      for (int e = 0; e < 8; e++) RF[i * 16 + hf * 8 + e] = x[e];
    }
    __syncthreads();
    if (c + 1 < nc) prefetch(c + 1);
    gla_chunk_prep(tid, wd, bias, Qr, Kr, Qe, Ke, KlT, RF, tot, lastv);
    f32x4 stn[NVT];
    {
      float el = __expf(lastv[16 * wid + l15]);
#pragma unroll
      for (int mv = 0; mv < NVT; mv++) {
        stn[mv] = st[mv] * el;
#pragma unroll
        for (int kk = 0; kk < 2; kk++) {
          bf16x8 va = *(const bf16x8*)(Vt + (16 * mv + l15) * LDT + kk * 32 + g * 8);
          bf16x8 kb = *(const bf16x8*)(KlT + (16 * wid + l15) * LDT + kk * 32 + g * 8);
          stn[mv] = mfma16(va, kb, stn[mv]);
        }
      }
      gla_att(wid, g, l15, Qe, Ke, Att);
    }
    __syncthreads();
    {
      bf16x8 aa[2], qa[2];
#pragma unroll
      for (int kk = 0; kk < 2; kk++) {
        aa[kk] = *(const bf16x8*)(Att + (16 * wid + l15) * LDT + kk * 32 + g * 8);
        qa[kk] = *(const bf16x8*)(Qe + (16 * wid + l15) * LDT + kk * 32 + g * 8);
      }
#pragma unroll
      for (int nv = 0; nv < NVT; nv++) {
        f32x4 oc = (f32x4){0.f, 0.f, 0.f, 0.f};
#pragma unroll
        for (int kk = 0; kk < 2; kk++) {
          bf16x8 vb = *(const bf16x8*)(Vt + (16 * nv + l15) * LDT + kk * 32 + g * 8);
          oc = mfma16(aa[kk], vb, oc);
          bf16x8 sb = *(const bf16x8*)(St + (16 * nv + l15) * LDT + kk * 32 + g * 8);
          oc = mfma16(qa[kk], sb, oc);
        }
#pragma unroll
        for (int r = 0; r < 4; r++) {
          int i = 16 * wid + 4 * g + r;
          int tok = dir ? (N - 1 - (c * 64 + i)) : (c * 64 + i);
          OG[(long)(rowbase + tok) * 512 + h * 128 + vs0 + 16 * nv + l15] = f2bf(oc[r]);
        }
      }
    }
    __syncthreads();
#pragma unroll
    for (int mv = 0; mv < NVT; mv++) {
      st[mv] = stn[mv];
#pragma unroll
      for (int r = 0; r < 4; r++) St[(16 * mv + 4 * g + r) * LDT + 16 * wid + l15] = f2bf(st[mv][r]);
    }
  }
  __syncthreads();
  if (!lat) {
    float* so = p.out + (dir ? O_SB : O_SF) + ((long)((seq * 2 + l) * 4 + h)) * 8192 + (long)(16 * wid + l15) * 128 + vs0;
#pragma unroll
    for (int mv = 0; mv < NVT; mv++)
      *(float4*)(so + 16 * mv + 4 * g) = make_float4(st[mv][0], st[mv][1], st[mv][2], st[mv][3]);
  }
}

__device__ __forceinline__ void phase_mla_up(const Params& p, int l, bfr* sm) {
  bfr* Z = (bfr*)(p.ws + WS_Z);
  const float* rope = (const float*)(p.ws + WS_ROPE);
  const int lane = TIDX & 63, wid = TIDX >> 6, wr = wid >> 1, wc = wid & 1;
  const int g = lane >> 4;
  for (int t = blockIdx.x; t < 288 + 624 + 1024; t += gridDim.x) {
    if (t >= 912) {
      int i = t - 912;
      gla_prep_item(p, l, i >> 9, (i >> 7) & 3, (i >> 6) & 1, i & 63, sm);
      continue;
    }
    f32x4 acc[4][4];
#pragma unroll
    for (int a = 0; a < 4; a++)
#pragma unroll
      for (int b = 0; b < 4; b++) acc[a][b] = (f32x4){0.f, 0.f, 0.f, 0.f};
    if (t < 288) {
      int tn = t % 3, tm = t / 3;
      gemm128k64<4, true>((const bfr*)(p.ws + WS_WUQ) + (long)tn * 128 * 256, 256, 128, Z + (long)tm * 128 * ZLD + C_QL, ZLD, 256,
                    acc, sm);
      bfr* CQ = (bfr*)(p.ws + WS_CQ);
      const float qs = 0.10206207261596577f * 1.4426950408889634f;
#pragma unroll
      for (int pi = 0; pi < 4; pi++) {
        int nb = tn * 128 + wr * 64 + pi * 16;
        int wb = nb % 96;
        bool ropet = wb >= 64;
        int part = (wb - 64) >> 4;
#pragma unroll
        for (int qi = 0; qi < 4; qi++) {
          int tok = tm * 128 + wc * 64 + qi * 16 + (lane & 15);
          float y[4] = {acc[pi][qi][0], acc[pi][qi][1], acc[pi][qi][2], acc[pi][qi][3]};
          if (ropet) {
            bool lat = tok >= NCTX;
            int tl = (tok - NCTX) & 4095;
            int pos = part ? (tl & 63) : (tl >> 6);
            bool hi = (g & 2) != 0;
            int i0 = (g & 1) * 4;
#pragma unroll
            for (int r = 0; r < 4; r++) {
              float yp = __shfl_xor(y[r], 32);
              float c = rope[2048 + pos * 8 + i0 + r], s = rope[2560 + pos * 8 + i0 + r];
              float yr = hi ? (yp * s + y[r] * c) : (y[r] * c - yp * s);
              y[r] = lat ? yr : y[r];
            }
          }
          u32x2 o;
          o.x = pack2(y[0] * qs, y[1] * qs);
          o.y = pack2(y[2] * qs, y[3] * qs);
          *(u32x2*)(CQ + (long)tok * 384 + nb + g * 4) = o;
        }
      }
    } else {
      int t2 = t - 288;
      int tn = t2 % 6, tm = t2 / 6;
      const bfr* Q;
      long ldq;
      long kbase, vbase;
      int nk, key0;
      if (tm < 32) {
        Q = Z + (long)tm * 128 * ZLD + C_KV;
        ldq = ZLD;
        int s = tm >> 1;
        key0 = (tm & 1) * 128;
        nk = 256;
        kbase = (long)s * (4 * 256 * 64);
        vbase = (long)s * 131072;
      } else {
        int r = (tm - 32) * 128;
        int b = r / 4608, within = r % 4608;
        key0 = within;
        nk = 4608;
        kbase = 16l * (4 * 256 * 64) + (long)b * (4 * 4608 * 64);
        vbase = 16l * 131072 + (long)b * (4 * 128 * 4608);
        if (within < 512) {
          Q = (const bfr*)(p.ws + WS_CKVC) + (long)(b * 512 + within) * 256;
          ldq = 256;
        } else {
          Q = Z + (long)(NCTX + b * 4096 + within - 512) * ZLD + C_KV;
          ldq = ZLD;
        }
      }
      gemm128k64<4, true>((const bfr*)(p.ws + WS_WUKV) + (long)tn * 128 * 256, 256, 128, Q, ldq, 256, acc, sm);
      bfr* KN = (bfr*)(p.ws + WS_KNOPE);
      bfr* VTC = (bfr*)(p.ws + WS_VTC);
#pragma unroll
      for (int pi = 0; pi < 4; pi++) {
        int n0 = tn * 128 + wr * 64 + pi * 16 + g * 4;
        int head = n0 / 192, w = n0 % 192;
#pragma unroll
        for (int qi = 0; qi < 4; qi++) {
          int key = key0 + wc * 64 + qi * 16 + (lane & 15);
          if (w < 64) {
            u32x2 o;
            o.x = pack2(acc[pi][qi][0], acc[pi][qi][1]);
            o.y = pack2(acc[pi][qi][2], acc[pi][qi][3]);
            *(u32x2*)(KN + kbase + ((long)head * nk + key) * 64 + w) = o;
          } else {
#pragma unroll
            for (int r = 0; r < 4; r++)
              VTC[vbase + ((long)head * 128 + (w - 64) + r) * nk + key] = f2bf(acc[pi][qi][r]);
          }
        }
      }
    }
  }
}

template <int DQ, int DV, bool MLA, int NQB>
__device__ __forceinline__ void attn_item(const Params& p, int seq, int head, int qoff, bfr* sm, int dry, int amode = 0) {
  constexpr int KLD = DQ + 8;
  constexpr int KSZ = 64 * KLD;
  constexpr int VSZ = DV * LDT;
  constexpr int BUF = KSZ + VSZ;
  constexpr int NKK = DQ / 32;
  constexpr int NDV = DV / 16;
  constexpr int NVL = DV / 32;
  const int tid = TIDX, lane = tid & 63, wid = tid >> 6, g = lane >> 4, l15 = lane & 15;
  bfr* Z = (bfr*)(p.ws + WS_Z);
  const bool lat = seq >= 16;
  const int b = seq - 16;
  const int nk = lat ? 4608 : 256;
  const int rowbase = lat ? NCTX + b * 4096 : seq * 256;
  const int nkt = nk >> 6;

  bf16x8 qf[NQB][NKK];
#pragma unroll
  for (int qb = 0; qb < NQB; qb++) {
    int qrow = rowbase + qoff + wid * (16 * NQB) + qb * 16 + l15;
    const bfr* qp = MLA ? ((const bfr*)(p.ws + WS_CQ) + (long)qrow * 384 + head * 96) : (Z + (long)qrow * ZLD + C_QA + head * 64);
#pragma unroll
    for (int kk = 0; kk < NKK; kk++) qf[qb][kk] = *(const bf16x8*)(qp + kk * 32 + g * 8);
  }

  u32x4 rk[2], rkr, rv[NVL];
  auto prefetch = [&](int kt) {
    int k0 = kt * 64;
    bool cache = lat && (k0 < 512);
    int tokrow0 = lat ? (NCTX + b * 4096 + k0 - 512) : (seq * 256 + k0);
    if (!MLA) {
      int kvh = head >> 2;
#pragma unroll
      for (int i = 0; i < 2; i++) {
        int c = tid + 256 * i;
        int kr_ = c >> 3, ch = c & 7;
        const bfr* src = cache ? ((const bfr*)(p.ws + WS_KCA) + (long)(b * 512 + k0 + kr_) * 128 + kvh * 64 + ch * 8)
                               : (Z + (long)(tokrow0 + kr_) * ZLD + C_KA + kvh * 64 + ch * 8);
        rk[i] = *(const u32x4*)src;
      }
      long vb = lat ? (16l * 32768 + (long)b * (2 * 64 * 4608)) : ((long)seq * 32768);
#pragma unroll
      for (int i = 0; i < NVL; i++) {
        int c = tid + 256 * i;
        int dv = c >> 3, ch = c & 7;
        rv[i] = *(const u32x4*)((const bfr*)(p.ws + WS_VTA) + vb + (long)(kvh * 64 + dv) * nk + k0 + ch * 8);
      }
    } else {
      long kb = lat ? (16l * (4 * 256 * 64) + (long)b * (4 * 4608 * 64)) : ((long)seq * (4 * 256 * 64));
#pragma unroll
      for (int i = 0; i < 2; i++) {
        int c = tid + 256 * i;
        int kr_ = c >> 3, ch = c & 7;
        rk[i] = *(const u32x4*)((const bfr*)(p.ws + WS_KNOPE) + kb + ((long)head * nk + k0 + kr_) * 64 + ch * 8);
      }
      {
        int kr_ = tid >> 2, ch = tid & 3;
        const bfr* src = cache ? ((const bfr*)(p.ws + WS_KRC) + (long)(b * 512 + k0 + kr_) * 32 + ch * 8)
                               : (Z + (long)(tokrow0 + kr_) * ZLD + C_KR + ch * 8);
        rkr = *(const u32x4*)src;
      }
      long vb = lat ? (16l * 131072 + (long)b * (4 * 128 * 4608)) : ((long)seq * 131072);
#pragma unroll
      for (int i = 0; i < NVL; i++) {
        int c = tid + 256 * i;
        int dv = c >> 3, ch = c & 7;
        rv[i] = *(const u32x4*)((const bfr*)(p.ws + WS_VTC) + vb + (long)(head * 128 + dv) * nk + k0 + ch * 8);
      }
    }
  };

  f32x4 o[NQB][NDV];
#pragma unroll
  for (int qb = 0; qb < NQB; qb++)
#pragma unroll
    for (int d = 0; d < NDV; d++) o[qb][d] = (f32x4){0.f, 0.f, 0.f, 0.f};
  float mrun[NQB];
  f32x4 lacc[NQB];
#pragma unroll
  for (int qb = 0; qb < NQB; qb++) { mrun[qb] = 0.f; lacc[qb] = (f32x4){0.f, 0.f, 0.f, 0.f}; }
  const bf16x8 ones = (bf16x8){(short)0x3F80, (short)0x3F80, (short)0x3F80, (short)0x3F80, (short)0x3F80, (short)0x3F80, (short)0x3F80, (short)0x3F80};

  prefetch(0);
  for (int kt = 0; kt < nkt; kt++) {
    bfr* Ks = sm + (kt & 1) * BUF;
    bfr* Vs = Ks + KSZ;
    if (amode != 1) {
#pragma unroll
    for (int i = 0; i < 2; i++) {
      int c = tid + 256 * i;
      *(u32x4*)(Ks + (c >> 3) * KLD + (c & 7) * 8) = rk[i];
    }
    if (MLA) *(u32x4*)(Ks + (tid >> 2) * KLD + 64 + (tid & 3) * 8) = rkr;
#pragma unroll
    for (int i = 0; i < NVL; i++) {
      int c = tid + 256 * i;
      *(u32x4*)(Vs + (c >> 3) * LDT + (c & 7) * 8) = rv[i];
    }
    }
    __syncthreads();
    if (kt + 1 < nkt && amode != 1) prefetch(kt + 1);
    if (amode == 2) continue;

    f32x4 s[NQB][4];
    bf16x8 kfr[4][NKK];
#pragma unroll
    for (int t = 0; t < 2; t++) {
      int krow = 32 * (t >> 1) + 8 * (l15 >> 2) + 4 * (t & 1) + (l15 & 3);
#pragma unroll
      for (int kk = 0; kk < NKK; kk++) kfr[t][kk] = *(const bf16x8*)(Ks + krow * KLD + kk * 32 + g * 8);
    }
#pragma unroll
    for (int t = 0; t < 4; t++) {
#pragma unroll
      for (int qb = 0; qb < NQB; qb++) s[qb][t] = (f32x4){-mrun[qb], -mrun[qb], -mrun[qb], -mrun[qb]};
      if (t + 2 < 4) {
        int krow = 32 * ((t + 2) >> 1) + 8 * (l15 >> 2) + 4 * ((t + 2) & 1) + (l15 & 3);
#pragma unroll
        for (int kk = 0; kk < NKK; kk++) kfr[t + 2][kk] = *(const bf16x8*)(Ks + krow * KLD + kk * 32 + g * 8);
      }
#pragma unroll
      for (int kk = 0; kk < NKK; kk++) {
#pragma unroll
        for (int qb = 0; qb < NQB; qb++) s[qb][t] = mfma16(kfr[t][kk], qf[qb][kk], s[qb][t]);
      }
    }
    bf16x8 vfr[4][2];
#pragma unroll
    for (int d = 0; d < 4; d++)
#pragma unroll
      for (int sx = 0; sx < 2; sx++) vfr[d][sx] = *(const bf16x8*)(Vs + (d * 16 + l15) * LDT + sx * 32 + g * 8);
    bf16x8 pf[NQB][2];
#pragma unroll
    for (int qb = 0; qb < NQB; qb++) {
      float mt = s[qb][0][0];
#pragma unroll
      for (int t = 0; t < 4; t++)
#pragma unroll
        for (int r = 0; r < 4; r++) mt = fmaxf(mt, s[qb][t][r]);
      const bool first = (kt == 0);
      if (first || __builtin_amdgcn_ballot_w64(mt > 8.f) != 0ull) {
        mt = fmaxf(mt, __shfl_xor(mt, 16));
        mt = fmaxf(mt, __shfl_xor(mt, 32));
        const bool need = first || mt > 8.f;
        const float dm = need ? mt : 0.f;
        const float alpha = first ? 1.f : __builtin_amdgcn_exp2f(-dm);
        mrun[qb] += dm;
        lacc[qb] *= alpha;
#pragma unroll
        for (int d = 0; d < NDV; d++) o[qb][d] *= alpha;
#pragma unroll
        for (int t = 0; t < 4; t++) s[qb][t] -= dm;
      }
#pragma unroll
      for (int t = 0; t < 4; t++)
#pragma unroll
        for (int r = 0; r < 4; r++) s[qb][t][r] = __builtin_amdgcn_exp2f(s[qb][t][r]);
#pragma unroll
      for (int sx = 0; sx < 2; sx++) {
        u32x4 u;
        u.x = pack2(s[qb][2 * sx][0], s[qb][2 * sx][1]);
        u.y = pack2(s[qb][2 * sx][2], s[qb][2 * sx][3]);
        u.z = pack2(s[qb][2 * sx + 1][0], s[qb][2 * sx + 1][1]);
        u.w = pack2(s[qb][2 * sx + 1][2], s[qb][2 * sx + 1][3]);
        pf[qb][sx] = *(bf16x8*)&u;
      }
    }
#pragma unroll
    for (int d = 0; d < NDV; d++) {
#pragma unroll
      for (int sx = 0; sx < 2; sx++) {
#pragma unroll
        for (int qb = 0; qb < NQB; qb++) o[qb][d] = mfma16(vfr[d & 3][sx], pf[qb][sx], o[qb][d]);
      }
      if (d + 4 < NDV) {
#pragma unroll
        for (int sx = 0; sx < 2; sx++)
          vfr[d & 3][sx] = *(const bf16x8*)(Vs + ((d + 4) * 16 + l15) * LDT + sx * 32 + g * 8);
      }
    }
#pragma unroll
    for (int sx = 0; sx < 2; sx++) {
#pragma unroll
      for (int qb = 0; qb < NQB; qb++) lacc[qb] = mfma16(ones, pf[qb][sx], lacc[qb]);
    }
  }
  __syncthreads();
#pragma unroll
  for (int qb = 0; qb < NQB; qb++) {
    float inv = 1.f / lacc[qb][0];
    int qrow = rowbase + qoff + wid * (16 * NQB) + qb * 16 + l15;
    bfr* gp = Z + (long)qrow * ZLD + (MLA ? C_GC : C_GA) + head * DV + g * 4;
#pragma unroll
    for (int d = 0; d < NDV; d++) {
      u32x2 gr = *(const u32x2*)(gp + d * 16);
      float y0 = o[qb][d][0] * inv * siluf(lo16(gr.x));
      float y1 = o[qb][d][1] * inv * siluf(hi16(gr.x));
      float y2 = o[qb][d][2] * inv * siluf(lo16(gr.y));
      float y3 = o[qb][d][3] * inv * siluf(hi16(gr.y));
      u32x2 ov;
      ov.x = pack2(y0, y1);
      ov.y = pack2(y2, y3);
      if (!dry) *(u32x2*)(gp + d * 16) = ov;
    }
  }
}

__device__ __forceinline__ void phase_mixers(const Params& p, int l, bfr* sm, int* s_item, int dry) {
  unsigned* ctr = (unsigned*)(p.ws + WS_CTR) + (2 + l + 2 * dry) * 128;
  auto cnt = [](int) { return 184; };
  int q = (int)xcc_id(), tried = 0;
  for (;;) {
    if (TIDX == 0) {
      unsigned first = atomicAdd(ctr + q * 16, 1u);
      *s_item = xq_take(ctr, q, tried, first, cnt);
    }
    __syncthreads();
    const int it = *s_item;
    __syncthreads();
    if (it < 0) break;
    const int x = it >> 20, j = it & 0xfffff;
    int kind, a0, a1, a2, a3 = 0;
    if (j < 4) {
      int idx = x * 4 + j;
      kind = 3; a0 = idx >> 4; a1 = (idx >> 2) & 3; a2 = (idx >> 1) & 1; a3 = idx & 1;
    } else if (j < 36) {
      kind = 1; a0 = 16 + (x >> 2); a1 = x & 3; a2 = (j - 4) * 128;
    } else if (j < 96) {
      int i = j - 36;
      kind = 2; a0 = 16 + (x >> 2); a1 = ((x >> 1) & 1) * 4 + (x & 1) * 2 + (i >> 5); a2 = (i & 31) * 128;
    } else if (j < 104) {
      int k = j - 96;
      int i = 60 + (k >> 1);
      kind = 4; a0 = 16 + (x >> 2); a1 = ((x >> 1) & 1) * 4 + (x & 1) * 2 + (i >> 5); a2 = (i & 31) * 128 + (k & 1) * 64;
    } else if (j < 136) {
      int i = j - 104;
      kind = 0; a0 = 2 * x + (i >> 4); a1 = (i >> 2) & 3; a2 = (i >> 1) & 1; a3 = i & 1;
    } else if (j < 152) {
      int i = j - 136;
      kind = 1; a0 = 2 * x + (i >> 3); a1 = (i >> 1) & 3; a2 = (i & 1) * 128;
    } else {
      int i = j - 152;
      kind = 2; a0 = 2 * x + (i >> 4); a1 = (i >> 1) & 7; a2 = (i & 1) * 128;
    }
#ifdef PROBE_MIXKIND
    if (dry && ((PROBE_MIXKIND == 1) != (kind == 0 || kind == 3))) continue;
#endif
    if (kind == 0) gla_item<64>(p, l, a0, a1, a2, a3, sm);
    else if (kind == 3) gla_chain_item(p, l, a0, a1, a2, a3, sm);
    else if (kind == 1) attn_item<96, 128, true, 2>(p, a0, a1, a2, sm, dry);
    else if (kind == 2) attn_item<64, 64, false, 2>(p, a0, a1, a2, sm, dry);
    else attn_item<64, 64, false, 1>(p, a0, a1, a2, sm, dry);
  }
}

__device__ __forceinline__ void phase_gla_out(const Params& p, int l) {
  const int lane = TIDX & 63;
  bfr* Z = (bfr*)(p.ws + WS_Z);
  const bfr* OF = (const bfr*)(p.ws + WS_R1);
  const bfr* OB = OF + (long)NROWS * 512;
  for (int row = blockIdx.x * 4 + (TIDX >> 6); row < NROWS; row += gridDim.x * 4) {
    float a[8], c[8], gt[8];
    unpack8(*(const u32x4*)(OF + (long)row * 512 + lane * 8), a);
    unpack8(*(const u32x4*)(OB + (long)row * 512 + lane * 8), c);
    bfr* gp = Z + (long)row * ZLD + C_GG + lane * 8;
    unpack8(*(const u32x4*)gp, gt);
    float ss = 0.f;
#pragma unroll
    for (int e = 0; e < 8; e++) {
      a[e] = bf2f(f2bf(a[e] + c[e]));
      ss += a[e] * a[e];
    }
    ss += __shfl_xor(ss, 1); ss += __shfl_xor(ss, 2); ss += __shfl_xor(ss, 4); ss += __shfl_xor(ss, 8);
    float rs = rsqrtf(ss * (1.f / 128.f) + 1e-6f);
    const float* gg = p.in[21] + l * 128 + (lane & 15) * 8;
#pragma unroll
    for (int e = 0; e < 8; e++) a[e] = a[e] * rs * gg[e] * siluf(gt[e]);
    *(u32x4*)gp = pack8(a);
  }
}

template <int NQ>
__device__ __forceinline__ void merge_tile(const Params& p, bfr* sm, int tn, int tok0) {
  constexpr int STG = 8192 + 2048 * NQ;
  bfr* Z = (bfr*)(p.ws + WS_Z);
  bfr* MG = (bfr*)(p.ws + WS_R1);
  const int tid = TIDX;
  const int lane = tid & 63, wid = tid >> 6, wr = wid >> 1, wc = wid & 1, g = lane >> 4, l15 = lane & 15;
  f32x4 totl[4][NQ];
#pragma unroll
  for (int a = 0; a < 4; a++)
#pragma unroll
    for (int b = 0; b < NQ; b++) totl[a][b] = (f32x4){0.f, 0.f, 0.f, 0.f};
#pragma unroll 1
  for (int seg = 0; seg < 3; seg++) {
    f32x4 acc[4][NQ];
#pragma unroll
    for (int a = 0; a < 4; a++)
#pragma unroll
      for (int b = 0; b < NQ; b++) acc[a][b] = (f32x4){0.f, 0.f, 0.f, 0.f};
    int ycol = seg == 0 ? C_GA : (seg == 1 ? C_GG : C_GC);
    int mcol = C_M1 + seg * 1024;
    const bfr* W = (const bfr*)(p.ws + WS_WOA + (unsigned long)seg * 1048576ul) + (long)tn * 128 * 512;
    gemm128k64<NQ, false, true>(W, 512, 128, Z + (long)tok0 * ZLD + ycol, ZLD, 512, acc, sm,
                                Z + (long)tok0 * ZLD + mcol + tn * 128, ZLD);
    const bfr* gt = sm;
#pragma unroll
    for (int pi = 0; pi < 4; pi++) {
      const int nl = wr * 64 + pi * 16 + g * 4;
#pragma unroll
      for (int qi = 0; qi < NQ; qi++) {
        const int tl = wc * 16 * NQ + qi * 16 + l15;
        u32x2 mr = *(const u32x2*)(gt + tl * 128 + (((nl >> 3) ^ (tl & 15)) * 8) + (nl & 4));
        totl[pi][qi][0] += sigmf(lo16(mr.x)) * acc[pi][qi][0];
        totl[pi][qi][1] += sigmf(hi16(mr.x)) * acc[pi][qi][1];
        totl[pi][qi][2] += sigmf(lo16(mr.y)) * acc[pi][qi][2];
        totl[pi][qi][3] += sigmf(hi16(mr.y)) * acc[pi][qi][3];
      }
    }
    __syncthreads();
  }
#pragma unroll
  for (int pi = 0; pi < 4; pi++)
#pragma unroll
    for (int qi = 0; qi < NQ; qi++) {
      u32x2 o;
      o.x = pack2(totl[pi][qi][0], totl[pi][qi][1]);
      o.y = pack2(totl[pi][qi][2], totl[pi][qi][3]);
      *(u32x2*)(sm + (wc * 16 * NQ + qi * 16 + l15) * 136 + wr * 64 + pi * 16 + g * 4) = o;
    }
  __syncthreads();
#pragma unroll
  for (int i = 0; i < 2 * NQ; i++) {
    int c = tid + 256 * i;
    int row = c >> 4, c16 = c & 15;
    *(u32x4*)(MG + (long)(tok0 + row) * 1024 + tn * 128 + c16 * 8) = *(const u32x4*)(sm + row * 136 + c16 * 8);
  }
  __syncthreads();
}

__device__ __forceinline__ void phase_merge(const Params& p, bfr* sm) {
  for (int t = blockIdx.x; t < 1024; t += gridDim.x) {
    if (t < 512) {
      merge_tile<4>(p, sm, t & 7, (t >> 3) * 128);
    } else {
      int u = t - 512;
      int full = 512 + (u >> 1);
      merge_tile<2>(p, sm, full & 7, (full >> 3) * 128 + (u & 1) * 64);
    }
  }
}

template <int NQ>
__device__ __forceinline__ void outproj_tile(const Params& p, bfr* sm, int tn, int tok0) {
  const bfr* MG = (const bfr*)(p.ws + WS_R1);
  float* OUT = (float*)(p.ws + WS_Z);
  const int tid = TIDX;
  const int lane = tid & 63, wid = tid >> 6, wr = wid >> 1, wc = wid & 1, g = lane >> 4, l15 = lane & 15;
  f32x4 acc[4][NQ];
#pragma unroll
  for (int a = 0; a < 4; a++)
#pragma unroll
    for (int b = 0; b < NQ; b++) acc[a][b] = (f32x4){0.f, 0.f, 0.f, 0.f};
  gemm128k64<NQ, true>((const bfr*)(p.ws + WS_WOUT) + (long)tn * 128 * 1024, 1024, 128, MG + (long)tok0 * 1024, 1024, 1024, acc, sm);
  float* smf = (float*)sm;
#pragma unroll
  for (int pi = 0; pi < 4; pi++)
#pragma unroll
    for (int qi = 0; qi < NQ; qi++)
      *(f32x4*)(smf + (wc * 16 * NQ + qi * 16 + l15) * 132 + wr * 64 + pi * 16 + g * 4) = acc[pi][qi];
  __syncthreads();
#pragma unroll
  for (int i = 0; i < 4 * NQ; i++) {
    int c = tid + 256 * i;
    int row = c >> 5, c16 = c & 31;
    *(f32x4*)(OUT + (long)(tok0 + row) * 1024 + tn * 128 + c16 * 4) = *(const f32x4*)(smf + row * 132 + c16 * 4);
  }
  __syncthreads();
}
__device__ __forceinline__ void phase_outproj(const Params& p, bfr* sm) {
  for (int t = blockIdx.x; t < 1024; t += gridDim.x) {
    if (t < 512) {
      outproj_tile<4>(p, sm, t & 7, (t >> 3) * 128);
    } else {
      int u = t - 512;
      int full = 512 + (u >> 1);
      outproj_tile<2>(p, sm, full & 7, (full >> 3) * 128 + (u & 1) * 64);
    }
  }
}

__device__ __forceinline__ void phase_post(const Params& p, int l) {
  const int lane = TIDX & 63;
  const float* mod = (const float*)(p.ws + WS_MOD);
  const float* OUT = (const float*)(p.ws + WS_Z);
  bfr* H = (bfr*)(p.ws + WS_R1);
  for (int row = blockIdx.x * 4 + (TIDX >> 6); row < NROWS; row += gridDim.x * 4) {
    const float* x = (l == 0) ? xrow(p, row) : (p.out + (long)row * 1024);
    const float* md = mod + (l * 3 + row_cond(row)) * 3072;
    float4 v[4];
    float ss = 0.f;
#pragma unroll
    for (int i = 0; i < 4; i++) {
      v[i] = *(const float4*)(OUT + (long)row * 1024 + i * 256 + lane * 4);
      ss += v[i].x * v[i].x + v[i].y * v[i].y + v[i].z * v[i].z + v[i].w * v[i].w;
    }
    ss = wave_sum(ss);
    float rs = rsqrtf(ss * (1.f / 1024.f) + 1e-6f);
    float ss2 = 0.f;
#pragma unroll
    for (int i = 0; i < 4; i++) {
      int n = i * 256 + lane * 4;
      float4 g = *(const float4*)(p.in[13] + l * 1024 + n);
      float4 gt = *(const float4*)(md + 2048 + n);
      float4 xv = *(const float4*)(x + n);
      v[i].x = xv.x + gt.x * (v[i].x * rs * g.x);
      v[i].y = xv.y + gt.y * (v[i].y * rs * g.y);
      v[i].z = xv.z + gt.z * (v[i].z * rs * g.z);
      v[i].w = xv.w + gt.w * (v[i].w * rs * g.w);
      *(float4*)(p.out + (long)row * 1024 + n) = v[i];
      ss2 += v[i].x * v[i].x + v[i].y * v[i].y + v[i].z * v[i].z + v[i].w * v[i].w;
    }
    if (l == 0) {
      ss2 = wave_sum(ss2);
      float rs2 = rsqrtf(ss2 * (1.f / 1024.f) + 1e-6f);
      const float* md1 = mod + (1 * 3 + row_cond(row)) * 3072;
#pragma unroll
      for (int i = 0; i < 4; i++) {
        int n = i * 256 + lane * 4;
        float4 g = *(const float4*)(p.in[12] + 1024 + n);
        float4 sh = *(const float4*)(md1 + n);
        float4 sc = *(const float4*)(md1 + 1024 + n);
        float h0 = v[i].x * rs2 * g.x * (1.f + sc.x) + sh.x;
        float h1 = v[i].y * rs2 * g.y * (1.f + sc.y) + sh.y;
        float h2 = v[i].z * rs2 * g.z * (1.f + sc.z) + sh.z;
        float h3 = v[i].w * rs2 * g.w * (1.f + sc.w) + sh.w;
        u32x2 o;
        o.x = pack2(h0, h1);
        o.y = pack2(h2, h3);
        *(u32x2*)(H + (long)row * 1024 + n) = o;
      }
    }
  }
}

__global__ void __launch_bounds__(256, 2) fwd_megakernel(Params p) {
  __shared__ __attribute__((aligned(16))) bfr sm[SMEM_SHORTS + 16];
  int* s_item_p = (int*)(sm + SMEM_SHORTS + 8);
  cg::grid_group grid = cg::this_grid();
  if (threadIdx.x == 0) { ((unsigned*)(sm + SMEM_SHORTS))[0] = 0u; ((unsigned*)(sm + SMEM_SHORTS))[1] = 0u; }
  __syncthreads();
  XcdBarrier xb = xcd_barrier_post((unsigned*)(p.ws + WS_BAR), (volatile LAS unsigned*)(sm + SMEM_SHORTS));
  if (p.ws == nullptr) grid.sync();
  (void)xb;
#define GSYNC1 do { XcdBarrier b_; b_.bar = (unsigned*)(p.ws + WS_BAR); b_.x = xb_xcc_id(); \
                    b_.st = (volatile LAS unsigned*)(sm + SMEM_SHORTS); xcd_barrier(b_); } while (0)
#ifdef PROBE_SYNC
#define GSYNC do { GSYNC1; GSYNC1; } while (0)
#else
#define GSYNC GSYNC1
#endif
#ifdef PROBE_PRE
  phase_s0(launder(p), sm);
  GSYNC;
  phase_s1(launder(p));
  wconv_phase(p, 0, sm);
  GSYNC;
  phase_prenorm0(launder(p));
  GSYNC;
#endif

#ifndef PH
#define PH 0xffff
#endif
#if PH & 1
  phase_s0(launder(p), sm);
#endif
  GSYNC;
#if PH & 2
  phase_s1(launder(p));
  wconv_phase(p, 0, sm);
#endif
  GSYNC;
#if PH & 4
  phase_prenorm0(launder(p));
#endif
  GSYNC;
  for (int l = 0; l < 2; l++) {
#if PH & 8
#ifdef PROBE_INPROJ
    phase_inproj(launder(p), l, sm, s_item_p, 6 + l);
    GSYNC;
#endif
    phase_inproj(launder(p), l, sm, s_item_p, l);
#endif
    GSYNC;
#if PH & 16
    phase_rowpost(launder(p), l);
#endif
    GSYNC;
#if PH & 32
#ifdef PROBE_MLAUP
    phase_mla_up(launder(p), l, sm);
    GSYNC;
#endif
    phase_mla_up(launder(p), l, sm);
#endif
    GSYNC;
#if PH & 64
#ifdef PROBE_MIX
    { int dry = 1; asm volatile("" : "+s"(dry)); phase_mixers(launder(p), l, sm, s_item_p, dry); }
    GSYNC;
#endif
    { int dry = 0; asm volatile("" : "+s"(dry)); phase_mixers(launder(p), l, sm, s_item_p, dry); }
#endif
    GSYNC;
#if PH & 128
    phase_gla_out(launder(p), l);
#endif
    GSYNC;
#if PH & 256
#ifdef PROBE_MERGE
    phase_merge(launder(p), sm);
    GSYNC;
#endif
    phase_merge(launder(p), sm);
#endif
    GSYNC;
#if PH & 512
#ifdef PROBE_MERGE
    phase_outproj(launder(p), sm);
    GSYNC;
#endif
    phase_outproj(launder(p), sm);
#endif
    GSYNC;
#if PH & 1024
    phase_post(launder(p), l);
    if (l == 0) wconv_phase(p, 1, sm);
#endif
    GSYNC;
  }
}

extern "C" void kernel_launch(void* const* d_in, const int* in_sizes, int n_in, void* d_out, int out_size, void* d_ws,
                              size_t ws_size, hipStream_t stream) {
  static int grid_blocks = 0;
  if (!grid_blocks) {
    int dev = 0, cus = 0, per_cu = 0;
    hipGetDevice(&dev);
    hipDeviceGetAttribute(&cus, hipDeviceAttributeMultiprocessorCount, dev);
    hipOccupancyMaxActiveBlocksPerMultiprocessor(&per_cu, fwd_megakernel, 256, 0);
    if (per_cu > 2) per_cu = 2;
    if (per_cu < 1) per_cu = 1;
    grid_blocks = cus * per_cu;
  }
  Params p{};
  for (int i = 0; i < 30; i++) p.in[i] = (const float*)d_in[i];
  p.out = (float*)d_out;
  p.ws = (unsigned char*)d_ws;
  hipMemsetAsync(d_ws, 0, 20480, stream);
  void* args[] = {&p};
  hipError_t e = hipLaunchCooperativeKernel((void*)fwd_megakernel, dim3(grid_blocks), dim3(256), args, 0, stream);
  if (e != hipSuccess) fprintf(stderr, "cooperative launch failed: %s (grid %d)\n", hipGetErrorString(e), grid_blocks);
}
```

```cpp
#include <hip/hip_runtime.h>
#include <hip/hip_cooperative_groups.h>
#include <cstdio>
namespace cg = cooperative_groups;

typedef unsigned short bfr;
typedef __attribute__((ext_vector_type(8))) short bf16x8;
typedef __attribute__((ext_vector_type(4))) float f32x4;
typedef __attribute__((ext_vector_type(4))) unsigned u32x4;
typedef __attribute__((ext_vector_type(2))) unsigned u32x2;

#define NROWS 12288
#define NCTX 4096
#define ZLD 6976
#define LDT 72
#define SMEM_SHORTS (4 * 128 * LDT)

#define C_QA 0
#define C_KA 512
#define C_VA 640
#define C_GA 768
#define C_QG 1280
#define C_KG 1536
#define C_VG 1792
#define C_GG 2304
#define C_RF 2816
#define C_RB 2832
#define C_QL 2848
#define C_KV 3104
#define C_KR 3360
#define C_GC 3392
#define C_M1 3904
#define C_M2 4928
#define C_M3 5952

#define WS_BAR 0ul
#define WS_CTR 16384ul
#define WS_MODP 20480ul
#define WS_MOD (WS_MODP + 589824ul)
#define WS_ROPE (WS_MOD + 73728ul)
#define WS_WIN (WS_ROPE + 16384ul)
#define WS_WUQ (WS_WIN + 14417920ul)
#define WS_WUKV (WS_WUQ + 196608ul)
#define WS_WOA (WS_WUKV + 393216ul)
#define WS_WOB (WS_WOA + 1048576ul)
#define WS_WOC (WS_WOB + 1048576ul)
#define WS_WOUT (WS_WOC + 1048576ul)
#define WS_KCA (WS_WOUT + 2097152ul)
#define WS_CKVC (WS_KCA + 262144ul)
#define WS_KRC (WS_CKVC + 524288ul)
#define WS_VTA (WS_KRC + 65536ul)
#define WS_CQ (WS_VTA + 3407872ul)
#define WS_KNOPE (WS_CQ + 9437184ul)
#define WS_VTC (WS_KNOPE + 6815744ul)
#define WS_R1 (WS_VTC + 13631488ul)
#define WS_Z (WS_R1 + 25165824ul)
#define WS_END (WS_Z + 171442176ul)

#define O_Y 0
#define O_GK 12582912
#define O_GV 13631488
#define O_CKV 14680064
#define O_KR 16777216
#define O_SF 17039360
#define O_SB 18087936

struct Params {
  const float* in[30];
  float* out;
  unsigned char* ws;
};

__device__ __forceinline__ int tidx() {
  int t = threadIdx.x;
  asm volatile("" : "+v"(t));
  return t;
}
__device__ __forceinline__ Params launder(const Params& p) {
  Params q;
  long zo = 0;
  asm volatile("" : "+s"(zo));
#pragma unroll
  for (int i = 0; i < 30; i++) q.in[i] = p.in[i] + zo;
  q.out = p.out + zo;
  q.ws = p.ws + zo;
  return q;
}
__device__ __forceinline__ float bf2f(bfr b) { return __uint_as_float(((unsigned)b) << 16); }
typedef float f32x2_t __attribute__((ext_vector_type(2)));
typedef __bf16 bf16x2_t __attribute__((ext_vector_type(2)));
__device__ __forceinline__ bfr f2bf(float f) {
  __bf16 r = (__bf16)f;
  return *(bfr*)&r;
}
__device__ __forceinline__ unsigned pack2(float a, float b) {
  f32x2_t v = {a, b};
  bf16x2_t r = __builtin_convertvector(v, bf16x2_t);
  return *(unsigned*)&r;
}
__device__ __forceinline__ float lo16(unsigned u) { return __uint_as_float(u << 16); }
__device__ __forceinline__ float hi16(unsigned u) { return __uint_as_float(u & 0xffff0000u); }
__device__ __forceinline__ float siluf(float x) { return x / (1.f + __expf(-x)); }
__device__ __forceinline__ float sigmf(float x) { return 1.f / (1.f + __expf(-x)); }
__device__ __forceinline__ f32x4 mfma16(bf16x8 a, bf16x8 b, f32x4 c) {
  return __builtin_amdgcn_mfma_f32_16x16x32_bf16(a, b, c, 0, 0, 0);
}
__device__ __forceinline__ const float* xrow(const Params& p, int row) {
  return row < NCTX ? p.in[0] + (long)row * 1024 : p.in[1] + (long)(row - NCTX) * 1024;
}
__device__ __forceinline__ int row_cond(int row) { return row < NCTX ? 0 : 1 + ((row - NCTX) >> 12); }
__device__ __forceinline__ float wave_sum(float v) {
  v += __shfl_xor(v, 1); v += __shfl_xor(v, 2); v += __shfl_xor(v, 4);
  v += __shfl_xor(v, 8); v += __shfl_xor(v, 16); v += __shfl_xor(v, 32);
  return v;
}

#define XB_TMO      128
#define XB_XCNT(j)  (256  + 64 * (j))
#define XB_XSUB(j)  (1280 + 64 * (j))
#define XB_XGEN(j)  (2304 + 64 * (j))
#define XB_TOP      3328
#define XB_TOPGEN   3392
#define XCD_BAR_WORDS 3456
#define XB_SPIN_CAP (1u << 18)
#define LAS __attribute__((address_space(3)))

__device__ __forceinline__ unsigned xb_ld(unsigned* p)              { return __hip_atomic_load(p, __ATOMIC_RELAXED, __HIP_MEMORY_SCOPE_AGENT); }
__device__ __forceinline__ unsigned xb_add(unsigned* p, unsigned v) { return __hip_atomic_fetch_add(p, v, __ATOMIC_RELAXED, __HIP_MEMORY_SCOPE_AGENT); }
__device__ __forceinline__ unsigned xb_xcc_id() { return (unsigned)__builtin_amdgcn_s_getreg((3 << 11) | 20) & 0xFu; }
#define XB_SPIN(cond, bar) do { unsigned _sp = 0; while (cond) { __builtin_amdgcn_s_sleep(1); \
    if ((++_sp & 255u) == 0u) { if (xb_ld(&(bar)[XB_TMO])) break; if (_sp > XB_SPIN_CAP) { atomicAdd(&(bar)[XB_TMO], 1u); break; } } } } while (0)

struct XcdBarrier {
    unsigned* bar; unsigned x;
    volatile LAS unsigned* st;
};

__device__ __forceinline__ XcdBarrier xcd_barrier_post(unsigned* bar, volatile LAS unsigned* st) {
    XcdBarrier b; b.bar = bar; b.x = xb_xcc_id(); b.st = st;
    if (threadIdx.x == 0) (void)xb_add(&bar[XB_XCNT(b.x)], 1u);
    return b;
}
__device__ __forceinline__ void xcd_barrier_complete(unsigned* bar, unsigned x, unsigned& nloc, unsigned& nx) {
    const unsigned G = gridDim.x * gridDim.y * gridDim.z;
    unsigned sum, cnt, mine, sp = 0u;
    for (;;) {
        sum = 0u; cnt = 0u; mine = 0u;
#pragma unroll
        for (unsigned j = 0; j < 16; ++j) { const unsigned c = xb_ld(&bar[XB_XCNT(j)]); sum += c; cnt += (c > 0u) ? 1u : 0u; mine = (j == x) ? c : mine; }
        if (sum == G) break;
        __builtin_amdgcn_s_sleep(1);
        if ((++sp & 255u) == 0u) { if (xb_ld(&bar[XB_TMO])) break; if (sp > XB_SPIN_CAP) { atomicAdd(&bar[XB_TMO], 1u); break; } }
    }
    nloc = mine > 0u ? mine : 1u; nx = cnt > 0u ? cnt : 1u;
}

__device__ __forceinline__ void xcd_barrier(const XcdBarrier& b) {
    asm volatile("s_waitcnt vmcnt(0)" ::: "memory");
    __syncthreads();
    if (threadIdx.x == 0) {
        unsigned* bar = b.bar;
        __builtin_amdgcn_s_waitcnt(0);
        unsigned nloc = b.st[0], nx = b.st[1];
        if (nloc == 0u) { xcd_barrier_complete(bar, b.x, nloc, nx); b.st[0] = nloc; b.st[1] = nx; }
        const unsigned old = xb_add(&bar[XB_XSUB(b.x)], 1u);
        const unsigned gen = old / nloc;
        if (old + 1u == (gen + 1u) * nloc) {
            __builtin_amdgcn_fence(__ATOMIC_RELEASE, "agent");
            asm volatile("s_waitcnt vmcnt(0)" ::: "memory");
            const unsigned og = xb_add(&bar[XB_TOP], 1u);
            const unsigned tg = og / nx;
            if (og + 1u == (tg + 1u) * nx) xb_add(&bar[XB_TOPGEN], 1u);
            else XB_SPIN(xb_ld(&bar[XB_TOPGEN]) == tg, bar);
            __builtin_amdgcn_fence(__ATOMIC_ACQUIRE, "agent");
            xb_add(&bar[XB_XGEN(b.x)], 1u);
            asm volatile("s_waitcnt vmcnt(0)" ::: "memory");
        } else {
            XB_SPIN(xb_ld(&bar[XB_XGEN(b.x)]) == gen, bar);
            __builtin_amdgcn_fence(__ATOMIC_ACQUIRE, "agent");
            asm volatile("s_waitcnt vmcnt(0)" ::: "memory");
        }
    }
    __syncthreads();
}


#define TIDX tidx()
#define LDS3 __attribute__((address_space(3)))
__device__ __forceinline__ void glds16(const bfr* g, bfr* l) {
  __builtin_amdgcn_global_load_lds((const unsigned*)g, (LDS3 unsigned*)l, 16, 0, 0);
}
__device__ __forceinline__ void gemm128(const bfr* __restrict__ P, long ldp, int pmax,
                                        const bfr* __restrict__ Q, long ldq, int qmax, int K,
                                        f32x4 (&acc)[4][4], bfr* sm) {
  const int tid = TIDX, lane = tid & 63, wid = tid >> 6;
  const int wr = wid >> 1, wc = wid & 1;
  const int l15 = lane & 15, g = lane >> 4;
  const bfr* pp[2];
  const bfr* qp[2];
  {
    const int r0 = tid >> 2;
    const int c = (tid & 3) ^ ((tid >> 4) & 3);
#pragma unroll
    for (int i = 0; i < 2; i++) {
      int r = r0 + 64 * i;
      pp[i] = P + (long)min(r, pmax - 1) * ldp + c * 8;
      qp[i] = Q + (long)min(r, qmax - 1) * ldq + c * 8;
    }
  }
  const int nk = K >> 5;
#define GEMM_ISSUE(T)                                                    \
  do {                                                                   \
    bfr* nb_ = sm + ((T) & 3) * 8192;                                    \
    glds16(pp[0] + (T) * 32, nb_ + tid * 8);                             \
    glds16(pp[1] + (T) * 32, nb_ + 2048 + tid * 8);                      \
    glds16(qp[0] + (T) * 32, nb_ + 4096 + tid * 8);                      \
    glds16(qp[1] + (T) * 32, nb_ + 6144 + tid * 8);                      \
  } while (0)
  GEMM_ISSUE(0);
  GEMM_ISSUE(1);
  GEMM_ISSUE(2);
  const int pos = (g ^ ((l15 >> 2) & 3)) * 8;
  for (int kt = 0; kt < nk; kt++) {
    if (kt + 2 < nk) asm volatile("s_waitcnt vmcnt(8)" ::: "memory");
    else if (kt + 1 < nk) asm volatile("s_waitcnt vmcnt(4)" ::: "memory");
    else asm volatile("s_waitcnt vmcnt(0)" ::: "memory");
    __builtin_amdgcn_s_barrier();
    if (kt + 3 < nk) GEMM_ISSUE(kt + 3);
    const bfr* Ps = sm + (kt & 3) * 8192;
    const bfr* Qs = Ps + 4096;
    bf16x8 pf[4], qf[4];
#pragma unroll
    for (int m = 0; m < 4; m++) {
      pf[m] = *(const bf16x8*)(Ps + (wr * 64 + m * 16 + l15) * 32 + pos);
      qf[m] = *(const bf16x8*)(Qs + (wc * 64 + m * 16 + l15) * 32 + pos);
    }
#pragma unroll
    for (int m = 0; m < 4; m++)
#pragma unroll
      for (int n = 0; n < 4; n++) acc[m][n] = mfma16(pf[m], qf[n], acc[m][n]);
  }
#undef GEMM_ISSUE
  __syncthreads();
}

template <int NQ>
__device__ __forceinline__ void gemm128q(const bfr* __restrict__ P, long ldp, const bfr* __restrict__ Q, long ldq, int K,
                                         f32x4 (&acc)[4][NQ], bfr* sm) {
  constexpr int QI = NQ / 2;
  constexpr int STG = 4096 + QI * 2048;
  const int tid = TIDX, lane = tid & 63, wid = tid >> 6;
  const int wr = wid >> 1, wc = wid & 1;
  const int l15 = lane & 15, g = lane >> 4;
  const bfr* pp[2];
  const bfr* qp[QI];
  {
    const int r0 = tid >> 2;
    const int c = (tid & 3) ^ (((tid >> 5) & 1) * 3);
#pragma unroll
    for (int i = 0; i < 2; i++) pp[i] = P + (long)(r0 + 64 * i) * ldp + c * 8;
#pragma unroll
    for (int i = 0; i < QI; i++) qp[i] = Q + (long)(r0 + 64 * i) * ldq + c * 8;
  }
  const int nk = K >> 5;
  auto issue = [&](int T) {
    bfr* nb_ = sm + (T & 3) * STG;
    glds16(pp[0] + T * 32, nb_ + tid * 8);
    glds16(pp[1] + T * 32, nb_ + 2048 + tid * 8);
#pragma unroll
    for (int i = 0; i < QI; i++) glds16(qp[i] + T * 32, nb_ + 4096 + i * 2048 + tid * 8);
  };
  issue(0);
  issue(1);
  issue(2);
  const int pos = (g ^ (((l15 >> 3) & 1) * 3)) * 8;
  for (int kt = 0; kt < nk; kt++) {
    if (kt + 2 < nk) {
      if (QI == 2) asm volatile("s_waitcnt vmcnt(8)" ::: "memory"); else asm volatile("s_waitcnt vmcnt(6)" ::: "memory");
    } else if (kt + 1 < nk) {
      if (QI == 2) asm volatile("s_waitcnt vmcnt(4)" ::: "memory"); else asm volatile("s_waitcnt vmcnt(3)" ::: "memory");
    } else {
      asm volatile("s_waitcnt vmcnt(0)" ::: "memory");
    }
    __builtin_amdgcn_s_barrier();
    if (kt + 3 < nk) issue(kt + 3);
    const bfr* Ps = sm + (kt & 3) * STG;
    const bfr* Qs = Ps + 4096;
    bf16x8 pf[4], qf[NQ];
#pragma unroll
    for (int m = 0; m < 4; m++) pf[m] = *(const bf16x8*)(Ps + (wr * 64 + m * 16 + l15) * 32 + pos);
#pragma unroll
    for (int n = 0; n < NQ; n++) qf[n] = *(const bf16x8*)(Qs + (wc * 16 * NQ + n * 16 + l15) * 32 + pos);
#pragma unroll
    for (int m = 0; m < 4; m++)
#pragma unroll
      for (int n = 0; n < NQ; n++) acc[m][n] = mfma16(pf[m], qf[n], acc[m][n]);
  }
  __syncthreads();
}

template <int NQ>
__device__ __forceinline__ void gemm256x128(const bfr* __restrict__ P, long ldp, int pmax,
                                            const bfr* __restrict__ Q, long ldq, int K,
                                            f32x4 (&acc)[8][NQ], bfr* sm) {
  constexpr int QI = NQ / 2;
  constexpr int STG = 8192 + QI * 2048;
  const int tid = TIDX, lane = tid & 63, wid = tid >> 6;
  const int wr = wid >> 1, wc = wid & 1;
  const int l15 = lane & 15, g = lane >> 4;
  const bfr* pp[4];
  const bfr* qp[QI];
  {
    const int r0 = tid >> 2;
    const int c = (tid & 3) ^ (((tid >> 5) & 1) * 3);
#pragma unroll
    for (int i = 0; i < 4; i++) pp[i] = P + (long)min(r0 + 64 * i, pmax - 1) * ldp + c * 8;
#pragma unroll
    for (int i = 0; i < QI; i++) qp[i] = Q + (long)(r0 + 64 * i) * ldq + c * 8;
  }
  const int nk = K >> 5;
  auto issue = [&](int T, int stg) {
    bfr* nb_ = sm + stg * STG;
    glds16(pp[0] + T * 32, nb_ + tid * 8);
    glds16(pp[1] + T * 32, nb_ + 2048 + tid * 8);
    glds16(pp[2] + T * 32, nb_ + 4096 + tid * 8);
    glds16(pp[3] + T * 32, nb_ + 6144 + tid * 8);
#pragma unroll
    for (int i = 0; i < QI; i++) glds16(qp[i] + T * 32, nb_ + 8192 + i * 2048 + tid * 8);
  };
  issue(0, 0);
  issue(1, 1);
  const int pos = (g ^ (((l15 >> 3) & 1) * 3)) * 8;
  int st = 0;
  for (int kt = 0; kt < nk; kt++) {
    if (kt + 1 < nk) {
      if (QI == 2) asm volatile("s_waitcnt vmcnt(6)" ::: "memory"); else asm volatile("s_waitcnt vmcnt(5)" ::: "memory");
    } else {
      asm volatile("s_waitcnt vmcnt(0)" ::: "memory");
    }
    __builtin_amdgcn_s_barrier();
    if (kt + 2 < nk) issue(kt + 2, st == 0 ? 2 : st - 1);
    const bfr* Ps = sm + st * STG;
    const bfr* Qs = Ps + 8192;
    st = (st == 2) ? 0 : st + 1;
    bf16x8 qf[NQ], pf[8];
#pragma unroll
    for (int n = 0; n < NQ; n++) qf[n] = *(const bf16x8*)(Qs + (wc * 16 * NQ + n * 16 + l15) * 32 + pos);
#pragma unroll
    for (int m = 0; m < 8; m++) pf[m] = *(const bf16x8*)(Ps + (wr * 128 + m * 16 + l15) * 32 + pos);
#pragma unroll
    for (int m = 0; m < 8; m++)
#pragma unroll
      for (int n = 0; n < NQ; n++) acc[m][n] = mfma16(pf[m], qf[n], acc[m][n]);
    __builtin_amdgcn_sched_group_barrier(0x100, NQ + 2, 0);
#pragma unroll
    for (int i = 0; i < 6; i++) {
      __builtin_amdgcn_sched_group_barrier(0x008, NQ, 0);
      __builtin_amdgcn_sched_group_barrier(0x100, 1, 0);
    }
    __builtin_amdgcn_sched_group_barrier(0x008, 2 * NQ, 0);
  }
  __syncthreads();
}

template <int NQ, bool PIPE, bool TAIL = false>
__device__ __forceinline__ void gemm128k64(const bfr* __restrict__ P, long ldp, int pmax,
                                           const bfr* __restrict__ Q, long ldq, int K,
                                           f32x4 (&acc)[4][NQ], bfr* sm, const bfr* tail_src = nullptr, long tail_ld = 0) {
  constexpr int STG = 8192 + 2048 * NQ;
  const int tid = TIDX, lane = tid & 63, wid = tid >> 6;
  const int wr = wid >> 1, wc = wid & 1;
  const int l15 = lane & 15, g = lane >> 4;
  const bfr* pp[4];
  const bfr* qp[NQ];
  {
    const int r0 = tid >> 3;
    const int c = (tid & 7) ^ ((tid >> 4) & 7);
#pragma unroll
    for (int i = 0; i < 4; i++) pp[i] = P + (long)min(r0 + 32 * i, pmax - 1) * ldp + c * 8;
#pragma unroll
    for (int i = 0; i < NQ; i++) qp[i] = Q + (long)(r0 + 32 * i) * ldq + c * 8;
  }
  const int nk = K >> 6;
#pragma unroll
  for (int i = 0; i < 4; i++) glds16(pp[i], sm + i * 2048 + tid * 8);
#pragma unroll
  for (int i = 0; i < NQ; i++) glds16(qp[i], sm + 8192 + i * 2048 + tid * 8);
  const int swz = l15 >> 1;
  for (int kt = 0; kt < nk; kt++) {
    asm volatile("s_waitcnt vmcnt(0)" ::: "memory");
    __builtin_amdgcn_s_barrier();
    if (kt + 1 < nk) {
      bfr* nb = sm + ((kt + 1) & 1) * STG;
#pragma unroll
      for (int i = 0; i < 4; i++) glds16(pp[i] + (kt + 1) * 64, nb + i * 2048 + tid * 8);
#pragma unroll
      for (int i = 0; i < NQ; i++) glds16(qp[i] + (kt + 1) * 64, nb + 8192 + i * 2048 + tid * 8);
    } else if (TAIL) {
      bfr* nb = sm + ((kt + 1) & 1) * STG;
      const bfr* ts = tail_src + (long)(tid >> 4) * tail_ld + (((tid & 15) ^ ((tid >> 4) & 15)) * 8);
#pragma unroll
      for (int i = 0; i < 2 * NQ; i++) glds16(ts + (long)(16 * i) * tail_ld, nb + i * 2048 + tid * 8);
    }
    const bfr* Ps = sm + (kt & 1) * STG;
    const bfr* Qs = Ps + 8192;
    if (PIPE) {
      bf16x8 pf[2][4], qf[2][NQ];
#pragma unroll
      for (int kk = 0; kk < 2; kk++) {
        const int pos = ((kk * 4 + g) ^ swz) * 8;
#pragma unroll
        for (int m = 0; m < 4; m++) pf[kk][m] = *(const bf16x8*)(Ps + (wr * 64 + m * 16 + l15) * 64 + pos);
#pragma unroll
        for (int n = 0; n < NQ; n++) qf[kk][n] = *(const bf16x8*)(Qs + (wc * 16 * NQ + n * 16 + l15) * 64 + pos);
      }
#pragma unroll
      for (int kk = 0; kk < 2; kk++)
#pragma unroll
        for (int m = 0; m < 4; m++)
#pragma unroll
          for (int n = 0; n < NQ; n++) acc[m][n] = mfma16(pf[kk][m], qf[kk][n], acc[m][n]);
      __builtin_amdgcn_sched_group_barrier(0x100, 4 + NQ, 0);
#pragma unroll
      for (int i = 0; i < 4 + NQ; i++) {
        __builtin_amdgcn_sched_group_barrier(0x008, NQ == 4 ? 2 : 1, 0);
        __builtin_amdgcn_sched_group_barrier(0x100, 1, 0);
      }
      __builtin_amdgcn_sched_group_barrier(0x008, NQ == 4 ? 16 : 10, 0);
    } else {
#pragma unroll
      for (int kk = 0; kk < 2; kk++) {
        bf16x8 pf[4], qf[NQ];
        const int pos = ((kk * 4 + g) ^ swz) * 8;
#pragma unroll
        for (int m = 0; m < 4; m++) pf[m] = *(const bf16x8*)(Ps + (wr * 64 + m * 16 + l15) * 64 + pos);
#pragma unroll
        for (int n = 0; n < NQ; n++) qf[n] = *(const bf16x8*)(Qs + (wc * 16 * NQ + n * 16 + l15) * 64 + pos);
#pragma unroll
        for (int m = 0; m < 4; m++)
#pragma unroll
          for (int n = 0; n < NQ; n++) acc[m][n] = mfma16(pf[m], qf[n], acc[m][n]);
      }
    }
  }
  if (TAIL) asm volatile("s_waitcnt vmcnt(0)" ::: "memory");
  __syncthreads();
}

__device__ __forceinline__ void gemm160x128(const bfr* __restrict__ P, long ldp, int pmax,
                                            const bfr* __restrict__ Q, long ldq, int K,
                                            f32x4 (&acc)[5][4], bfr* sm) {
  constexpr int STG = 160 * 64 + 128 * 64;
  const int tid = TIDX, lane = tid & 63, wid = tid >> 6;
  const int wr = wid >> 1, wc = wid & 1;
  const int l15 = lane & 15, g = lane >> 4;
  const bfr* pp[5];
  const bfr* qp[4];
  {
    const int r0 = tid >> 3;
    const int c = (tid & 7) ^ ((tid >> 4) & 7);
#pragma unroll
    for (int i = 0; i < 5; i++) pp[i] = P + (long)min(r0 + 32 * i, pmax - 1) * ldp + c * 8;
#pragma unroll
    for (int i = 0; i < 4; i++) qp[i] = Q + (long)(r0 + 32 * i) * ldq + c * 8;
  }
  const int nk = K >> 6;
#pragma unroll
  for (int i = 0; i < 5; i++) glds16(pp[i], sm + i * 2048 + tid * 8);
#pragma unroll
  for (int i = 0; i < 4; i++) glds16(qp[i], sm + 10240 + i * 2048 + tid * 8);
  const int swz = l15 >> 1;
  for (int kt = 0; kt < nk; kt++) {
    asm volatile("s_waitcnt vmcnt(0)" ::: "memory");
    __builtin_amdgcn_s_barrier();
    if (kt + 1 < nk) {
      bfr* nb = sm + ((kt + 1) & 1) * STG;
#pragma unroll
      for (int i = 0; i < 5; i++) glds16(pp[i] + (kt + 1) * 64, nb + i * 2048 + tid * 8);
#pragma unroll
      for (int i = 0; i < 4; i++) glds16(qp[i] + (kt + 1) * 64, nb + 10240 + i * 2048 + tid * 8);
    }
    const bfr* Ps = sm + (kt & 1) * STG;
    const bfr* Qs = Ps + 10240;
    bf16x8 pf[2][5], qf[2][4];
#pragma unroll
    for (int kk = 0; kk < 2; kk++) {
      const int pos = ((kk * 4 + g) ^ swz) * 8;
#pragma unroll
      for (int m = 0; m < 5; m++) pf[kk][m] = *(const bf16x8*)(Ps + (wr * 80 + m * 16 + l15) * 64 + pos);
#pragma unroll
      for (int n = 0; n < 4; n++) qf[kk][n] = *(const bf16x8*)(Qs + (wc * 64 + n * 16 + l15) * 64 + pos);
    }
#pragma unroll
    for (int kk = 0; kk < 2; kk++)
#pragma unroll
      for (int m = 0; m < 5; m++)
#pragma unroll
        for (int n = 0; n < 4; n++) acc[m][n] = mfma16(pf[kk][m], qf[kk][n], acc[m][n]);
    __builtin_amdgcn_sched_group_barrier(0x100, 9, 0);
#pragma unroll
    for (int i = 0; i < 9; i++) {
      __builtin_amdgcn_sched_group_barrier(0x008, 2, 0);
      __builtin_amdgcn_sched_group_barrier(0x100, 1, 0);
    }
    __builtin_amdgcn_sched_group_barrier(0x008, 22, 0);
  }
  __syncthreads();
}

__device__ __forceinline__ void phase_s0(const Params& p, bfr* sm) {
  const int tid = TIDX;
  float* rope = (float*)(p.ws + WS_ROPE);
  for (int idx = blockIdx.x * 256 + tid; idx < 1536; idx += gridDim.x * 256) {
    if (idx < 1024) {
      int pos = idx >> 4, i = idx & 15;
      float fr = powf(10000.f, -(float)i / 16.f);
      float a = (float)pos * fr;
      rope[idx] = cosf(a);
      rope[1024 + idx] = sinf(a);
    } else {
      int j = idx - 1024;
      int pos = j >> 3, i = j & 7;
      float fr = powf(10000.f, -(float)i / 8.f);
      float a = (float)pos * fr;
      rope[2048 + j] = cosf(a);
      rope[2560 + j] = sinf(a);
    }
  }
  float* smf = (float*)sm;
  float* modp = (float*)(p.ws + WS_MODP);
  for (int it = blockIdx.x; it < 768; it += gridDim.x) {
    int l = it / 384, rem = it % 384, cgp = rem >> 3, ks = rem & 7;
    int col = cgp * 64 + (tid & 63), kq = tid >> 6;
    const float* w = p.in[10] + (long)l * 1024 * 3072 + col;
    float a0 = 0.f, a1 = 0.f, a2 = 0.f;
    int k0 = ks * 128 + kq * 32;
#pragma unroll 8
    for (int k = k0; k < k0 + 32; k++) {
      float wv = w[(long)k * 3072];
      a0 += siluf(p.in[9][k]) * wv;
      a1 += siluf(p.in[8][k]) * wv;
      a2 += siluf(p.in[8][1024 + k]) * wv;
    }
    smf[(kq * 3 + 0) * 64 + (tid & 63)] = a0;
    smf[(kq * 3 + 1) * 64 + (tid & 63)] = a1;
    smf[(kq * 3 + 2) * 64 + (tid & 63)] = a2;
    __syncthreads();
    if (tid < 192) {
      int c = tid >> 6, cc = tid & 63;
      float s = smf[(0 * 3 + c) * 64 + cc] + smf[(1 * 3 + c) * 64 + cc] + smf[(2 * 3 + c) * 64 + cc] + smf[(3 * 3 + c) * 64 + cc];
      modp[((ks * 2 + l) * 3 + c) * 3072 + cgp * 64 + cc] = s;
    }
    __syncthreads();
  }
}

__device__ __forceinline__ void phase_s1(const Params& p) {
  float* modp = (float*)(p.ws + WS_MODP);
  float* mod = (float*)(p.ws + WS_MOD);
  for (int idx = blockIdx.x * 256 + TIDX; idx < 2 * 3 * 3072; idx += gridDim.x * 256) {
    int l = idx / 9216, n = idx % 3072;
    float s = p.in[11][l * 3072 + n];
#pragma unroll
    for (int ks = 0; ks < 8; ks++) s += modp[ks * 18432 + idx];
    mod[idx] = s;
  }
}

#define WCONV_ITEMS 2456
struct WcItem { const float* src; bfr* dst; int K, N, tk, tn; };
__device__ __forceinline__ WcItem wconv_decode(const Params& p, int l, int item) {
  WcItem w;
  if (item < 1744) {
    w.src = p.in[14] + (long)l * 1024 * 6976; w.K = 1024; w.N = 6976; w.dst = (bfr*)(p.ws + WS_WIN); w.tk = item & 15; w.tn = item >> 4;
  } else if (item < 1768) {
    item -= 1744;
    w.src = p.in[24] + (long)l * 256 * 384; w.K = 256; w.N = 384; w.dst = (bfr*)(p.ws + WS_WUQ); w.tk = item & 3; w.tn = item >> 2;
  } else if (item < 1816) {
    item -= 1768;
    w.src = p.in[25] + (long)l * 256 * 768; w.K = 256; w.N = 768; w.dst = (bfr*)(p.ws + WS_WUKV); w.tk = item & 3; w.tn = item >> 2;
  } else if (item < 2200) {
    item -= 1816;
    int ww = item >> 7, it = item & 127;
    w.src = (ww == 0 ? p.in[26] : (ww == 1 ? p.in[27] : p.in[28])) + (long)l * 512 * 1024;
    w.K = 512; w.N = 1024; w.dst = (bfr*)(p.ws + WS_WOA + (unsigned long)ww * 1048576ul); w.tk = it & 7; w.tn = it >> 3;
  } else {
    item -= 2200;
    w.src = p.in[29] + (long)l * 1024 * 1024; w.K = 1024; w.N = 1024; w.dst = (bfr*)(p.ws + WS_WOUT); w.tk = item & 15; w.tn = item >> 4;
  }
  return w;
}
__device__ __forceinline__ void wconv_phase(const Params& p, int l, bfr* sm) {
  bfr* sT = sm;
  const int tid = TIDX;
  const int n4 = (tid & 15) * 4, k0 = (tid >> 4) * 4;
  float4 v[4];
  int item = blockIdx.x;
  if (item < WCONV_ITEMS) {
    WcItem w = wconv_decode(p, l, item);
#pragma unroll
    for (int i = 0; i < 4; i++) v[i] = *(const float4*)(w.src + (long)(w.tk * 64 + k0 + i) * w.N + w.tn * 64 + n4);
  }
  const int wcol = (((k0 >> 3) ^ ((n4 >> 2) & 7)) * 8) + (k0 & 4);
  for (; item < WCONV_ITEMS; item += gridDim.x) {
    WcItem w = wconv_decode(p, l, item);
    {
      u32x2 o;
      o.x = pack2(v[0].x, v[1].x); o.y = pack2(v[2].x, v[3].x);
      *(u32x2*)(sT + (n4 + 0) * 64 + wcol) = o;
      o.x = pack2(v[0].y, v[1].y); o.y = pack2(v[2].y, v[3].y);
      *(u32x2*)(sT + (n4 + 1) * 64 + wcol) = o;
      o.x = pack2(v[0].z, v[1].z); o.y = pack2(v[2].z, v[3].z);
      *(u32x2*)(sT + (n4 + 2) * 64 + wcol) = o;
      o.x = pack2(v[0].w, v[1].w); o.y = pack2(v[2].w, v[3].w);
      *(u32x2*)(sT + (n4 + 3) * 64 + wcol) = o;
    }
    const int nitem = item + gridDim.x;
    if (nitem < WCONV_ITEMS) {
      WcItem wn = wconv_decode(p, l, nitem);
#pragma unroll
      for (int i = 0; i < 4; i++) v[i] = *(const float4*)(wn.src + (long)(wn.tk * 64 + k0 + i) * wn.N + wn.tn * 64 + n4);
    }
    __syncthreads();
#pragma unroll
    for (int i = 0; i < 2; i++) {
      int c = tid + 256 * i;
      int n = c >> 3, kc = c & 7;
      *(u32x4*)(w.dst + (long)(w.tn * 64 + n) * w.K + w.tk * 64 + kc * 8) = *(const u32x4*)(sT + n * 64 + ((kc ^ ((n >> 2) & 7)) * 8));
    }
    __syncthreads();
  }
}

__device__ __forceinline__ void phase_prenorm0(const Params& p) {
  const int lane = TIDX & 63;
  const float* mod = (const float*)(p.ws + WS_MOD);
  bfr* H = (bfr*)(p.ws + WS_R1);
  for (int row = blockIdx.x * 4 + (TIDX >> 6); row < NROWS; row += gridDim.x * 4) {
    const float* x = xrow(p, row);
    const float* md = mod + (0 * 3 + row_cond(row)) * 3072;
    float4 v[4];
    float ss = 0.f;
#pragma unroll
    for (int i = 0; i < 4; i++) {
      v[i] = *(const float4*)(x + i * 256 + lane * 4);
      ss += v[i].x * v[i].x + v[i].y * v[i].y + v[i].z * v[i].z + v[i].w * v[i].w;
    }
    ss = wave_sum(ss);
    float rs = rsqrtf(ss * (1.f / 1024.f) + 1e-6f);
#pragma unroll
    for (int i = 0; i < 4; i++) {
      int n = i * 256 + lane * 4;
      float4 g = *(const float4*)(p.in[12] + n);
      float4 sh = *(const float4*)(md + n);
      float4 sc = *(const float4*)(md + 1024 + n);
      float h0 = v[i].x * rs * g.x * (1.f + sc.x) + sh.x;
      float h1 = v[i].y * rs * g.y * (1.f + sc.y) + sh.y;
      float h2 = v[i].z * rs * g.z * (1.f + sc.z) + sh.z;
      float h3 = v[i].w * rs * g.w * (1.f + sc.w) + sh.w;
      u32x2 o;
      o.x = pack2(h0, h1);
      o.y = pack2(h2, h3);
      *(u32x2*)(H + (long)row * 1024 + n) = o;
    }
  }
}

__device__ __forceinline__ unsigned xcc_id() { return (unsigned)__builtin_amdgcn_s_getreg((3 << 11) | 20) & 7u; }
template <class CountF>
__device__ __forceinline__ int xq_take(unsigned* ctr, int& q, int& tried, unsigned first, CountF cnt) {
  unsigned j = first;
  for (;;) {
    if (j < (unsigned)cnt(q)) return (q << 20) | (int)j;
    q = (q + 1) & 7;
    if (++tried >= 8) return -1;
    j = atomicAdd(ctr + q * 16, 1u);
  }
}

__device__ __forceinline__ void phase_inproj(const Params& p, int l, bfr* sm, int* s_item, int slot) {
  const bfr* H = (const bfr*)(p.ws + WS_R1);
  const bfr* W = (const bfr*)(p.ws + WS_WIN);
  bfr* Z = (bfr*)(p.ws + WS_Z);
  const int tid = TIDX;
  const int lane = tid & 63, wid = tid >> 6, wr = wid >> 1, wc = wid & 1;
  unsigned* ctr = (unsigned*)(p.ws + WS_CTR) + slot * 128;
  auto cnt = [](int q) { return 96 * ((44 * (q + 1)) / 8 - (44 * q) / 8); };
  int q = (int)xcc_id(), tried = 0;
  unsigned nxt = 0;
  if (tid == 0) nxt = atomicAdd(ctr + q * 16, 1u);
  for (;;) {
    if (tid == 0) *s_item = xq_take(ctr, q, tried, nxt, cnt);
    __syncthreads();
    const int it = *s_item;
    __syncthreads();
    if (it < 0) break;
    const int qq = it >> 20, j = it & 0xfffff;
    if (tid == 0) nxt = atomicAdd(ctr + q * 16, 1u);
    const int tn0 = (44 * qq) / 8, w = (44 * (qq + 1)) / 8 - tn0;
    const int tm = j / w, tn = tn0 + j % w;
    f32x4 acc[5][4];
#pragma unroll
    for (int a = 0; a < 5; a++)
#pragma unroll
      for (int b = 0; b < 4; b++) acc[a][b] = (f32x4){0.f, 0.f, 0.f, 0.f};
    gemm160x128(W + (long)tn * 160 * 1024, 1024, ZLD - tn * 160, H + (long)tm * 128 * 1024, 1024, 1024, acc, sm);
    {
      const int g = lane >> 4, l15 = lane & 15;
#pragma unroll
      for (int pi = 0; pi < 5; pi++)
#pragma unroll
        for (int qi = 0; qi < 4; qi++) {
          u32x2 o;
          o.x = pack2(acc[pi][qi][0], acc[pi][qi][1]);
          o.y = pack2(acc[pi][qi][2], acc[pi][qi][3]);
          *(u32x2*)(sm + (wc * 64 + qi * 16 + l15) * 168 + wr * 80 + pi * 16 + g * 4) = o;
        }
      __syncthreads();
      const int ncol = min(20, (ZLD - tn * 160) >> 3);
#pragma unroll
      for (int i = 0; i < 10; i++) {
        int c = tid + 256 * i;
        int row = c / 20, c16 = c % 20;
        if (c16 < ncol)
          *(u32x4*)(Z + (long)(tm * 128 + row) * ZLD + tn * 160 + c16 * 8) = *(const u32x4*)(sm + row * 168 + c16 * 8);
      }
      __syncthreads();
    }
  }
}

__device__ __forceinline__ void unpack8(u32x4 v, float* x) {
  x[0] = lo16(v.x); x[1] = hi16(v.x); x[2] = lo16(v.y); x[3] = hi16(v.y);
  x[4] = lo16(v.z); x[5] = hi16(v.z); x[6] = lo16(v.w); x[7] = hi16(v.w);
}
__device__ __forceinline__ u32x4 pack8(const float* y) {
  u32x4 o;
  o.x = pack2(y[0], y[1]); o.y = pack2(y[2], y[3]); o.z = pack2(y[4], y[5]); o.w = pack2(y[6], y[7]);
  return o;
}

__device__ __forceinline__ void phase_rowpost(const Params& p, int l) {
  const int lane = TIDX & 63;
  bfr* Z = (bfr*)(p.ws + WS_Z);
  const float* rope = (const float*)(p.ws + WS_ROPE);
  bfr* VTA = (bfr*)(p.ws + WS_VTA);
  bfr* KCA = (bfr*)(p.ws + WS_KCA);
  bfr* CKVC = (bfr*)(p.ws + WS_CKVC);
  bfr* KRC = (bfr*)(p.ws + WS_KRC);
  float* out = p.out;
  for (int row = blockIdx.x * 4 + (TIDX >> 6); row < NROWS + 1024; row += gridDim.x * 4) {
    if (row < NROWS) {
      const bool lat = row >= NCTX;
      const int bc = row >> 8, tc = row & 255;
      const int bl = (row - NCTX) >> 12, tl = (row - NCTX) & 4095;
      const int prow = tl >> 6, pcol = tl & 63;
      bfr* z = Z + (long)row * ZLD;
      {
        float x[8];
        unpack8(*(const u32x4*)(z + C_QA + lane * 8), x);
        float ss = 0.f;
#pragma unroll
        for (int e = 0; e < 8; e++) ss += x[e] * x[e];
        ss += __shfl_xor(ss, 1); ss += __shfl_xor(ss, 2); ss += __shfl_xor(ss, 4);
        float rs = rsqrtf(ss * (1.f / 64.f) + 1e-6f);
        int sub = lane & 7;
        const float* g = p.in[15] + l * 64 + sub * 8;
#pragma unroll
        for (int e = 0; e < 8; e++) x[e] = x[e] * rs * g[e];
        if (lat) {
          int pos = (sub >> 2) ? pcol : prow;
          bool hi = (sub & 2) != 0;
          int i0 = (sub & 1) * 8;
#pragma unroll
          for (int e = 0; e < 8; e++) {
            float yp = __shfl_xor(x[e], 2);
            float c = rope[pos * 16 + i0 + e], s = rope[1024 + pos * 16 + i0 + e];
            x[e] = hi ? (yp * s + x[e] * c) : (x[e] * c - yp * s);
          }
        }
        const float qs = 0.125f * 1.4426950408889634f;
#pragma unroll
        for (int e = 0; e < 8; e++) x[e] *= qs;
        *(u32x4*)(z + C_QA + lane * 8) = pack8(x);
      }
      {
        int L = lane & 15;
        float x[8];
        unpack8(*(const u32x4*)(z + C_KA + L * 8), x);
        float ss = 0.f;
#pragma unroll
        for (int e = 0; e < 8; e++) ss += x[e] * x[e];
        ss += __shfl_xor(ss, 1); ss += __shfl_xor(ss, 2); ss += __shfl_xor(ss, 4);
        float rs = rsqrtf(ss * (1.f / 64.f) + 1e-6f);
        int sub = L & 7;
        const float* g = p.in[16] + l * 64 + sub * 8;
#pragma unroll
        for (int e = 0; e < 8; e++) x[e] = x[e] * rs * g[e];
        if (lat) {
          int pos = (sub >> 2) ? pcol : prow;
          bool hi = (sub & 2) != 0;
          int i0 = (sub & 1) * 8;
#pragma unroll
          for (int e = 0; e < 8; e++) {
            float yp = __shfl_xor(x[e], 2);
            float c = rope[pos * 16 + i0 + e], s = rope[1024 + pos * 16 + i0 + e];
            x[e] = hi ? (yp * s + x[e] * c) : (x[e] * c - yp * s);
          }
        } else if (lane < 16) {
          float* o = out + O_GK + ((long)(bc * 2 + l) * 256 + tc) * 128 + L * 8;
          *(float4*)(o) = make_float4(x[0], x[1], x[2], x[3]);
          *(float4*)(o + 4) = make_float4(x[4], x[5], x[6], x[7]);
        }
        if (lane < 16) *(u32x4*)(z + C_KA + L * 8) = pack8(x);
      }
      if (lane < 16) {
        int L = lane;
        u32x4 raw = *(const u32x4*)(z + C_VA + L * 8);
        float x[8];
        unpack8(raw, x);
        if (!lat) {
          float* o = out + O_GV + ((long)(bc * 2 + l) * 256 + tc) * 128 + L * 8;
          *(float4*)(o) = make_float4(x[0], x[1], x[2], x[3]);
          *(float4*)(o + 4) = make_float4(x[4], x[5], x[6], x[7]);
        }
        int g = L >> 3, d0 = (L & 7) * 8;
        long base; int nk, key;
        if (!lat) { base = (long)bc * 32768; nk = 256; key = tc; }
        else { base = 16l * 32768 + (long)bl * (2 * 64 * 4608); nk = 4608; key = 512 + tl; }
        const bfr* rb = (const bfr*)&raw;
#pragma unroll
        for (int e = 0; e < 8; e++) VTA[base + (long)(g * 64 + d0 + e) * nk + key] = rb[e];
      }
      {
        u32x2 rq = *(const u32x2*)(z + C_QL + lane * 4);
        u32x2 rk = *(const u32x2*)(z + C_KV + lane * 4);
        float q[4] = {lo16(rq.x), hi16(rq.x), lo16(rq.y), hi16(rq.y)};
        float k[4] = {lo16(rk.x), hi16(rk.x), lo16(rk.y), hi16(rk.y)};
        float sq = q[0] * q[0] + q[1] * q[1] + q[2] * q[2] + q[3] * q[3];
        float sk = k[0] * k[0] + k[1] * k[1] + k[2] * k[2] + k[3] * k[3];
        sq = wave_sum(sq);
        sk = wave_sum(sk);
        float rq_ = rsqrtf(sq * (1.f / 256.f) + 1e-6f), rk_ = rsqrtf(sk * (1.f / 256.f) + 1e-6f);
        float4 gq = *(const float4*)(p.in[22] + l * 256 + lane * 4);
        float4 gk = *(const float4*)(p.in[23] + l * 256 + lane * 4);
        q[0] *= rq_ * gq.x; q[1] *= rq_ * gq.y; q[2] *= rq_ * gq.z; q[3] *= rq_ * gq.w;
        k[0] *= rk_ * gk.x; k[1] *= rk_ * gk.y; k[2] *= rk_ * gk.z; k[3] *= rk_ * gk.w;
        u32x2 o;
        o.x = pack2(q[0], q[1]); o.y = pack2(q[2], q[3]);
        *(u32x2*)(z + C_QL + lane * 4) = o;
        o.x = pack2(k[0], k[1]); o.y = pack2(k[2], k[3]);
        *(u32x2*)(z + C_KV + lane * 4) = o;
        if (!lat) *(float4*)(out + O_CKV + ((long)(bc * 2 + l) * 256 + tc) * 256 + lane * 4) = make_float4(k[0], k[1], k[2], k[3]);
      }
      {
        int L = lane & 3;
        float x[8];
        unpack8(*(const u32x4*)(z + C_KR + L * 8), x);
        if (lat) {
          int pos = (L >> 1) ? pcol : prow;
          bool hi = (L & 1) != 0;
#pragma unroll
          for (int e = 0; e < 8; e++) {
            float yp = __shfl_xor(x[e], 1);
            float c = rope[2048 + pos * 8 + e], s = rope[2560 + pos * 8 + e];
            x[e] = hi ? (yp * s + x[e] * c) : (x[e] * c - yp * s);
          }
          if (lane < 4) *(u32x4*)(z + C_KR + L * 8) = pack8(x);
        } else if (lane < 4) {
          float* o = out + O_KR + ((long)(bc * 2 + l) * 256 + tc) * 32 + L * 8;
          *(float4*)(o) = make_float4(x[0], x[1], x[2], x[3]);
          *(float4*)(o + 4) = make_float4(x[4], x[5], x[6], x[7]);
        }
      }
    } else {
      int cr = row - NROWS;
      int b = cr >> 9, t = cr & 511;
      long src = (long)(b * 2 + l) * 512 + t;
      {
        float2 kv = *(const float2*)(p.in[2] + src * 128 + lane * 2);
        *(unsigned*)(KCA + (long)(b * 512 + t) * 128 + lane * 2) = pack2(kv.x, kv.y);
        float2 vv = *(const float2*)(p.in[3] + src * 128 + lane * 2);
        int c0 = lane * 2;
        long base = 16l * 32768 + (long)b * (2 * 64 * 4608);
        VTA[base + (long)c0 * 4608 + t] = f2bf(vv.x);
        VTA[base + (long)(c0 + 1) * 4608 + t] = f2bf(vv.y);
        float4 cv = *(const float4*)(p.in[4] + src * 256 + lane * 4);
        u32x2 o;
        o.x = pack2(cv.x, cv.y); o.y = pack2(cv.z, cv.w);
        *(u32x2*)(CKVC + (long)(b * 512 + t) * 256 + lane * 4) = o;
        if (lane < 32) KRC[(long)(b * 512 + t) * 32 + lane] = f2bf(p.in[5][src * 32 + lane]);
      }
    }
  }
}

#define WS_PREP1 251703296ul
#define WS_EL (WS_WIN + 12582912ul)
__device__ __forceinline__ bfr* prep_base(const Params& p, int b, int h, int dir, int c) {
  return (bfr*)(p.ws + (b ? WS_PREP1 : WS_WIN)) + (long)((h * 2 + dir) * 64 + c) * 12288;
}

__device__ __forceinline__ void gla_chunk_prep(int tid, const float (&wd)[16], float bias, const bfr* Qr, const bfr* Kr,
                                               bfr* Qe, bfr* Ke, bfr* KlT, const float* RF, float* tot, float* lastv) {
  const int ch = tid & 63, part = tid >> 6;
  float cum[16];
  {
    float run = 0.f;
#pragma unroll
    for (int ii = 0; ii < 16; ii++) {
      int i = part * 16 + ii;
      float x = bias;
#pragma unroll
      for (int r = 0; r < 16; r++) x += RF[i * 16 + r] * wd[r];
      float la = (fminf(x, 0.f) - __logf(1.f + __expf(-fabsf(x)))) * (1.f / 16.f);
      run += la;
      cum[ii] = run;
    }
    tot[part * 64 + ch] = run;
  }
  __syncthreads();
  {
    float off = 0.f, last = 0.f;
#pragma unroll
    for (int pp = 0; pp < 4; pp++) {
      float tv = tot[pp * 64 + ch];
      if (pp < part) off += tv;
      last += tv;
    }
    if (part == 0) lastv[ch] = last;
#pragma unroll
    for (int ii = 0; ii < 16; ii++) {
      int i = part * 16 + ii;
      float cc = cum[ii] + off;
      float qv = bf2f(Qr[i * LDT + ch]), kv = bf2f(Kr[i * LDT + ch]);
      Qe[i * LDT + ch] = f2bf(qv * __expf(cc) * 0.125f);
      Ke[i * LDT + ch] = f2bf(kv * __expf(-cc));
      KlT[ch * LDT + i] = f2bf(kv * __expf(last - cc));
    }
  }
  __syncthreads();
}

__device__ __forceinline__ void gla_att(int wid, int g, int l15, const bfr* Qe, const bfr* Ke, bfr* Att) {
  f32x4 att[4];
  bf16x8 qa[2];
#pragma unroll
  for (int kk = 0; kk < 2; kk++) qa[kk] = *(const bf16x8*)(Qe + (16 * wid + l15) * LDT + kk * 32 + g * 8);
#pragma unroll
  for (int nj = 0; nj < 4; nj++) {
    att[nj] = (f32x4){0.f, 0.f, 0.f, 0.f};
#pragma unroll
    for (int kk = 0; kk < 2; kk++) {
      bf16x8 kb = *(const bf16x8*)(Ke + (16 * nj + l15) * LDT + kk * 32 + g * 8);
      att[nj] = mfma16(qa[kk], kb, att[nj]);
    }
  }
#pragma unroll
  for (int nj = 0; nj < 4; nj++)
#pragma unroll
    for (int r = 0; r < 4; r++) {
      int i = 16 * wid + 4 * g + r, j = 16 * nj + l15;
      Att[i * LDT + j] = f2bf(i >= j ? att[nj][r] : 0.f);
    }
}

__device__ __forceinline__ void gla_prep_item(const Params& p, int l, int b, int h, int dir, int c, bfr* sm) {
  const int tid = TIDX, lane = tid & 63, wid = tid >> 6, g = lane >> 4, l15 = lane & 15;
  const bfr* Z = (const bfr*)(p.ws + WS_Z);
  const int N = 4096;
  const int rowbase = NCTX + b * 4096;
  bfr* Qr = sm;
  bfr* Kr = Qr + 64 * LDT;
  bfr* Qe = Kr + 64 * LDT;
  bfr* Ke = Qe + 64 * LDT;
  bfr* KlT = Ke + 64 * LDT;
  float* RF = (float*)(KlT + 64 * LDT);
  float* tot = RF + 64 * 16;
  float* lastv = tot + 256;
  bfr* Att = Qr;
  const int ch = tid & 63;
  float wd[16];
  {
    const float* W = (dir ? p.in[19] : p.in[17]) + (long)l * 16 * 256 + h * 64 + ch;
#pragma unroll
    for (int r = 0; r < 16; r++) wd[r] = W[r * 256];
  }
  const float bias = (dir ? p.in[20] : p.in[18])[l * 256 + h * 64 + ch];
#pragma unroll
  for (int ii = 0; ii < 2; ii++) {
    int cc = tid + 256 * ii;
    int i = cc >> 3, c8 = cc & 7;
    int tok = dir ? (N - 1 - (c * 64 + i)) : (c * 64 + i);
    const bfr* zr = Z + (long)(rowbase + tok) * ZLD;
    *(u32x4*)(Qr + i * LDT + c8 * 8) = *(const u32x4*)(zr + C_QG + h * 64 + c8 * 8);
    *(u32x4*)(Kr + i * LDT + c8 * 8) = *(const u32x4*)(zr + C_KG + h * 64 + c8 * 8);
  }
  if (tid < 128) {
    int i = tid >> 1, hf = tid & 1;
    int tok = dir ? (N - 1 - (c * 64 + i)) : (c * 64 + i);
    u32x4 rr = *(const u32x4*)(Z + (long)(rowbase + tok) * ZLD + (dir ? C_RB : C_RF) + hf * 8);
    float x[8];
    unpack8(rr, x);
#pragma unroll
    for (int e = 0; e < 8; e++) RF[i * 16 + hf * 8 + e] = x[e];
  }
  __syncthreads();
  gla_chunk_prep(tid, wd, bias, Qr, Kr, Qe, Ke, KlT, RF, tot, lastv);
  gla_att(wid, g, l15, Qe, Ke, Att);
  __syncthreads();
  bfr* dst = prep_base(p, b, h, dir, c);
#pragma unroll
  for (int ii = 0; ii < 2; ii++) {
    int cc = tid + 256 * ii;
    int i = cc >> 3, c8 = cc & 7;
    *(u32x4*)(dst + i * 64 + c8 * 8) = *(const u32x4*)(Qe + i * LDT + c8 * 8);
    *(u32x4*)(dst + 4096 + i * 64 + c8 * 8) = *(const u32x4*)(KlT + i * LDT + c8 * 8);
    *(u32x4*)(dst + 8192 + i * 64 + c8 * 8) = *(const u32x4*)(Att + i * LDT + c8 * 8);
  }
  if (tid < 64) ((float*)(p.ws + WS_EL))[((long)(((b * 4 + h) * 2 + dir) * 64 + c)) * 64 + tid] = __expf(lastv[tid]);
  __syncthreads();
}

__device__ __forceinline__ void gla_chain_item(const Params& p, int l, int b, int h, int dir, int vh, bfr* sm) {
  const int tid = TIDX, lane = tid & 63, wid = tid >> 6, g = lane >> 4, l15 = lane & 15;
  const bfr* Z = (const bfr*)(p.ws + WS_Z);
  bfr* OG = (bfr*)(p.ws + WS_R1) + (long)dir * NROWS * 512;
  const float* EL = (const float*)(p.ws + WS_EL) + (long)(((b * 4 + h) * 2 + dir) * 64) * 64;
  const int N = 4096, nc = 64;
  const int rowbase = NCTX + b * 4096;
  const int vs0 = vh * 64;
  bfr* Vt = sm;
  bfr* St = Vt + 64 * LDT;
  f32x4 st[4];
  {
    const float* S0 = (dir ? p.in[7] : p.in[6]) + ((long)((b * 2 + l) * 4 + h)) * 8192 + (long)(16 * wid + l15) * 128 + vs0;
#pragma unroll
    for (int vt = 0; vt < 4; vt++) {
      float4 a = *(const float4*)(S0 + 16 * vt + 4 * g);
      st[vt] = (f32x4){a.x, a.y, a.z, a.w};
#pragma unroll
      for (int r = 0; r < 4; r++) St[(16 * vt + 4 * g + r) * LDT + 16 * wid + l15] = f2bf(st[vt][r]);
    }
  }
  u32x4 n_qe[2], n_kl[2], n_at[2], n_v[2];
  float n_el;
  auto prefetch = [&](int c) {
    const bfr* base = prep_base(p, b, h, dir, c) + (16 * wid + l15) * 64 + 8 * g;
#pragma unroll
    for (int kk = 0; kk < 2; kk++) {
      n_qe[kk] = *(const u32x4*)(base + kk * 32);
      n_kl[kk] = *(const u32x4*)(base + 4096 + kk * 32);
      n_at[kk] = *(const u32x4*)(base + 8192 + kk * 32);
    }
    n_el = EL[c * 64 + 16 * wid + l15];
#pragma unroll
    for (int ii = 0; ii < 2; ii++) {
      int cc = tid + 256 * ii;
      int i = cc >> 3, c8 = cc & 7;
      int tok = dir ? (N - 1 - (c * 64 + i)) : (c * 64 + i);
      n_v[ii] = *(const u32x4*)(Z + (long)(rowbase + tok) * ZLD + C_VG + h * 128 + vs0 + c8 * 8);
    }
  };
  prefetch(0);
  for (int c = 0; c < nc; c++) {
    u32x4 c_qe[2] = {n_qe[0], n_qe[1]}, c_kl[2] = {n_kl[0], n_kl[1]}, c_at[2] = {n_at[0], n_at[1]};
    const float el = n_el;
#pragma unroll
    for (int ii = 0; ii < 2; ii++) {
      int cc = tid + 256 * ii;
      int i = cc >> 3, c8 = cc & 7;
      const bfr* rb = (const bfr*)&n_v[ii];
#pragma unroll
      for (int e = 0; e < 8; e++) Vt[(c8 * 8 + e) * LDT + i] = rb[e];
    }
    __syncthreads();
    if (c + 1 < nc) prefetch(c + 1);
    f32x4 stn[4];
    const int i = 16 * wid + l15;
    const int tok = dir ? (N - 1 - (c * 64 + i)) : (c * 64 + i);
    bfr* og = OG + (long)(rowbase + tok) * 512 + h * 128 + vs0 + 4 * g;
#pragma unroll
    for (int vt = 0; vt < 4; vt++) {
      f32x4 oc = (f32x4){0.f, 0.f, 0.f, 0.f};
      stn[vt] = st[vt] * el;
#pragma unroll
      for (int kk = 0; kk < 2; kk++) {
        bf16x8 vf = *(const bf16x8*)(Vt + (16 * vt + l15) * LDT + kk * 32 + g * 8);
        bf16x8 sf = *(const bf16x8*)(St + (16 * vt + l15) * LDT + kk * 32 + g * 8);
        oc = mfma16(vf, *(bf16x8*)&c_at[kk], oc);
        oc = mfma16(sf, *(bf16x8*)&c_qe[kk], oc);
        stn[vt] = mfma16(vf, *(bf16x8*)&c_kl[kk], stn[vt]);
      }
      u32x2 ov;
      ov.x = pack2(oc[0], oc[1]);
      ov.y = pack2(oc[2], oc[3]);
      *(u32x2*)(og + 16 * vt) = ov;
    }
    __syncthreads();
#pragma unroll
    for (int vt = 0; vt < 4; vt++) {
      st[vt] = stn[vt];
#pragma unroll
      for (int r = 0; r < 4; r++) St[(16 * vt + 4 * g + r) * LDT + 16 * wid + l15] = f2bf(st[vt][r]);
    }
  }
  __syncthreads();
}

template <int VS>
__device__ __forceinline__ void gla_item(const Params& p, int l, int seq, int h, int dir, int vsl, bfr* sm) {
  constexpr int NVT = VS / 16;
  constexpr int NVL = VS / 32;
  const int tid = TIDX, lane = tid & 63, wid = tid >> 6, g = lane >> 4, l15 = lane & 15;
  bfr* Z = (bfr*)(p.ws + WS_Z);
  bfr* OG = (bfr*)(p.ws + WS_R1) + (long)dir * NROWS * 512;
  const bool lat = seq >= 16;
  const int b = seq - 16;
  const int N = lat ? 4096 : 256;
  const int rowbase = lat ? NCTX + b * 4096 : seq * 256;
  const int nc = N >> 6;
  const int vs0 = vsl * VS;
  bfr* Qr = sm;
  bfr* Kr = Qr + 64 * LDT;
  bfr* Qe = Kr + 64 * LDT;
  bfr* Ke = Qe + 64 * LDT;
  bfr* KlT = Ke + 64 * LDT;
  float* RF = (float*)(KlT + 64 * LDT);
  float* tot = RF + 64 * 16;
  float* lastv = tot + 256;
  bfr* Vt = (bfr*)(lastv + 64);
  bfr* St = Vt + VS * LDT;
  bfr* Att = Qr;
  const int ch = tid & 63;
  float wd[16];
  {
    const float* W = (dir ? p.in[19] : p.in[17]) + (long)l * 16 * 256 + h * 64 + ch;
#pragma unroll
    for (int r = 0; r < 16; r++) wd[r] = W[r * 256];
  }
  const float bias = (dir ? p.in[20] : p.in[18])[l * 256 + h * 64 + ch];

  f32x4 st[NVT];
  {
    const float* S0 = (dir ? p.in[7] : p.in[6]) + ((long)((b * 2 + l) * 4 + h)) * 8192 + (long)(16 * wid + l15) * 128 + vs0;
#pragma unroll
    for (int mv = 0; mv < NVT; mv++) {
      if (lat) {
        float4 a = *(const float4*)(S0 + 16 * mv + 4 * g);
        st[mv] = (f32x4){a.x, a.y, a.z, a.w};
      } else {
        st[mv] = (f32x4){0.f, 0.f, 0.f, 0.f};
      }
#pragma unroll
      for (int r = 0; r < 4; r++) St[(16 * mv + 4 * g + r) * LDT + 16 * wid + l15] = f2bf(st[mv][r]);
    }
  }
  u32x4 rq[2], rk[2], rv[NVL], rr;
  auto prefetch = [&](int c) {
#pragma unroll
    for (int ii = 0; ii < 2; ii++) {
      int cc = tid + 256 * ii;
      int i = cc >> 3, c8 = cc & 7;
      int tok = dir ? (N - 1 - (c * 64 + i)) : (c * 64 + i);
      const bfr* zr = Z + (long)(rowbase + tok) * ZLD;
      rq[ii] = *(const u32x4*)(zr + C_QG + h * 64 + c8 * 8);
      rk[ii] = *(const u32x4*)(zr + C_KG + h * 64 + c8 * 8);
    }
#pragma unroll
    for (int ii = 0; ii < NVL; ii++) {
      int cc = tid + 256 * ii;
      int i = cc / (VS / 8), c4 = cc % (VS / 8);
      int tok = dir ? (N - 1 - (c * 64 + i)) : (c * 64 + i);
      rv[ii] = *(const u32x4*)(Z + (long)(rowbase + tok) * ZLD + C_VG + h * 128 + vs0 + c4 * 8);
    }
    if (tid < 128) {
      int i = tid >> 1, hf = tid & 1;
      int tok = dir ? (N - 1 - (c * 64 + i)) : (c * 64 + i);
      rr = *(const u32x4*)(Z + (long)(rowbase + tok) * ZLD + (dir ? C_RB : C_RF) + hf * 8);
    }
  };
  prefetch(0);
  for (int c = 0; c < nc; c++) {
#pragma unroll
    for (int ii = 0; ii < 2; ii++) {
      int cc = tid + 256 * ii;
      *(u32x4*)(Qr + (cc >> 3) * LDT + (cc & 7) * 8) = rq[ii];
      *(u32x4*)(Kr + (cc >> 3) * LDT + (cc & 7) * 8) = rk[ii];
    }
#pragma unroll
    for (int ii = 0; ii < NVL; ii++) {
      int cc = tid + 256 * ii;
      int i = cc / (VS / 8), c4 = cc % (VS / 8);
      const bfr* rb = (const bfr*)&rv[ii];
#pragma unroll
      for (int e = 0; e < 8; e++) Vt[(c4 * 8 + e) * LDT + i] = rb[e];
    }
    if (tid < 128) {
      int i = tid >> 1, hf = tid & 1;
      float x[8];
      unpack8(rr, x);
#pragma unroll
      for (int e = 0; e < 8; e++) RF[i * 16 + hf * 8 + e] = x[e];
    }
    __syncthreads();
    if (c + 1 < nc) prefetch(c + 1);
    gla_chunk_prep(tid, wd, bias, Qr, Kr, Qe, Ke, KlT, RF, tot, lastv);
    f32x4 stn[NVT];
    {
      float el = __expf(lastv[16 * wid + l15]);
#pragma unroll
      for (int mv = 0; mv < NVT; mv++) {
        stn[mv] = st[mv] * el;
#pragma unroll
        for (int kk = 0; kk < 2; kk++) {
          bf16x8 va = *(const bf16x8*)(Vt + (16 * mv + l15) * LDT + kk * 32 + g * 8);
          bf16x8 kb = *(const bf16x8*)(KlT + (16 * wid + l15) * LDT + kk * 32 + g * 8);
          stn[mv] = mfma16(va, kb, stn[mv]);
        }
      }
      gla_att(wid, g, l15, Qe, Ke, Att);
    }
    __syncthreads();
    {
      bf16x8 aa[2], qa[2];
#pragma unroll
      for (int kk = 0; kk < 2; kk++) {
        aa[kk] = *(const bf16x8*)(Att + (16 * wid + l15) * LDT + kk * 32 + g * 8);
        qa[kk] = *(const bf16x8*)(Qe + (16 * wid + l15) * LDT + kk * 32 + g * 8);
      }
#pragma unroll
      for (int nv = 0; nv < NVT; nv++) {
        f32x4 oc = (f32x4){0.f, 0.f, 0.f, 0.f};
#pragma unroll
        for (int kk = 0; kk < 2; kk++) {
          bf16x8 vb = *(const bf16x8*)(Vt + (16 * nv + l15) * LDT + kk * 32 + g * 8);
          oc = mfma16(aa[kk], vb, oc);
          bf16x8 sb = *(const bf16x8*)(St + (16 * nv + l15) * LDT + kk * 32 + g * 8);
          oc = mfma16(qa[kk], sb, oc);
        }
#pragma unroll
        for (int r = 0; r < 4; r++) {
          int i = 16 * wid + 4 * g + r;
          int tok = dir ? (N - 1 - (c * 64 + i)) : (c * 64 + i);
          OG[(long)(rowbase + tok) * 512 + h * 128 + vs0 + 16 * nv + l15] = f2bf(oc[r]);
        }
      }
    }
    __syncthreads();
#pragma unroll
    for (int mv = 0; mv < NVT; mv++) {
      st[mv] = stn[mv];
#pragma unroll
      for (int r = 0; r < 4; r++) St[(16 * mv + 4 * g + r) * LDT + 16 * wid + l15] = f2bf(st[mv][r]);
    }
  }
  __syncthreads();
  if (!lat) {
    float* so = p.out + (dir ? O_SB : O_SF) + ((long)((seq * 2 + l) * 4 + h)) * 8192 + (long)(16 * wid + l15) * 128 + vs0;
#pragma unroll
    for (int mv = 0; mv < NVT; mv++)
      *(float4*)(so + 16 * mv + 4 * g) = make_float4(st[mv][0], st[mv][1], st[mv][2], st[mv][3]);
  }
}

__device__ __forceinline__ void phase_mla_up(const Params& p, int l, bfr* sm) {
  bfr* Z = (bfr*)(p.ws + WS_Z);
  const float* rope = (const float*)(p.ws + WS_ROPE);
  const int lane = TIDX & 63, wid = TIDX >> 6, wr = wid >> 1, wc = wid & 1;
  const int g = lane >> 4;
  for (int t = blockIdx.x; t < 288 + 624 + 1024; t += gridDim.x) {
    if (t >= 912) {
      int i = t - 912;
      gla_prep_item(p, l, i >> 9, (i >> 7) & 3, (i >> 6) & 1, i & 63, sm);
      continue;
    }
    f32x4 acc[4][4];
#pragma unroll
    for (int a = 0; a < 4; a++)
#pragma unroll
      for (int b = 0; b < 4; b++) acc[a][b] = (f32x4){0.f, 0.f, 0.f, 0.f};
    if (t < 288) {
      int tn = t % 3, tm = t / 3;
      gemm128k64<4, true>((const bfr*)(p.ws + WS_WUQ) + (long)tn * 128 * 256, 256, 128, Z + (long)tm * 128 * ZLD + C_QL, ZLD, 256,
                    acc, sm);
      bfr* CQ = (bfr*)(p.ws + WS_CQ);
      const float qs = 0.10206207261596577f * 1.4426950408889634f;
#pragma unroll
      for (int pi = 0; pi < 4; pi++) {
        int nb = tn * 128 + wr * 64 + pi * 16;
        int wb = nb % 96;
        bool ropet = wb >= 64;
        int part = (wb - 64) >> 4;
#pragma unroll
        for (int qi = 0; qi < 4; qi++) {
          int tok = tm * 128 + wc * 64 + qi * 16 + (lane & 15);
          float y[4] = {acc[pi][qi][0], acc[pi][qi][1], acc[pi][qi][2], acc[pi][qi][3]};
          if (ropet) {
            bool lat = tok >= NCTX;
            int tl = (tok - NCTX) & 4095;
            int pos = part ? (tl & 63) : (tl >> 6);
            bool hi = (g & 2) != 0;
            int i0 = (g & 1) * 4;
#pragma unroll
            for (int r = 0; r < 4; r++) {
              float yp = __shfl_xor(y[r], 32);
              float c = rope[2048 + pos * 8 + i0 + r], s = rope[2560 + pos * 8 + i0 + r];
              float yr = hi ? (yp * s + y[r] * c) : (y[r] * c - yp * s);
              y[r] = lat ? yr : y[r];
            }
          }
          u32x2 o;
          o.x = pack2(y[0] * qs, y[1] * qs);
          o.y = pack2(y[2] * qs, y[3] * qs);
          *(u32x2*)(CQ + (long)tok * 384 + nb + g * 4) = o;
        }
      }
    } else {
      int t2 = t - 288;
      int tn = t2 % 6, tm = t2 / 6;
      const bfr* Q;
      long ldq;
      long kbase, vbase;
      int nk, key0;
      if (tm < 32) {
        Q = Z + (long)tm * 128 * ZLD + C_KV;
        ldq = ZLD;
        int s = tm >> 1;
        key0 = (tm & 1) * 128;
        nk = 256;
        kbase = (long)s * (4 * 256 * 64);
        vbase = (long)s * 131072;
      } else {
        int r = (tm - 32) * 128;
        int b = r / 4608, within = r % 4608;
        key0 = within;
        nk = 4608;
        kbase = 16l * (4 * 256 * 64) + (long)b * (4 * 4608 * 64);
        vbase = 16l * 131072 + (long)b * (4 * 128 * 4608);
        if (within < 512) {
          Q = (const bfr*)(p.ws + WS_CKVC) + (long)(b * 512 + within) * 256;
          ldq = 256;
        } else {
          Q = Z + (long)(NCTX + b * 4096 + within - 512) * ZLD + C_KV;
          ldq = ZLD;
        }
      }
      gemm128k64<4, true>((const bfr*)(p.ws + WS_WUKV) + (long)tn * 128 * 256, 256, 128, Q, ldq, 256, acc, sm);
      bfr* KN = (bfr*)(p.ws + WS_KNOPE);
      bfr* VTC = (bfr*)(p.ws + WS_VTC);
#pragma unroll
      for (int pi = 0; pi < 4; pi++) {
        int n0 = tn * 128 + wr * 64 + pi * 16 + g * 4;
        int head = n0 / 192, w = n0 % 192;
#pragma unroll
        for (int qi = 0; qi < 4; qi++) {
          int key = key0 + wc * 64 + qi * 16 + (lane & 15);
          if (w < 64) {
            u32x2 o;
            o.x = pack2(acc[pi][qi][0], acc[pi][qi][1]);
            o.y = pack2(acc[pi][qi][2], acc[pi][qi][3]);
            *(u32x2*)(KN + kbase + ((long)head * nk + key) * 64 + w) = o;
          } else {
#pragma unroll
            for (int r = 0; r < 4; r++)
              VTC[vbase + ((long)head * 128 + (w - 64) + r) * nk + key] = f2bf(acc[pi][qi][r]);
          }
        }
      }
    }
  }
}

template <int DQ, int DV, bool MLA, int NQB>
__device__ __forceinline__ void attn_item(const Params& p, int seq, int head, int qoff, bfr* sm, int dry, int amode = 0) {
  constexpr int KLD = DQ + 8;
  constexpr int KSZ = 64 * KLD;
  constexpr int VSZ = DV * LDT;
  constexpr int BUF = KSZ + VSZ;
  constexpr int NKK = DQ / 32;
  constexpr int NDV = DV / 16;
  constexpr int NVL = DV / 32;
  const int tid = TIDX, lane = tid & 63, wid = tid >> 6, g = lane >> 4, l15 = lane & 15;
  bfr* Z = (bfr*)(p.ws + WS_Z);
  const bool lat = seq >= 16;
  const int b = seq - 16;
  const int nk = lat ? 4608 : 256;
  const int rowbase = lat ? NCTX + b * 4096 : seq * 256;
  const int nkt = nk >> 6;

  bf16x8 qf[NQB][NKK];
#pragma unroll
  for (int qb = 0; qb < NQB; qb++) {
    int qrow = rowbase + qoff + wid * (16 * NQB) + qb * 16 + l15;
    const bfr* qp = MLA ? ((const bfr*)(p.ws + WS_CQ) + (long)qrow * 384 + head * 96) : (Z + (long)qrow * ZLD + C_QA + head * 64);
#pragma unroll
    for (int kk = 0; kk < NKK; kk++) qf[qb][kk] = *(const bf16x8*)(qp + kk * 32 + g * 8);
  }

  u32x4 rk[2], rkr, rv[NVL];
  auto prefetch = [&](int kt) {
    int k0 = kt * 64;
    bool cache = lat && (k0 < 512);
    int tokrow0 = lat ? (NCTX + b * 4096 + k0 - 512) : (seq * 256 + k0);
    if (!MLA) {
      int kvh = head >> 2;
#pragma unroll
      for (int i = 0; i < 2; i++) {
        int c = tid + 256 * i;
        int kr_ = c >> 3, ch = c & 7;
        const bfr* src = cache ? ((const bfr*)(p.ws + WS_KCA) + (long)(b * 512 + k0 + kr_) * 128 + kvh * 64 + ch * 8)
                               : (Z + (long)(tokrow0 + kr_) * ZLD + C_KA + kvh * 64 + ch * 8);
        rk[i] = *(const u32x4*)src;
      }
      long vb = lat ? (16l * 32768 + (long)b * (2 * 64 * 4608)) : ((long)seq * 32768);
#pragma unroll
      for (int i = 0; i < NVL; i++) {
        int c = tid + 256 * i;
        int dv = c >> 3, ch = c & 7;
        rv[i] = *(const u32x4*)((const bfr*)(p.ws + WS_VTA) + vb + (long)(kvh * 64 + dv) * nk + k0 + ch * 8);
      }
    } else {
      long kb = lat ? (16l * (4 * 256 * 64) + (long)b * (4 * 4608 * 64)) : ((long)seq * (4 * 256 * 64));
#pragma unroll
      for (int i = 0; i < 2; i++) {
        int c = tid + 256 * i;
        int kr_ = c >> 3, ch = c & 7;
        rk[i] = *(const u32x4*)((const bfr*)(p.ws + WS_KNOPE) + kb + ((long)head * nk + k0 + kr_) * 64 + ch * 8);
      }
      {
        int kr_ = tid >> 2, ch = tid & 3;
        const bfr* src = cache ? ((const bfr*)(p.ws + WS_KRC) + (long)(b * 512 + k0 + kr_) * 32 + ch * 8)
                               : (Z + (long)(tokrow0 + kr_) * ZLD + C_KR + ch * 8);
        rkr = *(const u32x4*)src;
      }
      long vb = lat ? (16l * 131072 + (long)b * (4 * 128 * 4608)) : ((long)seq * 131072);
#pragma unroll
      for (int i = 0; i < NVL; i++) {
        int c = tid + 256 * i;
        int dv = c >> 3, ch = c & 7;
        rv[i] = *(const u32x4*)((const bfr*)(p.ws + WS_VTC) + vb + (long)(head * 128 + dv) * nk + k0 + ch * 8);
      }
    }
  };

  f32x4 o[NQB][NDV];
#pragma unroll
  for (int qb = 0; qb < NQB; qb++)
#pragma unroll
    for (int d = 0; d < NDV; d++) o[qb][d] = (f32x4){0.f, 0.f, 0.f, 0.f};
  float mrun[NQB];
  f32x4 lacc[NQB];
#pragma unroll
  for (int qb = 0; qb < NQB; qb++) { mrun[qb] = 0.f; lacc[qb] = (f32x4){0.f, 0.f, 0.f, 0.f}; }
  const bf16x8 ones = (bf16x8){(short)0x3F80, (short)0x3F80, (short)0x3F80, (short)0x3F80, (short)0x3F80, (short)0x3F80, (short)0x3F80, (short)0x3F80};

  prefetch(0);
  for (int kt = 0; kt < nkt; kt++) {
    bfr* Ks = sm + (kt & 1) * BUF;
    bfr* Vs = Ks + KSZ;
    if (amode != 1) {
#pragma unroll
    for (int i = 0; i < 2; i++) {
      int c = tid + 256 * i;
      *(u32x4*)(Ks + (c >> 3) * KLD + (c & 7) * 8) = rk[i];
    }
    if (MLA) *(u32x4*)(Ks + (tid >> 2) * KLD + 64 + (tid & 3) * 8) = rkr;
#pragma unroll
    for (int i = 0; i < NVL; i++) {
      int c = tid + 256 * i;
      *(u32x4*)(Vs + (c >> 3) * LDT + (c & 7) * 8) = rv[i];
    }
    }
    __syncthreads();
    if (kt + 1 < nkt && amode != 1) prefetch(kt + 1);
    if (amode == 2) continue;

    f32x4 s[NQB][4];
    bf16x8 kfr[4][NKK];
#pragma unroll
    for (int t = 0; t < 2; t++) {
      int krow = 32 * (t >> 1) + 8 * (l15 >> 2) + 4 * (t & 1) + (l15 & 3);
#pragma unroll
      for (int kk = 0; kk < NKK; kk++) kfr[t][kk] = *(const bf16x8*)(Ks + krow * KLD + kk * 32 + g * 8);
    }
#pragma unroll
    for (int t = 0; t < 4; t++) {
#pragma unroll
      for (int qb = 0; qb < NQB; qb++) s[qb][t] = (f32x4){-mrun[qb], -mrun[qb], -mrun[qb], -mrun[qb]};
      if (t + 2 < 4) {
        int krow = 32 * ((t + 2) >> 1) + 8 * (l15 >> 2) + 4 * ((t + 2) & 1) + (l15 & 3);
#pragma unroll
        for (int kk = 0; kk < NKK; kk++) kfr[t + 2][kk] = *(const bf16x8*)(Ks + krow * KLD + kk * 32 + g * 8);
      }
#pragma unroll
      for (int kk = 0; kk < NKK; kk++) {
#pragma unroll
        for (int qb = 0; qb < NQB; qb++) s[qb][t] = mfma16(kfr[t][kk], qf[qb][kk], s[qb][t]);
      }
    }
    bf16x8 vfr[4][2];
#pragma unroll
    for (int d = 0; d < 4; d++)
#pragma unroll
      for (int sx = 0; sx < 2; sx++) vfr[d][sx] = *(const bf16x8*)(Vs + (d * 16 + l15) * LDT + sx * 32 + g * 8);
    bf16x8 pf[NQB][2];
#pragma unroll
    for (int qb = 0; qb < NQB; qb++) {
      float mt = s[qb][0][0];
#pragma unroll
      for (int t = 0; t < 4; t++)
#pragma unroll
        for (int r = 0; r < 4; r++) mt = fmaxf(mt, s[qb][t][r]);
      const bool first = (kt == 0);
      if (first || __builtin_amdgcn_ballot_w64(mt > 8.f) != 0ull) {
        mt = fmaxf(mt, __shfl_xor(mt, 16));
        mt = fmaxf(mt, __shfl_xor(mt, 32));
        const bool need = first || mt > 8.f;
        const float dm = need ? mt : 0.f;
        const float alpha = first ? 1.f : __builtin_amdgcn_exp2f(-dm);
        mrun[qb] += dm;
        lacc[qb] *= alpha;
#pragma unroll
        for (int d = 0; d < NDV; d++) o[qb][d] *= alpha;
#pragma unroll
        for (int t = 0; t < 4; t++) s[qb][t] -= dm;
      }
#pragma unroll
      for (int t = 0; t < 4; t++)
#pragma unroll
        for (int r = 0; r < 4; r++) s[qb][t][r] = __builtin_amdgcn_exp2f(s[qb][t][r]);
#pragma unroll
      for (int sx = 0; sx < 2; sx++) {
        u32x4 u;
        u.x = pack2(s[qb][2 * sx][0], s[qb][2 * sx][1]);
        u.y = pack2(s[qb][2 * sx][2], s[qb][2 * sx][3]);
        u.z = pack2(s[qb][2 * sx + 1][0], s[qb][2 * sx + 1][1]);
        u.w = pack2(s[qb][2 * sx + 1][2], s[qb][2 * sx + 1][3]);
        pf[qb][sx] = *(bf16x8*)&u;
      }
    }
#pragma unroll
    for (int d = 0; d < NDV; d++) {
#pragma unroll
      for (int sx = 0; sx < 2; sx++) {
#pragma unroll
        for (int qb = 0; qb < NQB; qb++) o[qb][d] = mfma16(vfr[d & 3][sx], pf[qb][sx], o[qb][d]);
      }
      if (d + 4 < NDV) {
#pragma unroll
        for (int sx = 0; sx < 2; sx++)
          vfr[d & 3][sx] = *(const bf16x8*)(Vs + ((d + 4) * 16 + l15) * LDT + sx * 32 + g * 8);
      }
    }
#pragma unroll
    for (int sx = 0; sx < 2; sx++) {
#pragma unroll
      for (int qb = 0; qb < NQB; qb++) lacc[qb] = mfma16(ones, pf[qb][sx], lacc[qb]);
    }
  }
  __syncthreads();
#pragma unroll
  for (int qb = 0; qb < NQB; qb++) {
    float inv = 1.f / lacc[qb][0];
    int qrow = rowbase + qoff + wid * (16 * NQB) + qb * 16 + l15;
    bfr* gp = Z + (long)qrow * ZLD + (MLA ? C_GC : C_GA) + head * DV + g * 4;
#pragma unroll
    for (int d = 0; d < NDV; d++) {
      u32x2 gr = *(const u32x2*)(gp + d * 16);
      float y0 = o[qb][d][0] * inv * siluf(lo16(gr.x));
      float y1 = o[qb][d][1] * inv * siluf(hi16(gr.x));
      float y2 = o[qb][d][2] * inv * siluf(lo16(gr.y));
      float y3 = o[qb][d][3] * inv * siluf(hi16(gr.y));
      u32x2 ov;
      ov.x = pack2(y0, y1);
      ov.y = pack2(y2, y3);
      if (!dry) *(u32x2*)(gp + d * 16) = ov;
    }
  }
}

__device__ __forceinline__ void phase_mixers(const Params& p, int l, bfr* sm, int* s_item, int dry) {
  unsigned* ctr = (unsigned*)(p.ws + WS_CTR) + (2 + l + 2 * dry) * 128;
  auto cnt = [](int) { return 184; };
  int q = (int)xcc_id(), tried = 0;
  for (;;) {
    if (TIDX == 0) {
      unsigned first = atomicAdd(ctr + q * 16, 1u);
      *s_item = xq_take(ctr, q, tried, first, cnt);
    }
    __syncthreads();
    const int it = *s_item;
    __syncthreads();
    if (it < 0) break;
    const int x = it >> 20, j = it & 0xfffff;
    int kind, a0, a1, a2, a3 = 0;
    if (j < 4) {
      int idx = x * 4 + j;
      kind = 3; a0 = idx >> 4; a1 = (idx >> 2) & 3; a2 = (idx >> 1) & 1; a3 = idx & 1;
    } else if (j < 36) {
      kind = 1; a0 = 16 + (x >> 2); a1 = x & 3; a2 = (j - 4) * 128;
    } else if (j < 96) {
      int i = j - 36;
      kind = 2; a0 = 16 + (x >> 2); a1 = ((x >> 1) & 1) * 4 + (x & 1) * 2 + (i >> 5); a2 = (i & 31) * 128;
    } else if (j < 104) {
      int k = j - 96;
      int i = 60 + (k >> 1);
      kind = 4; a0 = 16 + (x >> 2); a1 = ((x >> 1) & 1) * 4 + (x & 1) * 2 + (i >> 5); a2 = (i & 31) * 128 + (k & 1) * 64;
    } else if (j < 136) {
      int i = j - 104;
      kind = 0; a0 = 2 * x + (i >> 4); a1 = (i >> 2) & 3; a2 = (i >> 1) & 1; a3 = i & 1;
    } else if (j < 152) {
      int i = j - 136;
      kind = 1; a0 = 2 * x + (i >> 3); a1 = (i >> 1) & 3; a2 = (i & 1) * 128;
    } else {
      int i = j - 152;
      kind = 2; a0 = 2 * x + (i >> 4); a1 = (i >> 1) & 7; a2 = (i & 1) * 128;
    }
#ifdef PROBE_MIXKIND
    if (dry && ((PROBE_MIXKIND == 1) != (kind == 0 || kind == 3))) continue;
#endif
    if (kind == 0) gla_item<64>(p, l, a0, a1, a2, a3, sm);
    else if (kind == 3) gla_chain_item(p, l, a0, a1, a2, a3, sm);
    else if (kind == 1) attn_item<96, 128, true, 2>(p, a0, a1, a2, sm, dry);
    else if (kind == 2) attn_item<64, 64, false, 2>(p, a0, a1, a2, sm, dry);
    else attn_item<64, 64, false, 1>(p, a0, a1, a2, sm, dry);
  }
}

__device__ __forceinline__ void phase_gla_out(const Params& p, int l) {
  const int lane = TIDX & 63;
  bfr* Z = (bfr*)(p.ws + WS_Z);
  const bfr* OF = (const bfr*)(p.ws + WS_R1);
  const bfr* OB = OF + (long)NROWS * 512;
  for (int row = blockIdx.x * 4 + (TIDX >> 6); row < NROWS; row += gridDim.x * 4) {
    float a[8], c[8], gt[8];
    unpack8(*(const u32x4*)(OF + (long)row * 512 + lane * 8), a);
    unpack8(*(const u32x4*)(OB + (long)row * 512 + lane * 8), c);
    bfr* gp = Z + (long)row * ZLD + C_GG + lane * 8;
    unpack8(*(const u32x4*)gp, gt);
    float ss = 0.f;
#pragma unroll
    for (int e = 0; e < 8; e++) {
      a[e] = bf2f(f2bf(a[e] + c[e]));
      ss += a[e] * a[e];
    }
    ss += __shfl_xor(ss, 1); ss += __shfl_xor(ss, 2); ss += __shfl_xor(ss, 4); ss += __shfl_xor(ss, 8);
    float rs = rsqrtf(ss * (1.f / 128.f) + 1e-6f);
    const float* gg = p.in[21] + l * 128 + (lane & 15) * 8;
#pragma unroll
    for (int e = 0; e < 8; e++) a[e] = a[e] * rs * gg[e] * siluf(gt[e]);
    *(u32x4*)gp = pack8(a);
  }
}

template <int NQ>
__device__ __forceinline__ void merge_tile(const Params& p, bfr* sm, int tn, int tok0) {
  constexpr int STG = 8192 + 2048 * NQ;
  bfr* Z = (bfr*)(p.ws + WS_Z);
  bfr* MG = (bfr*)(p.ws + WS_R1);
  const int tid = TIDX;
  const int lane = tid & 63, wid = tid >> 6, wr = wid >> 1, wc = wid & 1, g = lane >> 4, l15 = lane & 15;
  f32x4 totl[4][NQ];
#pragma unroll
  for (int a = 0; a < 4; a++)
#pragma unroll
    for (int b = 0; b < NQ; b++) totl[a][b] = (f32x4){0.f, 0.f, 0.f, 0.f};
#pragma unroll 1
  for (int seg = 0; seg < 3; seg++) {
    f32x4 acc[4][NQ];
#pragma unroll
    for (int a = 0; a < 4; a++)
#pragma unroll
      for (int b = 0; b < NQ; b++) acc[a][b] = (f32x4){0.f, 0.f, 0.f, 0.f};
    int ycol = seg == 0 ? C_GA : (seg == 1 ? C_GG : C_GC);
    int mcol = C_M1 + seg * 1024;
    const bfr* W = (const bfr*)(p.ws + WS_WOA + (unsigned long)seg * 1048576ul) + (long)tn * 128 * 512;
    gemm128k64<NQ, false, true>(W, 512, 128, Z + (long)tok0 * ZLD + ycol, ZLD, 512, acc, sm,
                                Z + (long)tok0 * ZLD + mcol + tn * 128, ZLD);
    const bfr* gt = sm;
#pragma unroll
    for (int pi = 0; pi < 4; pi++) {
      const int nl = wr * 64 + pi * 16 + g * 4;
#pragma unroll
      for (int qi = 0; qi < NQ; qi++) {
        const int tl = wc * 16 * NQ + qi * 16 + l15;
        u32x2 mr = *(const u32x2*)(gt + tl * 128 + (((nl >> 3) ^ (tl & 15)) * 8) + (nl & 4));
        totl[pi][qi][0] += sigmf(lo16(mr.x)) * acc[pi][qi][0];
        totl[pi][qi][1] += sigmf(hi16(mr.x)) * acc[pi][qi][1];
        totl[pi][qi][2] += sigmf(lo16(mr.y)) * acc[pi][qi][2];
        totl[pi][qi][3] += sigmf(hi16(mr.y)) * acc[pi][qi][3];
      }
    }
    __syncthreads();
  }
#pragma unroll
  for (int pi = 0; pi < 4; pi++)
#pragma unroll
    for (int qi = 0; qi < NQ; qi++) {
      u32x2 o;
      o.x = pack2(totl[pi][qi][0], totl[pi][qi][1]);
      o.y = pack2(totl[pi][qi][2], totl[pi][qi][3]);
      *(u32x2*)(sm + (wc * 16 * NQ + qi * 16 + l15) * 136 + wr * 64 + pi * 16 + g * 4) = o;
    }
  __syncthreads();
#pragma unroll
  for (int i = 0; i < 2 * NQ; i++) {
    int c = tid + 256 * i;
    int row = c >> 4, c16 = c & 15;
    *(u32x4*)(MG + (long)(tok0 + row) * 1024 + tn * 128 + c16 * 8) = *(const u32x4*)(sm + row * 136 + c16 * 8);
  }
  __syncthreads();
}

__device__ __forceinline__ void phase_merge(const Params& p, bfr* sm) {
  for (int t = blockIdx.x; t < 1024; t += gridDim.x) {
    if (t < 512) {
      merge_tile<4>(p, sm, t & 7, (t >> 3) * 128);
    } else {
      int u = t - 512;
      int full = 512 + (u >> 1);
      merge_tile<2>(p, sm, full & 7, (full >> 3) * 128 + (u & 1) * 64);
    }
  }
}

template <int NQ>
__device__ __forceinline__ void outproj_tile(const Params& p, bfr* sm, int tn, int tok0) {
  const bfr* MG = (const bfr*)(p.ws + WS_R1);
  float* OUT = (float*)(p.ws + WS_Z);
  const int tid = TIDX;
  const int lane = tid & 63, wid = tid >> 6, wr = wid >> 1, wc = wid & 1, g = lane >> 4, l15 = lane & 15;
  f32x4 acc[4][NQ];
#pragma unroll
  for (int a = 0; a < 4; a++)
#pragma unroll
    for (int b = 0; b < NQ; b++) acc[a][b] = (f32x4){0.f, 0.f, 0.f, 0.f};
  gemm128k64<NQ, true>((const bfr*)(p.ws + WS_WOUT) + (long)tn * 128 * 1024, 1024, 128, MG + (long)tok0 * 1024, 1024, 1024, acc, sm);
  float* smf = (float*)sm;
#pragma unroll
  for (int pi = 0; pi < 4; pi++)
#pragma unroll
    for (int qi = 0; qi < NQ; qi++)
      *(f32x4*)(smf + (wc * 16 * NQ + qi * 16 + l15) * 132 + wr * 64 + pi * 16 + g * 4) = acc[pi][qi];
  __syncthreads();
#pragma unroll
  for (int i = 0; i < 4 * NQ; i++) {
    int c = tid + 256 * i;
    int row = c >> 5, c16 = c & 31;
    *(f32x4*)(OUT + (long)(tok0 + row) * 1024 + tn * 128 + c16 * 4) = *(const f32x4*)(smf + row * 132 + c16 * 4);
  }
  __syncthreads();
}
__device__ __forceinline__ void phase_outproj(const Params& p, bfr* sm) {
  for (int t = blockIdx.x; t < 1024; t += gridDim.x) {
    if (t < 512) {
      outproj_tile<4>(p, sm, t & 7, (t >> 3) * 128);
    } else {
      int u = t - 512;
      int full = 512 + (u >> 1);
      outproj_tile<2>(p, sm, full & 7, (full >> 3) * 128 + (u & 1) * 64);
    }
  }
}

__device__ __forceinline__ void phase_post(const Params& p, int l) {
  const int lane = TIDX & 63;
  const float* mod = (const float*)(p.ws + WS_MOD);
  const float* OUT = (const float*)(p.ws + WS_Z);
  bfr* H = (bfr*)(p.ws + WS_R1);
  for (int row = blockIdx.x * 4 + (TIDX >> 6); row < NROWS; row += gridDim.x * 4) {
    const float* x = (l == 0) ? xrow(p, row) : (p.out + (long)row * 1024);
    const float* md = mod + (l * 3 + row_cond(row)) * 3072;
    float4 v[4];
    float ss = 0.f;
#pragma unroll
    for (int i = 0; i < 4; i++) {
      v[i] = *(const float4*)(OUT + (long)row * 1024 + i * 256 + lane * 4);
      ss += v[i].x * v[i].x + v[i].y * v[i].y + v[i].z * v[i].z + v[i].w * v[i].w;
    }
    ss = wave_sum(ss);
    float rs = rsqrtf(ss * (1.f / 1024.f) + 1e-6f);
    float ss2 = 0.f;
#pragma unroll
    for (int i = 0; i < 4; i++) {
      int n = i * 256 + lane * 4;
      float4 g = *(const float4*)(p.in[13] + l * 1024 + n);
      float4 gt = *(const float4*)(md + 2048 + n);
      float4 xv = *(const float4*)(x + n);
      v[i].x = xv.x + gt.x * (v[i].x * rs * g.x);
      v[i].y = xv.y + gt.y * (v[i].y * rs * g.y);
      v[i].z = xv.z + gt.z * (v[i].z * rs * g.z);
      v[i].w = xv.w + gt.w * (v[i].w * rs * g.w);
      *(float4*)(p.out + (long)row * 1024 + n) = v[i];
      ss2 += v[i].x * v[i].x + v[i].y * v[i].y + v[i].z * v[i].z + v[i].w * v[i].w;
    }
    if (l == 0) {
      ss2 = wave_sum(ss2);
      float rs2 = rsqrtf(ss2 * (1.f / 1024.f) + 1e-6f);
      const float* md1 = mod + (1 * 3 + row_cond(row)) * 3072;
#pragma unroll
      for (int i = 0; i < 4; i++) {
        int n = i * 256 + lane * 4;
        float4 g = *(const float4*)(p.in[12] + 1024 + n);
        float4 sh = *(const float4*)(md1 + n);
        float4 sc = *(const float4*)(md1 + 1024 + n);
        float h0 = v[i].x * rs2 * g.x * (1.f + sc.x) + sh.x;
        float h1 = v[i].y * rs2 * g.y * (1.f + sc.y) + sh.y;
        float h2 = v[i].z * rs2 * g.z * (1.f + sc.z) + sh.z;
        float h3 = v[i].w * rs2 * g.w * (1.f + sc.w) + sh.w;
        u32x2 o;
        o.x = pack2(h0, h1);
        o.y = pack2(h2, h3);
        *(u32x2*)(H + (long)row * 1024 + n) = o;
      }
    }
  }
}

__global__ void __launch_bounds__(256, 2) fwd_megakernel(Params p) {
  __shared__ __attribute__((aligned(16))) bfr sm[SMEM_SHORTS + 16];
  int* s_item_p = (int*)(sm + SMEM_SHORTS + 8);
  cg::grid_group grid = cg::this_grid();
  if (threadIdx.x == 0) { ((unsigned*)(sm + SMEM_SHORTS))[0] = 0u; ((unsigned*)(sm + SMEM_SHORTS))[1] = 0u; }
  __syncthreads();
  XcdBarrier xb = xcd_barrier_post((unsigned*)(p.ws + WS_BAR), (volatile LAS unsigned*)(sm + SMEM_SHORTS));
  if (p.ws == nullptr) grid.sync();
  (void)xb;
#define GSYNC1 do { XcdBarrier b_; b_.bar = (unsigned*)(p.ws + WS_BAR); b_.x = xb_xcc_id(); \
                    b_.st = (volatile LAS unsigned*)(sm + SMEM_SHORTS); xcd_barrier(b_); } while (0)
#ifdef PROBE_SYNC
#define GSYNC do { GSYNC1; GSYNC1; } while (0)
#else
#define GSYNC GSYNC1
#endif
#ifdef PROBE_PRE
  phase_s0(launder(p), sm);
  GSYNC;
  phase_s1(launder(p));
  wconv_phase(p, 0, sm);
  GSYNC;
  phase_prenorm0(launder(p));
  GSYNC;
#endif

#ifndef PH
#define PH 0xffff
#endif
#if PH & 1
  phase_s0(launder(p), sm);
#endif
  GSYNC;
#if PH & 2
  phase_s1(launder(p));
  wconv_phase(p, 0, sm);
#endif
  GSYNC;
#if PH & 4
  phase_prenorm0(launder(p));
#endif
  GSYNC;
  for (int l = 0; l < 2; l++) {
#if PH & 8
#ifdef PROBE_INPROJ
    phase_inproj(launder(p), l, sm, s_item_p, 6 + l);
    GSYNC;
#endif
    phase_inproj(launder(p), l, sm, s_item_p, l);
#endif
    GSYNC;
#if PH & 16
    phase_rowpost(launder(p), l);
#endif
    GSYNC;
#if PH & 32
#ifdef PROBE_MLAUP
    phase_mla_up(launder(p), l, sm);
    GSYNC;
#endif
    phase_mla_up(launder(p), l, sm);
#endif
    GSYNC;
#if PH & 64
#ifdef PROBE_MIX
    { int dry = 1; asm volatile("" : "+s"(dry)); phase_mixers(launder(p), l, sm, s_item_p, dry); }
    GSYNC;
#endif
    { int dry = 0; asm volatile("" : "+s"(dry)); phase_mixers(launder(p), l, sm, s_item_p, dry); }
#endif
    GSYNC;
#if PH & 128
    phase_gla_out(launder(p), l);
#endif
    GSYNC;
#if PH & 256
#ifdef PROBE_MERGE
    phase_merge(launder(p), sm);
    GSYNC;
#endif
    phase_merge(launder(p), sm);
#endif
    GSYNC;
#if PH & 512
#ifdef PROBE_MERGE
    phase_outproj(launder(p), sm);
    GSYNC;
#endif
    phase_outproj(launder(p), sm);
#endif
    GSYNC;
#if PH & 1024
    phase_post(launder(p), l);
    if (l == 0) wconv_phase(p, 1, sm);
#endif
    GSYNC;
  }
}

extern "C" void kernel_launch(void* const* d_in, const int* in_sizes, int n_in, void* d_out, int out_size, void* d_ws,
                              size_t ws_size, hipStream_t stream) {
  static int grid_blocks = 0;
  if (!grid_blocks) {
    int dev = 0, cus = 0, per_cu = 0;
    hipGetDevice(&dev);
    hipDeviceGetAttribute(&cus, hipDeviceAttributeMultiprocessorCount, dev);
    hipOccupancyMaxActiveBlocksPerMultiprocessor(&per_cu, fwd_megakernel, 256, 0);
    if (per_cu > 2) per_cu = 2;
    if (per_cu < 1) per_cu = 1;
    grid_blocks = cus * per_cu;
  }
  Params p{};
  for (int i = 0; i < 30; i++) p.in[i] = (const float*)d_in[i];
  p.out = (float*)d_out;
  p.ws = (unsigned char*)d_ws;
  hipMemsetAsync(d_ws, 0, 20480, stream);
  void* args[] = {&p};
  hipError_t e = hipLaunchCooperativeKernel((void*)fwd_megakernel, dim3(grid_blocks), dim3(256), args, 0, stream);
  if (e != hipSuccess) fprintf(stderr, "cooperative launch failed: %s (grid %d)\n", hipGetErrorString(e), grid_blocks);
}
```

```cpp
#include <hip/hip_runtime.h>
#include <hip/hip_cooperative_groups.h>
#include <cstdio>
namespace cg = cooperative_groups;

typedef unsigned short bfr;
typedef __attribute__((ext_vector_type(8))) short bf16x8;
typedef __attribute__((ext_vector_type(4))) float f32x4;
typedef __attribute__((ext_vector_type(4))) unsigned u32x4;
typedef __attribute__((ext_vector_type(2))) unsigned u32x2;

#define NROWS 12288
#define NCTX 4096
#define ZLD 6976
#define LDT 72
#define SMEM_SHORTS (4 * 128 * LDT)

#define C_QA 0
#define C_KA 512
#define C_VA 640
#define C_GA 768
#define C_QG 1280
#define C_KG 1536
#define C_VG 1792
#define C_GG 2304
#define C_RF 2816
#define C_RB 2832
#define C_QL 2848
#define C_KV 3104
#define C_KR 3360
#define C_GC 3392
#define C_M1 3904
#define C_M2 4928
#define C_M3 5952

#define WS_BAR 0ul
#define WS_CTR 16384ul
#define WS_MODP 20480ul
#define WS_MOD (WS_MODP + 589824ul)
#define WS_ROPE (WS_MOD + 73728ul)
#define WS_WIN (WS_ROPE + 16384ul)
#define WS_WUQ (WS_WIN + 14417920ul)
#define WS_WUKV (WS_WUQ + 196608ul)
#define WS_WOA (WS_WUKV + 393216ul)
#define WS_WOB (WS_WOA + 1048576ul)
#define WS_WOC (WS_WOB + 1048576ul)
#define WS_WOUT (WS_WOC + 1048576ul)
#define WS_KCA (WS_WOUT + 2097152ul)
#define WS_CKVC (WS_KCA + 262144ul)
#define WS_KRC (WS_CKVC + 524288ul)
#define WS_VTA (WS_KRC + 65536ul)
#define WS_CQ (WS_VTA + 3407872ul)
#define WS_KNOPE (WS_CQ + 9437184ul)
#define WS_VTC (WS_KNOPE + 6815744ul)
#define WS_R1 (WS_VTC + 13631488ul)
#define WS_Z (WS_R1 + 25165824ul)
#define WS_END (WS_Z + 171442176ul)

#define O_Y 0
#define O_GK 12582912
#define O_GV 13631488
#define O_CKV 14680064
#define O_KR 16777216
#define O_SF 17039360
#define O_SB 18087936

struct Params {
  const float* in[30];
  float* out;
  unsigned char* ws;
};

__device__ __forceinline__ int tidx() {
  int t = threadIdx.x;
  asm volatile("" : "+v"(t));
  return t;
}
__device__ __forceinline__ Params launder(const Params& p) {
  Params q;
  long zo = 0;
  asm volatile("" : "+s"(zo));
#pragma unroll
  for (int i = 0; i < 30; i++) q.in[i] = p.in[i] + zo;
  q.out = p.out + zo;
  q.ws = p.ws + zo;
  return q;
}
__device__ __forceinline__ float bf2f(bfr b) { return __uint_as_float(((unsigned)b) << 16); }
typedef float f32x2_t __attribute__((ext_vector_type(2)));
typedef __bf16 bf16x2_t __attribute__((ext_vector_type(2)));
__device__ __forceinline__ bfr f2bf(float f) {
  __bf16 r = (__bf16)f;
  return *(bfr*)&r;
}
__device__ __forceinline__ unsigned pack2(float a, float b) {
  f32x2_t v = {a, b};
  bf16x2_t r = __builtin_convertvector(v, bf16x2_t);
  return *(unsigned*)&r;
}
__device__ __forceinline__ float lo16(unsigned u) { return __uint_as_float(u << 16); }
__device__ __forceinline__ float hi16(unsigned u) { return __uint_as_float(u & 0xffff0000u); }
__device__ __forceinline__ float siluf(float x) { return x / (1.f + __expf(-x)); }
__device__ __forceinline__ float sigmf(float x) { return 1.f / (1.f + __expf(-x)); }
__device__ __forceinline__ f32x4 mfma16(bf16x8 a, bf16x8 b, f32x4 c) {
  return __builtin_amdgcn_mfma_f32_16x16x32_bf16(a, b, c, 0, 0, 0);
}
__device__ __forceinline__ const float* xrow(const Params& p, int row) {
  return row < NCTX ? p.in[0] + (long)row * 1024 : p.in[1] + (long)(row - NCTX) * 1024;
}
__device__ __forceinline__ int row_cond(int row) { return row < NCTX ? 0 : 1 + ((row - NCTX) >> 12); }
__device__ __forceinline__ float wave_sum(float v) {
  v += __shfl_xor(v, 1); v += __shfl_xor(v, 2); v += __shfl_xor(v, 4);
  v += __shfl_xor(v, 8); v += __shfl_xor(v, 16); v += __shfl_xor(v, 32);
  return v;
}

#define XB_TMO      128
#define XB_XCNT(j)  (256  + 64 * (j))
#define XB_XSUB(j)  (1280 + 64 * (j))
#define XB_XGEN(j)  (2304 + 64 * (j))
#define XB_TOP      3328
#define XB_TOPGEN   3392
#define XCD_BAR_WORDS 3456
#define XB_SPIN_CAP (1u << 18)
#define LAS __attribute__((address_space(3)))

__device__ __forceinline__ unsigned xb_ld(unsigned* p)              { return __hip_atomic_load(p, __ATOMIC_RELAXED, __HIP_MEMORY_SCOPE_AGENT); }
__device__ __forceinline__ unsigned xb_add(unsigned* p, unsigned v) { return __hip_atomic_fetch_add(p, v, __ATOMIC_RELAXED, __HIP_MEMORY_SCOPE_AGENT); }
__device__ __forceinline__ unsigned xb_xcc_id() { return (unsigned)__builtin_amdgcn_s_getreg((3 << 11) | 20) & 0xFu; }
#define XB_SPIN(cond, bar) do { unsigned _sp = 0; while (cond) { __builtin_amdgcn_s_sleep(1); \
    if ((++_sp & 255u) == 0u) { if (xb_ld(&(bar)[XB_TMO])) break; if (_sp > XB_SPIN_CAP) { atomicAdd(&(bar)[XB_TMO], 1u); break; } } } } while (0)

struct XcdBarrier {
    unsigned* bar; unsigned x;
    volatile LAS unsigned* st;
};

__device__ __forceinline__ XcdBarrier xcd_barrier_post(unsigned* bar, volatile LAS unsigned* st) {
    XcdBarrier b; b.bar = bar; b.x = xb_xcc_id(); b.st = st;
    if (threadIdx.x == 0) (void)xb_add(&bar[XB_XCNT(b.x)], 1u);
    return b;
}
__device__ __forceinline__ void xcd_barrier_complete(unsigned* bar, unsigned x, unsigned& nloc, unsigned& nx) {
    const unsigned G = gridDim.x * gridDim.y * gridDim.z;
    unsigned sum, cnt, mine, sp = 0u;
    for (;;) {
        sum = 0u; cnt = 0u; mine = 0u;
#pragma unroll
        for (unsigned j = 0; j < 16; ++j) { const unsigned c = xb_ld(&bar[XB_XCNT(j)]); sum += c; cnt += (c > 0u) ? 1u : 0u; mine = (j == x) ? c : mine; }
        if (sum == G) break;
        __builtin_amdgcn_s_sleep(1);
        if ((++sp & 255u) == 0u) { if (xb_ld(&bar[XB_TMO])) break; if (sp > XB_SPIN_CAP) { atomicAdd(&bar[XB_TMO], 1u); break; } }
    }
    nloc = mine > 0u ? mine : 1u; nx = cnt > 0u ? cnt : 1u;
}

__device__ __forceinline__ void xcd_barrier(const XcdBarrier& b) {
    asm volatile("s_waitcnt vmcnt(0)" ::: "memory");
    __syncthreads();
    if (threadIdx.x == 0) {
        unsigned* bar = b.bar;
        __builtin_amdgcn_s_waitcnt(0);
        unsigned nloc = b.st[0], nx = b.st[1];
        if (nloc == 0u) { xcd_barrier_complete(bar, b.x, nloc, nx); b.st[0] = nloc; b.st[1] = nx; }
        const unsigned old = xb_add(&bar[XB_XSUB(b.x)], 1u);
        const unsigned gen = old / nloc;
        if (old + 1u == (gen + 1u) * nloc) {
            __builtin_amdgcn_fence(__ATOMIC_RELEASE, "agent");
            asm volatile("s_waitcnt vmcnt(0)" ::: "memory");
            const unsigned og = xb_add(&bar[XB_TOP], 1u);
            const unsigned tg = og / nx;
            if (og + 1u == (tg + 1u) * nx) xb_add(&bar[XB_TOPGEN], 1u);
            else XB_SPIN(xb_ld(&bar[XB_TOPGEN]) == tg, bar);
            __builtin_amdgcn_fence(__ATOMIC_ACQUIRE, "agent");
            xb_add(&bar[XB_XGEN(b.x)], 1u);
            asm volatile("s_waitcnt vmcnt(0)" ::: "memory");
        } else {
            XB_SPIN(xb_ld(&bar[XB_XGEN(b.x)]) == gen, bar);
            __builtin_amdgcn_fence(__ATOMIC_ACQUIRE, "agent");
            asm volatile("s_waitcnt vmcnt(0)" ::: "memory");
        }
    }
    __syncthreads();
}


#define TIDX tidx()
#define LDS3 __attribute__((address_space(3)))
__device__ __forceinline__ void glds16(const bfr* g, bfr* l) {
  __builtin_amdgcn_global_load_lds((const unsigned*)g, (LDS3 unsigned*)l, 16, 0, 0);
}
__device__ __forceinline__ void gemm128(const bfr* __restrict__ P, long ldp, int pmax,
                                        const bfr* __restrict__ Q, long ldq, int qmax, int K,
                                        f32x4 (&acc)[4][4], bfr* sm) {
  const int tid = TIDX, lane = tid & 63, wid = tid >> 6;
  const int wr = wid >> 1, wc = wid & 1;
  const int l15 = lane & 15, g = lane >> 4;
  const bfr* pp[2];
  const bfr* qp[2];
  {
    const int r0 = tid >> 2;
    const int c = (tid & 3) ^ ((tid >> 4) & 3);
#pragma unroll
    for (int i = 0; i < 2; i++) {
      int r = r0 + 64 * i;
      pp[i] = P + (long)min(r, pmax - 1) * ldp + c * 8;
      qp[i] = Q + (long)min(r, qmax - 1) * ldq + c * 8;
    }
  }
  const int nk = K >> 5;
#define GEMM_ISSUE(T)                                                    \
  do {                                                                   \
    bfr* nb_ = sm + ((T) & 3) * 8192;                                    \
    glds16(pp[0] + (T) * 32, nb_ + tid * 8);                             \
    glds16(pp[1] + (T) * 32, nb_ + 2048 + tid * 8);                      \
    glds16(qp[0] + (T) * 32, nb_ + 4096 + tid * 8);                      \
    glds16(qp[1] + (T) * 32, nb_ + 6144 + tid * 8);                      \
  } while (0)
  GEMM_ISSUE(0);
  GEMM_ISSUE(1);
  GEMM_ISSUE(2);
  const int pos = (g ^ ((l15 >> 2) & 3)) * 8;
  for (int kt = 0; kt < nk; kt++) {
    if (kt + 2 < nk) asm volatile("s_waitcnt vmcnt(8)" ::: "memory");
    else if (kt + 1 < nk) asm volatile("s_waitcnt vmcnt(4)" ::: "memory");
    else asm volatile("s_waitcnt vmcnt(0)" ::: "memory");
    __builtin_amdgcn_s_barrier();
    if (kt + 3 < nk) GEMM_ISSUE(kt + 3);
    const bfr* Ps = sm + (kt & 3) * 8192;
    const bfr* Qs = Ps + 4096;
    bf16x8 pf[4], qf[4];
#pragma unroll
    for (int m = 0; m < 4; m++) {
      pf[m] = *(const bf16x8*)(Ps + (wr * 64 + m * 16 + l15) * 32 + pos);
      qf[m] = *(const bf16x8*)(Qs + (wc * 64 + m * 16 + l15) * 32 + pos);
    }
#pragma unroll
    for (int m = 0; m < 4; m++)
#pragma unroll
      for (int n = 0; n < 4; n++) acc[m][n] = mfma16(pf[m], qf[n], acc[m][n]);
  }
#undef GEMM_ISSUE
  __syncthreads();
}

template <int NQ>
__device__ __forceinline__ void gemm128q(const bfr* __restrict__ P, long ldp, const bfr* __restrict__ Q, long ldq, int K,
                                         f32x4 (&acc)[4][NQ], bfr* sm) {
  constexpr int QI = NQ / 2;
  constexpr int STG = 4096 + QI * 2048;
  const int tid = TIDX, lane = tid & 63, wid = tid >> 6;
  const int wr = wid >> 1, wc = wid & 1;
  const int l15 = lane & 15, g = lane >> 4;
  const bfr* pp[2];
  const bfr* qp[QI];
  {
    const int r0 = tid >> 2;
    const int c = (tid & 3) ^ (((tid >> 5) & 1) * 3);
#pragma unroll
    for (int i = 0; i < 2; i++) pp[i] = P + (long)(r0 + 64 * i) * ldp + c * 8;
#pragma unroll
    for (int i = 0; i < QI; i++) qp[i] = Q + (long)(r0 + 64 * i) * ldq + c * 8;
  }
  const int nk = K >> 5;
  auto issue = [&](int T) {
    bfr* nb_ = sm + (T & 3) * STG;
    glds16(pp[0] + T * 32, nb_ + tid * 8);
    glds16(pp[1] + T * 32, nb_ + 2048 + tid * 8);
#pragma unroll
    for (int i = 0; i < QI; i++) glds16(qp[i] + T * 32, nb_ + 4096 + i * 2048 + tid * 8);
  };
  issue(0);
  issue(1);
  issue(2);
  const int pos = (g ^ (((l15 >> 3) & 1) * 3)) * 8;
  for (int kt = 0; kt < nk; kt++) {
    if (kt + 2 < nk) {
      if (QI == 2) asm volatile("s_waitcnt vmcnt(8)" ::: "memory"); else asm volatile("s_waitcnt vmcnt(6)" ::: "memory");
    } else if (kt + 1 < nk) {
      if (QI == 2) asm volatile("s_waitcnt vmcnt(4)" ::: "memory"); else asm volatile("s_waitcnt vmcnt(3)" ::: "memory");
    } else {
      asm volatile("s_waitcnt vmcnt(0)" ::: "memory");
    }
    __builtin_amdgcn_s_barrier();
    if (kt + 3 < nk) issue(kt + 3);
    const bfr* Ps = sm + (kt & 3) * STG;
    const bfr* Qs = Ps + 4096;
    bf16x8 pf[4], qf[NQ];
#pragma unroll
    for (int m = 0; m < 4; m++) pf[m] = *(const bf16x8*)(Ps + (wr * 64 + m * 16 + l15) * 32 + pos);
#pragma unroll
    for (int n = 0; n < NQ; n++) qf[n] = *(const bf16x8*)(Qs + (wc * 16 * NQ + n * 16 + l15) * 32 + pos);
#pragma unroll
    for (int m = 0; m < 4; m++)
#pragma unroll
      for (int n = 0; n < NQ; n++) acc[m][n] = mfma16(pf[m], qf[n], acc[m][n]);
  }
  __syncthreads();
}

template <int NQ>
__device__ __forceinline__ void gemm256x128(const bfr* __restrict__ P, long ldp, int pmax,
                                            const bfr* __restrict__ Q, long ldq, int K,
                                            f32x4 (&acc)[8][NQ], bfr* sm) {
  constexpr int QI = NQ / 2;
  constexpr int STG = 8192 + QI * 2048;
  const int tid = TIDX, lane = tid & 63, wid = tid >> 6;
  const int wr = wid >> 1, wc = wid & 1;
  const int l15 = lane & 15, g = lane >> 4;
  const bfr* pp[4];
  const bfr* qp[QI];
  {
    const int r0 = tid >> 2;
    const int c = (tid & 3) ^ (((tid >> 5) & 1) * 3);
#pragma unroll
    for (int i = 0; i < 4; i++) pp[i] = P + (long)min(r0 + 64 * i, pmax - 1) * ldp + c * 8;
#pragma unroll
    for (int i = 0; i < QI; i++) qp[i] = Q + (long)(r0 + 64 * i) * ldq + c * 8;
  }
  const int nk = K >> 5;
  auto issue = [&](int T, int stg) {
    bfr* nb_ = sm + stg * STG;
    glds16(pp[0] + T * 32, nb_ + tid * 8);
    glds16(pp[1] + T * 32, nb_ + 2048 + tid * 8);
    glds16(pp[2] + T * 32, nb_ + 4096 + tid * 8);
    glds16(pp[3] + T * 32, nb_ + 6144 + tid * 8);
#pragma unroll
    for (int i = 0; i < QI; i++) glds16(qp[i] + T * 32, nb_ + 8192 + i * 2048 + tid * 8);
  };
  issue(0, 0);
  issue(1, 1);
  const int pos = (g ^ (((l15 >> 3) & 1) * 3)) * 8;
  int st = 0;
  for (int kt = 0; kt < nk; kt++) {
    if (kt + 1 < nk) {
      if (QI == 2) asm volatile("s_waitcnt vmcnt(6)" ::: "memory"); else asm volatile("s_waitcnt vmcnt(5)" ::: "memory");
    } else {
      asm volatile("s_waitcnt vmcnt(0)" ::: "memory");
    }
    __builtin_amdgcn_s_barrier();
    if (kt + 2 < nk) issue(kt + 2, st == 0 ? 2 : st - 1);
    const bfr* Ps = sm + st * STG;
    const bfr* Qs = Ps + 8192;
    st = (st == 2) ? 0 : st + 1;
    bf16x8 qf[NQ], pf[8];
#pragma unroll
    for (int n = 0; n < NQ; n++) qf[n] = *(const bf16x8*)(Qs + (wc * 16 * NQ + n * 16 + l15) * 32 + pos);
#pragma unroll
    for (int m = 0; m < 8; m++) pf[m] = *(const bf16x8*)(Ps + (wr * 128 + m * 16 + l15) * 32 + pos);
#pragma unroll
    for (int m = 0; m < 8; m++)
#pragma unroll
      for (int n = 0; n < NQ; n++) acc[m][n] = mfma16(pf[m], qf[n], acc[m][n]);
    __builtin_amdgcn_sched_group_barrier(0x100, NQ + 2, 0);
#pragma unroll
    for (int i = 0; i < 6; i++) {
      __builtin_amdgcn_sched_group_barrier(0x008, NQ, 0);
      __builtin_amdgcn_sched_group_barrier(0x100, 1, 0);
    }
    __builtin_amdgcn_sched_group_barrier(0x008, 2 * NQ, 0);
  }
  __syncthreads();
}

template <int NQ, bool PIPE, bool TAIL = false>
__device__ __forceinline__ void gemm128k64(const bfr* __restrict__ P, long ldp, int pmax,
                                           const bfr* __restrict__ Q, long ldq, int K,
                                           f32x4 (&acc)[4][NQ], bfr* sm, const bfr* tail_src = nullptr, long tail_ld = 0) {
  constexpr int STG = 8192 + 2048 * NQ;
  const int tid = TIDX, lane = tid & 63, wid = tid >> 6;
  const int wr = wid >> 1, wc = wid & 1;
  const int l15 = lane & 15, g = lane >> 4;
  const bfr* pp[4];
  const bfr* qp[NQ];
  {
    const int r0 = tid >> 3;
    const int c = (tid & 7) ^ ((tid >> 4) & 7);
#pragma unroll
    for (int i = 0; i < 4; i++) pp[i] = P + (long)min(r0 + 32 * i, pmax - 1) * ldp + c * 8;
#pragma unroll
    for (int i = 0; i < NQ; i++) qp[i] = Q + (long)(r0 + 32 * i) * ldq + c * 8;
  }
  const int nk = K >> 6;
#pragma unroll
  for (int i = 0; i < 4; i++) glds16(pp[i], sm + i * 2048 + tid * 8);
#pragma unroll
  for (int i = 0; i < NQ; i++) glds16(qp[i], sm + 8192 + i * 2048 + tid * 8);
  const int swz = l15 >> 1;
  for (int kt = 0; kt < nk; kt++) {
    asm volatile("s_waitcnt vmcnt(0)" ::: "memory");
    __builtin_amdgcn_s_barrier();
    if (kt + 1 < nk) {
      bfr* nb = sm + ((kt + 1) & 1) * STG;
#pragma unroll
      for (int i = 0; i < 4; i++) glds16(pp[i] + (kt + 1) * 64, nb + i * 2048 + tid * 8);
#pragma unroll
      for (int i = 0; i < NQ; i++) glds16(qp[i] + (kt + 1) * 64, nb + 8192 + i * 2048 + tid * 8);
    } else if (TAIL) {
      bfr* nb = sm + ((kt + 1) & 1) * STG;
      const bfr* ts = tail_src + (long)(tid >> 4) * tail_ld + (((tid & 15) ^ ((tid >> 4) & 15)) * 8);
#pragma unroll
      for (int i = 0; i < 2 * NQ; i++) glds16(ts + (long)(16 * i) * tail_ld, nb + i * 2048 + tid * 8);
    }
    const bfr* Ps = sm + (kt & 1) * STG;
    const bfr* Qs = Ps + 8192;
    if (PIPE) {
      bf16x8 pf[2][4], qf[2][NQ];
#pragma unroll
      for (int kk = 0; kk < 2; kk++) {
        const int pos = ((kk * 4 + g) ^ swz) * 8;
#pragma unroll
        for (int m = 0; m < 4; m++) pf[kk][m] = *(const bf16x8*)(Ps + (wr * 64 + m * 16 + l15) * 64 + pos);
#pragma unroll
        for (int n = 0; n < NQ; n++) qf[kk][n] = *(const bf16x8*)(Qs + (wc * 16 * NQ + n * 16 + l15) * 64 + pos);
      }
#pragma unroll
      for (int kk = 0; kk < 2; kk++)
#pragma unroll
        for (int m = 0; m < 4; m++)
#pragma unroll
          for (int n = 0; n < NQ; n++) acc[m][n] = mfma16(pf[kk][m], qf[kk][n], acc[m][n]);
      __builtin_amdgcn_sched_group_barrier(0x100, 4 + NQ, 0);
#pragma unroll
      for (int i = 0; i < 4 + NQ; i++) {
        __builtin_amdgcn_sched_group_barrier(0x008, NQ == 4 ? 2 : 1, 0);
        __builtin_amdgcn_sched_group_barrier(0x100, 1, 0);
      }
      __builtin_amdgcn_sched_group_barrier(0x008, NQ == 4 ? 16 : 10, 0);
    } else {
#pragma unroll
      for (int kk = 0; kk < 2; kk++) {
        bf16x8 pf[4], qf[NQ];
        const int pos = ((kk * 4 + g) ^ swz) * 8;
#pragma unroll
        for (int m = 0; m < 4; m++) pf[m] = *(const bf16x8*)(Ps + (wr * 64 + m * 16 + l15) * 64 + pos);
#pragma unroll
        for (int n = 0; n < NQ; n++) qf[n] = *(const bf16x8*)(Qs + (wc * 16 * NQ + n * 16 + l15) * 64 + pos);
#pragma unroll
        for (int m = 0; m < 4; m++)
#pragma unroll
          for (int n = 0; n < NQ; n++) acc[m][n] = mfma16(pf[m], qf[n], acc[m][n]);
      }
    }
  }
  if (TAIL) asm volatile("s_waitcnt vmcnt(0)" ::: "memory");
  __syncthreads();
}

__device__ __forceinline__ void gemm160x128(const bfr* __restrict__ P, long ldp, int pmax,
                                            const bfr* __restrict__ Q, long ldq, int K,
                                            f32x4 (&acc)[5][4], bfr* sm) {
  constexpr int STG = 160 * 64 + 128 * 64;
  const int tid = TIDX, lane = tid & 63, wid = tid >> 6;
  const int wr = wid >> 1, wc = wid & 1;
  const int l15 = lane & 15, g = lane >> 4;
  const bfr* pp[5];
  const bfr* qp[4];
  {
    const int r0 = tid >> 3;
    const int c = (tid & 7) ^ ((tid >> 4) & 7);
#pragma unroll
    for (int i = 0; i < 5; i++) pp[i] = P + (long)min(r0 + 32 * i, pmax - 1) * ldp + c * 8;
#pragma unroll
    for (int i = 0; i < 4; i++) qp[i] = Q + (long)(r0 + 32 * i) * ldq + c * 8;
  }
  const int nk = K >> 6;
#pragma unroll
  for (int i = 0; i < 5; i++) glds16(pp[i], sm + i * 2048 + tid * 8);
#pragma unroll
  for (int i = 0; i < 4; i++) glds16(qp[i], sm + 10240 + i * 2048 + tid * 8);
  const int swz = l15 >> 1;
  for (int kt = 0; kt < nk; kt++) {
    asm volatile("s_waitcnt vmcnt(0)" ::: "memory");
    __builtin_amdgcn_s_barrier();
    if (kt + 1 < nk) {
      bfr* nb = sm + ((kt + 1) & 1) * STG;
#pragma unroll
      for (int i = 0; i < 5; i++) glds16(pp[i] + (kt + 1) * 64, nb + i * 2048 + tid * 8);
#pragma unroll
      for (int i = 0; i < 4; i++) glds16(qp[i] + (kt + 1) * 64, nb + 10240 + i * 2048 + tid * 8);
    }
    const bfr* Ps = sm + (kt & 1) * STG;
    const bfr* Qs = Ps + 10240;
    bf16x8 pf[2][5], qf[2][4];
#pragma unroll
    for (int kk = 0; kk < 2; kk++) {
      const int pos = ((kk * 4 + g) ^ swz) * 8;
#pragma unroll
      for (int m = 0; m < 5; m++) pf[kk][m] = *(const bf16x8*)(Ps + (wr * 80 + m * 16 + l15) * 64 + pos);
#pragma unroll
      for (int n = 0; n < 4; n++) qf[kk][n] = *(const bf16x8*)(Qs + (wc * 64 + n * 16 + l15) * 64 + pos);
    }
#pragma unroll
    for (int kk = 0; kk < 2; kk++)
#pragma unroll
      for (int m = 0; m < 5; m++)
#pragma unroll
        for (int n = 0; n < 4; n++) acc[m][n] = mfma16(pf[kk][m], qf[kk][n], acc[m][n]);
    __builtin_amdgcn_sched_group_barrier(0x100, 9, 0);
#pragma unroll
    for (int i = 0; i < 9; i++) {
      __builtin_amdgcn_sched_group_barrier(0x008, 2, 0);
      __builtin_amdgcn_sched_group_barrier(0x100, 1, 0);
    }
    __builtin_amdgcn_sched_group_barrier(0x008, 22, 0);
  }
  __syncthreads();
}

__device__ __forceinline__ void phase_s0(const Params& p, bfr* sm) {
  const int tid = TIDX;
  float* rope = (float*)(p.ws + WS_ROPE);
  for (int idx = blockIdx.x * 256 + tid; idx < 1536; idx += gridDim.x * 256) {
    if (idx < 1024) {
      int pos = idx >> 4, i = idx & 15;
      float fr = powf(10000.f, -(float)i / 16.f);
      float a = (float)pos * fr;
      rope[idx] = cosf(a);
      rope[1024 + idx] = sinf(a);
    } else {
      int j = idx - 1024;
      int pos = j >> 3, i = j & 7;
      float fr = powf(10000.f, -(float)i / 8.f);
      float a = (float)pos * fr;
      rope[2048 + j] = cosf(a);
      rope[2560 + j] = sinf(a);
    }
  }
  float* smf = (float*)sm;
  float* modp = (float*)(p.ws + WS_MODP);
  for (int it = blockIdx.x; it < 768; it += gridDim.x) {
    int l = it / 384, rem = it % 384, cgp = rem >> 3, ks = rem & 7;
    int col = cgp * 64 + (tid & 63), kq = tid >> 6;
    const float* w = p.in[10] + (long)l * 1024 * 3072 + col;
    float a0 = 0.f, a1 = 0.f, a2 = 0.f;
    int k0 = ks * 128 + kq * 32;
#pragma unroll 8
    for (int k = k0; k < k0 + 32; k++) {
      float wv = w[(long)k * 3072];
      a0 += siluf(p.in[9][k]) * wv;
      a1 += siluf(p.in[8][k]) * wv;
      a2 += siluf(p.in[8][1024 + k]) * wv;
    }
    smf[(kq * 3 + 0) * 64 + (tid & 63)] = a0;
    smf[(kq * 3 + 1) * 64 + (tid & 63)] = a1;
    smf[(kq * 3 + 2) * 64 + (tid & 63)] = a2;
    __syncthreads();
    if (tid < 192) {
      int c = tid >> 6, cc = tid & 63;
      float s = smf[(0 * 3 + c) * 64 + cc] + smf[(1 * 3 + c) * 64 + cc] + smf[(2 * 3 + c) * 64 + cc] + smf[(3 * 3 + c) * 64 + cc];
      modp[((ks * 2 + l) * 3 + c) * 3072 + cgp * 64 + cc] = s;
    }
    __syncthreads();
  }
}

__device__ __forceinline__ void phase_s1(const Params& p) {
  float* modp = (float*)(p.ws + WS_MODP);
  float* mod = (float*)(p.ws + WS_MOD);
  for (int idx = blockIdx.x * 256 + TIDX; idx < 2 * 3 * 3072; idx += gridDim.x * 256) {
    int l = idx / 9216, n = idx % 3072;
    float s = p.in[11][l * 3072 + n];
#pragma unroll
    for (int ks = 0; ks < 8; ks++) s += modp[ks * 18432 + idx];
    mod[idx] = s;
  }
}

#define WCONV_ITEMS 2456
struct WcItem { const float* src; bfr* dst; int K, N, tk, tn; };
__device__ __forceinline__ WcItem wconv_decode(const Params& p, int l, int item) {
  WcItem w;
  if (item < 1744) {
    w.src = p.in[14] + (long)l * 1024 * 6976; w.K = 1024; w.N = 6976; w.dst = (bfr*)(p.ws + WS_WIN); w.tk = item & 15; w.tn = item >> 4;
  } else if (item < 1768) {
    item -= 1744;
    w.src = p.in[24] + (long)l * 256 * 384; w.K = 256; w.N = 384; w.dst = (bfr*)(p.ws + WS_WUQ); w.tk = item & 3; w.tn = item >> 2;
  } else if (item < 1816) {
    item -= 1768;
    w.src = p.in[25] + (long)l * 256 * 768; w.K = 256; w.N = 768; w.dst = (bfr*)(p.ws + WS_WUKV); w.tk = item & 3; w.tn = item >> 2;
  } else if (item < 2200) {
    item -= 1816;
    int ww = item >> 7, it = item & 127;
    w.src = (ww == 0 ? p.in[26] : (ww == 1 ? p.in[27] : p.in[28])) + (long)l * 512 * 1024;
    w.K = 512; w.N = 1024; w.dst = (bfr*)(p.ws + WS_WOA + (unsigned long)ww * 1048576ul); w.tk = it & 7; w.tn = it >> 3;
  } else {
    item -= 2200;
    w.src = p.in[29] + (long)l * 1024 * 1024; w.K = 1024; w.N = 1024; w.dst = (bfr*)(p.ws + WS_WOUT); w.tk = item & 15; w.tn = item >> 4;
  }
  return w;
}
__device__ __forceinline__ void wconv_phase(const Params& p, int l, bfr* sm) {
  bfr* sT = sm;
  const int tid = TIDX;
  const int n4 = (tid & 15) * 4, k0 = (tid >> 4) * 4;
  float4 v[4];
  int item = blockIdx.x;
  if (item < WCONV_ITEMS) {
    WcItem w = wconv_decode(p, l, item);
#pragma unroll
    for (int i = 0; i < 4; i++) v[i] = *(const float4*)(w.src + (long)(w.tk * 64 + k0 + i) * w.N + w.tn * 64 + n4);
  }
  const int wcol = (((k0 >> 3) ^ ((n4 >> 2) & 7)) * 8) + (k0 & 4);
  for (; item < WCONV_ITEMS; item += gridDim.x) {
    WcItem w = wconv_decode(p, l, item);
    {
      u32x2 o;
      o.x = pack2(v[0].x, v[1].x); o.y = pack2(v[2].x, v[3].x);
      *(u32x2*)(sT + (n4 + 0) * 64 + wcol) = o;
      o.x = pack2(v[0].y, v[1].y); o.y = pack2(v[2].y, v[3].y);
      *(u32x2*)(sT + (n4 + 1) * 64 + wcol) = o;
      o.x = pack2(v[0].z, v[1].z); o.y = pack2(v[2].z, v[3].z);
      *(u32x2*)(sT + (n4 + 2) * 64 + wcol) = o;
      o.x = pack2(v[0].w, v[1].w); o.y = pack2(v[2].w, v[3].w);
      *(u32x2*)(sT + (n4 + 3) * 64 + wcol) = o;
    }
    const int nitem = item + gridDim.x;
    if (nitem < WCONV_ITEMS) {
      WcItem wn = wconv_decode(p, l, nitem);
#pragma unroll
      for (int i = 0; i < 4; i++) v[i] = *(const float4*)(wn.src + (long)(wn.tk * 64 + k0 + i) * wn.N + wn.tn * 64 + n4);
    }
    __syncthreads();
#pragma unroll
    for (int i = 0; i < 2; i++) {
      int c = tid + 256 * i;
      int n = c >> 3, kc = c & 7;
      *(u32x4*)(w.dst + (long)(w.tn * 64 + n) * w.K + w.tk * 64 + kc * 8) = *(const u32x4*)(sT + n * 64 + ((kc ^ ((n >> 2) & 7)) * 8));
    }
    __syncthreads();
  }
}

__device__ __forceinline__ void phase_prenorm0(const Params& p) {
  const int lane = TIDX & 63;
  const float* mod = (const float*)(p.ws + WS_MOD);
  bfr* H = (bfr*)(p.ws + WS_R1);
  for (int row = blockIdx.x * 4 + (TIDX >> 6); row < NROWS; row += gridDim.x * 4) {
    const float* x = xrow(p, row);
    const float* md = mod + (0 * 3 + row_cond(row)) * 3072;
    float4 v[4];
    float ss = 0.f;
#pragma unroll
    for (int i = 0; i < 4; i++) {
      v[i] = *(const float4*)(x + i * 256 + lane * 4);
      ss += v[i].x * v[i].x + v[i].y * v[i].y + v[i].z * v[i].z + v[i].w * v[i].w;
    }
    ss = wave_sum(ss);
    float rs = rsqrtf(ss * (1.f / 1024.f) + 1e-6f);
#pragma unroll
    for (int i = 0; i < 4; i++) {
      int n = i * 256 + lane * 4;
      float4 g = *(const float4*)(p.in[12] + n);
      float4 sh = *(const float4*)(md + n);
      float4 sc = *(const float4*)(md + 1024 + n);
      float h0 = v[i].x * rs * g.x * (1.f + sc.x) + sh.x;
      float h1 = v[i].y * rs * g.y * (1.f + sc.y) + sh.y;
      float h2 = v[i].z * rs * g.z * (1.f + sc.z) + sh.z;
      float h3 = v[i].w * rs * g.w * (1.f + sc.w) + sh.w;
      u32x2 o;
      o.x = pack2(h0, h1);
      o.y = pack2(h2, h3);
      *(u32x2*)(H + (long)row * 1024 + n) = o;
    }
  }
}

__device__ __forceinline__ unsigned xcc_id() { return (unsigned)__builtin_amdgcn_s_getreg((3 << 11) | 20) & 7u; }
template <class CountF>
__device__ __forceinline__ int xq_take(unsigned* ctr, int& q, int& tried, unsigned first, CountF cnt) {
  unsigned j = first;
  for (;;) {
    if (j < (unsigned)cnt(q)) return (q << 20) | (int)j;
    q = (q + 1) & 7;
    if (++tried >= 8) return -1;
    j = atomicAdd(ctr + q * 16, 1u);
  }
}

__device__ __forceinline__ void phase_inproj(const Params& p, int l, bfr* sm, int* s_item, int slot) {
  const bfr* H = (const bfr*)(p.ws + WS_R1);
  const bfr* W = (const bfr*)(p.ws + WS_WIN);
  bfr* Z = (bfr*)(p.ws + WS_Z);
  const int tid = TIDX;
  const int lane = tid & 63, wid = tid >> 6, wr = wid >> 1, wc = wid & 1;
  unsigned* ctr = (unsigned*)(p.ws + WS_CTR) + slot * 128;
  auto cnt = [](int q) { return 96 * ((44 * (q + 1)) / 8 - (44 * q) / 8); };
  int q = (int)xcc_id(), tried = 0;
  unsigned nxt = 0;
  if (tid == 0) nxt = atomicAdd(ctr + q * 16, 1u);
  for (;;) {
    if (tid == 0) *s_item = xq_take(ctr, q, tried, nxt, cnt);
    __syncthreads();
    const int it = *s_item;
    __syncthreads();
    if (it < 0) break;
    const int qq = it >> 20, j = it & 0xfffff;
    if (tid == 0) nxt = atomicAdd(ctr + q * 16, 1u);
    const int tn0 = (44 * qq) / 8, w = (44 * (qq + 1)) / 8 - tn0;
    const int tm = j / w, tn = tn0 + j % w;
    f32x4 acc[5][4];
#pragma unroll
    for (int a = 0; a < 5; a++)
#pragma unroll
      for (int b = 0; b < 4; b++) acc[a][b] = (f32x4){0.f, 0.f, 0.f, 0.f};
    gemm160x128(W + (long)tn * 160 * 1024, 1024, ZLD - tn * 160, H + (long)tm * 128 * 1024, 1024, 1024, acc, sm);
    {
      const int g = lane >> 4, l15 = lane & 15;
#pragma unroll
      for (int pi = 0; pi < 5; pi++)
#pragma unroll
        for (int qi = 0; qi < 4; qi++) {
          u32x2 o;
          o.x = pack2(acc[pi][qi][0], acc[pi][qi][1]);
          o.y = pack2(acc[pi][qi][2], acc[pi][qi][3]);
          *(u32x2*)(sm + (wc * 64 + qi * 16 + l15) * 168 + wr * 80 + pi * 16 + g * 4) = o;
        }
      __syncthreads();
      const int ncol = min(20, (ZLD - tn * 160) >> 3);
#pragma unroll
      for (int i = 0; i < 10; i++) {
        int c = tid + 256 * i;
        int row = c / 20, c16 = c % 20;
        if (c16 < ncol)
          *(u32x4*)(Z + (long)(tm * 128 + row) * ZLD + tn * 160 + c16 * 8) = *(const u32x4*)(sm + row * 168 + c16 * 8);
      }
      __syncthreads();
    }
  }
}

__device__ __forceinline__ void unpack8(u32x4 v, float* x) {
  x[0] = lo16(v.x); x[1] = hi16(v.x); x[2] = lo16(v.y); x[3] = hi16(v.y);
  x[4] = lo16(v.z); x[5] = hi16(v.z); x[6] = lo16(v.w); x[7] = hi16(v.w);
}
__device__ __forceinline__ u32x4 pack8(const float* y) {
  u32x4 o;
  o.x = pack2(y[0], y[1]); o.y = pack2(y[2], y[3]); o.z = pack2(y[4], y[5]); o.w = pack2(y[6], y[7]);
  return o;
}

__device__ __forceinline__ void phase_rowpost(const Params& p, int l) {
  const int lane = TIDX & 63;
  bfr* Z = (bfr*)(p.ws + WS_Z);
  const float* rope = (const float*)(p.ws + WS_ROPE);
  bfr* VTA = (bfr*)(p.ws + WS_VTA);
  bfr* KCA = (bfr*)(p.ws + WS_KCA);
  bfr* CKVC = (bfr*)(p.ws + WS_CKVC);
  bfr* KRC = (bfr*)(p.ws + WS_KRC);
  float* out = p.out;
  for (int row = blockIdx.x * 4 + (TIDX >> 6); row < NROWS + 1024; row += gridDim.x * 4) {
    if (row < NROWS) {
      const bool lat = row >= NCTX;
      const int bc = row >> 8, tc = row & 255;
      const int bl = (row - NCTX) >> 12, tl = (row - NCTX) & 4095;
      const int prow = tl >> 6, pcol = tl & 63;
      bfr* z = Z + (long)row * ZLD;
      {
        float x[8];
        unpack8(*(const u32x4*)(z + C_QA + lane * 8), x);
        float ss = 0.f;
#pragma unroll
        for (int e = 0; e < 8; e++) ss += x[e] * x[e];
        ss += __shfl_xor(ss, 1); ss += __shfl_xor(ss, 2); ss += __shfl_xor(ss, 4);
        float rs = rsqrtf(ss * (1.f / 64.f) + 1e-6f);
        int sub = lane & 7;
        const float* g = p.in[15] + l * 64 + sub * 8;
#pragma unroll
        for (int e = 0; e < 8; e++) x[e] = x[e] * rs * g[e];
        if (lat) {
          int pos = (sub >> 2) ? pcol : prow;
          bool hi = (sub & 2) != 0;
          int i0 = (sub & 1) * 8;
#pragma unroll
          for (int e = 0; e < 8; e++) {
            float yp = __shfl_xor(x[e], 2);
            float c = rope[pos * 16 + i0 + e], s = rope[1024 + pos * 16 + i0 + e];
            x[e] = hi ? (yp * s + x[e] * c) : (x[e] * c - yp * s);
          }
        }
        const float qs = 0.125f * 1.4426950408889634f;
#pragma unroll
        for (int e = 0; e < 8; e++) x[e] *= qs;
        *(u32x4*)(z + C_QA + lane * 8) = pack8(x);
      }
      {
        int L = lane & 15;
        float x[8];
        unpack8(*(const u32x4*)(z + C_KA + L * 8), x);
        float ss = 0.f;
#pragma unroll
        for (int e = 0; e < 8; e++) ss += x[e] * x[e];
        ss += __shfl_xor(ss, 1); ss += __shfl_xor(ss, 2); ss += __shfl_xor(ss, 4);
        float rs = rsqrtf(ss * (1.f / 64.f) + 1e-6f);
        int sub = L & 7;
        const float* g = p.in[16] + l * 64 + sub * 8;
#pragma unroll
        for (int e = 0; e < 8; e++) x[e] = x[e] * rs * g[e];
        if (lat) {
          int pos = (sub >> 2) ? pcol : prow;
          bool hi = (sub & 2) != 0;
          int i0 = (sub & 1) * 8;
#pragma unroll
          for (int e = 0; e < 8; e++) {
            float yp = __shfl_xor(x[e], 2);
            float c = rope[pos * 16 + i0 + e], s = rope[1024 + pos * 16 + i0 + e];
            x[e] = hi ? (yp * s + x[e] * c) : (x[e] * c - yp * s);
          }
        } else if (lane < 16) {
          float* o = out + O_GK + ((long)(bc * 2 + l) * 256 + tc) * 128 + L * 8;
          *(float4*)(o) = make_float4(x[0], x[1], x[2], x[3]);
          *(float4*)(o + 4) = make_float4(x[4], x[5], x[6], x[7]);
        }
        if (lane < 16) *(u32x4*)(z + C_KA + L * 8) = pack8(x);
      }
      if (lane < 16) {
        int L = lane;
        u32x4 raw = *(const u32x4*)(z + C_VA + L * 8);
        float x[8];
        unpack8(raw, x);
        if (!lat) {
          float* o = out + O_GV + ((long)(bc * 2 + l) * 256 + tc) * 128 + L * 8;
          *(float4*)(o) = make_float4(x[0], x[1], x[2], x[3]);
          *(float4*)(o + 4) = make_float4(x[4], x[5], x[6], x[7]);
        }
        int g = L >> 3, d0 = (L & 7) * 8;
        long base; int nk, key;
        if (!lat) { base = (long)bc * 32768; nk = 256; key = tc; }
        else { base = 16l * 32768 + (long)bl * (2 * 64 * 4608); nk = 4608; key = 512 + tl; }
        const bfr* rb = (const bfr*)&raw;
#pragma unroll
        for (int e = 0; e < 8; e++) VTA[base + (long)(g * 64 + d0 + e) * nk + key] = rb[e];
      }
      {
        u32x2 rq = *(const u32x2*)(z + C_QL + lane * 4);
        u32x2 rk = *(const u32x2*)(z + C_KV + lane * 4);
        float q[4] = {lo16(rq.x), hi16(rq.x), lo16(rq.y), hi16(rq.y)};
        float k[4] = {lo16(rk.x), hi16(rk.x), lo16(rk.y), hi16(rk.y)};
        float sq = q[0] * q[0] + q[1] * q[1] + q[2] * q[2] + q[3] * q[3];
        float sk = k[0] * k[0] + k[1] * k[1] + k[2] * k[2] + k[3] * k[3];
        sq = wave_sum(sq);
        sk = wave_sum(sk);
        float rq_ = rsqrtf(sq * (1.f / 256.f) + 1e-6f), rk_ = rsqrtf(sk * (1.f / 256.f) + 1e-6f);
        float4 gq = *(const float4*)(p.in[22] + l * 256 + lane * 4);
        float4 gk = *(const float4*)(p.in[23] + l * 256 + lane * 4);
        q[0] *= rq_ * gq.x; q[1] *= rq_ * gq.y; q[2] *= rq_ * gq.z; q[3] *= rq_ * gq.w;
        k[0] *= rk_ * gk.x; k[1] *= rk_ * gk.y; k[2] *= rk_ * gk.z; k[3] *= rk_ * gk.w;
        u32x2 o;
        o.x = pack2(q[0], q[1]); o.y = pack2(q[2], q[3]);
        *(u32x2*)(z + C_QL + lane * 4) = o;
        o.x = pack2(k[0], k[1]); o.y = pack2(k[2], k[3]);
        *(u32x2*)(z + C_KV + lane * 4) = o;
        if (!lat) *(float4*)(out + O_CKV + ((long)(bc * 2 + l) * 256 + tc) * 256 + lane * 4) = make_float4(k[0], k[1], k[2], k[3]);
      }
      {
        int L = lane & 3;
        float x[8];
        unpack8(*(const u32x4*)(z + C_KR + L * 8), x);
        if (lat) {
          int pos = (L >> 1) ? pcol : prow;
          bool hi = (L & 1) != 0;
#pragma unroll
          for (int e = 0; e < 8; e++) {
            float yp = __shfl_xor(x[e], 1);
            float c = rope[2048 + pos * 8 + e], s = rope[2560 + pos * 8 + e];
            x[e] = hi ? (yp * s + x[e] * c) : (x[e] * c - yp * s);
          }
          if (lane < 4) *(u32x4*)(z + C_KR + L * 8) = pack8(x);
        } else if (lane < 4) {
          float* o = out + O_KR + ((long)(bc * 2 + l) * 256 + tc) * 32 + L * 8;
          *(float4*)(o) = make_float4(x[0], x[1], x[2], x[3]);
          *(float4*)(o + 4) = make_float4(x[4], x[5], x[6], x[7]);
        }
      }
    } else {
      int cr = row - NROWS;
      int b = cr >> 9, t = cr & 511;
      long src = (long)(b * 2 + l) * 512 + t;
      {
        float2 kv = *(const float2*)(p.in[2] + src * 128 + lane * 2);
        *(unsigned*)(KCA + (long)(b * 512 + t) * 128 + lane * 2) = pack2(kv.x, kv.y);
        float2 vv = *(const float2*)(p.in[3] + src * 128 + lane * 2);
        int c0 = lane * 2;
        long base = 16l * 32768 + (long)b * (2 * 64 * 4608);
        VTA[base + (long)c0 * 4608 + t] = f2bf(vv.x);
        VTA[base + (long)(c0 + 1) * 4608 + t] = f2bf(vv.y);
        float4 cv = *(const float4*)(p.in[4] + src * 256 + lane * 4);
        u32x2 o;
        o.x = pack2(cv.x, cv.y); o.y = pack2(cv.z, cv.w);
        *(u32x2*)(CKVC + (long)(b * 512 + t) * 256 + lane * 4) = o;
        if (lane < 32) KRC[(long)(b * 512 + t) * 32 + lane] = f2bf(p.in[5][src * 32 + lane]);
      }
    }
  }
}

#define WS_PREP1 251703296ul
#define WS_EL (WS_WIN + 12582912ul)
__device__ __forceinline__ bfr* prep_base(const Params& p, int b, int h, int dir, int c) {
  return (bfr*)(p.ws + (b ? WS_PREP1 : WS_WIN)) + (long)((h * 2 + dir) * 64 + c) * 12288;
}

__device__ __forceinline__ void gla_chunk_prep(int tid, const float (&wd)[16], float bias, const bfr* Qr, const bfr* Kr,
                                               bfr* Qe, bfr* Ke, bfr* KlT, const float* RF, float* tot, float* lastv) {
  const int ch = tid & 63, part = tid >> 6;
  float cum[16];
  {
    float run = 0.f;
#pragma unroll
    for (int ii = 0; ii < 16; ii++) {
      int i = part * 16 + ii;
      float x = bias;
#pragma unroll
      for (int r = 0; r < 16; r++) x += RF[i * 16 + r] * wd[r];
      float la = (fminf(x, 0.f) - __logf(1.f + __expf(-fabsf(x)))) * (1.f / 16.f);
      run += la;
      cum[ii] = run;
    }
    tot[part * 64 + ch] = run;
  }
  __syncthreads();
  {
    float off = 0.f, last = 0.f;
#pragma unroll
    for (int pp = 0; pp < 4; pp++) {
      float tv = tot[pp * 64 + ch];
      if (pp < part) off += tv;
      last += tv;
    }
    if (part == 0) lastv[ch] = last;
#pragma unroll
    for (int ii = 0; ii < 16; ii++) {
      int i = part * 16 + ii;
      float cc = cum[ii] + off;
      float qv = bf2f(Qr[i * LDT + ch]), kv = bf2f(Kr[i * LDT + ch]);
      Qe[i * LDT + ch] = f2bf(qv * __expf(cc) * 0.125f);
      Ke[i * LDT + ch] = f2bf(kv * __expf(-cc));
      KlT[ch * LDT + i] = f2bf(kv * __expf(last - cc));
    }
  }
  __syncthreads();
}

__device__ __forceinline__ void gla_att(int wid, int g, int l15, const bfr* Qe, const bfr* Ke, bfr* Att) {
  f32x4 att[4];
  bf16x8 qa[2];
#pragma unroll
  for (int kk = 0; kk < 2; kk++) qa[kk] = *(const bf16x8*)(Qe + (16 * wid + l15) * LDT + kk * 32 + g * 8);
#pragma unroll
  for (int nj = 0; nj < 4; nj++) {
    att[nj] = (f32x4){0.f, 0.f, 0.f, 0.f};
#pragma unroll
    for (int kk = 0; kk < 2; kk++) {
      bf16x8 kb = *(const bf16x8*)(Ke + (16 * nj + l15) * LDT + kk * 32 + g * 8);
      att[nj] = mfma16(qa[kk], kb, att[nj]);
    }
  }
#pragma unroll
  for (int nj = 0; nj < 4; nj++)
#pragma unroll
    for (int r = 0; r < 4; r++) {
      int i = 16 * wid + 4 * g + r, j = 16 * nj + l15;
      Att[i * LDT + j] = f2bf(i >= j ? att[nj][r] : 0.f);
    }
}

__device__ __forceinline__ void gla_prep_item(const Params& p, int l, int b, int h, int dir, int c, bfr* sm) {
  const int tid = TIDX, lane = tid & 63, wid = tid >> 6, g = lane >> 4, l15 = lane & 15;
  const bfr* Z = (const bfr*)(p.ws + WS_Z);
  const int N = 4096;
  const int rowbase = NCTX + b * 4096;
  bfr* Qr = sm;
  bfr* Kr = Qr + 64 * LDT;
  bfr* Qe = Kr + 64 * LDT;
  bfr* Ke = Qe + 64 * LDT;
  bfr* KlT = Ke + 64 * LDT;
  float* RF = (float*)(KlT + 64 * LDT);
  float* tot = RF + 64 * 16;
  float* lastv = tot + 256;
  bfr* Att = Qr;
  const int ch = tid & 63;
  float wd[16];
  {
    const float* W = (dir ? p.in[19] : p.in[17]) + (long)l * 16 * 256 + h * 64 + ch;
#pragma unroll
    for (int r = 0; r < 16; r++) wd[r] = W[r * 256];
  }
  const float bias = (dir ? p.in[20] : p.in[18])[l * 256 + h * 64 + ch];
#pragma unroll
  for (int ii = 0; ii < 2; ii++) {
    int cc = tid + 256 * ii;
    int i = cc >> 3, c8 = cc & 7;
    int tok = dir ? (N - 1 - (c * 64 + i)) : (c * 64 + i);
    const bfr* zr = Z + (long)(rowbase + tok) * ZLD;
    *(u32x4*)(Qr + i * LDT + c8 * 8) = *(const u32x4*)(zr + C_QG + h * 64 + c8 * 8);
    *(u32x4*)(Kr + i * LDT + c8 * 8) = *(const u32x4*)(zr + C_KG + h * 64 + c8 * 8);
  }
  if (tid < 128) {
    int i = tid >> 1, hf = tid & 1;
    int tok = dir ? (N - 1 - (c * 64 + i)) : (c * 64 + i);
    u32x4 rr = *(const u32x4*)(Z + (long)(rowbase + tok) * ZLD + (dir ? C_RB : C_RF) + hf * 8);
    float x[8];
    unpack8(rr, x);
#pragma unroll
    for (int e = 0; e < 8; e++) RF[i * 16 + hf * 8 + e] = x[e];
  }
  __syncthreads();
  gla_chunk_prep(tid, wd, bias, Qr, Kr, Qe, Ke, KlT, RF, tot, lastv);
  gla_att(wid, g, l15, Qe, Ke, Att);
  __syncthreads();
  bfr* dst = prep_base(p, b, h, dir, c);
#pragma unroll
  for (int ii = 0; ii < 2; ii++) {
    int cc = tid + 256 * ii;
    int i = cc >> 3, c8 = cc & 7;
    *(u32x4*)(dst + i * 64 + c8 * 8) = *(const u32x4*)(Qe + i * LDT + c8 * 8);
    *(u32x4*)(dst + 4096 + i * 64 + c8 * 8) = *(const u32x4*)(KlT + i * LDT + c8 * 8);
    *(u32x4*)(dst + 8192 + i * 64 + c8 * 8) = *(const u32x4*)(Att + i * LDT + c8 * 8);
  }
  if (tid < 64) ((float*)(p.ws + WS_EL))[((long)(((b * 4 + h) * 2 + dir) * 64 + c)) * 64 + tid] = __expf(lastv[tid]);
  __syncthreads();
}

__device__ __forceinline__ void gla_chain_item(const Params& p, int l, int b, int h, int dir, int vh, bfr* sm) {
  const int tid = TIDX, lane = tid & 63, wid = tid >> 6, g = lane >> 4, l15 = lane & 15;
  const bfr* Z = (const bfr*)(p.ws + WS_Z);
  bfr* OG = (bfr*)(p.ws + WS_R1) + (long)dir * NROWS * 512;
  const float* EL = (const float*)(p.ws + WS_EL) + (long)(((b * 4 + h) * 2 + dir) * 64) * 64;
  const int N = 4096, nc = 64;
  const int rowbase = NCTX + b * 4096;
  const int vs0 = vh * 64;
  bfr* Vt = sm;
  bfr* St = Vt + 64 * LDT;
  f32x4 st[4];
  {
    const float* S0 = (dir ? p.in[7] : p.in[6]) + ((long)((b * 2 + l) * 4 + h)) * 8192 + (long)(16 * wid + l15) * 128 + vs0;
#pragma unroll
    for (int vt = 0; vt < 4; vt++) {
      float4 a = *(const float4*)(S0 + 16 * vt + 4 * g);
      st[vt] = (f32x4){a.x, a.y, a.z, a.w};
#pragma unroll
      for (int r = 0; r < 4; r++) St[(16 * vt + 4 * g + r) * LDT + 16 * wid + l15] = f2bf(st[vt][r]);
    }
  }
  u32x4 n_qe[2], n_kl[2], n_at[2], n_v[2];
  float n_el;
  auto prefetch = [&](int c) {
    const bfr* base = prep_base(p, b, h, dir, c) + (16 * wid + l15) * 64 + 8 * g;
#pragma unroll
    for (int kk = 0; kk < 2; kk++) {
      n_qe[kk] = *(const u32x4*)(base + kk * 32);
      n_kl[kk] = *(const u32x4*)(base + 4096 + kk * 32);
      n_at[kk] = *(const u32x4*)(base + 8192 + kk * 32);
    }
    n_el = EL[c * 64 + 16 * wid + l15];
#pragma unroll
    for (int ii = 0; ii < 2; ii++) {
      int cc = tid + 256 * ii;
      int i = cc >> 3, c8 = cc & 7;
      int tok = dir ? (N - 1 - (c * 64 + i)) : (c * 64 + i);
      n_v[ii] = *(const u32x4*)(Z + (long)(rowbase + tok) * ZLD + C_VG + h * 128 + vs0 + c8 * 8);
    }
  };
  prefetch(0);
  for (int c = 0; c < nc; c++) {
    u32x4 c_qe[2] = {n_qe[0], n_qe[1]}, c_kl[2] = {n_kl[0], n_kl[1]}, c_at[2] = {n_at[0], n_at[1]};
    const float el = n_el;
#pragma unroll
    for (int ii = 0; ii < 2; ii++) {
      int cc = tid + 256 * ii;
      int i = cc >> 3, c8 = cc & 7;
      const bfr* rb = (const bfr*)&n_v[ii];
#pragma unroll
      for (int e = 0; e < 8; e++) Vt[(c8 * 8 + e) * LDT + i] = rb[e];
    }
    __syncthreads();
    if (c + 1 < nc) prefetch(c + 1);
    f32x4 stn[4];
    const int i = 16 * wid + l15;
    const int tok = dir ? (N - 1 - (c * 64 + i)) : (c * 64 + i);
    bfr* og = OG + (long)(rowbase + tok) * 512 + h * 128 + vs0 + 4 * g;
#pragma unroll
    for (int vt = 0; vt < 4; vt++) {
      f32x4 oc = (f32x4){0.f, 0.f, 0.f, 0.f};
      stn[vt] = st[vt] * el;
#pragma unroll
      for (int kk = 0; kk < 2; kk++) {
        bf16x8 vf = *(const bf16x8*)(Vt + (16 * vt + l15) * LDT + kk * 32 + g * 8);
        bf16x8 sf = *(const bf16x8*)(St + (16 * vt + l15) * LDT + kk * 32 + g * 8);
        oc = mfma16(vf, *(bf16x8*)&c_at[kk], oc);
        oc = mfma16(sf, *(bf16x8*)&c_qe[kk], oc);
        stn[vt] = mfma16(vf, *(bf16x8*)&c_kl[kk], stn[vt]);
      }
      u32x2 ov;
      ov.x = pack2(oc[0], oc[1]);
      ov.y = pack2(oc[2], oc[3]);
      *(u32x2*)(og + 16 * vt) = ov;
    }
    __syncthreads();
#pragma unroll
    for (int vt = 0; vt < 4; vt++) {
      st[vt] = stn[vt];
#pragma unroll
      for (int r = 0; r < 4; r++) St[(16 * vt + 4 * g + r) * LDT + 16 * wid + l15] = f2bf(st[vt][r]);
    }
  }
  __syncthreads();
}

template <int VS>
__device__ __forceinline__ void gla_item(const Params& p, int l, int seq, int h, int dir, int vsl, bfr* sm) {
  constexpr int NVT = VS / 16;
  constexpr int NVL = VS / 32;
  const int tid = TIDX, lane = tid & 63, wid = tid >> 6, g = lane >> 4, l15 = lane & 15;
  bfr* Z = (bfr*)(p.ws + WS_Z);
  bfr* OG = (bfr*)(p.ws + WS_R1) + (long)dir * NROWS * 512;
  const bool lat = seq >= 16;
  const int b = seq - 16;
  const int N = lat ? 4096 : 256;
  const int rowbase = lat ? NCTX + b * 4096 : seq * 256;
  const int nc = N >> 6;
  const int vs0 = vsl * VS;
  bfr* Qr = sm;
  bfr* Kr = Qr + 64 * LDT;
  bfr* Qe = Kr + 64 * LDT;
  bfr* Ke = Qe + 64 * LDT;
  bfr* KlT = Ke + 64 * LDT;
  float* RF = (float*)(KlT + 64 * LDT);
  float* tot = RF + 64 * 16;
  float* lastv = tot + 256;
  bfr* Vt = (bfr*)(lastv + 64);
  bfr* St = Vt + VS * LDT;
  bfr* Att = Qr;
  const int ch = tid & 63;
  float wd[16];
  {
    const float* W = (dir ? p.in[19] : p.in[17]) + (long)l * 16 * 256 + h * 64 + ch;
#pragma unroll
    for (int r = 0; r < 16; r++) wd[r] = W[r * 256];
  }
  const float bias = (dir ? p.in[20] : p.in[18])[l * 256 + h * 64 + ch];

  f32x4 st[NVT];
  {
    const float* S0 = (dir ? p.in[7] : p.in[6]) + ((long)((b * 2 + l) * 4 + h)) * 8192 + (long)(16 * wid + l15) * 128 + vs0;
#pragma unroll
    for (int mv = 0; mv < NVT; mv++) {
      if (lat) {
        float4 a = *(const float4*)(S0 + 16 * mv + 4 * g);
        st[mv] = (f32x4){a.x, a.y, a.z, a.w};
      } else {
        st[mv] = (f32x4){0.f, 0.f, 0.f, 0.f};
      }
#pragma unroll
      for (int r = 0; r < 4; r++) St[(16 * mv + 4 * g + r) * LDT + 16 * wid + l15] = f2bf(st[mv][r]);
    }
  }
  u32x4 rq[2], rk[2], rv[NVL], rr;
  auto prefetch = [&](int c) {
#pragma unroll
    for (int ii = 0; ii < 2; ii++) {
      int cc = tid + 256 * ii;
      int i = cc >> 3, c8 = cc & 7;
      int tok = dir ? (N - 1 - (c * 64 + i)) : (c * 64 + i);
      const bfr* zr = Z + (long)(rowbase + tok) * ZLD;
      rq[ii] = *(const u32x4*)(zr + C_QG + h * 64 + c8 * 8);
      rk[ii] = *(const u32x4*)(zr + C_KG + h * 64 + c8 * 8);
    }
#pragma unroll
    for (int ii = 0; ii < NVL; ii++) {
      int cc = tid + 256 * ii;
      int i = cc / (VS / 8), c4 = cc % (VS / 8);
      int tok = dir ? (N - 1 - (c * 64 + i)) : (c * 64 + i);
      rv[ii] = *(const u32x4*)(Z + (long)(rowbase + tok) * ZLD + C_VG + h * 128 + vs0 + c4 * 8);
    }
    if (tid < 128) {
      int i = tid >> 1, hf = tid & 1;
      int tok = dir ? (N - 1 - (c * 64 + i)) : (c * 64 + i);
      rr = *(const u32x4*)(Z + (long)(rowbase + tok) * ZLD + (dir ? C_RB : C_RF) + hf * 8);
    }
  };
  prefetch(0);
  for (int c = 0; c < nc; c++) {
#pragma unroll
    for (int ii = 0; ii < 2; ii++) {
      int cc = tid + 256 * ii;
      *(u32x4*)(Qr + (cc >> 3) * LDT + (cc & 7) * 8) = rq[ii];
      *(u32x4*)(Kr + (cc >> 3) * LDT + (cc & 7) * 8) = rk[ii];
    }
#pragma unroll
    for (int ii = 0; ii < NVL; ii++) {
      int cc = tid + 256 * ii;
      int i = cc / (VS / 8), c4 = cc % (VS / 8);
      const bfr* rb = (const bfr*)&rv[ii];
#pragma unroll
      for (int e = 0; e < 8; e++) Vt[(c4 * 8 + e) * LDT + i] = rb[e];
    }
    if (tid < 128) {
      int i = tid >> 1, hf = tid & 1;
      float x[8];
      unpack8(rr, x);
#pragma unroll
      for (int e = 0; e < 8; e++) RF[i * 16 + hf * 8 + e] = x[e];
    }
    __syncthreads();
    if (c + 1 < nc) prefetch(c + 1);
    gla_chunk_prep(tid, wd, bias, Qr, Kr, Qe, Ke, KlT, RF, tot, lastv);
    f32x4 stn[NVT];
    {
      float el = __expf(lastv[16 * wid + l15]);
#pragma unroll
      for (int mv = 0; mv < NVT; mv++) {
        stn[mv] = st[mv] * el;
#pragma unroll
        for (int kk = 0; kk < 2; kk++) {
          bf16x8 va = *(const bf16x8*)(Vt + (16 * mv + l15) * LDT + kk * 32 + g * 8);
          bf16x8 kb = *(const bf16x8*)(KlT + (16 * wid + l15) * LDT + kk * 32 + g * 8);
          stn[mv] = mfma16(va, kb, stn[mv]);
        }
      }
      gla_att(wid, g, l15, Qe, Ke, Att);
    }
    __syncthreads();
    {
      bf16x8 aa[2], qa[2];
#pragma unroll
      for (int kk = 0; kk < 2; kk++) {
        aa[kk] = *(const bf16x8*)(Att + (16 * wid + l15) * LDT + kk * 32 + g * 8);
        qa[kk] = *(const bf16x8*)(Qe + (16 * wid + l15) * LDT + kk * 32 + g * 8);
      }
#pragma unroll
      for (int nv = 0; nv < NVT; nv++) {
        f32x4 oc = (f32x4){0.f, 0.f, 0.f, 0.f};
#pragma unroll
        for (int kk = 0; kk < 2; kk++) {
          bf16x8 vb = *(const bf16x8*)(Vt + (16 * nv + l15) * LDT + kk * 32 + g * 8);
          oc = mfma16(aa[kk], vb, oc);
          bf16x8 sb = *(const bf16x8*)(St + (16 * nv + l15) * LDT + kk * 32 + g * 8);
          oc = mfma16(qa[kk], sb, oc);
        }
#pragma unroll
        for (int r = 0; r < 4; r++) {
          int i = 16 * wid + 4 * g + r;
          int tok = dir ? (N - 1 - (c * 64 + i)) : (c * 64 + i);
          OG[(long)(rowbase + tok) * 512 + h * 128 + vs0 + 16 * nv + l15] = f2bf(oc[r]);
        }
      }
    }
    __syncthreads();
#pragma unroll
    for (int mv = 0; mv < NVT; mv++) {
      st[mv] = stn[mv];
#pragma unroll
      for (int r = 0; r < 4; r++) St[(16 * mv + 4 * g + r) * LDT + 16 * wid + l15] = f2bf(st[mv][r]);
    }
  }
  __syncthreads();
  if (!lat) {
    float* so = p.out + (dir ? O_SB : O_SF) + ((long)((seq * 2 + l) * 4 + h)) * 8192 + (long)(16 * wid + l15) * 128 + vs0;
#pragma unroll
    for (int mv = 0; mv < NVT; mv++)
      *(float4*)(so + 16 * mv + 4 * g) = make_float4(st[mv][0], st[mv][1], st[mv][2], st[mv][3]);
  }
}

__device__ __forceinline__ void phase_mla_up(const Params& p, int l, bfr* sm) {
  bfr* Z = (bfr*)(p.ws + WS_Z);
  const float* rope = (const float*)(p.ws + WS_ROPE);
  const int lane = TIDX & 63, wid = TIDX >> 6, wr = wid >> 1, wc = wid & 1;
  const int g = lane >> 4;
  for (int t = blockIdx.x; t < 288 + 624 + 1024; t += gridDim.x) {
    if (t >= 912) {
      int i = t - 912;
      gla_prep_item(p, l, i >> 9, (i >> 7) & 3, (i >> 6) & 1, i & 63, sm);
      continue;
    }
    f32x4 acc[4][4];
#pragma unroll
    for (int a = 0; a < 4; a++)
#pragma unroll
      for (int b = 0; b < 4; b++) acc[a][b] = (f32x4){0.f, 0.f, 0.f, 0.f};
    if (t < 288) {
      int tn = t % 3, tm = t / 3;
      gemm128k64<4, true>((const bfr*)(p.ws + WS_WUQ) + (long)tn * 128 * 256, 256, 128, Z + (long)tm * 128 * ZLD + C_QL, ZLD, 256,
                    acc, sm);
      bfr* CQ = (bfr*)(p.ws + WS_CQ);
      const float qs = 0.10206207261596577f * 1.4426950408889634f;
#pragma unroll
      for (int pi = 0; pi < 4; pi++) {
        int nb = tn * 128 + wr * 64 + pi * 16;
        int wb = nb % 96;
        bool ropet = wb >= 64;
        int part = (wb - 64) >> 4;
#pragma unroll
        for (int qi = 0; qi < 4; qi++) {
          int tok = tm * 128 + wc * 64 + qi * 16 + (lane & 15);
          float y[4] = {acc[pi][qi][0], acc[pi][qi][1], acc[pi][qi][2], acc[pi][qi][3]};
          if (ropet) {
            bool lat = tok >= NCTX;
            int tl = (tok - NCTX) & 4095;
            int pos = part ? (tl & 63) : (tl >> 6);
            bool hi = (g & 2) != 0;
            int i0 = (g & 1) * 4;
#pragma unroll
            for (int r = 0; r < 4; r++) {
              float yp = __shfl_xor(y[r], 32);
              float c = rope[2048 + pos * 8 + i0 + r], s = rope[2560 + pos * 8 + i0 + r];
              float yr = hi ? (yp * s + y[r] * c) : (y[r] * c - yp * s);
              y[r] = lat ? yr : y[r];
            }
          }
          u32x2 o;
          o.x = pack2(y[0] * qs, y[1] * qs);
          o.y = pack2(y[2] * qs, y[3] * qs);
          *(u32x2*)(CQ + (long)tok * 384 + nb + g * 4) = o;
        }
      }
    } else {
      int t2 = t - 288;
      int tn = t2 % 6, tm = t2 / 6;
      const bfr* Q;
      long ldq;
      long kbase, vbase;
      int nk, key0;
      if (tm < 32) {
        Q = Z + (long)tm * 128 * ZLD + C_KV;
        ldq = ZLD;
        int s = tm >> 1;
        key0 = (tm & 1) * 128;
        nk = 256;
        kbase = (long)s * (4 * 256 * 64);
        vbase = (long)s * 131072;
      } else {
        int r = (tm - 32) * 128;
        int b = r / 4608, within = r % 4608;
        key0 = within;
        nk = 4608;
        kbase = 16l * (4 * 256 * 64) + (long)b * (4 * 4608 * 64);
        vbase = 16l * 131072 + (long)b * (4 * 128 * 4608);
        if (within < 512) {
          Q = (const bfr*)(p.ws + WS_CKVC) + (long)(b * 512 + within) * 256;
          ldq = 256;
        } else {
          Q = Z + (long)(NCTX + b * 4096 + within - 512) * ZLD + C_KV;
          ldq = ZLD;
        }
      }
      gemm128k64<4, true>((const bfr*)(p.ws + WS_WUKV) + (long)tn * 128 * 256, 256, 128, Q, ldq, 256, acc, sm);
      bfr* KN = (bfr*)(p.ws + WS_KNOPE);
      bfr* VTC = (bfr*)(p.ws + WS_VTC);
#pragma unroll
      for (int pi = 0; pi < 4; pi++) {
        int n0 = tn * 128 + wr * 64 + pi * 16 + g * 4;
        int head = n0 / 192, w = n0 % 192;
#pragma unroll
        for (int qi = 0; qi < 4; qi++) {
          int key = key0 + wc * 64 + qi * 16 + (lane & 15);
          if (w < 64) {
            u32x2 o;
            o.x = pack2(acc[pi][qi][0], acc[pi][qi][1]);
            o.y = pack2(acc[pi][qi][2], acc[pi][qi][3]);
            *(u32x2*)(KN + kbase + ((long)head * nk + key) * 64 + w) = o;
          } else {
#pragma unroll
            for (int r = 0; r < 4; r++)
              VTC[vbase + ((long)head * 128 + (w - 64) + r) * nk + key] = f2bf(acc[pi][qi][r]);
          }
        }
      }
    }
  }
}

template <int DQ, int DV, bool MLA, int NQB, bool DMA, int TP>
__device__ __forceinline__ void attn_item(const Params& p, int seq, int head, int qoff, bfr* sm, int dry) {
  constexpr int KLD = DQ + 8;
  constexpr int KSZ = DMA ? 6144 : 64 * KLD;
  constexpr int VSZ = DMA ? 8192 : DV * LDT;
  constexpr int BUF = KSZ + VSZ;
  constexpr int NKK = DQ / 32;
  constexpr int NDV = DV / 16;
  constexpr int NVL = DV / 32;
  const int tid = TIDX, lane = tid & 63, wid = tid >> 6, g = lane >> 4, l15 = lane & 15;
  bfr* Z = (bfr*)(p.ws + WS_Z);
  const int sK = 2 * (l15 >> 2) + ((l15 >> 1) & 1), sR = ((l15 >> 3) & 1) * 2, sV = l15 >> 1;
  auto kaddr = [&](const bfr* Ks, int krow, int kk) -> const bfr* {
    if (DMA) return (kk < 2) ? (Ks + krow * 64 + (((kk * 4 + g) ^ sK) * 8)) : (Ks + 4096 + krow * 32 + ((g ^ sR) * 8));
    return Ks + krow * KLD + kk * 32 + g * 8;
  };
  auto vaddr = [&](const bfr* Vs, int d, int sx) -> const bfr* {
    if (DMA) return Vs + (d * 16 + l15) * 64 + (((sx * 4 + g) ^ sV) * 8);
    return Vs + (d * 16 + l15) * LDT + sx * 32 + g * 8;
  };
  const bool lat = seq >= 16;
  const int b = seq - 16;
  const int nk = lat ? 4608 : 256;
  const int rowbase = lat ? NCTX + b * 4096 : seq * 256;
  const int nkt = nk >> 6;

  bf16x8 qf[NQB][NKK];
#pragma unroll
  for (int qb = 0; qb < NQB; qb++) {
    int qrow = rowbase + qoff + wid * (16 * NQB) + qb * 16 + l15;
    const bfr* qp = MLA ? ((const bfr*)(p.ws + WS_CQ) + (long)qrow * 384 + head * 96) : (Z + (long)qrow * ZLD + C_QA + head * 64);
#pragma unroll
    for (int kk = 0; kk < NKK; kk++) qf[qb][kk] = *(const bf16x8*)(qp + kk * 32 + g * 8);
  }

  u32x4 rk[TP][2], rkr[TP], rv[TP][NVL];
  auto prefetch = [&](int pi) {
#pragma unroll
   for (int u = 0; u < TP; u++) {
    int k0 = (pi * TP + u) * 64;
    bool cache = lat && (k0 < 512);
    int tokrow0 = lat ? (NCTX + b * 4096 + k0 - 512) : (seq * 256 + k0);
    if (!MLA) {
      int kvh = head >> 2;
#pragma unroll
      for (int i = 0; i < 2; i++) {
        int c = tid + 256 * i;
        int kr_ = c >> 3, ch = c & 7;
        const bfr* src = cache ? ((const bfr*)(p.ws + WS_KCA) + (long)(b * 512 + k0 + kr_) * 128 + kvh * 64 + ch * 8)
                               : (Z + (long)(tokrow0 + kr_) * ZLD + C_KA + kvh * 64 + ch * 8);
        rk[u][i] = *(const u32x4*)src;
      }
      long vb = lat ? (16l * 32768 + (long)b * (2 * 64 * 4608)) : ((long)seq * 32768);
#pragma unroll
      for (int i = 0; i < NVL; i++) {
        int c = tid + 256 * i;
        int dv = c >> 3, ch = c & 7;
        rv[u][i] = *(const u32x4*)((const bfr*)(p.ws + WS_VTA) + vb + (long)(kvh * 64 + dv) * nk + k0 + ch * 8);
      }
    } else {
      long kb = lat ? (16l * (4 * 256 * 64) + (long)b * (4 * 4608 * 64)) : ((long)seq * (4 * 256 * 64));
#pragma unroll
      for (int i = 0; i < 2; i++) {
        int c = tid + 256 * i;
        int kr_ = c >> 3, ch = c & 7;
        rk[u][i] = *(const u32x4*)((const bfr*)(p.ws + WS_KNOPE) + kb + ((long)head * nk + k0 + kr_) * 64 + ch * 8);
      }
      {
        int kr_ = tid >> 2, ch = tid & 3;
        const bfr* src = cache ? ((const bfr*)(p.ws + WS_KRC) + (long)(b * 512 + k0 + kr_) * 32 + ch * 8)
                               : (Z + (long)(tokrow0 + kr_) * ZLD + C_KR + ch * 8);
        rkr[u] = *(const u32x4*)src;
      }
      long vb = lat ? (16l * 131072 + (long)b * (4 * 128 * 4608)) : ((long)seq * 131072);
#pragma unroll
      for (int i = 0; i < NVL; i++) {
        int c = tid + 256 * i;
        int dv = c >> 3, ch = c & 7;
        rv[u][i] = *(const u32x4*)((const bfr*)(p.ws + WS_VTC) + vb + (long)(head * 128 + dv) * nk + k0 + ch * 8);
      }
    }
   }
  };

  f32x4 o[NQB][NDV];
#pragma unroll
  for (int qb = 0; qb < NQB; qb++)
#pragma unroll
    for (int d = 0; d < NDV; d++) o[qb][d] = (f32x4){0.f, 0.f, 0.f, 0.f};
  float mrun[NQB];
  f32x4 lacc[NQB];
#pragma unroll
  for (int qb = 0; qb < NQB; qb++) { mrun[qb] = 0.f; lacc[qb] = (f32x4){0.f, 0.f, 0.f, 0.f}; }
  const bf16x8 ones = (bf16x8){(short)0x3F80, (short)0x3F80, (short)0x3F80, (short)0x3F80, (short)0x3F80, (short)0x3F80, (short)0x3F80, (short)0x3F80};

  auto dma_issue = [&](int kt, bfr* stg) {
    const int k0 = kt * 64;
    const bool cache = lat && (k0 < 512);
    const int tokrow0 = lat ? (NCTX + b * 4096 + k0 - 512) : (seq * 256 + k0);
    const long kb = lat ? (16l * (4 * 256 * 64) + (long)b * (4 * 4608 * 64)) : ((long)seq * (4 * 256 * 64));
    const long vb = lat ? (16l * 131072 + (long)b * (4 * 128 * 4608)) : ((long)seq * 131072);
    {
      const int c = (tid & 7) ^ (((tid >> 6) & 3) * 2 + ((tid >> 4) & 1));
#pragma unroll
      for (int i = 0; i < 2; i++)
        glds16((const bfr*)(p.ws + WS_KNOPE) + kb + ((long)head * nk + k0 + i * 32 + (tid >> 3)) * 64 + c * 8, stg + i * 2048 + tid * 8);
    }
    {
      const int row = tid >> 2, c = (tid & 3) ^ (((tid >> 6) & 1) * 2);
      const bfr* src = cache ? ((const bfr*)(p.ws + WS_KRC) + (long)(b * 512 + k0 + row) * 32 + c * 8)
                             : (Z + (long)(tokrow0 + row) * ZLD + C_KR + c * 8);
      glds16(src, stg + 4096 + tid * 8);
    }
    {
      const int c = (tid & 7) ^ ((tid >> 4) & 7);
#pragma unroll
      for (int i = 0; i < 4; i++)
        glds16((const bfr*)(p.ws + WS_VTC) + vb + (long)(head * 128 + i * 32 + (tid >> 3)) * nk + k0 + c * 8, stg + 6144 + i * 2048 + tid * 8);
    }
  };
  if (DMA) dma_issue(0, sm); else prefetch(0);
  const int np = nkt / TP;
  for (int pi = 0; pi < np; pi++) {
    bfr* base = sm + (pi & 1) * (TP * BUF);
    if (DMA) {
      asm volatile("s_waitcnt vmcnt(0)" ::: "memory");
      __syncthreads();
      if (pi + 1 < np) dma_issue(pi + 1, sm + ((pi + 1) & 1) * BUF);
    } else {
#pragma unroll
      for (int u = 0; u < TP; u++) {
        bfr* Ks = base + u * BUF;
        bfr* Vs = Ks + KSZ;
#pragma unroll
        for (int i = 0; i < 2; i++) {
          int c = tid + 256 * i;
          *(u32x4*)(Ks + (c >> 3) * KLD + (c & 7) * 8) = rk[u][i];
        }
        if (MLA) *(u32x4*)(Ks + (tid >> 2) * KLD + 64 + (tid & 3) * 8) = rkr[u];
#pragma unroll
        for (int i = 0; i < NVL; i++) {
          int c = tid + 256 * i;
          *(u32x4*)(Vs + (c >> 3) * LDT + (c & 7) * 8) = rv[u][i];
        }
      }
      __syncthreads();
      if (pi + 1 < np) prefetch(pi + 1);
    }
#pragma unroll
   for (int u = 0; u < TP; u++) {
    const bfr* Ks = base + u * BUF;
    const bfr* Vs = Ks + KSZ;
    const int kt = pi * TP + u;

    f32x4 s[NQB][4];
    bf16x8 kfr[4][NKK];
#pragma unroll
    for (int t = 0; t < 2; t++) {
      int krow = 32 * (t >> 1) + 8 * (l15 >> 2) + 4 * (t & 1) + (l15 & 3);
#pragma unroll
      for (int kk = 0; kk < NKK; kk++) kfr[t][kk] = *(const bf16x8*)kaddr(Ks, krow, kk);
    }
#pragma unroll
    for (int t = 0; t < 4; t++) {
#pragma unroll
      for (int qb = 0; qb < NQB; qb++) s[qb][t] = (f32x4){-mrun[qb], -mrun[qb], -mrun[qb], -mrun[qb]};
      if (t + 2 < 4) {
        int krow = 32 * ((t + 2) >> 1) + 8 * (l15 >> 2) + 4 * ((t + 2) & 1) + (l15 & 3);
#pragma unroll
        for (int kk = 0; kk < NKK; kk++) kfr[t + 2][kk] = *(const bf16x8*)kaddr(Ks, krow, kk);
      }
#pragma unroll
      for (int kk = 0; kk < NKK; kk++) {
#pragma unroll
        for (int qb = 0; qb < NQB; qb++) s[qb][t] = mfma16(kfr[t][kk], qf[qb][kk], s[qb][t]);
      }
    }
    bf16x8 vfr[4][2];
#pragma unroll
    for (int d = 0; d < 4; d++)
#pragma unroll
      for (int sx = 0; sx < 2; sx++) vfr[d][sx] = *(const bf16x8*)vaddr(Vs, d, sx);
    bf16x8 pf[NQB][2];
#pragma unroll
    for (int qb = 0; qb < NQB; qb++) {
      float mt = s[qb][0][0];
#pragma unroll
      for (int t = 0; t < 4; t++)
#pragma unroll
        for (int r = 0; r < 4; r++) mt = fmaxf(mt, s[qb][t][r]);
      const bool first = (kt == 0);
      if (first || __builtin_amdgcn_ballot_w64(mt > 8.f) != 0ull) {
        mt = fmaxf(mt, __shfl_xor(mt, 16));
        mt = fmaxf(mt, __shfl_xor(mt, 32));
        const bool need = first || mt > 8.f;
        const float dm = need ? mt : 0.f;
        const float alpha = first ? 1.f : __builtin_amdgcn_exp2f(-dm);
        mrun[qb] += dm;
        lacc[qb] *= alpha;
#pragma unroll
        for (int d = 0; d < NDV; d++) o[qb][d] *= alpha;
#pragma unroll
        for (int t = 0; t < 4; t++) s[qb][t] -= dm;
      }
#pragma unroll
      for (int t = 0; t < 4; t++)
#pragma unroll
        for (int r = 0; r < 4; r++) s[qb][t][r] = __builtin_amdgcn_exp2f(s[qb][t][r]);
#pragma unroll
      for (int sx = 0; sx < 2; sx++) {
        u32x4 u;
        u.x = pack2(s[qb][2 * sx][0], s[qb][2 * sx][1]);
        u.y = pack2(s[qb][2 * sx][2], s[qb][2 * sx][3]);
        u.z = pack2(s[qb][2 * sx + 1][0], s[qb][2 * sx + 1][1]);
        u.w = pack2(s[qb][2 * sx + 1][2], s[qb][2 * sx + 1][3]);
        pf[qb][sx] = *(bf16x8*)&u;
      }
    }
#pragma unroll
    for (int d = 0; d < NDV; d++) {
#pragma unroll
      for (int sx = 0; sx < 2; sx++) {
#pragma unroll
        for (int qb = 0; qb < NQB; qb++) o[qb][d] = mfma16(vfr[d & 3][sx], pf[qb][sx], o[qb][d]);
      }
      if (d + 4 < NDV) {
#pragma unroll
        for (int sx = 0; sx < 2; sx++)
          vfr[d & 3][sx] = *(const bf16x8*)vaddr(Vs, d + 4, sx);
      }
    }
#pragma unroll
    for (int sx = 0; sx < 2; sx++) {
#pragma unroll
      for (int qb = 0; qb < NQB; qb++) lacc[qb] = mfma16(ones, pf[qb][sx], lacc[qb]);
    }
   }
  }
  __syncthreads();
#pragma unroll
  for (int qb = 0; qb < NQB; qb++) {
    float inv = 1.f / lacc[qb][0];
    int qrow = rowbase + qoff + wid * (16 * NQB) + qb * 16 + l15;
    bfr* gp = Z + (long)qrow * ZLD + (MLA ? C_GC : C_GA) + head * DV + g * 4;
#pragma unroll
    for (int d = 0; d < NDV; d++) {
      u32x2 gr = *(const u32x2*)(gp + d * 16);
      float y0 = o[qb][d][0] * inv * siluf(lo16(gr.x));
      float y1 = o[qb][d][1] * inv * siluf(hi16(gr.x));
      float y2 = o[qb][d][2] * inv * siluf(lo16(gr.y));
      float y3 = o[qb][d][3] * inv * siluf(hi16(gr.y));
      u32x2 ov;
      ov.x = pack2(y0, y1);
      ov.y = pack2(y2, y3);
      if (!dry) *(u32x2*)(gp + d * 16) = ov;
    }
  }
}

__device__ __forceinline__ void phase_mixers(const Params& p, int l, bfr* sm, int* s_item, int dry) {
  unsigned* ctr = (unsigned*)(p.ws + WS_CTR) + (2 + l + 2 * dry) * 128;
  auto cnt = [](int) { return 184; };
  int q = (int)xcc_id(), tried = 0;
  for (;;) {
    if (TIDX == 0) {
      unsigned first = atomicAdd(ctr + q * 16, 1u);
      *s_item = xq_take(ctr, q, tried, first, cnt);
    }
    __syncthreads();
    const int it = *s_item;
    __syncthreads();
    if (it < 0) break;
    const int x = it >> 20, j = it & 0xfffff;
    int kind, a0, a1, a2, a3 = 0;
    if (j < 4) {
      int idx = x * 4 + j;
      kind = 3; a0 = idx >> 4; a1 = (idx >> 2) & 3; a2 = (idx >> 1) & 1; a3 = idx & 1;
    } else if (j < 36) {
      kind = 1; a0 = 16 + (x >> 2); a1 = x & 3; a2 = (j - 4) * 128;
    } else if (j < 96) {
      int i = j - 36;
      kind = 2; a0 = 16 + (x >> 2); a1 = ((x >> 1) & 1) * 4 + (x & 1) * 2 + (i >> 5); a2 = (i & 31) * 128;
    } else if (j < 104) {
      int k = j - 96;
      int i = 60 + (k >> 1);
      kind = 4; a0 = 16 + (x >> 2); a1 = ((x >> 1) & 1) * 4 + (x & 1) * 2 + (i >> 5); a2 = (i & 31) * 128 + (k & 1) * 64;
    } else if (j < 136) {
      int i = j - 104;
      kind = 0; a0 = 2 * x + (i >> 4); a1 = (i >> 2) & 3; a2 = (i >> 1) & 1; a3 = i & 1;
    } else if (j < 152) {
      int i = j - 136;
      kind = 1; a0 = 2 * x + (i >> 3); a1 = (i >> 1) & 3; a2 = (i & 1) * 128;
    } else {
      int i = j - 152;
      kind = 2; a0 = 2 * x + (i >> 4); a1 = (i >> 1) & 7; a2 = (i & 1) * 128;
    }
#ifdef PROBE_MIXKIND
    if (dry && ((PROBE_MIXKIND == 1) != (kind == 0 || kind == 3))) continue;
#endif
    if (kind == 0) gla_item<64>(p, l, a0, a1, a2, a3, sm);
    else if (kind == 3) gla_chain_item(p, l, a0, a1, a2, a3, sm);
    else if (kind == 1) attn_item<96, 128, true, 2, true, 1>(p, a0, a1, a2, sm, dry);
    else if (kind == 2) attn_item<64, 64, false, 2, false, 2>(p, a0, a1, a2, sm, dry);
    else attn_item<64, 64, false, 1, false, 2>(p, a0, a1, a2, sm, dry);
  }
}

__device__ __forceinline__ void phase_gla_out(const Params& p, int l) {
  const int lane = TIDX & 63;
  bfr* Z = (bfr*)(p.ws + WS_Z);
  const bfr* OF = (const bfr*)(p.ws + WS_R1);
  const bfr* OB = OF + (long)NROWS * 512;
  for (int row = blockIdx.x * 4 + (TIDX >> 6); row < NROWS; row += gridDim.x * 4) {
    float a[8], c[8], gt[8];
    unpack8(*(const u32x4*)(OF + (long)row * 512 + lane * 8), a);
    unpack8(*(const u32x4*)(OB + (long)row * 512 + lane * 8), c);
    bfr* gp = Z + (long)row * ZLD + C_GG + lane * 8;
    unpack8(*(const u32x4*)gp, gt);
    float ss = 0.f;
#pragma unroll
    for (int e = 0; e < 8; e++) {
      a[e] = bf2f(f2bf(a[e] + c[e]));
      ss += a[e] * a[e];
    }
    ss += __shfl_xor(ss, 1); ss += __shfl_xor(ss, 2); ss += __shfl_xor(ss, 4); ss += __shfl_xor(ss, 8);
    float rs = rsqrtf(ss * (1.f / 128.f) + 1e-6f);
    const float* gg = p.in[21] + l * 128 + (lane & 15) * 8;
#pragma unroll
    for (int e = 0; e < 8; e++) a[e] = a[e] * rs * gg[e] * siluf(gt[e]);
    *(u32x4*)gp = pack8(a);
  }
}

template <int NQ>
__device__ __forceinline__ void merge_tile(const Params& p, bfr* sm, int tn, int tok0) {
  constexpr int STG = 8192 + 2048 * NQ;
  bfr* Z = (bfr*)(p.ws + WS_Z);
  bfr* MG = (bfr*)(p.ws + WS_R1);
  const int tid = TIDX;
  const int lane = tid & 63, wid = tid >> 6, wr = wid >> 1, wc = wid & 1, g = lane >> 4, l15 = lane & 15;
  f32x4 totl[4][NQ];
#pragma unroll
  for (int a = 0; a < 4; a++)
#pragma unroll
    for (int b = 0; b < NQ; b++) totl[a][b] = (f32x4){0.f, 0.f, 0.f, 0.f};
#pragma unroll 1
  for (int seg = 0; seg < 3; seg++) {
    f32x4 acc[4][NQ];
#pragma unroll
    for (int a = 0; a < 4; a++)
#pragma unroll
      for (int b = 0; b < NQ; b++) acc[a][b] = (f32x4){0.f, 0.f, 0.f, 0.f};
    int ycol = seg == 0 ? C_GA : (seg == 1 ? C_GG : C_GC);
    int mcol = C_M1 + seg * 1024;
    const bfr* W = (const bfr*)(p.ws + WS_WOA + (unsigned long)seg * 1048576ul) + (long)tn * 128 * 512;
    gemm128k64<NQ, false, true>(W, 512, 128, Z + (long)tok0 * ZLD + ycol, ZLD, 512, acc, sm,
                                Z + (long)tok0 * ZLD + mcol + tn * 128, ZLD);
    const bfr* gt = sm;
#pragma unroll
    for (int pi = 0; pi < 4; pi++) {
      const int nl = wr * 64 + pi * 16 + g * 4;
#pragma unroll
      for (int qi = 0; qi < NQ; qi++) {
        const int tl = wc * 16 * NQ + qi * 16 + l15;
        u32x2 mr = *(const u32x2*)(gt + tl * 128 + (((nl >> 3) ^ (tl & 15)) * 8) + (nl & 4));
        totl[pi][qi][0] += sigmf(lo16(mr.x)) * acc[pi][qi][0];
        totl[pi][qi][1] += sigmf(hi16(mr.x)) * acc[pi][qi][1];
        totl[pi][qi][2] += sigmf(lo16(mr.y)) * acc[pi][qi][2];
        totl[pi][qi][3] += sigmf(hi16(mr.y)) * acc[pi][qi][3];
      }
    }
    __syncthreads();
  }
#pragma unroll
  for (int pi = 0; pi < 4; pi++)
#pragma unroll
    for (int qi = 0; qi < NQ; qi++) {
      u32x2 o;
      o.x = pack2(totl[pi][qi][0], totl[pi][qi][1]);
      o.y = pack2(totl[pi][qi][2], totl[pi][qi][3]);
      *(u32x2*)(sm + (wc * 16 * NQ + qi * 16 + l15) * 136 + wr * 64 + pi * 16 + g * 4) = o;
    }
  __syncthreads();
#pragma unroll
  for (int i = 0; i < 2 * NQ; i++) {
    int c = tid + 256 * i;
    int row = c >> 4, c16 = c & 15;
    *(u32x4*)(MG + (long)(tok0 + row) * 1024 + tn * 128 + c16 * 8) = *(const u32x4*)(sm + row * 136 + c16 * 8);
  }
  __syncthreads();
}

__device__ __forceinline__ void phase_merge(const Params& p, bfr* sm) {
  for (int t = blockIdx.x; t < 1024; t += gridDim.x) {
    if (t < 512) {
      merge_tile<4>(p, sm, t & 7, (t >> 3) * 128);
    } else {
      int u = t - 512;
      int full = 512 + (u >> 1);
      merge_tile<2>(p, sm, full & 7, (full >> 3) * 128 + (u & 1) * 64);
    }
  }
}

template <int NQ>
__device__ __forceinline__ void outproj_tile(const Params& p, bfr* sm, int tn, int tok0) {
  const bfr* MG = (const bfr*)(p.ws + WS_R1);
  float* OUT = (float*)(p.ws + WS_Z);
  const int tid = TIDX;
  const int lane = tid & 63, wid = tid >> 6, wr = wid >> 1, wc = wid & 1, g = lane >> 4, l15 = lane & 15;
  f32x4 acc[4][NQ];
#pragma unroll
  for (int a = 0; a < 4; a++)
#pragma unroll
    for (int b = 0; b < NQ; b++) acc[a][b] = (f32x4){0.f, 0.f, 0.f, 0.f};
  gemm128k64<NQ, true>((const bfr*)(p.ws + WS_WOUT) + (long)tn * 128 * 1024, 1024, 128, MG + (long)tok0 * 1024, 1024, 1024, acc, sm);
  float* smf = (float*)sm;
#pragma unroll
  for (int pi = 0; pi < 4; pi++)
#pragma unroll
    for (int qi = 0; qi < NQ; qi++)
      *(f32x4*)(smf + (wc * 16 * NQ + qi * 16 + l15) * 132 + wr * 64 + pi * 16 + g * 4) = acc[pi][qi];
  __syncthreads();
#pragma unroll
  for (int i = 0; i < 4 * NQ; i++) {
    int c = tid + 256 * i;
    int row = c >> 5, c16 = c & 31;
    *(f32x4*)(OUT + (long)(tok0 + row) * 1024 + tn * 128 + c16 * 4) = *(const f32x4*)(smf + row * 132 + c16 * 4);
  }
  __syncthreads();
}
__device__ __forceinline__ void phase_outproj(const Params& p, bfr* sm) {
  for (int t = blockIdx.x; t < 1024; t += gridDim.x) {
    if (t < 512) {
      outproj_tile<4>(p, sm, t & 7, (t >> 3) * 128);
    } else {
      int u = t - 512;
      int full = 512 + (u >> 1);
      outproj_tile<2>(p, sm, full & 7, (full >> 3) * 128 + (u & 1) * 64);
    }
  }
}

__device__ __forceinline__ void phase_post(const Params& p, int l) {
  const int lane = TIDX & 63;
  const float* mod = (const float*)(p.ws + WS_MOD);
  const float* OUT = (const float*)(p.ws + WS_Z);
  bfr* H = (bfr*)(p.ws + WS_R1);
  for (int row = blockIdx.x * 4 + (TIDX >> 6); row < NROWS; row += gridDim.x * 4) {
    const float* x = (l == 0) ? xrow(p, row) : (p.out + (long)row * 1024);
    const float* md = mod + (l * 3 + row_cond(row)) * 3072;
    float4 v[4];
    float ss = 0.f;
#pragma unroll
    for (int i = 0; i < 4; i++) {
      v[i] = *(const float4*)(OUT + (long)row * 1024 + i * 256 + lane * 4);
      ss += v[i].x * v[i].x + v[i].y * v[i].y + v[i].z * v[i].z + v[i].w * v[i].w;
    }
    ss = wave_sum(ss);
    float rs = rsqrtf(ss * (1.f / 1024.f) + 1e-6f);
    float ss2 = 0.f;
#pragma unroll
    for (int i = 0; i < 4; i++) {
      int n = i * 256 + lane * 4;
      float4 g = *(const float4*)(p.in[13] + l * 1024 + n);
      float4 gt = *(const float4*)(md + 2048 + n);
      float4 xv = *(const float4*)(x + n);
      v[i].x = xv.x + gt.x * (v[i].x * rs * g.x);
      v[i].y = xv.y + gt.y * (v[i].y * rs * g.y);
      v[i].z = xv.z + gt.z * (v[i].z * rs * g.z);
      v[i].w = xv.w + gt.w * (v[i].w * rs * g.w);
      *(float4*)(p.out + (long)row * 1024 + n) = v[i];
      ss2 += v[i].x * v[i].x + v[i].y * v[i].y + v[i].z * v[i].z + v[i].w * v[i].w;
    }
    if (l == 0) {
      ss2 = wave_sum(ss2);
      float rs2 = rsqrtf(ss2 * (1.f / 1024.f) + 1e-6f);
      const float* md1 = mod + (1 * 3 + row_cond(row)) * 3072;
#pragma unroll
      for (int i = 0; i < 4; i++) {
        int n = i * 256 + lane * 4;
        float4 g = *(const float4*)(p.in[12] + 1024 + n);
        float4 sh = *(const float4*)(md1 + n);
        float4 sc = *(const float4*)(md1 + 1024 + n);
        float h0 = v[i].x * rs2 * g.x * (1.f + sc.x) + sh.x;
        float h1 = v[i].y * rs2 * g.y * (1.f + sc.y) + sh.y;
        float h2 = v[i].z * rs2 * g.z * (1.f + sc.z) + sh.z;
        float h3 = v[i].w * rs2 * g.w * (1.f + sc.w) + sh.w;
        u32x2 o;
        o.x = pack2(h0, h1);
        o.y = pack2(h2, h3);
        *(u32x2*)(H + (long)row * 1024 + n) = o;
      }
    }
  }
}

__global__ void __launch_bounds__(256, 2) fwd_megakernel(Params p) {
  __shared__ __attribute__((aligned(16))) bfr sm[SMEM_SHORTS + 16];
  int* s_item_p = (int*)(sm + SMEM_SHORTS + 8);
  cg::grid_group grid = cg::this_grid();
  if (threadIdx.x == 0) { ((unsigned*)(sm + SMEM_SHORTS))[0] = 0u; ((unsigned*)(sm + SMEM_SHORTS))[1] = 0u; }
  __syncthreads();
  XcdBarrier xb = xcd_barrier_post((unsigned*)(p.ws + WS_BAR), (volatile LAS unsigned*)(sm + SMEM_SHORTS));
  if (p.ws == nullptr) grid.sync();
  (void)xb;
#define GSYNC1 do { XcdBarrier b_; b_.bar = (unsigned*)(p.ws + WS_BAR); b_.x = xb_xcc_id(); \
                    b_.st = (volatile LAS unsigned*)(sm + SMEM_SHORTS); xcd_barrier(b_); } while (0)
#ifdef PROBE_SYNC
#define GSYNC do { GSYNC1; GSYNC1; } while (0)
#else
#define GSYNC GSYNC1
#endif
#ifdef PROBE_PRE
  phase_s0(launder(p), sm);
  GSYNC;
  phase_s1(launder(p));
  wconv_phase(p, 0, sm);
  GSYNC;
  phase_prenorm0(launder(p));
  GSYNC;
#endif

#ifndef PH
#define PH 0xffff
#endif
#if PH & 1
  phase_s0(launder(p), sm);
#endif
  GSYNC;
#if PH & 2
  phase_s1(launder(p));
  wconv_phase(p, 0, sm);
#endif
  GSYNC;
#if PH & 4
  phase_prenorm0(launder(p));
#endif
  GSYNC;
  for (int l = 0; l < 2; l++) {
#if PH & 8
#ifdef PROBE_INPROJ
    phase_inproj(launder(p), l, sm, s_item_p, 6 + l);
    GSYNC;
#endif
    phase_inproj(launder(p), l, sm, s_item_p, l);
#endif
    GSYNC;
#if PH & 16
    phase_rowpost(launder(p), l);
#endif
    GSYNC;
#if PH & 32
#ifdef PROBE_MLAUP
    phase_mla_up(launder(p), l, sm);
    GSYNC;
#endif
    phase_mla_up(launder(p), l, sm);
#endif
    GSYNC;
#if PH & 64
#ifdef PROBE_MIX
    { int dry = 1; asm volatile("" : "+s"(dry)); phase_mixers(launder(p), l, sm, s_item_p, dry); }
    GSYNC;
#endif
    { int dry = 0; asm volatile("" : "+s"(dry)); phase_mixers(launder(p), l, sm, s_item_p, dry); }
#endif
    GSYNC;
#if PH & 128
    phase_gla_out(launder(p), l);
#endif
    GSYNC;
#if PH & 256
#ifdef PROBE_MERGE
    phase_merge(launder(p), sm);
    GSYNC;
#endif
    phase_merge(launder(p), sm);
#endif
    GSYNC;
#if PH & 512
#ifdef PROBE_MERGE
    phase_outproj(launder(p), sm);
    GSYNC;
#endif
    phase_outproj(launder(p), sm);
#endif
    GSYNC;
#if PH & 1024
    phase_post(launder(p), l);
    if (l == 0) wconv_phase(p, 1, sm);
#endif
    GSYNC;
  }
}

extern "C" void kernel_launch(void* const* d_in, const int* in_sizes, int n_in, void* d_out, int out_size, void* d_ws,
                              size_t ws_size, hipStream_t stream) {
  static int grid_blocks = 0;
  if (!grid_blocks) {
    int dev = 0, cus = 0, per_cu = 0;
    hipGetDevice(&dev);
    hipDeviceGetAttribute(&cus, hipDeviceAttributeMultiprocessorCount, dev);
    hipOccupancyMaxActiveBlocksPerMultiprocessor(&per_cu, fwd_megakernel, 256, 0);
    if (per_cu > 2) per_cu = 2;
    if (per_cu < 1) per_cu = 1;
    grid_blocks = cus * per_cu;
  }
  Params p{};
  for (int i = 0; i < 30; i++) p.in[i] = (const float*)d_in[i];
  p.out = (float*)d_out;
  p.ws = (unsigned char*)d_ws;
  hipMemsetAsync(d_ws, 0, 20480, stream);
  void* args[] = {&p};
  hipError_t e = hipLaunchCooperativeKernel((void*)fwd_megakernel, dim3(grid_blocks), dim3(256), args, 0, stream);
  if (e != hipSuccess) fprintf(stderr, "cooperative launch failed: %s (grid %d)\n", hipGetErrorString(e), grid_blocks);
}
```

```cpp
#include <hip/hip_runtime.h>
#include <hip/hip_cooperative_groups.h>
#include <cstdio>
namespace cg = cooperative_groups;

typedef unsigned short bfr;
typedef __attribute__((ext_vector_type(8))) short bf16x8;
typedef __attribute__((ext_vector_type(4))) float f32x4;
typedef __attribute__((ext_vector_type(4))) unsigned u32x4;
typedef __attribute__((ext_vector_type(2))) unsigned u32x2;

#define NROWS 12288
#define NCTX 4096
#define ZLD 6976
#define LDT 72
#define SMEM_SHORTS (4 * 128 * LDT)

#define C_QA 0
#define C_KA 512
#define C_VA 640
#define C_GA 768
#define C_QG 1280
#define C_KG 1536
#define C_VG 1792
#define C_GG 2304
#define C_RF 2816
#define C_RB 2832
#define C_QL 2848
#define C_KV 3104
#define C_KR 3360
#define C_GC 3392
#define C_M1 3904
#define C_M2 4928
#define C_M3 5952

#define WS_BAR 0ul
#define WS_CTR 16384ul
#define WS_MODP 20480ul
#define WS_MOD (WS_MODP + 589824ul)
#define WS_ROPE (WS_MOD + 73728ul)
#define WS_WIN (WS_ROPE + 16384ul)
#define WS_WUQ (WS_WIN + 14417920ul)
#define WS_WUKV (WS_WUQ + 196608ul)
#define WS_WOA (WS_WUKV + 393216ul)
#define WS_WOB (WS_WOA + 1048576ul)
#define WS_WOC (WS_WOB + 1048576ul)
#define WS_WOUT (WS_WOC + 1048576ul)
#define WS_KCA (WS_WOUT + 2097152ul)
#define WS_CKVC (WS_KCA + 262144ul)
#define WS_KRC (WS_CKVC + 524288ul)
#define WS_VTA (WS_KRC + 65536ul)
#define WS_CQ (WS_VTA + 3407872ul)
#define WS_KNOPE (WS_CQ + 9437184ul)
#define WS_VTC (WS_KNOPE + 6815744ul)
#define WS_R1 (WS_VTC + 13631488ul)
#define WS_Z (WS_R1 + 25165824ul)
#define WS_END (WS_Z + 171442176ul)

#define O_Y 0
#define O_GK 12582912
#define O_GV 13631488
#define O_CKV 14680064
#define O_KR 16777216
#define O_SF 17039360
#define O_SB 18087936

struct Params {
  const float* in[30];
  float* out;
  unsigned char* ws;
};

__device__ __forceinline__ int tidx() {
  int t = threadIdx.x;
  asm volatile("" : "+v"(t));
  return t;
}
__device__ __forceinline__ Params launder(const Params& p) {
  Params q;
  long zo = 0;
  asm volatile("" : "+s"(zo));
#pragma unroll
  for (int i = 0; i < 30; i++) q.in[i] = p.in[i] + zo;
  q.out = p.out + zo;
  q.ws = p.ws + zo;
  return q;
}
__device__ __forceinline__ float bf2f(bfr b) { return __uint_as_float(((unsigned)b) << 16); }
typedef float f32x2_t __attribute__((ext_vector_type(2)));
typedef __bf16 bf16x2_t __attribute__((ext_vector_type(2)));
__device__ __forceinline__ bfr f2bf(float f) {
  __bf16 r = (__bf16)f;
  return *(bfr*)&r;
}
__device__ __forceinline__ unsigned pack2(float a, float b) {
  f32x2_t v = {a, b};
  bf16x2_t r = __builtin_convertvector(v, bf16x2_t);
  return *(unsigned*)&r;
}
__device__ __forceinline__ float lo16(unsigned u) { return __uint_as_float(u << 16); }
__device__ __forceinline__ float hi16(unsigned u) { return __uint_as_float(u & 0xffff0000u); }
__device__ __forceinline__ float siluf(float x) { return x / (1.f + __expf(-x)); }
__device__ __forceinline__ float sigmf(float x) { return 1.f / (1.f + __expf(-x)); }
__device__ __forceinline__ f32x4 mfma16(bf16x8 a, bf16x8 b, f32x4 c) {
  return __builtin_amdgcn_mfma_f32_16x16x32_bf16(a, b, c, 0, 0, 0);
}
__device__ __forceinline__ const float* xrow(const Params& p, int row) {
  return row < NCTX ? p.in[0] + (long)row * 1024 : p.in[1] + (long)(row - NCTX) * 1024;
}
__device__ __forceinline__ int row_cond(int row) { return row < NCTX ? 0 : 1 + ((row - NCTX) >> 12); }
__device__ __forceinline__ float wave_sum(float v) {
  v += __shfl_xor(v, 1); v += __shfl_xor(v, 2); v += __shfl_xor(v, 4);
  v += __shfl_xor(v, 8); v += __shfl_xor(v, 16); v += __shfl_xor(v, 32);
  return v;
}

#define XB_TMO      128
#define XB_XCNT(j)  (256  + 64 * (j))
#define XB_XSUB(j)  (1280 + 64 * (j))
#define XB_XGEN(j)  (2304 + 64 * (j))
#define XB_TOP      3328
#define XB_TOPGEN   3392
#define XCD_BAR_WORDS 3456
#define XB_SPIN_CAP (1u << 18)
#define LAS __attribute__((address_space(3)))

__device__ __forceinline__ unsigned xb_ld(unsigned* p)              { return __hip_atomic_load(p, __ATOMIC_RELAXED, __HIP_MEMORY_SCOPE_AGENT); }
__device__ __forceinline__ unsigned xb_add(unsigned* p, unsigned v) { return __hip_atomic_fetch_add(p, v, __ATOMIC_RELAXED, __HIP_MEMORY_SCOPE_AGENT); }
__device__ __forceinline__ unsigned xb_xcc_id() { return (unsigned)__builtin_amdgcn_s_getreg((3 << 11) | 20) & 0xFu; }
#define XB_SPIN(cond, bar) do { unsigned _sp = 0; while (cond) { __builtin_amdgcn_s_sleep(1); \
    if ((++_sp & 255u) == 0u) { if (xb_ld(&(bar)[XB_TMO])) break; if (_sp > XB_SPIN_CAP) { atomicAdd(&(bar)[XB_TMO], 1u); break; } } } } while (0)

struct XcdBarrier {
    unsigned* bar; unsigned x;
    volatile LAS unsigned* st;
};

__device__ __forceinline__ XcdBarrier xcd_barrier_post(unsigned* bar, volatile LAS unsigned* st) {
    XcdBarrier b; b.bar = bar; b.x = xb_xcc_id(); b.st = st;
    if (threadIdx.x == 0) (void)xb_add(&bar[XB_XCNT(b.x)], 1u);
    return b;
}
__device__ __forceinline__ void xcd_barrier_complete(unsigned* bar, unsigned x, unsigned& nloc, unsigned& nx) {
    const unsigned G = gridDim.x * gridDim.y * gridDim.z;
    unsigned sum, cnt, mine, sp = 0u;
    for (;;) {
        sum = 0u; cnt = 0u; mine = 0u;
#pragma unroll
        for (unsigned j = 0; j < 16; ++j) { const unsigned c = xb_ld(&bar[XB_XCNT(j)]); sum += c; cnt += (c > 0u) ? 1u : 0u; mine = (j == x) ? c : mine; }
        if (sum == G) break;
        __builtin_amdgcn_s_sleep(1);
        if ((++sp & 255u) == 0u) { if (xb_ld(&bar[XB_TMO])) break; if (sp > XB_SPIN_CAP) { atomicAdd(&bar[XB_TMO], 1u); break; } }
    }
    nloc = mine > 0u ? mine : 1u; nx = cnt > 0u ? cnt : 1u;
}

__device__ __forceinline__ void xcd_barrier(const XcdBarrier& b) {
    asm volatile("s_waitcnt vmcnt(0)" ::: "memory");
    __syncthreads();
    if (threadIdx.x == 0) {
        unsigned* bar = b.bar;
        __builtin_amdgcn_s_waitcnt(0);
        unsigned nloc = b.st[0], nx = b.st[1];
        if (nloc == 0u) { xcd_barrier_complete(bar, b.x, nloc, nx); b.st[0] = nloc; b.st[1] = nx; }
        const unsigned old = xb_add(&bar[XB_XSUB(b.x)], 1u);
        const unsigned gen = old / nloc;
        if (old + 1u == (gen + 1u) * nloc) {
            __builtin_amdgcn_fence(__ATOMIC_RELEASE, "agent");
            asm volatile("s_waitcnt vmcnt(0)" ::: "memory");
            const unsigned og = xb_add(&bar[XB_TOP], 1u);
            const unsigned tg = og / nx;
            if (og + 1u == (tg + 1u) * nx) xb_add(&bar[XB_TOPGEN], 1u);
            else XB_SPIN(xb_ld(&bar[XB_TOPGEN]) == tg, bar);
            __builtin_amdgcn_fence(__ATOMIC_ACQUIRE, "agent");
            xb_add(&bar[XB_XGEN(b.x)], 1u);
            asm volatile("s_waitcnt vmcnt(0)" ::: "memory");
        } else {
            XB_SPIN(xb_ld(&bar[XB_XGEN(b.x)]) == gen, bar);
            __builtin_amdgcn_fence(__ATOMIC_ACQUIRE, "agent");
            asm volatile("s_waitcnt vmcnt(0)" ::: "memory");
        }
    }
    __syncthreads();
}


#define TIDX tidx()
#define LDS3 __attribute__((address_space(3)))
__device__ __forceinline__ void glds16(const bfr* g, bfr* l) {
  __builtin_amdgcn_global_load_lds((const unsigned*)g, (LDS3 unsigned*)l, 16, 0, 0);
}
__device__ __forceinline__ void gemm128(const bfr* __restrict__ P, long ldp, int pmax,
                                        const bfr* __restrict__ Q, long ldq, int qmax, int K,
                                        f32x4 (&acc)[4][4], bfr* sm) {
  const int tid = TIDX, lane = tid & 63, wid = tid >> 6;
  const int wr = wid >> 1, wc = wid & 1;
  const int l15 = lane & 15, g = lane >> 4;
  const bfr* pp[2];
  const bfr* qp[2];
  {
    const int r0 = tid >> 2;
    const int c = (tid & 3) ^ ((tid >> 4) & 3);
#pragma unroll
    for (int i = 0; i < 2; i++) {
      int r = r0 + 64 * i;
      pp[i] = P + (long)min(r, pmax - 1) * ldp + c * 8;
      qp[i] = Q + (long)min(r, qmax - 1) * ldq + c * 8;
    }
  }
  const int nk = K >> 5;
#define GEMM_ISSUE(T)                                                    \
  do {                                                                   \
    bfr* nb_ = sm + ((T) & 3) * 8192;                                    \
    glds16(pp[0] + (T) * 32, nb_ + tid * 8);                             \
    glds16(pp[1] + (T) * 32, nb_ + 2048 + tid * 8);                      \
    glds16(qp[0] + (T) * 32, nb_ + 4096 + tid * 8);                      \
    glds16(qp[1] + (T) * 32, nb_ + 6144 + tid * 8);                      \
  } while (0)
  GEMM_ISSUE(0);
  GEMM_ISSUE(1);
  GEMM_ISSUE(2);
  const int pos = (g ^ ((l15 >> 2) & 3)) * 8;
  for (int kt = 0; kt < nk; kt++) {
    if (kt + 2 < nk) asm volatile("s_waitcnt vmcnt(8)" ::: "memory");
    else if (kt + 1 < nk) asm volatile("s_waitcnt vmcnt(4)" ::: "memory");
    else asm volatile("s_waitcnt vmcnt(0)" ::: "memory");
    __builtin_amdgcn_s_barrier();
    if (kt + 3 < nk) GEMM_ISSUE(kt + 3);
    const bfr* Ps = sm + (kt & 3) * 8192;
    const bfr* Qs = Ps + 4096;
    bf16x8 pf[4], qf[4];
#pragma unroll
    for (int m = 0; m < 4; m++) {
      pf[m] = *(const bf16x8*)(Ps + (wr * 64 + m * 16 + l15) * 32 + pos);
      qf[m] = *(const bf16x8*)(Qs + (wc * 64 + m * 16 + l15) * 32 + pos);
    }
#pragma unroll
    for (int m = 0; m < 4; m++)
#pragma unroll
      for (int n = 0; n < 4; n++) acc[m][n] = mfma16(pf[m], qf[n], acc[m][n]);
  }
#undef GEMM_ISSUE
  __syncthreads();
}

template <int NQ>
__device__ __forceinline__ void gemm128q(const bfr* __restrict__ P, long ldp, const bfr* __restrict__ Q, long ldq, int K,
                                         f32x4 (&acc)[4][NQ], bfr* sm) {
  constexpr int QI = NQ / 2;
  constexpr int STG = 4096 + QI * 2048;
  const int tid = TIDX, lane = tid & 63, wid = tid >> 6;
  const int wr = wid >> 1, wc = wid & 1;
  const int l15 = lane & 15, g = lane >> 4;
  const bfr* pp[2];
  const bfr* qp[QI];
  {
    const int r0 = tid >> 2;
    const int c = (tid & 3) ^ (((tid >> 5) & 1) * 3);
#pragma unroll
    for (int i = 0; i < 2; i++) pp[i] = P + (long)(r0 + 64 * i) * ldp + c * 8;
#pragma unroll
    for (int i = 0; i < QI; i++) qp[i] = Q + (long)(r0 + 64 * i) * ldq + c * 8;
  }
  const int nk = K >> 5;
  auto issue = [&](int T) {
    bfr* nb_ = sm + (T & 3) * STG;
    glds16(pp[0] + T * 32, nb_ + tid * 8);
    glds16(pp[1] + T * 32, nb_ + 2048 + tid * 8);
#pragma unroll
    for (int i = 0; i < QI; i++) glds16(qp[i] + T * 32, nb_ + 4096 + i * 2048 + tid * 8);
  };
  issue(0);
  issue(1);
  issue(2);
  const int pos = (g ^ (((l15 >> 3) & 1) * 3)) * 8;
  for (int kt = 0; kt < nk; kt++) {
    if (kt + 2 < nk) {
      if (QI == 2) asm volatile("s_waitcnt vmcnt(8)" ::: "memory"); else asm volatile("s_waitcnt vmcnt(6)" ::: "memory");
    } else if (kt + 1 < nk) {
      if (QI == 2) asm volatile("s_waitcnt vmcnt(4)" ::: "memory"); else asm volatile("s_waitcnt vmcnt(3)" ::: "memory");
    } else {
      asm volatile("s_waitcnt vmcnt(0)" ::: "memory");
    }
    __builtin_amdgcn_s_barrier();
    if (kt + 3 < nk) issue(kt + 3);
    const bfr* Ps = sm + (kt & 3) * STG;
    const bfr* Qs = Ps + 4096;
    bf16x8 pf[4], qf[NQ];
#pragma unroll
    for (int m = 0; m < 4; m++) pf[m] = *(const bf16x8*)(Ps + (wr * 64 + m * 16 + l15) * 32 + pos);
#pragma unroll
    for (int n = 0; n < NQ; n++) qf[n] = *(const bf16x8*)(Qs + (wc * 16 * NQ + n * 16 + l15) * 32 + pos);
#pragma unroll
    for (int m = 0; m < 4; m++)
#pragma unroll
      for (int n = 0; n < NQ; n++) acc[m][n] = mfma16(pf[m], qf[n], acc[m][n]);
  }
  __syncthreads();
}

template <int NQ>
__device__ __forceinline__ void gemm256x128(const bfr* __restrict__ P, long ldp, int pmax,
                                            const bfr* __restrict__ Q, long ldq, int K,
                                            f32x4 (&acc)[8][NQ], bfr* sm) {
  constexpr int QI = NQ / 2;
  constexpr int STG = 8192 + QI * 2048;
  const int tid = TIDX, lane = tid & 63, wid = tid >> 6;
  const int wr = wid >> 1, wc = wid & 1;
  const int l15 = lane & 15, g = lane >> 4;
  const bfr* pp[4];
  const bfr* qp[QI];
  {
    const int r0 = tid >> 2;
    const int c = (tid & 3) ^ (((tid >> 5) & 1) * 3);
#pragma unroll
    for (int i = 0; i < 4; i++) pp[i] = P + (long)min(r0 + 64 * i, pmax - 1) * ldp + c * 8;
#pragma unroll
    for (int i = 0; i < QI; i++) qp[i] = Q + (long)(r0 + 64 * i) * ldq + c * 8;
  }
  const int nk = K >> 5;
  auto issue = [&](int T, int stg) {
    bfr* nb_ = sm + stg * STG;
    glds16(pp[0] + T * 32, nb_ + tid * 8);
    glds16(pp[1] + T * 32, nb_ + 2048 + tid * 8);
    glds16(pp[2] + T * 32, nb_ + 4096 + tid * 8);
    glds16(pp[3] + T * 32, nb_ + 6144 + tid * 8);
#pragma unroll
    for (int i = 0; i < QI; i++) glds16(qp[i] + T * 32, nb_ + 8192 + i * 2048 + tid * 8);
  };
  issue(0, 0);
  issue(1, 1);
  const int pos = (g ^ (((l15 >> 3) & 1) * 3)) * 8;
  int st = 0;
  for (int kt = 0; kt < nk; kt++) {
    if (kt + 1 < nk) {
      if (QI == 2) asm volatile("s_waitcnt vmcnt(6)" ::: "memory"); else asm volatile("s_waitcnt vmcnt(5)" ::: "memory");
    } else {
      asm volatile("s_waitcnt vmcnt(0)" ::: "memory");
    }
    __builtin_amdgcn_s_barrier();
    if (kt + 2 < nk) issue(kt + 2, st == 0 ? 2 : st - 1);
    const bfr* Ps = sm + st * STG;
    const bfr* Qs = Ps + 8192;
    st = (st == 2) ? 0 : st + 1;
    bf16x8 qf[NQ], pf[8];
#pragma unroll
    for (int n = 0; n < NQ; n++) qf[n] = *(const bf16x8*)(Qs + (wc * 16 * NQ + n * 16 + l15) * 32 + pos);
#pragma unroll
    for (int m = 0; m < 8; m++) pf[m] = *(const bf16x8*)(Ps + (wr * 128 + m * 16 + l15) * 32 + pos);
#pragma unroll
    for (int m = 0; m < 8; m++)
#pragma unroll
      for (int n = 0; n < NQ; n++) acc[m][n] = mfma16(pf[m], qf[n], acc[m][n]);
    __builtin_amdgcn_sched_group_barrier(0x100, NQ + 2, 0);
#pragma unroll
    for (int i = 0; i < 6; i++) {
      __builtin_amdgcn_sched_group_barrier(0x008, NQ, 0);
      __builtin_amdgcn_sched_group_barrier(0x100, 1, 0);
    }
    __builtin_amdgcn_sched_group_barrier(0x008, 2 * NQ, 0);
  }
  __syncthreads();
}

template <int NQ, bool PIPE, bool TAIL = false>
__device__ __forceinline__ void gemm128k64(const bfr* __restrict__ P, long ldp, int pmax,
                                           const bfr* __restrict__ Q, long ldq, int K,
                                           f32x4 (&acc)[4][NQ], bfr* sm, const bfr* tail_src = nullptr, long tail_ld = 0) {
  constexpr int STG = 8192 + 2048 * NQ;
  const int tid = TIDX, lane = tid & 63, wid = tid >> 6;
  const int wr = wid >> 1, wc = wid & 1;
  const int l15 = lane & 15, g = lane >> 4;
  const bfr* pp[4];
  const bfr* qp[NQ];
  {
    const int r0 = tid >> 3;
    const int c = (tid & 7) ^ ((tid >> 4) & 7);
#pragma unroll
    for (int i = 0; i < 4; i++) pp[i] = P + (long)min(r0 + 32 * i, pmax - 1) * ldp + c * 8;
#pragma unroll
    for (int i = 0; i < NQ; i++) qp[i] = Q + (long)(r0 + 32 * i) * ldq + c * 8;
  }
  const int nk = K >> 6;
#pragma unroll
  for (int i = 0; i < 4; i++) glds16(pp[i], sm + i * 2048 + tid * 8);
#pragma unroll
  for (int i = 0; i < NQ; i++) glds16(qp[i], sm + 8192 + i * 2048 + tid * 8);
  const int swz = l15 >> 1;
  for (int kt = 0; kt < nk; kt++) {
    asm volatile("s_waitcnt vmcnt(0)" ::: "memory");
    __builtin_amdgcn_s_barrier();
    if (kt + 1 < nk) {
      bfr* nb = sm + ((kt + 1) & 1) * STG;
#pragma unroll
      for (int i = 0; i < 4; i++) glds16(pp[i] + (kt + 1) * 64, nb + i * 2048 + tid * 8);
#pragma unroll
      for (int i = 0; i < NQ; i++) glds16(qp[i] + (kt + 1) * 64, nb + 8192 + i * 2048 + tid * 8);
    } else if (TAIL) {
      bfr* nb = sm + ((kt + 1) & 1) * STG;
      const bfr* ts = tail_src + (long)(tid >> 4) * tail_ld + (((tid & 15) ^ ((tid >> 4) & 15)) * 8);
#pragma unroll
      for (int i = 0; i < 2 * NQ; i++) glds16(ts + (long)(16 * i) * tail_ld, nb + i * 2048 + tid * 8);
    }
    const bfr* Ps = sm + (kt & 1) * STG;
    const bfr* Qs = Ps + 8192;
    if (PIPE) {
      bf16x8 pf[2][4], qf[2][NQ];
#pragma unroll
      for (int kk = 0; kk < 2; kk++) {
        const int pos = ((kk * 4 + g) ^ swz) * 8;
#pragma unroll
        for (int m = 0; m < 4; m++) pf[kk][m] = *(const bf16x8*)(Ps + (wr * 64 + m * 16 + l15) * 64 + pos);
#pragma unroll
        for (int n = 0; n < NQ; n++) qf[kk][n] = *(const bf16x8*)(Qs + (wc * 16 * NQ + n * 16 + l15) * 64 + pos);
      }
#pragma unroll
      for (int kk = 0; kk < 2; kk++)
#pragma unroll
        for (int m = 0; m < 4; m++)
#pragma unroll
          for (int n = 0; n < NQ; n++) acc[m][n] = mfma16(pf[kk][m], qf[kk][n], acc[m][n]);
      __builtin_amdgcn_sched_group_barrier(0x100, 4 + NQ, 0);
#pragma unroll
      for (int i = 0; i < 4 + NQ; i++) {
        __builtin_amdgcn_sched_group_barrier(0x008, NQ == 4 ? 2 : 1, 0);
        __builtin_amdgcn_sched_group_barrier(0x100, 1, 0);
      }
      __builtin_amdgcn_sched_group_barrier(0x008, NQ == 4 ? 16 : 10, 0);
    } else {
#pragma unroll
      for (int kk = 0; kk < 2; kk++) {
        bf16x8 pf[4], qf[NQ];
        const int pos = ((kk * 4 + g) ^ swz) * 8;
#pragma unroll
        for (int m = 0; m < 4; m++) pf[m] = *(const bf16x8*)(Ps + (wr * 64 + m * 16 + l15) * 64 + pos);
#pragma unroll
        for (int n = 0; n < NQ; n++) qf[n] = *(const bf16x8*)(Qs + (wc * 16 * NQ + n * 16 + l15) * 64 + pos);
#pragma unroll
        for (int m = 0; m < 4; m++)
#pragma unroll
          for (int n = 0; n < NQ; n++) acc[m][n] = mfma16(pf[m], qf[n], acc[m][n]);
      }
    }
  }
  if (TAIL) asm volatile("s_waitcnt vmcnt(0)" ::: "memory");
  __syncthreads();
}

__device__ __forceinline__ void gemm160x128(const bfr* __restrict__ P, long ldp, int pmax,
                                            const bfr* __restrict__ Q, long ldq, int K,
                                            f32x4 (&acc)[5][4], bfr* sm) {
  constexpr int STG = 160 * 64 + 128 * 64;
  const int tid = TIDX, lane = tid & 63, wid = tid >> 6;
  const int wr = wid >> 1, wc = wid & 1;
  const int l15 = lane & 15, g = lane >> 4;
  const bfr* pp[5];
  const bfr* qp[4];
  {
    const int r0 = tid >> 3;
    const int c = (tid & 7) ^ ((tid >> 4) & 7);
#pragma unroll
    for (int i = 0; i < 5; i++) pp[i] = P + (long)min(r0 + 32 * i, pmax - 1) * ldp + c * 8;
#pragma unroll
    for (int i = 0; i < 4; i++) qp[i] = Q + (long)(r0 + 32 * i) * ldq + c * 8;
  }
  const int nk = K >> 6;
#pragma unroll
  for (int i = 0; i < 5; i++) glds16(pp[i], sm + i * 2048 + tid * 8);
#pragma unroll
  for (int i = 0; i < 4; i++) glds16(qp[i], sm + 10240 + i * 2048 + tid * 8);
  const int swz = l15 >> 1;
  for (int kt = 0; kt < nk; kt++) {
    asm volatile("s_waitcnt vmcnt(0)" ::: "memory");
    __builtin_amdgcn_s_barrier();
    if (kt + 1 < nk) {
      bfr* nb = sm + ((kt + 1) & 1) * STG;
#pragma unroll
      for (int i = 0; i < 5; i++) glds16(pp[i] + (kt + 1) * 64, nb + i * 2048 + tid * 8);
#pragma unroll
      for (int i = 0; i < 4; i++) glds16(qp[i] + (kt + 1) * 64, nb + 10240 + i * 2048 + tid * 8);
    }
    const bfr* Ps = sm + (kt & 1) * STG;
    const bfr* Qs = Ps + 10240;
    bf16x8 pf[2][5], qf[2][4];
#pragma unroll
    for (int kk = 0; kk < 2; kk++) {
      const int pos = ((kk * 4 + g) ^ swz) * 8;
#pragma unroll
      for (int m = 0; m < 5; m++) pf[kk][m] = *(const bf16x8*)(Ps + (wr * 80 + m * 16 + l15) * 64 + pos);
#pragma unroll
      for (int n = 0; n < 4; n++) qf[kk][n] = *(const bf16x8*)(Qs + (wc * 64 + n * 16 + l15) * 64 + pos);
    }
#pragma unroll
    for (int kk = 0; kk < 2; kk++)
#pragma unroll
      for (int m = 0; m < 5; m++)
#pragma unroll
        for (int n = 0; n < 4; n++) acc[m][n] = mfma16(pf[kk][m], qf[kk][n], acc[m][n]);
    __builtin_amdgcn_sched_group_barrier(0x100, 9, 0);
#pragma unroll
    for (int i = 0; i < 9; i++) {
      __builtin_amdgcn_sched_group_barrier(0x008, 2, 0);
      __builtin_amdgcn_sched_group_barrier(0x100, 1, 0);
    }
    __builtin_amdgcn_sched_group_barrier(0x008, 22, 0);
  }
  __syncthreads();
}

__device__ __forceinline__ void phase_s0(const Params& p, bfr* sm) {
  const int tid = TIDX;
  float* rope = (float*)(p.ws + WS_ROPE);
  for (int idx = blockIdx.x * 256 + tid; idx < 1536; idx += gridDim.x * 256) {
    if (idx < 1024) {
      int pos = idx >> 4, i = idx & 15;
      float fr = powf(10000.f, -(float)i / 16.f);
      float a = (float)pos * fr;
      rope[idx] = cosf(a);
      rope[1024 + idx] = sinf(a);
    } else {
      int j = idx - 1024;
      int pos = j >> 3, i = j & 7;
      float fr = powf(10000.f, -(float)i / 8.f);
      float a = (float)pos * fr;
      rope[2048 + j] = cosf(a);
      rope[2560 + j] = sinf(a);
    }
  }
  float* smf = (float*)sm;
  float* modp = (float*)(p.ws + WS_MODP);
  for (int it = blockIdx.x; it < 768; it += gridDim.x) {
    int l = it / 384, rem = it % 384, cgp = rem >> 3, ks = rem & 7;
    int col = cgp * 64 + (tid & 63), kq = tid >> 6;
    const float* w = p.in[10] + (long)l * 1024 * 3072 + col;
    float a0 = 0.f, a1 = 0.f, a2 = 0.f;
    int k0 = ks * 128 + kq * 32;
#pragma unroll 8
    for (int k = k0; k < k0 + 32; k++) {
      float wv = w[(long)k * 3072];
      a0 += siluf(p.in[9][k]) * wv;
      a1 += siluf(p.in[8][k]) * wv;
      a2 += siluf(p.in[8][1024 + k]) * wv;
    }
    smf[(kq * 3 + 0) * 64 + (tid & 63)] = a0;
    smf[(kq * 3 + 1) * 64 + (tid & 63)] = a1;
    smf[(kq * 3 + 2) * 64 + (tid & 63)] = a2;
    __syncthreads();
    if (tid < 192) {
      int c = tid >> 6, cc = tid & 63;
      float s = smf[(0 * 3 + c) * 64 + cc] + smf[(1 * 3 + c) * 64 + cc] + smf[(2 * 3 + c) * 64 + cc] + smf[(3 * 3 + c) * 64 + cc];
      modp[((ks * 2 + l) * 3 + c) * 3072 + cgp * 64 + cc] = s;
    }
    __syncthreads();
  }
}

__device__ __forceinline__ void phase_s1(const Params& p) {
  float* modp = (float*)(p.ws + WS_MODP);
  float* mod = (float*)(p.ws + WS_MOD);
  for (int idx = blockIdx.x * 256 + TIDX; idx < 2 * 3 * 3072; idx += gridDim.x * 256) {
    int l = idx / 9216, n = idx % 3072;
    float s = p.in[11][l * 3072 + n];
#pragma unroll
    for (int ks = 0; ks < 8; ks++) s += modp[ks * 18432 + idx];
    mod[idx] = s;
  }
}

#define WCONV_ITEMS 2456
struct WcItem { const float* src; bfr* dst; int K, N, tk, tn; };
__device__ __forceinline__ WcItem wconv_decode(const Params& p, int l, int item) {
  WcItem w;
  if (item < 1744) {
    w.src = p.in[14] + (long)l * 1024 * 6976; w.K = 1024; w.N = 6976; w.dst = (bfr*)(p.ws + WS_WIN); w.tk = item & 15; w.tn = item >> 4;
  } else if (item < 1768) {
    item -= 1744;
    w.src = p.in[24] + (long)l * 256 * 384; w.K = 256; w.N = 384; w.dst = (bfr*)(p.ws + WS_WUQ); w.tk = item & 3; w.tn = item >> 2;
  } else if (item < 1816) {
    item -= 1768;
    w.src = p.in[25] + (long)l * 256 * 768; w.K = 256; w.N = 768; w.dst = (bfr*)(p.ws + WS_WUKV); w.tk = item & 3; w.tn = item >> 2;
  } else if (item < 2200) {
    item -= 1816;
    int ww = item >> 7, it = item & 127;
    w.src = (ww == 0 ? p.in[26] : (ww == 1 ? p.in[27] : p.in[28])) + (long)l * 512 * 1024;
    w.K = 512; w.N = 1024; w.dst = (bfr*)(p.ws + WS_WOA + (unsigned long)ww * 1048576ul); w.tk = it & 7; w.tn = it >> 3;
  } else {
    item -= 2200;
    w.src = p.in[29] + (long)l * 1024 * 1024; w.K = 1024; w.N = 1024; w.dst = (bfr*)(p.ws + WS_WOUT); w.tk = item & 15; w.tn = item >> 4;
  }
  return w;
}
__device__ __forceinline__ void wconv_phase(const Params& p, int l, bfr* sm) {
  bfr* sT = sm;
  const int tid = TIDX;
  const int n4 = (tid & 15) * 4, k0 = (tid >> 4) * 4;
  float4 v[4];
  int item = blockIdx.x;
  if (item < WCONV_ITEMS) {
    WcItem w = wconv_decode(p, l, item);
#pragma unroll
    for (int i = 0; i < 4; i++) v[i] = *(const float4*)(w.src + (long)(w.tk * 64 + k0 + i) * w.N + w.tn * 64 + n4);
  }
  const int wcol = (((k0 >> 3) ^ ((n4 >> 2) & 7)) * 8) + (k0 & 4);
  for (; item < WCONV_ITEMS; item += gridDim.x) {
    WcItem w = wconv_decode(p, l, item);
    {
      u32x2 o;
      o.x = pack2(v[0].x, v[1].x); o.y = pack2(v[2].x, v[3].x);
      *(u32x2*)(sT + (n4 + 0) * 64 + wcol) = o;
      o.x = pack2(v[0].y, v[1].y); o.y = pack2(v[2].y, v[3].y);
      *(u32x2*)(sT + (n4 + 1) * 64 + wcol) = o;
      o.x = pack2(v[0].z, v[1].z); o.y = pack2(v[2].z, v[3].z);
      *(u32x2*)(sT + (n4 + 2) * 64 + wcol) = o;
      o.x = pack2(v[0].w, v[1].w); o.y = pack2(v[2].w, v[3].w);
      *(u32x2*)(sT + (n4 + 3) * 64 + wcol) = o;
    }
    const int nitem = item + gridDim.x;
    if (nitem < WCONV_ITEMS) {
      WcItem wn = wconv_decode(p, l, nitem);
#pragma unroll
      for (int i = 0; i < 4; i++) v[i] = *(const float4*)(wn.src + (long)(wn.tk * 64 + k0 + i) * wn.N + wn.tn * 64 + n4);
    }
    __syncthreads();
#pragma unroll
    for (int i = 0; i < 2; i++) {
      int c = tid + 256 * i;
      int n = c >> 3, kc = c & 7;
      *(u32x4*)(w.dst + (long)(w.tn * 64 + n) * w.K + w.tk * 64 + kc * 8) = *(const u32x4*)(sT + n * 64 + ((kc ^ ((n >> 2) & 7)) * 8));
    }
    __syncthreads();
  }
}

__device__ __forceinline__ void phase_prenorm0(const Params& p) {
  const int lane = TIDX & 63;
  const float* mod = (const float*)(p.ws + WS_MOD);
  bfr* H = (bfr*)(p.ws + WS_R1);
  for (int row = blockIdx.x * 4 + (TIDX >> 6); row < NROWS; row += gridDim.x * 4) {
    const float* x = xrow(p, row);
    const float* md = mod + (0 * 3 + row_cond(row)) * 3072;
    float4 v[4];
    float ss = 0.f;
#pragma unroll
    for (int i = 0; i < 4; i++) {
      v[i] = *(const float4*)(x + i * 256 + lane * 4);
      ss += v[i].x * v[i].x + v[i].y * v[i].y + v[i].z * v[i].z + v[i].w * v[i].w;
    }
    ss = wave_sum(ss);
    float rs = rsqrtf(ss * (1.f / 1024.f) + 1e-6f);
#pragma unroll
    for (int i = 0; i < 4; i++) {
      int n = i * 256 + lane * 4;
      float4 g = *(const float4*)(p.in[12] + n);
      float4 sh = *(const float4*)(md + n);
      float4 sc = *(const float4*)(md + 1024 + n);
      float h0 = v[i].x * rs * g.x * (1.f + sc.x) + sh.x;
      float h1 = v[i].y * rs * g.y * (1.f + sc.y) + sh.y;
      float h2 = v[i].z * rs * g.z * (1.f + sc.z) + sh.z;
      float h3 = v[i].w * rs * g.w * (1.f + sc.w) + sh.w;
      u32x2 o;
      o.x = pack2(h0, h1);
      o.y = pack2(h2, h3);
      *(u32x2*)(H + (long)row * 1024 + n) = o;
    }
  }
}

__device__ __forceinline__ unsigned xcc_id() { return (unsigned)__builtin_amdgcn_s_getreg((3 << 11) | 20) & 7u; }
template <class CountF>
__device__ __forceinline__ int xq_take(unsigned* ctr, int& q, int& tried, unsigned first, CountF cnt) {
  unsigned j = first;
  for (;;) {
    if (j < (unsigned)cnt(q)) return (q << 20) | (int)j;
    q = (q + 1) & 7;
    if (++tried >= 8) return -1;
    j = atomicAdd(ctr + q * 16, 1u);
  }
}

__device__ __forceinline__ void phase_inproj(const Params& p, int l, bfr* sm, int* s_item, int slot) {
  const bfr* H = (const bfr*)(p.ws + WS_R1);
  const bfr* W = (const bfr*)(p.ws + WS_WIN);
  bfr* Z = (bfr*)(p.ws + WS_Z);
  const int tid = TIDX;
  const int lane = tid & 63, wid = tid >> 6, wr = wid >> 1, wc = wid & 1;
  unsigned* ctr = (unsigned*)(p.ws + WS_CTR) + slot * 128;
  auto cnt = [](int q) { return 96 * ((44 * (q + 1)) / 8 - (44 * q) / 8); };
  int q = (int)xcc_id(), tried = 0;
  unsigned nxt = 0;
  if (tid == 0) nxt = atomicAdd(ctr + q * 16, 1u);
  for (;;) {
    if (tid == 0) *s_item = xq_take(ctr, q, tried, nxt, cnt);
    __syncthreads();
    const int it = *s_item;
    __syncthreads();
    if (it < 0) break;
    const int qq = it >> 20, j = it & 0xfffff;
    if (tid == 0) nxt = atomicAdd(ctr + q * 16, 1u);
    const int tn0 = (44 * qq) / 8, w = (44 * (qq + 1)) / 8 - tn0;
    const int tm = j / w, tn = tn0 + j % w;
    f32x4 acc[5][4];
#pragma unroll
    for (int a = 0; a < 5; a++)
#pragma unroll
      for (int b = 0; b < 4; b++) acc[a][b] = (f32x4){0.f, 0.f, 0.f, 0.f};
    gemm160x128(W + (long)tn * 160 * 1024, 1024, ZLD - tn * 160, H + (long)tm * 128 * 1024, 1024, 1024, acc, sm);
    {
      const int g = lane >> 4, l15 = lane & 15;
#pragma unroll
      for (int pi = 0; pi < 5; pi++)
#pragma unroll
        for (int qi = 0; qi < 4; qi++) {
          u32x2 o;
          o.x = pack2(acc[pi][qi][0], acc[pi][qi][1]);
          o.y = pack2(acc[pi][qi][2], acc[pi][qi][3]);
          *(u32x2*)(sm + (wc * 64 + qi * 16 + l15) * 168 + wr * 80 + pi * 16 + g * 4) = o;
        }
      __syncthreads();
      const int ncol = min(20, (ZLD - tn * 160) >> 3);
#pragma unroll
      for (int i = 0; i < 10; i++) {
        int c = tid + 256 * i;
        int row = c / 20, c16 = c % 20;
        if (c16 < ncol)
          *(u32x4*)(Z + (long)(tm * 128 + row) * ZLD + tn * 160 + c16 * 8) = *(const u32x4*)(sm + row * 168 + c16 * 8);
      }
      __syncthreads();
    }
  }
}

__device__ __forceinline__ void unpack8(u32x4 v, float* x) {
  x[0] = lo16(v.x); x[1] = hi16(v.x); x[2] = lo16(v.y); x[3] = hi16(v.y);
  x[4] = lo16(v.z); x[5] = hi16(v.z); x[6] = lo16(v.w); x[7] = hi16(v.w);
}
__device__ __forceinline__ u32x4 pack8(const float* y) {
  u32x4 o;
  o.x = pack2(y[0], y[1]); o.y = pack2(y[2], y[3]); o.z = pack2(y[4], y[5]); o.w = pack2(y[6], y[7]);
  return o;
}

__device__ __forceinline__ void phase_rowpost(const Params& p, int l) {
  const int lane = TIDX & 63;
  bfr* Z = (bfr*)(p.ws + WS_Z);
  const float* rope = (const float*)(p.ws + WS_ROPE);
  bfr* VTA = (bfr*)(p.ws + WS_VTA);
  bfr* KCA = (bfr*)(p.ws + WS_KCA);
  bfr* CKVC = (bfr*)(p.ws + WS_CKVC);
  bfr* KRC = (bfr*)(p.ws + WS_KRC);
  float* out = p.out;
  for (int row = blockIdx.x * 4 + (TIDX >> 6); row < NROWS + 1024; row += gridDim.x * 4) {
    if (row < NROWS) {
      const bool lat = row >= NCTX;
      const int bc = row >> 8, tc = row & 255;
      const int bl = (row - NCTX) >> 12, tl = (row - NCTX) & 4095;
      const int prow = tl >> 6, pcol = tl & 63;
      bfr* z = Z + (long)row * ZLD;
      {
        float x[8];
        unpack8(*(const u32x4*)(z + C_QA + lane * 8), x);
        float ss = 0.f;
#pragma unroll
        for (int e = 0; e < 8; e++) ss += x[e] * x[e];
        ss += __shfl_xor(ss, 1); ss += __shfl_xor(ss, 2); ss += __shfl_xor(ss, 4);
        float rs = rsqrtf(ss * (1.f / 64.f) + 1e-6f);
        int sub = lane & 7;
        const float* g = p.in[15] + l * 64 + sub * 8;
#pragma unroll
        for (int e = 0; e < 8; e++) x[e] = x[e] * rs * g[e];
        if (lat) {
          int pos = (sub >> 2) ? pcol : prow;
          bool hi = (sub & 2) != 0;
          int i0 = (sub & 1) * 8;
#pragma unroll
          for (int e = 0; e < 8; e++) {
            float yp = __shfl_xor(x[e], 2);
            float c = rope[pos * 16 + i0 + e], s = rope[1024 + pos * 16 + i0 + e];
            x[e] = hi ? (yp * s + x[e] * c) : (x[e] * c - yp * s);
          }
        }
        const float qs = 0.125f * 1.4426950408889634f;
#pragma unroll
        for (int e = 0; e < 8; e++) x[e] *= qs;
        *(u32x4*)(z + C_QA + lane * 8) = pack8(x);
      }
      {
        int L = lane & 15;
        float x[8];
        unpack8(*(const u32x4*)(z + C_KA + L * 8), x);
        float ss = 0.f;
#pragma unroll
        for (int e = 0; e < 8; e++) ss += x[e] * x[e];
        ss += __shfl_xor(ss, 1); ss += __shfl_xor(ss, 2); ss += __shfl_xor(ss, 4);
        float rs = rsqrtf(ss * (1.f / 64.f) + 1e-6f);
        int sub = L & 7;
        const float* g = p.in[16] + l * 64 + sub * 8;
#pragma unroll
        for (int e = 0; e < 8; e++) x[e] = x[e] * rs * g[e];
        if (lat) {
          int pos = (sub >> 2) ? pcol : prow;
          bool hi = (sub & 2) != 0;
          int i0 = (sub & 1) * 8;
#pragma unroll
          for (int e = 0; e < 8; e++) {
            float yp = __shfl_xor(x[e], 2);
            float c = rope[pos * 16 + i0 + e], s = rope[1024 + pos * 16 + i0 + e];
            x[e] = hi ? (yp * s + x[e] * c) : (x[e] * c - yp * s);
          }
        } else if (lane < 16) {
          float* o = out + O_GK + ((long)(bc * 2 + l) * 256 + tc) * 128 + L * 8;
          *(float4*)(o) = make_float4(x[0], x[1], x[2], x[3]);
          *(float4*)(o + 4) = make_float4(x[4], x[5], x[6], x[7]);
        }
        if (lane < 16) *(u32x4*)(z + C_KA + L * 8) = pack8(x);
      }
      if (lane < 16) {
        int L = lane;
        u32x4 raw = *(const u32x4*)(z + C_VA + L * 8);
        float x[8];
        unpack8(raw, x);
        if (!lat) {
          float* o = out + O_GV + ((long)(bc * 2 + l) * 256 + tc) * 128 + L * 8;
          *(float4*)(o) = make_float4(x[0], x[1], x[2], x[3]);
          *(float4*)(o + 4) = make_float4(x[4], x[5], x[6], x[7]);
        }
        int g = L >> 3, d0 = (L & 7) * 8;
        long base; int nk, key;
        if (!lat) { base = (long)bc * 32768; nk = 256; key = tc; }
        else { base = 16l * 32768 + (long)bl * (2 * 64 * 4608); nk = 4608; key = 512 + tl; }
        const bfr* rb = (const bfr*)&raw;
#pragma unroll
        for (int e = 0; e < 8; e++) VTA[base + (long)(g * 64 + d0 + e) * nk + key] = rb[e];
      }
      {
        u32x2 rq = *(const u32x2*)(z + C_QL + lane * 4);
        u32x2 rk = *(const u32x2*)(z + C_KV + lane * 4);
        float q[4] = {lo16(rq.x), hi16(rq.x), lo16(rq.y), hi16(rq.y)};
        float k[4] = {lo16(rk.x), hi16(rk.x), lo16(rk.y), hi16(rk.y)};
        float sq = q[0] * q[0] + q[1] * q[1] + q[2] * q[2] + q[3] * q[3];
        float sk = k[0] * k[0] + k[1] * k[1] + k[2] * k[2] + k[3] * k[3];
        sq = wave_sum(sq);
        sk = wave_sum(sk);
        float rq_ = rsqrtf(sq * (1.f / 256.f) + 1e-6f), rk_ = rsqrtf(sk * (1.f / 256.f) + 1e-6f);
        float4 gq = *(const float4*)(p.in[22] + l * 256 + lane * 4);
        float4 gk = *(const float4*)(p.in[23] + l * 256 + lane * 4);
        q[0] *= rq_ * gq.x; q[1] *= rq_ * gq.y; q[2] *= rq_ * gq.z; q[3] *= rq_ * gq.w;
        k[0] *= rk_ * gk.x; k[1] *= rk_ * gk.y; k[2] *= rk_ * gk.z; k[3] *= rk_ * gk.w;
        u32x2 o;
        o.x = pack2(q[0], q[1]); o.y = pack2(q[2], q[3]);
        *(u32x2*)(z + C_QL + lane * 4) = o;
        o.x = pack2(k[0], k[1]); o.y = pack2(k[2], k[3]);
        *(u32x2*)(z + C_KV + lane * 4) = o;
        if (!lat) *(float4*)(out + O_CKV + ((long)(bc * 2 + l) * 256 + tc) * 256 + lane * 4) = make_float4(k[0], k[1], k[2], k[3]);
      }
      {
        int L = lane & 3;
        float x[8];
        unpack8(*(const u32x4*)(z + C_KR + L * 8), x);
        if (lat) {
          int pos = (L >> 1) ? pcol : prow;
          bool hi = (L & 1) != 0;
#pragma unroll
          for (int e = 0; e < 8; e++) {
            float yp = __shfl_xor(x[e], 1);
            float c = rope[2048 + pos * 8 + e], s = rope[2560 + pos * 8 + e];
            x[e] = hi ? (yp * s + x[e] * c) : (x[e] * c - yp * s);
          }
          if (lane < 4) *(u32x4*)(z + C_KR + L * 8) = pack8(x);
        } else if (lane < 4) {
          float* o = out + O_KR + ((long)(bc * 2 + l) * 256 + tc) * 32 + L * 8;
          *(float4*)(o) = make_float4(x[0], x[1], x[2], x[3]);
          *(float4*)(o + 4) = make_float4(x[4], x[5], x[6], x[7]);
        }
      }
    } else {
      int cr = row - NROWS;
      int b = cr >> 9, t = cr & 511;
      long src = (long)(b * 2 + l) * 512 + t;
      {
        float2 kv = *(const float2*)(p.in[2] + src * 128 + lane * 2);
        *(unsigned*)(KCA + (long)(b * 512 + t) * 128 + lane * 2) = pack2(kv.x, kv.y);
        float2 vv = *(const float2*)(p.in[3] + src * 128 + lane * 2);
        int c0 = lane * 2;
        long base = 16l * 32768 + (long)b * (2 * 64 * 4608);
        VTA[base + (long)c0 * 4608 + t] = f2bf(vv.x);
        VTA[base + (long)(c0 + 1) * 4608 + t] = f2bf(vv.y);
        float4 cv = *(const float4*)(p.in[4] + src * 256 + lane * 4);
        u32x2 o;
        o.x = pack2(cv.x, cv.y); o.y = pack2(cv.z, cv.w);
        *(u32x2*)(CKVC + (long)(b * 512 + t) * 256 + lane * 4) = o;
        if (lane < 32) KRC[(long)(b * 512 + t) * 32 + lane] = f2bf(p.in[5][src * 32 + lane]);
      }
    }
  }
}

#define WS_PREP1 251703296ul
#define WS_EL (WS_WIN + 12582912ul)
__device__ __forceinline__ bfr* prep_base(const Params& p, int b, int h, int dir, int c) {
  return (bfr*)(p.ws + (b ? WS_PREP1 : WS_WIN)) + (long)((h * 2 + dir) * 64 + c) * 12288;
}

__device__ __forceinline__ void gla_chunk_prep(int tid, const float (&wd)[16], float bias, const bfr* Qr, const bfr* Kr,
                                               bfr* Qe, bfr* Ke, bfr* KlT, const float* RF, float* tot, float* lastv) {
  const int ch = tid & 63, part = tid >> 6;
  float cum[16];
  {
    float run = 0.f;
#pragma unroll
    for (int ii = 0; ii < 16; ii++) {
      int i = part * 16 + ii;
      float x = bias;
#pragma unroll
      for (int r = 0; r < 16; r++) x += RF[i * 16 + r] * wd[r];
      float la = (fminf(x, 0.f) - __logf(1.f + __expf(-fabsf(x)))) * (1.f / 16.f);
      run += la;
      cum[ii] = run;
    }
    tot[part * 64 + ch] = run;
  }
  __syncthreads();
  {
    float off = 0.f, last = 0.f;
#pragma unroll
    for (int pp = 0; pp < 4; pp++) {
      float tv = tot[pp * 64 + ch];
      if (pp < part) off += tv;
      last += tv;
    }
    if (part == 0) lastv[ch] = last;
#pragma unroll
    for (int ii = 0; ii < 16; ii++) {
      int i = part * 16 + ii;
      float cc = cum[ii] + off;
      float qv = bf2f(Qr[i * LDT + ch]), kv = bf2f(Kr[i * LDT + ch]);
      Qe[i * LDT + ch] = f2bf(qv * __expf(cc) * 0.125f);
      Ke[i * LDT + ch] = f2bf(kv * __expf(-cc));
      KlT[ch * LDT + i] = f2bf(kv * __expf(last - cc));
    }
  }
  __syncthreads();
}

__device__ __forceinline__ void gla_att(int wid, int g, int l15, const bfr* Qe, const bfr* Ke, bfr* Att) {
  f32x4 att[4];
  bf16x8 qa[2];
#pragma unroll
  for (int kk = 0; kk < 2; kk++) qa[kk] = *(const bf16x8*)(Qe + (16 * wid + l15) * LDT + kk * 32 + g * 8);
#pragma unroll
  for (int nj = 0; nj < 4; nj++) {
    att[nj] = (f32x4){0.f, 0.f, 0.f, 0.f};
#pragma unroll
    for (int kk = 0; kk < 2; kk++) {
      bf16x8 kb = *(const bf16x8*)(Ke + (16 * nj + l15) * LDT + kk * 32 + g * 8);
      att[nj] = mfma16(qa[kk], kb, att[nj]);
    }
  }
#pragma unroll
  for (int nj = 0; nj < 4; nj++)
#pragma unroll
    for (int r = 0; r < 4; r++) {
      int i = 16 * wid + 4 * g + r, j = 16 * nj + l15;
      Att[i * LDT + j] = f2bf(i >= j ? att[nj][r] : 0.f);
    }
}

__device__ __forceinline__ void gla_prep_item(const Params& p, int l, int b, int h, int dir, int c, bfr* sm) {
  const int tid = TIDX, lane = tid & 63, wid = tid >> 6, g = lane >> 4, l15 = lane & 15;
  const bfr* Z = (const bfr*)(p.ws + WS_Z);
  const int N = 4096;
  const int rowbase = NCTX + b * 4096;
  bfr* Qr = sm;
  bfr* Kr = Qr + 64 * LDT;
  bfr* Qe = Kr + 64 * LDT;
  bfr* Ke = Qe + 64 * LDT;
  bfr* KlT = Ke + 64 * LDT;
  float* RF = (float*)(KlT + 64 * LDT);
  float* tot = RF + 64 * 16;
  float* lastv = tot + 256;
  bfr* Att = Qr;
  const int ch = tid & 63;
  float wd[16];
  {
    const float* W = (dir ? p.in[19] : p.in[17]) + (long)l * 16 * 256 + h * 64 + ch;
#pragma unroll
    for (int r = 0; r < 16; r++) wd[r] = W[r * 256];
  }
  const float bias = (dir ? p.in[20] : p.in[18])[l * 256 + h * 64 + ch];
#pragma unroll
  for (int ii = 0; ii < 2; ii++) {
    int cc = tid + 256 * ii;
    int i = cc >> 3, c8 = cc & 7;
    int tok = dir ? (N - 1 - (c * 64 + i)) : (c * 64 + i);
    const bfr* zr = Z + (long)(rowbase + tok) * ZLD;
    *(u32x4*)(Qr + i * LDT + c8 * 8) = *(const u32x4*)(zr + C_QG + h * 64 + c8 * 8);
    *(u32x4*)(Kr + i * LDT + c8 * 8) = *(const u32x4*)(zr + C_KG + h * 64 + c8 * 8);
  }
  if (tid < 128) {
    int i = tid >> 1, hf = tid & 1;
    int tok = dir ? (N - 1 - (c * 64 + i)) : (c * 64 + i);
    u32x4 rr = *(const u32x4*)(Z + (long)(rowbase + tok) * ZLD + (dir ? C_RB : C_RF) + hf * 8);
    float x[8];
    unpack8(rr, x);
#pragma unroll
    for (int e = 0; e < 8; e++) RF[i * 16 + hf * 8 + e] = x[e];
  }
  __syncthreads();
  gla_chunk_prep(tid, wd, bias, Qr, Kr, Qe, Ke, KlT, RF, tot, lastv);
  gla_att(wid, g, l15, Qe, Ke, Att);
  __syncthreads();
  bfr* dst = prep_base(p, b, h, dir, c);
#pragma unroll
  for (int ii = 0; ii < 2; ii++) {
    int cc = tid + 256 * ii;
    int i = cc >> 3, c8 = cc & 7;
    *(u32x4*)(dst + i * 64 + c8 * 8) = *(const u32x4*)(Qe + i * LDT + c8 * 8);
    *(u32x4*)(dst + 4096 + i * 64 + c8 * 8) = *(const u32x4*)(KlT + i * LDT + c8 * 8);
    *(u32x4*)(dst + 8192 + i * 64 + c8 * 8) = *(const u32x4*)(Att + i * LDT + c8 * 8);
  }
  if (tid < 64) ((float*)(p.ws + WS_EL))[((long)(((b * 4 + h) * 2 + dir) * 64 + c)) * 64 + tid] = __expf(lastv[tid]);
  __syncthreads();
}

__device__ __forceinline__ void gla_chain_item(const Params& p, int l, int b, int h, int dir, int vh, bfr* sm) {
  const int tid = TIDX, lane = tid & 63, wid = tid >> 6, g = lane >> 4, l15 = lane & 15;
  const bfr* Z = (const bfr*)(p.ws + WS_Z);
  bfr* OG = (bfr*)(p.ws + WS_R1) + (long)dir * NROWS * 512;
  const float* EL = (const float*)(p.ws + WS_EL) + (long)(((b * 4 + h) * 2 + dir) * 64) * 64;
  const int N = 4096, nc = 64;
  const int rowbase = NCTX + b * 4096;
  const int vs0 = vh * 64;
  bfr* Vt = sm;
  bfr* St = Vt + 64 * LDT;
  f32x4 st[4];
  {
    const float* S0 = (dir ? p.in[7] : p.in[6]) + ((long)((b * 2 + l) * 4 + h)) * 8192 + (long)(16 * wid + l15) * 128 + vs0;
#pragma unroll
    for (int vt = 0; vt < 4; vt++) {
      float4 a = *(const float4*)(S0 + 16 * vt + 4 * g);
      st[vt] = (f32x4){a.x, a.y, a.z, a.w};
#pragma unroll
      for (int r = 0; r < 4; r++) St[(16 * vt + 4 * g + r) * LDT + 16 * wid + l15] = f2bf(st[vt][r]);
    }
  }
  u32x4 n_qe[2], n_kl[2], n_at[2], n_v[2];
  float n_el;
  auto prefetch = [&](int c) {
    const bfr* base = prep_base(p, b, h, dir, c) + (16 * wid + l15) * 64 + 8 * g;
#pragma unroll
    for (int kk = 0; kk < 2; kk++) {
      n_qe[kk] = *(const u32x4*)(base + kk * 32);
      n_kl[kk] = *(const u32x4*)(base + 4096 + kk * 32);
      n_at[kk] = *(const u32x4*)(base + 8192 + kk * 32);
    }
    n_el = EL[c * 64 + 16 * wid + l15];
#pragma unroll
    for (int ii = 0; ii < 2; ii++) {
      int cc = tid + 256 * ii;
      int i = cc >> 3, c8 = cc & 7;
      int tok = dir ? (N - 1 - (c * 64 + i)) : (c * 64 + i);
      n_v[ii] = *(const u32x4*)(Z + (long)(rowbase + tok) * ZLD + C_VG + h * 128 + vs0 + c8 * 8);
    }
  };
  prefetch(0);
  for (int c = 0; c < nc; c++) {
    u32x4 c_qe[2] = {n_qe[0], n_qe[1]}, c_kl[2] = {n_kl[0], n_kl[1]}, c_at[2] = {n_at[0], n_at[1]};
    const float el = n_el;
#pragma unroll
    for (int ii = 0; ii < 2; ii++) {
      int cc = tid + 256 * ii;
      int i = cc >> 3, c8 = cc & 7;
      const bfr* rb = (const bfr*)&n_v[ii];
#pragma unroll
      for (int e = 0; e < 8; e++) Vt[(c8 * 8 + e) * LDT + i] = rb[e];
    }
    __syncthreads();
    if (c + 1 < nc) prefetch(c + 1);
    f32x4 stn[4];
    const int i = 16 * wid + l15;
    const int tok = dir ? (N - 1 - (c * 64 + i)) : (c * 64 + i);
    bfr* og = OG + (long)(rowbase + tok) * 512 + h * 128 + vs0 + 4 * g;
#pragma unroll
    for (int vt = 0; vt < 4; vt++) {
      f32x4 oc = (f32x4){0.f, 0.f, 0.f, 0.f};
      stn[vt] = st[vt] * el;
#pragma unroll
      for (int kk = 0; kk < 2; kk++) {
        bf16x8 vf = *(const bf16x8*)(Vt + (16 * vt + l15) * LDT + kk * 32 + g * 8);
        bf16x8 sf = *(const bf16x8*)(St + (16 * vt + l15) * LDT + kk * 32 + g * 8);
        oc = mfma16(vf, *(bf16x8*)&c_at[kk], oc);
        oc = mfma16(sf, *(bf16x8*)&c_qe[kk], oc);
        stn[vt] = mfma16(vf, *(bf16x8*)&c_kl[kk], stn[vt]);
      }
      u32x2 ov;
      ov.x = pack2(oc[0], oc[1]);
      ov.y = pack2(oc[2], oc[3]);
      *(u32x2*)(og + 16 * vt) = ov;
    }
    __syncthreads();
#pragma unroll
    for (int vt = 0; vt < 4; vt++) {
      st[vt] = stn[vt];
#pragma unroll
      for (int r = 0; r < 4; r++) St[(16 * vt + 4 * g + r) * LDT + 16 * wid + l15] = f2bf(st[vt][r]);
    }
  }
  __syncthreads();
}

template <int VS>
__device__ __forceinline__ void gla_item(const Params& p, int l, int seq, int h, int dir, int vsl, bfr* sm) {
  constexpr int NVT = VS / 16;
  constexpr int NVL = VS / 32;
  const int tid = TIDX, lane = tid & 63, wid = tid >> 6, g = lane >> 4, l15 = lane & 15;
  bfr* Z = (bfr*)(p.ws + WS_Z);
  bfr* OG = (bfr*)(p.ws + WS_R1) + (long)dir * NROWS * 512;
  const bool lat = seq >= 16;
  const int b = seq - 16;
  const int N = lat ? 4096 : 256;
  const int rowbase = lat ? NCTX + b * 4096 : seq * 256;
  const int nc = N >> 6;
  const int vs0 = vsl * VS;
  bfr* Qr = sm;
  bfr* Kr = Qr + 64 * LDT;
  bfr* Qe = Kr + 64 * LDT;
  bfr* Ke = Qe + 64 * LDT;
  bfr* KlT = Ke + 64 * LDT;
  float* RF = (float*)(KlT + 64 * LDT);
  float* tot = RF + 64 * 16;
  float* lastv = tot + 256;
  bfr* Vt = (bfr*)(lastv + 64);
  bfr* St = Vt + VS * LDT;
  bfr* Att = Qr;
  const int ch = tid & 63;
  float wd[16];
  {
    const float* W = (dir ? p.in[19] : p.in[17]) + (long)l * 16 * 256 + h * 64 + ch;
#pragma unroll
    for (int r = 0; r < 16; r++) wd[r] = W[r * 256];
  }
  const float bias = (dir ? p.in[20] : p.in[18])[l * 256 + h * 64 + ch];

  f32x4 st[NVT];
  {
    const float* S0 = (dir ? p.in[7] : p.in[6]) + ((long)((b * 2 + l) * 4 + h)) * 8192 + (long)(16 * wid + l15) * 128 + vs0;
#pragma unroll
    for (int mv = 0; mv < NVT; mv++) {
      if (lat) {
        float4 a = *(const float4*)(S0 + 16 * mv + 4 * g);
        st[mv] = (f32x4){a.x, a.y, a.z, a.w};
      } else {
        st[mv] = (f32x4){0.f, 0.f, 0.f, 0.f};
      }
#pragma unroll
      for (int r = 0; r < 4; r++) St[(16 * mv + 4 * g + r) * LDT + 16 * wid + l15] = f2bf(st[mv][r]);
    }
  }
  u32x4 rq[2], rk[2], rv[NVL], rr;
  auto prefetch = [&](int c) {
#pragma unroll
    for (int ii = 0; ii < 2; ii++) {
      int cc = tid + 256 * ii;
      int i = cc >> 3, c8 = cc & 7;
      int tok = dir ? (N - 1 - (c * 64 + i)) : (c * 64 + i);
      const bfr* zr = Z + (long)(rowbase + tok) * ZLD;
      rq[ii] = *(const u32x4*)(zr + C_QG + h * 64 + c8 * 8);
      rk[ii] = *(const u32x4*)(zr + C_KG + h * 64 + c8 * 8);
    }
#pragma unroll
    for (int ii = 0; ii < NVL; ii++) {
      int cc = tid + 256 * ii;
      int i = cc / (VS / 8), c4 = cc % (VS / 8);
      int tok = dir ? (N - 1 - (c * 64 + i)) : (c * 64 + i);
      rv[ii] = *(const u32x4*)(Z + (long)(rowbase + tok) * ZLD + C_VG + h * 128 + vs0 + c4 * 8);
    }
    if (tid < 128) {
      int i = tid >> 1, hf = tid & 1;
      int tok = dir ? (N - 1 - (c * 64 + i)) : (c * 64 + i);
      rr = *(const u32x4*)(Z + (long)(rowbase + tok) * ZLD + (dir ? C_RB : C_RF) + hf * 8);
    }
  };
  prefetch(0);
  for (int c = 0; c < nc; c++) {
#pragma unroll
    for (int ii = 0; ii < 2; ii++) {
      int cc = tid + 256 * ii;
      *(u32x4*)(Qr + (cc >> 3) * LDT + (cc & 7) * 8) = rq[ii];
      *(u32x4*)(Kr + (cc >> 3) * LDT + (cc & 7) * 8) = rk[ii];
    }
#pragma unroll
    for (int ii = 0; ii < NVL; ii++) {
      int cc = tid + 256 * ii;
      int i = cc / (VS / 8), c4 = cc % (VS / 8);
      const bfr* rb = (const bfr*)&rv[ii];
#pragma unroll
      for (int e = 0; e < 8; e++) Vt[(c4 * 8 + e) * LDT + i] = rb[e];
    }
    if (tid < 128) {
      int i = tid >> 1, hf = tid & 1;
      float x[8];
      unpack8(rr, x);
#pragma unroll
      for (int e = 0; e < 8; e++) RF[i * 16 + hf * 8 + e] = x[e];
    }
    __syncthreads();
    if (c + 1 < nc) prefetch(c + 1);
    gla_chunk_prep(tid, wd, bias, Qr, Kr, Qe, Ke, KlT, RF, tot, lastv);
    f32x4 stn[NVT];
    {
      float el = __expf(lastv[16 * wid + l15]);
#pragma unroll
      for (int mv = 0; mv < NVT; mv++) {
        stn[mv] = st[mv] * el;
#pragma unroll
        for (int kk = 0; kk < 2; kk++) {
          bf16x8 va = *(const bf16x8*)(Vt + (16 * mv + l15) * LDT + kk * 32 + g * 8);
          bf16x8 kb = *(const bf16x8*)(KlT + (16 * wid + l15) * LDT + kk * 32 + g * 8);
          stn[mv] = mfma16(va, kb, stn[mv]);
        }
      }
      gla_att(wid, g, l15, Qe, Ke, Att);
    }
    __syncthreads();
    {
      bf16x8 aa[2], qa[2];
#pragma unroll
      for (int kk = 0; kk < 2; kk++) {
        aa[kk] = *(const bf16x8*)(Att + (16 * wid + l15) * LDT + kk * 32 + g * 8);
        qa[kk] = *(const bf16x8*)(Qe + (16 * wid + l15) * LDT + kk * 32 + g * 8);
      }
#pragma unroll
      for (int nv = 0; nv < NVT; nv++) {
        f32x4 oc = (f32x4){0.f, 0.f, 0.f, 0.f};
#pragma unroll
        for (int kk = 0; kk < 2; kk++) {
          bf16x8 vb = *(const bf16x8*)(Vt + (16 * nv + l15) * LDT + kk * 32 + g * 8);
          oc = mfma16(aa[kk], vb, oc);
          bf16x8 sb = *(const bf16x8*)(St + (16 * nv + l15) * LDT + kk * 32 + g * 8);
          oc = mfma16(qa[kk], sb, oc);
        }
#pragma unroll
        for (int r = 0; r < 4; r++) {
          int i = 16 * wid + 4 * g + r;
          int tok = dir ? (N - 1 - (c * 64 + i)) : (c * 64 + i);
          OG[(long)(rowbase + tok) * 512 + h * 128 + vs0 + 16 * nv + l15] = f2bf(oc[r]);
        }
      }
    }
    __syncthreads();
#pragma unroll
    for (int mv = 0; mv < NVT; mv++) {
      st[mv] = stn[mv];
#pragma unroll
      for (int r = 0; r < 4; r++) St[(16 * mv + 4 * g + r) * LDT + 16 * wid + l15] = f2bf(st[mv][r]);
    }
  }
  __syncthreads();
  if (!lat) {
    float* so = p.out + (dir ? O_SB : O_SF) + ((long)((seq * 2 + l) * 4 + h)) * 8192 + (long)(16 * wid + l15) * 128 + vs0;
#pragma unroll
    for (int mv = 0; mv < NVT; mv++)
      *(float4*)(so + 16 * mv + 4 * g) = make_float4(st[mv][0], st[mv][1], st[mv][2], st[mv][3]);
  }
}

__device__ __forceinline__ void phase_mla_up(const Params& p, int l, bfr* sm) {
  bfr* Z = (bfr*)(p.ws + WS_Z);
  const float* rope = (const float*)(p.ws + WS_ROPE);
  const int lane = TIDX & 63, wid = TIDX >> 6, wr = wid >> 1, wc = wid & 1;
  const int g = lane >> 4;
  for (int t = blockIdx.x; t < 288 + 624 + 1024; t += gridDim.x) {
    if (t >= 912) {
      int i = t - 912;
      gla_prep_item(p, l, i >> 9, (i >> 7) & 3, (i >> 6) & 1, i & 63, sm);
      continue;
    }
    f32x4 acc[4][4];
#pragma unroll
    for (int a = 0; a < 4; a++)
#pragma unroll
      for (int b = 0; b < 4; b++) acc[a][b] = (f32x4){0.f, 0.f, 0.f, 0.f};
    if (t < 288) {
      int tn = t % 3, tm = t / 3;
      gemm128k64<4, true>((const bfr*)(p.ws + WS_WUQ) + (long)tn * 128 * 256, 256, 128, Z + (long)tm * 128 * ZLD + C_QL, ZLD, 256,
                    acc, sm);
      bfr* CQ = (bfr*)(p.ws + WS_CQ);
      const float qs = 0.10206207261596577f * 1.4426950408889634f;
#pragma unroll
      for (int pi = 0; pi < 4; pi++) {
        int nb = tn * 128 + wr * 64 + pi * 16;
        int wb = nb % 96;
        bool ropet = wb >= 64;
        int part = (wb - 64) >> 4;
#pragma unroll
        for (int qi = 0; qi < 4; qi++) {
          int tok = tm * 128 + wc * 64 + qi * 16 + (lane & 15);
          float y[4] = {acc[pi][qi][0], acc[pi][qi][1], acc[pi][qi][2], acc[pi][qi][3]};
          if (ropet) {
            bool lat = tok >= NCTX;
            int tl = (tok - NCTX) & 4095;
            int pos = part ? (tl & 63) : (tl >> 6);
            bool hi = (g & 2) != 0;
            int i0 = (g & 1) * 4;
#pragma unroll
            for (int r = 0; r < 4; r++) {
              float yp = __shfl_xor(y[r], 32);
              float c = rope[2048 + pos * 8 + i0 + r], s = rope[2560 + pos * 8 + i0 + r];
              float yr = hi ? (yp * s + y[r] * c) : (y[r] * c - yp * s);
              y[r] = lat ? yr : y[r];
            }
          }
          u32x2 o;
          o.x = pack2(y[0] * qs, y[1] * qs);
          o.y = pack2(y[2] * qs, y[3] * qs);
          *(u32x2*)(CQ + (long)tok * 384 + nb + g * 4) = o;
        }
      }
    } else {
      int t2 = t - 288;
      int tn = t2 % 6, tm = t2 / 6;
      const bfr* Q;
      long ldq;
      long kbase, vbase;
      int nk, key0;
      if (tm < 32) {
        Q = Z + (long)tm * 128 * ZLD + C_KV;
        ldq = ZLD;
        int s = tm >> 1;
        key0 = (tm & 1) * 128;
        nk = 256;
        kbase = (long)s * (4 * 256 * 64);
        vbase = (long)s * 131072;
      } else {
        int r = (tm - 32) * 128;
        int b = r / 4608, within = r % 4608;
        key0 = within;
        nk = 4608;
        kbase = 16l * (4 * 256 * 64) + (long)b * (4 * 4608 * 64);
        vbase = 16l * 131072 + (long)b * (4 * 128 * 4608);
        if (within < 512) {
          Q = (const bfr*)(p.ws + WS_CKVC) + (long)(b * 512 + within) * 256;
          ldq = 256;
        } else {
          Q = Z + (long)(NCTX + b * 4096 + within - 512) * ZLD + C_KV;
          ldq = ZLD;
        }
      }
      gemm128k64<4, true>((const bfr*)(p.ws + WS_WUKV) + (long)tn * 128 * 256, 256, 128, Q, ldq, 256, acc, sm);
      bfr* KN = (bfr*)(p.ws + WS_KNOPE);
      bfr* VTC = (bfr*)(p.ws + WS_VTC);
#pragma unroll
      for (int pi = 0; pi < 4; pi++) {
        int n0 = tn * 128 + wr * 64 + pi * 16 + g * 4;
        int head = n0 / 192, w = n0 % 192;
#pragma unroll
        for (int qi = 0; qi < 4; qi++) {
          int key = key0 + wc * 64 + qi * 16 + (lane & 15);
          if (w < 64) {
            u32x2 o;
            o.x = pack2(acc[pi][qi][0], acc[pi][qi][1]);
            o.y = pack2(acc[pi][qi][2], acc[pi][qi][3]);
            *(u32x2*)(KN + kbase + ((long)head * nk + key) * 64 + w) = o;
          } else {
#pragma unroll
            for (int r = 0; r < 4; r++)
              VTC[vbase + ((long)head * 128 + (w - 64) + r) * nk + key] = f2bf(acc[pi][qi][r]);
          }
        }
      }
    }
  }
}

template <int DQ, int DV, bool MLA, int NQB, bool DMA, int TP>
__device__ __forceinline__ void attn_item(const Params& p, int seq, int head, int qoff, bfr* sm, int dry) {
  constexpr int KLD = DQ + 8;
  constexpr int KSZ = DMA ? (MLA ? 6144 : 4096) : 64 * KLD;
  constexpr int VSZ = DMA ? DV * 64 : DV * LDT;
  constexpr int BUF = KSZ + VSZ;
  constexpr int NKK = DQ / 32;
  constexpr int NDV = DV / 16;
  constexpr int NVL = DV / 32;
  const int tid = TIDX, lane = tid & 63, wid = tid >> 6, g = lane >> 4, l15 = lane & 15;
  bfr* Z = (bfr*)(p.ws + WS_Z);
  const int sK = 2 * (l15 >> 2) + ((l15 >> 1) & 1), sR = ((l15 >> 3) & 1) * 2, sV = l15 >> 1;
  auto kaddr = [&](const bfr* Ks, int krow, int kk) -> const bfr* {
    if (DMA) return (kk < 2) ? (Ks + krow * 64 + (((kk * 4 + g) ^ sK) * 8)) : (Ks + 4096 + krow * 32 + ((g ^ sR) * 8));
    return Ks + krow * KLD + kk * 32 + g * 8;
  };
  auto vaddr = [&](const bfr* Vs, int d, int sx) -> const bfr* {
    if (DMA) return Vs + (d * 16 + l15) * 64 + (((sx * 4 + g) ^ sV) * 8);
    return Vs + (d * 16 + l15) * LDT + sx * 32 + g * 8;
  };
  const bool lat = seq >= 16;
  const int b = seq - 16;
  const int nk = lat ? 4608 : 256;
  const int rowbase = lat ? NCTX + b * 4096 : seq * 256;
  const int nkt = nk >> 6;

  bf16x8 qf[NQB][NKK];
#pragma unroll
  for (int qb = 0; qb < NQB; qb++) {
    int qrow = rowbase + qoff + wid * (16 * NQB) + qb * 16 + l15;
    const bfr* qp = MLA ? ((const bfr*)(p.ws + WS_CQ) + (long)qrow * 384 + head * 96) : (Z + (long)qrow * ZLD + C_QA + head * 64);
#pragma unroll
    for (int kk = 0; kk < NKK; kk++) qf[qb][kk] = *(const bf16x8*)(qp + kk * 32 + g * 8);
  }

  u32x4 rk[TP][2], rkr[TP], rv[TP][NVL];
  auto prefetch = [&](int pi) {
#pragma unroll
   for (int u = 0; u < TP; u++) {
    int k0 = (pi * TP + u) * 64;
    bool cache = lat && (k0 < 512);
    int tokrow0 = lat ? (NCTX + b * 4096 + k0 - 512) : (seq * 256 + k0);
    if (!MLA) {
      int kvh = head >> 2;
#pragma unroll
      for (int i = 0; i < 2; i++) {
        int c = tid + 256 * i;
        int kr_ = c >> 3, ch = c & 7;
        const bfr* src = cache ? ((const bfr*)(p.ws + WS_KCA) + (long)(b * 512 + k0 + kr_) * 128 + kvh * 64 + ch * 8)
                               : (Z + (long)(tokrow0 + kr_) * ZLD + C_KA + kvh * 64 + ch * 8);
        rk[u][i] = *(const u32x4*)src;
      }
      long vb = lat ? (16l * 32768 + (long)b * (2 * 64 * 4608)) : ((long)seq * 32768);
#pragma unroll
      for (int i = 0; i < NVL; i++) {
        int c = tid + 256 * i;
        int dv = c >> 3, ch = c & 7;
        rv[u][i] = *(const u32x4*)((const bfr*)(p.ws + WS_VTA) + vb + (long)(kvh * 64 + dv) * nk + k0 + ch * 8);
      }
    } else {
      long kb = lat ? (16l * (4 * 256 * 64) + (long)b * (4 * 4608 * 64)) : ((long)seq * (4 * 256 * 64));
#pragma unroll
      for (int i = 0; i < 2; i++) {
        int c = tid + 256 * i;
        int kr_ = c >> 3, ch = c & 7;
        rk[u][i] = *(const u32x4*)((const bfr*)(p.ws + WS_KNOPE) + kb + ((long)head * nk + k0 + kr_) * 64 + ch * 8);
      }
      {
        int kr_ = tid >> 2, ch = tid & 3;
        const bfr* src = cache ? ((const bfr*)(p.ws + WS_KRC) + (long)(b * 512 + k0 + kr_) * 32 + ch * 8)
                               : (Z + (long)(tokrow0 + kr_) * ZLD + C_KR + ch * 8);
        rkr[u] = *(const u32x4*)src;
      }
      long vb = lat ? (16l * 131072 + (long)b * (4 * 128 * 4608)) : ((long)seq * 131072);
#pragma unroll
      for (int i = 0; i < NVL; i++) {
        int c = tid + 256 * i;
        int dv = c >> 3, ch = c & 7;
        rv[u][i] = *(const u32x4*)((const bfr*)(p.ws + WS_VTC) + vb + (long)(head * 128 + dv) * nk + k0 + ch * 8);
      }
    }
   }
  };

  f32x4 o[NQB][NDV];
#pragma unroll
  for (int qb = 0; qb < NQB; qb++)
#pragma unroll
    for (int d = 0; d < NDV; d++) o[qb][d] = (f32x4){0.f, 0.f, 0.f, 0.f};
  float mrun[NQB];
  f32x4 lacc[NQB];
#pragma unroll
  for (int qb = 0; qb < NQB; qb++) { mrun[qb] = 0.f; lacc[qb] = (f32x4){0.f, 0.f, 0.f, 0.f}; }
  const bf16x8 ones = (bf16x8){(short)0x3F80, (short)0x3F80, (short)0x3F80, (short)0x3F80, (short)0x3F80, (short)0x3F80, (short)0x3F80, (short)0x3F80};

  auto dma_issue = [&](int pi, bfr* stg0) {
#pragma unroll
   for (int u = 0; u < TP; u++) {
    bfr* stg = stg0 + u * BUF;
    const int k0 = (pi * TP + u) * 64;
    const bool cache = lat && (k0 < 512);
    const int tokrow0 = lat ? (NCTX + b * 4096 + k0 - 512) : (seq * 256 + k0);
    const int cK = (tid & 7) ^ (((tid >> 6) & 3) * 2 + ((tid >> 4) & 1));
    const int cV = (tid & 7) ^ ((tid >> 4) & 7);
    if (MLA) {
      const long kb = lat ? (16l * (4 * 256 * 64) + (long)b * (4 * 4608 * 64)) : ((long)seq * (4 * 256 * 64));
      const long vb = lat ? (16l * 131072 + (long)b * (4 * 128 * 4608)) : ((long)seq * 131072);
#pragma unroll
      for (int i = 0; i < 2; i++)
        glds16((const bfr*)(p.ws + WS_KNOPE) + kb + ((long)head * nk + k0 + i * 32 + (tid >> 3)) * 64 + cK * 8, stg + i * 2048 + tid * 8);
      {
        const int row = tid >> 2, c = (tid & 3) ^ (((tid >> 6) & 1) * 2);
        const bfr* src = cache ? ((const bfr*)(p.ws + WS_KRC) + (long)(b * 512 + k0 + row) * 32 + c * 8)
                               : (Z + (long)(tokrow0 + row) * ZLD + C_KR + c * 8);
        glds16(src, stg + 4096 + tid * 8);
      }
#pragma unroll
      for (int i = 0; i < 4; i++)
        glds16((const bfr*)(p.ws + WS_VTC) + vb + (long)(head * 128 + i * 32 + (tid >> 3)) * nk + k0 + cV * 8, stg + 6144 + i * 2048 + tid * 8);
    } else {
      const int kvh = head >> 2;
      const long vb = lat ? (16l * 32768 + (long)b * (2 * 64 * 4608)) : ((long)seq * 32768);
#pragma unroll
      for (int i = 0; i < 2; i++) {
        const int row = i * 32 + (tid >> 3);
        const bfr* src = cache ? ((const bfr*)(p.ws + WS_KCA) + (long)(b * 512 + k0 + row) * 128 + kvh * 64 + cK * 8)
                               : (Z + (long)(tokrow0 + row) * ZLD + C_KA + kvh * 64 + cK * 8);
        glds16(src, stg + i * 2048 + tid * 8);
      }
#pragma unroll
      for (int i = 0; i < 2; i++)
        glds16((const bfr*)(p.ws + WS_VTA) + vb + (long)(kvh * 64 + i * 32 + (tid >> 3)) * nk + k0 + cV * 8, stg + 4096 + i * 2048 + tid * 8);
    }
   }
  };
  if (DMA) dma_issue(0, sm); else prefetch(0);
  const int np = nkt / TP;
  for (int pi = 0; pi < np; pi++) {
    bfr* base = sm + (pi & 1) * (TP * BUF);
    if (DMA) {
      asm volatile("s_waitcnt vmcnt(0)" ::: "memory");
      __syncthreads();
      if (pi + 1 < np) dma_issue(pi + 1, sm + ((pi + 1) & 1) * (TP * BUF));
    } else {
#pragma unroll
      for (int u = 0; u < TP; u++) {
        bfr* Ks = base + u * BUF;
        bfr* Vs = Ks + KSZ;
#pragma unroll
        for (int i = 0; i < 2; i++) {
          int c = tid + 256 * i;
          *(u32x4*)(Ks + (c >> 3) * KLD + (c & 7) * 8) = rk[u][i];
        }
        if (MLA) *(u32x4*)(Ks + (tid >> 2) * KLD + 64 + (tid & 3) * 8) = rkr[u];
#pragma unroll
        for (int i = 0; i < NVL; i++) {
          int c = tid + 256 * i;
          *(u32x4*)(Vs + (c >> 3) * LDT + (c & 7) * 8) = rv[u][i];
        }
      }
      __syncthreads();
      if (pi + 1 < np) prefetch(pi + 1);
    }
#pragma unroll
   for (int u = 0; u < TP; u++) {
    const bfr* Ks = base + u * BUF;
    const bfr* Vs = Ks + KSZ;
    const int kt = pi * TP + u;

    f32x4 s[NQB][4];
    bf16x8 kfr[4][NKK];
#pragma unroll
    for (int t = 0; t < 2; t++) {
      int krow = 32 * (t >> 1) + 8 * (l15 >> 2) + 4 * (t & 1) + (l15 & 3);
#pragma unroll
      for (int kk = 0; kk < NKK; kk++) kfr[t][kk] = *(const bf16x8*)kaddr(Ks, krow, kk);
    }
#pragma unroll
    for (int t = 0; t < 4; t++) {
#pragma unroll
      for (int qb = 0; qb < NQB; qb++) s[qb][t] = (f32x4){-mrun[qb], -mrun[qb], -mrun[qb], -mrun[qb]};
      if (t + 2 < 4) {
        int krow = 32 * ((t + 2) >> 1) + 8 * (l15 >> 2) + 4 * ((t + 2) & 1) + (l15 & 3);
#pragma unroll
        for (int kk = 0; kk < NKK; kk++) kfr[t + 2][kk] = *(const bf16x8*)kaddr(Ks, krow, kk);
      }
#pragma unroll
      for (int kk = 0; kk < NKK; kk++) {
#pragma unroll
        for (int qb = 0; qb < NQB; qb++) s[qb][t] = mfma16(kfr[t][kk], qf[qb][kk], s[qb][t]);
      }
    }
    bf16x8 vfr[4][2];
#pragma unroll
    for (int d = 0; d < 4; d++)
#pragma unroll
      for (int sx = 0; sx < 2; sx++) vfr[d][sx] = *(const bf16x8*)vaddr(Vs, d, sx);
    bf16x8 pf[NQB][2];
#pragma unroll
    for (int qb = 0; qb < NQB; qb++) {
      float mt = s[qb][0][0];
#pragma unroll
      for (int t = 0; t < 4; t++)
#pragma unroll
        for (int r = 0; r < 4; r++) mt = fmaxf(mt, s[qb][t][r]);
      const bool first = (kt == 0);
      if (first || __builtin_amdgcn_ballot_w64(mt > 8.f) != 0ull) {
        mt = fmaxf(mt, __shfl_xor(mt, 16));
        mt = fmaxf(mt, __shfl_xor(mt, 32));
        const bool need = first || mt > 8.f;
        const float dm = need ? mt : 0.f;
        const float alpha = first ? 1.f : __builtin_amdgcn_exp2f(-dm);
        mrun[qb] += dm;
        lacc[qb] *= alpha;
#pragma unroll
        for (int d = 0; d < NDV; d++) o[qb][d] *= alpha;
#pragma unroll
        for (int t = 0; t < 4; t++) s[qb][t] -= dm;
      }
#pragma unroll
      for (int t = 0; t < 4; t++)
#pragma unroll
        for (int r = 0; r < 4; r++) s[qb][t][r] = __builtin_amdgcn_exp2f(s[qb][t][r]);
#pragma unroll
      for (int sx = 0; sx < 2; sx++) {
        u32x4 u;
        u.x = pack2(s[qb][2 * sx][0], s[qb][2 * sx][1]);
        u.y = pack2(s[qb][2 * sx][2], s[qb][2 * sx][3]);
        u.z = pack2(s[qb][2 * sx + 1][0], s[qb][2 * sx + 1][1]);
        u.w = pack2(s[qb][2 * sx + 1][2], s[qb][2 * sx + 1][3]);
        pf[qb][sx] = *(bf16x8*)&u;
      }
    }
#pragma unroll
    for (int d = 0; d < NDV; d++) {
#pragma unroll
      for (int sx = 0; sx < 2; sx++) {
#pragma unroll
        for (int qb = 0; qb < NQB; qb++) o[qb][d] = mfma16(vfr[d & 3][sx], pf[qb][sx], o[qb][d]);
      }
      if (d + 4 < NDV) {
#pragma unroll
        for (int sx = 0; sx < 2; sx++)
          vfr[d & 3][sx] = *(const bf16x8*)vaddr(Vs, d + 4, sx);
      }
    }
#pragma unroll
    for (int sx = 0; sx < 2; sx++) {
#pragma unroll
      for (int qb = 0; qb < NQB; qb++) lacc[qb] = mfma16(ones, pf[qb][sx], lacc[qb]);
    }
   }
  }
  __syncthreads();
#pragma unroll
  for (int qb = 0; qb < NQB; qb++) {
    float inv = 1.f / lacc[qb][0];
    int qrow = rowbase + qoff + wid * (16 * NQB) + qb * 16 + l15;
    bfr* gp = Z + (long)qrow * ZLD + (MLA ? C_GC : C_GA) + head * DV + g * 4;
#pragma unroll
    for (int d = 0; d < NDV; d++) {
      u32x2 gr = *(const u32x2*)(gp + d * 16);
      float y0 = o[qb][d][0] * inv * siluf(lo16(gr.x));
      float y1 = o[qb][d][1] * inv * siluf(hi16(gr.x));
      float y2 = o[qb][d][2] * inv * siluf(lo16(gr.y));
      float y3 = o[qb][d][3] * inv * siluf(hi16(gr.y));
      u32x2 ov;
      ov.x = pack2(y0, y1);
      ov.y = pack2(y2, y3);
      if (!dry) *(u32x2*)(gp + d * 16) = ov;
    }
  }
}

__device__ __forceinline__ void phase_mixers(const Params& p, int l, bfr* sm, int* s_item, int dry) {
  unsigned* ctr = (unsigned*)(p.ws + WS_CTR) + (2 + l + 2 * dry) * 128;
  auto cnt = [](int) { return 184; };
  int q = (int)xcc_id(), tried = 0;
  for (;;) {
    if (TIDX == 0) {
      unsigned first = atomicAdd(ctr + q * 16, 1u);
      *s_item = xq_take(ctr, q, tried, first, cnt);
    }
    __syncthreads();
    const int it = *s_item;
    __syncthreads();
    if (it < 0) break;
    const int x = it >> 20, j = it & 0xfffff;
    int kind, a0, a1, a2, a3 = 0;
    if (j < 4) {
      int idx = x * 4 + j;
      kind = 3; a0 = idx >> 4; a1 = (idx >> 2) & 3; a2 = (idx >> 1) & 1; a3 = idx & 1;
    } else if (j < 36) {
      kind = 1; a0 = 16 + (x >> 2); a1 = x & 3; a2 = (j - 4) * 128;
    } else if (j < 96) {
      int i = j - 36;
      kind = 2; a0 = 16 + (x >> 2); a1 = ((x >> 1) & 1) * 4 + (x & 1) * 2 + (i >> 5); a2 = (i & 31) * 128;
    } else if (j < 104) {
      int k = j - 96;
      int i = 60 + (k >> 1);
      kind = 4; a0 = 16 + (x >> 2); a1 = ((x >> 1) & 1) * 4 + (x & 1) * 2 + (i >> 5); a2 = (i & 31) * 128 + (k & 1) * 64;
    } else if (j < 136) {
      int i = j - 104;
      kind = 0; a0 = 2 * x + (i >> 4); a1 = (i >> 2) & 3; a2 = (i >> 1) & 1; a3 = i & 1;
    } else if (j < 152) {
      int i = j - 136;
      kind = 1; a0 = 2 * x + (i >> 3); a1 = (i >> 1) & 3; a2 = (i & 1) * 128;
    } else {
      int i = j - 152;
      kind = 2; a0 = 2 * x + (i >> 4); a1 = (i >> 1) & 7; a2 = (i & 1) * 128;
    }
#ifdef PROBE_MIXKIND
    if (dry && ((PROBE_MIXKIND == 1) != (kind == 0 || kind == 3))) continue;
#endif
    if (kind == 0) gla_item<64>(p, l, a0, a1, a2, a3, sm);
    else if (kind == 3) gla_chain_item(p, l, a0, a1, a2, a3, sm);
    else if (kind == 1) attn_item<96, 128, true, 2, true, 1>(p, a0, a1, a2, sm, dry);
    else if (kind == 2) attn_item<64, 64, false, 2, true, 2>(p, a0, a1, a2, sm, dry);
    else attn_item<64, 64, false, 1, true, 2>(p, a0, a1, a2, sm, dry);
  }
}

__device__ __forceinline__ void phase_gla_out(const Params& p, int l) {
  const int lane = TIDX & 63;
  bfr* Z = (bfr*)(p.ws + WS_Z);
  const bfr* OF = (const bfr*)(p.ws + WS_R1);
  const bfr* OB = OF + (long)NROWS * 512;
  for (int row = blockIdx.x * 4 + (TIDX >> 6); row < NROWS; row += gridDim.x * 4) {
    float a[8], c[8], gt[8];
    unpack8(*(const u32x4*)(OF + (long)row * 512 + lane * 8), a);
    unpack8(*(const u32x4*)(OB + (long)row * 512 + lane * 8), c);
    bfr* gp = Z + (long)row * ZLD + C_GG + lane * 8;
    unpack8(*(const u32x4*)gp, gt);
    float ss = 0.f;
#pragma unroll
    for (int e = 0; e < 8; e++) {
      a[e] = bf2f(f2bf(a[e] + c[e]));
      ss += a[e] * a[e];
    }
    ss += __shfl_xor(ss, 1); ss += __shfl_xor(ss, 2); ss += __shfl_xor(ss, 4); ss += __shfl_xor(ss, 8);
    float rs = rsqrtf(ss * (1.f / 128.f) + 1e-6f);
    const float* gg = p.in[21] + l * 128 + (lane & 15) * 8;
#pragma unroll
    for (int e = 0; e < 8; e++) a[e] = a[e] * rs * gg[e] * siluf(gt[e]);
    *(u32x4*)gp = pack8(a);
  }
}

template <int NQ>
__device__ __forceinline__ void merge_tile(const Params& p, bfr* sm, int tn, int tok0) {
  constexpr int STG = 8192 + 2048 * NQ;
  bfr* Z = (bfr*)(p.ws + WS_Z);
  bfr* MG = (bfr*)(p.ws + WS_R1);
  const int tid = TIDX;
  const int lane = tid & 63, wid = tid >> 6, wr = wid >> 1, wc = wid & 1, g = lane >> 4, l15 = lane & 15;
  f32x4 totl[4][NQ];
#pragma unroll
  for (int a = 0; a < 4; a++)
#pragma unroll
    for (int b = 0; b < NQ; b++) totl[a][b] = (f32x4){0.f, 0.f, 0.f, 0.f};
#pragma unroll 1
  for (int seg = 0; seg < 3; seg++) {
    f32x4 acc[4][NQ];
#pragma unroll
    for (int a = 0; a < 4; a++)
#pragma unroll
      for (int b = 0; b < NQ; b++) acc[a][b] = (f32x4){0.f, 0.f, 0.f, 0.f};
    int ycol = seg == 0 ? C_GA : (seg == 1 ? C_GG : C_GC);
    int mcol = C_M1 + seg * 1024;
    const bfr* W = (const bfr*)(p.ws + WS_WOA + (unsigned long)seg * 1048576ul) + (long)tn * 128 * 512;
    gemm128k64<NQ, false, true>(W, 512, 128, Z + (long)tok0 * ZLD + ycol, ZLD, 512, acc, sm,
                                Z + (long)tok0 * ZLD + mcol + tn * 128, ZLD);
    const bfr* gt = sm;
#pragma unroll
    for (int pi = 0; pi < 4; pi++) {
      const int nl = wr * 64 + pi * 16 + g * 4;
#pragma unroll
      for (int qi = 0; qi < NQ; qi++) {
        const int tl = wc * 16 * NQ + qi * 16 + l15;
        u32x2 mr = *(const u32x2*)(gt + tl * 128 + (((nl >> 3) ^ (tl & 15)) * 8) + (nl & 4));
        totl[pi][qi][0] += sigmf(lo16(mr.x)) * acc[pi][qi][0];
        totl[pi][qi][1] += sigmf(hi16(mr.x)) * acc[pi][qi][1];
        totl[pi][qi][2] += sigmf(lo16(mr.y)) * acc[pi][qi][2];
        totl[pi][qi][3] += sigmf(hi16(mr.y)) * acc[pi][qi][3];
      }
    }
    __syncthreads();
  }
#pragma unroll
  for (int pi = 0; pi < 4; pi++)
#pragma unroll
    for (int qi = 0; qi < NQ; qi++) {
      u32x2 o;
      o.x = pack2(totl[pi][qi][0], totl[pi][qi][1]);
      o.y = pack2(totl[pi][qi][2], totl[pi][qi][3]);
      *(u32x2*)(sm + (wc * 16 * NQ + qi * 16 + l15) * 136 + wr * 64 + pi * 16 + g * 4) = o;
    }
  __syncthreads();
#pragma unroll
  for (int i = 0; i < 2 * NQ; i++) {
    int c = tid + 256 * i;
    int row = c >> 4, c16 = c & 15;
    *(u32x4*)(MG + (long)(tok0 + row) * 1024 + tn * 128 + c16 * 8) = *(const u32x4*)(sm + row * 136 + c16 * 8);
  }
  __syncthreads();
}

__device__ __forceinline__ void phase_merge(const Params& p, bfr* sm) {
  for (int t = blockIdx.x; t < 1024; t += gridDim.x) {
    if (t < 512) {
      merge_tile<4>(p, sm, t & 7, (t >> 3) * 128);
    } else {
      int u = t - 512;
      int full = 512 + (u >> 1);
      merge_tile<2>(p, sm, full & 7, (full >> 3) * 128 + (u & 1) * 64);
    }
  }
}

template <int NQ>
__device__ __forceinline__ void outproj_tile(const Params& p, bfr* sm, int tn, int tok0) {
  const bfr* MG = (const bfr*)(p.ws + WS_R1);
  float* OUT = (float*)(p.ws + WS_Z);
  const int tid = TIDX;
  const int lane = tid & 63, wid = tid >> 6, wr = wid >> 1, wc = wid & 1, g = lane >> 4, l15 = lane & 15;
  f32x4 acc[4][NQ];
#pragma unroll
  for (int a = 0; a < 4; a++)
#pragma unroll
    for (int b = 0; b < NQ; b++) acc[a][b] = (f32x4){0.f, 0.f, 0.f, 0.f};
  gemm128k64<NQ, true>((const bfr*)(p.ws + WS_WOUT) + (long)tn * 128 * 1024, 1024, 128, MG + (long)tok0 * 1024, 1024, 1024, acc, sm);
  float* smf = (float*)sm;
#pragma unroll
  for (int pi = 0; pi < 4; pi++)
#pragma unroll
    for (int qi = 0; qi < NQ; qi++)
      *(f32x4*)(smf + (wc * 16 * NQ + qi * 16 + l15) * 132 + wr * 64 + pi * 16 + g * 4) = acc[pi][qi];
  __syncthreads();
#pragma unroll
  for (int i = 0; i < 4 * NQ; i++) {
    int c = tid + 256 * i;
    int row = c >> 5, c16 = c & 31;
    *(f32x4*)(OUT + (long)(tok0 + row) * 1024 + tn * 128 + c16 * 4) = *(const f32x4*)(smf + row * 132 + c16 * 4);
  }
  __syncthreads();
}
__device__ __forceinline__ void phase_outproj(const Params& p, bfr* sm) {
  for (int t = blockIdx.x; t < 1024; t += gridDim.x) {
    if (t < 512) {
      outproj_tile<4>(p, sm, t & 7, (t >> 3) * 128);
    } else {
      int u = t - 512;
      int full = 512 + (u >> 1);
      outproj_tile<2>(p, sm, full & 7, (full >> 3) * 128 + (u & 1) * 64);
    }
  }
}

__device__ __forceinline__ void phase_post(const Params& p, int l) {
  const int lane = TIDX & 63;
  const float* mod = (const float*)(p.ws + WS_MOD);
  const float* OUT = (const float*)(p.ws + WS_Z);
  bfr* H = (bfr*)(p.ws + WS_R1);
  for (int row = blockIdx.x * 4 + (TIDX >> 6); row < NROWS; row += gridDim.x * 4) {
    const float* x = (l == 0) ? xrow(p, row) : (p.out + (long)row * 1024);
    const float* md = mod + (l * 3 + row_cond(row)) * 3072;
    float4 v[4];
    float ss = 0.f;
#pragma unroll
    for (int i = 0; i < 4; i++) {
      v[i] = *(const float4*)(OUT + (long)row * 1024 + i * 256 + lane * 4);
      ss += v[i].x * v[i].x + v[i].y * v[i].y + v[i].z * v[i].z + v[i].w * v[i].w;
    }
    ss = wave_sum(ss);
    float rs = rsqrtf(ss * (1.f / 1024.f) + 1e-6f);
    float ss2 = 0.f;
#pragma unroll
    for (int i = 0; i < 4; i++) {
      int n = i * 256 + lane * 4;
      float4 g = *(const float4*)(p.in[13] + l * 1024 + n);
      float4 gt = *(const float4*)(md + 2048 + n);
      float4 xv = *(const float4*)(x + n);
      v[i].x = xv.x + gt.x * (v[i].x * rs * g.x);
      v[i].y = xv.y + gt.y * (v[i].y * rs * g.y);
      v[i].z = xv.z + gt.z * (v[i].z * rs * g.z);
      v[i].w = xv.w + gt.w * (v[i].w * rs * g.w);
      *(float4*)(p.out + (long)row * 1024 + n) = v[i];
      ss2 += v[i].x * v[i].x + v[i].y * v[i].y + v[i].z * v[i].z + v[i].w * v[i].w;
    }
    if (l == 0) {
      ss2 = wave_sum(ss2);
      float rs2 = rsqrtf(ss2 * (1.f / 1024.f) + 1e-6f);
      const float* md1 = mod + (1 * 3 + row_cond(row)) * 3072;
#pragma unroll
      for (int i = 0; i < 4; i++) {
        int n = i * 256 + lane * 4;
        float4 g = *(const float4*)(p.in[12] + 1024 + n);
        float4 sh = *(const float4*)(md1 + n);
        float4 sc = *(const float4*)(md1 + 1024 + n);
        float h0 = v[i].x * rs2 * g.x * (1.f + sc.x) + sh.x;
        float h1 = v[i].y * rs2 * g.y * (1.f + sc.y) + sh.y;
        float h2 = v[i].z * rs2 * g.z * (1.f + sc.z) + sh.z;
        float h3 = v[i].w * rs2 * g.w * (1.f + sc.w) + sh.w;
        u32x2 o;
        o.x = pack2(h0, h1);
        o.y = pack2(h2, h3);
        *(u32x2*)(H + (long)row * 1024 + n) = o;
      }
    }
  }
}

__global__ void __launch_bounds__(256, 2) fwd_megakernel(Params p) {
  __shared__ __attribute__((aligned(16))) bfr sm[SMEM_SHORTS + 16];
  int* s_item_p = (int*)(sm + SMEM_SHORTS + 8);
  cg::grid_group grid = cg::this_grid();
  if (threadIdx.x == 0) { ((unsigned*)(sm + SMEM_SHORTS))[0] = 0u; ((unsigned*)(sm + SMEM_SHORTS))[1] = 0u; }
  __syncthreads();
  XcdBarrier xb = xcd_barrier_post((unsigned*)(p.ws + WS_BAR), (volatile LAS unsigned*)(sm + SMEM_SHORTS));
  if (p.ws == nullptr) grid.sync();
  (void)xb;
#define GSYNC1 do { XcdBarrier b_; b_.bar = (unsigned*)(p.ws + WS_BAR); b_.x = xb_xcc_id(); \
                    b_.st = (volatile LAS unsigned*)(sm + SMEM_SHORTS); xcd_barrier(b_); } while (0)
#ifdef PROBE_SYNC
#define GSYNC do { GSYNC1; GSYNC1; } while (0)
#else
#define GSYNC GSYNC1
#endif
#ifdef PROBE_PRE
  phase_s0(launder(p), sm);
  GSYNC;
  phase_s1(launder(p));
  wconv_phase(p, 0, sm);
  GSYNC;
  phase_prenorm0(launder(p));
  GSYNC;
#endif

#ifndef PH
#define PH 0xffff
#endif
#if PH & 1
  phase_s0(launder(p), sm);
#endif
  GSYNC;
#if PH & 2
  phase_s1(launder(p));
  wconv_phase(p, 0, sm);
#endif
  GSYNC;
#if PH & 4
  phase_prenorm0(launder(p));
#endif
  GSYNC;
  for (int l = 0; l < 2; l++) {
#if PH & 8
#ifdef PROBE_INPROJ
    phase_inproj(launder(p), l, sm, s_item_p, 6 + l);
    GSYNC;
#endif
    phase_inproj(launder(p), l, sm, s_item_p, l);
#endif
    GSYNC;
#if PH & 16
    phase_rowpost(launder(p), l);
#endif
    GSYNC;
#if PH & 32
#ifdef PROBE_MLAUP
    phase_mla_up(launder(p), l, sm);
    GSYNC;
#endif
    phase_mla_up(launder(p), l, sm);
#endif
    GSYNC;
#if PH & 64
#ifdef PROBE_MIX
    { int dry = 1; asm volatile("" : "+s"(dry)); phase_mixers(launder(p), l, sm, s_item_p, dry); }
    GSYNC;
#endif
    { int dry = 0; asm volatile("" : "+s"(dry)); phase_mixers(launder(p), l, sm, s_item_p, dry); }
#endif
    GSYNC;
#if PH & 128
    phase_gla_out(launder(p), l);
#endif
    GSYNC;
#if PH & 256
#ifdef PROBE_MERGE
    phase_merge(launder(p), sm);
    GSYNC;
#endif
    phase_merge(launder(p), sm);
#endif
    GSYNC;
#if PH & 512
#ifdef PROBE_MERGE
    phase_outproj(launder(p), sm);
    GSYNC;
#endif
    phase_outproj(launder(p), sm);
#endif
    GSYNC;
#if PH & 1024
    phase_post(launder(p), l);
    if (l == 0) wconv_phase(p, 1, sm);
#endif
    GSYNC;
  }
}

extern "C" void kernel_launch(void* const* d_in, const int* in_sizes, int n_in, void* d_out, int out_size, void* d_ws,
                              size_t ws_size, hipStream_t stream) {
  static int grid_blocks = 0;
  if (!grid_blocks) {
    int dev = 0, cus = 0, per_cu = 0;
    hipGetDevice(&dev);
    hipDeviceGetAttribute(&cus, hipDeviceAttributeMultiprocessorCount, dev);
    hipOccupancyMaxActiveBlocksPerMultiprocessor(&per_cu, fwd_megakernel, 256, 0);
    if (per_cu > 2) per_cu = 2;
    if (per_cu < 1) per_cu = 1;
    grid_blocks = cus * per_cu;
  }
  Params p{};
  for (int i = 0; i < 30; i++) p.in[i] = (const float*)d_in[i];
  p.out = (float*)d_out;
  p.ws = (unsigned char*)d_ws;
  hipMemsetAsync(d_ws, 0, 20480, stream);
  void* args[] = {&p};
  hipError_t e = hipLaunchCooperativeKernel((void*)fwd_megakernel, dim3(grid_blocks), dim3(256), args, 0, stream);
  if (e != hipSuccess) fprintf(stderr, "cooperative launch failed: %s (grid %d)\n", hipGetErrorString(e), grid_blocks);
}
```

```cpp
#include <hip/hip_runtime.h>
#include <hip/hip_cooperative_groups.h>
#include <cstdio>
namespace cg = cooperative_groups;

typedef unsigned short bfr;
typedef __attribute__((ext_vector_type(8))) short bf16x8;
typedef __attribute__((ext_vector_type(4))) float f32x4;
typedef __attribute__((ext_vector_type(4))) unsigned u32x4;
typedef __attribute__((ext_vector_type(2))) unsigned u32x2;

#define NROWS 12288
#define NCTX 4096
#define ZLD 6976
#define LDT 72
#define SMEM_SHORTS (4 * 128 * LDT)

#define C_QA 0
#define C_KA 512
#define C_VA 640
#define C_GA 768
#define C_QG 1280
#define C_KG 1536
#define C_VG 1792
#define C_GG 2304
#define C_RF 2816
#define C_RB 2832
#define C_QL 2848
#define C_KV 3104
#define C_KR 3360
#define C_GC 3392
#define C_M1 3904
#define C_M2 4928
#define C_M3 5952

#define WS_BAR 0ul
#define WS_CTR 16384ul
#define WS_MODP 20480ul
#define WS_MOD (WS_MODP + 589824ul)
#define WS_ROPE (WS_MOD + 73728ul)
#define WS_WIN (WS_ROPE + 16384ul)
#define WS_WUQ (WS_WIN + 14417920ul)
#define WS_WUKV (WS_WUQ + 196608ul)
#define WS_WOA (WS_WUKV + 393216ul)
#define WS_WOB (WS_WOA + 1048576ul)
#define WS_WOC (WS_WOB + 1048576ul)
#define WS_WOUT (WS_WOC + 1048576ul)
#define WS_KCA (WS_WOUT + 2097152ul)
#define WS_CKVC (WS_KCA + 262144ul)
#define WS_KRC (WS_CKVC + 524288ul)
#define WS_VTA (WS_KRC + 65536ul)
#define WS_CQ (WS_VTA + 3407872ul)
#define WS_KNOPE (WS_CQ + 9437184ul)
#define WS_VTC (WS_KNOPE + 6815744ul)
#define WS_R1 (WS_VTC + 13631488ul)
#define WS_Z (WS_R1 + 25165824ul)
#define WS_END (WS_Z + 171442176ul)

#define O_Y 0
#define O_GK 12582912
#define O_GV 13631488
#define O_CKV 14680064
#define O_KR 16777216
#define O_SF 17039360
#define O_SB 18087936

struct Params {
  const float* in[30];
  float* out;
  unsigned char* ws;
};

__device__ __forceinline__ int tidx() {
  int t = threadIdx.x;
  asm volatile("" : "+v"(t));
  return t;
}
__device__ __forceinline__ Params launder(const Params& p) {
  Params q;
  long zo = 0;
  asm volatile("" : "+s"(zo));
#pragma unroll
  for (int i = 0; i < 30; i++) q.in[i] = p.in[i] + zo;
  q.out = p.out + zo;
  q.ws = p.ws + zo;
  return q;
}
__device__ __forceinline__ float bf2f(bfr b) { return __uint_as_float(((unsigned)b) << 16); }
typedef float f32x2_t __attribute__((ext_vector_type(2)));
typedef __bf16 bf16x2_t __attribute__((ext_vector_type(2)));
__device__ __forceinline__ bfr f2bf(float f) {
  __bf16 r = (__bf16)f;
  return *(bfr*)&r;
}
__device__ __forceinline__ unsigned pack2(float a, float b) {
  f32x2_t v = {a, b};
  bf16x2_t r = __builtin_convertvector(v, bf16x2_t);
  return *(unsigned*)&r;
}
__device__ __forceinline__ float lo16(unsigned u) { return __uint_as_float(u << 16); }
__device__ __forceinline__ float hi16(unsigned u) { return __uint_as_float(u & 0xffff0000u); }
__device__ __forceinline__ float siluf(float x) { return x / (1.f + __expf(-x)); }
__device__ __forceinline__ float sigmf(float x) { return 1.f / (1.f + __expf(-x)); }
__device__ __forceinline__ f32x4 mfma16(bf16x8 a, bf16x8 b, f32x4 c) {
  return __builtin_amdgcn_mfma_f32_16x16x32_bf16(a, b, c, 0, 0, 0);
}
__device__ __forceinline__ const float* xrow(const Params& p, int row) {
  return row < NCTX ? p.in[0] + (long)row * 1024 : p.in[1] + (long)(row - NCTX) * 1024;
}
__device__ __forceinline__ int row_cond(int row) { return row < NCTX ? 0 : 1 + ((row - NCTX) >> 12); }
__device__ __forceinline__ float wave_sum(float v) {
  v += __shfl_xor(v, 1); v += __shfl_xor(v, 2); v += __shfl_xor(v, 4);
  v += __shfl_xor(v, 8); v += __shfl_xor(v, 16); v += __shfl_xor(v, 32);
  return v;
}

#define XB_TMO      128
#define XB_XCNT(j)  (256  + 64 * (j))
#define XB_XSUB(j)  (1280 + 64 * (j))
#define XB_XGEN(j)  (2304 + 64 * (j))
#define XB_TOP      3328
#define XB_TOPGEN   3392
#define XCD_BAR_WORDS 3456
#define XB_SPIN_CAP (1u << 18)
#define LAS __attribute__((address_space(3)))

__device__ __forceinline__ unsigned xb_ld(unsigned* p)              { return __hip_atomic_load(p, __ATOMIC_RELAXED, __HIP_MEMORY_SCOPE_AGENT); }
__device__ __forceinline__ unsigned xb_add(unsigned* p, unsigned v) { return __hip_atomic_fetch_add(p, v, __ATOMIC_RELAXED, __HIP_MEMORY_SCOPE_AGENT); }
__device__ __forceinline__ unsigned xb_xcc_id() { return (unsigned)__builtin_amdgcn_s_getreg((3 << 11) | 20) & 0xFu; }
#define XB_SPIN(cond, bar) do { unsigned _sp = 0; while (cond) { __builtin_amdgcn_s_sleep(1); \
    if ((++_sp & 255u) == 0u) { if (xb_ld(&(bar)[XB_TMO])) break; if (_sp > XB_SPIN_CAP) { atomicAdd(&(bar)[XB_TMO], 1u); break; } } } } while (0)

struct XcdBarrier {
    unsigned* bar; unsigned x;
    volatile LAS unsigned* st;
};

__device__ __forceinline__ XcdBarrier xcd_barrier_post(unsigned* bar, volatile LAS unsigned* st) {
    XcdBarrier b; b.bar = bar; b.x = xb_xcc_id(); b.st = st;
    if (threadIdx.x == 0) (void)xb_add(&bar[XB_XCNT(b.x)], 1u);
    return b;
}
__device__ __forceinline__ void xcd_barrier_complete(unsigned* bar, unsigned x, unsigned& nloc, unsigned& nx) {
    const unsigned G = gridDim.x * gridDim.y * gridDim.z;
    unsigned sum, cnt, mine, sp = 0u;
    for (;;) {
        sum = 0u; cnt = 0u; mine = 0u;
#pragma unroll
        for (unsigned j = 0; j < 16; ++j) { const unsigned c = xb_ld(&bar[XB_XCNT(j)]); sum += c; cnt += (c > 0u) ? 1u : 0u; mine = (j == x) ? c : mine; }
        if (sum == G) break;
        __builtin_amdgcn_s_sleep(1);
        if ((++sp & 255u) == 0u) { if (xb_ld(&bar[XB_TMO])) break; if (sp > XB_SPIN_CAP) { atomicAdd(&bar[XB_TMO], 1u); break; } }
    }
    nloc = mine > 0u ? mine : 1u; nx = cnt > 0u ? cnt : 1u;
}

__device__ __forceinline__ void xcd_barrier(const XcdBarrier& b) {
    asm volatile("s_waitcnt vmcnt(0)" ::: "memory");
    __syncthreads();
    if (threadIdx.x == 0) {
        unsigned* bar = b.bar;
        __builtin_amdgcn_s_waitcnt(0);
        unsigned nloc = b.st[0], nx = b.st[1];
        if (nloc == 0u) { xcd_barrier_complete(bar, b.x, nloc, nx); b.st[0] = nloc; b.st[1] = nx; }
        const unsigned old = xb_add(&bar[XB_XSUB(b.x)], 1u);
        const unsigned gen = old / nloc;
        if (old + 1u == (gen + 1u) * nloc) {
            __builtin_amdgcn_fence(__ATOMIC_RELEASE, "agent");
            asm volatile("s_waitcnt vmcnt(0)" ::: "memory");
            const unsigned og = xb_add(&bar[XB_TOP], 1u);
            const unsigned tg = og / nx;
            if (og + 1u == (tg + 1u) * nx) xb_add(&bar[XB_TOPGEN], 1u);
            else XB_SPIN(xb_ld(&bar[XB_TOPGEN]) == tg, bar);
            __builtin_amdgcn_fence(__ATOMIC_ACQUIRE, "agent");
            xb_add(&bar[XB_XGEN(b.x)], 1u);
            asm volatile("s_waitcnt vmcnt(0)" ::: "memory");
        } else {
            XB_SPIN(xb_ld(&bar[XB_XGEN(b.x)]) == gen, bar);
            __builtin_amdgcn_fence(__ATOMIC_ACQUIRE, "agent");
            asm volatile("s_waitcnt vmcnt(0)" ::: "memory");
        }
    }
    __syncthreads();
}


#define TIDX tidx()
#define LDS3 __attribute__((address_space(3)))
__device__ __forceinline__ void glds16(const bfr* g, bfr* l) {
  __builtin_amdgcn_global_load_lds((const unsigned*)g, (LDS3 unsigned*)l, 16, 0, 0);
}
__device__ __forceinline__ void gemm128(const bfr* __restrict__ P, long ldp, int pmax,
                                        const bfr* __restrict__ Q, long ldq, int qmax, int K,
                                        f32x4 (&acc)[4][4], bfr* sm) {
  const int tid = TIDX, lane = tid & 63, wid = tid >> 6;
  const int wr = wid >> 1, wc = wid & 1;
  const int l15 = lane & 15, g = lane >> 4;
  const bfr* pp[2];
  const bfr* qp[2];
  {
    const int r0 = tid >> 2;
    const int c = (tid & 3) ^ ((tid >> 4) & 3);
#pragma unroll
    for (int i = 0; i < 2; i++) {
      int r = r0 + 64 * i;
      pp[i] = P + (long)min(r, pmax - 1) * ldp + c * 8;
      qp[i] = Q + (long)min(r, qmax - 1) * ldq + c * 8;
    }
  }
  const int nk = K >> 5;
#define GEMM_ISSUE(T)                                                    \
  do {                                                                   \
    bfr* nb_ = sm + ((T) & 3) * 8192;                                    \
    glds16(pp[0] + (T) * 32, nb_ + tid * 8);                             \
    glds16(pp[1] + (T) * 32, nb_ + 2048 + tid * 8);                      \
    glds16(qp[0] + (T) * 32, nb_ + 4096 + tid * 8);                      \
    glds16(qp[1] + (T) * 32, nb_ + 6144 + tid * 8);                      \
  } while (0)
  GEMM_ISSUE(0);
  GEMM_ISSUE(1);
  GEMM_ISSUE(2);
  const int pos = (g ^ ((l15 >> 2) & 3)) * 8;
  for (int kt = 0; kt < nk; kt++) {
    if (kt + 2 < nk) asm volatile("s_waitcnt vmcnt(8)" ::: "memory");
    else if (kt + 1 < nk) asm volatile("s_waitcnt vmcnt(4)" ::: "memory");
    else asm volatile("s_waitcnt vmcnt(0)" ::: "memory");
    __builtin_amdgcn_s_barrier();
    if (kt + 3 < nk) GEMM_ISSUE(kt + 3);
    const bfr* Ps = sm + (kt & 3) * 8192;
    const bfr* Qs = Ps + 4096;
    bf16x8 pf[4], qf[4];
#pragma unroll
    for (int m = 0; m < 4; m++) {
      pf[m] = *(const bf16x8*)(Ps + (wr * 64 + m * 16 + l15) * 32 + pos);
      qf[m] = *(const bf16x8*)(Qs + (wc * 64 + m * 16 + l15) * 32 + pos);
    }
#pragma unroll
    for (int m = 0; m < 4; m++)
#pragma unroll
      for (int n = 0; n < 4; n++) acc[m][n] = mfma16(pf[m], qf[n], acc[m][n]);
  }
#undef GEMM_ISSUE
  __syncthreads();
}

template <int NQ>
__device__ __forceinline__ void gemm128q(const bfr* __restrict__ P, long ldp, const bfr* __restrict__ Q, long ldq, int K,
                                         f32x4 (&acc)[4][NQ], bfr* sm) {
  constexpr int QI = NQ / 2;
  constexpr int STG = 4096 + QI * 2048;
  const int tid = TIDX, lane = tid & 63, wid = tid >> 6;
  const int wr = wid >> 1, wc = wid & 1;
  const int l15 = lane & 15, g = lane >> 4;
  const bfr* pp[2];
  const bfr* qp[QI];
  {
    const int r0 = tid >> 2;
    const int c = (tid & 3) ^ (((tid >> 5) & 1) * 3);
#pragma unroll
    for (int i = 0; i < 2; i++) pp[i] = P + (long)(r0 + 64 * i) * ldp + c * 8;
#pragma unroll
    for (int i = 0; i < QI; i++) qp[i] = Q + (long)(r0 + 64 * i) * ldq + c * 8;
  }
  const int nk = K >> 5;
  auto issue = [&](int T) {
    bfr* nb_ = sm + (T & 3) * STG;
    glds16(pp[0] + T * 32, nb_ + tid * 8);
    glds16(pp[1] + T * 32, nb_ + 2048 + tid * 8);
#pragma unroll
    for (int i = 0; i < QI; i++) glds16(qp[i] + T * 32, nb_ + 4096 + i * 2048 + tid * 8);
  };
  issue(0);
  issue(1);
  issue(2);
  const int pos = (g ^ (((l15 >> 3) & 1) * 3)) * 8;
  for (int kt = 0; kt < nk; kt++) {
    if (kt + 2 < nk) {
      if (QI == 2) asm volatile("s_waitcnt vmcnt(8)" ::: "memory"); else asm volatile("s_waitcnt vmcnt(6)" ::: "memory");
    } else if (kt + 1 < nk) {
      if (QI == 2) asm volatile("s_waitcnt vmcnt(4)" ::: "memory"); else asm volatile("s_waitcnt vmcnt(3)" ::: "memory");
    } else {
      asm volatile("s_waitcnt vmcnt(0)" ::: "memory");
    }
    __builtin_amdgcn_s_barrier();
    if (kt + 3 < nk) issue(kt + 3);
    const bfr* Ps = sm + (kt & 3) * STG;
    const bfr* Qs = Ps + 4096;
    bf16x8 pf[4], qf[NQ];
#pragma unroll
    for (int m = 0; m < 4; m++) pf[m] = *(const bf16x8*)(Ps + (wr * 64 + m * 16 + l15) * 32 + pos);
#pragma unroll
    for (int n = 0; n < NQ; n++) qf[n] = *(const bf16x8*)(Qs + (wc * 16 * NQ + n * 16 + l15) * 32 + pos);
#pragma unroll
    for (int m = 0; m < 4; m++)
#pragma unroll
      for (int n = 0; n < NQ; n++) acc[m][n] = mfma16(pf[m], qf[n], acc[m][n]);
  }
  __syncthreads();
}

template <int NQ>
__device__ __forceinline__ void gemm256x128(const bfr* __restrict__ P, long ldp, int pmax,
                                            const bfr* __restrict__ Q, long ldq, int K,
                                            f32x4 (&acc)[8][NQ], bfr* sm) {
  constexpr int QI = NQ / 2;
  constexpr int STG = 8192 + QI * 2048;
  const int tid = TIDX, lane = tid & 63, wid = tid >> 6;
  const int wr = wid >> 1, wc = wid & 1;
  const int l15 = lane & 15, g = lane >> 4;
  const bfr* pp[4];
  const bfr* qp[QI];
  {
    const int r0 = tid >> 2;
    const int c = (tid & 3) ^ (((tid >> 5) & 1) * 3);
#pragma unroll
    for (int i = 0; i < 4; i++) pp[i] = P + (long)min(r0 + 64 * i, pmax - 1) * ldp + c * 8;
#pragma unroll
    for (int i = 0; i < QI; i++) qp[i] = Q + (long)(r0 + 64 * i) * ldq + c * 8;
  }
  const int nk = K >> 5;
  auto issue = [&](int T, int stg) {
    bfr* nb_ = sm + stg * STG;
    glds16(pp[0] + T * 32, nb_ + tid * 8);
    glds16(pp[1] + T * 32, nb_ + 2048 + tid * 8);
    glds16(pp[2] + T * 32, nb_ + 4096 + tid * 8);
    glds16(pp[3] + T * 32, nb_ + 6144 + tid * 8);
#pragma unroll
    for (int i = 0; i < QI; i++) glds16(qp[i] + T * 32, nb_ + 8192 + i * 2048 + tid * 8);
  };
  issue(0, 0);
  issue(1, 1);
  const int pos = (g ^ (((l15 >> 3) & 1) * 3)) * 8;
  int st = 0;
  for (int kt = 0; kt < nk; kt++) {
    if (kt + 1 < nk) {
      if (QI == 2) asm volatile("s_waitcnt vmcnt(6)" ::: "memory"); else asm volatile("s_waitcnt vmcnt(5)" ::: "memory");
    } else {
      asm volatile("s_waitcnt vmcnt(0)" ::: "memory");
    }
    __builtin_amdgcn_s_barrier();
    if (kt + 2 < nk) issue(kt + 2, st == 0 ? 2 : st - 1);
    const bfr* Ps = sm + st * STG;
    const bfr* Qs = Ps + 8192;
    st = (st == 2) ? 0 : st + 1;
    bf16x8 qf[NQ], pf[8];
#pragma unroll
    for (int n = 0; n < NQ; n++) qf[n] = *(const bf16x8*)(Qs + (wc * 16 * NQ + n * 16 + l15) * 32 + pos);
#pragma unroll
    for (int m = 0; m < 8; m++) pf[m] = *(const bf16x8*)(Ps + (wr * 128 + m * 16 + l15) * 32 + pos);
#pragma unroll
    for (int m = 0; m < 8; m++)
#pragma unroll
      for (int n = 0; n < NQ; n++) acc[m][n] = mfma16(pf[m], qf[n], acc[m][n]);
    __builtin_amdgcn_sched_group_barrier(0x100, NQ + 2, 0);
#pragma unroll
    for (int i = 0; i < 6; i++) {
      __builtin_amdgcn_sched_group_barrier(0x008, NQ, 0);
      __builtin_amdgcn_sched_group_barrier(0x100, 1, 0);
    }
    __builtin_amdgcn_sched_group_barrier(0x008, 2 * NQ, 0);
  }
  __syncthreads();
}

template <int NQ, bool PIPE, bool TAIL = false>
__device__ __forceinline__ void gemm128k64(const bfr* __restrict__ P, long ldp, int pmax,
                                           const bfr* __restrict__ Q, long ldq, int K,
                                           f32x4 (&acc)[4][NQ], bfr* sm, const bfr* tail_src = nullptr, long tail_ld = 0) {
  constexpr int STG = 8192 + 2048 * NQ;
  const int tid = TIDX, lane = tid & 63, wid = tid >> 6;
  const int wr = wid >> 1, wc = wid & 1;
  const int l15 = lane & 15, g = lane >> 4;
  const bfr* pp[4];
  const bfr* qp[NQ];
  {
    const int r0 = tid >> 3;
    const int c = (tid & 7) ^ ((tid >> 4) & 7);
#pragma unroll
    for (int i = 0; i < 4; i++) pp[i] = P + (long)min(r0 + 32 * i, pmax - 1) * ldp + c * 8;
#pragma unroll
    for (int i = 0; i < NQ; i++) qp[i] = Q + (long)(r0 + 32 * i) * ldq + c * 8;
  }
  const int nk = K >> 6;
#pragma unroll
  for (int i = 0; i < 4; i++) glds16(pp[i], sm + i * 2048 + tid * 8);
#pragma unroll
  for (int i = 0; i < NQ; i++) glds16(qp[i], sm + 8192 + i * 2048 + tid * 8);
  const int swz = l15 >> 1;
  for (int kt = 0; kt < nk; kt++) {
    asm volatile("s_waitcnt vmcnt(0)" ::: "memory");
    __builtin_amdgcn_s_barrier();
    if (kt + 1 < nk) {
      bfr* nb = sm + ((kt + 1) & 1) * STG;
#pragma unroll
      for (int i = 0; i < 4; i++) glds16(pp[i] + (kt + 1) * 64, nb + i * 2048 + tid * 8);
#pragma unroll
      for (int i = 0; i < NQ; i++) glds16(qp[i] + (kt + 1) * 64, nb + 8192 + i * 2048 + tid * 8);
    } else if (TAIL) {
      bfr* nb = sm + ((kt + 1) & 1) * STG;
      const bfr* ts = tail_src + (long)(tid >> 4) * tail_ld + (((tid & 15) ^ ((tid >> 4) & 15)) * 8);
#pragma unroll
      for (int i = 0; i < 2 * NQ; i++) glds16(ts + (long)(16 * i) * tail_ld, nb + i * 2048 + tid * 8);
    }
    const bfr* Ps = sm + (kt & 1) * STG;
    const bfr* Qs = Ps + 8192;
    if (PIPE) {
      bf16x8 pf[2][4], qf[2][NQ];
#pragma unroll
      for (int kk = 0; kk < 2; kk++) {
        const int pos = ((kk * 4 + g) ^ swz) * 8;
#pragma unroll
        for (int m = 0; m < 4; m++) pf[kk][m] = *(const bf16x8*)(Ps + (wr * 64 + m * 16 + l15) * 64 + pos);
#pragma unroll
        for (int n = 0; n < NQ; n++) qf[kk][n] = *(const bf16x8*)(Qs + (wc * 16 * NQ + n * 16 + l15) * 64 + pos);
      }
#pragma unroll
      for (int kk = 0; kk < 2; kk++)
#pragma unroll
        for (int m = 0; m < 4; m++)
#pragma unroll
          for (int n = 0; n < NQ; n++) acc[m][n] = mfma16(pf[kk][m], qf[kk][n], acc[m][n]);
      __builtin_amdgcn_sched_group_barrier(0x100, 4 + NQ, 0);
#pragma unroll
      for (int i = 0; i < 4 + NQ; i++) {
        __builtin_amdgcn_sched_group_barrier(0x008, NQ == 4 ? 2 : 1, 0);
        __builtin_amdgcn_sched_group_barrier(0x100, 1, 0);
      }
      __builtin_amdgcn_sched_group_barrier(0x008, NQ == 4 ? 16 : 10, 0);
    } else {
#pragma unroll
      for (int kk = 0; kk < 2; kk++) {
        bf16x8 pf[4], qf[NQ];
        const int pos = ((kk * 4 + g) ^ swz) * 8;
#pragma unroll
        for (int m = 0; m < 4; m++) pf[m] = *(const bf16x8*)(Ps + (wr * 64 + m * 16 + l15) * 64 + pos);
#pragma unroll
        for (int n = 0; n < NQ; n++) qf[n] = *(const bf16x8*)(Qs + (wc * 16 * NQ + n * 16 + l15) * 64 + pos);
#pragma unroll
        for (int m = 0; m < 4; m++)
#pragma unroll
          for (int n = 0; n < NQ; n++) acc[m][n] = mfma16(pf[m], qf[n], acc[m][n]);
      }
    }
  }
  if (TAIL) asm volatile("s_waitcnt vmcnt(0)" ::: "memory");
  __syncthreads();
}

__device__ __forceinline__ void gemm160x128(const bfr* __restrict__ P, long ldp, int pmax,
                                            const bfr* __restrict__ Q, long ldq, int K,
                                            f32x4 (&acc)[5][4], bfr* sm) {
  constexpr int STG = 160 * 64 + 128 * 64;
  const int tid = TIDX, lane = tid & 63, wid = tid >> 6;
  const int wr = wid >> 1, wc = wid & 1;
  const int l15 = lane & 15, g = lane >> 4;
  const bfr* pp[5];
  const bfr* qp[4];
  {
    const int r0 = tid >> 3;
    const int c = (tid & 7) ^ ((tid >> 4) & 7);
#pragma unroll
    for (int i = 0; i < 5; i++) pp[i] = P + (long)min(r0 + 32 * i, pmax - 1) * ldp + c * 8;
#pragma unroll
    for (int i = 0; i < 4; i++) qp[i] = Q + (long)(r0 + 32 * i) * ldq + c * 8;
  }
  const int nk = K >> 6;
#pragma unroll
  for (int i = 0; i < 5; i++) glds16(pp[i], sm + i * 2048 + tid * 8);
#pragma unroll
  for (int i = 0; i < 4; i++) glds16(qp[i], sm + 10240 + i * 2048 + tid * 8);
  const int swz = l15 >> 1;
  for (int kt = 0; kt < nk; kt++) {
    asm volatile("s_waitcnt vmcnt(0)" ::: "memory");
    __builtin_amdgcn_s_barrier();
    if (kt + 1 < nk) {
      bfr* nb = sm + ((kt + 1) & 1) * STG;
#pragma unroll
      for (int i = 0; i < 5; i++) glds16(pp[i] + (kt + 1) * 64, nb + i * 2048 + tid * 8);
#pragma unroll
      for (int i = 0; i < 4; i++) glds16(qp[i] + (kt + 1) * 64, nb + 10240 + i * 2048 + tid * 8);
    }
    const bfr* Ps = sm + (kt & 1) * STG;
    const bfr* Qs = Ps + 10240;
    bf16x8 pf[2][5], qf[2][4];
#pragma unroll
    for (int kk = 0; kk < 2; kk++) {
      const int pos = ((kk * 4 + g) ^ swz) * 8;
#pragma unroll
      for (int m = 0; m < 5; m++) pf[kk][m] = *(const bf16x8*)(Ps + (wr * 80 + m * 16 + l15) * 64 + pos);
#pragma unroll
      for (int n = 0; n < 4; n++) qf[kk][n] = *(const bf16x8*)(Qs + (wc * 64 + n * 16 + l15) * 64 + pos);
    }
#pragma unroll
    for (int kk = 0; kk < 2; kk++)
#pragma unroll
      for (int m = 0; m < 5; m++)
#pragma unroll
        for (int n = 0; n < 4; n++) acc[m][n] = mfma16(pf[kk][m], qf[kk][n], acc[m][n]);
    __builtin_amdgcn_sched_group_barrier(0x100, 9, 0);
#pragma unroll
    for (int i = 0; i < 9; i++) {
      __builtin_amdgcn_sched_group_barrier(0x008, 2, 0);
      __builtin_amdgcn_sched_group_barrier(0x100, 1, 0);
    }
    __builtin_amdgcn_sched_group_barrier(0x008, 22, 0);
  }
  __syncthreads();
}

__device__ __forceinline__ void phase_s0(const Params& p, bfr* sm) {
  const int tid = TIDX;
  float* rope = (float*)(p.ws + WS_ROPE);
  for (int idx = blockIdx.x * 256 + tid; idx < 1536; idx += gridDim.x * 256) {
    if (idx < 1024) {
      int pos = idx >> 4, i = idx & 15;
      float fr = powf(10000.f, -(float)i / 16.f);
      float a = (float)pos * fr;
      rope[idx] = cosf(a);
      rope[1024 + idx] = sinf(a);
    } else {
      int j = idx - 1024;
      int pos = j >> 3, i = j & 7;
      float fr = powf(10000.f, -(float)i / 8.f);
      float a = (float)pos * fr;
      rope[2048 + j] = cosf(a);
      rope[2560 + j] = sinf(a);
    }
  }
  float* smf = (float*)sm;
  float* modp = (float*)(p.ws + WS_MODP);
  for (int it = blockIdx.x; it < 768; it += gridDim.x) {
    int l = it / 384, rem = it % 384, cgp = rem >> 3, ks = rem & 7;
    int col = cgp * 64 + (tid & 63), kq = tid >> 6;
    const float* w = p.in[10] + (long)l * 1024 * 3072 + col;
    float a0 = 0.f, a1 = 0.f, a2 = 0.f;
    int k0 = ks * 128 + kq * 32;
#pragma unroll 8
    for (int k = k0; k < k0 + 32; k++) {
      float wv = w[(long)k * 3072];
      a0 += siluf(p.in[9][k]) * wv;
      a1 += siluf(p.in[8][k]) * wv;
      a2 += siluf(p.in[8][1024 + k]) * wv;
    }
    smf[(kq * 3 + 0) * 64 + (tid & 63)] = a0;
    smf[(kq * 3 + 1) * 64 + (tid & 63)] = a1;
    smf[(kq * 3 + 2) * 64 + (tid & 63)] = a2;
    __syncthreads();
    if (tid < 192) {
      int c = tid >> 6, cc = tid & 63;
      float s = smf[(0 * 3 + c) * 64 + cc] + smf[(1 * 3 + c) * 64 + cc] + smf[(2 * 3 + c) * 64 + cc] + smf[(3 * 3 + c) * 64 + cc];
      modp[((ks * 2 + l) * 3 + c) * 3072 + cgp * 64 + cc] = s;
    }
    __syncthreads();
  }
}

__device__ __forceinline__ void phase_s1(const Params& p) {
  float* modp = (float*)(p.ws + WS_MODP);
  float* mod = (float*)(p.ws + WS_MOD);
  for (int idx = blockIdx.x * 256 + TIDX; idx < 2 * 3 * 3072; idx += gridDim.x * 256) {
    int l = idx / 9216, n = idx % 3072;
    float s = p.in[11][l * 3072 + n];
#pragma unroll
    for (int ks = 0; ks < 8; ks++) s += modp[ks * 18432 + idx];
    mod[idx] = s;
  }
}

#define WCONV_ITEMS 2456
struct WcItem { const float* src; bfr* dst; int K, N, tk, tn; };
__device__ __forceinline__ WcItem wconv_decode(const Params& p, int l, int item) {
  WcItem w;
  if (item < 1744) {
    w.src = p.in[14] + (long)l * 1024 * 6976; w.K = 1024; w.N = 6976; w.dst = (bfr*)(p.ws + WS_WIN); w.tk = item & 15; w.tn = item >> 4;
  } else if (item < 1768) {
    item -= 1744;
    w.src = p.in[24] + (long)l * 256 * 384; w.K = 256; w.N = 384; w.dst = (bfr*)(p.ws + WS_WUQ); w.tk = item & 3; w.tn = item >> 2;
  } else if (item < 1816) {
    item -= 1768;
    w.src = p.in[25] + (long)l * 256 * 768; w.K = 256; w.N = 768; w.dst = (bfr*)(p.ws + WS_WUKV); w.tk = item & 3; w.tn = item >> 2;
  } else if (item < 2200) {
    item -= 1816;
    int ww = item >> 7, it = item & 127;
    w.src = (ww == 0 ? p.in[26] : (ww == 1 ? p.in[27] : p.in[28])) + (long)l * 512 * 1024;
    w.K = 512; w.N = 1024; w.dst = (bfr*)(p.ws + WS_WOA + (unsigned long)ww * 1048576ul); w.tk = it & 7; w.tn = it >> 3;
  } else {
    item -= 2200;
    w.src = p.in[29] + (long)l * 1024 * 1024; w.K = 1024; w.N = 1024; w.dst = (bfr*)(p.ws + WS_WOUT); w.tk = item & 15; w.tn = item >> 4;
  }
  return w;
}
__device__ __forceinline__ void wconv_phase(const Params& p, int l, bfr* sm) {
  bfr* sT = sm;
  const int tid = TIDX;
  const int n4 = (tid & 15) * 4, k0 = (tid >> 4) * 4;
  float4 v[4];
  int item = blockIdx.x;
  if (item < WCONV_ITEMS) {
    WcItem w = wconv_decode(p, l, item);
#pragma unroll
    for (int i = 0; i < 4; i++) v[i] = *(const float4*)(w.src + (long)(w.tk * 64 + k0 + i) * w.N + w.tn * 64 + n4);
  }
  const int wcol = (((k0 >> 3) ^ ((n4 >> 2) & 7)) * 8) + (k0 & 4);
  for (; item < WCONV_ITEMS; item += gridDim.x) {
    WcItem w = wconv_decode(p, l, item);
    {
      u32x2 o;
      o.x = pack2(v[0].x, v[1].x); o.y = pack2(v[2].x, v[3].x);
      *(u32x2*)(sT + (n4 + 0) * 64 + wcol) = o;
      o.x = pack2(v[0].y, v[1].y); o.y = pack2(v[2].y, v[3].y);
      *(u32x2*)(sT + (n4 + 1) * 64 + wcol) = o;
      o.x = pack2(v[0].z, v[1].z); o.y = pack2(v[2].z, v[3].z);
      *(u32x2*)(sT + (n4 + 2) * 64 + wcol) = o;
      o.x = pack2(v[0].w, v[1].w); o.y = pack2(v[2].w, v[3].w);
      *(u32x2*)(sT + (n4 + 3) * 64 + wcol) = o;
    }
    const int nitem = item + gridDim.x;
    if (nitem < WCONV_ITEMS) {
      WcItem wn = wconv_decode(p, l, nitem);
#pragma unroll
      for (int i = 0; i < 4; i++) v[i] = *(const float4*)(wn.src + (long)(wn.tk * 64 + k0 + i) * wn.N + wn.tn * 64 + n4);
    }
    __syncthreads();
#pragma unroll
    for (int i = 0; i < 2; i++) {
      int c = tid + 256 * i;
      int n = c >> 3, kc = c & 7;
      *(u32x4*)(w.dst + (long)(w.tn * 64 + n) * w.K + w.tk * 64 + kc * 8) = *(const u32x4*)(sT + n * 64 + ((kc ^ ((n >> 2) & 7)) * 8));
    }
    __syncthreads();
  }
}

__device__ __forceinline__ void phase_prenorm0(const Params& p) {
  const int lane = TIDX & 63;
  const float* mod = (const float*)(p.ws + WS_MOD);
  bfr* H = (bfr*)(p.ws + WS_R1);
  for (int row = blockIdx.x * 4 + (TIDX >> 6); row < NROWS; row += gridDim.x * 4) {
    const float* x = xrow(p, row);
    const float* md = mod + (0 * 3 + row_cond(row)) * 3072;
    float4 v[4];
    float ss = 0.f;
#pragma unroll
    for (int i = 0; i < 4; i++) {
      v[i] = *(const float4*)(x + i * 256 + lane * 4);
      ss += v[i].x * v[i].x + v[i].y * v[i].y + v[i].z * v[i].z + v[i].w * v[i].w;
    }
    ss = wave_sum(ss);
    float rs = rsqrtf(ss * (1.f / 1024.f) + 1e-6f);
#pragma unroll
    for (int i = 0; i < 4; i++) {
      int n = i * 256 + lane * 4;
      float4 g = *(const float4*)(p.in[12] + n);
      float4 sh = *(const float4*)(md + n);
      float4 sc = *(const float4*)(md + 1024 + n);
      float h0 = v[i].x * rs * g.x * (1.f + sc.x) + sh.x;
      float h1 = v[i].y * rs * g.y * (1.f + sc.y) + sh.y;
      float h2 = v[i].z * rs * g.z * (1.f + sc.z) + sh.z;
      float h3 = v[i].w * rs * g.w * (1.f + sc.w) + sh.w;
      u32x2 o;
      o.x = pack2(h0, h1);
      o.y = pack2(h2, h3);
      *(u32x2*)(H + (long)row * 1024 + n) = o;
    }
  }
}

__device__ __forceinline__ unsigned xcc_id() { return (unsigned)__builtin_amdgcn_s_getreg((3 << 11) | 20) & 7u; }
template <class CountF>
__device__ __forceinline__ int xq_take(unsigned* ctr, int& q, int& tried, unsigned first, CountF cnt) {
  unsigned j = first;
  for (;;) {
    if (j < (unsigned)cnt(q)) return (q << 20) | (int)j;
    q = (q + 1) & 7;
    if (++tried >= 8) return -1;
    j = atomicAdd(ctr + q * 16, 1u);
  }
}

__device__ __forceinline__ void phase_inproj(const Params& p, int l, bfr* sm, int* s_item, int slot) {
  const bfr* H = (const bfr*)(p.ws + WS_R1);
  const bfr* W = (const bfr*)(p.ws + WS_WIN);
  bfr* Z = (bfr*)(p.ws + WS_Z);
  const int tid = TIDX;
  const int lane = tid & 63, wid = tid >> 6, wr = wid >> 1, wc = wid & 1;
  unsigned* ctr = (unsigned*)(p.ws + WS_CTR) + slot * 128;
  auto cnt = [](int q) { return 96 * ((44 * (q + 1)) / 8 - (44 * q) / 8); };
  int q = (int)xcc_id(), tried = 0;
  unsigned nxt = 0;
  if (tid == 0) nxt = atomicAdd(ctr + q * 16, 1u);
  for (;;) {
    if (tid == 0) *s_item = xq_take(ctr, q, tried, nxt, cnt);
    __syncthreads();
    const int it = *s_item;
    __syncthreads();
    if (it < 0) break;
    const int qq = it >> 20, j = it & 0xfffff;
    if (tid == 0) nxt = atomicAdd(ctr + q * 16, 1u);
    const int tn0 = (44 * qq) / 8, w = (44 * (qq + 1)) / 8 - tn0;
    const int tm = j / w, tn = tn0 + j % w;
    f32x4 acc[5][4];
#pragma unroll
    for (int a = 0; a < 5; a++)
#pragma unroll
      for (int b = 0; b < 4; b++) acc[a][b] = (f32x4){0.f, 0.f, 0.f, 0.f};
    gemm160x128(W + (long)tn * 160 * 1024, 1024, ZLD - tn * 160, H + (long)tm * 128 * 1024, 1024, 1024, acc, sm);
    {
      const int g = lane >> 4, l15 = lane & 15;
#pragma unroll
      for (int pi = 0; pi < 5; pi++)
#pragma unroll
        for (int qi = 0; qi < 4; qi++) {
          u32x2 o;
          o.x = pack2(acc[pi][qi][0], acc[pi][qi][1]);
          o.y = pack2(acc[pi][qi][2], acc[pi][qi][3]);
          *(u32x2*)(sm + (wc * 64 + qi * 16 + l15) * 168 + wr * 80 + pi * 16 + g * 4) = o;
        }
      __syncthreads();
      const int ncol = min(20, (ZLD - tn * 160) >> 3);
#pragma unroll
      for (int i = 0; i < 10; i++) {
        int c = tid + 256 * i;
        int row = c / 20, c16 = c % 20;
        if (c16 < ncol)
          *(u32x4*)(Z + (long)(tm * 128 + row) * ZLD + tn * 160 + c16 * 8) = *(const u32x4*)(sm + row * 168 + c16 * 8);
      }
      __syncthreads();
    }
  }
}

__device__ __forceinline__ void unpack8(u32x4 v, float* x) {
  x[0] = lo16(v.x); x[1] = hi16(v.x); x[2] = lo16(v.y); x[3] = hi16(v.y);
  x[4] = lo16(v.z); x[5] = hi16(v.z); x[6] = lo16(v.w); x[7] = hi16(v.w);
}
__device__ __forceinline__ u32x4 pack8(const float* y) {
  u32x4 o;
  o.x = pack2(y[0], y[1]); o.y = pack2(y[2], y[3]); o.z = pack2(y[4], y[5]); o.w = pack2(y[6], y[7]);
  return o;
}

__device__ __forceinline__ void phase_rowpost(const Params& p, int l) {
  const int lane = TIDX & 63;
  bfr* Z = (bfr*)(p.ws + WS_Z);
  const float* rope = (const float*)(p.ws + WS_ROPE);
  bfr* VTA = (bfr*)(p.ws + WS_VTA);
  bfr* KCA = (bfr*)(p.ws + WS_KCA);
  bfr* CKVC = (bfr*)(p.ws + WS_CKVC);
  bfr* KRC = (bfr*)(p.ws + WS_KRC);
  float* out = p.out;
  for (int row = blockIdx.x * 4 + (TIDX >> 6); row < NROWS + 1024; row += gridDim.x * 4) {
    if (row < NROWS) {
      const bool lat = row >= NCTX;
      const int bc = row >> 8, tc = row & 255;
      const int bl = (row - NCTX) >> 12, tl = (row - NCTX) & 4095;
      const int prow = tl >> 6, pcol = tl & 63;
      bfr* z = Z + (long)row * ZLD;
      {
        float x[8];
        unpack8(*(const u32x4*)(z + C_QA + lane * 8), x);
        float ss = 0.f;
#pragma unroll
        for (int e = 0; e < 8; e++) ss += x[e] * x[e];
        ss += __shfl_xor(ss, 1); ss += __shfl_xor(ss, 2); ss += __shfl_xor(ss, 4);
        float rs = rsqrtf(ss * (1.f / 64.f) + 1e-6f);
        int sub = lane & 7;
        const float* g = p.in[15] + l * 64 + sub * 8;
#pragma unroll
        for (int e = 0; e < 8; e++) x[e] = x[e] * rs * g[e];
        if (lat) {
          int pos = (sub >> 2) ? pcol : prow;
          bool hi = (sub & 2) != 0;
          int i0 = (sub & 1) * 8;
#pragma unroll
          for (int e = 0; e < 8; e++) {
            float yp = __shfl_xor(x[e], 2);
            float c = rope[pos * 16 + i0 + e], s = rope[1024 + pos * 16 + i0 + e];
            x[e] = hi ? (yp * s + x[e] * c) : (x[e] * c - yp * s);
          }
        }
        const float qs = 0.125f * 1.4426950408889634f;
#pragma unroll
        for (int e = 0; e < 8; e++) x[e] *= qs;
        *(u32x4*)(z + C_QA + lane * 8) = pack8(x);
      }
      {
        int L = lane & 15;
        float x[8];
        unpack8(*(const u32x4*)(z + C_KA + L * 8), x);
        float ss = 0.f;
#pragma unroll
        for (int e = 0; e < 8; e++) ss += x[e] * x[e];
        ss += __shfl_xor(ss, 1); ss += __shfl_xor(ss, 2); ss += __shfl_xor(ss, 4);
        float rs = rsqrtf(ss * (1.f / 64.f) + 1e-6f);
        int sub = L & 7;
        const float* g = p.in[16] + l * 64 + sub * 8;
#pragma unroll
        for (int e = 0; e < 8; e++) x[e] = x[e] * rs * g[e];
        if (lat) {
          int pos = (sub >> 2) ? pcol : prow;
          bool hi = (sub & 2) != 0;
          int i0 = (sub & 1) * 8;
#pragma unroll
          for (int e = 0; e < 8; e++) {
            float yp = __shfl_xor(x[e], 2);
            float c = rope[pos * 16 + i0 + e], s = rope[1024 + pos * 16 + i0 + e];
            x[e] = hi ? (yp * s + x[e] * c) : (x[e] * c - yp * s);
          }
        } else if (lane < 16) {
          float* o = out + O_GK + ((long)(bc * 2 + l) * 256 + tc) * 128 + L * 8;
          *(float4*)(o) = make_float4(x[0], x[1], x[2], x[3]);
          *(float4*)(o + 4) = make_float4(x[4], x[5], x[6], x[7]);
        }
        if (lane < 16) *(u32x4*)(z + C_KA + L * 8) = pack8(x);
      }
      if (lane < 16) {
        int L = lane;
        u32x4 raw = *(const u32x4*)(z + C_VA + L * 8);
        float x[8];
        unpack8(raw, x);
        if (!lat) {
          float* o = out + O_GV + ((long)(bc * 2 + l) * 256 + tc) * 128 + L * 8;
          *(float4*)(o) = make_float4(x[0], x[1], x[2], x[3]);
          *(float4*)(o + 4) = make_float4(x[4], x[5], x[6], x[7]);
        }
        int g = L >> 3, d0 = (L & 7) * 8;
        long base; int nk, key;
        if (!lat) { base = (long)bc * 32768; nk = 256; key = tc; }
        else { base = 16l * 32768 + (long)bl * (2 * 64 * 4608); nk = 4608; key = 512 + tl; }
        const bfr* rb = (const bfr*)&raw;
#pragma unroll
        for (int e = 0; e < 8; e++) VTA[base + (long)(g * 64 + d0 + e) * nk + key] = rb[e];
      }
      {
        u32x2 rq = *(const u32x2*)(z + C_QL + lane * 4);
        u32x2 rk = *(const u32x2*)(z + C_KV + lane * 4);
        float q[4] = {lo16(rq.x), hi16(rq.x), lo16(rq.y), hi16(rq.y)};
        float k[4] = {lo16(rk.x), hi16(rk.x), lo16(rk.y), hi16(rk.y)};
        float sq = q[0] * q[0] + q[1] * q[1] + q[2] * q[2] + q[3] * q[3];
        float sk = k[0] * k[0] + k[1] * k[1] + k[2] * k[2] + k[3] * k[3];
        sq = wave_sum(sq);
        sk = wave_sum(sk);
        float rq_ = rsqrtf(sq * (1.f / 256.f) + 1e-6f), rk_ = rsqrtf(sk * (1.f / 256.f) + 1e-6f);
        float4 gq = *(const float4*)(p.in[22] + l * 256 + lane * 4);
        float4 gk = *(const float4*)(p.in[23] + l * 256 + lane * 4);
        q[0] *= rq_ * gq.x; q[1] *= rq_ * gq.y; q[2] *= rq_ * gq.z; q[3] *= rq_ * gq.w;
        k[0] *= rk_ * gk.x; k[1] *= rk_ * gk.y; k[2] *= rk_ * gk.z; k[3] *= rk_ * gk.w;
        u32x2 o;
        o.x = pack2(q[0], q[1]); o.y = pack2(q[2], q[3]);
        *(u32x2*)(z + C_QL + lane * 4) = o;
        o.x = pack2(k[0], k[1]); o.y = pack2(k[2], k[3]);
        *(u32x2*)(z + C_KV + lane * 4) = o;
        if (!lat) *(float4*)(out + O_CKV + ((long)(bc * 2 + l) * 256 + tc) * 256 + lane * 4) = make_float4(k[0], k[1], k[2], k[3]);
      }
      {
        int L = lane & 3;
        float x[8];
        unpack8(*(const u32x4*)(z + C_KR + L * 8), x);
        if (lat) {
          int pos = (L >> 1) ? pcol : prow;
          bool hi = (L & 1) != 0;
#pragma unroll
          for (int e = 0; e < 8; e++) {
            float yp = __shfl_xor(x[e], 1);
            float c = rope[2048 + pos * 8 + e], s = rope[2560 + pos * 8 + e];
            x[e] = hi ? (yp * s + x[e] * c) : (x[e] * c - yp * s);
          }
          if (lane < 4) *(u32x4*)(z + C_KR + L * 8) = pack8(x);
        } else if (lane < 4) {
          float* o = out + O_KR + ((long)(bc * 2 + l) * 256 + tc) * 32 + L * 8;
          *(float4*)(o) = make_float4(x[0], x[1], x[2], x[3]);
          *(float4*)(o + 4) = make_float4(x[4], x[5], x[6], x[7]);
        }
      }
    } else {
      int cr = row - NROWS;
      int b = cr >> 9, t = cr & 511;
      long src = (long)(b * 2 + l) * 512 + t;
      {
        float2 kv = *(const float2*)(p.in[2] + src * 128 + lane * 2);
        *(unsigned*)(KCA + (long)(b * 512 + t) * 128 + lane * 2) = pack2(kv.x, kv.y);
        float2 vv = *(const float2*)(p.in[3] + src * 128 + lane * 2);
        int c0 = lane * 2;
        long base = 16l * 32768 + (long)b * (2 * 64 * 4608);
        VTA[base + (long)c0 * 4608 + t] = f2bf(vv.x);
        VTA[base + (long)(c0 + 1) * 4608 + t] = f2bf(vv.y);
        float4 cv = *(const float4*)(p.in[4] + src * 256 + lane * 4);
        u32x2 o;
        o.x = pack2(cv.x, cv.y); o.y = pack2(cv.z, cv.w);
        *(u32x2*)(CKVC + (long)(b * 512 + t) * 256 + lane * 4) = o;
        if (lane < 32) KRC[(long)(b * 512 + t) * 32 + lane] = f2bf(p.in[5][src * 32 + lane]);
      }
    }
  }
}

#define WS_PREP1 251703296ul
#define WS_EL (WS_WIN + 12582912ul)
__device__ __forceinline__ bfr* prep_base(const Params& p, int b, int h, int dir, int c) {
  return (bfr*)(p.ws + (b ? WS_PREP1 : WS_WIN)) + (long)((h * 2 + dir) * 64 + c) * 12288;
}

__device__ __forceinline__ void gla_chunk_prep(int tid, const float (&wd)[16], float bias, const bfr* Qr, const bfr* Kr,
                                               bfr* Qe, bfr* Ke, bfr* KlT, const float* RF, float* tot, float* lastv) {
  const int ch = tid & 63, part = tid >> 6;
  float cum[16];
  {
    float run = 0.f;
#pragma unroll
    for (int ii = 0; ii < 16; ii++) {
      int i = part * 16 + ii;
      float x = bias;
#pragma unroll
      for (int r = 0; r < 16; r++) x += RF[i * 16 + r] * wd[r];
      float la = (fminf(x, 0.f) - __logf(1.f + __expf(-fabsf(x)))) * (1.f / 16.f);
      run += la;
      cum[ii] = run;
    }
    tot[part * 64 + ch] = run;
  }
  __syncthreads();
  {
    float off = 0.f, last = 0.f;
#pragma unroll
    for (int pp = 0; pp < 4; pp++) {
      float tv = tot[pp * 64 + ch];
      if (pp < part) off += tv;
      last += tv;
    }
    if (part == 0) lastv[ch] = last;
#pragma unroll
    for (int ii = 0; ii < 16; ii++) {
      int i = part * 16 + ii;
      float cc = cum[ii] + off;
      float qv = bf2f(Qr[i * LDT + ch]), kv = bf2f(Kr[i * LDT + ch]);
      Qe[i * LDT + ch] = f2bf(qv * __expf(cc) * 0.125f);
      Ke[i * LDT + ch] = f2bf(kv * __expf(-cc));
      KlT[ch * LDT + i] = f2bf(kv * __expf(last - cc));
    }
  }
  __syncthreads();
}

__device__ __forceinline__ void gla_att(int wid, int g, int l15, const bfr* Qe, const bfr* Ke, bfr* Att) {
  f32x4 att[4];
  bf16x8 qa[2];
#pragma unroll
  for (int kk = 0; kk < 2; kk++) qa[kk] = *(const bf16x8*)(Qe + (16 * wid + l15) * LDT + kk * 32 + g * 8);
#pragma unroll
  for (int nj = 0; nj < 4; nj++) {
    att[nj] = (f32x4){0.f, 0.f, 0.f, 0.f};
#pragma unroll
    for (int kk = 0; kk < 2; kk++) {
      bf16x8 kb = *(const bf16x8*)(Ke + (16 * nj + l15) * LDT + kk * 32 + g * 8);
      att[nj] = mfma16(qa[kk], kb, att[nj]);
    }
  }
#pragma unroll
  for (int nj = 0; nj < 4; nj++)
#pragma unroll
    for (int r = 0; r < 4; r++) {
      int i = 16 * wid + 4 * g + r, j = 16 * nj + l15;
      Att[i * LDT + j] = f2bf(i >= j ? att[nj][r] : 0.f);
    }
}

__device__ __forceinline__ void gla_prep_item(const Params& p, int l, int b, int h, int dir, int c, bfr* sm) {
  const int tid = TIDX, lane = tid & 63, wid = tid >> 6, g = lane >> 4, l15 = lane & 15;
  const bfr* Z = (const bfr*)(p.ws + WS_Z);
  const int N = 4096;
  const int rowbase = NCTX + b * 4096;
  bfr* Qr = sm;
  bfr* Kr = Qr + 64 * LDT;
  bfr* Qe = Kr + 64 * LDT;
  bfr* Ke = Qe + 64 * LDT;
  bfr* KlT = Ke + 64 * LDT;
  float* RF = (float*)(KlT + 64 * LDT);
  float* tot = RF + 64 * 16;
  float* lastv = tot + 256;
  bfr* Att = Qr;
  const int ch = tid & 63;
  float wd[16];
  {
    const float* W = (dir ? p.in[19] : p.in[17]) + (long)l * 16 * 256 + h * 64 + ch;
#pragma unroll
    for (int r = 0; r < 16; r++) wd[r] = W[r * 256];
  }
  const float bias = (dir ? p.in[20] : p.in[18])[l * 256 + h * 64 + ch];
#pragma unroll
  for (int ii = 0; ii < 2; ii++) {
    int cc = tid + 256 * ii;
    int i = cc >> 3, c8 = cc & 7;
    int tok = dir ? (N - 1 - (c * 64 + i)) : (c * 64 + i);
    const bfr* zr = Z + (long)(rowbase + tok) * ZLD;
    *(u32x4*)(Qr + i * LDT + c8 * 8) = *(const u32x4*)(zr + C_QG + h * 64 + c8 * 8);
    *(u32x4*)(Kr + i * LDT + c8 * 8) = *(const u32x4*)(zr + C_KG + h * 64 + c8 * 8);
  }
  if (tid < 128) {
    int i = tid >> 1, hf = tid & 1;
    int tok = dir ? (N - 1 - (c * 64 + i)) : (c * 64 + i);
    u32x4 rr = *(const u32x4*)(Z + (long)(rowbase + tok) * ZLD + (dir ? C_RB : C_RF) + hf * 8);
    float x[8];
    unpack8(rr, x);
#pragma unroll
    for (int e = 0; e < 8; e++) RF[i * 16 + hf * 8 + e] = x[e];
  }
  __syncthreads();
  gla_chunk_prep(tid, wd, bias, Qr, Kr, Qe, Ke, KlT, RF, tot, lastv);
  gla_att(wid, g, l15, Qe, Ke, Att);
  __syncthreads();
  bfr* dst = prep_base(p, b, h, dir, c);
#pragma unroll
  for (int ii = 0; ii < 2; ii++) {
    int cc = tid + 256 * ii;
    int i = cc >> 3, c8 = cc & 7;
    *(u32x4*)(dst + i * 64 + c8 * 8) = *(const u32x4*)(Qe + i * LDT + c8 * 8);
    *(u32x4*)(dst + 4096 + i * 64 + c8 * 8) = *(const u32x4*)(KlT + i * LDT + c8 * 8);
    *(u32x4*)(dst + 8192 + i * 64 + c8 * 8) = *(const u32x4*)(Att + i * LDT + c8 * 8);
  }
  if (tid < 64) ((float*)(p.ws + WS_EL))[((long)(((b * 4 + h) * 2 + dir) * 64 + c)) * 64 + tid] = __expf(lastv[tid]);
  __syncthreads();
}

__device__ __forceinline__ void gla_chain_item(const Params& p, int l, int b, int h, int dir, int vh, bfr* sm) {
  const int tid = TIDX, lane = tid & 63, wid = tid >> 6, g = lane >> 4, l15 = lane & 15;
  const bfr* Z = (const bfr*)(p.ws + WS_Z);
  bfr* OG = (bfr*)(p.ws + WS_R1) + (long)dir * NROWS * 512;
  const float* EL = (const float*)(p.ws + WS_EL) + (long)(((b * 4 + h) * 2 + dir) * 64) * 64;
  const int N = 4096, nc = 64;
  const int rowbase = NCTX + b * 4096;
  const int vs0 = vh * 64;
  bfr* Vt = sm;
  bfr* St = Vt + 64 * LDT;
  f32x4 st[4];
  {
    const float* S0 = (dir ? p.in[7] : p.in[6]) + ((long)((b * 2 + l) * 4 + h)) * 8192 + (long)(16 * wid + l15) * 128 + vs0;
#pragma unroll
    for (int vt = 0; vt < 4; vt++) {
      float4 a = *(const float4*)(S0 + 16 * vt + 4 * g);
      st[vt] = (f32x4){a.x, a.y, a.z, a.w};
#pragma unroll
      for (int r = 0; r < 4; r++) St[(16 * vt + 4 * g + r) * LDT + 16 * wid + l15] = f2bf(st[vt][r]);
    }
  }
  u32x4 n_qe[2], n_kl[2], n_at[2], n_v[2];
  float n_el;
  auto prefetch = [&](int c) {
    const bfr* base = prep_base(p, b, h, dir, c) + (16 * wid + l15) * 64 + 8 * g;
#pragma unroll
    for (int kk = 0; kk < 2; kk++) {
      n_qe[kk] = *(const u32x4*)(base + kk * 32);
      n_kl[kk] = *(const u32x4*)(base + 4096 + kk * 32);
      n_at[kk] = *(const u32x4*)(base + 8192 + kk * 32);
    }
    n_el = EL[c * 64 + 16 * wid + l15];
#pragma unroll
    for (int ii = 0; ii < 2; ii++) {
      int cc = tid + 256 * ii;
      int i = cc >> 3, c8 = cc & 7;
      int tok = dir ? (N - 1 - (c * 64 + i)) : (c * 64 + i);
      n_v[ii] = *(const u32x4*)(Z + (long)(rowbase + tok) * ZLD + C_VG + h * 128 + vs0 + c8 * 8);
    }
  };
  prefetch(0);
  for (int c = 0; c < nc; c++) {
    u32x4 c_qe[2] = {n_qe[0], n_qe[1]}, c_kl[2] = {n_kl[0], n_kl[1]}, c_at[2] = {n_at[0], n_at[1]};
    const float el = n_el;
#pragma unroll
    for (int ii = 0; ii < 2; ii++) {
      int cc = tid + 256 * ii;
      int i = cc >> 3, c8 = cc & 7;
      const bfr* rb = (const bfr*)&n_v[ii];
#pragma unroll
      for (int e = 0; e < 8; e++) Vt[(c8 * 8 + e) * LDT + i] = rb[e];
    }
    __syncthreads();
    if (c + 1 < nc) prefetch(c + 1);
    f32x4 stn[4];
    const int i = 16 * wid + l15;
    const int tok = dir ? (N - 1 - (c * 64 + i)) : (c * 64 + i);
    bfr* og = OG + (long)(rowbase + tok) * 512 + h * 128 + vs0 + 4 * g;
#pragma unroll
    for (int vt = 0; vt < 4; vt++) {
      f32x4 oc = (f32x4){0.f, 0.f, 0.f, 0.f};
      stn[vt] = st[vt] * el;
#pragma unroll
      for (int kk = 0; kk < 2; kk++) {
        bf16x8 vf = *(const bf16x8*)(Vt + (16 * vt + l15) * LDT + kk * 32 + g * 8);
        bf16x8 sf = *(const bf16x8*)(St + (16 * vt + l15) * LDT + kk * 32 + g * 8);
        oc = mfma16(vf, *(bf16x8*)&c_at[kk], oc);
        oc = mfma16(sf, *(bf16x8*)&c_qe[kk], oc);
        stn[vt] = mfma16(vf, *(bf16x8*)&c_kl[kk], stn[vt]);
      }
      u32x2 ov;
      ov.x = pack2(oc[0], oc[1]);
      ov.y = pack2(oc[2], oc[3]);
      *(u32x2*)(og + 16 * vt) = ov;
    }
    __syncthreads();
#pragma unroll
    for (int vt = 0; vt < 4; vt++) {
      st[vt] = stn[vt];
#pragma unroll
      for (int r = 0; r < 4; r++) St[(16 * vt + 4 * g + r) * LDT + 16 * wid + l15] = f2bf(st[vt][r]);
    }
  }
  __syncthreads();
}

template <int VS>
__device__ __forceinline__ void gla_item(const Params& p, int l, int seq, int h, int dir, int vsl, bfr* sm) {
  constexpr int NVT = VS / 16;
  constexpr int NVL = VS / 32;
  const int tid = TIDX, lane = tid & 63, wid = tid >> 6, g = lane >> 4, l15 = lane & 15;
  bfr* Z = (bfr*)(p.ws + WS_Z);
  bfr* OG = (bfr*)(p.ws + WS_R1) + (long)dir * NROWS * 512;
  const bool lat = seq >= 16;
  const int b = seq - 16;
  const int N = lat ? 4096 : 256;
  const int rowbase = lat ? NCTX + b * 4096 : seq * 256;
  const int nc = N >> 6;
  const int vs0 = vsl * VS;
  bfr* Qr = sm;
  bfr* Kr = Qr + 64 * LDT;
  bfr* Qe = Kr + 64 * LDT;
  bfr* Ke = Qe + 64 * LDT;
  bfr* KlT = Ke + 64 * LDT;
  float* RF = (float*)(KlT + 64 * LDT);
  float* tot = RF + 64 * 16;
  float* lastv = tot + 256;
  bfr* Vt = (bfr*)(lastv + 64);
  bfr* St = Vt + VS * LDT;
  bfr* Att = Qr;
  const int ch = tid & 63;
  float wd[16];
  {
    const float* W = (dir ? p.in[19] : p.in[17]) + (long)l * 16 * 256 + h * 64 + ch;
#pragma unroll
    for (int r = 0; r < 16; r++) wd[r] = W[r * 256];
  }
  const float bias = (dir ? p.in[20] : p.in[18])[l * 256 + h * 64 + ch];

  f32x4 st[NVT];
  {
    const float* S0 = (dir ? p.in[7] : p.in[6]) + ((long)((b * 2 + l) * 4 + h)) * 8192 + (long)(16 * wid + l15) * 128 + vs0;
#pragma unroll
    for (int mv = 0; mv < NVT; mv++) {
      if (lat) {
        float4 a = *(const float4*)(S0 + 16 * mv + 4 * g);
        st[mv] = (f32x4){a.x, a.y, a.z, a.w};
      } else {
        st[mv] = (f32x4){0.f, 0.f, 0.f, 0.f};
      }
#pragma unroll
      for (int r = 0; r < 4; r++) St[(16 * mv + 4 * g + r) * LDT + 16 * wid + l15] = f2bf(st[mv][r]);
    }
  }
  u32x4 rq[2], rk[2], rv[NVL], rr;
  auto prefetch = [&](int c) {
#pragma unroll
    for (int ii = 0; ii < 2; ii++) {
      int cc = tid + 256 * ii;
      int i = cc >> 3, c8 = cc & 7;
      int tok = dir ? (N - 1 - (c * 64 + i)) : (c * 64 + i);
      const bfr* zr = Z + (long)(rowbase + tok) * ZLD;
      rq[ii] = *(const u32x4*)(zr + C_QG + h * 64 + c8 * 8);
      rk[ii] = *(const u32x4*)(zr + C_KG + h * 64 + c8 * 8);
    }
#pragma unroll
    for (int ii = 0; ii < NVL; ii++) {
      int cc = tid + 256 * ii;
      int i = cc / (VS / 8), c4 = cc % (VS / 8);
      int tok = dir ? (N - 1 - (c * 64 + i)) : (c * 64 + i);
      rv[ii] = *(const u32x4*)(Z + (long)(rowbase + tok) * ZLD + C_VG + h * 128 + vs0 + c4 * 8);
    }
    if (tid < 128) {
      int i = tid >> 1, hf = tid & 1;
      int tok = dir ? (N - 1 - (c * 64 + i)) : (c * 64 + i);
      rr = *(const u32x4*)(Z + (long)(rowbase + tok) * ZLD + (dir ? C_RB : C_RF) + hf * 8);
    }
  };
  prefetch(0);
  for (int c = 0; c < nc; c++) {
#pragma unroll
    for (int ii = 0; ii < 2; ii++) {
      int cc = tid + 256 * ii;
      *(u32x4*)(Qr + (cc >> 3) * LDT + (cc & 7) * 8) = rq[ii];
      *(u32x4*)(Kr + (cc >> 3) * LDT + (cc & 7) * 8) = rk[ii];
    }
#pragma unroll
    for (int ii = 0; ii < NVL; ii++) {
      int cc = tid + 256 * ii;
      int i = cc / (VS / 8), c4 = cc % (VS / 8);
      const bfr* rb = (const bfr*)&rv[ii];
#pragma unroll
      for (int e = 0; e < 8; e++) Vt[(c4 * 8 + e) * LDT + i] = rb[e];
    }
    if (tid < 128) {
      int i = tid >> 1, hf = tid & 1;
      float x[8];
      unpack8(rr, x);
#pragma unroll
      for (int e = 0; e < 8; e++) RF[i * 16 + hf * 8 + e] = x[e];
    }
    __syncthreads();
    if (c + 1 < nc) prefetch(c + 1);
    gla_chunk_prep(tid, wd, bias, Qr, Kr, Qe, Ke, KlT, RF, tot, lastv);
    f32x4 stn[NVT];
    {
      float el = __expf(lastv[16 * wid + l15]);
#pragma unroll
      for (int mv = 0; mv < NVT; mv++) {
        stn[mv] = st[mv] * el;
#pragma unroll
        for (int kk = 0; kk < 2; kk++) {
          bf16x8 va = *(const bf16x8*)(Vt + (16 * mv + l15) * LDT + kk * 32 + g * 8);
          bf16x8 kb = *(const bf16x8*)(KlT + (16 * wid + l15) * LDT + kk * 32 + g * 8);
          stn[mv] = mfma16(va, kb, stn[mv]);
        }
      }
      gla_att(wid, g, l15, Qe, Ke, Att);
    }
    __syncthreads();
    {
      bf16x8 aa[2], qa[2];
#pragma unroll
      for (int kk = 0; kk < 2; kk++) {
        aa[kk] = *(const bf16x8*)(Att + (16 * wid + l15) * LDT + kk * 32 + g * 8);
        qa[kk] = *(const bf16x8*)(Qe + (16 * wid + l15) * LDT + kk * 32 + g * 8);
      }
#pragma unroll
      for (int nv = 0; nv < NVT; nv++) {
        f32x4 oc = (f32x4){0.f, 0.f, 0.f, 0.f};
#pragma unroll
        for (int kk = 0; kk < 2; kk++) {
          bf16x8 vb = *(const bf16x8*)(Vt + (16 * nv + l15) * LDT + kk * 32 + g * 8);
          oc = mfma16(aa[kk], vb, oc);
          bf16x8 sb = *(const bf16x8*)(St + (16 * nv + l15) * LDT + kk * 32 + g * 8);
          oc = mfma16(qa[kk], sb, oc);
        }
#pragma unroll
        for (int r = 0; r < 4; r++) {
          int i = 16 * wid + 4 * g + r;
          int tok = dir ? (N - 1 - (c * 64 + i)) : (c * 64 + i);
          OG[(long)(rowbase + tok) * 512 + h * 128 + vs0 + 16 * nv + l15] = f2bf(oc[r]);
        }
      }
    }
    __syncthreads();
#pragma unroll
    for (int mv = 0; mv < NVT; mv++) {
      st[mv] = stn[mv];
#pragma unroll
      for (int r = 0; r < 4; r++) St[(16 * mv + 4 * g + r) * LDT + 16 * wid + l15] = f2bf(st[mv][r]);
    }
  }
  __syncthreads();
  if (!lat) {
    float* so = p.out + (dir ? O_SB : O_SF) + ((long)((seq * 2 + l) * 4 + h)) * 8192 + (long)(16 * wid + l15) * 128 + vs0;
#pragma unroll
    for (int mv = 0; mv < NVT; mv++)
      *(float4*)(so + 16 * mv + 4 * g) = make_float4(st[mv][0], st[mv][1], st[mv][2], st[mv][3]);
  }
}

__device__ __forceinline__ void phase_mla_up(const Params& p, int l, bfr* sm) {
  bfr* Z = (bfr*)(p.ws + WS_Z);
  const float* rope = (const float*)(p.ws + WS_ROPE);
  const int lane = TIDX & 63, wid = TIDX >> 6, wr = wid >> 1, wc = wid & 1;
  const int g = lane >> 4;
  for (int t = blockIdx.x; t < 288 + 624 + 1024; t += gridDim.x) {
    if (t >= 912) {
      int i = t - 912;
      gla_prep_item(p, l, i >> 9, (i >> 7) & 3, (i >> 6) & 1, i & 63, sm);
      continue;
    }
    f32x4 acc[4][4];
#pragma unroll
    for (int a = 0; a < 4; a++)
#pragma unroll
      for (int b = 0; b < 4; b++) acc[a][b] = (f32x4){0.f, 0.f, 0.f, 0.f};
    if (t < 288) {
      int tn = t % 3, tm = t / 3;
      gemm128k64<4, true>((const bfr*)(p.ws + WS_WUQ) + (long)tn * 128 * 256, 256, 128, Z + (long)tm * 128 * ZLD + C_QL, ZLD, 256,
                    acc, sm);
      bfr* CQ = (bfr*)(p.ws + WS_CQ);
      const float qs = 0.10206207261596577f * 1.4426950408889634f;
#pragma unroll
      for (int pi = 0; pi < 4; pi++) {
        int nb = tn * 128 + wr * 64 + pi * 16;
        int wb = nb % 96;
        bool ropet = wb >= 64;
        int part = (wb - 64) >> 4;
#pragma unroll
        for (int qi = 0; qi < 4; qi++) {
          int tok = tm * 128 + wc * 64 + qi * 16 + (lane & 15);
          float y[4] = {acc[pi][qi][0], acc[pi][qi][1], acc[pi][qi][2], acc[pi][qi][3]};
          if (ropet) {
            bool lat = tok >= NCTX;
            int tl = (tok - NCTX) & 4095;
            int pos = part ? (tl & 63) : (tl >> 6);
            bool hi = (g & 2) != 0;
            int i0 = (g & 1) * 4;
#pragma unroll
            for (int r = 0; r < 4; r++) {
              float yp = __shfl_xor(y[r], 32);
              float c = rope[2048 + pos * 8 + i0 + r], s = rope[2560 + pos * 8 + i0 + r];
              float yr = hi ? (yp * s + y[r] * c) : (y[r] * c - yp * s);
              y[r] = lat ? yr : y[r];
            }
          }
          u32x2 o;
          o.x = pack2(y[0] * qs, y[1] * qs);
          o.y = pack2(y[2] * qs, y[3] * qs);
          *(u32x2*)(CQ + (long)tok * 384 + nb + g * 4) = o;
        }
      }
    } else {
      int t2 = t - 288;
      int tn = t2 % 6, tm = t2 / 6;
      const bfr* Q;
      long ldq;
      long kbase, vbase;
      int nk, key0;
      if (tm < 32) {
        Q = Z + (long)tm * 128 * ZLD + C_KV;
        ldq = ZLD;
        int s = tm >> 1;
        key0 = (tm & 1) * 128;
        nk = 256;
        kbase = (long)s * (4 * 256 * 64);
        vbase = (long)s * 131072;
      } else {
        int r = (tm - 32) * 128;
        int b = r / 4608, within = r % 4608;
        key0 = within;
        nk = 4608;
        kbase = 16l * (4 * 256 * 64) + (long)b * (4 * 4608 * 64);
        vbase = 16l * 131072 + (long)b * (4 * 128 * 4608);
        if (within < 512) {
          Q = (const bfr*)(p.ws + WS_CKVC) + (long)(b * 512 + within) * 256;
          ldq = 256;
        } else {
          Q = Z + (long)(NCTX + b * 4096 + within - 512) * ZLD + C_KV;
          ldq = ZLD;
        }
      }
      gemm128k64<4, true>((const bfr*)(p.ws + WS_WUKV) + (long)tn * 128 * 256, 256, 128, Q, ldq, 256, acc, sm);
      bfr* KN = (bfr*)(p.ws + WS_KNOPE);
      bfr* VTC = (bfr*)(p.ws + WS_VTC);
#pragma unroll
      for (int pi = 0; pi < 4; pi++) {
        int n0 = tn * 128 + wr * 64 + pi * 16 + g * 4;
        int head = n0 / 192, w = n0 % 192;
#pragma unroll
        for (int qi = 0; qi < 4; qi++) {
          int key = key0 + wc * 64 + qi * 16 + (lane & 15);
          if (w < 64) {
            u32x2 o;
            o.x = pack2(acc[pi][qi][0], acc[pi][qi][1]);
            o.y = pack2(acc[pi][qi][2], acc[pi][qi][3]);
            *(u32x2*)(KN + kbase + ((long)head * nk + key) * 64 + w) = o;
          } else {
#pragma unroll
            for (int r = 0; r < 4; r++)
              VTC[vbase + ((long)head * 128 + (w - 64) + r) * nk + key] = f2bf(acc[pi][qi][r]);
          }
        }
      }
    }
  }
}

template <int DQ, int DV, bool MLA, int NQB, bool DMA, int TP>
__device__ __forceinline__ void attn_item(const Params& p, int seq, int head, int qoff, bfr* sm, int dry) {
  constexpr int KLD = DQ + 8;
  constexpr int KSZ = DMA ? (MLA ? 6144 : 4096) : 64 * KLD;
  constexpr int VSZ = DMA ? DV * 64 : DV * LDT;
  constexpr int BUF = KSZ + VSZ;
  constexpr int NKK = DQ / 32;
  constexpr int NDV = DV / 16;
  constexpr int NVL = DV / 32;
  const int tid = TIDX, lane = tid & 63, wid = tid >> 6, g = lane >> 4, l15 = lane & 15;
  bfr* Z = (bfr*)(p.ws + WS_Z);
  const int sK = 2 * (l15 >> 2) + ((l15 >> 1) & 1), sR = ((l15 >> 3) & 1) * 2, sV = l15 >> 1;
  auto kaddr = [&](const bfr* Ks, int krow, int kk) -> const bfr* {
    if (DMA) return (kk < 2) ? (Ks + krow * 64 + (((kk * 4 + g) ^ sK) * 8)) : (Ks + 4096 + krow * 32 + ((g ^ sR) * 8));
    return Ks + krow * KLD + kk * 32 + g * 8;
  };
  auto vaddr = [&](const bfr* Vs, int d, int sx) -> const bfr* {
    if (DMA) return Vs + (d * 16 + l15) * 64 + (((sx * 4 + g) ^ sV) * 8);
    return Vs + (d * 16 + l15) * LDT + sx * 32 + g * 8;
  };
  const bool lat = seq >= 16;
  const int b = seq - 16;
  const int nk = lat ? 4608 : 256;
  const int rowbase = lat ? NCTX + b * 4096 : seq * 256;
  const int nkt = nk >> 6;

  bf16x8 qf[NQB][NKK];
#pragma unroll
  for (int qb = 0; qb < NQB; qb++) {
    int qrow = rowbase + qoff + wid * (16 * NQB) + qb * 16 + l15;
    const bfr* qp = MLA ? ((const bfr*)(p.ws + WS_CQ) + (long)qrow * 384 + head * 96) : (Z + (long)qrow * ZLD + C_QA + head * 64);
#pragma unroll
    for (int kk = 0; kk < NKK; kk++) qf[qb][kk] = *(const bf16x8*)(qp + kk * 32 + g * 8);
  }

  u32x4 rk[TP][2], rkr[TP], rv[TP][NVL];
  auto prefetch = [&](int pi) {
#pragma unroll
   for (int u = 0; u < TP; u++) {
    int k0 = (pi * TP + u) * 64;
    bool cache = lat && (k0 < 512);
    int tokrow0 = lat ? (NCTX + b * 4096 + k0 - 512) : (seq * 256 + k0);
    if (!MLA) {
      int kvh = head >> 2;
#pragma unroll
      for (int i = 0; i < 2; i++) {
        int c = tid + 256 * i;
        int kr_ = c >> 3, ch = c & 7;
        const bfr* src = cache ? ((const bfr*)(p.ws + WS_KCA) + (long)(b * 512 + k0 + kr_) * 128 + kvh * 64 + ch * 8)
                               : (Z + (long)(tokrow0 + kr_) * ZLD + C_KA + kvh * 64 + ch * 8);
        rk[u][i] = *(const u32x4*)src;
      }
      long vb = lat ? (16l * 32768 + (long)b * (2 * 64 * 4608)) : ((long)seq * 32768);
#pragma unroll
      for (int i = 0; i < NVL; i++) {
        int c = tid + 256 * i;
        int dv = c >> 3, ch = c & 7;
        rv[u][i] = *(const u32x4*)((const bfr*)(p.ws + WS_VTA) + vb + (long)(kvh * 64 + dv) * nk + k0 + ch * 8);
      }
    } else {
      long kb = lat ? (16l * (4 * 256 * 64) + (long)b * (4 * 4608 * 64)) : ((long)seq * (4 * 256 * 64));
#pragma unroll
      for (int i = 0; i < 2; i++) {
        int c = tid + 256 * i;
        int kr_ = c >> 3, ch = c & 7;
        rk[u][i] = *(const u32x4*)((const bfr*)(p.ws + WS_KNOPE) + kb + ((long)head * nk + k0 + kr_) * 64 + ch * 8);
      }
      {
        int kr_ = tid >> 2, ch = tid & 3;
        const bfr* src = cache ? ((const bfr*)(p.ws + WS_KRC) + (long)(b * 512 + k0 + kr_) * 32 + ch * 8)
                               : (Z + (long)(tokrow0 + kr_) * ZLD + C_KR + ch * 8);
        rkr[u] = *(const u32x4*)src;
      }
      long vb = lat ? (16l * 131072 + (long)b * (4 * 128 * 4608)) : ((long)seq * 131072);
#pragma unroll
      for (int i = 0; i < NVL; i++) {
        int c = tid + 256 * i;
        int dv = c >> 3, ch = c & 7;
        rv[u][i] = *(const u32x4*)((const bfr*)(p.ws + WS_VTC) + vb + (long)(head * 128 + dv) * nk + k0 + ch * 8);
      }
    }
   }
  };

  f32x4 o[NQB][NDV];
#pragma unroll
  for (int qb = 0; qb < NQB; qb++)
#pragma unroll
    for (int d = 0; d < NDV; d++) o[qb][d] = (f32x4){0.f, 0.f, 0.f, 0.f};
  float mrun[NQB];
  f32x4 lacc[NQB];
#pragma unroll
  for (int qb = 0; qb < NQB; qb++) { mrun[qb] = 0.f; lacc[qb] = (f32x4){0.f, 0.f, 0.f, 0.f}; }
  const bf16x8 ones = (bf16x8){(short)0x3F80, (short)0x3F80, (short)0x3F80, (short)0x3F80, (short)0x3F80, (short)0x3F80, (short)0x3F80, (short)0x3F80};

  auto dma_issue = [&](int pi, bfr* stg0) {
#pragma unroll
   for (int u = 0; u < TP; u++) {
    bfr* stg = stg0 + u * BUF;
    const int k0 = (pi * TP + u) * 64;
    const bool cache = lat && (k0 < 512);
    const int tokrow0 = lat ? (NCTX + b * 4096 + k0 - 512) : (seq * 256 + k0);
    const int cK = (tid & 7) ^ (((tid >> 6) & 3) * 2 + ((tid >> 4) & 1));
    const int cV = (tid & 7) ^ ((tid >> 4) & 7);
    if (MLA) {
      const long kb = lat ? (16l * (4 * 256 * 64) + (long)b * (4 * 4608 * 64)) : ((long)seq * (4 * 256 * 64));
      const long vb = lat ? (16l * 131072 + (long)b * (4 * 128 * 4608)) : ((long)seq * 131072);
#pragma unroll
      for (int i = 0; i < 2; i++)
        glds16((const bfr*)(p.ws + WS_KNOPE) + kb + ((long)head * nk + k0 + i * 32 + (tid >> 3)) * 64 + cK * 8, stg + i * 2048 + tid * 8);
      {
        const int row = tid >> 2, c = (tid & 3) ^ (((tid >> 6) & 1) * 2);
        const bfr* src = cache ? ((const bfr*)(p.ws + WS_KRC) + (long)(b * 512 + k0 + row) * 32 + c * 8)
                               : (Z + (long)(tokrow0 + row) * ZLD + C_KR + c * 8);
        glds16(src, stg + 4096 + tid * 8);
      }
#pragma unroll
      for (int i = 0; i < 4; i++)
        glds16((const bfr*)(p.ws + WS_VTC) + vb + (long)(head * 128 + i * 32 + (tid >> 3)) * nk + k0 + cV * 8, stg + 6144 + i * 2048 + tid * 8);
    } else {
      const int kvh = head >> 2;
      const long vb = lat ? (16l * 32768 + (long)b * (2 * 64 * 4608)) : ((long)seq * 32768);
#pragma unroll
      for (int i = 0; i < 2; i++) {
        const int row = i * 32 + (tid >> 3);
        const bfr* src = cache ? ((const bfr*)(p.ws + WS_KCA) + (long)(b * 512 + k0 + row) * 128 + kvh * 64 + cK * 8)
                               : (Z + (long)(tokrow0 + row) * ZLD + C_KA + kvh * 64 + cK * 8);
        glds16(src, stg + i * 2048 + tid * 8);
      }
#pragma unroll
      for (int i = 0; i < 2; i++)
        glds16((const bfr*)(p.ws + WS_VTA) + vb + (long)(kvh * 64 + i * 32 + (tid >> 3)) * nk + k0 + cV * 8, stg + 4096 + i * 2048 + tid * 8);
    }
   }
  };
  if (DMA) dma_issue(0, sm); else prefetch(0);
  const int np = nkt / TP;
  for (int pi = 0; pi < np; pi++) {
    bfr* base = sm + (pi & 1) * (TP * BUF);
    if (DMA) {
      asm volatile("s_waitcnt vmcnt(0)" ::: "memory");
      __syncthreads();
      if (pi + 1 < np) dma_issue(pi + 1, sm + ((pi + 1) & 1) * (TP * BUF));
    } else {
#pragma unroll
      for (int u = 0; u < TP; u++) {
        bfr* Ks = base + u * BUF;
        bfr* Vs = Ks + KSZ;
#pragma unroll
        for (int i = 0; i < 2; i++) {
          int c = tid + 256 * i;
          *(u32x4*)(Ks + (c >> 3) * KLD + (c & 7) * 8) = rk[u][i];
        }
        if (MLA) *(u32x4*)(Ks + (tid >> 2) * KLD + 64 + (tid & 3) * 8) = rkr[u];
#pragma unroll
        for (int i = 0; i < NVL; i++) {
          int c = tid + 256 * i;
          *(u32x4*)(Vs + (c >> 3) * LDT + (c & 7) * 8) = rv[u][i];
        }
      }
      __syncthreads();
      if (pi + 1 < np) prefetch(pi + 1);
    }
#pragma unroll
   for (int u = 0; u < TP; u++) {
    const bfr* Ks = base + u * BUF;
    const bfr* Vs = Ks + KSZ;
    const int kt = pi * TP + u;

    f32x4 s[NQB][4];
    bf16x8 kfr[4][NKK];
#pragma unroll
    for (int t = 0; t < 2; t++) {
      int krow = 32 * (t >> 1) + 8 * (l15 >> 2) + 4 * (t & 1) + (l15 & 3);
#pragma unroll
      for (int kk = 0; kk < NKK; kk++) kfr[t][kk] = *(const bf16x8*)kaddr(Ks, krow, kk);
    }
#pragma unroll
    for (int t = 0; t < 4; t++) {
#pragma unroll
      for (int qb = 0; qb < NQB; qb++) s[qb][t] = (f32x4){-mrun[qb], -mrun[qb], -mrun[qb], -mrun[qb]};
      if (t + 2 < 4) {
        int krow = 32 * ((t + 2) >> 1) + 8 * (l15 >> 2) + 4 * ((t + 2) & 1) + (l15 & 3);
#pragma unroll
        for (int kk = 0; kk < NKK; kk++) kfr[t + 2][kk] = *(const bf16x8*)kaddr(Ks, krow, kk);
      }
#pragma unroll
      for (int kk = 0; kk < NKK; kk++) {
#pragma unroll
        for (int qb = 0; qb < NQB; qb++) s[qb][t] = mfma16(kfr[t][kk], qf[qb][kk], s[qb][t]);
      }
    }
    bf16x8 vfr[4][2];
#pragma unroll
    for (int d = 0; d < 4; d++)
#pragma unroll
      for (int sx = 0; sx < 2; sx++) vfr[d][sx] = *(const bf16x8*)vaddr(Vs, d, sx);
    bf16x8 pf[NQB][2];
#pragma unroll
    for (int qb = 0; qb < NQB; qb++) {
      float mt = s[qb][0][0];
#pragma unroll
      for (int t = 0; t < 4; t++)
#pragma unroll
        for (int r = 0; r < 4; r++) mt = fmaxf(mt, s[qb][t][r]);
      const bool first = (kt == 0);
      if (first || __builtin_amdgcn_ballot_w64(mt > 8.f) != 0ull) {
        mt = fmaxf(mt, __shfl_xor(mt, 16));
        mt = fmaxf(mt, __shfl_xor(mt, 32));
        const bool need = first || mt > 8.f;
        const float dm = need ? mt : 0.f;
        const float alpha = first ? 1.f : __builtin_amdgcn_exp2f(-dm);
        mrun[qb] += dm;
        lacc[qb] *= alpha;
#pragma unroll
        for (int d = 0; d < NDV; d++) o[qb][d] *= alpha;
#pragma unroll
        for (int t = 0; t < 4; t++) s[qb][t] -= dm;
      }
#pragma unroll
      for (int t = 0; t < 4; t++)
#pragma unroll
        for (int r = 0; r < 4; r++) s[qb][t][r] = __builtin_amdgcn_exp2f(s[qb][t][r]);
#pragma unroll
      for (int sx = 0; sx < 2; sx++) {
        u32x4 u;
        u.x = pack2(s[qb][2 * sx][0], s[qb][2 * sx][1]);
        u.y = pack2(s[qb][2 * sx][2], s[qb][2 * sx][3]);
        u.z = pack2(s[qb][2 * sx + 1][0], s[qb][2 * sx + 1][1]);
        u.w = pack2(s[qb][2 * sx + 1][2], s[qb][2 * sx + 1][3]);
        pf[qb][sx] = *(bf16x8*)&u;
      }
    }
#pragma unroll
    for (int d = 0; d < NDV; d++) {
#pragma unroll
      for (int sx = 0; sx < 2; sx++) {
#pragma unroll
        for (int qb = 0; qb < NQB; qb++) o[qb][d] = mfma16(vfr[d & 3][sx], pf[qb][sx], o[qb][d]);
      }
      if (d + 4 < NDV) {
#pragma unroll
        for (int sx = 0; sx < 2; sx++)
          vfr[d & 3][sx] = *(const bf16x8*)vaddr(Vs, d + 4, sx);
      }
    }
#pragma unroll
    for (int sx = 0; sx < 2; sx++) {
#pragma unroll
      for (int qb = 0; qb < NQB; qb++) lacc[qb] = mfma16(ones, pf[qb][sx], lacc[qb]);
    }
   }
  }
  __syncthreads();
#pragma unroll
  for (int qb = 0; qb < NQB; qb++) {
    float inv = 1.f / lacc[qb][0];
    int qrow = rowbase + qoff + wid * (16 * NQB) + qb * 16 + l15;
    bfr* gp = Z + (long)qrow * ZLD + (MLA ? C_GC : C_GA) + head * DV + g * 4;
#pragma unroll
    for (int d = 0; d < NDV; d++) {
      u32x2 gr = *(const u32x2*)(gp + d * 16);
      float y0 = o[qb][d][0] * inv * siluf(lo16(gr.x));
      float y1 = o[qb][d][1] * inv * siluf(hi16(gr.x));
      float y2 = o[qb][d][2] * inv * siluf(lo16(gr.y));
      float y3 = o[qb][d][3] * inv * siluf(hi16(gr.y));
      u32x2 ov;
      ov.x = pack2(y0, y1);
      ov.y = pack2(y2, y3);
      if (!dry) *(u32x2*)(gp + d * 16) = ov;
    }
  }
}

__device__ __forceinline__ void phase_mixers(const Params& p, int l, bfr* sm, int* s_item, int dry) {
  unsigned* ctr = (unsigned*)(p.ws + WS_CTR) + (2 + l + 2 * dry) * 128;
  auto cnt = [](int) { return 184; };
  int q = (int)xcc_id(), tried = 0;
  for (;;) {
    if (TIDX == 0) {
      unsigned first = atomicAdd(ctr + q * 16, 1u);
      *s_item = xq_take(ctr, q, tried, first, cnt);
    }
    __syncthreads();
    const int it = *s_item;
    __syncthreads();
    if (it < 0) break;
    const int x = it >> 20, j = it & 0xfffff;
    int kind, a0, a1, a2, a3 = 0;
    if (j < 4) {
      int idx = x * 4 + j;
      kind = 3; a0 = idx >> 4; a1 = (idx >> 2) & 3; a2 = (idx >> 1) & 1; a3 = idx & 1;
    } else if (j < 36) {
      kind = 1; a0 = 16 + (x >> 2); a1 = x & 3; a2 = (j - 4) * 128;
    } else if (j < 96) {
      int i = j - 36;
      kind = 2; a0 = 16 + (x >> 2); a1 = ((x >> 1) & 1) * 4 + (x & 1) * 2 + (i >> 5); a2 = (i & 31) * 128;
    } else if (j < 104) {
      int k = j - 96;
      int i = 60 + (k >> 1);
      kind = 4; a0 = 16 + (x >> 2); a1 = ((x >> 1) & 1) * 4 + (x & 1) * 2 + (i >> 5); a2 = (i & 31) * 128 + (k & 1) * 64;
    } else if (j < 136) {
      int i = j - 104;
      kind = 0; a0 = 2 * x + (i >> 4); a1 = (i >> 2) & 3; a2 = (i >> 1) & 1; a3 = i & 1;
    } else if (j < 152) {
      int i = j - 136;
      kind = 1; a0 = 2 * x + (i >> 3); a1 = (i >> 1) & 3; a2 = (i & 1) * 128;
    } else {
      int i = j - 152;
      kind = 2; a0 = 2 * x + (i >> 4); a1 = (i >> 1) & 7; a2 = (i & 1) * 128;
    }
#ifdef PROBE_MIXKIND
    if (dry && ((PROBE_MIXKIND == 1) != (kind == 0 || kind == 3))) continue;
#endif
    if (kind == 0) gla_item<64>(p, l, a0, a1, a2, a3, sm);
    else if (kind == 3) gla_chain_item(p, l, a0, a1, a2, a3, sm);
    else if (kind == 1) attn_item<96, 128, true, 2, true, 1>(p, a0, a1, a2, sm, dry);
    else if (kind == 2) attn_item<64, 64, false, 2, true, 2>(p, a0, a1, a2, sm, dry);
    else attn_item<64, 64, false, 1, true, 2>(p, a0, a1, a2, sm, dry);
  }
}

__device__ __forceinline__ void phase_gla_out(const Params& p, int l) {
  const int lane = TIDX & 63;
  bfr* Z = (bfr*)(p.ws + WS_Z);
  const bfr* OF = (const bfr*)(p.ws + WS_R1);
  const bfr* OB = OF + (long)NROWS * 512;
  for (int row = blockIdx.x * 4 + (TIDX >> 6); row < NROWS; row += gridDim.x * 4) {
    float a[8], c[8], gt[8];
    unpack8(*(const u32x4*)(OF + (long)row * 512 + lane * 8), a);
    unpack8(*(const u32x4*)(OB + (long)row * 512 + lane * 8), c);
    bfr* gp = Z + (long)row * ZLD + C_GG + lane * 8;
    unpack8(*(const u32x4*)gp, gt);
    float ss = 0.f;
#pragma unroll
    for (int e = 0; e < 8; e++) {
      a[e] = bf2f(f2bf(a[e] + c[e]));
      ss += a[e] * a[e];
    }
    ss += __shfl_xor(ss, 1); ss += __shfl_xor(ss, 2); ss += __shfl_xor(ss, 4); ss += __shfl_xor(ss, 8);
    float rs = rsqrtf(ss * (1.f / 128.f) + 1e-6f);
    const float* gg = p.in[21] + l * 128 + (lane & 15) * 8;
#pragma unroll
    for (int e = 0; e < 8; e++) a[e] = a[e] * rs * gg[e] * siluf(gt[e]);
    *(u32x4*)gp = pack8(a);
  }
}

template <int NQ>
__device__ __forceinline__ void merge_tile(const Params& p, bfr* sm, int tn, int tok0) {
  constexpr int STG = 8192 + 2048 * NQ;
  bfr* Z = (bfr*)(p.ws + WS_Z);
  bfr* MG = (bfr*)(p.ws + WS_R1);
  const int tid = TIDX;
  const int lane = tid & 63, wid = tid >> 6, wr = wid >> 1, wc = wid & 1, g = lane >> 4, l15 = lane & 15;
  f32x4 totl[4][NQ];
#pragma unroll
  for (int a = 0; a < 4; a++)
#pragma unroll
    for (int b = 0; b < NQ; b++) totl[a][b] = (f32x4){0.f, 0.f, 0.f, 0.f};
#pragma unroll 1
  for (int seg = 0; seg < 3; seg++) {
    f32x4 acc[4][NQ];
#pragma unroll
    for (int a = 0; a < 4; a++)
#pragma unroll
      for (int b = 0; b < NQ; b++) acc[a][b] = (f32x4){0.f, 0.f, 0.f, 0.f};
    int ycol = seg == 0 ? C_GA : (seg == 1 ? C_GG : C_GC);
    int mcol = C_M1 + seg * 1024;
    const bfr* W = (const bfr*)(p.ws + WS_WOA + (unsigned long)seg * 1048576ul) + (long)tn * 128 * 512;
    gemm128k64<NQ, false, true>(W, 512, 128, Z + (long)tok0 * ZLD + ycol, ZLD, 512, acc, sm,
                                Z + (long)tok0 * ZLD + mcol + tn * 128, ZLD);
    const bfr* gt = sm;
#pragma unroll
    for (int pi = 0; pi < 4; pi++) {
      const int nl = wr * 64 + pi * 16 + g * 4;
#pragma unroll
      for (int qi = 0; qi < NQ; qi++) {
        const int tl = wc * 16 * NQ + qi * 16 + l15;
        u32x2 mr = *(const u32x2*)(gt + tl * 128 + (((nl >> 3) ^ (tl & 15)) * 8) + (nl & 4));
        totl[pi][qi][0] += sigmf(lo16(mr.x)) * acc[pi][qi][0];
        totl[pi][qi][1] += sigmf(hi16(mr.x)) * acc[pi][qi][1];
        totl[pi][qi][2] += sigmf(lo16(mr.y)) * acc[pi][qi][2];
        totl[pi][qi][3] += sigmf(hi16(mr.y)) * acc[pi][qi][3];
      }
    }
    __syncthreads();
  }
#pragma unroll
  for (int pi = 0; pi < 4; pi++)
#pragma unroll
    for (int qi = 0; qi < NQ; qi++) {
      u32x2 o;
      o.x = pack2(totl[pi][qi][0], totl[pi][qi][1]);
      o.y = pack2(totl[pi][qi][2], totl[pi][qi][3]);
      *(u32x2*)(sm + (wc * 16 * NQ + qi * 16 + l15) * 136 + wr * 64 + pi * 16 + g * 4) = o;
    }
  __syncthreads();
#pragma unroll
  for (int i = 0; i < 2 * NQ; i++) {
    int c = tid + 256 * i;
    int row = c >> 4, c16 = c & 15;
    *(u32x4*)(MG + (long)(tok0 + row) * 1024 + tn * 128 + c16 * 8) = *(const u32x4*)(sm + row * 136 + c16 * 8);
  }
  __syncthreads();
}

__device__ __forceinline__ void phase_merge(const Params& p, bfr* sm) {
  for (int t = blockIdx.x; t < 1024; t += gridDim.x) {
    if (t < 512) {
      merge_tile<4>(p, sm, t & 7, (t >> 3) * 128);
    } else {
      int u = t - 512;
      int full = 512 + (u >> 1);
      merge_tile<2>(p, sm, full & 7, (full >> 3) * 128 + (u & 1) * 64);
    }
  }
}

template <int NQ>
__device__ __forceinline__ void outproj_tile(const Params& p, bfr* sm, int tn, int tok0) {
  const bfr* MG = (const bfr*)(p.ws + WS_R1);
  float* OUT = (float*)(p.ws + WS_Z);
  const int tid = TIDX;
  const int lane = tid & 63, wid = tid >> 6, wr = wid >> 1, wc = wid & 1, g = lane >> 4, l15 = lane & 15;
  f32x4 acc[4][NQ];
#pragma unroll
  for (int a = 0; a < 4; a++)
#pragma unroll
    for (int b = 0; b < NQ; b++) acc[a][b] = (f32x4){0.f, 0.f, 0.f, 0.f};
  gemm128k64<NQ, true>((const bfr*)(p.ws + WS_WOUT) + (long)tn * 128 * 1024, 1024, 128, MG + (long)tok0 * 1024, 1024, 1024, acc, sm);
  float* smf = (float*)sm;
#pragma unroll
  for (int pi = 0; pi < 4; pi++)
#pragma unroll
    for (int qi = 0; qi < NQ; qi++)
      *(f32x4*)(smf + (wc * 16 * NQ + qi * 16 + l15) * 132 + wr * 64 + pi * 16 + g * 4) = acc[pi][qi];
  __syncthreads();
#pragma unroll
  for (int i = 0; i < 4 * NQ; i++) {
    int c = tid + 256 * i;
    int row = c >> 5, c16 = c & 31;
    *(f32x4*)(OUT + (long)(tok0 + row) * 1024 + tn * 128 + c16 * 4) = *(const f32x4*)(smf + row * 132 + c16 * 4);
  }
  __syncthreads();
}
__device__ __forceinline__ void phase_outproj(const Params& p, bfr* sm) {
  for (int t = blockIdx.x; t < 1024; t += gridDim.x) {
    if (t < 512) {
      outproj_tile<4>(p, sm, t & 7, (t >> 3) * 128);
    } else {
      int u = t - 512;
      int full = 512 + (u >> 1);
      outproj_tile<2>(p, sm, full & 7, (full >> 3) * 128 + (u & 1) * 64);
    }
  }
}

__device__ __forceinline__ void phase_post(const Params& p, int l) {
  const int lane = TIDX & 63;
  const float* mod = (const float*)(p.ws + WS_MOD);
  const float* OUT = (const float*)(p.ws + WS_Z);
  bfr* H = (bfr*)(p.ws + WS_R1);
  for (int row = blockIdx.x * 4 + (TIDX >> 6); row < NROWS; row += gridDim.x * 4) {
    const float* x = (l == 0) ? xrow(p, row) : (p.out + (long)row * 1024);
    const float* md = mod + (l * 3 + row_cond(row)) * 3072;
    float4 v[4];
    float ss = 0.f;
#pragma unroll
    for (int i = 0; i < 4; i++) {
      v[i] = *(const float4*)(OUT + (long)row * 1024 + i * 256 + lane * 4);
      ss += v[i].x * v[i].x + v[i].y * v[i].y + v[i].z * v[i].z + v[i].w * v[i].w;
    }
    ss = wave_sum(ss);
    float rs = rsqrtf(ss * (1.f / 1024.f) + 1e-6f);
    float ss2 = 0.f;
#pragma unroll
    for (int i = 0; i < 4; i++) {
      int n = i * 256 + lane * 4;
      float4 g = *(const float4*)(p.in[13] + l * 1024 + n);
      float4 gt = *(const float4*)(md + 2048 + n);
      float4 xv = *(const float4*)(x + n);
      v[i].x = xv.x + gt.x * (v[i].x * rs * g.x);
      v[i].y = xv.y + gt.y * (v[i].y * rs * g.y);
      v[i].z = xv.z + gt.z * (v[i].z * rs * g.z);
      v[i].w = xv.w + gt.w * (v[i].w * rs * g.w);
      *(float4*)(p.out + (long)row * 1024 + n) = v[i];
      ss2 += v[i].x * v[i].x + v[i].y * v[i].y + v[i].z * v[i].z + v[i].w * v[i].w;
    }
    if (l == 0) {
      ss2 = wave_sum(ss2);
      float rs2 = rsqrtf(ss2 * (1.f / 1024.f) + 1e-6f);
      const float* md1 = mod + (1 * 3 + row_cond(row)) * 3072;
#pragma unroll
      for (int i = 0; i < 4; i++) {
        int n = i * 256 + lane * 4;
        float4 g = *(const float4*)(p.in[12] + 1024 + n);
        float4 sh = *(const float4*)(md1 + n);
        float4 sc = *(const float4*)(md1 + 1024 + n);
        float h0 = v[i].x * rs2 * g.x * (1.f + sc.x) + sh.x;
        float h1 = v[i].y * rs2 * g.y * (1.f + sc.y) + sh.y;
        float h2 = v[i].z * rs2 * g.z * (1.f + sc.z) + sh.z;
        float h3 = v[i].w * rs2 * g.w * (1.f + sc.w) + sh.w;
        u32x2 o;
        o.x = pack2(h0, h1);
        o.y = pack2(h2, h3);
        *(u32x2*)(H + (long)row * 1024 + n) = o;
      }
    }
  }
}

__global__ void __launch_bounds__(256, 2) fwd_megakernel(Params p) {
  __shared__ __attribute__((aligned(16))) bfr sm[SMEM_SHORTS + 16];
  int* s_item_p = (int*)(sm + SMEM_SHORTS + 8);
  cg::grid_group grid = cg::this_grid();
  if (threadIdx.x == 0) { ((unsigned*)(sm + SMEM_SHORTS))[0] = 0u; ((unsigned*)(sm + SMEM_SHORTS))[1] = 0u; }
  __syncthreads();
  XcdBarrier xb = xcd_barrier_post((unsigned*)(p.ws + WS_BAR), (volatile LAS unsigned*)(sm + SMEM_SHORTS));
  if (p.ws == nullptr) grid.sync();
  (void)xb;
#define GSYNC1 do { XcdBarrier b_; b_.bar = (unsigned*)(p.ws + WS_BAR); b_.x = xb_xcc_id(); \
                    b_.st = (volatile LAS unsigned*)(sm + SMEM_SHORTS); xcd_barrier(b_); } while (0)
#ifdef PROBE_SYNC
#define GSYNC do { GSYNC1; GSYNC1; } while (0)
#else
#define GSYNC GSYNC1
#endif
#ifdef PROBE_PRE
  phase_s0(launder(p), sm);
  GSYNC;
  phase_s1(launder(p));
  wconv_phase(p, 0, sm);
  GSYNC;
  phase_prenorm0(launder(p));
  GSYNC;
#endif

#ifndef PH
#define PH 0xffff
#endif
#if PH & 1
  phase_s0(launder(p), sm);
#endif
  GSYNC;
#if PH & 2
  phase_s1(launder(p));
  wconv_phase(p, 0, sm);
#endif
  GSYNC;
#if PH & 4
  phase_prenorm0(launder(p));
#endif
  GSYNC;
  for (int l = 0; l < 2; l++) {
#if PH & 8
#ifdef PROBE_INPROJ
    phase_inproj(launder(p), l, sm, s_item_p, 6 + l);
    GSYNC;
#endif
    phase_inproj(launder(p), l, sm, s_item_p, l);
#endif
    GSYNC;
#if PH & 16
    phase_rowpost(launder(p), l);
#endif
    GSYNC;
#if PH & 32
#ifdef PROBE_MLAUP
    phase_mla_up(launder(p), l, sm);
    GSYNC;
#endif
    phase_mla_up(launder(p), l, sm);
#endif
    GSYNC;
#if PH & 64
#ifdef PROBE_MIX
    { int dry = 1; asm volatile("" : "+s"(dry)); phase_mixers(launder(p), l, sm, s_item_p, dry); }
    GSYNC;
#endif
    { int dry = 0; asm volatile("" : "+s"(dry)); phase_mixers(launder(p), l, sm, s_item_p, dry); }
#endif
    GSYNC;
#if PH & 128
    phase_gla_out(launder(p), l);
#endif
    GSYNC;
#if PH & 256
#ifdef PROBE_MERGE
    phase_merge(launder(p), sm);
    GSYNC;
#endif
    phase_merge(launder(p), sm);
#endif
    GSYNC;
#if PH & 512
#ifdef PROBE_MERGE
    phase_outproj(launder(p), sm);
    GSYNC;
#endif
    phase_outproj(launder(p), sm);
#endif
    GSYNC;
#if PH & 1024
    phase_post(launder(p), l);
    if (l == 0) wconv_phase(p, 1, sm);
#endif
    if (l == 0) GSYNC;
  }
}

extern "C" void kernel_launch(void* const* d_in, const int* in_sizes, int n_in, void* d_out, int out_size, void* d_ws,
                              size_t ws_size, hipStream_t stream) {
  static int grid_blocks = 0;
  if (!grid_blocks) {
    int dev = 0, cus = 0, per_cu = 0;
    hipGetDevice(&dev);
    hipDeviceGetAttribute(&cus, hipDeviceAttributeMultiprocessorCount, dev);
    hipOccupancyMaxActiveBlocksPerMultiprocessor(&per_cu, fwd_megakernel, 256, 0);
    if (per_cu > 2) per_cu = 2;
    if (per_cu < 1) per_cu = 1;
    grid_blocks = cus * per_cu;
  }
  Params p{};
  for (int i = 0; i < 30; i++) p.in[i] = (const float*)d_in[i];
  p.out = (float*)d_out;
  p.ws = (unsigned char*)d_ws;
  hipMemsetAsync(d_ws, 0, 20480, stream);
  void* args[] = {&p};
  hipError_t e = hipLaunchCooperativeKernel((void*)fwd_megakernel, dim3(grid_blocks), dim3(256), args, 0, stream);
  if (e != hipSuccess) fprintf(stderr, "cooperative launch failed: %s (grid %d)\n", hipGetErrorString(e), grid_blocks);
}
```

```cpp
#include <hip/hip_runtime.h>
#include <hip/hip_cooperative_groups.h>
#include <cstdio>
namespace cg = cooperative_groups;

typedef unsigned short bfr;
typedef __attribute__((ext_vector_type(8))) short bf16x8;
typedef __attribute__((ext_vector_type(4))) float f32x4;
typedef __attribute__((ext_vector_type(4))) unsigned u32x4;
typedef __attribute__((ext_vector_type(2))) unsigned u32x2;

#define NROWS 12288
#define NCTX 4096
#define ZLD 6976
#define LDT 72
#define SMEM_SHORTS (4 * 128 * LDT)

#define C_QA 0
#define C_KA 512
#define C_VA 640
#define C_GA 768
#define C_QG 1280
#define C_KG 1536
#define C_VG 1792
#define C_GG 2304
#define C_RF 2816
#define C_RB 2832
#define C_QL 2848
#define C_KV 3104
#define C_KR 3360
#define C_GC 3392
#define C_M1 3904
#define C_M2 4928
#define C_M3 5952

#define WS_BAR 0ul
#define WS_CTR 16384ul
#define WS_MODP 20480ul
#define WS_MOD (WS_MODP + 589824ul)
#define WS_ROPE (WS_MOD + 73728ul)
#define WS_WIN (WS_ROPE + 16384ul)
#define WS_WUQ (WS_WIN + 14417920ul)
#define WS_WUKV (WS_WUQ + 196608ul)
#define WS_WOA (WS_WUKV + 393216ul)
#define WS_WOB (WS_WOA + 1048576ul)
#define WS_WOC (WS_WOB + 1048576ul)
#define WS_WOUT (WS_WOC + 1048576ul)
#define WS_KCA (WS_WOUT + 2097152ul)
#define WS_CKVC (WS_KCA + 262144ul)
#define WS_KRC (WS_CKVC + 524288ul)
#define WS_VTA (WS_KRC + 65536ul)
#define WS_CQ (WS_VTA + 3407872ul)
#define WS_KNOPE (WS_CQ + 9437184ul)
#define WS_VTC (WS_KNOPE + 6815744ul)
#define WS_R1 (WS_VTC + 13631488ul)
#define WS_Z (WS_R1 + 25165824ul)
#define WS_END (WS_Z + 171442176ul)

#define O_Y 0
#define O_GK 12582912
#define O_GV 13631488
#define O_CKV 14680064
#define O_KR 16777216
#define O_SF 17039360
#define O_SB 18087936

struct Params {
  const float* in[30];
  float* out;
  unsigned char* ws;
};

__device__ __forceinline__ int tidx() {
  int t = threadIdx.x;
  asm volatile("" : "+v"(t));
  return t;
}
__device__ __forceinline__ Params launder(const Params& p) {
  Params q;
  long zo = 0;
  asm volatile("" : "+s"(zo));
#pragma unroll
  for (int i = 0; i < 30; i++) q.in[i] = p.in[i] + zo;
  q.out = p.out + zo;
  q.ws = p.ws + zo;
  return q;
}
__device__ __forceinline__ float bf2f(bfr b) { return __uint_as_float(((unsigned)b) << 16); }
typedef float f32x2_t __attribute__((ext_vector_type(2)));
typedef __bf16 bf16x2_t __attribute__((ext_vector_type(2)));
__device__ __forceinline__ bfr f2bf(float f) {
  __bf16 r = (__bf16)f;
  return *(bfr*)&r;
}
__device__ __forceinline__ unsigned pack2(float a, float b) {
  f32x2_t v = {a, b};
  bf16x2_t r = __builtin_convertvector(v, bf16x2_t);
  return *(unsigned*)&r;
}
__device__ __forceinline__ float lo16(unsigned u) { return __uint_as_float(u << 16); }
__device__ __forceinline__ float hi16(unsigned u) { return __uint_as_float(u & 0xffff0000u); }
__device__ __forceinline__ float siluf(float x) { return x / (1.f + __expf(-x)); }
__device__ __forceinline__ float sigmf(float x) { return 1.f / (1.f + __expf(-x)); }
__device__ __forceinline__ f32x4 mfma16(bf16x8 a, bf16x8 b, f32x4 c) {
  return __builtin_amdgcn_mfma_f32_16x16x32_bf16(a, b, c, 0, 0, 0);
}
__device__ __forceinline__ const float* xrow(const Params& p, int row) {
  return row < NCTX ? p.in[0] + (long)row * 1024 : p.in[1] + (long)(row - NCTX) * 1024;
}
__device__ __forceinline__ int row_cond(int row) { return row < NCTX ? 0 : 1 + ((row - NCTX) >> 12); }
__device__ __forceinline__ float wave_sum(float v) {
  v += __shfl_xor(v, 1); v += __shfl_xor(v, 2); v += __shfl_xor(v, 4);
  v += __shfl_xor(v, 8); v += __shfl_xor(v, 16); v += __shfl_xor(v, 32);
  return v;
}

#define XB_TMO      128
#define XB_XCNT(j)  (256  + 64 * (j))
#define XB_XSUB(j)  (1280 + 64 * (j))
#define XB_XGEN(j)  (2304 + 64 * (j))
#define XB_TOP      3328
#define XB_TOPGEN   3392
#define XCD_BAR_WORDS 3456
#define XB_SPIN_CAP (1u << 18)
#define LAS __attribute__((address_space(3)))

__device__ __forceinline__ unsigned xb_ld(unsigned* p)              { return __hip_atomic_load(p, __ATOMIC_RELAXED, __HIP_MEMORY_SCOPE_AGENT); }
__device__ __forceinline__ unsigned xb_add(unsigned* p, unsigned v) { return __hip_atomic_fetch_add(p, v, __ATOMIC_RELAXED, __HIP_MEMORY_SCOPE_AGENT); }
__device__ __forceinline__ unsigned xb_xcc_id() { return (unsigned)__builtin_amdgcn_s_getreg((3 << 11) | 20) & 0xFu; }
#define XB_SPIN(cond, bar) do { unsigned _sp = 0; while (cond) { __builtin_amdgcn_s_sleep(1); \
    if ((++_sp & 255u) == 0u) { if (xb_ld(&(bar)[XB_TMO])) break; if (_sp > XB_SPIN_CAP) { atomicAdd(&(bar)[XB_TMO], 1u); break; } } } } while (0)

struct XcdBarrier {
    unsigned* bar; unsigned x;
    volatile LAS unsigned* st;
};

__device__ __forceinline__ XcdBarrier xcd_barrier_post(unsigned* bar, volatile LAS unsigned* st) {
    XcdBarrier b; b.bar = bar; b.x = xb_xcc_id(); b.st = st;
    if (threadIdx.x == 0) (void)xb_add(&bar[XB_XCNT(b.x)], 1u);
    return b;
}
__device__ __forceinline__ void xcd_barrier_complete(unsigned* bar, unsigned x, unsigned& nloc, unsigned& nx) {
    const unsigned G = gridDim.x * gridDim.y * gridDim.z;
    unsigned sum, cnt, mine, sp = 0u;
    for (;;) {
        sum = 0u; cnt = 0u; mine = 0u;
#pragma unroll
        for (unsigned j = 0; j < 16; ++j) { const unsigned c = xb_ld(&bar[XB_XCNT(j)]); sum += c; cnt += (c > 0u) ? 1u : 0u; mine = (j == x) ? c : mine; }
        if (sum == G) break;
        __builtin_amdgcn_s_sleep(1);
        if ((++sp & 255u) == 0u) { if (xb_ld(&bar[XB_TMO])) break; if (sp > XB_SPIN_CAP) { atomicAdd(&bar[XB_TMO], 1u); break; } }
    }
    nloc = mine > 0u ? mine : 1u; nx = cnt > 0u ? cnt : 1u;
}

__device__ __forceinline__ void xcd_barrier(const XcdBarrier& b) {
    asm volatile("s_waitcnt vmcnt(0)" ::: "memory");
    __syncthreads();
    if (threadIdx.x == 0) {
        unsigned* bar = b.bar;
        __builtin_amdgcn_s_waitcnt(0);
        unsigned nloc = b.st[0], nx = b.st[1];
        if (nloc == 0u) { xcd_barrier_complete(bar, b.x, nloc, nx); b.st[0] = nloc; b.st[1] = nx; }
        const unsigned old = xb_add(&bar[XB_XSUB(b.x)], 1u);
        const unsigned gen = old / nloc;
        if (old + 1u == (gen + 1u) * nloc) {
            __builtin_amdgcn_fence(__ATOMIC_RELEASE, "agent");
            asm volatile("s_waitcnt vmcnt(0)" ::: "memory");
            const unsigned og = xb_add(&bar[XB_TOP], 1u);
            const unsigned tg = og / nx;
            if (og + 1u == (tg + 1u) * nx) xb_add(&bar[XB_TOPGEN], 1u);
            else XB_SPIN(xb_ld(&bar[XB_TOPGEN]) == tg, bar);
            __builtin_amdgcn_fence(__ATOMIC_ACQUIRE, "agent");
            xb_add(&bar[XB_XGEN(b.x)], 1u);
            asm volatile("s_waitcnt vmcnt(0)" ::: "memory");
        } else {
            XB_SPIN(xb_ld(&bar[XB_XGEN(b.x)]) == gen, bar);
            __builtin_amdgcn_fence(__ATOMIC_ACQUIRE, "agent");
            asm volatile("s_waitcnt vmcnt(0)" ::: "memory");
        }
    }
    __syncthreads();
}


#define TIDX tidx()
#define LDS3 __attribute__((address_space(3)))
__device__ __forceinline__ void glds16(const bfr* g, bfr* l) {
  __builtin_amdgcn_global_load_lds((const unsigned*)g, (LDS3 unsigned*)l, 16, 0, 0);
}
__device__ __forceinline__ void gemm128(const bfr* __restrict__ P, long ldp, int pmax,
                                        const bfr* __restrict__ Q, long ldq, int qmax, int K,
                                        f32x4 (&acc)[4][4], bfr* sm) {
  const int tid = TIDX, lane = tid & 63, wid = tid >> 6;
  const int wr = wid >> 1, wc = wid & 1;
  const int l15 = lane & 15, g = lane >> 4;
  const bfr* pp[2];
  const bfr* qp[2];
  {
    const int r0 = tid >> 2;
    const int c = (tid & 3) ^ ((tid >> 4) & 3);
#pragma unroll
    for (int i = 0; i < 2; i++) {
      int r = r0 + 64 * i;
      pp[i] = P + (long)min(r, pmax - 1) * ldp + c * 8;
      qp[i] = Q + (long)min(r, qmax - 1) * ldq + c * 8;
    }
  }
  const int nk = K >> 5;
#define GEMM_ISSUE(T)                                                    \
  do {                                                                   \
    bfr* nb_ = sm + ((T) & 3) * 8192;                                    \
    glds16(pp[0] + (T) * 32, nb_ + tid * 8);                             \
    glds16(pp[1] + (T) * 32, nb_ + 2048 + tid * 8);                      \
    glds16(qp[0] + (T) * 32, nb_ + 4096 + tid * 8);                      \
    glds16(qp[1] + (T) * 32, nb_ + 6144 + tid * 8);                      \
  } while (0)
  GEMM_ISSUE(0);
  GEMM_ISSUE(1);
  GEMM_ISSUE(2);
  const int pos = (g ^ ((l15 >> 2) & 3)) * 8;
  for (int kt = 0; kt < nk; kt++) {
    if (kt + 2 < nk) asm volatile("s_waitcnt vmcnt(8)" ::: "memory");
    else if (kt + 1 < nk) asm volatile("s_waitcnt vmcnt(4)" ::: "memory");
    else asm volatile("s_waitcnt vmcnt(0)" ::: "memory");
    __builtin_amdgcn_s_barrier();
    if (kt + 3 < nk) GEMM_ISSUE(kt + 3);
    const bfr* Ps = sm + (kt & 3) * 8192;
    const bfr* Qs = Ps + 4096;
    bf16x8 pf[4], qf[4];
#pragma unroll
    for (int m = 0; m < 4; m++) {
      pf[m] = *(const bf16x8*)(Ps + (wr * 64 + m * 16 + l15) * 32 + pos);
      qf[m] = *(const bf16x8*)(Qs + (wc * 64 + m * 16 + l15) * 32 + pos);
    }
#pragma unroll
    for (int m = 0; m < 4; m++)
#pragma unroll
      for (int n = 0; n < 4; n++) acc[m][n] = mfma16(pf[m], qf[n], acc[m][n]);
  }
#undef GEMM_ISSUE
  __syncthreads();
}

template <int NQ>
__device__ __forceinline__ void gemm128q(const bfr* __restrict__ P, long ldp, const bfr* __restrict__ Q, long ldq, int K,
                                         f32x4 (&acc)[4][NQ], bfr* sm) {
  constexpr int QI = NQ / 2;
  constexpr int STG = 4096 + QI * 2048;
  const int tid = TIDX, lane = tid & 63, wid = tid >> 6;
  const int wr = wid >> 1, wc = wid & 1;
  const int l15 = lane & 15, g = lane >> 4;
  const bfr* pp[2];
  const bfr* qp[QI];
  {
    const int r0 = tid >> 2;
    const int c = (tid & 3) ^ (((tid >> 5) & 1) * 3);
#pragma unroll
    for (int i = 0; i < 2; i++) pp[i] = P + (long)(r0 + 64 * i) * ldp + c * 8;
#pragma unroll
    for (int i = 0; i < QI; i++) qp[i] = Q + (long)(r0 + 64 * i) * ldq + c * 8;
  }
  const int nk = K >> 5;
  auto issue = [&](int T) {
    bfr* nb_ = sm + (T & 3) * STG;
    glds16(pp[0] + T * 32, nb_ + tid * 8);
    glds16(pp[1] + T * 32, nb_ + 2048 + tid * 8);
#pragma unroll
    for (int i = 0; i < QI; i++) glds16(qp[i] + T * 32, nb_ + 4096 + i * 2048 + tid * 8);
  };
  issue(0);
  issue(1);
  issue(2);
  const int pos = (g ^ (((l15 >> 3) & 1) * 3)) * 8;
  for (int kt = 0; kt < nk; kt++) {
    if (kt + 2 < nk) {
      if (QI == 2) asm volatile("s_waitcnt vmcnt(8)" ::: "memory"); else asm volatile("s_waitcnt vmcnt(6)" ::: "memory");
    } else if (kt + 1 < nk) {
      if (QI == 2) asm volatile("s_waitcnt vmcnt(4)" ::: "memory"); else asm volatile("s_waitcnt vmcnt(3)" ::: "memory");
    } else {
      asm volatile("s_waitcnt vmcnt(0)" ::: "memory");
    }
    __builtin_amdgcn_s_barrier();
    if (kt + 3 < nk) issue(kt + 3);
    const bfr* Ps = sm + (kt & 3) * STG;
    const bfr* Qs = Ps + 4096;
    bf16x8 pf[4], qf[NQ];
#pragma unroll
    for (int m = 0; m < 4; m++) pf[m] = *(const bf16x8*)(Ps + (wr * 64 + m * 16 + l15) * 32 + pos);
#pragma unroll
    for (int n = 0; n < NQ; n++) qf[n] = *(const bf16x8*)(Qs + (wc * 16 * NQ + n * 16 + l15) * 32 + pos);
#pragma unroll
    for (int m = 0; m < 4; m++)
#pragma unroll
      for (int n = 0; n < NQ; n++) acc[m][n] = mfma16(pf[m], qf[n], acc[m][n]);
  }
  __syncthreads();
}

template <int NQ>
__device__ __forceinline__ void gemm256x128(const bfr* __restrict__ P, long ldp, int pmax,
                                            const bfr* __restrict__ Q, long ldq, int K,
                                            f32x4 (&acc)[8][NQ], bfr* sm) {
  constexpr int QI = NQ / 2;
  constexpr int STG = 8192 + QI * 2048;
  const int tid = TIDX, lane = tid & 63, wid = tid >> 6;
  const int wr = wid >> 1, wc = wid & 1;
  const int l15 = lane & 15, g = lane >> 4;
  const bfr* pp[4];
  const bfr* qp[QI];
  {
    const int r0 = tid >> 2;
    const int c = (tid & 3) ^ (((tid >> 5) & 1) * 3);
#pragma unroll
    for (int i = 0; i < 4; i++) pp[i] = P + (long)min(r0 + 64 * i, pmax - 1) * ldp + c * 8;
#pragma unroll
    for (int i = 0; i < QI; i++) qp[i] = Q + (long)(r0 + 64 * i) * ldq + c * 8;
  }
  const int nk = K >> 5;
  auto issue = [&](int T, int stg) {
    bfr* nb_ = sm + stg * STG;
    glds16(pp[0] + T * 32, nb_ + tid * 8);
    glds16(pp[1] + T * 32, nb_ + 2048 + tid * 8);
    glds16(pp[2] + T * 32, nb_ + 4096 + tid * 8);
    glds16(pp[3] + T * 32, nb_ + 6144 + tid * 8);
#pragma unroll
    for (int i = 0; i < QI; i++) glds16(qp[i] + T * 32, nb_ + 8192 + i * 2048 + tid * 8);
  };
  issue(0, 0);
  issue(1, 1);
  const int pos = (g ^ (((l15 >> 3) & 1) * 3)) * 8;
  int st = 0;
  for (int kt = 0; kt < nk; kt++) {
    if (kt + 1 < nk) {
      if (QI == 2) asm volatile("s_waitcnt vmcnt(6)" ::: "memory"); else asm volatile("s_waitcnt vmcnt(5)" ::: "memory");
    } else {
      asm volatile("s_waitcnt vmcnt(0)" ::: "memory");
    }
    __builtin_amdgcn_s_barrier();
    if (kt + 2 < nk) issue(kt + 2, st == 0 ? 2 : st - 1);
    const bfr* Ps = sm + st * STG;
    const bfr* Qs = Ps + 8192;
    st = (st == 2) ? 0 : st + 1;
    bf16x8 qf[NQ], pf[8];
#pragma unroll
    for (int n = 0; n < NQ; n++) qf[n] = *(const bf16x8*)(Qs + (wc * 16 * NQ + n * 16 + l15) * 32 + pos);
#pragma unroll
    for (int m = 0; m < 8; m++) pf[m] = *(const bf16x8*)(Ps + (wr * 128 + m * 16 + l15) * 32 + pos);
#pragma unroll
    for (int m = 0; m < 8; m++)
#pragma unroll
      for (int n = 0; n < NQ; n++) acc[m][n] = mfma16(pf[m], qf[n], acc[m][n]);
    __builtin_amdgcn_sched_group_barrier(0x100, NQ + 2, 0);
#pragma unroll
    for (int i = 0; i < 6; i++) {
      __builtin_amdgcn_sched_group_barrier(0x008, NQ, 0);
      __builtin_amdgcn_sched_group_barrier(0x100, 1, 0);
    }
    __builtin_amdgcn_sched_group_barrier(0x008, 2 * NQ, 0);
  }
  __syncthreads();
}

template <int NQ, bool PIPE, bool TAIL = false>
__device__ __forceinline__ void gemm128k64(const bfr* __restrict__ P, long ldp, int pmax,
                                           const bfr* __restrict__ Q, long ldq, int K,
                                           f32x4 (&acc)[4][NQ], bfr* sm, const bfr* tail_src = nullptr, long tail_ld = 0) {
  constexpr int STG = 8192 + 2048 * NQ;
  const int tid = TIDX, lane = tid & 63, wid = tid >> 6;
  const int wr = wid >> 1, wc = wid & 1;
  const int l15 = lane & 15, g = lane >> 4;
  const bfr* pp[4];
  const bfr* qp[NQ];
  {
    const int r0 = tid >> 3;
    const int c = (tid & 7) ^ ((tid >> 4) & 7);
#pragma unroll
    for (int i = 0; i < 4; i++) pp[i] = P + (long)min(r0 + 32 * i, pmax - 1) * ldp + c * 8;
#pragma unroll
    for (int i = 0; i < NQ; i++) qp[i] = Q + (long)(r0 + 32 * i) * ldq + c * 8;
  }
  const int nk = K >> 6;
#pragma unroll
  for (int i = 0; i < 4; i++) glds16(pp[i], sm + i * 2048 + tid * 8);
#pragma unroll
  for (int i = 0; i < NQ; i++) glds16(qp[i], sm + 8192 + i * 2048 + tid * 8);
  const int swz = l15 >> 1;
  for (int kt = 0; kt < nk; kt++) {
    asm volatile("s_waitcnt vmcnt(0)" ::: "memory");
    __builtin_amdgcn_s_barrier();
    if (kt + 1 < nk) {
      bfr* nb = sm + ((kt + 1) & 1) * STG;
#pragma unroll
      for (int i = 0; i < 4; i++) glds16(pp[i] + (kt + 1) * 64, nb + i * 2048 + tid * 8);
#pragma unroll
      for (int i = 0; i < NQ; i++) glds16(qp[i] + (kt + 1) * 64, nb + 8192 + i * 2048 + tid * 8);
    } else if (TAIL) {
      bfr* nb = sm + ((kt + 1) & 1) * STG;
      const bfr* ts = tail_src + (long)(tid >> 4) * tail_ld + (((tid & 15) ^ ((tid >> 4) & 15)) * 8);
#pragma unroll
      for (int i = 0; i < 2 * NQ; i++) glds16(ts + (long)(16 * i) * tail_ld, nb + i * 2048 + tid * 8);
    }
    const bfr* Ps = sm + (kt & 1) * STG;
    const bfr* Qs = Ps + 8192;
    if (PIPE) {
      bf16x8 pf[2][4], qf[2][NQ];
#pragma unroll
      for (int kk = 0; kk < 2; kk++) {
        const int pos = ((kk * 4 + g) ^ swz) * 8;
#pragma unroll
        for (int m = 0; m < 4; m++) pf[kk][m] = *(const bf16x8*)(Ps + (wr * 64 + m * 16 + l15) * 64 + pos);
#pragma unroll
        for (int n = 0; n < NQ; n++) qf[kk][n] = *(const bf16x8*)(Qs + (wc * 16 * NQ + n * 16 + l15) * 64 + pos);
      }
#pragma unroll
      for (int kk = 0; kk < 2; kk++)
#pragma unroll
        for (int m = 0; m < 4; m++)
#pragma unroll
          for (int n = 0; n < NQ; n++) acc[m][n] = mfma16(pf[kk][m], qf[kk][n], acc[m][n]);
      __builtin_amdgcn_sched_group_barrier(0x100, 4 + NQ, 0);
#pragma unroll
      for (int i = 0; i < 4 + NQ; i++) {
        __builtin_amdgcn_sched_group_barrier(0x008, NQ == 4 ? 2 : 1, 0);
        __builtin_amdgcn_sched_group_barrier(0x100, 1, 0);
      }
      __builtin_amdgcn_sched_group_barrier(0x008, NQ == 4 ? 16 : 10, 0);
    } else {
#pragma unroll
      for (int kk = 0; kk < 2; kk++) {
        bf16x8 pf[4], qf[NQ];
        const int pos = ((kk * 4 + g) ^ swz) * 8;
#pragma unroll
        for (int m = 0; m < 4; m++) pf[m] = *(const bf16x8*)(Ps + (wr * 64 + m * 16 + l15) * 64 + pos);
#pragma unroll
        for (int n = 0; n < NQ; n++) qf[n] = *(const bf16x8*)(Qs + (wc * 16 * NQ + n * 16 + l15) * 64 + pos);
#pragma unroll
        for (int m = 0; m < 4; m++)
#pragma unroll
          for (int n = 0; n < NQ; n++) acc[m][n] = mfma16(pf[m], qf[n], acc[m][n]);
      }
    }
  }
  if (TAIL) asm volatile("s_waitcnt vmcnt(0)" ::: "memory");
  __syncthreads();
}

__device__ __forceinline__ void gemm160x128(const bfr* __restrict__ P, long ldp, int pmax,
                                            const bfr* __restrict__ Q, long ldq, int K,
                                            f32x4 (&acc)[5][4], bfr* sm) {
  constexpr int STG = 160 * 64 + 128 * 64;
  const int tid = TIDX, lane = tid & 63, wid = tid >> 6;
  const int wr = wid >> 1, wc = wid & 1;
  const int l15 = lane & 15, g = lane >> 4;
  const bfr* pp[5];
  const bfr* qp[4];
  {
    const int r0 = tid >> 3;
    const int c = (tid & 7) ^ ((tid >> 4) & 7);
#pragma unroll
    for (int i = 0; i < 5; i++) pp[i] = P + (long)min(r0 + 32 * i, pmax - 1) * ldp + c * 8;
#pragma unroll
    for (int i = 0; i < 4; i++) qp[i] = Q + (long)(r0 + 32 * i) * ldq + c * 8;
  }
  const int nk = K >> 6;
#pragma unroll
  for (int i = 0; i < 5; i++) glds16(pp[i], sm + i * 2048 + tid * 8);
#pragma unroll
  for (int i = 0; i < 4; i++) glds16(qp[i], sm + 10240 + i * 2048 + tid * 8);
  const int swz = l15 >> 1;
  for (int kt = 0; kt < nk; kt++) {
    asm volatile("s_waitcnt vmcnt(0)" ::: "memory");
    __builtin_amdgcn_s_barrier();
    if (kt + 1 < nk) {
      bfr* nb = sm + ((kt + 1) & 1) * STG;
#pragma unroll
      for (int i = 0; i < 5; i++) glds16(pp[i] + (kt + 1) * 64, nb + i * 2048 + tid * 8);
#pragma unroll
      for (int i = 0; i < 4; i++) glds16(qp[i] + (kt + 1) * 64, nb + 10240 + i * 2048 + tid * 8);
    }
    const bfr* Ps = sm + (kt & 1) * STG;
    const bfr* Qs = Ps + 10240;
    bf16x8 pf[2][5], qf[2][4];
#pragma unroll
    for (int kk = 0; kk < 2; kk++) {
      const int pos = ((kk * 4 + g) ^ swz) * 8;
#pragma unroll
      for (int m = 0; m < 5; m++) pf[kk][m] = *(const bf16x8*)(Ps + (wr * 80 + m * 16 + l15) * 64 + pos);
#pragma unroll
      for (int n = 0; n < 4; n++) qf[kk][n] = *(const bf16x8*)(Qs + (wc * 64 + n * 16 + l15) * 64 + pos);
    }
#pragma unroll
    for (int kk = 0; kk < 2; kk++)
#pragma unroll
      for (int m = 0; m < 5; m++)
#pragma unroll
        for (int n = 0; n < 4; n++) acc[m][n] = mfma16(pf[kk][m], qf[kk][n], acc[m][n]);
    __builtin_amdgcn_sched_group_barrier(0x100, 9, 0);
#pragma unroll
    for (int i = 0; i < 9; i++) {
      __builtin_amdgcn_sched_group_barrier(0x008, 2, 0);
      __builtin_amdgcn_sched_group_barrier(0x100, 1, 0);
    }
    __builtin_amdgcn_sched_group_barrier(0x008, 22, 0);
  }
  __syncthreads();
}

__device__ __forceinline__ void phase_s0(const Params& p, bfr* sm) {
  const int tid = TIDX;
  float* rope = (float*)(p.ws + WS_ROPE);
  for (int idx = blockIdx.x * 256 + tid; idx < 1536; idx += gridDim.x * 256) {
    if (idx < 1024) {
      int pos = idx >> 4, i = idx & 15;
      float fr = powf(10000.f, -(float)i / 16.f);
      float a = (float)pos * fr;
      rope[idx] = cosf(a);
      rope[1024 + idx] = sinf(a);
    } else {
      int j = idx - 1024;
      int pos = j >> 3, i = j & 7;
      float fr = powf(10000.f, -(float)i / 8.f);
      float a = (float)pos * fr;
      rope[2048 + j] = cosf(a);
      rope[2560 + j] = sinf(a);
    }
  }
  float* smf = (float*)sm;
  float* modp = (float*)(p.ws + WS_MODP);
  for (int it = blockIdx.x; it < 768; it += gridDim.x) {
    int l = it / 384, rem = it % 384, cgp = rem >> 3, ks = rem & 7;
    int col = cgp * 64 + (tid & 63), kq = tid >> 6;
    const float* w = p.in[10] + (long)l * 1024 * 3072 + col;
    float a0 = 0.f, a1 = 0.f, a2 = 0.f;
    int k0 = ks * 128 + kq * 32;
#pragma unroll 8
    for (int k = k0; k < k0 + 32; k++) {
      float wv = w[(long)k * 3072];
      a0 += siluf(p.in[9][k]) * wv;
      a1 += siluf(p.in[8][k]) * wv;
      a2 += siluf(p.in[8][1024 + k]) * wv;
    }
    smf[(kq * 3 + 0) * 64 + (tid & 63)] = a0;
    smf[(kq * 3 + 1) * 64 + (tid & 63)] = a1;
    smf[(kq * 3 + 2) * 64 + (tid & 63)] = a2;
    __syncthreads();
    if (tid < 192) {
      int c = tid >> 6, cc = tid & 63;
      float s = smf[(0 * 3 + c) * 64 + cc] + smf[(1 * 3 + c) * 64 + cc] + smf[(2 * 3 + c) * 64 + cc] + smf[(3 * 3 + c) * 64 + cc];
      modp[((ks * 2 + l) * 3 + c) * 3072 + cgp * 64 + cc] = s;
    }
    __syncthreads();
  }
}

__device__ __forceinline__ void phase_s1(const Params& p) {
  float* modp = (float*)(p.ws + WS_MODP);
  float* mod = (float*)(p.ws + WS_MOD);
  for (int idx = blockIdx.x * 256 + TIDX; idx < 2 * 3 * 3072; idx += gridDim.x * 256) {
    int l = idx / 9216, n = idx % 3072;
    float s = p.in[11][l * 3072 + n];
#pragma unroll
    for (int ks = 0; ks < 8; ks++) s += modp[ks * 18432 + idx];
    mod[idx] = s;
  }
}

#define WCONV_ITEMS 2456
struct WcItem { const float* src; bfr* dst; int K, N, tk, tn; };
__device__ __forceinline__ WcItem wconv_decode(const Params& p, int l, int item) {
  WcItem w;
  if (item < 1744) {
    w.src = p.in[14] + (long)l * 1024 * 6976; w.K = 1024; w.N = 6976; w.dst = (bfr*)(p.ws + WS_WIN); w.tk = item & 15; w.tn = item >> 4;
  } else if (item < 1768) {
    item -= 1744;
    w.src = p.in[24] + (long)l * 256 * 384; w.K = 256; w.N = 384; w.dst = (bfr*)(p.ws + WS_WUQ); w.tk = item & 3; w.tn = item >> 2;
  } else if (item < 1816) {
    item -= 1768;
    w.src = p.in[25] + (long)l * 256 * 768; w.K = 256; w.N = 768; w.dst = (bfr*)(p.ws + WS_WUKV); w.tk = item & 3; w.tn = item >> 2;
  } else if (item < 2200) {
    item -= 1816;
    int ww = item >> 7, it = item & 127;
    w.src = (ww == 0 ? p.in[26] : (ww == 1 ? p.in[27] : p.in[28])) + (long)l * 512 * 1024;
    w.K = 512; w.N = 1024; w.dst = (bfr*)(p.ws + WS_WOA + (unsigned long)ww * 1048576ul); w.tk = it & 7; w.tn = it >> 3;
  } else {
    item -= 2200;
    w.src = p.in[29] + (long)l * 1024 * 1024; w.K = 1024; w.N = 1024; w.dst = (bfr*)(p.ws + WS_WOUT); w.tk = item & 15; w.tn = item >> 4;
  }
  return w;
}
__device__ __forceinline__ void wconv_phase(const Params& p, int l, bfr* sm) {
  bfr* sT = sm;
  const int tid = TIDX;
  const int n4 = (tid & 15) * 4, k0 = (tid >> 4) * 4;
  float4 v[4];
  int item = blockIdx.x;
  if (item < WCONV_ITEMS) {
    WcItem w = wconv_decode(p, l, item);
#pragma unroll
    for (int i = 0; i < 4; i++) v[i] = *(const float4*)(w.src + (long)(w.tk * 64 + k0 + i) * w.N + w.tn * 64 + n4);
  }
  const int wcol = (((k0 >> 3) ^ ((n4 >> 2) & 7)) * 8) + (k0 & 4);
  for (; item < WCONV_ITEMS; item += gridDim.x) {
    WcItem w = wconv_decode(p, l, item);
    {
      u32x2 o;
      o.x = pack2(v[0].x, v[1].x); o.y = pack2(v[2].x, v[3].x);
      *(u32x2*)(sT + (n4 + 0) * 64 + wcol) = o;
      o.x = pack2(v[0].y, v[1].y); o.y = pack2(v[2].y, v[3].y);
      *(u32x2*)(sT + (n4 + 1) * 64 + wcol) = o;
      o.x = pack2(v[0].z, v[1].z); o.y = pack2(v[2].z, v[3].z);
      *(u32x2*)(sT + (n4 + 2) * 64 + wcol) = o;
      o.x = pack2(v[0].w, v[1].w); o.y = pack2(v[2].w, v[3].w);
      *(u32x2*)(sT + (n4 + 3) * 64 + wcol) = o;
    }
    const int nitem = item + gridDim.x;
    if (nitem < WCONV_ITEMS) {
      WcItem wn = wconv_decode(p, l, nitem);
#pragma unroll
      for (int i = 0; i < 4; i++) v[i] = *(const float4*)(wn.src + (long)(wn.tk * 64 + k0 + i) * wn.N + wn.tn * 64 + n4);
    }
    __syncthreads();
#pragma unroll
    for (int i = 0; i < 2; i++) {
      int c = tid + 256 * i;
      int n = c >> 3, kc = c & 7;
      *(u32x4*)(w.dst + (long)(w.tn * 64 + n) * w.K + w.tk * 64 + kc * 8) = *(const u32x4*)(sT + n * 64 + ((kc ^ ((n >> 2) & 7)) * 8));
    }
    __syncthreads();
  }
}

__device__ __forceinline__ void phase_prenorm0(const Params& p) {
  const int lane = TIDX & 63;
  const float* mod = (const float*)(p.ws + WS_MOD);
  bfr* H = (bfr*)(p.ws + WS_R1);
  for (int row = blockIdx.x * 4 + (TIDX >> 6); row < NROWS; row += gridDim.x * 4) {
    const float* x = xrow(p, row);
    const float* md = mod + (0 * 3 + row_cond(row)) * 3072;
    float4 v[4];
    float ss = 0.f;
#pragma unroll
    for (int i = 0; i < 4; i++) {
      v[i] = *(const float4*)(x + i * 256 + lane * 4);
      ss += v[i].x * v[i].x + v[i].y * v[i].y + v[i].z * v[i].z + v[i].w * v[i].w;
    }
    ss = wave_sum(ss);
    float rs = rsqrtf(ss * (1.f / 1024.f) + 1e-6f);
#pragma unroll
    for (int i = 0; i < 4; i++) {
      int n = i * 256 + lane * 4;
      float4 g = *(const float4*)(p.in[12] + n);
      float4 sh = *(const float4*)(md + n);
      float4 sc = *(const float4*)(md + 1024 + n);
      float h0 = v[i].x * rs * g.x * (1.f + sc.x) + sh.x;
      float h1 = v[i].y * rs * g.y * (1.f + sc.y) + sh.y;
      float h2 = v[i].z * rs * g.z * (1.f + sc.z) + sh.z;
      float h3 = v[i].w * rs * g.w * (1.f + sc.w) + sh.w;
      u32x2 o;
      o.x = pack2(h0, h1);
      o.y = pack2(h2, h3);
      *(u32x2*)(H + (long)row * 1024 + n) = o;
    }
  }
}

__device__ __forceinline__ unsigned xcc_id() { return (unsigned)__builtin_amdgcn_s_getreg((3 << 11) | 20) & 7u; }
template <class CountF>
__device__ __forceinline__ int xq_take(unsigned* ctr, int& q, int& tried, unsigned first, CountF cnt) {
  unsigned j = first;
  for (;;) {
    if (j < (unsigned)cnt(q)) return (q << 20) | (int)j;
    q = (q + 1) & 7;
    if (++tried >= 8) return -1;
    j = atomicAdd(ctr + q * 16, 1u);
  }
}

__device__ __forceinline__ void phase_inproj(const Params& p, int l, bfr* sm, int* s_item, int slot) {
  const bfr* H = (const bfr*)(p.ws + WS_R1);
  const bfr* W = (const bfr*)(p.ws + WS_WIN);
  bfr* Z = (bfr*)(p.ws + WS_Z);
  const int tid = TIDX;
  const int lane = tid & 63, wid = tid >> 6, wr = wid >> 1, wc = wid & 1;
  unsigned* ctr = (unsigned*)(p.ws + WS_CTR) + slot * 128;
  auto cnt = [](int q) { return 96 * ((44 * (q + 1)) / 8 - (44 * q) / 8); };
  int q = (int)xcc_id(), tried = 0;
  unsigned nxt = 0;
  if (tid == 0) nxt = atomicAdd(ctr + q * 16, 1u);
  for (;;) {
    if (tid == 0) *s_item = xq_take(ctr, q, tried, nxt, cnt);
    __syncthreads();
    const int it = *s_item;
    __syncthreads();
    if (it < 0) break;
    const int qq = it >> 20, j = it & 0xfffff;
    if (tid == 0) nxt = atomicAdd(ctr + q * 16, 1u);
    const int tn0 = (44 * qq) / 8, w = (44 * (qq + 1)) / 8 - tn0;
    const int tm = j / w, tn = tn0 + j % w;
    f32x4 acc[5][4];
#pragma unroll
    for (int a = 0; a < 5; a++)
#pragma unroll
      for (int b = 0; b < 4; b++) acc[a][b] = (f32x4){0.f, 0.f, 0.f, 0.f};
    gemm160x128(W + (long)tn * 160 * 1024, 1024, ZLD - tn * 160, H + (long)tm * 128 * 1024, 1024, 1024, acc, sm);
    {
      const int g = lane >> 4, l15 = lane & 15;
#pragma unroll
      for (int pi = 0; pi < 5; pi++)
#pragma unroll
        for (int qi = 0; qi < 4; qi++) {
          u32x2 o;
          o.x = pack2(acc[pi][qi][0], acc[pi][qi][1]);
          o.y = pack2(acc[pi][qi][2], acc[pi][qi][3]);
          *(u32x2*)(sm + (wc * 64 + qi * 16 + l15) * 168 + wr * 80 + pi * 16 + g * 4) = o;
        }
      __syncthreads();
      const int ncol = min(20, (ZLD - tn * 160) >> 3);
#pragma unroll
      for (int i = 0; i < 10; i++) {
        int c = tid + 256 * i;
        int row = c / 20, c16 = c % 20;
        if (c16 < ncol)
          *(u32x4*)(Z + (long)(tm * 128 + row) * ZLD + tn * 160 + c16 * 8) = *(const u32x4*)(sm + row * 168 + c16 * 8);
      }
      __syncthreads();
    }
  }
}

__device__ __forceinline__ void unpack8(u32x4 v, float* x) {
  x[0] = lo16(v.x); x[1] = hi16(v.x); x[2] = lo16(v.y); x[3] = hi16(v.y);
  x[4] = lo16(v.z); x[5] = hi16(v.z); x[6] = lo16(v.w); x[7] = hi16(v.w);
}
__device__ __forceinline__ u32x4 pack8(const float* y) {
  u32x4 o;
  o.x = pack2(y[0], y[1]); o.y = pack2(y[2], y[3]); o.z = pack2(y[4], y[5]); o.w = pack2(y[6], y[7]);
  return o;
}

__device__ __forceinline__ void phase_rowpost(const Params& p, int l) {
  const int lane = TIDX & 63;
  bfr* Z = (bfr*)(p.ws + WS_Z);
  const float* rope = (const float*)(p.ws + WS_ROPE);
  bfr* VTA = (bfr*)(p.ws + WS_VTA);
  bfr* KCA = (bfr*)(p.ws + WS_KCA);
  bfr* CKVC = (bfr*)(p.ws + WS_CKVC);
  bfr* KRC = (bfr*)(p.ws + WS_KRC);
  float* out = p.out;
  for (int row = blockIdx.x * 4 + (TIDX >> 6); row < NROWS + 1024; row += gridDim.x * 4) {
    if (row < NROWS) {
      const bool lat = row >= NCTX;
      const int bc = row >> 8, tc = row & 255;
      const int bl = (row - NCTX) >> 12, tl = (row - NCTX) & 4095;
      const int prow = tl >> 6, pcol = tl & 63;
      bfr* z = Z + (long)row * ZLD;
      {
        float x[8];
        unpack8(*(const u32x4*)(z + C_QA + lane * 8), x);
        float ss = 0.f;
#pragma unroll
        for (int e = 0; e < 8; e++) ss += x[e] * x[e];
        ss += __shfl_xor(ss, 1); ss += __shfl_xor(ss, 2); ss += __shfl_xor(ss, 4);
        float rs = rsqrtf(ss * (1.f / 64.f) + 1e-6f);
        int sub = lane & 7;
        const float* g = p.in[15] + l * 64 + sub * 8;
#pragma unroll
        for (int e = 0; e < 8; e++) x[e] = x[e] * rs * g[e];
        if (lat) {
          int pos = (sub >> 2) ? pcol : prow;
          bool hi = (sub & 2) != 0;
          int i0 = (sub & 1) * 8;
#pragma unroll
          for (int e = 0; e < 8; e++) {
            float yp = __shfl_xor(x[e], 2);
            float c = rope[pos * 16 + i0 + e], s = rope[1024 + pos * 16 + i0 + e];
            x[e] = hi ? (yp * s + x[e] * c) : (x[e] * c - yp * s);
          }
        }
        const float qs = 0.125f * 1.4426950408889634f;
#pragma unroll
        for (int e = 0; e < 8; e++) x[e] *= qs;
        *(u32x4*)(z + C_QA + lane * 8) = pack8(x);
      }
      {
        int L = lane & 15;
        float x[8];
        unpack8(*(const u32x4*)(z + C_KA + L * 8), x);
        float ss = 0.f;
#pragma unroll
        for (int e = 0; e < 8; e++) ss += x[e] * x[e];
        ss += __shfl_xor(ss, 1); ss += __shfl_xor(ss, 2); ss += __shfl_xor(ss, 4);
        float rs = rsqrtf(ss * (1.f / 64.f) + 1e-6f);
        int sub = L & 7;
        const float* g = p.in[16] + l * 64 + sub * 8;
#pragma unroll
        for (int e = 0; e < 8; e++) x[e] = x[e] * rs * g[e];
        if (lat) {
          int pos = (sub >> 2) ? pcol : prow;
          bool hi = (sub & 2) != 0;
          int i0 = (sub & 1) * 8;
#pragma unroll
          for (int e = 0; e < 8; e++) {
            float yp = __shfl_xor(x[e], 2);
            float c = rope[pos * 16 + i0 + e], s = rope[1024 + pos * 16 + i0 + e];
            x[e] = hi ? (yp * s + x[e] * c) : (x[e] * c - yp * s);
          }
        } else if (lane < 16) {
          float* o = out + O_GK + ((long)(bc * 2 + l) * 256 + tc) * 128 + L * 8;
          *(float4*)(o) = make_float4(x[0], x[1], x[2], x[3]);
          *(float4*)(o + 4) = make_float4(x[4], x[5], x[6], x[7]);
        }
        if (lane < 16) *(u32x4*)(z + C_KA + L * 8) = pack8(x);
      }
      if (lane < 16) {
        int L = lane;
        u32x4 raw = *(const u32x4*)(z + C_VA + L * 8);
        float x[8];
        unpack8(raw, x);
        if (!lat) {
          float* o = out + O_GV + ((long)(bc * 2 + l) * 256 + tc) * 128 + L * 8;
          *(float4*)(o) = make_float4(x[0], x[1], x[2], x[3]);
          *(float4*)(o + 4) = make_float4(x[4], x[5], x[6], x[7]);
        }
        int g = L >> 3, d0 = (L & 7) * 8;
        long base; int nk, key;
        if (!lat) { base = (long)bc * 32768; nk = 256; key = tc; }
        else { base = 16l * 32768 + (long)bl * (2 * 64 * 4608); nk = 4608; key = 512 + tl; }
        const bfr* rb = (const bfr*)&raw;
#pragma unroll
        for (int e = 0; e < 8; e++) VTA[base + (long)(g * 64 + d0 + e) * nk + key] = rb[e];
      }
      {
        u32x2 rq = *(const u32x2*)(z + C_QL + lane * 4);
        u32x2 rk = *(const u32x2*)(z + C_KV + lane * 4);
        float q[4] = {lo16(rq.x), hi16(rq.x), lo16(rq.y), hi16(rq.y)};
        float k[4] = {lo16(rk.x), hi16(rk.x), lo16(rk.y), hi16(rk.y)};
        float sq = q[0] * q[0] + q[1] * q[1] + q[2] * q[2] + q[3] * q[3];
        float sk = k[0] * k[0] + k[1] * k[1] + k[2] * k[2] + k[3] * k[3];
        sq = wave_sum(sq);
        sk = wave_sum(sk);
        float rq_ = rsqrtf(sq * (1.f / 256.f) + 1e-6f), rk_ = rsqrtf(sk * (1.f / 256.f) + 1e-6f);
        float4 gq = *(const float4*)(p.in[22] + l * 256 + lane * 4);
        float4 gk = *(const float4*)(p.in[23] + l * 256 + lane * 4);
        q[0] *= rq_ * gq.x; q[1] *= rq_ * gq.y; q[2] *= rq_ * gq.z; q[3] *= rq_ * gq.w;
        k[0] *= rk_ * gk.x; k[1] *= rk_ * gk.y; k[2] *= rk_ * gk.z; k[3] *= rk_ * gk.w;
        u32x2 o;
        o.x = pack2(q[0], q[1]); o.y = pack2(q[2], q[3]);
        *(u32x2*)(z + C_QL + lane * 4) = o;
        o.x = pack2(k[0], k[1]); o.y = pack2(k[2], k[3]);
        *(u32x2*)(z + C_KV + lane * 4) = o;
        if (!lat) *(float4*)(out + O_CKV + ((long)(bc * 2 + l) * 256 + tc) * 256 + lane * 4) = make_float4(k[0], k[1], k[2], k[3]);
      }
      {
        int L = lane & 3;
        float x[8];
        unpack8(*(const u32x4*)(z + C_KR + L * 8), x);
        if (lat) {
          int pos = (L >> 1) ? pcol : prow;
          bool hi = (L & 1) != 0;
#pragma unroll
          for (int e = 0; e < 8; e++) {
            float yp = __shfl_xor(x[e], 1);
            float c = rope[2048 + pos * 8 + e], s = rope[2560 + pos * 8 + e];
            x[e] = hi ? (yp * s + x[e] * c) : (x[e] * c - yp * s);
          }
          if (lane < 4) *(u32x4*)(z + C_KR + L * 8) = pack8(x);
        } else if (lane < 4) {
          float* o = out + O_KR + ((long)(bc * 2 + l) * 256 + tc) * 32 + L * 8;
          *(float4*)(o) = make_float4(x[0], x[1], x[2], x[3]);
          *(float4*)(o + 4) = make_float4(x[4], x[5], x[6], x[7]);
        }
      }
    } else {
      int cr = row - NROWS;
      int b = cr >> 9, t = cr & 511;
      long src = (long)(b * 2 + l) * 512 + t;
      {
        float2 kv = *(const float2*)(p.in[2] + src * 128 + lane * 2);
        *(unsigned*)(KCA + (long)(b * 512 + t) * 128 + lane * 2) = pack2(kv.x, kv.y);
        float2 vv = *(const float2*)(p.in[3] + src * 128 + lane * 2);
        int c0 = lane * 2;
        long base = 16l * 32768 + (long)b * (2 * 64 * 4608);
        VTA[base + (long)c0 * 4608 + t] = f2bf(vv.x);
        VTA[base + (long)(c0 + 1) * 4608 + t] = f2bf(vv.y);
        float4 cv = *(const float4*)(p.in[4] + src * 256 + lane * 4);
        u32x2 o;
        o.x = pack2(cv.x, cv.y); o.y = pack2(cv.z, cv.w);
        *(u32x2*)(CKVC + (long)(b * 512 + t) * 256 + lane * 4) = o;
        if (lane < 32) KRC[(long)(b * 512 + t) * 32 + lane] = f2bf(p.in[5][src * 32 + lane]);
      }
    }
  }
}

#define WS_PREP1 251703296ul
#define WS_EL (WS_WIN + 12582912ul)
__device__ __forceinline__ bfr* prep_base(const Params& p, int b, int h, int dir, int c) {
  return (bfr*)(p.ws + (b ? WS_PREP1 : WS_WIN)) + (long)((h * 2 + dir) * 64 + c) * 12288;
}

__device__ __forceinline__ void gla_chunk_prep(int tid, const float (&wd)[16], float bias, const bfr* Qr, const bfr* Kr,
                                               bfr* Qe, bfr* Ke, bfr* KlT, const float* RF, float* tot, float* lastv) {
  const int ch = tid & 63, part = tid >> 6;
  float cum[16];
  {
    float run = 0.f;
#pragma unroll
    for (int ii = 0; ii < 16; ii++) {
      int i = part * 16 + ii;
      float x = bias;
#pragma unroll
      for (int r = 0; r < 16; r++) x += RF[i * 16 + r] * wd[r];
      float la = (fminf(x, 0.f) - __logf(1.f + __expf(-fabsf(x)))) * (1.f / 16.f);
      run += la;
      cum[ii] = run;
    }
    tot[part * 64 + ch] = run;
  }
  __syncthreads();
  {
    float off = 0.f, last = 0.f;
#pragma unroll
    for (int pp = 0; pp < 4; pp++) {
      float tv = tot[pp * 64 + ch];
      if (pp < part) off += tv;
      last += tv;
    }
    if (part == 0) lastv[ch] = last;
#pragma unroll
    for (int ii = 0; ii < 16; ii++) {
      int i = part * 16 + ii;
      float cc = cum[ii] + off;
      float qv = bf2f(Qr[i * LDT + ch]), kv = bf2f(Kr[i * LDT + ch]);
      Qe[i * LDT + ch] = f2bf(qv * __expf(cc) * 0.125f);
      Ke[i * LDT + ch] = f2bf(kv * __expf(-cc));
      KlT[ch * LDT + i] = f2bf(kv * __expf(last - cc));
    }
  }
  __syncthreads();
}

__device__ __forceinline__ void gla_att(int wid, int g, int l15, const bfr* Qe, const bfr* Ke, bfr* Att) {
  f32x4 att[4];
  bf16x8 qa[2];
#pragma unroll
  for (int kk = 0; kk < 2; kk++) qa[kk] = *(const bf16x8*)(Qe + (16 * wid + l15) * LDT + kk * 32 + g * 8);
#pragma unroll
  for (int nj = 0; nj < 4; nj++) {
    att[nj] = (f32x4){0.f, 0.f, 0.f, 0.f};
#pragma unroll
    for (int kk = 0; kk < 2; kk++) {
      bf16x8 kb = *(const bf16x8*)(Ke + (16 * nj + l15) * LDT + kk * 32 + g * 8);
      att[nj] = mfma16(qa[kk], kb, att[nj]);
    }
  }
#pragma unroll
  for (int nj = 0; nj < 4; nj++)
#pragma unroll
    for (int r = 0; r < 4; r++) {
      int i = 16 * wid + 4 * g + r, j = 16 * nj + l15;
      Att[i * LDT + j] = f2bf(i >= j ? att[nj][r] : 0.f);
    }
}

__device__ __forceinline__ void gla_prep_item(const Params& p, int l, int b, int h, int dir, int c, bfr* sm) {
  const int tid = TIDX, lane = tid & 63, wid = tid >> 6, g = lane >> 4, l15 = lane & 15;
  const bfr* Z = (const bfr*)(p.ws + WS_Z);
  const int N = 4096;
  const int rowbase = NCTX + b * 4096;
  bfr* Qr = sm;
  bfr* Kr = Qr + 64 * LDT;
  bfr* Qe = Kr + 64 * LDT;
  bfr* Ke = Qe + 64 * LDT;
  bfr* KlT = Ke + 64 * LDT;
  float* RF = (float*)(KlT + 64 * LDT);
  float* tot = RF + 64 * 16;
  float* lastv = tot + 256;
  bfr* Att = Qr;
  const int ch = tid & 63;
  float wd[16];
  {
    const float* W = (dir ? p.in[19] : p.in[17]) + (long)l * 16 * 256 + h * 64 + ch;
#pragma unroll
    for (int r = 0; r < 16; r++) wd[r] = W[r * 256];
  }
  const float bias = (dir ? p.in[20] : p.in[18])[l * 256 + h * 64 + ch];
#pragma unroll
  for (int ii = 0; ii < 2; ii++) {
    int cc = tid + 256 * ii;
    int i = cc >> 3, c8 = cc & 7;
    int tok = dir ? (N - 1 - (c * 64 + i)) : (c * 64 + i);
    const bfr* zr = Z + (long)(rowbase + tok) * ZLD;
    *(u32x4*)(Qr + i * LDT + c8 * 8) = *(const u32x4*)(zr + C_QG + h * 64 + c8 * 8);
    *(u32x4*)(Kr + i * LDT + c8 * 8) = *(const u32x4*)(zr + C_KG + h * 64 + c8 * 8);
  }
  if (tid < 128) {
    int i = tid >> 1, hf = tid & 1;
    int tok = dir ? (N - 1 - (c * 64 + i)) : (c * 64 + i);
    u32x4 rr = *(const u32x4*)(Z + (long)(rowbase + tok) * ZLD + (dir ? C_RB : C_RF) + hf * 8);
    float x[8];
    unpack8(rr, x);
#pragma unroll
    for (int e = 0; e < 8; e++) RF[i * 16 + hf * 8 + e] = x[e];
  }
  __syncthreads();
  gla_chunk_prep(tid, wd, bias, Qr, Kr, Qe, Ke, KlT, RF, tot, lastv);
  gla_att(wid, g, l15, Qe, Ke, Att);
  __syncthreads();
  bfr* dst = prep_base(p, b, h, dir, c);
#pragma unroll
  for (int ii = 0; ii < 2; ii++) {
    int cc = tid + 256 * ii;
    int i = cc >> 3, c8 = cc & 7;
    *(u32x4*)(dst + i * 64 + c8 * 8) = *(const u32x4*)(Qe + i * LDT + c8 * 8);
    *(u32x4*)(dst + 4096 + i * 64 + c8 * 8) = *(const u32x4*)(KlT + i * LDT + c8 * 8);
    *(u32x4*)(dst + 8192 + i * 64 + c8 * 8) = *(const u32x4*)(Att + i * LDT + c8 * 8);
  }
  if (tid < 64) ((float*)(p.ws + WS_EL))[((long)(((b * 4 + h) * 2 + dir) * 64 + c)) * 64 + tid] = __expf(lastv[tid]);
  __syncthreads();
}

__device__ __forceinline__ void gla_chain_item(const Params& p, int l, int b, int h, int dir, int vh, bfr* sm) {
  const int tid = TIDX, lane = tid & 63, wid = tid >> 6, g = lane >> 4, l15 = lane & 15;
  const bfr* Z = (const bfr*)(p.ws + WS_Z);
  bfr* OG = (bfr*)(p.ws + WS_R1) + (long)dir * NROWS * 512;
  const float* EL = (const float*)(p.ws + WS_EL) + (long)(((b * 4 + h) * 2 + dir) * 64) * 64;
  const int N = 4096, nc = 64;
  const int rowbase = NCTX + b * 4096;
  const int vs0 = vh * 64;
  bfr* Vt = sm;
  bfr* St = Vt + 64 * LDT;
  f32x4 st[4];
  {
    const float* S0 = (dir ? p.in[7] : p.in[6]) + ((long)((b * 2 + l) * 4 + h)) * 8192 + (long)(16 * wid + l15) * 128 + vs0;
#pragma unroll
    for (int vt = 0; vt < 4; vt++) {
      float4 a = *(const float4*)(S0 + 16 * vt + 4 * g);
      st[vt] = (f32x4){a.x, a.y, a.z, a.w};
#pragma unroll
      for (int r = 0; r < 4; r++) St[(16 * vt + 4 * g + r) * LDT + 16 * wid + l15] = f2bf(st[vt][r]);
    }
  }
  u32x4 n_qe[2], n_kl[2], n_at[2], n_v[2];
  float n_el;
  auto prefetch = [&](int c) {
    const bfr* base = prep_base(p, b, h, dir, c) + (16 * wid + l15) * 64 + 8 * g;
#pragma unroll
    for (int kk = 0; kk < 2; kk++) {
      n_qe[kk] = *(const u32x4*)(base + kk * 32);
      n_kl[kk] = *(const u32x4*)(base + 4096 + kk * 32);
      n_at[kk] = *(const u32x4*)(base + 8192 + kk * 32);
    }
    n_el = EL[c * 64 + 16 * wid + l15];
#pragma unroll
    for (int ii = 0; ii < 2; ii++) {
      int cc = tid + 256 * ii;
      int i = cc >> 3, c8 = cc & 7;
      int tok = dir ? (N - 1 - (c * 64 + i)) : (c * 64 + i);
      n_v[ii] = *(const u32x4*)(Z + (long)(rowbase + tok) * ZLD + C_VG + h * 128 + vs0 + c8 * 8);
    }
  };
  prefetch(0);
  for (int c = 0; c < nc; c++) {
    u32x4 c_qe[2] = {n_qe[0], n_qe[1]}, c_kl[2] = {n_kl[0], n_kl[1]}, c_at[2] = {n_at[0], n_at[1]};
    const float el = n_el;
#pragma unroll
    for (int ii = 0; ii < 2; ii++) {
      int cc = tid + 256 * ii;
      int i = cc >> 3, c8 = cc & 7;
      const bfr* rb = (const bfr*)&n_v[ii];
#pragma unroll
      for (int e = 0; e < 8; e++) Vt[(c8 * 8 + e) * LDT + i] = rb[e];
    }
    __syncthreads();
    if (c + 1 < nc) prefetch(c + 1);
    f32x4 stn[4];
    const int i = 16 * wid + l15;
    const int tok = dir ? (N - 1 - (c * 64 + i)) : (c * 64 + i);
    bfr* og = OG + (long)(rowbase + tok) * 512 + h * 128 + vs0 + 4 * g;
#pragma unroll
    for (int vt = 0; vt < 4; vt++) {
      f32x4 oc = (f32x4){0.f, 0.f, 0.f, 0.f};
      stn[vt] = st[vt] * el;
#pragma unroll
      for (int kk = 0; kk < 2; kk++) {
        bf16x8 vf = *(const bf16x8*)(Vt + (16 * vt + l15) * LDT + kk * 32 + g * 8);
        bf16x8 sf = *(const bf16x8*)(St + (16 * vt + l15) * LDT + kk * 32 + g * 8);
        oc = mfma16(vf, *(bf16x8*)&c_at[kk], oc);
        oc = mfma16(sf, *(bf16x8*)&c_qe[kk], oc);
        stn[vt] = mfma16(vf, *(bf16x8*)&c_kl[kk], stn[vt]);
      }
      u32x2 ov;
      ov.x = pack2(oc[0], oc[1]);
      ov.y = pack2(oc[2], oc[3]);
      *(u32x2*)(og + 16 * vt) = ov;
    }
    __syncthreads();
#pragma unroll
    for (int vt = 0; vt < 4; vt++) {
      st[vt] = stn[vt];
#pragma unroll
      for (int r = 0; r < 4; r++) St[(16 * vt + 4 * g + r) * LDT + 16 * wid + l15] = f2bf(st[vt][r]);
    }
  }
  __syncthreads();
}

template <int VS>
__device__ __forceinline__ void gla_item(const Params& p, int l, int seq, int h, int dir, int vsl, bfr* sm) {
  constexpr int NVT = VS / 16;
  constexpr int NVL = VS / 32;
  const int tid = TIDX, lane = tid & 63, wid = tid >> 6, g = lane >> 4, l15 = lane & 15;
  bfr* Z = (bfr*)(p.ws + WS_Z);
  bfr* OG = (bfr*)(p.ws + WS_R1) + (long)dir * NROWS * 512;
  const bool lat = seq >= 16;
  const int b = seq - 16;
  const int N = lat ? 4096 : 256;
  const int rowbase = lat ? NCTX + b * 4096 : seq * 256;
  const int nc = N >> 6;
  const int vs0 = vsl * VS;
  bfr* Qr = sm;
  bfr* Kr = Qr + 64 * LDT;
  bfr* Qe = Kr + 64 * LDT;
  bfr* Ke = Qe + 64 * LDT;
  bfr* KlT = Ke + 64 * LDT;
  float* RF = (float*)(KlT + 64 * LDT);
  float* tot = RF + 64 * 16;
  float* lastv = tot + 256;
  bfr* Vt = (bfr*)(lastv + 64);
  bfr* St = Vt + VS * LDT;
  bfr* Att = Qr;
  const int ch = tid & 63;
  float wd[16];
  {
    const float* W = (dir ? p.in[19] : p.in[17]) + (long)l * 16 * 256 + h * 64 + ch;
#pragma unroll
    for (int r = 0; r < 16; r++) wd[r] = W[r * 256];
  }
  const float bias = (dir ? p.in[20] : p.in[18])[l * 256 + h * 64 + ch];

  f32x4 st[NVT];
  {
    const float* S0 = (dir ? p.in[7] : p.in[6]) + ((long)((b * 2 + l) * 4 + h)) * 8192 + (long)(16 * wid + l15) * 128 + vs0;
#pragma unroll
    for (int mv = 0; mv < NVT; mv++) {
      if (lat) {
        float4 a = *(const float4*)(S0 + 16 * mv + 4 * g);
        st[mv] = (f32x4){a.x, a.y, a.z, a.w};
      } else {
        st[mv] = (f32x4){0.f, 0.f, 0.f, 0.f};
      }
#pragma unroll
      for (int r = 0; r < 4; r++) St[(16 * mv + 4 * g + r) * LDT + 16 * wid + l15] = f2bf(st[mv][r]);
    }
  }
  u32x4 rq[2], rk[2], rv[NVL], rr;
  auto prefetch = [&](int c) {
#pragma unroll
    for (int ii = 0; ii < 2; ii++) {
      int cc = tid + 256 * ii;
      int i = cc >> 3, c8 = cc & 7;
      int tok = dir ? (N - 1 - (c * 64 + i)) : (c * 64 + i);
      const bfr* zr = Z + (long)(rowbase + tok) * ZLD;
      rq[ii] = *(const u32x4*)(zr + C_QG + h * 64 + c8 * 8);
      rk[ii] = *(const u32x4*)(zr + C_KG + h * 64 + c8 * 8);
    }
#pragma unroll
    for (int ii = 0; ii < NVL; ii++) {
      int cc = tid + 256 * ii;
      int i = cc / (VS / 8), c4 = cc % (VS / 8);
      int tok = dir ? (N - 1 - (c * 64 + i)) : (c * 64 + i);
      rv[ii] = *(const u32x4*)(Z + (long)(rowbase + tok) * ZLD + C_VG + h * 128 + vs0 + c4 * 8);
    }
    if (tid < 128) {
      int i = tid >> 1, hf = tid & 1;
      int tok = dir ? (N - 1 - (c * 64 + i)) : (c * 64 + i);
      rr = *(const u32x4*)(Z + (long)(rowbase + tok) * ZLD + (dir ? C_RB : C_RF) + hf * 8);
    }
  };
  prefetch(0);
  for (int c = 0; c < nc; c++) {
#pragma unroll
    for (int ii = 0; ii < 2; ii++) {
      int cc = tid + 256 * ii;
      *(u32x4*)(Qr + (cc >> 3) * LDT + (cc & 7) * 8) = rq[ii];
      *(u32x4*)(Kr + (cc >> 3) * LDT + (cc & 7) * 8) = rk[ii];
    }
#pragma unroll
    for (int ii = 0; ii < NVL; ii++) {
      int cc = tid + 256 * ii;
      int i = cc / (VS / 8), c4 = cc % (VS / 8);
      const bfr* rb = (const bfr*)&rv[ii];
#pragma unroll
      for (int e = 0; e < 8; e++) Vt[(c4 * 8 + e) * LDT + i] = rb[e];
    }
    if (tid < 128) {
      int i = tid >> 1, hf = tid & 1;
      float x[8];
      unpack8(rr, x);
#pragma unroll
      for (int e = 0; e < 8; e++) RF[i * 16 + hf * 8 + e] = x[e];
    }
    __syncthreads();
    if (c + 1 < nc) prefetch(c + 1);
    gla_chunk_prep(tid, wd, bias, Qr, Kr, Qe, Ke, KlT, RF, tot, lastv);
    f32x4 stn[NVT];
    {
      float el = __expf(lastv[16 * wid + l15]);
#pragma unroll
      for (int mv = 0; mv < NVT; mv++) {
        stn[mv] = st[mv] * el;
#pragma unroll
        for (int kk = 0; kk < 2; kk++) {
          bf16x8 va = *(const bf16x8*)(Vt + (16 * mv + l15) * LDT + kk * 32 + g * 8);
          bf16x8 kb = *(const bf16x8*)(KlT + (16 * wid + l15) * LDT + kk * 32 + g * 8);
          stn[mv] = mfma16(va, kb, stn[mv]);
        }
      }
      gla_att(wid, g, l15, Qe, Ke, Att);
    }
    __syncthreads();
    {
      bf16x8 aa[2], qa[2];
#pragma unroll
      for (int kk = 0; kk < 2; kk++) {
        aa[kk] = *(const bf16x8*)(Att + (16 * wid + l15) * LDT + kk * 32 + g * 8);
        qa[kk] = *(const bf16x8*)(Qe + (16 * wid + l15) * LDT + kk * 32 + g * 8);
      }
#pragma unroll
      for (int nv = 0; nv < NVT; nv++) {
        f32x4 oc = (f32x4){0.f, 0.f, 0.f, 0.f};
#pragma unroll
        for (int kk = 0; kk < 2; kk++) {
          bf16x8 vb = *(const bf16x8*)(Vt + (16 * nv + l15) * LDT + kk * 32 + g * 8);
          oc = mfma16(aa[kk], vb, oc);
          bf16x8 sb = *(const bf16x8*)(St + (16 * nv + l15) * LDT + kk * 32 + g * 8);
          oc = mfma16(qa[kk], sb, oc);
        }
#pragma unroll
        for (int r = 0; r < 4; r++) {
          int i = 16 * wid + 4 * g + r;
          int tok = dir ? (N - 1 - (c * 64 + i)) : (c * 64 + i);
          OG[(long)(rowbase + tok) * 512 + h * 128 + vs0 + 16 * nv + l15] = f2bf(oc[r]);
        }
      }
    }
    __syncthreads();
#pragma unroll
    for (int mv = 0; mv < NVT; mv++) {
      st[mv] = stn[mv];
#pragma unroll
      for (int r = 0; r < 4; r++) St[(16 * mv + 4 * g + r) * LDT + 16 * wid + l15] = f2bf(st[mv][r]);
    }
  }
  __syncthreads();
  if (!lat) {
    float* so = p.out + (dir ? O_SB : O_SF) + ((long)((seq * 2 + l) * 4 + h)) * 8192 + (long)(16 * wid + l15) * 128 + vs0;
#pragma unroll
    for (int mv = 0; mv < NVT; mv++)
      *(float4*)(so + 16 * mv + 4 * g) = make_float4(st[mv][0], st[mv][1], st[mv][2], st[mv][3]);
  }
}

__device__ __forceinline__ void phase_mla_up(const Params& p, int l, bfr* sm) {
  bfr* Z = (bfr*)(p.ws + WS_Z);
  const float* rope = (const float*)(p.ws + WS_ROPE);
  const int lane = TIDX & 63, wid = TIDX >> 6, wr = wid >> 1, wc = wid & 1;
  const int g = lane >> 4;
  for (int t = blockIdx.x; t < 288 + 624 + 1024; t += gridDim.x) {
    if (t >= 912) {
      int i = t - 912;
      gla_prep_item(p, l, i >> 9, (i >> 7) & 3, (i >> 6) & 1, i & 63, sm);
      continue;
    }
    f32x4 acc[4][4];
#pragma unroll
    for (int a = 0; a < 4; a++)
#pragma unroll
      for (int b = 0; b < 4; b++) acc[a][b] = (f32x4){0.f, 0.f, 0.f, 0.f};
    if (t < 288) {
      int tn = t % 3, tm = t / 3;
      gemm128k64<4, true>((const bfr*)(p.ws + WS_WUQ) + (long)tn * 128 * 256, 256, 128, Z + (long)tm * 128 * ZLD + C_QL, ZLD, 256,
                    acc, sm);
      bfr* CQ = (bfr*)(p.ws + WS_CQ);
      const float qs = 0.10206207261596577f * 1.4426950408889634f;
#pragma unroll
      for (int pi = 0; pi < 4; pi++) {
        int nb = tn * 128 + wr * 64 + pi * 16;
        int wb = nb % 96;
        bool ropet = wb >= 64;
        int part = (wb - 64) >> 4;
#pragma unroll
        for (int qi = 0; qi < 4; qi++) {
          int tok = tm * 128 + wc * 64 + qi * 16 + (lane & 15);
          float y[4] = {acc[pi][qi][0], acc[pi][qi][1], acc[pi][qi][2], acc[pi][qi][3]};
          if (ropet) {
            bool lat = tok >= NCTX;
            int tl = (tok - NCTX) & 4095;
            int pos = part ? (tl & 63) : (tl >> 6);
            bool hi = (g & 2) != 0;
            int i0 = (g & 1) * 4;
#pragma unroll
            for (int r = 0; r < 4; r++) {
              float yp = __shfl_xor(y[r], 32);
              float c = rope[2048 + pos * 8 + i0 + r], s = rope[2560 + pos * 8 + i0 + r];
              float yr = hi ? (yp * s + y[r] * c) : (y[r] * c - yp * s);
              y[r] = lat ? yr : y[r];
            }
          }
          u32x2 o;
          o.x = pack2(y[0] * qs, y[1] * qs);
          o.y = pack2(y[2] * qs, y[3] * qs);
          *(u32x2*)(CQ + (long)tok * 384 + nb + g * 4) = o;
        }
      }
    } else {
      int t2 = t - 288;
      int tn = t2 % 6, tm = t2 / 6;
      const bfr* Q;
      long ldq;
      long kbase, vbase;
      int nk, key0;
      if (tm < 32) {
        Q = Z + (long)tm * 128 * ZLD + C_KV;
        ldq = ZLD;
        int s = tm >> 1;
        key0 = (tm & 1) * 128;
        nk = 256;
        kbase = (long)s * (4 * 256 * 64);
        vbase = (long)s * 131072;
      } else {
        int r = (tm - 32) * 128;
        int b = r / 4608, within = r % 4608;
        key0 = within;
        nk = 4608;
        kbase = 16l * (4 * 256 * 64) + (long)b * (4 * 4608 * 64);
        vbase = 16l * 131072 + (long)b * (4 * 128 * 4608);
        if (within < 512) {
          Q = (const bfr*)(p.ws + WS_CKVC) + (long)(b * 512 + within) * 256;
          ldq = 256;
        } else {
          Q = Z + (long)(NCTX + b * 4096 + within - 512) * ZLD + C_KV;
          ldq = ZLD;
        }
      }
      gemm128k64<4, true>((const bfr*)(p.ws + WS_WUKV) + (long)tn * 128 * 256, 256, 128, Q, ldq, 256, acc, sm);
      bfr* KN = (bfr*)(p.ws + WS_KNOPE);
      bfr* VTC = (bfr*)(p.ws + WS_VTC);
#pragma unroll
      for (int pi = 0; pi < 4; pi++) {
        int n0 = tn * 128 + wr * 64 + pi * 16 + g * 4;
        int head = n0 / 192, w = n0 % 192;
#pragma unroll
        for (int qi = 0; qi < 4; qi++) {
          int key = key0 + wc * 64 + qi * 16 + (lane & 15);
          if (w < 64) {
            u32x2 o;
            o.x = pack2(acc[pi][qi][0], acc[pi][qi][1]);
            o.y = pack2(acc[pi][qi][2], acc[pi][qi][3]);
            *(u32x2*)(KN + kbase + ((long)head * nk + key) * 64 + w) = o;
          } else {
#pragma unroll
            for (int r = 0; r < 4; r++)
              VTC[vbase + ((long)head * 128 + (w - 64) + r) * nk + key] = f2bf(acc[pi][qi][r]);
          }
        }
      }
    }
  }
}

template <int DQ, int DV, bool MLA, int NQB, bool DMA, int TP>
__device__ __forceinline__ void attn_item(const Params& p, int seq, int head, int qoff, bfr* sm, int dry) {
  constexpr int KLD = DQ + 8;
  constexpr int KSZ = DMA ? (MLA ? 6144 : 4096) : 64 * KLD;
  constexpr int VSZ = DMA ? DV * 64 : DV * LDT;
  constexpr int BUF = KSZ + VSZ;
  constexpr int NKK = DQ / 32;
  constexpr int NDV = DV / 16;
  constexpr int NVL = DV / 32;
  const int tid = TIDX, lane = tid & 63, wid = tid >> 6, g = lane >> 4, l15 = lane & 15;
  bfr* Z = (bfr*)(p.ws + WS_Z);
  const int sK = 2 * (l15 >> 2) + ((l15 >> 1) & 1), sR = ((l15 >> 3) & 1) * 2, sV = l15 >> 1;
  auto kaddr = [&](const bfr* Ks, int krow, int kk) -> const bfr* {
    if (DMA) return (kk < 2) ? (Ks + krow * 64 + (((kk * 4 + g) ^ sK) * 8)) : (Ks + 4096 + krow * 32 + ((g ^ sR) * 8));
    return Ks + krow * KLD + kk * 32 + g * 8;
  };
  auto vaddr = [&](const bfr* Vs, int d, int sx) -> const bfr* {
    if (DMA) return Vs + (d * 16 + l15) * 64 + (((sx * 4 + g) ^ sV) * 8);
    return Vs + (d * 16 + l15) * LDT + sx * 32 + g * 8;
  };
  const bool lat = seq >= 16;
  const int b = seq - 16;
  const int nk = lat ? 4608 : 256;
  const int rowbase = lat ? NCTX + b * 4096 : seq * 256;
  const int nkt = nk >> 6;

  bf16x8 qf[NQB][NKK];
#pragma unroll
  for (int qb = 0; qb < NQB; qb++) {
    int qrow = rowbase + qoff + wid * (16 * NQB) + qb * 16 + l15;
    const bfr* qp = MLA ? ((const bfr*)(p.ws + WS_CQ) + (long)qrow * 384 + head * 96) : (Z + (long)qrow * ZLD + C_QA + head * 64);
#pragma unroll
    for (int kk = 0; kk < NKK; kk++) qf[qb][kk] = *(const bf16x8*)(qp + kk * 32 + g * 8);
  }

  u32x4 rk[TP][2], rkr[TP], rv[TP][NVL];
  auto prefetch = [&](int pi) {
#pragma unroll
   for (int u = 0; u < TP; u++) {
    int k0 = (pi * TP + u) * 64;
    bool cache = lat && (k0 < 512);
    int tokrow0 = lat ? (NCTX + b * 4096 + k0 - 512) : (seq * 256 + k0);
    if (!MLA) {
      int kvh = head >> 2;
#pragma unroll
      for (int i = 0; i < 2; i++) {
        int c = tid + 256 * i;
        int kr_ = c >> 3, ch = c & 7;
        const bfr* src = cache ? ((const bfr*)(p.ws + WS_KCA) + (long)(b * 512 + k0 + kr_) * 128 + kvh * 64 + ch * 8)
                               : (Z + (long)(tokrow0 + kr_) * ZLD + C_KA + kvh * 64 + ch * 8);
        rk[u][i] = *(const u32x4*)src;
      }
      long vb = lat ? (16l * 32768 + (long)b * (2 * 64 * 4608)) : ((long)seq * 32768);
#pragma unroll
      for (int i = 0; i < NVL; i++) {
        int c = tid + 256 * i;
        int dv = c >> 3, ch = c & 7;
        rv[u][i] = *(const u32x4*)((const bfr*)(p.ws + WS_VTA) + vb + (long)(kvh * 64 + dv) * nk + k0 + ch * 8);
      }
    } else {
      long kb = lat ? (16l * (4 * 256 * 64) + (long)b * (4 * 4608 * 64)) : ((long)seq * (4 * 256 * 64));
#pragma unroll
      for (int i = 0; i < 2; i++) {
        int c = tid + 256 * i;
        int kr_ = c >> 3, ch = c & 7;
        rk[u][i] = *(const u32x4*)((const bfr*)(p.ws + WS_KNOPE) + kb + ((long)head * nk + k0 + kr_) * 64 + ch * 8);
      }
      {
        int kr_ = tid >> 2, ch = tid & 3;
        const bfr* src = cache ? ((const bfr*)(p.ws + WS_KRC) + (long)(b * 512 + k0 + kr_) * 32 + ch * 8)
                               : (Z + (long)(tokrow0 + kr_) * ZLD + C_KR + ch * 8);
        rkr[u] = *(const u32x4*)src;
      }
      long vb = lat ? (16l * 131072 + (long)b * (4 * 128 * 4608)) : ((long)seq * 131072);
#pragma unroll
      for (int i = 0; i < NVL; i++) {
        int c = tid + 256 * i;
        int dv = c >> 3, ch = c & 7;
        rv[u][i] = *(const u32x4*)((const bfr*)(p.ws + WS_VTC) + vb + (long)(head * 128 + dv) * nk + k0 + ch * 8);
      }
    }
   }
  };

  f32x4 o[NQB][NDV];
#pragma unroll
  for (int qb = 0; qb < NQB; qb++)
#pragma unroll
    for (int d = 0; d < NDV; d++) o[qb][d] = (f32x4){0.f, 0.f, 0.f, 0.f};
  float mrun[NQB];
  f32x4 lacc[NQB];
#pragma unroll
  for (int qb = 0; qb < NQB; qb++) { mrun[qb] = 0.f; lacc[qb] = (f32x4){0.f, 0.f, 0.f, 0.f}; }
  const bf16x8 ones = (bf16x8){(short)0x3F80, (short)0x3F80, (short)0x3F80, (short)0x3F80, (short)0x3F80, (short)0x3F80, (short)0x3F80, (short)0x3F80};

  auto dma_issue = [&](int pi, bfr* stg0) {
#pragma unroll
   for (int u = 0; u < TP; u++) {
    bfr* stg = stg0 + u * BUF;
    const int k0 = (pi * TP + u) * 64;
    const bool cache = lat && (k0 < 512);
    const int tokrow0 = lat ? (NCTX + b * 4096 + k0 - 512) : (seq * 256 + k0);
    const int cK = (tid & 7) ^ (((tid >> 6) & 3) * 2 + ((tid >> 4) & 1));
    const int cV = (tid & 7) ^ ((tid >> 4) & 7);
    if (MLA) {
      const long kb = lat ? (16l * (4 * 256 * 64) + (long)b * (4 * 4608 * 64)) : ((long)seq * (4 * 256 * 64));
      const long vb = lat ? (16l * 131072 + (long)b * (4 * 128 * 4608)) : ((long)seq * 131072);
#pragma unroll
      for (int i = 0; i < 2; i++)
        glds16((const bfr*)(p.ws + WS_KNOPE) + kb + ((long)head * nk + k0 + i * 32 + (tid >> 3)) * 64 + cK * 8, stg + i * 2048 + tid * 8);
      {
        const int row = tid >> 2, c = (tid & 3) ^ (((tid >> 6) & 1) * 2);
        const bfr* src = cache ? ((const bfr*)(p.ws + WS_KRC) + (long)(b * 512 + k0 + row) * 32 + c * 8)
                               : (Z + (long)(tokrow0 + row) * ZLD + C_KR + c * 8);
        glds16(src, stg + 4096 + tid * 8);
      }
#pragma unroll
      for (int i = 0; i < 4; i++)
        glds16((const bfr*)(p.ws + WS_VTC) + vb + (long)(head * 128 + i * 32 + (tid >> 3)) * nk + k0 + cV * 8, stg + 6144 + i * 2048 + tid * 8);
    } else {
      const int kvh = head >> 2;
      const long vb = lat ? (16l * 32768 + (long)b * (2 * 64 * 4608)) : ((long)seq * 32768);
#pragma unroll
      for (int i = 0; i < 2; i++) {
        const int row = i * 32 + (tid >> 3);
        const bfr* src = cache ? ((const bfr*)(p.ws + WS_KCA) + (long)(b * 512 + k0 + row) * 128 + kvh * 64 + cK * 8)
                               : (Z + (long)(tokrow0 + row) * ZLD + C_KA + kvh * 64 + cK * 8);
        glds16(src, stg + i * 2048 + tid * 8);
      }
#pragma unroll
      for (int i = 0; i < 2; i++)
        glds16((const bfr*)(p.ws + WS_VTA) + vb + (long)(kvh * 64 + i * 32 + (tid >> 3)) * nk + k0 + cV * 8, stg + 4096 + i * 2048 + tid * 8);
    }
   }
  };
  if (DMA) dma_issue(0, sm); else prefetch(0);
  const int np = nkt / TP;
  for (int pi = 0; pi < np; pi++) {
    bfr* base = sm + (pi & 1) * (TP * BUF);
    if (DMA) {
      asm volatile("s_waitcnt vmcnt(0)" ::: "memory");
      __syncthreads();
      if (pi + 1 < np) dma_issue(pi + 1, sm + ((pi + 1) & 1) * (TP * BUF));
    } else {
#pragma unroll
      for (int u = 0; u < TP; u++) {
        bfr* Ks = base + u * BUF;
        bfr* Vs = Ks + KSZ;
#pragma unroll
        for (int i = 0; i < 2; i++) {
          int c = tid + 256 * i;
          *(u32x4*)(Ks + (c >> 3) * KLD + (c & 7) * 8) = rk[u][i];
        }
        if (MLA) *(u32x4*)(Ks + (tid >> 2) * KLD + 64 + (tid & 3) * 8) = rkr[u];
#pragma unroll
        for (int i = 0; i < NVL; i++) {
          int c = tid + 256 * i;
          *(u32x4*)(Vs + (c >> 3) * LDT + (c & 7) * 8) = rv[u][i];
        }
      }
      __syncthreads();
      if (pi + 1 < np) prefetch(pi + 1);
    }
    f32x4 sa[TP][NQB][4];
#pragma unroll
   for (int u = 0; u < TP; u++) {
    const bfr* Ks = base + u * BUF;
    bf16x8 kfr[4][NKK];
#pragma unroll
    for (int t = 0; t < 2; t++) {
      int krow = 32 * (t >> 1) + 8 * (l15 >> 2) + 4 * (t & 1) + (l15 & 3);
#pragma unroll
      for (int kk = 0; kk < NKK; kk++) kfr[t][kk] = *(const bf16x8*)kaddr(Ks, krow, kk);
    }
#pragma unroll
    for (int t = 0; t < 4; t++) {
#pragma unroll
      for (int qb = 0; qb < NQB; qb++) sa[u][qb][t] = (f32x4){-mrun[qb], -mrun[qb], -mrun[qb], -mrun[qb]};
      if (t + 2 < 4) {
        int krow = 32 * ((t + 2) >> 1) + 8 * (l15 >> 2) + 4 * ((t + 2) & 1) + (l15 & 3);
#pragma unroll
        for (int kk = 0; kk < NKK; kk++) kfr[t + 2][kk] = *(const bf16x8*)kaddr(Ks, krow, kk);
      }
#pragma unroll
      for (int kk = 0; kk < NKK; kk++) {
#pragma unroll
        for (int qb = 0; qb < NQB; qb++) sa[u][qb][t] = mfma16(kfr[t][kk], qf[qb][kk], sa[u][qb][t]);
      }
    }
   }
#pragma unroll
   for (int u = 0; u < TP; u++) {
    const bfr* Vs = base + u * BUF + KSZ;
    const int kt = pi * TP + u;
    bf16x8 vfr[4][2];
#pragma unroll
    for (int d = 0; d < 4; d++)
#pragma unroll
      for (int sx = 0; sx < 2; sx++) vfr[d][sx] = *(const bf16x8*)vaddr(Vs, d, sx);
    bf16x8 pf[NQB][2];
#pragma unroll
    for (int qb = 0; qb < NQB; qb++) {
      float mt = sa[u][qb][0][0];
#pragma unroll
      for (int t = 0; t < 4; t++)
#pragma unroll
        for (int r = 0; r < 4; r++) mt = fmaxf(mt, sa[u][qb][t][r]);
      const bool first = (kt == 0);
      if (first || __builtin_amdgcn_ballot_w64(mt > 8.f) != 0ull) {
        mt = fmaxf(mt, __shfl_xor(mt, 16));
        mt = fmaxf(mt, __shfl_xor(mt, 32));
        const bool need = first || mt > 8.f;
        const float dm = need ? mt : 0.f;
        const float alpha = first ? 1.f : __builtin_amdgcn_exp2f(-dm);
        mrun[qb] += dm;
        lacc[qb] *= alpha;
#pragma unroll
        for (int d = 0; d < NDV; d++) o[qb][d] *= alpha;
#pragma unroll
        for (int u2 = 0; u2 < TP; u2++)
          if (u2 >= u) {
#pragma unroll
            for (int t = 0; t < 4; t++) sa[u2][qb][t] -= dm;
          }
      }
#pragma unroll
      for (int t = 0; t < 4; t++)
#pragma unroll
        for (int r = 0; r < 4; r++) sa[u][qb][t][r] = __builtin_amdgcn_exp2f(sa[u][qb][t][r]);
#pragma unroll
      for (int sx = 0; sx < 2; sx++) {
        u32x4 uu;
        uu.x = pack2(sa[u][qb][2 * sx][0], sa[u][qb][2 * sx][1]);
        uu.y = pack2(sa[u][qb][2 * sx][2], sa[u][qb][2 * sx][3]);
        uu.z = pack2(sa[u][qb][2 * sx + 1][0], sa[u][qb][2 * sx + 1][1]);
        uu.w = pack2(sa[u][qb][2 * sx + 1][2], sa[u][qb][2 * sx + 1][3]);
        pf[qb][sx] = *(bf16x8*)&uu;
      }
    }
#pragma unroll
    for (int d = 0; d < NDV; d++) {
#pragma unroll
      for (int sx = 0; sx < 2; sx++) {
#pragma unroll
        for (int qb = 0; qb < NQB; qb++) o[qb][d] = mfma16(vfr[d & 3][sx], pf[qb][sx], o[qb][d]);
      }
      if (d + 4 < NDV) {
#pragma unroll
        for (int sx = 0; sx < 2; sx++)
          vfr[d & 3][sx] = *(const bf16x8*)vaddr(Vs, d + 4, sx);
      }
    }
#pragma unroll
    for (int sx = 0; sx < 2; sx++) {
#pragma unroll
      for (int qb = 0; qb < NQB; qb++) lacc[qb] = mfma16(ones, pf[qb][sx], lacc[qb]);
    }
   }
  }
  __syncthreads();
#pragma unroll
  for (int qb = 0; qb < NQB; qb++) {
    float inv = 1.f / lacc[qb][0];
    int qrow = rowbase + qoff + wid * (16 * NQB) + qb * 16 + l15;
    bfr* gp = Z + (long)qrow * ZLD + (MLA ? C_GC : C_GA) + head * DV + g * 4;
#pragma unroll
    for (int d = 0; d < NDV; d++) {
      u32x2 gr = *(const u32x2*)(gp + d * 16);
      float y0 = o[qb][d][0] * inv * siluf(lo16(gr.x));
      float y1 = o[qb][d][1] * inv * siluf(hi16(gr.x));
      float y2 = o[qb][d][2] * inv * siluf(lo16(gr.y));
      float y3 = o[qb][d][3] * inv * siluf(hi16(gr.y));
      u32x2 ov;
      ov.x = pack2(y0, y1);
      ov.y = pack2(y2, y3);
      if (!dry) *(u32x2*)(gp + d * 16) = ov;
    }
  }
}

__device__ __forceinline__ void phase_mixers(const Params& p, int l, bfr* sm, int* s_item, int dry) {
  unsigned* ctr = (unsigned*)(p.ws + WS_CTR) + (2 + l + 2 * dry) * 128;
  auto cnt = [](int) { return 184; };
  int q = (int)xcc_id(), tried = 0;
  for (;;) {
    if (TIDX == 0) {
      unsigned first = atomicAdd(ctr + q * 16, 1u);
      *s_item = xq_take(ctr, q, tried, first, cnt);
    }
    __syncthreads();
    const int it = *s_item;
    __syncthreads();
    if (it < 0) break;
    const int x = it >> 20, j = it & 0xfffff;
    int kind, a0, a1, a2, a3 = 0;
    if (j < 4) {
      int idx = x * 4 + j;
      kind = 3; a0 = idx >> 4; a1 = (idx >> 2) & 3; a2 = (idx >> 1) & 1; a3 = idx & 1;
    } else if (j < 36) {
      kind = 1; a0 = 16 + (x >> 2); a1 = x & 3; a2 = (j - 4) * 128;
    } else if (j < 96) {
      int i = j - 36;
      kind = 2; a0 = 16 + (x >> 2); a1 = ((x >> 1) & 1) * 4 + (x & 1) * 2 + (i >> 5); a2 = (i & 31) * 128;
    } else if (j < 104) {
      int k = j - 96;
      int i = 60 + (k >> 1);
      kind = 4; a0 = 16 + (x >> 2); a1 = ((x >> 1) & 1) * 4 + (x & 1) * 2 + (i >> 5); a2 = (i & 31) * 128 + (k & 1) * 64;
    } else if (j < 136) {
      int i = j - 104;
      kind = 0; a0 = 2 * x + (i >> 4); a1 = (i >> 2) & 3; a2 = (i >> 1) & 1; a3 = i & 1;
    } else if (j < 152) {
      int i = j - 136;
      kind = 1; a0 = 2 * x + (i >> 3); a1 = (i >> 1) & 3; a2 = (i & 1) * 128;
    } else {
      int i = j - 152;
      kind = 2; a0 = 2 * x + (i >> 4); a1 = (i >> 1) & 7; a2 = (i & 1) * 128;
    }
#ifdef PROBE_MIXKIND
    if (dry && ((PROBE_MIXKIND == 1) != (kind == 0 || kind == 3))) continue;
#endif
    if (kind == 0) gla_item<64>(p, l, a0, a1, a2, a3, sm);
    else if (kind == 3) gla_chain_item(p, l, a0, a1, a2, a3, sm);
    else if (kind == 1) attn_item<96, 128, true, 2, true, 1>(p, a0, a1, a2, sm, dry);
    else if (kind == 2) attn_item<64, 64, false, 2, true, 2>(p, a0, a1, a2, sm, dry);
    else attn_item<64, 64, false, 1, true, 2>(p, a0, a1, a2, sm, dry);
  }
}

__device__ __forceinline__ void phase_gla_out(const Params& p, int l) {
  const int lane = TIDX & 63;
  bfr* Z = (bfr*)(p.ws + WS_Z);
  const bfr* OF = (const bfr*)(p.ws + WS_R1);
  const bfr* OB = OF + (long)NROWS * 512;
  for (int row = blockIdx.x * 4 + (TIDX >> 6); row < NROWS; row += gridDim.x * 4) {
    float a[8], c[8], gt[8];
    unpack8(*(const u32x4*)(OF + (long)row * 512 + lane * 8), a);
    unpack8(*(const u32x4*)(OB + (long)row * 512 + lane * 8), c);
    bfr* gp = Z + (long)row * ZLD + C_GG + lane * 8;
    unpack8(*(const u32x4*)gp, gt);
    float ss = 0.f;
#pragma unroll
    for (int e = 0; e < 8; e++) {
      a[e] = bf2f(f2bf(a[e] + c[e]));
      ss += a[e] * a[e];
    }
    ss += __shfl_xor(ss, 1); ss += __shfl_xor(ss, 2); ss += __shfl_xor(ss, 4); ss += __shfl_xor(ss, 8);
    float rs = rsqrtf(ss * (1.f / 128.f) + 1e-6f);
    const float* gg = p.in[21] + l * 128 + (lane & 15) * 8;
#pragma unroll
    for (int e = 0; e < 8; e++) a[e] = a[e] * rs * gg[e] * siluf(gt[e]);
    *(u32x4*)gp = pack8(a);
  }
}

template <int NQ>
__device__ __forceinline__ void merge_tile(const Params& p, bfr* sm, int tn, int tok0) {
  constexpr int STG = 8192 + 2048 * NQ;
  bfr* Z = (bfr*)(p.ws + WS_Z);
  bfr* MG = (bfr*)(p.ws + WS_R1);
  const int tid = TIDX;
  const int lane = tid & 63, wid = tid >> 6, wr = wid >> 1, wc = wid & 1, g = lane >> 4, l15 = lane & 15;
  f32x4 totl[4][NQ];
#pragma unroll
  for (int a = 0; a < 4; a++)
#pragma unroll
    for (int b = 0; b < NQ; b++) totl[a][b] = (f32x4){0.f, 0.f, 0.f, 0.f};
#pragma unroll 1
  for (int seg = 0; seg < 3; seg++) {
    f32x4 acc[4][NQ];
#pragma unroll
    for (int a = 0; a < 4; a++)
#pragma unroll
      for (int b = 0; b < NQ; b++) acc[a][b] = (f32x4){0.f, 0.f, 0.f, 0.f};
    int ycol = seg == 0 ? C_GA : (seg == 1 ? C_GG : C_GC);
    int mcol = C_M1 + seg * 1024;
    const bfr* W = (const bfr*)(p.ws + WS_WOA + (unsigned long)seg * 1048576ul) + (long)tn * 128 * 512;
    gemm128k64<NQ, false, true>(W, 512, 128, Z + (long)tok0 * ZLD + ycol, ZLD, 512, acc, sm,
                                Z + (long)tok0 * ZLD + mcol + tn * 128, ZLD);
    const bfr* gt = sm;
#pragma unroll
    for (int pi = 0; pi < 4; pi++) {
      const int nl = wr * 64 + pi * 16 + g * 4;
#pragma unroll
      for (int qi = 0; qi < NQ; qi++) {
        const int tl = wc * 16 * NQ + qi * 16 + l15;
        u32x2 mr = *(const u32x2*)(gt + tl * 128 + (((nl >> 3) ^ (tl & 15)) * 8) + (nl & 4));
        totl[pi][qi][0] += sigmf(lo16(mr.x)) * acc[pi][qi][0];
        totl[pi][qi][1] += sigmf(hi16(mr.x)) * acc[pi][qi][1];
        totl[pi][qi][2] += sigmf(lo16(mr.y)) * acc[pi][qi][2];
        totl[pi][qi][3] += sigmf(hi16(mr.y)) * acc[pi][qi][3];
      }
    }
    __syncthreads();
  }
#pragma unroll
  for (int pi = 0; pi < 4; pi++)
#pragma unroll
    for (int qi = 0; qi < NQ; qi++) {
      u32x2 o;
      o.x = pack2(totl[pi][qi][0], totl[pi][qi][1]);
      o.y = pack2(totl[pi][qi][2], totl[pi][qi][3]);
      *(u32x2*)(sm + (wc * 16 * NQ + qi * 16 + l15) * 136 + wr * 64 + pi * 16 + g * 4) = o;
    }
  __syncthreads();
#pragma unroll
  for (int i = 0; i < 2 * NQ; i++) {
    int c = tid + 256 * i;
    int row = c >> 4, c16 = c & 15;
    *(u32x4*)(MG + (long)(tok0 + row) * 1024 + tn * 128 + c16 * 8) = *(const u32x4*)(sm + row * 136 + c16 * 8);
  }
  __syncthreads();
}

__device__ __forceinline__ void phase_merge(const Params& p, bfr* sm) {
  for (int t = blockIdx.x; t < 1024; t += gridDim.x) {
    if (t < 512) {
      merge_tile<4>(p, sm, t & 7, (t >> 3) * 128);
    } else {
      int u = t - 512;
      int full = 512 + (u >> 1);
      merge_tile<2>(p, sm, full & 7, (full >> 3) * 128 + (u & 1) * 64);
    }
  }
}

template <int NQ>
__device__ __forceinline__ void outproj_tile(const Params& p, bfr* sm, int tn, int tok0) {
  const bfr* MG = (const bfr*)(p.ws + WS_R1);
  float* OUT = (float*)(p.ws + WS_Z);
  const int tid = TIDX;
  const int lane = tid & 63, wid = tid >> 6, wr = wid >> 1, wc = wid & 1, g = lane >> 4, l15 = lane & 15;
  f32x4 acc[4][NQ];
#pragma unroll
  for (int a = 0; a < 4; a++)
#pragma unroll
    for (int b = 0; b < NQ; b++) acc[a][b] = (f32x4){0.f, 0.f, 0.f, 0.f};
  gemm128k64<NQ, true>((const bfr*)(p.ws + WS_WOUT) + (long)tn * 128 * 1024, 1024, 128, MG + (long)tok0 * 1024, 1024, 1024, acc, sm);
  float* smf = (float*)sm;
#pragma unroll
  for (int pi = 0; pi < 4; pi++)
#pragma unroll
    for (int qi = 0; qi < NQ; qi++)
      *(f32x4*)(smf + (wc * 16 * NQ + qi * 16 + l15) * 132 + wr * 64 + pi * 16 + g * 4) = acc[pi][qi];
  __syncthreads();
#pragma unroll
  for (int i = 0; i < 4 * NQ; i++) {
    int c = tid + 256 * i;
    int row = c >> 5, c16 = c & 31;
    *(f32x4*)(OUT + (long)(tok0 + row) * 1024 + tn * 128 + c16 * 4) = *(const f32x4*)(smf + row * 132 + c16 * 4);
  }
  __syncthreads();
}
__device__ __forceinline__ void phase_outproj(const Params& p, bfr* sm) {
  for (int t = blockIdx.x; t < 1024; t += gridDim.x) {
    if (t < 512) {
      outproj_tile<4>(p, sm, t & 7, (t >> 3) * 128);
    } else {
      int u = t - 512;
      int full = 512 + (u >> 1);
      outproj_tile<2>(p, sm, full & 7, (full >> 3) * 128 + (u & 1) * 64);
    }
  }
}

__device__ __forceinline__ void phase_post(const Params& p, int l) {
  const int lane = TIDX & 63;
  const float* mod = (const float*)(p.ws + WS_MOD);
  const float* OUT = (const float*)(p.ws + WS_Z);
  bfr* H = (bfr*)(p.ws + WS_R1);
  for (int row = blockIdx.x * 4 + (TIDX >> 6); row < NROWS; row += gridDim.x * 4) {
    const float* x = (l == 0) ? xrow(p, row) : (p.out + (long)row * 1024);
    const float* md = mod + (l * 3 + row_cond(row)) * 3072;
    float4 v[4];
    float ss = 0.f;
#pragma unroll
    for (int i = 0; i < 4; i++) {
      v[i] = *(const float4*)(OUT + (long)row * 1024 + i * 256 + lane * 4);
      ss += v[i].x * v[i].x + v[i].y * v[i].y + v[i].z * v[i].z + v[i].w * v[i].w;
    }
    ss = wave_sum(ss);
    float rs = rsqrtf(ss * (1.f / 1024.f) + 1e-6f);
    float ss2 = 0.f;
#pragma unroll
    for (int i = 0; i < 4; i++) {
      int n = i * 256 + lane * 4;
      float4 g = *(const float4*)(p.in[13] + l * 1024 + n);
      float4 gt = *(const float4*)(md + 2048 + n);
      float4 xv = *(const float4*)(x + n);
      v[i].x = xv.x + gt.x * (v[i].x * rs * g.x);
      v[i].y = xv.y + gt.y * (v[i].y * rs * g.y);
      v[i].z = xv.z + gt.z * (v[i].z * rs * g.z);
      v[i].w = xv.w + gt.w * (v[i].w * rs * g.w);
      *(float4*)(p.out + (long)row * 1024 + n) = v[i];
      ss2 += v[i].x * v[i].x + v[i].y * v[i].y + v[i].z * v[i].z + v[i].w * v[i].w;
    }
    if (l == 0) {
      ss2 = wave_sum(ss2);
      float rs2 = rsqrtf(ss2 * (1.f / 1024.f) + 1e-6f);
      const float* md1 = mod + (1 * 3 + row_cond(row)) * 3072;
#pragma unroll
      for (int i = 0; i < 4; i++) {
        int n = i * 256 + lane * 4;
        float4 g = *(const float4*)(p.in[12] + 1024 + n);
        float4 sh = *(const float4*)(md1 + n);
        float4 sc = *(const float4*)(md1 + 1024 + n);
        float h0 = v[i].x * rs2 * g.x * (1.f + sc.x) + sh.x;
        float h1 = v[i].y * rs2 * g.y * (1.f + sc.y) + sh.y;
        float h2 = v[i].z * rs2 * g.z * (1.f + sc.z) + sh.z;
        float h3 = v[i].w * rs2 * g.w * (1.f + sc.w) + sh.w;
        u32x2 o;
        o.x = pack2(h0, h1);
        o.y = pack2(h2, h3);
        *(u32x2*)(H + (long)row * 1024 + n) = o;
      }
    }
  }
}

__global__ void __launch_bounds__(256, 2) fwd_megakernel(Params p) {
  __shared__ __attribute__((aligned(16))) bfr sm[SMEM_SHORTS + 16];
  int* s_item_p = (int*)(sm + SMEM_SHORTS + 8);
  cg::grid_group grid = cg::this_grid();
  if (threadIdx.x == 0) { ((unsigned*)(sm + SMEM_SHORTS))[0] = 0u; ((unsigned*)(sm + SMEM_SHORTS))[1] = 0u; }
  __syncthreads();
  XcdBarrier xb = xcd_barrier_post((unsigned*)(p.ws + WS_BAR), (volatile LAS unsigned*)(sm + SMEM_SHORTS));
  if (p.ws == nullptr) grid.sync();
  (void)xb;
#define GSYNC1 do { XcdBarrier b_; b_.bar = (unsigned*)(p.ws + WS_BAR); b_.x = xb_xcc_id(); \
                    b_.st = (volatile LAS unsigned*)(sm + SMEM_SHORTS); xcd_barrier(b_); } while (0)
#ifdef PROBE_SYNC
#define GSYNC do { GSYNC1; GSYNC1; } while (0)
#else
#define GSYNC GSYNC1
#endif
#ifdef PROBE_PRE
  phase_s0(launder(p), sm);
  GSYNC;
  phase_s1(launder(p));
  wconv_phase(p, 0, sm);
  GSYNC;
  phase_prenorm0(launder(p));
  GSYNC;
#endif

#ifndef PH
#define PH 0xffff
#endif
#if PH & 1
  phase_s0(launder(p), sm);
#endif
  GSYNC;
#if PH & 2
  phase_s1(launder(p));
  wconv_phase(p, 0, sm);
#endif
  GSYNC;
#if PH & 4
  phase_prenorm0(launder(p));
#endif
  GSYNC;
  for (int l = 0; l < 2; l++) {
#if PH & 8
#ifdef PROBE_INPROJ
    phase_inproj(launder(p), l, sm, s_item_p, 6 + l);
    GSYNC;
#endif
    phase_inproj(launder(p), l, sm, s_item_p, l);
#endif
    GSYNC;
#if PH & 16
    phase_rowpost(launder(p), l);
#endif
    GSYNC;
#if PH & 32
#ifdef PROBE_MLAUP
    phase_mla_up(launder(p), l, sm);
    GSYNC;
#endif
    phase_mla_up(launder(p), l, sm);
#endif
    GSYNC;
#if PH & 64
#ifdef PROBE_MIX
    { int dry = 1; asm volatile("" : "+s"(dry)); phase_mixers(launder(p), l, sm, s_item_p, dry); }
    GSYNC;
#endif
    { int dry = 0; asm volatile("" : "+s"(dry)); phase_mixers(launder(p), l, sm, s_item_p, dry); }
#endif
    GSYNC;
#if PH & 128
    phase_gla_out(launder(p), l);
#endif
    GSYNC;
#if PH & 256
#ifdef PROBE_MERGE
    phase_merge(launder(p), sm);
    GSYNC;
#endif
    phase_merge(launder(p), sm);
#endif
    GSYNC;
#if PH & 512
#ifdef PROBE_MERGE
    phase_outproj(launder(p), sm);
    GSYNC;
#endif
    phase_outproj(launder(p), sm);
#endif
    GSYNC;
#if PH & 1024
    phase_post(launder(p), l);
    if (l == 0) wconv_phase(p, 1, sm);
#endif
    if (l == 0) GSYNC;
  }
}

extern "C" void kernel_launch(void* const* d_in, const int* in_sizes, int n_in, void* d_out, int out_size, void* d_ws,
                              size_t ws_size, hipStream_t stream) {
  static int grid_blocks = 0;
  if (!grid_blocks) {
    int dev = 0, cus = 0, per_cu = 0;
    hipGetDevice(&dev);
    hipDeviceGetAttribute(&cus, hipDeviceAttributeMultiprocessorCount, dev);
    hipOccupancyMaxActiveBlocksPerMultiprocessor(&per_cu, fwd_megakernel, 256, 0);
    if (per_cu > 2) per_cu = 2;
    if (per_cu < 1) per_cu = 1;
    grid_blocks = cus * per_cu;
  }
  Params p{};
  for (int i = 0; i < 30; i++) p.in[i] = (const float*)d_in[i];
  p.out = (float*)d_out;
  p.ws = (unsigned char*)d_ws;
  hipMemsetAsync(d_ws, 0, 20480, stream);
  void* args[] = {&p};
  hipError_t e = hipLaunchCooperativeKernel((void*)fwd_megakernel, dim3(grid_blocks), dim3(256), args, 0, stream);
  if (e != hipSuccess) fprintf(stderr, "cooperative launch failed: %s (grid %d)\n", hipGetErrorString(e), grid_blocks);
}
```

```cpp
#include <hip/hip_runtime.h>
#include <hip/hip_cooperative_groups.h>
#include <cstdio>
namespace cg = cooperative_groups;

typedef unsigned short bfr;
typedef __attribute__((ext_vector_type(8))) short bf16x8;
typedef __attribute__((ext_vector_type(4))) float f32x4;
typedef __attribute__((ext_vector_type(4))) unsigned u32x4;
typedef __attribute__((ext_vector_type(2))) unsigned u32x2;

#define NROWS 12288
#define NCTX 4096
#define ZLD 6976
#define LDT 72
#define SMEM_SHORTS (4 * 128 * LDT)

#define C_QA 0
#define C_KA 512
#define C_VA 640
#define C_GA 768
#define C_QG 1280
#define C_KG 1536
#define C_VG 1792
#define C_GG 2304
#define C_RF 2816
#define C_RB 2832
#define C_QL 2848
#define C_KV 3104
#define C_KR 3360
#define C_GC 3392
#define C_M1 3904
#define C_M2 4928
#define C_M3 5952

#define WS_BAR 0ul
#define WS_CTR 16384ul
#define WS_MODP 20480ul
#define WS_MOD (WS_MODP + 589824ul)
#define WS_ROPE (WS_MOD + 73728ul)
#define WS_WIN (WS_ROPE + 16384ul)
#define WS_WUQ (WS_WIN + 14417920ul)
#define WS_WUKV (WS_WUQ + 196608ul)
#define WS_WOA (WS_WUKV + 393216ul)
#define WS_WOB (WS_WOA + 1048576ul)
#define WS_WOC (WS_WOB + 1048576ul)
#define WS_WOUT (WS_WOC + 1048576ul)
#define WS_KCA (WS_WOUT + 2097152ul)
#define WS_CKVC (WS_KCA + 262144ul)
#define WS_KRC (WS_CKVC + 524288ul)
#define WS_VTA (WS_KRC + 65536ul)
#define WS_CQ (WS_VTA + 3407872ul)
#define WS_KNOPE (WS_CQ + 9437184ul)
#define WS_VTC (WS_KNOPE + 6815744ul)
#define WS_R1 (WS_VTC + 13631488ul)
#define WS_Z (WS_R1 + 25165824ul)
#define WS_END (WS_Z + 171442176ul)

#define O_Y 0
#define O_GK 12582912
#define O_GV 13631488
#define O_CKV 14680064
#define O_KR 16777216
#define O_SF 17039360
#define O_SB 18087936

struct Params {
  const float* in[30];
  float* out;
  unsigned char* ws;
};

__device__ __forceinline__ int tidx() {
  int t = threadIdx.x;
  asm volatile("" : "+v"(t));
  return t;
}
__device__ __forceinline__ Params launder(const Params& p) {
  Params q;
  long zo = 0;
  asm volatile("" : "+s"(zo));
#pragma unroll
  for (int i = 0; i < 30; i++) q.in[i] = p.in[i] + zo;
  q.out = p.out + zo;
  q.ws = p.ws + zo;
  return q;
}
__device__ __forceinline__ float bf2f(bfr b) { return __uint_as_float(((unsigned)b) << 16); }
typedef float f32x2_t __attribute__((ext_vector_type(2)));
typedef __bf16 bf16x2_t __attribute__((ext_vector_type(2)));
__device__ __forceinline__ bfr f2bf(float f) {
  __bf16 r = (__bf16)f;
  return *(bfr*)&r;
}
__device__ __forceinline__ unsigned pack2(float a, float b) {
  f32x2_t v = {a, b};
  bf16x2_t r = __builtin_convertvector(v, bf16x2_t);
  return *(unsigned*)&r;
}
__device__ __forceinline__ float lo16(unsigned u) { return __uint_as_float(u << 16); }
__device__ __forceinline__ float hi16(unsigned u) { return __uint_as_float(u & 0xffff0000u); }
__device__ __forceinline__ float siluf(float x) { return x / (1.f + __expf(-x)); }
__device__ __forceinline__ float sigmf(float x) { return 1.f / (1.f + __expf(-x)); }
__device__ __forceinline__ f32x4 mfma16(bf16x8 a, bf16x8 b, f32x4 c) {
  return __builtin_amdgcn_mfma_f32_16x16x32_bf16(a, b, c, 0, 0, 0);
}
__device__ __forceinline__ const float* xrow(const Params& p, int row) {
  return row < NCTX ? p.in[0] + (long)row * 1024 : p.in[1] + (long)(row - NCTX) * 1024;
}
__device__ __forceinline__ int row_cond(int row) { return row < NCTX ? 0 : 1 + ((row - NCTX) >> 12); }
__device__ __forceinline__ float wave_sum(float v) {
  v += __shfl_xor(v, 1); v += __shfl_xor(v, 2); v += __shfl_xor(v, 4);
  v += __shfl_xor(v, 8); v += __shfl_xor(v, 16); v += __shfl_xor(v, 32);
  return v;
}

#define XB_TMO      128
#define XB_XCNT(j)  (256  + 64 * (j))
#define XB_XSUB(j)  (1280 + 64 * (j))
#define XB_XGEN(j)  (2304 + 64 * (j))
#define XB_TOP      3328
#define XB_TOPGEN   3392
#define XCD_BAR_WORDS 3456
#define XB_SPIN_CAP (1u << 18)
#define LAS __attribute__((address_space(3)))

__device__ __forceinline__ unsigned xb_ld(unsigned* p)              { return __hip_atomic_load(p, __ATOMIC_RELAXED, __HIP_MEMORY_SCOPE_AGENT); }
__device__ __forceinline__ unsigned xb_add(unsigned* p, unsigned v) { return __hip_atomic_fetch_add(p, v, __ATOMIC_RELAXED, __HIP_MEMORY_SCOPE_AGENT); }
__device__ __forceinline__ unsigned xb_xcc_id() { return (unsigned)__builtin_amdgcn_s_getreg((3 << 11) | 20) & 0xFu; }
#define XB_SPIN(cond, bar) do { unsigned _sp = 0; while (cond) { __builtin_amdgcn_s_sleep(1); \
    if ((++_sp & 255u) == 0u) { if (xb_ld(&(bar)[XB_TMO])) break; if (_sp > XB_SPIN_CAP) { atomicAdd(&(bar)[XB_TMO], 1u); break; } } } } while (0)

struct XcdBarrier {
    unsigned* bar; unsigned x;
    volatile LAS unsigned* st;
};

__device__ __forceinline__ XcdBarrier xcd_barrier_post(unsigned* bar, volatile LAS unsigned* st) {
    XcdBarrier b; b.bar = bar; b.x = xb_xcc_id(); b.st = st;
    if (threadIdx.x == 0) (void)xb_add(&bar[XB_XCNT(b.x)], 1u);
    return b;
}
__device__ __forceinline__ void xcd_barrier_complete(unsigned* bar, unsigned x, unsigned& nloc, unsigned& nx) {
    const unsigned G = gridDim.x * gridDim.y * gridDim.z;
    unsigned sum, cnt, mine, sp = 0u;
    for (;;) {
        sum = 0u; cnt = 0u; mine = 0u;
#pragma unroll
        for (unsigned j = 0; j < 16; ++j) { const unsigned c = xb_ld(&bar[XB_XCNT(j)]); sum += c; cnt += (c > 0u) ? 1u : 0u; mine = (j == x) ? c : mine; }
        if (sum == G) break;
        __builtin_amdgcn_s_sleep(1);
        if ((++sp & 255u) == 0u) { if (xb_ld(&bar[XB_TMO])) break; if (sp > XB_SPIN_CAP) { atomicAdd(&bar[XB_TMO], 1u); break; } }
    }
    nloc = mine > 0u ? mine : 1u; nx = cnt > 0u ? cnt : 1u;
}

__device__ __forceinline__ void xcd_barrier(const XcdBarrier& b) {
    asm volatile("s_waitcnt vmcnt(0)" ::: "memory");
    __syncthreads();
    if (threadIdx.x == 0) {
        unsigned* bar = b.bar;
        __builtin_amdgcn_s_waitcnt(0);
        unsigned nloc = b.st[0], nx = b.st[1];
        if (nloc == 0u) { xcd_barrier_complete(bar, b.x, nloc, nx); b.st[0] = nloc; b.st[1] = nx; }
        const unsigned old = xb_add(&bar[XB_XSUB(b.x)], 1u);
        const unsigned gen = old / nloc;
        if (old + 1u == (gen + 1u) * nloc) {
            __builtin_amdgcn_fence(__ATOMIC_RELEASE, "agent");
            asm volatile("s_waitcnt vmcnt(0)" ::: "memory");
            const unsigned og = xb_add(&bar[XB_TOP], 1u);
            const unsigned tg = og / nx;
            if (og + 1u == (tg + 1u) * nx) xb_add(&bar[XB_TOPGEN], 1u);
            else XB_SPIN(xb_ld(&bar[XB_TOPGEN]) == tg, bar);
            __builtin_amdgcn_fence(__ATOMIC_ACQUIRE, "agent");
            xb_add(&bar[XB_XGEN(b.x)], 1u);
            asm volatile("s_waitcnt vmcnt(0)" ::: "memory");
        } else {
            XB_SPIN(xb_ld(&bar[XB_XGEN(b.x)]) == gen, bar);
            __builtin_amdgcn_fence(__ATOMIC_ACQUIRE, "agent");
            asm volatile("s_waitcnt vmcnt(0)" ::: "memory");
        }
    }
    __syncthreads();
}


#define TIDX tidx()
#define LDS3 __attribute__((address_space(3)))
__device__ __forceinline__ void glds16(const bfr* g, bfr* l) {
  __builtin_amdgcn_global_load_lds((const unsigned*)g, (LDS3 unsigned*)l, 16, 0, 0);
}
__device__ __forceinline__ void gemm128(const bfr* __restrict__ P, long ldp, int pmax,
                                        const bfr* __restrict__ Q, long ldq, int qmax, int K,
                                        f32x4 (&acc)[4][4], bfr* sm) {
  const int tid = TIDX, lane = tid & 63, wid = tid >> 6;
  const int wr = wid >> 1, wc = wid & 1;
  const int l15 = lane & 15, g = lane >> 4;
  const bfr* pp[2];
  const bfr* qp[2];
  {
    const int r0 = tid >> 2;
    const int c = (tid & 3) ^ ((tid >> 4) & 3);
#pragma unroll
    for (int i = 0; i < 2; i++) {
      int r = r0 + 64 * i;
      pp[i] = P + (long)min(r, pmax - 1) * ldp + c * 8;
      qp[i] = Q + (long)min(r, qmax - 1) * ldq + c * 8;
    }
  }
  const int nk = K >> 5;
#define GEMM_ISSUE(T)                                                    \
  do {                                                                   \
    bfr* nb_ = sm + ((T) & 3) * 8192;                                    \
    glds16(pp[0] + (T) * 32, nb_ + tid * 8);                             \
    glds16(pp[1] + (T) * 32, nb_ + 2048 + tid * 8);                      \
    glds16(qp[0] + (T) * 32, nb_ + 4096 + tid * 8);                      \
    glds16(qp[1] + (T) * 32, nb_ + 6144 + tid * 8);                      \
  } while (0)
  GEMM_ISSUE(0);
  GEMM_ISSUE(1);
  GEMM_ISSUE(2);
  const int pos = (g ^ ((l15 >> 2) & 3)) * 8;
  for (int kt = 0; kt < nk; kt++) {
    if (kt + 2 < nk) asm volatile("s_waitcnt vmcnt(8)" ::: "memory");
    else if (kt + 1 < nk) asm volatile("s_waitcnt vmcnt(4)" ::: "memory");
    else asm volatile("s_waitcnt vmcnt(0)" ::: "memory");
    __builtin_amdgcn_s_barrier();
    if (kt + 3 < nk) GEMM_ISSUE(kt + 3);
    const bfr* Ps = sm + (kt & 3) * 8192;
    const bfr* Qs = Ps + 4096;
    bf16x8 pf[4], qf[4];
#pragma unroll
    for (int m = 0; m < 4; m++) {
      pf[m] = *(const bf16x8*)(Ps + (wr * 64 + m * 16 + l15) * 32 + pos);
      qf[m] = *(const bf16x8*)(Qs + (wc * 64 + m * 16 + l15) * 32 + pos);
    }
#pragma unroll
    for (int m = 0; m < 4; m++)
#pragma unroll
      for (int n = 0; n < 4; n++) acc[m][n] = mfma16(pf[m], qf[n], acc[m][n]);
  }
#undef GEMM_ISSUE
  __syncthreads();
}

template <int NQ>
__device__ __forceinline__ void gemm128q(const bfr* __restrict__ P, long ldp, const bfr* __restrict__ Q, long ldq, int K,
                                         f32x4 (&acc)[4][NQ], bfr* sm) {
  constexpr int QI = NQ / 2;
  constexpr int STG = 4096 + QI * 2048;
  const int tid = TIDX, lane = tid & 63, wid = tid >> 6;
  const int wr = wid >> 1, wc = wid & 1;
  const int l15 = lane & 15, g = lane >> 4;
  const bfr* pp[2];
  const bfr* qp[QI];
  {
    const int r0 = tid >> 2;
    const int c = (tid & 3) ^ (((tid >> 5) & 1) * 3);
#pragma unroll
    for (int i = 0; i < 2; i++) pp[i] = P + (long)(r0 + 64 * i) * ldp + c * 8;
#pragma unroll
    for (int i = 0; i < QI; i++) qp[i] = Q + (long)(r0 + 64 * i) * ldq + c * 8;
  }
  const int nk = K >> 5;
  auto issue = [&](int T) {
    bfr* nb_ = sm + (T & 3) * STG;
    glds16(pp[0] + T * 32, nb_ + tid * 8);
    glds16(pp[1] + T * 32, nb_ + 2048 + tid * 8);
#pragma unroll
    for (int i = 0; i < QI; i++) glds16(qp[i] + T * 32, nb_ + 4096 + i * 2048 + tid * 8);
  };
  issue(0);
  issue(1);
  issue(2);
  const int pos = (g ^ (((l15 >> 3) & 1) * 3)) * 8;
  for (int kt = 0; kt < nk; kt++) {
    if (kt + 2 < nk) {
      if (QI == 2) asm volatile("s_waitcnt vmcnt(8)" ::: "memory"); else asm volatile("s_waitcnt vmcnt(6)" ::: "memory");
    } else if (kt + 1 < nk) {
      if (QI == 2) asm volatile("s_waitcnt vmcnt(4)" ::: "memory"); else asm volatile("s_waitcnt vmcnt(3)" ::: "memory");
    } else {
      asm volatile("s_waitcnt vmcnt(0)" ::: "memory");
    }
    __builtin_amdgcn_s_barrier();
    if (kt + 3 < nk) issue(kt + 3);
    const bfr* Ps = sm + (kt & 3) * STG;
    const bfr* Qs = Ps + 4096;
    bf16x8 pf[4], qf[NQ];
#pragma unroll
    for (int m = 0; m < 4; m++) pf[m] = *(const bf16x8*)(Ps + (wr * 64 + m * 16 + l15) * 32 + pos);
#pragma unroll
    for (int n = 0; n < NQ; n++) qf[n] = *(const bf16x8*)(Qs + (wc * 16 * NQ + n * 16 + l15) * 32 + pos);
#pragma unroll
    for (int m = 0; m < 4; m++)
#pragma unroll
      for (int n = 0; n < NQ; n++) acc[m][n] = mfma16(pf[m], qf[n], acc[m][n]);
  }
  __syncthreads();
}

template <int NQ>
__device__ __forceinline__ void gemm256x128(const bfr* __restrict__ P, long ldp, int pmax,
                                            const bfr* __restrict__ Q, long ldq, int K,
                                            f32x4 (&acc)[8][NQ], bfr* sm) {
  constexpr int QI = NQ / 2;
  constexpr int STG = 8192 + QI * 2048;
  const int tid = TIDX, lane = tid & 63, wid = tid >> 6;
  const int wr = wid >> 1, wc = wid & 1;
  const int l15 = lane & 15, g = lane >> 4;
  const bfr* pp[4];
  const bfr* qp[QI];
  {
    const int r0 = tid >> 2;
    const int c = (tid & 3) ^ (((tid >> 5) & 1) * 3);
#pragma unroll
    for (int i = 0; i < 4; i++) pp[i] = P + (long)min(r0 + 64 * i, pmax - 1) * ldp + c * 8;
#pragma unroll
    for (int i = 0; i < QI; i++) qp[i] = Q + (long)(r0 + 64 * i) * ldq + c * 8;
  }
  const int nk = K >> 5;
  auto issue = [&](int T, int stg) {
    bfr* nb_ = sm + stg * STG;
    glds16(pp[0] + T * 32, nb_ + tid * 8);
    glds16(pp[1] + T * 32, nb_ + 2048 + tid * 8);
    glds16(pp[2] + T * 32, nb_ + 4096 + tid * 8);
    glds16(pp[3] + T * 32, nb_ + 6144 + tid * 8);
#pragma unroll
    for (int i = 0; i < QI; i++) glds16(qp[i] + T * 32, nb_ + 8192 + i * 2048 + tid * 8);
  };
  issue(0, 0);
  issue(1, 1);
  const int pos = (g ^ (((l15 >> 3) & 1) * 3)) * 8;
  int st = 0;
  for (int kt = 0; kt < nk; kt++) {
    if (kt + 1 < nk) {
      if (QI == 2) asm volatile("s_waitcnt vmcnt(6)" ::: "memory"); else asm volatile("s_waitcnt vmcnt(5)" ::: "memory");
    } else {
      asm volatile("s_waitcnt vmcnt(0)" ::: "memory");
    }
    __builtin_amdgcn_s_barrier();
    if (kt + 2 < nk) issue(kt + 2, st == 0 ? 2 : st - 1);
    const bfr* Ps = sm + st * STG;
    const bfr* Qs = Ps + 8192;
    st = (st == 2) ? 0 : st + 1;
    bf16x8 qf[NQ], pf[8];
#pragma unroll
    for (int n = 0; n < NQ; n++) qf[n] = *(const bf16x8*)(Qs + (wc * 16 * NQ + n * 16 + l15) * 32 + pos);
#pragma unroll
    for (int m = 0; m < 8; m++) pf[m] = *(const bf16x8*)(Ps + (wr * 128 + m * 16 + l15) * 32 + pos);
#pragma unroll
    for (int m = 0; m < 8; m++)
#pragma unroll
      for (int n = 0; n < NQ; n++) acc[m][n] = mfma16(pf[m], qf[n], acc[m][n]);
    __builtin_amdgcn_sched_group_barrier(0x100, NQ + 2, 0);
#pragma unroll
    for (int i = 0; i < 6; i++) {
      __builtin_amdgcn_sched_group_barrier(0x008, NQ, 0);
      __builtin_amdgcn_sched_group_barrier(0x100, 1, 0);
    }
    __builtin_amdgcn_sched_group_barrier(0x008, 2 * NQ, 0);
  }
  __syncthreads();
}

template <int NQ, bool PIPE, bool TAIL = false>
__device__ __forceinline__ void gemm128k64(const bfr* __restrict__ P, long ldp, int pmax,
                                           const bfr* __restrict__ Q, long ldq, int K,
                                           f32x4 (&acc)[4][NQ], bfr* sm, const bfr* tail_src = nullptr, long tail_ld = 0) {
  constexpr int STG = 8192 + 2048 * NQ;
  const int tid = TIDX, lane = tid & 63, wid = tid >> 6;
  const int wr = wid >> 1, wc = wid & 1;
  const int l15 = lane & 15, g = lane >> 4;
  const bfr* pp[4];
  const bfr* qp[NQ];
  {
    const int r0 = tid >> 3;
    const int c = (tid & 7) ^ ((tid >> 4) & 7);
#pragma unroll
    for (int i = 0; i < 4; i++) pp[i] = P + (long)min(r0 + 32 * i, pmax - 1) * ldp + c * 8;
#pragma unroll
    for (int i = 0; i < NQ; i++) qp[i] = Q + (long)(r0 + 32 * i) * ldq + c * 8;
  }
  const int nk = K >> 6;
#pragma unroll
  for (int i = 0; i < 4; i++) glds16(pp[i], sm + i * 2048 + tid * 8);
#pragma unroll
  for (int i = 0; i < NQ; i++) glds16(qp[i], sm + 8192 + i * 2048 + tid * 8);
  const int swz = l15 >> 1;
  for (int kt = 0; kt < nk; kt++) {
    asm volatile("s_waitcnt vmcnt(0)" ::: "memory");
    __builtin_amdgcn_s_barrier();
    if (kt + 1 < nk) {
      bfr* nb = sm + ((kt + 1) & 1) * STG;
#pragma unroll
      for (int i = 0; i < 4; i++) glds16(pp[i] + (kt + 1) * 64, nb + i * 2048 + tid * 8);
#pragma unroll
      for (int i = 0; i < NQ; i++) glds16(qp[i] + (kt + 1) * 64, nb + 8192 + i * 2048 + tid * 8);
    } else if (TAIL) {
      bfr* nb = sm + ((kt + 1) & 1) * STG;
      const bfr* ts = tail_src + (long)(tid >> 4) * tail_ld + (((tid & 15) ^ ((tid >> 4) & 15)) * 8);
#pragma unroll
      for (int i = 0; i < 2 * NQ; i++) glds16(ts + (long)(16 * i) * tail_ld, nb + i * 2048 + tid * 8);
    }
    const bfr* Ps = sm + (kt & 1) * STG;
    const bfr* Qs = Ps + 8192;
    if (PIPE) {
      bf16x8 pf[2][4], qf[2][NQ];
#pragma unroll
      for (int kk = 0; kk < 2; kk++) {
        const int pos = ((kk * 4 + g) ^ swz) * 8;
#pragma unroll
        for (int m = 0; m < 4; m++) pf[kk][m] = *(const bf16x8*)(Ps + (wr * 64 + m * 16 + l15) * 64 + pos);
#pragma unroll
        for (int n = 0; n < NQ; n++) qf[kk][n] = *(const bf16x8*)(Qs + (wc * 16 * NQ + n * 16 + l15) * 64 + pos);
      }
#pragma unroll
      for (int kk = 0; kk < 2; kk++)
#pragma unroll
        for (int m = 0; m < 4; m++)
#pragma unroll
          for (int n = 0; n < NQ; n++) acc[m][n] = mfma16(pf[kk][m], qf[kk][n], acc[m][n]);
      __builtin_amdgcn_sched_group_barrier(0x100, 4 + NQ, 0);
#pragma unroll
      for (int i = 0; i < 4 + NQ; i++) {
        __builtin_amdgcn_sched_group_barrier(0x008, NQ == 4 ? 2 : 1, 0);
        __builtin_amdgcn_sched_group_barrier(0x100, 1, 0);
      }
      __builtin_amdgcn_sched_group_barrier(0x008, NQ == 4 ? 16 : 10, 0);
    } else {
#pragma unroll
      for (int kk = 0; kk < 2; kk++) {
        bf16x8 pf[4], qf[NQ];
        const int pos = ((kk * 4 + g) ^ swz) * 8;
#pragma unroll
        for (int m = 0; m < 4; m++) pf[m] = *(const bf16x8*)(Ps + (wr * 64 + m * 16 + l15) * 64 + pos);
#pragma unroll
        for (int n = 0; n < NQ; n++) qf[n] = *(const bf16x8*)(Qs + (wc * 16 * NQ + n * 16 + l15) * 64 + pos);
#pragma unroll
        for (int m = 0; m < 4; m++)
#pragma unroll
          for (int n = 0; n < NQ; n++) acc[m][n] = mfma16(pf[m], qf[n], acc[m][n]);
      }
    }
  }
  if (TAIL) asm volatile("s_waitcnt vmcnt(0)" ::: "memory");
  __syncthreads();
}

__device__ __forceinline__ void gemm160x128(const bfr* __restrict__ P, long ldp, int pmax,
                                            const bfr* __restrict__ Q, long ldq, int K,
                                            f32x4 (&acc)[5][4], bfr* sm) {
  constexpr int STG = 160 * 64 + 128 * 64;
  const int tid = TIDX, lane = tid & 63, wid = tid >> 6;
  const int wr = wid >> 1, wc = wid & 1;
  const int l15 = lane & 15, g = lane >> 4;
  const bfr* pp[5];
  const bfr* qp[4];
  {
    const int r0 = tid >> 3;
    const int c = (tid & 7) ^ ((tid >> 4) & 7);
#pragma unroll
    for (int i = 0; i < 5; i++) pp[i] = P + (long)min(r0 + 32 * i, pmax - 1) * ldp + c * 8;
#pragma unroll
    for (int i = 0; i < 4; i++) qp[i] = Q + (long)(r0 + 32 * i) * ldq + c * 8;
  }
  const int nk = K >> 6;
#pragma unroll
  for (int i = 0; i < 5; i++) glds16(pp[i], sm + i * 2048 + tid * 8);
#pragma unroll
  for (int i = 0; i < 4; i++) glds16(qp[i], sm + 10240 + i * 2048 + tid * 8);
  const int swz = l15 >> 1;
  for (int kt = 0; kt < nk; kt++) {
    asm volatile("s_waitcnt vmcnt(0)" ::: "memory");
    __builtin_amdgcn_s_barrier();
    if (kt + 1 < nk) {
      bfr* nb = sm + ((kt + 1) & 1) * STG;
#pragma unroll
      for (int i = 0; i < 5; i++) glds16(pp[i] + (kt + 1) * 64, nb + i * 2048 + tid * 8);
#pragma unroll
      for (int i = 0; i < 4; i++) glds16(qp[i] + (kt + 1) * 64, nb + 10240 + i * 2048 + tid * 8);
    }
    const bfr* Ps = sm + (kt & 1) * STG;
    const bfr* Qs = Ps + 10240;
    bf16x8 pf[2][5], qf[2][4];
#pragma unroll
    for (int kk = 0; kk < 2; kk++) {
      const int pos = ((kk * 4 + g) ^ swz) * 8;
#pragma unroll
      for (int m = 0; m < 5; m++) pf[kk][m] = *(const bf16x8*)(Ps + (wr * 80 + m * 16 + l15) * 64 + pos);
#pragma unroll
      for (int n = 0; n < 4; n++) qf[kk][n] = *(const bf16x8*)(Qs + (wc * 64 + n * 16 + l15) * 64 + pos);
    }
#pragma unroll
    for (int kk = 0; kk < 2; kk++)
#pragma unroll
      for (int m = 0; m < 5; m++)
#pragma unroll
        for (int n = 0; n < 4; n++) acc[m][n] = mfma16(pf[kk][m], qf[kk][n], acc[m][n]);
    __builtin_amdgcn_sched_group_barrier(0x100, 9, 0);
#pragma unroll
    for (int i = 0; i < 9; i++) {
      __builtin_amdgcn_sched_group_barrier(0x008, 2, 0);
      __builtin_amdgcn_sched_group_barrier(0x100, 1, 0);
    }
    __builtin_amdgcn_sched_group_barrier(0x008, 22, 0);
  }
  __syncthreads();
}

__device__ __forceinline__ void phase_s0(const Params& p, bfr* sm) {
  const int tid = TIDX;
  float* rope = (float*)(p.ws + WS_ROPE);
  for (int idx = blockIdx.x * 256 + tid; idx < 1536; idx += gridDim.x * 256) {
    if (idx < 1024) {
      int pos = idx >> 4, i = idx & 15;
      float fr = powf(10000.f, -(float)i / 16.f);
      float a = (float)pos * fr;
      rope[idx] = cosf(a);
      rope[1024 + idx] = sinf(a);
    } else {
      int j = idx - 1024;
      int pos = j >> 3, i = j & 7;
      float fr = powf(10000.f, -(float)i / 8.f);
      float a = (float)pos * fr;
      rope[2048 + j] = cosf(a);
      rope[2560 + j] = sinf(a);
    }
  }
  float* smf = (float*)sm;
  float* modp = (float*)(p.ws + WS_MODP);
  for (int it = blockIdx.x; it < 768; it += gridDim.x) {
    int l = it / 384, rem = it % 384, cgp = rem >> 3, ks = rem & 7;
    int col = cgp * 64 + (tid & 63), kq = tid >> 6;
    const float* w = p.in[10] + (long)l * 1024 * 3072 + col;
    float a0 = 0.f, a1 = 0.f, a2 = 0.f;
    int k0 = ks * 128 + kq * 32;
#pragma unroll 8
    for (int k = k0; k < k0 + 32; k++) {
      float wv = w[(long)k * 3072];
      a0 += siluf(p.in[9][k]) * wv;
      a1 += siluf(p.in[8][k]) * wv;
      a2 += siluf(p.in[8][1024 + k]) * wv;
    }
    smf[(kq * 3 + 0) * 64 + (tid & 63)] = a0;
    smf[(kq * 3 + 1) * 64 + (tid & 63)] = a1;
    smf[(kq * 3 + 2) * 64 + (tid & 63)] = a2;
    __syncthreads();
    if (tid < 192) {
      int c = tid >> 6, cc = tid & 63;
      float s = smf[(0 * 3 + c) * 64 + cc] + smf[(1 * 3 + c) * 64 + cc] + smf[(2 * 3 + c) * 64 + cc] + smf[(3 * 3 + c) * 64 + cc];
      modp[((ks * 2 + l) * 3 + c) * 3072 + cgp * 64 + cc] = s;
    }
    __syncthreads();
  }
}

__device__ __forceinline__ void phase_s1(const Params& p) {
  float* modp = (float*)(p.ws + WS_MODP);
  float* mod = (float*)(p.ws + WS_MOD);
  for (int idx = blockIdx.x * 256 + TIDX; idx < 2 * 3 * 3072; idx += gridDim.x * 256) {
    int l = idx / 9216, n = idx % 3072;
    float s = p.in[11][l * 3072 + n];
#pragma unroll
    for (int ks = 0; ks < 8; ks++) s += modp[ks * 18432 + idx];
    mod[idx] = s;
  }
}

#define WCONV_ITEMS 2456
struct WcItem { const float* src; bfr* dst; int K, N, tk, tn; };
__device__ __forceinline__ WcItem wconv_decode(const Params& p, int l, int item) {
  WcItem w;
  if (item < 1744) {
    w.src = p.in[14] + (long)l * 1024 * 6976; w.K = 1024; w.N = 6976; w.dst = (bfr*)(p.ws + WS_WIN); w.tk = item & 15; w.tn = item >> 4;
  } else if (item < 1768) {
    item -= 1744;
    w.src = p.in[24] + (long)l * 256 * 384; w.K = 256; w.N = 384; w.dst = (bfr*)(p.ws + WS_WUQ); w.tk = item & 3; w.tn = item >> 2;
  } else if (item < 1816) {
    item -= 1768;
    w.src = p.in[25] + (long)l * 256 * 768; w.K = 256; w.N = 768; w.dst = (bfr*)(p.ws + WS_WUKV); w.tk = item & 3; w.tn = item >> 2;
  } else if (item < 2200) {
    item -= 1816;
    int ww = item >> 7, it = item & 127;
    w.src = (ww == 0 ? p.in[26] : (ww == 1 ? p.in[27] : p.in[28])) + (long)l * 512 * 1024;
    w.K = 512; w.N = 1024; w.dst = (bfr*)(p.ws + WS_WOA + (unsigned long)ww * 1048576ul); w.tk = it & 7; w.tn = it >> 3;
  } else {
    item -= 2200;
    w.src = p.in[29] + (long)l * 1024 * 1024; w.K = 1024; w.N = 1024; w.dst = (bfr*)(p.ws + WS_WOUT); w.tk = item & 15; w.tn = item >> 4;
  }
  return w;
}
__device__ __forceinline__ void wconv_phase(const Params& p, int l, bfr* sm) {
  bfr* sT = sm;
  const int tid = TIDX;
  const int n4 = (tid & 15) * 4, k0 = (tid >> 4) * 4;
  float4 v[4];
  int item = blockIdx.x;
  if (item < WCONV_ITEMS) {
    WcItem w = wconv_decode(p, l, item);
#pragma unroll
    for (int i = 0; i < 4; i++) v[i] = *(const float4*)(w.src + (long)(w.tk * 64 + k0 + i) * w.N + w.tn * 64 + n4);
  }
  const int wcol = (((k0 >> 3) ^ ((n4 >> 2) & 7)) * 8) + (k0 & 4);
  for (; item < WCONV_ITEMS; item += gridDim.x) {
    WcItem w = wconv_decode(p, l, item);
    {
      u32x2 o;
      o.x = pack2(v[0].x, v[1].x); o.y = pack2(v[2].x, v[3].x);
      *(u32x2*)(sT + (n4 + 0) * 64 + wcol) = o;
      o.x = pack2(v[0].y, v[1].y); o.y = pack2(v[2].y, v[3].y);
      *(u32x2*)(sT + (n4 + 1) * 64 + wcol) = o;
      o.x = pack2(v[0].z, v[1].z); o.y = pack2(v[2].z, v[3].z);
      *(u32x2*)(sT + (n4 + 2) * 64 + wcol) = o;
      o.x = pack2(v[0].w, v[1].w); o.y = pack2(v[2].w, v[3].w);
      *(u32x2*)(sT + (n4 + 3) * 64 + wcol) = o;
    }
    const int nitem = item + gridDim.x;
    if (nitem < WCONV_ITEMS) {
      WcItem wn = wconv_decode(p, l, nitem);
#pragma unroll
      for (int i = 0; i < 4; i++) v[i] = *(const float4*)(wn.src + (long)(wn.tk * 64 + k0 + i) * wn.N + wn.tn * 64 + n4);
    }
    __syncthreads();
#pragma unroll
    for (int i = 0; i < 2; i++) {
      int c = tid + 256 * i;
      int n = c >> 3, kc = c & 7;
      *(u32x4*)(w.dst + (long)(w.tn * 64 + n) * w.K + w.tk * 64 + kc * 8) = *(const u32x4*)(sT + n * 64 + ((kc ^ ((n >> 2) & 7)) * 8));
    }
    __syncthreads();
  }
}

__device__ __forceinline__ void phase_prenorm0(const Params& p) {
  const int lane = TIDX & 63;
  const float* mod = (const float*)(p.ws + WS_MOD);
  bfr* H = (bfr*)(p.ws + WS_R1);
  for (int row = blockIdx.x * 4 + (TIDX >> 6); row < NROWS; row += gridDim.x * 4) {
    const float* x = xrow(p, row);
    const float* md = mod + (0 * 3 + row_cond(row)) * 3072;
    float4 v[4];
    float ss = 0.f;
#pragma unroll
    for (int i = 0; i < 4; i++) {
      v[i] = *(const float4*)(x + i * 256 + lane * 4);
      ss += v[i].x * v[i].x + v[i].y * v[i].y + v[i].z * v[i].z + v[i].w * v[i].w;
    }
    ss = wave_sum(ss);
    float rs = rsqrtf(ss * (1.f / 1024.f) + 1e-6f);
#pragma unroll
    for (int i = 0; i < 4; i++) {
      int n = i * 256 + lane * 4;
      float4 g = *(const float4*)(p.in[12] + n);
      float4 sh = *(const float4*)(md + n);
      float4 sc = *(const float4*)(md + 1024 + n);
      float h0 = v[i].x * rs * g.x * (1.f + sc.x) + sh.x;
      float h1 = v[i].y * rs * g.y * (1.f + sc.y) + sh.y;
      float h2 = v[i].z * rs * g.z * (1.f + sc.z) + sh.z;
      float h3 = v[i].w * rs * g.w * (1.f + sc.w) + sh.w;
      u32x2 o;
      o.x = pack2(h0, h1);
      o.y = pack2(h2, h3);
      *(u32x2*)(H + (long)row * 1024 + n) = o;
    }
  }
}

__device__ __forceinline__ unsigned xcc_id() { return (unsigned)__builtin_amdgcn_s_getreg((3 << 11) | 20) & 7u; }
template <class CountF>
__device__ __forceinline__ int xq_take(unsigned* ctr, int& q, int& tried, unsigned first, CountF cnt) {
  unsigned j = first;
  for (;;) {
    if (j < (unsigned)cnt(q)) return (q << 20) | (int)j;
    q = (q + 1) & 7;
    if (++tried >= 8) return -1;
    j = atomicAdd(ctr + q * 16, 1u);
  }
}

__device__ __forceinline__ void phase_inproj(const Params& p, int l, bfr* sm, int* s_item, int slot) {
  const bfr* H = (const bfr*)(p.ws + WS_R1);
  const bfr* W = (const bfr*)(p.ws + WS_WIN);
  bfr* Z = (bfr*)(p.ws + WS_Z);
  const int tid = TIDX;
  const int lane = tid & 63, wid = tid >> 6, wr = wid >> 1, wc = wid & 1;
  unsigned* ctr = (unsigned*)(p.ws + WS_CTR) + slot * 128;
  auto cnt = [](int q) { return 96 * ((44 * (q + 1)) / 8 - (44 * q) / 8); };
  int q = (int)xcc_id(), tried = 0;
  unsigned nxt = 0;
  if (tid == 0) nxt = atomicAdd(ctr + q * 16, 1u);
  for (;;) {
    if (tid == 0) *s_item = xq_take(ctr, q, tried, nxt, cnt);
    __syncthreads();
    const int it = *s_item;
    __syncthreads();
    if (it < 0) break;
    const int qq = it >> 20, j = it & 0xfffff;
    if (tid == 0) nxt = atomicAdd(ctr + q * 16, 1u);
    const int tn0 = (44 * qq) / 8, w = (44 * (qq + 1)) / 8 - tn0;
    const int tm = j / w, tn = tn0 + j % w;
    f32x4 acc[5][4];
#pragma unroll
    for (int a = 0; a < 5; a++)
#pragma unroll
      for (int b = 0; b < 4; b++) acc[a][b] = (f32x4){0.f, 0.f, 0.f, 0.f};
    gemm160x128(W + (long)tn * 160 * 1024, 1024, ZLD - tn * 160, H + (long)tm * 128 * 1024, 1024, 1024, acc, sm);
    {
      const int g = lane >> 4, l15 = lane & 15;
#pragma unroll
      for (int pi = 0; pi < 5; pi++)
#pragma unroll
        for (int qi = 0; qi < 4; qi++) {
          u32x2 o;
          o.x = pack2(acc[pi][qi][0], acc[pi][qi][1]);
          o.y = pack2(acc[pi][qi][2], acc[pi][qi][3]);
          *(u32x2*)(sm + (wc * 64 + qi * 16 + l15) * 168 + wr * 80 + pi * 16 + g * 4) = o;
        }
      __syncthreads();
      const int ncol = min(20, (ZLD - tn * 160) >> 3);
#pragma unroll
      for (int i = 0; i < 10; i++) {
        int c = tid + 256 * i;
        int row = c / 20, c16 = c % 20;
        if (c16 < ncol)
          *(u32x4*)(Z + (long)(tm * 128 + row) * ZLD + tn * 160 + c16 * 8) = *(const u32x4*)(sm + row * 168 + c16 * 8);
      }
      __syncthreads();
    }
  }
}

__device__ __forceinline__ void unpack8(u32x4 v, float* x) {
  x[0] = lo16(v.x); x[1] = hi16(v.x); x[2] = lo16(v.y); x[3] = hi16(v.y);
  x[4] = lo16(v.z); x[5] = hi16(v.z); x[6] = lo16(v.w); x[7] = hi16(v.w);
}
__device__ __forceinline__ u32x4 pack8(const float* y) {
  u32x4 o;
  o.x = pack2(y[0], y[1]); o.y = pack2(y[2], y[3]); o.z = pack2(y[4], y[5]); o.w = pack2(y[6], y[7]);
  return o;
}

__device__ __forceinline__ void phase_rowpost(const Params& p, int l) {
  const int lane = TIDX & 63;
  bfr* Z = (bfr*)(p.ws + WS_Z);
  const float* rope = (const float*)(p.ws + WS_ROPE);
  bfr* VTA = (bfr*)(p.ws + WS_VTA);
  bfr* KCA = (bfr*)(p.ws + WS_KCA);
  bfr* CKVC = (bfr*)(p.ws + WS_CKVC);
  bfr* KRC = (bfr*)(p.ws + WS_KRC);
  float* out = p.out;
  for (int row = blockIdx.x * 4 + (TIDX >> 6); row < NROWS + 1024; row += gridDim.x * 4) {
    if (row < NROWS) {
      const bool lat = row >= NCTX;
      const int bc = row >> 8, tc = row & 255;
      const int bl = (row - NCTX) >> 12, tl = (row - NCTX) & 4095;
      const int prow = tl >> 6, pcol = tl & 63;
      bfr* z = Z + (long)row * ZLD;
      {
        float x[8];
        unpack8(*(const u32x4*)(z + C_QA + lane * 8), x);
        float ss = 0.f;
#pragma unroll
        for (int e = 0; e < 8; e++) ss += x[e] * x[e];
        ss += __shfl_xor(ss, 1); ss += __shfl_xor(ss, 2); ss += __shfl_xor(ss, 4);
        float rs = rsqrtf(ss * (1.f / 64.f) + 1e-6f);
        int sub = lane & 7;
        const float* g = p.in[15] + l * 64 + sub * 8;
#pragma unroll
        for (int e = 0; e < 8; e++) x[e] = x[e] * rs * g[e];
        if (lat) {
          int pos = (sub >> 2) ? pcol : prow;
          bool hi = (sub & 2) != 0;
          int i0 = (sub & 1) * 8;
#pragma unroll
          for (int e = 0; e < 8; e++) {
            float yp = __shfl_xor(x[e], 2);
            float c = rope[pos * 16 + i0 + e], s = rope[1024 + pos * 16 + i0 + e];
            x[e] = hi ? (yp * s + x[e] * c) : (x[e] * c - yp * s);
          }
        }
        const float qs = 0.125f * 1.4426950408889634f;
#pragma unroll
        for (int e = 0; e < 8; e++) x[e] *= qs;
        *(u32x4*)(z + C_QA + lane * 8) = pack8(x);
      }
      {
        int L = lane & 15;
        float x[8];
        unpack8(*(const u32x4*)(z + C_KA + L * 8), x);
        float ss = 0.f;
#pragma unroll
        for (int e = 0; e < 8; e++) ss += x[e] * x[e];
        ss += __shfl_xor(ss, 1); ss += __shfl_xor(ss, 2); ss += __shfl_xor(ss, 4);
        float rs = rsqrtf(ss * (1.f / 64.f) + 1e-6f);
        int sub = L & 7;
        const float* g = p.in[16] + l * 64 + sub * 8;
#pragma unroll
        for (int e = 0; e < 8; e++) x[e] = x[e] * rs * g[e];
        if (lat) {
          int pos = (sub >> 2) ? pcol : prow;
          bool hi = (sub & 2) != 0;
          int i0 = (sub & 1) * 8;
#pragma unroll
          for (int e = 0; e < 8; e++) {
            float yp = __shfl_xor(x[e], 2);
            float c = rope[pos * 16 + i0 + e], s = rope[1024 + pos * 16 + i0 + e];
            x[e] = hi ? (yp * s + x[e] * c) : (x[e] * c - yp * s);
          }
        } else if (lane < 16) {
          float* o = out + O_GK + ((long)(bc * 2 + l) * 256 + tc) * 128 + L * 8;
          *(float4*)(o) = make_float4(x[0], x[1], x[2], x[3]);
          *(float4*)(o + 4) = make_float4(x[4], x[5], x[6], x[7]);
        }
        if (lane < 16) *(u32x4*)(z + C_KA + L * 8) = pack8(x);
      }
      if (lane < 16) {
        int L = lane;
        u32x4 raw = *(const u32x4*)(z + C_VA + L * 8);
        float x[8];
        unpack8(raw, x);
        if (!lat) {
          float* o = out + O_GV + ((long)(bc * 2 + l) * 256 + tc) * 128 + L * 8;
          *(float4*)(o) = make_float4(x[0], x[1], x[2], x[3]);
          *(float4*)(o + 4) = make_float4(x[4], x[5], x[6], x[7]);
        }
        int g = L >> 3, d0 = (L & 7) * 8;
        long base; int nk, key;
        if (!lat) { base = (long)bc * 32768; nk = 256; key = tc; }
        else { base = 16l * 32768 + (long)bl * (2 * 64 * 4608); nk = 4608; key = 512 + tl; }
        const bfr* rb = (const bfr*)&raw;
#pragma unroll
        for (int e = 0; e < 8; e++) VTA[base + (long)(g * 64 + d0 + e) * nk + key] = rb[e];
      }
      {
        u32x2 rq = *(const u32x2*)(z + C_QL + lane * 4);
        u32x2 rk = *(const u32x2*)(z + C_KV + lane * 4);
        float q[4] = {lo16(rq.x), hi16(rq.x), lo16(rq.y), hi16(rq.y)};
        float k[4] = {lo16(rk.x), hi16(rk.x), lo16(rk.y), hi16(rk.y)};
        float sq = q[0] * q[0] + q[1] * q[1] + q[2] * q[2] + q[3] * q[3];
        float sk = k[0] * k[0] + k[1] * k[1] + k[2] * k[2] + k[3] * k[3];
        sq = wave_sum(sq);
        sk = wave_sum(sk);
        float rq_ = rsqrtf(sq * (1.f / 256.f) + 1e-6f), rk_ = rsqrtf(sk * (1.f / 256.f) + 1e-6f);
        float4 gq = *(const float4*)(p.in[22] + l * 256 + lane * 4);
        float4 gk = *(const float4*)(p.in[23] + l * 256 + lane * 4);
        q[0] *= rq_ * gq.x; q[1] *= rq_ * gq.y; q[2] *= rq_ * gq.z; q[3] *= rq_ * gq.w;
        k[0] *= rk_ * gk.x; k[1] *= rk_ * gk.y; k[2] *= rk_ * gk.z; k[3] *= rk_ * gk.w;
        u32x2 o;
        o.x = pack2(q[0], q[1]); o.y = pack2(q[2], q[3]);
        *(u32x2*)(z + C_QL + lane * 4) = o;
        o.x = pack2(k[0], k[1]); o.y = pack2(k[2], k[3]);
        *(u32x2*)(z + C_KV + lane * 4) = o;
        if (!lat) *(float4*)(out + O_CKV + ((long)(bc * 2 + l) * 256 + tc) * 256 + lane * 4) = make_float4(k[0], k[1], k[2], k[3]);
      }
      {
        int L = lane & 3;
        float x[8];
        unpack8(*(const u32x4*)(z + C_KR + L * 8), x);
        if (lat) {
          int pos = (L >> 1) ? pcol : prow;
          bool hi = (L & 1) != 0;
#pragma unroll
          for (int e = 0; e < 8; e++) {
            float yp = __shfl_xor(x[e], 1);
            float c = rope[2048 + pos * 8 + e], s = rope[2560 + pos * 8 + e];
            x[e] = hi ? (yp * s + x[e] * c) : (x[e] * c - yp * s);
          }
          if (lane < 4) *(u32x4*)(z + C_KR + L * 8) = pack8(x);
        } else if (lane < 4) {
          float* o = out + O_KR + ((long)(bc * 2 + l) * 256 + tc) * 32 + L * 8;
          *(float4*)(o) = make_float4(x[0], x[1], x[2], x[3]);
          *(float4*)(o + 4) = make_float4(x[4], x[5], x[6], x[7]);
        }
      }
    } else {
      int cr = row - NROWS;
      int b = cr >> 9, t = cr & 511;
      long src = (long)(b * 2 + l) * 512 + t;
      {
        float2 kv = *(const float2*)(p.in[2] + src * 128 + lane * 2);
        *(unsigned*)(KCA + (long)(b * 512 + t) * 128 + lane * 2) = pack2(kv.x, kv.y);
        float2 vv = *(const float2*)(p.in[3] + src * 128 + lane * 2);
        int c0 = lane * 2;
        long base = 16l * 32768 + (long)b * (2 * 64 * 4608);
        VTA[base + (long)c0 * 4608 + t] = f2bf(vv.x);
        VTA[base + (long)(c0 + 1) * 4608 + t] = f2bf(vv.y);
        float4 cv = *(const float4*)(p.in[4] + src * 256 + lane * 4);
        u32x2 o;
        o.x = pack2(cv.x, cv.y); o.y = pack2(cv.z, cv.w);
        *(u32x2*)(CKVC + (long)(b * 512 + t) * 256 + lane * 4) = o;
        if (lane < 32) KRC[(long)(b * 512 + t) * 32 + lane] = f2bf(p.in[5][src * 32 + lane]);
      }
    }
  }
}

#define WS_PREP1 251703296ul
#define WS_EL (WS_WIN + 12582912ul)
__device__ __forceinline__ bfr* prep_base(const Params& p, int b, int h, int dir, int c) {
  return (bfr*)(p.ws + (b ? WS_PREP1 : WS_WIN)) + (long)((h * 2 + dir) * 64 + c) * 12288;
}

__device__ __forceinline__ void gla_chunk_prep(int tid, const float (&wd)[16], float bias, const bfr* Qr, const bfr* Kr,
                                               bfr* Qe, bfr* Ke, bfr* KlT, const float* RF, float* tot, float* lastv) {
  const int ch = tid & 63, part = tid >> 6;
  float cum[16];
  {
    float run = 0.f;
#pragma unroll
    for (int ii = 0; ii < 16; ii++) {
      int i = part * 16 + ii;
      float x = bias;
#pragma unroll
      for (int r = 0; r < 16; r++) x += RF[i * 16 + r] * wd[r];
      float la = (fminf(x, 0.f) - __logf(1.f + __expf(-fabsf(x)))) * (1.f / 16.f);
      run += la;
      cum[ii] = run;
    }
    tot[part * 64 + ch] = run;
  }
  __syncthreads();
  {
    float off = 0.f, last = 0.f;
#pragma unroll
    for (int pp = 0; pp < 4; pp++) {
      float tv = tot[pp * 64 + ch];
      if (pp < part) off += tv;
      last += tv;
    }
    if (part == 0) lastv[ch] = last;
#pragma unroll
    for (int ii = 0; ii < 16; ii++) {
      int i = part * 16 + ii;
      float cc = cum[ii] + off;
      float qv = bf2f(Qr[i * LDT + ch]), kv = bf2f(Kr[i * LDT + ch]);
      Qe[i * LDT + ch] = f2bf(qv * __expf(cc) * 0.125f);
      Ke[i * LDT + ch] = f2bf(kv * __expf(-cc));
      KlT[ch * LDT + i] = f2bf(kv * __expf(last - cc));
    }
  }
  __syncthreads();
}

__device__ __forceinline__ void gla_att(int wid, int g, int l15, const bfr* Qe, const bfr* Ke, bfr* Att) {
  f32x4 att[4];
  bf16x8 qa[2];
#pragma unroll
  for (int kk = 0; kk < 2; kk++) qa[kk] = *(const bf16x8*)(Qe + (16 * wid + l15) * LDT + kk * 32 + g * 8);
#pragma unroll
  for (int nj = 0; nj < 4; nj++) {
    att[nj] = (f32x4){0.f, 0.f, 0.f, 0.f};
#pragma unroll
    for (int kk = 0; kk < 2; kk++) {
      bf16x8 kb = *(const bf16x8*)(Ke + (16 * nj + l15) * LDT + kk * 32 + g * 8);
      att[nj] = mfma16(qa[kk], kb, att[nj]);
    }
  }
#pragma unroll
  for (int nj = 0; nj < 4; nj++)
#pragma unroll
    for (int r = 0; r < 4; r++) {
      int i = 16 * wid + 4 * g + r, j = 16 * nj + l15;
      Att[i * LDT + j] = f2bf(i >= j ? att[nj][r] : 0.f);
    }
}

__device__ __forceinline__ void gla_prep_item(const Params& p, int l, int b, int h, int dir, int c, bfr* sm) {
  const int tid = TIDX, lane = tid & 63, wid = tid >> 6, g = lane >> 4, l15 = lane & 15;
  const bfr* Z = (const bfr*)(p.ws + WS_Z);
  const int N = 4096;
  const int rowbase = NCTX + b * 4096;
  bfr* Qr = sm;
  bfr* Kr = Qr + 64 * LDT;
  bfr* Qe = Kr + 64 * LDT;
  bfr* Ke = Qe + 64 * LDT;
  bfr* KlT = Ke + 64 * LDT;
  float* RF = (float*)(KlT + 64 * LDT);
  float* tot = RF + 64 * 16;
  float* lastv = tot + 256;
  bfr* Att = Qr;
  const int ch = tid & 63;
  float wd[16];
  {
    const float* W = (dir ? p.in[19] : p.in[17]) + (long)l * 16 * 256 + h * 64 + ch;
#pragma unroll
    for (int r = 0; r < 16; r++) wd[r] = W[r * 256];
  }
  const float bias = (dir ? p.in[20] : p.in[18])[l * 256 + h * 64 + ch];
#pragma unroll
  for (int ii = 0; ii < 2; ii++) {
    int cc = tid + 256 * ii;
    int i = cc >> 3, c8 = cc & 7;
    int tok = dir ? (N - 1 - (c * 64 + i)) : (c * 64 + i);
    const bfr* zr = Z + (long)(rowbase + tok) * ZLD;
    *(u32x4*)(Qr + i * LDT + c8 * 8) = *(const u32x4*)(zr + C_QG + h * 64 + c8 * 8);
    *(u32x4*)(Kr + i * LDT + c8 * 8) = *(const u32x4*)(zr + C_KG + h * 64 + c8 * 8);
  }
  if (tid < 128) {
    int i = tid >> 1, hf = tid & 1;
    int tok = dir ? (N - 1 - (c * 64 + i)) : (c * 64 + i);
    u32x4 rr = *(const u32x4*)(Z + (long)(rowbase + tok) * ZLD + (dir ? C_RB : C_RF) + hf * 8);
    float x[8];
    unpack8(rr, x);
#pragma unroll
    for (int e = 0; e < 8; e++) RF[i * 16 + hf * 8 + e] = x[e];
  }
  __syncthreads();
  gla_chunk_prep(tid, wd, bias, Qr, Kr, Qe, Ke, KlT, RF, tot, lastv);
  gla_att(wid, g, l15, Qe, Ke, Att);
  __syncthreads();
  bfr* dst = prep_base(p, b, h, dir, c);
#pragma unroll
  for (int ii = 0; ii < 2; ii++) {
    int cc = tid + 256 * ii;
    int i = cc >> 3, c8 = cc & 7;
    *(u32x4*)(dst + i * 64 + c8 * 8) = *(const u32x4*)(Qe + i * LDT + c8 * 8);
    *(u32x4*)(dst + 4096 + i * 64 + c8 * 8) = *(const u32x4*)(KlT + i * LDT + c8 * 8);
    *(u32x4*)(dst + 8192 + i * 64 + c8 * 8) = *(const u32x4*)(Att + i * LDT + c8 * 8);
  }
  if (tid < 64) ((float*)(p.ws + WS_EL))[((long)(((b * 4 + h) * 2 + dir) * 64 + c)) * 64 + tid] = __expf(lastv[tid]);
  __syncthreads();
}

__device__ __forceinline__ void gla_chain_item(const Params& p, int l, int b, int h, int dir, int vh, bfr* sm) {
  const int tid = TIDX, lane = tid & 63, wid = tid >> 6, g = lane >> 4, l15 = lane & 15;
  const bfr* Z = (const bfr*)(p.ws + WS_Z);
  bfr* OG = (bfr*)(p.ws + WS_R1) + (long)dir * NROWS * 512;
  const float* EL = (const float*)(p.ws + WS_EL) + (long)(((b * 4 + h) * 2 + dir) * 64) * 64;
  const int N = 4096, nc = 64;
  const int rowbase = NCTX + b * 4096;
  const int vs0 = vh * 64;
  bfr* Vt = sm;
  bfr* St = Vt + 64 * LDT;
  f32x4 st[4];
  {
    const float* S0 = (dir ? p.in[7] : p.in[6]) + ((long)((b * 2 + l) * 4 + h)) * 8192 + (long)(16 * wid + l15) * 128 + vs0;
#pragma unroll
    for (int vt = 0; vt < 4; vt++) {
      float4 a = *(const float4*)(S0 + 16 * vt + 4 * g);
      st[vt] = (f32x4){a.x, a.y, a.z, a.w};
#pragma unroll
      for (int r = 0; r < 4; r++) St[(16 * vt + 4 * g + r) * LDT + 16 * wid + l15] = f2bf(st[vt][r]);
    }
  }
  u32x4 n_qe[2], n_kl[2], n_at[2], n_v[2];
  float n_el;
  auto prefetch = [&](int c) {
    const bfr* base = prep_base(p, b, h, dir, c) + (16 * wid + l15) * 64 + 8 * g;
#pragma unroll
    for (int kk = 0; kk < 2; kk++) {
      n_qe[kk] = *(const u32x4*)(base + kk * 32);
      n_kl[kk] = *(const u32x4*)(base + 4096 + kk * 32);
      n_at[kk] = *(const u32x4*)(base + 8192 + kk * 32);
    }
    n_el = EL[c * 64 + 16 * wid + l15];
#pragma unroll
    for (int ii = 0; ii < 2; ii++) {
      int cc = tid + 256 * ii;
      int i = cc >> 3, c8 = cc & 7;
      int tok = dir ? (N - 1 - (c * 64 + i)) : (c * 64 + i);
      n_v[ii] = *(const u32x4*)(Z + (long)(rowbase + tok) * ZLD + C_VG + h * 128 + vs0 + c8 * 8);
    }
  };
  prefetch(0);
  for (int c = 0; c < nc; c++) {
    u32x4 c_qe[2] = {n_qe[0], n_qe[1]}, c_kl[2] = {n_kl[0], n_kl[1]}, c_at[2] = {n_at[0], n_at[1]};
    const float el = n_el;
#pragma unroll
    for (int ii = 0; ii < 2; ii++) {
      int cc = tid + 256 * ii;
      int i = cc >> 3, c8 = cc & 7;
      const bfr* rb = (const bfr*)&n_v[ii];
#pragma unroll
      for (int e = 0; e < 8; e++) Vt[(c8 * 8 + e) * LDT + i] = rb[e];
    }
    __syncthreads();
    if (c + 1 < nc) prefetch(c + 1);
    f32x4 stn[4];
    const int i = 16 * wid + l15;
    const int tok = dir ? (N - 1 - (c * 64 + i)) : (c * 64 + i);
    bfr* og = OG + (long)(rowbase + tok) * 512 + h * 128 + vs0 + 4 * g;
#pragma unroll
    for (int vt = 0; vt < 4; vt++) {
      f32x4 oc = (f32x4){0.f, 0.f, 0.f, 0.f};
      stn[vt] = st[vt] * el;
#pragma unroll
      for (int kk = 0; kk < 2; kk++) {
        bf16x8 vf = *(const bf16x8*)(Vt + (16 * vt + l15) * LDT + kk * 32 + g * 8);
        bf16x8 sf = *(const bf16x8*)(St + (16 * vt + l15) * LDT + kk * 32 + g * 8);
        oc = mfma16(vf, *(bf16x8*)&c_at[kk], oc);
        oc = mfma16(sf, *(bf16x8*)&c_qe[kk], oc);
        stn[vt] = mfma16(vf, *(bf16x8*)&c_kl[kk], stn[vt]);
      }
      u32x2 ov;
      ov.x = pack2(oc[0], oc[1]);
      ov.y = pack2(oc[2], oc[3]);
      *(u32x2*)(og + 16 * vt) = ov;
    }
    __syncthreads();
#pragma unroll
    for (int vt = 0; vt < 4; vt++) {
      st[vt] = stn[vt];
#pragma unroll
      for (int r = 0; r < 4; r++) St[(16 * vt + 4 * g + r) * LDT + 16 * wid + l15] = f2bf(st[vt][r]);
    }
  }
  __syncthreads();
}

template <int VS>
__device__ __forceinline__ void gla_item(const Params& p, int l, int seq, int h, int dir, int vsl, bfr* sm) {
  constexpr int NVT = VS / 16;
  constexpr int NVL = VS / 32;
  const int tid = TIDX, lane = tid & 63, wid = tid >> 6, g = lane >> 4, l15 = lane & 15;
  bfr* Z = (bfr*)(p.ws + WS_Z);
  bfr* OG = (bfr*)(p.ws + WS_R1) + (long)dir * NROWS * 512;
  const bool lat = seq >= 16;
  const int b = seq - 16;
  const int N = lat ? 4096 : 256;
  const int rowbase = lat ? NCTX + b * 4096 : seq * 256;
  const int nc = N >> 6;
  const int vs0 = vsl * VS;
  bfr* Qr = sm;
  bfr* Kr = Qr + 64 * LDT;
  bfr* Qe = Kr + 64 * LDT;
  bfr* Ke = Qe + 64 * LDT;
  bfr* KlT = Ke + 64 * LDT;
  float* RF = (float*)(KlT + 64 * LDT);
  float* tot = RF + 64 * 16;
  float* lastv = tot + 256;
  bfr* Vt = (bfr*)(lastv + 64);
  bfr* St = Vt + VS * LDT;
  bfr* Att = Qr;
  const int ch = tid & 63;
  float wd[16];
  {
    const float* W = (dir ? p.in[19] : p.in[17]) + (long)l * 16 * 256 + h * 64 + ch;
#pragma unroll
    for (int r = 0; r < 16; r++) wd[r] = W[r * 256];
  }
  const float bias = (dir ? p.in[20] : p.in[18])[l * 256 + h * 64 + ch];

  f32x4 st[NVT];
  {
    const float* S0 = (dir ? p.in[7] : p.in[6]) + ((long)((b * 2 + l) * 4 + h)) * 8192 + (long)(16 * wid + l15) * 128 + vs0;
#pragma unroll
    for (int mv = 0; mv < NVT; mv++) {
      if (lat) {
        float4 a = *(const float4*)(S0 + 16 * mv + 4 * g);
        st[mv] = (f32x4){a.x, a.y, a.z, a.w};
      } else {
        st[mv] = (f32x4){0.f, 0.f, 0.f, 0.f};
      }
#pragma unroll
      for (int r = 0; r < 4; r++) St[(16 * mv + 4 * g + r) * LDT + 16 * wid + l15] = f2bf(st[mv][r]);
    }
  }
  u32x4 rq[2], rk[2], rv[NVL], rr;
  auto prefetch = [&](int c) {
#pragma unroll
    for (int ii = 0; ii < 2; ii++) {
      int cc = tid + 256 * ii;
      int i = cc >> 3, c8 = cc & 7;
      int tok = dir ? (N - 1 - (c * 64 + i)) : (c * 64 + i);
      const bfr* zr = Z + (long)(rowbase + tok) * ZLD;
      rq[ii] = *(const u32x4*)(zr + C_QG + h * 64 + c8 * 8);
      rk[ii] = *(const u32x4*)(zr + C_KG + h * 64 + c8 * 8);
    }
#pragma unroll
    for (int ii = 0; ii < NVL; ii++) {
      int cc = tid + 256 * ii;
      int i = cc / (VS / 8), c4 = cc % (VS / 8);
      int tok = dir ? (N - 1 - (c * 64 + i)) : (c * 64 + i);
      rv[ii] = *(const u32x4*)(Z + (long)(rowbase + tok) * ZLD + C_VG + h * 128 + vs0 + c4 * 8);
    }
    if (tid < 128) {
      int i = tid >> 1, hf = tid & 1;
      int tok = dir ? (N - 1 - (c * 64 + i)) : (c * 64 + i);
      rr = *(const u32x4*)(Z + (long)(rowbase + tok) * ZLD + (dir ? C_RB : C_RF) + hf * 8);
    }
  };
  prefetch(0);
  for (int c = 0; c < nc; c++) {
#pragma unroll
    for (int ii = 0; ii < 2; ii++) {
      int cc = tid + 256 * ii;
      *(u32x4*)(Qr + (cc >> 3) * LDT + (cc & 7) * 8) = rq[ii];
      *(u32x4*)(Kr + (cc >> 3) * LDT + (cc & 7) * 8) = rk[ii];
    }
#pragma unroll
    for (int ii = 0; ii < NVL; ii++) {
      int cc = tid + 256 * ii;
      int i = cc / (VS / 8), c4 = cc % (VS / 8);
      const bfr* rb = (const bfr*)&rv[ii];
#pragma unroll
      for (int e = 0; e < 8; e++) Vt[(c4 * 8 + e) * LDT + i] = rb[e];
    }
    if (tid < 128) {
      int i = tid >> 1, hf = tid & 1;
      float x[8];
      unpack8(rr, x);
#pragma unroll
      for (int e = 0; e < 8; e++) RF[i * 16 + hf * 8 + e] = x[e];
    }
    __syncthreads();
    if (c + 1 < nc) prefetch(c + 1);
    gla_chunk_prep(tid, wd, bias, Qr, Kr, Qe, Ke, KlT, RF, tot, lastv);
    f32x4 stn[NVT];
    {
      float el = __expf(lastv[16 * wid + l15]);
#pragma unroll
      for (int mv = 0; mv < NVT; mv++) {
        stn[mv] = st[mv] * el;
#pragma unroll
        for (int kk = 0; kk < 2; kk++) {
          bf16x8 va = *(const bf16x8*)(Vt + (16 * mv + l15) * LDT + kk * 32 + g * 8);
          bf16x8 kb = *(const bf16x8*)(KlT + (16 * wid + l15) * LDT + kk * 32 + g * 8);
          stn[mv] = mfma16(va, kb, stn[mv]);
        }
      }
      gla_att(wid, g, l15, Qe, Ke, Att);
    }
    __syncthreads();
    {
      bf16x8 aa[2], qa[2];
#pragma unroll
      for (int kk = 0; kk < 2; kk++) {
        aa[kk] = *(const bf16x8*)(Att + (16 * wid + l15) * LDT + kk * 32 + g * 8);
        qa[kk] = *(const bf16x8*)(Qe + (16 * wid + l15) * LDT + kk * 32 + g * 8);
      }
#pragma unroll
      for (int nv = 0; nv < NVT; nv++) {
        f32x4 oc = (f32x4){0.f, 0.f, 0.f, 0.f};
#pragma unroll
        for (int kk = 0; kk < 2; kk++) {
          bf16x8 vb = *(const bf16x8*)(Vt + (16 * nv + l15) * LDT + kk * 32 + g * 8);
          oc = mfma16(aa[kk], vb, oc);
          bf16x8 sb = *(const bf16x8*)(St + (16 * nv + l15) * LDT + kk * 32 + g * 8);
          oc = mfma16(qa[kk], sb, oc);
        }
#pragma unroll
        for (int r = 0; r < 4; r++) {
          int i = 16 * wid + 4 * g + r;
          int tok = dir ? (N - 1 - (c * 64 + i)) : (c * 64 + i);
          OG[(long)(rowbase + tok) * 512 + h * 128 + vs0 + 16 * nv + l15] = f2bf(oc[r]);
        }
      }
    }
    __syncthreads();
#pragma unroll
    for (int mv = 0; mv < NVT; mv++) {
      st[mv] = stn[mv];
#pragma unroll
      for (int r = 0; r < 4; r++) St[(16 * mv + 4 * g + r) * LDT + 16 * wid + l15] = f2bf(st[mv][r]);
    }
  }
  __syncthreads();
  if (!lat) {
    float* so = p.out + (dir ? O_SB : O_SF) + ((long)((seq * 2 + l) * 4 + h)) * 8192 + (long)(16 * wid + l15) * 128 + vs0;
#pragma unroll
    for (int mv = 0; mv < NVT; mv++)
      *(float4*)(so + 16 * mv + 4 * g) = make_float4(st[mv][0], st[mv][1], st[mv][2], st[mv][3]);
  }
}

__device__ __forceinline__ void phase_mla_up(const Params& p, int l, bfr* sm) {
  bfr* Z = (bfr*)(p.ws + WS_Z);
  const float* rope = (const float*)(p.ws + WS_ROPE);
  const int lane = TIDX & 63, wid = TIDX >> 6, wr = wid >> 1, wc = wid & 1;
  const int g = lane >> 4;
  for (int t = blockIdx.x; t < 288 + 624 + 1024; t += gridDim.x) {
    if (t >= 912) {
      int i = t - 912;
      gla_prep_item(p, l, i >> 9, (i >> 7) & 3, (i >> 6) & 1, i & 63, sm);
      continue;
    }
    f32x4 acc[4][4];
#pragma unroll
    for (int a = 0; a < 4; a++)
#pragma unroll
      for (int b = 0; b < 4; b++) acc[a][b] = (f32x4){0.f, 0.f, 0.f, 0.f};
    if (t < 288) {
      int tn = t % 3, tm = t / 3;
      gemm128k64<4, true>((const bfr*)(p.ws + WS_WUQ) + (long)tn * 128 * 256, 256, 128, Z + (long)tm * 128 * ZLD + C_QL, ZLD, 256,
                    acc, sm);
      bfr* CQ = (bfr*)(p.ws + WS_CQ);
      const float qs = 0.10206207261596577f * 1.4426950408889634f;
#pragma unroll
      for (int pi = 0; pi < 4; pi++) {
        int nb = tn * 128 + wr * 64 + pi * 16;
        int wb = nb % 96;
        bool ropet = wb >= 64;
        int part = (wb - 64) >> 4;
#pragma unroll
        for (int qi = 0; qi < 4; qi++) {
          int tok = tm * 128 + wc * 64 + qi * 16 + (lane & 15);
          float y[4] = {acc[pi][qi][0], acc[pi][qi][1], acc[pi][qi][2], acc[pi][qi][3]};
          if (ropet) {
            bool lat = tok >= NCTX;
            int tl = (tok - NCTX) & 4095;
            int pos = part ? (tl & 63) : (tl >> 6);
            bool hi = (g & 2) != 0;
            int i0 = (g & 1) * 4;
#pragma unroll
            for (int r = 0; r < 4; r++) {
              float yp = __shfl_xor(y[r], 32);
              float c = rope[2048 + pos * 8 + i0 + r], s = rope[2560 + pos * 8 + i0 + r];
              float yr = hi ? (yp * s + y[r] * c) : (y[r] * c - yp * s);
              y[r] = lat ? yr : y[r];
            }
          }
          u32x2 o;
          o.x = pack2(y[0] * qs, y[1] * qs);
          o.y = pack2(y[2] * qs, y[3] * qs);
          *(u32x2*)(CQ + (long)tok * 384 + nb + g * 4) = o;
        }
      }
    } else {
      int t2 = t - 288;
      int tn = t2 % 6, tm = t2 / 6;
      const bfr* Q;
      long ldq;
      long kbase, vbase;
      int nk, key0;
      if (tm < 32) {
        Q = Z + (long)tm * 128 * ZLD + C_KV;
        ldq = ZLD;
        int s = tm >> 1;
        key0 = (tm & 1) * 128;
        nk = 256;
        kbase = (long)s * (4 * 256 * 64);
        vbase = (long)s * 131072;
      } else {
        int r = (tm - 32) * 128;
        int b = r / 4608, within = r % 4608;
        key0 = within;
        nk = 4608;
        kbase = 16l * (4 * 256 * 64) + (long)b * (4 * 4608 * 64);
        vbase = 16l * 131072 + (long)b * (4 * 128 * 4608);
        if (within < 512) {
          Q = (const bfr*)(p.ws + WS_CKVC) + (long)(b * 512 + within) * 256;
          ldq = 256;
        } else {
          Q = Z + (long)(NCTX + b * 4096 + within - 512) * ZLD + C_KV;
          ldq = ZLD;
        }
      }
      gemm128k64<4, true>((const bfr*)(p.ws + WS_WUKV) + (long)tn * 128 * 256, 256, 128, Q, ldq, 256, acc, sm);
      bfr* KN = (bfr*)(p.ws + WS_KNOPE);
      bfr* VTC = (bfr*)(p.ws + WS_VTC);
#pragma unroll
      for (int pi = 0; pi < 4; pi++) {
        int n0 = tn * 128 + wr * 64 + pi * 16 + g * 4;
        int head = n0 / 192, w = n0 % 192;
#pragma unroll
        for (int qi = 0; qi < 4; qi++) {
          int key = key0 + wc * 64 + qi * 16 + (lane & 15);
          if (w < 64) {
            u32x2 o;
            o.x = pack2(acc[pi][qi][0], acc[pi][qi][1]);
            o.y = pack2(acc[pi][qi][2], acc[pi][qi][3]);
            *(u32x2*)(KN + kbase + ((long)head * nk + key) * 64 + w) = o;
          } else {
#pragma unroll
            for (int r = 0; r < 4; r++)
              VTC[vbase + ((long)head * 128 + (w - 64) + r) * nk + key] = f2bf(acc[pi][qi][r]);
          }
        }
      }
    }
  }
}

template <int DQ, int DV, bool MLA, int NQB, bool DMA, int TP, bool LA = false>
__device__ __forceinline__ void attn_item(const Params& p, int seq, int head, int qoff, bfr* sm, int dry) {
  constexpr int KLD = DQ + 8;
  constexpr int KSZ = DMA ? (MLA ? 6144 : 4096) : 64 * KLD;
  constexpr int VSZ = DMA ? DV * 64 : DV * LDT;
  constexpr int BUF = KSZ + VSZ;
  constexpr int NKK = DQ / 32;
  constexpr int NDV = DV / 16;
  constexpr int NVL = DV / 32;
  const int tid = TIDX, lane = tid & 63, wid = tid >> 6, g = lane >> 4, l15 = lane & 15;
  bfr* Z = (bfr*)(p.ws + WS_Z);
  const int sK = 2 * (l15 >> 2) + ((l15 >> 1) & 1), sR = ((l15 >> 3) & 1) * 2, sV = l15 >> 1;
  auto kaddr = [&](const bfr* Ks, int krow, int kk) -> const bfr* {
    if (DMA) return (kk < 2) ? (Ks + krow * 64 + (((kk * 4 + g) ^ sK) * 8)) : (Ks + 4096 + krow * 32 + ((g ^ sR) * 8));
    return Ks + krow * KLD + kk * 32 + g * 8;
  };
  auto vaddr = [&](const bfr* Vs, int d, int sx) -> const bfr* {
    if (DMA) return Vs + (d * 16 + l15) * 64 + (((sx * 4 + g) ^ sV) * 8);
    return Vs + (d * 16 + l15) * LDT + sx * 32 + g * 8;
  };
  const bool lat = seq >= 16;
  const int b = seq - 16;
  const int nk = lat ? 4608 : 256;
  const int rowbase = lat ? NCTX + b * 4096 : seq * 256;
  const int nkt = nk >> 6;

  bf16x8 qf[NQB][NKK];
#pragma unroll
  for (int qb = 0; qb < NQB; qb++) {
    int qrow = rowbase + qoff + wid * (16 * NQB) + qb * 16 + l15;
    const bfr* qp = MLA ? ((const bfr*)(p.ws + WS_CQ) + (long)qrow * 384 + head * 96) : (Z + (long)qrow * ZLD + C_QA + head * 64);
#pragma unroll
    for (int kk = 0; kk < NKK; kk++) qf[qb][kk] = *(const bf16x8*)(qp + kk * 32 + g * 8);
  }

  u32x4 rk[TP][2], rkr[TP], rv[TP][NVL];
  auto prefetch = [&](int pi) {
#pragma unroll
   for (int u = 0; u < TP; u++) {
    int k0 = (pi * TP + u) * 64;
    bool cache = lat && (k0 < 512);
    int tokrow0 = lat ? (NCTX + b * 4096 + k0 - 512) : (seq * 256 + k0);
    if (!MLA) {
      int kvh = head >> 2;
#pragma unroll
      for (int i = 0; i < 2; i++) {
        int c = tid + 256 * i;
        int kr_ = c >> 3, ch = c & 7;
        const bfr* src = cache ? ((const bfr*)(p.ws + WS_KCA) + (long)(b * 512 + k0 + kr_) * 128 + kvh * 64 + ch * 8)
                               : (Z + (long)(tokrow0 + kr_) * ZLD + C_KA + kvh * 64 + ch * 8);
        rk[u][i] = *(const u32x4*)src;
      }
      long vb = lat ? (16l * 32768 + (long)b * (2 * 64 * 4608)) : ((long)seq * 32768);
#pragma unroll
      for (int i = 0; i < NVL; i++) {
        int c = tid + 256 * i;
        int dv = c >> 3, ch = c & 7;
        rv[u][i] = *(const u32x4*)((const bfr*)(p.ws + WS_VTA) + vb + (long)(kvh * 64 + dv) * nk + k0 + ch * 8);
      }
    } else {
      long kb = lat ? (16l * (4 * 256 * 64) + (long)b * (4 * 4608 * 64)) : ((long)seq * (4 * 256 * 64));
#pragma unroll
      for (int i = 0; i < 2; i++) {
        int c = tid + 256 * i;
        int kr_ = c >> 3, ch = c & 7;
        rk[u][i] = *(const u32x4*)((const bfr*)(p.ws + WS_KNOPE) + kb + ((long)head * nk + k0 + kr_) * 64 + ch * 8);
      }
      {
        int kr_ = tid >> 2, ch = tid & 3;
        const bfr* src = cache ? ((const bfr*)(p.ws + WS_KRC) + (long)(b * 512 + k0 + kr_) * 32 + ch * 8)
                               : (Z + (long)(tokrow0 + kr_) * ZLD + C_KR + ch * 8);
        rkr[u] = *(const u32x4*)src;
      }
      long vb = lat ? (16l * 131072 + (long)b * (4 * 128 * 4608)) : ((long)seq * 131072);
#pragma unroll
      for (int i = 0; i < NVL; i++) {
        int c = tid + 256 * i;
        int dv = c >> 3, ch = c & 7;
        rv[u][i] = *(const u32x4*)((const bfr*)(p.ws + WS_VTC) + vb + (long)(head * 128 + dv) * nk + k0 + ch * 8);
      }
    }
   }
  };

  f32x4 o[NQB][NDV];
#pragma unroll
  for (int qb = 0; qb < NQB; qb++)
#pragma unroll
    for (int d = 0; d < NDV; d++) o[qb][d] = (f32x4){0.f, 0.f, 0.f, 0.f};
  float mrun[NQB];
  f32x4 lacc[NQB];
#pragma unroll
  for (int qb = 0; qb < NQB; qb++) { mrun[qb] = 0.f; lacc[qb] = (f32x4){0.f, 0.f, 0.f, 0.f}; }
  const bf16x8 ones = (bf16x8){(short)0x3F80, (short)0x3F80, (short)0x3F80, (short)0x3F80, (short)0x3F80, (short)0x3F80, (short)0x3F80, (short)0x3F80};

  auto dma_issue = [&](int pi, bfr* stg0, bool doK = true, bool doV = true) {
#pragma unroll
   for (int u = 0; u < TP; u++) {
    bfr* stg = stg0 + u * BUF;
    const int k0 = (pi * TP + u) * 64;
    const bool cache = lat && (k0 < 512);
    const int tokrow0 = lat ? (NCTX + b * 4096 + k0 - 512) : (seq * 256 + k0);
    const int cK = (tid & 7) ^ (((tid >> 6) & 3) * 2 + ((tid >> 4) & 1));
    const int cV = (tid & 7) ^ ((tid >> 4) & 7);
    if (MLA) {
      const long kb = lat ? (16l * (4 * 256 * 64) + (long)b * (4 * 4608 * 64)) : ((long)seq * (4 * 256 * 64));
      const long vb = lat ? (16l * 131072 + (long)b * (4 * 128 * 4608)) : ((long)seq * 131072);
      if (doK) {
#pragma unroll
        for (int i = 0; i < 2; i++)
          glds16((const bfr*)(p.ws + WS_KNOPE) + kb + ((long)head * nk + k0 + i * 32 + (tid >> 3)) * 64 + cK * 8, stg + i * 2048 + tid * 8);
        const int row = tid >> 2, c = (tid & 3) ^ (((tid >> 6) & 1) * 2);
        const bfr* src = cache ? ((const bfr*)(p.ws + WS_KRC) + (long)(b * 512 + k0 + row) * 32 + c * 8)
                               : (Z + (long)(tokrow0 + row) * ZLD + C_KR + c * 8);
        glds16(src, stg + 4096 + tid * 8);
      }
      if (doV) {
#pragma unroll
        for (int i = 0; i < 4; i++)
          glds16((const bfr*)(p.ws + WS_VTC) + vb + (long)(head * 128 + i * 32 + (tid >> 3)) * nk + k0 + cV * 8, stg + 6144 + i * 2048 + tid * 8);
      }
    } else {
      const int kvh = head >> 2;
      const long vb = lat ? (16l * 32768 + (long)b * (2 * 64 * 4608)) : ((long)seq * 32768);
#pragma unroll
      for (int i = 0; i < 2; i++) {
        const int row = i * 32 + (tid >> 3);
        const bfr* src = cache ? ((const bfr*)(p.ws + WS_KCA) + (long)(b * 512 + k0 + row) * 128 + kvh * 64 + cK * 8)
                               : (Z + (long)(tokrow0 + row) * ZLD + C_KA + kvh * 64 + cK * 8);
        glds16(src, stg + i * 2048 + tid * 8);
      }
#pragma unroll
      for (int i = 0; i < 2; i++)
        glds16((const bfr*)(p.ws + WS_VTA) + vb + (long)(kvh * 64 + i * 32 + (tid >> 3)) * nk + k0 + cV * 8, stg + 4096 + i * 2048 + tid * 8);
    }
   }
  };
  auto qk = [&](const bfr* Ks, f32x4 (&sq)[NQB][4]) {
    bf16x8 kfr[4][NKK];
#pragma unroll
    for (int t = 0; t < 2; t++) {
      int krow = 32 * (t >> 1) + 8 * (l15 >> 2) + 4 * (t & 1) + (l15 & 3);
#pragma unroll
      for (int kk = 0; kk < NKK; kk++) kfr[t][kk] = *(const bf16x8*)kaddr(Ks, krow, kk);
    }
#pragma unroll
    for (int t = 0; t < 4; t++) {
#pragma unroll
      for (int qb = 0; qb < NQB; qb++) sq[qb][t] = (f32x4){-mrun[qb], -mrun[qb], -mrun[qb], -mrun[qb]};
      if (t + 2 < 4) {
        int krow = 32 * ((t + 2) >> 1) + 8 * (l15 >> 2) + 4 * ((t + 2) & 1) + (l15 & 3);
#pragma unroll
        for (int kk = 0; kk < NKK; kk++) kfr[t + 2][kk] = *(const bf16x8*)kaddr(Ks, krow, kk);
      }
#pragma unroll
      for (int kk = 0; kk < NKK; kk++) {
#pragma unroll
        for (int qb = 0; qb < NQB; qb++) sq[qb][t] = mfma16(kfr[t][kk], qf[qb][kk], sq[qb][t]);
      }
    }
  };
  auto smpv = [&](const bfr* Vs, bool first, f32x4 (&sc)[NQB][4], f32x4 (*later)[NQB][4], int nlater) {
    bf16x8 vfr[4][2];
#pragma unroll
    for (int d = 0; d < 4; d++)
#pragma unroll
      for (int sx = 0; sx < 2; sx++) vfr[d][sx] = *(const bf16x8*)vaddr(Vs, d, sx);
    bf16x8 pf[NQB][2];
#pragma unroll
    for (int qb = 0; qb < NQB; qb++) {
      float mt = sc[qb][0][0];
#pragma unroll
      for (int t = 0; t < 4; t++)
#pragma unroll
        for (int r = 0; r < 4; r++) mt = fmaxf(mt, sc[qb][t][r]);
      if (first || __builtin_amdgcn_ballot_w64(mt > 8.f) != 0ull) {
        mt = fmaxf(mt, __shfl_xor(mt, 16));
        mt = fmaxf(mt, __shfl_xor(mt, 32));
        const bool need = first || mt > 8.f;
        const float dm = need ? mt : 0.f;
        const float alpha = first ? 1.f : __builtin_amdgcn_exp2f(-dm);
        mrun[qb] += dm;
        lacc[qb] *= alpha;
#pragma unroll
        for (int d = 0; d < NDV; d++) o[qb][d] *= alpha;
#pragma unroll
        for (int t = 0; t < 4; t++) sc[qb][t] -= dm;
#pragma unroll
        for (int u2 = 0; u2 < 2; u2++)
          if (u2 < nlater) {
#pragma unroll
            for (int t = 0; t < 4; t++) later[u2][qb][t] -= dm;
          }
      }
#pragma unroll
      for (int t = 0; t < 4; t++)
#pragma unroll
        for (int r = 0; r < 4; r++) sc[qb][t][r] = __builtin_amdgcn_exp2f(sc[qb][t][r]);
#pragma unroll
      for (int sx = 0; sx < 2; sx++) {
        u32x4 uu;
        uu.x = pack2(sc[qb][2 * sx][0], sc[qb][2 * sx][1]);
        uu.y = pack2(sc[qb][2 * sx][2], sc[qb][2 * sx][3]);
        uu.z = pack2(sc[qb][2 * sx + 1][0], sc[qb][2 * sx + 1][1]);
        uu.w = pack2(sc[qb][2 * sx + 1][2], sc[qb][2 * sx + 1][3]);
        pf[qb][sx] = *(bf16x8*)&uu;
      }
    }
#pragma unroll
    for (int d = 0; d < NDV; d++) {
#pragma unroll
      for (int sx = 0; sx < 2; sx++) {
#pragma unroll
        for (int qb = 0; qb < NQB; qb++) o[qb][d] = mfma16(vfr[d & 3][sx], pf[qb][sx], o[qb][d]);
      }
      if (d + 4 < NDV) {
#pragma unroll
        for (int sx = 0; sx < 2; sx++) vfr[d & 3][sx] = *(const bf16x8*)vaddr(Vs, d + 4, sx);
      }
    }
#pragma unroll
    for (int sx = 0; sx < 2; sx++) {
#pragma unroll
      for (int qb = 0; qb < NQB; qb++) lacc[qb] = mfma16(ones, pf[qb][sx], lacc[qb]);
    }
  };

  if (LA) {
    bfr* st0 = sm;
    bfr* st1 = sm + BUF;
    dma_issue(0, st0, true, true);
    if (nkt > 1) dma_issue(1, st1, true, false);
    asm volatile("s_waitcnt vmcnt(0)" ::: "memory");
    __syncthreads();
    f32x4 scur[1][NQB][4], snext[1][NQB][4];
    qk(st0, scur[0]);
    __syncthreads();
    for (int j = 0; j < nkt; j++) {
      bfr* sj = (j & 1) ? st1 : st0;
      bfr* sn = (j & 1) ? st0 : st1;
      if (j + 1 < nkt) dma_issue(j + 1, sn, false, true);
      if (j + 2 < nkt) dma_issue(j + 2, sj, true, false);
      const bool more = (j + 1 < nkt);
      if (more) qk(sn, snext[0]);
      smpv(sj + KSZ, j == 0, scur[0], snext, more ? 1 : 0);
      if (more) {
#pragma unroll
        for (int qb = 0; qb < NQB; qb++)
#pragma unroll
          for (int t = 0; t < 4; t++) scur[0][qb][t] = snext[0][qb][t];
      }
      asm volatile("s_waitcnt vmcnt(0)" ::: "memory");
      __syncthreads();
    }
  } else {
  if (DMA) dma_issue(0, sm); else prefetch(0);
  const int np = nkt / TP;
  for (int pi = 0; pi < np; pi++) {
    bfr* base = sm + (pi & 1) * (TP * BUF);
    if (DMA) {
      asm volatile("s_waitcnt vmcnt(0)" ::: "memory");
      __syncthreads();
      if (pi + 1 < np) dma_issue(pi + 1, sm + ((pi + 1) & 1) * (TP * BUF));
    } else {
#pragma unroll
      for (int u = 0; u < TP; u++) {
        bfr* Ks = base + u * BUF;
        bfr* Vs = Ks + KSZ;
#pragma unroll
        for (int i = 0; i < 2; i++) {
          int c = tid + 256 * i;
          *(u32x4*)(Ks + (c >> 3) * KLD + (c & 7) * 8) = rk[u][i];
        }
        if (MLA) *(u32x4*)(Ks + (tid >> 2) * KLD + 64 + (tid & 3) * 8) = rkr[u];
#pragma unroll
        for (int i = 0; i < NVL; i++) {
          int c = tid + 256 * i;
          *(u32x4*)(Vs + (c >> 3) * LDT + (c & 7) * 8) = rv[u][i];
        }
      }
      __syncthreads();
      if (pi + 1 < np) prefetch(pi + 1);
    }
    f32x4 sa[TP][NQB][4];
#pragma unroll
    for (int u = 0; u < TP; u++) qk(base + u * BUF, sa[u]);
#pragma unroll
    for (int u = 0; u < TP; u++) smpv(base + u * BUF + KSZ, pi * TP + u == 0, sa[u], &sa[(u + 1 < TP) ? u + 1 : u], TP - 1 - u);
  }
  }
  __syncthreads();
#pragma unroll
  for (int qb = 0; qb < NQB; qb++) {
    float inv = 1.f / lacc[qb][0];
    int qrow = rowbase + qoff + wid * (16 * NQB) + qb * 16 + l15;
    bfr* gp = Z + (long)qrow * ZLD + (MLA ? C_GC : C_GA) + head * DV + g * 4;
#pragma unroll
    for (int d = 0; d < NDV; d++) {
      u32x2 gr = *(const u32x2*)(gp + d * 16);
      float y0 = o[qb][d][0] * inv * siluf(lo16(gr.x));
      float y1 = o[qb][d][1] * inv * siluf(hi16(gr.x));
      float y2 = o[qb][d][2] * inv * siluf(lo16(gr.y));
      float y3 = o[qb][d][3] * inv * siluf(hi16(gr.y));
      u32x2 ov;
      ov.x = pack2(y0, y1);
      ov.y = pack2(y2, y3);
      if (!dry) *(u32x2*)(gp + d * 16) = ov;
    }
  }
}

__device__ __forceinline__ void phase_mixers(const Params& p, int l, bfr* sm, int* s_item, int dry) {
  unsigned* ctr = (unsigned*)(p.ws + WS_CTR) + (2 + l + 2 * dry) * 128;
  auto cnt = [](int) { return 184; };
  int q = (int)xcc_id(), tried = 0;
  for (;;) {
    if (TIDX == 0) {
      unsigned first = atomicAdd(ctr + q * 16, 1u);
      *s_item = xq_take(ctr, q, tried, first, cnt);
    }
    __syncthreads();
    const int it = *s_item;
    __syncthreads();
    if (it < 0) break;
    const int x = it >> 20, j = it & 0xfffff;
    int kind, a0, a1, a2, a3 = 0;
    if (j < 4) {
      int idx = x * 4 + j;
      kind = 3; a0 = idx >> 4; a1 = (idx >> 2) & 3; a2 = (idx >> 1) & 1; a3 = idx & 1;
    } else if (j < 36) {
      kind = 1; a0 = 16 + (x >> 2); a1 = x & 3; a2 = (j - 4) * 128;
    } else if (j < 96) {
      int i = j - 36;
      kind = 2; a0 = 16 + (x >> 2); a1 = ((x >> 1) & 1) * 4 + (x & 1) * 2 + (i >> 5); a2 = (i & 31) * 128;
    } else if (j < 104) {
      int k = j - 96;
      int i = 60 + (k >> 1);
      kind = 4; a0 = 16 + (x >> 2); a1 = ((x >> 1) & 1) * 4 + (x & 1) * 2 + (i >> 5); a2 = (i & 31) * 128 + (k & 1) * 64;
    } else if (j < 136) {
      int i = j - 104;
      kind = 0; a0 = 2 * x + (i >> 4); a1 = (i >> 2) & 3; a2 = (i >> 1) & 1; a3 = i & 1;
    } else if (j < 152) {
      int i = j - 136;
      kind = 1; a0 = 2 * x + (i >> 3); a1 = (i >> 1) & 3; a2 = (i & 1) * 128;
    } else {
      int i = j - 152;
      kind = 2; a0 = 2 * x + (i >> 4); a1 = (i >> 1) & 7; a2 = (i & 1) * 128;
    }
#ifdef PROBE_MIXKIND
    if (dry && ((PROBE_MIXKIND == 1) != (kind == 0 || kind == 3))) continue;
#endif
    if (kind == 0) gla_item<64>(p, l, a0, a1, a2, a3, sm);
    else if (kind == 3) gla_chain_item(p, l, a0, a1, a2, a3, sm);
    else if (kind == 1) attn_item<96, 128, true, 2, true, 1, true>(p, a0, a1, a2, sm, dry);
    else if (kind == 2) attn_item<64, 64, false, 2, true, 2>(p, a0, a1, a2, sm, dry);
    else attn_item<64, 64, false, 1, true, 2>(p, a0, a1, a2, sm, dry);
  }
}

__device__ __forceinline__ void phase_gla_out(const Params& p, int l) {
  const int lane = TIDX & 63;
  bfr* Z = (bfr*)(p.ws + WS_Z);
  const bfr* OF = (const bfr*)(p.ws + WS_R1);
  const bfr* OB = OF + (long)NROWS * 512;
  for (int row = blockIdx.x * 4 + (TIDX >> 6); row < NROWS; row += gridDim.x * 4) {
    float a[8], c[8], gt[8];
    unpack8(*(const u32x4*)(OF + (long)row * 512 + lane * 8), a);
    unpack8(*(const u32x4*)(OB + (long)row * 512 + lane * 8), c);
    bfr* gp = Z + (long)row * ZLD + C_GG + lane * 8;
    unpack8(*(const u32x4*)gp, gt);
    float ss = 0.f;
#pragma unroll
    for (int e = 0; e < 8; e++) {
      a[e] = bf2f(f2bf(a[e] + c[e]));
      ss += a[e] * a[e];
    }
    ss += __shfl_xor(ss, 1); ss += __shfl_xor(ss, 2); ss += __shfl_xor(ss, 4); ss += __shfl_xor(ss, 8);
    float rs = rsqrtf(ss * (1.f / 128.f) + 1e-6f);
    const float* gg = p.in[21] + l * 128 + (lane & 15) * 8;
#pragma unroll
    for (int e = 0; e < 8; e++) a[e] = a[e] * rs * gg[e] * siluf(gt[e]);
    *(u32x4*)gp = pack8(a);
  }
}

template <int NQ>
__device__ __forceinline__ void merge_tile(const Params& p, bfr* sm, int tn, int tok0) {
  constexpr int STG = 8192 + 2048 * NQ;
  bfr* Z = (bfr*)(p.ws + WS_Z);
  bfr* MG = (bfr*)(p.ws + WS_R1);
  const int tid = TIDX;
  const int lane = tid & 63, wid = tid >> 6, wr = wid >> 1, wc = wid & 1, g = lane >> 4, l15 = lane & 15;
  f32x4 totl[4][NQ];
#pragma unroll
  for (int a = 0; a < 4; a++)
#pragma unroll
    for (int b = 0; b < NQ; b++) totl[a][b] = (f32x4){0.f, 0.f, 0.f, 0.f};
#pragma unroll 1
  for (int seg = 0; seg < 3; seg++) {
    f32x4 acc[4][NQ];
#pragma unroll
    for (int a = 0; a < 4; a++)
#pragma unroll
      for (int b = 0; b < NQ; b++) acc[a][b] = (f32x4){0.f, 0.f, 0.f, 0.f};
    int ycol = seg == 0 ? C_GA : (seg == 1 ? C_GG : C_GC);
    int mcol = C_M1 + seg * 1024;
    const bfr* W = (const bfr*)(p.ws + WS_WOA + (unsigned long)seg * 1048576ul) + (long)tn * 128 * 512;
    gemm128k64<NQ, false, true>(W, 512, 128, Z + (long)tok0 * ZLD + ycol, ZLD, 512, acc, sm,
                                Z + (long)tok0 * ZLD + mcol + tn * 128, ZLD);
    const bfr* gt = sm;
#pragma unroll
    for (int pi = 0; pi < 4; pi++) {
      const int nl = wr * 64 + pi * 16 + g * 4;
#pragma unroll
      for (int qi = 0; qi < NQ; qi++) {
        const int tl = wc * 16 * NQ + qi * 16 + l15;
        u32x2 mr = *(const u32x2*)(gt + tl * 128 + (((nl >> 3) ^ (tl & 15)) * 8) + (nl & 4));
        totl[pi][qi][0] += sigmf(lo16(mr.x)) * acc[pi][qi][0];
        totl[pi][qi][1] += sigmf(hi16(mr.x)) * acc[pi][qi][1];
        totl[pi][qi][2] += sigmf(lo16(mr.y)) * acc[pi][qi][2];
        totl[pi][qi][3] += sigmf(hi16(mr.y)) * acc[pi][qi][3];
      }
    }
    __syncthreads();
  }
#pragma unroll
  for (int pi = 0; pi < 4; pi++)
#pragma unroll
    for (int qi = 0; qi < NQ; qi++) {
      u32x2 o;
      o.x = pack2(totl[pi][qi][0], totl[pi][qi][1]);
      o.y = pack2(totl[pi][qi][2], totl[pi][qi][3]);
      *(u32x2*)(sm + (wc * 16 * NQ + qi * 16 + l15) * 136 + wr * 64 + pi * 16 + g * 4) = o;
    }
  __syncthreads();
#pragma unroll
  for (int i = 0; i < 2 * NQ; i++) {
    int c = tid + 256 * i;
    int row = c >> 4, c16 = c & 15;
    *(u32x4*)(MG + (long)(tok0 + row) * 1024 + tn * 128 + c16 * 8) = *(const u32x4*)(sm + row * 136 + c16 * 8);
  }
  __syncthreads();
}

__device__ __forceinline__ void phase_merge(const Params& p, bfr* sm) {
  for (int t = blockIdx.x; t < 1024; t += gridDim.x) {
    if (t < 512) {
      merge_tile<4>(p, sm, t & 7, (t >> 3) * 128);
    } else {
      int u = t - 512;
      int full = 512 + (u >> 1);
      merge_tile<2>(p, sm, full & 7, (full >> 3) * 128 + (u & 1) * 64);
    }
  }
}

template <int NQ>
__device__ __forceinline__ void outproj_tile(const Params& p, bfr* sm, int tn, int tok0) {
  const bfr* MG = (const bfr*)(p.ws + WS_R1);
  float* OUT = (float*)(p.ws + WS_Z);
  const int tid = TIDX;
  const int lane = tid & 63, wid = tid >> 6, wr = wid >> 1, wc = wid & 1, g = lane >> 4, l15 = lane & 15;
  f32x4 acc[4][NQ];
#pragma unroll
  for (int a = 0; a < 4; a++)
#pragma unroll
    for (int b = 0; b < NQ; b++) acc[a][b] = (f32x4){0.f, 0.f, 0.f, 0.f};
  gemm128k64<NQ, true>((const bfr*)(p.ws + WS_WOUT) + (long)tn * 128 * 1024, 1024, 128, MG + (long)tok0 * 1024, 1024, 1024, acc, sm);
  float* smf = (float*)sm;
#pragma unroll
  for (int pi = 0; pi < 4; pi++)
#pragma unroll
    for (int qi = 0; qi < NQ; qi++)
      *(f32x4*)(smf + (wc * 16 * NQ + qi * 16 + l15) * 132 + wr * 64 + pi * 16 + g * 4) = acc[pi][qi];
  __syncthreads();
#pragma unroll
  for (int i = 0; i < 4 * NQ; i++) {
    int c = tid + 256 * i;
    int row = c >> 5, c16 = c & 31;
    *(f32x4*)(OUT + (long)(tok0 + row) * 1024 + tn * 128 + c16 * 4) = *(const f32x4*)(smf + row * 132 + c16 * 4);
  }
  __syncthreads();
}
__device__ __forceinline__ void phase_outproj(const Params& p, bfr* sm) {
  for (int t = blockIdx.x; t < 1024; t += gridDim.x) {
    if (t < 512) {
      outproj_tile<4>(p, sm, t & 7, (t >> 3) * 128);
    } else {
      int u = t - 512;
      int full = 512 + (u >> 1);
      outproj_tile<2>(p, sm, full & 7, (full >> 3) * 128 + (u & 1) * 64);
    }
  }
}

__device__ __forceinline__ void phase_post(const Params& p, int l) {
  const int lane = TIDX & 63;
  const float* mod = (const float*)(p.ws + WS_MOD);
  const float* OUT = (const float*)(p.ws + WS_Z);
  bfr* H = (bfr*)(p.ws + WS_R1);
  for (int row = blockIdx.x * 4 + (TIDX >> 6); row < NROWS; row += gridDim.x * 4) {
    const float* x = (l == 0) ? xrow(p, row) : (p.out + (long)row * 1024);
    const float* md = mod + (l * 3 + row_cond(row)) * 3072;
    float4 v[4];
    float ss = 0.f;
#pragma unroll
    for (int i = 0; i < 4; i++) {
      v[i] = *(const float4*)(OUT + (long)row * 1024 + i * 256 + lane * 4);
      ss += v[i].x * v[i].x + v[i].y * v[i].y + v[i].z * v[i].z + v[i].w * v[i].w;
    }
    ss = wave_sum(ss);
    float rs = rsqrtf(ss * (1.f / 1024.f) + 1e-6f);
    float ss2 = 0.f;
#pragma unroll
    for (int i = 0; i < 4; i++) {
      int n = i * 256 + lane * 4;
      float4 g = *(const float4*)(p.in[13] + l * 1024 + n);
      float4 gt = *(const float4*)(md + 2048 + n);
      float4 xv = *(const float4*)(x + n);
      v[i].x = xv.x + gt.x * (v[i].x * rs * g.x);
      v[i].y = xv.y + gt.y * (v[i].y * rs * g.y);
      v[i].z = xv.z + gt.z * (v[i].z * rs * g.z);
      v[i].w = xv.w + gt.w * (v[i].w * rs * g.w);
      *(float4*)(p.out + (long)row * 1024 + n) = v[i];
      ss2 += v[i].x * v[i].x + v[i].y * v[i].y + v[i].z * v[i].z + v[i].w * v[i].w;
    }
    if (l == 0) {
      ss2 = wave_sum(ss2);
      float rs2 = rsqrtf(ss2 * (1.f / 1024.f) + 1e-6f);
      const float* md1 = mod + (1 * 3 + row_cond(row)) * 3072;
#pragma unroll
      for (int i = 0; i < 4; i++) {
        int n = i * 256 + lane * 4;
        float4 g = *(const float4*)(p.in[12] + 1024 + n);
        float4 sh = *(const float4*)(md1 + n);
        float4 sc = *(const float4*)(md1 + 1024 + n);
        float h0 = v[i].x * rs2 * g.x * (1.f + sc.x) + sh.x;
        float h1 = v[i].y * rs2 * g.y * (1.f + sc.y) + sh.y;
        float h2 = v[i].z * rs2 * g.z * (1.f + sc.z) + sh.z;
        float h3 = v[i].w * rs2 * g.w * (1.f + sc.w) + sh.w;
        u32x2 o;
        o.x = pack2(h0, h1);
        o.y = pack2(h2, h3);
        *(u32x2*)(H + (long)row * 1024 + n) = o;
      }
    }
  }
}

__global__ void __launch_bounds__(256, 2) fwd_megakernel(Params p) {
  __shared__ __attribute__((aligned(16))) bfr sm[SMEM_SHORTS + 16];
  int* s_item_p = (int*)(sm + SMEM_SHORTS + 8);
  cg::grid_group grid = cg::this_grid();
  if (threadIdx.x == 0) { ((unsigned*)(sm + SMEM_SHORTS))[0] = 0u; ((unsigned*)(sm + SMEM_SHORTS))[1] = 0u; }
  __syncthreads();
  XcdBarrier xb = xcd_barrier_post((unsigned*)(p.ws + WS_BAR), (volatile LAS unsigned*)(sm + SMEM_SHORTS));
  if (p.ws == nullptr) grid.sync();
  (void)xb;
#define GSYNC1 do { XcdBarrier b_; b_.bar = (unsigned*)(p.ws + WS_BAR); b_.x = xb_xcc_id(); \
                    b_.st = (volatile LAS unsigned*)(sm + SMEM_SHORTS); xcd_barrier(b_); } while (0)
#ifdef PROBE_SYNC
#define GSYNC do { GSYNC1; GSYNC1; } while (0)
#else
#define GSYNC GSYNC1
#endif
#ifdef PROBE_PRE
  phase_s0(launder(p), sm);
  GSYNC;
  phase_s1(launder(p));
  wconv_phase(p, 0, sm);
  GSYNC;
  phase_prenorm0(launder(p));
  GSYNC;
#endif

#ifndef PH
#define PH 0xffff
#endif
#if PH & 1
  phase_s0(launder(p), sm);
#endif
  GSYNC;
#if PH & 2
  phase_s1(launder(p));
  wconv_phase(p, 0, sm);
#endif
  GSYNC;
#if PH & 4
  phase_prenorm0(launder(p));
#endif
  GSYNC;
  for (int l = 0; l < 2; l++) {
#if PH & 8
#ifdef PROBE_INPROJ
    phase_inproj(launder(p), l, sm, s_item_p, 6 + l);
    GSYNC;
#endif
    phase_inproj(launder(p), l, sm, s_item_p, l);
#endif
    GSYNC;
#if PH & 16
    phase_rowpost(launder(p), l);
#endif
    GSYNC;
#if PH & 32
#ifdef PROBE_MLAUP
    phase_mla_up(launder(p), l, sm);
    GSYNC;
#endif
    phase_mla_up(launder(p), l, sm);
#endif
    GSYNC;
#if PH & 64
#ifdef PROBE_MIX
    { int dry = 1; asm volatile("" : "+s"(dry)); phase_mixers(launder(p), l, sm, s_item_p, dry); }
    GSYNC;
#endif
    { int dry = 0; asm volatile("" : "+s"(dry)); phase_mixers(launder(p), l, sm, s_item_p, dry); }
#endif
    GSYNC;
#if PH & 128
    phase_gla_out(launder(p), l);
#endif
    GSYNC;
#if PH & 256
#ifdef PROBE_MERGE
    phase_merge(launder(p), sm);
    GSYNC;
#endif
    phase_merge(launder(p), sm);
#endif
    GSYNC;
#if PH & 512
#ifdef PROBE_MERGE
    phase_outproj(launder(p), sm);
    GSYNC;
#endif
    phase_outproj(launder(p), sm);
#endif
    GSYNC;
#if PH & 1024
    phase_post(launder(p), l);
    if (l == 0) wconv_phase(p, 1, sm);
#endif
    if (l == 0) GSYNC;
  }
}

extern "C" void kernel_launch(void* const* d_in, const int* in_sizes, int n_in, void* d_out, int out_size, void* d_ws,
                              size_t ws_size, hipStream_t stream) {
  static int grid_blocks = 0;
  if (!grid_blocks) {
    int dev = 0, cus = 0, per_cu = 0;
    hipGetDevice(&dev);
    hipDeviceGetAttribute(&cus, hipDeviceAttributeMultiprocessorCount, dev);
    hipOccupancyMaxActiveBlocksPerMultiprocessor(&per_cu, fwd_megakernel, 256, 0);
    if (per_cu > 2) per_cu = 2;
    if (per_cu < 1) per_cu = 1;
    grid_blocks = cus * per_cu;
  }
  Params p{};
  for (int i = 0; i < 30; i++) p.in[i] = (const float*)d_in[i];
  p.out = (float*)d_out;
  p.ws = (unsigned char*)d_ws;
  hipMemsetAsync(d_ws, 0, 20480, stream);
  void* args[] = {&p};
  hipError_t e = hipLaunchCooperativeKernel((void*)fwd_megakernel, dim3(grid_blocks), dim3(256), args, 0, stream);
  if (e != hipSuccess) fprintf(stderr, "cooperative launch failed: %s (grid %d)\n", hipGetErrorString(e), grid_blocks);
}
```

```cpp
#include <hip/hip_runtime.h>
#include <hip/hip_cooperative_groups.h>
#include <cstdio>
namespace cg = cooperative_groups;

typedef unsigned short bfr;
typedef __attribute__((ext_vector_type(8))) short bf16x8;
typedef __attribute__((ext_vector_type(4))) float f32x4;
typedef __attribute__((ext_vector_type(4))) unsigned u32x4;
typedef __attribute__((ext_vector_type(2))) unsigned u32x2;

#define NROWS 12288
#define NCTX 4096
#define ZLD 6976
#define LDT 72
#define SMEM_SHORTS (4 * 128 * LDT)

#define C_QA 0
#define C_KA 512
#define C_VA 640
#define C_GA 768
#define C_QG 1280
#define C_KG 1536
#define C_VG 1792
#define C_GG 2304
#define C_RF 2816
#define C_RB 2832
#define C_QL 2848
#define C_KV 3104
#define C_KR 3360
#define C_GC 3392
#define C_M1 3904
#define C_M2 4928
#define C_M3 5952

#define WS_BAR 0ul
#define WS_CTR 16384ul
#define WS_MODP 20480ul
#define WS_MOD (WS_MODP + 589824ul)
#define WS_ROPE (WS_MOD + 73728ul)
#define WS_WIN (WS_ROPE + 16384ul)
#define WS_WUQ (WS_WIN + 14417920ul)
#define WS_WUKV (WS_WUQ + 196608ul)
#define WS_WOA (WS_WUKV + 393216ul)
#define WS_WOB (WS_WOA + 1048576ul)
#define WS_WOC (WS_WOB + 1048576ul)
#define WS_WOUT (WS_WOC + 1048576ul)
#define WS_KCA (WS_WOUT + 2097152ul)
#define WS_CKVC (WS_KCA + 262144ul)
#define WS_KRC (WS_CKVC + 524288ul)
#define WS_VTA (WS_KRC + 65536ul)
#define WS_CQ (WS_VTA + 3407872ul)
#define WS_KNOPE (WS_CQ + 9437184ul)
#define WS_VTC (WS_KNOPE + 6815744ul)
#define WS_R1 (WS_VTC + 13631488ul)
#define WS_Z (WS_R1 + 25165824ul)
#define WS_END (WS_Z + 171442176ul)

#define O_Y 0
#define O_GK 12582912
#define O_GV 13631488
#define O_CKV 14680064
#define O_KR 16777216
#define O_SF 17039360
#define O_SB 18087936

struct Params {
  const float* in[30];
  float* out;
  unsigned char* ws;
};

__device__ __forceinline__ int tidx() {
  int t = threadIdx.x;
  asm volatile("" : "+v"(t));
  return t;
}
__device__ __forceinline__ Params launder(const Params& p) {
  Params q;
  long zo = 0;
  asm volatile("" : "+s"(zo));
#pragma unroll
  for (int i = 0; i < 30; i++) q.in[i] = p.in[i] + zo;
  q.out = p.out + zo;
  q.ws = p.ws + zo;
  return q;
}
__device__ __forceinline__ float bf2f(bfr b) { return __uint_as_float(((unsigned)b) << 16); }
typedef float f32x2_t __attribute__((ext_vector_type(2)));
typedef __bf16 bf16x2_t __attribute__((ext_vector_type(2)));
__device__ __forceinline__ bfr f2bf(float f) {
  __bf16 r = (__bf16)f;
  return *(bfr*)&r;
}
__device__ __forceinline__ unsigned pack2(float a, float b) {
  f32x2_t v = {a, b};
  bf16x2_t r = __builtin_convertvector(v, bf16x2_t);
  return *(unsigned*)&r;
}
__device__ __forceinline__ float lo16(unsigned u) { return __uint_as_float(u << 16); }
__device__ __forceinline__ float hi16(unsigned u) { return __uint_as_float(u & 0xffff0000u); }
__device__ __forceinline__ float siluf(float x) { return x / (1.f + __expf(-x)); }
__device__ __forceinline__ float sigmf(float x) { return 1.f / (1.f + __expf(-x)); }
__device__ __forceinline__ f32x4 mfma16(bf16x8 a, bf16x8 b, f32x4 c) {
  return __builtin_amdgcn_mfma_f32_16x16x32_bf16(a, b, c, 0, 0, 0);
}
__device__ __forceinline__ const float* xrow(const Params& p, int row) {
  return row < NCTX ? p.in[0] + (long)row * 1024 : p.in[1] + (long)(row - NCTX) * 1024;
}
__device__ __forceinline__ int row_cond(int row) { return row < NCTX ? 0 : 1 + ((row - NCTX) >> 12); }
__device__ __forceinline__ float wave_sum(float v) {
  v += __shfl_xor(v, 1); v += __shfl_xor(v, 2); v += __shfl_xor(v, 4);
  v += __shfl_xor(v, 8); v += __shfl_xor(v, 16); v += __shfl_xor(v, 32);
  return v;
}

#define XB_TMO      128
#define XB_XCNT(j)  (256  + 64 * (j))
#define XB_XSUB(j)  (1280 + 64 * (j))
#define XB_XGEN(j)  (2304 + 64 * (j))
#define XB_TOP      3328
#define XB_TOPGEN   3392
#define XCD_BAR_WORDS 3456
#define XB_SPIN_CAP (1u << 18)
#define LAS __attribute__((address_space(3)))

__device__ __forceinline__ unsigned xb_ld(unsigned* p)              { return __hip_atomic_load(p, __ATOMIC_RELAXED, __HIP_MEMORY_SCOPE_AGENT); }
__device__ __forceinline__ unsigned xb_add(unsigned* p, unsigned v) { return __hip_atomic_fetch_add(p, v, __ATOMIC_RELAXED, __HIP_MEMORY_SCOPE_AGENT); }
__device__ __forceinline__ unsigned xb_xcc_id() { return (unsigned)__builtin_amdgcn_s_getreg((3 << 11) | 20) & 0xFu; }
#define XB_SPIN(cond, bar) do { unsigned _sp = 0; while (cond) { __builtin_amdgcn_s_sleep(1); \
    if ((++_sp & 255u) == 0u) { if (xb_ld(&(bar)[XB_TMO])) break; if (_sp > XB_SPIN_CAP) { atomicAdd(&(bar)[XB_TMO], 1u); break; } } } } while (0)

struct XcdBarrier {
    unsigned* bar; unsigned x;
    volatile LAS unsigned* st;
};

__device__ __forceinline__ XcdBarrier xcd_barrier_post(unsigned* bar, volatile LAS unsigned* st) {
    XcdBarrier b; b.bar = bar; b.x = xb_xcc_id(); b.st = st;
    if (threadIdx.x == 0) (void)xb_add(&bar[XB_XCNT(b.x)], 1u);
    return b;
}
__device__ __forceinline__ void xcd_barrier_complete(unsigned* bar, unsigned x, unsigned& nloc, unsigned& nx) {
    const unsigned G = gridDim.x * gridDim.y * gridDim.z;
    unsigned sum, cnt, mine, sp = 0u;
    for (;;) {
        sum = 0u; cnt = 0u; mine = 0u;
#pragma unroll
        for (unsigned j = 0; j < 16; ++j) { const unsigned c = xb_ld(&bar[XB_XCNT(j)]); sum += c; cnt += (c > 0u) ? 1u : 0u; mine = (j == x) ? c : mine; }
        if (sum == G) break;
        __builtin_amdgcn_s_sleep(1);
        if ((++sp & 255u) == 0u) { if (xb_ld(&bar[XB_TMO])) break; if (sp > XB_SPIN_CAP) { atomicAdd(&bar[XB_TMO], 1u); break; } }
    }
    nloc = mine > 0u ? mine : 1u; nx = cnt > 0u ? cnt : 1u;
}

__device__ __forceinline__ void xcd_barrier(const XcdBarrier& b) {
    asm volatile("s_waitcnt vmcnt(0)" ::: "memory");
    __syncthreads();
    if (threadIdx.x == 0) {
        unsigned* bar = b.bar;
        __builtin_amdgcn_s_waitcnt(0);
        unsigned nloc = b.st[0], nx = b.st[1];
        if (nloc == 0u) { xcd_barrier_complete(bar, b.x, nloc, nx); b.st[0] = nloc; b.st[1] = nx; }
        const unsigned old = xb_add(&bar[XB_XSUB(b.x)], 1u);
        const unsigned gen = old / nloc;
        if (old + 1u == (gen + 1u) * nloc) {
            __builtin_amdgcn_fence(__ATOMIC_RELEASE, "agent");
            asm volatile("s_waitcnt vmcnt(0)" ::: "memory");
            const unsigned og = xb_add(&bar[XB_TOP], 1u);
            const unsigned tg = og / nx;
            if (og + 1u == (tg + 1u) * nx) xb_add(&bar[XB_TOPGEN], 1u);
            else XB_SPIN(xb_ld(&bar[XB_TOPGEN]) == tg, bar);
            __builtin_amdgcn_fence(__ATOMIC_ACQUIRE, "agent");
            xb_add(&bar[XB_XGEN(b.x)], 1u);
            asm volatile("s_waitcnt vmcnt(0)" ::: "memory");
        } else {
            XB_SPIN(xb_ld(&bar[XB_XGEN(b.x)]) == gen, bar);
            __builtin_amdgcn_fence(__ATOMIC_ACQUIRE, "agent");
            asm volatile("s_waitcnt vmcnt(0)" ::: "memory");
        }
    }
    __syncthreads();
}


#define TIDX tidx()
#define LDS3 __attribute__((address_space(3)))
__device__ __forceinline__ void glds16(const bfr* g, bfr* l) {
  __builtin_amdgcn_global_load_lds((const unsigned*)g, (LDS3 unsigned*)l, 16, 0, 0);
}
__device__ __forceinline__ void gemm128(const bfr* __restrict__ P, long ldp, int pmax,
                                        const bfr* __restrict__ Q, long ldq, int qmax, int K,
                                        f32x4 (&acc)[4][4], bfr* sm) {
  const int tid = TIDX, lane = tid & 63, wid = tid >> 6;
  const int wr = wid >> 1, wc = wid & 1;
  const int l15 = lane & 15, g = lane >> 4;
  const bfr* pp[2];
  const bfr* qp[2];
  {
    const int r0 = tid >> 2;
    const int c = (tid & 3) ^ ((tid >> 4) & 3);
#pragma unroll
    for (int i = 0; i < 2; i++) {
      int r = r0 + 64 * i;
      pp[i] = P + (long)min(r, pmax - 1) * ldp + c * 8;
      qp[i] = Q + (long)min(r, qmax - 1) * ldq + c * 8;
    }
  }
  const int nk = K >> 5;
#define GEMM_ISSUE(T)                                                    \
  do {                                                                   \
    bfr* nb_ = sm + ((T) & 3) * 8192;                                    \
    glds16(pp[0] + (T) * 32, nb_ + tid * 8);                             \
    glds16(pp[1] + (T) * 32, nb_ + 2048 + tid * 8);                      \
    glds16(qp[0] + (T) * 32, nb_ + 4096 + tid * 8);                      \
    glds16(qp[1] + (T) * 32, nb_ + 6144 + tid * 8);                      \
  } while (0)
  GEMM_ISSUE(0);
  GEMM_ISSUE(1);
  GEMM_ISSUE(2);
  const int pos = (g ^ ((l15 >> 2) & 3)) * 8;
  for (int kt = 0; kt < nk; kt++) {
    if (kt + 2 < nk) asm volatile("s_waitcnt vmcnt(8)" ::: "memory");
    else if (kt + 1 < nk) asm volatile("s_waitcnt vmcnt(4)" ::: "memory");
    else asm volatile("s_waitcnt vmcnt(0)" ::: "memory");
    __builtin_amdgcn_s_barrier();
    if (kt + 3 < nk) GEMM_ISSUE(kt + 3);
    const bfr* Ps = sm + (kt & 3) * 8192;
    const bfr* Qs = Ps + 4096;
    bf16x8 pf[4], qf[4];
#pragma unroll
    for (int m = 0; m < 4; m++) {
      pf[m] = *(const bf16x8*)(Ps + (wr * 64 + m * 16 + l15) * 32 + pos);
      qf[m] = *(const bf16x8*)(Qs + (wc * 64 + m * 16 + l15) * 32 + pos);
    }
#pragma unroll
    for (int m = 0; m < 4; m++)
#pragma unroll
      for (int n = 0; n < 4; n++) acc[m][n] = mfma16(pf[m], qf[n], acc[m][n]);
  }
#undef GEMM_ISSUE
  __syncthreads();
}

template <int NQ>
__device__ __forceinline__ void gemm128q(const bfr* __restrict__ P, long ldp, const bfr* __restrict__ Q, long ldq, int K,
                                         f32x4 (&acc)[4][NQ], bfr* sm) {
  constexpr int QI = NQ / 2;
  constexpr int STG = 4096 + QI * 2048;
  const int tid = TIDX, lane = tid & 63, wid = tid >> 6;
  const int wr = wid >> 1, wc = wid & 1;
  const int l15 = lane & 15, g = lane >> 4;
  const bfr* pp[2];
  const bfr* qp[QI];
  {
    const int r0 = tid >> 2;
    const int c = (tid & 3) ^ (((tid >> 5) & 1) * 3);
#pragma unroll
    for (int i = 0; i < 2; i++) pp[i] = P + (long)(r0 + 64 * i) * ldp + c * 8;
#pragma unroll
    for (int i = 0; i < QI; i++) qp[i] = Q + (long)(r0 + 64 * i) * ldq + c * 8;
  }
  const int nk = K >> 5;
  auto issue = [&](int T) {
    bfr* nb_ = sm + (T & 3) * STG;
    glds16(pp[0] + T * 32, nb_ + tid * 8);
    glds16(pp[1] + T * 32, nb_ + 2048 + tid * 8);
#pragma unroll
    for (int i = 0; i < QI; i++) glds16(qp[i] + T * 32, nb_ + 4096 + i * 2048 + tid * 8);
  };
  issue(0);
  issue(1);
  issue(2);
  const int pos = (g ^ (((l15 >> 3) & 1) * 3)) * 8;
  for (int kt = 0; kt < nk; kt++) {
    if (kt + 2 < nk) {
      if (QI == 2) asm volatile("s_waitcnt vmcnt(8)" ::: "memory"); else asm volatile("s_waitcnt vmcnt(6)" ::: "memory");
    } else if (kt + 1 < nk) {
      if (QI == 2) asm volatile("s_waitcnt vmcnt(4)" ::: "memory"); else asm volatile("s_waitcnt vmcnt(3)" ::: "memory");
    } else {
      asm volatile("s_waitcnt vmcnt(0)" ::: "memory");
    }
    __builtin_amdgcn_s_barrier();
    if (kt + 3 < nk) issue(kt + 3);
    const bfr* Ps = sm + (kt & 3) * STG;
    const bfr* Qs = Ps + 4096;
    bf16x8 pf[4], qf[NQ];
#pragma unroll
    for (int m = 0; m < 4; m++) pf[m] = *(const bf16x8*)(Ps + (wr * 64 + m * 16 + l15) * 32 + pos);
#pragma unroll
    for (int n = 0; n < NQ; n++) qf[n] = *(const bf16x8*)(Qs + (wc * 16 * NQ + n * 16 + l15) * 32 + pos);
#pragma unroll
    for (int m = 0; m < 4; m++)
#pragma unroll
      for (int n = 0; n < NQ; n++) acc[m][n] = mfma16(pf[m], qf[n], acc[m][n]);
  }
  __syncthreads();
}

template <int NQ>
__device__ __forceinline__ void gemm256x128(const bfr* __restrict__ P, long ldp, int pmax,
                                            const bfr* __restrict__ Q, long ldq, int K,
                                            f32x4 (&acc)[8][NQ], bfr* sm) {
  constexpr int QI = NQ / 2;
  constexpr int STG = 8192 + QI * 2048;
  const int tid = TIDX, lane = tid & 63, wid = tid >> 6;
  const int wr = wid >> 1, wc = wid & 1;
  const int l15 = lane & 15, g = lane >> 4;
  const bfr* pp[4];
  const bfr* qp[QI];
  {
    const int r0 = tid >> 2;
    const int c = (tid & 3) ^ (((tid >> 5) & 1) * 3);
#pragma unroll
    for (int i = 0; i < 4; i++) pp[i] = P + (long)min(r0 + 64 * i, pmax - 1) * ldp + c * 8;
#pragma unroll
    for (int i = 0; i < QI; i++) qp[i] = Q + (long)(r0 + 64 * i) * ldq + c * 8;
  }
  const int nk = K >> 5;
  auto issue = [&](int T, int stg) {
    bfr* nb_ = sm + stg * STG;
    glds16(pp[0] + T * 32, nb_ + tid * 8);
    glds16(pp[1] + T * 32, nb_ + 2048 + tid * 8);
    glds16(pp[2] + T * 32, nb_ + 4096 + tid * 8);
    glds16(pp[3] + T * 32, nb_ + 6144 + tid * 8);
#pragma unroll
    for (int i = 0; i < QI; i++) glds16(qp[i] + T * 32, nb_ + 8192 + i * 2048 + tid * 8);
  };
  issue(0, 0);
  issue(1, 1);
  const int pos = (g ^ (((l15 >> 3) & 1) * 3)) * 8;
  int st = 0;
  for (int kt = 0; kt < nk; kt++) {
    if (kt + 1 < nk) {
      if (QI == 2) asm volatile("s_waitcnt vmcnt(6)" ::: "memory"); else asm volatile("s_waitcnt vmcnt(5)" ::: "memory");
    } else {
      asm volatile("s_waitcnt vmcnt(0)" ::: "memory");
    }
    __builtin_amdgcn_s_barrier();
    if (kt + 2 < nk) issue(kt + 2, st == 0 ? 2 : st - 1);
    const bfr* Ps = sm + st * STG;
    const bfr* Qs = Ps + 8192;
    st = (st == 2) ? 0 : st + 1;
    bf16x8 qf[NQ], pf[8];
#pragma unroll
    for (int n = 0; n < NQ; n++) qf[n] = *(const bf16x8*)(Qs + (wc * 16 * NQ + n * 16 + l15) * 32 + pos);
#pragma unroll
    for (int m = 0; m < 8; m++) pf[m] = *(const bf16x8*)(Ps + (wr * 128 + m * 16 + l15) * 32 + pos);
#pragma unroll
    for (int m = 0; m < 8; m++)
#pragma unroll
      for (int n = 0; n < NQ; n++) acc[m][n] = mfma16(pf[m], qf[n], acc[m][n]);
    __builtin_amdgcn_sched_group_barrier(0x100, NQ + 2, 0);
#pragma unroll
    for (int i = 0; i < 6; i++) {
      __builtin_amdgcn_sched_group_barrier(0x008, NQ, 0);
      __builtin_amdgcn_sched_group_barrier(0x100, 1, 0);
    }
    __builtin_amdgcn_sched_group_barrier(0x008, 2 * NQ, 0);
  }
  __syncthreads();
}

template <int NQ, bool PIPE, bool TAIL = false>
__device__ __forceinline__ void gemm128k64(const bfr* __restrict__ P, long ldp, int pmax,
                                           const bfr* __restrict__ Q, long ldq, int K,
                                           f32x4 (&acc)[4][NQ], bfr* sm, const bfr* tail_src = nullptr, long tail_ld = 0) {
  constexpr int STG = 8192 + 2048 * NQ;
  const int tid = TIDX, lane = tid & 63, wid = tid >> 6;
  const int wr = wid >> 1, wc = wid & 1;
  const int l15 = lane & 15, g = lane >> 4;
  const bfr* pp[4];
  const bfr* qp[NQ];
  {
    const int r0 = tid >> 3;
    const int c = (tid & 7) ^ ((tid >> 4) & 7);
#pragma unroll
    for (int i = 0; i < 4; i++) pp[i] = P + (long)min(r0 + 32 * i, pmax - 1) * ldp + c * 8;
#pragma unroll
    for (int i = 0; i < NQ; i++) qp[i] = Q + (long)(r0 + 32 * i) * ldq + c * 8;
  }
  const int nk = K >> 6;
#pragma unroll
  for (int i = 0; i < 4; i++) glds16(pp[i], sm + i * 2048 + tid * 8);
#pragma unroll
  for (int i = 0; i < NQ; i++) glds16(qp[i], sm + 8192 + i * 2048 + tid * 8);
  const int swz = l15 >> 1;
  for (int kt = 0; kt < nk; kt++) {
    asm volatile("s_waitcnt vmcnt(0)" ::: "memory");
    __builtin_amdgcn_s_barrier();
    if (kt + 1 < nk) {
      bfr* nb = sm + ((kt + 1) & 1) * STG;
#pragma unroll
      for (int i = 0; i < 4; i++) glds16(pp[i] + (kt + 1) * 64, nb + i * 2048 + tid * 8);
#pragma unroll
      for (int i = 0; i < NQ; i++) glds16(qp[i] + (kt + 1) * 64, nb + 8192 + i * 2048 + tid * 8);
    } else if (TAIL) {
      bfr* nb = sm + ((kt + 1) & 1) * STG;
      const bfr* ts = tail_src + (long)(tid >> 4) * tail_ld + (((tid & 15) ^ ((tid >> 4) & 15)) * 8);
#pragma unroll
      for (int i = 0; i < 2 * NQ; i++) glds16(ts + (long)(16 * i) * tail_ld, nb + i * 2048 + tid * 8);
    }
    const bfr* Ps = sm + (kt & 1) * STG;
    const bfr* Qs = Ps + 8192;
    if (PIPE) {
      bf16x8 pf[2][4], qf[2][NQ];
#pragma unroll
      for (int kk = 0; kk < 2; kk++) {
        const int pos = ((kk * 4 + g) ^ swz) * 8;
#pragma unroll
        for (int m = 0; m < 4; m++) pf[kk][m] = *(const bf16x8*)(Ps + (wr * 64 + m * 16 + l15) * 64 + pos);
#pragma unroll
        for (int n = 0; n < NQ; n++) qf[kk][n] = *(const bf16x8*)(Qs + (wc * 16 * NQ + n * 16 + l15) * 64 + pos);
      }
#pragma unroll
      for (int kk = 0; kk < 2; kk++)
#pragma unroll
        for (int m = 0; m < 4; m++)
#pragma unroll
          for (int n = 0; n < NQ; n++) acc[m][n] = mfma16(pf[kk][m], qf[kk][n], acc[m][n]);
      __builtin_amdgcn_sched_group_barrier(0x100, 4 + NQ, 0);
#pragma unroll
      for (int i = 0; i < 4 + NQ; i++) {
        __builtin_amdgcn_sched_group_barrier(0x008, NQ == 4 ? 2 : 1, 0);
        __builtin_amdgcn_sched_group_barrier(0x100, 1, 0);
      }
      __builtin_amdgcn_sched_group_barrier(0x008, NQ == 4 ? 16 : 10, 0);
    } else {
#pragma unroll
      for (int kk = 0; kk < 2; kk++) {
        bf16x8 pf[4], qf[NQ];
        const int pos = ((kk * 4 + g) ^ swz) * 8;
#pragma unroll
        for (int m = 0; m < 4; m++) pf[m] = *(const bf16x8*)(Ps + (wr * 64 + m * 16 + l15) * 64 + pos);
#pragma unroll
        for (int n = 0; n < NQ; n++) qf[n] = *(const bf16x8*)(Qs + (wc * 16 * NQ + n * 16 + l15) * 64 + pos);
#pragma unroll
        for (int m = 0; m < 4; m++)
#pragma unroll
          for (int n = 0; n < NQ; n++) acc[m][n] = mfma16(pf[m], qf[n], acc[m][n]);
      }
    }
  }
  if (TAIL) asm volatile("s_waitcnt vmcnt(0)" ::: "memory");
  __syncthreads();
}

__device__ __forceinline__ void gemm160x128(const bfr* __restrict__ P, long ldp, int pmax,
                                            const bfr* __restrict__ Q, long ldq, int K,
                                            f32x4 (&acc)[5][4], bfr* sm) {
  constexpr int STG = 160 * 64 + 128 * 64;
  const int tid = TIDX, lane = tid & 63, wid = tid >> 6;
  const int wr = wid >> 1, wc = wid & 1;
  const int l15 = lane & 15, g = lane >> 4;
  const bfr* pp[5];
  const bfr* qp[4];
  {
    const int r0 = tid >> 3;
    const int c = (tid & 7) ^ ((tid >> 4) & 7);
#pragma unroll
    for (int i = 0; i < 5; i++) pp[i] = P + (long)min(r0 + 32 * i, pmax - 1) * ldp + c * 8;
#pragma unroll
    for (int i = 0; i < 4; i++) qp[i] = Q + (long)(r0 + 32 * i) * ldq + c * 8;
  }
  const int nk = K >> 6;
#pragma unroll
  for (int i = 0; i < 5; i++) glds16(pp[i], sm + i * 2048 + tid * 8);
#pragma unroll
  for (int i = 0; i < 4; i++) glds16(qp[i], sm + 10240 + i * 2048 + tid * 8);
  const int swz = l15 >> 1;
  for (int kt = 0; kt < nk; kt++) {
    asm volatile("s_waitcnt vmcnt(0)" ::: "memory");
    __builtin_amdgcn_s_barrier();
    if (kt + 1 < nk) {
      bfr* nb = sm + ((kt + 1) & 1) * STG;
#pragma unroll
      for (int i = 0; i < 5; i++) glds16(pp[i] + (kt + 1) * 64, nb + i * 2048 + tid * 8);
#pragma unroll
      for (int i = 0; i < 4; i++) glds16(qp[i] + (kt + 1) * 64, nb + 10240 + i * 2048 + tid * 8);
    }
    const bfr* Ps = sm + (kt & 1) * STG;
    const bfr* Qs = Ps + 10240;
    bf16x8 pf[2][5], qf[2][4];
#pragma unroll
    for (int kk = 0; kk < 2; kk++) {
      const int pos = ((kk * 4 + g) ^ swz) * 8;
#pragma unroll
      for (int m = 0; m < 5; m++) pf[kk][m] = *(const bf16x8*)(Ps + (wr * 80 + m * 16 + l15) * 64 + pos);
#pragma unroll
      for (int n = 0; n < 4; n++) qf[kk][n] = *(const bf16x8*)(Qs + (wc * 64 + n * 16 + l15) * 64 + pos);
    }
#pragma unroll
    for (int kk = 0; kk < 2; kk++)
#pragma unroll
      for (int m = 0; m < 5; m++)
#pragma unroll
        for (int n = 0; n < 4; n++) acc[m][n] = mfma16(pf[kk][m], qf[kk][n], acc[m][n]);
    __builtin_amdgcn_sched_group_barrier(0x100, 9, 0);
#pragma unroll
    for (int i = 0; i < 9; i++) {
      __builtin_amdgcn_sched_group_barrier(0x008, 2, 0);
      __builtin_amdgcn_sched_group_barrier(0x100, 1, 0);
    }
    __builtin_amdgcn_sched_group_barrier(0x008, 22, 0);
  }
  __syncthreads();
}

__device__ __forceinline__ void phase_s0(const Params& p, bfr* sm) {
  const int tid = TIDX;
  float* rope = (float*)(p.ws + WS_ROPE);
  for (int idx = blockIdx.x * 256 + tid; idx < 1536; idx += gridDim.x * 256) {
    if (idx < 1024) {
      int pos = idx >> 4, i = idx & 15;
      float fr = powf(10000.f, -(float)i / 16.f);
      float a = (float)pos * fr;
      rope[idx] = cosf(a);
      rope[1024 + idx] = sinf(a);
    } else {
      int j = idx - 1024;
      int pos = j >> 3, i = j & 7;
      float fr = powf(10000.f, -(float)i / 8.f);
      float a = (float)pos * fr;
      rope[2048 + j] = cosf(a);
      rope[2560 + j] = sinf(a);
    }
  }
  float* smf = (float*)sm;
  float* modp = (float*)(p.ws + WS_MODP);
  for (int it = blockIdx.x; it < 768; it += gridDim.x) {
    int l = it / 384, rem = it % 384, cgp = rem >> 3, ks = rem & 7;
    int col = cgp * 64 + (tid & 63), kq = tid >> 6;
    const float* w = p.in[10] + (long)l * 1024 * 3072 + col;
    float a0 = 0.f, a1 = 0.f, a2 = 0.f;
    int k0 = ks * 128 + kq * 32;
#pragma unroll 8
    for (int k = k0; k < k0 + 32; k++) {
      float wv = w[(long)k * 3072];
      a0 += siluf(p.in[9][k]) * wv;
      a1 += siluf(p.in[8][k]) * wv;
      a2 += siluf(p.in[8][1024 + k]) * wv;
    }
    smf[(kq * 3 + 0) * 64 + (tid & 63)] = a0;
    smf[(kq * 3 + 1) * 64 + (tid & 63)] = a1;
    smf[(kq * 3 + 2) * 64 + (tid & 63)] = a2;
    __syncthreads();
    if (tid < 192) {
      int c = tid >> 6, cc = tid & 63;
      float s = smf[(0 * 3 + c) * 64 + cc] + smf[(1 * 3 + c) * 64 + cc] + smf[(2 * 3 + c) * 64 + cc] + smf[(3 * 3 + c) * 64 + cc];
      modp[((ks * 2 + l) * 3 + c) * 3072 + cgp * 64 + cc] = s;
    }
    __syncthreads();
  }
}

__device__ __forceinline__ void phase_s1(const Params& p) {
  float* modp = (float*)(p.ws + WS_MODP);
  float* mod = (float*)(p.ws + WS_MOD);
  for (int idx = blockIdx.x * 256 + TIDX; idx < 2 * 3 * 3072; idx += gridDim.x * 256) {
    int l = idx / 9216, n = idx % 3072;
    float s = p.in[11][l * 3072 + n];
#pragma unroll
    for (int ks = 0; ks < 8; ks++) s += modp[ks * 18432 + idx];
    mod[idx] = s;
  }
}

#define WCONV_ITEMS 2456
struct WcItem { const float* src; bfr* dst; int K, N, tk, tn; };
__device__ __forceinline__ WcItem wconv_decode(const Params& p, int l, int item) {
  WcItem w;
  if (item < 1744) {
    w.src = p.in[14] + (long)l * 1024 * 6976; w.K = 1024; w.N = 6976; w.dst = (bfr*)(p.ws + WS_WIN); w.tk = item & 15; w.tn = item >> 4;
  } else if (item < 1768) {
    item -= 1744;
    w.src = p.in[24] + (long)l * 256 * 384; w.K = 256; w.N = 384; w.dst = (bfr*)(p.ws + WS_WUQ); w.tk = item & 3; w.tn = item >> 2;
  } else if (item < 1816) {
    item -= 1768;
    w.src = p.in[25] + (long)l * 256 * 768; w.K = 256; w.N = 768; w.dst = (bfr*)(p.ws + WS_WUKV); w.tk = item & 3; w.tn = item >> 2;
  } else if (item < 2200) {
    item -= 1816;
    int ww = item >> 7, it = item & 127;
    w.src = (ww == 0 ? p.in[26] : (ww == 1 ? p.in[27] : p.in[28])) + (long)l * 512 * 1024;
    w.K = 512; w.N = 1024; w.dst = (bfr*)(p.ws + WS_WOA + (unsigned long)ww * 1048576ul); w.tk = it & 7; w.tn = it >> 3;
  } else {
    item -= 2200;
    w.src = p.in[29] + (long)l * 1024 * 1024; w.K = 1024; w.N = 1024; w.dst = (bfr*)(p.ws + WS_WOUT); w.tk = item & 15; w.tn = item >> 4;
  }
  return w;
}
__device__ __forceinline__ void wconv_phase(const Params& p, int l, bfr* sm) {
  bfr* sT = sm;
  const int tid = TIDX;
  const int n4 = (tid & 15) * 4, k0 = (tid >> 4) * 4;
  float4 v[4];
  int item = blockIdx.x;
  if (item < WCONV_ITEMS) {
    WcItem w = wconv_decode(p, l, item);
#pragma unroll
    for (int i = 0; i < 4; i++) v[i] = *(const float4*)(w.src + (long)(w.tk * 64 + k0 + i) * w.N + w.tn * 64 + n4);
  }
  const int wcol = (((k0 >> 3) ^ ((n4 >> 2) & 7)) * 8) + (k0 & 4);
  for (; item < WCONV_ITEMS; item += gridDim.x) {
    WcItem w = wconv_decode(p, l, item);
    {
      u32x2 o;
      o.x = pack2(v[0].x, v[1].x); o.y = pack2(v[2].x, v[3].x);
      *(u32x2*)(sT + (n4 + 0) * 64 + wcol) = o;
      o.x = pack2(v[0].y, v[1].y); o.y = pack2(v[2].y, v[3].y);
      *(u32x2*)(sT + (n4 + 1) * 64 + wcol) = o;
      o.x = pack2(v[0].z, v[1].z); o.y = pack2(v[2].z, v[3].z);
      *(u32x2*)(sT + (n4 + 2) * 64 + wcol) = o;
      o.x = pack2(v[0].w, v[1].w); o.y = pack2(v[2].w, v[3].w);
      *(u32x2*)(sT + (n4 + 3) * 64 + wcol) = o;
    }
    const int nitem = item + gridDim.x;
    if (nitem < WCONV_ITEMS) {
      WcItem wn = wconv_decode(p, l, nitem);
#pragma unroll
      for (int i = 0; i < 4; i++) v[i] = *(const float4*)(wn.src + (long)(wn.tk * 64 + k0 + i) * wn.N + wn.tn * 64 + n4);
    }
    __syncthreads();
#pragma unroll
    for (int i = 0; i < 2; i++) {
      int c = tid + 256 * i;
      int n = c >> 3, kc = c & 7;
      *(u32x4*)(w.dst + (long)(w.tn * 64 + n) * w.K + w.tk * 64 + kc * 8) = *(const u32x4*)(sT + n * 64 + ((kc ^ ((n >> 2) & 7)) * 8));
    }
    __syncthreads();
  }
}

__device__ __forceinline__ void phase_prenorm0(const Params& p) {
  const int lane = TIDX & 63;
  const float* mod = (const float*)(p.ws + WS_MOD);
  bfr* H = (bfr*)(p.ws + WS_R1);
  for (int row = blockIdx.x * 4 + (TIDX >> 6); row < NROWS; row += gridDim.x * 4) {
    const float* x = xrow(p, row);
    const float* md = mod + (0 * 3 + row_cond(row)) * 3072;
    float4 v[4];
    float ss = 0.f;
#pragma unroll
    for (int i = 0; i < 4; i++) {
      v[i] = *(const float4*)(x + i * 256 + lane * 4);
      ss += v[i].x * v[i].x + v[i].y * v[i].y + v[i].z * v[i].z + v[i].w * v[i].w;
    }
    ss = wave_sum(ss);
    float rs = rsqrtf(ss * (1.f / 1024.f) + 1e-6f);
#pragma unroll
    for (int i = 0; i < 4; i++) {
      int n = i * 256 + lane * 4;
      float4 g = *(const float4*)(p.in[12] + n);
      float4 sh = *(const float4*)(md + n);
      float4 sc = *(const float4*)(md + 1024 + n);
      float h0 = v[i].x * rs * g.x * (1.f + sc.x) + sh.x;
      float h1 = v[i].y * rs * g.y * (1.f + sc.y) + sh.y;
      float h2 = v[i].z * rs * g.z * (1.f + sc.z) + sh.z;
      float h3 = v[i].w * rs * g.w * (1.f + sc.w) + sh.w;
      u32x2 o;
      o.x = pack2(h0, h1);
      o.y = pack2(h2, h3);
      *(u32x2*)(H + (long)row * 1024 + n) = o;
    }
  }
}

__device__ __forceinline__ unsigned xcc_id() { return (unsigned)__builtin_amdgcn_s_getreg((3 << 11) | 20) & 7u; }
template <class CountF>
__device__ __forceinline__ int xq_take(unsigned* ctr, int& q, int& tried, unsigned first, CountF cnt) {
  unsigned j = first;
  for (;;) {
    if (j < (unsigned)cnt(q)) return (q << 20) | (int)j;
    q = (q + 1) & 7;
    if (++tried >= 8) return -1;
    j = atomicAdd(ctr + q * 16, 1u);
  }
}

__device__ __forceinline__ void phase_inproj(const Params& p, int l, bfr* sm, int* s_item, int slot) {
  const bfr* H = (const bfr*)(p.ws + WS_R1);
  const bfr* W = (const bfr*)(p.ws + WS_WIN);
  bfr* Z = (bfr*)(p.ws + WS_Z);
  const int tid = TIDX;
  const int lane = tid & 63, wid = tid >> 6, wr = wid >> 1, wc = wid & 1;
  unsigned* ctr = (unsigned*)(p.ws + WS_CTR) + slot * 128;
  auto cnt = [](int q) { return 96 * ((44 * (q + 1)) / 8 - (44 * q) / 8); };
  int q = (int)xcc_id(), tried = 0;
  unsigned nxt = 0;
  if (tid == 0) nxt = atomicAdd(ctr + q * 16, 1u);
  for (;;) {
    if (tid == 0) *s_item = xq_take(ctr, q, tried, nxt, cnt);
    __syncthreads();
    const int it = *s_item;
    __syncthreads();
    if (it < 0) break;
    const int qq = it >> 20, j = it & 0xfffff;
    if (tid == 0) nxt = atomicAdd(ctr + q * 16, 1u);
    const int tn0 = (44 * qq) / 8, w = (44 * (qq + 1)) / 8 - tn0;
    const int tm = j / w, tn = tn0 + j % w;
    f32x4 acc[5][4];
#pragma unroll
    for (int a = 0; a < 5; a++)
#pragma unroll
      for (int b = 0; b < 4; b++) acc[a][b] = (f32x4){0.f, 0.f, 0.f, 0.f};
    gemm160x128(W + (long)tn * 160 * 1024, 1024, ZLD - tn * 160, H + (long)tm * 128 * 1024, 1024, 1024, acc, sm);
    {
      const int g = lane >> 4, l15 = lane & 15;
#pragma unroll
      for (int pi = 0; pi < 5; pi++)
#pragma unroll
        for (int qi = 0; qi < 4; qi++) {
          u32x2 o;
          o.x = pack2(acc[pi][qi][0], acc[pi][qi][1]);
          o.y = pack2(acc[pi][qi][2], acc[pi][qi][3]);
          *(u32x2*)(sm + (wc * 64 + qi * 16 + l15) * 168 + wr * 80 + pi * 16 + g * 4) = o;
        }
      __syncthreads();
      const int ncol = min(20, (ZLD - tn * 160) >> 3);
#pragma unroll
      for (int i = 0; i < 10; i++) {
        int c = tid + 256 * i;
        int row = c / 20, c16 = c % 20;
        if (c16 < ncol)
          *(u32x4*)(Z + (long)(tm * 128 + row) * ZLD + tn * 160 + c16 * 8) = *(const u32x4*)(sm + row * 168 + c16 * 8);
      }
      __syncthreads();
    }
  }
}

__device__ __forceinline__ void unpack8(u32x4 v, float* x) {
  x[0] = lo16(v.x); x[1] = hi16(v.x); x[2] = lo16(v.y); x[3] = hi16(v.y);
  x[4] = lo16(v.z); x[5] = hi16(v.z); x[6] = lo16(v.w); x[7] = hi16(v.w);
}
__device__ __forceinline__ u32x4 pack8(const float* y) {
  u32x4 o;
  o.x = pack2(y[0], y[1]); o.y = pack2(y[2], y[3]); o.z = pack2(y[4], y[5]); o.w = pack2(y[6], y[7]);
  return o;
}

__device__ __forceinline__ void phase_rowpost(const Params& p, int l) {
  const int lane = TIDX & 63;
  bfr* Z = (bfr*)(p.ws + WS_Z);
  const float* rope = (const float*)(p.ws + WS_ROPE);
  bfr* VTA = (bfr*)(p.ws + WS_VTA);
  bfr* KCA = (bfr*)(p.ws + WS_KCA);
  bfr* CKVC = (bfr*)(p.ws + WS_CKVC);
  bfr* KRC = (bfr*)(p.ws + WS_KRC);
  float* out = p.out;
  for (int row = blockIdx.x * 4 + (TIDX >> 6); row < NROWS + 1024; row += gridDim.x * 4) {
    if (row < NROWS) {
      const bool lat = row >= NCTX;
      const int bc = row >> 8, tc = row & 255;
      const int bl = (row - NCTX) >> 12, tl = (row - NCTX) & 4095;
      const int prow = tl >> 6, pcol = tl & 63;
      bfr* z = Z + (long)row * ZLD;
      {
        float x[8];
        unpack8(*(const u32x4*)(z + C_QA + lane * 8), x);
        float ss = 0.f;
#pragma unroll
        for (int e = 0; e < 8; e++) ss += x[e] * x[e];
        ss += __shfl_xor(ss, 1); ss += __shfl_xor(ss, 2); ss += __shfl_xor(ss, 4);
        float rs = rsqrtf(ss * (1.f / 64.f) + 1e-6f);
        int sub = lane & 7;
        const float* g = p.in[15] + l * 64 + sub * 8;
#pragma unroll
        for (int e = 0; e < 8; e++) x[e] = x[e] * rs * g[e];
        if (lat) {
          int pos = (sub >> 2) ? pcol : prow;
          bool hi = (sub & 2) != 0;
          int i0 = (sub & 1) * 8;
#pragma unroll
          for (int e = 0; e < 8; e++) {
            float yp = __shfl_xor(x[e], 2);
            float c = rope[pos * 16 + i0 + e], s = rope[1024 + pos * 16 + i0 + e];
            x[e] = hi ? (yp * s + x[e] * c) : (x[e] * c - yp * s);
          }
        }
        const float qs = 0.125f * 1.4426950408889634f;
#pragma unroll
        for (int e = 0; e < 8; e++) x[e] *= qs;
        *(u32x4*)(z + C_QA + lane * 8) = pack8(x);
      }
      {
        int L = lane & 15;
        float x[8];
        unpack8(*(const u32x4*)(z + C_KA + L * 8), x);
        float ss = 0.f;
#pragma unroll
        for (int e = 0; e < 8; e++) ss += x[e] * x[e];
        ss += __shfl_xor(ss, 1); ss += __shfl_xor(ss, 2); ss += __shfl_xor(ss, 4);
        float rs = rsqrtf(ss * (1.f / 64.f) + 1e-6f);
        int sub = L & 7;
        const float* g = p.in[16] + l * 64 + sub * 8;
#pragma unroll
        for (int e = 0; e < 8; e++) x[e] = x[e] * rs * g[e];
        if (lat) {
          int pos = (sub >> 2) ? pcol : prow;
          bool hi = (sub & 2) != 0;
          int i0 = (sub & 1) * 8;
#pragma unroll
          for (int e = 0; e < 8; e++) {
            float yp = __shfl_xor(x[e], 2);
            float c = rope[pos * 16 + i0 + e], s = rope[1024 + pos * 16 + i0 + e];
            x[e] = hi ? (yp * s + x[e] * c) : (x[e] * c - yp * s);
          }
        } else if (lane < 16) {
          float* o = out + O_GK + ((long)(bc * 2 + l) * 256 + tc) * 128 + L * 8;
          *(float4*)(o) = make_float4(x[0], x[1], x[2], x[3]);
          *(float4*)(o + 4) = make_float4(x[4], x[5], x[6], x[7]);
        }
        if (lane < 16) *(u32x4*)(z + C_KA + L * 8) = pack8(x);
      }
      if (lane < 16) {
        int L = lane;
        u32x4 raw = *(const u32x4*)(z + C_VA + L * 8);
        float x[8];
        unpack8(raw, x);
        if (!lat) {
          float* o = out + O_GV + ((long)(bc * 2 + l) * 256 + tc) * 128 + L * 8;
          *(float4*)(o) = make_float4(x[0], x[1], x[2], x[3]);
          *(float4*)(o + 4) = make_float4(x[4], x[5], x[6], x[7]);
        }
        int g = L >> 3, d0 = (L & 7) * 8;
        long base; int nk, key;
        if (!lat) { base = (long)bc * 32768; nk = 256; key = tc; }
        else { base = 16l * 32768 + (long)bl * (2 * 64 * 4608); nk = 4608; key = 512 + tl; }
        const bfr* rb = (const bfr*)&raw;
#pragma unroll
        for (int e = 0; e < 8; e++) VTA[base + (long)(g * 64 + d0 + e) * nk + key] = rb[e];
      }
      {
        u32x2 rq = *(const u32x2*)(z + C_QL + lane * 4);
        u32x2 rk = *(const u32x2*)(z + C_KV + lane * 4);
        float q[4] = {lo16(rq.x), hi16(rq.x), lo16(rq.y), hi16(rq.y)};
        float k[4] = {lo16(rk.x), hi16(rk.x), lo16(rk.y), hi16(rk.y)};
        float sq = q[0] * q[0] + q[1] * q[1] + q[2] * q[2] + q[3] * q[3];
        float sk = k[0] * k[0] + k[1] * k[1] + k[2] * k[2] + k[3] * k[3];
        sq = wave_sum(sq);
        sk = wave_sum(sk);
        float rq_ = rsqrtf(sq * (1.f / 256.f) + 1e-6f), rk_ = rsqrtf(sk * (1.f / 256.f) + 1e-6f);
        float4 gq = *(const float4*)(p.in[22] + l * 256 + lane * 4);
        float4 gk = *(const float4*)(p.in[23] + l * 256 + lane * 4);
        q[0] *= rq_ * gq.x; q[1] *= rq_ * gq.y; q[2] *= rq_ * gq.z; q[3] *= rq_ * gq.w;
        k[0] *= rk_ * gk.x; k[1] *= rk_ * gk.y; k[2] *= rk_ * gk.z; k[3] *= rk_ * gk.w;
        u32x2 o;
        o.x = pack2(q[0], q[1]); o.y = pack2(q[2], q[3]);
        *(u32x2*)(z + C_QL + lane * 4) = o;
        o.x = pack2(k[0], k[1]); o.y = pack2(k[2], k[3]);
        *(u32x2*)(z + C_KV + lane * 4) = o;
        if (!lat) *(float4*)(out + O_CKV + ((long)(bc * 2 + l) * 256 + tc) * 256 + lane * 4) = make_float4(k[0], k[1], k[2], k[3]);
      }
      {
        int L = lane & 3;
        float x[8];
        unpack8(*(const u32x4*)(z + C_KR + L * 8), x);
        if (lat) {
          int pos = (L >> 1) ? pcol : prow;
          bool hi = (L & 1) != 0;
#pragma unroll
          for (int e = 0; e < 8; e++) {
            float yp = __shfl_xor(x[e], 1);
            float c = rope[2048 + pos * 8 + e], s = rope[2560 + pos * 8 + e];
            x[e] = hi ? (yp * s + x[e] * c) : (x[e] * c - yp * s);
          }
          if (lane < 4) *(u32x4*)(z + C_KR + L * 8) = pack8(x);
        } else if (lane < 4) {
          float* o = out + O_KR + ((long)(bc * 2 + l) * 256 + tc) * 32 + L * 8;
          *(float4*)(o) = make_float4(x[0], x[1], x[2], x[3]);
          *(float4*)(o + 4) = make_float4(x[4], x[5], x[6], x[7]);
        }
      }
    } else {
      int cr = row - NROWS;
      int b = cr >> 9, t = cr & 511;
      long src = (long)(b * 2 + l) * 512 + t;
      {
        float2 kv = *(const float2*)(p.in[2] + src * 128 + lane * 2);
        *(unsigned*)(KCA + (long)(b * 512 + t) * 128 + lane * 2) = pack2(kv.x, kv.y);
        float2 vv = *(const float2*)(p.in[3] + src * 128 + lane * 2);
        int c0 = lane * 2;
        long base = 16l * 32768 + (long)b * (2 * 64 * 4608);
        VTA[base + (long)c0 * 4608 + t] = f2bf(vv.x);
        VTA[base + (long)(c0 + 1) * 4608 + t] = f2bf(vv.y);
        float4 cv = *(const float4*)(p.in[4] + src * 256 + lane * 4);
        u32x2 o;
        o.x = pack2(cv.x, cv.y); o.y = pack2(cv.z, cv.w);
        *(u32x2*)(CKVC + (long)(b * 512 + t) * 256 + lane * 4) = o;
        if (lane < 32) KRC[(long)(b * 512 + t) * 32 + lane] = f2bf(p.in[5][src * 32 + lane]);
      }
    }
  }
}

#define WS_PREP1 251703296ul
#define WS_EL (WS_WIN + 12582912ul)
__device__ __forceinline__ bfr* prep_base(const Params& p, int b, int h, int dir, int c) {
  return (bfr*)(p.ws + (b ? WS_PREP1 : WS_WIN)) + (long)((h * 2 + dir) * 64 + c) * 12288;
}

__device__ __forceinline__ void gla_chunk_prep(int tid, const float (&wd)[16], float bias, const bfr* Qr, const bfr* Kr,
                                               bfr* Qe, bfr* Ke, bfr* KlT, const float* RF, float* tot, float* lastv) {
  const int ch = tid & 63, part = tid >> 6;
  float cum[16];
  {
    float run = 0.f;
#pragma unroll
    for (int ii = 0; ii < 16; ii++) {
      int i = part * 16 + ii;
      float x = bias;
#pragma unroll
      for (int r = 0; r < 16; r++) x += RF[i * 16 + r] * wd[r];
      float la = (fminf(x, 0.f) - __logf(1.f + __expf(-fabsf(x)))) * (1.f / 16.f);
      run += la;
      cum[ii] = run;
    }
    tot[part * 64 + ch] = run;
  }
  __syncthreads();
  {
    float off = 0.f, last = 0.f;
#pragma unroll
    for (int pp = 0; pp < 4; pp++) {
      float tv = tot[pp * 64 + ch];
      if (pp < part) off += tv;
      last += tv;
    }
    if (part == 0) lastv[ch] = last;
#pragma unroll
    for (int ii = 0; ii < 16; ii++) {
      int i = part * 16 + ii;
      float cc = cum[ii] + off;
      float qv = bf2f(Qr[i * LDT + ch]), kv = bf2f(Kr[i * LDT + ch]);
      Qe[i * LDT + ch] = f2bf(qv * __expf(cc) * 0.125f);
      Ke[i * LDT + ch] = f2bf(kv * __expf(-cc));
      KlT[ch * LDT + i] = f2bf(kv * __expf(last - cc));
    }
  }
  __syncthreads();
}

__device__ __forceinline__ void gla_att(int wid, int g, int l15, const bfr* Qe, const bfr* Ke, bfr* Att) {
  f32x4 att[4];
  bf16x8 qa[2];
#pragma unroll
  for (int kk = 0; kk < 2; kk++) qa[kk] = *(const bf16x8*)(Qe + (16 * wid + l15) * LDT + kk * 32 + g * 8);
#pragma unroll
  for (int nj = 0; nj < 4; nj++) {
    att[nj] = (f32x4){0.f, 0.f, 0.f, 0.f};
#pragma unroll
    for (int kk = 0; kk < 2; kk++) {
      bf16x8 kb = *(const bf16x8*)(Ke + (16 * nj + l15) * LDT + kk * 32 + g * 8);
      att[nj] = mfma16(qa[kk], kb, att[nj]);
    }
  }
#pragma unroll
  for (int nj = 0; nj < 4; nj++)
#pragma unroll
    for (int r = 0; r < 4; r++) {
      int i = 16 * wid + 4 * g + r, j = 16 * nj + l15;
      Att[i * LDT + j] = f2bf(i >= j ? att[nj][r] : 0.f);
    }
}

__device__ __forceinline__ void gla_prep_item(const Params& p, int l, int b, int h, int dir, int c, bfr* sm) {
  const int tid = TIDX, lane = tid & 63, wid = tid >> 6, g = lane >> 4, l15 = lane & 15;
  const bfr* Z = (const bfr*)(p.ws + WS_Z);
  const int N = 4096;
  const int rowbase = NCTX + b * 4096;
  bfr* Qr = sm;
  bfr* Kr = Qr + 64 * LDT;
  bfr* Qe = Kr + 64 * LDT;
  bfr* Ke = Qe + 64 * LDT;
  bfr* KlT = Ke + 64 * LDT;
  float* RF = (float*)(KlT + 64 * LDT);
  float* tot = RF + 64 * 16;
  float* lastv = tot + 256;
  bfr* Att = Qr;
  const int ch = tid & 63;
  float wd[16];
  {
    const float* W = (dir ? p.in[19] : p.in[17]) + (long)l * 16 * 256 + h * 64 + ch;
#pragma unroll
    for (int r = 0; r < 16; r++) wd[r] = W[r * 256];
  }
  const float bias = (dir ? p.in[20] : p.in[18])[l * 256 + h * 64 + ch];
#pragma unroll
  for (int ii = 0; ii < 2; ii++) {
    int cc = tid + 256 * ii;
    int i = cc >> 3, c8 = cc & 7;
    int tok = dir ? (N - 1 - (c * 64 + i)) : (c * 64 + i);
    const bfr* zr = Z + (long)(rowbase + tok) * ZLD;
    *(u32x4*)(Qr + i * LDT + c8 * 8) = *(const u32x4*)(zr + C_QG + h * 64 + c8 * 8);
    *(u32x4*)(Kr + i * LDT + c8 * 8) = *(const u32x4*)(zr + C_KG + h * 64 + c8 * 8);
  }
  if (tid < 128) {
    int i = tid >> 1, hf = tid & 1;
    int tok = dir ? (N - 1 - (c * 64 + i)) : (c * 64 + i);
    u32x4 rr = *(const u32x4*)(Z + (long)(rowbase + tok) * ZLD + (dir ? C_RB : C_RF) + hf * 8);
    float x[8];
    unpack8(rr, x);
#pragma unroll
    for (int e = 0; e < 8; e++) RF[i * 16 + hf * 8 + e] = x[e];
  }
  __syncthreads();
  gla_chunk_prep(tid, wd, bias, Qr, Kr, Qe, Ke, KlT, RF, tot, lastv);
  gla_att(wid, g, l15, Qe, Ke, Att);
  __syncthreads();
  bfr* dst = prep_base(p, b, h, dir, c);
#pragma unroll
  for (int ii = 0; ii < 2; ii++) {
    int cc = tid + 256 * ii;
    int i = cc >> 3, c8 = cc & 7;
    *(u32x4*)(dst + i * 64 + c8 * 8) = *(const u32x4*)(Qe + i * LDT + c8 * 8);
    *(u32x4*)(dst + 4096 + i * 64 + c8 * 8) = *(const u32x4*)(KlT + i * LDT + c8 * 8);
    *(u32x4*)(dst + 8192 + i * 64 + c8 * 8) = *(const u32x4*)(Att + i * LDT + c8 * 8);
  }
  if (tid < 64) ((float*)(p.ws + WS_EL))[((long)(((b * 4 + h) * 2 + dir) * 64 + c)) * 64 + tid] = __expf(lastv[tid]);
  __syncthreads();
}

__device__ __forceinline__ void gla_chain_item(const Params& p, int l, int b, int h, int dir, int vh, bfr* sm) {
  const int tid = TIDX, lane = tid & 63, wid = tid >> 6, g = lane >> 4, l15 = lane & 15;
  const bfr* Z = (const bfr*)(p.ws + WS_Z);
  bfr* OG = (bfr*)(p.ws + WS_R1) + (long)dir * NROWS * 512;
  const float* EL = (const float*)(p.ws + WS_EL) + (long)(((b * 4 + h) * 2 + dir) * 64) * 64;
  const int N = 4096, nc = 64;
  const int rowbase = NCTX + b * 4096;
  const int vs0 = vh * 64;
  bfr* Vt = sm;
  bfr* St = Vt + 64 * LDT;
  f32x4 st[4];
  {
    const float* S0 = (dir ? p.in[7] : p.in[6]) + ((long)((b * 2 + l) * 4 + h)) * 8192 + (long)(16 * wid + l15) * 128 + vs0;
#pragma unroll
    for (int vt = 0; vt < 4; vt++) {
      float4 a = *(const float4*)(S0 + 16 * vt + 4 * g);
      st[vt] = (f32x4){a.x, a.y, a.z, a.w};
#pragma unroll
      for (int r = 0; r < 4; r++) St[(16 * vt + 4 * g + r) * LDT + 16 * wid + l15] = f2bf(st[vt][r]);
    }
  }
  u32x4 n_qe[2], n_kl[2], n_at[2], n_v[2];
  float n_el;
  auto prefetch = [&](int c) {
    const bfr* base = prep_base(p, b, h, dir, c) + (16 * wid + l15) * 64 + 8 * g;
#pragma unroll
    for (int kk = 0; kk < 2; kk++) {
      n_qe[kk] = *(const u32x4*)(base + kk * 32);
      n_kl[kk] = *(const u32x4*)(base + 4096 + kk * 32);
      n_at[kk] = *(const u32x4*)(base + 8192 + kk * 32);
    }
    n_el = EL[c * 64 + 16 * wid + l15];
#pragma unroll
    for (int ii = 0; ii < 2; ii++) {
      int cc = tid + 256 * ii;
      int i = cc >> 3, c8 = cc & 7;
      int tok = dir ? (N - 1 - (c * 64 + i)) : (c * 64 + i);
      n_v[ii] = *(const u32x4*)(Z + (long)(rowbase + tok) * ZLD + C_VG + h * 128 + vs0 + c8 * 8);
    }
  };
  prefetch(0);
  for (int c = 0; c < nc; c++) {
    u32x4 c_qe[2] = {n_qe[0], n_qe[1]}, c_kl[2] = {n_kl[0], n_kl[1]}, c_at[2] = {n_at[0], n_at[1]};
    const float el = n_el;
#pragma unroll
    for (int ii = 0; ii < 2; ii++) {
      int cc = tid + 256 * ii;
      int i = cc >> 3, c8 = cc & 7;
      const bfr* rb = (const bfr*)&n_v[ii];
#pragma unroll
      for (int e = 0; e < 8; e++) Vt[(c8 * 8 + e) * LDT + i] = rb[e];
    }
    __syncthreads();
    if (c + 1 < nc) prefetch(c + 1);
    f32x4 stn[4];
    const int i = 16 * wid + l15;
    const int tok = dir ? (N - 1 - (c * 64 + i)) : (c * 64 + i);
    bfr* og = OG + (long)(rowbase + tok) * 512 + h * 128 + vs0 + 4 * g;
#pragma unroll
    for (int vt = 0; vt < 4; vt++) {
      f32x4 oc = (f32x4){0.f, 0.f, 0.f, 0.f};
      stn[vt] = st[vt] * el;
#pragma unroll
      for (int kk = 0; kk < 2; kk++) {
        bf16x8 vf = *(const bf16x8*)(Vt + (16 * vt + l15) * LDT + kk * 32 + g * 8);
        bf16x8 sf = *(const bf16x8*)(St + (16 * vt + l15) * LDT + kk * 32 + g * 8);
        oc = mfma16(vf, *(bf16x8*)&c_at[kk], oc);
        oc = mfma16(sf, *(bf16x8*)&c_qe[kk], oc);
        stn[vt] = mfma16(vf, *(bf16x8*)&c_kl[kk], stn[vt]);
      }
      u32x2 ov;
      ov.x = pack2(oc[0], oc[1]);
      ov.y = pack2(oc[2], oc[3]);
      *(u32x2*)(og + 16 * vt) = ov;
    }
    __syncthreads();
#pragma unroll
    for (int vt = 0; vt < 4; vt++) {
      st[vt] = stn[vt];
#pragma unroll
      for (int r = 0; r < 4; r++) St[(16 * vt + 4 * g + r) * LDT + 16 * wid + l15] = f2bf(st[vt][r]);
    }
  }
  __syncthreads();
}

template <int VS>
__device__ __forceinline__ void gla_item(const Params& p, int l, int seq, int h, int dir, int vsl, bfr* sm) {
  constexpr int NVT = VS / 16;
  constexpr int NVL = VS / 32;
  const int tid = TIDX, lane = tid & 63, wid = tid >> 6, g = lane >> 4, l15 = lane & 15;
  bfr* Z = (bfr*)(p.ws + WS_Z);
  bfr* OG = (bfr*)(p.ws + WS_R1) + (long)dir * NROWS * 512;
  const bool lat = seq >= 16;
  const int b = seq - 16;
  const int N = lat ? 4096 : 256;
  const int rowbase = lat ? NCTX + b * 4096 : seq * 256;
  const int nc = N >> 6;
  const int vs0 = vsl * VS;
  bfr* Qr = sm;
  bfr* Kr = Qr + 64 * LDT;
  bfr* Qe = Kr + 64 * LDT;
  bfr* Ke = Qe + 64 * LDT;
  bfr* KlT = Ke + 64 * LDT;
  float* RF = (float*)(KlT + 64 * LDT);
  float* tot = RF + 64 * 16;
  float* lastv = tot + 256;
  bfr* Vt = (bfr*)(lastv + 64);
  bfr* St = Vt + VS * LDT;
  bfr* Att = Qr;
  const int ch = tid & 63;
  float wd[16];
  {
    const float* W = (dir ? p.in[19] : p.in[17]) + (long)l * 16 * 256 + h * 64 + ch;
#pragma unroll
    for (int r = 0; r < 16; r++) wd[r] = W[r * 256];
  }
  const float bias = (dir ? p.in[20] : p.in[18])[l * 256 + h * 64 + ch];

  f32x4 st[NVT];
  {
    const float* S0 = (dir ? p.in[7] : p.in[6]) + ((long)((b * 2 + l) * 4 + h)) * 8192 + (long)(16 * wid + l15) * 128 + vs0;
#pragma unroll
    for (int mv = 0; mv < NVT; mv++) {
      if (lat) {
        float4 a = *(const float4*)(S0 + 16 * mv + 4 * g);
        st[mv] = (f32x4){a.x, a.y, a.z, a.w};
      } else {
        st[mv] = (f32x4){0.f, 0.f, 0.f, 0.f};
      }
#pragma unroll
      for (int r = 0; r < 4; r++) St[(16 * mv + 4 * g + r) * LDT + 16 * wid + l15] = f2bf(st[mv][r]);
    }
  }
  u32x4 rq[2], rk[2], rv[NVL], rr;
  auto prefetch = [&](int c) {
#pragma unroll
    for (int ii = 0; ii < 2; ii++) {
      int cc = tid + 256 * ii;
      int i = cc >> 3, c8 = cc & 7;
      int tok = dir ? (N - 1 - (c * 64 + i)) : (c * 64 + i);
      const bfr* zr = Z + (long)(rowbase + tok) * ZLD;
      rq[ii] = *(const u32x4*)(zr + C_QG + h * 64 + c8 * 8);
      rk[ii] = *(const u32x4*)(zr + C_KG + h * 64 + c8 * 8);
    }
#pragma unroll
    for (int ii = 0; ii < NVL; ii++) {
      int cc = tid + 256 * ii;
      int i = cc / (VS / 8), c4 = cc % (VS / 8);
      int tok = dir ? (N - 1 - (c * 64 + i)) : (c * 64 + i);
      rv[ii] = *(const u32x4*)(Z + (long)(rowbase + tok) * ZLD + C_VG + h * 128 + vs0 + c4 * 8);
    }
    if (tid < 128) {
      int i = tid >> 1, hf = tid & 1;
      int tok = dir ? (N - 1 - (c * 64 + i)) : (c * 64 + i);
      rr = *(const u32x4*)(Z + (long)(rowbase + tok) * ZLD + (dir ? C_RB : C_RF) + hf * 8);
    }
  };
  prefetch(0);
  for (int c = 0; c < nc; c++) {
#pragma unroll
    for (int ii = 0; ii < 2; ii++) {
      int cc = tid + 256 * ii;
      *(u32x4*)(Qr + (cc >> 3) * LDT + (cc & 7) * 8) = rq[ii];
      *(u32x4*)(Kr + (cc >> 3) * LDT + (cc & 7) * 8) = rk[ii];
    }
#pragma unroll
    for (int ii = 0; ii < NVL; ii++) {
      int cc = tid + 256 * ii;
      int i = cc / (VS / 8), c4 = cc % (VS / 8);
      const bfr* rb = (const bfr*)&rv[ii];
#pragma unroll
      for (int e = 0; e < 8; e++) Vt[(c4 * 8 + e) * LDT + i] = rb[e];
    }
    if (tid < 128) {
      int i = tid >> 1, hf = tid & 1;
      float x[8];
      unpack8(rr, x);
#pragma unroll
      for (int e = 0; e < 8; e++) RF[i * 16 + hf * 8 + e] = x[e];
    }
    __syncthreads();
    if (c + 1 < nc) prefetch(c + 1);
    gla_chunk_prep(tid, wd, bias, Qr, Kr, Qe, Ke, KlT, RF, tot, lastv);
    f32x4 stn[NVT];
    {
      float el = __expf(lastv[16 * wid + l15]);
#pragma unroll
      for (int mv = 0; mv < NVT; mv++) {
        stn[mv] = st[mv] * el;
#pragma unroll
        for (int kk = 0; kk < 2; kk++) {
          bf16x8 va = *(const bf16x8*)(Vt + (16 * mv + l15) * LDT + kk * 32 + g * 8);
          bf16x8 kb = *(const bf16x8*)(KlT + (16 * wid + l15) * LDT + kk * 32 + g * 8);
          stn[mv] = mfma16(va, kb, stn[mv]);
        }
      }
      gla_att(wid, g, l15, Qe, Ke, Att);
    }
    __syncthreads();
    {
      bf16x8 aa[2], qa[2];
#pragma unroll
      for (int kk = 0; kk < 2; kk++) {
        aa[kk] = *(const bf16x8*)(Att + (16 * wid + l15) * LDT + kk * 32 + g * 8);
        qa[kk] = *(const bf16x8*)(Qe + (16 * wid + l15) * LDT + kk * 32 + g * 8);
      }
#pragma unroll
      for (int nv = 0; nv < NVT; nv++) {
        f32x4 oc = (f32x4){0.f, 0.f, 0.f, 0.f};
#pragma unroll
        for (int kk = 0; kk < 2; kk++) {
          bf16x8 vb = *(const bf16x8*)(Vt + (16 * nv + l15) * LDT + kk * 32 + g * 8);
          oc = mfma16(aa[kk], vb, oc);
          bf16x8 sb = *(const bf16x8*)(St + (16 * nv + l15) * LDT + kk * 32 + g * 8);
          oc = mfma16(qa[kk], sb, oc);
        }
#pragma unroll
        for (int r = 0; r < 4; r++) {
          int i = 16 * wid + 4 * g + r;
          int tok = dir ? (N - 1 - (c * 64 + i)) : (c * 64 + i);
          OG[(long)(rowbase + tok) * 512 + h * 128 + vs0 + 16 * nv + l15] = f2bf(oc[r]);
        }
      }
    }
    __syncthreads();
#pragma unroll
    for (int mv = 0; mv < NVT; mv++) {
      st[mv] = stn[mv];
#pragma unroll
      for (int r = 0; r < 4; r++) St[(16 * mv + 4 * g + r) * LDT + 16 * wid + l15] = f2bf(st[mv][r]);
    }
  }
  __syncthreads();
  if (!lat) {
    float* so = p.out + (dir ? O_SB : O_SF) + ((long)((seq * 2 + l) * 4 + h)) * 8192 + (long)(16 * wid + l15) * 128 + vs0;
#pragma unroll
    for (int mv = 0; mv < NVT; mv++)
      *(float4*)(so + 16 * mv + 4 * g) = make_float4(st[mv][0], st[mv][1], st[mv][2], st[mv][3]);
  }
}

__device__ __forceinline__ void phase_mla_up(const Params& p, int l, bfr* sm) {
  bfr* Z = (bfr*)(p.ws + WS_Z);
  const float* rope = (const float*)(p.ws + WS_ROPE);
  const int lane = TIDX & 63, wid = TIDX >> 6, wr = wid >> 1, wc = wid & 1;
  const int g = lane >> 4;
  for (int t = blockIdx.x; t < 288 + 624 + 1024; t += gridDim.x) {
    if (t >= 912) {
      int i = t - 912;
      gla_prep_item(p, l, i >> 9, (i >> 7) & 3, (i >> 6) & 1, i & 63, sm);
      continue;
    }
    f32x4 acc[4][4];
#pragma unroll
    for (int a = 0; a < 4; a++)
#pragma unroll
      for (int b = 0; b < 4; b++) acc[a][b] = (f32x4){0.f, 0.f, 0.f, 0.f};
    if (t < 288) {
      int tn = t % 3, tm = t / 3;
      gemm128k64<4, true>((const bfr*)(p.ws + WS_WUQ) + (long)tn * 128 * 256, 256, 128, Z + (long)tm * 128 * ZLD + C_QL, ZLD, 256,
                    acc, sm);
      bfr* CQ = (bfr*)(p.ws + WS_CQ);
      const float qs = 0.10206207261596577f * 1.4426950408889634f;
#pragma unroll
      for (int pi = 0; pi < 4; pi++) {
        int nb = tn * 128 + wr * 64 + pi * 16;
        int wb = nb % 96;
        bool ropet = wb >= 64;
        int part = (wb - 64) >> 4;
#pragma unroll
        for (int qi = 0; qi < 4; qi++) {
          int tok = tm * 128 + wc * 64 + qi * 16 + (lane & 15);
          float y[4] = {acc[pi][qi][0], acc[pi][qi][1], acc[pi][qi][2], acc[pi][qi][3]};
          if (ropet) {
            bool lat = tok >= NCTX;
            int tl = (tok - NCTX) & 4095;
            int pos = part ? (tl & 63) : (tl >> 6);
            bool hi = (g & 2) != 0;
            int i0 = (g & 1) * 4;
#pragma unroll
            for (int r = 0; r < 4; r++) {
              float yp = __shfl_xor(y[r], 32);
              float c = rope[2048 + pos * 8 + i0 + r], s = rope[2560 + pos * 8 + i0 + r];
              float yr = hi ? (yp * s + y[r] * c) : (y[r] * c - yp * s);
              y[r] = lat ? yr : y[r];
            }
          }
          u32x2 o;
          o.x = pack2(y[0] * qs, y[1] * qs);
          o.y = pack2(y[2] * qs, y[3] * qs);
          *(u32x2*)(CQ + (long)tok * 384 + nb + g * 4) = o;
        }
      }
    } else {
      int t2 = t - 288;
      int tn = t2 % 6, tm = t2 / 6;
      const bfr* Q;
      long ldq;
      long kbase, vbase;
      int nk, key0;
      if (tm < 32) {
        Q = Z + (long)tm * 128 * ZLD + C_KV;
        ldq = ZLD;
        int s = tm >> 1;
        key0 = (tm & 1) * 128;
        nk = 256;
        kbase = (long)s * (4 * 256 * 64);
        vbase = (long)s * 131072;
      } else {
        int r = (tm - 32) * 128;
        int b = r / 4608, within = r % 4608;
        key0 = within;
        nk = 4608;
        kbase = 16l * (4 * 256 * 64) + (long)b * (4 * 4608 * 64);
        vbase = 16l * 131072 + (long)b * (4 * 128 * 4608);
        if (within < 512) {
          Q = (const bfr*)(p.ws + WS_CKVC) + (long)(b * 512 + within) * 256;
          ldq = 256;
        } else {
          Q = Z + (long)(NCTX + b * 4096 + within - 512) * ZLD + C_KV;
          ldq = ZLD;
        }
      }
      gemm128k64<4, true>((const bfr*)(p.ws + WS_WUKV) + (long)tn * 128 * 256, 256, 128, Q, ldq, 256, acc, sm);
      bfr* KN = (bfr*)(p.ws + WS_KNOPE);
      bfr* VTC = (bfr*)(p.ws + WS_VTC);
#pragma unroll
      for (int pi = 0; pi < 4; pi++) {
        int n0 = tn * 128 + wr * 64 + pi * 16 + g * 4;
        int head = n0 / 192, w = n0 % 192;
#pragma unroll
        for (int qi = 0; qi < 4; qi++) {
          int key = key0 + wc * 64 + qi * 16 + (lane & 15);
          if (w < 64) {
            u32x2 o;
            o.x = pack2(acc[pi][qi][0], acc[pi][qi][1]);
            o.y = pack2(acc[pi][qi][2], acc[pi][qi][3]);
            *(u32x2*)(KN + kbase + ((long)head * nk + key) * 64 + w) = o;
          } else {
#pragma unroll
            for (int r = 0; r < 4; r++)
              VTC[vbase + ((long)head * 128 + (w - 64) + r) * nk + key] = f2bf(acc[pi][qi][r]);
          }
        }
      }
    }
  }
}

template <int DQ, int DV, bool MLA, int NQB, bool DMA, int TP, bool LA = false>
__device__ __forceinline__ void attn_item(const Params& p, int seq, int head, int qoff, bfr* sm, int dry) {
  constexpr int KLD = DQ + 8;
  constexpr int KSZ = DMA ? (MLA ? 6144 : 4096) : 64 * KLD;
  constexpr int VSZ = DMA ? DV * 64 : DV * LDT;
  constexpr int BUF = KSZ + VSZ;
  constexpr int NKK = DQ / 32;
  constexpr int NDV = DV / 16;
  constexpr int NVL = DV / 32;
  const int tid = TIDX, lane = tid & 63, wid = tid >> 6, g = lane >> 4, l15 = lane & 15;
  bfr* Z = (bfr*)(p.ws + WS_Z);
  const int sK = 2 * (l15 >> 2) + ((l15 >> 1) & 1), sR = ((l15 >> 3) & 1) * 2, sV = l15 >> 1;
  auto kaddr = [&](const bfr* Ks, int krow, int kk) -> const bfr* {
    if (DMA) return (kk < 2) ? (Ks + krow * 64 + (((kk * 4 + g) ^ sK) * 8)) : (Ks + 4096 + krow * 32 + ((g ^ sR) * 8));
    return Ks + krow * KLD + kk * 32 + g * 8;
  };
  auto vaddr = [&](const bfr* Vs, int d, int sx) -> const bfr* {
    if (DMA) return Vs + (d * 16 + l15) * 64 + (((sx * 4 + g) ^ sV) * 8);
    return Vs + (d * 16 + l15) * LDT + sx * 32 + g * 8;
  };
  const bool lat = seq >= 16;
  const int b = seq - 16;
  const int nk = lat ? 4608 : 256;
  const int rowbase = lat ? NCTX + b * 4096 : seq * 256;
  const int nkt = nk >> 6;

  bf16x8 qf[NQB][NKK];
#pragma unroll
  for (int qb = 0; qb < NQB; qb++) {
    int qrow = rowbase + qoff + wid * (16 * NQB) + qb * 16 + l15;
    const bfr* qp = MLA ? ((const bfr*)(p.ws + WS_CQ) + (long)qrow * 384 + head * 96) : (Z + (long)qrow * ZLD + C_QA + head * 64);
#pragma unroll
    for (int kk = 0; kk < NKK; kk++) qf[qb][kk] = *(const bf16x8*)(qp + kk * 32 + g * 8);
  }

  u32x4 rk[TP][2], rkr[TP], rv[TP][NVL];
  auto prefetch = [&](int pi) {
#pragma unroll
   for (int u = 0; u < TP; u++) {
    int k0 = (pi * TP + u) * 64;
    bool cache = lat && (k0 < 512);
    int tokrow0 = lat ? (NCTX + b * 4096 + k0 - 512) : (seq * 256 + k0);
    if (!MLA) {
      int kvh = head >> 2;
#pragma unroll
      for (int i = 0; i < 2; i++) {
        int c = tid + 256 * i;
        int kr_ = c >> 3, ch = c & 7;
        const bfr* src = cache ? ((const bfr*)(p.ws + WS_KCA) + (long)(b * 512 + k0 + kr_) * 128 + kvh * 64 + ch * 8)
                               : (Z + (long)(tokrow0 + kr_) * ZLD + C_KA + kvh * 64 + ch * 8);
        rk[u][i] = *(const u32x4*)src;
      }
      long vb = lat ? (16l * 32768 + (long)b * (2 * 64 * 4608)) : ((long)seq * 32768);
#pragma unroll
      for (int i = 0; i < NVL; i++) {
        int c = tid + 256 * i;
        int dv = c >> 3, ch = c & 7;
        rv[u][i] = *(const u32x4*)((const bfr*)(p.ws + WS_VTA) + vb + (long)(kvh * 64 + dv) * nk + k0 + ch * 8);
      }
    } else {
      long kb = lat ? (16l * (4 * 256 * 64) + (long)b * (4 * 4608 * 64)) : ((long)seq * (4 * 256 * 64));
#pragma unroll
      for (int i = 0; i < 2; i++) {
        int c = tid + 256 * i;
        int kr_ = c >> 3, ch = c & 7;
        rk[u][i] = *(const u32x4*)((const bfr*)(p.ws + WS_KNOPE) + kb + ((long)head * nk + k0 + kr_) * 64 + ch * 8);
      }
      {
        int kr_ = tid >> 2, ch = tid & 3;
        const bfr* src = cache ? ((const bfr*)(p.ws + WS_KRC) + (long)(b * 512 + k0 + kr_) * 32 + ch * 8)
                               : (Z + (long)(tokrow0 + kr_) * ZLD + C_KR + ch * 8);
        rkr[u] = *(const u32x4*)src;
      }
      long vb = lat ? (16l * 131072 + (long)b * (4 * 128 * 4608)) : ((long)seq * 131072);
#pragma unroll
      for (int i = 0; i < NVL; i++) {
        int c = tid + 256 * i;
        int dv = c >> 3, ch = c & 7;
        rv[u][i] = *(const u32x4*)((const bfr*)(p.ws + WS_VTC) + vb + (long)(head * 128 + dv) * nk + k0 + ch * 8);
      }
    }
   }
  };

  f32x4 o[NQB][NDV];
#pragma unroll
  for (int qb = 0; qb < NQB; qb++)
#pragma unroll
    for (int d = 0; d < NDV; d++) o[qb][d] = (f32x4){0.f, 0.f, 0.f, 0.f};
  float mrun[NQB];
  f32x4 lacc[NQB];
#pragma unroll
  for (int qb = 0; qb < NQB; qb++) { mrun[qb] = 0.f; lacc[qb] = (f32x4){0.f, 0.f, 0.f, 0.f}; }
  const bf16x8 ones = (bf16x8){(short)0x3F80, (short)0x3F80, (short)0x3F80, (short)0x3F80, (short)0x3F80, (short)0x3F80, (short)0x3F80, (short)0x3F80};

  auto dma_issue = [&](int pi, bfr* stg0, bool doK = true, bool doV = true) {
#pragma unroll
   for (int u = 0; u < TP; u++) {
    bfr* stg = stg0 + u * BUF;
    const int k0 = (pi * TP + u) * 64;
    const bool cache = lat && (k0 < 512);
    const int tokrow0 = lat ? (NCTX + b * 4096 + k0 - 512) : (seq * 256 + k0);
    const int cK = (tid & 7) ^ (((tid >> 6) & 3) * 2 + ((tid >> 4) & 1));
    const int cV = (tid & 7) ^ ((tid >> 4) & 7);
    if (MLA) {
      const long kb = lat ? (16l * (4 * 256 * 64) + (long)b * (4 * 4608 * 64)) : ((long)seq * (4 * 256 * 64));
      const long vb = lat ? (16l * 131072 + (long)b * (4 * 128 * 4608)) : ((long)seq * 131072);
      if (doK) {
#pragma unroll
        for (int i = 0; i < 2; i++)
          glds16((const bfr*)(p.ws + WS_KNOPE) + kb + ((long)head * nk + k0 + i * 32 + (tid >> 3)) * 64 + cK * 8, stg + i * 2048 + tid * 8);
        const int row = tid >> 2, c = (tid & 3) ^ (((tid >> 6) & 1) * 2);
        const bfr* src = cache ? ((const bfr*)(p.ws + WS_KRC) + (long)(b * 512 + k0 + row) * 32 + c * 8)
                               : (Z + (long)(tokrow0 + row) * ZLD + C_KR + c * 8);
        glds16(src, stg + 4096 + tid * 8);
      }
      if (doV) {
#pragma unroll
        for (int i = 0; i < 4; i++)
          glds16((const bfr*)(p.ws + WS_VTC) + vb + (long)(head * 128 + i * 32 + (tid >> 3)) * nk + k0 + cV * 8, stg + 6144 + i * 2048 + tid * 8);
      }
    } else {
      const int kvh = head >> 2;
      const long vb = lat ? (16l * 32768 + (long)b * (2 * 64 * 4608)) : ((long)seq * 32768);
#pragma unroll
      for (int i = 0; i < 2; i++) {
        const int row = i * 32 + (tid >> 3);
        const bfr* src = cache ? ((const bfr*)(p.ws + WS_KCA) + (long)(b * 512 + k0 + row) * 128 + kvh * 64 + cK * 8)
                               : (Z + (long)(tokrow0 + row) * ZLD + C_KA + kvh * 64 + cK * 8);
        glds16(src, stg + i * 2048 + tid * 8);
      }
#pragma unroll
      for (int i = 0; i < 2; i++)
        glds16((const bfr*)(p.ws + WS_VTA) + vb + (long)(kvh * 64 + i * 32 + (tid >> 3)) * nk + k0 + cV * 8, stg + 4096 + i * 2048 + tid * 8);
    }
   }
  };
  auto qk = [&](const bfr* Ks, f32x4 (&sq)[NQB][4]) {
    bf16x8 kfr[4][NKK];
#pragma unroll
    for (int t = 0; t < 2; t++) {
      int krow = 32 * (t >> 1) + 8 * (l15 >> 2) + 4 * (t & 1) + (l15 & 3);
#pragma unroll
      for (int kk = 0; kk < NKK; kk++) kfr[t][kk] = *(const bf16x8*)kaddr(Ks, krow, kk);
    }
#pragma unroll
    for (int t = 0; t < 4; t++) {
#pragma unroll
      for (int qb = 0; qb < NQB; qb++) sq[qb][t] = (f32x4){-mrun[qb], -mrun[qb], -mrun[qb], -mrun[qb]};
      if (t + 2 < 4) {
        int krow = 32 * ((t + 2) >> 1) + 8 * (l15 >> 2) + 4 * ((t + 2) & 1) + (l15 & 3);
#pragma unroll
        for (int kk = 0; kk < NKK; kk++) kfr[t + 2][kk] = *(const bf16x8*)kaddr(Ks, krow, kk);
      }
#pragma unroll
      for (int kk = 0; kk < NKK; kk++) {
#pragma unroll
        for (int qb = 0; qb < NQB; qb++) sq[qb][t] = mfma16(kfr[t][kk], qf[qb][kk], sq[qb][t]);
      }
    }
  };
  auto smpv = [&](const bfr* Vs, bool first, f32x4 (&sc)[NQB][4], f32x4 (*later)[NQB][4], int nlater) {
    bf16x8 vfr[4][2];
#pragma unroll
    for (int d = 0; d < 4; d++)
#pragma unroll
      for (int sx = 0; sx < 2; sx++) vfr[d][sx] = *(const bf16x8*)vaddr(Vs, d, sx);
    bf16x8 pf[NQB][2];
#pragma unroll
    for (int qb = 0; qb < NQB; qb++) {
      float mt = sc[qb][0][0];
#pragma unroll
      for (int t = 0; t < 4; t++)
#pragma unroll
        for (int r = 0; r < 4; r++) mt = fmaxf(mt, sc[qb][t][r]);
      if (first || __builtin_amdgcn_ballot_w64(mt > 8.f) != 0ull) {
        mt = fmaxf(mt, __shfl_xor(mt, 16));
        mt = fmaxf(mt, __shfl_xor(mt, 32));
        const bool need = first || mt > 8.f;
        const float dm = need ? mt : 0.f;
        const float alpha = first ? 1.f : __builtin_amdgcn_exp2f(-dm);
        mrun[qb] += dm;
        lacc[qb] *= alpha;
#pragma unroll
        for (int d = 0; d < NDV; d++) o[qb][d] *= alpha;
#pragma unroll
        for (int t = 0; t < 4; t++) sc[qb][t] -= dm;
#pragma unroll
        for (int u2 = 0; u2 < 2; u2++)
          if (u2 < nlater) {
#pragma unroll
            for (int t = 0; t < 4; t++) later[u2][qb][t] -= dm;
          }
      }
#pragma unroll
      for (int t = 0; t < 4; t++)
#pragma unroll
        for (int r = 0; r < 4; r++) sc[qb][t][r] = __builtin_amdgcn_exp2f(sc[qb][t][r]);
#pragma unroll
      for (int sx = 0; sx < 2; sx++) {
        u32x4 uu;
        uu.x = pack2(sc[qb][2 * sx][0], sc[qb][2 * sx][1]);
        uu.y = pack2(sc[qb][2 * sx][2], sc[qb][2 * sx][3]);
        uu.z = pack2(sc[qb][2 * sx + 1][0], sc[qb][2 * sx + 1][1]);
        uu.w = pack2(sc[qb][2 * sx + 1][2], sc[qb][2 * sx + 1][3]);
        pf[qb][sx] = *(bf16x8*)&uu;
      }
    }
#pragma unroll
    for (int d = 0; d < NDV; d++) {
#pragma unroll
      for (int sx = 0; sx < 2; sx++) {
#pragma unroll
        for (int qb = 0; qb < NQB; qb++) o[qb][d] = mfma16(vfr[d & 3][sx], pf[qb][sx], o[qb][d]);
      }
      if (d + 4 < NDV) {
#pragma unroll
        for (int sx = 0; sx < 2; sx++) vfr[d & 3][sx] = *(const bf16x8*)vaddr(Vs, d + 4, sx);
      }
    }
#pragma unroll
    for (int sx = 0; sx < 2; sx++) {
#pragma unroll
      for (int qb = 0; qb < NQB; qb++) lacc[qb] = mfma16(ones, pf[qb][sx], lacc[qb]);
    }
  };

  if (LA) {
    bfr* st0 = sm;
    bfr* st1 = sm + BUF;
    dma_issue(0, st0, true, true);
    if (nkt > 1) dma_issue(1, st1, true, false);
    asm volatile("s_waitcnt vmcnt(0)" ::: "memory");
    __syncthreads();
    f32x4 scur[1][NQB][4], snext[1][NQB][4];
    qk(st0, scur[0]);
    __syncthreads();
    for (int j = 0; j < nkt; j++) {
      bfr* sj = (j & 1) ? st1 : st0;
      bfr* sn = (j & 1) ? st0 : st1;
      if (j + 1 < nkt) dma_issue(j + 1, sn, false, true);
      if (j + 2 < nkt) dma_issue(j + 2, sj, true, false);
      const bool more = (j + 1 < nkt);
      if (more) qk(sn, snext[0]);
      smpv(sj + KSZ, j == 0, scur[0], snext, more ? 1 : 0);
      if (more) {
#pragma unroll
        for (int qb = 0; qb < NQB; qb++)
#pragma unroll
          for (int t = 0; t < 4; t++) scur[0][qb][t] = snext[0][qb][t];
      }
      asm volatile("s_waitcnt vmcnt(0)" ::: "memory");
      __syncthreads();
    }
  } else {
  if (DMA) dma_issue(0, sm); else prefetch(0);
  const int np = nkt / TP;
  for (int pi = 0; pi < np; pi++) {
    bfr* base = sm + (pi & 1) * (TP * BUF);
    if (DMA) {
      asm volatile("s_waitcnt vmcnt(0)" ::: "memory");
      __syncthreads();
      if (pi + 1 < np) dma_issue(pi + 1, sm + ((pi + 1) & 1) * (TP * BUF));
    } else {
#pragma unroll
      for (int u = 0; u < TP; u++) {
        bfr* Ks = base + u * BUF;
        bfr* Vs = Ks + KSZ;
#pragma unroll
        for (int i = 0; i < 2; i++) {
          int c = tid + 256 * i;
          *(u32x4*)(Ks + (c >> 3) * KLD + (c & 7) * 8) = rk[u][i];
        }
        if (MLA) *(u32x4*)(Ks + (tid >> 2) * KLD + 64 + (tid & 3) * 8) = rkr[u];
#pragma unroll
        for (int i = 0; i < NVL; i++) {
          int c = tid + 256 * i;
          *(u32x4*)(Vs + (c >> 3) * LDT + (c & 7) * 8) = rv[u][i];
        }
      }
      __syncthreads();
      if (pi + 1 < np) prefetch(pi + 1);
    }
    f32x4 sa[TP][NQB][4];
#pragma unroll
    for (int u = 0; u < TP; u++) qk(base + u * BUF, sa[u]);
#pragma unroll
    for (int u = 0; u < TP; u++) smpv(base + u * BUF + KSZ, pi * TP + u == 0, sa[u], &sa[(u + 1 < TP) ? u + 1 : u], TP - 1 - u);
  }
  }
  __syncthreads();
#pragma unroll
  for (int qb = 0; qb < NQB; qb++) {
    float inv = 1.f / lacc[qb][0];
    int qrow = rowbase + qoff + wid * (16 * NQB) + qb * 16 + l15;
    bfr* gp = Z + (long)qrow * ZLD + (MLA ? C_GC : C_GA) + head * DV + g * 4;
#pragma unroll
    for (int d = 0; d < NDV; d++) {
      u32x2 gr = *(const u32x2*)(gp + d * 16);
      float y0 = o[qb][d][0] * inv * siluf(lo16(gr.x));
      float y1 = o[qb][d][1] * inv * siluf(hi16(gr.x));
      float y2 = o[qb][d][2] * inv * siluf(lo16(gr.y));
      float y3 = o[qb][d][3] * inv * siluf(hi16(gr.y));
      u32x2 ov;
      ov.x = pack2(y0, y1);
      ov.y = pack2(y2, y3);
      if (!dry) *(u32x2*)(gp + d * 16) = ov;
    }
  }
}

__device__ __forceinline__ void phase_mixers(const Params& p, int l, bfr* sm, int* s_item, int dry) {
  unsigned* ctr = (unsigned*)(p.ws + WS_CTR) + (2 + l + 2 * dry) * 128;
  auto cnt = [](int) { return 184; };
  int q = (int)xcc_id(), tried = 0;
  for (;;) {
    if (TIDX == 0) {
      unsigned first = atomicAdd(ctr + q * 16, 1u);
      *s_item = xq_take(ctr, q, tried, first, cnt);
    }
    __syncthreads();
    const int it = *s_item;
    __syncthreads();
    if (it < 0) break;
    const int x = it >> 20, j = it & 0xfffff;
    int kind, a0, a1, a2, a3 = 0;
    if (j < 4) {
      int idx = x * 4 + j;
      kind = 3; a0 = idx >> 4; a1 = (idx >> 2) & 3; a2 = (idx >> 1) & 1; a3 = idx & 1;
    } else if (j < 36) {
      kind = 1; a0 = 16 + (x >> 2); a1 = x & 3; a2 = (j - 4) * 128;
    } else if (j < 96) {
      int i = j - 36;
      kind = 2; a0 = 16 + (x >> 2); a1 = ((x >> 1) & 1) * 4 + (x & 1) * 2 + (i >> 5); a2 = (i & 31) * 128;
    } else if (j < 104) {
      int k = j - 96;
      int i = 60 + (k >> 1);
      kind = 4; a0 = 16 + (x >> 2); a1 = ((x >> 1) & 1) * 4 + (x & 1) * 2 + (i >> 5); a2 = (i & 31) * 128 + (k & 1) * 64;
    } else if (j < 136) {
      int i = j - 104;
      kind = 0; a0 = 2 * x + (i >> 4); a1 = (i >> 2) & 3; a2 = (i >> 1) & 1; a3 = i & 1;
    } else if (j < 152) {
      int i = j - 136;
      kind = 1; a0 = 2 * x + (i >> 3); a1 = (i >> 1) & 3; a2 = (i & 1) * 128;
    } else {
      int i = j - 152;
      kind = 2; a0 = 2 * x + (i >> 4); a1 = (i >> 1) & 7; a2 = (i & 1) * 128;
    }
#ifdef PROBE_MIXKIND
    if (dry && ((PROBE_MIXKIND == 1) != (kind == 0 || kind == 3))) continue;
#endif
    if (kind == 0) gla_item<64>(p, l, a0, a1, a2, a3, sm);
    else if (kind == 3) gla_chain_item(p, l, a0, a1, a2, a3, sm);
    else if (kind == 1) attn_item<96, 128, true, 2, true, 1, true>(p, a0, a1, a2, sm, dry);
    else if (kind == 2) attn_item<64, 64, false, 2, true, 2>(p, a0, a1, a2, sm, dry);
    else attn_item<64, 64, false, 1, true, 2>(p, a0, a1, a2, sm, dry);
  }
}

__device__ __forceinline__ void phase_gla_out(const Params& p, int l) {
  const int lane = TIDX & 63;
  bfr* Z = (bfr*)(p.ws + WS_Z);
  const bfr* OF = (const bfr*)(p.ws + WS_R1);
  const bfr* OB = OF + (long)NROWS * 512;
  for (int row = blockIdx.x * 4 + (TIDX >> 6); row < NROWS; row += gridDim.x * 4) {
    float a[8], c[8], gt[8];
    unpack8(*(const u32x4*)(OF + (long)row * 512 + lane * 8), a);
    unpack8(*(const u32x4*)(OB + (long)row * 512 + lane * 8), c);
    bfr* gp = Z + (long)row * ZLD + C_GG + lane * 8;
    unpack8(*(const u32x4*)gp, gt);
    float ss = 0.f;
#pragma unroll
    for (int e = 0; e < 8; e++) {
      a[e] = bf2f(f2bf(a[e] + c[e]));
      ss += a[e] * a[e];
    }
    ss += __shfl_xor(ss, 1); ss += __shfl_xor(ss, 2); ss += __shfl_xor(ss, 4); ss += __shfl_xor(ss, 8);
    float rs = rsqrtf(ss * (1.f / 128.f) + 1e-6f);
    const float* gg = p.in[21] + l * 128 + (lane & 15) * 8;
#pragma unroll
    for (int e = 0; e < 8; e++) a[e] = a[e] * rs * gg[e] * siluf(gt[e]);
    *(u32x4*)gp = pack8(a);
  }
}

template <int NQ>
__device__ __forceinline__ void merge_tile(const Params& p, bfr* sm, int tn, int tok0) {
  constexpr int STG = 8192 + 2048 * NQ;
  bfr* Z = (bfr*)(p.ws + WS_Z);
  bfr* MG = (bfr*)(p.ws + WS_R1);
  const int tid = TIDX;
  const int lane = tid & 63, wid = tid >> 6, wr = wid >> 1, wc = wid & 1, g = lane >> 4, l15 = lane & 15;
  f32x4 totl[4][NQ];
#pragma unroll
  for (int a = 0; a < 4; a++)
#pragma unroll
    for (int b = 0; b < NQ; b++) totl[a][b] = (f32x4){0.f, 0.f, 0.f, 0.f};
#pragma unroll 1
  for (int seg = 0; seg < 3; seg++) {
    f32x4 acc[4][NQ];
#pragma unroll
    for (int a = 0; a < 4; a++)
#pragma unroll
      for (int b = 0; b < NQ; b++) acc[a][b] = (f32x4){0.f, 0.f, 0.f, 0.f};
    int ycol = seg == 0 ? C_GA : (seg == 1 ? C_GG : C_GC);
    int mcol = C_M1 + seg * 1024;
    const bfr* W = (const bfr*)(p.ws + WS_WOA + (unsigned long)seg * 1048576ul) + (long)tn * 128 * 512;
    gemm128k64<NQ, false, true>(W, 512, 128, Z + (long)tok0 * ZLD + ycol, ZLD, 512, acc, sm,
                                Z + (long)tok0 * ZLD + mcol + tn * 128, ZLD);
    const bfr* gt = sm;
#pragma unroll
    for (int pi = 0; pi < 4; pi++) {
      const int nl = wr * 64 + pi * 16 + g * 4;
#pragma unroll
      for (int qi = 0; qi < NQ; qi++) {
        const int tl = wc * 16 * NQ + qi * 16 + l15;
        u32x2 mr = *(const u32x2*)(gt + tl * 128 + (((nl >> 3) ^ (tl & 15)) * 8) + (nl & 4));
        totl[pi][qi][0] += sigmf(lo16(mr.x)) * acc[pi][qi][0];
        totl[pi][qi][1] += sigmf(hi16(mr.x)) * acc[pi][qi][1];
        totl[pi][qi][2] += sigmf(lo16(mr.y)) * acc[pi][qi][2];
        totl[pi][qi][3] += sigmf(hi16(mr.y)) * acc[pi][qi][3];
      }
    }
    __syncthreads();
  }
#pragma unroll
  for (int pi = 0; pi < 4; pi++)
#pragma unroll
    for (int qi = 0; qi < NQ; qi++) {
      u32x2 o;
      o.x = pack2(totl[pi][qi][0], totl[pi][qi][1]);
      o.y = pack2(totl[pi][qi][2], totl[pi][qi][3]);
      *(u32x2*)(sm + (wc * 16 * NQ + qi * 16 + l15) * 136 + wr * 64 + pi * 16 + g * 4) = o;
    }
  __syncthreads();
#pragma unroll
  for (int i = 0; i < 2 * NQ; i++) {
    int c = tid + 256 * i;
    int row = c >> 4, c16 = c & 15;
    *(u32x4*)(MG + (long)(tok0 + row) * 1024 + tn * 128 + c16 * 8) = *(const u32x4*)(sm + row * 136 + c16 * 8);
  }
  __syncthreads();
}

__device__ __forceinline__ void phase_merge(const Params& p, bfr* sm) {
  for (int t = blockIdx.x; t < 1024; t += gridDim.x) {
    if (t < 512) {
      merge_tile<4>(p, sm, t & 7, (t >> 3) * 128);
    } else {
      int u = t - 512;
      int full = 512 + (u >> 1);
      merge_tile<2>(p, sm, full & 7, (full >> 3) * 128 + (u & 1) * 64);
    }
  }
}

template <int NQ>
__device__ __forceinline__ void outproj_tile(const Params& p, bfr* sm, int tn, int tok0) {
  const bfr* MG = (const bfr*)(p.ws + WS_R1);
  float* OUT = (float*)(p.ws + WS_Z);
  const int tid = TIDX;
  const int lane = tid & 63, wid = tid >> 6, wr = wid >> 1, wc = wid & 1, g = lane >> 4, l15 = lane & 15;
  f32x4 acc[4][NQ];
#pragma unroll
  for (int a = 0; a < 4; a++)
#pragma unroll
    for (int b = 0; b < NQ; b++) acc[a][b] = (f32x4){0.f, 0.f, 0.f, 0.f};
  gemm128k64<NQ, true>((const bfr*)(p.ws + WS_WOUT) + (long)tn * 128 * 1024, 1024, 128, MG + (long)tok0 * 1024, 1024, 1024, acc, sm);
  float* smf = (float*)sm;
#pragma unroll
  for (int pi = 0; pi < 4; pi++)
#pragma unroll
    for (int qi = 0; qi < NQ; qi++)
      *(f32x4*)(smf + (wc * 16 * NQ + qi * 16 + l15) * 132 + wr * 64 + pi * 16 + g * 4) = acc[pi][qi];
  __syncthreads();
#pragma unroll
  for (int i = 0; i < 4 * NQ; i++) {
    int c = tid + 256 * i;
    int row = c >> 5, c16 = c & 31;
    *(f32x4*)(OUT + (long)(tok0 + row) * 1024 + tn * 128 + c16 * 4) = *(const f32x4*)(smf + row * 132 + c16 * 4);
  }
  __syncthreads();
}
__device__ __forceinline__ void phase_outproj(const Params& p, bfr* sm) {
  for (int t = blockIdx.x; t < 1024; t += gridDim.x) {
    if (t < 512) {
      outproj_tile<4>(p, sm, t & 7, (t >> 3) * 128);
    } else {
      int u = t - 512;
      int full = 512 + (u >> 1);
      outproj_tile<2>(p, sm, full & 7, (full >> 3) * 128 + (u & 1) * 64);
    }
  }
}

__device__ __forceinline__ void phase_post(const Params& p, int l) {
  const int lane = TIDX & 63;
  const float* mod = (const float*)(p.ws + WS_MOD);
  const float* OUT = (const float*)(p.ws + WS_Z);
  bfr* H = (bfr*)(p.ws + WS_R1);
  for (int row = blockIdx.x * 4 + (TIDX >> 6); row < NROWS; row += gridDim.x * 4) {
    const float* x = (l == 0) ? xrow(p, row) : (p.out + (long)row * 1024);
    const float* md = mod + (l * 3 + row_cond(row)) * 3072;
    float4 v[4];
    float ss = 0.f;
#pragma unroll
    for (int i = 0; i < 4; i++) {
      v[i] = *(const float4*)(OUT + (long)row * 1024 + i * 256 + lane * 4);
      ss += v[i].x * v[i].x + v[i].y * v[i].y + v[i].z * v[i].z + v[i].w * v[i].w;
    }
    ss = wave_sum(ss);
    float rs = rsqrtf(ss * (1.f / 1024.f) + 1e-6f);
    float ss2 = 0.f;
#pragma unroll
    for (int i = 0; i < 4; i++) {
      int n = i * 256 + lane * 4;
      float4 g = *(const float4*)(p.in[13] + l * 1024 + n);
      float4 gt = *(const float4*)(md + 2048 + n);
      float4 xv = *(const float4*)(x + n);
      v[i].x = xv.x + gt.x * (v[i].x * rs * g.x);
      v[i].y = xv.y + gt.y * (v[i].y * rs * g.y);
      v[i].z = xv.z + gt.z * (v[i].z * rs * g.z);
      v[i].w = xv.w + gt.w * (v[i].w * rs * g.w);
      *(float4*)(p.out + (long)row * 1024 + n) = v[i];
      ss2 += v[i].x * v[i].x + v[i].y * v[i].y + v[i].z * v[i].z + v[i].w * v[i].w;
    }
    if (l == 0) {
      ss2 = wave_sum(ss2);
      float rs2 = rsqrtf(ss2 * (1.f / 1024.f) + 1e-6f);
      const float* md1 = mod + (1 * 3 + row_cond(row)) * 3072;
#pragma unroll
      for (int i = 0; i < 4; i++) {
        int n = i * 256 + lane * 4;
        float4 g = *(const float4*)(p.in[12] + 1024 + n);
        float4 sh = *(const float4*)(md1 + n);
        float4 sc = *(const float4*)(md1 + 1024 + n);
        float h0 = v[i].x * rs2 * g.x * (1.f + sc.x) + sh.x;
        float h1 = v[i].y * rs2 * g.y * (1.f + sc.y) + sh.y;
        float h2 = v[i].z * rs2 * g.z * (1.f + sc.z) + sh.z;
        float h3 = v[i].w * rs2 * g.w * (1.f + sc.w) + sh.w;
        u32x2 o;
        o.x = pack2(h0, h1);
        o.y = pack2(h2, h3);
        *(u32x2*)(H + (long)row * 1024 + n) = o;
      }
    }
  }
}

__global__ void __launch_bounds__(256, 2) fwd_megakernel(Params p) {
  __shared__ __attribute__((aligned(16))) bfr sm[SMEM_SHORTS + 16];
  int* s_item_p = (int*)(sm + SMEM_SHORTS + 8);
  cg::grid_group grid = cg::this_grid();
  if (threadIdx.x == 0) { ((unsigned*)(sm + SMEM_SHORTS))[0] = 0u; ((unsigned*)(sm + SMEM_SHORTS))[1] = 0u; }
  __syncthreads();
  XcdBarrier xb = xcd_barrier_post((unsigned*)(p.ws + WS_BAR), (volatile LAS unsigned*)(sm + SMEM_SHORTS));
  if (p.ws == nullptr) grid.sync();
  (void)xb;
#define GSYNC1 do { XcdBarrier b_; b_.bar = (unsigned*)(p.ws + WS_BAR); b_.x = xb_xcc_id(); \
                    b_.st = (volatile LAS unsigned*)(sm + SMEM_SHORTS); xcd_barrier(b_); } while (0)
#ifdef PROBE_SYNC
#define GSYNC do { GSYNC1; GSYNC1; } while (0)
#else
#define GSYNC GSYNC1
#endif
#ifdef PROBE_PRE
  phase_s0(launder(p), sm);
  GSYNC;
  phase_s1(launder(p));
  wconv_phase(p, 0, sm);
  GSYNC;
  phase_prenorm0(launder(p));
  GSYNC;
#endif

#ifndef PH
#define PH 0xffff
#endif
#if PH & 1
  phase_s0(launder(p), sm);
  wconv_phase(p, 0, sm);
#endif
  GSYNC;
#if PH & 2
  phase_s1(launder(p));
#endif
  GSYNC;
#if PH & 4
  phase_prenorm0(launder(p));
#endif
  GSYNC;
  for (int l = 0; l < 2; l++) {
#if PH & 8
#ifdef PROBE_INPROJ
    phase_inproj(launder(p), l, sm, s_item_p, 6 + l);
    GSYNC;
#endif
    phase_inproj(launder(p), l, sm, s_item_p, l);
#endif
    GSYNC;
#if PH & 16
    phase_rowpost(launder(p), l);
#endif
    GSYNC;
#if PH & 32
#ifdef PROBE_MLAUP
    phase_mla_up(launder(p), l, sm);
    GSYNC;
#endif
    phase_mla_up(launder(p), l, sm);
#endif
    GSYNC;
#if PH & 64
#ifdef PROBE_MIX
    { int dry = 1; asm volatile("" : "+s"(dry)); phase_mixers(launder(p), l, sm, s_item_p, dry); }
    GSYNC;
#endif
    { int dry = 0; asm volatile("" : "+s"(dry)); phase_mixers(launder(p), l, sm, s_item_p, dry); }
#endif
    GSYNC;
#if PH & 128
    phase_gla_out(launder(p), l);
#endif
    GSYNC;
#if PH & 256
#ifdef PROBE_MERGE
    phase_merge(launder(p), sm);
    GSYNC;
#endif
    phase_merge(launder(p), sm);
#endif
    GSYNC;
#if PH & 512
#ifdef PROBE_MERGE
    phase_outproj(launder(p), sm);
    GSYNC;
#endif
    phase_outproj(launder(p), sm);
#endif
    GSYNC;
#if PH & 1024
    phase_post(launder(p), l);
    if (l == 0) wconv_phase(p, 1, sm);
#endif
    if (l == 0) GSYNC;
  }
}

extern "C" void kernel_launch(void* const* d_in, const int* in_sizes, int n_in, void* d_out, int out_size, void* d_ws,
                              size_t ws_size, hipStream_t stream) {
  static int grid_blocks = 0;
  if (!grid_blocks) {
    int dev = 0, cus = 0, per_cu = 0;
    hipGetDevice(&dev);
    hipDeviceGetAttribute(&cus, hipDeviceAttributeMultiprocessorCount, dev);
    hipOccupancyMaxActiveBlocksPerMultiprocessor(&per_cu, fwd_megakernel, 256, 0);
    if (per_cu > 2) per_cu = 2;
    if (per_cu < 1) per_cu = 1;
    grid_blocks = cus * per_cu;
  }
  Params p{};
  for (int i = 0; i < 30; i++) p.in[i] = (const float*)d_in[i];
  p.out = (float*)d_out;
  p.ws = (unsigned char*)d_ws;
  hipMemsetAsync(d_ws, 0, 20480, stream);
  void* args[] = {&p};
  hipError_t e = hipLaunchCooperativeKernel((void*)fwd_megakernel, dim3(grid_blocks), dim3(256), args, 0, stream);
  if (e != hipSuccess) fprintf(stderr, "cooperative launch failed: %s (grid %d)\n", hipGetErrorString(e), grid_blocks);
}
```

```cpp
#include <hip/hip_runtime.h>
#include <hip/hip_cooperative_groups.h>
#include <cstdio>
namespace cg = cooperative_groups;

typedef unsigned short bfr;
typedef __attribute__((ext_vector_type(8))) short bf16x8;
typedef __attribute__((ext_vector_type(4))) float f32x4;
typedef __attribute__((ext_vector_type(4))) unsigned u32x4;
typedef __attribute__((ext_vector_type(2))) unsigned u32x2;

#define NROWS 12288
#define NCTX 4096
#define ZLD 6976
#define LDT 72
#define SMEM_SHORTS (4 * 128 * LDT)

#define C_QA 0
#define C_KA 512
#define C_VA 640
#define C_GA 768
#define C_QG 1280
#define C_KG 1536
#define C_VG 1792
#define C_GG 2304
#define C_RF 2816
#define C_RB 2832
#define C_QL 2848
#define C_KV 3104
#define C_KR 3360
#define C_GC 3392
#define C_M1 3904
#define C_M2 4928
#define C_M3 5952

#define WS_BAR 0ul
#define WS_CTR 16384ul
#define WS_MODP 20480ul
#define WS_MOD (WS_MODP + 589824ul)
#define WS_ROPE (WS_MOD + 73728ul)
#define WS_WIN (WS_ROPE + 16384ul)
#define WS_WUQ (WS_WIN + 14417920ul)
#define WS_WUKV (WS_WUQ + 196608ul)
#define WS_WOA (WS_WUKV + 393216ul)
#define WS_WOB (WS_WOA + 1048576ul)
#define WS_WOC (WS_WOB + 1048576ul)
#define WS_WOUT (WS_WOC + 1048576ul)
#define WS_KCA (WS_WOUT + 2097152ul)
#define WS_CKVC (WS_KCA + 262144ul)
#define WS_KRC (WS_CKVC + 524288ul)
#define WS_VTA (WS_KRC + 65536ul)
#define WS_CQ (WS_VTA + 3407872ul)
#define WS_KNOPE (WS_CQ + 9437184ul)
#define WS_VTC (WS_KNOPE + 6815744ul)
#define WS_R1 (WS_VTC + 13631488ul)
#define WS_Z (WS_R1 + 25165824ul)
#define WS_END (WS_Z + 171442176ul)

#define O_Y 0
#define O_GK 12582912
#define O_GV 13631488
#define O_CKV 14680064
#define O_KR 16777216
#define O_SF 17039360
#define O_SB 18087936

struct Params {
  const float* in[30];
  float* out;
  unsigned char* ws;
};

__device__ __forceinline__ int tidx() {
  int t = threadIdx.x;
  asm volatile("" : "+v"(t));
  return t;
}
__device__ __forceinline__ Params launder(const Params& p) {
  Params q;
  long zo = 0;
  asm volatile("" : "+s"(zo));
#pragma unroll
  for (int i = 0; i < 30; i++) q.in[i] = p.in[i] + zo;
  q.out = p.out + zo;
  q.ws = p.ws + zo;
  return q;
}
__device__ __forceinline__ float bf2f(bfr b) { return __uint_as_float(((unsigned)b) << 16); }
typedef float f32x2_t __attribute__((ext_vector_type(2)));
typedef __bf16 bf16x2_t __attribute__((ext_vector_type(2)));
__device__ __forceinline__ bfr f2bf(float f) {
  __bf16 r = (__bf16)f;
  return *(bfr*)&r;
}
__device__ __forceinline__ unsigned pack2(float a, float b) {
  f32x2_t v = {a, b};
  bf16x2_t r = __builtin_convertvector(v, bf16x2_t);
  return *(unsigned*)&r;
}
__device__ __forceinline__ float lo16(unsigned u) { return __uint_as_float(u << 16); }
__device__ __forceinline__ float hi16(unsigned u) { return __uint_as_float(u & 0xffff0000u); }
__device__ __forceinline__ float siluf(float x) { return x / (1.f + __expf(-x)); }
__device__ __forceinline__ float sigmf(float x) { return 1.f / (1.f + __expf(-x)); }
__device__ __forceinline__ f32x4 mfma16(bf16x8 a, bf16x8 b, f32x4 c) {
  return __builtin_amdgcn_mfma_f32_16x16x32_bf16(a, b, c, 0, 0, 0);
}
__device__ __forceinline__ const float* xrow(const Params& p, int row) {
  return row < NCTX ? p.in[0] + (long)row * 1024 : p.in[1] + (long)(row - NCTX) * 1024;
}
__device__ __forceinline__ int row_cond(int row) { return row < NCTX ? 0 : 1 + ((row - NCTX) >> 12); }
__device__ __forceinline__ float wave_sum(float v) {
  v += __shfl_xor(v, 1); v += __shfl_xor(v, 2); v += __shfl_xor(v, 4);
  v += __shfl_xor(v, 8); v += __shfl_xor(v, 16); v += __shfl_xor(v, 32);
  return v;
}

#define XB_TMO      128
#define XB_XCNT(j)  (256  + 64 * (j))
#define XB_XSUB(j)  (1280 + 64 * (j))
#define XB_XGEN(j)  (2304 + 64 * (j))
#define XB_TOP      3328
#define XB_TOPGEN   3392
#define XCD_BAR_WORDS 3456
#define XB_SPIN_CAP (1u << 18)
#define LAS __attribute__((address_space(3)))

__device__ __forceinline__ unsigned xb_ld(unsigned* p)              { return __hip_atomic_load(p, __ATOMIC_RELAXED, __HIP_MEMORY_SCOPE_AGENT); }
__device__ __forceinline__ unsigned xb_add(unsigned* p, unsigned v) { return __hip_atomic_fetch_add(p, v, __ATOMIC_RELAXED, __HIP_MEMORY_SCOPE_AGENT); }
__device__ __forceinline__ unsigned xb_xcc_id() { return (unsigned)__builtin_amdgcn_s_getreg((3 << 11) | 20) & 0xFu; }
#define XB_SPIN(cond, bar) do { unsigned _sp = 0; while (cond) { __builtin_amdgcn_s_sleep(1); \
    if ((++_sp & 255u) == 0u) { if (xb_ld(&(bar)[XB_TMO])) break; if (_sp > XB_SPIN_CAP) { atomicAdd(&(bar)[XB_TMO], 1u); break; } } } } while (0)

struct XcdBarrier {
    unsigned* bar; unsigned x;
    volatile LAS unsigned* st;
};

__device__ __forceinline__ XcdBarrier xcd_barrier_post(unsigned* bar, volatile LAS unsigned* st) {
    XcdBarrier b; b.bar = bar; b.x = xb_xcc_id(); b.st = st;
    if (threadIdx.x == 0) (void)xb_add(&bar[XB_XCNT(b.x)], 1u);
    return b;
}
__device__ __forceinline__ void xcd_barrier_complete(unsigned* bar, unsigned x, unsigned& nloc, unsigned& nx) {
    const unsigned G = gridDim.x * gridDim.y * gridDim.z;
    unsigned sum, cnt, mine, sp = 0u;
    for (;;) {
        sum = 0u; cnt = 0u; mine = 0u;
#pragma unroll
        for (unsigned j = 0; j < 16; ++j) { const unsigned c = xb_ld(&bar[XB_XCNT(j)]); sum += c; cnt += (c > 0u) ? 1u : 0u; mine = (j == x) ? c : mine; }
        if (sum == G) break;
        __builtin_amdgcn_s_sleep(1);
        if ((++sp & 255u) == 0u) { if (xb_ld(&bar[XB_TMO])) break; if (sp > XB_SPIN_CAP) { atomicAdd(&bar[XB_TMO], 1u); break; } }
    }
    nloc = mine > 0u ? mine : 1u; nx = cnt > 0u ? cnt : 1u;
}

__device__ __forceinline__ void xcd_barrier(const XcdBarrier& b) {
    asm volatile("s_waitcnt vmcnt(0)" ::: "memory");
    __syncthreads();
    if (threadIdx.x == 0) {
        unsigned* bar = b.bar;
        __builtin_amdgcn_s_waitcnt(0);
        unsigned nloc = b.st[0], nx = b.st[1];
        if (nloc == 0u) { xcd_barrier_complete(bar, b.x, nloc, nx); b.st[0] = nloc; b.st[1] = nx; }
        const unsigned old = xb_add(&bar[XB_XSUB(b.x)], 1u);
        const unsigned gen = old / nloc;
        if (old + 1u == (gen + 1u) * nloc) {
            __builtin_amdgcn_fence(__ATOMIC_RELEASE, "agent");
            asm volatile("s_waitcnt vmcnt(0)" ::: "memory");
            const unsigned og = xb_add(&bar[XB_TOP], 1u);
            const unsigned tg = og / nx;
            if (og + 1u == (tg + 1u) * nx) xb_add(&bar[XB_TOPGEN], 1u);
            else XB_SPIN(xb_ld(&bar[XB_TOPGEN]) == tg, bar);
            __builtin_amdgcn_fence(__ATOMIC_ACQUIRE, "agent");
            xb_add(&bar[XB_XGEN(b.x)], 1u);
            asm volatile("s_waitcnt vmcnt(0)" ::: "memory");
        } else {
            XB_SPIN(xb_ld(&bar[XB_XGEN(b.x)]) == gen, bar);
            __builtin_amdgcn_fence(__ATOMIC_ACQUIRE, "agent");
            asm volatile("s_waitcnt vmcnt(0)" ::: "memory");
        }
    }
    __syncthreads();
}


#define TIDX tidx()
#define LDS3 __attribute__((address_space(3)))
__device__ __forceinline__ void glds16(const bfr* g, bfr* l) {
  __builtin_amdgcn_global_load_lds((const unsigned*)g, (LDS3 unsigned*)l, 16, 0, 0);
}
__device__ __forceinline__ void gemm128(const bfr* __restrict__ P, long ldp, int pmax,
                                        const bfr* __restrict__ Q, long ldq, int qmax, int K,
                                        f32x4 (&acc)[4][4], bfr* sm) {
  const int tid = TIDX, lane = tid & 63, wid = tid >> 6;
  const int wr = wid >> 1, wc = wid & 1;
  const int l15 = lane & 15, g = lane >> 4;
  const bfr* pp[2];
  const bfr* qp[2];
  {
    const int r0 = tid >> 2;
    const int c = (tid & 3) ^ ((tid >> 4) & 3);
#pragma unroll
    for (int i = 0; i < 2; i++) {
      int r = r0 + 64 * i;
      pp[i] = P + (long)min(r, pmax - 1) * ldp + c * 8;
      qp[i] = Q + (long)min(r, qmax - 1) * ldq + c * 8;
    }
  }
  const int nk = K >> 5;
#define GEMM_ISSUE(T)                                                    \
  do {                                                                   \
    bfr* nb_ = sm + ((T) & 3) * 8192;                                    \
    glds16(pp[0] + (T) * 32, nb_ + tid * 8);                             \
    glds16(pp[1] + (T) * 32, nb_ + 2048 + tid * 8);                      \
    glds16(qp[0] + (T) * 32, nb_ + 4096 + tid * 8);                      \
    glds16(qp[1] + (T) * 32, nb_ + 6144 + tid * 8);                      \
  } while (0)
  GEMM_ISSUE(0);
  GEMM_ISSUE(1);
  GEMM_ISSUE(2);
  const int pos = (g ^ ((l15 >> 2) & 3)) * 8;
  for (int kt = 0; kt < nk; kt++) {
    if (kt + 2 < nk) asm volatile("s_waitcnt vmcnt(8)" ::: "memory");
    else if (kt + 1 < nk) asm volatile("s_waitcnt vmcnt(4)" ::: "memory");
    else asm volatile("s_waitcnt vmcnt(0)" ::: "memory");
    __builtin_amdgcn_s_barrier();
    if (kt + 3 < nk) GEMM_ISSUE(kt + 3);
    const bfr* Ps = sm + (kt & 3) * 8192;
    const bfr* Qs = Ps + 4096;
    bf16x8 pf[4], qf[4];
#pragma unroll
    for (int m = 0; m < 4; m++) {
      pf[m] = *(const bf16x8*)(Ps + (wr * 64 + m * 16 + l15) * 32 + pos);
      qf[m] = *(const bf16x8*)(Qs + (wc * 64 + m * 16 + l15) * 32 + pos);
    }
#pragma unroll
    for (int m = 0; m < 4; m++)
#pragma unroll
      for (int n = 0; n < 4; n++) acc[m][n] = mfma16(pf[m], qf[n], acc[m][n]);
  }
#undef GEMM_ISSUE
  __syncthreads();
}

template <int NQ>
__device__ __forceinline__ void gemm128q(const bfr* __restrict__ P, long ldp, const bfr* __restrict__ Q, long ldq, int K,
                                         f32x4 (&acc)[4][NQ], bfr* sm) {
  constexpr int QI = NQ / 2;
  constexpr int STG = 4096 + QI * 2048;
  const int tid = TIDX, lane = tid & 63, wid = tid >> 6;
  const int wr = wid >> 1, wc = wid & 1;
  const int l15 = lane & 15, g = lane >> 4;
  const bfr* pp[2];
  const bfr* qp[QI];
  {
    const int r0 = tid >> 2;
    const int c = (tid & 3) ^ (((tid >> 5) & 1) * 3);
#pragma unroll
    for (int i = 0; i < 2; i++) pp[i] = P + (long)(r0 + 64 * i) * ldp + c * 8;
#pragma unroll
    for (int i = 0; i < QI; i++) qp[i] = Q + (long)(r0 + 64 * i) * ldq + c * 8;
  }
  const int nk = K >> 5;
  auto issue = [&](int T) {
    bfr* nb_ = sm + (T & 3) * STG;
    glds16(pp[0] + T * 32, nb_ + tid * 8);
    glds16(pp[1] + T * 32, nb_ + 2048 + tid * 8);
#pragma unroll
    for (int i = 0; i < QI; i++) glds16(qp[i] + T * 32, nb_ + 4096 + i * 2048 + tid * 8);
  };
  issue(0);
  issue(1);
  issue(2);
  const int pos = (g ^ (((l15 >> 3) & 1) * 3)) * 8;
  for (int kt = 0; kt < nk; kt++) {
    if (kt + 2 < nk) {
      if (QI == 2) asm volatile("s_waitcnt vmcnt(8)" ::: "memory"); else asm volatile("s_waitcnt vmcnt(6)" ::: "memory");
    } else if (kt + 1 < nk) {
      if (QI == 2) asm volatile("s_waitcnt vmcnt(4)" ::: "memory"); else asm volatile("s_waitcnt vmcnt(3)" ::: "memory");
    } else {
      asm volatile("s_waitcnt vmcnt(0)" ::: "memory");
    }
    __builtin_amdgcn_s_barrier();
    if (kt + 3 < nk) issue(kt + 3);
    const bfr* Ps = sm + (kt & 3) * STG;
    const bfr* Qs = Ps + 4096;
    bf16x8 pf[4], qf[NQ];
#pragma unroll
    for (int m = 0; m < 4; m++) pf[m] = *(const bf16x8*)(Ps + (wr * 64 + m * 16 + l15) * 32 + pos);
#pragma unroll
    for (int n = 0; n < NQ; n++) qf[n] = *(const bf16x8*)(Qs + (wc * 16 * NQ + n * 16 + l15) * 32 + pos);
#pragma unroll
    for (int m = 0; m < 4; m++)
#pragma unroll
      for (int n = 0; n < NQ; n++) acc[m][n] = mfma16(pf[m], qf[n], acc[m][n]);
  }
  __syncthreads();
}

template <int NQ>
__device__ __forceinline__ void gemm256x128(const bfr* __restrict__ P, long ldp, int pmax,
                                            const bfr* __restrict__ Q, long ldq, int K,
                                            f32x4 (&acc)[8][NQ], bfr* sm) {
  constexpr int QI = NQ / 2;
  constexpr int STG = 8192 + QI * 2048;
  const int tid = TIDX, lane = tid & 63, wid = tid >> 6;
  const int wr = wid >> 1, wc = wid & 1;
  const int l15 = lane & 15, g = lane >> 4;
  const bfr* pp[4];
  const bfr* qp[QI];
  {
    const int r0 = tid >> 2;
    const int c = (tid & 3) ^ (((tid >> 5) & 1) * 3);
#pragma unroll
    for (int i = 0; i < 4; i++) pp[i] = P + (long)min(r0 + 64 * i, pmax - 1) * ldp + c * 8;
#pragma unroll
    for (int i = 0; i < QI; i++) qp[i] = Q + (long)(r0 + 64 * i) * ldq + c * 8;
  }
  const int nk = K >> 5;
  auto issue = [&](int T, int stg) {
    bfr* nb_ = sm + stg * STG;
    glds16(pp[0] + T * 32, nb_ + tid * 8);
    glds16(pp[1] + T * 32, nb_ + 2048 + tid * 8);
    glds16(pp[2] + T * 32, nb_ + 4096 + tid * 8);
    glds16(pp[3] + T * 32, nb_ + 6144 + tid * 8);
#pragma unroll
    for (int i = 0; i < QI; i++) glds16(qp[i] + T * 32, nb_ + 8192 + i * 2048 + tid * 8);
  };
  issue(0, 0);
  issue(1, 1);
  const int pos = (g ^ (((l15 >> 3) & 1) * 3)) * 8;
  int st = 0;
  for (int kt = 0; kt < nk; kt++) {
    if (kt + 1 < nk) {
      if (QI == 2) asm volatile("s_waitcnt vmcnt(6)" ::: "memory"); else asm volatile("s_waitcnt vmcnt(5)" ::: "memory");
    } else {
      asm volatile("s_waitcnt vmcnt(0)" ::: "memory");
    }
    __builtin_amdgcn_s_barrier();
    if (kt + 2 < nk) issue(kt + 2, st == 0 ? 2 : st - 1);
    const bfr* Ps = sm + st * STG;
    const bfr* Qs = Ps + 8192;
    st = (st == 2) ? 0 : st + 1;
    bf16x8 qf[NQ], pf[8];
#pragma unroll
    for (int n = 0; n < NQ; n++) qf[n] = *(const bf16x8*)(Qs + (wc * 16 * NQ + n * 16 + l15) * 32 + pos);
#pragma unroll
    for (int m = 0; m < 8; m++) pf[m] = *(const bf16x8*)(Ps + (wr * 128 + m * 16 + l15) * 32 + pos);
#pragma unroll
    for (int m = 0; m < 8; m++)
#pragma unroll
      for (int n = 0; n < NQ; n++) acc[m][n] = mfma16(pf[m], qf[n], acc[m][n]);
    __builtin_amdgcn_sched_group_barrier(0x100, NQ + 2, 0);
#pragma unroll
    for (int i = 0; i < 6; i++) {
      __builtin_amdgcn_sched_group_barrier(0x008, NQ, 0);
      __builtin_amdgcn_sched_group_barrier(0x100, 1, 0);
    }
    __builtin_amdgcn_sched_group_barrier(0x008, 2 * NQ, 0);
  }
  __syncthreads();
}

template <int NQ, bool PIPE, bool TAIL = false>
__device__ __forceinline__ void gemm128k64(const bfr* __restrict__ P, long ldp, int pmax,
                                           const bfr* __restrict__ Q, long ldq, int K,
                                           f32x4 (&acc)[4][NQ], bfr* sm, const bfr* tail_src = nullptr, long tail_ld = 0) {
  constexpr int STG = 8192 + 2048 * NQ;
  const int tid = TIDX, lane = tid & 63, wid = tid >> 6;
  const int wr = wid >> 1, wc = wid & 1;
  const int l15 = lane & 15, g = lane >> 4;
  const bfr* pp[4];
  const bfr* qp[NQ];
  {
    const int r0 = tid >> 3;
    const int c = (tid & 7) ^ ((tid >> 4) & 7);
#pragma unroll
    for (int i = 0; i < 4; i++) pp[i] = P + (long)min(r0 + 32 * i, pmax - 1) * ldp + c * 8;
#pragma unroll
    for (int i = 0; i < NQ; i++) qp[i] = Q + (long)(r0 + 32 * i) * ldq + c * 8;
  }
  const int nk = K >> 6;
#pragma unroll
  for (int i = 0; i < 4; i++) glds16(pp[i], sm + i * 2048 + tid * 8);
#pragma unroll
  for (int i = 0; i < NQ; i++) glds16(qp[i], sm + 8192 + i * 2048 + tid * 8);
  const int swz = l15 >> 1;
  for (int kt = 0; kt < nk; kt++) {
    asm volatile("s_waitcnt vmcnt(0)" ::: "memory");
    __builtin_amdgcn_s_barrier();
    if (kt + 1 < nk) {
      bfr* nb = sm + ((kt + 1) & 1) * STG;
#pragma unroll
      for (int i = 0; i < 4; i++) glds16(pp[i] + (kt + 1) * 64, nb + i * 2048 + tid * 8);
#pragma unroll
      for (int i = 0; i < NQ; i++) glds16(qp[i] + (kt + 1) * 64, nb + 8192 + i * 2048 + tid * 8);
    } else if (TAIL) {
      bfr* nb = sm + ((kt + 1) & 1) * STG;
      const bfr* ts = tail_src + (long)(tid >> 4) * tail_ld + (((tid & 15) ^ ((tid >> 4) & 15)) * 8);
#pragma unroll
      for (int i = 0; i < 2 * NQ; i++) glds16(ts + (long)(16 * i) * tail_ld, nb + i * 2048 + tid * 8);
    }
    const bfr* Ps = sm + (kt & 1) * STG;
    const bfr* Qs = Ps + 8192;
    if (PIPE) {
      bf16x8 pf[2][4], qf[2][NQ];
#pragma unroll
      for (int kk = 0; kk < 2; kk++) {
        const int pos = ((kk * 4 + g) ^ swz) * 8;
#pragma unroll
        for (int m = 0; m < 4; m++) pf[kk][m] = *(const bf16x8*)(Ps + (wr * 64 + m * 16 + l15) * 64 + pos);
#pragma unroll
        for (int n = 0; n < NQ; n++) qf[kk][n] = *(const bf16x8*)(Qs + (wc * 16 * NQ + n * 16 + l15) * 64 + pos);
      }
#pragma unroll
      for (int kk = 0; kk < 2; kk++)
#pragma unroll
        for (int m = 0; m < 4; m++)
#pragma unroll
          for (int n = 0; n < NQ; n++) acc[m][n] = mfma16(pf[kk][m], qf[kk][n], acc[m][n]);
      __builtin_amdgcn_sched_group_barrier(0x100, 4 + NQ, 0);
#pragma unroll
      for (int i = 0; i < 4 + NQ; i++) {
        __builtin_amdgcn_sched_group_barrier(0x008, NQ == 4 ? 2 : 1, 0);
        __builtin_amdgcn_sched_group_barrier(0x100, 1, 0);
      }
      __builtin_amdgcn_sched_group_barrier(0x008, NQ == 4 ? 16 : 10, 0);
    } else {
#pragma unroll
      for (int kk = 0; kk < 2; kk++) {
        bf16x8 pf[4], qf[NQ];
        const int pos = ((kk * 4 + g) ^ swz) * 8;
#pragma unroll
        for (int m = 0; m < 4; m++) pf[m] = *(const bf16x8*)(Ps + (wr * 64 + m * 16 + l15) * 64 + pos);
#pragma unroll
        for (int n = 0; n < NQ; n++) qf[n] = *(const bf16x8*)(Qs + (wc * 16 * NQ + n * 16 + l15) * 64 + pos);
#pragma unroll
        for (int m = 0; m < 4; m++)
#pragma unroll
          for (int n = 0; n < NQ; n++) acc[m][n] = mfma16(pf[m], qf[n], acc[m][n]);
      }
    }
  }
  if (TAIL) asm volatile("s_waitcnt vmcnt(0)" ::: "memory");
  __syncthreads();
}

__device__ __forceinline__ void gemm160x128(const bfr* __restrict__ P, long ldp, int pmax,
                                            const bfr* __restrict__ Q, long ldq, int K,
                                            f32x4 (&acc)[5][4], bfr* sm) {
  constexpr int STG = 160 * 64 + 128 * 64;
  const int tid = TIDX, lane = tid & 63, wid = tid >> 6;
  const int wr = wid >> 1, wc = wid & 1;
  const int l15 = lane & 15, g = lane >> 4;
  const bfr* pp[5];
  const bfr* qp[4];
  {
    const int r0 = tid >> 3;
    const int c = (tid & 7) ^ ((tid >> 4) & 7);
#pragma unroll
    for (int i = 0; i < 5; i++) pp[i] = P + (long)min(r0 + 32 * i, pmax - 1) * ldp + c * 8;
#pragma unroll
    for (int i = 0; i < 4; i++) qp[i] = Q + (long)(r0 + 32 * i) * ldq + c * 8;
  }
  const int nk = K >> 6;
#pragma unroll
  for (int i = 0; i < 5; i++) glds16(pp[i], sm + i * 2048 + tid * 8);
#pragma unroll
  for (int i = 0; i < 4; i++) glds16(qp[i], sm + 10240 + i * 2048 + tid * 8);
  const int swz = l15 >> 1;
  for (int kt = 0; kt < nk; kt++) {
    asm volatile("s_waitcnt vmcnt(0)" ::: "memory");
    __builtin_amdgcn_s_barrier();
    if (kt + 1 < nk) {
      bfr* nb = sm + ((kt + 1) & 1) * STG;
#pragma unroll
      for (int i = 0; i < 5; i++) glds16(pp[i] + (kt + 1) * 64, nb + i * 2048 + tid * 8);
#pragma unroll
      for (int i = 0; i < 4; i++) glds16(qp[i] + (kt + 1) * 64, nb + 10240 + i * 2048 + tid * 8);
    }
    const bfr* Ps = sm + (kt & 1) * STG;
    const bfr* Qs = Ps + 10240;
    bf16x8 pf[2][5], qf[2][4];
#pragma unroll
    for (int kk = 0; kk < 2; kk++) {
      const int pos = ((kk * 4 + g) ^ swz) * 8;
#pragma unroll
      for (int m = 0; m < 5; m++) pf[kk][m] = *(const bf16x8*)(Ps + (wr * 80 + m * 16 + l15) * 64 + pos);
#pragma unroll
      for (int n = 0; n < 4; n++) qf[kk][n] = *(const bf16x8*)(Qs + (wc * 64 + n * 16 + l15) * 64 + pos);
    }
#pragma unroll
    for (int kk = 0; kk < 2; kk++)
#pragma unroll
      for (int m = 0; m < 5; m++)
#pragma unroll
        for (int n = 0; n < 4; n++) acc[m][n] = mfma16(pf[kk][m], qf[kk][n], acc[m][n]);
    __builtin_amdgcn_sched_group_barrier(0x100, 9, 0);
#pragma unroll
    for (int i = 0; i < 9; i++) {
      __builtin_amdgcn_sched_group_barrier(0x008, 2, 0);
      __builtin_amdgcn_sched_group_barrier(0x100, 1, 0);
    }
    __builtin_amdgcn_sched_group_barrier(0x008, 22, 0);
  }
  __syncthreads();
}

__device__ __forceinline__ void phase_s0(const Params& p, bfr* sm) {
  const int tid = TIDX;
  float* rope = (float*)(p.ws + WS_ROPE);
  for (int idx = blockIdx.x * 256 + tid; idx < 1536; idx += gridDim.x * 256) {
    if (idx < 1024) {
      int pos = idx >> 4, i = idx & 15;
      float fr = powf(10000.f, -(float)i / 16.f);
      float a = (float)pos * fr;
      rope[idx] = cosf(a);
      rope[1024 + idx] = sinf(a);
    } else {
      int j = idx - 1024;
      int pos = j >> 3, i = j & 7;
      float fr = powf(10000.f, -(float)i / 8.f);
      float a = (float)pos * fr;
      rope[2048 + j] = cosf(a);
      rope[2560 + j] = sinf(a);
    }
  }
  float* smf = (float*)sm;
  float* modp = (float*)(p.ws + WS_MODP);
  for (int it = blockIdx.x; it < 768; it += gridDim.x) {
    int l = it / 384, rem = it % 384, cgp = rem >> 3, ks = rem & 7;
    int col = cgp * 64 + (tid & 63), kq = tid >> 6;
    const float* w = p.in[10] + (long)l * 1024 * 3072 + col;
    float a0 = 0.f, a1 = 0.f, a2 = 0.f;
    int k0 = ks * 128 + kq * 32;
#pragma unroll 8
    for (int k = k0; k < k0 + 32; k++) {
      float wv = w[(long)k * 3072];
      a0 += siluf(p.in[9][k]) * wv;
      a1 += siluf(p.in[8][k]) * wv;
      a2 += siluf(p.in[8][1024 + k]) * wv;
    }
    smf[(kq * 3 + 0) * 64 + (tid & 63)] = a0;
    smf[(kq * 3 + 1) * 64 + (tid & 63)] = a1;
    smf[(kq * 3 + 2) * 64 + (tid & 63)] = a2;
    __syncthreads();
    if (tid < 192) {
      int c = tid >> 6, cc = tid & 63;
      float s = smf[(0 * 3 + c) * 64 + cc] + smf[(1 * 3 + c) * 64 + cc] + smf[(2 * 3 + c) * 64 + cc] + smf[(3 * 3 + c) * 64 + cc];
      modp[((ks * 2 + l) * 3 + c) * 3072 + cgp * 64 + cc] = s;
    }
    __syncthreads();
  }
}

__device__ __forceinline__ void phase_s1(const Params& p) {
  float* modp = (float*)(p.ws + WS_MODP);
  float* mod = (float*)(p.ws + WS_MOD);
  for (int idx = blockIdx.x * 256 + TIDX; idx < 2 * 3 * 3072; idx += gridDim.x * 256) {
    int l = idx / 9216, n = idx % 3072;
    float s = p.in[11][l * 3072 + n];
#pragma unroll
    for (int ks = 0; ks < 8; ks++) s += modp[ks * 18432 + idx];
    mod[idx] = s;
  }
}

#define WCONV_ITEMS 2456
struct WcItem { const float* src; bfr* dst; int K, N, tk, tn; };
__device__ __forceinline__ WcItem wconv_decode(const Params& p, int l, int item) {
  WcItem w;
  if (item < 1744) {
    w.src = p.in[14] + (long)l * 1024 * 6976; w.K = 1024; w.N = 6976; w.dst = (bfr*)(p.ws + WS_WIN); w.tk = item & 15; w.tn = item >> 4;
  } else if (item < 1768) {
    item -= 1744;
    w.src = p.in[24] + (long)l * 256 * 384; w.K = 256; w.N = 384; w.dst = (bfr*)(p.ws + WS_WUQ); w.tk = item & 3; w.tn = item >> 2;
  } else if (item < 1816) {
    item -= 1768;
    w.src = p.in[25] + (long)l * 256 * 768; w.K = 256; w.N = 768; w.dst = (bfr*)(p.ws + WS_WUKV); w.tk = item & 3; w.tn = item >> 2;
  } else if (item < 2200) {
    item -= 1816;
    int ww = item >> 7, it = item & 127;
    w.src = (ww == 0 ? p.in[26] : (ww == 1 ? p.in[27] : p.in[28])) + (long)l * 512 * 1024;
    w.K = 512; w.N = 1024; w.dst = (bfr*)(p.ws + WS_WOA + (unsigned long)ww * 1048576ul); w.tk = it & 7; w.tn = it >> 3;
  } else {
    item -= 2200;
    w.src = p.in[29] + (long)l * 1024 * 1024; w.K = 1024; w.N = 1024; w.dst = (bfr*)(p.ws + WS_WOUT); w.tk = item & 15; w.tn = item >> 4;
  }
  return w;
}
__device__ __forceinline__ void wconv_phase(const Params& p, int l, bfr* sm) {
  bfr* sT = sm;
  const int tid = TIDX;
  const int n4 = (tid & 15) * 4, k0 = (tid >> 4) * 4;
  float4 v[4];
  int item = blockIdx.x;
  if (item < WCONV_ITEMS) {
    WcItem w = wconv_decode(p, l, item);
#pragma unroll
    for (int i = 0; i < 4; i++) v[i] = *(const float4*)(w.src + (long)(w.tk * 64 + k0 + i) * w.N + w.tn * 64 + n4);
  }
  const int wcol = (((k0 >> 3) ^ ((n4 >> 2) & 7)) * 8) + (k0 & 4);
  for (; item < WCONV_ITEMS; item += gridDim.x) {
    WcItem w = wconv_decode(p, l, item);
    {
      u32x2 o;
      o.x = pack2(v[0].x, v[1].x); o.y = pack2(v[2].x, v[3].x);
      *(u32x2*)(sT + (n4 + 0) * 64 + wcol) = o;
      o.x = pack2(v[0].y, v[1].y); o.y = pack2(v[2].y, v[3].y);
      *(u32x2*)(sT + (n4 + 1) * 64 + wcol) = o;
      o.x = pack2(v[0].z, v[1].z); o.y = pack2(v[2].z, v[3].z);
      *(u32x2*)(sT + (n4 + 2) * 64 + wcol) = o;
      o.x = pack2(v[0].w, v[1].w); o.y = pack2(v[2].w, v[3].w);
      *(u32x2*)(sT + (n4 + 3) * 64 + wcol) = o;
    }
    const int nitem = item + gridDim.x;
    if (nitem < WCONV_ITEMS) {
      WcItem wn = wconv_decode(p, l, nitem);
#pragma unroll
      for (int i = 0; i < 4; i++) v[i] = *(const float4*)(wn.src + (long)(wn.tk * 64 + k0 + i) * wn.N + wn.tn * 64 + n4);
    }
    __syncthreads();
#pragma unroll
    for (int i = 0; i < 2; i++) {
      int c = tid + 256 * i;
      int n = c >> 3, kc = c & 7;
      *(u32x4*)(w.dst + (long)(w.tn * 64 + n) * w.K + w.tk * 64 + kc * 8) = *(const u32x4*)(sT + n * 64 + ((kc ^ ((n >> 2) & 7)) * 8));
    }
    __syncthreads();
  }
}

__device__ __forceinline__ void phase_prenorm0(const Params& p) {
  const int lane = TIDX & 63;
  const float* mod = (const float*)(p.ws + WS_MOD);
  bfr* H = (bfr*)(p.ws + WS_R1);
  for (int row = blockIdx.x * 4 + (TIDX >> 6); row < NROWS; row += gridDim.x * 4) {
    const float* x = xrow(p, row);
    const float* md = mod + (0 * 3 + row_cond(row)) * 3072;
    float4 v[4];
    float ss = 0.f;
#pragma unroll
    for (int i = 0; i < 4; i++) {
      v[i] = *(const float4*)(x + i * 256 + lane * 4);
      ss += v[i].x * v[i].x + v[i].y * v[i].y + v[i].z * v[i].z + v[i].w * v[i].w;
    }
    ss = wave_sum(ss);
    float rs = rsqrtf(ss * (1.f / 1024.f) + 1e-6f);
#pragma unroll
    for (int i = 0; i < 4; i++) {
      int n = i * 256 + lane * 4;
      float4 g = *(const float4*)(p.in[12] + n);
      float4 sh = *(const float4*)(md + n);
      float4 sc = *(const float4*)(md + 1024 + n);
      float h0 = v[i].x * rs * g.x * (1.f + sc.x) + sh.x;
      float h1 = v[i].y * rs * g.y * (1.f + sc.y) + sh.y;
      float h2 = v[i].z * rs * g.z * (1.f + sc.z) + sh.z;
      float h3 = v[i].w * rs * g.w * (1.f + sc.w) + sh.w;
      u32x2 o;
      o.x = pack2(h0, h1);
      o.y = pack2(h2, h3);
      *(u32x2*)(H + (long)row * 1024 + n) = o;
    }
  }
}

__device__ __forceinline__ unsigned xcc_id() { return (unsigned)__builtin_amdgcn_s_getreg((3 << 11) | 20) & 7u; }
template <class CountF>
__device__ __forceinline__ int xq_take(unsigned* ctr, int& q, int& tried, unsigned first, CountF cnt) {
  unsigned j = first;
  for (;;) {
    if (j < (unsigned)cnt(q)) return (q << 20) | (int)j;
    q = (q + 1) & 7;
    if (++tried >= 8) return -1;
    j = atomicAdd(ctr + q * 16, 1u);
  }
}

__device__ __forceinline__ void phase_inproj(const Params& p, int l, bfr* sm, int* s_item, int slot) {
  const bfr* H = (const bfr*)(p.ws + WS_R1);
  const bfr* W = (const bfr*)(p.ws + WS_WIN);
  bfr* Z = (bfr*)(p.ws + WS_Z);
  const int tid = TIDX;
  const int lane = tid & 63, wid = tid >> 6, wr = wid >> 1, wc = wid & 1;
  unsigned* ctr = (unsigned*)(p.ws + WS_CTR) + slot * 128;
  auto cnt = [](int q) { return 96 * ((44 * (q + 1)) / 8 - (44 * q) / 8); };
  int q = (int)xcc_id(), tried = 0;
  unsigned nxt = 0;
  if (tid == 0) nxt = atomicAdd(ctr + q * 16, 1u);
  for (;;) {
    if (tid == 0) *s_item = xq_take(ctr, q, tried, nxt, cnt);
    __syncthreads();
    const int it = *s_item;
    __syncthreads();
    if (it < 0) break;
    const int qq = it >> 20, j = it & 0xfffff;
    if (tid == 0) nxt = atomicAdd(ctr + q * 16, 1u);
    const int tn0 = (44 * qq) / 8, w = (44 * (qq + 1)) / 8 - tn0;
    const int tm = j / w, tn = tn0 + j % w;
    f32x4 acc[5][4];
#pragma unroll
    for (int a = 0; a < 5; a++)
#pragma unroll
      for (int b = 0; b < 4; b++) acc[a][b] = (f32x4){0.f, 0.f, 0.f, 0.f};
    gemm160x128(W + (long)tn * 160 * 1024, 1024, ZLD - tn * 160, H + (long)tm * 128 * 1024, 1024, 1024, acc, sm);
    {
      const int g = lane >> 4, l15 = lane & 15;
#pragma unroll
      for (int pi = 0; pi < 5; pi++)
#pragma unroll
        for (int qi = 0; qi < 4; qi++) {
          u32x2 o;
          o.x = pack2(acc[pi][qi][0], acc[pi][qi][1]);
          o.y = pack2(acc[pi][qi][2], acc[pi][qi][3]);
          *(u32x2*)(sm + (wc * 64 + qi * 16 + l15) * 168 + wr * 80 + pi * 16 + g * 4) = o;
        }
      __syncthreads();
      const int ncol = min(20, (ZLD - tn * 160) >> 3);
#pragma unroll
      for (int i = 0; i < 10; i++) {
        int c = tid + 256 * i;
        int row = c / 20, c16 = c % 20;
        if (c16 < ncol)
          *(u32x4*)(Z + (long)(tm * 128 + row) * ZLD + tn * 160 + c16 * 8) = *(const u32x4*)(sm + row * 168 + c16 * 8);
      }
      __syncthreads();
    }
  }
}

__device__ __forceinline__ void unpack8(u32x4 v, float* x) {
  x[0] = lo16(v.x); x[1] = hi16(v.x); x[2] = lo16(v.y); x[3] = hi16(v.y);
  x[4] = lo16(v.z); x[5] = hi16(v.z); x[6] = lo16(v.w); x[7] = hi16(v.w);
}
__device__ __forceinline__ u32x4 pack8(const float* y) {
  u32x4 o;
  o.x = pack2(y[0], y[1]); o.y = pack2(y[2], y[3]); o.z = pack2(y[4], y[5]); o.w = pack2(y[6], y[7]);
  return o;
}

__device__ __forceinline__ void phase_rowpost(const Params& p, int l) {
  const int lane = TIDX & 63;
  bfr* Z = (bfr*)(p.ws + WS_Z);
  const float* rope = (const float*)(p.ws + WS_ROPE);
  bfr* VTA = (bfr*)(p.ws + WS_VTA);
  bfr* KCA = (bfr*)(p.ws + WS_KCA);
  bfr* CKVC = (bfr*)(p.ws + WS_CKVC);
  bfr* KRC = (bfr*)(p.ws + WS_KRC);
  float* out = p.out;
  for (int row = blockIdx.x * 4 + (TIDX >> 6); row < NROWS + 1024; row += gridDim.x * 4) {
    if (row < NROWS) {
      const bool lat = row >= NCTX;
      const int bc = row >> 8, tc = row & 255;
      const int bl = (row - NCTX) >> 12, tl = (row - NCTX) & 4095;
      const int prow = tl >> 6, pcol = tl & 63;
      bfr* z = Z + (long)row * ZLD;
      {
        float x[8];
        unpack8(*(const u32x4*)(z + C_QA + lane * 8), x);
        float ss = 0.f;
#pragma unroll
        for (int e = 0; e < 8; e++) ss += x[e] * x[e];
        ss += __shfl_xor(ss, 1); ss += __shfl_xor(ss, 2); ss += __shfl_xor(ss, 4);
        float rs = rsqrtf(ss * (1.f / 64.f) + 1e-6f);
        int sub = lane & 7;
        const float* g = p.in[15] + l * 64 + sub * 8;
#pragma unroll
        for (int e = 0; e < 8; e++) x[e] = x[e] * rs * g[e];
        if (lat) {
          int pos = (sub >> 2) ? pcol : prow;
          bool hi = (sub & 2) != 0;
          int i0 = (sub & 1) * 8;
#pragma unroll
          for (int e = 0; e < 8; e++) {
            float yp = __shfl_xor(x[e], 2);
            float c = rope[pos * 16 + i0 + e], s = rope[1024 + pos * 16 + i0 + e];
            x[e] = hi ? (yp * s + x[e] * c) : (x[e] * c - yp * s);
          }
        }
        const float qs = 0.125f * 1.4426950408889634f;
#pragma unroll
        for (int e = 0; e < 8; e++) x[e] *= qs;
        *(u32x4*)(z + C_QA + lane * 8) = pack8(x);
      }
      {
        int L = lane & 15;
        float x[8];
        unpack8(*(const u32x4*)(z + C_KA + L * 8), x);
        float ss = 0.f;
#pragma unroll
        for (int e = 0; e < 8; e++) ss += x[e] * x[e];
        ss += __shfl_xor(ss, 1); ss += __shfl_xor(ss, 2); ss += __shfl_xor(ss, 4);
        float rs = rsqrtf(ss * (1.f / 64.f) + 1e-6f);
        int sub = L & 7;
        const float* g = p.in[16] + l * 64 + sub * 8;
#pragma unroll
        for (int e = 0; e < 8; e++) x[e] = x[e] * rs * g[e];
        if (lat) {
          int pos = (sub >> 2) ? pcol : prow;
          bool hi = (sub & 2) != 0;
          int i0 = (sub & 1) * 8;
#pragma unroll
          for (int e = 0; e < 8; e++) {
            float yp = __shfl_xor(x[e], 2);
            float c = rope[pos * 16 + i0 + e], s = rope[1024 + pos * 16 + i0 + e];
            x[e] = hi ? (yp * s + x[e] * c) : (x[e] * c - yp * s);
          }
        } else if (lane < 16) {
          float* o = out + O_GK + ((long)(bc * 2 + l) * 256 + tc) * 128 + L * 8;
          *(float4*)(o) = make_float4(x[0], x[1], x[2], x[3]);
          *(float4*)(o + 4) = make_float4(x[4], x[5], x[6], x[7]);
        }
        if (lane < 16) *(u32x4*)(z + C_KA + L * 8) = pack8(x);
      }
      if (lane < 16) {
        int L = lane;
        u32x4 raw = *(const u32x4*)(z + C_VA + L * 8);
        float x[8];
        unpack8(raw, x);
        if (!lat) {
          float* o = out + O_GV + ((long)(bc * 2 + l) * 256 + tc) * 128 + L * 8;
          *(float4*)(o) = make_float4(x[0], x[1], x[2], x[3]);
          *(float4*)(o + 4) = make_float4(x[4], x[5], x[6], x[7]);
        }
        int g = L >> 3, d0 = (L & 7) * 8;
        long base; int nk, key;
        if (!lat) { base = (long)bc * 32768; nk = 256; key = tc; }
        else { base = 16l * 32768 + (long)bl * (2 * 64 * 4608); nk = 4608; key = 512 + tl; }
        const bfr* rb = (const bfr*)&raw;
#pragma unroll
        for (int e = 0; e < 8; e++) VTA[base + (long)(g * 64 + d0 + e) * nk + key] = rb[e];
      }
      {
        u32x2 rq = *(const u32x2*)(z + C_QL + lane * 4);
        u32x2 rk = *(const u32x2*)(z + C_KV + lane * 4);
        float q[4] = {lo16(rq.x), hi16(rq.x), lo16(rq.y), hi16(rq.y)};
        float k[4] = {lo16(rk.x), hi16(rk.x), lo16(rk.y), hi16(rk.y)};
        float sq = q[0] * q[0] + q[1] * q[1] + q[2] * q[2] + q[3] * q[3];
        float sk = k[0] * k[0] + k[1] * k[1] + k[2] * k[2] + k[3] * k[3];
        sq = wave_sum(sq);
        sk = wave_sum(sk);
        float rq_ = rsqrtf(sq * (1.f / 256.f) + 1e-6f), rk_ = rsqrtf(sk * (1.f / 256.f) + 1e-6f);
        float4 gq = *(const float4*)(p.in[22] + l * 256 + lane * 4);
        float4 gk = *(const float4*)(p.in[23] + l * 256 + lane * 4);
        q[0] *= rq_ * gq.x; q[1] *= rq_ * gq.y; q[2] *= rq_ * gq.z; q[3] *= rq_ * gq.w;
        k[0] *= rk_ * gk.x; k[1] *= rk_ * gk.y; k[2] *= rk_ * gk.z; k[3] *= rk_ * gk.w;
        u32x2 o;
        o.x = pack2(q[0], q[1]); o.y = pack2(q[2], q[3]);
        *(u32x2*)(z + C_QL + lane * 4) = o;
        o.x = pack2(k[0], k[1]); o.y = pack2(k[2], k[3]);
        *(u32x2*)(z + C_KV + lane * 4) = o;
        if (!lat) *(float4*)(out + O_CKV + ((long)(bc * 2 + l) * 256 + tc) * 256 + lane * 4) = make_float4(k[0], k[1], k[2], k[3]);
      }
      {
        int L = lane & 3;
        float x[8];
        unpack8(*(const u32x4*)(z + C_KR + L * 8), x);
        if (lat) {
          int pos = (L >> 1) ? pcol : prow;
          bool hi = (L & 1) != 0;
#pragma unroll
          for (int e = 0; e < 8; e++) {
            float yp = __shfl_xor(x[e], 1);
            float c = rope[2048 + pos * 8 + e], s = rope[2560 + pos * 8 + e];
            x[e] = hi ? (yp * s + x[e] * c) : (x[e] * c - yp * s);
          }
          if (lane < 4) *(u32x4*)(z + C_KR + L * 8) = pack8(x);
        } else if (lane < 4) {
          float* o = out + O_KR + ((long)(bc * 2 + l) * 256 + tc) * 32 + L * 8;
          *(float4*)(o) = make_float4(x[0], x[1], x[2], x[3]);
          *(float4*)(o + 4) = make_float4(x[4], x[5], x[6], x[7]);
        }
      }
    } else {
      int cr = row - NROWS;
      int b = cr >> 9, t = cr & 511;
      long src = (long)(b * 2 + l) * 512 + t;
      {
        float2 kv = *(const float2*)(p.in[2] + src * 128 + lane * 2);
        *(unsigned*)(KCA + (long)(b * 512 + t) * 128 + lane * 2) = pack2(kv.x, kv.y);
        float2 vv = *(const float2*)(p.in[3] + src * 128 + lane * 2);
        int c0 = lane * 2;
        long base = 16l * 32768 + (long)b * (2 * 64 * 4608);
        VTA[base + (long)c0 * 4608 + t] = f2bf(vv.x);
        VTA[base + (long)(c0 + 1) * 4608 + t] = f2bf(vv.y);
        float4 cv = *(const float4*)(p.in[4] + src * 256 + lane * 4);
        u32x2 o;
        o.x = pack2(cv.x, cv.y); o.y = pack2(cv.z, cv.w);
        *(u32x2*)(CKVC + (long)(b * 512 + t) * 256 + lane * 4) = o;
        if (lane < 32) KRC[(long)(b * 512 + t) * 32 + lane] = f2bf(p.in[5][src * 32 + lane]);
      }
    }
  }
}

#define WS_PREP1 251703296ul
#define WS_EL (WS_WIN + 12582912ul)
__device__ __forceinline__ bfr* prep_base(const Params& p, int b, int h, int dir, int c) {
  return (bfr*)(p.ws + (b ? WS_PREP1 : WS_WIN)) + (long)((h * 2 + dir) * 64 + c) * 12288;
}

__device__ __forceinline__ void gla_chunk_prep(int tid, const float (&wd)[16], float bias, const bfr* Qr, const bfr* Kr,
                                               bfr* Qe, bfr* Ke, bfr* KlT, const float* RF, float* tot, float* lastv) {
  const int ch = tid & 63, part = tid >> 6;
  float cum[16];
  {
    float run = 0.f;
#pragma unroll
    for (int ii = 0; ii < 16; ii++) {
      int i = part * 16 + ii;
      float x = bias;
#pragma unroll
      for (int r = 0; r < 16; r++) x += RF[i * 16 + r] * wd[r];
      float la = (fminf(x, 0.f) - __logf(1.f + __expf(-fabsf(x)))) * (1.f / 16.f);
      run += la;
      cum[ii] = run;
    }
    tot[part * 64 + ch] = run;
  }
  __syncthreads();
  {
    float off = 0.f, last = 0.f;
#pragma unroll
    for (int pp = 0; pp < 4; pp++) {
      float tv = tot[pp * 64 + ch];
      if (pp < part) off += tv;
      last += tv;
    }
    if (part == 0) lastv[ch] = last;
#pragma unroll
    for (int ii = 0; ii < 16; ii++) {
      int i = part * 16 + ii;
      float cc = cum[ii] + off;
      float qv = bf2f(Qr[i * LDT + ch]), kv = bf2f(Kr[i * LDT + ch]);
      Qe[i * LDT + ch] = f2bf(qv * __expf(cc) * 0.125f);
      Ke[i * LDT + ch] = f2bf(kv * __expf(-cc));
      KlT[ch * LDT + i] = f2bf(kv * __expf(last - cc));
    }
  }
  __syncthreads();
}

__device__ __forceinline__ void gla_att(int wid, int g, int l15, const bfr* Qe, const bfr* Ke, bfr* Att) {
  f32x4 att[4];
  bf16x8 qa[2];
#pragma unroll
  for (int kk = 0; kk < 2; kk++) qa[kk] = *(const bf16x8*)(Qe + (16 * wid + l15) * LDT + kk * 32 + g * 8);
#pragma unroll
  for (int nj = 0; nj < 4; nj++) {
    att[nj] = (f32x4){0.f, 0.f, 0.f, 0.f};
#pragma unroll
    for (int kk = 0; kk < 2; kk++) {
      bf16x8 kb = *(const bf16x8*)(Ke + (16 * nj + l15) * LDT + kk * 32 + g * 8);
      att[nj] = mfma16(qa[kk], kb, att[nj]);
    }
  }
#pragma unroll
  for (int nj = 0; nj < 4; nj++)
#pragma unroll
    for (int r = 0; r < 4; r++) {
      int i = 16 * wid + 4 * g + r, j = 16 * nj + l15;
      Att[i * LDT + j] = f2bf(i >= j ? att[nj][r] : 0.f);
    }
}

__device__ __forceinline__ void gla_prep_item(const Params& p, int l, int b, int h, int dir, int c, bfr* sm) {
  const int tid = TIDX, lane = tid & 63, wid = tid >> 6, g = lane >> 4, l15 = lane & 15;
  const bfr* Z = (const bfr*)(p.ws + WS_Z);
  const int N = 4096;
  const int rowbase = NCTX + b * 4096;
  bfr* Qr = sm;
  bfr* Kr = Qr + 64 * LDT;
  bfr* Qe = Kr + 64 * LDT;
  bfr* Ke = Qe + 64 * LDT;
  bfr* KlT = Ke + 64 * LDT;
  float* RF = (float*)(KlT + 64 * LDT);
  float* tot = RF + 64 * 16;
  float* lastv = tot + 256;
  bfr* Att = Qr;
  const int ch = tid & 63;
  float wd[16];
  {
    const float* W = (dir ? p.in[19] : p.in[17]) + (long)l * 16 * 256 + h * 64 + ch;
#pragma unroll
    for (int r = 0; r < 16; r++) wd[r] = W[r * 256];
  }
  const float bias = (dir ? p.in[20] : p.in[18])[l * 256 + h * 64 + ch];
#pragma unroll
  for (int ii = 0; ii < 2; ii++) {
    int cc = tid + 256 * ii;
    int i = cc >> 3, c8 = cc & 7;
    int tok = dir ? (N - 1 - (c * 64 + i)) : (c * 64 + i);
    const bfr* zr = Z + (long)(rowbase + tok) * ZLD;
    *(u32x4*)(Qr + i * LDT + c8 * 8) = *(const u32x4*)(zr + C_QG + h * 64 + c8 * 8);
    *(u32x4*)(Kr + i * LDT + c8 * 8) = *(const u32x4*)(zr + C_KG + h * 64 + c8 * 8);
  }
  if (tid < 128) {
    int i = tid >> 1, hf = tid & 1;
    int tok = dir ? (N - 1 - (c * 64 + i)) : (c * 64 + i);
    u32x4 rr = *(const u32x4*)(Z + (long)(rowbase + tok) * ZLD + (dir ? C_RB : C_RF) + hf * 8);
    float x[8];
    unpack8(rr, x);
#pragma unroll
    for (int e = 0; e < 8; e++) RF[i * 16 + hf * 8 + e] = x[e];
  }
  __syncthreads();
  gla_chunk_prep(tid, wd, bias, Qr, Kr, Qe, Ke, KlT, RF, tot, lastv);
  gla_att(wid, g, l15, Qe, Ke, Att);
  __syncthreads();
  bfr* dst = prep_base(p, b, h, dir, c);
#pragma unroll
  for (int ii = 0; ii < 2; ii++) {
    int cc = tid + 256 * ii;
    int i = cc >> 3, c8 = cc & 7;
    *(u32x4*)(dst + i * 64 + c8 * 8) = *(const u32x4*)(Qe + i * LDT + c8 * 8);
    *(u32x4*)(dst + 4096 + i * 64 + c8 * 8) = *(const u32x4*)(KlT + i * LDT + c8 * 8);
    *(u32x4*)(dst + 8192 + i * 64 + c8 * 8) = *(const u32x4*)(Att + i * LDT + c8 * 8);
  }
  if (tid < 64) ((float*)(p.ws + WS_EL))[((long)(((b * 4 + h) * 2 + dir) * 64 + c)) * 64 + tid] = __expf(lastv[tid]);
  __syncthreads();
}

__device__ __forceinline__ void gla_chain_item(const Params& p, int l, int b, int h, int dir, int vh, bfr* sm) {
  const int tid = TIDX, lane = tid & 63, wid = tid >> 6, g = lane >> 4, l15 = lane & 15;
  const bfr* Z = (const bfr*)(p.ws + WS_Z);
  bfr* OG = (bfr*)(p.ws + WS_R1) + (long)dir * NROWS * 512;
  const float* EL = (const float*)(p.ws + WS_EL) + (long)(((b * 4 + h) * 2 + dir) * 64) * 64;
  const int N = 4096, nc = 64;
  const int rowbase = NCTX + b * 4096;
  const int vs0 = vh * 64;
  bfr* Vt = sm;
  bfr* St = Vt + 64 * LDT;
  f32x4 st[4];
  {
    const float* S0 = (dir ? p.in[7] : p.in[6]) + ((long)((b * 2 + l) * 4 + h)) * 8192 + (long)(16 * wid + l15) * 128 + vs0;
#pragma unroll
    for (int vt = 0; vt < 4; vt++) {
      float4 a = *(const float4*)(S0 + 16 * vt + 4 * g);
      st[vt] = (f32x4){a.x, a.y, a.z, a.w};
#pragma unroll
      for (int r = 0; r < 4; r++) St[(16 * vt + 4 * g + r) * LDT + 16 * wid + l15] = f2bf(st[vt][r]);
    }
  }
  u32x4 n_qe[2], n_kl[2], n_at[2], n_v[2];
  float n_el;
  auto prefetch = [&](int c) {
    const bfr* base = prep_base(p, b, h, dir, c) + (16 * wid + l15) * 64 + 8 * g;
#pragma unroll
    for (int kk = 0; kk < 2; kk++) {
      n_qe[kk] = *(const u32x4*)(base + kk * 32);
      n_kl[kk] = *(const u32x4*)(base + 4096 + kk * 32);
      n_at[kk] = *(const u32x4*)(base + 8192 + kk * 32);
    }
    n_el = EL[c * 64 + 16 * wid + l15];
#pragma unroll
    for (int ii = 0; ii < 2; ii++) {
      int cc = tid + 256 * ii;
      int i = cc >> 3, c8 = cc & 7;
      int tok = dir ? (N - 1 - (c * 64 + i)) : (c * 64 + i);
      n_v[ii] = *(const u32x4*)(Z + (long)(rowbase + tok) * ZLD + C_VG + h * 128 + vs0 + c8 * 8);
    }
  };
  prefetch(0);
  for (int c = 0; c < nc; c++) {
    u32x4 c_qe[2] = {n_qe[0], n_qe[1]}, c_kl[2] = {n_kl[0], n_kl[1]}, c_at[2] = {n_at[0], n_at[1]};
    const float el = n_el;
#pragma unroll
    for (int ii = 0; ii < 2; ii++) {
      int cc = tid + 256 * ii;
      int i = cc >> 3, c8 = cc & 7;
      const bfr* rb = (const bfr*)&n_v[ii];
#pragma unroll
      for (int e = 0; e < 8; e++) Vt[(c8 * 8 + e) * LDT + i] = rb[e];
    }
    __syncthreads();
    if (c + 1 < nc) prefetch(c + 1);
    f32x4 stn[4];
    const int i = 16 * wid + l15;
    const int tok = dir ? (N - 1 - (c * 64 + i)) : (c * 64 + i);
    bfr* og = OG + (long)(rowbase + tok) * 512 + h * 128 + vs0 + 4 * g;
#pragma unroll
    for (int vt = 0; vt < 4; vt++) {
      f32x4 oc = (f32x4){0.f, 0.f, 0.f, 0.f};
      stn[vt] = st[vt] * el;
#pragma unroll
      for (int kk = 0; kk < 2; kk++) {
        bf16x8 vf = *(const bf16x8*)(Vt + (16 * vt + l15) * LDT + kk * 32 + g * 8);
        bf16x8 sf = *(const bf16x8*)(St + (16 * vt + l15) * LDT + kk * 32 + g * 8);
        oc = mfma16(vf, *(bf16x8*)&c_at[kk], oc);
        oc = mfma16(sf, *(bf16x8*)&c_qe[kk], oc);
        stn[vt] = mfma16(vf, *(bf16x8*)&c_kl[kk], stn[vt]);
      }
      u32x2 ov;
      ov.x = pack2(oc[0], oc[1]);
      ov.y = pack2(oc[2], oc[3]);
      *(u32x2*)(og + 16 * vt) = ov;
    }
    __syncthreads();
#pragma unroll
    for (int vt = 0; vt < 4; vt++) {
      st[vt] = stn[vt];
#pragma unroll
      for (int r = 0; r < 4; r++) St[(16 * vt + 4 * g + r) * LDT + 16 * wid + l15] = f2bf(st[vt][r]);
    }
  }
  __syncthreads();
}

template <int VS>
__device__ __forceinline__ void gla_item(const Params& p, int l, int seq, int h, int dir, int vsl, bfr* sm) {
  constexpr int NVT = VS / 16;
  constexpr int NVL = VS / 32;
  const int tid = TIDX, lane = tid & 63, wid = tid >> 6, g = lane >> 4, l15 = lane & 15;
  bfr* Z = (bfr*)(p.ws + WS_Z);
  bfr* OG = (bfr*)(p.ws + WS_R1) + (long)dir * NROWS * 512;
  const bool lat = seq >= 16;
  const int b = seq - 16;
  const int N = lat ? 4096 : 256;
  const int rowbase = lat ? NCTX + b * 4096 : seq * 256;
  const int nc = N >> 6;
  const int vs0 = vsl * VS;
  bfr* Qr = sm;
  bfr* Kr = Qr + 64 * LDT;
  bfr* Qe = Kr + 64 * LDT;
  bfr* Ke = Qe + 64 * LDT;
  bfr* KlT = Ke + 64 * LDT;
  float* RF = (float*)(KlT + 64 * LDT);
  float* tot = RF + 64 * 16;
  float* lastv = tot + 256;
  bfr* Vt = (bfr*)(lastv + 64);
  bfr* St = Vt + VS * LDT;
  bfr* Att = Qr;
  const int ch = tid & 63;
  float wd[16];
  {
    const float* W = (dir ? p.in[19] : p.in[17]) + (long)l * 16 * 256 + h * 64 + ch;
#pragma unroll
    for (int r = 0; r < 16; r++) wd[r] = W[r * 256];
  }
  const float bias = (dir ? p.in[20] : p.in[18])[l * 256 + h * 64 + ch];

  f32x4 st[NVT];
  {
    const float* S0 = (dir ? p.in[7] : p.in[6]) + ((long)((b * 2 + l) * 4 + h)) * 8192 + (long)(16 * wid + l15) * 128 + vs0;
#pragma unroll
    for (int mv = 0; mv < NVT; mv++) {
      if (lat) {
        float4 a = *(const float4*)(S0 + 16 * mv + 4 * g);
        st[mv] = (f32x4){a.x, a.y, a.z, a.w};
      } else {
        st[mv] = (f32x4){0.f, 0.f, 0.f, 0.f};
      }
#pragma unroll
      for (int r = 0; r < 4; r++) St[(16 * mv + 4 * g + r) * LDT + 16 * wid + l15] = f2bf(st[mv][r]);
    }
  }
  u32x4 rq[2], rk[2], rv[NVL], rr;
  auto prefetch = [&](int c) {
#pragma unroll
    for (int ii = 0; ii < 2; ii++) {
      int cc = tid + 256 * ii;
      int i = cc >> 3, c8 = cc & 7;
      int tok = dir ? (N - 1 - (c * 64 + i)) : (c * 64 + i);
      const bfr* zr = Z + (long)(rowbase + tok) * ZLD;
      rq[ii] = *(const u32x4*)(zr + C_QG + h * 64 + c8 * 8);
      rk[ii] = *(const u32x4*)(zr + C_KG + h * 64 + c8 * 8);
    }
#pragma unroll
    for (int ii = 0; ii < NVL; ii++) {
      int cc = tid + 256 * ii;
      int i = cc / (VS / 8), c4 = cc % (VS / 8);
      int tok = dir ? (N - 1 - (c * 64 + i)) : (c * 64 + i);
      rv[ii] = *(const u32x4*)(Z + (long)(rowbase + tok) * ZLD + C_VG + h * 128 + vs0 + c4 * 8);
    }
    if (tid < 128) {
      int i = tid >> 1, hf = tid & 1;
      int tok = dir ? (N - 1 - (c * 64 + i)) : (c * 64 + i);
      rr = *(const u32x4*)(Z + (long)(rowbase + tok) * ZLD + (dir ? C_RB : C_RF) + hf * 8);
    }
  };
  prefetch(0);
  for (int c = 0; c < nc; c++) {
#pragma unroll
    for (int ii = 0; ii < 2; ii++) {
      int cc = tid + 256 * ii;
      *(u32x4*)(Qr + (cc >> 3) * LDT + (cc & 7) * 8) = rq[ii];
      *(u32x4*)(Kr + (cc >> 3) * LDT + (cc & 7) * 8) = rk[ii];
    }
#pragma unroll
    for (int ii = 0; ii < NVL; ii++) {
      int cc = tid + 256 * ii;
      int i = cc / (VS / 8), c4 = cc % (VS / 8);
      const bfr* rb = (const bfr*)&rv[ii];
#pragma unroll
      for (int e = 0; e < 8; e++) Vt[(c4 * 8 + e) * LDT + i] = rb[e];
    }
    if (tid < 128) {
      int i = tid >> 1, hf = tid & 1;
      float x[8];
      unpack8(rr, x);
#pragma unroll
      for (int e = 0; e < 8; e++) RF[i * 16 + hf * 8 + e] = x[e];
    }
    __syncthreads();
    if (c + 1 < nc) prefetch(c + 1);
    gla_chunk_prep(tid, wd, bias, Qr, Kr, Qe, Ke, KlT, RF, tot, lastv);
    f32x4 stn[NVT];
    {
      float el = __expf(lastv[16 * wid + l15]);
#pragma unroll
      for (int mv = 0; mv < NVT; mv++) {
        stn[mv] = st[mv] * el;
#pragma unroll
        for (int kk = 0; kk < 2; kk++) {
          bf16x8 va = *(const bf16x8*)(Vt + (16 * mv + l15) * LDT + kk * 32 + g * 8);
          bf16x8 kb = *(const bf16x8*)(KlT + (16 * wid + l15) * LDT + kk * 32 + g * 8);
          stn[mv] = mfma16(va, kb, stn[mv]);
        }
      }
      gla_att(wid, g, l15, Qe, Ke, Att);
    }
    __syncthreads();
    {
      bf16x8 aa[2], qa[2];
#pragma unroll
      for (int kk = 0; kk < 2; kk++) {
        aa[kk] = *(const bf16x8*)(Att + (16 * wid + l15) * LDT + kk * 32 + g * 8);
        qa[kk] = *(const bf16x8*)(Qe + (16 * wid + l15) * LDT + kk * 32 + g * 8);
      }
#pragma unroll
      for (int nv = 0; nv < NVT; nv++) {
        f32x4 oc = (f32x4){0.f, 0.f, 0.f, 0.f};
#pragma unroll
        for (int kk = 0; kk < 2; kk++) {
          bf16x8 vb = *(const bf16x8*)(Vt + (16 * nv + l15) * LDT + kk * 32 + g * 8);
          oc = mfma16(aa[kk], vb, oc);
          bf16x8 sb = *(const bf16x8*)(St + (16 * nv + l15) * LDT + kk * 32 + g * 8);
          oc = mfma16(qa[kk], sb, oc);
        }
#pragma unroll
        for (int r = 0; r < 4; r++) {
          int i = 16 * wid + 4 * g + r;
          int tok = dir ? (N - 1 - (c * 64 + i)) : (c * 64 + i);
          OG[(long)(rowbase + tok) * 512 + h * 128 + vs0 + 16 * nv + l15] = f2bf(oc[r]);
        }
      }
    }
    __syncthreads();
#pragma unroll
    for (int mv = 0; mv < NVT; mv++) {
      st[mv] = stn[mv];
#pragma unroll
      for (int r = 0; r < 4; r++) St[(16 * mv + 4 * g + r) * LDT + 16 * wid + l15] = f2bf(st[mv][r]);
    }
  }
  __syncthreads();
  if (!lat) {
    float* so = p.out + (dir ? O_SB : O_SF) + ((long)((seq * 2 + l) * 4 + h)) * 8192 + (long)(16 * wid + l15) * 128 + vs0;
#pragma unroll
    for (int mv = 0; mv < NVT; mv++)
      *(float4*)(so + 16 * mv + 4 * g) = make_float4(st[mv][0], st[mv][1], st[mv][2], st[mv][3]);
  }
}

__device__ __forceinline__ void phase_mla_up(const Params& p, int l, bfr* sm) {
  bfr* Z = (bfr*)(p.ws + WS_Z);
  const float* rope = (const float*)(p.ws + WS_ROPE);
  const int lane = TIDX & 63, wid = TIDX >> 6, wr = wid >> 1, wc = wid & 1;
  const int g = lane >> 4;
  for (int t = blockIdx.x; t < 288 + 624 + 1024; t += gridDim.x) {
    if (t >= 912) {
      int i = t - 912;
      gla_prep_item(p, l, i >> 9, (i >> 7) & 3, (i >> 6) & 1, i & 63, sm);
      continue;
    }
    f32x4 acc[4][4];
#pragma unroll
    for (int a = 0; a < 4; a++)
#pragma unroll
      for (int b = 0; b < 4; b++) acc[a][b] = (f32x4){0.f, 0.f, 0.f, 0.f};
    if (t < 288) {
      int tn = t % 3, tm = t / 3;
      gemm128k64<4, true>((const bfr*)(p.ws + WS_WUQ) + (long)tn * 128 * 256, 256, 128, Z + (long)tm * 128 * ZLD + C_QL, ZLD, 256,
                    acc, sm);
      bfr* CQ = (bfr*)(p.ws + WS_CQ);
      const float qs = 0.10206207261596577f * 1.4426950408889634f;
#pragma unroll
      for (int pi = 0; pi < 4; pi++) {
        int nb = tn * 128 + wr * 64 + pi * 16;
        int wb = nb % 96;
        bool ropet = wb >= 64;
        int part = (wb - 64) >> 4;
#pragma unroll
        for (int qi = 0; qi < 4; qi++) {
          int tok = tm * 128 + wc * 64 + qi * 16 + (lane & 15);
          float y[4] = {acc[pi][qi][0], acc[pi][qi][1], acc[pi][qi][2], acc[pi][qi][3]};
          if (ropet) {
            bool lat = tok >= NCTX;
            int tl = (tok - NCTX) & 4095;
            int pos = part ? (tl & 63) : (tl >> 6);
            bool hi = (g & 2) != 0;
            int i0 = (g & 1) * 4;
#pragma unroll
            for (int r = 0; r < 4; r++) {
              float yp = __shfl_xor(y[r], 32);
              float c = rope[2048 + pos * 8 + i0 + r], s = rope[2560 + pos * 8 + i0 + r];
              float yr = hi ? (yp * s + y[r] * c) : (y[r] * c - yp * s);
              y[r] = lat ? yr : y[r];
            }
          }
          u32x2 o;
          o.x = pack2(y[0] * qs, y[1] * qs);
          o.y = pack2(y[2] * qs, y[3] * qs);
          *(u32x2*)(CQ + (long)tok * 384 + nb + g * 4) = o;
        }
      }
    } else {
      int t2 = t - 288;
      int tn = t2 % 6, tm = t2 / 6;
      const bfr* Q;
      long ldq;
      long kbase, vbase;
      int nk, key0;
      if (tm < 32) {
        Q = Z + (long)tm * 128 * ZLD + C_KV;
        ldq = ZLD;
        int s = tm >> 1;
        key0 = (tm & 1) * 128;
        nk = 256;
        kbase = (long)s * (4 * 256 * 64);
        vbase = (long)s * 131072;
      } else {
        int r = (tm - 32) * 128;
        int b = r / 4608, within = r % 4608;
        key0 = within;
        nk = 4608;
        kbase = 16l * (4 * 256 * 64) + (long)b * (4 * 4608 * 64);
        vbase = 16l * 131072 + (long)b * (4 * 128 * 4608);
        if (within < 512) {
          Q = (const bfr*)(p.ws + WS_CKVC) + (long)(b * 512 + within) * 256;
          ldq = 256;
        } else {
          Q = Z + (long)(NCTX + b * 4096 + within - 512) * ZLD + C_KV;
          ldq = ZLD;
        }
      }
      gemm128k64<4, true>((const bfr*)(p.ws + WS_WUKV) + (long)tn * 128 * 256, 256, 128, Q, ldq, 256, acc, sm);
      bfr* KN = (bfr*)(p.ws + WS_KNOPE);
      bfr* VTC = (bfr*)(p.ws + WS_VTC);
#pragma unroll
      for (int pi = 0; pi < 4; pi++) {
        int n0 = tn * 128 + wr * 64 + pi * 16 + g * 4;
        int head = n0 / 192, w = n0 % 192;
#pragma unroll
        for (int qi = 0; qi < 4; qi++) {
          int key = key0 + wc * 64 + qi * 16 + (lane & 15);
          if (w < 64) {
            u32x2 o;
            o.x = pack2(acc[pi][qi][0], acc[pi][qi][1]);
            o.y = pack2(acc[pi][qi][2], acc[pi][qi][3]);
            *(u32x2*)(KN + kbase + ((long)head * nk + key) * 64 + w) = o;
          } else {
#pragma unroll
            for (int r = 0; r < 4; r++)
              VTC[vbase + ((long)head * 128 + (w - 64) + r) * nk + key] = f2bf(acc[pi][qi][r]);
          }
        }
      }
    }
  }
}

template <int DQ, int DV, bool MLA, int NQB, bool DMA, int TP, bool LA = false>
__device__ __forceinline__ void attn_item(const Params& p, int seq, int head, int qoff, bfr* sm, int dry) {
  constexpr int KLD = DQ + 8;
  constexpr int KSZ = DMA ? (MLA ? 6144 : 4096) : 64 * KLD;
  constexpr int VSZ = DMA ? DV * 64 : DV * LDT;
  constexpr int BUF = KSZ + VSZ;
  constexpr int NKK = DQ / 32;
  constexpr int NDV = DV / 16;
  constexpr int NVL = DV / 32;
  const int tid = TIDX, lane = tid & 63, wid = tid >> 6, g = lane >> 4, l15 = lane & 15;
  bfr* Z = (bfr*)(p.ws + WS_Z);
  const int sK = 2 * (l15 >> 2) + ((l15 >> 1) & 1), sR = ((l15 >> 3) & 1) * 2, sV = l15 >> 1;
  auto kaddr = [&](const bfr* Ks, int krow, int kk) -> const bfr* {
    if (DMA) return (kk < 2) ? (Ks + krow * 64 + (((kk * 4 + g) ^ sK) * 8)) : (Ks + 4096 + krow * 32 + ((g ^ sR) * 8));
    return Ks + krow * KLD + kk * 32 + g * 8;
  };
  auto vaddr = [&](const bfr* Vs, int d, int sx) -> const bfr* {
    if (DMA) return Vs + (d * 16 + l15) * 64 + (((sx * 4 + g) ^ sV) * 8);
    return Vs + (d * 16 + l15) * LDT + sx * 32 + g * 8;
  };
  const bool lat = seq >= 16;
  const int b = seq - 16;
  const int nk = lat ? 4608 : 256;
  const int rowbase = lat ? NCTX + b * 4096 : seq * 256;
  const int nkt = nk >> 6;

  bf16x8 qf[NQB][NKK];
#pragma unroll
  for (int qb = 0; qb < NQB; qb++) {
    int qrow = rowbase + qoff + wid * (16 * NQB) + qb * 16 + l15;
    const bfr* qp = MLA ? ((const bfr*)(p.ws + WS_CQ) + (long)qrow * 384 + head * 96) : (Z + (long)qrow * ZLD + C_QA + head * 64);
#pragma unroll
    for (int kk = 0; kk < NKK; kk++) qf[qb][kk] = *(const bf16x8*)(qp + kk * 32 + g * 8);
  }

  u32x4 rk[TP][2], rkr[TP], rv[TP][NVL];
  auto prefetch = [&](int pi) {
#pragma unroll
   for (int u = 0; u < TP; u++) {
    int k0 = (pi * TP + u) * 64;
    bool cache = lat && (k0 < 512);
    int tokrow0 = lat ? (NCTX + b * 4096 + k0 - 512) : (seq * 256 + k0);
    if (!MLA) {
      int kvh = head >> 2;
#pragma unroll
      for (int i = 0; i < 2; i++) {
        int c = tid + 256 * i;
        int kr_ = c >> 3, ch = c & 7;
        const bfr* src = cache ? ((const bfr*)(p.ws + WS_KCA) + (long)(b * 512 + k0 + kr_) * 128 + kvh * 64 + ch * 8)
                               : (Z + (long)(tokrow0 + kr_) * ZLD + C_KA + kvh * 64 + ch * 8);
        rk[u][i] = *(const u32x4*)src;
      }
      long vb = lat ? (16l * 32768 + (long)b * (2 * 64 * 4608)) : ((long)seq * 32768);
#pragma unroll
      for (int i = 0; i < NVL; i++) {
        int c = tid + 256 * i;
        int dv = c >> 3, ch = c & 7;
        rv[u][i] = *(const u32x4*)((const bfr*)(p.ws + WS_VTA) + vb + (long)(kvh * 64 + dv) * nk + k0 + ch * 8);
      }
    } else {
      long kb = lat ? (16l * (4 * 256 * 64) + (long)b * (4 * 4608 * 64)) : ((long)seq * (4 * 256 * 64));
#pragma unroll
      for (int i = 0; i < 2; i++) {
        int c = tid + 256 * i;
        int kr_ = c >> 3, ch = c & 7;
        rk[u][i] = *(const u32x4*)((const bfr*)(p.ws + WS_KNOPE) + kb + ((long)head * nk + k0 + kr_) * 64 + ch * 8);
      }
      {
        int kr_ = tid >> 2, ch = tid & 3;
        const bfr* src = cache ? ((const bfr*)(p.ws + WS_KRC) + (long)(b * 512 + k0 + kr_) * 32 + ch * 8)
                               : (Z + (long)(tokrow0 + kr_) * ZLD + C_KR + ch * 8);
        rkr[u] = *(const u32x4*)src;
      }
      long vb = lat ? (16l * 131072 + (long)b * (4 * 128 * 4608)) : ((long)seq * 131072);
#pragma unroll
      for (int i = 0; i < NVL; i++) {
        int c = tid + 256 * i;
        int dv = c >> 3, ch = c & 7;
        rv[u][i] = *(const u32x4*)((const bfr*)(p.ws + WS_VTC) + vb + (long)(head * 128 + dv) * nk + k0 + ch * 8);
      }
    }
   }
  };

  f32x4 o[NQB][NDV];
#pragma unroll
  for (int qb = 0; qb < NQB; qb++)
#pragma unroll
    for (int d = 0; d < NDV; d++) o[qb][d] = (f32x4){0.f, 0.f, 0.f, 0.f};
  float mrun[NQB];
  f32x4 lacc[NQB];
#pragma unroll
  for (int qb = 0; qb < NQB; qb++) { mrun[qb] = 0.f; lacc[qb] = (f32x4){0.f, 0.f, 0.f, 0.f}; }
  const bf16x8 ones = (bf16x8){(short)0x3F80, (short)0x3F80, (short)0x3F80, (short)0x3F80, (short)0x3F80, (short)0x3F80, (short)0x3F80, (short)0x3F80};

  auto dma_issue = [&](int pi, bfr* stg0, bool doK = true, bool doV = true) {
#pragma unroll
   for (int u = 0; u < TP; u++) {
    bfr* stg = stg0 + u * BUF;
    const int k0 = (pi * TP + u) * 64;
    const bool cache = lat && (k0 < 512);
    const int tokrow0 = lat ? (NCTX + b * 4096 + k0 - 512) : (seq * 256 + k0);
    const int cK = (tid & 7) ^ (((tid >> 6) & 3) * 2 + ((tid >> 4) & 1));
    const int cV = (tid & 7) ^ ((tid >> 4) & 7);
    if (MLA) {
      const long kb = lat ? (16l * (4 * 256 * 64) + (long)b * (4 * 4608 * 64)) : ((long)seq * (4 * 256 * 64));
      const long vb = lat ? (16l * 131072 + (long)b * (4 * 128 * 4608)) : ((long)seq * 131072);
      if (doK) {
#pragma unroll
        for (int i = 0; i < 2; i++)
          glds16((const bfr*)(p.ws + WS_KNOPE) + kb + ((long)head * nk + k0 + i * 32 + (tid >> 3)) * 64 + cK * 8, stg + i * 2048 + tid * 8);
        const int row = tid >> 2, c = (tid & 3) ^ (((tid >> 6) & 1) * 2);
        const bfr* src = cache ? ((const bfr*)(p.ws + WS_KRC) + (long)(b * 512 + k0 + row) * 32 + c * 8)
                               : (Z + (long)(tokrow0 + row) * ZLD + C_KR + c * 8);
        glds16(src, stg + 4096 + tid * 8);
      }
      if (doV) {
#pragma unroll
        for (int i = 0; i < 4; i++)
          glds16((const bfr*)(p.ws + WS_VTC) + vb + (long)(head * 128 + i * 32 + (tid >> 3)) * nk + k0 + cV * 8, stg + 6144 + i * 2048 + tid * 8);
      }
    } else {
      const int kvh = head >> 2;
      const long vb = lat ? (16l * 32768 + (long)b * (2 * 64 * 4608)) : ((long)seq * 32768);
#pragma unroll
      for (int i = 0; i < 2; i++) {
        const int row = i * 32 + (tid >> 3);
        const bfr* src = cache ? ((const bfr*)(p.ws + WS_KCA) + (long)(b * 512 + k0 + row) * 128 + kvh * 64 + cK * 8)
                               : (Z + (long)(tokrow0 + row) * ZLD + C_KA + kvh * 64 + cK * 8);
        glds16(src, stg + i * 2048 + tid * 8);
      }
#pragma unroll
      for (int i = 0; i < 2; i++)
        glds16((const bfr*)(p.ws + WS_VTA) + vb + (long)(kvh * 64 + i * 32 + (tid >> 3)) * nk + k0 + cV * 8, stg + 4096 + i * 2048 + tid * 8);
    }
   }
  };
  auto qk = [&](const bfr* Ks, f32x4 (&sq)[NQB][4]) {
    bf16x8 kfr[4][NKK];
#pragma unroll
    for (int t = 0; t < 2; t++) {
      int krow = 32 * (t >> 1) + 8 * (l15 >> 2) + 4 * (t & 1) + (l15 & 3);
#pragma unroll
      for (int kk = 0; kk < NKK; kk++) kfr[t][kk] = *(const bf16x8*)kaddr(Ks, krow, kk);
    }
#pragma unroll
    for (int t = 0; t < 4; t++) {
#pragma unroll
      for (int qb = 0; qb < NQB; qb++) sq[qb][t] = (f32x4){-mrun[qb], -mrun[qb], -mrun[qb], -mrun[qb]};
      if (t + 2 < 4) {
        int krow = 32 * ((t + 2) >> 1) + 8 * (l15 >> 2) + 4 * ((t + 2) & 1) + (l15 & 3);
#pragma unroll
        for (int kk = 0; kk < NKK; kk++) kfr[t + 2][kk] = *(const bf16x8*)kaddr(Ks, krow, kk);
      }
#pragma unroll
      for (int kk = 0; kk < NKK; kk++) {
#pragma unroll
        for (int qb = 0; qb < NQB; qb++) sq[qb][t] = mfma16(kfr[t][kk], qf[qb][kk], sq[qb][t]);
      }
    }
  };
  auto smpv = [&](const bfr* Vs, bool first, f32x4 (&sc)[NQB][4], f32x4 (*later)[NQB][4], int nlater) {
    bf16x8 vfr[4][2];
#pragma unroll
    for (int d = 0; d < 4; d++)
#pragma unroll
      for (int sx = 0; sx < 2; sx++) vfr[d][sx] = *(const bf16x8*)vaddr(Vs, d, sx);
    bf16x8 pf[NQB][2];
#pragma unroll
    for (int qb = 0; qb < NQB; qb++) {
      float mt = sc[qb][0][0];
#pragma unroll
      for (int t = 0; t < 4; t++)
#pragma unroll
        for (int r = 0; r < 4; r++) mt = fmaxf(mt, sc[qb][t][r]);
      if (first || __builtin_amdgcn_ballot_w64(mt > 8.f) != 0ull) {
        mt = fmaxf(mt, __shfl_xor(mt, 16));
        mt = fmaxf(mt, __shfl_xor(mt, 32));
        const bool need = first || mt > 8.f;
        const float dm = need ? mt : 0.f;
        const float alpha = first ? 1.f : __builtin_amdgcn_exp2f(-dm);
        mrun[qb] += dm;
        lacc[qb] *= alpha;
#pragma unroll
        for (int d = 0; d < NDV; d++) o[qb][d] *= alpha;
#pragma unroll
        for (int t = 0; t < 4; t++) sc[qb][t] -= dm;
#pragma unroll
        for (int u2 = 0; u2 < 2; u2++)
          if (u2 < nlater) {
#pragma unroll
            for (int t = 0; t < 4; t++) later[u2][qb][t] -= dm;
          }
      }
#pragma unroll
      for (int t = 0; t < 4; t++)
#pragma unroll
        for (int r = 0; r < 4; r++) sc[qb][t][r] = __builtin_amdgcn_exp2f(sc[qb][t][r]);
#pragma unroll
      for (int sx = 0; sx < 2; sx++) {
        u32x4 uu;
        uu.x = pack2(sc[qb][2 * sx][0], sc[qb][2 * sx][1]);
        uu.y = pack2(sc[qb][2 * sx][2], sc[qb][2 * sx][3]);
        uu.z = pack2(sc[qb][2 * sx + 1][0], sc[qb][2 * sx + 1][1]);
        uu.w = pack2(sc[qb][2 * sx + 1][2], sc[qb][2 * sx + 1][3]);
        pf[qb][sx] = *(bf16x8*)&uu;
      }
    }
#pragma unroll
    for (int d = 0; d < NDV; d++) {
#pragma unroll
      for (int sx = 0; sx < 2; sx++) {
#pragma unroll
        for (int qb = 0; qb < NQB; qb++) o[qb][d] = mfma16(vfr[d & 3][sx], pf[qb][sx], o[qb][d]);
      }
      if (d + 4 < NDV) {
#pragma unroll
        for (int sx = 0; sx < 2; sx++) vfr[d & 3][sx] = *(const bf16x8*)vaddr(Vs, d + 4, sx);
      }
    }
#pragma unroll
    for (int sx = 0; sx < 2; sx++) {
#pragma unroll
      for (int qb = 0; qb < NQB; qb++) lacc[qb] = mfma16(ones, pf[qb][sx], lacc[qb]);
    }
  };

  if (LA) {
    bfr* st0 = sm;
    bfr* st1 = sm + BUF;
    dma_issue(0, st0, true, true);
    if (nkt > 1) dma_issue(1, st1, true, false);
    asm volatile("s_waitcnt vmcnt(0)" ::: "memory");
    __syncthreads();
    f32x4 scur[1][NQB][4], snext[1][NQB][4];
    qk(st0, scur[0]);
    __syncthreads();
    for (int j = 0; j < nkt; j++) {
      bfr* sj = (j & 1) ? st1 : st0;
      bfr* sn = (j & 1) ? st0 : st1;
      if (j + 1 < nkt) dma_issue(j + 1, sn, false, true);
      if (j + 2 < nkt) dma_issue(j + 2, sj, true, false);
      const bool more = (j + 1 < nkt);
      if (more) qk(sn, snext[0]);
      smpv(sj + KSZ, j == 0, scur[0], snext, more ? 1 : 0);
      if (more) {
#pragma unroll
        for (int qb = 0; qb < NQB; qb++)
#pragma unroll
          for (int t = 0; t < 4; t++) scur[0][qb][t] = snext[0][qb][t];
      }
      asm volatile("s_waitcnt vmcnt(0)" ::: "memory");
      __syncthreads();
    }
  } else {
  if (DMA) dma_issue(0, sm); else prefetch(0);
  const int np = nkt / TP;
  for (int pi = 0; pi < np; pi++) {
    bfr* base = sm + (pi & 1) * (TP * BUF);
    if (DMA) {
      asm volatile("s_waitcnt vmcnt(0)" ::: "memory");
      __syncthreads();
      if (pi + 1 < np) dma_issue(pi + 1, sm + ((pi + 1) & 1) * (TP * BUF));
    } else {
#pragma unroll
      for (int u = 0; u < TP; u++) {
        bfr* Ks = base + u * BUF;
        bfr* Vs = Ks + KSZ;
#pragma unroll
        for (int i = 0; i < 2; i++) {
          int c = tid + 256 * i;
          *(u32x4*)(Ks + (c >> 3) * KLD + (c & 7) * 8) = rk[u][i];
        }
        if (MLA) *(u32x4*)(Ks + (tid >> 2) * KLD + 64 + (tid & 3) * 8) = rkr[u];
#pragma unroll
        for (int i = 0; i < NVL; i++) {
          int c = tid + 256 * i;
          *(u32x4*)(Vs + (c >> 3) * LDT + (c & 7) * 8) = rv[u][i];
        }
      }
      __syncthreads();
      if (pi + 1 < np) prefetch(pi + 1);
    }
    f32x4 sa[TP][NQB][4];
#pragma unroll
    for (int u = 0; u < TP; u++) qk(base + u * BUF, sa[u]);
#pragma unroll
    for (int u = 0; u < TP; u++) smpv(base + u * BUF + KSZ, pi * TP + u == 0, sa[u], &sa[(u + 1 < TP) ? u + 1 : u], TP - 1 - u);
  }
  }
  __syncthreads();
#pragma unroll
  for (int qb = 0; qb < NQB; qb++) {
    float inv = 1.f / lacc[qb][0];
    int qrow = rowbase + qoff + wid * (16 * NQB) + qb * 16 + l15;
    bfr* gp = Z + (long)qrow * ZLD + (MLA ? C_GC : C_GA) + head * DV + g * 4;
#pragma unroll
    for (int d = 0; d < NDV; d++) {
      u32x2 gr = *(const u32x2*)(gp + d * 16);
      float y0 = o[qb][d][0] * inv * siluf(lo16(gr.x));
      float y1 = o[qb][d][1] * inv * siluf(hi16(gr.x));
      float y2 = o[qb][d][2] * inv * siluf(lo16(gr.y));
      float y3 = o[qb][d][3] * inv * siluf(hi16(gr.y));
      u32x2 ov;
      ov.x = pack2(y0, y1);
      ov.y = pack2(y2, y3);
      if (!dry) *(u32x2*)(gp + d * 16) = ov;
    }
  }
}

__device__ __forceinline__ void phase_mixers(const Params& p, int l, bfr* sm, int* s_item, int dry) {
  unsigned* ctr = (unsigned*)(p.ws + WS_CTR) + (2 + l + 2 * dry) * 128;
  auto cnt = [](int) { return 184; };
  int q = (int)xcc_id(), tried = 0;
  for (;;) {
    if (TIDX == 0) {
      unsigned first = atomicAdd(ctr + q * 16, 1u);
      *s_item = xq_take(ctr, q, tried, first, cnt);
    }
    __syncthreads();
    const int it = *s_item;
    __syncthreads();
    if (it < 0) break;
    const int x = it >> 20, j = it & 0xfffff;
    int kind, a0, a1, a2, a3 = 0;
    if (j < 4) {
      int idx = x * 4 + j;
      kind = 3; a0 = idx >> 4; a1 = (idx >> 2) & 3; a2 = (idx >> 1) & 1; a3 = idx & 1;
    } else if (j < 36) {
      kind = 1; a0 = 16 + (x >> 2); a1 = x & 3; a2 = (j - 4) * 128;
    } else if (j < 96) {
      int i = j - 36;
      kind = 2; a0 = 16 + (x >> 2); a1 = ((x >> 1) & 1) * 4 + (x & 1) * 2 + (i >> 5); a2 = (i & 31) * 128;
    } else if (j < 104) {
      int k = j - 96;
      int i = 60 + (k >> 1);
      kind = 4; a0 = 16 + (x >> 2); a1 = ((x >> 1) & 1) * 4 + (x & 1) * 2 + (i >> 5); a2 = (i & 31) * 128 + (k & 1) * 64;
    } else if (j < 136) {
      int i = j - 104;
      kind = 0; a0 = 2 * x + (i >> 4); a1 = (i >> 2) & 3; a2 = (i >> 1) & 1; a3 = i & 1;
    } else if (j < 152) {
      int i = j - 136;
      kind = 1; a0 = 2 * x + (i >> 3); a1 = (i >> 1) & 3; a2 = (i & 1) * 128;
    } else {
      int i = j - 152;
      kind = 2; a0 = 2 * x + (i >> 4); a1 = (i >> 1) & 7; a2 = (i & 1) * 128;
    }
#ifdef PROBE_MIXKIND
    if (dry && ((PROBE_MIXKIND == 1) != (kind == 0 || kind == 3))) continue;
#endif
    if (kind == 0) gla_item<64>(p, l, a0, a1, a2, a3, sm);
    else if (kind == 3) gla_chain_item(p, l, a0, a1, a2, a3, sm);
    else if (kind == 1) attn_item<96, 128, true, 2, true, 1, true>(p, a0, a1, a2, sm, dry);
    else if (kind == 2) attn_item<64, 64, false, 2, true, 2>(p, a0, a1, a2, sm, dry);
    else attn_item<64, 64, false, 1, true, 2>(p, a0, a1, a2, sm, dry);
  }
}

__device__ __forceinline__ void phase_gla_out(const Params& p, int l) {
  const int lane = TIDX & 63;
  bfr* Z = (bfr*)(p.ws + WS_Z);
  const bfr* OF = (const bfr*)(p.ws + WS_R1);
  const bfr* OB = OF + (long)NROWS * 512;
  for (int row = blockIdx.x * 4 + (TIDX >> 6); row < NROWS; row += gridDim.x * 4) {
    float a[8], c[8], gt[8];
    unpack8(*(const u32x4*)(OF + (long)row * 512 + lane * 8), a);
    unpack8(*(const u32x4*)(OB + (long)row * 512 + lane * 8), c);
    bfr* gp = Z + (long)row * ZLD + C_GG + lane * 8;
    unpack8(*(const u32x4*)gp, gt);
    float ss = 0.f;
#pragma unroll
    for (int e = 0; e < 8; e++) {
      a[e] = bf2f(f2bf(a[e] + c[e]));
      ss += a[e] * a[e];
    }
    ss += __shfl_xor(ss, 1); ss += __shfl_xor(ss, 2); ss += __shfl_xor(ss, 4); ss += __shfl_xor(ss, 8);
    float rs = rsqrtf(ss * (1.f / 128.f) + 1e-6f);
    const float* gg = p.in[21] + l * 128 + (lane & 15) * 8;
#pragma unroll
    for (int e = 0; e < 8; e++) a[e] = a[e] * rs * gg[e] * siluf(gt[e]);
    *(u32x4*)gp = pack8(a);
  }
}

template <int NQ>
__device__ __forceinline__ void merge_tile(const Params& p, bfr* sm, int tn, int tok0) {
  constexpr int STG = 8192 + 2048 * NQ;
  bfr* Z = (bfr*)(p.ws + WS_Z);
  bfr* MG = (bfr*)(p.ws + WS_R1);
  const int tid = TIDX;
  const int lane = tid & 63, wid = tid >> 6, wr = wid >> 1, wc = wid & 1, g = lane >> 4, l15 = lane & 15;
  f32x4 totl[4][NQ];
#pragma unroll
  for (int a = 0; a < 4; a++)
#pragma unroll
    for (int b = 0; b < NQ; b++) totl[a][b] = (f32x4){0.f, 0.f, 0.f, 0.f};
#pragma unroll 1
  for (int seg = 0; seg < 3; seg++) {
    f32x4 acc[4][NQ];
#pragma unroll
    for (int a = 0; a < 4; a++)
#pragma unroll
      for (int b = 0; b < NQ; b++) acc[a][b] = (f32x4){0.f, 0.f, 0.f, 0.f};
    int ycol = seg == 0 ? C_GA : (seg == 1 ? C_GG : C_GC);
    int mcol = C_M1 + seg * 1024;
    const bfr* W = (const bfr*)(p.ws + WS_WOA + (unsigned long)seg * 1048576ul) + (long)tn * 128 * 512;
    gemm128k64<NQ, false, true>(W, 512, 128, Z + (long)tok0 * ZLD + ycol, ZLD, 512, acc, sm,
                                Z + (long)tok0 * ZLD + mcol + tn * 128, ZLD);
    const bfr* gt = sm;
#pragma unroll
    for (int pi = 0; pi < 4; pi++) {
      const int nl = wr * 64 + pi * 16 + g * 4;
#pragma unroll
      for (int qi = 0; qi < NQ; qi++) {
        const int tl = wc * 16 * NQ + qi * 16 + l15;
        u32x2 mr = *(const u32x2*)(gt + tl * 128 + (((nl >> 3) ^ (tl & 15)) * 8) + (nl & 4));
        totl[pi][qi][0] += sigmf(lo16(mr.x)) * acc[pi][qi][0];
        totl[pi][qi][1] += sigmf(hi16(mr.x)) * acc[pi][qi][1];
        totl[pi][qi][2] += sigmf(lo16(mr.y)) * acc[pi][qi][2];
        totl[pi][qi][3] += sigmf(hi16(mr.y)) * acc[pi][qi][3];
      }
    }
    __syncthreads();
  }
#pragma unroll
  for (int pi = 0; pi < 4; pi++)
#pragma unroll
    for (int qi = 0; qi < NQ; qi++) {
      u32x2 o;
      o.x = pack2(totl[pi][qi][0], totl[pi][qi][1]);
      o.y = pack2(totl[pi][qi][2], totl[pi][qi][3]);
      *(u32x2*)(sm + (wc * 16 * NQ + qi * 16 + l15) * 136 + wr * 64 + pi * 16 + g * 4) = o;
    }
  __syncthreads();
#pragma unroll
  for (int i = 0; i < 2 * NQ; i++) {
    int c = tid + 256 * i;
    int row = c >> 4, c16 = c & 15;
    *(u32x4*)(MG + (long)(tok0 + row) * 1024 + tn * 128 + c16 * 8) = *(const u32x4*)(sm + row * 136 + c16 * 8);
  }
  __syncthreads();
}

__device__ __forceinline__ void phase_merge(const Params& p, bfr* sm) {
  for (int t = blockIdx.x; t < 1024; t += gridDim.x) {
    if (t < 512) {
      merge_tile<4>(p, sm, (t >> 3) & 7, ((t & 7) + 8 * (t >> 6)) * 128);
    } else {
      int u = t - 512;
      int full = 512 + (u >> 1);
      merge_tile<2>(p, sm, full & 7, (full >> 3) * 128 + (u & 1) * 64);
    }
  }
}

template <int NQ>
__device__ __forceinline__ void outproj_tile(const Params& p, bfr* sm, int tn, int tok0) {
  const bfr* MG = (const bfr*)(p.ws + WS_R1);
  float* OUT = (float*)(p.ws + WS_Z);
  const int tid = TIDX;
  const int lane = tid & 63, wid = tid >> 6, wr = wid >> 1, wc = wid & 1, g = lane >> 4, l15 = lane & 15;
  f32x4 acc[4][NQ];
#pragma unroll
  for (int a = 0; a < 4; a++)
#pragma unroll
    for (int b = 0; b < NQ; b++) acc[a][b] = (f32x4){0.f, 0.f, 0.f, 0.f};
  gemm128k64<NQ, true>((const bfr*)(p.ws + WS_WOUT) + (long)tn * 128 * 1024, 1024, 128, MG + (long)tok0 * 1024, 1024, 1024, acc, sm);
  float* smf = (float*)sm;
#pragma unroll
  for (int pi = 0; pi < 4; pi++)
#pragma unroll
    for (int qi = 0; qi < NQ; qi++)
      *(f32x4*)(smf + (wc * 16 * NQ + qi * 16 + l15) * 132 + wr * 64 + pi * 16 + g * 4) = acc[pi][qi];
  __syncthreads();
#pragma unroll
  for (int i = 0; i < 4 * NQ; i++) {
    int c = tid + 256 * i;
    int row = c >> 5, c16 = c & 31;
    *(f32x4*)(OUT + (long)(tok0 + row) * 1024 + tn * 128 + c16 * 4) = *(const f32x4*)(smf + row * 132 + c16 * 4);
  }
  __syncthreads();
}
__device__ __forceinline__ void phase_outproj(const Params& p, bfr* sm) {
  for (int t = blockIdx.x; t < 1024; t += gridDim.x) {
    if (t < 512) {
      outproj_tile<4>(p, sm, (t >> 3) & 7, ((t & 7) + 8 * (t >> 6)) * 128);
    } else {
      int u = t - 512;
      int full = 512 + (u >> 1);
      outproj_tile<2>(p, sm, full & 7, (full >> 3) * 128 + (u & 1) * 64);
    }
  }
}

__device__ __forceinline__ void phase_post(const Params& p, int l) {
  const int lane = TIDX & 63;
  const float* mod = (const float*)(p.ws + WS_MOD);
  const float* OUT = (const float*)(p.ws + WS_Z);
  bfr* H = (bfr*)(p.ws + WS_R1);
  for (int row = blockIdx.x * 4 + (TIDX >> 6); row < NROWS; row += gridDim.x * 4) {
    const float* x = (l == 0) ? xrow(p, row) : (p.out + (long)row * 1024);
    const float* md = mod + (l * 3 + row_cond(row)) * 3072;
    float4 v[4];
    float ss = 0.f;
#pragma unroll
    for (int i = 0; i < 4; i++) {
      v[i] = *(const float4*)(OUT + (long)row * 1024 + i * 256 + lane * 4);
      ss += v[i].x * v[i].x + v[i].y * v[i].y + v[i].z * v[i].z + v[i].w * v[i].w;
    }
    ss = wave_sum(ss);
    float rs = rsqrtf(ss * (1.f / 1024.f) + 1e-6f);
    float ss2 = 0.f;
#pragma unroll
    for (int i = 0; i < 4; i++) {
      int n = i * 256 + lane * 4;
      float4 g = *(const float4*)(p.in[13] + l * 1024 + n);
      float4 gt = *(const float4*)(md + 2048 + n);
      float4 xv = *(const float4*)(x + n);
      v[i].x = xv.x + gt.x * (v[i].x * rs * g.x);
      v[i].y = xv.y + gt.y * (v[i].y * rs * g.y);
      v[i].z = xv.z + gt.z * (v[i].z * rs * g.z);
      v[i].w = xv.w + gt.w * (v[i].w * rs * g.w);
      *(float4*)(p.out + (long)row * 1024 + n) = v[i];
      ss2 += v[i].x * v[i].x + v[i].y * v[i].y + v[i].z * v[i].z + v[i].w * v[i].w;
    }
    if (l == 0) {
      ss2 = wave_sum(ss2);
      float rs2 = rsqrtf(ss2 * (1.f / 1024.f) + 1e-6f);
      const float* md1 = mod + (1 * 3 + row_cond(row)) * 3072;
#pragma unroll
      for (int i = 0; i < 4; i++) {
        int n = i * 256 + lane * 4;
        float4 g = *(const float4*)(p.in[12] + 1024 + n);
        float4 sh = *(const float4*)(md1 + n);
        float4 sc = *(const float4*)(md1 + 1024 + n);
        float h0 = v[i].x * rs2 * g.x * (1.f + sc.x) + sh.x;
        float h1 = v[i].y * rs2 * g.y * (1.f + sc.y) + sh.y;
        float h2 = v[i].z * rs2 * g.z * (1.f + sc.z) + sh.z;
        float h3 = v[i].w * rs2 * g.w * (1.f + sc.w) + sh.w;
        u32x2 o;
        o.x = pack2(h0, h1);
        o.y = pack2(h2, h3);
        *(u32x2*)(H + (long)row * 1024 + n) = o;
      }
    }
  }
}

__global__ void __launch_bounds__(256, 2) fwd_megakernel(Params p) {
  __shared__ __attribute__((aligned(16))) bfr sm[SMEM_SHORTS + 16];
  int* s_item_p = (int*)(sm + SMEM_SHORTS + 8);
  cg::grid_group grid = cg::this_grid();
  if (threadIdx.x == 0) { ((unsigned*)(sm + SMEM_SHORTS))[0] = 0u; ((unsigned*)(sm + SMEM_SHORTS))[1] = 0u; }
  __syncthreads();
  XcdBarrier xb = xcd_barrier_post((unsigned*)(p.ws + WS_BAR), (volatile LAS unsigned*)(sm + SMEM_SHORTS));
  if (p.ws == nullptr) grid.sync();
  (void)xb;
#define GSYNC1 do { XcdBarrier b_; b_.bar = (unsigned*)(p.ws + WS_BAR); b_.x = xb_xcc_id(); \
                    b_.st = (volatile LAS unsigned*)(sm + SMEM_SHORTS); xcd_barrier(b_); } while (0)
#ifdef PROBE_SYNC
#define GSYNC do { GSYNC1; GSYNC1; } while (0)
#else
#define GSYNC GSYNC1
#endif
#ifdef PROBE_PRE
  phase_s0(launder(p), sm);
  GSYNC;
  phase_s1(launder(p));
  wconv_phase(p, 0, sm);
  GSYNC;
  phase_prenorm0(launder(p));
  GSYNC;
#endif

#ifndef PH
#define PH 0xffff
#endif
#if PH & 1
  phase_s0(launder(p), sm);
  wconv_phase(p, 0, sm);
#endif
  GSYNC;
#if PH & 2
  phase_s1(launder(p));
#endif
  GSYNC;
#if PH & 4
  phase_prenorm0(launder(p));
#endif
  GSYNC;
  for (int l = 0; l < 2; l++) {
#if PH & 8
#ifdef PROBE_INPROJ
    phase_inproj(launder(p), l, sm, s_item_p, 6 + l);
    GSYNC;
#endif
    phase_inproj(launder(p), l, sm, s_item_p, l);
#endif
    GSYNC;
#if PH & 16
    phase_rowpost(launder(p), l);
#endif
    GSYNC;
#if PH & 32
#ifdef PROBE_MLAUP
    phase_mla_up(launder(p), l, sm);
    GSYNC;
#endif
    phase_mla_up(launder(p), l, sm);
#endif
    GSYNC;
#if PH & 64
#ifdef PROBE_MIX
    { int dry = 1; asm volatile("" : "+s"(dry)); phase_mixers(launder(p), l, sm, s_item_p, dry); }
    GSYNC;
#endif
    { int dry = 0; asm volatile("" : "+s"(dry)); phase_mixers(launder(p), l, sm, s_item_p, dry); }
#endif
    GSYNC;
#if PH & 128
    phase_gla_out(launder(p), l);
#endif
    GSYNC;
#if PH & 256
#ifdef PROBE_MERGE
    phase_merge(launder(p), sm);
    GSYNC;
#endif
    phase_merge(launder(p), sm);
#endif
    GSYNC;
#if PH & 512
#ifdef PROBE_MERGE
    phase_outproj(launder(p), sm);
    GSYNC;
#endif
    phase_outproj(launder(p), sm);
#endif
    GSYNC;
#if PH & 1024
    phase_post(launder(p), l);
    if (l == 0) wconv_phase(p, 1, sm);
#endif
    if (l == 0) GSYNC;
  }
}

extern "C" void kernel_launch(void* const* d_in, const int* in_sizes, int n_in, void* d_out, int out_size, void* d_ws,
                              size_t ws_size, hipStream_t stream) {
  static int grid_blocks = 0;
  if (!grid_blocks) {
    int dev = 0, cus = 0, per_cu = 0;
    hipGetDevice(&dev);
    hipDeviceGetAttribute(&cus, hipDeviceAttributeMultiprocessorCount, dev);
    hipOccupancyMaxActiveBlocksPerMultiprocessor(&per_cu, fwd_megakernel, 256, 0);
    if (per_cu > 2) per_cu = 2;
    if (per_cu < 1) per_cu = 1;
    grid_blocks = cus * per_cu;
  }
  Params p{};
  for (int i = 0; i < 30; i++) p.in[i] = (const float*)d_in[i];
  p.out = (float*)d_out;
  p.ws = (unsigned char*)d_ws;
  hipMemsetAsync(d_ws, 0, 20480, stream);
  void* args[] = {&p};
  hipError_t e = hipLaunchCooperativeKernel((void*)fwd_megakernel, dim3(grid_blocks), dim3(256), args, 0, stream);
  if (e != hipSuccess) fprintf(stderr, "cooperative launch failed: %s (grid %d)\n", hipGetErrorString(e), grid_blocks);
}
```

```cpp
#include <hip/hip_runtime.h>
#include <hip/hip_cooperative_groups.h>
#include <cstdio>
namespace cg = cooperative_groups;

typedef unsigned short bfr;
typedef __attribute__((ext_vector_type(8))) short bf16x8;
typedef __attribute__((ext_vector_type(4))) float f32x4;
typedef __attribute__((ext_vector_type(4))) unsigned u32x4;
typedef __attribute__((ext_vector_type(2))) unsigned u32x2;

#define NROWS 12288
#define NCTX 4096
#define ZLD 6976
#define LDT 72
#define SMEM_SHORTS (4 * 128 * LDT)

#define C_QA 0
#define C_KA 512
#define C_VA 640
#define C_GA 768
#define C_QG 1280
#define C_KG 1536
#define C_VG 1792
#define C_GG 2304
#define C_RF 2816
#define C_RB 2832
#define C_QL 2848
#define C_KV 3104
#define C_KR 3360
#define C_GC 3392
#define C_M1 3904
#define C_M2 4928
#define C_M3 5952

#define WS_BAR 0ul
#define WS_CTR 16384ul
#define WS_MODP 20480ul
#define WS_MOD (WS_MODP + 589824ul)
#define WS_ROPE (WS_MOD + 73728ul)
#define WS_WIN (WS_ROPE + 16384ul)
#define WS_WUQ (WS_WIN + 14417920ul)
#define WS_WUKV (WS_WUQ + 196608ul)
#define WS_WOA (WS_WUKV + 393216ul)
#define WS_WOB (WS_WOA + 1048576ul)
#define WS_WOC (WS_WOB + 1048576ul)
#define WS_WOUT (WS_WOC + 1048576ul)
#define WS_KCA (WS_WOUT + 2097152ul)
#define WS_CKVC (WS_KCA + 262144ul)
#define WS_KRC (WS_CKVC + 524288ul)
#define WS_VTA (WS_KRC + 65536ul)
#define WS_CQ (WS_VTA + 3407872ul)
#define WS_KNOPE (WS_CQ + 9437184ul)
#define WS_VTC (WS_KNOPE + 6815744ul)
#define WS_R1 (WS_VTC + 13631488ul)
#define WS_Z (WS_R1 + 25165824ul)
#define WS_END (WS_Z + 171442176ul)

#define O_Y 0
#define O_GK 12582912
#define O_GV 13631488
#define O_CKV 14680064
#define O_KR 16777216
#define O_SF 17039360
#define O_SB 18087936

struct Params {
  const float* in[30];
  float* out;
  unsigned char* ws;
};

__device__ __forceinline__ int tidx() {
  int t = threadIdx.x;
  asm volatile("" : "+v"(t));
  return t;
}
__device__ __forceinline__ Params launder(const Params& p) {
  Params q;
  long zo = 0;
  asm volatile("" : "+s"(zo));
#pragma unroll
  for (int i = 0; i < 30; i++) q.in[i] = p.in[i] + zo;
  q.out = p.out + zo;
  q.ws = p.ws + zo;
  return q;
}
__device__ __forceinline__ float bf2f(bfr b) { return __uint_as_float(((unsigned)b) << 16); }
typedef float f32x2_t __attribute__((ext_vector_type(2)));
typedef __bf16 bf16x2_t __attribute__((ext_vector_type(2)));
__device__ __forceinline__ bfr f2bf(float f) {
  __bf16 r = (__bf16)f;
  return *(bfr*)&r;
}
__device__ __forceinline__ unsigned pack2(float a, float b) {
  f32x2_t v = {a, b};
  bf16x2_t r = __builtin_convertvector(v, bf16x2_t);
  return *(unsigned*)&r;
}
__device__ __forceinline__ float lo16(unsigned u) { return __uint_as_float(u << 16); }
__device__ __forceinline__ float hi16(unsigned u) { return __uint_as_float(u & 0xffff0000u); }
__device__ __forceinline__ float siluf(float x) { return x / (1.f + __expf(-x)); }
__device__ __forceinline__ float sigmf(float x) { return 1.f / (1.f + __expf(-x)); }
__device__ __forceinline__ f32x4 mfma16(bf16x8 a, bf16x8 b, f32x4 c) {
  return __builtin_amdgcn_mfma_f32_16x16x32_bf16(a, b, c, 0, 0, 0);
}
__device__ __forceinline__ const float* xrow(const Params& p, int row) {
  return row < NCTX ? p.in[0] + (long)row * 1024 : p.in[1] + (long)(row - NCTX) * 1024;
}
__device__ __forceinline__ int row_cond(int row) { return row < NCTX ? 0 : 1 + ((row - NCTX) >> 12); }
__device__ __forceinline__ float wave_sum(float v) {
  v += __shfl_xor(v, 1); v += __shfl_xor(v, 2); v += __shfl_xor(v, 4);
  v += __shfl_xor(v, 8); v += __shfl_xor(v, 16); v += __shfl_xor(v, 32);
  return v;
}

#define XB_TMO      128
#define XB_XCNT(j)  (256  + 64 * (j))
#define XB_XSUB(j)  (1280 + 64 * (j))
#define XB_XGEN(j)  (2304 + 64 * (j))
#define XB_TOP      3328
#define XB_TOPGEN   3392
#define XCD_BAR_WORDS 3456
#define XB_SPIN_CAP (1u << 18)
#define LAS __attribute__((address_space(3)))

__device__ __forceinline__ unsigned xb_ld(unsigned* p)              { return __hip_atomic_load(p, __ATOMIC_RELAXED, __HIP_MEMORY_SCOPE_AGENT); }
__device__ __forceinline__ unsigned xb_add(unsigned* p, unsigned v) { return __hip_atomic_fetch_add(p, v, __ATOMIC_RELAXED, __HIP_MEMORY_SCOPE_AGENT); }
__device__ __forceinline__ unsigned xb_xcc_id() { return (unsigned)__builtin_amdgcn_s_getreg((3 << 11) | 20) & 0xFu; }
#define XB_SPIN(cond, bar) do { unsigned _sp = 0; while (cond) { __builtin_amdgcn_s_sleep(1); \
    if ((++_sp & 255u) == 0u) { if (xb_ld(&(bar)[XB_TMO])) break; if (_sp > XB_SPIN_CAP) { atomicAdd(&(bar)[XB_TMO], 1u); break; } } } } while (0)

struct XcdBarrier {
    unsigned* bar; unsigned x;
    volatile LAS unsigned* st;
};

__device__ __forceinline__ XcdBarrier xcd_barrier_post(unsigned* bar, volatile LAS unsigned* st) {
    XcdBarrier b; b.bar = bar; b.x = xb_xcc_id(); b.st = st;
    if (threadIdx.x == 0) (void)xb_add(&bar[XB_XCNT(b.x)], 1u);
    return b;
}
__device__ __forceinline__ void xcd_barrier_complete(unsigned* bar, unsigned x, unsigned& nloc, unsigned& nx) {
    const unsigned G = gridDim.x * gridDim.y * gridDim.z;
    unsigned sum, cnt, mine, sp = 0u;
    for (;;) {
        sum = 0u; cnt = 0u; mine = 0u;
#pragma unroll
        for (unsigned j = 0; j < 16; ++j) { const unsigned c = xb_ld(&bar[XB_XCNT(j)]); sum += c; cnt += (c > 0u) ? 1u : 0u; mine = (j == x) ? c : mine; }
        if (sum == G) break;
        __builtin_amdgcn_s_sleep(1);
        if ((++sp & 255u) == 0u) { if (xb_ld(&bar[XB_TMO])) break; if (sp > XB_SPIN_CAP) { atomicAdd(&bar[XB_TMO], 1u); break; } }
    }
    nloc = mine > 0u ? mine : 1u; nx = cnt > 0u ? cnt : 1u;
}

__device__ __forceinline__ void xcd_barrier(const XcdBarrier& b) {
    asm volatile("s_waitcnt vmcnt(0)" ::: "memory");
    __syncthreads();
    if (threadIdx.x == 0) {
        unsigned* bar = b.bar;
        __builtin_amdgcn_s_waitcnt(0);
        unsigned nloc = b.st[0], nx = b.st[1];
        if (nloc == 0u) { xcd_barrier_complete(bar, b.x, nloc, nx); b.st[0] = nloc; b.st[1] = nx; }
        const unsigned old = xb_add(&bar[XB_XSUB(b.x)], 1u);
        const unsigned gen = old / nloc;
        if (old + 1u == (gen + 1u) * nloc) {
            __builtin_amdgcn_fence(__ATOMIC_RELEASE, "agent");
            asm volatile("s_waitcnt vmcnt(0)" ::: "memory");
            const unsigned og = xb_add(&bar[XB_TOP], 1u);
            const unsigned tg = og / nx;
            if (og + 1u == (tg + 1u) * nx) xb_add(&bar[XB_TOPGEN], 1u);
            else XB_SPIN(xb_ld(&bar[XB_TOPGEN]) == tg, bar);
            __builtin_amdgcn_fence(__ATOMIC_ACQUIRE, "agent");
            xb_add(&bar[XB_XGEN(b.x)], 1u);
            asm volatile("s_waitcnt vmcnt(0)" ::: "memory");
        } else {
            XB_SPIN(xb_ld(&bar[XB_XGEN(b.x)]) == gen, bar);
            __builtin_amdgcn_fence(__ATOMIC_ACQUIRE, "agent");
            asm volatile("s_waitcnt vmcnt(0)" ::: "memory");
        }
    }
    __syncthreads();
}


#define TIDX tidx()
#define LDS3 __attribute__((address_space(3)))
__device__ __forceinline__ void glds16(const bfr* g, bfr* l) {
  __builtin_amdgcn_global_load_lds((const unsigned*)g, (LDS3 unsigned*)l, 16, 0, 0);
}
__device__ __forceinline__ void gemm128(const bfr* __restrict__ P, long ldp, int pmax,
                                        const bfr* __restrict__ Q, long ldq, int qmax, int K,
                                        f32x4 (&acc)[4][4], bfr* sm) {
  const int tid = TIDX, lane = tid & 63, wid = tid >> 6;
  const int wr = wid >> 1, wc = wid & 1;
  const int l15 = lane & 15, g = lane >> 4;
  const bfr* pp[2];
  const bfr* qp[2];
  {
    const int r0 = tid >> 2;
    const int c = (tid & 3) ^ ((tid >> 4) & 3);
#pragma unroll
    for (int i = 0; i < 2; i++) {
      int r = r0 + 64 * i;
      pp[i] = P + (long)min(r, pmax - 1) * ldp + c * 8;
      qp[i] = Q + (long)min(r, qmax - 1) * ldq + c * 8;
    }
  }
  const int nk = K >> 5;
#define GEMM_ISSUE(T)                                                    \
  do {                                                                   \
    bfr* nb_ = sm + ((T) & 3) * 8192;                                    \
    glds16(pp[0] + (T) * 32, nb_ + tid * 8);                             \
    glds16(pp[1] + (T) * 32, nb_ + 2048 + tid * 8);                      \
    glds16(qp[0] + (T) * 32, nb_ + 4096 + tid * 8);                      \
    glds16(qp[1] + (T) * 32, nb_ + 6144 + tid * 8);                      \
  } while (0)
  GEMM_ISSUE(0);
  GEMM_ISSUE(1);
  GEMM_ISSUE(2);
  const int pos = (g ^ ((l15 >> 2) & 3)) * 8;
  for (int kt = 0; kt < nk; kt++) {
    if (kt + 2 < nk) asm volatile("s_waitcnt vmcnt(8)" ::: "memory");
    else if (kt + 1 < nk) asm volatile("s_waitcnt vmcnt(4)" ::: "memory");
    else asm volatile("s_waitcnt vmcnt(0)" ::: "memory");
    __builtin_amdgcn_s_barrier();
    if (kt + 3 < nk) GEMM_ISSUE(kt + 3);
    const bfr* Ps = sm + (kt & 3) * 8192;
    const bfr* Qs = Ps + 4096;
    bf16x8 pf[4], qf[4];
#pragma unroll
    for (int m = 0; m < 4; m++) {
      pf[m] = *(const bf16x8*)(Ps + (wr * 64 + m * 16 + l15) * 32 + pos);
      qf[m] = *(const bf16x8*)(Qs + (wc * 64 + m * 16 + l15) * 32 + pos);
    }
#pragma unroll
    for (int m = 0; m < 4; m++)
#pragma unroll
      for (int n = 0; n < 4; n++) acc[m][n] = mfma16(pf[m], qf[n], acc[m][n]);
  }
#undef GEMM_ISSUE
  __syncthreads();
}

template <int NQ>
__device__ __forceinline__ void gemm128q(const bfr* __restrict__ P, long ldp, const bfr* __restrict__ Q, long ldq, int K,
                                         f32x4 (&acc)[4][NQ], bfr* sm) {
  constexpr int QI = NQ / 2;
  constexpr int STG = 4096 + QI * 2048;
  const int tid = TIDX, lane = tid & 63, wid = tid >> 6;
  const int wr = wid >> 1, wc = wid & 1;
  const int l15 = lane & 15, g = lane >> 4;
  const bfr* pp[2];
  const bfr* qp[QI];
  {
    const int r0 = tid >> 2;
    const int c = (tid & 3) ^ (((tid >> 5) & 1) * 3);
#pragma unroll
    for (int i = 0; i < 2; i++) pp[i] = P + (long)(r0 + 64 * i) * ldp + c * 8;
#pragma unroll
    for (int i = 0; i < QI; i++) qp[i] = Q + (long)(r0 + 64 * i) * ldq + c * 8;
  }
  const int nk = K >> 5;
  auto issue = [&](int T) {
    bfr* nb_ = sm + (T & 3) * STG;
    glds16(pp[0] + T * 32, nb_ + tid * 8);
    glds16(pp[1] + T * 32, nb_ + 2048 + tid * 8);
#pragma unroll
    for (int i = 0; i < QI; i++) glds16(qp[i] + T * 32, nb_ + 4096 + i * 2048 + tid * 8);
  };
  issue(0);
  issue(1);
  issue(2);
  const int pos = (g ^ (((l15 >> 3) & 1) * 3)) * 8;
  for (int kt = 0; kt < nk; kt++) {
    if (kt + 2 < nk) {
      if (QI == 2) asm volatile("s_waitcnt vmcnt(8)" ::: "memory"); else asm volatile("s_waitcnt vmcnt(6)" ::: "memory");
    } else if (kt + 1 < nk) {
      if (QI == 2) asm volatile("s_waitcnt vmcnt(4)" ::: "memory"); else asm volatile("s_waitcnt vmcnt(3)" ::: "memory");
    } else {
      asm volatile("s_waitcnt vmcnt(0)" ::: "memory");
    }
    __builtin_amdgcn_s_barrier();
    if (kt + 3 < nk) issue(kt + 3);
    const bfr* Ps = sm + (kt & 3) * STG;
    const bfr* Qs = Ps + 4096;
    bf16x8 pf[4], qf[NQ];
#pragma unroll
    for (int m = 0; m < 4; m++) pf[m] = *(const bf16x8*)(Ps + (wr * 64 + m * 16 + l15) * 32 + pos);
#pragma unroll
    for (int n = 0; n < NQ; n++) qf[n] = *(const bf16x8*)(Qs + (wc * 16 * NQ + n * 16 + l15) * 32 + pos);
#pragma unroll
    for (int m = 0; m < 4; m++)
#pragma unroll
      for (int n = 0; n < NQ; n++) acc[m][n] = mfma16(pf[m], qf[n], acc[m][n]);
  }
  __syncthreads();
}

template <int NQ>
__device__ __forceinline__ void gemm256x128(const bfr* __restrict__ P, long ldp, int pmax,
                                            const bfr* __restrict__ Q, long ldq, int K,
                                            f32x4 (&acc)[8][NQ], bfr* sm) {
  constexpr int QI = NQ / 2;
  constexpr int STG = 8192 + QI * 2048;
  const int tid = TIDX, lane = tid & 63, wid = tid >> 6;
  const int wr = wid >> 1, wc = wid & 1;
  const int l15 = lane & 15, g = lane >> 4;
  const bfr* pp[4];
  const bfr* qp[QI];
  {
    const int r0 = tid >> 2;
    const int c = (tid & 3) ^ (((tid >> 5) & 1) * 3);
#pragma unroll
    for (int i = 0; i < 4; i++) pp[i] = P + (long)min(r0 + 64 * i, pmax - 1) * ldp + c * 8;
#pragma unroll
    for (int i = 0; i < QI; i++) qp[i] = Q + (long)(r0 + 64 * i) * ldq + c * 8;
  }
  const int nk = K >> 5;
  auto issue = [&](int T, int stg) {
    bfr* nb_ = sm + stg * STG;
    glds16(pp[0] + T * 32, nb_ + tid * 8);
    glds16(pp[1] + T * 32, nb_ + 2048 + tid * 8);
    glds16(pp[2] + T * 32, nb_ + 4096 + tid * 8);
    glds16(pp[3] + T * 32, nb_ + 6144 + tid * 8);
#pragma unroll
    for (int i = 0; i < QI; i++) glds16(qp[i] + T * 32, nb_ + 8192 + i * 2048 + tid * 8);
  };
  issue(0, 0);
  issue(1, 1);
  const int pos = (g ^ (((l15 >> 3) & 1) * 3)) * 8;
  int st = 0;
  for (int kt = 0; kt < nk; kt++) {
    if (kt + 1 < nk) {
      if (QI == 2) asm volatile("s_waitcnt vmcnt(6)" ::: "memory"); else asm volatile("s_waitcnt vmcnt(5)" ::: "memory");
    } else {
      asm volatile("s_waitcnt vmcnt(0)" ::: "memory");
    }
    __builtin_amdgcn_s_barrier();
    if (kt + 2 < nk) issue(kt + 2, st == 0 ? 2 : st - 1);
    const bfr* Ps = sm + st * STG;
    const bfr* Qs = Ps + 8192;
    st = (st == 2) ? 0 : st + 1;
    bf16x8 qf[NQ], pf[8];
#pragma unroll
    for (int n = 0; n < NQ; n++) qf[n] = *(const bf16x8*)(Qs + (wc * 16 * NQ + n * 16 + l15) * 32 + pos);
#pragma unroll
    for (int m = 0; m < 8; m++) pf[m] = *(const bf16x8*)(Ps + (wr * 128 + m * 16 + l15) * 32 + pos);
#pragma unroll
    for (int m = 0; m < 8; m++)
#pragma unroll
      for (int n = 0; n < NQ; n++) acc[m][n] = mfma16(pf[m], qf[n], acc[m][n]);
    __builtin_amdgcn_sched_group_barrier(0x100, NQ + 2, 0);
#pragma unroll
    for (int i = 0; i < 6; i++) {
      __builtin_amdgcn_sched_group_barrier(0x008, NQ, 0);
      __builtin_amdgcn_sched_group_barrier(0x100, 1, 0);
    }
    __builtin_amdgcn_sched_group_barrier(0x008, 2 * NQ, 0);
  }
  __syncthreads();
}

template <int NQ, bool PIPE, bool TAIL = false>
__device__ __forceinline__ void gemm128k64(const bfr* __restrict__ P, long ldp, int pmax,
                                           const bfr* __restrict__ Q, long ldq, int K,
                                           f32x4 (&acc)[4][NQ], bfr* sm, const bfr* tail_src = nullptr, long tail_ld = 0) {
  constexpr int STG = 8192 + 2048 * NQ;
  const int tid = TIDX, lane = tid & 63, wid = tid >> 6;
  const int wr = wid >> 1, wc = wid & 1;
  const int l15 = lane & 15, g = lane >> 4;
  const bfr* pp[4];
  const bfr* qp[NQ];
  {
    const int r0 = tid >> 3;
    const int c = (tid & 7) ^ ((tid >> 4) & 7);
#pragma unroll
    for (int i = 0; i < 4; i++) pp[i] = P + (long)min(r0 + 32 * i, pmax - 1) * ldp + c * 8;
#pragma unroll
    for (int i = 0; i < NQ; i++) qp[i] = Q + (long)(r0 + 32 * i) * ldq + c * 8;
  }
  const int nk = K >> 6;
#pragma unroll
  for (int i = 0; i < 4; i++) glds16(pp[i], sm + i * 2048 + tid * 8);
#pragma unroll
  for (int i = 0; i < NQ; i++) glds16(qp[i], sm + 8192 + i * 2048 + tid * 8);
  const int swz = l15 >> 1;
  for (int kt = 0; kt < nk; kt++) {
    asm volatile("s_waitcnt vmcnt(0)" ::: "memory");
    __builtin_amdgcn_s_barrier();
    if (kt + 1 < nk) {
      bfr* nb = sm + ((kt + 1) & 1) * STG;
#pragma unroll
      for (int i = 0; i < 4; i++) glds16(pp[i] + (kt + 1) * 64, nb + i * 2048 + tid * 8);
#pragma unroll
      for (int i = 0; i < NQ; i++) glds16(qp[i] + (kt + 1) * 64, nb + 8192 + i * 2048 + tid * 8);
    } else if (TAIL) {
      bfr* nb = sm + ((kt + 1) & 1) * STG;
      const bfr* ts = tail_src + (long)(tid >> 4) * tail_ld + (((tid & 15) ^ ((tid >> 4) & 15)) * 8);
#pragma unroll
      for (int i = 0; i < 2 * NQ; i++) glds16(ts + (long)(16 * i) * tail_ld, nb + i * 2048 + tid * 8);
    }
    const bfr* Ps = sm + (kt & 1) * STG;
    const bfr* Qs = Ps + 8192;
    if (PIPE) {
      bf16x8 pf[2][4], qf[2][NQ];
#pragma unroll
      for (int kk = 0; kk < 2; kk++) {
        const int pos = ((kk * 4 + g) ^ swz) * 8;
#pragma unroll
        for (int m = 0; m < 4; m++) pf[kk][m] = *(const bf16x8*)(Ps + (wr * 64 + m * 16 + l15) * 64 + pos);
#pragma unroll
        for (int n = 0; n < NQ; n++) qf[kk][n] = *(const bf16x8*)(Qs + (wc * 16 * NQ + n * 16 + l15) * 64 + pos);
      }
#pragma unroll
      for (int kk = 0; kk < 2; kk++)
#pragma unroll
        for (int m = 0; m < 4; m++)
#pragma unroll
          for (int n = 0; n < NQ; n++) acc[m][n] = mfma16(pf[kk][m], qf[kk][n], acc[m][n]);
      __builtin_amdgcn_sched_group_barrier(0x100, 4 + NQ, 0);
#pragma unroll
      for (int i = 0; i < 4 + NQ; i++) {
        __builtin_amdgcn_sched_group_barrier(0x008, NQ == 4 ? 2 : 1, 0);
        __builtin_amdgcn_sched_group_barrier(0x100, 1, 0);
      }
      __builtin_amdgcn_sched_group_barrier(0x008, NQ == 4 ? 16 : 10, 0);
    } else {
#pragma unroll
      for (int kk = 0; kk < 2; kk++) {
        bf16x8 pf[4], qf[NQ];
        const int pos = ((kk * 4 + g) ^ swz) * 8;
#pragma unroll
        for (int m = 0; m < 4; m++) pf[m] = *(const bf16x8*)(Ps + (wr * 64 + m * 16 + l15) * 64 + pos);
#pragma unroll
        for (int n = 0; n < NQ; n++) qf[n] = *(const bf16x8*)(Qs + (wc * 16 * NQ + n * 16 + l15) * 64 + pos);
#pragma unroll
        for (int m = 0; m < 4; m++)
#pragma unroll
          for (int n = 0; n < NQ; n++) acc[m][n] = mfma16(pf[m], qf[n], acc[m][n]);
      }
    }
  }
  if (TAIL) asm volatile("s_waitcnt vmcnt(0)" ::: "memory");
  __syncthreads();
}

__device__ __forceinline__ void gemm160x128(const bfr* __restrict__ P, long ldp, int pmax,
                                            const bfr* __restrict__ Q, long ldq, int K,
                                            f32x4 (&acc)[5][4], bfr* sm) {
  constexpr int STG = 160 * 64 + 128 * 64;
  const int tid = TIDX, lane = tid & 63, wid = tid >> 6;
  const int wr = wid >> 1, wc = wid & 1;
  const int l15 = lane & 15, g = lane >> 4;
  const bfr* pp[5];
  const bfr* qp[4];
  {
    const int r0 = tid >> 3;
    const int c = (tid & 7) ^ ((tid >> 4) & 7);
#pragma unroll
    for (int i = 0; i < 5; i++) pp[i] = P + (long)min(r0 + 32 * i, pmax - 1) * ldp + c * 8;
#pragma unroll
    for (int i = 0; i < 4; i++) qp[i] = Q + (long)(r0 + 32 * i) * ldq + c * 8;
  }
  const int nk = K >> 6;
#pragma unroll
  for (int i = 0; i < 5; i++) glds16(pp[i], sm + i * 2048 + tid * 8);
#pragma unroll
  for (int i = 0; i < 4; i++) glds16(qp[i], sm + 10240 + i * 2048 + tid * 8);
  const int swz = l15 >> 1;
  for (int kt = 0; kt < nk; kt++) {
    asm volatile("s_waitcnt vmcnt(0)" ::: "memory");
    __builtin_amdgcn_s_barrier();
    if (kt + 1 < nk) {
      bfr* nb = sm + ((kt + 1) & 1) * STG;
#pragma unroll
      for (int i = 0; i < 5; i++) glds16(pp[i] + (kt + 1) * 64, nb + i * 2048 + tid * 8);
#pragma unroll
      for (int i = 0; i < 4; i++) glds16(qp[i] + (kt + 1) * 64, nb + 10240 + i * 2048 + tid * 8);
    }
    const bfr* Ps = sm + (kt & 1) * STG;
    const bfr* Qs = Ps + 10240;
    bf16x8 pf[2][5], qf[2][4];
#pragma unroll
    for (int kk = 0; kk < 2; kk++) {
      const int pos = ((kk * 4 + g) ^ swz) * 8;
#pragma unroll
      for (int m = 0; m < 5; m++) pf[kk][m] = *(const bf16x8*)(Ps + (wr * 80 + m * 16 + l15) * 64 + pos);
#pragma unroll
      for (int n = 0; n < 4; n++) qf[kk][n] = *(const bf16x8*)(Qs + (wc * 64 + n * 16 + l15) * 64 + pos);
    }
#pragma unroll
    for (int kk = 0; kk < 2; kk++)
#pragma unroll
      for (int m = 0; m < 5; m++)
#pragma unroll
        for (int n = 0; n < 4; n++) acc[m][n] = mfma16(pf[kk][m], qf[kk][n], acc[m][n]);
    __builtin_amdgcn_sched_group_barrier(0x100, 9, 0);
#pragma unroll
    for (int i = 0; i < 9; i++) {
      __builtin_amdgcn_sched_group_barrier(0x008, 2, 0);
      __builtin_amdgcn_sched_group_barrier(0x100, 1, 0);
    }
    __builtin_amdgcn_sched_group_barrier(0x008, 22, 0);
  }
  __syncthreads();
}

__device__ __forceinline__ void phase_s0(const Params& p, bfr* sm) {
  const int tid = TIDX;
  float* rope = (float*)(p.ws + WS_ROPE);
  for (int idx = blockIdx.x * 256 + tid; idx < 1536; idx += gridDim.x * 256) {
    if (idx < 1024) {
      int pos = idx >> 4, i = idx & 15;
      float fr = powf(10000.f, -(float)i / 16.f);
      float a = (float)pos * fr;
      rope[idx] = cosf(a);
      rope[1024 + idx] = sinf(a);
    } else {
      int j = idx - 1024;
      int pos = j >> 3, i = j & 7;
      float fr = powf(10000.f, -(float)i / 8.f);
      float a = (float)pos * fr;
      rope[2048 + j] = cosf(a);
      rope[2560 + j] = sinf(a);
    }
  }
  float* smf = (float*)sm;
  float* modp = (float*)(p.ws + WS_MODP);
  for (int it = blockIdx.x; it < 768; it += gridDim.x) {
    int l = it / 384, rem = it % 384, cgp = rem >> 3, ks = rem & 7;
    int col = cgp * 64 + (tid & 63), kq = tid >> 6;
    const float* w = p.in[10] + (long)l * 1024 * 3072 + col;
    float a0 = 0.f, a1 = 0.f, a2 = 0.f;
    int k0 = ks * 128 + kq * 32;
#pragma unroll 8
    for (int k = k0; k < k0 + 32; k++) {
      float wv = w[(long)k * 3072];
      a0 += siluf(p.in[9][k]) * wv;
      a1 += siluf(p.in[8][k]) * wv;
      a2 += siluf(p.in[8][1024 + k]) * wv;
    }
    smf[(kq * 3 + 0) * 64 + (tid & 63)] = a0;
    smf[(kq * 3 + 1) * 64 + (tid & 63)] = a1;
    smf[(kq * 3 + 2) * 64 + (tid & 63)] = a2;
    __syncthreads();
    if (tid < 192) {
      int c = tid >> 6, cc = tid & 63;
      float s = smf[(0 * 3 + c) * 64 + cc] + smf[(1 * 3 + c) * 64 + cc] + smf[(2 * 3 + c) * 64 + cc] + smf[(3 * 3 + c) * 64 + cc];
      modp[((ks * 2 + l) * 3 + c) * 3072 + cgp * 64 + cc] = s;
    }
    __syncthreads();
  }
}

__device__ __forceinline__ void phase_s1(const Params& p) {
  float* modp = (float*)(p.ws + WS_MODP);
  float* mod = (float*)(p.ws + WS_MOD);
  for (int idx = blockIdx.x * 256 + TIDX; idx < 2 * 3 * 3072; idx += gridDim.x * 256) {
    int l = idx / 9216, n = idx % 3072;
    float s = p.in[11][l * 3072 + n];
#pragma unroll
    for (int ks = 0; ks < 8; ks++) s += modp[ks * 18432 + idx];
    mod[idx] = s;
  }
}

#define WCONV_ITEMS 2456
struct WcItem { const float* src; bfr* dst; int K, N, tk, tn; };
__device__ __forceinline__ WcItem wconv_decode(const Params& p, int l, int item) {
  WcItem w;
  if (item < 1744) {
    w.src = p.in[14] + (long)l * 1024 * 6976; w.K = 1024; w.N = 6976; w.dst = (bfr*)(p.ws + WS_WIN); w.tk = item & 15; w.tn = item >> 4;
  } else if (item < 1768) {
    item -= 1744;
    w.src = p.in[24] + (long)l * 256 * 384; w.K = 256; w.N = 384; w.dst = (bfr*)(p.ws + WS_WUQ); w.tk = item & 3; w.tn = item >> 2;
  } else if (item < 1816) {
    item -= 1768;
    w.src = p.in[25] + (long)l * 256 * 768; w.K = 256; w.N = 768; w.dst = (bfr*)(p.ws + WS_WUKV); w.tk = item & 3; w.tn = item >> 2;
  } else if (item < 2200) {
    item -= 1816;
    int ww = item >> 7, it = item & 127;
    w.src = (ww == 0 ? p.in[26] : (ww == 1 ? p.in[27] : p.in[28])) + (long)l * 512 * 1024;
    w.K = 512; w.N = 1024; w.dst = (bfr*)(p.ws + WS_WOA + (unsigned long)ww * 1048576ul); w.tk = it & 7; w.tn = it >> 3;
  } else {
    item -= 2200;
    w.src = p.in[29] + (long)l * 1024 * 1024; w.K = 1024; w.N = 1024; w.dst = (bfr*)(p.ws + WS_WOUT); w.tk = item & 15; w.tn = item >> 4;
  }
  return w;
}
__device__ __forceinline__ void wconv_phase(const Params& p, int l, bfr* sm) {
  bfr* sT = sm;
  const int tid = TIDX;
  const int n4 = (tid & 15) * 4, k0 = (tid >> 4) * 4;
  float4 v[4];
  int item = blockIdx.x;
  if (item < WCONV_ITEMS) {
    WcItem w = wconv_decode(p, l, item);
#pragma unroll
    for (int i = 0; i < 4; i++) v[i] = *(const float4*)(w.src + (long)(w.tk * 64 + k0 + i) * w.N + w.tn * 64 + n4);
  }
  const int wcol = (((k0 >> 3) ^ ((n4 >> 2) & 7)) * 8) + (k0 & 4);
  for (; item < WCONV_ITEMS; item += gridDim.x) {
    WcItem w = wconv_decode(p, l, item);
    {
      u32x2 o;
      o.x = pack2(v[0].x, v[1].x); o.y = pack2(v[2].x, v[3].x);
      *(u32x2*)(sT + (n4 + 0) * 64 + wcol) = o;
      o.x = pack2(v[0].y, v[1].y); o.y = pack2(v[2].y, v[3].y);
      *(u32x2*)(sT + (n4 + 1) * 64 + wcol) = o;
      o.x = pack2(v[0].z, v[1].z); o.y = pack2(v[2].z, v[3].z);
      *(u32x2*)(sT + (n4 + 2) * 64 + wcol) = o;
      o.x = pack2(v[0].w, v[1].w); o.y = pack2(v[2].w, v[3].w);
      *(u32x2*)(sT + (n4 + 3) * 64 + wcol) = o;
    }
    const int nitem = item + gridDim.x;
    if (nitem < WCONV_ITEMS) {
      WcItem wn = wconv_decode(p, l, nitem);
#pragma unroll
      for (int i = 0; i < 4; i++) v[i] = *(const float4*)(wn.src + (long)(wn.tk * 64 + k0 + i) * wn.N + wn.tn * 64 + n4);
    }
    __syncthreads();
#pragma unroll
    for (int i = 0; i < 2; i++) {
      int c = tid + 256 * i;
      int n = c >> 3, kc = c & 7;
      *(u32x4*)(w.dst + (long)(w.tn * 64 + n) * w.K + w.tk * 64 + kc * 8) = *(const u32x4*)(sT + n * 64 + ((kc ^ ((n >> 2) & 7)) * 8));
    }
    __syncthreads();
  }
}

__device__ __forceinline__ void phase_prenorm0(const Params& p) {
  const int lane = TIDX & 63;
  const float* mod = (const float*)(p.ws + WS_MOD);
  bfr* H = (bfr*)(p.ws + WS_R1);
  for (int row = blockIdx.x * 4 + (TIDX >> 6); row < NROWS; row += gridDim.x * 4) {
    const float* x = xrow(p, row);
    const float* md = mod + (0 * 3 + row_cond(row)) * 3072;
    float4 v[4];
    float ss = 0.f;
#pragma unroll
    for (int i = 0; i < 4; i++) {
      v[i] = *(const float4*)(x + i * 256 + lane * 4);
      ss += v[i].x * v[i].x + v[i].y * v[i].y + v[i].z * v[i].z + v[i].w * v[i].w;
    }
    ss = wave_sum(ss);
    float rs = rsqrtf(ss * (1.f / 1024.f) + 1e-6f);
#pragma unroll
    for (int i = 0; i < 4; i++) {
      int n = i * 256 + lane * 4;
      float4 g = *(const float4*)(p.in[12] + n);
      float4 sh = *(const float4*)(md + n);
      float4 sc = *(const float4*)(md + 1024 + n);
      float h0 = v[i].x * rs * g.x * (1.f + sc.x) + sh.x;
      float h1 = v[i].y * rs * g.y * (1.f + sc.y) + sh.y;
      float h2 = v[i].z * rs * g.z * (1.f + sc.z) + sh.z;
      float h3 = v[i].w * rs * g.w * (1.f + sc.w) + sh.w;
      u32x2 o;
      o.x = pack2(h0, h1);
      o.y = pack2(h2, h3);
      *(u32x2*)(H + (long)row * 1024 + n) = o;
    }
  }
}

__device__ __forceinline__ unsigned xcc_id() { return (unsigned)__builtin_amdgcn_s_getreg((3 << 11) | 20) & 7u; }
template <class CountF>
__device__ __forceinline__ int xq_take(unsigned* ctr, int& q, int& tried, unsigned first, CountF cnt) {
  unsigned j = first;
  for (;;) {
    if (j < (unsigned)cnt(q)) return (q << 20) | (int)j;
    q = (q + 1) & 7;
    if (++tried >= 8) return -1;
    j = atomicAdd(ctr + q * 16, 1u);
  }
}

__device__ __forceinline__ void phase_inproj(const Params& p, int l, bfr* sm, int* s_item, int slot) {
  const bfr* H = (const bfr*)(p.ws + WS_R1);
  const bfr* W = (const bfr*)(p.ws + WS_WIN);
  bfr* Z = (bfr*)(p.ws + WS_Z);
  const int tid = TIDX;
  const int lane = tid & 63, wid = tid >> 6, wr = wid >> 1, wc = wid & 1;
  unsigned* ctr = (unsigned*)(p.ws + WS_CTR) + slot * 128;
  auto cnt = [](int) { return 528; };
  int q = (int)xcc_id(), tried = 0;
  unsigned nxt = 0;
  if (tid == 0) nxt = atomicAdd(ctr + q * 16, 1u);
  for (;;) {
    if (tid == 0) *s_item = xq_take(ctr, q, tried, nxt, cnt);
    __syncthreads();
    const int it = *s_item;
    __syncthreads();
    if (it < 0) break;
    const int qq = it >> 20, j = it & 0xfffff;
    if (tid == 0) nxt = atomicAdd(ctr + q * 16, 1u);
    int tm, tn;
    {
      const int base = 11 * (qq >> 1);
      if ((qq & 1) == 0) {
        if (j < 288) { tm = j / 6; tn = base + j % 6; }
        else { const int j2 = j - 288; tm = 48 + j2 / 5; tn = base + j2 % 5; }
      } else {
        if (j < 240) { tm = j / 5; tn = base + 6 + j % 5; }
        else { const int j2 = j - 240; tm = 48 + j2 / 6; tn = base + 5 + j2 % 6; }
      }
    }
    f32x4 acc[5][4];
#pragma unroll
    for (int a = 0; a < 5; a++)
#pragma unroll
      for (int b = 0; b < 4; b++) acc[a][b] = (f32x4){0.f, 0.f, 0.f, 0.f};
    gemm160x128(W + (long)tn * 160 * 1024, 1024, ZLD - tn * 160, H + (long)tm * 128 * 1024, 1024, 1024, acc, sm);
    {
      const int g = lane >> 4, l15 = lane & 15;
#pragma unroll
      for (int pi = 0; pi < 5; pi++)
#pragma unroll
        for (int qi = 0; qi < 4; qi++) {
          u32x2 o;
          o.x = pack2(acc[pi][qi][0], acc[pi][qi][1]);
          o.y = pack2(acc[pi][qi][2], acc[pi][qi][3]);
          *(u32x2*)(sm + (wc * 64 + qi * 16 + l15) * 168 + wr * 80 + pi * 16 + g * 4) = o;
        }
      __syncthreads();
      const int ncol = min(20, (ZLD - tn * 160) >> 3);
#pragma unroll
      for (int i = 0; i < 10; i++) {
        int c = tid + 256 * i;
        int row = c / 20, c16 = c % 20;
        if (c16 < ncol)
          *(u32x4*)(Z + (long)(tm * 128 + row) * ZLD + tn * 160 + c16 * 8) = *(const u32x4*)(sm + row * 168 + c16 * 8);
      }
      __syncthreads();
    }
  }
}

__device__ __forceinline__ void unpack8(u32x4 v, float* x) {
  x[0] = lo16(v.x); x[1] = hi16(v.x); x[2] = lo16(v.y); x[3] = hi16(v.y);
  x[4] = lo16(v.z); x[5] = hi16(v.z); x[6] = lo16(v.w); x[7] = hi16(v.w);
}
__device__ __forceinline__ u32x4 pack8(const float* y) {
  u32x4 o;
  o.x = pack2(y[0], y[1]); o.y = pack2(y[2], y[3]); o.z = pack2(y[4], y[5]); o.w = pack2(y[6], y[7]);
  return o;
}

__device__ __forceinline__ void phase_rowpost(const Params& p, int l) {
  const int lane = TIDX & 63;
  bfr* Z = (bfr*)(p.ws + WS_Z);
  const float* rope = (const float*)(p.ws + WS_ROPE);
  bfr* VTA = (bfr*)(p.ws + WS_VTA);
  bfr* KCA = (bfr*)(p.ws + WS_KCA);
  bfr* CKVC = (bfr*)(p.ws + WS_CKVC);
  bfr* KRC = (bfr*)(p.ws + WS_KRC);
  float* out = p.out;
  for (int row = blockIdx.x * 4 + (TIDX >> 6); row < NROWS + 1024; row += gridDim.x * 4) {
    if (row < NROWS) {
      const bool lat = row >= NCTX;
      const int bc = row >> 8, tc = row & 255;
      const int bl = (row - NCTX) >> 12, tl = (row - NCTX) & 4095;
      const int prow = tl >> 6, pcol = tl & 63;
      bfr* z = Z + (long)row * ZLD;
      {
        float x[8];
        unpack8(*(const u32x4*)(z + C_QA + lane * 8), x);
        float ss = 0.f;
#pragma unroll
        for (int e = 0; e < 8; e++) ss += x[e] * x[e];
        ss += __shfl_xor(ss, 1); ss += __shfl_xor(ss, 2); ss += __shfl_xor(ss, 4);
        float rs = rsqrtf(ss * (1.f / 64.f) + 1e-6f);
        int sub = lane & 7;
        const float* g = p.in[15] + l * 64 + sub * 8;
#pragma unroll
        for (int e = 0; e < 8; e++) x[e] = x[e] * rs * g[e];
        if (lat) {
          int pos = (sub >> 2) ? pcol : prow;
          bool hi = (sub & 2) != 0;
          int i0 = (sub & 1) * 8;
#pragma unroll
          for (int e = 0; e < 8; e++) {
            float yp = __shfl_xor(x[e], 2);
            float c = rope[pos * 16 + i0 + e], s = rope[1024 + pos * 16 + i0 + e];
            x[e] = hi ? (yp * s + x[e] * c) : (x[e] * c - yp * s);
          }
        }
        const float qs = 0.125f * 1.4426950408889634f;
#pragma unroll
        for (int e = 0; e < 8; e++) x[e] *= qs;
        *(u32x4*)(z + C_QA + lane * 8) = pack8(x);
      }
      {
        int L = lane & 15;
        float x[8];
        unpack8(*(const u32x4*)(z + C_KA + L * 8), x);
        float ss = 0.f;
#pragma unroll
        for (int e = 0; e < 8; e++) ss += x[e] * x[e];
        ss += __shfl_xor(ss, 1); ss += __shfl_xor(ss, 2); ss += __shfl_xor(ss, 4);
        float rs = rsqrtf(ss * (1.f / 64.f) + 1e-6f);
        int sub = L & 7;
        const float* g = p.in[16] + l * 64 + sub * 8;
#pragma unroll
        for (int e = 0; e < 8; e++) x[e] = x[e] * rs * g[e];
        if (lat) {
          int pos = (sub >> 2) ? pcol : prow;
          bool hi = (sub & 2) != 0;
          int i0 = (sub & 1) * 8;
#pragma unroll
          for (int e = 0; e < 8; e++) {
            float yp = __shfl_xor(x[e], 2);
            float c = rope[pos * 16 + i0 + e], s = rope[1024 + pos * 16 + i0 + e];
            x[e] = hi ? (yp * s + x[e] * c) : (x[e] * c - yp * s);
          }
        } else if (lane < 16) {
          float* o = out + O_GK + ((long)(bc * 2 + l) * 256 + tc) * 128 + L * 8;
          *(float4*)(o) = make_float4(x[0], x[1], x[2], x[3]);
          *(float4*)(o + 4) = make_float4(x[4], x[5], x[6], x[7]);
        }
        if (lane < 16) *(u32x4*)(z + C_KA + L * 8) = pack8(x);
      }
      if (lane < 16) {
        int L = lane;
        u32x4 raw = *(const u32x4*)(z + C_VA + L * 8);
        float x[8];
        unpack8(raw, x);
        if (!lat) {
          float* o = out + O_GV + ((long)(bc * 2 + l) * 256 + tc) * 128 + L * 8;
          *(float4*)(o) = make_float4(x[0], x[1], x[2], x[3]);
          *(float4*)(o + 4) = make_float4(x[4], x[5], x[6], x[7]);
        }
        int g = L >> 3, d0 = (L & 7) * 8;
        long base; int nk, key;
        if (!lat) { base = (long)bc * 32768; nk = 256; key = tc; }
        else { base = 16l * 32768 + (long)bl * (2 * 64 * 4608); nk = 4608; key = 512 + tl; }
        const bfr* rb = (const bfr*)&raw;
#pragma unroll
        for (int e = 0; e < 8; e++) VTA[base + (long)(g * 64 + d0 + e) * nk + key] = rb[e];
      }
      {
        u32x2 rq = *(const u32x2*)(z + C_QL + lane * 4);
        u32x2 rk = *(const u32x2*)(z + C_KV + lane * 4);
        float q[4] = {lo16(rq.x), hi16(rq.x), lo16(rq.y), hi16(rq.y)};
        float k[4] = {lo16(rk.x), hi16(rk.x), lo16(rk.y), hi16(rk.y)};
        float sq = q[0] * q[0] + q[1] * q[1] + q[2] * q[2] + q[3] * q[3];
        float sk = k[0] * k[0] + k[1] * k[1] + k[2] * k[2] + k[3] * k[3];
        sq = wave_sum(sq);
        sk = wave_sum(sk);
        float rq_ = rsqrtf(sq * (1.f / 256.f) + 1e-6f), rk_ = rsqrtf(sk * (1.f / 256.f) + 1e-6f);
        float4 gq = *(const float4*)(p.in[22] + l * 256 + lane * 4);
        float4 gk = *(const float4*)(p.in[23] + l * 256 + lane * 4);
        q[0] *= rq_ * gq.x; q[1] *= rq_ * gq.y; q[2] *= rq_ * gq.z; q[3] *= rq_ * gq.w;
        k[0] *= rk_ * gk.x; k[1] *= rk_ * gk.y; k[2] *= rk_ * gk.z; k[3] *= rk_ * gk.w;
        u32x2 o;
        o.x = pack2(q[0], q[1]); o.y = pack2(q[2], q[3]);
        *(u32x2*)(z + C_QL + lane * 4) = o;
        o.x = pack2(k[0], k[1]); o.y = pack2(k[2], k[3]);
        *(u32x2*)(z + C_KV + lane * 4) = o;
        if (!lat) *(float4*)(out + O_CKV + ((long)(bc * 2 + l) * 256 + tc) * 256 + lane * 4) = make_float4(k[0], k[1], k[2], k[3]);
      }
      {
        int L = lane & 3;
        float x[8];
        unpack8(*(const u32x4*)(z + C_KR + L * 8), x);
        if (lat) {
          int pos = (L >> 1) ? pcol : prow;
          bool hi = (L & 1) != 0;
#pragma unroll
          for (int e = 0; e < 8; e++) {
            float yp = __shfl_xor(x[e], 1);
            float c = rope[2048 + pos * 8 + e], s = rope[2560 + pos * 8 + e];
            x[e] = hi ? (yp * s + x[e] * c) : (x[e] * c - yp * s);
          }
          if (lane < 4) *(u32x4*)(z + C_KR + L * 8) = pack8(x);
        } else if (lane < 4) {
          float* o = out + O_KR + ((long)(bc * 2 + l) * 256 + tc) * 32 + L * 8;
          *(float4*)(o) = make_float4(x[0], x[1], x[2], x[3]);
          *(float4*)(o + 4) = make_float4(x[4], x[5], x[6], x[7]);
        }
      }
    } else {
      int cr = row - NROWS;
      int b = cr >> 9, t = cr & 511;
      long src = (long)(b * 2 + l) * 512 + t;
      {
        float2 kv = *(const float2*)(p.in[2] + src * 128 + lane * 2);
        *(unsigned*)(KCA + (long)(b * 512 + t) * 128 + lane * 2) = pack2(kv.x, kv.y);
        float2 vv = *(const float2*)(p.in[3] + src * 128 + lane * 2);
        int c0 = lane * 2;
        long base = 16l * 32768 + (long)b * (2 * 64 * 4608);
        VTA[base + (long)c0 * 4608 + t] = f2bf(vv.x);
        VTA[base + (long)(c0 + 1) * 4608 + t] = f2bf(vv.y);
        float4 cv = *(const float4*)(p.in[4] + src * 256 + lane * 4);
        u32x2 o;
        o.x = pack2(cv.x, cv.y); o.y = pack2(cv.z, cv.w);
        *(u32x2*)(CKVC + (long)(b * 512 + t) * 256 + lane * 4) = o;
        if (lane < 32) KRC[(long)(b * 512 + t) * 32 + lane] = f2bf(p.in[5][src * 32 + lane]);
      }
    }
  }
}

#define WS_PREP1 251703296ul
#define WS_EL (WS_WIN + 12582912ul)
__device__ __forceinline__ bfr* prep_base(const Params& p, int b, int h, int dir, int c) {
  return (bfr*)(p.ws + (b ? WS_PREP1 : WS_WIN)) + (long)((h * 2 + dir) * 64 + c) * 12288;
}

__device__ __forceinline__ void gla_chunk_prep(int tid, const float (&wd)[16], float bias, const bfr* Qr, const bfr* Kr,
                                               bfr* Qe, bfr* Ke, bfr* KlT, const float* RF, float* tot, float* lastv) {
  const int ch = tid & 63, part = tid >> 6;
  float cum[16];
  {
    float run = 0.f;
#pragma unroll
    for (int ii = 0; ii < 16; ii++) {
      int i = part * 16 + ii;
      float x = bias;
#pragma unroll
      for (int r = 0; r < 16; r++) x += RF[i * 16 + r] * wd[r];
      float la = (fminf(x, 0.f) - __logf(1.f + __expf(-fabsf(x)))) * (1.f / 16.f);
      run += la;
      cum[ii] = run;
    }
    tot[part * 64 + ch] = run;
  }
  __syncthreads();
  {
    float off = 0.f, last = 0.f;
#pragma unroll
    for (int pp = 0; pp < 4; pp++) {
      float tv = tot[pp * 64 + ch];
      if (pp < part) off += tv;
      last += tv;
    }
    if (part == 0) lastv[ch] = last;
#pragma unroll
    for (int ii = 0; ii < 16; ii++) {
      int i = part * 16 + ii;
      float cc = cum[ii] + off;
      float qv = bf2f(Qr[i * LDT + ch]), kv = bf2f(Kr[i * LDT + ch]);
      Qe[i * LDT + ch] = f2bf(qv * __expf(cc) * 0.125f);
      Ke[i * LDT + ch] = f2bf(kv * __expf(-cc));
      KlT[ch * LDT + i] = f2bf(kv * __expf(last - cc));
    }
  }
  __syncthreads();
}

__device__ __forceinline__ void gla_att(int wid, int g, int l15, const bfr* Qe, const bfr* Ke, bfr* Att) {
  f32x4 att[4];
  bf16x8 qa[2];
#pragma unroll
  for (int kk = 0; kk < 2; kk++) qa[kk] = *(const bf16x8*)(Qe + (16 * wid + l15) * LDT + kk * 32 + g * 8);
#pragma unroll
  for (int nj = 0; nj < 4; nj++) {
    att[nj] = (f32x4){0.f, 0.f, 0.f, 0.f};
#pragma unroll
    for (int kk = 0; kk < 2; kk++) {
      bf16x8 kb = *(const bf16x8*)(Ke + (16 * nj + l15) * LDT + kk * 32 + g * 8);
      att[nj] = mfma16(qa[kk], kb, att[nj]);
    }
  }
#pragma unroll
  for (int nj = 0; nj < 4; nj++)
#pragma unroll
    for (int r = 0; r < 4; r++) {
      int i = 16 * wid + 4 * g + r, j = 16 * nj + l15;
      Att[i * LDT + j] = f2bf(i >= j ? att[nj][r] : 0.f);
    }
}

__device__ __forceinline__ void gla_prep_item(const Params& p, int l, int b, int h, int dir, int c, bfr* sm) {
  const int tid = TIDX, lane = tid & 63, wid = tid >> 6, g = lane >> 4, l15 = lane & 15;
  const bfr* Z = (const bfr*)(p.ws + WS_Z);
  const int N = 4096;
  const int rowbase = NCTX + b * 4096;
  bfr* Qr = sm;
  bfr* Kr = Qr + 64 * LDT;
  bfr* Qe = Kr + 64 * LDT;
  bfr* Ke = Qe + 64 * LDT;
  bfr* KlT = Ke + 64 * LDT;
  float* RF = (float*)(KlT + 64 * LDT);
  float* tot = RF + 64 * 16;
  float* lastv = tot + 256;
  bfr* Att = Qr;
  const int ch = tid & 63;
  float wd[16];
  {
    const float* W = (dir ? p.in[19] : p.in[17]) + (long)l * 16 * 256 + h * 64 + ch;
#pragma unroll
    for (int r = 0; r < 16; r++) wd[r] = W[r * 256];
  }
  const float bias = (dir ? p.in[20] : p.in[18])[l * 256 + h * 64 + ch];
#pragma unroll
  for (int ii = 0; ii < 2; ii++) {
    int cc = tid + 256 * ii;
    int i = cc >> 3, c8 = cc & 7;
    int tok = dir ? (N - 1 - (c * 64 + i)) : (c * 64 + i);
    const bfr* zr = Z + (long)(rowbase + tok) * ZLD;
    *(u32x4*)(Qr + i * LDT + c8 * 8) = *(const u32x4*)(zr + C_QG + h * 64 + c8 * 8);
    *(u32x4*)(Kr + i * LDT + c8 * 8) = *(const u32x4*)(zr + C_KG + h * 64 + c8 * 8);
  }
  if (tid < 128) {
    int i = tid >> 1, hf = tid & 1;
    int tok = dir ? (N - 1 - (c * 64 + i)) : (c * 64 + i);
    u32x4 rr = *(const u32x4*)(Z + (long)(rowbase + tok) * ZLD + (dir ? C_RB : C_RF) + hf * 8);
    float x[8];
    unpack8(rr, x);
#pragma unroll
    for (int e = 0; e < 8; e++) RF[i * 16 + hf * 8 + e] = x[e];
  }
  __syncthreads();
  gla_chunk_prep(tid, wd, bias, Qr, Kr, Qe, Ke, KlT, RF, tot, lastv);
  gla_att(wid, g, l15, Qe, Ke, Att);
  __syncthreads();
  bfr* dst = prep_base(p, b, h, dir, c);
#pragma unroll
  for (int ii = 0; ii < 2; ii++) {
    int cc = tid + 256 * ii;
    int i = cc >> 3, c8 = cc & 7;
    *(u32x4*)(dst + i * 64 + c8 * 8) = *(const u32x4*)(Qe + i * LDT + c8 * 8);
    *(u32x4*)(dst + 4096 + i * 64 + c8 * 8) = *(const u32x4*)(KlT + i * LDT + c8 * 8);
    *(u32x4*)(dst + 8192 + i * 64 + c8 * 8) = *(const u32x4*)(Att + i * LDT + c8 * 8);
  }
  if (tid < 64) ((float*)(p.ws + WS_EL))[((long)(((b * 4 + h) * 2 + dir) * 64 + c)) * 64 + tid] = __expf(lastv[tid]);
  __syncthreads();
}

__device__ __forceinline__ void gla_chain_item(const Params& p, int l, int b, int h, int dir, int vh, bfr* sm) {
  const int tid = TIDX, lane = tid & 63, wid = tid >> 6, g = lane >> 4, l15 = lane & 15;
  const bfr* Z = (const bfr*)(p.ws + WS_Z);
  bfr* OG = (bfr*)(p.ws + WS_R1) + (long)dir * NROWS * 512;
  const float* EL = (const float*)(p.ws + WS_EL) + (long)(((b * 4 + h) * 2 + dir) * 64) * 64;
  const int N = 4096, nc = 64;
  const int rowbase = NCTX + b * 4096;
  const int vs0 = vh * 64;
  bfr* Vt = sm;
  bfr* St = Vt + 64 * LDT;
  f32x4 st[4];
  {
    const float* S0 = (dir ? p.in[7] : p.in[6]) + ((long)((b * 2 + l) * 4 + h)) * 8192 + (long)(16 * wid + l15) * 128 + vs0;
#pragma unroll
    for (int vt = 0; vt < 4; vt++) {
      float4 a = *(const float4*)(S0 + 16 * vt + 4 * g);
      st[vt] = (f32x4){a.x, a.y, a.z, a.w};
#pragma unroll
      for (int r = 0; r < 4; r++) St[(16 * vt + 4 * g + r) * LDT + 16 * wid + l15] = f2bf(st[vt][r]);
    }
  }
  u32x4 n_qe[2], n_kl[2], n_at[2], n_v[2];
  float n_el;
  auto prefetch = [&](int c) {
    const bfr* base = prep_base(p, b, h, dir, c) + (16 * wid + l15) * 64 + 8 * g;
#pragma unroll
    for (int kk = 0; kk < 2; kk++) {
      n_qe[kk] = *(const u32x4*)(base + kk * 32);
      n_kl[kk] = *(const u32x4*)(base + 4096 + kk * 32);
      n_at[kk] = *(const u32x4*)(base + 8192 + kk * 32);
    }
    n_el = EL[c * 64 + 16 * wid + l15];
#pragma unroll
    for (int ii = 0; ii < 2; ii++) {
      int cc = tid + 256 * ii;
      int i = cc >> 3, c8 = cc & 7;
      int tok = dir ? (N - 1 - (c * 64 + i)) : (c * 64 + i);
      n_v[ii] = *(const u32x4*)(Z + (long)(rowbase + tok) * ZLD + C_VG + h * 128 + vs0 + c8 * 8);
    }
  };
  prefetch(0);
  for (int c = 0; c < nc; c++) {
    u32x4 c_qe[2] = {n_qe[0], n_qe[1]}, c_kl[2] = {n_kl[0], n_kl[1]}, c_at[2] = {n_at[0], n_at[1]};
    const float el = n_el;
#pragma unroll
    for (int ii = 0; ii < 2; ii++) {
      int cc = tid + 256 * ii;
      int i = cc >> 3, c8 = cc & 7;
      const bfr* rb = (const bfr*)&n_v[ii];
#pragma unroll
      for (int e = 0; e < 8; e++) Vt[(c8 * 8 + e) * LDT + i] = rb[e];
    }
    __syncthreads();
    if (c + 1 < nc) prefetch(c + 1);
    f32x4 stn[4];
    const int i = 16 * wid + l15;
    const int tok = dir ? (N - 1 - (c * 64 + i)) : (c * 64 + i);
    bfr* og = OG + (long)(rowbase + tok) * 512 + h * 128 + vs0 + 4 * g;
#pragma unroll
    for (int vt = 0; vt < 4; vt++) {
      f32x4 oc = (f32x4){0.f, 0.f, 0.f, 0.f};
      stn[vt] = st[vt] * el;
#pragma unroll
      for (int kk = 0; kk < 2; kk++) {
        bf16x8 vf = *(const bf16x8*)(Vt + (16 * vt + l15) * LDT + kk * 32 + g * 8);
        bf16x8 sf = *(const bf16x8*)(St + (16 * vt + l15) * LDT + kk * 32 + g * 8);
        oc = mfma16(vf, *(bf16x8*)&c_at[kk], oc);
        oc = mfma16(sf, *(bf16x8*)&c_qe[kk], oc);
        stn[vt] = mfma16(vf, *(bf16x8*)&c_kl[kk], stn[vt]);
      }
      u32x2 ov;
      ov.x = pack2(oc[0], oc[1]);
      ov.y = pack2(oc[2], oc[3]);
      *(u32x2*)(og + 16 * vt) = ov;
    }
    __syncthreads();
#pragma unroll
    for (int vt = 0; vt < 4; vt++) {
      st[vt] = stn[vt];
#pragma unroll
      for (int r = 0; r < 4; r++) St[(16 * vt + 4 * g + r) * LDT + 16 * wid + l15] = f2bf(st[vt][r]);
    }
  }
  __syncthreads();
}

template <int VS>
__device__ __forceinline__ void gla_item(const Params& p, int l, int seq, int h, int dir, int vsl, bfr* sm) {
  constexpr int NVT = VS / 16;
  constexpr int NVL = VS / 32;
  const int tid = TIDX, lane = tid & 63, wid = tid >> 6, g = lane >> 4, l15 = lane & 15;
  bfr* Z = (bfr*)(p.ws + WS_Z);
  bfr* OG = (bfr*)(p.ws + WS_R1) + (long)dir * NROWS * 512;
  const bool lat = seq >= 16;
  const int b = seq - 16;
  const int N = lat ? 4096 : 256;
  const int rowbase = lat ? NCTX + b * 4096 : seq * 256;
  const int nc = N >> 6;
  const int vs0 = vsl * VS;
  bfr* Qr = sm;
  bfr* Kr = Qr + 64 * LDT;
  bfr* Qe = Kr + 64 * LDT;
  bfr* Ke = Qe + 64 * LDT;
  bfr* KlT = Ke + 64 * LDT;
  float* RF = (float*)(KlT + 64 * LDT);
  float* tot = RF + 64 * 16;
  float* lastv = tot + 256;
  bfr* Vt = (bfr*)(lastv + 64);
  bfr* St = Vt + VS * LDT;
  bfr* Att = Qr;
  const int ch = tid & 63;
  float wd[16];
  {
    const float* W = (dir ? p.in[19] : p.in[17]) + (long)l * 16 * 256 + h * 64 + ch;
#pragma unroll
    for (int r = 0; r < 16; r++) wd[r] = W[r * 256];
  }
  const float bias = (dir ? p.in[20] : p.in[18])[l * 256 + h * 64 + ch];

  f32x4 st[NVT];
  {
    const float* S0 = (dir ? p.in[7] : p.in[6]) + ((long)((b * 2 + l) * 4 + h)) * 8192 + (long)(16 * wid + l15) * 128 + vs0;
#pragma unroll
    for (int mv = 0; mv < NVT; mv++) {
      if (lat) {
        float4 a = *(const float4*)(S0 + 16 * mv + 4 * g);
        st[mv] = (f32x4){a.x, a.y, a.z, a.w};
      } else {
        st[mv] = (f32x4){0.f, 0.f, 0.f, 0.f};
      }
#pragma unroll
      for (int r = 0; r < 4; r++) St[(16 * mv + 4 * g + r) * LDT + 16 * wid + l15] = f2bf(st[mv][r]);
    }
  }
  u32x4 rq[2], rk[2], rv[NVL], rr;
  auto prefetch = [&](int c) {
#pragma unroll
    for (int ii = 0; ii < 2; ii++) {
      int cc = tid + 256 * ii;
      int i = cc >> 3, c8 = cc & 7;
      int tok = dir ? (N - 1 - (c * 64 + i)) : (c * 64 + i);
      const bfr* zr = Z + (long)(rowbase + tok) * ZLD;
      rq[ii] = *(const u32x4*)(zr + C_QG + h * 64 + c8 * 8);
      rk[ii] = *(const u32x4*)(zr + C_KG + h * 64 + c8 * 8);
    }
#pragma unroll
    for (int ii = 0; ii < NVL; ii++) {
      int cc = tid + 256 * ii;
      int i = cc / (VS / 8), c4 = cc % (VS / 8);
      int tok = dir ? (N - 1 - (c * 64 + i)) : (c * 64 + i);
      rv[ii] = *(const u32x4*)(Z + (long)(rowbase + tok) * ZLD + C_VG + h * 128 + vs0 + c4 * 8);
    }
    if (tid < 128) {
      int i = tid >> 1, hf = tid & 1;
      int tok = dir ? (N - 1 - (c * 64 + i)) : (c * 64 + i);
      rr = *(const u32x4*)(Z + (long)(rowbase + tok) * ZLD + (dir ? C_RB : C_RF) + hf * 8);
    }
  };
  prefetch(0);
  for (int c = 0; c < nc; c++) {
#pragma unroll
    for (int ii = 0; ii < 2; ii++) {
      int cc = tid + 256 * ii;
      *(u32x4*)(Qr + (cc >> 3) * LDT + (cc & 7) * 8) = rq[ii];
      *(u32x4*)(Kr + (cc >> 3) * LDT + (cc & 7) * 8) = rk[ii];
    }
#pragma unroll
    for (int ii = 0; ii < NVL; ii++) {
      int cc = tid + 256 * ii;
      int i = cc / (VS / 8), c4 = cc % (VS / 8);
      const bfr* rb = (const bfr*)&rv[ii];
#pragma unroll
      for (int e = 0; e < 8; e++) Vt[(c4 * 8 + e) * LDT + i] = rb[e];
    }
    if (tid < 128) {
      int i = tid >> 1, hf = tid & 1;
      float x[8];
      unpack8(rr, x);
#pragma unroll
      for (int e = 0; e < 8; e++) RF[i * 16 + hf * 8 + e] = x[e];
    }
    __syncthreads();
    if (c + 1 < nc) prefetch(c + 1);
    gla_chunk_prep(tid, wd, bias, Qr, Kr, Qe, Ke, KlT, RF, tot, lastv);
    f32x4 stn[NVT];
    {
      float el = __expf(lastv[16 * wid + l15]);
#pragma unroll
      for (int mv = 0; mv < NVT; mv++) {
        stn[mv] = st[mv] * el;
#pragma unroll
        for (int kk = 0; kk < 2; kk++) {
          bf16x8 va = *(const bf16x8*)(Vt + (16 * mv + l15) * LDT + kk * 32 + g * 8);
          bf16x8 kb = *(const bf16x8*)(KlT + (16 * wid + l15) * LDT + kk * 32 + g * 8);
          stn[mv] = mfma16(va, kb, stn[mv]);
        }
      }
      gla_att(wid, g, l15, Qe, Ke, Att);
    }
    __syncthreads();
    {
      bf16x8 aa[2], qa[2];
#pragma unroll
      for (int kk = 0; kk < 2; kk++) {
        aa[kk] = *(const bf16x8*)(Att + (16 * wid + l15) * LDT + kk * 32 + g * 8);
        qa[kk] = *(const bf16x8*)(Qe + (16 * wid + l15) * LDT + kk * 32 + g * 8);
      }
#pragma unroll
      for (int nv = 0; nv < NVT; nv++) {
        f32x4 oc = (f32x4){0.f, 0.f, 0.f, 0.f};
#pragma unroll
        for (int kk = 0; kk < 2; kk++) {
          bf16x8 vb = *(const bf16x8*)(Vt + (16 * nv + l15) * LDT + kk * 32 + g * 8);
          oc = mfma16(aa[kk], vb, oc);
          bf16x8 sb = *(const bf16x8*)(St + (16 * nv + l15) * LDT + kk * 32 + g * 8);
          oc = mfma16(qa[kk], sb, oc);
        }
#pragma unroll
        for (int r = 0; r < 4; r++) {
          int i = 16 * wid + 4 * g + r;
          int tok = dir ? (N - 1 - (c * 64 + i)) : (c * 64 + i);
          OG[(long)(rowbase + tok) * 512 + h * 128 + vs0 + 16 * nv + l15] = f2bf(oc[r]);
        }
      }
    }
    __syncthreads();
#pragma unroll
    for (int mv = 0; mv < NVT; mv++) {
      st[mv] = stn[mv];
#pragma unroll
      for (int r = 0; r < 4; r++) St[(16 * mv + 4 * g + r) * LDT + 16 * wid + l15] = f2bf(st[mv][r]);
    }
  }
  __syncthreads();
  if (!lat) {
    float* so = p.out + (dir ? O_SB : O_SF) + ((long)((seq * 2 + l) * 4 + h)) * 8192 + (long)(16 * wid + l15) * 128 + vs0;
#pragma unroll
    for (int mv = 0; mv < NVT; mv++)
      *(float4*)(so + 16 * mv + 4 * g) = make_float4(st[mv][0], st[mv][1], st[mv][2], st[mv][3]);
  }
}

__device__ __forceinline__ void phase_mla_up(const Params& p, int l, bfr* sm) {
  bfr* Z = (bfr*)(p.ws + WS_Z);
  const float* rope = (const float*)(p.ws + WS_ROPE);
  const int lane = TIDX & 63, wid = TIDX >> 6, wr = wid >> 1, wc = wid & 1;
  const int g = lane >> 4;
  for (int t = blockIdx.x; t < 288 + 624 + 1024; t += gridDim.x) {
    if (t >= 912) {
      int i = t - 912;
      gla_prep_item(p, l, i >> 9, (i >> 7) & 3, (i >> 6) & 1, i & 63, sm);
      continue;
    }
    f32x4 acc[4][4];
#pragma unroll
    for (int a = 0; a < 4; a++)
#pragma unroll
      for (int b = 0; b < 4; b++) acc[a][b] = (f32x4){0.f, 0.f, 0.f, 0.f};
    if (t < 288) {
      int tn = t % 3, tm = t / 3;
      gemm128k64<4, true>((const bfr*)(p.ws + WS_WUQ) + (long)tn * 128 * 256, 256, 128, Z + (long)tm * 128 * ZLD + C_QL, ZLD, 256,
                    acc, sm);
      bfr* CQ = (bfr*)(p.ws + WS_CQ);
      const float qs = 0.10206207261596577f * 1.4426950408889634f;
#pragma unroll
      for (int pi = 0; pi < 4; pi++) {
        int nb = tn * 128 + wr * 64 + pi * 16;
        int wb = nb % 96;
        bool ropet = wb >= 64;
        int part = (wb - 64) >> 4;
#pragma unroll
        for (int qi = 0; qi < 4; qi++) {
          int tok = tm * 128 + wc * 64 + qi * 16 + (lane & 15);
          float y[4] = {acc[pi][qi][0], acc[pi][qi][1], acc[pi][qi][2], acc[pi][qi][3]};
          if (ropet) {
            bool lat = tok >= NCTX;
            int tl = (tok - NCTX) & 4095;
            int pos = part ? (tl & 63) : (tl >> 6);
            bool hi = (g & 2) != 0;
            int i0 = (g & 1) * 4;
#pragma unroll
            for (int r = 0; r < 4; r++) {
              float yp = __shfl_xor(y[r], 32);
              float c = rope[2048 + pos * 8 + i0 + r], s = rope[2560 + pos * 8 + i0 + r];
              float yr = hi ? (yp * s + y[r] * c) : (y[r] * c - yp * s);
              y[r] = lat ? yr : y[r];
            }
          }
          u32x2 o;
          o.x = pack2(y[0] * qs, y[1] * qs);
          o.y = pack2(y[2] * qs, y[3] * qs);
          *(u32x2*)(CQ + (long)tok * 384 + nb + g * 4) = o;
        }
      }
    } else {
      int t2 = t - 288;
      int tn = t2 % 6, tm = t2 / 6;
      const bfr* Q;
      long ldq;
      long kbase, vbase;
      int nk, key0;
      if (tm < 32) {
        Q = Z + (long)tm * 128 * ZLD + C_KV;
        ldq = ZLD;
        int s = tm >> 1;
        key0 = (tm & 1) * 128;
        nk = 256;
        kbase = (long)s * (4 * 256 * 64);
        vbase = (long)s * 131072;
      } else {
        int r = (tm - 32) * 128;
        int b = r / 4608, within = r % 4608;
        key0 = within;
        nk = 4608;
        kbase = 16l * (4 * 256 * 64) + (long)b * (4 * 4608 * 64);
        vbase = 16l * 131072 + (long)b * (4 * 128 * 4608);
        if (within < 512) {
          Q = (const bfr*)(p.ws + WS_CKVC) + (long)(b * 512 + within) * 256;
          ldq = 256;
        } else {
          Q = Z + (long)(NCTX + b * 4096 + within - 512) * ZLD + C_KV;
          ldq = ZLD;
        }
      }
      gemm128k64<4, true>((const bfr*)(p.ws + WS_WUKV) + (long)tn * 128 * 256, 256, 128, Q, ldq, 256, acc, sm);
      bfr* KN = (bfr*)(p.ws + WS_KNOPE);
      bfr* VTC = (bfr*)(p.ws + WS_VTC);
#pragma unroll
      for (int pi = 0; pi < 4; pi++) {
        int n0 = tn * 128 + wr * 64 + pi * 16 + g * 4;
        int head = n0 / 192, w = n0 % 192;
#pragma unroll
        for (int qi = 0; qi < 4; qi++) {
          int key = key0 + wc * 64 + qi * 16 + (lane & 15);
          if (w < 64) {
            u32x2 o;
            o.x = pack2(acc[pi][qi][0], acc[pi][qi][1]);
            o.y = pack2(acc[pi][qi][2], acc[pi][qi][3]);
            *(u32x2*)(KN + kbase + ((long)head * nk + key) * 64 + w) = o;
          } else {
#pragma unroll
            for (int r = 0; r < 4; r++)
              VTC[vbase + ((long)head * 128 + (w - 64) + r) * nk + key] = f2bf(acc[pi][qi][r]);
          }
        }
      }
    }
  }
}

template <int DQ, int DV, bool MLA, int NQB, bool DMA, int TP, bool LA = false>
__device__ __forceinline__ void attn_item(const Params& p, int seq, int head, int qoff, bfr* sm, int dry) {
  constexpr int KLD = DQ + 8;
  constexpr int KSZ = DMA ? (MLA ? 6144 : 4096) : 64 * KLD;
  constexpr int VSZ = DMA ? DV * 64 : DV * LDT;
  constexpr int BUF = KSZ + VSZ;
  constexpr int NKK = DQ / 32;
  constexpr int NDV = DV / 16;
  constexpr int NVL = DV / 32;
  const int tid = TIDX, lane = tid & 63, wid = tid >> 6, g = lane >> 4, l15 = lane & 15;
  bfr* Z = (bfr*)(p.ws + WS_Z);
  const int sK = 2 * (l15 >> 2) + ((l15 >> 1) & 1), sR = ((l15 >> 3) & 1) * 2, sV = l15 >> 1;
  auto kaddr = [&](const bfr* Ks, int krow, int kk) -> const bfr* {
    if (DMA) return (kk < 2) ? (Ks + krow * 64 + (((kk * 4 + g) ^ sK) * 8)) : (Ks + 4096 + krow * 32 + ((g ^ sR) * 8));
    return Ks + krow * KLD + kk * 32 + g * 8;
  };
  auto vaddr = [&](const bfr* Vs, int d, int sx) -> const bfr* {
    if (DMA) return Vs + (d * 16 + l15) * 64 + (((sx * 4 + g) ^ sV) * 8);
    return Vs + (d * 16 + l15) * LDT + sx * 32 + g * 8;
  };
  const bool lat = seq >= 16;
  const int b = seq - 16;
  const int nk = lat ? 4608 : 256;
  const int rowbase = lat ? NCTX + b * 4096 : seq * 256;
  const int nkt = nk >> 6;

  bf16x8 qf[NQB][NKK];
#pragma unroll
  for (int qb = 0; qb < NQB; qb++) {
    int qrow = rowbase + qoff + wid * (16 * NQB) + qb * 16 + l15;
    const bfr* qp = MLA ? ((const bfr*)(p.ws + WS_CQ) + (long)qrow * 384 + head * 96) : (Z + (long)qrow * ZLD + C_QA + head * 64);
#pragma unroll
    for (int kk = 0; kk < NKK; kk++) qf[qb][kk] = *(const bf16x8*)(qp + kk * 32 + g * 8);
  }

  u32x4 rk[TP][2], rkr[TP], rv[TP][NVL];
  auto prefetch = [&](int pi) {
#pragma unroll
   for (int u = 0; u < TP; u++) {
    int k0 = (pi * TP + u) * 64;
    bool cache = lat && (k0 < 512);
    int tokrow0 = lat ? (NCTX + b * 4096 + k0 - 512) : (seq * 256 + k0);
    if (!MLA) {
      int kvh = head >> 2;
#pragma unroll
      for (int i = 0; i < 2; i++) {
        int c = tid + 256 * i;
        int kr_ = c >> 3, ch = c & 7;
        const bfr* src = cache ? ((const bfr*)(p.ws + WS_KCA) + (long)(b * 512 + k0 + kr_) * 128 + kvh * 64 + ch * 8)
                               : (Z + (long)(tokrow0 + kr_) * ZLD + C_KA + kvh * 64 + ch * 8);
        rk[u][i] = *(const u32x4*)src;
      }
      long vb = lat ? (16l * 32768 + (long)b * (2 * 64 * 4608)) : ((long)seq * 32768);
#pragma unroll
      for (int i = 0; i < NVL; i++) {
        int c = tid + 256 * i;
        int dv = c >> 3, ch = c & 7;
        rv[u][i] = *(const u32x4*)((const bfr*)(p.ws + WS_VTA) + vb + (long)(kvh * 64 + dv) * nk + k0 + ch * 8);
      }
    } else {
      long kb = lat ? (16l * (4 * 256 * 64) + (long)b * (4 * 4608 * 64)) : ((long)seq * (4 * 256 * 64));
#pragma unroll
      for (int i = 0; i < 2; i++) {
        int c = tid + 256 * i;
        int kr_ = c >> 3, ch = c & 7;
        rk[u][i] = *(const u32x4*)((const bfr*)(p.ws + WS_KNOPE) + kb + ((long)head * nk + k0 + kr_) * 64 + ch * 8);
      }
      {
        int kr_ = tid >> 2, ch = tid & 3;
        const bfr* src = cache ? ((const bfr*)(p.ws + WS_KRC) + (long)(b * 512 + k0 + kr_) * 32 + ch * 8)
                               : (Z + (long)(tokrow0 + kr_) * ZLD + C_KR + ch * 8);
        rkr[u] = *(const u32x4*)src;
      }
      long vb = lat ? (16l * 131072 + (long)b * (4 * 128 * 4608)) : ((long)seq * 131072);
#pragma unroll
      for (int i = 0; i < NVL; i++) {
        int c = tid + 256 * i;
        int dv = c >> 3, ch = c & 7;
        rv[u][i] = *(const u32x4*)((const bfr*)(p.ws + WS_VTC) + vb + (long)(head * 128 + dv) * nk + k0 + ch * 8);
      }
    }
   }
  };

  f32x4 o[NQB][NDV];
#pragma unroll
  for (int qb = 0; qb < NQB; qb++)
#pragma unroll
    for (int d = 0; d < NDV; d++) o[qb][d] = (f32x4){0.f, 0.f, 0.f, 0.f};
  float mrun[NQB];
  f32x4 lacc[NQB];
#pragma unroll
  for (int qb = 0; qb < NQB; qb++) { mrun[qb] = 0.f; lacc[qb] = (f32x4){0.f, 0.f, 0.f, 0.f}; }
  const bf16x8 ones = (bf16x8){(short)0x3F80, (short)0x3F80, (short)0x3F80, (short)0x3F80, (short)0x3F80, (short)0x3F80, (short)0x3F80, (short)0x3F80};

  auto dma_issue = [&](int pi, bfr* stg0, bool doK = true, bool doV = true) {
#pragma unroll
   for (int u = 0; u < TP; u++) {
    bfr* stg = stg0 + u * BUF;
    const int k0 = (pi * TP + u) * 64;
    const bool cache = lat && (k0 < 512);
    const int tokrow0 = lat ? (NCTX + b * 4096 + k0 - 512) : (seq * 256 + k0);
    const int cK = (tid & 7) ^ (((tid >> 6) & 3) * 2 + ((tid >> 4) & 1));
    const int cV = (tid & 7) ^ ((tid >> 4) & 7);
    if (MLA) {
      const long kb = lat ? (16l * (4 * 256 * 64) + (long)b * (4 * 4608 * 64)) : ((long)seq * (4 * 256 * 64));
      const long vb = lat ? (16l * 131072 + (long)b * (4 * 128 * 4608)) : ((long)seq * 131072);
      if (doK) {
#pragma unroll
        for (int i = 0; i < 2; i++)
          glds16((const bfr*)(p.ws + WS_KNOPE) + kb + ((long)head * nk + k0 + i * 32 + (tid >> 3)) * 64 + cK * 8, stg + i * 2048 + tid * 8);
        const int row = tid >> 2, c = (tid & 3) ^ (((tid >> 6) & 1) * 2);
        const bfr* src = cache ? ((const bfr*)(p.ws + WS_KRC) + (long)(b * 512 + k0 + row) * 32 + c * 8)
                               : (Z + (long)(tokrow0 + row) * ZLD + C_KR + c * 8);
        glds16(src, stg + 4096 + tid * 8);
      }
      if (doV) {
#pragma unroll
        for (int i = 0; i < 4; i++)
          glds16((const bfr*)(p.ws + WS_VTC) + vb + (long)(head * 128 + i * 32 + (tid >> 3)) * nk + k0 + cV * 8, stg + 6144 + i * 2048 + tid * 8);
      }
    } else {
      const int kvh = head >> 2;
      const long vb = lat ? (16l * 32768 + (long)b * (2 * 64 * 4608)) : ((long)seq * 32768);
#pragma unroll
      for (int i = 0; i < 2; i++) {
        const int row = i * 32 + (tid >> 3);
        const bfr* src = cache ? ((const bfr*)(p.ws + WS_KCA) + (long)(b * 512 + k0 + row) * 128 + kvh * 64 + cK * 8)
                               : (Z + (long)(tokrow0 + row) * ZLD + C_KA + kvh * 64 + cK * 8);
        glds16(src, stg + i * 2048 + tid * 8);
      }
#pragma unroll
      for (int i = 0; i < 2; i++)
        glds16((const bfr*)(p.ws + WS_VTA) + vb + (long)(kvh * 64 + i * 32 + (tid >> 3)) * nk + k0 + cV * 8, stg + 4096 + i * 2048 + tid * 8);
    }
   }
  };
  auto qk = [&](const bfr* Ks, f32x4 (&sq)[NQB][4]) {
    bf16x8 kfr[4][NKK];
#pragma unroll
    for (int t = 0; t < 2; t++) {
      int krow = 32 * (t >> 1) + 8 * (l15 >> 2) + 4 * (t & 1) + (l15 & 3);
#pragma unroll
      for (int kk = 0; kk < NKK; kk++) kfr[t][kk] = *(const bf16x8*)kaddr(Ks, krow, kk);
    }
#pragma unroll
    for (int t = 0; t < 4; t++) {
#pragma unroll
      for (int qb = 0; qb < NQB; qb++) sq[qb][t] = (f32x4){-mrun[qb], -mrun[qb], -mrun[qb], -mrun[qb]};
      if (t + 2 < 4) {
        int krow = 32 * ((t + 2) >> 1) + 8 * (l15 >> 2) + 4 * ((t + 2) & 1) + (l15 & 3);
#pragma unroll
        for (int kk = 0; kk < NKK; kk++) kfr[t + 2][kk] = *(const bf16x8*)kaddr(Ks, krow, kk);
      }
#pragma unroll
      for (int kk = 0; kk < NKK; kk++) {
#pragma unroll
        for (int qb = 0; qb < NQB; qb++) sq[qb][t] = mfma16(kfr[t][kk], qf[qb][kk], sq[qb][t]);
      }
    }
  };
  auto smpv = [&](const bfr* Vs, bool first, f32x4 (&sc)[NQB][4], f32x4 (*later)[NQB][4], int nlater) {
    bf16x8 vfr[4][2];
#pragma unroll
    for (int d = 0; d < 4; d++)
#pragma unroll
      for (int sx = 0; sx < 2; sx++) vfr[d][sx] = *(const bf16x8*)vaddr(Vs, d, sx);
    bf16x8 pf[NQB][2];
#pragma unroll
    for (int qb = 0; qb < NQB; qb++) {
      float mt = sc[qb][0][0];
#pragma unroll
      for (int t = 0; t < 4; t++)
#pragma unroll
        for (int r = 0; r < 4; r++) mt = fmaxf(mt, sc[qb][t][r]);
      if (first || __builtin_amdgcn_ballot_w64(mt > 8.f) != 0ull) {
        mt = fmaxf(mt, __shfl_xor(mt, 16));
        mt = fmaxf(mt, __shfl_xor(mt, 32));
        const bool need = first || mt > 8.f;
        const float dm = need ? mt : 0.f;
        const float alpha = first ? 1.f : __builtin_amdgcn_exp2f(-dm);
        mrun[qb] += dm;
        lacc[qb] *= alpha;
#pragma unroll
        for (int d = 0; d < NDV; d++) o[qb][d] *= alpha;
#pragma unroll
        for (int t = 0; t < 4; t++) sc[qb][t] -= dm;
#pragma unroll
        for (int u2 = 0; u2 < 2; u2++)
          if (u2 < nlater) {
#pragma unroll
            for (int t = 0; t < 4; t++) later[u2][qb][t] -= dm;
          }
      }
#pragma unroll
      for (int t = 0; t < 4; t++)
#pragma unroll
        for (int r = 0; r < 4; r++) sc[qb][t][r] = __builtin_amdgcn_exp2f(sc[qb][t][r]);
#pragma unroll
      for (int sx = 0; sx < 2; sx++) {
        u32x4 uu;
        uu.x = pack2(sc[qb][2 * sx][0], sc[qb][2 * sx][1]);
        uu.y = pack2(sc[qb][2 * sx][2], sc[qb][2 * sx][3]);
        uu.z = pack2(sc[qb][2 * sx + 1][0], sc[qb][2 * sx + 1][1]);
        uu.w = pack2(sc[qb][2 * sx + 1][2], sc[qb][2 * sx + 1][3]);
        pf[qb][sx] = *(bf16x8*)&uu;
      }
    }
#pragma unroll
    for (int d = 0; d < NDV; d++) {
#pragma unroll
      for (int sx = 0; sx < 2; sx++) {
#pragma unroll
        for (int qb = 0; qb < NQB; qb++) o[qb][d] = mfma16(vfr[d & 3][sx], pf[qb][sx], o[qb][d]);
      }
      if (d + 4 < NDV) {
#pragma unroll
        for (int sx = 0; sx < 2; sx++) vfr[d & 3][sx] = *(const bf16x8*)vaddr(Vs, d + 4, sx);
      }
    }
#pragma unroll
    for (int sx = 0; sx < 2; sx++) {
#pragma unroll
      for (int qb = 0; qb < NQB; qb++) lacc[qb] = mfma16(ones, pf[qb][sx], lacc[qb]);
    }
  };

  if (LA) {
    bfr* st0 = sm;
    bfr* st1 = sm + BUF;
    dma_issue(0, st0, true, true);
    if (nkt > 1) dma_issue(1, st1, true, false);
    asm volatile("s_waitcnt vmcnt(0)" ::: "memory");
    __syncthreads();
    f32x4 scur[1][NQB][4], snext[1][NQB][4];
    qk(st0, scur[0]);
    __syncthreads();
    for (int j = 0; j < nkt; j++) {
      bfr* sj = (j & 1) ? st1 : st0;
      bfr* sn = (j & 1) ? st0 : st1;
      if (j + 1 < nkt) dma_issue(j + 1, sn, false, true);
      if (j + 2 < nkt) dma_issue(j + 2, sj, true, false);
      const bool more = (j + 1 < nkt);
      if (more) qk(sn, snext[0]);
      smpv(sj + KSZ, j == 0, scur[0], snext, more ? 1 : 0);
      if (more) {
#pragma unroll
        for (int qb = 0; qb < NQB; qb++)
#pragma unroll
          for (int t = 0; t < 4; t++) scur[0][qb][t] = snext[0][qb][t];
      }
      asm volatile("s_waitcnt vmcnt(0)" ::: "memory");
      __syncthreads();
    }
  } else {
  if (DMA) dma_issue(0, sm); else prefetch(0);
  const int np = nkt / TP;
  for (int pi = 0; pi < np; pi++) {
    bfr* base = sm + (pi & 1) * (TP * BUF);
    if (DMA) {
      asm volatile("s_waitcnt vmcnt(0)" ::: "memory");
      __syncthreads();
      if (pi + 1 < np) dma_issue(pi + 1, sm + ((pi + 1) & 1) * (TP * BUF));
    } else {
#pragma unroll
      for (int u = 0; u < TP; u++) {
        bfr* Ks = base + u * BUF;
        bfr* Vs = Ks + KSZ;
#pragma unroll
        for (int i = 0; i < 2; i++) {
          int c = tid + 256 * i;
          *(u32x4*)(Ks + (c >> 3) * KLD + (c & 7) * 8) = rk[u][i];
        }
        if (MLA) *(u32x4*)(Ks + (tid >> 2) * KLD + 64 + (tid & 3) * 8) = rkr[u];
#pragma unroll
        for (int i = 0; i < NVL; i++) {
          int c = tid + 256 * i;
          *(u32x4*)(Vs + (c >> 3) * LDT + (c & 7) * 8) = rv[u][i];
        }
      }
      __syncthreads();
      if (pi + 1 < np) prefetch(pi + 1);
    }
    f32x4 sa[TP][NQB][4];
#pragma unroll
    for (int u = 0; u < TP; u++) qk(base + u * BUF, sa[u]);
#pragma unroll
    for (int u = 0; u < TP; u++) smpv(base + u * BUF + KSZ, pi * TP + u == 0, sa[u], &sa[(u + 1 < TP) ? u + 1 : u], TP - 1 - u);
  }
  }
  __syncthreads();
#pragma unroll
  for (int qb = 0; qb < NQB; qb++) {
    float inv = 1.f / lacc[qb][0];
    int qrow = rowbase + qoff + wid * (16 * NQB) + qb * 16 + l15;
    bfr* gp = Z + (long)qrow * ZLD + (MLA ? C_GC : C_GA) + head * DV + g * 4;
#pragma unroll
    for (int d = 0; d < NDV; d++) {
      u32x2 gr = *(const u32x2*)(gp + d * 16);
      float y0 = o[qb][d][0] * inv * siluf(lo16(gr.x));
      float y1 = o[qb][d][1] * inv * siluf(hi16(gr.x));
      float y2 = o[qb][d][2] * inv * siluf(lo16(gr.y));
      float y3 = o[qb][d][3] * inv * siluf(hi16(gr.y));
      u32x2 ov;
      ov.x = pack2(y0, y1);
      ov.y = pack2(y2, y3);
      if (!dry) *(u32x2*)(gp + d * 16) = ov;
    }
  }
}

__device__ __forceinline__ void phase_mixers(const Params& p, int l, bfr* sm, int* s_item, int dry) {
  unsigned* ctr = (unsigned*)(p.ws + WS_CTR) + (2 + l + 2 * dry) * 128;
  auto cnt = [](int) { return 184; };
  int q = (int)xcc_id(), tried = 0;
  for (;;) {
    if (TIDX == 0) {
      unsigned first = atomicAdd(ctr + q * 16, 1u);
      *s_item = xq_take(ctr, q, tried, first, cnt);
    }
    __syncthreads();
    const int it = *s_item;
    __syncthreads();
    if (it < 0) break;
    const int x = it >> 20, j = it & 0xfffff;
    int kind, a0, a1, a2, a3 = 0;
    if (j < 4) {
      int idx = x * 4 + j;
      kind = 3; a0 = idx >> 4; a1 = (idx >> 2) & 3; a2 = (idx >> 1) & 1; a3 = idx & 1;
    } else if (j < 36) {
      kind = 1; a0 = 16 + (x >> 2); a1 = x & 3; a2 = (j - 4) * 128;
    } else if (j < 96) {
      int i = j - 36;
      kind = 2; a0 = 16 + (x >> 2); a1 = ((x >> 1) & 1) * 4 + (x & 1) * 2 + (i >> 5); a2 = (i & 31) * 128;
    } else if (j < 104) {
      int k = j - 96;
      int i = 60 + (k >> 1);
      kind = 4; a0 = 16 + (x >> 2); a1 = ((x >> 1) & 1) * 4 + (x & 1) * 2 + (i >> 5); a2 = (i & 31) * 128 + (k & 1) * 64;
    } else if (j < 136) {
      int i = j - 104;
      kind = 0; a0 = 2 * x + (i >> 4); a1 = (i >> 2) & 3; a2 = (i >> 1) & 1; a3 = i & 1;
    } else if (j < 152) {
      int i = j - 136;
      kind = 1; a0 = 2 * x + (i >> 3); a1 = (i >> 1) & 3; a2 = (i & 1) * 128;
    } else {
      int i = j - 152;
      kind = 2; a0 = 2 * x + (i >> 4); a1 = (i >> 1) & 7; a2 = (i & 1) * 128;
    }
#ifdef PROBE_MIXKIND
    if (dry && ((PROBE_MIXKIND == 1) != (kind == 0 || kind == 3))) continue;
#endif
    if (kind == 0) gla_item<64>(p, l, a0, a1, a2, a3, sm);
    else if (kind == 3) gla_chain_item(p, l, a0, a1, a2, a3, sm);
    else if (kind == 1) attn_item<96, 128, true, 2, true, 1, true>(p, a0, a1, a2, sm, dry);
    else if (kind == 2) attn_item<64, 64, false, 2, true, 2>(p, a0, a1, a2, sm, dry);
    else attn_item<64, 64, false, 1, true, 2>(p, a0, a1, a2, sm, dry);
  }
}

__device__ __forceinline__ void phase_gla_out(const Params& p, int l) {
  const int lane = TIDX & 63;
  bfr* Z = (bfr*)(p.ws + WS_Z);
  const bfr* OF = (const bfr*)(p.ws + WS_R1);
  const bfr* OB = OF + (long)NROWS * 512;
  for (int row = blockIdx.x * 4 + (TIDX >> 6); row < NROWS; row += gridDim.x * 4) {
    float a[8], c[8], gt[8];
    unpack8(*(const u32x4*)(OF + (long)row * 512 + lane * 8), a);
    unpack8(*(const u32x4*)(OB + (long)row * 512 + lane * 8), c);
    bfr* gp = Z + (long)row * ZLD + C_GG + lane * 8;
    unpack8(*(const u32x4*)gp, gt);
    float ss = 0.f;
#pragma unroll
    for (int e = 0; e < 8; e++) {
      a[e] = bf2f(f2bf(a[e] + c[e]));
      ss += a[e] * a[e];
    }
    ss += __shfl_xor(ss, 1); ss += __shfl_xor(ss, 2); ss += __shfl_xor(ss, 4); ss += __shfl_xor(ss, 8);
    float rs = rsqrtf(ss * (1.f / 128.f) + 1e-6f);
    const float* gg = p.in[21] + l * 128 + (lane & 15) * 8;
#pragma unroll
    for (int e = 0; e < 8; e++) a[e] = a[e] * rs * gg[e] * siluf(gt[e]);
    *(u32x4*)gp = pack8(a);
  }
}

template <int NQ>
__device__ __forceinline__ void merge_tile(const Params& p, bfr* sm, int tn, int tok0) {
  constexpr int STG = 8192 + 2048 * NQ;
  bfr* Z = (bfr*)(p.ws + WS_Z);
  bfr* MG = (bfr*)(p.ws + WS_R1);
  const int tid = TIDX;
  const int lane = tid & 63, wid = tid >> 6, wr = wid >> 1, wc = wid & 1, g = lane >> 4, l15 = lane & 15;
  f32x4 totl[4][NQ];
#pragma unroll
  for (int a = 0; a < 4; a++)
#pragma unroll
    for (int b = 0; b < NQ; b++) totl[a][b] = (f32x4){0.f, 0.f, 0.f, 0.f};
#pragma unroll 1
  for (int seg = 0; seg < 3; seg++) {
    f32x4 acc[4][NQ];
#pragma unroll
    for (int a = 0; a < 4; a++)
#pragma unroll
      for (int b = 0; b < NQ; b++) acc[a][b] = (f32x4){0.f, 0.f, 0.f, 0.f};
    int ycol = seg == 0 ? C_GA : (seg == 1 ? C_GG : C_GC);
    int mcol = C_M1 + seg * 1024;
    const bfr* W = (const bfr*)(p.ws + WS_WOA + (unsigned long)seg * 1048576ul) + (long)tn * 128 * 512;
    gemm128k64<NQ, false, true>(W, 512, 128, Z + (long)tok0 * ZLD + ycol, ZLD, 512, acc, sm,
                                Z + (long)tok0 * ZLD + mcol + tn * 128, ZLD);
    const bfr* gt = sm;
#pragma unroll
    for (int pi = 0; pi < 4; pi++) {
      const int nl = wr * 64 + pi * 16 + g * 4;
#pragma unroll
      for (int qi = 0; qi < NQ; qi++) {
        const int tl = wc * 16 * NQ + qi * 16 + l15;
        u32x2 mr = *(const u32x2*)(gt + tl * 128 + (((nl >> 3) ^ (tl & 15)) * 8) + (nl & 4));
        totl[pi][qi][0] += sigmf(lo16(mr.x)) * acc[pi][qi][0];
        totl[pi][qi][1] += sigmf(hi16(mr.x)) * acc[pi][qi][1];
        totl[pi][qi][2] += sigmf(lo16(mr.y)) * acc[pi][qi][2];
        totl[pi][qi][3] += sigmf(hi16(mr.y)) * acc[pi][qi][3];
      }
    }
    __syncthreads();
  }
#pragma unroll
  for (int pi = 0; pi < 4; pi++)
#pragma unroll
    for (int qi = 0; qi < NQ; qi++) {
      u32x2 o;
      o.x = pack2(totl[pi][qi][0], totl[pi][qi][1]);
      o.y = pack2(totl[pi][qi][2], totl[pi][qi][3]);
      *(u32x2*)(sm + (wc * 16 * NQ + qi * 16 + l15) * 136 + wr * 64 + pi * 16 + g * 4) = o;
    }
  __syncthreads();
#pragma unroll
  for (int i = 0; i < 2 * NQ; i++) {
    int c = tid + 256 * i;
    int row = c >> 4, c16 = c & 15;
    *(u32x4*)(MG + (long)(tok0 + row) * 1024 + tn * 128 + c16 * 8) = *(const u32x4*)(sm + row * 136 + c16 * 8);
  }
  __syncthreads();
}

__device__ __forceinline__ void phase_merge(const Params& p, bfr* sm) {
  for (int t = blockIdx.x; t < 1024; t += gridDim.x) {
    if (t < 512) {
      merge_tile<4>(p, sm, (t >> 3) & 7, ((t & 7) + 8 * (t >> 6)) * 128);
    } else {
      int u = t - 512;
      int full = 512 + (u >> 1);
      merge_tile<2>(p, sm, full & 7, (full >> 3) * 128 + (u & 1) * 64);
    }
  }
}

template <int NQ>
__device__ __forceinline__ void outproj_tile(const Params& p, bfr* sm, int tn, int tok0) {
  const bfr* MG = (const bfr*)(p.ws + WS_R1);
  float* OUT = (float*)(p.ws + WS_Z);
  const int tid = TIDX;
  const int lane = tid & 63, wid = tid >> 6, wr = wid >> 1, wc = wid & 1, g = lane >> 4, l15 = lane & 15;
  f32x4 acc[4][NQ];
#pragma unroll
  for (int a = 0; a < 4; a++)
#pragma unroll
    for (int b = 0; b < NQ; b++) acc[a][b] = (f32x4){0.f, 0.f, 0.f, 0.f};
  gemm128k64<NQ, true>((const bfr*)(p.ws + WS_WOUT) + (long)tn * 128 * 1024, 1024, 128, MG + (long)tok0 * 1024, 1024, 1024, acc, sm);
  float* smf = (float*)sm;
#pragma unroll
  for (int pi = 0; pi < 4; pi++)
#pragma unroll
    for (int qi = 0; qi < NQ; qi++)
      *(f32x4*)(smf + (wc * 16 * NQ + qi * 16 + l15) * 132 + wr * 64 + pi * 16 + g * 4) = acc[pi][qi];
  __syncthreads();
#pragma unroll
  for (int i = 0; i < 4 * NQ; i++) {
    int c = tid + 256 * i;
    int row = c >> 5, c16 = c & 31;
    *(f32x4*)(OUT + (long)(tok0 + row) * 1024 + tn * 128 + c16 * 4) = *(const f32x4*)(smf + row * 132 + c16 * 4);
  }
  __syncthreads();
}
__device__ __forceinline__ void phase_outproj(const Params& p, bfr* sm) {
  for (int t = blockIdx.x; t < 1024; t += gridDim.x) {
    if (t < 512) {
      outproj_tile<4>(p, sm, (t >> 3) & 7, ((t & 7) + 8 * (t >> 6)) * 128);
    } else {
      int u = t - 512;
      int full = 512 + (u >> 1);
      outproj_tile<2>(p, sm, full & 7, (full >> 3) * 128 + (u & 1) * 64);
    }
  }
}

__device__ __forceinline__ void phase_post(const Params& p, int l) {
  const int lane = TIDX & 63;
  const float* mod = (const float*)(p.ws + WS_MOD);
  const float* OUT = (const float*)(p.ws + WS_Z);
  bfr* H = (bfr*)(p.ws + WS_R1);
  for (int row = blockIdx.x * 4 + (TIDX >> 6); row < NROWS; row += gridDim.x * 4) {
    const float* x = (l == 0) ? xrow(p, row) : (p.out + (long)row * 1024);
    const float* md = mod + (l * 3 + row_cond(row)) * 3072;
    float4 v[4];
    float ss = 0.f;
#pragma unroll
    for (int i = 0; i < 4; i++) {
      v[i] = *(const float4*)(OUT + (long)row * 1024 + i * 256 + lane * 4);
      ss += v[i].x * v[i].x + v[i].y * v[i].y + v[i].z * v[i].z + v[i].w * v[i].w;
    }
    ss = wave_sum(ss);
    float rs = rsqrtf(ss * (1.f / 1024.f) + 1e-6f);
    float ss2 = 0.f;
#pragma unroll
    for (int i = 0; i < 4; i++) {
      int n = i * 256 + lane * 4;
      float4 g = *(const float4*)(p.in[13] + l * 1024 + n);
      float4 gt = *(const float4*)(md + 2048 + n);
      float4 xv = *(const float4*)(x + n);
      v[i].x = xv.x + gt.x * (v[i].x * rs * g.x);
      v[i].y = xv.y + gt.y * (v[i].y * rs * g.y);
      v[i].z = xv.z + gt.z * (v[i].z * rs * g.z);
      v[i].w = xv.w + gt.w * (v[i].w * rs * g.w);
      *(float4*)(p.out + (long)row * 1024 + n) = v[i];
      ss2 += v[i].x * v[i].x + v[i].y * v[i].y + v[i].z * v[i].z + v[i].w * v[i].w;
    }
    if (l == 0) {
      ss2 = wave_sum(ss2);
      float rs2 = rsqrtf(ss2 * (1.f / 1024.f) + 1e-6f);
      const float* md1 = mod + (1 * 3 + row_cond(row)) * 3072;
#pragma unroll
      for (int i = 0; i < 4; i++) {
        int n = i * 256 + lane * 4;
        float4 g = *(const float4*)(p.in[12] + 1024 + n);
        float4 sh = *(const float4*)(md1 + n);
        float4 sc = *(const float4*)(md1 + 1024 + n);
        float h0 = v[i].x * rs2 * g.x * (1.f + sc.x) + sh.x;
        float h1 = v[i].y * rs2 * g.y * (1.f + sc.y) + sh.y;
        float h2 = v[i].z * rs2 * g.z * (1.f + sc.z) + sh.z;
        float h3 = v[i].w * rs2 * g.w * (1.f + sc.w) + sh.w;
        u32x2 o;
        o.x = pack2(h0, h1);
        o.y = pack2(h2, h3);
        *(u32x2*)(H + (long)row * 1024 + n) = o;
      }
    }
  }
}

__global__ void __launch_bounds__(256, 2) fwd_megakernel(Params p) {
  __shared__ __attribute__((aligned(16))) bfr sm[SMEM_SHORTS + 16];
  int* s_item_p = (int*)(sm + SMEM_SHORTS + 8);
  cg::grid_group grid = cg::this_grid();
  if (threadIdx.x == 0) { ((unsigned*)(sm + SMEM_SHORTS))[0] = 0u; ((unsigned*)(sm + SMEM_SHORTS))[1] = 0u; }
  __syncthreads();
  XcdBarrier xb = xcd_barrier_post((unsigned*)(p.ws + WS_BAR), (volatile LAS unsigned*)(sm + SMEM_SHORTS));
  if (p.ws == nullptr) grid.sync();
  (void)xb;
#define GSYNC1 do { XcdBarrier b_; b_.bar = (unsigned*)(p.ws + WS_BAR); b_.x = xb_xcc_id(); \
                    b_.st = (volatile LAS unsigned*)(sm + SMEM_SHORTS); xcd_barrier(b_); } while (0)
#ifdef PROBE_SYNC
#define GSYNC do { GSYNC1; GSYNC1; } while (0)
#else
#define GSYNC GSYNC1
#endif
#ifdef PROBE_PRE
  phase_s0(launder(p), sm);
  GSYNC;
  phase_s1(launder(p));
  wconv_phase(p, 0, sm);
  GSYNC;
  phase_prenorm0(launder(p));
  GSYNC;
#endif

#ifndef PH
#define PH 0xffff
#endif
#if PH & 1
  phase_s0(launder(p), sm);
  wconv_phase(p, 0, sm);
#endif
  GSYNC;
#if PH & 2
  phase_s1(launder(p));
#endif
  GSYNC;
#if PH & 4
  phase_prenorm0(launder(p));
#endif
  GSYNC;
  for (int l = 0; l < 2; l++) {
#if PH & 8
#ifdef PROBE_INPROJ
    phase_inproj(launder(p), l, sm, s_item_p, 6 + l);
    GSYNC;
#endif
    phase_inproj(launder(p), l, sm, s_item_p, l);
#endif
    GSYNC;
#if PH & 16
    phase_rowpost(launder(p), l);
#endif
    GSYNC;
#if PH & 32
#ifdef PROBE_MLAUP
    phase_mla_up(launder(p), l, sm);
    GSYNC;
#endif
    phase_mla_up(launder(p), l, sm);
#endif
    GSYNC;
#if PH & 64
#ifdef PROBE_MIX
    { int dry = 1; asm volatile("" : "+s"(dry)); phase_mixers(launder(p), l, sm, s_item_p, dry); }
    GSYNC;
#endif
    { int dry = 0; asm volatile("" : "+s"(dry)); phase_mixers(launder(p), l, sm, s_item_p, dry); }
#endif
    GSYNC;
#if PH & 128
    phase_gla_out(launder(p), l);
#endif
    GSYNC;
#if PH & 256
#ifdef PROBE_MERGE
    phase_merge(launder(p), sm);
    GSYNC;
#endif
    phase_merge(launder(p), sm);
#endif
    GSYNC;
#if PH & 512
#ifdef PROBE_MERGE
    phase_outproj(launder(p), sm);
    GSYNC;
#endif
    phase_outproj(launder(p), sm);
#endif
    GSYNC;
#if PH & 1024
    phase_post(launder(p), l);
    if (l == 0) wconv_phase(p, 1, sm);
#endif
    if (l == 0) GSYNC;
  }
}

extern "C" void kernel_launch(void* const* d_in, const int* in_sizes, int n_in, void* d_out, int out_size, void* d_ws,
                              size_t ws_size, hipStream_t stream) {
  static int grid_blocks = 0;
  if (!grid_blocks) {
    int dev = 0, cus = 0, per_cu = 0;
    hipGetDevice(&dev);
    hipDeviceGetAttribute(&cus, hipDeviceAttributeMultiprocessorCount, dev);
    hipOccupancyMaxActiveBlocksPerMultiprocessor(&per_cu, fwd_megakernel, 256, 0);
    if (per_cu > 2) per_cu = 2;
    if (per_cu < 1) per_cu = 1;
    grid_blocks = cus * per_cu;
  }
  Params p{};
  for (int i = 0; i < 30; i++) p.in[i] = (const float*)d_in[i];
  p.out = (float*)d_out;
  p.ws = (unsigned char*)d_ws;
  hipMemsetAsync(d_ws, 0, 20480, stream);
  void* args[] = {&p};
  hipError_t e = hipLaunchCooperativeKernel((void*)fwd_megakernel, dim3(grid_blocks), dim3(256), args, 0, stream);
  if (e != hipSuccess) fprintf(stderr, "cooperative launch failed: %s (grid %d)\n", hipGetErrorString(e), grid_blocks);
}
```
